# Optimizing an MI355X kernel written in HIP

```python
import jax
import jax.numpy as jnp
from jax import lax
import numpy as np

D_MODEL = 1024
BATCH = 2
SEQ = 16384
DEPTH = 1

GRID_W = 64
CTX_LEN = 256
D_A = 1024
HEAD_A = 64
N_HEADS_A = D_A // HEAD_A
DECAY_LORA = 64
ICLR_LORA = 64
GATE_LORA = 128
N_DIR = 2
D_B = 512
POOL_WINDOWS = (2, 4, 8, 16)
POOL_GROUP = D_B // len(POOL_WINDOWS)
N_BRANCH = 2
PEER_HEADS = 8
PEER_NKEYS = 128
PEER_EXPERTS = PEER_NKEYS * PEER_NKEYS
PEER_QDIM = 256
PEER_HALF = PEER_QDIM // 2
PEER_TOPK = 16
PEER_BLOCK = 128
RMS_EPS = 1e-6
GN_EPS = 64e-5
L2_EPS = 1e-12
SHIFT_COLS = 3 * D_A + N_DIR * DECAY_LORA + N_DIR * ICLR_LORA + GATE_LORA
IN_COLS = SHIFT_COLS + D_B + N_BRANCH * D_MODEL

kernel_name = 'hybrid_rwkv7_pool_peer_dit_block'


def rms_norm(x, g):
    xf = x.astype(jnp.float32)
    y = xf * lax.rsqrt(jnp.mean(xf * xf, axis=-1, keepdims=True) + RMS_EPS)
    return (y * g.astype(jnp.float32)).astype(x.dtype)


def ada_split(cond, w_mod, b_mod):
    m = jax.nn.silu(cond) @ w_mod + b_mod
    return jnp.split(m, 6, axis=-1)


def token_shift_mix(z, mu):
    prev = jnp.pad(z[:, :-1], ((0, 0), (1, 0), (0, 0)))
    nxt = jnp.pad(z[:, 1:], ((0, 0), (0, 1), (0, 0)))
    return z + mu * (0.5 * (prev + nxt) - z)


def split_heads(t):
    return t.reshape(t.shape[:-1] + (N_HEADS_A, HEAD_A))


def rwkv_prepare(zs, w0, w2, a0, a2, g2, k_k, k_a):
    B, T, _ = zs.shape
    bounds = [int(b) for b in np.cumsum([0, D_A, D_A, D_A, N_DIR * DECAY_LORA, N_DIR * ICLR_LORA, GATE_LORA])]
    r, k, v, wd, ad, gd = [zs[..., bounds[i]:bounds[i + 1]] for i in range(6)]
    wd = wd.reshape(B, T, N_DIR, DECAY_LORA)
    ad = ad.reshape(B, T, N_DIR, ICLR_LORA)
    w_log = -jax.nn.softplus(-(w0 + jnp.einsum('btdl,dlc->btdc', jnp.tanh(wd), w2))) - 0.5
    decay = jnp.exp(-jnp.exp(w_log.astype(jnp.float32)))
    iclr = jax.nn.sigmoid(a0 + jnp.einsum('btdl,dlc->btdc', ad, a2))
    gate = jax.nn.sigmoid(gd) @ g2
    kk = split_heads(k * k_k).astype(jnp.float32)
    kk = kk * lax.rsqrt(jnp.maximum(jnp.sum(kk * kk, axis=-1, keepdims=True), L2_EPS * L2_EPS))
    k_dir = k[:, :, None, :] * (1.0 + (iclr - 1.0) * k_a)
    return dict(r=split_heads(r), k_dir=split_heads(k_dir), v=split_heads(v), kk=kk,
                decay=split_heads(decay), iclr=split_heads(iclr), gate=gate)


def both_directions(t, per_dir):
    f, b = (t[:, :, 0], t[:, :, 1]) if per_dir else (t, t)
    return jnp.stack([f, b[:, ::-1]], axis=2).astype(jnp.float32).swapaxes(0, 1)


def rwkv_step(S, inp):
    r, w, k, v, a, b = inp
    sa = jnp.einsum('bdhvk,bdhk->bdhv', S, a)
    S = S * w[..., None, :] + sa[..., None] * b[..., None, :] + v[..., None] * k[..., None, :]
    return S, jnp.einsum('bdhvk,bdhk->bdhv', S, r)


def rwkv_scan(S0, prep):
    xs = (both_directions(prep['r'], False),
          both_directions(prep['decay'], True),
          both_directions(prep['k_dir'], True),
          both_directions(prep['v'], False),
          -both_directions(prep['kk'], False),
          both_directions(prep['kk'][:, :, None] * prep['iclr'], True))
    S, ys = lax.scan(rwkv_step, S0, xs)
    ys = ys.swapaxes(0, 1)
    return S, ys[:, :, 0] + ys[:, ::-1, 1]


def rwkv_readout(y, prep, r_k, ln_w, ln_b, w_a_out):
    dt = prep['gate'].dtype
    mu = jnp.mean(y, axis=-1, keepdims=True)
    var = jnp.mean(jnp.square(y - mu), axis=-1, keepdims=True)
    yn = ((y - mu) * lax.rsqrt(var + GN_EPS)).reshape(y.shape[:2] + (D_A,))
    yn = yn * ln_w.astype(jnp.float32) + ln_b.astype(jnp.float32)
    k_b = jnp.mean(prep['k_dir'], axis=2)
    bonus = jnp.sum(prep['r'] * k_b * split_heads(r_k), axis=-1, keepdims=True) * prep['v']
    out = (yn.astype(dt) + bonus.reshape(y.shape[:2] + (D_A,))) * prep['gate']
    return out @ w_a_out


def box_mean_grid(u, window, rows):
    B, T, C = u.shape
    g = u.astype(jnp.float32).reshape(B, rows, GRID_W, C)
    P = jnp.pad(jnp.cumsum(jnp.cumsum(g, axis=1), axis=2), ((0, 0), (1, 0), (1, 0), (0, 0)))
    half = window // 2
    ri = jnp.arange(rows)
    ci = jnp.arange(GRID_W)
    r0, r1 = jnp.clip(ri - half, 0, rows), jnp.clip(ri + half, 0, rows)
    c0, c1 = jnp.clip(ci - half, 0, GRID_W), jnp.clip(ci + half, 0, GRID_W)
    corner = lambda ra, ca: jnp.take(jnp.take(P, ra, axis=1), ca, axis=2)
    s = corner(r1, c1) - corner(r0, c1) - corner(r1, c0) + corner(r0, c0)
    cnt = ((r1 - r0)[:, None] * (c1 - c0)[None, :]).astype(jnp.float32)[None, :, :, None]
    return (s / cnt).reshape(B, T, C).astype(u.dtype) - u


def window_mean_seq(u, window):
    T = u.shape[1]
    P = jnp.pad(jnp.cumsum(u.astype(jnp.float32), axis=1), ((0, 0), (1, 0), (0, 0)))
    t = jnp.arange(T)
    lo, hi = jnp.clip(t - window // 2, 0, T), jnp.clip(t + window // 2, 0, T)
    s = jnp.take(P, hi, axis=1) - jnp.take(P, lo, axis=1)
    return (s / (hi - lo).astype(jnp.float32)[None, :, None]).astype(u.dtype) - u


def pool_branch(u, mean_fn, w_pool, pool_scale, w_b_out):
    outs = [jnp.einsum('btc,cd->btd', mean_fn(u[..., j * POOL_GROUP:(j + 1) * POOL_GROUP], win), w_pool[j])
            for j, win in enumerate(POOL_WINDOWS)]
    return (jnp.concatenate(outs, axis=-1) * pool_scale) @ w_b_out


def merge_branches(z, ya, mean_fn, b_gate, w_pool, pool_scale, w_b_out, w_o):
    yb = pool_branch(z[..., SHIFT_COLS:SHIFT_COLS + D_B], mean_fn, w_pool, pool_scale, w_b_out)
    gates = jax.nn.sigmoid(z[..., SHIFT_COLS + D_B:] + b_gate)
    m = gates[..., :D_MODEL] * ya + gates[..., D_MODEL:] * yb
    return m @ w_o


def peer_ffn(h, w_q, sub_keys, u_emb, v_emb):
    B, T, D = h.shape
    hb = h.reshape(-1, PEER_BLOCK, D)

    def block(xb):
        n = xb.shape[0]
        q = (xb @ w_q).reshape(n, PEER_HEADS, 2, PEER_HALF)
        s = jnp.einsum('nhpq,hpkq->nhpk', q, sub_keys)
        sv, si = lax.top_k(s, PEER_TOPK)
        cand = sv[:, :, 0, :, None] + sv[:, :, 1, None, :]
        cand_idx = si[:, :, 0, :, None] * PEER_NKEYS + si[:, :, 1, None, :]
        cs, ci = lax.top_k(cand.reshape(n, PEER_HEADS, PEER_TOPK * PEER_TOPK), PEER_TOPK)
        idx = jnp.take_along_axis(cand_idx.reshape(n, PEER_HEADS, -1), ci, axis=-1)
        gate = jax.nn.softmax(cs.astype(jnp.float32), axis=-1).astype(xb.dtype)
        ue = jnp.take(u_emb, idx, axis=0)
        act = jax.nn.gelu(jnp.einsum('nhed,nd->nhe', ue, xb), approximate=False)
        ve = jnp.take(v_emb, idx, axis=0)
        return jnp.einsum('nhe,nhed->nd', gate * act, ve)

    return lax.map(block, hb).reshape(B, T, D)


def setup_inputs(seed: int = 0) -> dict:
    key = jax.random.key(seed)
    ks = list(jax.random.split(key, 32))
    L, D = DEPTH, D_MODEL

    def nrm(i, shape, scale):
        return jax.random.normal(ks[i], shape, jnp.float32) * scale

    return {
        'x': nrm(0, (BATCH, SEQ, D), 1.0),
        'c': nrm(1, (BATCH, D), 1.0),
        'ctx': nrm(2, (BATCH, CTX_LEN, D), 1.0),
        'c_ctx': nrm(3, (D,), 1.0),
        'w_mod': nrm(4, (L, D, 6 * D), 0.5 * D ** -0.5),
        'b_mod': nrm(5, (L, 6 * D), 0.02),
        'g_pre_mix': 1.0 + nrm(6, (L, D), 0.05),
        'g_post_mix': 1.0 + nrm(7, (L, D), 0.05),
        'g_pre_ffn': 1.0 + nrm(8, (L, D), 0.05),
        'g_post_ffn': 1.0 + nrm(9, (L, D), 0.05),
        'w_in': nrm(10, (L, D, IN_COLS), D ** -0.5),
        'b_gate': nrm(11, (L, N_BRANCH * D), 0.02),
        'mu_shift': jax.random.uniform(ks[12], (L, SHIFT_COLS), jnp.float32),
        'w0': jax.random.uniform(ks[13], (L, N_DIR, D_A), jnp.float32, -6.0, -1.0),
        'w2': nrm(14, (L, N_DIR, DECAY_LORA, D_A), 0.1 * DECAY_LORA ** -0.5),
        'a0': nrm(15, (L, N_DIR, D_A), 0.1),
        'a2': nrm(16, (L, N_DIR, ICLR_LORA, D_A), 0.1 * ICLR_LORA ** -0.5),
        'g2': nrm(17, (L, GATE_LORA, D_A), GATE_LORA ** -0.5),
        'k_k': 0.85 + nrm(18, (L, D_A), 0.05),
        'k_a': 1.0 + nrm(19, (L, D_A), 0.05),
        'r_k': nrm(20, (L, D_A), 0.1),
        'ln_x_w': 1.0 + nrm(21, (L, D_A), 0.05),
        'ln_x_b': nrm(22, (L, D_A), 0.02),
        'w_a_out': nrm(23, (L, D_A, D), D_A ** -0.5),
        'w_pool': nrm(24, (L, len(POOL_WINDOWS), POOL_GROUP, POOL_GROUP), POOL_GROUP ** -0.5),
        'pool_scale': 1.0 + nrm(25, (L, D_B), 0.05),
        'w_b_out': nrm(26, (L, D_B, D), D_B ** -0.5),
        'w_o': nrm(27, (L, D, D), D ** -0.5),
        'peer_wq': nrm(28, (L, D, PEER_HEADS * PEER_QDIM), D ** -0.5),
        'peer_keys': nrm(29, (L, PEER_HEADS, 2, PEER_NKEYS, PEER_HALF), PEER_HALF ** -0.5),
        'peer_u': nrm(30, (L, PEER_EXPERTS, D), D ** -0.5),
        'peer_v': nrm(31, (L, PEER_EXPERTS, D), D ** -0.5),
    }


def reference(x, c, ctx, c_ctx, w_mod, b_mod, g_pre_mix, g_post_mix, g_pre_ffn, g_post_ffn,
              w_in, b_gate, mu_shift, w0, w2, a0, a2, g2, k_k, k_a, r_k, ln_x_w, ln_x_b,
              w_a_out, w_pool, pool_scale, w_b_out, w_o, peer_wq, peer_keys, peer_u, peer_v):
    rows = x.shape[1] // GRID_W
    grid_mean = lambda u, win: box_mean_grid(u, win, rows)
    state0 = jnp.zeros((x.shape[0], N_DIR, N_HEADS_A, HEAD_A, HEAD_A), jnp.float32)
    for l in range(DEPTH):
        last = l == DEPTH - 1
        sh1, sc1, gt1, sh2, sc2, gt2 = [t[:, None, :] for t in ada_split(c, w_mod[l], b_mod[l])]
        csh1, csc1, cgt1, csh2, csc2, cgt2 = ada_split(c_ctx, w_mod[l], b_mod[l])
        hx = rms_norm(x, g_pre_mix[l]) * (1.0 + sc1) + sh1
        hc = rms_norm(ctx, g_pre_mix[l]) * (1.0 + csc1) + csh1
        zx = hx @ w_in[l]
        zc = hc @ (w_in[l][:, :SHIFT_COLS] if last else w_in[l])
        rw = (w0[l], w2[l], a0[l], a2[l], g2[l], k_k[l], k_a[l])
        prep_c = rwkv_prepare(token_shift_mix(zc[..., :SHIFT_COLS], mu_shift[l]), *rw)
        prep_x = rwkv_prepare(token_shift_mix(zx[..., :SHIFT_COLS], mu_shift[l]), *rw)
        state_ctx, yc = rwkv_scan(state0, prep_c)
        _, yx = rwkv_scan(state_ctx, prep_x)
        ro = (r_k[l], ln_x_w[l], ln_x_b[l], w_a_out[l])
        ya_x = rwkv_readout(yx, prep_x, *ro)
        mix_x = merge_branches(zx, ya_x, grid_mean, b_gate[l], w_pool[l], pool_scale[l], w_b_out[l], w_o[l])
        x = x + gt1 * rms_norm(mix_x, g_post_mix[l])
        hx2 = rms_norm(x, g_pre_ffn[l]) * (1.0 + sc2) + sh2
        x = x + gt2 * rms_norm(peer_ffn(hx2, peer_wq[l], peer_keys[l], peer_u[l], peer_v[l]), g_post_ffn[l])
        if not last:
            ya_c = rwkv_readout(yc, prep_c, *ro)
            mix_c = merge_branches(zc, ya_c, window_mean_seq, b_gate[l], w_pool[l], pool_scale[l], w_b_out[l], w_o[l])
            ctx = ctx + cgt1 * rms_norm(mix_c, g_post_mix[l])
            hc2 = rms_norm(ctx, g_pre_ffn[l]) * (1.0 + csc2) + csh2
            ctx = ctx + cgt2 * rms_norm(peer_ffn(hc2, peer_wq[l], peer_keys[l], peer_u[l], peer_v[l]), g_post_ffn[l])
    return x
```

```cpp
#include <hip/hip_runtime.h>
#include <stdint.h>

typedef unsigned short bf16_t;
typedef short bf16x8 __attribute__((ext_vector_type(8)));
typedef float f32x4 __attribute__((ext_vector_type(4)));
typedef unsigned u32x4 __attribute__((ext_vector_type(4)));
typedef unsigned u32x2 __attribute__((ext_vector_type(2)));

#define NTOK 32768
#define SEQ 16384
#define CTXL 256
#define NCTX 512
#define MROWS 33280
#define DM 1024
#define SHIFTC 3456
#define INC 6016

__device__ __forceinline__ bf16_t f2bf(float f) { unsigned u = __float_as_uint(f); u += 0x7fffu + ((u >> 16) & 1u); return (bf16_t)(u >> 16); }
__device__ __forceinline__ float bf2f(bf16_t h) { return __uint_as_float(((unsigned)h) << 16); }
__device__ __forceinline__ float bflo(unsigned u) { return __uint_as_float(u << 16); }
__device__ __forceinline__ float bfhi(unsigned u) { return __uint_as_float(u & 0xffff0000u); }
__device__ __forceinline__ unsigned pack2(float a, float b) { return (unsigned)f2bf(a) | ((unsigned)f2bf(b) << 16); }
__device__ __forceinline__ float sigmoidf_(float x) { return 1.0f / (1.0f + __expf(-x)); }

struct P {
  const float *x, *c, *ctx, *c_ctx, *w_mod, *b_mod, *g_pre_mix, *g_post_mix, *g_pre_ffn, *g_post_ffn, *w_in, *b_gate, *mu_shift,
      *w0, *w2, *a0, *a2, *g2, *k_k, *k_a, *r_k, *ln_x_w, *ln_x_b, *w_a_out, *w_pool, *pool_scale, *w_b_out, *w_o, *peer_wq,
      *peer_keys, *peer_u, *peer_v;
  float* out;
  bf16_t* hx;
  bf16_t* zA;
  bf16_t* zP;
  bf16_t* zG;
  bf16_t* Wt_in;
  bf16_t* Wt_aout;
  bf16_t* Wt_eff;
  bf16_t* Wt_o;
  bf16_t* Wt_q;
  bf16_t* keys;
  float* modp;
  float* mod;
  bf16_t* ub;
  bf16_t* vb;
  bf16_t* Y0;
  bf16_t* Y1;
  float* bdot;
  bf16_t* out_a;
  bf16_t* ya;
  bf16_t* pooled;
  bf16_t* yb;
  bf16_t* mrg;
  bf16_t* mix;
  bf16_t* hx2;
  bf16_t* q;
  float* sv;
  int* si;
  int* pidx;
  float* pgate;
};

#define GS 72
#define GEMM_SMEM (2 * 128 * GS * 2)
template <class Epi>
__device__ __forceinline__ void gemm_tile(const bf16_t* __restrict__ A, int lda, const bf16_t* __restrict__ Bt, int ldb, int K, int m0, int n0,
                                          const Epi& epi, unsigned char* smem) {
  const int tid = threadIdx.x, lane = tid & 63, wid = tid >> 6, wr = wid >> 1, wc = wid & 1;
  bf16_t* sA = (bf16_t*)smem;
  bf16_t* sB = sA + 128 * GS;
  f32x4 acc[4][4];
#pragma unroll
  for (int i = 0; i < 4; ++i)
#pragma unroll
    for (int j = 0; j < 4; ++j) acc[i][j] = (f32x4){0.f, 0.f, 0.f, 0.f};
  const int lrow = tid >> 3, lcol = (tid & 7) * 8;
  const bf16_t* pa = A + (size_t)(m0 + lrow) * lda + lcol;
  const bf16_t* pb = Bt + (size_t)(n0 + lrow) * ldb + lcol;
  u32x4 ra[4], rb[4];
#pragma unroll
  for (int p = 0; p < 4; ++p) {
    ra[p] = *(const u32x4*)(pa + (size_t)(32 * p) * lda);
    rb[p] = *(const u32x4*)(pb + (size_t)(32 * p) * ldb);
  }
  for (int k0 = 0; k0 < K; k0 += 64) {
#pragma unroll
    for (int p = 0; p < 4; ++p) {
      *(u32x4*)(sA + (lrow + 32 * p) * GS + lcol) = ra[p];
      *(u32x4*)(sB + (lrow + 32 * p) * GS + lcol) = rb[p];
    }
    __syncthreads();
    if (k0 + 64 < K) {
#pragma unroll
      for (int p = 0; p < 4; ++p) {
        ra[p] = *(const u32x4*)(pa + (size_t)(32 * p) * lda + k0 + 64);
        rb[p] = *(const u32x4*)(pb + (size_t)(32 * p) * ldb + k0 + 64);
      }
    }
#pragma unroll
    for (int kk = 0; kk < 2; ++kk) {
      bf16x8 af[4], bfr[4];
#pragma unroll
      for (int i = 0; i < 4; ++i) af[i] = *(const bf16x8*)(sA + (wr * 64 + i * 16 + (lane & 15)) * GS + kk * 32 + (lane >> 4) * 8);
#pragma unroll
      for (int j = 0; j < 4; ++j) bfr[j] = *(const bf16x8*)(sB + (wc * 64 + j * 16 + (lane & 15)) * GS + kk * 32 + (lane >> 4) * 8);
#pragma unroll
      for (int i = 0; i < 4; ++i)
#pragma unroll
        for (int j = 0; j < 4; ++j) acc[i][j] = __builtin_amdgcn_mfma_f32_16x16x32_bf16(bfr[j], af[i], acc[i][j], 0, 0, 0);
    }
    __syncthreads();
  }
#pragma unroll
  for (int i = 0; i < 4; ++i)
#pragma unroll
    for (int j = 0; j < 4; ++j) epi(m0 + wr * 64 + i * 16 + (lane & 15), n0 + wc * 64 + j * 16 + (lane >> 4) * 4, acc[i][j]);
}

struct EpiStoreBf16 {
  bf16_t* C; int ldc;
  __device__ __forceinline__ void operator()(int m, int n, const f32x4& v) const {
    uint2 w; w.x = pack2(v[0], v[1]); w.y = pack2(v[2], v[3]);
    *(uint2*)(C + (size_t)m * ldc + n) = w;
  }
};
struct EpiZ {
  bf16_t *zA, *zP, *zG;
  __device__ __forceinline__ void operator()(int m, int n, const f32x4& v) const {
    uint2 w; w.x = pack2(v[0], v[1]); w.y = pack2(v[2], v[3]);
    if (n < SHIFTC) *(uint2*)(zA + (size_t)m * SHIFTC + n) = w;
    else if (m < NTOK) {
      if (n < SHIFTC + 512) *(uint2*)(zP + (size_t)m * 512 + (n - SHIFTC)) = w;
      else *(uint2*)(zG + (size_t)m * 2048 + (n - SHIFTC - 512)) = w;
    }
  }
};
struct EpiLds {
  float* S;
  __device__ __forceinline__ void operator()(int m, int n, const f32x4& v) const {
    float* r = S + (m & 127) * 129 + n;
    r[0] = v[0]; r[1] = v[1]; r[2] = v[2]; r[3] = v[3];
  }
};

__device__ __forceinline__ void ph_transpose(const float* __restrict__ in, bf16_t* __restrict__ out, int K, int N, int vb, int nvb, unsigned char* smem) {
  float* t = (float*)smem;
  const int tk = K / 32, tn = N / 32, tx = threadIdx.x & 31, ty = threadIdx.x >> 5;
  for (int it = vb; it < tk * tn; it += nvb) {
    const int k0 = (it / tn) * 32, n0 = (it % tn) * 32;
    __syncthreads();
#pragma unroll
    for (int r = 0; r < 4; ++r) t[(ty + 8 * r) * 33 + tx] = in[(size_t)(k0 + ty + 8 * r) * N + n0 + tx];
    __syncthreads();
#pragma unroll
    for (int r = 0; r < 4; ++r) out[(size_t)(n0 + ty + 8 * r) * K + k0 + tx] = f2bf(t[tx * 33 + ty + 8 * r]);
  }
}
__device__ __forceinline__ void ph_convert(const float* __restrict__ in, bf16_t* __restrict__ out, size_t n, int vb, int nvb) {
  for (size_t i = ((size_t)vb * 256 + threadIdx.x) * 4; i < n; i += (size_t)nvb * 1024) {
    const float4 v = *(const float4*)(in + i);
    uint2 w; w.x = pack2(v.x, v.y); w.y = pack2(v.z, v.w);
    *(uint2*)(out + i) = w;
  }
}
__device__ __forceinline__ void ph_weff(const P& p, int vb, int nvb) {
  for (int it = vb * 256 + threadIdx.x; it < 512 * 1024; it += nvb * 256) {
    const int n = it & 1023, k = it >> 10, j = k >> 7, kl = k & 127;
    const float* wp = p.w_pool + ((size_t)j * 128 + kl) * 128;
    float s = 0.f;
    for (int c = 0; c < 128; ++c) s += wp[c] * p.pool_scale[j * 128 + c] * p.w_b_out[(size_t)(j * 128 + c) * 1024 + n];
    p.Wt_eff[(size_t)n * 512 + k] = f2bf(s);
  }
}
__device__ __forceinline__ void ph_modp(const P& p, int vb, int nvb) {
  for (int it = vb; it < 24 * 16; it += nvb) {
    const int n = (it % 24) * 256 + threadIdx.x, ks = it / 24;
    float a0 = 0.f, a1 = 0.f, a2 = 0.f;
    for (int k = ks * 64; k < ks * 64 + 64; ++k) {
      const float w = p.w_mod[(size_t)k * 6144 + n];
      const float c0 = p.c[k], c1 = p.c[1024 + k], c2 = p.c_ctx[k];
      a0 += c0 * sigmoidf_(c0) * w; a1 += c1 * sigmoidf_(c1) * w; a2 += c2 * sigmoidf_(c2) * w;
    }
    p.modp[(ks * 3 + 0) * 6144 + n] = a0; p.modp[(ks * 3 + 1) * 6144 + n] = a1; p.modp[(ks * 3 + 2) * 6144 + n] = a2;
  }
}
__device__ __forceinline__ void ph_modf(const P& p, int vb, int nvb) {
  for (int it = vb * 256 + threadIdx.x; it < 3 * 6144; it += nvb * 256) {
    const int n = it % 6144;
    float s = p.b_mod[n];
    for (int ks = 0; ks < 16; ++ks) s += p.modp[ks * 3 * 6144 + it];
    p.mod[it] = s;
  }
}
__device__ __forceinline__ float wave_sum(float v) {
#pragma unroll
  for (int o = 32; o > 0; o >>= 1) v += __shfl_xor(v, o);
  return v;
}
__device__ __forceinline__ void ph_norm1(const P& p, int vb, int nvb) {
  const int lane = threadIdx.x & 63, wid = threadIdx.x >> 6;
  for (int m = vb * 4 + wid; m < MROWS; m += nvb * 4) {
    const float* src = m < NTOK ? p.x + (size_t)m * DM : p.ctx + (size_t)(m - NTOK) * DM;
    const float* md = p.mod + (m < NTOK ? (m / SEQ) : 2) * 6144;
    float4 v[4]; float ss = 0.f;
#pragma unroll
    for (int i = 0; i < 4; ++i) { v[i] = *(const float4*)(src + i * 256 + lane * 4); ss += v[i].x * v[i].x + v[i].y * v[i].y + v[i].z * v[i].z + v[i].w * v[i].w; }
    ss = wave_sum(ss);
    const float rstd = rsqrtf(ss * (1.0f / 1024.0f) + 1e-6f);
#pragma unroll
    for (int i = 0; i < 4; ++i) {
      const int col = i * 256 + lane * 4;
      const float4 g = *(const float4*)(p.g_pre_mix + col), sh = *(const float4*)(md + col), sc = *(const float4*)(md + 1024 + col);
      uint2 w;
      w.x = pack2(v[i].x * rstd * g.x * (1.f + sc.x) + sh.x, v[i].y * rstd * g.y * (1.f + sc.y) + sh.y);
      w.y = pack2(v[i].z * rstd * g.z * (1.f + sc.z) + sh.z, v[i].w * rstd * g.w * (1.f + sc.w) + sh.w);
      *(uint2*)(p.hx + (size_t)m * DM + col) = w;
    }
  }
}
__device__ __forceinline__ void ph_gemm1(const P& p, int vb, int nvb, unsigned char* smem) {
  const int nlat = 256 * 47, nall = nlat + 4 * 27;
  EpiZ epi{p.zA, p.zP, p.zG};
  for (int it = vb; it < nall; it += nvb) {
    int tm, tn;
    if (it < nlat) { tn = it / 256; tm = it % 256; } else { const int r = it - nlat; tn = r / 4; tm = 256 + r % 4; }
    gemm_tile(p.hx, DM, p.Wt_in, DM, DM, tm * 128, tn * 128, epi, smem);
  }
}
__device__ __forceinline__ void ph_gemm_simple(const bf16_t* A, int lda, const bf16_t* Bt, int ldb, int K, int M, int N, bf16_t* C, int ldc, int vb, int nvb, unsigned char* smem) {
  const int tm = M / 128, tn = N / 128;
  EpiStoreBf16 epi{C, ldc};
  for (int it = vb; it < tm * tn; it += nvb) gemm_tile(A, lda, Bt, ldb, K, (it % tm) * 128, (it / tm) * 128, epi, smem);
}

__device__ __forceinline__ void load_shift8(const bf16_t* __restrict__ zA, const float* __restrict__ mu, int rowbase, int t, int T, int col0, float* o) {
  const uint4 zc = *(const uint4*)(zA + (size_t)(rowbase + t) * SHIFTC + col0);
  uint4 zp = make_uint4(0, 0, 0, 0), zn = make_uint4(0, 0, 0, 0);
  if (t > 0) zp = *(const uint4*)(zA + (size_t)(rowbase + t - 1) * SHIFTC + col0);
  if (t < T - 1) zn = *(const uint4*)(zA + (size_t)(rowbase + t + 1) * SHIFTC + col0);
  const unsigned c[4] = {zc.x, zc.y, zc.z, zc.w}, pv[4] = {zp.x, zp.y, zp.z, zp.w}, nv[4] = {zn.x, zn.y, zn.z, zn.w};
#pragma unroll
  for (int i = 0; i < 4; ++i) {
    const float z0 = bflo(c[i]), z1 = bfhi(c[i]);
    o[2 * i] = z0 + mu[col0 + 2 * i] * (0.5f * (bflo(pv[i]) + bflo(nv[i])) - z0);
    o[2 * i + 1] = z1 + mu[col0 + 2 * i + 1] * (0.5f * (bfhi(pv[i]) + bfhi(nv[i])) - z1);
  }
}
__device__ __forceinline__ float red16(float v) {
  v += __shfl_xor(v, 1); v += __shfl_xor(v, 2); v += __shfl_xor(v, 4); v += __shfl_xor(v, 8);
  return v;
}
__device__ __forceinline__ float red8(float v) {
  v += __shfl_xor(v, 1); v += __shfl_xor(v, 2); v += __shfl_xor(v, 4);
  return v;
}

#define SCAN_SMEM (2 * 16384 + 2 * 8192 + 5 * 8192 + 2048)
__device__ __forceinline__ void ph_scan(const P& p, int vb, int nvb, unsigned char* smem) {
  float* w2s = (float*)smem;
  float* a2s = w2s + 4096;
  float* twd = a2s + 4096;
  float* tad = twd + 2048;
  float* pr = tad + 2048;
  float* pw = pr + 2048; float* pk = pw + 2048; float* pa = pk + 2048; float* pb = pa + 2048;
  float* pvv = pb + 2048;
  const int tid = threadIdx.x;
  for (int item = vb; item < 256; item += nvb) {
    const int chain = item >> 2, rg = item & 3, b = chain >> 5, d = (chain >> 4) & 1, h = chain & 15;
    __syncthreads();
    for (int i = tid; i < 4096; i += 256) {
      const int l = i >> 6, c = i & 63;
      w2s[i] = p.w2[((size_t)d * 64 + l) * 1024 + h * 64 + c];
      a2s[i] = p.a2[((size_t)d * 64 + l) * 1024 + h * 64 + c];
    }
    const int tt = tid >> 3, cg = tid & 7, ch0 = h * 64 + cg * 8;
    float cw0[8], ca0[8], ckk[8], cka[8], crk[8];
#pragma unroll
    for (int e = 0; e < 8; ++e) { cw0[e] = p.w0[d * 1024 + ch0 + e]; ca0[e] = p.a0[d * 1024 + ch0 + e]; ckk[e] = p.k_k[ch0 + e]; cka[e] = p.k_a[ch0 + e]; crk[e] = p.r_k[ch0 + e]; }
    const int row = tid >> 4, s4 = (tid & 15) * 4;
    float S0 = 0.f, S1 = 0.f, S2 = 0.f, S3 = 0.f;
    for (int seg = 0; seg < 2; ++seg) {
      const int T = seg == 0 ? CTXL : SEQ;
      const int rowbase = seg == 0 ? NTOK + b * CTXL : b * SEQ;
      for (int i0 = 0; i0 < T; i0 += 32) {
        const int isc = i0 + tt, t = d == 0 ? isc : T - 1 - isc;
        __syncthreads();
        {
          float o[8];
          load_shift8(p.zA, p.mu_shift, rowbase, t, T, 3072 + d * 64 + cg * 8, o);
#pragma unroll
          for (int e = 0; e < 8; ++e) twd[tt * 64 + cg * 8 + e] = tanhf(o[e]);
          load_shift8(p.zA, p.mu_shift, rowbase, t, T, 3200 + d * 64 + cg * 8, o);
#pragma unroll
          for (int e = 0; e < 8; ++e) tad[tt * 64 + cg * 8 + e] = o[e];
        }
        __syncthreads();
        {
          float lw[8], la[8];
#pragma unroll
          for (int e = 0; e < 8; ++e) { lw[e] = 0.f; la[e] = 0.f; }
          for (int l = 0; l < 64; ++l) {
            const float tw = twd[tt * 64 + l], ta = tad[tt * 64 + l];
            const float4 wa = *(const float4*)(w2s + l * 64 + cg * 8), wb = *(const float4*)(w2s + l * 64 + cg * 8 + 4);
            const float4 aa = *(const float4*)(a2s + l * 64 + cg * 8), ab = *(const float4*)(a2s + l * 64 + cg * 8 + 4);
            lw[0] += tw * wa.x; lw[1] += tw * wa.y; lw[2] += tw * wa.z; lw[3] += tw * wa.w; lw[4] += tw * wb.x; lw[5] += tw * wb.y; lw[6] += tw * wb.z; lw[7] += tw * wb.w;
            la[0] += ta * aa.x; la[1] += ta * aa.y; la[2] += ta * aa.z; la[3] += ta * aa.w; la[4] += ta * ab.x; la[5] += ta * ab.y; la[6] += ta * ab.z; la[7] += ta * ab.w;
          }
          float r8[8], k8[8], v8[8];
          load_shift8(p.zA, p.mu_shift, rowbase, t, T, ch0, r8);
          load_shift8(p.zA, p.mu_shift, rowbase, t, T, 1024 + ch0, k8);
          load_shift8(p.zA, p.mu_shift, rowbase, t, T, 2048 + ch0, v8);
          float kkv[8], ss = 0.f, bd = 0.f, dec[8], icl[8], kd[8];
#pragma unroll
          for (int e = 0; e < 8; ++e) {
            const float xw = -(cw0[e] + lw[e]);
            const float sp = fmaxf(xw, 0.f) + log1pf(__expf(-fabsf(xw)));
            const float wlog = -sp - 0.5f;
            dec[e] = __expf(-__expf(wlog));
            icl[e] = sigmoidf_(ca0[e] + la[e]);
            kkv[e] = k8[e] * ckk[e]; ss += kkv[e] * kkv[e];
            kd[e] = k8[e] * (1.f + (icl[e] - 1.f) * cka[e]);
            bd += r8[e] * kd[e] * crk[e];
          }
          ss = red8(ss); bd = red8(bd);
          const float rn = rsqrtf(fmaxf(ss, 1e-24f));
#pragma unroll
          for (int e = 0; e < 8; ++e) {
            const float kk = kkv[e] * rn;
            const int o = tt * 64 + cg * 8 + e;
            pr[o] = r8[e]; pw[o] = dec[e]; pk[o] = kd[e]; pa[o] = -kk; pb[o] = kk * icl[e];
          }
          if ((cg >> 1) == rg) {
#pragma unroll
            for (int e = 0; e < 8; ++e) pvv[tt * 16 + (cg & 1) * 8 + e] = v8[e];
          }
          if (seg == 1 && rg == 0 && cg == 0) p.bdot[((size_t)d * NTOK + rowbase + t) * 16 + h] = bd;
        }
        __syncthreads();
        for (int ii = 0; ii < 32; ++ii) {
          const float4 r4 = *(const float4*)(pr + ii * 64 + s4), w4 = *(const float4*)(pw + ii * 64 + s4), k4 = *(const float4*)(pk + ii * 64 + s4);
          const float4 a4 = *(const float4*)(pa + ii * 64 + s4), b4 = *(const float4*)(pb + ii * 64 + s4);
          const float v = pvv[ii * 16 + row];
          const float sa = red16(S0 * a4.x + S1 * a4.y + S2 * a4.z + S3 * a4.w);
          S0 = S0 * w4.x + sa * b4.x + v * k4.x; S1 = S1 * w4.y + sa * b4.y + v * k4.y;
          S2 = S2 * w4.z + sa * b4.z + v * k4.z; S3 = S3 * w4.w + sa * b4.w + v * k4.w;
          const float y = red16(S0 * r4.x + S1 * r4.y + S2 * r4.z + S3 * r4.w);
          if (seg == 1 && s4 == 0) {
            const int isq = i0 + ii, tq = d == 0 ? isq : T - 1 - isq;
            (d == 0 ? p.Y0 : p.Y1)[(size_t)(rowbase + tq) * DM + h * 64 + rg * 16 + row] = f2bf(y);
          }
        }
      }
    }
  }
}

#define RO_SMEM (128 * 16 * 4)
__device__ __forceinline__ void ph_readout(const P& p, int vb, int nvb, unsigned char* smem) {
  float* sgT = (float*)smem;
  const int tid = threadIdx.x, c4 = tid * 4, h = tid >> 4;
  const float4 lnw = *(const float4*)(p.ln_x_w + c4), lnb = *(const float4*)(p.ln_x_b + c4);
  for (int item = vb; item < NTOK / 16; item += nvb) {
    const int tok0 = item * 16;
    __syncthreads();
    {
      const int tk = tid >> 4, l8 = (tid & 15) * 8, m = tok0 + tk, b = m / SEQ, t = m % SEQ;
      float o[8];
      load_shift8(p.zA, p.mu_shift, b * SEQ, t, SEQ, 3328 + l8, o);
#pragma unroll
      for (int e = 0; e < 8; ++e) sgT[(l8 + e) * 16 + tk] = sigmoidf_(o[e]);
    }
    __syncthreads();
    float4 g[16];
#pragma unroll
    for (int k = 0; k < 16; ++k) g[k] = make_float4(0.f, 0.f, 0.f, 0.f);
    for (int l = 0; l < 128; ++l) {
      const float4 w = *(const float4*)(p.g2 + (size_t)l * 1024 + c4);
      const float4 s0 = *(const float4*)(sgT + l * 16), s1 = *(const float4*)(sgT + l * 16 + 4), s2 = *(const float4*)(sgT + l * 16 + 8), s3 = *(const float4*)(sgT + l * 16 + 12);
      const float sv[16] = {s0.x, s0.y, s0.z, s0.w, s1.x, s1.y, s1.z, s1.w, s2.x, s2.y, s2.z, s2.w, s3.x, s3.y, s3.z, s3.w};
#pragma unroll
      for (int k = 0; k < 16; ++k) { g[k].x += sv[k] * w.x; g[k].y += sv[k] * w.y; g[k].z += sv[k] * w.z; g[k].w += sv[k] * w.w; }
    }
#pragma unroll
    for (int k = 0; k < 16; ++k) {
      const int m = tok0 + k, b = m / SEQ, t = m % SEQ;
      const uint2 y0 = *(const uint2*)(p.Y0 + (size_t)m * DM + c4), y1 = *(const uint2*)(p.Y1 + (size_t)m * DM + c4);
      float y[4] = {bflo(y0.x) + bflo(y1.x), bfhi(y0.x) + bfhi(y1.x), bflo(y0.y) + bflo(y1.y), bfhi(y0.y) + bfhi(y1.y)};
      const float mu = red16(y[0] + y[1] + y[2] + y[3]) * (1.f / 64.f);
      float q = 0.f;
#pragma unroll
      for (int e = 0; e < 4; ++e) { y[e] -= mu; q += y[e] * y[e]; }
      const float rs = rsqrtf(red16(q) * (1.f / 64.f) + 64e-5f);
      const bf16_t* zr = p.zA + (size_t)m * SHIFTC + 2048 + c4;
      const uint2 zc = *(const uint2*)zr;
      uint2 zp = make_uint2(0, 0), zn = make_uint2(0, 0);
      if (t > 0) zp = *(const uint2*)(zr - SHIFTC);
      if (t < SEQ - 1) zn = *(const uint2*)(zr + SHIFTC);
      const float4 mu4 = *(const float4*)(p.mu_shift + 2048 + c4);
      float v[4];
      v[0] = bflo(zc.x) + mu4.x * (0.5f * (bflo(zp.x) + bflo(zn.x)) - bflo(zc.x));
      v[1] = bfhi(zc.x) + mu4.y * (0.5f * (bfhi(zp.x) + bfhi(zn.x)) - bfhi(zc.x));
      v[2] = bflo(zc.y) + mu4.z * (0.5f * (bflo(zp.y) + bflo(zn.y)) - bflo(zc.y));
      v[3] = bfhi(zc.y) + mu4.w * (0.5f * (bfhi(zp.y) + bfhi(zn.y)) - bfhi(zc.y));
      const float bon = 0.5f * (p.bdot[(size_t)m * 16 + h] + p.bdot[((size_t)NTOK + m) * 16 + h]);
      const float o0 = (y[0] * rs * lnw.x + lnb.x + bon * v[0]) * g[k].x, o1 = (y[1] * rs * lnw.y + lnb.y + bon * v[1]) * g[k].y;
      const float o2 = (y[2] * rs * lnw.z + lnb.z + bon * v[2]) * g[k].z, o3 = (y[3] * rs * lnw.w + lnb.w + bon * v[3]) * g[k].w;
      uint2 w; w.x = pack2(o0, o1); w.y = pack2(o2, o3);
      *(uint2*)(p.out_a + (size_t)m * DM + c4) = w;
    }
  }
}

#define POOL_SMEM (64 * 128 * 4)
__device__ __forceinline__ void ph_pool(const P& p, int vb, int nvb, unsigned char* smem) {
  float* V = (float*)smem;
  const int tid = threadIdx.x;
  for (int item = vb; item < 2 * 256 * 4; item += nvb) {
    const int j = item & 3, r = (item >> 2) & 255, b = item >> 10;
    const int win = 2 << j, half = win >> 1;
    const int r0 = max(r - half, 0), r1 = min(r + half, 256);
    __syncthreads();
    const int cp = tid & 63, cq = tid >> 6;
    float a0[16], a1[16];
#pragma unroll
    for (int i = 0; i < 16; ++i) { a0[i] = 0.f; a1[i] = 0.f; }
    for (int rr = r0; rr < r1; ++rr) {
      const bf16_t* base = p.zP + ((size_t)b * SEQ + rr * 64) * 512 + j * 128 + cp * 2;
#pragma unroll
      for (int i = 0; i < 16; ++i) {
        const unsigned u = *(const unsigned*)(base + (size_t)(cq + 4 * i) * 512);
        a0[i] += bflo(u); a1[i] += bfhi(u);
      }
    }
#pragma unroll
    for (int i = 0; i < 16; ++i) { V[(cq + 4 * i) * 128 + cp * 2] = a0[i]; V[(cq + 4 * i) * 128 + cp * 2 + 1] = a1[i]; }
    __syncthreads();
#pragma unroll
    for (int i = 0; i < 16; ++i) {
      const int col = cq + 4 * i, c0 = max(col - half, 0), c1 = min(col + half, 64);
      float s0 = 0.f, s1 = 0.f;
      for (int cc = c0; cc < c1; ++cc) { s0 += V[cc * 128 + cp * 2]; s1 += V[cc * 128 + cp * 2 + 1]; }
      const float inv = 1.0f / (float)((r1 - r0) * (c1 - c0));
      const size_t tokoff = ((size_t)b * SEQ + r * 64 + col) * 512 + j * 128 + cp * 2;
      const unsigned u = *(const unsigned*)(p.zP + tokoff);
      *(unsigned*)(p.pooled + tokoff) = pack2(s0 * inv - bflo(u), s1 * inv - bfhi(u));
    }
  }
}
__device__ __forceinline__ void ph_merge(const P& p, int vb, int nvb) {
  for (size_t i = ((size_t)vb * 256 + threadIdx.x) * 4; i < (size_t)NTOK * DM; i += (size_t)nvb * 1024) {
    const size_t m = i >> 10; const int c = (int)(i & 1023);
    const uint2 g1 = *(const uint2*)(p.zG + m * 2048 + c), g2 = *(const uint2*)(p.zG + m * 2048 + 1024 + c);
    const uint2 a = *(const uint2*)(p.ya + i), bq = *(const uint2*)(p.yb + i);
    const float4 b1 = *(const float4*)(p.b_gate + c), b2 = *(const float4*)(p.b_gate + 1024 + c);
    const float m0 = sigmoidf_(bflo(g1.x) + b1.x) * bflo(a.x) + sigmoidf_(bflo(g2.x) + b2.x) * bflo(bq.x);
    const float m1 = sigmoidf_(bfhi(g1.x) + b1.y) * bfhi(a.x) + sigmoidf_(bfhi(g2.x) + b2.y) * bfhi(bq.x);
    const float m2 = sigmoidf_(bflo(g1.y) + b1.z) * bflo(a.y) + sigmoidf_(bflo(g2.y) + b2.z) * bflo(bq.y);
    const float m3 = sigmoidf_(bfhi(g1.y) + b1.w) * bfhi(a.y) + sigmoidf_(bfhi(g2.y) + b2.w) * bfhi(bq.y);
    uint2 w; w.x = pack2(m0, m1); w.y = pack2(m2, m3);
    *(uint2*)(p.mrg + i) = w;
  }
}
__device__ __forceinline__ void ph_res1(const P& p, int vb, int nvb) {
  const int lane = threadIdx.x & 63, wid = threadIdx.x >> 6;
  for (int m = vb * 4 + wid; m < NTOK; m += nvb * 4) {
    const float* md = p.mod + (m / SEQ) * 6144;
    float mx[16]; float ss = 0.f;
#pragma unroll
    for (int i = 0; i < 4; ++i) {
      const uint2 u = *(const uint2*)(p.mix + (size_t)m * DM + i * 256 + lane * 4);
      mx[4 * i] = bflo(u.x); mx[4 * i + 1] = bfhi(u.x); mx[4 * i + 2] = bflo(u.y); mx[4 * i + 3] = bfhi(u.y);
#pragma unroll
      for (int e = 0; e < 4; ++e) ss += mx[4 * i + e] * mx[4 * i + e];
    }
    ss = wave_sum(ss);
    const float rstd = rsqrtf(ss * (1.0f / 1024.0f) + 1e-6f);
    float x1[16]; float s2 = 0.f;
#pragma unroll
    for (int i = 0; i < 4; ++i) {
      const int col = i * 256 + lane * 4;
      const float4 xv = *(const float4*)(p.x + (size_t)m * DM + col), g = *(const float4*)(p.g_post_mix + col), gt = *(const float4*)(md + 2048 + col);
      x1[4 * i] = xv.x + gt.x * mx[4 * i] * rstd * g.x; x1[4 * i + 1] = xv.y + gt.y * mx[4 * i + 1] * rstd * g.y;
      x1[4 * i + 2] = xv.z + gt.z * mx[4 * i + 2] * rstd * g.z; x1[4 * i + 3] = xv.w + gt.w * mx[4 * i + 3] * rstd * g.w;
      *(float4*)(p.out + (size_t)m * DM + col) = make_float4(x1[4 * i], x1[4 * i + 1], x1[4 * i + 2], x1[4 * i + 3]);
#pragma unroll
      for (int e = 0; e < 4; ++e) s2 += x1[4 * i + e] * x1[4 * i + e];
    }
    s2 = wave_sum(s2);
    const float r2 = rsqrtf(s2 * (1.0f / 1024.0f) + 1e-6f);
#pragma unroll
    for (int i = 0; i < 4; ++i) {
      const int col = i * 256 + lane * 4;
      const float4 g = *(const float4*)(p.g_pre_ffn + col), sh = *(const float4*)(md + 3072 + col), sc = *(const float4*)(md + 4096 + col);
      uint2 w;
      w.x = pack2(x1[4 * i] * r2 * g.x * (1.f + sc.x) + sh.x, x1[4 * i + 1] * r2 * g.y * (1.f + sc.y) + sh.y);
      w.y = pack2(x1[4 * i + 2] * r2 * g.z * (1.f + sc.z) + sh.z, x1[4 * i + 3] * r2 * g.w * (1.f + sc.w) + sh.w);
      *(uint2*)(p.hx2 + (size_t)m * DM + col) = w;
    }
  }
}

#define PS1_SMEM (GEMM_SMEM + 128 * 129 * 4)
__device__ __forceinline__ void ph_peer_s1(const P& p, int vb, int nvb, unsigned char* smem) {
  float* S = (float*)(smem + GEMM_SMEM);
  EpiLds epi{S};
  const int tid = threadIdx.x, row = tid >> 1, hf = tid & 1;
  for (int item = vb; item < 256 * 16; item += nvb) {
    const int hp = item & 15, tm = item >> 4;
    __syncthreads();
    gemm_tile(p.q + hp * 128, 2048, p.keys + (size_t)hp * 128 * 128, 128, 128, tm * 128, 0, epi, smem);
    __syncthreads();
    float v[64];
#pragma unroll
    for (int i = 0; i < 64; ++i) v[i] = S[row * 129 + hf * 64 + i];
    const size_t ob = ((size_t)(tm * 128 + row) * 16 + hp) * 16;
    for (int it = 0; it < 16; ++it) {
      float mx = v[0];
#pragma unroll
      for (int i = 1; i < 64; ++i) mx = fmaxf(mx, v[i]);
      const float ox = __shfl_xor(mx, 1);
      const bool mine = hf == 0 ? (mx >= ox) : (mx > ox);
      const float best = fmaxf(mx, ox);
      int idx = 0;
      if (mine) {
        bool found = false;
#pragma unroll
        for (int i = 0; i < 64; ++i) {
          const bool hit = !found && (v[i] == best);
          if (hit) { idx = hf * 64 + i; v[i] = -3.0e38f; found = true; }
        }
      }
      const int oidx = __shfl_xor(idx, 1);
      if (hf == 0) { p.sv[ob + it] = best; p.si[ob + it] = mine ? idx : oidx; }
    }
  }
}
__device__ __forceinline__ void ph_peer_s2(const P& p, int vb, int nvb) {
  for (int it = vb * 256 + threadIdx.x; it < NTOK * 8; it += nvb * 256) {
    const size_t ob = (size_t)it * 32;
    float a[16], bq[16]; int ia[16], ib[16];
#pragma unroll
    for (int i = 0; i < 16; i += 4) {
      const float4 fa = *(const float4*)(p.sv + ob + i), fb = *(const float4*)(p.sv + ob + 16 + i);
      const int4 ja = *(const int4*)(p.si + ob + i), jb = *(const int4*)(p.si + ob + 16 + i);
      a[i] = fa.x; a[i + 1] = fa.y; a[i + 2] = fa.z; a[i + 3] = fa.w; bq[i] = fb.x; bq[i + 1] = fb.y; bq[i + 2] = fb.z; bq[i + 3] = fb.w;
      ia[i] = ja.x; ia[i + 1] = ja.y; ia[i + 2] = ja.z; ia[i + 3] = ja.w; ib[i] = jb.x; ib[i + 1] = jb.y; ib[i + 2] = jb.z; ib[i + 3] = jb.w;
    }
    float cs[50]; int ci[50];
    {
      int n = 0;
#pragma unroll
      for (int i = 0; i < 16; ++i)
#pragma unroll
        for (int j = 0; j < 16; ++j)
          if ((i + 1) * (j + 1) <= 16) { cs[n] = a[i] + bq[j]; ci[n] = ia[i] * 128 + ib[j]; ++n; }
    }
    float sel[16]; int seli[16];
#pragma unroll
    for (int k = 0; k < 16; ++k) {
      float mx = cs[0];
#pragma unroll
      for (int n = 1; n < 50; ++n) mx = fmaxf(mx, cs[n]);
      int id = 0; bool found = false;
#pragma unroll
      for (int n = 0; n < 50; ++n) {
        const bool hit = !found && (cs[n] == mx);
        if (hit) { id = ci[n]; cs[n] = -3.0e38f; found = true; }
      }
      sel[k] = mx; seli[k] = id;
    }
    float den = 0.f; const float smax = sel[0];
#pragma unroll
    for (int k = 0; k < 16; ++k) { sel[k] = __expf(sel[k] - smax); den += sel[k]; }
    const float inv = 1.0f / den;
    const size_t o2 = (size_t)it * 16;
#pragma unroll
    for (int k = 0; k < 16; ++k) { p.pidx[o2 + k] = seli[k]; p.pgate[o2 + k] = sel[k] * inv; }
  }
}
__device__ __forceinline__ void ph_peer_gather(const P& p, int vb, int nvb) {
  const int lane = threadIdx.x & 63, wid = threadIdx.x >> 6;
  for (int m = vb * 4 + wid; m < NTOK; m += nvb * 4) {
    const float* md = p.mod + (m / SEQ) * 6144;
    float xv[16];
    {
      const uint4 u0 = *(const uint4*)(p.hx2 + (size_t)m * DM + lane * 16), u1 = *(const uint4*)(p.hx2 + (size_t)m * DM + lane * 16 + 8);
      const unsigned uu[8] = {u0.x, u0.y, u0.z, u0.w, u1.x, u1.y, u1.z, u1.w};
#pragma unroll
      for (int e = 0; e < 8; ++e) { xv[2 * e] = bflo(uu[e]); xv[2 * e + 1] = bfhi(uu[e]); }
    }
    const int id0 = p.pidx[(size_t)m * 128 + lane], id1 = p.pidx[(size_t)m * 128 + 64 + lane];
    const float g0 = p.pgate[(size_t)m * 128 + lane], g1 = p.pgate[(size_t)m * 128 + 64 + lane];
    float cf0 = 0.f, cf1 = 0.f;
    for (int e0 = 0; e0 < 128; e0 += 4) {
      float d[4];
#pragma unroll
      for (int q = 0; q < 4; ++q) {
        const int e = e0 + q;
        const int id = __shfl(e < 64 ? id0 : id1, e & 63);
        const uint4 u0 = *(const uint4*)(p.ub + (size_t)id * DM + lane * 16), u1 = *(const uint4*)(p.ub + (size_t)id * DM + lane * 16 + 8);
        const unsigned uu[8] = {u0.x, u0.y, u0.z, u0.w, u1.x, u1.y, u1.z, u1.w};
        float s = 0.f;
#pragma unroll
        for (int k = 0; k < 8; ++k) s += bflo(uu[k]) * xv[2 * k] + bfhi(uu[k]) * xv[2 * k + 1];
        d[q] = s;
      }
#pragma unroll
      for (int q = 0; q < 4; ++q) {
        const float s = wave_sum(d[q]);
        const float act = 0.5f * s * (1.0f + erff(s * 0.70710678118654752f));
        const int e = e0 + q;
        if (e < 64) { if (lane == e) cf0 = act * g0; } else { if (lane == e - 64) cf1 = act * g1; }
      }
    }
    float acc[16];
#pragma unroll
    for (int k = 0; k < 16; ++k) acc[k] = 0.f;
    for (int e = 0; e < 128; ++e) {
      const int id = __shfl(e < 64 ? id0 : id1, e & 63);
      const float cf = __shfl(e < 64 ? cf0 : cf1, e & 63);
      const uint4 u0 = *(const uint4*)(p.vb + (size_t)id * DM + lane * 16), u1 = *(const uint4*)(p.vb + (size_t)id * DM + lane * 16 + 8);
      const unsigned uu[8] = {u0.x, u0.y, u0.z, u0.w, u1.x, u1.y, u1.z, u1.w};
#pragma unroll
      for (int k = 0; k < 8; ++k) { acc[2 * k] += cf * bflo(uu[k]); acc[2 * k + 1] += cf * bfhi(uu[k]); }
    }
    float ss = 0.f;
#pragma unroll
    for (int k = 0; k < 16; ++k) ss += acc[k] * acc[k];
    ss = wave_sum(ss);
    const float rstd = rsqrtf(ss * (1.0f / 1024.0f) + 1e-6f);
#pragma unroll
    for (int k4 = 0; k4 < 4; ++k4) {
      const int col = lane * 16 + k4 * 4;
      float4 x1 = *(const float4*)(p.out + (size_t)m * DM + col);
      const float4 g = *(const float4*)(p.g_post_ffn + col), gt = *(const float4*)(md + 5120 + col);
      x1.x += gt.x * acc[k4 * 4] * rstd * g.x; x1.y += gt.y * acc[k4 * 4 + 1] * rstd * g.y;
      x1.z += gt.z * acc[k4 * 4 + 2] * rstd * g.z; x1.w += gt.w * acc[k4 * 4 + 3] * rstd * g.w;
      *(float4*)(p.out + (size_t)m * DM + col) = x1;
    }
  }
}

enum { PH_PREP = 0, PH_MODF, PH_NORM1, PH_GEMM1, PH_SCAN, PH_READOUT, PH_GEMM2, PH_POOL, PH_GEMM3, PH_MERGE, PH_GEMM4, PH_RES1, PH_GEMM5, PH_PS1, PH_PS2, PH_GATHER };
#define SMEM_MAX 106496
template <int PH>
__global__ void __launch_bounds__(256) k_phase(P p) {
  __shared__ __attribute__((aligned(16))) unsigned char smem[PH == PH_SCAN ? SCAN_SMEM : (PH == PH_PS1 ? PS1_SMEM : (PH == PH_POOL ? POOL_SMEM : GEMM_SMEM))];
  const int vb = blockIdx.x, nvb = gridDim.x;
  if (PH == PH_PREP) {
    ph_modp(p, vb, nvb);
    ph_transpose(p.w_in, p.Wt_in, DM, INC, vb, nvb, smem);
    ph_transpose(p.w_a_out, p.Wt_aout, DM, DM, vb, nvb, smem);
    ph_transpose(p.w_o, p.Wt_o, DM, DM, vb, nvb, smem);
    ph_transpose(p.peer_wq, p.Wt_q, DM, 2048, vb, nvb, smem);
    ph_weff(p, vb, nvb);
    ph_convert(p.peer_keys, p.keys, (size_t)16 * 128 * 128, vb, nvb);
    ph_convert(p.peer_u, p.ub, (size_t)16384 * 1024, vb, nvb);
    ph_convert(p.peer_v, p.vb, (size_t)16384 * 1024, vb, nvb);
  }
  if (PH == PH_MODF) ph_modf(p, vb, nvb);
  if (PH == PH_NORM1) ph_norm1(p, vb, nvb);
  if (PH == PH_GEMM1) ph_gemm1(p, vb, nvb, smem);
  if (PH == PH_SCAN) ph_scan(p, vb, nvb, smem);
  if (PH == PH_READOUT) ph_readout(p, vb, nvb, smem);
  if (PH == PH_GEMM2) ph_gemm_simple(p.out_a, DM, p.Wt_aout, DM, DM, NTOK, DM, p.ya, DM, vb, nvb, smem);
  if (PH == PH_POOL) ph_pool(p, vb, nvb, smem);
  if (PH == PH_GEMM3) ph_gemm_simple(p.pooled, 512, p.Wt_eff, 512, 512, NTOK, DM, p.yb, DM, vb, nvb, smem);
  if (PH == PH_MERGE) ph_merge(p, vb, nvb);
  if (PH == PH_GEMM4) ph_gemm_simple(p.mrg, DM, p.Wt_o, DM, DM, NTOK, DM, p.mix, DM, vb, nvb, smem);
  if (PH == PH_RES1) ph_res1(p, vb, nvb);
  if (PH == PH_GEMM5) ph_gemm_simple(p.hx2, DM, p.Wt_q, DM, DM, NTOK, 2048, p.q, 2048, vb, nvb, smem);
  if (PH == PH_PS1) ph_peer_s1(p, vb, nvb, smem);
  if (PH == PH_PS2) ph_peer_s2(p, vb, nvb);
  if (PH == PH_GATHER) ph_peer_gather(p, vb, nvb);
}

extern "C" void kernel_launch(void* const* d_in, const int* in_sizes, int n_in, void* d_out, int out_size, void* d_ws, size_t ws_size, hipStream_t stream) {
  P p{};
  const float** f = (const float**)&p;
  for (int i = 0; i < 32; ++i) f[i] = (const float*)d_in[i];
  p.out = (float*)d_out;
  unsigned char* w = (unsigned char*)d_ws;
  const size_t MiB = 1048576;
  p.hx = (bf16_t*)(w + 0 * MiB);
  p.zA = (bf16_t*)(w + 65 * MiB);
  p.zP = (bf16_t*)(w + 285 * MiB);
  p.zG = (bf16_t*)d_out;
  unsigned char* rw = w + 317 * MiB;
  p.Wt_in = (bf16_t*)rw; rw += 12 * MiB;
  p.Wt_aout = (bf16_t*)rw; rw += 2 * MiB;
  p.Wt_eff = (bf16_t*)rw; rw += 1 * MiB;
  p.Wt_o = (bf16_t*)rw; rw += 2 * MiB;
  p.Wt_q = (bf16_t*)rw; rw += 4 * MiB;
  p.keys = (bf16_t*)rw; rw += 1 * MiB;
  p.modp = (float*)rw; rw += 2 * MiB;
  p.mod = (float*)rw; rw += 1 * MiB;
  p.ub = (bf16_t*)(w + 345 * MiB);
  p.vb = (bf16_t*)(w + 377 * MiB);
  p.Y0 = (bf16_t*)(w + 0 * MiB);
  p.Y1 = (bf16_t*)(w + 409 * MiB);
  p.bdot = (float*)(w + 473 * MiB);
  p.out_a = (bf16_t*)(w + 0 * MiB);
  p.ya = (bf16_t*)(w + 65 * MiB);
  p.pooled = (bf16_t*)(w + 129 * MiB);
  p.yb = (bf16_t*)(w + 161 * MiB);
  p.mrg = (bf16_t*)(w + 409 * MiB);
  p.mix = (bf16_t*)(w + 65 * MiB);
  p.hx2 = (bf16_t*)(w + 0 * MiB);
  p.q = (bf16_t*)(w + 129 * MiB);
  p.sv = (float*)(w + 409 * MiB);
  p.si = (int*)(w + 441 * MiB);
  p.pidx = (int*)(w + 257 * MiB);
  p.pgate = (float*)(w + 273 * MiB);
  k_phase<PH_PREP><<<2048, 256, 0, stream>>>(p);
  k_phase<PH_MODF><<<72, 256, 0, stream>>>(p);
  k_phase<PH_NORM1><<<2048, 256, 0, stream>>>(p);
  k_phase<PH_GEMM1><<<2048, 256, 0, stream>>>(p);
  k_phase<PH_SCAN><<<256, 256, 0, stream>>>(p);
  k_phase<PH_READOUT><<<2048, 256, 0, stream>>>(p);
  k_phase<PH_POOL><<<2048, 256, 0, stream>>>(p);
  k_phase<PH_GEMM2><<<2048, 256, 0, stream>>>(p);
  k_phase<PH_GEMM3><<<2048, 256, 0, stream>>>(p);
  k_phase<PH_MERGE><<<2048, 256, 0, stream>>>(p);
  k_phase<PH_GEMM4><<<2048, 256, 0, stream>>>(p);
  k_phase<PH_RES1><<<2048, 256, 0, stream>>>(p);
  k_phase<PH_GEMM5><<<2048, 256, 0, stream>>>(p);
  k_phase<PH_PS1><<<2048, 256, 0, stream>>>(p);
  k_phase<PH_PS2><<<1024, 256, 0, stream>>>(p);
  k_phase<PH_GATHER><<<2048, 256, 0, stream>>>(p);
}
```

```cpp
#include <hip/hip_runtime.h>
#include <hip/hip_cooperative_groups.h>
#include <stdint.h>
#include <cstdio>
namespace cg = cooperative_groups;

typedef unsigned short bf16_t;
typedef short bf16x8 __attribute__((ext_vector_type(8)));
typedef float f32x4 __attribute__((ext_vector_type(4)));
typedef unsigned u32x4 __attribute__((ext_vector_type(4)));
typedef unsigned u32x2 __attribute__((ext_vector_type(2)));

#define NTOK 32768
#define SEQ 16384
#define CTXL 256
#define NCTX 512
#define MROWS 33280
#define DM 1024
#define SHIFTC 3456
#define INC 6016

__device__ __forceinline__ bf16_t f2bf(float f) { unsigned u = __float_as_uint(f); u += 0x7fffu + ((u >> 16) & 1u); return (bf16_t)(u >> 16); }
__device__ __forceinline__ float bf2f(bf16_t h) { return __uint_as_float(((unsigned)h) << 16); }
__device__ __forceinline__ float bflo(unsigned u) { return __uint_as_float(u << 16); }
__device__ __forceinline__ float bfhi(unsigned u) { return __uint_as_float(u & 0xffff0000u); }
__device__ __forceinline__ unsigned pack2(float a, float b) { return (unsigned)f2bf(a) | ((unsigned)f2bf(b) << 16); }
__device__ __forceinline__ float sigmoidf_(float x) { return 1.0f / (1.0f + __expf(-x)); }

struct P {
  const float *x, *c, *ctx, *c_ctx, *w_mod, *b_mod, *g_pre_mix, *g_post_mix, *g_pre_ffn, *g_post_ffn, *w_in, *b_gate, *mu_shift,
      *w0, *w2, *a0, *a2, *g2, *k_k, *k_a, *r_k, *ln_x_w, *ln_x_b, *w_a_out, *w_pool, *pool_scale, *w_b_out, *w_o, *peer_wq,
      *peer_keys, *peer_u, *peer_v;
  float* out;
  bf16_t* hx;
  bf16_t* zA;
  bf16_t* zP;
  bf16_t* zG;
  bf16_t* Wt_in;
  bf16_t* Wt_aout;
  bf16_t* Wt_eff;
  bf16_t* Wt_o;
  bf16_t* Wt_q;
  bf16_t* keys;
  float* mod;
  bf16_t* ub;
  bf16_t* vb;
  bf16_t* w2T;
  bf16_t* a2T;
  bf16_t* Mst;
  float* Nst;
  bf16_t* Y0;
  bf16_t* Y1;
  float* bdot;
  bf16_t* out_a;
  bf16_t* ya;
  bf16_t* pooled;
  bf16_t* yb;
  bf16_t* mrg;
  bf16_t* mix;
  bf16_t* hx2;
  bf16_t* q;
  float* sv;
  int* si;
  int* pidx;
  float* pgate;
};

#define GS 72
#define GEMM_SMEM (2 * 128 * GS * 2)
template <class Epi>
__device__ __forceinline__ void gemm_tile(const bf16_t* __restrict__ A, int lda, const bf16_t* __restrict__ Bt, int ldb, int K, int m0, int n0,
                                          const Epi& epi, unsigned char* smem) {
  const int tid = threadIdx.x, lane = tid & 63, wid = tid >> 6, wr = wid >> 1, wc = wid & 1;
  bf16_t* sA = (bf16_t*)smem;
  bf16_t* sB = sA + 128 * GS;
  f32x4 acc[4][4];
#pragma unroll
  for (int i = 0; i < 4; ++i)
#pragma unroll
    for (int j = 0; j < 4; ++j) acc[i][j] = (f32x4){0.f, 0.f, 0.f, 0.f};
  const int lrow = tid >> 3, lcol = (tid & 7) * 8;
  const bf16_t* pa = A + (size_t)(m0 + lrow) * lda + lcol;
  const bf16_t* pb = Bt + (size_t)(n0 + lrow) * ldb + lcol;
  u32x4 ra[4], rb[4];
#pragma unroll
  for (int p = 0; p < 4; ++p) {
    ra[p] = *(const u32x4*)(pa + (size_t)(32 * p) * lda);
    rb[p] = *(const u32x4*)(pb + (size_t)(32 * p) * ldb);
  }
  for (int k0 = 0; k0 < K; k0 += 64) {
#pragma unroll
    for (int p = 0; p < 4; ++p) {
      *(u32x4*)(sA + (lrow + 32 * p) * GS + lcol) = ra[p];
      *(u32x4*)(sB + (lrow + 32 * p) * GS + lcol) = rb[p];
    }
    __syncthreads();
    if (k0 + 64 < K) {
#pragma unroll
      for (int p = 0; p < 4; ++p) {
        ra[p] = *(const u32x4*)(pa + (size_t)(32 * p) * lda + k0 + 64);
        rb[p] = *(const u32x4*)(pb + (size_t)(32 * p) * ldb + k0 + 64);
      }
    }
#pragma unroll
    for (int kk = 0; kk < 2; ++kk) {
      bf16x8 af[4], bfr[4];
#pragma unroll
      for (int i = 0; i < 4; ++i) af[i] = *(const bf16x8*)(sA + (wr * 64 + i * 16 + (lane & 15)) * GS + kk * 32 + (lane >> 4) * 8);
#pragma unroll
      for (int j = 0; j < 4; ++j) bfr[j] = *(const bf16x8*)(sB + (wc * 64 + j * 16 + (lane & 15)) * GS + kk * 32 + (lane >> 4) * 8);
#pragma unroll
      for (int i = 0; i < 4; ++i)
#pragma unroll
        for (int j = 0; j < 4; ++j) acc[i][j] = __builtin_amdgcn_mfma_f32_16x16x32_bf16(bfr[j], af[i], acc[i][j], 0, 0, 0);
    }
    __syncthreads();
  }
#pragma unroll
  for (int i = 0; i < 4; ++i)
#pragma unroll
    for (int j = 0; j < 4; ++j) epi(m0 + wr * 64 + i * 16 + (lane & 15), n0 + wc * 64 + j * 16 + (lane >> 4) * 4, acc[i][j]);
}

struct EpiStoreBf16 {
  bf16_t* C; int ldc;
  __device__ __forceinline__ void operator()(int m, int n, const f32x4& v) const {
    uint2 w; w.x = pack2(v[0], v[1]); w.y = pack2(v[2], v[3]);
    *(uint2*)(C + (size_t)m * ldc + n) = w;
  }
};
struct EpiZ {
  bf16_t *zA, *zP, *zG;
  __device__ __forceinline__ void operator()(int m, int n, const f32x4& v) const {
    uint2 w; w.x = pack2(v[0], v[1]); w.y = pack2(v[2], v[3]);
    if (n < SHIFTC) *(uint2*)(zA + (size_t)m * SHIFTC + n) = w;
    else if (m < NTOK) {
      if (n < SHIFTC + 512) *(uint2*)(zP + (size_t)m * 512 + (n - SHIFTC)) = w;
      else *(uint2*)(zG + (size_t)m * 2048 + (n - SHIFTC - 512)) = w;
    }
  }
};
struct EpiLds {
  float* S;
  __device__ __forceinline__ void operator()(int m, int n, const f32x4& v) const {
    float* r = S + (m & 127) * 129 + n;
    r[0] = v[0]; r[1] = v[1]; r[2] = v[2]; r[3] = v[3];
  }
};

__device__ __forceinline__ void ph_transpose(const float* __restrict__ in, bf16_t* __restrict__ out, int K, int N, int vb, int nvb, unsigned char* smem) {
  float* t = (float*)smem;
  const int tk = K / 32, tn = N / 32, tx = threadIdx.x & 31, ty = threadIdx.x >> 5;
  for (int it = vb; it < tk * tn; it += nvb) {
    const int k0 = (it / tn) * 32, n0 = (it % tn) * 32;
    __syncthreads();
#pragma unroll
    for (int r = 0; r < 4; ++r) t[(ty + 8 * r) * 33 + tx] = in[(size_t)(k0 + ty + 8 * r) * N + n0 + tx];
    __syncthreads();
#pragma unroll
    for (int r = 0; r < 4; ++r) out[(size_t)(n0 + ty + 8 * r) * K + k0 + tx] = f2bf(t[tx * 33 + ty + 8 * r]);
  }
}
__device__ __forceinline__ void ph_convert(const float* __restrict__ in, bf16_t* __restrict__ out, size_t n, int vb, int nvb) {
  for (size_t i = ((size_t)vb * 256 + threadIdx.x) * 4; i < n; i += (size_t)nvb * 1024) {
    const float4 v = *(const float4*)(in + i);
    uint2 w; w.x = pack2(v.x, v.y); w.y = pack2(v.z, v.w);
    *(uint2*)(out + i) = w;
  }
}
__device__ __forceinline__ void ph_weff(const P& p, int vb, int nvb) {
  for (int it = vb * 256 + threadIdx.x; it < 512 * 1024; it += nvb * 256) {
    const int n = it & 1023, k = it >> 10, j = k >> 7, kl = k & 127;
    const float* wp = p.w_pool + ((size_t)j * 128 + kl) * 128;
    float s = 0.f;
    for (int c = 0; c < 128; ++c) s += wp[c] * p.pool_scale[j * 128 + c] * p.w_b_out[(size_t)(j * 128 + c) * 1024 + n];
    p.Wt_eff[(size_t)n * 512 + k] = f2bf(s);
  }
}
__device__ __forceinline__ void ph_mod(const P& p, int vb, int nvb, unsigned char* smem) {
  float* red = (float*)smem;
  const int lane = threadIdx.x & 63, wid = threadIdx.x >> 6;
  for (int it = vb; it < 96; it += nvb) {
    const int n = it * 64 + lane;
    float a0 = 0.f, a1 = 0.f, a2 = 0.f;
#pragma unroll 8
    for (int k = wid * 256; k < wid * 256 + 256; ++k) {
      const float w = p.w_mod[(size_t)k * 6144 + n];
      const float c0 = p.c[k], c1 = p.c[1024 + k], c2 = p.c_ctx[k];
      a0 += c0 * sigmoidf_(c0) * w; a1 += c1 * sigmoidf_(c1) * w; a2 += c2 * sigmoidf_(c2) * w;
    }
    __syncthreads();
    red[(wid * 3 + 0) * 64 + lane] = a0; red[(wid * 3 + 1) * 64 + lane] = a1; red[(wid * 3 + 2) * 64 + lane] = a2;
    __syncthreads();
    if (wid < 3) {
      const float sum = red[(0 * 3 + wid) * 64 + lane] + red[(1 * 3 + wid) * 64 + lane] + red[(2 * 3 + wid) * 64 + lane] + red[(3 * 3 + wid) * 64 + lane];
      p.mod[wid * 6144 + n] = sum + p.b_mod[n];
    }
  }
}
__device__ __forceinline__ float wave_sum(float v) {
#pragma unroll
  for (int o = 32; o > 0; o >>= 1) v += __shfl_xor(v, o);
  return v;
}
__device__ __forceinline__ void ph_norm1(const P& p, int vb, int nvb) {
  const int lane = threadIdx.x & 63, wid = threadIdx.x >> 6;
  for (int m = vb * 4 + wid; m < MROWS; m += nvb * 4) {
    const float* src = m < NTOK ? p.x + (size_t)m * DM : p.ctx + (size_t)(m - NTOK) * DM;
    const float* md = p.mod + (m < NTOK ? (m / SEQ) : 2) * 6144;
    float4 v[4]; float ss = 0.f;
#pragma unroll
    for (int i = 0; i < 4; ++i) { v[i] = *(const float4*)(src + i * 256 + lane * 4); ss += v[i].x * v[i].x + v[i].y * v[i].y + v[i].z * v[i].z + v[i].w * v[i].w; }
    ss = wave_sum(ss);
    const float rstd = rsqrtf(ss * (1.0f / 1024.0f) + 1e-6f);
#pragma unroll
    for (int i = 0; i < 4; ++i) {
      const int col = i * 256 + lane * 4;
      const float4 g = *(const float4*)(p.g_pre_mix + col), sh = *(const float4*)(md + col), sc = *(const float4*)(md + 1024 + col);
      uint2 w;
      w.x = pack2(v[i].x * rstd * g.x * (1.f + sc.x) + sh.x, v[i].y * rstd * g.y * (1.f + sc.y) + sh.y);
      w.y = pack2(v[i].z * rstd * g.z * (1.f + sc.z) + sh.z, v[i].w * rstd * g.w * (1.f + sc.w) + sh.w);
      *(uint2*)(p.hx + (size_t)m * DM + col) = w;
    }
  }
}
__device__ __forceinline__ void ph_gemm1(const P& p, int vb, int nvb, unsigned char* smem) {
  const int nlat = 256 * 47, nall = nlat + 4 * 27;
  EpiZ epi{p.zA, p.zP, p.zG};
  for (int it = vb; it < nall; it += nvb) {
    int tm, tn;
    if (it < nlat) { tn = it / 256; tm = it % 256; } else { const int r = it - nlat; tn = r / 4; tm = 256 + r % 4; }
    gemm_tile(p.hx, DM, p.Wt_in, DM, DM, tm * 128, tn * 128, epi, smem);
  }
}
__device__ __forceinline__ void ph_gemm_simple(const bf16_t* A, int lda, const bf16_t* Bt, int ldb, int K, int M, int N, bf16_t* C, int ldc, int vb, int nvb, unsigned char* smem) {
  const int tm = M / 128, tn = N / 128;
  EpiStoreBf16 epi{C, ldc};
  for (int it = vb; it < tm * tn; it += nvb) gemm_tile(A, lda, Bt, ldb, K, (it % tm) * 128, (it / tm) * 128, epi, smem);
}

__device__ __forceinline__ void load_shift8(const bf16_t* __restrict__ zA, const float* __restrict__ mu, int rowbase, int t, int T, int col0, float* o) {
  const u32x4 zc = *(const u32x4*)(zA + (size_t)(rowbase + t) * SHIFTC + col0);
  u32x4 zp = (u32x4){0u, 0u, 0u, 0u}, zn = (u32x4){0u, 0u, 0u, 0u};
  if (t > 0) zp = *(const u32x4*)(zA + (size_t)(rowbase + t - 1) * SHIFTC + col0);
  if (t < T - 1) zn = *(const u32x4*)(zA + (size_t)(rowbase + t + 1) * SHIFTC + col0);
  const unsigned c[4] = {zc.x, zc.y, zc.z, zc.w}, pv[4] = {zp.x, zp.y, zp.z, zp.w}, nv[4] = {zn.x, zn.y, zn.z, zn.w};
  const f32x4 m0 = *(const f32x4*)(mu + col0), m1 = *(const f32x4*)(mu + col0 + 4);
  const float mm[8] = {m0[0], m0[1], m0[2], m0[3], m1[0], m1[1], m1[2], m1[3]};
#pragma unroll
  for (int i = 0; i < 4; ++i) {
    const float z0 = bflo(c[i]), z1 = bfhi(c[i]);
    o[2 * i] = z0 + mm[2 * i] * (0.5f * (bflo(pv[i]) + bflo(nv[i])) - z0);
    o[2 * i + 1] = z1 + mm[2 * i + 1] * (0.5f * (bfhi(pv[i]) + bfhi(nv[i])) - z1);
  }
}
__device__ __forceinline__ void load_shift4(const bf16_t* __restrict__ zA, const float* __restrict__ mu, int rowbase, int t, int T, int col0, float* o) {
  const u32x2 zc = *(const u32x2*)(zA + (size_t)(rowbase + t) * SHIFTC + col0);
  u32x2 zp = (u32x2){0u, 0u}, zn = (u32x2){0u, 0u};
  if (t > 0) zp = *(const u32x2*)(zA + (size_t)(rowbase + t - 1) * SHIFTC + col0);
  if (t < T - 1) zn = *(const u32x2*)(zA + (size_t)(rowbase + t + 1) * SHIFTC + col0);
#pragma unroll
  for (int i = 0; i < 2; ++i) {
    const float z0 = bflo(zc[i]), z1 = bfhi(zc[i]);
    o[2 * i] = z0 + mu[col0 + 2 * i] * (0.5f * (bflo(zp[i]) + bflo(zn[i])) - z0);
    o[2 * i + 1] = z1 + mu[col0 + 2 * i + 1] * (0.5f * (bfhi(zp[i]) + bfhi(zn[i])) - z1);
  }
}
__device__ __forceinline__ float red16(float v) {
  v += __shfl_xor(v, 1); v += __shfl_xor(v, 2); v += __shfl_xor(v, 4); v += __shfl_xor(v, 8);
  return v;
}
__device__ __forceinline__ float red8(float v) {
  v += __shfl_xor(v, 1); v += __shfl_xor(v, 2); v += __shfl_xor(v, 4);
  return v;
}

#define O_R1 0
#define O_R2 10240
#define O_TA (O_R2 + 17408)
#define O_TR (O_TA + 4608)
#define O_TB (O_TR + 4608)
#define O_TK (O_TB + 4608)
#define O_TBT (O_TK + 4608)
#define O_TKT (O_TBT + 5120)
#define O_TVT (O_TKT + 5120)
#define O_GAM (O_TVT + 5120)
#define O_TST (O_GAM + 256)
#define RWKV_SMEM (O_TST + 2 * 9216)
#define NSUP 65
__device__ __forceinline__ void lds_wave_fence() { asm volatile("s_waitcnt lgkmcnt(0)" ::: "memory"); }
__device__ __forceinline__ u32x2 pack4(const f32x4& v) { u32x2 r; r.x = pack2(v[0], v[1]); r.y = pack2(v[2], v[3]); return r; }

struct RwkvConsts { bf16x8 w2f[2], a2f[2]; };

template <int NS, bool WANTY>
__device__ __forceinline__ void rwkv_chunk(const P& p, unsigned char* smem, int d, int h, int rowbase, int T, int isc0, bool latent, f32x4 (&st)[NS][4], const RwkvConsts& cc) {
  int tid = threadIdx.x;
  asm volatile("" : "+v"(tid));
  const int lane = tid & 63, w = __builtin_amdgcn_readfirstlane(tid >> 6), l15 = lane & 15, q = lane >> 4;
  const int tt = tid >> 3, cg = tid & 7, ch0 = h * 64 + cg * 8;
  const int isc = isc0 + tt, t = d == 0 ? isc : T - 1 - isc;
  bf16_t* TWD = (bf16_t*)(smem + O_R1); bf16_t* TAD = TWD + 32 * 72;
  float* EL = (float*)(smem + O_R1);
  bf16_t* XT = (bf16_t*)(smem + O_R1); bf16_t* UT = XT + 64 * 40;
  float* LW = (float*)(smem + O_R2); float* LA = LW + 32 * 68;
  float* TL = (float*)(smem + O_R2);
  bf16_t* TT = (bf16_t*)(smem + O_R2 + 4608); bf16_t* TAK = TT + 32 * 40; bf16_t* TRB = TAK + 32 * 40; bf16_t* TRK = TRB + 32 * 40;
  bf16_t* TA = (bf16_t*)(smem + O_TA); bf16_t* TR = (bf16_t*)(smem + O_TR); bf16_t* TB = (bf16_t*)(smem + O_TB); bf16_t* TK = (bf16_t*)(smem + O_TK);
  bf16_t* TBT = (bf16_t*)(smem + O_TBT); bf16_t* TKT = (bf16_t*)(smem + O_TKT); bf16_t* TVT = (bf16_t*)(smem + O_TVT);
  float* GAM = (float*)(smem + O_GAM);
  bf16_t* TST = (bf16_t*)(smem + O_TST);
  __syncthreads();
  {
    float o[8];
    load_shift8(p.zA, p.mu_shift, rowbase, t, T, 3072 + d * 64 + cg * 8, o);
    u32x4 pk; pk.x = pack2(tanhf(o[0]), tanhf(o[1])); pk.y = pack2(tanhf(o[2]), tanhf(o[3])); pk.z = pack2(tanhf(o[4]), tanhf(o[5])); pk.w = pack2(tanhf(o[6]), tanhf(o[7]));
    *(u32x4*)(TWD + tt * 72 + cg * 8) = pk;
    load_shift8(p.zA, p.mu_shift, rowbase, t, T, 3200 + d * 64 + cg * 8, o);
    pk.x = pack2(o[0], o[1]); pk.y = pack2(o[2], o[3]); pk.z = pack2(o[4], o[5]); pk.w = pack2(o[6], o[7]);
    *(u32x4*)(TAD + tt * 72 + cg * 8) = pk;
  }

  __syncthreads();
  {
    f32x4 lw[2], la[2];
    bf16x8 w2f[2], a2f[2];
#pragma unroll
    for (int ks = 0; ks < 2; ++ks) {
      w2f[ks] = *(const bf16x8*)(p.w2T + ((size_t)d * 1024 + h * 64 + 16 * w + l15) * 64 + 32 * ks + 8 * q);
      a2f[ks] = *(const bf16x8*)(p.a2T + ((size_t)d * 1024 + h * 64 + 16 * w + l15) * 64 + 32 * ks + 8 * q);
    }
#pragma unroll
    for (int it = 0; it < 2; ++it) { lw[it] = (f32x4){0.f, 0.f, 0.f, 0.f}; la[it] = (f32x4){0.f, 0.f, 0.f, 0.f}; }
#pragma unroll
    for (int ks = 0; ks < 2; ++ks)
#pragma unroll
      for (int it = 0; it < 2; ++it) {
        const bf16x8 aw = *(const bf16x8*)(TWD + (16 * it + l15) * 72 + 32 * ks + 8 * q);
        const bf16x8 aa = *(const bf16x8*)(TAD + (16 * it + l15) * 72 + 32 * ks + 8 * q);
        lw[it] = __builtin_amdgcn_mfma_f32_16x16x32_bf16(aw, w2f[ks], lw[it], 0, 0, 0);
        la[it] = __builtin_amdgcn_mfma_f32_16x16x32_bf16(aa, a2f[ks], la[it], 0, 0, 0);
      }
#pragma unroll
    for (int it = 0; it < 2; ++it)
#pragma unroll
      for (int rg = 0; rg < 4; ++rg) { LW[(16 * it + 4 * q + rg) * 68 + 16 * w + l15] = lw[it][rg]; LA[(16 * it + 4 * q + rg) * 68 + 16 * w + l15] = la[it][rg]; }
  }
  __syncthreads();
  float e8[8], icl[8], kkn[8], kd[8];
  {
    float ss = 0.f, bd = 0.f;
    float k8[8], r8[8];
    load_shift8(p.zA, p.mu_shift, rowbase, t, T, 1024 + ch0, k8);
    if (WANTY) load_shift8(p.zA, p.mu_shift, rowbase, t, T, ch0, r8);
    float cw0[8], ca0[8], ckk[8], cka[8], crk[8];
#pragma unroll
    for (int e4 = 0; e4 < 8; e4 += 4) {
      const f32x4 a = *(const f32x4*)(p.w0 + d * 1024 + ch0 + e4), b2 = *(const f32x4*)(p.a0 + d * 1024 + ch0 + e4), c2 = *(const f32x4*)(p.k_k + ch0 + e4);
      const f32x4 d2 = *(const f32x4*)(p.k_a + ch0 + e4), f2 = *(const f32x4*)(p.r_k + ch0 + e4);
#pragma unroll
      for (int e = 0; e < 4; ++e) { cw0[e4 + e] = a[e]; ca0[e4 + e] = b2[e]; ckk[e4 + e] = c2[e]; cka[e4 + e] = d2[e]; crk[e4 + e] = f2[e]; }
    }
#pragma unroll
    for (int e = 0; e < 8; ++e) {
      const float xw = -(cw0[e] + LW[tt * 68 + cg * 8 + e]);
      const float sp = fmaxf(xw, 0.f) + log1pf(__expf(-fabsf(xw)));
      e8[e] = __expf(-sp - 0.5f);
      icl[e] = sigmoidf_(ca0[e] + LA[tt * 68 + cg * 8 + e]);
      kkn[e] = k8[e] * ckk[e]; ss += kkn[e] * kkn[e];
      kd[e] = k8[e] * (1.f + (icl[e] - 1.f) * cka[e]);
      if (WANTY) bd += r8[e] * kd[e] * crk[e];
    }
    ss = red8(ss); if (WANTY) bd = red8(bd);
    const float rn = rsqrtf(fmaxf(ss, 1e-24f));
#pragma unroll
    for (int e = 0; e < 8; ++e) kkn[e] *= rn;
    if (WANTY && cg == 0) p.bdot[((size_t)d * NTOK + rowbase + t) * 16 + h] = bd;
  }
#pragma unroll
  for (int e = 0; e < 8; ++e) EL[tt * 68 + cg * 8 + e] = e8[e];
  __syncthreads();
  if (tid < 64) {
    float ev[32];
#pragma unroll
    for (int i = 0; i < 32; ++i) ev[i] = EL[i * 68 + tid];
    float run = 0.f;
#pragma unroll
    for (int i = 0; i < 32; ++i) { run += ev[i]; EL[i * 68 + tid] = run; }
  }
  __syncthreads();
  {
    float ta[8], tr[8], tb[8], tk[8], r8[8], v8[8];
    load_shift8(p.zA, p.mu_shift, rowbase, t, T, ch0, r8);
    load_shift8(p.zA, p.mu_shift, rowbase, t, T, 2048 + ch0, v8);
#pragma unroll
    for (int e = 0; e < 8; ++e) {
      const float Li = EL[tt * 68 + cg * 8 + e];
      const float gi = __expf(-Li), gim1 = __expf(-(Li - e8[e])), ginv = __expf(Li);
      ta[e] = -kkn[e] * gim1; tr[e] = r8[e] * gi; tb[e] = kkn[e] * icl[e] * ginv; tk[e] = kd[e] * ginv;
      if (tt == 31) GAM[cg * 8 + e] = gi;
    }
    u32x4 pk;
    pk.x = pack2(ta[0], ta[1]); pk.y = pack2(ta[2], ta[3]); pk.z = pack2(ta[4], ta[5]); pk.w = pack2(ta[6], ta[7]); *(u32x4*)(TA + tt * 72 + cg * 8) = pk;
    pk.x = pack2(tr[0], tr[1]); pk.y = pack2(tr[2], tr[3]); pk.z = pack2(tr[4], tr[5]); pk.w = pack2(tr[6], tr[7]); *(u32x4*)(TR + tt * 72 + cg * 8) = pk;
    pk.x = pack2(tb[0], tb[1]); pk.y = pack2(tb[2], tb[3]); pk.z = pack2(tb[4], tb[5]); pk.w = pack2(tb[6], tb[7]); *(u32x4*)(TB + tt * 72 + cg * 8) = pk;
    pk.x = pack2(tk[0], tk[1]); pk.y = pack2(tk[2], tk[3]); pk.z = pack2(tk[4], tk[5]); pk.w = pack2(tk[6], tk[7]); *(u32x4*)(TK + tt * 72 + cg * 8) = pk;
#pragma unroll
    for (int e = 0; e < 8; ++e) { TBT[(cg * 8 + e) * 40 + tt] = f2bf(tb[e]); TKT[(cg * 8 + e) * 40 + tt] = f2bf(tk[e]); TVT[(cg * 8 + e) * 40 + tt] = f2bf(v8[e]); }
  }
  __syncthreads();
  {
    const bf16_t* X = (w < 2) ? TA : TR; const bf16_t* Y = (w & 1) ? TK : TB;
    f32x4 g[2][2];
#pragma unroll
    for (int it = 0; it < 2; ++it)
#pragma unroll
      for (int s2 = 0; s2 < 2; ++s2) g[it][s2] = (f32x4){0.f, 0.f, 0.f, 0.f};
#pragma unroll
    for (int ks = 0; ks < 2; ++ks) {
      bf16x8 xa[2], yb[2];
#pragma unroll
      for (int it = 0; it < 2; ++it) { xa[it] = *(const bf16x8*)(X + (16 * it + l15) * 72 + 32 * ks + 8 * q); yb[it] = *(const bf16x8*)(Y + (16 * it + l15) * 72 + 32 * ks + 8 * q); }
#pragma unroll
      for (int it = 0; it < 2; ++it)
#pragma unroll
        for (int s2 = 0; s2 < 2; ++s2) g[it][s2] = __builtin_amdgcn_mfma_f32_16x16x32_bf16(xa[it], yb[s2], g[it][s2], 0, 0, 0);
    }
    bf16_t* dst = w == 1 ? TAK : (w == 2 ? TRB : TRK);
#pragma unroll
    for (int it = 0; it < 2; ++it)
#pragma unroll
      for (int s2 = 0; s2 < 2; ++s2)
#pragma unroll
        for (int rg = 0; rg < 4; ++rg) {
          const int i = 16 * it + 4 * q + rg, s = 16 * s2 + l15;
          const float val = g[it][s2][rg];
          if (w == 0) TL[i * 36 + s] = (s < i) ? val : 0.f;
          else dst[i * 40 + s] = f2bf(((w == 1) ? (s < i) : (s <= i)) ? val : 0.f);
        }
  }
  __syncthreads();
  if (w == 0) {
    const int c = lane & 31;
    float Tr[32];
#pragma unroll
    for (int i = 0; i < 32; ++i) {
      float acc = (i == c) ? 1.f : 0.f;
#pragma unroll
      for (int j4 = 0; j4 < (i + 3) / 4; ++j4) {
        const f32x4 l4 = *(const f32x4*)(TL + i * 36 + 4 * j4);
#pragma unroll
        for (int jj = 0; jj < 4; ++jj) if (4 * j4 + jj < i) acc += l4[jj] * Tr[4 * j4 + jj];
      }
      Tr[i] = acc;
    }
    if (lane < 32) {
#pragma unroll
      for (int i = 0; i < 32; ++i) TT[i * 40 + c] = f2bf(Tr[i]);
    }
  }
  __syncthreads();
  const bf16x8 vfr = *(const bf16x8*)(TVT + (16 * w + l15) * 40 + 8 * q);
#pragma unroll
  for (int si = 0; si < NS; ++si) {
    const bool useV = (NS == 1) || (si == 1);
    const bf16_t* STs = TST + (si * 64 + 16 * w + l15) * 72;
    bf16x8 sf[2];
    sf[0] = *(const bf16x8*)(STs + 8 * q); sf[1] = *(const bf16x8*)(STs + 32 + 8 * q);
    f32x4 xa[2];
#pragma unroll
    for (int it = 0; it < 2; ++it) {
      xa[it] = (f32x4){0.f, 0.f, 0.f, 0.f};
#pragma unroll
      for (int ks = 0; ks < 2; ++ks) xa[it] = __builtin_amdgcn_mfma_f32_16x16x32_bf16(*(const bf16x8*)(TA + (16 * it + l15) * 72 + 32 * ks + 8 * q), sf[ks], xa[it], 0, 0, 0);
      if (useV) xa[it] = __builtin_amdgcn_mfma_f32_16x16x32_bf16(*(const bf16x8*)(TAK + (16 * it + l15) * 40 + 8 * q), vfr, xa[it], 0, 0, 0);
      *(u32x2*)(XT + (16 * w + l15) * 40 + 16 * it + 4 * q) = pack4(xa[it]);
    }
    lds_wave_fence();
    const bf16x8 xf = *(const bf16x8*)(XT + (16 * w + l15) * 40 + 8 * q);
    f32x4 ua[2];
#pragma unroll
    for (int it = 0; it < 2; ++it) {
      ua[it] = __builtin_amdgcn_mfma_f32_16x16x32_bf16(*(const bf16x8*)(TT + (16 * it + l15) * 40 + 8 * q), xf, (f32x4){0.f, 0.f, 0.f, 0.f}, 0, 0, 0);
      *(u32x2*)(UT + (16 * w + l15) * 40 + 16 * it + 4 * q) = pack4(ua[it]);
    }
    lds_wave_fence();
    const bf16x8 uf = *(const bf16x8*)(UT + (16 * w + l15) * 40 + 8 * q);
    if (WANTY) {
#pragma unroll
      for (int it = 0; it < 2; ++it) {
        f32x4 ya = (f32x4){0.f, 0.f, 0.f, 0.f};
#pragma unroll
        for (int ks = 0; ks < 2; ++ks) ya = __builtin_amdgcn_mfma_f32_16x16x32_bf16(*(const bf16x8*)(TR + (16 * it + l15) * 72 + 32 * ks + 8 * q), sf[ks], ya, 0, 0, 0);
        ya = __builtin_amdgcn_mfma_f32_16x16x32_bf16(*(const bf16x8*)(TRB + (16 * it + l15) * 40 + 8 * q), uf, ya, 0, 0, 0);
        ya = __builtin_amdgcn_mfma_f32_16x16x32_bf16(*(const bf16x8*)(TRK + (16 * it + l15) * 40 + 8 * q), vfr, ya, 0, 0, 0);
        bf16_t* Yd = d == 0 ? p.Y0 : p.Y1;
#pragma unroll
        for (int rg = 0; rg < 4; ++rg) {
          const int iq = isc0 + 16 * it + 4 * q + rg, tq = d == 0 ? iq : T - 1 - iq;
          Yd[(size_t)(rowbase + tq) * DM + h * 64 + 16 * w + l15] = f2bf(ya[rg]);
        }
      }
    }
#pragma unroll
    for (int kt = 0; kt < 4; ++kt) {
      f32x4 hv = st[si][kt];
      hv = __builtin_amdgcn_mfma_f32_16x16x32_bf16(*(const bf16x8*)(TBT + (16 * kt + l15) * 40 + 8 * q), uf, hv, 0, 0, 0);
      if (useV) hv = __builtin_amdgcn_mfma_f32_16x16x32_bf16(*(const bf16x8*)(TKT + (16 * kt + l15) * 40 + 8 * q), vfr, hv, 0, 0, 0);
      hv *= *(const f32x4*)(GAM + 16 * kt + 4 * q);
      st[si][kt] = hv;
      *(u32x2*)(TST + (si * 64 + 16 * w + l15) * 72 + 16 * kt + 4 * q) = pack4(hv);
    }
  }
}

__device__ __forceinline__ void rwkv_consts(const P& p, int d, int h, RwkvConsts& cc) {
  const int tid = threadIdx.x, lane = tid & 63, w = tid >> 6, l15 = lane & 15, q = lane >> 4;
#pragma unroll
  for (int ks = 0; ks < 2; ++ks) {
    cc.w2f[ks] = *(const bf16x8*)(p.w2T + ((size_t)d * 1024 + h * 64 + 16 * w + l15) * 64 + 32 * ks + 8 * q);
    cc.a2f[ks] = *(const bf16x8*)(p.a2T + ((size_t)d * 1024 + h * 64 + 16 * w + l15) * 64 + 32 * ks + 8 * q);
  }
}
__device__ __forceinline__ void ph_rwkv_A(const P& p, int vb, int nvb, unsigned char* smem) {
  const int tid = threadIdx.x, lane = tid & 63, w = tid >> 6, l15 = lane & 15, q = lane >> 4;
  bf16_t* TST = (bf16_t*)(smem + O_TST);
  for (int item = vb; item < 64 * 64; item += nvb) {
    const int chain = item >> 6, j = item & 63, b = chain >> 5, d = (chain >> 4) & 1, h = chain & 15;
    const bool latent = j > 0;
    const int T = latent ? SEQ : CTXL, rowbase = latent ? b * SEQ : NTOK + b * CTXL, base = latent ? (j - 1) * 256 : 0;
    RwkvConsts cc; rwkv_consts(p, d, h, cc);
    f32x4 st[2][4];
    __syncthreads();
#pragma unroll
    for (int kt = 0; kt < 4; ++kt) {
#pragma unroll
      for (int rg = 0; rg < 4; ++rg) st[0][kt][rg] = (16 * kt + 4 * q + rg == 16 * w + l15) ? 1.f : 0.f;
      st[1][kt] = (f32x4){0.f, 0.f, 0.f, 0.f};
      *(u32x2*)(TST + (16 * w + l15) * 72 + 16 * kt + 4 * q) = pack4(st[0][kt]);
      *(u32x2*)(TST + (64 + 16 * w + l15) * 72 + 16 * kt + 4 * q) = pack4(st[1][kt]);
    }
    for (int c = 0; c < 8; ++c) rwkv_chunk<2, false>(p, smem, d, h, rowbase, T, base + 32 * c, latent, st, cc);
    const size_t slot = (size_t)chain * NSUP + j;
#pragma unroll
    for (int kt = 0; kt < 4; ++kt) {
#pragma unroll
      for (int rg = 0; rg < 4; ++rg) p.Mst[(slot * 64 + 16 * kt + 4 * q + rg) * 64 + 16 * w + l15] = f2bf(st[0][kt][rg]);
      *(f32x4*)(p.Nst + (slot * 64 + 16 * w + l15) * 64 + 16 * kt + 4 * q) = st[1][kt];
    }
  }
}
__device__ __forceinline__ void ph_rwkv_B(const P& p, int vb, int nvb, unsigned char* smem) {
  const int tid = threadIdx.x, lane = tid & 63, w = tid >> 6, l15 = lane & 15, q = lane >> 4;
  bf16_t* HT = (bf16_t*)smem;
  for (int chain = vb; chain < 64; chain += nvb) {
    f32x4 hs[4];
#pragma unroll
    for (int kt = 0; kt < 4; ++kt) hs[kt] = (f32x4){0.f, 0.f, 0.f, 0.f};
    __syncthreads();
    for (int j = 0; j < 64; ++j) {
      const size_t slot = (size_t)chain * NSUP + j;
      f32x4 nv[4];
#pragma unroll
      for (int kt = 0; kt < 4; ++kt) nv[kt] = *(const f32x4*)(p.Nst + (slot * 64 + 16 * w + l15) * 64 + 16 * kt + 4 * q);
      bf16x8 mf[4][2];
#pragma unroll
      for (int kt = 0; kt < 4; ++kt)
#pragma unroll
        for (int ks = 0; ks < 2; ++ks) mf[kt][ks] = *(const bf16x8*)(p.Mst + (slot * 64 + 16 * kt + l15) * 64 + 32 * ks + 8 * q);
#pragma unroll
      for (int kt = 0; kt < 4; ++kt) {
        *(f32x4*)(p.Nst + (slot * 64 + 16 * w + l15) * 64 + 16 * kt + 4 * q) = hs[kt];
        *(u32x2*)(HT + (16 * w + l15) * 72 + 16 * kt + 4 * q) = pack4(hs[kt]);
      }
      lds_wave_fence();
      bf16x8 hf[2];
      hf[0] = *(const bf16x8*)(HT + (16 * w + l15) * 72 + 8 * q); hf[1] = *(const bf16x8*)(HT + (16 * w + l15) * 72 + 32 + 8 * q);
      lds_wave_fence();
#pragma unroll
      for (int kt = 0; kt < 4; ++kt) {
        f32x4 a = nv[kt];
#pragma unroll
        for (int ks = 0; ks < 2; ++ks) a = __builtin_amdgcn_mfma_f32_16x16x32_bf16(mf[kt][ks], hf[ks], a, 0, 0, 0);
        hs[kt] = a;
      }
    }
    const size_t slot = (size_t)chain * NSUP + 64;
#pragma unroll
    for (int kt = 0; kt < 4; ++kt) *(f32x4*)(p.Nst + (slot * 64 + 16 * w + l15) * 64 + 16 * kt + 4 * q) = hs[kt];
  }
}
__device__ __forceinline__ void ph_rwkv_C(const P& p, int vb, int nvb, unsigned char* smem) {
  const int tid = threadIdx.x, lane = tid & 63, w = tid >> 6, l15 = lane & 15, q = lane >> 4;
  bf16_t* TST = (bf16_t*)(smem + O_TST);
  for (int item = vb; item < 64 * 64; item += nvb) {
    const int chain = item >> 6, j = (item & 63) + 1, b = chain >> 5, d = (chain >> 4) & 1, h = chain & 15;
    RwkvConsts cc; rwkv_consts(p, d, h, cc);
    f32x4 st[1][4];
    const size_t slot = (size_t)chain * NSUP + j;
    __syncthreads();
#pragma unroll
    for (int kt = 0; kt < 4; ++kt) {
      st[0][kt] = *(const f32x4*)(p.Nst + (slot * 64 + 16 * w + l15) * 64 + 16 * kt + 4 * q);
      *(u32x2*)(TST + (16 * w + l15) * 72 + 16 * kt + 4 * q) = pack4(st[0][kt]);
    }
    for (int c = 0; c < 8; ++c) rwkv_chunk<1, true>(p, smem, d, h, b * SEQ, SEQ, (j - 1) * 256 + 32 * c, true, st, cc);
  }
}

#define RO_SMEM (128 * 16 * 4)
__device__ __forceinline__ void ph_readout(const P& p, int vb, int nvb, unsigned char* smem) {
  float* sgT = (float*)smem;
  const int tid = threadIdx.x, c4 = tid * 4, h = tid >> 4;
  const float4 lnw = *(const float4*)(p.ln_x_w + c4), lnb = *(const float4*)(p.ln_x_b + c4);
  for (int item = vb; item < NTOK / 16; item += nvb) {
    const int tok0 = item * 16;
    __syncthreads();
    {
      const int tk = tid >> 4, l8 = (tid & 15) * 8, m = tok0 + tk, b = m / SEQ, t = m % SEQ;
      float o[8];
      load_shift8(p.zA, p.mu_shift, b * SEQ, t, SEQ, 3328 + l8, o);
#pragma unroll
      for (int e = 0; e < 8; ++e) sgT[(l8 + e) * 16 + tk] = sigmoidf_(o[e]);
    }
    __syncthreads();
    float4 g[16];
#pragma unroll
    for (int k = 0; k < 16; ++k) g[k] = make_float4(0.f, 0.f, 0.f, 0.f);
    for (int l = 0; l < 128; ++l) {
      const float4 w = *(const float4*)(p.g2 + (size_t)l * 1024 + c4);
      const float4 s0 = *(const float4*)(sgT + l * 16), s1 = *(const float4*)(sgT + l * 16 + 4), s2 = *(const float4*)(sgT + l * 16 + 8), s3 = *(const float4*)(sgT + l * 16 + 12);
      const float sv[16] = {s0.x, s0.y, s0.z, s0.w, s1.x, s1.y, s1.z, s1.w, s2.x, s2.y, s2.z, s2.w, s3.x, s3.y, s3.z, s3.w};
#pragma unroll
      for (int k = 0; k < 16; ++k) { g[k].x += sv[k] * w.x; g[k].y += sv[k] * w.y; g[k].z += sv[k] * w.z; g[k].w += sv[k] * w.w; }
    }
#pragma unroll
    for (int k = 0; k < 16; ++k) {
      const int m = tok0 + k, b = m / SEQ, t = m % SEQ;
      const uint2 y0 = *(const uint2*)(p.Y0 + (size_t)m * DM + c4), y1 = *(const uint2*)(p.Y1 + (size_t)m * DM + c4);
      float y[4] = {bflo(y0.x) + bflo(y1.x), bfhi(y0.x) + bfhi(y1.x), bflo(y0.y) + bflo(y1.y), bfhi(y0.y) + bfhi(y1.y)};
      const float mu = red16(y[0] + y[1] + y[2] + y[3]) * (1.f / 64.f);
      float q = 0.f;
#pragma unroll
      for (int e = 0; e < 4; ++e) { y[e] -= mu; q += y[e] * y[e]; }
      const float rs = rsqrtf(red16(q) * (1.f / 64.f) + 64e-5f);
      const bf16_t* zr = p.zA + (size_t)m * SHIFTC + 2048 + c4;
      const uint2 zc = *(const uint2*)zr;
      uint2 zp = make_uint2(0, 0), zn = make_uint2(0, 0);
      if (t > 0) zp = *(const uint2*)(zr - SHIFTC);
      if (t < SEQ - 1) zn = *(const uint2*)(zr + SHIFTC);
      const float4 mu4 = *(const float4*)(p.mu_shift + 2048 + c4);
      float v[4];
      v[0] = bflo(zc.x) + mu4.x * (0.5f * (bflo(zp.x) + bflo(zn.x)) - bflo(zc.x));
      v[1] = bfhi(zc.x) + mu4.y * (0.5f * (bfhi(zp.x) + bfhi(zn.x)) - bfhi(zc.x));
      v[2] = bflo(zc.y) + mu4.z * (0.5f * (bflo(zp.y) + bflo(zn.y)) - bflo(zc.y));
      v[3] = bfhi(zc.y) + mu4.w * (0.5f * (bfhi(zp.y) + bfhi(zn.y)) - bfhi(zc.y));
      const float bon = 0.5f * (p.bdot[(size_t)m * 16 + h] + p.bdot[((size_t)NTOK + m) * 16 + h]);
      const float o0 = (y[0] * rs * lnw.x + lnb.x + bon * v[0]) * g[k].x, o1 = (y[1] * rs * lnw.y + lnb.y + bon * v[1]) * g[k].y;
      const float o2 = (y[2] * rs * lnw.z + lnb.z + bon * v[2]) * g[k].z, o3 = (y[3] * rs * lnw.w + lnb.w + bon * v[3]) * g[k].w;
      uint2 w; w.x = pack2(o0, o1); w.y = pack2(o2, o3);
      *(uint2*)(p.out_a + (size_t)m * DM + c4) = w;
    }
  }
}

#define POOL_SMEM (64 * 128 * 4)
__device__ __forceinline__ void ph_pool(const P& p, int vb, int nvb, unsigned char* smem) {
  float* V = (float*)smem;
  const int tid = threadIdx.x;
  for (int item = vb; item < 2 * 256 * 4; item += nvb) {
    const int j = item & 3, r = (item >> 2) & 255, b = item >> 10;
    const int win = 2 << j, half = win >> 1;
    const int r0 = max(r - half, 0), r1 = min(r + half, 256);
    __syncthreads();
    const int cp = tid & 63, cq = tid >> 6;
    float a0[16], a1[16];
#pragma unroll
    for (int i = 0; i < 16; ++i) { a0[i] = 0.f; a1[i] = 0.f; }
    for (int rr = r0; rr < r1; ++rr) {
      const bf16_t* base = p.zP + ((size_t)b * SEQ + rr * 64) * 512 + j * 128 + cp * 2;
#pragma unroll
      for (int i = 0; i < 16; ++i) {
        const unsigned u = *(const unsigned*)(base + (size_t)(cq + 4 * i) * 512);
        a0[i] += bflo(u); a1[i] += bfhi(u);
      }
    }
#pragma unroll
    for (int i = 0; i < 16; ++i) { V[(cq + 4 * i) * 128 + cp * 2] = a0[i]; V[(cq + 4 * i) * 128 + cp * 2 + 1] = a1[i]; }
    __syncthreads();
#pragma unroll
    for (int i = 0; i < 16; ++i) {
      const int col = cq + 4 * i, c0 = max(col - half, 0), c1 = min(col + half, 64);
      float s0 = 0.f, s1 = 0.f;
      for (int cc = c0; cc < c1; ++cc) { s0 += V[cc * 128 + cp * 2]; s1 += V[cc * 128 + cp * 2 + 1]; }
      const float inv = 1.0f / (float)((r1 - r0) * (c1 - c0));
      const size_t tokoff = ((size_t)b * SEQ + r * 64 + col) * 512 + j * 128 + cp * 2;
      const unsigned u = *(const unsigned*)(p.zP + tokoff);
      *(unsigned*)(p.pooled + tokoff) = pack2(s0 * inv - bflo(u), s1 * inv - bfhi(u));
    }
  }
}
__device__ __forceinline__ void ph_merge(const P& p, int vb, int nvb) {
  for (size_t i = ((size_t)vb * 256 + threadIdx.x) * 4; i < (size_t)NTOK * DM; i += (size_t)nvb * 1024) {
    const size_t m = i >> 10; const int c = (int)(i & 1023);
    const uint2 g1 = *(const uint2*)(p.zG + m * 2048 + c), g2 = *(const uint2*)(p.zG + m * 2048 + 1024 + c);
    const uint2 a = *(const uint2*)(p.ya + i), bq = *(const uint2*)(p.yb + i);
    const float4 b1 = *(const float4*)(p.b_gate + c), b2 = *(const float4*)(p.b_gate + 1024 + c);
    const float m0 = sigmoidf_(bflo(g1.x) + b1.x) * bflo(a.x) + sigmoidf_(bflo(g2.x) + b2.x) * bflo(bq.x);
    const float m1 = sigmoidf_(bfhi(g1.x) + b1.y) * bfhi(a.x) + sigmoidf_(bfhi(g2.x) + b2.y) * bfhi(bq.x);
    const float m2 = sigmoidf_(bflo(g1.y) + b1.z) * bflo(a.y) + sigmoidf_(bflo(g2.y) + b2.z) * bflo(bq.y);
    const float m3 = sigmoidf_(bfhi(g1.y) + b1.w) * bfhi(a.y) + sigmoidf_(bfhi(g2.y) + b2.w) * bfhi(bq.y);
    uint2 w; w.x = pack2(m0, m1); w.y = pack2(m2, m3);
    *(uint2*)(p.mrg + i) = w;
  }
}
__device__ __forceinline__ void ph_res1(const P& p, int vb, int nvb) {
  const int lane = threadIdx.x & 63, wid = threadIdx.x >> 6;
  for (int m = vb * 4 + wid; m < NTOK; m += nvb * 4) {
    const float* md = p.mod + (m / SEQ) * 6144;
    float mx[16]; float ss = 0.f;
#pragma unroll
    for (int i = 0; i < 4; ++i) {
      const uint2 u = *(const uint2*)(p.mix + (size_t)m * DM + i * 256 + lane * 4);
      mx[4 * i] = bflo(u.x); mx[4 * i + 1] = bfhi(u.x); mx[4 * i + 2] = bflo(u.y); mx[4 * i + 3] = bfhi(u.y);
#pragma unroll
      for (int e = 0; e < 4; ++e) ss += mx[4 * i + e] * mx[4 * i + e];
    }
    ss = wave_sum(ss);
    const float rstd = rsqrtf(ss * (1.0f / 1024.0f) + 1e-6f);
    float x1[16]; float s2 = 0.f;
#pragma unroll
    for (int i = 0; i < 4; ++i) {
      const int col = i * 256 + lane * 4;
      const float4 xv = *(const float4*)(p.x + (size_t)m * DM + col), g = *(const float4*)(p.g_post_mix + col), gt = *(const float4*)(md + 2048 + col);
      x1[4 * i] = xv.x + gt.x * mx[4 * i] * rstd * g.x; x1[4 * i + 1] = xv.y + gt.y * mx[4 * i + 1] * rstd * g.y;
      x1[4 * i + 2] = xv.z + gt.z * mx[4 * i + 2] * rstd * g.z; x1[4 * i + 3] = xv.w + gt.w * mx[4 * i + 3] * rstd * g.w;
      *(float4*)(p.out + (size_t)m * DM + col) = make_float4(x1[4 * i], x1[4 * i + 1], x1[4 * i + 2], x1[4 * i + 3]);
#pragma unroll
      for (int e = 0; e < 4; ++e) s2 += x1[4 * i + e] * x1[4 * i + e];
    }
    s2 = wave_sum(s2);
    const float r2 = rsqrtf(s2 * (1.0f / 1024.0f) + 1e-6f);
#pragma unroll
    for (int i = 0; i < 4; ++i) {
      const int col = i * 256 + lane * 4;
      const float4 g = *(const float4*)(p.g_pre_ffn + col), sh = *(const float4*)(md + 3072 + col), sc = *(const float4*)(md + 4096 + col);
      uint2 w;
      w.x = pack2(x1[4 * i] * r2 * g.x * (1.f + sc.x) + sh.x, x1[4 * i + 1] * r2 * g.y * (1.f + sc.y) + sh.y);
      w.y = pack2(x1[4 * i + 2] * r2 * g.z * (1.f + sc.z) + sh.z, x1[4 * i + 3] * r2 * g.w * (1.f + sc.w) + sh.w);
      *(uint2*)(p.hx2 + (size_t)m * DM + col) = w;
    }
  }
}

#define PS1_SMEM (128 * 129 * 4)
__device__ __forceinline__ void ph_peer_s1(const P& p, int vb, int nvb, unsigned char* smem) {
  float* S = (float*)smem;
  EpiLds epi{S};
  const int tid = threadIdx.x, row = tid >> 1, hf = tid & 1;
  for (int item = vb; item < 256 * 16; item += nvb) {
    const int hp = item & 15, tm = item >> 4;
    __syncthreads();
    gemm_tile(p.q + hp * 128, 2048, p.keys + (size_t)hp * 128 * 128, 128, 128, tm * 128, 0, epi, smem);
    __syncthreads();
    float v[64];
#pragma unroll
    for (int i = 0; i < 64; ++i) v[i] = S[row * 129 + hf * 64 + i];
    const size_t ob = ((size_t)(tm * 128 + row) * 16 + hp) * 16;
    for (int it = 0; it < 16; ++it) {
      float mx = v[0];
#pragma unroll
      for (int i = 1; i < 64; ++i) mx = fmaxf(mx, v[i]);
      const float ox = __shfl_xor(mx, 1);
      const bool mine = hf == 0 ? (mx >= ox) : (mx > ox);
      const float best = fmaxf(mx, ox);
      int idx = 0;
      if (mine) {
        bool found = false;
#pragma unroll
        for (int i = 0; i < 64; ++i) {
          const bool hit = !found && (v[i] == best);
          if (hit) { idx = hf * 64 + i; v[i] = -3.0e38f; found = true; }
        }
      }
      const int oidx = __shfl_xor(idx, 1);
      if (hf == 0) { p.sv[ob + it] = best; p.si[ob + it] = mine ? idx : oidx; }
    }
  }
}
__device__ __forceinline__ void ph_peer_s2(const P& p, int vb, int nvb) {
  for (int it = vb * 256 + threadIdx.x; it < NTOK * 8; it += nvb * 256) {
    const size_t ob = (size_t)it * 32;
    float a[16], bq[16]; int ia[16], ib[16];
#pragma unroll
    for (int i = 0; i < 16; i += 4) {
      const float4 fa = *(const float4*)(p.sv + ob + i), fb = *(const float4*)(p.sv + ob + 16 + i);
      const int4 ja = *(const int4*)(p.si + ob + i), jb = *(const int4*)(p.si + ob + 16 + i);
      a[i] = fa.x; a[i + 1] = fa.y; a[i + 2] = fa.z; a[i + 3] = fa.w; bq[i] = fb.x; bq[i + 1] = fb.y; bq[i + 2] = fb.z; bq[i + 3] = fb.w;
      ia[i] = ja.x; ia[i + 1] = ja.y; ia[i + 2] = ja.z; ia[i + 3] = ja.w; ib[i] = jb.x; ib[i + 1] = jb.y; ib[i + 2] = jb.z; ib[i + 3] = jb.w;
    }
    float cs[50]; int ci[50];
    {
      int n = 0;
#pragma unroll
      for (int i = 0; i < 16; ++i)
#pragma unroll
        for (int j = 0; j < 16; ++j)
          if ((i + 1) * (j + 1) <= 16) { cs[n] = a[i] + bq[j]; ci[n] = ia[i] * 128 + ib[j]; ++n; }
    }
    float sel[16]; int seli[16];
#pragma unroll
    for (int k = 0; k < 16; ++k) {
      float mx = cs[0];
#pragma unroll
      for (int n = 1; n < 50; ++n) mx = fmaxf(mx, cs[n]);
      int id = 0; bool found = false;
#pragma unroll
      for (int n = 0; n < 50; ++n) {
        const bool hit = !found && (cs[n] == mx);
        if (hit) { id = ci[n]; cs[n] = -3.0e38f; found = true; }
      }
      sel[k] = mx; seli[k] = id;
    }
    float den = 0.f; const float smax = sel[0];
#pragma unroll
    for (int k = 0; k < 16; ++k) { sel[k] = __expf(sel[k] - smax); den += sel[k]; }
    const float inv = 1.0f / den;
    const size_t o2 = (size_t)it * 16;
#pragma unroll
    for (int k = 0; k < 16; ++k) { p.pidx[o2 + k] = seli[k]; p.pgate[o2 + k] = sel[k] * inv; }
  }
}
__device__ __forceinline__ void ph_peer_gather(const P& p, int vb, int nvb) {
  const int lane = threadIdx.x & 63, wid = threadIdx.x >> 6;
  for (int m = vb * 4 + wid; m < NTOK; m += nvb * 4) {
    const float* md = p.mod + (m / SEQ) * 6144;
    float xv[16];
    {
      const uint4 u0 = *(const uint4*)(p.hx2 + (size_t)m * DM + lane * 16), u1 = *(const uint4*)(p.hx2 + (size_t)m * DM + lane * 16 + 8);
      const unsigned uu[8] = {u0.x, u0.y, u0.z, u0.w, u1.x, u1.y, u1.z, u1.w};
#pragma unroll
      for (int e = 0; e < 8; ++e) { xv[2 * e] = bflo(uu[e]); xv[2 * e + 1] = bfhi(uu[e]); }
    }
    const int id0 = p.pidx[(size_t)m * 128 + lane], id1 = p.pidx[(size_t)m * 128 + 64 + lane];
    const float g0 = p.pgate[(size_t)m * 128 + lane], g1 = p.pgate[(size_t)m * 128 + 64 + lane];
    float cf0 = 0.f, cf1 = 0.f;
    for (int e0 = 0; e0 < 128; e0 += 4) {
      float d[4];
#pragma unroll
      for (int q = 0; q < 4; ++q) {
        const int e = e0 + q;
        const int id = __shfl(e < 64 ? id0 : id1, e & 63);
        const uint4 u0 = *(const uint4*)(p.ub + (size_t)id * DM + lane * 16), u1 = *(const uint4*)(p.ub + (size_t)id * DM + lane * 16 + 8);
        const unsigned uu[8] = {u0.x, u0.y, u0.z, u0.w, u1.x, u1.y, u1.z, u1.w};
        float s = 0.f;
#pragma unroll
        for (int k = 0; k < 8; ++k) s += bflo(uu[k]) * xv[2 * k] + bfhi(uu[k]) * xv[2 * k + 1];
        d[q] = s;
      }
#pragma unroll
      for (int q = 0; q < 4; ++q) {
        const float s = wave_sum(d[q]);
        const float act = 0.5f * s * (1.0f + erff(s * 0.70710678118654752f));
        const int e = e0 + q;
        if (e < 64) { if (lane == e) cf0 = act * g0; } else { if (lane == e - 64) cf1 = act * g1; }
      }
    }
    float acc[16];
#pragma unroll
    for (int k = 0; k < 16; ++k) acc[k] = 0.f;
    for (int e = 0; e < 128; ++e) {
      const int id = __shfl(e < 64 ? id0 : id1, e & 63);
      const float cf = __shfl(e < 64 ? cf0 : cf1, e & 63);
      const uint4 u0 = *(const uint4*)(p.vb + (size_t)id * DM + lane * 16), u1 = *(const uint4*)(p.vb + (size_t)id * DM + lane * 16 + 8);
      const unsigned uu[8] = {u0.x, u0.y, u0.z, u0.w, u1.x, u1.y, u1.z, u1.w};
#pragma unroll
      for (int k = 0; k < 8; ++k) { acc[2 * k] += cf * bflo(uu[k]); acc[2 * k + 1] += cf * bfhi(uu[k]); }
    }
    float ss = 0.f;
#pragma unroll
    for (int k = 0; k < 16; ++k) ss += acc[k] * acc[k];
    ss = wave_sum(ss);
    const float rstd = rsqrtf(ss * (1.0f / 1024.0f) + 1e-6f);
#pragma unroll
    for (int k4 = 0; k4 < 4; ++k4) {
      const int col = lane * 16 + k4 * 4;
      float4 x1 = *(const float4*)(p.out + (size_t)m * DM + col);
      const float4 g = *(const float4*)(p.g_post_ffn + col), gt = *(const float4*)(md + 5120 + col);
      x1.x += gt.x * acc[k4 * 4] * rstd * g.x; x1.y += gt.y * acc[k4 * 4 + 1] * rstd * g.y;
      x1.z += gt.z * acc[k4 * 4 + 2] * rstd * g.z; x1.w += gt.w * acc[k4 * 4 + 3] * rstd * g.w;
      *(float4*)(p.out + (size_t)m * DM + col) = x1;
    }
  }
}

#define SMEM_BYTES RWKV_SMEM
__global__ void __launch_bounds__(256, 2) mega(P p) {
  __shared__ __attribute__((aligned(16))) unsigned char smem[SMEM_BYTES];
  cg::grid_group grid = cg::this_grid();
  const int vb = blockIdx.x, nvb = gridDim.x;
  ph_mod(p, vb, nvb, smem);
  ph_transpose(p.w_in, p.Wt_in, DM, INC, vb, nvb, smem);
  ph_transpose(p.w_a_out, p.Wt_aout, DM, DM, vb, nvb, smem);
  ph_transpose(p.w_o, p.Wt_o, DM, DM, vb, nvb, smem);
  ph_transpose(p.peer_wq, p.Wt_q, DM, 2048, vb, nvb, smem);
  ph_transpose(p.w2, p.w2T, 64, 1024, vb, nvb, smem);
  ph_transpose(p.w2 + 65536, p.w2T + 65536, 64, 1024, vb, nvb, smem);
  ph_transpose(p.a2, p.a2T, 64, 1024, vb, nvb, smem);
  ph_transpose(p.a2 + 65536, p.a2T + 65536, 64, 1024, vb, nvb, smem);
  ph_weff(p, vb, nvb);
  ph_convert(p.peer_keys, p.keys, (size_t)16 * 128 * 128, vb, nvb);
  grid.sync();
  ph_norm1(p, vb, nvb);
  grid.sync();
  ph_gemm1(p, vb, nvb, smem);
  grid.sync();
  ph_rwkv_A(p, vb, nvb, smem);
  grid.sync();
  ph_rwkv_B(p, vb, nvb, smem);
  grid.sync();
  ph_rwkv_C(p, vb, nvb, smem);
  grid.sync();
  ph_readout(p, vb, nvb, smem);
  ph_pool(p, vb, nvb, smem);
  ph_convert(p.peer_u, p.ub, (size_t)16384 * 1024, vb, nvb);
  ph_convert(p.peer_v, p.vb, (size_t)16384 * 1024, vb, nvb);
  grid.sync();
  ph_gemm_simple(p.out_a, DM, p.Wt_aout, DM, DM, NTOK, DM, p.ya, DM, vb, nvb, smem);
  ph_gemm_simple(p.pooled, 512, p.Wt_eff, 512, 512, NTOK, DM, p.yb, DM, vb, nvb, smem);
  grid.sync();
  ph_merge(p, vb, nvb);
  grid.sync();
  ph_gemm_simple(p.mrg, DM, p.Wt_o, DM, DM, NTOK, DM, p.mix, DM, vb, nvb, smem);
  grid.sync();
  ph_res1(p, vb, nvb);
  grid.sync();
  ph_gemm_simple(p.hx2, DM, p.Wt_q, DM, DM, NTOK, 2048, p.q, 2048, vb, nvb, smem);
  grid.sync();
  ph_peer_s1(p, vb, nvb, smem);
  grid.sync();
  ph_peer_s2(p, vb, nvb);
  grid.sync();
  ph_peer_gather(p, vb, nvb);
}

extern "C" void kernel_launch(void* const* d_in, const int* in_sizes, int n_in, void* d_out, int out_size, void* d_ws, size_t ws_size, hipStream_t stream) {
  P p{};
  const float** f = (const float**)&p;
  for (int i = 0; i < 32; ++i) f[i] = (const float*)d_in[i];
  p.out = (float*)d_out;
  unsigned char* w = (unsigned char*)d_ws;
  const size_t MiB = 1048576;
  const size_t HM = 524288;
  p.hx = (bf16_t*)(w + 0 * MiB);
  p.zA = (bf16_t*)(w + 65 * MiB);
  p.zP = (bf16_t*)(w + 569 * HM);
  p.zG = (bf16_t*)d_out;
  unsigned char* rw = w + 633 * HM;
  p.Wt_in = (bf16_t*)rw; rw += 12 * MiB;
  p.Wt_aout = (bf16_t*)rw; rw += 2 * MiB;
  p.Wt_eff = (bf16_t*)rw; rw += 1 * MiB;
  p.Wt_o = (bf16_t*)rw; rw += 2 * MiB;
  p.Wt_q = (bf16_t*)rw; rw += 4 * MiB;
  p.keys = (bf16_t*)rw; rw += HM;
  p.mod = (float*)rw; rw += HM;
  p.w2T = (bf16_t*)rw; rw += HM;
  p.a2T = (bf16_t*)rw; rw += HM;
  p.Y0 = (bf16_t*)(w + 0 * MiB);
  p.Y1 = (bf16_t*)(w + 340 * MiB);
  p.bdot = (float*)(w + 404 * MiB);
  p.Mst = (bf16_t*)(w + 408 * MiB);
  p.Nst = (float*)(w + 441 * MiB);
  p.ub = (bf16_t*)(w + 408 * MiB);
  p.vb = (bf16_t*)(w + 440 * MiB);
  p.pooled = (bf16_t*)(w + 478 * MiB);
  p.out_a = (bf16_t*)(w + 0 * MiB);
  p.ya = (bf16_t*)(w + 65 * MiB);
  p.yb = (bf16_t*)(w + 129 * MiB);
  p.mrg = (bf16_t*)(w + 193 * MiB);
  p.mix = (bf16_t*)(w + 65 * MiB);
  p.hx2 = (bf16_t*)(w + 0 * MiB);
  p.q = (bf16_t*)(w + 129 * MiB);
  p.sv = (float*)(w + 340 * MiB);
  p.si = (int*)(w + 372 * MiB);
  p.pidx = (int*)(w + 257 * MiB);
  p.pgate = (float*)(w + 273 * MiB);
  static int grid_blocks = 0;
  if (!grid_blocks) {
    int dev = 0, cus = 0, per_cu = 0;
    hipGetDevice(&dev);
    hipDeviceGetAttribute(&cus, hipDeviceAttributeMultiprocessorCount, dev);
    hipOccupancyMaxActiveBlocksPerMultiprocessor(&per_cu, mega, 256, 0);
    if (per_cu > 2) per_cu = 2;
    if (per_cu < 1) per_cu = 1;
    grid_blocks = cus * per_cu;
  }
  void* args[] = {&p};
  hipError_t e = hipLaunchCooperativeKernel((void*)mega, dim3(grid_blocks), dim3(256), args, 0, stream);
  if (e != hipSuccess) fprintf(stderr, "cooperative launch failed: %s (grid %d)\n", hipGetErrorString(e), grid_blocks);
}
```

```cpp
#include <hip/hip_runtime.h>
#include <hip/hip_cooperative_groups.h>
#include <stdint.h>
#include <cstdio>
namespace cg = cooperative_groups;

typedef unsigned short bf16_t;
typedef short bf16x8 __attribute__((ext_vector_type(8)));
typedef float f32x4 __attribute__((ext_vector_type(4)));
typedef unsigned u32x4 __attribute__((ext_vector_type(4)));
typedef unsigned u32x2 __attribute__((ext_vector_type(2)));

#define NTOK 32768
#define SEQ 16384
#define CTXL 256
#define NCTX 512
#define MROWS 33280
#define DM 1024
#define SHIFTC 3456
#define INC 6016

__device__ __forceinline__ bf16_t f2bf(float f) { unsigned u = __float_as_uint(f); u += 0x7fffu + ((u >> 16) & 1u); return (bf16_t)(u >> 16); }
__device__ __forceinline__ float bf2f(bf16_t h) { return __uint_as_float(((unsigned)h) << 16); }
__device__ __forceinline__ float bflo(unsigned u) { return __uint_as_float(u << 16); }
__device__ __forceinline__ float bfhi(unsigned u) { return __uint_as_float(u & 0xffff0000u); }
__device__ __forceinline__ unsigned pack2(float a, float b) { return (unsigned)f2bf(a) | ((unsigned)f2bf(b) << 16); }
__device__ __forceinline__ float sigmoidf_(float x) { return 1.0f / (1.0f + __expf(-x)); }

struct P {
  const float *x, *c, *ctx, *c_ctx, *w_mod, *b_mod, *g_pre_mix, *g_post_mix, *g_pre_ffn, *g_post_ffn, *w_in, *b_gate, *mu_shift,
      *w0, *w2, *a0, *a2, *g2, *k_k, *k_a, *r_k, *ln_x_w, *ln_x_b, *w_a_out, *w_pool, *pool_scale, *w_b_out, *w_o, *peer_wq,
      *peer_keys, *peer_u, *peer_v;
  float* out;
  unsigned* bar;
  bf16_t* hx;
  bf16_t* zA;
  bf16_t* zP;
  bf16_t* zG;
  bf16_t* Wt_in;
  bf16_t* Wt_aout;
  bf16_t* Wt_eff;
  bf16_t* Wt_o;
  bf16_t* Wt_q;
  bf16_t* keys;
  float* mod;
  unsigned char* ub8;
  unsigned char* vb8;
  float* us;
  float* vs;
  bf16_t* w2T;
  bf16_t* a2T;
  bf16_t* Mst;
  float* Nst;
  bf16_t* Y0;
  bf16_t* Y1;
  float* bdot;
  bf16_t* out_a;
  bf16_t* ya;
  bf16_t* pooled;
  bf16_t* yb;
  bf16_t* mrg;
  bf16_t* mix;
  bf16_t* hx2;
  bf16_t* q;
  float* sv;
  int* si;
  int* pidx;
  float* pgate;
};

#define GS 72
#define GEMM_SMEM (2 * 128 * GS * 2)
template <class Epi>
__device__ __forceinline__ void gemm_tile(const bf16_t* __restrict__ A, int lda, const bf16_t* __restrict__ Bt, int ldb, int K, int m0, int n0,
                                          const Epi& epi, unsigned char* smem) {
  const int tid = threadIdx.x, lane = tid & 63, wid = tid >> 6, wr = wid >> 1, wc = wid & 1;
  bf16_t* sA = (bf16_t*)smem;
  bf16_t* sB = sA + 128 * GS;
  f32x4 acc[4][4];
#pragma unroll
  for (int i = 0; i < 4; ++i)
#pragma unroll
    for (int j = 0; j < 4; ++j) acc[i][j] = (f32x4){0.f, 0.f, 0.f, 0.f};
  const int lrow = tid >> 3, lcol = (tid & 7) * 8;
  const bf16_t* pa = A + (size_t)(m0 + lrow) * lda + lcol;
  const bf16_t* pb = Bt + (size_t)(n0 + lrow) * ldb + lcol;
  u32x4 ra[4], rb[4];
#pragma unroll
  for (int p = 0; p < 4; ++p) {
    ra[p] = *(const u32x4*)(pa + (size_t)(32 * p) * lda);
    rb[p] = *(const u32x4*)(pb + (size_t)(32 * p) * ldb);
  }
  for (int k0 = 0; k0 < K; k0 += 64) {
#pragma unroll
    for (int p = 0; p < 4; ++p) {
      *(u32x4*)(sA + (lrow + 32 * p) * GS + lcol) = ra[p];
      *(u32x4*)(sB + (lrow + 32 * p) * GS + lcol) = rb[p];
    }
    __syncthreads();
    if (k0 + 64 < K) {
#pragma unroll
      for (int p = 0; p < 4; ++p) {
        ra[p] = *(const u32x4*)(pa + (size_t)(32 * p) * lda + k0 + 64);
        rb[p] = *(const u32x4*)(pb + (size_t)(32 * p) * ldb + k0 + 64);
      }
    }
#pragma unroll
    for (int kk = 0; kk < 2; ++kk) {
      bf16x8 af[4], bfr[4];
#pragma unroll
      for (int i = 0; i < 4; ++i) af[i] = *(const bf16x8*)(sA + (wr * 64 + i * 16 + (lane & 15)) * GS + kk * 32 + (lane >> 4) * 8);
#pragma unroll
      for (int j = 0; j < 4; ++j) bfr[j] = *(const bf16x8*)(sB + (wc * 64 + j * 16 + (lane & 15)) * GS + kk * 32 + (lane >> 4) * 8);
#pragma unroll
      for (int i = 0; i < 4; ++i)
#pragma unroll
        for (int j = 0; j < 4; ++j) acc[i][j] = __builtin_amdgcn_mfma_f32_16x16x32_bf16(bfr[j], af[i], acc[i][j], 0, 0, 0);
    }
    __syncthreads();
  }
#pragma unroll
  for (int i = 0; i < 4; ++i)
#pragma unroll
    for (int j = 0; j < 4; ++j) epi(m0 + wr * 64 + i * 16 + (lane & 15), n0 + wc * 64 + j * 16 + (lane >> 4) * 4, acc[i][j]);
}

struct EpiStoreBf16 {
  bf16_t* C; int ldc;
  __device__ __forceinline__ void operator()(int m, int n, const f32x4& v) const {
    uint2 w; w.x = pack2(v[0], v[1]); w.y = pack2(v[2], v[3]);
    *(uint2*)(C + (size_t)m * ldc + n) = w;
  }
};
struct EpiZ {
  bf16_t *zA, *zP, *zG;
  __device__ __forceinline__ void operator()(int m, int n, const f32x4& v) const {
    uint2 w; w.x = pack2(v[0], v[1]); w.y = pack2(v[2], v[3]);
    if (n < SHIFTC) *(uint2*)(zA + (size_t)m * SHIFTC + n) = w;
    else if (m < NTOK) {
      if (n < SHIFTC + 512) *(uint2*)(zP + (size_t)m * 512 + (n - SHIFTC)) = w;
      else *(uint2*)(zG + (size_t)m * 2048 + (n - SHIFTC - 512)) = w;
    }
  }
};
struct EpiLds {
  float* S;
  __device__ __forceinline__ void operator()(int m, int n, const f32x4& v) const {
    float* r = S + (m & 127) * 129 + n;
    r[0] = v[0]; r[1] = v[1]; r[2] = v[2]; r[3] = v[3];
  }
};

__device__ __forceinline__ void ph_transpose(const float* __restrict__ in, bf16_t* __restrict__ out, int K, int N, int vb, int nvb, unsigned char* smem) {
  float* t = (float*)smem;
  const int tk = K / 32, tn = N / 32, tx = threadIdx.x & 31, ty = threadIdx.x >> 5;
  for (int it = vb; it < tk * tn; it += nvb) {
    const int k0 = (it / tn) * 32, n0 = (it % tn) * 32;
    __syncthreads();
#pragma unroll
    for (int r = 0; r < 4; ++r) t[(ty + 8 * r) * 33 + tx] = in[(size_t)(k0 + ty + 8 * r) * N + n0 + tx];
    __syncthreads();
#pragma unroll
    for (int r = 0; r < 4; ++r) out[(size_t)(n0 + ty + 8 * r) * K + k0 + tx] = f2bf(t[tx * 33 + ty + 8 * r]);
  }
}
__device__ __forceinline__ void ph_convert(const float* __restrict__ in, bf16_t* __restrict__ out, size_t n, int vb, int nvb) {
  for (size_t i = ((size_t)vb * 256 + threadIdx.x) * 4; i < n; i += (size_t)nvb * 1024) {
    const float4 v = *(const float4*)(in + i);
    uint2 w; w.x = pack2(v.x, v.y); w.y = pack2(v.z, v.w);
    *(uint2*)(out + i) = w;
  }
}
__device__ __forceinline__ void ph_weff(const P& p, int vb, int nvb) {
  for (int it = vb * 256 + threadIdx.x; it < 512 * 1024; it += nvb * 256) {
    const int n = it & 1023, k = it >> 10, j = k >> 7, kl = k & 127;
    const float* wp = p.w_pool + ((size_t)j * 128 + kl) * 128;
    float s = 0.f;
    for (int c = 0; c < 128; ++c) s += wp[c] * p.pool_scale[j * 128 + c] * p.w_b_out[(size_t)(j * 128 + c) * 1024 + n];
    p.Wt_eff[(size_t)n * 512 + k] = f2bf(s);
  }
}
__device__ __forceinline__ void ph_mod(const P& p, int vb, int nvb, unsigned char* smem) {
  float* red = (float*)smem;
  const int lane = threadIdx.x & 63, wid = threadIdx.x >> 6;
  for (int it = vb; it < 96; it += nvb) {
    const int n = it * 64 + lane;
    float a0 = 0.f, a1 = 0.f, a2 = 0.f;
#pragma unroll 8
    for (int k = wid * 256; k < wid * 256 + 256; ++k) {
      const float w = p.w_mod[(size_t)k * 6144 + n];
      const float c0 = p.c[k], c1 = p.c[1024 + k], c2 = p.c_ctx[k];
      a0 += c0 * sigmoidf_(c0) * w; a1 += c1 * sigmoidf_(c1) * w; a2 += c2 * sigmoidf_(c2) * w;
    }
    __syncthreads();
    red[(wid * 3 + 0) * 64 + lane] = a0; red[(wid * 3 + 1) * 64 + lane] = a1; red[(wid * 3 + 2) * 64 + lane] = a2;
    __syncthreads();
    if (wid < 3) {
      const float sum = red[(0 * 3 + wid) * 64 + lane] + red[(1 * 3 + wid) * 64 + lane] + red[(2 * 3 + wid) * 64 + lane] + red[(3 * 3 + wid) * 64 + lane];
      p.mod[wid * 6144 + n] = sum + p.b_mod[n];
    }
  }
}
__device__ __forceinline__ float wave_sum(float v) {
#pragma unroll
  for (int o = 32; o > 0; o >>= 1) v += __shfl_xor(v, o);
  return v;
}
__device__ __forceinline__ void ph_norm1(const P& p, int vb, int nvb) {
  const int lane = threadIdx.x & 63, wid = threadIdx.x >> 6;
  for (int m = vb * 4 + wid; m < MROWS; m += nvb * 4) {
    const float* src = m < NTOK ? p.x + (size_t)m * DM : p.ctx + (size_t)(m - NTOK) * DM;
    const float* md = p.mod + (m < NTOK ? (m / SEQ) : 2) * 6144;
    float4 v[4]; float ss = 0.f;
#pragma unroll
    for (int i = 0; i < 4; ++i) { v[i] = *(const float4*)(src + i * 256 + lane * 4); ss += v[i].x * v[i].x + v[i].y * v[i].y + v[i].z * v[i].z + v[i].w * v[i].w; }
    ss = wave_sum(ss);
    const float rstd = rsqrtf(ss * (1.0f / 1024.0f) + 1e-6f);
#pragma unroll
    for (int i = 0; i < 4; ++i) {
      const int col = i * 256 + lane * 4;
      const float4 g = *(const float4*)(p.g_pre_mix + col), sh = *(const float4*)(md + col), sc = *(const float4*)(md + 1024 + col);
      uint2 w;
      w.x = pack2(v[i].x * rstd * g.x * (1.f + sc.x) + sh.x, v[i].y * rstd * g.y * (1.f + sc.y) + sh.y);
      w.y = pack2(v[i].z * rstd * g.z * (1.f + sc.z) + sh.z, v[i].w * rstd * g.w * (1.f + sc.w) + sh.w);
      *(uint2*)(p.hx + (size_t)m * DM + col) = w;
    }
  }
}
__device__ __forceinline__ void ph_gemm1(const P& p, int vb, int nvb, unsigned char* smem) {
  const int nlat = 256 * 47, nall = nlat + 4 * 27;
  EpiZ epi{p.zA, p.zP, p.zG};
  for (int it = vb; it < nall; it += nvb) {
    int tm, tn;
    if (it < nlat) { tn = it / 256; tm = it % 256; } else { const int r = it - nlat; tn = r / 4; tm = 256 + r % 4; }
    gemm_tile(p.hx, DM, p.Wt_in, DM, DM, tm * 128, tn * 128, epi, smem);
  }
}
__device__ __forceinline__ void ph_gemm_simple(const bf16_t* A, int lda, const bf16_t* Bt, int ldb, int K, int M, int N, bf16_t* C, int ldc, int vb, int nvb, unsigned char* smem) {
  const int tm = M / 128, tn = N / 128;
  EpiStoreBf16 epi{C, ldc};
  for (int it = vb; it < tm * tn; it += nvb) gemm_tile(A, lda, Bt, ldb, K, (it % tm) * 128, (it / tm) * 128, epi, smem);
}

__device__ __forceinline__ void load_shift8(const bf16_t* __restrict__ zA, const float* __restrict__ mu, int rowbase, int t, int T, int col0, float* o) {
  const u32x4 zc = *(const u32x4*)(zA + (size_t)(rowbase + t) * SHIFTC + col0);
  u32x4 zp = (u32x4){0u, 0u, 0u, 0u}, zn = (u32x4){0u, 0u, 0u, 0u};
  if (t > 0) zp = *(const u32x4*)(zA + (size_t)(rowbase + t - 1) * SHIFTC + col0);
  if (t < T - 1) zn = *(const u32x4*)(zA + (size_t)(rowbase + t + 1) * SHIFTC + col0);
  const unsigned c[4] = {zc.x, zc.y, zc.z, zc.w}, pv[4] = {zp.x, zp.y, zp.z, zp.w}, nv[4] = {zn.x, zn.y, zn.z, zn.w};
  const f32x4 m0 = *(const f32x4*)(mu + col0), m1 = *(const f32x4*)(mu + col0 + 4);
  const float mm[8] = {m0[0], m0[1], m0[2], m0[3], m1[0], m1[1], m1[2], m1[3]};
#pragma unroll
  for (int i = 0; i < 4; ++i) {
    const float z0 = bflo(c[i]), z1 = bfhi(c[i]);
    o[2 * i] = z0 + mm[2 * i] * (0.5f * (bflo(pv[i]) + bflo(nv[i])) - z0);
    o[2 * i + 1] = z1 + mm[2 * i + 1] * (0.5f * (bfhi(pv[i]) + bfhi(nv[i])) - z1);
  }
}
__device__ __forceinline__ void load_shift4(const bf16_t* __restrict__ zA, const float* __restrict__ mu, int rowbase, int t, int T, int col0, float* o) {
  const u32x2 zc = *(const u32x2*)(zA + (size_t)(rowbase + t) * SHIFTC + col0);
  u32x2 zp = (u32x2){0u, 0u}, zn = (u32x2){0u, 0u};
  if (t > 0) zp = *(const u32x2*)(zA + (size_t)(rowbase + t - 1) * SHIFTC + col0);
  if (t < T - 1) zn = *(const u32x2*)(zA + (size_t)(rowbase + t + 1) * SHIFTC + col0);
#pragma unroll
  for (int i = 0; i < 2; ++i) {
    const float z0 = bflo(zc[i]), z1 = bfhi(zc[i]);
    o[2 * i] = z0 + mu[col0 + 2 * i] * (0.5f * (bflo(zp[i]) + bflo(zn[i])) - z0);
    o[2 * i + 1] = z1 + mu[col0 + 2 * i + 1] * (0.5f * (bfhi(zp[i]) + bfhi(zn[i])) - z1);
  }
}
__device__ __forceinline__ float red16(float v) {
  v += __shfl_xor(v, 1); v += __shfl_xor(v, 2); v += __shfl_xor(v, 4); v += __shfl_xor(v, 8);
  return v;
}
__device__ __forceinline__ float red8(float v) {
  v += __shfl_xor(v, 1); v += __shfl_xor(v, 2); v += __shfl_xor(v, 4);
  return v;
}

#define O_R1 0
#define O_R2 10240
#define O_TA (O_R2 + 17408)
#define O_TR (O_TA + 4608)
#define O_TB (O_TR + 4608)
#define O_TK (O_TB + 4608)
#define O_TBT (O_TK + 4608)
#define O_TKT (O_TBT + 5120)
#define O_TVT (O_TKT + 5120)
#define O_GAM (O_TVT + 5120)
#define O_TST (O_GAM + 256)
#define RWKV_SMEM (O_TST + 2 * 9216)
#define NSUP 65
__device__ __forceinline__ void lds_wave_fence() { asm volatile("s_waitcnt lgkmcnt(0)" ::: "memory"); }
__device__ __forceinline__ u32x2 pack4(const f32x4& v) { u32x2 r; r.x = pack2(v[0], v[1]); r.y = pack2(v[2], v[3]); return r; }

struct RwkvConsts { bf16x8 w2f[2], a2f[2]; };

typedef short s16x4 __attribute__((ext_vector_type(4)));
__device__ __forceinline__ float fast_tanh(float x) { const float e = __expf(2.0f * x); return 1.0f - __fdividef(2.0f, e + 1.0f); }
template <int NS, bool WANTY>
__device__ __forceinline__ void rwkv_chunk(const P& p, unsigned char* smem, int d, int h, int rowbase, int T, int isc0, bool latent, f32x4 (&st)[NS][4], const RwkvConsts& cc) {
  int tid = threadIdx.x;
  asm volatile("" : "+v"(tid));
  const int lane = tid & 63, w = __builtin_amdgcn_readfirstlane(tid >> 6), l15 = lane & 15, q = lane >> 4;
  const int tt = tid >> 3, cg = tid & 7, ch0 = h * 64 + cg * 8;
  const int isc = isc0 + tt, t = d == 0 ? isc : T - 1 - isc;
  bf16_t* TWD = (bf16_t*)(smem + O_R1); bf16_t* TAD = TWD + 32 * 72;
  float* WT = (float*)(smem + O_R1);
  bf16_t* XT = (bf16_t*)(smem + O_R1); bf16_t* UT = XT + 64 * 40;
  float* LW = (float*)(smem + O_R2); float* LA = LW + 32 * 68;
  float* TL = (float*)(smem + O_R2);
  bf16_t* TT = (bf16_t*)(smem + O_R2 + 4608); bf16_t* TAK = TT + 32 * 40; bf16_t* TRB = TAK + 32 * 40; bf16_t* TRK = TRB + 32 * 40; bf16_t* TLB = TRK + 32 * 40;
  bf16_t* TA = (bf16_t*)(smem + O_TA); bf16_t* TR = (bf16_t*)(smem + O_TR); bf16_t* TB = (bf16_t*)(smem + O_TB); bf16_t* TK = (bf16_t*)(smem + O_TK);
  bf16_t* TBT = (bf16_t*)(smem + O_TBT); bf16_t* TKT = (bf16_t*)(smem + O_TKT); bf16_t* TVT = (bf16_t*)(smem + O_TVT);
  float* GAM = (float*)(smem + O_GAM);
  bf16_t* TST = (bf16_t*)(smem + O_TST);
  __syncthreads();
  float k8[8], r8[8];
  {
    float o[8];
    load_shift8(p.zA, p.mu_shift, rowbase, t, T, 3072 + d * 64 + cg * 8, o);
    u32x4 pk; pk.x = pack2(fast_tanh(o[0]), fast_tanh(o[1])); pk.y = pack2(fast_tanh(o[2]), fast_tanh(o[3])); pk.z = pack2(fast_tanh(o[4]), fast_tanh(o[5])); pk.w = pack2(fast_tanh(o[6]), fast_tanh(o[7]));
    *(u32x4*)(TWD + tt * 72 + cg * 8) = pk;
    load_shift8(p.zA, p.mu_shift, rowbase, t, T, 3200 + d * 64 + cg * 8, o);
    pk.x = pack2(o[0], o[1]); pk.y = pack2(o[2], o[3]); pk.z = pack2(o[4], o[5]); pk.w = pack2(o[6], o[7]);
    *(u32x4*)(TAD + tt * 72 + cg * 8) = pk;
  }
  load_shift8(p.zA, p.mu_shift, rowbase, t, T, 1024 + ch0, k8);
  if (WANTY) load_shift8(p.zA, p.mu_shift, rowbase, t, T, ch0, r8);
  __syncthreads();
  {
    f32x4 lw[2], la[2];
    bf16x8 w2f[2], a2f[2];
#pragma unroll
    for (int ks = 0; ks < 2; ++ks) {
      w2f[ks] = *(const bf16x8*)(p.w2T + ((size_t)d * 1024 + h * 64 + 16 * w + l15) * 64 + 32 * ks + 8 * q);
      a2f[ks] = *(const bf16x8*)(p.a2T + ((size_t)d * 1024 + h * 64 + 16 * w + l15) * 64 + 32 * ks + 8 * q);
    }
#pragma unroll
    for (int it = 0; it < 2; ++it) { lw[it] = (f32x4){0.f, 0.f, 0.f, 0.f}; la[it] = (f32x4){0.f, 0.f, 0.f, 0.f}; }
#pragma unroll
    for (int ks = 0; ks < 2; ++ks)
#pragma unroll
      for (int it = 0; it < 2; ++it) {
        const bf16x8 aw = *(const bf16x8*)(TWD + (16 * it + l15) * 72 + 32 * ks + 8 * q);
        const bf16x8 aa = *(const bf16x8*)(TAD + (16 * it + l15) * 72 + 32 * ks + 8 * q);
        lw[it] = __builtin_amdgcn_mfma_f32_16x16x32_bf16(aw, w2f[ks], lw[it], 0, 0, 0);
        la[it] = __builtin_amdgcn_mfma_f32_16x16x32_bf16(aa, a2f[ks], la[it], 0, 0, 0);
      }
#pragma unroll
    for (int it = 0; it < 2; ++it)
#pragma unroll
      for (int rg = 0; rg < 4; ++rg) { LW[(16 * it + 4 * q + rg) * 68 + 16 * w + l15] = lw[it][rg]; LA[(16 * it + 4 * q + rg) * 68 + 16 * w + l15] = la[it][rg]; }
  }
  __syncthreads();
  float e8[8], icl[8], kkn[8], kd[8], Lloc[8];
  u32x4 vzc, vzp = (u32x4){0u, 0u, 0u, 0u}, vzn = (u32x4){0u, 0u, 0u, 0u};
  {
    const bf16_t* vp = p.zA + (size_t)(rowbase + t) * SHIFTC + 2048 + ch0;
    vzc = *(const u32x4*)vp;
    if (t > 0) vzp = *(const u32x4*)(vp - SHIFTC);
    if (t < T - 1) vzn = *(const u32x4*)(vp + SHIFTC);
  }
  {
    float ss = 0.f, bd = 0.f;
    float cw0[8], ca0[8], ckk[8], cka[8], crk[8];
#pragma unroll
    for (int e4 = 0; e4 < 8; e4 += 4) {
      const f32x4 a = *(const f32x4*)(p.w0 + d * 1024 + ch0 + e4), b2 = *(const f32x4*)(p.a0 + d * 1024 + ch0 + e4), c2 = *(const f32x4*)(p.k_k + ch0 + e4);
      const f32x4 d2 = *(const f32x4*)(p.k_a + ch0 + e4), f2 = *(const f32x4*)(p.r_k + ch0 + e4);
#pragma unroll
      for (int e = 0; e < 4; ++e) { cw0[e4 + e] = a[e]; ca0[e4 + e] = b2[e]; ckk[e4 + e] = c2[e]; cka[e4 + e] = d2[e]; crk[e4 + e] = f2[e]; }
    }
#pragma unroll
    for (int e = 0; e < 8; ++e) {
      const float xw = -(cw0[e] + LW[tt * 68 + cg * 8 + e]);
      const float sp = fmaxf(xw, 0.f) + __logf(1.0f + __expf(-fabsf(xw)));
      e8[e] = __expf(-sp - 0.5f);
      icl[e] = sigmoidf_(ca0[e] + LA[tt * 68 + cg * 8 + e]);
      kkn[e] = k8[e] * ckk[e]; ss += kkn[e] * kkn[e];
      kd[e] = k8[e] * (1.f + (icl[e] - 1.f) * cka[e]);
      if (WANTY) bd += r8[e] * kd[e] * crk[e];
    }
    ss = red8(ss); if (WANTY) bd = red8(bd);
    const float rn = rsqrtf(fmaxf(ss, 1e-24f));
#pragma unroll
    for (int e = 0; e < 8; ++e) kkn[e] *= rn;
    if (WANTY && cg == 0) p.bdot[((size_t)d * NTOK + rowbase + t) * 16 + h] = bd;
#pragma unroll
    for (int e = 0; e < 8; ++e) {
      float v = e8[e];
      float u = __shfl_up(v, 8); if (lane >= 8) v += u;
      u = __shfl_up(v, 16); if (lane >= 16) v += u;
      u = __shfl_up(v, 32); if (lane >= 32) v += u;
      Lloc[e] = v;
    }
    if (lane >= 56) {
#pragma unroll
      for (int e = 0; e < 8; ++e) WT[w * 64 + cg * 8 + e] = Lloc[e];
    }
  }
  __syncthreads();
  {
    float ta[8], tr[8], tb[8], tk[8], v8[8];
    {
      const f32x4 m0 = *(const f32x4*)(p.mu_shift + 2048 + ch0), m1 = *(const f32x4*)(p.mu_shift + 2048 + ch0 + 4);
      const float mm[8] = {m0[0], m0[1], m0[2], m0[3], m1[0], m1[1], m1[2], m1[3]};
#pragma unroll
      for (int i = 0; i < 4; ++i) {
        const float z0 = bflo(vzc[i]), z1 = bfhi(vzc[i]);
        v8[2 * i] = z0 + mm[2 * i] * (0.5f * (bflo(vzp[i]) + bflo(vzn[i])) - z0);
        v8[2 * i + 1] = z1 + mm[2 * i + 1] * (0.5f * (bfhi(vzp[i]) + bfhi(vzn[i])) - z1);
      }
    }
    float pre[8];
#pragma unroll
    for (int e = 0; e < 8; ++e) pre[e] = 0.f;
    for (int w2 = 0; w2 < w; ++w2) {
      const f32x4 a = *(const f32x4*)(WT + w2 * 64 + cg * 8), b2 = *(const f32x4*)(WT + w2 * 64 + cg * 8 + 4);
#pragma unroll
      for (int e = 0; e < 4; ++e) { pre[e] += a[e]; pre[4 + e] += b2[e]; }
    }
#pragma unroll
    for (int e = 0; e < 8; ++e) {
      const float Li = Lloc[e] + pre[e];
      const float gi = __expf(-Li), gim1 = __expf(-(Li - e8[e])), ginv = __expf(Li);
      ta[e] = -kkn[e] * gim1; if (WANTY) tr[e] = r8[e] * gi; tb[e] = kkn[e] * icl[e] * ginv; tk[e] = kd[e] * ginv;
      if (tt == 31) GAM[cg * 8 + e] = gi;
    }
    u32x4 pk;
    pk.x = pack2(ta[0], ta[1]); pk.y = pack2(ta[2], ta[3]); pk.z = pack2(ta[4], ta[5]); pk.w = pack2(ta[6], ta[7]); *(u32x4*)(TA + tt * 72 + cg * 8) = pk;
    if (WANTY) { pk.x = pack2(tr[0], tr[1]); pk.y = pack2(tr[2], tr[3]); pk.z = pack2(tr[4], tr[5]); pk.w = pack2(tr[6], tr[7]); *(u32x4*)(TR + tt * 72 + cg * 8) = pk; }
    pk.x = pack2(tb[0], tb[1]); pk.y = pack2(tb[2], tb[3]); pk.z = pack2(tb[4], tb[5]); pk.w = pack2(tb[6], tb[7]); *(u32x4*)(TB + tt * 72 + cg * 8) = pk;
    pk.x = pack2(tk[0], tk[1]); pk.y = pack2(tk[2], tk[3]); pk.z = pack2(tk[4], tk[5]); pk.w = pack2(tk[6], tk[7]); *(u32x4*)(TK + tt * 72 + cg * 8) = pk;
#pragma unroll
    for (int e = 0; e < 8; ++e) { TBT[(cg * 8 + e) * 40 + tt] = f2bf(tb[e]); TKT[(cg * 8 + e) * 40 + tt] = f2bf(tk[e]); TVT[(cg * 8 + e) * 40 + tt] = f2bf(v8[e]); }
  }
  __syncthreads();
  if (WANTY || w < 2) {
    const bf16_t* X = (w < 2) ? TA : TR; const bf16_t* Y = (w & 1) ? TK : TB;
    f32x4 g[2][2];
#pragma unroll
    for (int it = 0; it < 2; ++it)
#pragma unroll
      for (int s2 = 0; s2 < 2; ++s2) g[it][s2] = (f32x4){0.f, 0.f, 0.f, 0.f};
#pragma unroll
    for (int ks = 0; ks < 2; ++ks) {
      bf16x8 xa[2], yb[2];
#pragma unroll
      for (int it = 0; it < 2; ++it) { xa[it] = *(const bf16x8*)(X + (16 * it + l15) * 72 + 32 * ks + 8 * q); yb[it] = *(const bf16x8*)(Y + (16 * it + l15) * 72 + 32 * ks + 8 * q); }
#pragma unroll
      for (int it = 0; it < 2; ++it)
#pragma unroll
        for (int s2 = 0; s2 < 2; ++s2) g[it][s2] = __builtin_amdgcn_mfma_f32_16x16x32_bf16(xa[it], yb[s2], g[it][s2], 0, 0, 0);
    }
    bf16_t* dst = w == 1 ? TAK : (w == 2 ? TRB : TRK);
#pragma unroll
    for (int it = 0; it < 2; ++it)
#pragma unroll
      for (int s2 = 0; s2 < 2; ++s2)
#pragma unroll
        for (int rg = 0; rg < 4; ++rg) {
          const int i = 16 * it + 4 * q + rg, s = 16 * s2 + l15;
          const float val = g[it][s2][rg];
          if (w == 0) {
            TL[i * 36 + s] = (s < i) ? val : 0.f;
            if (it == 1 && s2 == 0) TLB[(i - 16) * 40 + s] = f2bf(val);
          } else dst[i * 40 + s] = f2bf(((w == 1) ? (s < i) : (s <= i)) ? val : 0.f);
        }
  }
  if (w == 0) {
    lds_wave_fence();
    const int c = lane & 15, hb = lane & 16;
    float Tr[16];
#pragma unroll
    for (int i = 0; i < 16; ++i) {
      float acc = (i == c) ? 1.f : 0.f;
#pragma unroll
      for (int j4 = 0; j4 < (i + 3) / 4; ++j4) {
        const f32x4 l4 = *(const f32x4*)(TL + (hb + i) * 36 + hb + 4 * j4);
#pragma unroll
        for (int jj = 0; jj < 4; ++jj) if (4 * j4 + jj < i) acc += l4[jj] * Tr[4 * j4 + jj];
      }
      Tr[i] = acc;
    }
    if (lane < 32) {
#pragma unroll
      for (int i = 0; i < 16; ++i) TT[(hb + i) * 40 + hb + c] = f2bf(Tr[i]);
    }
  }
  __syncthreads();
  const bf16x8 vfr = *(const bf16x8*)(TVT + (16 * w + l15) * 40 + 8 * q);
  const s16x4 t1f = *(const s16x4*)(TT + l15 * 40 + 4 * q), t2f = *(const s16x4*)(TT + (16 + l15) * 40 + 16 + 4 * q), l21f = *(const s16x4*)(TLB + l15 * 40 + 4 * q);
  bf16_t* XTw = XT + (16 * w + l15) * 40; bf16_t* UTw = UT + (16 * w + l15) * 40;
#pragma unroll
  for (int si = 0; si < NS; ++si) {
    const bool useV = (NS == 1) || (si == 1);
    const bf16_t* STs = TST + (si * 64 + 16 * w + l15) * 72;
    bf16x8 sf[2];
    sf[0] = *(const bf16x8*)(STs + 8 * q); sf[1] = *(const bf16x8*)(STs + 32 + 8 * q);
    f32x4 xa[2];
#pragma unroll
    for (int it = 0; it < 2; ++it) {
      xa[it] = (f32x4){0.f, 0.f, 0.f, 0.f};
#pragma unroll
      for (int ks = 0; ks < 2; ++ks) xa[it] = __builtin_amdgcn_mfma_f32_16x16x32_bf16(*(const bf16x8*)(TA + (16 * it + l15) * 72 + 32 * ks + 8 * q), sf[ks], xa[it], 0, 0, 0);
      if (useV) xa[it] = __builtin_amdgcn_mfma_f32_16x16x32_bf16(*(const bf16x8*)(TAK + (16 * it + l15) * 40 + 8 * q), vfr, xa[it], 0, 0, 0);
    }
    *(u32x2*)(XTw + 4 * q) = pack4(xa[0]);
    lds_wave_fence();
    f32x4 ua = __builtin_amdgcn_mfma_f32_16x16x16bf16_1k(t1f, *(const s16x4*)(XTw + 4 * q), (f32x4){0.f, 0.f, 0.f, 0.f}, 0, 0, 0);
    *(u32x2*)(UTw + 4 * q) = pack4(ua);
    lds_wave_fence();
    xa[1] = __builtin_amdgcn_mfma_f32_16x16x16bf16_1k(l21f, *(const s16x4*)(UTw + 4 * q), xa[1], 0, 0, 0);
    *(u32x2*)(XTw + 16 + 4 * q) = pack4(xa[1]);
    lds_wave_fence();
    ua = __builtin_amdgcn_mfma_f32_16x16x16bf16_1k(t2f, *(const s16x4*)(XTw + 16 + 4 * q), (f32x4){0.f, 0.f, 0.f, 0.f}, 0, 0, 0);
    *(u32x2*)(UTw + 16 + 4 * q) = pack4(ua);
    lds_wave_fence();
    const bf16x8 uf = *(const bf16x8*)(UTw + 8 * q);
    if (WANTY) {
#pragma unroll
      for (int it = 0; it < 2; ++it) {
        f32x4 ya = (f32x4){0.f, 0.f, 0.f, 0.f};
#pragma unroll
        for (int ks = 0; ks < 2; ++ks) ya = __builtin_amdgcn_mfma_f32_16x16x32_bf16(*(const bf16x8*)(TR + (16 * it + l15) * 72 + 32 * ks + 8 * q), sf[ks], ya, 0, 0, 0);
        ya = __builtin_amdgcn_mfma_f32_16x16x32_bf16(*(const bf16x8*)(TRB + (16 * it + l15) * 40 + 8 * q), uf, ya, 0, 0, 0);
        ya = __builtin_amdgcn_mfma_f32_16x16x32_bf16(*(const bf16x8*)(TRK + (16 * it + l15) * 40 + 8 * q), vfr, ya, 0, 0, 0);
        bf16_t* Yd = d == 0 ? p.Y0 : p.Y1;
#pragma unroll
        for (int rg = 0; rg < 4; ++rg) {
          const int iq = isc0 + 16 * it + 4 * q + rg, tq = d == 0 ? iq : T - 1 - iq;
          Yd[(size_t)(rowbase + tq) * DM + h * 64 + 16 * w + l15] = f2bf(ya[rg]);
        }
      }
    }
#pragma unroll
    for (int kt = 0; kt < 4; ++kt) {
      f32x4 hv = st[si][kt];
      hv = __builtin_amdgcn_mfma_f32_16x16x32_bf16(*(const bf16x8*)(TBT + (16 * kt + l15) * 40 + 8 * q), uf, hv, 0, 0, 0);
      if (useV) hv = __builtin_amdgcn_mfma_f32_16x16x32_bf16(*(const bf16x8*)(TKT + (16 * kt + l15) * 40 + 8 * q), vfr, hv, 0, 0, 0);
      hv *= *(const f32x4*)(GAM + 16 * kt + 4 * q);
      st[si][kt] = hv;
      *(u32x2*)(TST + (si * 64 + 16 * w + l15) * 72 + 16 * kt + 4 * q) = pack4(hv);
    }
  }
}

__device__ __forceinline__ void rwkv_consts(const P& p, int d, int h, RwkvConsts& cc) {
  const int tid = threadIdx.x, lane = tid & 63, w = tid >> 6, l15 = lane & 15, q = lane >> 4;
#pragma unroll
  for (int ks = 0; ks < 2; ++ks) {
    cc.w2f[ks] = *(const bf16x8*)(p.w2T + ((size_t)d * 1024 + h * 64 + 16 * w + l15) * 64 + 32 * ks + 8 * q);
    cc.a2f[ks] = *(const bf16x8*)(p.a2T + ((size_t)d * 1024 + h * 64 + 16 * w + l15) * 64 + 32 * ks + 8 * q);
  }
}
__device__ __forceinline__ void ph_rwkv_A(const P& p, int vb, int nvb, unsigned char* smem) {
  const int tid = threadIdx.x, lane = tid & 63, w = tid >> 6, l15 = lane & 15, q = lane >> 4;
  bf16_t* TST = (bf16_t*)(smem + O_TST);
  for (int item = vb; item < 64 * 64; item += nvb) {
    const int chain = item >> 6, j = item & 63, b = chain >> 5, d = (chain >> 4) & 1, h = chain & 15;
    const bool latent = j > 0;
    const int T = latent ? SEQ : CTXL, rowbase = latent ? b * SEQ : NTOK + b * CTXL, base = latent ? (j - 1) * 256 : 0;
    RwkvConsts cc; rwkv_consts(p, d, h, cc);
    f32x4 st[2][4];
    __syncthreads();
#pragma unroll
    for (int kt = 0; kt < 4; ++kt) {
#pragma unroll
      for (int rg = 0; rg < 4; ++rg) st[0][kt][rg] = (16 * kt + 4 * q + rg == 16 * w + l15) ? 1.f : 0.f;
      st[1][kt] = (f32x4){0.f, 0.f, 0.f, 0.f};
      *(u32x2*)(TST + (16 * w + l15) * 72 + 16 * kt + 4 * q) = pack4(st[0][kt]);
      *(u32x2*)(TST + (64 + 16 * w + l15) * 72 + 16 * kt + 4 * q) = pack4(st[1][kt]);
    }
    for (int c = 0; c < 8; ++c) rwkv_chunk<2, false>(p, smem, d, h, rowbase, T, base + 32 * c, latent, st, cc);
    const size_t slot = (size_t)chain * NSUP + j;
#pragma unroll
    for (int kt = 0; kt < 4; ++kt) {
#pragma unroll
      for (int rg = 0; rg < 4; ++rg) p.Mst[(slot * 64 + 16 * kt + 4 * q + rg) * 64 + 16 * w + l15] = f2bf(st[0][kt][rg]);
      *(f32x4*)(p.Nst + (slot * 64 + 16 * w + l15) * 64 + 16 * kt + 4 * q) = st[1][kt];
    }
  }
}
__device__ __forceinline__ void ph_rwkv_B(const P& p, int vb, int nvb, unsigned char* smem) {
  const int tid = threadIdx.x, lane = tid & 63, w = tid >> 6, l15 = lane & 15, q = lane >> 4;
  bf16_t* HT = (bf16_t*)smem;
  for (int chain = vb; chain < 64; chain += nvb) {
    f32x4 hs[4];
#pragma unroll
    for (int kt = 0; kt < 4; ++kt) hs[kt] = (f32x4){0.f, 0.f, 0.f, 0.f};
    __syncthreads();
    for (int j = 0; j < 64; ++j) {
      const size_t slot = (size_t)chain * NSUP + j;
      f32x4 nv[4];
#pragma unroll
      for (int kt = 0; kt < 4; ++kt) nv[kt] = *(const f32x4*)(p.Nst + (slot * 64 + 16 * w + l15) * 64 + 16 * kt + 4 * q);
      bf16x8 mf[4][2];
#pragma unroll
      for (int kt = 0; kt < 4; ++kt)
#pragma unroll
        for (int ks = 0; ks < 2; ++ks) mf[kt][ks] = *(const bf16x8*)(p.Mst + (slot * 64 + 16 * kt + l15) * 64 + 32 * ks + 8 * q);
#pragma unroll
      for (int kt = 0; kt < 4; ++kt) {
        *(f32x4*)(p.Nst + (slot * 64 + 16 * w + l15) * 64 + 16 * kt + 4 * q) = hs[kt];
        *(u32x2*)(HT + (16 * w + l15) * 72 + 16 * kt + 4 * q) = pack4(hs[kt]);
      }
      lds_wave_fence();
      bf16x8 hf[2];
      hf[0] = *(const bf16x8*)(HT + (16 * w + l15) * 72 + 8 * q); hf[1] = *(const bf16x8*)(HT + (16 * w + l15) * 72 + 32 + 8 * q);
      lds_wave_fence();
#pragma unroll
      for (int kt = 0; kt < 4; ++kt) {
        f32x4 a = nv[kt];
#pragma unroll
        for (int ks = 0; ks < 2; ++ks) a = __builtin_amdgcn_mfma_f32_16x16x32_bf16(mf[kt][ks], hf[ks], a, 0, 0, 0);
        hs[kt] = a;
      }
    }
    const size_t slot = (size_t)chain * NSUP + 64;
#pragma unroll
    for (int kt = 0; kt < 4; ++kt) *(f32x4*)(p.Nst + (slot * 64 + 16 * w + l15) * 64 + 16 * kt + 4 * q) = hs[kt];
  }
}
__device__ __forceinline__ void ph_rwkv_C(const P& p, int vb, int nvb, unsigned char* smem) {
  const int tid = threadIdx.x, lane = tid & 63, w = tid >> 6, l15 = lane & 15, q = lane >> 4;
  bf16_t* TST = (bf16_t*)(smem + O_TST);
  for (int item = vb; item < 64 * 64; item += nvb) {
    const int chain = item >> 6, j = (item & 63) + 1, b = chain >> 5, d = (chain >> 4) & 1, h = chain & 15;
    RwkvConsts cc; rwkv_consts(p, d, h, cc);
    f32x4 st[1][4];
    const size_t slot = (size_t)chain * NSUP + j;
    __syncthreads();
#pragma unroll
    for (int kt = 0; kt < 4; ++kt) {
      st[0][kt] = *(const f32x4*)(p.Nst + (slot * 64 + 16 * w + l15) * 64 + 16 * kt + 4 * q);
      *(u32x2*)(TST + (16 * w + l15) * 72 + 16 * kt + 4 * q) = pack4(st[0][kt]);
    }
    for (int c = 0; c < 8; ++c) rwkv_chunk<1, true>(p, smem, d, h, b * SEQ, SEQ, (j - 1) * 256 + 32 * c, true, st, cc);
  }
}

#define RO_SMEM (128 * 16 * 4)
__device__ __forceinline__ void ph_readout(const P& p, int vb, int nvb, unsigned char* smem) {
  float* sgT = (float*)smem;
  const int tid = threadIdx.x, c4 = tid * 4, h = tid >> 4;
  const float4 lnw = *(const float4*)(p.ln_x_w + c4), lnb = *(const float4*)(p.ln_x_b + c4);
  for (int item = vb; item < NTOK / 16; item += nvb) {
    const int tok0 = item * 16;
    __syncthreads();
    {
      const int tk = tid >> 4, l8 = (tid & 15) * 8, m = tok0 + tk, b = m / SEQ, t = m % SEQ;
      float o[8];
      load_shift8(p.zA, p.mu_shift, b * SEQ, t, SEQ, 3328 + l8, o);
#pragma unroll
      for (int e = 0; e < 8; ++e) sgT[(l8 + e) * 16 + tk] = sigmoidf_(o[e]);
    }
    __syncthreads();
    float4 g[16];
#pragma unroll
    for (int k = 0; k < 16; ++k) g[k] = make_float4(0.f, 0.f, 0.f, 0.f);
    for (int l = 0; l < 128; ++l) {
      const float4 w = *(const float4*)(p.g2 + (size_t)l * 1024 + c4);
      const float4 s0 = *(const float4*)(sgT + l * 16), s1 = *(const float4*)(sgT + l * 16 + 4), s2 = *(const float4*)(sgT + l * 16 + 8), s3 = *(const float4*)(sgT + l * 16 + 12);
      const float sv[16] = {s0.x, s0.y, s0.z, s0.w, s1.x, s1.y, s1.z, s1.w, s2.x, s2.y, s2.z, s2.w, s3.x, s3.y, s3.z, s3.w};
#pragma unroll
      for (int k = 0; k < 16; ++k) { g[k].x += sv[k] * w.x; g[k].y += sv[k] * w.y; g[k].z += sv[k] * w.z; g[k].w += sv[k] * w.w; }
    }
#pragma unroll
    for (int k = 0; k < 16; ++k) {
      const int m = tok0 + k, b = m / SEQ, t = m % SEQ;
      const uint2 y0 = *(const uint2*)(p.Y0 + (size_t)m * DM + c4), y1 = *(const uint2*)(p.Y1 + (size_t)m * DM + c4);
      float y[4] = {bflo(y0.x) + bflo(y1.x), bfhi(y0.x) + bfhi(y1.x), bflo(y0.y) + bflo(y1.y), bfhi(y0.y) + bfhi(y1.y)};
      const float mu = red16(y[0] + y[1] + y[2] + y[3]) * (1.f / 64.f);
      float q = 0.f;
#pragma unroll
      for (int e = 0; e < 4; ++e) { y[e] -= mu; q += y[e] * y[e]; }
      const float rs = rsqrtf(red16(q) * (1.f / 64.f) + 64e-5f);
      const bf16_t* zr = p.zA + (size_t)m * SHIFTC + 2048 + c4;
      const uint2 zc = *(const uint2*)zr;
      uint2 zp = make_uint2(0, 0), zn = make_uint2(0, 0);
      if (t > 0) zp = *(const uint2*)(zr - SHIFTC);
      if (t < SEQ - 1) zn = *(const uint2*)(zr + SHIFTC);
      const float4 mu4 = *(const float4*)(p.mu_shift + 2048 + c4);
      float v[4];
      v[0] = bflo(zc.x) + mu4.x * (0.5f * (bflo(zp.x) + bflo(zn.x)) - bflo(zc.x));
      v[1] = bfhi(zc.x) + mu4.y * (0.5f * (bfhi(zp.x) + bfhi(zn.x)) - bfhi(zc.x));
      v[2] = bflo(zc.y) + mu4.z * (0.5f * (bflo(zp.y) + bflo(zn.y)) - bflo(zc.y));
      v[3] = bfhi(zc.y) + mu4.w * (0.5f * (bfhi(zp.y) + bfhi(zn.y)) - bfhi(zc.y));
      const float bon = 0.5f * (p.bdot[(size_t)m * 16 + h] + p.bdot[((size_t)NTOK + m) * 16 + h]);
      const float o0 = (y[0] * rs * lnw.x + lnb.x + bon * v[0]) * g[k].x, o1 = (y[1] * rs * lnw.y + lnb.y + bon * v[1]) * g[k].y;
      const float o2 = (y[2] * rs * lnw.z + lnb.z + bon * v[2]) * g[k].z, o3 = (y[3] * rs * lnw.w + lnb.w + bon * v[3]) * g[k].w;
      uint2 w; w.x = pack2(o0, o1); w.y = pack2(o2, o3);
      *(uint2*)(p.out_a + (size_t)m * DM + c4) = w;
    }
  }
}

#define POOL_SMEM (64 * 128 * 4)
__device__ __forceinline__ void ph_pool(const P& p, int vb, int nvb, unsigned char* smem) {
  float* V = (float*)smem;
  const int tid = threadIdx.x;
  for (int item = vb; item < 2 * 256 * 4; item += nvb) {
    const int j = item & 3, r = (item >> 2) & 255, b = item >> 10;
    const int win = 2 << j, half = win >> 1;
    const int r0 = max(r - half, 0), r1 = min(r + half, 256);
    __syncthreads();
    const int cp = tid & 63, cq = tid >> 6;
    float a0[16], a1[16];
#pragma unroll
    for (int i = 0; i < 16; ++i) { a0[i] = 0.f; a1[i] = 0.f; }
    for (int rr = r0; rr < r1; ++rr) {
      const bf16_t* base = p.zP + ((size_t)b * SEQ + rr * 64) * 512 + j * 128 + cp * 2;
#pragma unroll
      for (int i = 0; i < 16; ++i) {
        const unsigned u = *(const unsigned*)(base + (size_t)(cq + 4 * i) * 512);
        a0[i] += bflo(u); a1[i] += bfhi(u);
      }
    }
#pragma unroll
    for (int i = 0; i < 16; ++i) { V[(cq + 4 * i) * 128 + cp * 2] = a0[i]; V[(cq + 4 * i) * 128 + cp * 2 + 1] = a1[i]; }
    __syncthreads();
#pragma unroll
    for (int i = 0; i < 16; ++i) {
      const int col = cq + 4 * i, c0 = max(col - half, 0), c1 = min(col + half, 64);
      float s0 = 0.f, s1 = 0.f;
      for (int cc = c0; cc < c1; ++cc) { s0 += V[cc * 128 + cp * 2]; s1 += V[cc * 128 + cp * 2 + 1]; }
      const float inv = 1.0f / (float)((r1 - r0) * (c1 - c0));
      const size_t tokoff = ((size_t)b * SEQ + r * 64 + col) * 512 + j * 128 + cp * 2;
      const unsigned u = *(const unsigned*)(p.zP + tokoff);
      *(unsigned*)(p.pooled + tokoff) = pack2(s0 * inv - bflo(u), s1 * inv - bfhi(u));
    }
  }
}
__device__ __forceinline__ void ph_merge(const P& p, int vb, int nvb) {
  for (size_t i = ((size_t)vb * 256 + threadIdx.x) * 4; i < (size_t)NTOK * DM; i += (size_t)nvb * 1024) {
    const size_t m = i >> 10; const int c = (int)(i & 1023);
    const uint2 g1 = *(const uint2*)(p.zG + m * 2048 + c), g2 = *(const uint2*)(p.zG + m * 2048 + 1024 + c);
    const uint2 a = *(const uint2*)(p.ya + i), bq = *(const uint2*)(p.yb + i);
    const float4 b1 = *(const float4*)(p.b_gate + c), b2 = *(const float4*)(p.b_gate + 1024 + c);
    const float m0 = sigmoidf_(bflo(g1.x) + b1.x) * bflo(a.x) + sigmoidf_(bflo(g2.x) + b2.x) * bflo(bq.x);
    const float m1 = sigmoidf_(bfhi(g1.x) + b1.y) * bfhi(a.x) + sigmoidf_(bfhi(g2.x) + b2.y) * bfhi(bq.x);
    const float m2 = sigmoidf_(bflo(g1.y) + b1.z) * bflo(a.y) + sigmoidf_(bflo(g2.y) + b2.z) * bflo(bq.y);
    const float m3 = sigmoidf_(bfhi(g1.y) + b1.w) * bfhi(a.y) + sigmoidf_(bfhi(g2.y) + b2.w) * bfhi(bq.y);
    uint2 w; w.x = pack2(m0, m1); w.y = pack2(m2, m3);
    *(uint2*)(p.mrg + i) = w;
  }
}
__device__ __forceinline__ void ph_res1(const P& p, int vb, int nvb) {
  const int lane = threadIdx.x & 63, wid = threadIdx.x >> 6;
  for (int m = vb * 4 + wid; m < NTOK; m += nvb * 4) {
    const float* md = p.mod + (m / SEQ) * 6144;
    float mx[16]; float ss = 0.f;
#pragma unroll
    for (int i = 0; i < 4; ++i) {
      const uint2 u = *(const uint2*)(p.mix + (size_t)m * DM + i * 256 + lane * 4);
      mx[4 * i] = bflo(u.x); mx[4 * i + 1] = bfhi(u.x); mx[4 * i + 2] = bflo(u.y); mx[4 * i + 3] = bfhi(u.y);
#pragma unroll
      for (int e = 0; e < 4; ++e) ss += mx[4 * i + e] * mx[4 * i + e];
    }
    ss = wave_sum(ss);
    const float rstd = rsqrtf(ss * (1.0f / 1024.0f) + 1e-6f);
    float x1[16]; float s2 = 0.f;
#pragma unroll
    for (int i = 0; i < 4; ++i) {
      const int col = i * 256 + lane * 4;
      const float4 xv = *(const float4*)(p.x + (size_t)m * DM + col), g = *(const float4*)(p.g_post_mix + col), gt = *(const float4*)(md + 2048 + col);
      x1[4 * i] = xv.x + gt.x * mx[4 * i] * rstd * g.x; x1[4 * i + 1] = xv.y + gt.y * mx[4 * i + 1] * rstd * g.y;
      x1[4 * i + 2] = xv.z + gt.z * mx[4 * i + 2] * rstd * g.z; x1[4 * i + 3] = xv.w + gt.w * mx[4 * i + 3] * rstd * g.w;
      *(float4*)(p.out + (size_t)m * DM + col) = make_float4(x1[4 * i], x1[4 * i + 1], x1[4 * i + 2], x1[4 * i + 3]);
#pragma unroll
      for (int e = 0; e < 4; ++e) s2 += x1[4 * i + e] * x1[4 * i + e];
    }
    s2 = wave_sum(s2);
    const float r2 = rsqrtf(s2 * (1.0f / 1024.0f) + 1e-6f);
#pragma unroll
    for (int i = 0; i < 4; ++i) {
      const int col = i * 256 + lane * 4;
      const float4 g = *(const float4*)(p.g_pre_ffn + col), sh = *(const float4*)(md + 3072 + col), sc = *(const float4*)(md + 4096 + col);
      uint2 w;
      w.x = pack2(x1[4 * i] * r2 * g.x * (1.f + sc.x) + sh.x, x1[4 * i + 1] * r2 * g.y * (1.f + sc.y) + sh.y);
      w.y = pack2(x1[4 * i + 2] * r2 * g.z * (1.f + sc.z) + sh.z, x1[4 * i + 3] * r2 * g.w * (1.f + sc.w) + sh.w);
      *(uint2*)(p.hx2 + (size_t)m * DM + col) = w;
    }
  }
}

#define PS1_SMEM (128 * 129 * 4)
__device__ __forceinline__ void ph_peer_s1(const P& p, int vb, int nvb, unsigned char* smem) {
  float* S = (float*)smem;
  EpiLds epi{S};
  const int tid = threadIdx.x, row = tid >> 1, hf = tid & 1;
  for (int item = vb; item < 256 * 16; item += nvb) {
    const int hp = item & 15, tm = item >> 4;
    __syncthreads();
    gemm_tile(p.q + hp * 128, 2048, p.keys + (size_t)hp * 128 * 128, 128, 128, tm * 128, 0, epi, smem);
    __syncthreads();
    float v[64];
#pragma unroll
    for (int i = 0; i < 64; ++i) v[i] = S[row * 129 + hf * 64 + i];
    const size_t ob = ((size_t)(tm * 128 + row) * 16 + hp) * 16;
    for (int it = 0; it < 16; ++it) {
      float mx = v[0];
#pragma unroll
      for (int i = 1; i < 64; ++i) mx = fmaxf(mx, v[i]);
      const float ox = __shfl_xor(mx, 1);
      const bool mine = hf == 0 ? (mx >= ox) : (mx > ox);
      const float best = fmaxf(mx, ox);
      int idx = 0;
      if (mine) {
        bool found = false;
#pragma unroll
        for (int i = 0; i < 64; ++i) {
          const bool hit = !found && (v[i] == best);
          if (hit) { idx = hf * 64 + i; v[i] = -3.0e38f; found = true; }
        }
      }
      const int oidx = __shfl_xor(idx, 1);
      if (hf == 0) { p.sv[ob + it] = best; p.si[ob + it] = mine ? idx : oidx; }
    }
  }
}
__device__ __forceinline__ void ph_peer_s2(const P& p, int vb, int nvb) {
  for (int it = vb * 256 + threadIdx.x; it < NTOK * 8; it += nvb * 256) {
    const size_t ob = (size_t)it * 32;
    float a[16], bq[16]; int ia[16], ib[16];
#pragma unroll
    for (int i = 0; i < 16; i += 4) {
      const float4 fa = *(const float4*)(p.sv + ob + i), fb = *(const float4*)(p.sv + ob + 16 + i);
      const int4 ja = *(const int4*)(p.si + ob + i), jb = *(const int4*)(p.si + ob + 16 + i);
      a[i] = fa.x; a[i + 1] = fa.y; a[i + 2] = fa.z; a[i + 3] = fa.w; bq[i] = fb.x; bq[i + 1] = fb.y; bq[i + 2] = fb.z; bq[i + 3] = fb.w;
      ia[i] = ja.x; ia[i + 1] = ja.y; ia[i + 2] = ja.z; ia[i + 3] = ja.w; ib[i] = jb.x; ib[i + 1] = jb.y; ib[i + 2] = jb.z; ib[i + 3] = jb.w;
    }
    float cs[50]; int ci[50];
    {
      int n = 0;
#pragma unroll
      for (int i = 0; i < 16; ++i)
#pragma unroll
        for (int j = 0; j < 16; ++j)
          if ((i + 1) * (j + 1) <= 16) { cs[n] = a[i] + bq[j]; ci[n] = ia[i] * 128 + ib[j]; ++n; }
    }
    float sel[16]; int seli[16];
#pragma unroll
    for (int k = 0; k < 16; ++k) {
      float mx = cs[0];
#pragma unroll
      for (int n = 1; n < 50; ++n) mx = fmaxf(mx, cs[n]);
      int id = 0; bool found = false;
#pragma unroll
      for (int n = 0; n < 50; ++n) {
        const bool hit = !found && (cs[n] == mx);
        if (hit) { id = ci[n]; cs[n] = -3.0e38f; found = true; }
      }
      sel[k] = mx; seli[k] = id;
    }
    float den = 0.f; const float smax = sel[0];
#pragma unroll
    for (int k = 0; k < 16; ++k) { sel[k] = __expf(sel[k] - smax); den += sel[k]; }
    const float inv = 1.0f / den;
    const size_t o2 = (size_t)it * 16;
#pragma unroll
    for (int k = 0; k < 16; ++k) { p.pidx[o2 + k] = seli[k]; p.pgate[o2 + k] = sel[k] * inv; }
  }
}
typedef float f32x2 __attribute__((ext_vector_type(2)));
__device__ __forceinline__ float wave_max(float v) {
#pragma unroll
  for (int o = 32; o > 0; o >>= 1) v = fmaxf(v, __shfl_xor(v, o));
  return v;
}
__device__ __forceinline__ void ph_cvt_fp8(const float* __restrict__ in, unsigned char* __restrict__ out, float* __restrict__ inv_scale, int vb, int nvb) {
  const int lane = threadIdx.x & 63, wid = threadIdx.x >> 6;
  for (int row = vb * 4 + wid; row < 16384; row += nvb * 4) {
    f32x4 v[4]; float am = 0.f;
#pragma unroll
    for (int i = 0; i < 4; ++i) {
      v[i] = *(const f32x4*)(in + (size_t)row * DM + lane * 16 + 4 * i);
      am = fmaxf(am, fmaxf(fmaxf(fabsf(v[i][0]), fabsf(v[i][1])), fmaxf(fabsf(v[i][2]), fabsf(v[i][3]))));
    }
    am = wave_max(am);
    const float sc = am > 0.f ? 416.0f / am : 1.0f;
    u32x4 w;
#pragma unroll
    for (int i = 0; i < 4; ++i) {
      int pk = 0;
      pk = __builtin_amdgcn_cvt_pk_fp8_f32(v[i][0] * sc, v[i][1] * sc, pk, false);
      pk = __builtin_amdgcn_cvt_pk_fp8_f32(v[i][2] * sc, v[i][3] * sc, pk, true);
      w[i] = (unsigned)pk;
    }
    *(u32x4*)(out + (size_t)row * DM + lane * 16) = w;
    if (lane == 0) inv_scale[row] = am > 0.f ? am / 416.0f : 1.0f;
  }
}
__device__ __forceinline__ void fp8x16_to_f32(const u32x4& r, float* o) {
#pragma unroll
  for (int i = 0; i < 4; ++i) {
    const f32x2 a = __builtin_amdgcn_cvt_pk_f32_fp8((int)r[i], false), b = __builtin_amdgcn_cvt_pk_f32_fp8((int)r[i], true);
    o[4 * i] = a.x; o[4 * i + 1] = a.y; o[4 * i + 2] = b.x; o[4 * i + 3] = b.y;
  }
}
__device__ __forceinline__ void ph_peer_gather(const P& p, int vb, int nvb) {
  const int lane = threadIdx.x & 63, wid = threadIdx.x >> 6;
  const int jmap = 4 * (lane & 1) + (lane & 2) + ((lane >> 2) & 1);
  for (int m = vb * 4 + wid; m < NTOK; m += nvb * 4) {
    const float* md = p.mod + (m / SEQ) * 6144;
    float xv[16];
    {
      const u32x4 u0 = *(const u32x4*)(p.hx2 + (size_t)m * DM + lane * 16), u1 = *(const u32x4*)(p.hx2 + (size_t)m * DM + lane * 16 + 8);
#pragma unroll
      for (int e = 0; e < 4; ++e) { xv[2 * e] = bflo(u0[e]); xv[2 * e + 1] = bfhi(u0[e]); xv[8 + 2 * e] = bflo(u1[e]); xv[8 + 2 * e + 1] = bfhi(u1[e]); }
    }
    const int id0 = p.pidx[(size_t)m * 128 + lane], id1 = p.pidx[(size_t)m * 128 + 64 + lane];
    const float su0 = p.us[id0], su1 = p.us[id1];
    const float gs0 = p.pgate[(size_t)m * 128 + lane] * p.vs[id0], gs1 = p.pgate[(size_t)m * 128 + 64 + lane] * p.vs[id1];
    float acc[16];
#pragma unroll
    for (int k = 0; k < 16; ++k) acc[k] = 0.f;
    for (int e0 = 0; e0 < 128; e0 += 8) {
      u32x4 ur[8], vr[8];
#pragma unroll
      for (int j = 0; j < 8; ++j) {
        const int id = __shfl(e0 < 64 ? id0 : id1, (e0 + j) & 63);
        ur[j] = *(const u32x4*)(p.ub8 + (size_t)id * DM + lane * 16);
        vr[j] = *(const u32x4*)(p.vb8 + (size_t)id * DM + lane * 16);
      }
      float d[8];
#pragma unroll
      for (int j = 0; j < 8; ++j) {
        float f[16]; fp8x16_to_f32(ur[j], f);
        float s = 0.f;
#pragma unroll
        for (int k = 0; k < 16; ++k) s += f[k] * xv[k];
        d[j] = s;
      }
      float r4[4], r2[2], r1;
      {
        const bool lo = (lane & 1) == 0;
#pragma unroll
        for (int i = 0; i < 4; ++i) { const float keep = lo ? d[i] : d[i + 4], send = lo ? d[i + 4] : d[i]; r4[i] = keep + __shfl_xor(send, 1); }
        const bool lo2 = (lane & 2) == 0;
#pragma unroll
        for (int i = 0; i < 2; ++i) { const float keep = lo2 ? r4[i] : r4[i + 2], send = lo2 ? r4[i + 2] : r4[i]; r2[i] = keep + __shfl_xor(send, 2); }
        const bool lo4 = (lane & 4) == 0;
        { const float keep = lo4 ? r2[0] : r2[1], send = lo4 ? r2[1] : r2[0]; r1 = keep + __shfl_xor(send, 4); }
        r1 += __shfl_xor(r1, 8); r1 += __shfl_xor(r1, 16); r1 += __shfl_xor(r1, 32);
      }
      const int esrc = (e0 + jmap) & 63;
      const float su = __shfl(e0 < 64 ? su0 : su1, esrc), gs = __shfl(e0 < 64 ? gs0 : gs1, esrc);
      const float sdot = r1 * su;
      const float cf = 0.5f * sdot * (1.0f + erff(sdot * 0.70710678118654752f)) * gs;
#pragma unroll
      for (int j = 0; j < 8; ++j) {
        const float cj = __shfl(cf, (j >> 2) | (j & 2) | ((j & 1) << 2));
        float f[16]; fp8x16_to_f32(vr[j], f);
#pragma unroll
        for (int k = 0; k < 16; ++k) acc[k] += cj * f[k];
      }
    }
    float ss = 0.f;
#pragma unroll
    for (int k = 0; k < 16; ++k) ss += acc[k] * acc[k];
    ss = wave_sum(ss);
    const float rstd = rsqrtf(ss * (1.0f / 1024.0f) + 1e-6f);
#pragma unroll
    for (int k4 = 0; k4 < 4; ++k4) {
      const int col = lane * 16 + k4 * 4;
      f32x4 x1 = *(const f32x4*)(p.out + (size_t)m * DM + col);
      const f32x4 g = *(const f32x4*)(p.g_post_ffn + col), gt = *(const f32x4*)(md + 5120 + col);
      x1[0] += gt[0] * acc[k4 * 4] * rstd * g[0]; x1[1] += gt[1] * acc[k4 * 4 + 1] * rstd * g[1];
      x1[2] += gt[2] * acc[k4 * 4 + 2] * rstd * g[2]; x1[3] += gt[3] * acc[k4 * 4 + 3] * rstd * g[3];
      *(f32x4*)(p.out + (size_t)m * DM + col) = x1;
    }
  }
}

#define XB_TMO      128
#define XB_XCNT(j)  (256  + 64 * (j))
#define XB_XSUB(j)  (1280 + 64 * (j))
#define XB_XGEN(j)  (2304 + 64 * (j))
#define XB_TOP      3328
#define XB_TOPGEN   3392
#define XCD_BAR_WORDS 3456
#define XB_SPIN_CAP (1u << 20)
#define LAS __attribute__((address_space(3)))
__device__ __forceinline__ unsigned xb_ld(unsigned* p)              { return __hip_atomic_load(p, __ATOMIC_RELAXED, __HIP_MEMORY_SCOPE_AGENT); }
__device__ __forceinline__ unsigned xb_add(unsigned* p, unsigned v) { return __hip_atomic_fetch_add(p, v, __ATOMIC_RELAXED, __HIP_MEMORY_SCOPE_AGENT); }
__device__ __forceinline__ unsigned xb_xcc_id() { return (unsigned)__builtin_amdgcn_s_getreg((3 << 11) | 20) & 0xFu; }
#define XB_SPIN(cond, bar) do { unsigned _sp = 0; while (cond) { __builtin_amdgcn_s_sleep(1); \
    if ((++_sp & 255u) == 0u) { if (xb_ld(&(bar)[XB_TMO])) break; if (_sp > XB_SPIN_CAP) { atomicAdd(&(bar)[XB_TMO], 1u); break; } } } } while (0)
struct XcdBarrier { unsigned* bar; unsigned x; volatile LAS unsigned* st; };
__device__ __forceinline__ XcdBarrier xcd_barrier_post(unsigned* bar, volatile LAS unsigned* st) {
  XcdBarrier b; b.bar = bar; b.x = xb_xcc_id(); b.st = st;
  if (threadIdx.x == 0) (void)xb_add(&bar[XB_XCNT(b.x)], 1u);
  return b;
}
__device__ __forceinline__ void xcd_barrier_complete(unsigned* bar, unsigned x, unsigned& nloc, unsigned& nx) {
  const unsigned G = gridDim.x * gridDim.y * gridDim.z;
  unsigned sum, cnt, mine, sp = 0u;
  for (;;) {
    sum = 0u; cnt = 0u; mine = 0u;
#pragma unroll
    for (unsigned j = 0; j < 16; ++j) { const unsigned c = xb_ld(&bar[XB_XCNT(j)]); sum += c; cnt += (c > 0u) ? 1u : 0u; mine = (j == x) ? c : mine; }
    if (sum == G) break;
    __builtin_amdgcn_s_sleep(1);
    if ((++sp & 255u) == 0u) { if (xb_ld(&bar[XB_TMO])) break; if (sp > XB_SPIN_CAP) { atomicAdd(&bar[XB_TMO], 1u); break; } }
  }
  nloc = mine > 0u ? mine : 1u; nx = cnt > 0u ? cnt : 1u;
}
__device__ __forceinline__ void xcd_barrier(const XcdBarrier& b) {
  asm volatile("s_waitcnt vmcnt(0)" ::: "memory");
  __syncthreads();
  if (threadIdx.x == 0) {
    unsigned* bar = b.bar;
    __builtin_amdgcn_s_waitcnt(0);
    unsigned nloc = b.st[0], nx = b.st[1];
    if (nloc == 0u) { xcd_barrier_complete(bar, b.x, nloc, nx); b.st[0] = nloc; b.st[1] = nx; }
    const unsigned old = xb_add(&bar[XB_XSUB(b.x)], 1u);
    const unsigned gen = old / nloc;
    if (old + 1u == (gen + 1u) * nloc) {
      __builtin_amdgcn_fence(__ATOMIC_RELEASE, "agent");
      asm volatile("s_waitcnt vmcnt(0)" ::: "memory");
      const unsigned og = xb_add(&bar[XB_TOP], 1u);
      const unsigned tg = og / nx;
      if (og + 1u == (tg + 1u) * nx) xb_add(&bar[XB_TOPGEN], 1u);
      else XB_SPIN(xb_ld(&bar[XB_TOPGEN]) == tg, bar);
      __builtin_amdgcn_fence(__ATOMIC_ACQUIRE, "agent");
      xb_add(&bar[XB_XGEN(b.x)], 1u);
      asm volatile("s_waitcnt vmcnt(0)" ::: "memory");
    } else {
      XB_SPIN(xb_ld(&bar[XB_XGEN(b.x)]) == gen, bar);
      __builtin_amdgcn_fence(__ATOMIC_ACQUIRE, "agent");
      asm volatile("s_waitcnt vmcnt(0)" ::: "memory");
    }
  }
  __syncthreads();
}

#define SMEM_BYTES RWKV_SMEM
__global__ void __launch_bounds__(256, 2) mega(P p) {
  __shared__ __attribute__((aligned(16))) unsigned char smem[SMEM_BYTES + 16];
  cg::grid_group grid = cg::this_grid();
  const int vb = blockIdx.x, nvb = gridDim.x;
  if (threadIdx.x == 0) *(u32x4*)(smem + SMEM_BYTES) = (u32x4){0u, 0u, 0u, 0u};
  __syncthreads();
  const XcdBarrier xb = xcd_barrier_post(p.bar, (volatile LAS unsigned*)(smem + SMEM_BYTES));
  ph_mod(p, vb, nvb, smem);
  ph_transpose(p.w_in, p.Wt_in, DM, INC, vb, nvb, smem);
  ph_transpose(p.w_a_out, p.Wt_aout, DM, DM, vb, nvb, smem);
  ph_transpose(p.w_o, p.Wt_o, DM, DM, vb, nvb, smem);
  ph_transpose(p.peer_wq, p.Wt_q, DM, 2048, vb, nvb, smem);
  ph_transpose(p.w2, p.w2T, 64, 1024, vb, nvb, smem);
  ph_transpose(p.w2 + 65536, p.w2T + 65536, 64, 1024, vb, nvb, smem);
  ph_transpose(p.a2, p.a2T, 64, 1024, vb, nvb, smem);
  ph_transpose(p.a2 + 65536, p.a2T + 65536, 64, 1024, vb, nvb, smem);
  ph_weff(p, vb, nvb);
  ph_convert(p.peer_keys, p.keys, (size_t)16 * 128 * 128, vb, nvb);
  grid.sync();
  ph_norm1(p, vb, nvb);
  xcd_barrier(xb);
  ph_gemm1(p, vb, nvb, smem);
  xcd_barrier(xb);
  ph_rwkv_A(p, vb, nvb, smem);
  xcd_barrier(xb);
  ph_rwkv_B(p, vb, nvb, smem);
  xcd_barrier(xb);
  ph_rwkv_C(p, vb, nvb, smem);
  xcd_barrier(xb);
  ph_readout(p, vb, nvb, smem);
  ph_pool(p, vb, nvb, smem);
  ph_cvt_fp8(p.peer_u, p.ub8, p.us, vb, nvb);
  ph_cvt_fp8(p.peer_v, p.vb8, p.vs, vb, nvb);
  xcd_barrier(xb);
  ph_gemm_simple(p.out_a, DM, p.Wt_aout, DM, DM, NTOK, DM, p.ya, DM, vb, nvb, smem);
  ph_gemm_simple(p.pooled, 512, p.Wt_eff, 512, 512, NTOK, DM, p.yb, DM, vb, nvb, smem);
  xcd_barrier(xb);
  ph_merge(p, vb, nvb);
  xcd_barrier(xb);
  ph_gemm_simple(p.mrg, DM, p.Wt_o, DM, DM, NTOK, DM, p.mix, DM, vb, nvb, smem);
  xcd_barrier(xb);
  ph_res1(p, vb, nvb);
  xcd_barrier(xb);
  ph_gemm_simple(p.hx2, DM, p.Wt_q, DM, DM, NTOK, 2048, p.q, 2048, vb, nvb, smem);
  xcd_barrier(xb);
  ph_peer_s1(p, vb, nvb, smem);
  xcd_barrier(xb);
  ph_peer_s2(p, vb, nvb);
  xcd_barrier(xb);
  ph_peer_gather(p, vb, nvb);
}

extern "C" void kernel_launch(void* const* d_in, const int* in_sizes, int n_in, void* d_out, int out_size, void* d_ws, size_t ws_size, hipStream_t stream) {
  P p{};
  const float** f = (const float**)&p;
  for (int i = 0; i < 32; ++i) f[i] = (const float*)d_in[i];
  p.out = (float*)d_out;
  p.bar = (unsigned*)((unsigned char*)d_ws + 511 * 1048576);
  unsigned char* w = (unsigned char*)d_ws;
  const size_t MiB = 1048576;
  const size_t HM = 524288;
  p.hx = (bf16_t*)(w + 0 * MiB);
  p.zA = (bf16_t*)(w + 65 * MiB);
  p.zP = (bf16_t*)(w + 569 * HM);
  p.zG = (bf16_t*)d_out;
  unsigned char* rw = w + 633 * HM;
  p.Wt_in = (bf16_t*)rw; rw += 12 * MiB;
  p.Wt_aout = (bf16_t*)rw; rw += 2 * MiB;
  p.Wt_eff = (bf16_t*)rw; rw += 1 * MiB;
  p.Wt_o = (bf16_t*)rw; rw += 2 * MiB;
  p.Wt_q = (bf16_t*)rw; rw += 4 * MiB;
  p.keys = (bf16_t*)rw; rw += HM;
  p.mod = (float*)rw; rw += HM;
  p.w2T = (bf16_t*)rw; rw += HM;
  p.a2T = (bf16_t*)rw; rw += HM;
  p.Y0 = (bf16_t*)(w + 0 * MiB);
  p.Y1 = (bf16_t*)(w + 340 * MiB);
  p.bdot = (float*)(w + 404 * MiB);
  p.Mst = (bf16_t*)(w + 408 * MiB);
  p.Nst = (float*)(w + 441 * MiB);
  p.ub8 = w + 408 * MiB;
  p.vb8 = w + 424 * MiB;
  p.us = (float*)(w + 440 * MiB);
  p.vs = (float*)(w + 441 * MiB);
  p.pooled = (bf16_t*)(w + 478 * MiB);
  p.out_a = (bf16_t*)(w + 0 * MiB);
  p.ya = (bf16_t*)(w + 65 * MiB);
  p.yb = (bf16_t*)(w + 129 * MiB);
  p.mrg = (bf16_t*)(w + 193 * MiB);
  p.mix = (bf16_t*)(w + 65 * MiB);
  p.hx2 = (bf16_t*)(w + 0 * MiB);
  p.q = (bf16_t*)(w + 129 * MiB);
  p.sv = (float*)(w + 340 * MiB);
  p.si = (int*)(w + 372 * MiB);
  p.pidx = (int*)(w + 257 * MiB);
  p.pgate = (float*)(w + 273 * MiB);
  static int grid_blocks = 0;
  if (!grid_blocks) {
    int dev = 0, cus = 0, per_cu = 0;
    hipGetDevice(&dev);
    hipDeviceGetAttribute(&cus, hipDeviceAttributeMultiprocessorCount, dev);
    hipOccupancyMaxActiveBlocksPerMultiprocessor(&per_cu, mega, 256, 0);
    if (per_cu > 2) per_cu = 2;
    if (per_cu < 1) per_cu = 1;
    grid_blocks = cus * per_cu;
  }
  hipMemsetAsync(p.bar, 0, XCD_BAR_WORDS * 4, stream);
  void* args[] = {&p};
  hipError_t e = hipLaunchCooperativeKernel((void*)mega, dim3(grid_blocks), dim3(256), args, 0, stream);
  if (e != hipSuccess) fprintf(stderr, "cooperative launch failed: %s (grid %d)\n", hipGetErrorString(e), grid_blocks);
}
```

```cpp
#include <hip/hip_runtime.h>
#include <hip/hip_cooperative_groups.h>
#include <stdint.h>
#include <cstdio>
namespace cg = cooperative_groups;

typedef unsigned short bf16_t;
typedef short bf16x8 __attribute__((ext_vector_type(8)));
typedef float f32x4 __attribute__((ext_vector_type(4)));
typedef unsigned u32x4 __attribute__((ext_vector_type(4)));
typedef unsigned u32x2 __attribute__((ext_vector_type(2)));

#define NTOK 32768
#define SEQ 16384
#define CTXL 256
#define NCTX 512
#define MROWS 33280
#define DM 1024
#define SHIFTC 3456
#define INC 6016

typedef __bf16 hwbf2 __attribute__((ext_vector_type(2)));
typedef float hwf2 __attribute__((ext_vector_type(2)));
__device__ __forceinline__ unsigned pack2(float a, float b) { return __builtin_bit_cast(unsigned, __builtin_convertvector((hwf2){a, b}, hwbf2)); }
__device__ __forceinline__ bf16_t f2bf(float f) { return __builtin_bit_cast(unsigned short, (__bf16)f); }
__device__ __forceinline__ float bf2f(bf16_t h) { return __uint_as_float(((unsigned)h) << 16); }
__device__ __forceinline__ float bflo(unsigned u) { return __uint_as_float(u << 16); }
__device__ __forceinline__ float bfhi(unsigned u) { return __uint_as_float(u & 0xffff0000u); }
__device__ __forceinline__ float sigmoidf_(float x) { return 1.0f / (1.0f + __expf(-x)); }

__device__ __forceinline__ void load_shift8(const bf16_t* __restrict__ zA, const float* __restrict__ mu, int rowbase, int t, int T, int col0, float* o) {
  const u32x4 zc = *(const u32x4*)(zA + (size_t)(rowbase + t) * SHIFTC + col0);
  u32x4 zp = (u32x4){0u, 0u, 0u, 0u}, zn = (u32x4){0u, 0u, 0u, 0u};
  if (t > 0) zp = *(const u32x4*)(zA + (size_t)(rowbase + t - 1) * SHIFTC + col0);
  if (t < T - 1) zn = *(const u32x4*)(zA + (size_t)(rowbase + t + 1) * SHIFTC + col0);
  const unsigned c[4] = {zc.x, zc.y, zc.z, zc.w}, pv[4] = {zp.x, zp.y, zp.z, zp.w}, nv[4] = {zn.x, zn.y, zn.z, zn.w};
  const f32x4 m0 = *(const f32x4*)(mu + col0), m1 = *(const f32x4*)(mu + col0 + 4);
  const float mm[8] = {m0[0], m0[1], m0[2], m0[3], m1[0], m1[1], m1[2], m1[3]};
#pragma unroll
  for (int i = 0; i < 4; ++i) {
    const float z0 = bflo(c[i]), z1 = bfhi(c[i]);
    o[2 * i] = z0 + mm[2 * i] * (0.5f * (bflo(pv[i]) + bflo(nv[i])) - z0);
    o[2 * i + 1] = z1 + mm[2 * i + 1] * (0.5f * (bfhi(pv[i]) + bfhi(nv[i])) - z1);
  }
}
__device__ __forceinline__ void load_shift4(const bf16_t* __restrict__ zA, const float* __restrict__ mu, int rowbase, int t, int T, int col0, float* o) {
  const u32x2 zc = *(const u32x2*)(zA + (size_t)(rowbase + t) * SHIFTC + col0);
  u32x2 zp = (u32x2){0u, 0u}, zn = (u32x2){0u, 0u};
  if (t > 0) zp = *(const u32x2*)(zA + (size_t)(rowbase + t - 1) * SHIFTC + col0);
  if (t < T - 1) zn = *(const u32x2*)(zA + (size_t)(rowbase + t + 1) * SHIFTC + col0);
#pragma unroll
  for (int i = 0; i < 2; ++i) {
    const float z0 = bflo(zc[i]), z1 = bfhi(zc[i]);
    o[2 * i] = z0 + mu[col0 + 2 * i] * (0.5f * (bflo(zp[i]) + bflo(zn[i])) - z0);
    o[2 * i + 1] = z1 + mu[col0 + 2 * i + 1] * (0.5f * (bfhi(zp[i]) + bfhi(zn[i])) - z1);
  }
}
__device__ __forceinline__ float red16(float v) {
  v += __shfl_xor(v, 1); v += __shfl_xor(v, 2); v += __shfl_xor(v, 4); v += __shfl_xor(v, 8);
  return v;
}
__device__ __forceinline__ float red8(float v) {
  v += __shfl_xor(v, 1); v += __shfl_xor(v, 2); v += __shfl_xor(v, 4);
  return v;
}

struct P {
  const float *x, *c, *ctx, *c_ctx, *w_mod, *b_mod, *g_pre_mix, *g_post_mix, *g_pre_ffn, *g_post_ffn, *w_in, *b_gate, *mu_shift,
      *w0, *w2, *a0, *a2, *g2, *k_k, *k_a, *r_k, *ln_x_w, *ln_x_b, *w_a_out, *w_pool, *pool_scale, *w_b_out, *w_o, *peer_wq,
      *peer_keys, *peer_u, *peer_v;
  float* out;
  unsigned* bar;
  bf16_t* hx;
  bf16_t* zA;
  bf16_t* zP;
  bf16_t* zG;
  bf16_t* Wt_in;
  bf16_t* Wt_aout;
  bf16_t* Wt_eff;
  bf16_t* Wt_o;
  bf16_t* Wt_q;
  bf16_t* keys;
  float* mod;
  unsigned char* ub8;
  unsigned char* vb8;
  float* us;
  float* vs;
  bf16_t* sg;
  bf16_t* g2T;
  bf16_t* w2T;
  bf16_t* a2T;
  bf16_t* Mst;
  float* Nst;
  bf16_t* Y0;
  bf16_t* Y1;
  float* bdot;
  bf16_t* out_a;
  bf16_t* ya;
  bf16_t* pooled;
  bf16_t* yb;
  bf16_t* mrg;
  bf16_t* mix;
  bf16_t* hx2;
  bf16_t* q;
  float* sv;
  int* si;
  int* pidx;
  float* pgate;
};

#define GS 72
#define GEMM_SMEM (2 * 128 * GS * 2)
template <class Epi>
__device__ __forceinline__ void gemm_tile(const bf16_t* __restrict__ A, int lda, const bf16_t* __restrict__ Bt, int ldb, int K, int m0, int n0,
                                          const Epi& epi, unsigned char* smem) {
  const int tid = threadIdx.x, lane = tid & 63, wid = tid >> 6, wr = wid >> 1, wc = wid & 1;
  bf16_t* sA = (bf16_t*)smem;
  bf16_t* sB = sA + 128 * GS;
  f32x4 acc[4][4];
#pragma unroll
  for (int i = 0; i < 4; ++i)
#pragma unroll
    for (int j = 0; j < 4; ++j) acc[i][j] = (f32x4){0.f, 0.f, 0.f, 0.f};
  const int lrow = tid >> 3, lcol = (tid & 7) * 8;
  const bf16_t* pa = A + (size_t)(m0 + lrow) * lda + lcol;
  const bf16_t* pb = Bt + (size_t)(n0 + lrow) * ldb + lcol;
  u32x4 ra[4], rb[4];
#pragma unroll
  for (int p = 0; p < 4; ++p) {
    ra[p] = *(const u32x4*)(pa + (size_t)(32 * p) * lda);
    rb[p] = *(const u32x4*)(pb + (size_t)(32 * p) * ldb);
  }
  for (int k0 = 0; k0 < K; k0 += 64) {
#pragma unroll
    for (int p = 0; p < 4; ++p) {
      *(u32x4*)(sA + (lrow + 32 * p) * GS + lcol) = ra[p];
      *(u32x4*)(sB + (lrow + 32 * p) * GS + lcol) = rb[p];
    }
    __syncthreads();
    if (k0 + 64 < K) {
#pragma unroll
      for (int p = 0; p < 4; ++p) {
        ra[p] = *(const u32x4*)(pa + (size_t)(32 * p) * lda + k0 + 64);
        rb[p] = *(const u32x4*)(pb + (size_t)(32 * p) * ldb + k0 + 64);
      }
    }
#pragma unroll
    for (int kk = 0; kk < 2; ++kk) {
      bf16x8 af[4], bfr[4];
#pragma unroll
      for (int i = 0; i < 4; ++i) af[i] = *(const bf16x8*)(sA + (wr * 64 + i * 16 + (lane & 15)) * GS + kk * 32 + (lane >> 4) * 8);
#pragma unroll
      for (int j = 0; j < 4; ++j) bfr[j] = *(const bf16x8*)(sB + (wc * 64 + j * 16 + (lane & 15)) * GS + kk * 32 + (lane >> 4) * 8);
#pragma unroll
      for (int i = 0; i < 4; ++i)
#pragma unroll
        for (int j = 0; j < 4; ++j) acc[i][j] = __builtin_amdgcn_mfma_f32_16x16x32_bf16(bfr[j], af[i], acc[i][j], 0, 0, 0);
    }
    __syncthreads();
  }
#pragma unroll
  for (int i = 0; i < 4; ++i)
#pragma unroll
    for (int j = 0; j < 4; ++j) epi(m0 + wr * 64 + i * 16 + (lane & 15), n0 + wc * 64 + j * 16 + (lane >> 4) * 4, acc[i][j]);
}

#define G2S 40
#define GEMM2_SMEM (2 * (256 + 128) * G2S * 2)
template <class Epi>
__device__ __forceinline__ void gemm_tile2(const bf16_t* __restrict__ A, int lda, const bf16_t* __restrict__ Bt, int ldb, int K, int m0, int n0,
                                           const Epi& epi, unsigned char* smem) {
  const int tid = threadIdx.x, lane = tid & 63, wid = tid >> 6, wr = wid >> 1, wc = wid & 1, l15 = lane & 15, q = lane >> 4;
  bf16_t* sA = (bf16_t*)smem;
  bf16_t* sB = sA + 2 * 256 * G2S;
  f32x4 acc[8][4];
#pragma unroll
  for (int i = 0; i < 8; ++i)
#pragma unroll
    for (int j = 0; j < 4; ++j) acc[i][j] = (f32x4){0.f, 0.f, 0.f, 0.f};
  const int lrow = tid >> 2, lcol = (tid & 3) * 8;
  const bf16_t* pa = A + (size_t)(m0 + lrow) * lda + lcol;
  const bf16_t* pb = Bt + (size_t)(n0 + lrow) * ldb + lcol;
  u32x4 ra[4], rb[2];
#pragma unroll
  for (int pp = 0; pp < 4; ++pp) ra[pp] = *(const u32x4*)(pa + (size_t)(64 * pp) * lda);
#pragma unroll
  for (int pp = 0; pp < 2; ++pp) rb[pp] = *(const u32x4*)(pb + (size_t)(64 * pp) * ldb);
  __syncthreads();
#pragma unroll
  for (int pp = 0; pp < 4; ++pp) *(u32x4*)(sA + (lrow + 64 * pp) * G2S + lcol) = ra[pp];
#pragma unroll
  for (int pp = 0; pp < 2; ++pp) *(u32x4*)(sB + (lrow + 64 * pp) * G2S + lcol) = rb[pp];
  __syncthreads();
  const int nk = K >> 5;
  for (int kt = 0; kt < nk; ++kt) {
    const int cur = kt & 1;
    const bf16_t* cA = sA + cur * 256 * G2S;
    const bf16_t* cB = sB + cur * 128 * G2S;
    if (kt + 1 < nk) {
#pragma unroll
      for (int pp = 0; pp < 4; ++pp) ra[pp] = *(const u32x4*)(pa + (size_t)(64 * pp) * lda + (kt + 1) * 32);
#pragma unroll
      for (int pp = 0; pp < 2; ++pp) rb[pp] = *(const u32x4*)(pb + (size_t)(64 * pp) * ldb + (kt + 1) * 32);
    }
    bf16x8 bfr[4];
#pragma unroll
    for (int j = 0; j < 4; ++j) bfr[j] = *(const bf16x8*)(cB + (wc * 64 + j * 16 + l15) * G2S + q * 8);
#pragma unroll
    for (int i = 0; i < 8; ++i) {
      const bf16x8 af = *(const bf16x8*)(cA + (wr * 128 + i * 16 + l15) * G2S + q * 8);
#pragma unroll
      for (int j = 0; j < 4; ++j) acc[i][j] = __builtin_amdgcn_mfma_f32_16x16x32_bf16(bfr[j], af, acc[i][j], 0, 0, 0);
    }
    if (kt + 1 < nk) {
      bf16_t* nA = sA + (cur ^ 1) * 256 * G2S;
      bf16_t* nB = sB + (cur ^ 1) * 128 * G2S;
#pragma unroll
      for (int pp = 0; pp < 4; ++pp) *(u32x4*)(nA + (lrow + 64 * pp) * G2S + lcol) = ra[pp];
#pragma unroll
      for (int pp = 0; pp < 2; ++pp) *(u32x4*)(nB + (lrow + 64 * pp) * G2S + lcol) = rb[pp];
    }
    __syncthreads();
  }
#pragma unroll
  for (int i = 0; i < 8; ++i)
#pragma unroll
    for (int j = 0; j < 4; ++j) epi(m0 + wr * 128 + i * 16 + l15, n0 + wc * 64 + j * 16 + q * 4, acc[i][j]);
}

#define G3_STAGE 24576
#define G3_ES 136
#define GEMM3_SMEM (256 * G3_ES * 2)
typedef __attribute__((address_space(3))) unsigned lds_u32;
template <class Epi>
__device__ __forceinline__ void gemm_tile3(const bf16_t* __restrict__ A, int lda, const bf16_t* __restrict__ Bt, int ldb, int K, int m0, int n0,
                                           const Epi& epi, unsigned char* smem) {
  int tid = threadIdx.x;
  asm volatile("" : "+v"(tid));
  const int lane = tid & 63, wid = __builtin_amdgcn_readfirstlane(tid >> 6), wr = wid >> 1, wc = wid & 1, l15 = lane & 15, q = lane >> 4;
  f32x4 acc[8][4];
#pragma unroll
  for (int i = 0; i < 8; ++i)
#pragma unroll
    for (int j = 0; j < 4; ++j) acc[i][j] = (f32x4){0.f, 0.f, 0.f, 0.f};
  const int gr = lane >> 2, gc = ((lane & 3) ^ (((gr >> 2) & 1) << 1)) * 8;
  const bf16_t* pa = A + (size_t)(m0 + wid * 64 + gr) * lda + gc;
  const bf16_t* pb = Bt + (size_t)(n0 + wid * 32 + gr) * ldb + gc;
  unsigned char* dA = smem + wid * 4096 + lane * 16;
  unsigned char* dB = smem + 16384 + wid * 2048 + lane * 16;
  const int sw = (q ^ (((l15 >> 2) & 1) << 1)) * 16;
  const unsigned char* fA = smem + (wr * 128 + l15) * 64 + sw;
  const unsigned char* fB = smem + 16384 + (wc * 64 + l15) * 64 + sw;
#define G3_ISSUE(ST, KT) { _Pragma("unroll") for (int ii = 0; ii < 4; ++ii) __builtin_amdgcn_global_load_lds((const unsigned*)(pa + (size_t)(16 * ii) * lda + (KT) * 32), (lds_u32*)(dA + (ST) * G3_STAGE + ii * 1024), 16, 0, 0); \
                           _Pragma("unroll") for (int ii = 0; ii < 2; ++ii) __builtin_amdgcn_global_load_lds((const unsigned*)(pb + (size_t)(16 * ii) * ldb + (KT) * 32), (lds_u32*)(dB + (ST) * G3_STAGE + ii * 1024), 16, 0, 0); }
  const int nk = K >> 5;
  __syncthreads();
  G3_ISSUE(0, 0);
  for (int kt = 0; kt < nk; ++kt) {
    const int cur = kt & 1;
    asm volatile("s_waitcnt vmcnt(0)" ::: "memory");
    __syncthreads();
    if (kt + 1 < nk) G3_ISSUE(cur ^ 1, kt + 1);
    const unsigned char* cA = fA + cur * G3_STAGE;
    const unsigned char* cB = fB + cur * G3_STAGE;
    bf16x8 bfr[4];
#pragma unroll
    for (int j = 0; j < 4; ++j) bfr[j] = *(const bf16x8*)(cB + j * 1024);
#pragma unroll
    for (int i = 0; i < 8; ++i) {
      const bf16x8 af = *(const bf16x8*)(cA + i * 1024);
#pragma unroll
      for (int j = 0; j < 4; ++j) acc[i][j] = __builtin_amdgcn_mfma_f32_16x16x32_bf16(bfr[j], af, acc[i][j], 0, 0, 0);
    }
  }
#undef G3_ISSUE
  bf16_t* sE = (bf16_t*)smem;
  __syncthreads();
#pragma unroll
  for (int i = 0; i < 8; ++i)
#pragma unroll
    for (int j = 0; j < 4; ++j) {
      u32x2 w; w.x = pack2(acc[i][j][0], acc[i][j][1]); w.y = pack2(acc[i][j][2], acc[i][j][3]);
      *(u32x2*)(sE + (wr * 128 + i * 16 + l15) * G3_ES + wc * 64 + j * 16 + q * 4) = w;
    }
  __syncthreads();
  epi.finish(sE, m0, n0, tid);
}
template <class D> struct Epi3RowChunks {
  __device__ __forceinline__ void finish(const bf16_t* sE, int m0, int n0, int tid) const {
#pragma unroll
    for (int pp = 0; pp < 16; ++pp) {
      const int id = tid + 256 * pp, row = id >> 4, cc = (id & 15) * 8;
      static_cast<const D*>(this)->store(m0 + row, n0 + cc, *(const u32x4*)(sE + row * G3_ES + cc));
    }
  }
};
struct Epi3StoreBf16 : Epi3RowChunks<Epi3StoreBf16> {
  bf16_t* C; int ldc;
  __device__ Epi3StoreBf16(bf16_t* c, int l) : C(c), ldc(l) {}
  __device__ __forceinline__ void store(int m, int n, const u32x4& v) const { *(u32x4*)(C + (size_t)m * ldc + n) = v; }
};
struct Epi3GateA : Epi3RowChunks<Epi3GateA> {
  const bf16_t* zG; const float* bg; bf16_t* mrg;
  __device__ Epi3GateA(const bf16_t* z, const float* b, bf16_t* m) : zG(z), bg(b), mrg(m) {}
  __device__ __forceinline__ void store(int m, int n, const u32x4& v) const {
    const u32x4 g = *(const u32x4*)(zG + (size_t)m * 2048 + n);
    const f32x4 b0 = *(const f32x4*)(bg + n), b1 = *(const f32x4*)(bg + n + 4);
    u32x4 o;
#pragma unroll
    for (int i = 0; i < 4; ++i) {
      const float bl = i < 2 ? b0[2 * i] : b1[2 * i - 4], bh = i < 2 ? b0[2 * i + 1] : b1[2 * i - 3];
      o[i] = pack2(sigmoidf_(bflo(g[i]) + bl) * bflo(v[i]), sigmoidf_(bfhi(g[i]) + bh) * bfhi(v[i]));
    }
    *(u32x4*)(mrg + (size_t)m * DM + n) = o;
  }
};
struct Epi3GateB : Epi3RowChunks<Epi3GateB> {
  const bf16_t* zG; const float* bg; bf16_t* mrg;
  __device__ Epi3GateB(const bf16_t* z, const float* b, bf16_t* m) : zG(z), bg(b), mrg(m) {}
  __device__ __forceinline__ void store(int m, int n, const u32x4& v) const {
    const u32x4 g = *(const u32x4*)(zG + (size_t)m * 2048 + 1024 + n);
    const u32x4 a = *(const u32x4*)(mrg + (size_t)m * DM + n);
    const f32x4 b0 = *(const f32x4*)(bg + 1024 + n), b1 = *(const f32x4*)(bg + 1024 + n + 4);
    u32x4 o;
#pragma unroll
    for (int i = 0; i < 4; ++i) {
      const float bl = i < 2 ? b0[2 * i] : b1[2 * i - 4], bh = i < 2 ? b0[2 * i + 1] : b1[2 * i - 3];
      o[i] = pack2(bflo(a[i]) + sigmoidf_(bflo(g[i]) + bl) * bflo(v[i]), bfhi(a[i]) + sigmoidf_(bfhi(g[i]) + bh) * bfhi(v[i]));
    }
    *(u32x4*)(mrg + (size_t)m * DM + n) = o;
  }
};
struct Epi3Z : Epi3RowChunks<Epi3Z> {
  bf16_t *zA, *zP, *zG;
  __device__ Epi3Z(bf16_t* a, bf16_t* b, bf16_t* c) : zA(a), zP(b), zG(c) {}
  __device__ __forceinline__ void store(int m, int n, const u32x4& v) const {
    if (n < SHIFTC) *(u32x4*)(zA + (size_t)m * SHIFTC + n) = v;
    else if (m < NTOK) {
      if (n < SHIFTC + 512) *(u32x4*)(zP + (size_t)m * 512 + (n - SHIFTC)) = v;
      else *(u32x4*)(zG + (size_t)m * 2048 + (n - SHIFTC - 512)) = v;
    }
  }
};

struct EpiStoreBf16 {
  bf16_t* C; int ldc;
  __device__ __forceinline__ void operator()(int m, int n, const f32x4& v) const {
    uint2 w; w.x = pack2(v[0], v[1]); w.y = pack2(v[2], v[3]);
    *(uint2*)(C + (size_t)m * ldc + n) = w;
  }
};
struct EpiZ {
  bf16_t *zA, *zP, *zG;
  __device__ __forceinline__ void operator()(int m, int n, const f32x4& v) const {
    uint2 w; w.x = pack2(v[0], v[1]); w.y = pack2(v[2], v[3]);
    if (n < SHIFTC) *(uint2*)(zA + (size_t)m * SHIFTC + n) = w;
    else if (m < NTOK) {
      if (n < SHIFTC + 512) *(uint2*)(zP + (size_t)m * 512 + (n - SHIFTC)) = w;
      else *(uint2*)(zG + (size_t)m * 2048 + (n - SHIFTC - 512)) = w;
    }
  }
};
struct EpiLds {
  float* S;
  __device__ __forceinline__ void operator()(int m, int n, const f32x4& v) const {
    float* r = S + (m & 127) * 133 + n + (n >> 5);
    r[0] = v[0]; r[1] = v[1]; r[2] = v[2]; r[3] = v[3];
  }
};

__device__ __forceinline__ void ph_transpose(const float* __restrict__ in, bf16_t* __restrict__ out, int K, int N, int vb, int nvb, unsigned char* smem) {
  float* t = (float*)smem;
  const int tk = K / 32, tn = N / 32, tx = threadIdx.x & 31, ty = threadIdx.x >> 5;
  for (int it = vb; it < tk * tn; it += nvb) {
    const int k0 = (it / tn) * 32, n0 = (it % tn) * 32;
    __syncthreads();
#pragma unroll
    for (int r = 0; r < 4; ++r) t[(ty + 8 * r) * 33 + tx] = in[(size_t)(k0 + ty + 8 * r) * N + n0 + tx];
    __syncthreads();
#pragma unroll
    for (int r = 0; r < 4; ++r) out[(size_t)(n0 + ty + 8 * r) * K + k0 + tx] = f2bf(t[tx * 33 + ty + 8 * r]);
  }
}
__device__ __forceinline__ void ph_convert(const float* __restrict__ in, bf16_t* __restrict__ out, size_t n, int vb, int nvb) {
  for (size_t i = ((size_t)vb * 256 + threadIdx.x) * 4; i < n; i += (size_t)nvb * 1024) {
    const float4 v = *(const float4*)(in + i);
    uint2 w; w.x = pack2(v.x, v.y); w.y = pack2(v.z, v.w);
    *(uint2*)(out + i) = w;
  }
}
__device__ __forceinline__ void ph_weff(const P& p, int vb, int nvb) {
  for (int it = vb * 256 + threadIdx.x; it < 512 * 1024; it += nvb * 256) {
    const int n = it & 1023, k = it >> 10, j = k >> 7, kl = k & 127;
    const float* wp = p.w_pool + ((size_t)j * 128 + kl) * 128;
    float s = 0.f;
    for (int c = 0; c < 128; ++c) s += wp[c] * p.pool_scale[j * 128 + c] * p.w_b_out[(size_t)(j * 128 + c) * 1024 + n];
    p.Wt_eff[(size_t)n * 512 + k] = f2bf(s);
  }
}
__device__ __forceinline__ void ph_mod(const P& p, int vb, int nvb, unsigned char* smem) {
  float* red = (float*)smem;
  const int lane = threadIdx.x & 63, wid = threadIdx.x >> 6;
  for (int it = vb; it < 96; it += nvb) {
    const int n = it * 64 + lane;
    float a0 = 0.f, a1 = 0.f, a2 = 0.f;
#pragma unroll 8
    for (int k = wid * 256; k < wid * 256 + 256; ++k) {
      const float w = p.w_mod[(size_t)k * 6144 + n];
      const float c0 = p.c[k], c1 = p.c[1024 + k], c2 = p.c_ctx[k];
      a0 += c0 * sigmoidf_(c0) * w; a1 += c1 * sigmoidf_(c1) * w; a2 += c2 * sigmoidf_(c2) * w;
    }
    __syncthreads();
    red[(wid * 3 + 0) * 64 + lane] = a0; red[(wid * 3 + 1) * 64 + lane] = a1; red[(wid * 3 + 2) * 64 + lane] = a2;
    __syncthreads();
    if (wid < 3) {
      const float sum = red[(0 * 3 + wid) * 64 + lane] + red[(1 * 3 + wid) * 64 + lane] + red[(2 * 3 + wid) * 64 + lane] + red[(3 * 3 + wid) * 64 + lane];
      p.mod[wid * 6144 + n] = sum + p.b_mod[n];
    }
  }
}
__device__ __forceinline__ float wave_sum(float v) {
#pragma unroll
  for (int o = 32; o > 0; o >>= 1) v += __shfl_xor(v, o);
  return v;
}
__device__ __forceinline__ void ph_norm1(const P& p, int vb, int nvb) {
  const int lane = threadIdx.x & 63, wid = threadIdx.x >> 6;
  for (int m = vb * 4 + wid; m < MROWS; m += nvb * 4) {
    const float* src = m < NTOK ? p.x + (size_t)m * DM : p.ctx + (size_t)(m - NTOK) * DM;
    const float* md = p.mod + (m < NTOK ? (m / SEQ) : 2) * 6144;
    float4 v[4]; float ss = 0.f;
#pragma unroll
    for (int i = 0; i < 4; ++i) { v[i] = *(const float4*)(src + i * 256 + lane * 4); ss += v[i].x * v[i].x + v[i].y * v[i].y + v[i].z * v[i].z + v[i].w * v[i].w; }
    ss = wave_sum(ss);
    const float rstd = rsqrtf(ss * (1.0f / 1024.0f) + 1e-6f);
#pragma unroll
    for (int i = 0; i < 4; ++i) {
      const int col = i * 256 + lane * 4;
      const float4 g = *(const float4*)(p.g_pre_mix + col), sh = *(const float4*)(md + col), sc = *(const float4*)(md + 1024 + col);
      uint2 w;
      w.x = pack2(v[i].x * rstd * g.x * (1.f + sc.x) + sh.x, v[i].y * rstd * g.y * (1.f + sc.y) + sh.y);
      w.y = pack2(v[i].z * rstd * g.z * (1.f + sc.z) + sh.z, v[i].w * rstd * g.w * (1.f + sc.w) + sh.w);
      *(uint2*)(p.hx + (size_t)m * DM + col) = w;
    }
  }
}
struct Epi3Readout {
  const P* pp;
  __device__ __forceinline__ void finish(const bf16_t* sE, int m0, int n0, int tid) const {
    const P& p = *pp;
#pragma unroll 2
    for (int pq = 0; pq < 16; ++pq) {
      const int id = tid + 256 * pq, row = id >> 4, cc = (id & 15) * 8, m = m0 + row, n = n0 + cc, t = m % SEQ, h = n >> 6;
      const u32x4 g = *(const u32x4*)(sE + row * G3_ES + cc);
      const u32x4 y0 = *(const u32x4*)(p.Y0 + (size_t)m * DM + n), y1 = *(const u32x4*)(p.Y1 + (size_t)m * DM + n);
      float y[8], v[8];
#pragma unroll
      for (int i = 0; i < 4; ++i) { y[2 * i] = bflo(y0[i]) + bflo(y1[i]); y[2 * i + 1] = bfhi(y0[i]) + bfhi(y1[i]); }
      float sm = 0.f;
#pragma unroll
      for (int i = 0; i < 8; ++i) sm += y[i];
      const float mu = red8(sm) * (1.f / 64.f);
      float qv = 0.f;
#pragma unroll
      for (int i = 0; i < 8; ++i) { y[i] -= mu; qv += y[i] * y[i]; }
      const float rs = rsqrtf(red8(qv) * (1.f / 64.f) + 64e-5f);
      load_shift8(p.zA, p.mu_shift, m - t, t, SEQ, 2048 + n, v);
      const float bon = 0.5f * (p.bdot[(size_t)m * 16 + h] + p.bdot[((size_t)NTOK + m) * 16 + h]);
      const f32x4 w0 = *(const f32x4*)(p.ln_x_w + n), w1 = *(const f32x4*)(p.ln_x_w + n + 4), b0 = *(const f32x4*)(p.ln_x_b + n), b1 = *(const f32x4*)(p.ln_x_b + n + 4);
      const float lw[8] = {w0[0], w0[1], w0[2], w0[3], w1[0], w1[1], w1[2], w1[3]}, lb[8] = {b0[0], b0[1], b0[2], b0[3], b1[0], b1[1], b1[2], b1[3]};
      u32x4 o;
#pragma unroll
      for (int i = 0; i < 4; ++i)
        o[i] = pack2((y[2 * i] * rs * lw[2 * i] + lb[2 * i] + bon * v[2 * i]) * bflo(g[i]), (y[2 * i + 1] * rs * lw[2 * i + 1] + lb[2 * i + 1] + bon * v[2 * i + 1]) * bfhi(g[i]));
      *(u32x4*)(p.out_a + (size_t)m * DM + n) = o;
    }
  }
};
__device__ __forceinline__ int xcd_tile(int vb, int nvb, int round, int TM, int TN, int& tm, int& tn) {
  if (nvb % 64 != 0) { const int it = round * nvb + vb; if (it >= TM * TN) return 0; tm = it % TM; tn = it / TM; return 1; }
  const int spg = nvb >> 3, g = vb & 7, slot = vb >> 3, SC = spg >> 3;
  const int nsr = (TM + 7) >> 3, nsc = (TN + SC - 1) / SC, st = round * 8 + g;
  if (st >= nsr * nsc) return 0;
  tm = (st % nsr) * 8 + (slot & 7); tn = (st / nsr) * SC + (slot >> 3);
  return (tm < TM && tn < TN) ? 1 : 2;
}
__device__ __forceinline__ void ph_gemm1(const P& p, int vb, int nvb, unsigned char* smem) {
  Epi3Z epi{p.zA, p.zP, p.zG};
  if (nvb == 512) {
    const int g = vb & 7, slot = vb >> 3;
    for (int round = 0; round < 12; ++round) {
      const int st = round * 8 + g, sr = st & 15, sc = st >> 4;
      int tm = sr * 8 + (slot & 7), tn = sc * 8 + (slot >> 3);
      if (tn >= 47) { const int ci = sr * 8 + (slot & 7); if (ci >= 54) continue; tm = 128 + (ci & 1); tn = ci >> 1; }
      gemm_tile3(p.hx, DM, p.Wt_in, DM, DM, tm * 256, tn * 128, epi, smem);
    }
  } else {
    for (int it = vb; it < 128 * 47 + 54; it += nvb) {
      int tm, tn;
      if (it < 128 * 47) { tm = it % 128; tn = it / 128; } else { tm = 128 + (it - 128 * 47) % 2; tn = (it - 128 * 47) / 2; }
      gemm_tile3(p.hx, DM, p.Wt_in, DM, DM, tm * 256, tn * 128, epi, smem);
    }
  }
}
__device__ __forceinline__ void ph_readout_gemm(const P& p, int vb, int nvb, unsigned char* smem) {
  Epi3Readout epi{&p};
  for (int round = 0;; ++round) {
    int tm, tn; const int r = xcd_tile(vb, nvb, round, NTOK / 256, DM / 128, tm, tn);
    if (r == 0) break;
    if (r == 1) gemm_tile3(p.sg, 128, p.g2T, 128, 128, tm * 256, tn * 128, epi, smem);
  }
}
__device__ __forceinline__ void ph_sg(const P& p, int vb, int nvb) {
  for (int it = vb * 256 + threadIdx.x; it < NTOK * 16; it += nvb * 256) {
    const int m = it >> 4, l8 = (it & 15) * 8, t = m % SEQ;
    float o[8];
    load_shift8(p.zA, p.mu_shift, m - t, t, SEQ, 3328 + l8, o);
    u32x4 w;
#pragma unroll
    for (int i = 0; i < 4; ++i) w[i] = pack2(sigmoidf_(o[2 * i]), sigmoidf_(o[2 * i + 1]));
    *(u32x4*)(p.sg + (size_t)m * 128 + l8) = w;
  }
}
__device__ __forceinline__ void ph_gemm_merge(const P& p, int vb, int nvb, unsigned char* smem) {
  Epi3GateA ea{p.zG, p.b_gate, p.mrg};
  Epi3GateB eb{p.zG, p.b_gate, p.mrg};
  for (int round = 0;; ++round) {
    int tm, tn; const int r = xcd_tile(vb, nvb, round, NTOK / 256, DM / 128, tm, tn);
    if (r == 0) break;
    if (r == 1) {
      gemm_tile3(p.out_a, DM, p.Wt_aout, DM, DM, tm * 256, tn * 128, ea, smem);
      gemm_tile3(p.pooled, 512, p.Wt_eff, 512, 512, tm * 256, tn * 128, eb, smem);
    }
  }
}
__device__ __forceinline__ void ph_gemm_simple(const bf16_t* A, int lda, const bf16_t* Bt, int ldb, int K, int M, int N, bf16_t* C, int ldc, int vb, int nvb, unsigned char* smem) {
  Epi3StoreBf16 epi{C, ldc};
  for (int round = 0;; ++round) {
    int tm, tn; const int r = xcd_tile(vb, nvb, round, M / 256, N / 128, tm, tn);
    if (r == 0) break;
    if (r == 1) gemm_tile3(A, lda, Bt, ldb, K, tm * 256, tn * 128, epi, smem);
  }
}


#define O_R1 0
#define O_R2 10240
#define O_TA (O_R2 + 17408)
#define O_TR (O_TA + 4608)
#define O_TB (O_TR + 4608)
#define O_TK (O_TB + 4608)
#define O_TBT (O_TK + 4608)
#define O_TKT (O_TBT + 5120)
#define O_TVT (O_TKT + 5120)
#define O_GAM (O_TVT + 5120)
#define O_TST (O_GAM + 256)
#define RWKV_SMEM (O_TST + 2 * 9216)
#define NSUP 65
__device__ __forceinline__ void lds_wave_fence() { asm volatile("s_waitcnt lgkmcnt(0)" ::: "memory"); }
__device__ __forceinline__ u32x2 pack4(const f32x4& v) { u32x2 r; r.x = pack2(v[0], v[1]); r.y = pack2(v[2], v[3]); return r; }

struct RwkvConsts { bf16x8 w2f[2], a2f[2]; };

typedef short s16x4 __attribute__((ext_vector_type(4)));
__device__ __forceinline__ float fast_tanh(float x) { const float e = __expf(2.0f * x); return 1.0f - __fdividef(2.0f, e + 1.0f); }
template <int NS, bool WANTY>
__device__ __forceinline__ void rwkv_chunk(const P& p, unsigned char* smem, int d, int h, int rowbase, int T, int isc0, bool latent, f32x4 (&st)[NS][4], const RwkvConsts& cc) {
  int tid = threadIdx.x;
  asm volatile("" : "+v"(tid));
  const int lane = tid & 63, w = __builtin_amdgcn_readfirstlane(tid >> 6), l15 = lane & 15, q = lane >> 4;
  const int tt = tid >> 3, cg = tid & 7, ch0 = h * 64 + cg * 8;
  const int isc = isc0 + tt, t = d == 0 ? isc : T - 1 - isc;
  bf16_t* TWD = (bf16_t*)(smem + O_R1); bf16_t* TAD = TWD + 32 * 72;
  float* WT = (float*)(smem + O_R1);
  bf16_t* XT = (bf16_t*)(smem + O_R1); bf16_t* UT = XT + 64 * 40;
  float* LW = (float*)(smem + O_R2); float* LA = LW + 32 * 68;
  float* TL = (float*)(smem + O_R2);
  bf16_t* TT = (bf16_t*)(smem + O_R2 + 4608); bf16_t* TAK = TT + 32 * 40; bf16_t* TRB = TAK + 32 * 40; bf16_t* TRK = TRB + 32 * 40; bf16_t* TLB = TRK + 32 * 40;
  bf16_t* TA = (bf16_t*)(smem + O_TA); bf16_t* TR = (bf16_t*)(smem + O_TR); bf16_t* TB = (bf16_t*)(smem + O_TB); bf16_t* TK = (bf16_t*)(smem + O_TK);
  bf16_t* TBT = (bf16_t*)(smem + O_TBT); bf16_t* TKT = (bf16_t*)(smem + O_TKT); bf16_t* TVT = (bf16_t*)(smem + O_TVT);
  float* GAM = (float*)(smem + O_GAM);
  bf16_t* TST = (bf16_t*)(smem + O_TST);
  __syncthreads();
  float k8[8], r8[8];
  {
    float o[8];
    load_shift8(p.zA, p.mu_shift, rowbase, t, T, 3072 + d * 64 + cg * 8, o);
    u32x4 pk; pk.x = pack2(fast_tanh(o[0]), fast_tanh(o[1])); pk.y = pack2(fast_tanh(o[2]), fast_tanh(o[3])); pk.z = pack2(fast_tanh(o[4]), fast_tanh(o[5])); pk.w = pack2(fast_tanh(o[6]), fast_tanh(o[7]));
    *(u32x4*)(TWD + tt * 72 + cg * 8) = pk;
    load_shift8(p.zA, p.mu_shift, rowbase, t, T, 3200 + d * 64 + cg * 8, o);
    pk.x = pack2(o[0], o[1]); pk.y = pack2(o[2], o[3]); pk.z = pack2(o[4], o[5]); pk.w = pack2(o[6], o[7]);
    *(u32x4*)(TAD + tt * 72 + cg * 8) = pk;
  }
  load_shift8(p.zA, p.mu_shift, rowbase, t, T, 1024 + ch0, k8);
  if (WANTY) load_shift8(p.zA, p.mu_shift, rowbase, t, T, ch0, r8);
  __syncthreads();
  {
    f32x4 lw[2], la[2];
    bf16x8 w2f[2], a2f[2];
#pragma unroll
    for (int ks = 0; ks < 2; ++ks) {
      w2f[ks] = *(const bf16x8*)(p.w2T + ((size_t)d * 1024 + h * 64 + 16 * w + l15) * 64 + 32 * ks + 8 * q);
      a2f[ks] = *(const bf16x8*)(p.a2T + ((size_t)d * 1024 + h * 64 + 16 * w + l15) * 64 + 32 * ks + 8 * q);
    }
#pragma unroll
    for (int it = 0; it < 2; ++it) { lw[it] = (f32x4){0.f, 0.f, 0.f, 0.f}; la[it] = (f32x4){0.f, 0.f, 0.f, 0.f}; }
#pragma unroll
    for (int ks = 0; ks < 2; ++ks)
#pragma unroll
      for (int it = 0; it < 2; ++it) {
        const bf16x8 aw = *(const bf16x8*)(TWD + (16 * it + l15) * 72 + 32 * ks + 8 * q);
        const bf16x8 aa = *(const bf16x8*)(TAD + (16 * it + l15) * 72 + 32 * ks + 8 * q);
        lw[it] = __builtin_amdgcn_mfma_f32_16x16x32_bf16(aw, w2f[ks], lw[it], 0, 0, 0);
        la[it] = __builtin_amdgcn_mfma_f32_16x16x32_bf16(aa, a2f[ks], la[it], 0, 0, 0);
      }
#pragma unroll
    for (int it = 0; it < 2; ++it)
#pragma unroll
      for (int rg = 0; rg < 4; ++rg) { LW[(16 * it + 4 * q + rg) * 68 + 16 * w + l15] = lw[it][rg]; LA[(16 * it + 4 * q + rg) * 68 + 16 * w + l15] = la[it][rg]; }
  }
  __syncthreads();
  float e8[8], icl[8], kkn[8], kd[8], Lloc[8];
  u32x4 vzc, vzp = (u32x4){0u, 0u, 0u, 0u}, vzn = (u32x4){0u, 0u, 0u, 0u};
  {
    const bf16_t* vp = p.zA + (size_t)(rowbase + t) * SHIFTC + 2048 + ch0;
    vzc = *(const u32x4*)vp;
    if (t > 0) vzp = *(const u32x4*)(vp - SHIFTC);
    if (t < T - 1) vzn = *(const u32x4*)(vp + SHIFTC);
  }
  {
    float ss = 0.f, bd = 0.f;
    float cw0[8], ca0[8], ckk[8], cka[8], crk[8];
#pragma unroll
    for (int e4 = 0; e4 < 8; e4 += 4) {
      const f32x4 a = *(const f32x4*)(p.w0 + d * 1024 + ch0 + e4), b2 = *(const f32x4*)(p.a0 + d * 1024 + ch0 + e4), c2 = *(const f32x4*)(p.k_k + ch0 + e4);
      const f32x4 d2 = *(const f32x4*)(p.k_a + ch0 + e4), f2 = *(const f32x4*)(p.r_k + ch0 + e4);
#pragma unroll
      for (int e = 0; e < 4; ++e) { cw0[e4 + e] = a[e]; ca0[e4 + e] = b2[e]; ckk[e4 + e] = c2[e]; cka[e4 + e] = d2[e]; crk[e4 + e] = f2[e]; }
    }
#pragma unroll
    for (int e = 0; e < 8; ++e) {
      const float xw = -(cw0[e] + LW[tt * 68 + cg * 8 + e]);
      const float sp = fmaxf(xw, 0.f) + __logf(1.0f + __expf(-fabsf(xw)));
      e8[e] = __expf(-sp - 0.5f);
      icl[e] = sigmoidf_(ca0[e] + LA[tt * 68 + cg * 8 + e]);
      kkn[e] = k8[e] * ckk[e]; ss += kkn[e] * kkn[e];
      kd[e] = k8[e] * (1.f + (icl[e] - 1.f) * cka[e]);
      if (WANTY) bd += r8[e] * kd[e] * crk[e];
    }
    ss = red8(ss); if (WANTY) bd = red8(bd);
    const float rn = rsqrtf(fmaxf(ss, 1e-24f));
#pragma unroll
    for (int e = 0; e < 8; ++e) kkn[e] *= rn;
    if (WANTY && cg == 0) p.bdot[((size_t)d * NTOK + rowbase + t) * 16 + h] = bd;
#pragma unroll
    for (int e = 0; e < 8; ++e) {
      float v = e8[e];
      float u = __shfl_up(v, 8); if (lane >= 8) v += u;
      u = __shfl_up(v, 16); if (lane >= 16) v += u;
      u = __shfl_up(v, 32); if (lane >= 32) v += u;
      Lloc[e] = v;
    }
    if (lane >= 56) {
#pragma unroll
      for (int e = 0; e < 8; ++e) WT[w * 64 + cg * 8 + e] = Lloc[e];
    }
  }
  __syncthreads();
  {
    float ta[8], tr[8], tb[8], tk[8], v8[8];
    {
      const f32x4 m0 = *(const f32x4*)(p.mu_shift + 2048 + ch0), m1 = *(const f32x4*)(p.mu_shift + 2048 + ch0 + 4);
      const float mm[8] = {m0[0], m0[1], m0[2], m0[3], m1[0], m1[1], m1[2], m1[3]};
#pragma unroll
      for (int i = 0; i < 4; ++i) {
        const float z0 = bflo(vzc[i]), z1 = bfhi(vzc[i]);
        v8[2 * i] = z0 + mm[2 * i] * (0.5f * (bflo(vzp[i]) + bflo(vzn[i])) - z0);
        v8[2 * i + 1] = z1 + mm[2 * i + 1] * (0.5f * (bfhi(vzp[i]) + bfhi(vzn[i])) - z1);
      }
    }
    float pre[8];
#pragma unroll
    for (int e = 0; e < 8; ++e) pre[e] = 0.f;
    for (int w2 = 0; w2 < w; ++w2) {
      const f32x4 a = *(const f32x4*)(WT + w2 * 64 + cg * 8), b2 = *(const f32x4*)(WT + w2 * 64 + cg * 8 + 4);
#pragma unroll
      for (int e = 0; e < 4; ++e) { pre[e] += a[e]; pre[4 + e] += b2[e]; }
    }
#pragma unroll
    for (int e = 0; e < 8; ++e) {
      const float Li = Lloc[e] + pre[e];
      const float gi = __expf(-Li), gim1 = __expf(-(Li - e8[e])), ginv = __expf(Li);
      ta[e] = -kkn[e] * gim1; if (WANTY) tr[e] = r8[e] * gi; tb[e] = kkn[e] * icl[e] * ginv; tk[e] = kd[e] * ginv;
      if (tt == 31) GAM[cg * 8 + e] = gi;
    }
    u32x4 pk;
    pk.x = pack2(ta[0], ta[1]); pk.y = pack2(ta[2], ta[3]); pk.z = pack2(ta[4], ta[5]); pk.w = pack2(ta[6], ta[7]); *(u32x4*)(TA + tt * 72 + cg * 8) = pk;
    if (WANTY) { pk.x = pack2(tr[0], tr[1]); pk.y = pack2(tr[2], tr[3]); pk.z = pack2(tr[4], tr[5]); pk.w = pack2(tr[6], tr[7]); *(u32x4*)(TR + tt * 72 + cg * 8) = pk; }
    pk.x = pack2(tb[0], tb[1]); pk.y = pack2(tb[2], tb[3]); pk.z = pack2(tb[4], tb[5]); pk.w = pack2(tb[6], tb[7]); *(u32x4*)(TB + tt * 72 + cg * 8) = pk;
    pk.x = pack2(tk[0], tk[1]); pk.y = pack2(tk[2], tk[3]); pk.z = pack2(tk[4], tk[5]); pk.w = pack2(tk[6], tk[7]); *(u32x4*)(TK + tt * 72 + cg * 8) = pk;
#pragma unroll
    for (int e = 0; e < 8; ++e) { TBT[(cg * 8 + e) * 40 + tt] = f2bf(tb[e]); TKT[(cg * 8 + e) * 40 + tt] = f2bf(tk[e]); TVT[(cg * 8 + e) * 40 + tt] = f2bf(v8[e]); }
  }
  __syncthreads();
  if (WANTY || w < 2) {
    const bf16_t* X = (w < 2) ? TA : TR; const bf16_t* Y = (w & 1) ? TK : TB;
    f32x4 g[2][2];
#pragma unroll
    for (int it = 0; it < 2; ++it)
#pragma unroll
      for (int s2 = 0; s2 < 2; ++s2) g[it][s2] = (f32x4){0.f, 0.f, 0.f, 0.f};
#pragma unroll
    for (int ks = 0; ks < 2; ++ks) {
      bf16x8 xa[2], yb[2];
#pragma unroll
      for (int it = 0; it < 2; ++it) { xa[it] = *(const bf16x8*)(X + (16 * it + l15) * 72 + 32 * ks + 8 * q); yb[it] = *(const bf16x8*)(Y + (16 * it + l15) * 72 + 32 * ks + 8 * q); }
#pragma unroll
      for (int it = 0; it < 2; ++it)
#pragma unroll
        for (int s2 = 0; s2 < 2; ++s2) g[it][s2] = __builtin_amdgcn_mfma_f32_16x16x32_bf16(xa[it], yb[s2], g[it][s2], 0, 0, 0);
    }
    bf16_t* dst = w == 1 ? TAK : (w == 2 ? TRB : TRK);
#pragma unroll
    for (int it = 0; it < 2; ++it)
#pragma unroll
      for (int s2 = 0; s2 < 2; ++s2)
#pragma unroll
        for (int rg = 0; rg < 4; ++rg) {
          const int i = 16 * it + 4 * q + rg, s = 16 * s2 + l15;
          const float val = g[it][s2][rg];
          if (w == 0) {
            TL[i * 36 + s] = (s < i) ? val : 0.f;
            if (it == 1 && s2 == 0) TLB[(i - 16) * 40 + s] = f2bf(val);
          } else dst[i * 40 + s] = f2bf(((w == 1) ? (s < i) : (s <= i)) ? val : 0.f);
        }
  }
  if (w == 0) {
    lds_wave_fence();
    const int c = lane & 15, hb = lane & 16;
    float Tr[16];
#pragma unroll
    for (int i = 0; i < 16; ++i) {
      float acc = (i == c) ? 1.f : 0.f;
#pragma unroll
      for (int j4 = 0; j4 < (i + 3) / 4; ++j4) {
        const f32x4 l4 = *(const f32x4*)(TL + (hb + i) * 36 + hb + 4 * j4);
#pragma unroll
        for (int jj = 0; jj < 4; ++jj) if (4 * j4 + jj < i) acc += l4[jj] * Tr[4 * j4 + jj];
      }
      Tr[i] = acc;
    }
    if (lane < 32) {
#pragma unroll
      for (int i = 0; i < 16; ++i) TT[(hb + i) * 40 + hb + c] = f2bf(Tr[i]);
    }
  }
  __syncthreads();
  const bf16x8 vfr = *(const bf16x8*)(TVT + (16 * w + l15) * 40 + 8 * q);
  const s16x4 t1f = *(const s16x4*)(TT + l15 * 40 + 4 * q), t2f = *(const s16x4*)(TT + (16 + l15) * 40 + 16 + 4 * q), l21f = *(const s16x4*)(TLB + l15 * 40 + 4 * q);
  bf16_t* XTw = XT + (16 * w + l15) * 40; bf16_t* UTw = UT + (16 * w + l15) * 40;
#pragma unroll
  for (int si = 0; si < NS; ++si) {
    const bool useV = (NS == 1) || (si == 1);
    const bf16_t* STs = TST + (si * 64 + 16 * w + l15) * 72;
    bf16x8 sf[2];
    sf[0] = *(const bf16x8*)(STs + 8 * q); sf[1] = *(const bf16x8*)(STs + 32 + 8 * q);
    f32x4 xa[2];
#pragma unroll
    for (int it = 0; it < 2; ++it) {
      xa[it] = (f32x4){0.f, 0.f, 0.f, 0.f};
#pragma unroll
      for (int ks = 0; ks < 2; ++ks) xa[it] = __builtin_amdgcn_mfma_f32_16x16x32_bf16(*(const bf16x8*)(TA + (16 * it + l15) * 72 + 32 * ks + 8 * q), sf[ks], xa[it], 0, 0, 0);
      if (useV) xa[it] = __builtin_amdgcn_mfma_f32_16x16x32_bf16(*(const bf16x8*)(TAK + (16 * it + l15) * 40 + 8 * q), vfr, xa[it], 0, 0, 0);
    }
    *(u32x2*)(XTw + 4 * q) = pack4(xa[0]);
    lds_wave_fence();
    f32x4 ua = __builtin_amdgcn_mfma_f32_16x16x16bf16_1k(t1f, *(const s16x4*)(XTw + 4 * q), (f32x4){0.f, 0.f, 0.f, 0.f}, 0, 0, 0);
    *(u32x2*)(UTw + 4 * q) = pack4(ua);
    lds_wave_fence();
    xa[1] = __builtin_amdgcn_mfma_f32_16x16x16bf16_1k(l21f, *(const s16x4*)(UTw + 4 * q), xa[1], 0, 0, 0);
    *(u32x2*)(XTw + 16 + 4 * q) = pack4(xa[1]);
    lds_wave_fence();
    ua = __builtin_amdgcn_mfma_f32_16x16x16bf16_1k(t2f, *(const s16x4*)(XTw + 16 + 4 * q), (f32x4){0.f, 0.f, 0.f, 0.f}, 0, 0, 0);
    *(u32x2*)(UTw + 16 + 4 * q) = pack4(ua);
    lds_wave_fence();
    const bf16x8 uf = *(const bf16x8*)(UTw + 8 * q);
    if (WANTY) {
#pragma unroll
      for (int it = 0; it < 2; ++it) {
        f32x4 ya = (f32x4){0.f, 0.f, 0.f, 0.f};
#pragma unroll
        for (int ks = 0; ks < 2; ++ks) ya = __builtin_amdgcn_mfma_f32_16x16x32_bf16(*(const bf16x8*)(TR + (16 * it + l15) * 72 + 32 * ks + 8 * q), sf[ks], ya, 0, 0, 0);
        ya = __builtin_amdgcn_mfma_f32_16x16x32_bf16(*(const bf16x8*)(TRB + (16 * it + l15) * 40 + 8 * q), uf, ya, 0, 0, 0);
        ya = __builtin_amdgcn_mfma_f32_16x16x32_bf16(*(const bf16x8*)(TRK + (16 * it + l15) * 40 + 8 * q), vfr, ya, 0, 0, 0);
        bf16_t* Yd = d == 0 ? p.Y0 : p.Y1;
#pragma unroll
        for (int rg = 0; rg < 4; ++rg) {
          const int iq = isc0 + 16 * it + 4 * q + rg, tq = d == 0 ? iq : T - 1 - iq;
          Yd[(size_t)(rowbase + tq) * DM + h * 64 + 16 * w + l15] = f2bf(ya[rg]);
        }
      }
    }
#pragma unroll
    for (int kt = 0; kt < 4; ++kt) {
      f32x4 hv = st[si][kt];
      hv = __builtin_amdgcn_mfma_f32_16x16x32_bf16(*(const bf16x8*)(TBT + (16 * kt + l15) * 40 + 8 * q), uf, hv, 0, 0, 0);
      if (useV) hv = __builtin_amdgcn_mfma_f32_16x16x32_bf16(*(const bf16x8*)(TKT + (16 * kt + l15) * 40 + 8 * q), vfr, hv, 0, 0, 0);
      hv *= *(const f32x4*)(GAM + 16 * kt + 4 * q);
      st[si][kt] = hv;
      *(u32x2*)(TST + (si * 64 + 16 * w + l15) * 72 + 16 * kt + 4 * q) = pack4(hv);
    }
  }
}

__device__ __forceinline__ void rwkv_consts(const P& p, int d, int h, RwkvConsts& cc) {
  const int tid = threadIdx.x, lane = tid & 63, w = tid >> 6, l15 = lane & 15, q = lane >> 4;
#pragma unroll
  for (int ks = 0; ks < 2; ++ks) {
    cc.w2f[ks] = *(const bf16x8*)(p.w2T + ((size_t)d * 1024 + h * 64 + 16 * w + l15) * 64 + 32 * ks + 8 * q);
    cc.a2f[ks] = *(const bf16x8*)(p.a2T + ((size_t)d * 1024 + h * 64 + 16 * w + l15) * 64 + 32 * ks + 8 * q);
  }
}
__device__ __forceinline__ void ph_rwkv_A(const P& p, int vb, int nvb, unsigned char* smem) {
  const int tid = threadIdx.x, lane = tid & 63, w = tid >> 6, l15 = lane & 15, q = lane >> 4;
  bf16_t* TST = (bf16_t*)(smem + O_TST);
  for (int item = vb; item < 64 * 64; item += nvb) {
    const int chain = item >> 6, j = item & 63, b = chain >> 5, d = (chain >> 4) & 1, h = chain & 15;
    const bool latent = j > 0;
    const int T = latent ? SEQ : CTXL, rowbase = latent ? b * SEQ : NTOK + b * CTXL, base = latent ? (j - 1) * 256 : 0;
    RwkvConsts cc; rwkv_consts(p, d, h, cc);
    f32x4 st[2][4];
    __syncthreads();
#pragma unroll
    for (int kt = 0; kt < 4; ++kt) {
#pragma unroll
      for (int rg = 0; rg < 4; ++rg) st[0][kt][rg] = (16 * kt + 4 * q + rg == 16 * w + l15) ? 1.f : 0.f;
      st[1][kt] = (f32x4){0.f, 0.f, 0.f, 0.f};
      *(u32x2*)(TST + (16 * w + l15) * 72 + 16 * kt + 4 * q) = pack4(st[0][kt]);
      *(u32x2*)(TST + (64 + 16 * w + l15) * 72 + 16 * kt + 4 * q) = pack4(st[1][kt]);
    }
    for (int c = 0; c < 8; ++c) rwkv_chunk<2, false>(p, smem, d, h, rowbase, T, base + 32 * c, latent, st, cc);
    const size_t slot = (size_t)chain * NSUP + j;
#pragma unroll
    for (int kt = 0; kt < 4; ++kt) {
#pragma unroll
      for (int rg = 0; rg < 4; ++rg) p.Mst[(slot * 64 + 16 * kt + 4 * q + rg) * 64 + 16 * w + l15] = f2bf(st[0][kt][rg]);
      *(f32x4*)(p.Nst + (slot * 64 + 16 * w + l15) * 64 + 16 * kt + 4 * q) = st[1][kt];
    }
  }
}
__device__ __forceinline__ void ph_rwkv_B(const P& p, int vb, int nvb, unsigned char* smem) {
  const int tid = threadIdx.x, lane = tid & 63, w = tid >> 6, l15 = lane & 15, q = lane >> 4;
  bf16_t* HT = (bf16_t*)smem;
  for (int chain = vb; chain < 64; chain += nvb) {
    f32x4 hs[4];
#pragma unroll
    for (int kt = 0; kt < 4; ++kt) hs[kt] = (f32x4){0.f, 0.f, 0.f, 0.f};
    __syncthreads();
    for (int j = 0; j < 64; ++j) {
      const size_t slot = (size_t)chain * NSUP + j;
      f32x4 nv[4];
#pragma unroll
      for (int kt = 0; kt < 4; ++kt) nv[kt] = *(const f32x4*)(p.Nst + (slot * 64 + 16 * w + l15) * 64 + 16 * kt + 4 * q);
      bf16x8 mf[4][2];
#pragma unroll
      for (int kt = 0; kt < 4; ++kt)
#pragma unroll
        for (int ks = 0; ks < 2; ++ks) mf[kt][ks] = *(const bf16x8*)(p.Mst + (slot * 64 + 16 * kt + l15) * 64 + 32 * ks + 8 * q);
#pragma unroll
      for (int kt = 0; kt < 4; ++kt) {
        *(f32x4*)(p.Nst + (slot * 64 + 16 * w + l15) * 64 + 16 * kt + 4 * q) = hs[kt];
        *(u32x2*)(HT + (16 * w + l15) * 72 + 16 * kt + 4 * q) = pack4(hs[kt]);
      }
      lds_wave_fence();
      bf16x8 hf[2];
      hf[0] = *(const bf16x8*)(HT + (16 * w + l15) * 72 + 8 * q); hf[1] = *(const bf16x8*)(HT + (16 * w + l15) * 72 + 32 + 8 * q);
      lds_wave_fence();
#pragma unroll
      for (int kt = 0; kt < 4; ++kt) {
        f32x4 a = nv[kt];
#pragma unroll
        for (int ks = 0; ks < 2; ++ks) a = __builtin_amdgcn_mfma_f32_16x16x32_bf16(mf[kt][ks], hf[ks], a, 0, 0, 0);
        hs[kt] = a;
      }
    }
    const size_t slot = (size_t)chain * NSUP + 64;
#pragma unroll
    for (int kt = 0; kt < 4; ++kt) *(f32x4*)(p.Nst + (slot * 64 + 16 * w + l15) * 64 + 16 * kt + 4 * q) = hs[kt];
  }
}
__device__ __forceinline__ void ph_rwkv_C(const P& p, int vb, int nvb, unsigned char* smem) {
  const int tid = threadIdx.x, lane = tid & 63, w = tid >> 6, l15 = lane & 15, q = lane >> 4;
  bf16_t* TST = (bf16_t*)(smem + O_TST);
  for (int item = vb; item < 64 * 64; item += nvb) {
    const int chain = item >> 6, j = (item & 63) + 1, b = chain >> 5, d = (chain >> 4) & 1, h = chain & 15;
    RwkvConsts cc; rwkv_consts(p, d, h, cc);
    f32x4 st[1][4];
    const size_t slot = (size_t)chain * NSUP + j;
    __syncthreads();
#pragma unroll
    for (int kt = 0; kt < 4; ++kt) {
      st[0][kt] = *(const f32x4*)(p.Nst + (slot * 64 + 16 * w + l15) * 64 + 16 * kt + 4 * q);
      *(u32x2*)(TST + (16 * w + l15) * 72 + 16 * kt + 4 * q) = pack4(st[0][kt]);
    }
    for (int c = 0; c < 8; ++c) rwkv_chunk<1, true>(p, smem, d, h, b * SEQ, SEQ, (j - 1) * 256 + 32 * c, true, st, cc);
  }
}

#define RO_SMEM (128 * 16 * 4)
__device__ __forceinline__ void ph_readout(const P& p, int vb, int nvb, unsigned char* smem) {
  float* sgT = (float*)smem;
  const int tid = threadIdx.x, c4 = tid * 4, h = tid >> 4;
  const float4 lnw = *(const float4*)(p.ln_x_w + c4), lnb = *(const float4*)(p.ln_x_b + c4);
  for (int item = vb; item < NTOK / 16; item += nvb) {
    const int tok0 = item * 16;
    __syncthreads();
    {
      const int tk = tid >> 4, l8 = (tid & 15) * 8, m = tok0 + tk, b = m / SEQ, t = m % SEQ;
      float o[8];
      load_shift8(p.zA, p.mu_shift, b * SEQ, t, SEQ, 3328 + l8, o);
#pragma unroll
      for (int e = 0; e < 8; ++e) sgT[(l8 + e) * 16 + tk] = sigmoidf_(o[e]);
    }
    __syncthreads();
    float4 g[16];
#pragma unroll
    for (int k = 0; k < 16; ++k) g[k] = make_float4(0.f, 0.f, 0.f, 0.f);
    for (int l = 0; l < 128; ++l) {
      const float4 w = *(const float4*)(p.g2 + (size_t)l * 1024 + c4);
      const float4 s0 = *(const float4*)(sgT + l * 16), s1 = *(const float4*)(sgT + l * 16 + 4), s2 = *(const float4*)(sgT + l * 16 + 8), s3 = *(const float4*)(sgT + l * 16 + 12);
      const float sv[16] = {s0.x, s0.y, s0.z, s0.w, s1.x, s1.y, s1.z, s1.w, s2.x, s2.y, s2.z, s2.w, s3.x, s3.y, s3.z, s3.w};
#pragma unroll
      for (int k = 0; k < 16; ++k) { g[k].x += sv[k] * w.x; g[k].y += sv[k] * w.y; g[k].z += sv[k] * w.z; g[k].w += sv[k] * w.w; }
    }
#pragma unroll
    for (int k = 0; k < 16; ++k) {
      const int m = tok0 + k, b = m / SEQ, t = m % SEQ;
      const uint2 y0 = *(const uint2*)(p.Y0 + (size_t)m * DM + c4), y1 = *(const uint2*)(p.Y1 + (size_t)m * DM + c4);
      float y[4] = {bflo(y0.x) + bflo(y1.x), bfhi(y0.x) + bfhi(y1.x), bflo(y0.y) + bflo(y1.y), bfhi(y0.y) + bfhi(y1.y)};
      const float mu = red16(y[0] + y[1] + y[2] + y[3]) * (1.f / 64.f);
      float q = 0.f;
#pragma unroll
      for (int e = 0; e < 4; ++e) { y[e] -= mu; q += y[e] * y[e]; }
      const float rs = rsqrtf(red16(q) * (1.f / 64.f) + 64e-5f);
      const bf16_t* zr = p.zA + (size_t)m * SHIFTC + 2048 + c4;
      const uint2 zc = *(const uint2*)zr;
      uint2 zp = make_uint2(0, 0), zn = make_uint2(0, 0);
      if (t > 0) zp = *(const uint2*)(zr - SHIFTC);
      if (t < SEQ - 1) zn = *(const uint2*)(zr + SHIFTC);
      const float4 mu4 = *(const float4*)(p.mu_shift + 2048 + c4);
      float v[4];
      v[0] = bflo(zc.x) + mu4.x * (0.5f * (bflo(zp.x) + bflo(zn.x)) - bflo(zc.x));
      v[1] = bfhi(zc.x) + mu4.y * (0.5f * (bfhi(zp.x) + bfhi(zn.x)) - bfhi(zc.x));
      v[2] = bflo(zc.y) + mu4.z * (0.5f * (bflo(zp.y) + bflo(zn.y)) - bflo(zc.y));
      v[3] = bfhi(zc.y) + mu4.w * (0.5f * (bfhi(zp.y) + bfhi(zn.y)) - bfhi(zc.y));
      const float bon = 0.5f * (p.bdot[(size_t)m * 16 + h] + p.bdot[((size_t)NTOK + m) * 16 + h]);
      const float o0 = (y[0] * rs * lnw.x + lnb.x + bon * v[0]) * g[k].x, o1 = (y[1] * rs * lnw.y + lnb.y + bon * v[1]) * g[k].y;
      const float o2 = (y[2] * rs * lnw.z + lnb.z + bon * v[2]) * g[k].z, o3 = (y[3] * rs * lnw.w + lnb.w + bon * v[3]) * g[k].w;
      uint2 w; w.x = pack2(o0, o1); w.y = pack2(o2, o3);
      *(uint2*)(p.out_a + (size_t)m * DM + c4) = w;
    }
  }
}

#define POOL_SMEM (64 * 128 * 4)
__device__ __forceinline__ void ph_pool(const P& p, int vb, int nvb, unsigned char* smem) {
  float* V = (float*)smem;
  const int tid = threadIdx.x;
  for (int item = vb; item < 2 * 256 * 4; item += nvb) {
    const int j = item & 3, r = (item >> 2) & 255, b = item >> 10;
    const int win = 2 << j, half = win >> 1;
    const int r0 = max(r - half, 0), r1 = min(r + half, 256);
    __syncthreads();
    const int cp = tid & 63, cq = tid >> 6;
    float a0[16], a1[16];
#pragma unroll
    for (int i = 0; i < 16; ++i) { a0[i] = 0.f; a1[i] = 0.f; }
    for (int rr = r0; rr < r1; ++rr) {
      const bf16_t* base = p.zP + ((size_t)b * SEQ + rr * 64) * 512 + j * 128 + cp * 2;
#pragma unroll
      for (int i = 0; i < 16; ++i) {
        const unsigned u = *(const unsigned*)(base + (size_t)(cq + 4 * i) * 512);
        a0[i] += bflo(u); a1[i] += bfhi(u);
      }
    }
#pragma unroll
    for (int i = 0; i < 16; ++i) { V[(cq + 4 * i) * 128 + cp * 2] = a0[i]; V[(cq + 4 * i) * 128 + cp * 2 + 1] = a1[i]; }
    __syncthreads();
#pragma unroll
    for (int i = 0; i < 16; ++i) {
      const int col = cq + 4 * i, c0 = max(col - half, 0), c1 = min(col + half, 64);
      float s0 = 0.f, s1 = 0.f;
      for (int cc = c0; cc < c1; ++cc) { s0 += V[cc * 128 + cp * 2]; s1 += V[cc * 128 + cp * 2 + 1]; }
      const float inv = 1.0f / (float)((r1 - r0) * (c1 - c0));
      const size_t tokoff = ((size_t)b * SEQ + r * 64 + col) * 512 + j * 128 + cp * 2;
      const unsigned u = *(const unsigned*)(p.zP + tokoff);
      *(unsigned*)(p.pooled + tokoff) = pack2(s0 * inv - bflo(u), s1 * inv - bfhi(u));
    }
  }
}
__device__ __forceinline__ void ph_merge(const P& p, int vb, int nvb) {
  for (size_t i = ((size_t)vb * 256 + threadIdx.x) * 4; i < (size_t)NTOK * DM; i += (size_t)nvb * 1024) {
    const size_t m = i >> 10; const int c = (int)(i & 1023);
    const uint2 g1 = *(const uint2*)(p.zG + m * 2048 + c), g2 = *(const uint2*)(p.zG + m * 2048 + 1024 + c);
    const uint2 a = *(const uint2*)(p.ya + i), bq = *(const uint2*)(p.yb + i);
    const float4 b1 = *(const float4*)(p.b_gate + c), b2 = *(const float4*)(p.b_gate + 1024 + c);
    const float m0 = sigmoidf_(bflo(g1.x) + b1.x) * bflo(a.x) + sigmoidf_(bflo(g2.x) + b2.x) * bflo(bq.x);
    const float m1 = sigmoidf_(bfhi(g1.x) + b1.y) * bfhi(a.x) + sigmoidf_(bfhi(g2.x) + b2.y) * bfhi(bq.x);
    const float m2 = sigmoidf_(bflo(g1.y) + b1.z) * bflo(a.y) + sigmoidf_(bflo(g2.y) + b2.z) * bflo(bq.y);
    const float m3 = sigmoidf_(bfhi(g1.y) + b1.w) * bfhi(a.y) + sigmoidf_(bfhi(g2.y) + b2.w) * bfhi(bq.y);
    uint2 w; w.x = pack2(m0, m1); w.y = pack2(m2, m3);
    *(uint2*)(p.mrg + i) = w;
  }
}
__device__ __forceinline__ void ph_res1(const P& p, int vb, int nvb) {
  const int lane = threadIdx.x & 63, wid = threadIdx.x >> 6;
  for (int m = vb * 4 + wid; m < NTOK; m += nvb * 4) {
    const float* md = p.mod + (m / SEQ) * 6144;
    float mx[16]; float ss = 0.f;
#pragma unroll
    for (int i = 0; i < 4; ++i) {
      const uint2 u = *(const uint2*)(p.mix + (size_t)m * DM + i * 256 + lane * 4);
      mx[4 * i] = bflo(u.x); mx[4 * i + 1] = bfhi(u.x); mx[4 * i + 2] = bflo(u.y); mx[4 * i + 3] = bfhi(u.y);
#pragma unroll
      for (int e = 0; e < 4; ++e) ss += mx[4 * i + e] * mx[4 * i + e];
    }
    ss = wave_sum(ss);
    const float rstd = rsqrtf(ss * (1.0f / 1024.0f) + 1e-6f);
    float x1[16]; float s2 = 0.f;
#pragma unroll
    for (int i = 0; i < 4; ++i) {
      const int col = i * 256 + lane * 4;
      const float4 xv = *(const float4*)(p.x + (size_t)m * DM + col), g = *(const float4*)(p.g_post_mix + col), gt = *(const float4*)(md + 2048 + col);
      x1[4 * i] = xv.x + gt.x * mx[4 * i] * rstd * g.x; x1[4 * i + 1] = xv.y + gt.y * mx[4 * i + 1] * rstd * g.y;
      x1[4 * i + 2] = xv.z + gt.z * mx[4 * i + 2] * rstd * g.z; x1[4 * i + 3] = xv.w + gt.w * mx[4 * i + 3] * rstd * g.w;
      *(float4*)(p.out + (size_t)m * DM + col) = make_float4(x1[4 * i], x1[4 * i + 1], x1[4 * i + 2], x1[4 * i + 3]);
#pragma unroll
      for (int e = 0; e < 4; ++e) s2 += x1[4 * i + e] * x1[4 * i + e];
    }
    s2 = wave_sum(s2);
    const float r2 = rsqrtf(s2 * (1.0f / 1024.0f) + 1e-6f);
#pragma unroll
    for (int i = 0; i < 4; ++i) {
      const int col = i * 256 + lane * 4;
      const float4 g = *(const float4*)(p.g_pre_ffn + col), sh = *(const float4*)(md + 3072 + col), sc = *(const float4*)(md + 4096 + col);
      uint2 w;
      w.x = pack2(x1[4 * i] * r2 * g.x * (1.f + sc.x) + sh.x, x1[4 * i + 1] * r2 * g.y * (1.f + sc.y) + sh.y);
      w.y = pack2(x1[4 * i + 2] * r2 * g.z * (1.f + sc.z) + sh.z, x1[4 * i + 3] * r2 * g.w * (1.f + sc.w) + sh.w);
      *(uint2*)(p.hx2 + (size_t)m * DM + col) = w;
    }
  }
}

#define PS1_SMEM (128 * 133 * 4)
#define CE_DESC(a, b) { const float _mx = fmaxf(a, b), _mn = fminf(a, b); a = _mx; b = _mn; }
template <int N> __device__ __forceinline__ void bitonic_sort_desc(float (&v)[N]) {
#pragma unroll
  for (int k = 2; k <= N; k <<= 1)
#pragma unroll
    for (int j = k >> 1; j > 0; j >>= 1)
#pragma unroll
      for (int i = 0; i < N; ++i) { const int l = i ^ j; if (l > i) { if ((i & k) == 0) CE_DESC(v[i], v[l]) else CE_DESC(v[l], v[i]) } }
}
__device__ __forceinline__ void bitonic_merge16_desc(float (&v)[16]) {
#pragma unroll
  for (int j = 8; j > 0; j >>= 1)
#pragma unroll
    for (int i = 0; i < 16; ++i) { const int l = i ^ j; if (l > i) CE_DESC(v[i], v[l]) }
}
__device__ __forceinline__ void ph_peer_s1(const P& p, int vb, int nvb, unsigned char* smem) {
  float* S = (float*)smem;
  EpiLds epi{S};
  const int tid = threadIdx.x, sub = tid & 3;
  for (int item = vb; item < 256 * 16; item += nvb) {
    const int hp = item & 15, tm = item >> 4;
    __syncthreads();
    gemm_tile(p.q + hp * 128, 2048, p.keys + (size_t)hp * 128 * 128, 128, 128, tm * 128, 0, epi, smem);
    __syncthreads();
#pragma unroll 1
    for (int pass = 0; pass < 2; ++pass) {
      const int row = pass * 64 + (tid >> 2);
      float a[16], b[16];
#pragma unroll
      for (int i = 0; i < 16; ++i) {
        a[i] = __uint_as_float((__float_as_uint(S[row * 133 + sub * 33 + i]) & ~127u) | (unsigned)(sub * 32 + i));
        b[i] = __uint_as_float((__float_as_uint(S[row * 133 + sub * 33 + 16 + i]) & ~127u) | (unsigned)(sub * 32 + 16 + i));
      }
      bitonic_sort_desc<16>(a); bitonic_sort_desc<16>(b);
#pragma unroll
      for (int i = 0; i < 16; ++i) a[i] = fmaxf(a[i], b[15 - i]);
      bitonic_merge16_desc(a);
#pragma unroll
      for (int lvl = 1; lvl <= 2; lvl <<= 1) {
#pragma unroll
        for (int i = 0; i < 16; ++i) b[i] = __shfl_xor(a[i], lvl);
#pragma unroll
        for (int i = 0; i < 16; ++i) a[i] = fmaxf(a[i], b[15 - i]);
        bitonic_merge16_desc(a);
      }
      if (sub == 0) {
        const size_t ob = ((size_t)(tm * 128 + row) * 16 + hp) * 16;
#pragma unroll
        for (int i = 0; i < 16; i += 4) {
          *(f32x4*)(p.sv + ob + i) = (f32x4){a[i], a[i + 1], a[i + 2], a[i + 3]};
          typedef int i32x4 __attribute__((ext_vector_type(4)));
          *(i32x4*)(p.si + ob + i) = (i32x4){(int)(__float_as_uint(a[i]) & 127u), (int)(__float_as_uint(a[i + 1]) & 127u), (int)(__float_as_uint(a[i + 2]) & 127u), (int)(__float_as_uint(a[i + 3]) & 127u)};
        }
      }
    }
  }
}
__device__ __forceinline__ void ph_peer_s2(const P& p, int vb, int nvb) {
  for (int it = vb * 256 + threadIdx.x; it < NTOK * 8; it += nvb * 256) {
    const size_t ob = (size_t)it * 32;
    float a[16], bq[16]; int ia[16], ib[16];
#pragma unroll
    for (int i = 0; i < 16; i += 4) {
      const float4 fa = *(const float4*)(p.sv + ob + i), fb = *(const float4*)(p.sv + ob + 16 + i);
      const int4 ja = *(const int4*)(p.si + ob + i), jb = *(const int4*)(p.si + ob + 16 + i);
      a[i] = fa.x; a[i + 1] = fa.y; a[i + 2] = fa.z; a[i + 3] = fa.w; bq[i] = fb.x; bq[i + 1] = fb.y; bq[i + 2] = fb.z; bq[i + 3] = fb.w;
      ia[i] = ja.x; ia[i + 1] = ja.y; ia[i + 2] = ja.z; ia[i + 3] = ja.w; ib[i] = jb.x; ib[i + 1] = jb.y; ib[i + 2] = jb.z; ib[i + 3] = jb.w;
    }
    float cs[50]; int ci[50];
    {
      int n = 0;
#pragma unroll
      for (int i = 0; i < 16; ++i)
#pragma unroll
        for (int j = 0; j < 16; ++j)
          if ((i + 1) * (j + 1) <= 16) { cs[n] = a[i] + bq[j]; ci[n] = ia[i] * 128 + ib[j]; ++n; }
    }
    float sel[16]; int seli[16];
#pragma unroll
    for (int k = 0; k < 16; ++k) {
      float mx = cs[0];
#pragma unroll
      for (int n = 1; n < 50; ++n) mx = fmaxf(mx, cs[n]);
      int id = 0; bool found = false;
#pragma unroll
      for (int n = 0; n < 50; ++n) {
        const bool hit = !found && (cs[n] == mx);
        if (hit) { id = ci[n]; cs[n] = -3.0e38f; found = true; }
      }
      sel[k] = mx; seli[k] = id;
    }
    float den = 0.f; const float smax = sel[0];
#pragma unroll
    for (int k = 0; k < 16; ++k) { sel[k] = __expf(sel[k] - smax); den += sel[k]; }
    const float inv = 1.0f / den;
    const size_t o2 = (size_t)it * 16;
#pragma unroll
    for (int k = 0; k < 16; ++k) { p.pidx[o2 + k] = seli[k]; p.pgate[o2 + k] = sel[k] * inv; }
  }
}
typedef float f32x2 __attribute__((ext_vector_type(2)));
__device__ __forceinline__ float wave_max(float v) {
#pragma unroll
  for (int o = 32; o > 0; o >>= 1) v = fmaxf(v, __shfl_xor(v, o));
  return v;
}
__device__ __forceinline__ void ph_cvt_fp8(const float* __restrict__ in, unsigned char* __restrict__ out, float* __restrict__ inv_scale, int vb, int nvb) {
  const int lane = threadIdx.x & 63, wid = threadIdx.x >> 6;
  for (int row = vb * 4 + wid; row < 16384; row += nvb * 4) {
    f32x4 v[4]; float am = 0.f;
#pragma unroll
    for (int i = 0; i < 4; ++i) {
      v[i] = *(const f32x4*)(in + (size_t)row * DM + lane * 16 + 4 * i);
      am = fmaxf(am, fmaxf(fmaxf(fabsf(v[i][0]), fabsf(v[i][1])), fmaxf(fabsf(v[i][2]), fabsf(v[i][3]))));
    }
    am = wave_max(am);
    const float sc = am > 0.f ? 416.0f / am : 1.0f;
    u32x4 w;
#pragma unroll
    for (int i = 0; i < 4; ++i) {
      int pk = 0;
      pk = __builtin_amdgcn_cvt_pk_fp8_f32(v[i][0] * sc, v[i][1] * sc, pk, false);
      pk = __builtin_amdgcn_cvt_pk_fp8_f32(v[i][2] * sc, v[i][3] * sc, pk, true);
      w[i] = (unsigned)pk;
    }
    *(u32x4*)(out + (size_t)row * DM + lane * 16) = w;
    if (lane == 0) inv_scale[row] = am > 0.f ? am / 416.0f : 1.0f;
  }
}
__device__ __forceinline__ void fp8x16_to_f32(const u32x4& r, float* o) {
#pragma unroll
  for (int i = 0; i < 4; ++i) {
    const f32x2 a = __builtin_amdgcn_cvt_pk_f32_fp8((int)r[i], false), b = __builtin_amdgcn_cvt_pk_f32_fp8((int)r[i], true);
    o[4 * i] = a.x; o[4 * i + 1] = a.y; o[4 * i + 2] = b.x; o[4 * i + 3] = b.y;
  }
}
__device__ __forceinline__ void ph_peer_gather(const P& p, int vb, int nvb) {
  const int lane = threadIdx.x & 63, wid = threadIdx.x >> 6;
  const int jmap = 4 * (lane & 1) + (lane & 2) + ((lane >> 2) & 1);
  for (int m = vb * 4 + wid; m < NTOK; m += nvb * 4) {
    const float* md = p.mod + (m / SEQ) * 6144;
    float xv[16];
    {
      const u32x4 u0 = *(const u32x4*)(p.hx2 + (size_t)m * DM + lane * 16), u1 = *(const u32x4*)(p.hx2 + (size_t)m * DM + lane * 16 + 8);
#pragma unroll
      for (int e = 0; e < 4; ++e) { xv[2 * e] = bflo(u0[e]); xv[2 * e + 1] = bfhi(u0[e]); xv[8 + 2 * e] = bflo(u1[e]); xv[8 + 2 * e + 1] = bfhi(u1[e]); }
    }
    const int id0 = p.pidx[(size_t)m * 128 + lane], id1 = p.pidx[(size_t)m * 128 + 64 + lane];
    const float su0 = p.us[id0], su1 = p.us[id1];
    const float gs0 = p.pgate[(size_t)m * 128 + lane] * p.vs[id0], gs1 = p.pgate[(size_t)m * 128 + 64 + lane] * p.vs[id1];
    float acc[16];
#pragma unroll
    for (int k = 0; k < 16; ++k) acc[k] = 0.f;
    for (int e0 = 0; e0 < 128; e0 += 8) {
      u32x4 ur[8], vr[8];
#pragma unroll
      for (int j = 0; j < 8; ++j) {
        const int id = __shfl(e0 < 64 ? id0 : id1, (e0 + j) & 63);
        ur[j] = *(const u32x4*)(p.ub8 + (size_t)id * DM + lane * 16);
        vr[j] = *(const u32x4*)(p.vb8 + (size_t)id * DM + lane * 16);
      }
      float d[8];
#pragma unroll
      for (int j = 0; j < 8; ++j) {
        float f[16]; fp8x16_to_f32(ur[j], f);
        float s = 0.f;
#pragma unroll
        for (int k = 0; k < 16; ++k) s += f[k] * xv[k];
        d[j] = s;
      }
      float r4[4], r2[2], r1;
      {
        const bool lo = (lane & 1) == 0;
#pragma unroll
        for (int i = 0; i < 4; ++i) { const float keep = lo ? d[i] : d[i + 4], send = lo ? d[i + 4] : d[i]; r4[i] = keep + __shfl_xor(send, 1); }
        const bool lo2 = (lane & 2) == 0;
#pragma unroll
        for (int i = 0; i < 2; ++i) { const float keep = lo2 ? r4[i] : r4[i + 2], send = lo2 ? r4[i + 2] : r4[i]; r2[i] = keep + __shfl_xor(send, 2); }
        const bool lo4 = (lane & 4) == 0;
        { const float keep = lo4 ? r2[0] : r2[1], send = lo4 ? r2[1] : r2[0]; r1 = keep + __shfl_xor(send, 4); }
        r1 += __shfl_xor(r1, 8); r1 += __shfl_xor(r1, 16); r1 += __shfl_xor(r1, 32);
      }
      const int esrc = (e0 + jmap) & 63;
      const float su = __shfl(e0 < 64 ? su0 : su1, esrc), gs = __shfl(e0 < 64 ? gs0 : gs1, esrc);
      const float sdot = r1 * su;
      const float cf = 0.5f * sdot * (1.0f + erff(sdot * 0.70710678118654752f)) * gs;
#pragma unroll
      for (int j = 0; j < 8; ++j) {
        const float cj = __shfl(cf, (j >> 2) | (j & 2) | ((j & 1) << 2));
        float f[16]; fp8x16_to_f32(vr[j], f);
#pragma unroll
        for (int k = 0; k < 16; ++k) acc[k] += cj * f[k];
      }
    }
    float ss = 0.f;
#pragma unroll
    for (int k = 0; k < 16; ++k) ss += acc[k] * acc[k];
    ss = wave_sum(ss);
    const float rstd = rsqrtf(ss * (1.0f / 1024.0f) + 1e-6f);
#pragma unroll
    for (int k4 = 0; k4 < 4; ++k4) {
      const int col = lane * 16 + k4 * 4;
      f32x4 x1 = *(const f32x4*)(p.out + (size_t)m * DM + col);
      const f32x4 g = *(const f32x4*)(p.g_post_ffn + col), gt = *(const f32x4*)(md + 5120 + col);
      x1[0] += gt[0] * acc[k4 * 4] * rstd * g[0]; x1[1] += gt[1] * acc[k4 * 4 + 1] * rstd * g[1];
      x1[2] += gt[2] * acc[k4 * 4 + 2] * rstd * g[2]; x1[3] += gt[3] * acc[k4 * 4 + 3] * rstd * g[3];
      *(f32x4*)(p.out + (size_t)m * DM + col) = x1;
    }
  }
}

#define XB_TMO      128
#define XB_XCNT(j)  (256  + 64 * (j))
#define XB_XSUB(j)  (1280 + 64 * (j))
#define XB_XGEN(j)  (2304 + 64 * (j))
#define XB_TOP      3328
#define XB_TOPGEN   3392
#define XCD_BAR_WORDS 3456
#define XB_SPIN_CAP (1u << 20)
#define LAS __attribute__((address_space(3)))
__device__ __forceinline__ unsigned xb_ld(unsigned* p)              { return __hip_atomic_load(p, __ATOMIC_RELAXED, __HIP_MEMORY_SCOPE_AGENT); }
__device__ __forceinline__ unsigned xb_add(unsigned* p, unsigned v) { return __hip_atomic_fetch_add(p, v, __ATOMIC_RELAXED, __HIP_MEMORY_SCOPE_AGENT); }
__device__ __forceinline__ unsigned xb_xcc_id() { return (unsigned)__builtin_amdgcn_s_getreg((3 << 11) | 20) & 0xFu; }
#define XB_SPIN(cond, bar) do { unsigned _sp = 0; while (cond) { __builtin_amdgcn_s_sleep(1); \
    if ((++_sp & 255u) == 0u) { if (xb_ld(&(bar)[XB_TMO])) break; if (_sp > XB_SPIN_CAP) { atomicAdd(&(bar)[XB_TMO], 1u); break; } } } } while (0)
struct XcdBarrier { unsigned* bar; unsigned x; volatile LAS unsigned* st; };
__device__ __forceinline__ XcdBarrier xcd_barrier_post(unsigned* bar, volatile LAS unsigned* st) {
  XcdBarrier b; b.bar = bar; b.x = xb_xcc_id(); b.st = st;
  if (threadIdx.x == 0) (void)xb_add(&bar[XB_XCNT(b.x)], 1u);
  return b;
}
__device__ __forceinline__ void xcd_barrier_complete(unsigned* bar, unsigned x, unsigned& nloc, unsigned& nx) {
  const unsigned G = gridDim.x * gridDim.y * gridDim.z;
  unsigned sum, cnt, mine, sp = 0u;
  for (;;) {
    sum = 0u; cnt = 0u; mine = 0u;
#pragma unroll
    for (unsigned j = 0; j < 16; ++j) { const unsigned c = xb_ld(&bar[XB_XCNT(j)]); sum += c; cnt += (c > 0u) ? 1u : 0u; mine = (j == x) ? c : mine; }
    if (sum == G) break;
    __builtin_amdgcn_s_sleep(1);
    if ((++sp & 255u) == 0u) { if (xb_ld(&bar[XB_TMO])) break; if (sp > XB_SPIN_CAP) { atomicAdd(&bar[XB_TMO], 1u); break; } }
  }
  nloc = mine > 0u ? mine : 1u; nx = cnt > 0u ? cnt : 1u;
}
__device__ __forceinline__ void xcd_barrier(const XcdBarrier& b) {
  asm volatile("s_waitcnt vmcnt(0)" ::: "memory");
  __syncthreads();
  if (threadIdx.x == 0) {
    unsigned* bar = b.bar;
    __builtin_amdgcn_s_waitcnt(0);
    unsigned nloc = b.st[0], nx = b.st[1];
    if (nloc == 0u) { xcd_barrier_complete(bar, b.x, nloc, nx); b.st[0] = nloc; b.st[1] = nx; }
    const unsigned old = xb_add(&bar[XB_XSUB(b.x)], 1u);
    const unsigned gen = old / nloc;
    if (old + 1u == (gen + 1u) * nloc) {
      __builtin_amdgcn_fence(__ATOMIC_RELEASE, "agent");
      asm volatile("s_waitcnt vmcnt(0)" ::: "memory");
      const unsigned og = xb_add(&bar[XB_TOP], 1u);
      const unsigned tg = og / nx;
      if (og + 1u == (tg + 1u) * nx) xb_add(&bar[XB_TOPGEN], 1u);
      else XB_SPIN(xb_ld(&bar[XB_TOPGEN]) == tg, bar);
      __builtin_amdgcn_fence(__ATOMIC_ACQUIRE, "agent");
      xb_add(&bar[XB_XGEN(b.x)], 1u);
      asm volatile("s_waitcnt vmcnt(0)" ::: "memory");
    } else {
      XB_SPIN(xb_ld(&bar[XB_XGEN(b.x)]) == gen, bar);
      __builtin_amdgcn_fence(__ATOMIC_ACQUIRE, "agent");
      asm volatile("s_waitcnt vmcnt(0)" ::: "memory");
    }
  }
  __syncthreads();
}

#define SMEM_BYTES RWKV_SMEM
__global__ void __launch_bounds__(256, 2) mega(P p) {
  __shared__ __attribute__((aligned(16))) unsigned char smem[SMEM_BYTES + 16];
  cg::grid_group grid = cg::this_grid();
  const int vb = blockIdx.x, nvb = gridDim.x;
  if (threadIdx.x == 0) *(u32x4*)(smem + SMEM_BYTES) = (u32x4){0u, 0u, 0u, 0u};
  __syncthreads();
  const XcdBarrier xb = xcd_barrier_post(p.bar, (volatile LAS unsigned*)(smem + SMEM_BYTES));
  ph_mod(p, vb, nvb, smem);
  ph_transpose(p.w_in, p.Wt_in, DM, INC, vb, nvb, smem);
  ph_transpose(p.w_a_out, p.Wt_aout, DM, DM, vb, nvb, smem);
  ph_transpose(p.w_o, p.Wt_o, DM, DM, vb, nvb, smem);
  ph_transpose(p.peer_wq, p.Wt_q, DM, 2048, vb, nvb, smem);
  ph_transpose(p.g2, p.g2T, 128, 1024, vb, nvb, smem);
  ph_transpose(p.w2, p.w2T, 64, 1024, vb, nvb, smem);
  ph_transpose(p.w2 + 65536, p.w2T + 65536, 64, 1024, vb, nvb, smem);
  ph_transpose(p.a2, p.a2T, 64, 1024, vb, nvb, smem);
  ph_transpose(p.a2 + 65536, p.a2T + 65536, 64, 1024, vb, nvb, smem);
  ph_weff(p, vb, nvb);
  ph_convert(p.peer_keys, p.keys, (size_t)16 * 128 * 128, vb, nvb);
  grid.sync();
  ph_norm1(p, vb, nvb);
  xcd_barrier(xb);
  ph_gemm1(p, vb, nvb, smem);
  xcd_barrier(xb);
  ph_rwkv_A(p, vb, nvb, smem);
  xcd_barrier(xb);
  ph_rwkv_B(p, vb, nvb, smem);
  xcd_barrier(xb);
  ph_rwkv_C(p, vb, nvb, smem);
  ph_sg(p, vb, nvb);
  xcd_barrier(xb);
  ph_readout_gemm(p, vb, nvb, smem);
  ph_pool(p, vb, nvb, smem);
  ph_cvt_fp8(p.peer_u, p.ub8, p.us, vb, nvb);
  ph_cvt_fp8(p.peer_v, p.vb8, p.vs, vb, nvb);
  xcd_barrier(xb);
  ph_gemm_merge(p, vb, nvb, smem);
  xcd_barrier(xb);
  ph_gemm_simple(p.mrg, DM, p.Wt_o, DM, DM, NTOK, DM, p.mix, DM, vb, nvb, smem);
  xcd_barrier(xb);
  ph_res1(p, vb, nvb);
  xcd_barrier(xb);
  ph_gemm_simple(p.hx2, DM, p.Wt_q, DM, DM, NTOK, 2048, p.q, 2048, vb, nvb, smem);
  xcd_barrier(xb);
  ph_peer_s1(p, vb, nvb, smem);
  xcd_barrier(xb);
  ph_peer_s2(p, vb, nvb);
  xcd_barrier(xb);
  ph_peer_gather(p, vb, nvb);
}

extern "C" void kernel_launch(void* const* d_in, const int* in_sizes, int n_in, void* d_out, int out_size, void* d_ws, size_t ws_size, hipStream_t stream) {
  P p{};
  const float** f = (const float**)&p;
  for (int i = 0; i < 32; ++i) f[i] = (const float*)d_in[i];
  p.out = (float*)d_out;
  p.bar = (unsigned*)((unsigned char*)d_ws + 511 * 1048576);
  unsigned char* w = (unsigned char*)d_ws;
  const size_t MiB = 1048576;
  const size_t HM = 524288;
  p.hx = (bf16_t*)(w + 0 * MiB);
  p.zA = (bf16_t*)(w + 65 * MiB);
  p.zP = (bf16_t*)(w + 569 * HM);
  p.zG = (bf16_t*)d_out;
  unsigned char* rw = w + 633 * HM;
  p.Wt_in = (bf16_t*)rw; rw += 12 * MiB;
  p.Wt_aout = (bf16_t*)rw; rw += 2 * MiB;
  p.Wt_eff = (bf16_t*)rw; rw += 1 * MiB;
  p.Wt_o = (bf16_t*)rw; rw += 2 * MiB;
  p.Wt_q = (bf16_t*)rw; rw += 4 * MiB;
  p.keys = (bf16_t*)rw; rw += HM;
  p.mod = (float*)rw; rw += HM;
  p.g2T = (bf16_t*)rw; rw += HM;
  p.w2T = (bf16_t*)rw; rw += HM;
  p.a2T = (bf16_t*)rw; rw += HM;
  p.Y0 = (bf16_t*)(w + 0 * MiB);
  p.Y1 = (bf16_t*)(w + 340 * MiB);
  p.bdot = (float*)(w + 404 * MiB);
  p.Mst = (bf16_t*)(w + 408 * MiB);
  p.sg = (bf16_t*)(w + 408 * MiB);
  p.Nst = (float*)(w + 441 * MiB);
  p.ub8 = w + 416 * MiB;
  p.vb8 = w + 432 * MiB;
  p.us = (float*)(w + 448 * MiB);
  p.vs = (float*)(w + 449 * MiB);
  p.pooled = (bf16_t*)(w + 478 * MiB);
  p.out_a = (bf16_t*)(w + 0 * MiB);
  p.ya = (bf16_t*)(w + 65 * MiB);
  p.yb = (bf16_t*)(w + 129 * MiB);
  p.mrg = (bf16_t*)(w + 193 * MiB);
  p.mix = (bf16_t*)(w + 65 * MiB);
  p.hx2 = (bf16_t*)(w + 0 * MiB);
  p.q = (bf16_t*)(w + 129 * MiB);
  p.sv = (float*)(w + 340 * MiB);
  p.si = (int*)(w + 372 * MiB);
  p.pidx = (int*)(w + 257 * MiB);
  p.pgate = (float*)(w + 273 * MiB);
  static int grid_blocks = 0;
  if (!grid_blocks) {
    int dev = 0, cus = 0, per_cu = 0;
    hipGetDevice(&dev);
    hipDeviceGetAttribute(&cus, hipDeviceAttributeMultiprocessorCount, dev);
    hipOccupancyMaxActiveBlocksPerMultiprocessor(&per_cu, mega, 256, 0);
    if (per_cu > 2) per_cu = 2;
    if (per_cu < 1) per_cu = 1;
    grid_blocks = cus * per_cu;
  }
  hipMemsetAsync(p.bar, 0, XCD_BAR_WORDS * 4, stream);
  void* args[] = {&p};
  hipError_t e = hipLaunchCooperativeKernel((void*)mega, dim3(grid_blocks), dim3(256), args, 0, stream);
  if (e != hipSuccess) fprintf(stderr, "cooperative launch failed: %s (grid %d)\n", hipGetErrorString(e), grid_blocks);
}
```

```cpp
#include <hip/hip_runtime.h>
#include <hip/hip_cooperative_groups.h>
#include <stdint.h>
#include <cstdio>
namespace cg = cooperative_groups;

typedef unsigned short bf16_t;
typedef short bf16x8 __attribute__((ext_vector_type(8)));
typedef float f32x4 __attribute__((ext_vector_type(4)));
typedef unsigned u32x4 __attribute__((ext_vector_type(4)));
typedef unsigned u32x2 __attribute__((ext_vector_type(2)));

#define NTOK 32768
#define SEQ 16384
#define CTXL 256
#define NCTX 512
#define MROWS 33280
#define DM 1024
#define SHIFTC 3456
#define INC 6016

typedef __bf16 hwbf2 __attribute__((ext_vector_type(2)));
typedef float hwf2 __attribute__((ext_vector_type(2)));
__device__ __forceinline__ unsigned pack2(float a, float b) { return __builtin_bit_cast(unsigned, __builtin_convertvector((hwf2){a, b}, hwbf2)); }
__device__ __forceinline__ bf16_t f2bf(float f) { return __builtin_bit_cast(unsigned short, (__bf16)f); }
__device__ __forceinline__ float bf2f(bf16_t h) { return __uint_as_float(((unsigned)h) << 16); }
__device__ __forceinline__ float bflo(unsigned u) { return __uint_as_float(u << 16); }
__device__ __forceinline__ float bfhi(unsigned u) { return __uint_as_float(u & 0xffff0000u); }
__device__ __forceinline__ float sigmoidf_(float x) { return 1.0f / (1.0f + __expf(-x)); }

__device__ __forceinline__ void load_shift8(const bf16_t* __restrict__ zA, const float* __restrict__ mu, int rowbase, int t, int T, int col0, float* o) {
  const u32x4 zc = *(const u32x4*)(zA + (size_t)(rowbase + t) * SHIFTC + col0);
  u32x4 zp = (u32x4){0u, 0u, 0u, 0u}, zn = (u32x4){0u, 0u, 0u, 0u};
  if (t > 0) zp = *(const u32x4*)(zA + (size_t)(rowbase + t - 1) * SHIFTC + col0);
  if (t < T - 1) zn = *(const u32x4*)(zA + (size_t)(rowbase + t + 1) * SHIFTC + col0);
  const unsigned c[4] = {zc.x, zc.y, zc.z, zc.w}, pv[4] = {zp.x, zp.y, zp.z, zp.w}, nv[4] = {zn.x, zn.y, zn.z, zn.w};
  const f32x4 m0 = *(const f32x4*)(mu + col0), m1 = *(const f32x4*)(mu + col0 + 4);
  const float mm[8] = {m0[0], m0[1], m0[2], m0[3], m1[0], m1[1], m1[2], m1[3]};
#pragma unroll
  for (int i = 0; i < 4; ++i) {
    const float z0 = bflo(c[i]), z1 = bfhi(c[i]);
    o[2 * i] = z0 + mm[2 * i] * (0.5f * (bflo(pv[i]) + bflo(nv[i])) - z0);
    o[2 * i + 1] = z1 + mm[2 * i + 1] * (0.5f * (bfhi(pv[i]) + bfhi(nv[i])) - z1);
  }
}
__device__ __forceinline__ void load8(const bf16_t* __restrict__ zA, int row, int col0, float* o) {
  const u32x4 zc = *(const u32x4*)(zA + (size_t)row * SHIFTC + col0);
#pragma unroll
  for (int i = 0; i < 4; ++i) { o[2 * i] = bflo(zc[i]); o[2 * i + 1] = bfhi(zc[i]); }
}
__device__ __forceinline__ void load_shift4(const bf16_t* __restrict__ zA, const float* __restrict__ mu, int rowbase, int t, int T, int col0, float* o) {
  const u32x2 zc = *(const u32x2*)(zA + (size_t)(rowbase + t) * SHIFTC + col0);
  u32x2 zp = (u32x2){0u, 0u}, zn = (u32x2){0u, 0u};
  if (t > 0) zp = *(const u32x2*)(zA + (size_t)(rowbase + t - 1) * SHIFTC + col0);
  if (t < T - 1) zn = *(const u32x2*)(zA + (size_t)(rowbase + t + 1) * SHIFTC + col0);
#pragma unroll
  for (int i = 0; i < 2; ++i) {
    const float z0 = bflo(zc[i]), z1 = bfhi(zc[i]);
    o[2 * i] = z0 + mu[col0 + 2 * i] * (0.5f * (bflo(zp[i]) + bflo(zn[i])) - z0);
    o[2 * i + 1] = z1 + mu[col0 + 2 * i + 1] * (0.5f * (bfhi(zp[i]) + bfhi(zn[i])) - z1);
  }
}
__device__ __forceinline__ float red16(float v) {
  v += __shfl_xor(v, 1); v += __shfl_xor(v, 2); v += __shfl_xor(v, 4); v += __shfl_xor(v, 8);
  return v;
}
__device__ __forceinline__ float red8(float v) {
  v += __shfl_xor(v, 1); v += __shfl_xor(v, 2); v += __shfl_xor(v, 4);
  return v;
}

struct P {
  const float *x, *c, *ctx, *c_ctx, *w_mod, *b_mod, *g_pre_mix, *g_post_mix, *g_pre_ffn, *g_post_ffn, *w_in, *b_gate, *mu_shift,
      *w0, *w2, *a0, *a2, *g2, *k_k, *k_a, *r_k, *ln_x_w, *ln_x_b, *w_a_out, *w_pool, *pool_scale, *w_b_out, *w_o, *peer_wq,
      *peer_keys, *peer_u, *peer_v;
  float* out;
  unsigned* bar;
  bf16_t* hx;
  bf16_t* zA;
  bf16_t* zP;
  bf16_t* zG;
  bf16_t* Wt_in;
  bf16_t* Wt_aout;
  bf16_t* Wt_eff;
  bf16_t* Wt_o;
  bf16_t* Wt_q;
  bf16_t* keys;
  float* mod;
  unsigned char* ub8;
  unsigned char* vb8;
  float* us;
  float* vs;
  bf16_t* sg;
  bf16_t* g2T;
  bf16_t* w2T;
  bf16_t* a2T;
  bf16_t* Mst;
  float* Nst;
  bf16_t* Y0;
  bf16_t* Y1;
  float* bdot;
  bf16_t* out_a;
  bf16_t* ya;
  bf16_t* pooled;
  bf16_t* yb;
  bf16_t* mrg;
  bf16_t* mix;
  bf16_t* hx2;
  bf16_t* q;
  float* sv;
  int* si;
  int* pidx;
  float* pgate;
};

#define GS 72
#define GEMM_SMEM (2 * 128 * GS * 2)
template <class Epi>
__device__ __forceinline__ void gemm_tile(const bf16_t* __restrict__ A, int lda, const bf16_t* __restrict__ Bt, int ldb, int K, int m0, int n0,
                                          const Epi& epi, unsigned char* smem) {
  const int tid = threadIdx.x, lane = tid & 63, wid = tid >> 6, wr = wid >> 1, wc = wid & 1;
  bf16_t* sA = (bf16_t*)smem;
  bf16_t* sB = sA + 128 * GS;
  f32x4 acc[4][4];
#pragma unroll
  for (int i = 0; i < 4; ++i)
#pragma unroll
    for (int j = 0; j < 4; ++j) acc[i][j] = (f32x4){0.f, 0.f, 0.f, 0.f};
  const int lrow = tid >> 3, lcol = (tid & 7) * 8;
  const bf16_t* pa = A + (size_t)(m0 + lrow) * lda + lcol;
  const bf16_t* pb = Bt + (size_t)(n0 + lrow) * ldb + lcol;
  u32x4 ra[4], rb[4];
#pragma unroll
  for (int p = 0; p < 4; ++p) {
    ra[p] = *(const u32x4*)(pa + (size_t)(32 * p) * lda);
    rb[p] = *(const u32x4*)(pb + (size_t)(32 * p) * ldb);
  }
  for (int k0 = 0; k0 < K; k0 += 64) {
#pragma unroll
    for (int p = 0; p < 4; ++p) {
      *(u32x4*)(sA + (lrow + 32 * p) * GS + lcol) = ra[p];
      *(u32x4*)(sB + (lrow + 32 * p) * GS + lcol) = rb[p];
    }
    __syncthreads();
    if (k0 + 64 < K) {
#pragma unroll
      for (int p = 0; p < 4; ++p) {
        ra[p] = *(const u32x4*)(pa + (size_t)(32 * p) * lda + k0 + 64);
        rb[p] = *(const u32x4*)(pb + (size_t)(32 * p) * ldb + k0 + 64);
      }
    }
#pragma unroll
    for (int kk = 0; kk < 2; ++kk) {
      bf16x8 af[4], bfr[4];
#pragma unroll
      for (int i = 0; i < 4; ++i) af[i] = *(const bf16x8*)(sA + (wr * 64 + i * 16 + (lane & 15)) * GS + kk * 32 + (lane >> 4) * 8);
#pragma unroll
      for (int j = 0; j < 4; ++j) bfr[j] = *(const bf16x8*)(sB + (wc * 64 + j * 16 + (lane & 15)) * GS + kk * 32 + (lane >> 4) * 8);
#pragma unroll
      for (int i = 0; i < 4; ++i)
#pragma unroll
        for (int j = 0; j < 4; ++j) acc[i][j] = __builtin_amdgcn_mfma_f32_16x16x32_bf16(bfr[j], af[i], acc[i][j], 0, 0, 0);
    }
    __syncthreads();
  }
#pragma unroll
  for (int i = 0; i < 4; ++i)
#pragma unroll
    for (int j = 0; j < 4; ++j) epi(m0 + wr * 64 + i * 16 + (lane & 15), n0 + wc * 64 + j * 16 + (lane >> 4) * 4, acc[i][j]);
}

#define G2S 40
#define GEMM2_SMEM (2 * (256 + 128) * G2S * 2)
template <class Epi>
__device__ __forceinline__ void gemm_tile2(const bf16_t* __restrict__ A, int lda, const bf16_t* __restrict__ Bt, int ldb, int K, int m0, int n0,
                                           const Epi& epi, unsigned char* smem) {
  const int tid = threadIdx.x, lane = tid & 63, wid = tid >> 6, wr = wid >> 1, wc = wid & 1, l15 = lane & 15, q = lane >> 4;
  bf16_t* sA = (bf16_t*)smem;
  bf16_t* sB = sA + 2 * 256 * G2S;
  f32x4 acc[8][4];
#pragma unroll
  for (int i = 0; i < 8; ++i)
#pragma unroll
    for (int j = 0; j < 4; ++j) acc[i][j] = (f32x4){0.f, 0.f, 0.f, 0.f};
  const int lrow = tid >> 2, lcol = (tid & 3) * 8;
  const bf16_t* pa = A + (size_t)(m0 + lrow) * lda + lcol;
  const bf16_t* pb = Bt + (size_t)(n0 + lrow) * ldb + lcol;
  u32x4 ra[4], rb[2];
#pragma unroll
  for (int pp = 0; pp < 4; ++pp) ra[pp] = *(const u32x4*)(pa + (size_t)(64 * pp) * lda);
#pragma unroll
  for (int pp = 0; pp < 2; ++pp) rb[pp] = *(const u32x4*)(pb + (size_t)(64 * pp) * ldb);
  __syncthreads();
#pragma unroll
  for (int pp = 0; pp < 4; ++pp) *(u32x4*)(sA + (lrow + 64 * pp) * G2S + lcol) = ra[pp];
#pragma unroll
  for (int pp = 0; pp < 2; ++pp) *(u32x4*)(sB + (lrow + 64 * pp) * G2S + lcol) = rb[pp];
  __syncthreads();
  const int nk = K >> 5;
  for (int kt = 0; kt < nk; ++kt) {
    const int cur = kt & 1;
    const bf16_t* cA = sA + cur * 256 * G2S;
    const bf16_t* cB = sB + cur * 128 * G2S;
    if (kt + 1 < nk) {
#pragma unroll
      for (int pp = 0; pp < 4; ++pp) ra[pp] = *(const u32x4*)(pa + (size_t)(64 * pp) * lda + (kt + 1) * 32);
#pragma unroll
      for (int pp = 0; pp < 2; ++pp) rb[pp] = *(const u32x4*)(pb + (size_t)(64 * pp) * ldb + (kt + 1) * 32);
    }
    bf16x8 bfr[4];
#pragma unroll
    for (int j = 0; j < 4; ++j) bfr[j] = *(const bf16x8*)(cB + (wc * 64 + j * 16 + l15) * G2S + q * 8);
#pragma unroll
    for (int i = 0; i < 8; ++i) {
      const bf16x8 af = *(const bf16x8*)(cA + (wr * 128 + i * 16 + l15) * G2S + q * 8);
#pragma unroll
      for (int j = 0; j < 4; ++j) acc[i][j] = __builtin_amdgcn_mfma_f32_16x16x32_bf16(bfr[j], af, acc[i][j], 0, 0, 0);
    }
    if (kt + 1 < nk) {
      bf16_t* nA = sA + (cur ^ 1) * 256 * G2S;
      bf16_t* nB = sB + (cur ^ 1) * 128 * G2S;
#pragma unroll
      for (int pp = 0; pp < 4; ++pp) *(u32x4*)(nA + (lrow + 64 * pp) * G2S + lcol) = ra[pp];
#pragma unroll
      for (int pp = 0; pp < 2; ++pp) *(u32x4*)(nB + (lrow + 64 * pp) * G2S + lcol) = rb[pp];
    }
    __syncthreads();
  }
#pragma unroll
  for (int i = 0; i < 8; ++i)
#pragma unroll
    for (int j = 0; j < 4; ++j) epi(m0 + wr * 128 + i * 16 + l15, n0 + wc * 64 + j * 16 + q * 4, acc[i][j]);
}

#define G3_STAGE 24576
#define G3_ES 136
#define GEMM3_SMEM (256 * G3_ES * 2)
typedef __attribute__((address_space(3))) unsigned lds_u32;
template <class Epi>
__device__ __forceinline__ void gemm_tile3(const bf16_t* __restrict__ A, int lda, const bf16_t* __restrict__ Bt, int ldb, int K, int m0, int n0,
                                           const Epi& epi, unsigned char* smem) {
  int tid = threadIdx.x;
  asm volatile("" : "+v"(tid));
  const int lane = tid & 63, wid = __builtin_amdgcn_readfirstlane(tid >> 6), wr = wid >> 1, wc = wid & 1, l15 = lane & 15, q = lane >> 4;
  f32x4 acc[8][4];
#pragma unroll
  for (int i = 0; i < 8; ++i)
#pragma unroll
    for (int j = 0; j < 4; ++j) acc[i][j] = (f32x4){0.f, 0.f, 0.f, 0.f};
  const int gr = lane >> 2, gc = ((lane & 3) ^ (((gr >> 2) & 1) << 1)) * 8;
  const bf16_t* pa = A + (long)(m0 + wid * 64 + gr) * lda + gc;
  const bf16_t* pb = Bt + (size_t)(n0 + wid * 32 + gr) * ldb + gc;
  unsigned char* dA = smem + wid * 4096 + lane * 16;
  unsigned char* dB = smem + 16384 + wid * 2048 + lane * 16;
  const int sw = (q ^ (((l15 >> 2) & 1) << 1)) * 16;
  const unsigned char* fA = smem + (wr * 128 + l15) * 64 + sw;
  const unsigned char* fB = smem + 16384 + (wc * 64 + l15) * 64 + sw;
#define G3_ISSUE(ST, KT) { _Pragma("unroll") for (int ii = 0; ii < 4; ++ii) __builtin_amdgcn_global_load_lds((const unsigned*)(pa + (size_t)(16 * ii) * lda + (KT) * 32), (lds_u32*)(dA + (ST) * G3_STAGE + ii * 1024), 16, 0, 0); \
                           _Pragma("unroll") for (int ii = 0; ii < 2; ++ii) __builtin_amdgcn_global_load_lds((const unsigned*)(pb + (size_t)(16 * ii) * ldb + (KT) * 32), (lds_u32*)(dB + (ST) * G3_STAGE + ii * 1024), 16, 0, 0); }
  const int nk = K >> 5;
  __syncthreads();
  G3_ISSUE(0, 0);
  for (int kt = 0; kt < nk; ++kt) {
    const int cur = kt & 1;
    asm volatile("s_waitcnt vmcnt(0)" ::: "memory");
    __syncthreads();
    if (kt + 1 < nk) G3_ISSUE(cur ^ 1, kt + 1);
    const unsigned char* cA = fA + cur * G3_STAGE;
    const unsigned char* cB = fB + cur * G3_STAGE;
    bf16x8 bfr[4];
#pragma unroll
    for (int j = 0; j < 4; ++j) bfr[j] = *(const bf16x8*)(cB + j * 1024);
#pragma unroll
    for (int i = 0; i < 8; ++i) {
      const bf16x8 af = *(const bf16x8*)(cA + i * 1024);
#pragma unroll
      for (int j = 0; j < 4; ++j) acc[i][j] = __builtin_amdgcn_mfma_f32_16x16x32_bf16(bfr[j], af, acc[i][j], 0, 0, 0);
    }
  }
#undef G3_ISSUE
  bf16_t* sE = (bf16_t*)smem;
  __syncthreads();
#pragma unroll
  for (int i = 0; i < 8; ++i)
#pragma unroll
    for (int j = 0; j < 4; ++j) {
      u32x2 w; w.x = pack2(acc[i][j][0], acc[i][j][1]); w.y = pack2(acc[i][j][2], acc[i][j][3]);
      *(u32x2*)(sE + (wr * 128 + i * 16 + l15) * G3_ES + wc * 64 + j * 16 + q * 4) = w;
    }
  __syncthreads();
  epi.finish(sE, m0, n0, tid);
}
template <class D> struct Epi3RowChunks {
  __device__ __forceinline__ void finish(const bf16_t* sE, int m0, int n0, int tid) const {
#pragma unroll
    for (int pp = 0; pp < 16; ++pp) {
      const int id = tid + 256 * pp, row = id >> 4, cc = (id & 15) * 8;
      static_cast<const D*>(this)->store(m0 + row, n0 + cc, *(const u32x4*)(sE + row * G3_ES + cc));
    }
  }
};
struct Epi3StoreBf16 : Epi3RowChunks<Epi3StoreBf16> {
  bf16_t* C; int ldc;
  __device__ Epi3StoreBf16(bf16_t* c, int l) : C(c), ldc(l) {}
  __device__ __forceinline__ void store(int m, int n, const u32x4& v) const { *(u32x4*)(C + (size_t)m * ldc + n) = v; }
};
struct Epi3GateA : Epi3RowChunks<Epi3GateA> {
  const bf16_t* zG; const float* bg; bf16_t* mrg;
  __device__ Epi3GateA(const bf16_t* z, const float* b, bf16_t* m) : zG(z), bg(b), mrg(m) {}
  __device__ __forceinline__ void store(int m, int n, const u32x4& v) const {
    const u32x4 g = *(const u32x4*)(zG + (size_t)m * 2048 + n);
    const f32x4 b0 = *(const f32x4*)(bg + n), b1 = *(const f32x4*)(bg + n + 4);
    u32x4 o;
#pragma unroll
    for (int i = 0; i < 4; ++i) {
      const float bl = i < 2 ? b0[2 * i] : b1[2 * i - 4], bh = i < 2 ? b0[2 * i + 1] : b1[2 * i - 3];
      o[i] = pack2(sigmoidf_(bflo(g[i]) + bl) * bflo(v[i]), sigmoidf_(bfhi(g[i]) + bh) * bfhi(v[i]));
    }
    *(u32x4*)(mrg + (size_t)m * DM + n) = o;
  }
};
struct Epi3GateB : Epi3RowChunks<Epi3GateB> {
  const bf16_t* zG; const float* bg; bf16_t* mrg;
  __device__ Epi3GateB(const bf16_t* z, const float* b, bf16_t* m) : zG(z), bg(b), mrg(m) {}
  __device__ __forceinline__ void store(int m, int n, const u32x4& v) const {
    const u32x4 g = *(const u32x4*)(zG + (size_t)m * 2048 + 1024 + n);
    const u32x4 a = *(const u32x4*)(mrg + (size_t)m * DM + n);
    const f32x4 b0 = *(const f32x4*)(bg + 1024 + n), b1 = *(const f32x4*)(bg + 1024 + n + 4);
    u32x4 o;
#pragma unroll
    for (int i = 0; i < 4; ++i) {
      const float bl = i < 2 ? b0[2 * i] : b1[2 * i - 4], bh = i < 2 ? b0[2 * i + 1] : b1[2 * i - 3];
      o[i] = pack2(bflo(a[i]) + sigmoidf_(bflo(g[i]) + bl) * bflo(v[i]), bfhi(a[i]) + sigmoidf_(bfhi(g[i]) + bh) * bfhi(v[i]));
    }
    *(u32x4*)(mrg + (size_t)m * DM + n) = o;
  }
};
struct Epi3ZS {
  bf16_t* zA; const float* mu; int own_lo, own_hi, t0, T;
  __device__ __forceinline__ void finish(const bf16_t* sE, int m0, int n0, int tid) const {
#pragma unroll 4
    for (int pq = 0; pq < 16; ++pq) {
      const int id = tid + 256 * pq, row = id >> 4, cc = (id & 15) * 8, t = t0 + row;
      if (row < own_lo || row > own_hi) continue;
      const u32x4 zc = *(const u32x4*)(sE + row * G3_ES + cc);
      u32x4 zp = (u32x4){0u, 0u, 0u, 0u}, zn = (u32x4){0u, 0u, 0u, 0u};
      if (t > 0) zp = *(const u32x4*)(sE + (row - 1) * G3_ES + cc);
      if (t < T - 1) zn = *(const u32x4*)(sE + (row + 1) * G3_ES + cc);
      const f32x4 m0v = *(const f32x4*)(mu + n0 + cc), m1v = *(const f32x4*)(mu + n0 + cc + 4);
      const float mm[8] = {m0v[0], m0v[1], m0v[2], m0v[3], m1v[0], m1v[1], m1v[2], m1v[3]};
      u32x4 o;
#pragma unroll
      for (int i = 0; i < 4; ++i) {
        const float z0 = bflo(zc[i]), z1 = bfhi(zc[i]);
        o[i] = pack2(z0 + mm[2 * i] * (0.5f * (bflo(zp[i]) + bflo(zn[i])) - z0), z1 + mm[2 * i + 1] * (0.5f * (bfhi(zp[i]) + bfhi(zn[i])) - z1));
      }
      *(u32x4*)(zA + (long)(m0 + row) * SHIFTC + n0 + cc) = o;
    }
  }
};
struct Epi3Z : Epi3RowChunks<Epi3Z> {
  bf16_t *zA, *zP, *zG;
  __device__ Epi3Z(bf16_t* a, bf16_t* b, bf16_t* c) : zA(a), zP(b), zG(c) {}
  __device__ __forceinline__ void store(int m, int n, const u32x4& v) const {
    if (n < SHIFTC) *(u32x4*)(zA + (size_t)m * SHIFTC + n) = v;
    else if (m < NTOK) {
      if (n < SHIFTC + 512) *(u32x4*)(zP + (size_t)m * 512 + (n - SHIFTC)) = v;
      else *(u32x4*)(zG + (size_t)m * 2048 + (n - SHIFTC - 512)) = v;
    }
  }
};

struct EpiStoreBf16 {
  bf16_t* C; int ldc;
  __device__ __forceinline__ void operator()(int m, int n, const f32x4& v) const {
    uint2 w; w.x = pack2(v[0], v[1]); w.y = pack2(v[2], v[3]);
    *(uint2*)(C + (size_t)m * ldc + n) = w;
  }
};
struct EpiZ {
  bf16_t *zA, *zP, *zG;
  __device__ __forceinline__ void operator()(int m, int n, const f32x4& v) const {
    uint2 w; w.x = pack2(v[0], v[1]); w.y = pack2(v[2], v[3]);
    if (n < SHIFTC) *(uint2*)(zA + (size_t)m * SHIFTC + n) = w;
    else if (m < NTOK) {
      if (n < SHIFTC + 512) *(uint2*)(zP + (size_t)m * 512 + (n - SHIFTC)) = w;
      else *(uint2*)(zG + (size_t)m * 2048 + (n - SHIFTC - 512)) = w;
    }
  }
};
struct EpiLds {
  float* S;
  __device__ __forceinline__ void operator()(int m, int n, const f32x4& v) const {
    float* r = S + (m & 127) * 133 + n + (n >> 5);
    r[0] = v[0]; r[1] = v[1]; r[2] = v[2]; r[3] = v[3];
  }
};

__device__ __forceinline__ void ph_transpose(const float* __restrict__ in, bf16_t* __restrict__ out, int K, int N, int vb, int nvb, unsigned char* smem) {
  float* t = (float*)smem;
  const int tk = K / 32, tn = N / 32, tx = threadIdx.x & 31, ty = threadIdx.x >> 5;
  for (int it = vb; it < tk * tn; it += nvb) {
    const int k0 = (it / tn) * 32, n0 = (it % tn) * 32;
    __syncthreads();
#pragma unroll
    for (int r = 0; r < 4; ++r) t[(ty + 8 * r) * 33 + tx] = in[(size_t)(k0 + ty + 8 * r) * N + n0 + tx];
    __syncthreads();
#pragma unroll
    for (int r = 0; r < 4; ++r) out[(size_t)(n0 + ty + 8 * r) * K + k0 + tx] = f2bf(t[tx * 33 + ty + 8 * r]);
  }
}
__device__ __forceinline__ void ph_convert(const float* __restrict__ in, bf16_t* __restrict__ out, size_t n, int vb, int nvb) {
  for (size_t i = ((size_t)vb * 256 + threadIdx.x) * 4; i < n; i += (size_t)nvb * 1024) {
    const float4 v = *(const float4*)(in + i);
    uint2 w; w.x = pack2(v.x, v.y); w.y = pack2(v.z, v.w);
    *(uint2*)(out + i) = w;
  }
}
__device__ __forceinline__ void ph_weff(const P& p, int vb, int nvb) {
  for (int it = vb * 256 + threadIdx.x; it < 512 * 1024; it += nvb * 256) {
    const int n = it & 1023, k = it >> 10, j = k >> 7, kl = k & 127;
    const float* wp = p.w_pool + ((size_t)j * 128 + kl) * 128;
    float s = 0.f;
    for (int c = 0; c < 128; ++c) s += wp[c] * p.pool_scale[j * 128 + c] * p.w_b_out[(size_t)(j * 128 + c) * 1024 + n];
    p.Wt_eff[(size_t)n * 512 + k] = f2bf(s);
  }
}
__device__ __forceinline__ void ph_mod(const P& p, int vb, int nvb, unsigned char* smem) {
  float* red = (float*)smem;
  const int lane = threadIdx.x & 63, wid = threadIdx.x >> 6;
  for (int it = vb; it < 96; it += nvb) {
    const int n = it * 64 + lane;
    float a0 = 0.f, a1 = 0.f, a2 = 0.f;
#pragma unroll 8
    for (int k = wid * 256; k < wid * 256 + 256; ++k) {
      const float w = p.w_mod[(size_t)k * 6144 + n];
      const float c0 = p.c[k], c1 = p.c[1024 + k], c2 = p.c_ctx[k];
      a0 += c0 * sigmoidf_(c0) * w; a1 += c1 * sigmoidf_(c1) * w; a2 += c2 * sigmoidf_(c2) * w;
    }
    __syncthreads();
    red[(wid * 3 + 0) * 64 + lane] = a0; red[(wid * 3 + 1) * 64 + lane] = a1; red[(wid * 3 + 2) * 64 + lane] = a2;
    __syncthreads();
    if (wid < 3) {
      const float sum = red[(0 * 3 + wid) * 64 + lane] + red[(1 * 3 + wid) * 64 + lane] + red[(2 * 3 + wid) * 64 + lane] + red[(3 * 3 + wid) * 64 + lane];
      p.mod[wid * 6144 + n] = sum + p.b_mod[n];
    }
  }
}
__device__ __forceinline__ float wave_sum(float v) {
#pragma unroll
  for (int o = 32; o > 0; o >>= 1) v += __shfl_xor(v, o);
  return v;
}
__device__ __forceinline__ void ph_norm1(const P& p, int vb, int nvb) {
  const int lane = threadIdx.x & 63, wid = threadIdx.x >> 6;
  for (int m = vb * 4 + wid; m < MROWS; m += nvb * 4) {
    const float* src = m < NTOK ? p.x + (size_t)m * DM : p.ctx + (size_t)(m - NTOK) * DM;
    const float* md = p.mod + (m < NTOK ? (m / SEQ) : 2) * 6144;
    float4 v[4]; float ss = 0.f;
#pragma unroll
    for (int i = 0; i < 4; ++i) { v[i] = *(const float4*)(src + i * 256 + lane * 4); ss += v[i].x * v[i].x + v[i].y * v[i].y + v[i].z * v[i].z + v[i].w * v[i].w; }
    ss = wave_sum(ss);
    const float rstd = rsqrtf(ss * (1.0f / 1024.0f) + 1e-6f);
#pragma unroll
    for (int i = 0; i < 4; ++i) {
      const int col = i * 256 + lane * 4;
      const float4 g = *(const float4*)(p.g_pre_mix + col), sh = *(const float4*)(md + col), sc = *(const float4*)(md + 1024 + col);
      uint2 w;
      w.x = pack2(v[i].x * rstd * g.x * (1.f + sc.x) + sh.x, v[i].y * rstd * g.y * (1.f + sc.y) + sh.y);
      w.y = pack2(v[i].z * rstd * g.z * (1.f + sc.z) + sh.z, v[i].w * rstd * g.w * (1.f + sc.w) + sh.w);
      *(uint2*)(p.hx + (size_t)m * DM + col) = w;
    }
  }
}
struct Epi3Readout {
  const P* pp;
  __device__ __forceinline__ void finish(const bf16_t* sE, int m0, int n0, int tid) const {
    const P& p = *pp;
#pragma unroll 2
    for (int pq = 0; pq < 16; ++pq) {
      const int id = tid + 256 * pq, row = id >> 4, cc = (id & 15) * 8, m = m0 + row, n = n0 + cc, t = m % SEQ, h = n >> 6;
      const u32x4 g = *(const u32x4*)(sE + row * G3_ES + cc);
      const u32x4 y0 = *(const u32x4*)(p.Y0 + (size_t)m * DM + n), y1 = *(const u32x4*)(p.Y1 + (size_t)m * DM + n);
      float y[8], v[8];
#pragma unroll
      for (int i = 0; i < 4; ++i) { y[2 * i] = bflo(y0[i]) + bflo(y1[i]); y[2 * i + 1] = bfhi(y0[i]) + bfhi(y1[i]); }
      float sm = 0.f;
#pragma unroll
      for (int i = 0; i < 8; ++i) sm += y[i];
      const float mu = red8(sm) * (1.f / 64.f);
      float qv = 0.f;
#pragma unroll
      for (int i = 0; i < 8; ++i) { y[i] -= mu; qv += y[i] * y[i]; }
      const float rs = rsqrtf(red8(qv) * (1.f / 64.f) + 64e-5f);
      load8(p.zA, m, 2048 + n, v);
      const float bon = 0.5f * (p.bdot[(size_t)m * 16 + h] + p.bdot[((size_t)NTOK + m) * 16 + h]);
      const f32x4 w0 = *(const f32x4*)(p.ln_x_w + n), w1 = *(const f32x4*)(p.ln_x_w + n + 4), b0 = *(const f32x4*)(p.ln_x_b + n), b1 = *(const f32x4*)(p.ln_x_b + n + 4);
      const float lw[8] = {w0[0], w0[1], w0[2], w0[3], w1[0], w1[1], w1[2], w1[3]}, lb[8] = {b0[0], b0[1], b0[2], b0[3], b1[0], b1[1], b1[2], b1[3]};
      u32x4 o;
#pragma unroll
      for (int i = 0; i < 4; ++i)
        o[i] = pack2((y[2 * i] * rs * lw[2 * i] + lb[2 * i] + bon * v[2 * i]) * bflo(g[i]), (y[2 * i + 1] * rs * lw[2 * i + 1] + lb[2 * i + 1] + bon * v[2 * i + 1]) * bfhi(g[i]));
      *(u32x4*)(p.out_a + (size_t)m * DM + n) = o;
    }
  }
};
__device__ __forceinline__ int xcd_tile(int vb, int nvb, int round, int TM, int TN, int& tm, int& tn) {
  if (nvb % 64 != 0) { const int it = round * nvb + vb; if (it >= TM * TN) return 0; tm = it % TM; tn = it / TM; return 1; }
  const int spg = nvb >> 3, g = vb & 7, slot = vb >> 3, SC = spg >> 3;
  const int nsr = (TM + 7) >> 3, nsc = (TN + SC - 1) / SC, st = round * 8 + g;
  if (st >= nsr * nsc) return 0;
  tm = (st % nsr) * 8 + (slot & 7); tn = (st / nsr) * SC + (slot >> 3);
  return (tm < TM && tn < TN) ? 1 : 2;
}
__device__ __forceinline__ void ph_gemm1(const P& p, int vb, int nvb, unsigned char* smem) {
  const int NS_ = 132 * 27, NALL = NS_ + 128 * 20;
  const int per = nvb >> 3;
  for (int round = 0;; ++round) {
    int item;
    if ((nvb & 7) == 0) { const int blk = round * 8 + (vb & 7); if (blk * per >= NALL) break; item = blk * per + (vb >> 3); if (item >= NALL) continue; }
    else { item = round * nvb + vb; if (item >= NALL) break; }
    if (item < NS_) {
      const int cgp = item / (132 * 9), rem = item % (132 * 9), tmS = rem / 9, tn = cgp * 9 + rem % 9;
      Epi3ZS epi;
      epi.zA = p.zA; epi.mu = p.mu_shift;
      int m0;
      if (tmS < 130) { const int b = tmS / 65, i = tmS % 65; m0 = b * SEQ + 254 * i - 1; epi.own_lo = 1; epi.own_hi = min(254, SEQ - 254 * i); epi.t0 = 254 * i - 1; epi.T = SEQ; }
      else { m0 = NTOK + (tmS - 130) * CTXL; epi.own_lo = 0; epi.own_hi = 255; epi.t0 = 0; epi.T = CTXL; }
      gemm_tile3(p.hx, DM, p.Wt_in, DM, DM, m0, tn * 128, epi, smem);
    } else {
      const int i2 = item - NS_;
      int tm, tn;
      if (i2 < 2048) { tm = (i2 & 1023) >> 3; tn = 27 + (i2 >> 10) * 8 + (i2 & 7); } else { tm = (i2 - 2048) >> 2; tn = 43 + (i2 & 3); }
      Epi3Z epi{p.zA, p.zP, p.zG};
      gemm_tile3(p.hx, DM, p.Wt_in, DM, DM, tm * 256, tn * 128, epi, smem);
    }
  }
}
__device__ __forceinline__ void ph_readout_gemm(const P& p, int vb, int nvb, unsigned char* smem) {
  Epi3Readout epi{&p};
  for (int round = 0;; ++round) {
    int tm, tn; const int r = xcd_tile(vb, nvb, round, NTOK / 256, DM / 128, tm, tn);
    if (r == 0) break;
    if (r == 1) gemm_tile3(p.sg, 128, p.g2T, 128, 128, tm * 256, tn * 128, epi, smem);
  }
}
__device__ __forceinline__ void ph_sg(const P& p, int vb, int nvb) {
  for (int it = vb * 256 + threadIdx.x; it < NTOK * 16; it += nvb * 256) {
    const int m = it >> 4, l8 = (it & 15) * 8, t = m % SEQ;
    float o[8];
    load8(p.zA, m, 3328 + l8, o);
    u32x4 w;
#pragma unroll
    for (int i = 0; i < 4; ++i) w[i] = pack2(sigmoidf_(o[2 * i]), sigmoidf_(o[2 * i + 1]));
    *(u32x4*)(p.sg + (size_t)m * 128 + l8) = w;
  }
}
__device__ __forceinline__ void ph_gemm_merge(const P& p, int vb, int nvb, unsigned char* smem) {
  Epi3GateA ea{p.zG, p.b_gate, p.mrg};
  Epi3GateB eb{p.zG, p.b_gate, p.mrg};
  for (int round = 0;; ++round) {
    int tm, tn; const int r = xcd_tile(vb, nvb, round, NTOK / 256, DM / 128, tm, tn);
    if (r == 0) break;
    if (r == 1) {
      gemm_tile3(p.out_a, DM, p.Wt_aout, DM, DM, tm * 256, tn * 128, ea, smem);
      gemm_tile3(p.pooled, 512, p.Wt_eff, 512, 512, tm * 256, tn * 128, eb, smem);
    }
  }
}
__device__ __forceinline__ void ph_gemm_simple(const bf16_t* A, int lda, const bf16_t* Bt, int ldb, int K, int M, int N, bf16_t* C, int ldc, int vb, int nvb, unsigned char* smem) {
  Epi3StoreBf16 epi{C, ldc};
  for (int round = 0;; ++round) {
    int tm, tn; const int r = xcd_tile(vb, nvb, round, M / 256, N / 128, tm, tn);
    if (r == 0) break;
    if (r == 1) gemm_tile3(A, lda, Bt, ldb, K, tm * 256, tn * 128, epi, smem);
  }
}


#define O_R1 0
#define O_R2 10240
#define O_TA (O_R2 + 17408)
#define O_TR (O_TA + 4608)
#define O_TB (O_TR + 4608)
#define O_TK (O_TB + 4608)
#define O_TBT (O_TK + 4608)
#define O_TKT (O_TBT + 5120)
#define O_TVT (O_TKT + 5120)
#define O_GAM (O_TVT + 5120)
#define O_TST (O_GAM + 256)
#define RWKV_SMEM (O_TST + 2 * 9216)
#define NSUP 65
__device__ __forceinline__ void lds_wave_fence() { asm volatile("s_waitcnt lgkmcnt(0)" ::: "memory"); }
__device__ __forceinline__ u32x2 pack4(const f32x4& v) { u32x2 r; r.x = pack2(v[0], v[1]); r.y = pack2(v[2], v[3]); return r; }

struct RwkvConsts { bf16x8 w2f[2], a2f[2]; };

typedef short s16x4 __attribute__((ext_vector_type(4)));
__device__ __forceinline__ float fast_tanh(float x) { const float e = __expf(2.0f * x); return 1.0f - __fdividef(2.0f, e + 1.0f); }
template <int NS, bool WANTY>
__device__ __forceinline__ void rwkv_chunk(const P& p, unsigned char* smem, int d, int h, int rowbase, int T, int isc0, bool latent, f32x4 (&st)[NS][4], const RwkvConsts& cc) {
  int tid = threadIdx.x;
  asm volatile("" : "+v"(tid));
  const int lane = tid & 63, w = __builtin_amdgcn_readfirstlane(tid >> 6), l15 = lane & 15, q = lane >> 4;
  const int tt = tid >> 3, cg = tid & 7, ch0 = h * 64 + cg * 8;
  const int isc = isc0 + tt, t = d == 0 ? isc : T - 1 - isc;
  bf16_t* TWD = (bf16_t*)(smem + O_R1); bf16_t* TAD = TWD + 32 * 72;
  float* WT = (float*)(smem + O_R1);
  bf16_t* XT = (bf16_t*)(smem + O_R1); bf16_t* UT = XT + 64 * 40;
  float* LW = (float*)(smem + O_R2); float* LA = LW + 32 * 68;
  float* TL = (float*)(smem + O_R2);
  bf16_t* TT = (bf16_t*)(smem + O_R2 + 4608); bf16_t* TAK = TT + 32 * 40; bf16_t* TRB = TAK + 32 * 40; bf16_t* TRK = TRB + 32 * 40; bf16_t* TLB = TRK + 32 * 40;
  bf16_t* TA = (bf16_t*)(smem + O_TA); bf16_t* TR = (bf16_t*)(smem + O_TR); bf16_t* TB = (bf16_t*)(smem + O_TB); bf16_t* TK = (bf16_t*)(smem + O_TK);
  bf16_t* TBT = (bf16_t*)(smem + O_TBT); bf16_t* TKT = (bf16_t*)(smem + O_TKT); bf16_t* TVT = (bf16_t*)(smem + O_TVT);
  float* GAM = (float*)(smem + O_GAM);
  bf16_t* TST = (bf16_t*)(smem + O_TST);
  __syncthreads();
  float k8[8], r8[8];
  {
    float o[8];
    load8(p.zA, rowbase + t, 3072 + d * 64 + cg * 8, o);
    u32x4 pk; pk.x = pack2(fast_tanh(o[0]), fast_tanh(o[1])); pk.y = pack2(fast_tanh(o[2]), fast_tanh(o[3])); pk.z = pack2(fast_tanh(o[4]), fast_tanh(o[5])); pk.w = pack2(fast_tanh(o[6]), fast_tanh(o[7]));
    *(u32x4*)(TWD + tt * 72 + cg * 8) = pk;
    load8(p.zA, rowbase + t, 3200 + d * 64 + cg * 8, o);
    pk.x = pack2(o[0], o[1]); pk.y = pack2(o[2], o[3]); pk.z = pack2(o[4], o[5]); pk.w = pack2(o[6], o[7]);
    *(u32x4*)(TAD + tt * 72 + cg * 8) = pk;
  }
  load8(p.zA, rowbase + t, 1024 + ch0, k8);
  if (WANTY) load8(p.zA, rowbase + t, ch0, r8);
  __syncthreads();
  {
    f32x4 lw[2], la[2];
    bf16x8 w2f[2], a2f[2];
#pragma unroll
    for (int ks = 0; ks < 2; ++ks) {
      w2f[ks] = *(const bf16x8*)(p.w2T + ((size_t)d * 1024 + h * 64 + 16 * w + l15) * 64 + 32 * ks + 8 * q);
      a2f[ks] = *(const bf16x8*)(p.a2T + ((size_t)d * 1024 + h * 64 + 16 * w + l15) * 64 + 32 * ks + 8 * q);
    }
#pragma unroll
    for (int it = 0; it < 2; ++it) { lw[it] = (f32x4){0.f, 0.f, 0.f, 0.f}; la[it] = (f32x4){0.f, 0.f, 0.f, 0.f}; }
#pragma unroll
    for (int ks = 0; ks < 2; ++ks)
#pragma unroll
      for (int it = 0; it < 2; ++it) {
        const bf16x8 aw = *(const bf16x8*)(TWD + (16 * it + l15) * 72 + 32 * ks + 8 * q);
        const bf16x8 aa = *(const bf16x8*)(TAD + (16 * it + l15) * 72 + 32 * ks + 8 * q);
        lw[it] = __builtin_amdgcn_mfma_f32_16x16x32_bf16(aw, w2f[ks], lw[it], 0, 0, 0);
        la[it] = __builtin_amdgcn_mfma_f32_16x16x32_bf16(aa, a2f[ks], la[it], 0, 0, 0);
      }
    {
      const float cw0 = p.w0[d * 1024 + h * 64 + 16 * w + l15];
      float tot0 = 0.f;
#pragma unroll
      for (int it = 0; it < 2; ++it) {
        float pr[4];
#pragma unroll
        for (int rg = 0; rg < 4; ++rg) {
          const float xw = -(cw0 + lw[it][rg]);
          const float sp = fmaxf(xw, 0.f) + __logf(1.0f + __expf(-fabsf(xw)));
          const float e = __expf(-sp - 0.5f);
          pr[rg] = rg == 0 ? e : pr[rg - 1] + e;
        }
        float x = pr[3];
        float y = __shfl_up(x, 16); if (q >= 1) x += y;
        y = __shfl_up(x, 32); if (q >= 2) x += y;
        const float base = (x - pr[3]) + (it == 1 ? tot0 : 0.f);
        if (it == 0) tot0 = __shfl(x, 48 + l15);
#pragma unroll
        for (int rg = 0; rg < 4; ++rg) lw[it][rg] = pr[rg] + base;
      }
      if (q == 3) GAM[16 * w + l15] = __expf(-lw[1][3]);
    }
#pragma unroll
    for (int it = 0; it < 2; ++it)
#pragma unroll
      for (int rg = 0; rg < 4; ++rg) { LW[(16 * it + 4 * q + rg) * 68 + 16 * w + l15] = lw[it][rg]; LA[(16 * it + 4 * q + rg) * 68 + 16 * w + l15] = la[it][rg]; }
  }
  __syncthreads();
  float icl[8], kkn[8], kd[8];
  const u32x4 vzc = *(const u32x4*)(p.zA + (size_t)(rowbase + t) * SHIFTC + 2048 + ch0);
  {
    float ss = 0.f, bd = 0.f;
    float ca0[8], ckk[8], cka[8], crk[8];
#pragma unroll
    for (int e4 = 0; e4 < 8; e4 += 4) {
      const f32x4 b2 = *(const f32x4*)(p.a0 + d * 1024 + ch0 + e4), c2 = *(const f32x4*)(p.k_k + ch0 + e4);
      const f32x4 d2 = *(const f32x4*)(p.k_a + ch0 + e4), f2 = *(const f32x4*)(p.r_k + ch0 + e4);
#pragma unroll
      for (int e = 0; e < 4; ++e) { ca0[e4 + e] = b2[e]; ckk[e4 + e] = c2[e]; cka[e4 + e] = d2[e]; crk[e4 + e] = f2[e]; }
    }
#pragma unroll
    for (int e = 0; e < 8; ++e) {
      icl[e] = sigmoidf_(ca0[e] + LA[tt * 68 + cg * 8 + e]);
      kkn[e] = k8[e] * ckk[e]; ss += kkn[e] * kkn[e];
      kd[e] = k8[e] * (1.f + (icl[e] - 1.f) * cka[e]);
      if (WANTY) bd += r8[e] * kd[e] * crk[e];
    }
    ss = red8(ss); if (WANTY) bd = red8(bd);
    const float rn = rsqrtf(fmaxf(ss, 1e-24f));
#pragma unroll
    for (int e = 0; e < 8; ++e) kkn[e] *= rn;
    if (WANTY && cg == 0) p.bdot[((size_t)d * NTOK + rowbase + t) * 16 + h] = bd;
  }
  {
    float ta[8], tr[8], tb[8], tk[8], v8[8];
#pragma unroll
    for (int i = 0; i < 4; ++i) { v8[2 * i] = bflo(vzc[i]); v8[2 * i + 1] = bfhi(vzc[i]); }
#pragma unroll
    for (int e = 0; e < 8; ++e) {
      const float Li = LW[tt * 68 + cg * 8 + e];
      const float Lp = tt > 0 ? LW[(tt - 1) * 68 + cg * 8 + e] : 0.f;
      const float gi = __expf(-Li), gim1 = __expf(-Lp), ginv = __expf(Li);
      ta[e] = -kkn[e] * gim1; if (WANTY) tr[e] = r8[e] * gi; tb[e] = kkn[e] * icl[e] * ginv; tk[e] = kd[e] * ginv;
    }
    u32x4 pk;
    pk.x = pack2(ta[0], ta[1]); pk.y = pack2(ta[2], ta[3]); pk.z = pack2(ta[4], ta[5]); pk.w = pack2(ta[6], ta[7]); *(u32x4*)(TA + tt * 72 + cg * 8) = pk;
    if (WANTY) { pk.x = pack2(tr[0], tr[1]); pk.y = pack2(tr[2], tr[3]); pk.z = pack2(tr[4], tr[5]); pk.w = pack2(tr[6], tr[7]); *(u32x4*)(TR + tt * 72 + cg * 8) = pk; }
    pk.x = pack2(tb[0], tb[1]); pk.y = pack2(tb[2], tb[3]); pk.z = pack2(tb[4], tb[5]); pk.w = pack2(tb[6], tb[7]); *(u32x4*)(TB + tt * 72 + cg * 8) = pk;
    pk.x = pack2(tk[0], tk[1]); pk.y = pack2(tk[2], tk[3]); pk.z = pack2(tk[4], tk[5]); pk.w = pack2(tk[6], tk[7]); *(u32x4*)(TK + tt * 72 + cg * 8) = pk;
#pragma unroll
    for (int e = 0; e < 8; ++e) { TBT[(cg * 8 + e) * 40 + tt] = f2bf(tb[e]); TKT[(cg * 8 + e) * 40 + tt] = f2bf(tk[e]); TVT[(cg * 8 + e) * 40 + tt] = f2bf(v8[e]); }
  }
  __syncthreads();
  if (WANTY || w < 2) {
    const bf16_t* X = (w < 2) ? TA : TR; const bf16_t* Y = (w & 1) ? TK : TB;
    f32x4 g[2][2];
#pragma unroll
    for (int it = 0; it < 2; ++it)
#pragma unroll
      for (int s2 = 0; s2 < 2; ++s2) g[it][s2] = (f32x4){0.f, 0.f, 0.f, 0.f};
#pragma unroll
    for (int ks = 0; ks < 2; ++ks) {
      bf16x8 xa[2], yb[2];
#pragma unroll
      for (int it = 0; it < 2; ++it) { xa[it] = *(const bf16x8*)(X + (16 * it + l15) * 72 + 32 * ks + 8 * q); yb[it] = *(const bf16x8*)(Y + (16 * it + l15) * 72 + 32 * ks + 8 * q); }
#pragma unroll
      for (int it = 0; it < 2; ++it)
#pragma unroll
        for (int s2 = 0; s2 < 2; ++s2) g[it][s2] = __builtin_amdgcn_mfma_f32_16x16x32_bf16(xa[it], yb[s2], g[it][s2], 0, 0, 0);
    }
    bf16_t* dst = w == 1 ? TAK : (w == 2 ? TRB : TRK);
#pragma unroll
    for (int it = 0; it < 2; ++it)
#pragma unroll
      for (int s2 = 0; s2 < 2; ++s2)
#pragma unroll
        for (int rg = 0; rg < 4; ++rg) {
          const int i = 16 * it + 4 * q + rg, s = 16 * s2 + l15;
          const float val = g[it][s2][rg];
          if (w == 0) {
            TL[i * 36 + s] = (s < i) ? val : 0.f;
            if (it == 1 && s2 == 0) TLB[(i - 16) * 40 + s] = f2bf(val);
          } else dst[i * 40 + s] = f2bf(((w == 1) ? (s < i) : (s <= i)) ? val : 0.f);
        }
  }
  if (w == 0) {
    lds_wave_fence();
    const int c = lane & 15, hb = lane & 16;
    float Tr[16];
#pragma unroll
    for (int i = 0; i < 16; ++i) {
      float acc = (i == c) ? 1.f : 0.f;
#pragma unroll
      for (int j4 = 0; j4 < (i + 3) / 4; ++j4) {
        const f32x4 l4 = *(const f32x4*)(TL + (hb + i) * 36 + hb + 4 * j4);
#pragma unroll
        for (int jj = 0; jj < 4; ++jj) if (4 * j4 + jj < i) acc += l4[jj] * Tr[4 * j4 + jj];
      }
      Tr[i] = acc;
    }
    if (lane < 32) {
#pragma unroll
      for (int i = 0; i < 16; ++i) TT[(hb + i) * 40 + hb + c] = f2bf(Tr[i]);
    }
  }
  __syncthreads();
  const bf16x8 vfr = *(const bf16x8*)(TVT + (16 * w + l15) * 40 + 8 * q);
  const s16x4 t1f = *(const s16x4*)(TT + l15 * 40 + 4 * q), t2f = *(const s16x4*)(TT + (16 + l15) * 40 + 16 + 4 * q), l21f = *(const s16x4*)(TLB + l15 * 40 + 4 * q);
  bf16_t* XTw = XT + (16 * w + l15) * 40; bf16_t* UTw = UT + (16 * w + l15) * 40;
#pragma unroll
  for (int si = 0; si < NS; ++si) {
    const bool useV = (NS == 1) || (si == 1);
    const bf16_t* STs = TST + (si * 64 + 16 * w + l15) * 72;
    bf16x8 sf[2];
    sf[0] = *(const bf16x8*)(STs + 8 * q); sf[1] = *(const bf16x8*)(STs + 32 + 8 * q);
    f32x4 xa[2];
#pragma unroll
    for (int it = 0; it < 2; ++it) {
      xa[it] = (f32x4){0.f, 0.f, 0.f, 0.f};
#pragma unroll
      for (int ks = 0; ks < 2; ++ks) xa[it] = __builtin_amdgcn_mfma_f32_16x16x32_bf16(*(const bf16x8*)(TA + (16 * it + l15) * 72 + 32 * ks + 8 * q), sf[ks], xa[it], 0, 0, 0);
      if (useV) xa[it] = __builtin_amdgcn_mfma_f32_16x16x32_bf16(*(const bf16x8*)(TAK + (16 * it + l15) * 40 + 8 * q), vfr, xa[it], 0, 0, 0);
    }
    *(u32x2*)(XTw + 4 * q) = pack4(xa[0]);
    lds_wave_fence();
    f32x4 ua = __builtin_amdgcn_mfma_f32_16x16x16bf16_1k(t1f, *(const s16x4*)(XTw + 4 * q), (f32x4){0.f, 0.f, 0.f, 0.f}, 0, 0, 0);
    *(u32x2*)(UTw + 4 * q) = pack4(ua);
    lds_wave_fence();
    xa[1] = __builtin_amdgcn_mfma_f32_16x16x16bf16_1k(l21f, *(const s16x4*)(UTw + 4 * q), xa[1], 0, 0, 0);
    *(u32x2*)(XTw + 16 + 4 * q) = pack4(xa[1]);
    lds_wave_fence();
    ua = __builtin_amdgcn_mfma_f32_16x16x16bf16_1k(t2f, *(const s16x4*)(XTw + 16 + 4 * q), (f32x4){0.f, 0.f, 0.f, 0.f}, 0, 0, 0);
    *(u32x2*)(UTw + 16 + 4 * q) = pack4(ua);
    lds_wave_fence();
    const bf16x8 uf = *(const bf16x8*)(UTw + 8 * q);
    if (WANTY) {
#pragma unroll
      for (int it = 0; it < 2; ++it) {
        f32x4 ya = (f32x4){0.f, 0.f, 0.f, 0.f};
#pragma unroll
        for (int ks = 0; ks < 2; ++ks) ya = __builtin_amdgcn_mfma_f32_16x16x32_bf16(*(const bf16x8*)(TR + (16 * it + l15) * 72 + 32 * ks + 8 * q), sf[ks], ya, 0, 0, 0);
        ya = __builtin_amdgcn_mfma_f32_16x16x32_bf16(*(const bf16x8*)(TRB + (16 * it + l15) * 40 + 8 * q), uf, ya, 0, 0, 0);
        ya = __builtin_amdgcn_mfma_f32_16x16x32_bf16(*(const bf16x8*)(TRK + (16 * it + l15) * 40 + 8 * q), vfr, ya, 0, 0, 0);
        bf16_t* Yd = d == 0 ? p.Y0 : p.Y1;
#pragma unroll
        for (int rg = 0; rg < 4; ++rg) {
          const int iq = isc0 + 16 * it + 4 * q + rg, tq = d == 0 ? iq : T - 1 - iq;
          Yd[(size_t)(rowbase + tq) * DM + h * 64 + 16 * w + l15] = f2bf(ya[rg]);
        }
      }
    }
#pragma unroll
    for (int kt = 0; kt < 4; ++kt) {
      f32x4 hv = st[si][kt];
      hv = __builtin_amdgcn_mfma_f32_16x16x32_bf16(*(const bf16x8*)(TBT + (16 * kt + l15) * 40 + 8 * q), uf, hv, 0, 0, 0);
      if (useV) hv = __builtin_amdgcn_mfma_f32_16x16x32_bf16(*(const bf16x8*)(TKT + (16 * kt + l15) * 40 + 8 * q), vfr, hv, 0, 0, 0);
      hv *= *(const f32x4*)(GAM + 16 * kt + 4 * q);
      st[si][kt] = hv;
      *(u32x2*)(TST + (si * 64 + 16 * w + l15) * 72 + 16 * kt + 4 * q) = pack4(hv);
    }
  }
}

__device__ __forceinline__ void rwkv_consts(const P& p, int d, int h, RwkvConsts& cc) {
  const int tid = threadIdx.x, lane = tid & 63, w = tid >> 6, l15 = lane & 15, q = lane >> 4;
#pragma unroll
  for (int ks = 0; ks < 2; ++ks) {
    cc.w2f[ks] = *(const bf16x8*)(p.w2T + ((size_t)d * 1024 + h * 64 + 16 * w + l15) * 64 + 32 * ks + 8 * q);
    cc.a2f[ks] = *(const bf16x8*)(p.a2T + ((size_t)d * 1024 + h * 64 + 16 * w + l15) * 64 + 32 * ks + 8 * q);
  }
}
__device__ __forceinline__ void ph_rwkv_A(const P& p, int vb, int nvb, unsigned char* smem) {
  const int tid = threadIdx.x, lane = tid & 63, w = tid >> 6, l15 = lane & 15, q = lane >> 4;
  bf16_t* TST = (bf16_t*)(smem + O_TST);
  for (int item = vb; item < 64 * 64; item += nvb) {
    const int chain = item >> 6, j = item & 63, b = chain >> 5, d = (chain >> 4) & 1, h = chain & 15;
    const bool latent = j > 0;
    const int T = latent ? SEQ : CTXL, rowbase = latent ? b * SEQ : NTOK + b * CTXL, base = latent ? (j - 1) * 256 : 0;
    RwkvConsts cc; rwkv_consts(p, d, h, cc);
    f32x4 st[2][4];
    __syncthreads();
#pragma unroll
    for (int kt = 0; kt < 4; ++kt) {
#pragma unroll
      for (int rg = 0; rg < 4; ++rg) st[0][kt][rg] = (16 * kt + 4 * q + rg == 16 * w + l15) ? 1.f : 0.f;
      st[1][kt] = (f32x4){0.f, 0.f, 0.f, 0.f};
      *(u32x2*)(TST + (16 * w + l15) * 72 + 16 * kt + 4 * q) = pack4(st[0][kt]);
      *(u32x2*)(TST + (64 + 16 * w + l15) * 72 + 16 * kt + 4 * q) = pack4(st[1][kt]);
    }
    for (int c = 0; c < 8; ++c) rwkv_chunk<2, false>(p, smem, d, h, rowbase, T, base + 32 * c, latent, st, cc);
    const size_t slot = (size_t)chain * NSUP + j;
#pragma unroll
    for (int kt = 0; kt < 4; ++kt) {
#pragma unroll
      for (int rg = 0; rg < 4; ++rg) p.Mst[(slot * 64 + 16 * kt + 4 * q + rg) * 64 + 16 * w + l15] = f2bf(st[0][kt][rg]);
      *(f32x4*)(p.Nst + (slot * 64 + 16 * w + l15) * 64 + 16 * kt + 4 * q) = st[1][kt];
    }
  }
}
__device__ __forceinline__ void ph_rwkv_B(const P& p, int vb, int nvb, unsigned char* smem) {
  const int tid = threadIdx.x, lane = tid & 63, w = tid >> 6, l15 = lane & 15, q = lane >> 4;
  bf16_t* HT = (bf16_t*)smem;
  for (int chain = vb; chain < 64; chain += nvb) {
    f32x4 hs[4];
#pragma unroll
    for (int kt = 0; kt < 4; ++kt) hs[kt] = (f32x4){0.f, 0.f, 0.f, 0.f};
    __syncthreads();
    for (int j = 0; j < 64; ++j) {
      const size_t slot = (size_t)chain * NSUP + j;
      f32x4 nv[4];
#pragma unroll
      for (int kt = 0; kt < 4; ++kt) nv[kt] = *(const f32x4*)(p.Nst + (slot * 64 + 16 * w + l15) * 64 + 16 * kt + 4 * q);
      bf16x8 mf[4][2];
#pragma unroll
      for (int kt = 0; kt < 4; ++kt)
#pragma unroll
        for (int ks = 0; ks < 2; ++ks) mf[kt][ks] = *(const bf16x8*)(p.Mst + (slot * 64 + 16 * kt + l15) * 64 + 32 * ks + 8 * q);
#pragma unroll
      for (int kt = 0; kt < 4; ++kt) {
        *(f32x4*)(p.Nst + (slot * 64 + 16 * w + l15) * 64 + 16 * kt + 4 * q) = hs[kt];
        *(u32x2*)(HT + (16 * w + l15) * 72 + 16 * kt + 4 * q) = pack4(hs[kt]);
      }
      lds_wave_fence();
      bf16x8 hf[2];
      hf[0] = *(const bf16x8*)(HT + (16 * w + l15) * 72 + 8 * q); hf[1] = *(const bf16x8*)(HT + (16 * w + l15) * 72 + 32 + 8 * q);
      lds_wave_fence();
#pragma unroll
      for (int kt = 0; kt < 4; ++kt) {
        f32x4 a = nv[kt];
#pragma unroll
        for (int ks = 0; ks < 2; ++ks) a = __builtin_amdgcn_mfma_f32_16x16x32_bf16(mf[kt][ks], hf[ks], a, 0, 0, 0);
        hs[kt] = a;
      }
    }
    const size_t slot = (size_t)chain * NSUP + 64;
#pragma unroll
    for (int kt = 0; kt < 4; ++kt) *(f32x4*)(p.Nst + (slot * 64 + 16 * w + l15) * 64 + 16 * kt + 4 * q) = hs[kt];
  }
}
__device__ __forceinline__ void ph_rwkv_C(const P& p, int vb, int nvb, unsigned char* smem) {
  const int tid = threadIdx.x, lane = tid & 63, w = tid >> 6, l15 = lane & 15, q = lane >> 4;
  bf16_t* TST = (bf16_t*)(smem + O_TST);
  for (int item = vb; item < 64 * 64; item += nvb) {
    const int chain = item >> 6, j = (item & 63) + 1, b = chain >> 5, d = (chain >> 4) & 1, h = chain & 15;
    RwkvConsts cc; rwkv_consts(p, d, h, cc);
    f32x4 st[1][4];
    const size_t slot = (size_t)chain * NSUP + j;
    __syncthreads();
#pragma unroll
    for (int kt = 0; kt < 4; ++kt) {
      st[0][kt] = *(const f32x4*)(p.Nst + (slot * 64 + 16 * w + l15) * 64 + 16 * kt + 4 * q);
      *(u32x2*)(TST + (16 * w + l15) * 72 + 16 * kt + 4 * q) = pack4(st[0][kt]);
    }
    for (int c = 0; c < 8; ++c) rwkv_chunk<1, true>(p, smem, d, h, b * SEQ, SEQ, (j - 1) * 256 + 32 * c, true, st, cc);
  }
}

#define RO_SMEM (128 * 16 * 4)
__device__ __forceinline__ void ph_readout(const P& p, int vb, int nvb, unsigned char* smem) {
  float* sgT = (float*)smem;
  const int tid = threadIdx.x, c4 = tid * 4, h = tid >> 4;
  const float4 lnw = *(const float4*)(p.ln_x_w + c4), lnb = *(const float4*)(p.ln_x_b + c4);
  for (int item = vb; item < NTOK / 16; item += nvb) {
    const int tok0 = item * 16;
    __syncthreads();
    {
      const int tk = tid >> 4, l8 = (tid & 15) * 8, m = tok0 + tk, b = m / SEQ, t = m % SEQ;
      float o[8];
      load_shift8(p.zA, p.mu_shift, b * SEQ, t, SEQ, 3328 + l8, o);
#pragma unroll
      for (int e = 0; e < 8; ++e) sgT[(l8 + e) * 16 + tk] = sigmoidf_(o[e]);
    }
    __syncthreads();
    float4 g[16];
#pragma unroll
    for (int k = 0; k < 16; ++k) g[k] = make_float4(0.f, 0.f, 0.f, 0.f);
    for (int l = 0; l < 128; ++l) {
      const float4 w = *(const float4*)(p.g2 + (size_t)l * 1024 + c4);
      const float4 s0 = *(const float4*)(sgT + l * 16), s1 = *(const float4*)(sgT + l * 16 + 4), s2 = *(const float4*)(sgT + l * 16 + 8), s3 = *(const float4*)(sgT + l * 16 + 12);
      const float sv[16] = {s0.x, s0.y, s0.z, s0.w, s1.x, s1.y, s1.z, s1.w, s2.x, s2.y, s2.z, s2.w, s3.x, s3.y, s3.z, s3.w};
#pragma unroll
      for (int k = 0; k < 16; ++k) { g[k].x += sv[k] * w.x; g[k].y += sv[k] * w.y; g[k].z += sv[k] * w.z; g[k].w += sv[k] * w.w; }
    }
#pragma unroll
    for (int k = 0; k < 16; ++k) {
      const int m = tok0 + k, b = m / SEQ, t = m % SEQ;
      const uint2 y0 = *(const uint2*)(p.Y0 + (size_t)m * DM + c4), y1 = *(const uint2*)(p.Y1 + (size_t)m * DM + c4);
      float y[4] = {bflo(y0.x) + bflo(y1.x), bfhi(y0.x) + bfhi(y1.x), bflo(y0.y) + bflo(y1.y), bfhi(y0.y) + bfhi(y1.y)};
      const float mu = red16(y[0] + y[1] + y[2] + y[3]) * (1.f / 64.f);
      float q = 0.f;
#pragma unroll
      for (int e = 0; e < 4; ++e) { y[e] -= mu; q += y[e] * y[e]; }
      const float rs = rsqrtf(red16(q) * (1.f / 64.f) + 64e-5f);
      const bf16_t* zr = p.zA + (size_t)m * SHIFTC + 2048 + c4;
      const uint2 zc = *(const uint2*)zr;
      uint2 zp = make_uint2(0, 0), zn = make_uint2(0, 0);
      if (t > 0) zp = *(const uint2*)(zr - SHIFTC);
      if (t < SEQ - 1) zn = *(const uint2*)(zr + SHIFTC);
      const float4 mu4 = *(const float4*)(p.mu_shift + 2048 + c4);
      float v[4];
      v[0] = bflo(zc.x) + mu4.x * (0.5f * (bflo(zp.x) + bflo(zn.x)) - bflo(zc.x));
      v[1] = bfhi(zc.x) + mu4.y * (0.5f * (bfhi(zp.x) + bfhi(zn.x)) - bfhi(zc.x));
      v[2] = bflo(zc.y) + mu4.z * (0.5f * (bflo(zp.y) + bflo(zn.y)) - bflo(zc.y));
      v[3] = bfhi(zc.y) + mu4.w * (0.5f * (bfhi(zp.y) + bfhi(zn.y)) - bfhi(zc.y));
      const float bon = 0.5f * (p.bdot[(size_t)m * 16 + h] + p.bdot[((size_t)NTOK + m) * 16 + h]);
      const float o0 = (y[0] * rs * lnw.x + lnb.x + bon * v[0]) * g[k].x, o1 = (y[1] * rs * lnw.y + lnb.y + bon * v[1]) * g[k].y;
      const float o2 = (y[2] * rs * lnw.z + lnb.z + bon * v[2]) * g[k].z, o3 = (y[3] * rs * lnw.w + lnb.w + bon * v[3]) * g[k].w;
      uint2 w; w.x = pack2(o0, o1); w.y = pack2(o2, o3);
      *(uint2*)(p.out_a + (size_t)m * DM + c4) = w;
    }
  }
}

#define POOL_SMEM (64 * 128 * 4)
__device__ __forceinline__ void ph_pool(const P& p, int vb, int nvb, unsigned char* smem) {
  float* V = (float*)smem;
  const int tid = threadIdx.x;
  for (int item = vb; item < 2 * 256 * 4; item += nvb) {
    const int j = item & 3, r = (item >> 2) & 255, b = item >> 10;
    const int win = 2 << j, half = win >> 1;
    const int r0 = max(r - half, 0), r1 = min(r + half, 256);
    __syncthreads();
    const int cp = tid & 63, cq = tid >> 6;
    float a0[16], a1[16];
#pragma unroll
    for (int i = 0; i < 16; ++i) { a0[i] = 0.f; a1[i] = 0.f; }
    for (int rr = r0; rr < r1; ++rr) {
      const bf16_t* base = p.zP + ((size_t)b * SEQ + rr * 64) * 512 + j * 128 + cp * 2;
#pragma unroll
      for (int i = 0; i < 16; ++i) {
        const unsigned u = *(const unsigned*)(base + (size_t)(cq + 4 * i) * 512);
        a0[i] += bflo(u); a1[i] += bfhi(u);
      }
    }
#pragma unroll
    for (int i = 0; i < 16; ++i) { V[(cq + 4 * i) * 128 + cp * 2] = a0[i]; V[(cq + 4 * i) * 128 + cp * 2 + 1] = a1[i]; }
    __syncthreads();
#pragma unroll
    for (int i = 0; i < 16; ++i) {
      const int col = cq + 4 * i, c0 = max(col - half, 0), c1 = min(col + half, 64);
      float s0 = 0.f, s1 = 0.f;
      for (int cc = c0; cc < c1; ++cc) { s0 += V[cc * 128 + cp * 2]; s1 += V[cc * 128 + cp * 2 + 1]; }
      const float inv = 1.0f / (float)((r1 - r0) * (c1 - c0));
      const size_t tokoff = ((size_t)b * SEQ + r * 64 + col) * 512 + j * 128 + cp * 2;
      const unsigned u = *(const unsigned*)(p.zP + tokoff);
      *(unsigned*)(p.pooled + tokoff) = pack2(s0 * inv - bflo(u), s1 * inv - bfhi(u));
    }
  }
}
__device__ __forceinline__ void ph_merge(const P& p, int vb, int nvb) {
  for (size_t i = ((size_t)vb * 256 + threadIdx.x) * 4; i < (size_t)NTOK * DM; i += (size_t)nvb * 1024) {
    const size_t m = i >> 10; const int c = (int)(i & 1023);
    const uint2 g1 = *(const uint2*)(p.zG + m * 2048 + c), g2 = *(const uint2*)(p.zG + m * 2048 + 1024 + c);
    const uint2 a = *(const uint2*)(p.ya + i), bq = *(const uint2*)(p.yb + i);
    const float4 b1 = *(const float4*)(p.b_gate + c), b2 = *(const float4*)(p.b_gate + 1024 + c);
    const float m0 = sigmoidf_(bflo(g1.x) + b1.x) * bflo(a.x) + sigmoidf_(bflo(g2.x) + b2.x) * bflo(bq.x);
    const float m1 = sigmoidf_(bfhi(g1.x) + b1.y) * bfhi(a.x) + sigmoidf_(bfhi(g2.x) + b2.y) * bfhi(bq.x);
    const float m2 = sigmoidf_(bflo(g1.y) + b1.z) * bflo(a.y) + sigmoidf_(bflo(g2.y) + b2.z) * bflo(bq.y);
    const float m3 = sigmoidf_(bfhi(g1.y) + b1.w) * bfhi(a.y) + sigmoidf_(bfhi(g2.y) + b2.w) * bfhi(bq.y);
    uint2 w; w.x = pack2(m0, m1); w.y = pack2(m2, m3);
    *(uint2*)(p.mrg + i) = w;
  }
}
__device__ __forceinline__ void ph_res1(const P& p, int vb, int nvb) {
  const int lane = threadIdx.x & 63, wid = threadIdx.x >> 6;
  for (int m = vb * 4 + wid; m < NTOK; m += nvb * 4) {
    const float* md = p.mod + (m / SEQ) * 6144;
    float mx[16]; float ss = 0.f;
#pragma unroll
    for (int i = 0; i < 4; ++i) {
      const uint2 u = *(const uint2*)(p.mix + (size_t)m * DM + i * 256 + lane * 4);
      mx[4 * i] = bflo(u.x); mx[4 * i + 1] = bfhi(u.x); mx[4 * i + 2] = bflo(u.y); mx[4 * i + 3] = bfhi(u.y);
#pragma unroll
      for (int e = 0; e < 4; ++e) ss += mx[4 * i + e] * mx[4 * i + e];
    }
    ss = wave_sum(ss);
    const float rstd = rsqrtf(ss * (1.0f / 1024.0f) + 1e-6f);
    float x1[16]; float s2 = 0.f;
#pragma unroll
    for (int i = 0; i < 4; ++i) {
      const int col = i * 256 + lane * 4;
      const float4 xv = *(const float4*)(p.x + (size_t)m * DM + col), g = *(const float4*)(p.g_post_mix + col), gt = *(const float4*)(md + 2048 + col);
      x1[4 * i] = xv.x + gt.x * mx[4 * i] * rstd * g.x; x1[4 * i + 1] = xv.y + gt.y * mx[4 * i + 1] * rstd * g.y;
      x1[4 * i + 2] = xv.z + gt.z * mx[4 * i + 2] * rstd * g.z; x1[4 * i + 3] = xv.w + gt.w * mx[4 * i + 3] * rstd * g.w;
      *(float4*)(p.out + (size_t)m * DM + col) = make_float4(x1[4 * i], x1[4 * i + 1], x1[4 * i + 2], x1[4 * i + 3]);
#pragma unroll
      for (int e = 0; e < 4; ++e) s2 += x1[4 * i + e] * x1[4 * i + e];
    }
    s2 = wave_sum(s2);
    const float r2 = rsqrtf(s2 * (1.0f / 1024.0f) + 1e-6f);
#pragma unroll
    for (int i = 0; i < 4; ++i) {
      const int col = i * 256 + lane * 4;
      const float4 g = *(const float4*)(p.g_pre_ffn + col), sh = *(const float4*)(md + 3072 + col), sc = *(const float4*)(md + 4096 + col);
      uint2 w;
      w.x = pack2(x1[4 * i] * r2 * g.x * (1.f + sc.x) + sh.x, x1[4 * i + 1] * r2 * g.y * (1.f + sc.y) + sh.y);
      w.y = pack2(x1[4 * i + 2] * r2 * g.z * (1.f + sc.z) + sh.z, x1[4 * i + 3] * r2 * g.w * (1.f + sc.w) + sh.w);
      *(uint2*)(p.hx2 + (size_t)m * DM + col) = w;
    }
  }
}

#define PS1_SMEM (128 * 133 * 4)
#define CE_DESC(a, b) { const float _mx = fmaxf(a, b), _mn = fminf(a, b); a = _mx; b = _mn; }
template <int N> __device__ __forceinline__ void bitonic_sort_desc(float (&v)[N]) {
#pragma unroll
  for (int k = 2; k <= N; k <<= 1)
#pragma unroll
    for (int j = k >> 1; j > 0; j >>= 1)
#pragma unroll
      for (int i = 0; i < N; ++i) { const int l = i ^ j; if (l > i) { if ((i & k) == 0) CE_DESC(v[i], v[l]) else CE_DESC(v[l], v[i]) } }
}
__device__ __forceinline__ void bitonic_merge16_desc(float (&v)[16]) {
#pragma unroll
  for (int j = 8; j > 0; j >>= 1)
#pragma unroll
    for (int i = 0; i < 16; ++i) { const int l = i ^ j; if (l > i) CE_DESC(v[i], v[l]) }
}
__device__ __forceinline__ void ph_peer_s1(const P& p, int vb, int nvb, unsigned char* smem) {
  float* S = (float*)smem;
  EpiLds epi{S};
  const int tid = threadIdx.x, sub = tid & 3;
  for (int item = vb; item < 256 * 16; item += nvb) {
    const int hp = item & 15, tm = item >> 4;
    __syncthreads();
    gemm_tile(p.q + hp * 128, 2048, p.keys + (size_t)hp * 128 * 128, 128, 128, tm * 128, 0, epi, smem);
    __syncthreads();
#pragma unroll 1
    for (int pass = 0; pass < 2; ++pass) {
      const int row = pass * 64 + (tid >> 2);
      float a[16], b[16];
#pragma unroll
      for (int i = 0; i < 16; ++i) {
        a[i] = __uint_as_float((__float_as_uint(S[row * 133 + sub * 33 + i]) & ~127u) | (unsigned)(sub * 32 + i));
        b[i] = __uint_as_float((__float_as_uint(S[row * 133 + sub * 33 + 16 + i]) & ~127u) | (unsigned)(sub * 32 + 16 + i));
      }
      bitonic_sort_desc<16>(a); bitonic_sort_desc<16>(b);
#pragma unroll
      for (int i = 0; i < 16; ++i) a[i] = fmaxf(a[i], b[15 - i]);
      bitonic_merge16_desc(a);
#pragma unroll
      for (int lvl = 1; lvl <= 2; lvl <<= 1) {
#pragma unroll
        for (int i = 0; i < 16; ++i) b[i] = __shfl_xor(a[i], lvl);
#pragma unroll
        for (int i = 0; i < 16; ++i) a[i] = fmaxf(a[i], b[15 - i]);
        bitonic_merge16_desc(a);
      }
      if (sub == 0) {
        const size_t ob = ((size_t)(tm * 128 + row) * 16 + hp) * 16;
#pragma unroll
        for (int i = 0; i < 16; i += 4) {
          *(f32x4*)(p.sv + ob + i) = (f32x4){a[i], a[i + 1], a[i + 2], a[i + 3]};
          typedef int i32x4 __attribute__((ext_vector_type(4)));
          *(i32x4*)(p.si + ob + i) = (i32x4){(int)(__float_as_uint(a[i]) & 127u), (int)(__float_as_uint(a[i + 1]) & 127u), (int)(__float_as_uint(a[i + 2]) & 127u), (int)(__float_as_uint(a[i + 3]) & 127u)};
        }
      }
    }
  }
}
__device__ __forceinline__ void ph_peer_s2(const P& p, int vb, int nvb) {
  for (int it = vb * 256 + threadIdx.x; it < NTOK * 8; it += nvb * 256) {
    const size_t ob = (size_t)it * 32;
    float a[16], bq[16]; int ia[16], ib[16];
#pragma unroll
    for (int i = 0; i < 16; i += 4) {
      const float4 fa = *(const float4*)(p.sv + ob + i), fb = *(const float4*)(p.sv + ob + 16 + i);
      const int4 ja = *(const int4*)(p.si + ob + i), jb = *(const int4*)(p.si + ob + 16 + i);
      a[i] = fa.x; a[i + 1] = fa.y; a[i + 2] = fa.z; a[i + 3] = fa.w; bq[i] = fb.x; bq[i + 1] = fb.y; bq[i + 2] = fb.z; bq[i + 3] = fb.w;
      ia[i] = ja.x; ia[i + 1] = ja.y; ia[i + 2] = ja.z; ia[i + 3] = ja.w; ib[i] = jb.x; ib[i + 1] = jb.y; ib[i + 2] = jb.z; ib[i + 3] = jb.w;
    }
    float cs[50]; int ci[50];
    {
      int n = 0;
#pragma unroll
      for (int i = 0; i < 16; ++i)
#pragma unroll
        for (int j = 0; j < 16; ++j)
          if ((i + 1) * (j + 1) <= 16) { cs[n] = a[i] + bq[j]; ci[n] = ia[i] * 128 + ib[j]; ++n; }
    }
    float sel[16]; int seli[16];
#pragma unroll
    for (int k = 0; k < 16; ++k) {
      float mx = cs[0];
#pragma unroll
      for (int n = 1; n < 50; ++n) mx = fmaxf(mx, cs[n]);
      int id = 0; bool found = false;
#pragma unroll
      for (int n = 0; n < 50; ++n) {
        const bool hit = !found && (cs[n] == mx);
        if (hit) { id = ci[n]; cs[n] = -3.0e38f; found = true; }
      }
      sel[k] = mx; seli[k] = id;
    }
    float den = 0.f; const float smax = sel[0];
#pragma unroll
    for (int k = 0; k < 16; ++k) { sel[k] = __expf(sel[k] - smax); den += sel[k]; }
    const float inv = 1.0f / den;
    const size_t o2 = (size_t)it * 16;
#pragma unroll
    for (int k = 0; k < 16; ++k) { p.pidx[o2 + k] = seli[k]; p.pgate[o2 + k] = sel[k] * inv; }
  }
}
typedef float f32x2 __attribute__((ext_vector_type(2)));
typedef float f32x16 __attribute__((ext_vector_type(16)));
typedef float f32x32 __attribute__((ext_vector_type(32)));
typedef unsigned u32x6 __attribute__((ext_vector_type(6)));
__device__ __forceinline__ float half_max(float v) {
#pragma unroll
  for (int o = 16; o > 0; o >>= 1) v = fmaxf(v, __shfl_xor(v, o));
  return v;
}
__device__ __forceinline__ float half_sum(float v) {
#pragma unroll
  for (int o = 16; o > 0; o >>= 1) v += __shfl_xor(v, o);
  return v;
}
__device__ __forceinline__ void ph_cvt_fp6(const float* __restrict__ in, unsigned char* __restrict__ out, float* __restrict__ inv_scale, int vb, int nvb) {
  const int lane = threadIdx.x & 63, wid = threadIdx.x >> 6, hf = lane >> 5, sl = lane & 31;
  for (int rp = vb * 4 + wid; rp < 8192; rp += nvb * 4) {
    const int row = rp * 2 + hf;
    f32x16 a, b2; float am = 0.f;
#pragma unroll
    for (int i = 0; i < 4; ++i) {
      const f32x4 v0 = *(const f32x4*)(in + (size_t)row * DM + sl * 32 + 4 * i), v1 = *(const f32x4*)(in + (size_t)row * DM + sl * 32 + 16 + 4 * i);
#pragma unroll
      for (int e = 0; e < 4; ++e) { a[4 * i + e] = v0[e]; b2[4 * i + e] = v1[e]; am = fmaxf(am, fmaxf(fabsf(v0[e]), fabsf(v1[e]))); }
    }
    am = half_max(am);
    const float sc = am > 0.f ? 7.0f / am : 1.0f;
    const u32x6 pk = __builtin_amdgcn_cvt_scalef32_2xpk16_fp6_f32(a * sc, b2 * sc, 1.0f);
    unsigned char* o = out + (size_t)row * 768 + sl * 24;
    *(u32x2*)(o) = (u32x2){pk[0], pk[1]}; *(u32x2*)(o + 8) = (u32x2){pk[2], pk[3]}; *(u32x2*)(o + 16) = (u32x2){pk[4], pk[5]};
    if (sl == 0) inv_scale[row] = am > 0.f ? am / 7.0f : 1.0f;
  }
}
__device__ __forceinline__ u32x6 load_row6(const unsigned char* base, int id, int sl) {
  const unsigned char* q = base + (size_t)id * 768 + sl * 24;
  const u32x2 a = *(const u32x2*)q, b = *(const u32x2*)(q + 8), c = *(const u32x2*)(q + 16);
  return (u32x6){a.x, a.y, b.x, b.y, c.x, c.y};
}
#define GATHER_SMEM (4 * 64 * 33 * 4)
__device__ __forceinline__ void ph_peer_gather(const P& p, int vb, int nvb, unsigned char* smem) {
  const int lane = threadIdx.x & 63, wid = threadIdx.x >> 6, hf = lane >> 5, sl = lane & 31;
  float* scr = (float*)smem + (wid * 64 + lane) * 33;
  int* tauL = (int*)(smem + GATHER_SMEM) + wid * 32;
  {
    f32x16 a, b2;
#pragma unroll
    for (int i = 0; i < 16; ++i) { a[i] = __uint_as_float((unsigned)i << 20) * 0x1p126f; b2[i] = __uint_as_float((unsigned)(16 + i) << 20) * 0x1p126f; }
    const f32x32 o = __builtin_amdgcn_cvt_scalef32_pk32_f32_fp6(__builtin_amdgcn_cvt_scalef32_2xpk16_fp6_f32(a, b2, 1.0f), 1.0f);
    if (lane == 0) {
#pragma unroll
      for (int j = 0; j < 32; ++j) tauL[j] = (int)((__float_as_uint(o[j] * 0x1p-126f) >> 20) & 31u);
    }
  }
  const int jmap = 2 * (lane & 1) + ((lane >> 1) & 1);
  __syncthreads();
  for (int m = vb * 4 + wid; m < NTOK; m += nvb * 4) {
    const float* md = p.mod + (m / SEQ) * 6144;
    float xh[32];
    {
#pragma unroll
      for (int c4 = 0; c4 < 4; ++c4) {
        const u32x4 u = *(const u32x4*)(p.hx2 + (size_t)m * DM + sl * 32 + 8 * c4);
#pragma unroll
        for (int e = 0; e < 4; ++e) { scr[8 * c4 + 2 * e] = bflo(u[e]); scr[8 * c4 + 2 * e + 1] = bfhi(u[e]); }
      }
      lds_wave_fence();
#pragma unroll
      for (int j = 0; j < 32; ++j) xh[j] = scr[tauL[j]];
      lds_wave_fence();
    }
    const int id0 = p.pidx[(size_t)m * 128 + lane], id1 = p.pidx[(size_t)m * 128 + 64 + lane];
    const float su0 = p.us[id0], su1 = p.us[id1];
    const float gs0 = p.pgate[(size_t)m * 128 + lane] * p.vs[id0], gs1 = p.pgate[(size_t)m * 128 + 64 + lane] * p.vs[id1];
    float acch[32];
#pragma unroll
    for (int k = 0; k < 32; ++k) acch[k] = 0.f;
    for (int e0 = 0; e0 < 128; e0 += 8) {
      u32x6 ur[4], vr[4];
#pragma unroll
      for (int j = 0; j < 4; ++j) {
        const int id = __shfl(e0 < 64 ? id0 : id1, (e0 + hf * 4 + j) & 63);
        ur[j] = load_row6(p.ub8, id, sl);
        vr[j] = load_row6(p.vb8, id, sl);
      }
      float d[4];
#pragma unroll
      for (int j = 0; j < 4; ++j) {
        const f32x32 f = __builtin_amdgcn_cvt_scalef32_pk32_f32_fp6(ur[j], 1.0f);
        float s0 = 0.f, s1 = 0.f;
#pragma unroll
        for (int k = 0; k < 32; k += 2) { s0 += f[k] * xh[k]; s1 += f[k + 1] * xh[k + 1]; }
        d[j] = s0 + s1;
      }
      float r2[2], r1;
      {
        const bool lo = (lane & 1) == 0;
#pragma unroll
        for (int i = 0; i < 2; ++i) { const float keep = lo ? d[i] : d[i + 2], send = lo ? d[i + 2] : d[i]; r2[i] = keep + __shfl_xor(send, 1); }
        const bool lo2 = (lane & 2) == 0;
        { const float keep = lo2 ? r2[0] : r2[1], send = lo2 ? r2[1] : r2[0]; r1 = keep + __shfl_xor(send, 2); }
        r1 += __shfl_xor(r1, 4); r1 += __shfl_xor(r1, 8); r1 += __shfl_xor(r1, 16);
      }
      const int esrc = (e0 + hf * 4 + jmap) & 63;
      const float su = __shfl(e0 < 64 ? su0 : su1, esrc), gs = __shfl(e0 < 64 ? gs0 : gs1, esrc);
      const float sdot = r1 * su;
      const float cf = 0.5f * sdot * (1.0f + erff(sdot * 0.70710678118654752f)) * gs;
#pragma unroll
      for (int j = 0; j < 4; ++j) {
        const float cj = __shfl(cf, (lane & 32) | ((j >> 1) | ((j & 1) << 1)));
        const f32x32 f = __builtin_amdgcn_cvt_scalef32_pk32_f32_fp6(vr[j], 1.0f);
#pragma unroll
        for (int k = 0; k < 32; ++k) acch[k] += cj * f[k];
      }
    }
#pragma unroll
    for (int k = 0; k < 32; ++k) { acch[k] += __shfl_xor(acch[k], 32); scr[tauL[k]] = acch[k]; }
    lds_wave_fence();
    float ss = 0.f;
#pragma unroll
    for (int k = 0; k < 32; ++k) { const float v = scr[k]; ss += v * v; }
    ss = half_sum(ss);
    const float rstd = rsqrtf(ss * (1.0f / 1024.0f) + 1e-6f);
#pragma unroll
    for (int k4 = 0; k4 < 4; ++k4) {
      const int kk = hf * 16 + k4 * 4, col = sl * 32 + kk;
      f32x4 x1 = *(const f32x4*)(p.out + (size_t)m * DM + col);
      const f32x4 g = *(const f32x4*)(p.g_post_ffn + col), gt = *(const f32x4*)(md + 5120 + col);
#pragma unroll
      for (int e = 0; e < 4; ++e) x1[e] += gt[e] * scr[kk + e] * rstd * g[e];
      *(f32x4*)(p.out + (size_t)m * DM + col) = x1;
    }
    lds_wave_fence();
  }
}

#define XB_TMO      128
#define XB_XCNT(j)  (256  + 64 * (j))
#define XB_XSUB(j)  (1280 + 64 * (j))
#define XB_XGEN(j)  (2304 + 64 * (j))
#define XB_TOP      3328
#define XB_TOPGEN   3392
#define XCD_BAR_WORDS 3456
#define XB_SPIN_CAP (1u << 20)
#define LAS __attribute__((address_space(3)))
__device__ __forceinline__ unsigned xb_ld(unsigned* p)              { return __hip_atomic_load(p, __ATOMIC_RELAXED, __HIP_MEMORY_SCOPE_AGENT); }
__device__ __forceinline__ unsigned xb_add(unsigned* p, unsigned v) { return __hip_atomic_fetch_add(p, v, __ATOMIC_RELAXED, __HIP_MEMORY_SCOPE_AGENT); }
__device__ __forceinline__ unsigned xb_xcc_id() { return (unsigned)__builtin_amdgcn_s_getreg((3 << 11) | 20) & 0xFu; }
#define XB_SPIN(cond, bar) do { unsigned _sp = 0; while (cond) { __builtin_amdgcn_s_sleep(1); \
    if ((++_sp & 255u) == 0u) { if (xb_ld(&(bar)[XB_TMO])) break; if (_sp > XB_SPIN_CAP) { atomicAdd(&(bar)[XB_TMO], 1u); break; } } } } while (0)
struct XcdBarrier { unsigned* bar; unsigned x; volatile LAS unsigned* st; };
__device__ __forceinline__ XcdBarrier xcd_barrier_post(unsigned* bar, volatile LAS unsigned* st) {
  XcdBarrier b; b.bar = bar; b.x = xb_xcc_id(); b.st = st;
  if (threadIdx.x == 0) (void)xb_add(&bar[XB_XCNT(b.x)], 1u);
  return b;
}
__device__ __forceinline__ void xcd_barrier_complete(unsigned* bar, unsigned x, unsigned& nloc, unsigned& nx) {
  const unsigned G = gridDim.x * gridDim.y * gridDim.z;
  unsigned sum, cnt, mine, sp = 0u;
  for (;;) {
    sum = 0u; cnt = 0u; mine = 0u;
#pragma unroll
    for (unsigned j = 0; j < 16; ++j) { const unsigned c = xb_ld(&bar[XB_XCNT(j)]); sum += c; cnt += (c > 0u) ? 1u : 0u; mine = (j == x) ? c : mine; }
    if (sum == G) break;
    __builtin_amdgcn_s_sleep(1);
    if ((++sp & 255u) == 0u) { if (xb_ld(&bar[XB_TMO])) break; if (sp > XB_SPIN_CAP) { atomicAdd(&bar[XB_TMO], 1u); break; } }
  }
  nloc = mine > 0u ? mine : 1u; nx = cnt > 0u ? cnt : 1u;
}
__device__ __forceinline__ void xcd_barrier(const XcdBarrier& b) {
  asm volatile("s_waitcnt vmcnt(0)" ::: "memory");
  __syncthreads();
  if (threadIdx.x == 0) {
    unsigned* bar = b.bar;
    __builtin_amdgcn_s_waitcnt(0);
    unsigned nloc = b.st[0], nx = b.st[1];
    if (nloc == 0u) { xcd_barrier_complete(bar, b.x, nloc, nx); b.st[0] = nloc; b.st[1] = nx; }
    const unsigned old = xb_add(&bar[XB_XSUB(b.x)], 1u);
    const unsigned gen = old / nloc;
    if (old + 1u == (gen + 1u) * nloc) {
      __builtin_amdgcn_fence(__ATOMIC_RELEASE, "agent");
      asm volatile("s_waitcnt vmcnt(0)" ::: "memory");
      const unsigned og = xb_add(&bar[XB_TOP], 1u);
      const unsigned tg = og / nx;
      if (og + 1u == (tg + 1u) * nx) xb_add(&bar[XB_TOPGEN], 1u);
      else XB_SPIN(xb_ld(&bar[XB_TOPGEN]) == tg, bar);
      __builtin_amdgcn_fence(__ATOMIC_ACQUIRE, "agent");
      xb_add(&bar[XB_XGEN(b.x)], 1u);
      asm volatile("s_waitcnt vmcnt(0)" ::: "memory");
    } else {
      XB_SPIN(xb_ld(&bar[XB_XGEN(b.x)]) == gen, bar);
      __builtin_amdgcn_fence(__ATOMIC_ACQUIRE, "agent");
      asm volatile("s_waitcnt vmcnt(0)" ::: "memory");
    }
  }
  __syncthreads();
}

#define SMEM_BYTES RWKV_SMEM
__global__ void __launch_bounds__(256, 2) mega(P p) {
  __shared__ __attribute__((aligned(16))) unsigned char smem[SMEM_BYTES + 16];
  cg::grid_group grid = cg::this_grid();
  const int vb = blockIdx.x, nvb = gridDim.x;
  if (threadIdx.x == 0) *(u32x4*)(smem + SMEM_BYTES) = (u32x4){0u, 0u, 0u, 0u};
  __syncthreads();
  const XcdBarrier xb = xcd_barrier_post(p.bar, (volatile LAS unsigned*)(smem + SMEM_BYTES));
  ph_mod(p, vb, nvb, smem);
  ph_transpose(p.w_in, p.Wt_in, DM, INC, vb, nvb, smem);
  ph_transpose(p.w2, p.w2T, 64, 1024, vb, nvb, smem);
  ph_transpose(p.w2 + 65536, p.w2T + 65536, 64, 1024, vb, nvb, smem);
  ph_transpose(p.a2, p.a2T, 64, 1024, vb, nvb, smem);
  ph_transpose(p.a2 + 65536, p.a2T + 65536, 64, 1024, vb, nvb, smem);
  grid.sync();
  ph_norm1(p, vb, nvb);
  xcd_barrier(xb);
  ph_gemm1(p, vb, nvb, smem);
  xcd_barrier(xb);
  ph_rwkv_A(p, vb, nvb, smem);
  xcd_barrier(xb);
  ph_rwkv_B(p, vb, nvb, smem);
  if (nvb > 128 && vb >= 64) {
    const int v2 = vb - 64, n2 = nvb - 64;
    ph_transpose(p.w_a_out, p.Wt_aout, DM, DM, v2, n2, smem);
    ph_transpose(p.w_o, p.Wt_o, DM, DM, v2, n2, smem);
    ph_transpose(p.peer_wq, p.Wt_q, DM, 2048, v2, n2, smem);
    ph_transpose(p.g2, p.g2T, 128, 1024, v2, n2, smem);
    ph_weff(p, v2, n2);
    ph_convert(p.peer_keys, p.keys, (size_t)16 * 128 * 128, v2, n2);
  } else if (nvb <= 128) {
    ph_transpose(p.w_a_out, p.Wt_aout, DM, DM, vb, nvb, smem);
    ph_transpose(p.w_o, p.Wt_o, DM, DM, vb, nvb, smem);
    ph_transpose(p.peer_wq, p.Wt_q, DM, 2048, vb, nvb, smem);
    ph_transpose(p.g2, p.g2T, 128, 1024, vb, nvb, smem);
    ph_weff(p, vb, nvb);
    ph_convert(p.peer_keys, p.keys, (size_t)16 * 128 * 128, vb, nvb);
  }
  xcd_barrier(xb);
  ph_rwkv_C(p, vb, nvb, smem);
  ph_sg(p, vb, nvb);
  xcd_barrier(xb);
  ph_readout_gemm(p, vb, nvb, smem);
  ph_pool(p, vb, nvb, smem);
  ph_cvt_fp6(p.peer_u, p.ub8, p.us, vb, nvb);
  ph_cvt_fp6(p.peer_v, p.vb8, p.vs, vb, nvb);
  xcd_barrier(xb);
  ph_gemm_merge(p, vb, nvb, smem);
  xcd_barrier(xb);
  ph_gemm_simple(p.mrg, DM, p.Wt_o, DM, DM, NTOK, DM, p.mix, DM, vb, nvb, smem);
  xcd_barrier(xb);
  ph_res1(p, vb, nvb);
  xcd_barrier(xb);
  ph_gemm_simple(p.hx2, DM, p.Wt_q, DM, DM, NTOK, 2048, p.q, 2048, vb, nvb, smem);
  xcd_barrier(xb);
  ph_peer_s1(p, vb, nvb, smem);
  xcd_barrier(xb);
  ph_peer_s2(p, vb, nvb);
  xcd_barrier(xb);
  ph_peer_gather(p, vb, nvb, smem);
}

extern "C" void kernel_launch(void* const* d_in, const int* in_sizes, int n_in, void* d_out, int out_size, void* d_ws, size_t ws_size, hipStream_t stream) {
  P p{};
  const float** f = (const float**)&p;
  for (int i = 0; i < 32; ++i) f[i] = (const float*)d_in[i];
  p.out = (float*)d_out;
  p.bar = (unsigned*)((unsigned char*)d_ws + 511 * 1048576);
  unsigned char* w = (unsigned char*)d_ws;
  const size_t MiB = 1048576;
  const size_t HM = 524288;
  p.hx = (bf16_t*)(w + 4096);
  p.zA = (bf16_t*)(w + 65 * MiB + 8192);
  p.zP = (bf16_t*)(w + 569 * HM);
  p.zG = (bf16_t*)d_out;
  unsigned char* rw = w + 633 * HM;
  p.Wt_in = (bf16_t*)rw; rw += 12 * MiB;
  p.Wt_aout = (bf16_t*)rw; rw += 2 * MiB;
  p.Wt_eff = (bf16_t*)rw; rw += 1 * MiB;
  p.Wt_o = (bf16_t*)rw; rw += 2 * MiB;
  p.Wt_q = (bf16_t*)rw; rw += 4 * MiB;
  p.keys = (bf16_t*)rw; rw += HM;
  p.mod = (float*)rw; rw += HM;
  p.g2T = (bf16_t*)rw; rw += HM;
  p.w2T = (bf16_t*)rw; rw += HM;
  p.a2T = (bf16_t*)rw; rw += HM;
  p.Y0 = (bf16_t*)(w + 0 * MiB);
  p.Y1 = (bf16_t*)(w + 340 * MiB);
  p.bdot = (float*)(w + 404 * MiB);
  p.Mst = (bf16_t*)(w + 408 * MiB);
  p.sg = (bf16_t*)(w + 408 * MiB);
  p.Nst = (float*)(w + 441 * MiB);
  p.ub8 = w + 416 * MiB;
  p.vb8 = w + 432 * MiB;
  p.us = (float*)(w + 448 * MiB);
  p.vs = (float*)(w + 449 * MiB);
  p.pooled = (bf16_t*)(w + 478 * MiB);
  p.out_a = (bf16_t*)(w + 0 * MiB);
  p.ya = (bf16_t*)(w + 65 * MiB);
  p.yb = (bf16_t*)(w + 129 * MiB);
  p.mrg = (bf16_t*)(w + 193 * MiB);
  p.mix = (bf16_t*)(w + 65 * MiB);
  p.hx2 = (bf16_t*)(w + 0 * MiB);
  p.q = (bf16_t*)(w + 129 * MiB);
  p.sv = (float*)(w + 340 * MiB);
  p.si = (int*)(w + 372 * MiB);
  p.pidx = (int*)(w + 257 * MiB);
  p.pgate = (float*)(w + 273 * MiB);
  static int grid_blocks = 0;
  if (!grid_blocks) {
    int dev = 0, cus = 0, per_cu = 0;
    hipGetDevice(&dev);
    hipDeviceGetAttribute(&cus, hipDeviceAttributeMultiprocessorCount, dev);
    hipOccupancyMaxActiveBlocksPerMultiprocessor(&per_cu, mega, 256, 0);
    if (per_cu > 2) per_cu = 2;
    if (per_cu < 1) per_cu = 1;
    grid_blocks = cus * per_cu;
  }
  hipMemsetAsync(p.bar, 0, XCD_BAR_WORDS * 4, stream);
  void* args[] = {&p};
  hipError_t e = hipLaunchCooperativeKernel((void*)mega, dim3(grid_blocks), dim3(256), args, 0, stream);
  if (e != hipSuccess) fprintf(stderr, "cooperative launch failed: %s (grid %d)\n", hipGetErrorString(e), grid_blocks);
}
```

```cpp
#include <hip/hip_runtime.h>
#include <hip/hip_cooperative_groups.h>
#include <stdint.h>
#include <cstdio>
namespace cg = cooperative_groups;

typedef unsigned short bf16_t;
typedef short bf16x8 __attribute__((ext_vector_type(8)));
typedef float f32x4 __attribute__((ext_vector_type(4)));
typedef unsigned u32x4 __attribute__((ext_vector_type(4)));
typedef unsigned u32x2 __attribute__((ext_vector_type(2)));

#define NTOK 32768
#define SEQ 16384
#define CTXL 256
#define NCTX 512
#define MROWS 33280
#define DM 1024
#define SHIFTC 3456
#define INC 6016

typedef __bf16 hwbf2 __attribute__((ext_vector_type(2)));
typedef float hwf2 __attribute__((ext_vector_type(2)));
__device__ __forceinline__ unsigned pack2(float a, float b) { return __builtin_bit_cast(unsigned, __builtin_convertvector((hwf2){a, b}, hwbf2)); }
__device__ __forceinline__ bf16_t f2bf(float f) { return __builtin_bit_cast(unsigned short, (__bf16)f); }
__device__ __forceinline__ float bf2f(bf16_t h) { return __uint_as_float(((unsigned)h) << 16); }
__device__ __forceinline__ float bflo(unsigned u) { return __uint_as_float(u << 16); }
__device__ __forceinline__ float bfhi(unsigned u) { return __uint_as_float(u & 0xffff0000u); }
__device__ __forceinline__ float sigmoidf_(float x) { return 1.0f / (1.0f + __expf(-x)); }

__device__ __forceinline__ void load_shift8(const bf16_t* __restrict__ zA, const float* __restrict__ mu, int rowbase, int t, int T, int col0, float* o) {
  const u32x4 zc = *(const u32x4*)(zA + (size_t)(rowbase + t) * SHIFTC + col0);
  u32x4 zp = (u32x4){0u, 0u, 0u, 0u}, zn = (u32x4){0u, 0u, 0u, 0u};
  if (t > 0) zp = *(const u32x4*)(zA + (size_t)(rowbase + t - 1) * SHIFTC + col0);
  if (t < T - 1) zn = *(const u32x4*)(zA + (size_t)(rowbase + t + 1) * SHIFTC + col0);
  const unsigned c[4] = {zc.x, zc.y, zc.z, zc.w}, pv[4] = {zp.x, zp.y, zp.z, zp.w}, nv[4] = {zn.x, zn.y, zn.z, zn.w};
  const f32x4 m0 = *(const f32x4*)(mu + col0), m1 = *(const f32x4*)(mu + col0 + 4);
  const float mm[8] = {m0[0], m0[1], m0[2], m0[3], m1[0], m1[1], m1[2], m1[3]};
#pragma unroll
  for (int i = 0; i < 4; ++i) {
    const float z0 = bflo(c[i]), z1 = bfhi(c[i]);
    o[2 * i] = z0 + mm[2 * i] * (0.5f * (bflo(pv[i]) + bflo(nv[i])) - z0);
    o[2 * i + 1] = z1 + mm[2 * i + 1] * (0.5f * (bfhi(pv[i]) + bfhi(nv[i])) - z1);
  }
}
__device__ __forceinline__ void load8(const bf16_t* __restrict__ zA, int row, int col0, float* o) {
  const u32x4 zc = *(const u32x4*)(zA + (size_t)row * SHIFTC + col0);
#pragma unroll
  for (int i = 0; i < 4; ++i) { o[2 * i] = bflo(zc[i]); o[2 * i + 1] = bfhi(zc[i]); }
}
__device__ __forceinline__ void load_shift4(const bf16_t* __restrict__ zA, const float* __restrict__ mu, int rowbase, int t, int T, int col0, float* o) {
  const u32x2 zc = *(const u32x2*)(zA + (size_t)(rowbase + t) * SHIFTC + col0);
  u32x2 zp = (u32x2){0u, 0u}, zn = (u32x2){0u, 0u};
  if (t > 0) zp = *(const u32x2*)(zA + (size_t)(rowbase + t - 1) * SHIFTC + col0);
  if (t < T - 1) zn = *(const u32x2*)(zA + (size_t)(rowbase + t + 1) * SHIFTC + col0);
#pragma unroll
  for (int i = 0; i < 2; ++i) {
    const float z0 = bflo(zc[i]), z1 = bfhi(zc[i]);
    o[2 * i] = z0 + mu[col0 + 2 * i] * (0.5f * (bflo(zp[i]) + bflo(zn[i])) - z0);
    o[2 * i + 1] = z1 + mu[col0 + 2 * i + 1] * (0.5f * (bfhi(zp[i]) + bfhi(zn[i])) - z1);
  }
}
__device__ __forceinline__ float red16(float v) {
  v += __shfl_xor(v, 1); v += __shfl_xor(v, 2); v += __shfl_xor(v, 4); v += __shfl_xor(v, 8);
  return v;
}
__device__ __forceinline__ float red8(float v) {
  v += __shfl_xor(v, 1); v += __shfl_xor(v, 2); v += __shfl_xor(v, 4);
  return v;
}

struct P {
  const float *x, *c, *ctx, *c_ctx, *w_mod, *b_mod, *g_pre_mix, *g_post_mix, *g_pre_ffn, *g_post_ffn, *w_in, *b_gate, *mu_shift,
      *w0, *w2, *a0, *a2, *g2, *k_k, *k_a, *r_k, *ln_x_w, *ln_x_b, *w_a_out, *w_pool, *pool_scale, *w_b_out, *w_o, *peer_wq,
      *peer_keys, *peer_u, *peer_v;
  float* out;
  unsigned* bar;
  bf16_t* hx;
  bf16_t* zA;
  bf16_t* zP;
  bf16_t* zG;
  bf16_t* Wt_in;
  bf16_t* Wt_aout;
  bf16_t* Wt_eff;
  bf16_t* Wt_o;
  bf16_t* Wt_q;
  bf16_t* keys;
  float* mod;
  unsigned char* ub8;
  unsigned char* vb8;
  float* us;
  float* vs;
  bf16_t* sg;
  bf16_t* g2T;
  bf16_t* w2T;
  bf16_t* a2T;
  bf16_t* Mst;
  float* Nst;
  bf16_t* Y0;
  bf16_t* Y1;
  float* bdot;
  bf16_t* out_a;
  bf16_t* ya;
  bf16_t* pooled;
  bf16_t* yb;
  bf16_t* mrg;
  bf16_t* mix;
  bf16_t* hx2;
  bf16_t* q;
  float* sv;
  int* si;
  int* pidx;
  float* pgate;
};

#define GS 72
#define GEMM_SMEM (2 * 128 * GS * 2)
template <class Epi>
__device__ __forceinline__ void gemm_tile(const bf16_t* __restrict__ A, int lda, const bf16_t* __restrict__ Bt, int ldb, int K, int m0, int n0,
                                          const Epi& epi, unsigned char* smem) {
  const int tid = threadIdx.x, lane = tid & 63, wid = tid >> 6, wr = wid >> 1, wc = wid & 1;
  bf16_t* sA = (bf16_t*)smem;
  bf16_t* sB = sA + 128 * GS;
  f32x4 acc[4][4];
#pragma unroll
  for (int i = 0; i < 4; ++i)
#pragma unroll
    for (int j = 0; j < 4; ++j) acc[i][j] = (f32x4){0.f, 0.f, 0.f, 0.f};
  const int lrow = tid >> 3, lcol = (tid & 7) * 8;
  const bf16_t* pa = A + (size_t)(m0 + lrow) * lda + lcol;
  const bf16_t* pb = Bt + (size_t)(n0 + lrow) * ldb + lcol;
  u32x4 ra[4], rb[4];
#pragma unroll
  for (int p = 0; p < 4; ++p) {
    ra[p] = *(const u32x4*)(pa + (size_t)(32 * p) * lda);
    rb[p] = *(const u32x4*)(pb + (size_t)(32 * p) * ldb);
  }
  for (int k0 = 0; k0 < K; k0 += 64) {
#pragma unroll
    for (int p = 0; p < 4; ++p) {
      *(u32x4*)(sA + (lrow + 32 * p) * GS + lcol) = ra[p];
      *(u32x4*)(sB + (lrow + 32 * p) * GS + lcol) = rb[p];
    }
    __syncthreads();
    if (k0 + 64 < K) {
#pragma unroll
      for (int p = 0; p < 4; ++p) {
        ra[p] = *(const u32x4*)(pa + (size_t)(32 * p) * lda + k0 + 64);
        rb[p] = *(const u32x4*)(pb + (size_t)(32 * p) * ldb + k0 + 64);
      }
    }
#pragma unroll
    for (int kk = 0; kk < 2; ++kk) {
      bf16x8 af[4], bfr[4];
#pragma unroll
      for (int i = 0; i < 4; ++i) af[i] = *(const bf16x8*)(sA + (wr * 64 + i * 16 + (lane & 15)) * GS + kk * 32 + (lane >> 4) * 8);
#pragma unroll
      for (int j = 0; j < 4; ++j) bfr[j] = *(const bf16x8*)(sB + (wc * 64 + j * 16 + (lane & 15)) * GS + kk * 32 + (lane >> 4) * 8);
#pragma unroll
      for (int i = 0; i < 4; ++i)
#pragma unroll
        for (int j = 0; j < 4; ++j) acc[i][j] = __builtin_amdgcn_mfma_f32_16x16x32_bf16(bfr[j], af[i], acc[i][j], 0, 0, 0);
    }
    __syncthreads();
  }
#pragma unroll
  for (int i = 0; i < 4; ++i)
#pragma unroll
    for (int j = 0; j < 4; ++j) epi(m0 + wr * 64 + i * 16 + (lane & 15), n0 + wc * 64 + j * 16 + (lane >> 4) * 4, acc[i][j]);
}

#define G2S 40
#define GEMM2_SMEM (2 * (256 + 128) * G2S * 2)
template <class Epi>
__device__ __forceinline__ void gemm_tile2(const bf16_t* __restrict__ A, int lda, const bf16_t* __restrict__ Bt, int ldb, int K, int m0, int n0,
                                           const Epi& epi, unsigned char* smem) {
  const int tid = threadIdx.x, lane = tid & 63, wid = tid >> 6, wr = wid >> 1, wc = wid & 1, l15 = lane & 15, q = lane >> 4;
  bf16_t* sA = (bf16_t*)smem;
  bf16_t* sB = sA + 2 * 256 * G2S;
  f32x4 acc[8][4];
#pragma unroll
  for (int i = 0; i < 8; ++i)
#pragma unroll
    for (int j = 0; j < 4; ++j) acc[i][j] = (f32x4){0.f, 0.f, 0.f, 0.f};
  const int lrow = tid >> 2, lcol = (tid & 3) * 8;
  const bf16_t* pa = A + (size_t)(m0 + lrow) * lda + lcol;
  const bf16_t* pb = Bt + (size_t)(n0 + lrow) * ldb + lcol;
  u32x4 ra[4], rb[2];
#pragma unroll
  for (int pp = 0; pp < 4; ++pp) ra[pp] = *(const u32x4*)(pa + (size_t)(64 * pp) * lda);
#pragma unroll
  for (int pp = 0; pp < 2; ++pp) rb[pp] = *(const u32x4*)(pb + (size_t)(64 * pp) * ldb);
  __syncthreads();
#pragma unroll
  for (int pp = 0; pp < 4; ++pp) *(u32x4*)(sA + (lrow + 64 * pp) * G2S + lcol) = ra[pp];
#pragma unroll
  for (int pp = 0; pp < 2; ++pp) *(u32x4*)(sB + (lrow + 64 * pp) * G2S + lcol) = rb[pp];
  __syncthreads();
  const int nk = K >> 5;
  for (int kt = 0; kt < nk; ++kt) {
    const int cur = kt & 1;
    const bf16_t* cA = sA + cur * 256 * G2S;
    const bf16_t* cB = sB + cur * 128 * G2S;
    if (kt + 1 < nk) {
#pragma unroll
      for (int pp = 0; pp < 4; ++pp) ra[pp] = *(const u32x4*)(pa + (size_t)(64 * pp) * lda + (kt + 1) * 32);
#pragma unroll
      for (int pp = 0; pp < 2; ++pp) rb[pp] = *(const u32x4*)(pb + (size_t)(64 * pp) * ldb + (kt + 1) * 32);
    }
    bf16x8 bfr[4];
#pragma unroll
    for (int j = 0; j < 4; ++j) bfr[j] = *(const bf16x8*)(cB + (wc * 64 + j * 16 + l15) * G2S + q * 8);
#pragma unroll
    for (int i = 0; i < 8; ++i) {
      const bf16x8 af = *(const bf16x8*)(cA + (wr * 128 + i * 16 + l15) * G2S + q * 8);
#pragma unroll
      for (int j = 0; j < 4; ++j) acc[i][j] = __builtin_amdgcn_mfma_f32_16x16x32_bf16(bfr[j], af, acc[i][j], 0, 0, 0);
    }
    if (kt + 1 < nk) {
      bf16_t* nA = sA + (cur ^ 1) * 256 * G2S;
      bf16_t* nB = sB + (cur ^ 1) * 128 * G2S;
#pragma unroll
      for (int pp = 0; pp < 4; ++pp) *(u32x4*)(nA + (lrow + 64 * pp) * G2S + lcol) = ra[pp];
#pragma unroll
      for (int pp = 0; pp < 2; ++pp) *(u32x4*)(nB + (lrow + 64 * pp) * G2S + lcol) = rb[pp];
    }
    __syncthreads();
  }
#pragma unroll
  for (int i = 0; i < 8; ++i)
#pragma unroll
    for (int j = 0; j < 4; ++j) epi(m0 + wr * 128 + i * 16 + l15, n0 + wc * 64 + j * 16 + q * 4, acc[i][j]);
}

#define G3_STAGE 24576
#define G3_ES 136
#define GEMM3_SMEM (256 * G3_ES * 2)
typedef __attribute__((address_space(3))) unsigned lds_u32;
template <class Epi>
__device__ __forceinline__ void gemm_tile3(const bf16_t* __restrict__ A, int lda, const bf16_t* __restrict__ Bt, int ldb, int K, int m0, int n0,
                                           const Epi& epi, unsigned char* smem) {
  int tid = threadIdx.x;
  asm volatile("" : "+v"(tid));
  const int lane = tid & 63, wid = __builtin_amdgcn_readfirstlane(tid >> 6), wr = wid >> 1, wc = wid & 1, l15 = lane & 15, q = lane >> 4;
  f32x4 acc[8][4];
#pragma unroll
  for (int i = 0; i < 8; ++i)
#pragma unroll
    for (int j = 0; j < 4; ++j) acc[i][j] = (f32x4){0.f, 0.f, 0.f, 0.f};
  const int gr = lane >> 2, gc = ((lane & 3) ^ (((gr >> 2) & 1) << 1)) * 8;
  const bf16_t* pa = A + (long)(m0 + wid * 64 + gr) * lda + gc;
  const bf16_t* pb = Bt + (size_t)(n0 + wid * 32 + gr) * ldb + gc;
  unsigned char* dA = smem + wid * 4096 + lane * 16;
  unsigned char* dB = smem + 16384 + wid * 2048 + lane * 16;
  const int sw = (q ^ (((l15 >> 2) & 1) << 1)) * 16;
  const unsigned char* fA = smem + (wr * 128 + l15) * 64 + sw;
  const unsigned char* fB = smem + 16384 + (wc * 64 + l15) * 64 + sw;
#define G3_ISSUE(ST, KT) { _Pragma("unroll") for (int ii = 0; ii < 4; ++ii) __builtin_amdgcn_global_load_lds((const unsigned*)(pa + (size_t)(16 * ii) * lda + (KT) * 32), (lds_u32*)(dA + (ST) * G3_STAGE + ii * 1024), 16, 0, 0); \
                           _Pragma("unroll") for (int ii = 0; ii < 2; ++ii) __builtin_amdgcn_global_load_lds((const unsigned*)(pb + (size_t)(16 * ii) * ldb + (KT) * 32), (lds_u32*)(dB + (ST) * G3_STAGE + ii * 1024), 16, 0, 0); }
  const int nk = K >> 5;
  __syncthreads();
  G3_ISSUE(0, 0);
  for (int kt = 0; kt < nk; ++kt) {
    const int cur = kt & 1;
    asm volatile("s_waitcnt vmcnt(0)" ::: "memory");
    __syncthreads();
    if (kt + 1 < nk) G3_ISSUE(cur ^ 1, kt + 1);
    const unsigned char* cA = fA + cur * G3_STAGE;
    const unsigned char* cB = fB + cur * G3_STAGE;
    bf16x8 bfr[4];
#pragma unroll
    for (int j = 0; j < 4; ++j) bfr[j] = *(const bf16x8*)(cB + j * 1024);
#pragma unroll
    for (int i = 0; i < 8; ++i) {
      const bf16x8 af = *(const bf16x8*)(cA + i * 1024);
#pragma unroll
      for (int j = 0; j < 4; ++j) acc[i][j] = __builtin_amdgcn_mfma_f32_16x16x32_bf16(bfr[j], af, acc[i][j], 0, 0, 0);
    }
  }
#undef G3_ISSUE
  bf16_t* sE = (bf16_t*)smem;
  __syncthreads();
#pragma unroll
  for (int i = 0; i < 8; ++i)
#pragma unroll
    for (int j = 0; j < 4; ++j) {
      u32x2 w; w.x = pack2(acc[i][j][0], acc[i][j][1]); w.y = pack2(acc[i][j][2], acc[i][j][3]);
      *(u32x2*)(sE + (wr * 128 + i * 16 + l15) * G3_ES + wc * 64 + j * 16 + q * 4) = w;
    }
  __syncthreads();
  epi.finish(sE, m0, n0, tid);
}
template <class D> struct Epi3RowChunks {
  __device__ __forceinline__ void finish(const bf16_t* sE, int m0, int n0, int tid) const {
#pragma unroll
    for (int pp = 0; pp < 16; ++pp) {
      const int id = tid + 256 * pp, row = id >> 4, cc = (id & 15) * 8;
      static_cast<const D*>(this)->store(m0 + row, n0 + cc, *(const u32x4*)(sE + row * G3_ES + cc));
    }
  }
};
struct Epi3StoreBf16 : Epi3RowChunks<Epi3StoreBf16> {
  bf16_t* C; int ldc;
  __device__ Epi3StoreBf16(bf16_t* c, int l) : C(c), ldc(l) {}
  __device__ __forceinline__ void store(int m, int n, const u32x4& v) const { *(u32x4*)(C + (size_t)m * ldc + n) = v; }
};
struct Epi3GateA : Epi3RowChunks<Epi3GateA> {
  const bf16_t* zG; const float* bg; bf16_t* mrg;
  __device__ Epi3GateA(const bf16_t* z, const float* b, bf16_t* m) : zG(z), bg(b), mrg(m) {}
  __device__ __forceinline__ void store(int m, int n, const u32x4& v) const {
    const u32x4 g = *(const u32x4*)(zG + (size_t)m * 2048 + n);
    const f32x4 b0 = *(const f32x4*)(bg + n), b1 = *(const f32x4*)(bg + n + 4);
    u32x4 o;
#pragma unroll
    for (int i = 0; i < 4; ++i) {
      const float bl = i < 2 ? b0[2 * i] : b1[2 * i - 4], bh = i < 2 ? b0[2 * i + 1] : b1[2 * i - 3];
      o[i] = pack2(sigmoidf_(bflo(g[i]) + bl) * bflo(v[i]), sigmoidf_(bfhi(g[i]) + bh) * bfhi(v[i]));
    }
    *(u32x4*)(mrg + (size_t)m * DM + n) = o;
  }
};
struct Epi3GateB : Epi3RowChunks<Epi3GateB> {
  const bf16_t* zG; const float* bg; bf16_t* mrg;
  __device__ Epi3GateB(const bf16_t* z, const float* b, bf16_t* m) : zG(z), bg(b), mrg(m) {}
  __device__ __forceinline__ void store(int m, int n, const u32x4& v) const {
    const u32x4 g = *(const u32x4*)(zG + (size_t)m * 2048 + 1024 + n);
    const u32x4 a = *(const u32x4*)(mrg + (size_t)m * DM + n);
    const f32x4 b0 = *(const f32x4*)(bg + 1024 + n), b1 = *(const f32x4*)(bg + 1024 + n + 4);
    u32x4 o;
#pragma unroll
    for (int i = 0; i < 4; ++i) {
      const float bl = i < 2 ? b0[2 * i] : b1[2 * i - 4], bh = i < 2 ? b0[2 * i + 1] : b1[2 * i - 3];
      o[i] = pack2(bflo(a[i]) + sigmoidf_(bflo(g[i]) + bl) * bflo(v[i]), bfhi(a[i]) + sigmoidf_(bfhi(g[i]) + bh) * bfhi(v[i]));
    }
    *(u32x4*)(mrg + (size_t)m * DM + n) = o;
  }
};
struct Epi3ZS {
  bf16_t* zA; const float* mu; int own_lo, own_hi, t0, T;
  __device__ __forceinline__ void finish(const bf16_t* sE, int m0, int n0, int tid) const {
#pragma unroll 4
    for (int pq = 0; pq < 16; ++pq) {
      const int id = tid + 256 * pq, row = id >> 4, cc = (id & 15) * 8, t = t0 + row;
      if (row < own_lo || row > own_hi) continue;
      const u32x4 zc = *(const u32x4*)(sE + row * G3_ES + cc);
      u32x4 zp = (u32x4){0u, 0u, 0u, 0u}, zn = (u32x4){0u, 0u, 0u, 0u};
      if (t > 0) zp = *(const u32x4*)(sE + (row - 1) * G3_ES + cc);
      if (t < T - 1) zn = *(const u32x4*)(sE + (row + 1) * G3_ES + cc);
      const f32x4 m0v = *(const f32x4*)(mu + n0 + cc), m1v = *(const f32x4*)(mu + n0 + cc + 4);
      const float mm[8] = {m0v[0], m0v[1], m0v[2], m0v[3], m1v[0], m1v[1], m1v[2], m1v[3]};
      u32x4 o;
#pragma unroll
      for (int i = 0; i < 4; ++i) {
        const float z0 = bflo(zc[i]), z1 = bfhi(zc[i]);
        o[i] = pack2(z0 + mm[2 * i] * (0.5f * (bflo(zp[i]) + bflo(zn[i])) - z0), z1 + mm[2 * i + 1] * (0.5f * (bfhi(zp[i]) + bfhi(zn[i])) - z1));
      }
      *(u32x4*)(zA + (long)(m0 + row) * SHIFTC + n0 + cc) = o;
    }
  }
};
struct Epi3Z : Epi3RowChunks<Epi3Z> {
  bf16_t *zA, *zP, *zG;
  __device__ Epi3Z(bf16_t* a, bf16_t* b, bf16_t* c) : zA(a), zP(b), zG(c) {}
  __device__ __forceinline__ void store(int m, int n, const u32x4& v) const {
    if (n < SHIFTC) *(u32x4*)(zA + (size_t)m * SHIFTC + n) = v;
    else if (m < NTOK) {
      if (n < SHIFTC + 512) *(u32x4*)(zP + (size_t)m * 512 + (n - SHIFTC)) = v;
      else *(u32x4*)(zG + (size_t)m * 2048 + (n - SHIFTC - 512)) = v;
    }
  }
};

struct EpiStoreBf16 {
  bf16_t* C; int ldc;
  __device__ __forceinline__ void operator()(int m, int n, const f32x4& v) const {
    uint2 w; w.x = pack2(v[0], v[1]); w.y = pack2(v[2], v[3]);
    *(uint2*)(C + (size_t)m * ldc + n) = w;
  }
};
struct EpiZ {
  bf16_t *zA, *zP, *zG;
  __device__ __forceinline__ void operator()(int m, int n, const f32x4& v) const {
    uint2 w; w.x = pack2(v[0], v[1]); w.y = pack2(v[2], v[3]);
    if (n < SHIFTC) *(uint2*)(zA + (size_t)m * SHIFTC + n) = w;
    else if (m < NTOK) {
      if (n < SHIFTC + 512) *(uint2*)(zP + (size_t)m * 512 + (n - SHIFTC)) = w;
      else *(uint2*)(zG + (size_t)m * 2048 + (n - SHIFTC - 512)) = w;
    }
  }
};
struct EpiLds {
  float* S;
  __device__ __forceinline__ void operator()(int m, int n, const f32x4& v) const {
    float* r = S + (m & 127) * 133 + n + (n >> 5);
    r[0] = v[0]; r[1] = v[1]; r[2] = v[2]; r[3] = v[3];
  }
};

__device__ __forceinline__ void ph_transpose(const float* __restrict__ in, bf16_t* __restrict__ out, int K, int N, int vb, int nvb, unsigned char* smem) {
  float* t = (float*)smem;
  const int tk = K / 64, tn = N / 64, tid = threadIdx.x, tx = tid & 15, ty = tid >> 4;
  for (int it = vb; it < tk * tn; it += nvb) {
    const int k0 = (it / tn) * 64, n0 = (it % tn) * 64;
    __syncthreads();
#pragma unroll
    for (int r = 0; r < 4; ++r) {
      const f32x4 v = *(const f32x4*)(in + (size_t)(k0 + ty + 16 * r) * N + n0 + 4 * tx);
#pragma unroll
      for (int e = 0; e < 4; ++e) t[(ty + 16 * r) * 65 + 4 * tx + e] = v[e];
    }
    __syncthreads();
    const int n = tid >> 2, kq = (tid & 3) * 16;
    u32x4 w0, w1;
#pragma unroll
    for (int e = 0; e < 4; ++e) {
      w0[e] = pack2(t[(kq + 2 * e) * 65 + n], t[(kq + 2 * e + 1) * 65 + n]);
      w1[e] = pack2(t[(kq + 8 + 2 * e) * 65 + n], t[(kq + 8 + 2 * e + 1) * 65 + n]);
    }
    *(u32x4*)(out + (size_t)(n0 + n) * K + k0 + kq) = w0;
    *(u32x4*)(out + (size_t)(n0 + n) * K + k0 + kq + 8) = w1;
  }
}
__device__ __forceinline__ void ph_convert(const float* __restrict__ in, bf16_t* __restrict__ out, size_t n, int vb, int nvb) {
  for (size_t i = ((size_t)vb * 256 + threadIdx.x) * 4; i < n; i += (size_t)nvb * 1024) {
    const float4 v = *(const float4*)(in + i);
    uint2 w; w.x = pack2(v.x, v.y); w.y = pack2(v.z, v.w);
    *(uint2*)(out + i) = w;
  }
}
__device__ __forceinline__ void ph_weff(const P& p, int vb, int nvb) {
  for (int it = vb * 256 + threadIdx.x; it < 512 * 1024; it += nvb * 256) {
    const int n = it & 1023, k = it >> 10, j = k >> 7, kl = k & 127;
    const float* wp = p.w_pool + ((size_t)j * 128 + kl) * 128;
    float s = 0.f;
    for (int c = 0; c < 128; ++c) s += wp[c] * p.pool_scale[j * 128 + c] * p.w_b_out[(size_t)(j * 128 + c) * 1024 + n];
    p.Wt_eff[(size_t)n * 512 + k] = f2bf(s);
  }
}
__device__ __forceinline__ void ph_mod(const P& p, int vb, int nvb, unsigned char* smem) {
  float* red = (float*)smem;
  const int lane = threadIdx.x & 63, wid = threadIdx.x >> 6;
  for (int it = vb; it < 96; it += nvb) {
    const int n = it * 64 + lane;
    float a0 = 0.f, a1 = 0.f, a2 = 0.f;
#pragma unroll 32
    for (int k = wid * 256; k < wid * 256 + 256; ++k) {
      const float w = p.w_mod[(size_t)k * 6144 + n];
      const float c0 = p.c[k], c1 = p.c[1024 + k], c2 = p.c_ctx[k];
      a0 += c0 * sigmoidf_(c0) * w; a1 += c1 * sigmoidf_(c1) * w; a2 += c2 * sigmoidf_(c2) * w;
    }
    __syncthreads();
    red[(wid * 3 + 0) * 64 + lane] = a0; red[(wid * 3 + 1) * 64 + lane] = a1; red[(wid * 3 + 2) * 64 + lane] = a2;
    __syncthreads();
    if (wid < 3) {
      const float sum = red[(0 * 3 + wid) * 64 + lane] + red[(1 * 3 + wid) * 64 + lane] + red[(2 * 3 + wid) * 64 + lane] + red[(3 * 3 + wid) * 64 + lane];
      p.mod[wid * 6144 + n] = sum + p.b_mod[n];
    }
  }
}
__device__ __forceinline__ float wave_sum(float v) {
#pragma unroll
  for (int o = 32; o > 0; o >>= 1) v += __shfl_xor(v, o);
  return v;
}
__device__ __forceinline__ void ph_norm1(const P& p, int vb, int nvb) {
  const int lane = threadIdx.x & 63, wid = threadIdx.x >> 6, nw = nvb * 4;
  for (int m0 = vb * 4 + wid; m0 < MROWS; m0 += 2 * nw) {
    const int m1 = m0 + nw; const bool has1 = m1 < MROWS; const int mb = has1 ? m1 : m0;
    const float* srcA = m0 < NTOK ? p.x + (size_t)m0 * DM : p.ctx + (size_t)(m0 - NTOK) * DM;
    const float* srcB = mb < NTOK ? p.x + (size_t)mb * DM : p.ctx + (size_t)(mb - NTOK) * DM;
    f32x4 va[4], vbq[4]; float sa = 0.f, sb = 0.f;
#pragma unroll
    for (int i = 0; i < 4; ++i) { va[i] = *(const f32x4*)(srcA + i * 256 + lane * 4); vbq[i] = *(const f32x4*)(srcB + i * 256 + lane * 4); }
#pragma unroll
    for (int i = 0; i < 4; ++i)
#pragma unroll
      for (int e = 0; e < 4; ++e) { sa += va[i][e] * va[i][e]; sb += vbq[i][e] * vbq[i][e]; }
    sa = wave_sum(sa); sb = wave_sum(sb);
#pragma unroll
    for (int rr = 0; rr < 2; ++rr) {
      if (rr == 1 && !has1) break;
      const int m = rr == 0 ? m0 : m1;
      const float rstd = rsqrtf((rr == 0 ? sa : sb) * (1.0f / 1024.0f) + 1e-6f);
      const float* md = p.mod + (m < NTOK ? (m / SEQ) : 2) * 6144;
#pragma unroll
      for (int i = 0; i < 4; ++i) {
        const int col = i * 256 + lane * 4;
        const f32x4 v = rr == 0 ? va[i] : vbq[i];
        const f32x4 g = *(const f32x4*)(p.g_pre_mix + col), sh = *(const f32x4*)(md + col), sc = *(const f32x4*)(md + 1024 + col);
        u32x2 w;
        w.x = pack2(v[0] * rstd * g[0] * (1.f + sc[0]) + sh[0], v[1] * rstd * g[1] * (1.f + sc[1]) + sh[1]);
        w.y = pack2(v[2] * rstd * g[2] * (1.f + sc[2]) + sh[2], v[3] * rstd * g[3] * (1.f + sc[3]) + sh[3]);
        *(u32x2*)(p.hx + (size_t)m * DM + col) = w;
      }
    }
  }
}
struct Epi3Readout {
  const P* pp;
  __device__ __forceinline__ void finish(const bf16_t* sE, int m0, int n0, int tid) const {
    const P& p = *pp;
#pragma unroll 2
    for (int pq = 0; pq < 16; ++pq) {
      const int id = tid + 256 * pq, row = id >> 4, cc = (id & 15) * 8, m = m0 + row, n = n0 + cc, t = m % SEQ, h = n >> 6;
      const u32x4 g = *(const u32x4*)(sE + row * G3_ES + cc);
      const u32x4 y0 = *(const u32x4*)(p.Y0 + (size_t)m * DM + n), y1 = *(const u32x4*)(p.Y1 + (size_t)m * DM + n);
      float y[8], v[8];
#pragma unroll
      for (int i = 0; i < 4; ++i) { y[2 * i] = bflo(y0[i]) + bflo(y1[i]); y[2 * i + 1] = bfhi(y0[i]) + bfhi(y1[i]); }
      float sm = 0.f;
#pragma unroll
      for (int i = 0; i < 8; ++i) sm += y[i];
      const float mu = red8(sm) * (1.f / 64.f);
      float qv = 0.f;
#pragma unroll
      for (int i = 0; i < 8; ++i) { y[i] -= mu; qv += y[i] * y[i]; }
      const float rs = rsqrtf(red8(qv) * (1.f / 64.f) + 64e-5f);
      load8(p.zA, m, 2048 + n, v);
      const float bon = 0.5f * (p.bdot[(size_t)m * 16 + h] + p.bdot[((size_t)NTOK + m) * 16 + h]);
      const f32x4 w0 = *(const f32x4*)(p.ln_x_w + n), w1 = *(const f32x4*)(p.ln_x_w + n + 4), b0 = *(const f32x4*)(p.ln_x_b + n), b1 = *(const f32x4*)(p.ln_x_b + n + 4);
      const float lw[8] = {w0[0], w0[1], w0[2], w0[3], w1[0], w1[1], w1[2], w1[3]}, lb[8] = {b0[0], b0[1], b0[2], b0[3], b1[0], b1[1], b1[2], b1[3]};
      u32x4 o;
#pragma unroll
      for (int i = 0; i < 4; ++i)
        o[i] = pack2((y[2 * i] * rs * lw[2 * i] + lb[2 * i] + bon * v[2 * i]) * bflo(g[i]), (y[2 * i + 1] * rs * lw[2 * i + 1] + lb[2 * i + 1] + bon * v[2 * i + 1]) * bfhi(g[i]));
      *(u32x4*)(p.out_a + (size_t)m * DM + n) = o;
    }
  }
};
__device__ __forceinline__ int xcd_tile(int vb, int nvb, int round, int TM, int TN, int& tm, int& tn) {
  if (nvb % 64 != 0) { const int it = round * nvb + vb; if (it >= TM * TN) return 0; tm = it % TM; tn = it / TM; return 1; }
  const int spg = nvb >> 3, g = vb & 7, slot = vb >> 3, SC = spg >> 3;
  const int nsr = (TM + 7) >> 3, nsc = (TN + SC - 1) / SC, st = round * 8 + g;
  if (st >= nsr * nsc) return 0;
  tm = (st % nsr) * 8 + (slot & 7); tn = (st / nsr) * SC + (slot >> 3);
  return (tm < TM && tn < TN) ? 1 : 2;
}
__device__ __forceinline__ void ph_gemm1(const P& p, int vb, int nvb, unsigned char* smem) {
  const int NS_ = 132 * 27, NALL = NS_ + 128 * 20;
  const int per = nvb >> 3;
  for (int round = 0;; ++round) {
    int item;
    if ((nvb & 7) == 0) { const int blk = round * 8 + (vb & 7); if (blk * per >= NALL) break; item = blk * per + (vb >> 3); if (item >= NALL) continue; }
    else { item = round * nvb + vb; if (item >= NALL) break; }
    if (item < NS_) {
      const int cgp = item / (132 * 9), rem = item % (132 * 9), tmS = rem / 9, tn = cgp * 9 + rem % 9;
      Epi3ZS epi;
      epi.zA = p.zA; epi.mu = p.mu_shift;
      int m0;
      if (tmS < 130) { const int b = tmS / 65, i = tmS % 65; m0 = b * SEQ + 254 * i - 1; epi.own_lo = 1; epi.own_hi = min(254, SEQ - 254 * i); epi.t0 = 254 * i - 1; epi.T = SEQ; }
      else { m0 = NTOK + (tmS - 130) * CTXL; epi.own_lo = 0; epi.own_hi = 255; epi.t0 = 0; epi.T = CTXL; }
      gemm_tile3(p.hx, DM, p.Wt_in, DM, DM, m0, tn * 128, epi, smem);
    } else {
      const int i2 = item - NS_;
      int tm, tn;
      if (i2 < 2048) { tm = (i2 & 1023) >> 3; tn = 27 + (i2 >> 10) * 8 + (i2 & 7); } else { tm = (i2 - 2048) >> 2; tn = 43 + (i2 & 3); }
      Epi3Z epi{p.zA, p.zP, p.zG};
      gemm_tile3(p.hx, DM, p.Wt_in, DM, DM, tm * 256, tn * 128, epi, smem);
    }
  }
}
__device__ __forceinline__ void ph_readout_gemm(const P& p, int vb, int nvb, unsigned char* smem) {
  Epi3Readout epi{&p};
  for (int round = 0;; ++round) {
    int tm, tn; const int r = xcd_tile(vb, nvb, round, NTOK / 256, DM / 128, tm, tn);
    if (r == 0) break;
    if (r == 1) gemm_tile3(p.sg, 128, p.g2T, 128, 128, tm * 256, tn * 128, epi, smem);
  }
}
__device__ __forceinline__ void ph_sg(const P& p, int vb, int nvb) {
  for (int it = vb * 256 + threadIdx.x; it < NTOK * 16; it += nvb * 256) {
    const int m = it >> 4, l8 = (it & 15) * 8, t = m % SEQ;
    float o[8];
    load8(p.zA, m, 3328 + l8, o);
    u32x4 w;
#pragma unroll
    for (int i = 0; i < 4; ++i) w[i] = pack2(sigmoidf_(o[2 * i]), sigmoidf_(o[2 * i + 1]));
    *(u32x4*)(p.sg + (size_t)m * 128 + l8) = w;
  }
}
__device__ __forceinline__ void ph_gemm_merge(const P& p, int vb, int nvb, unsigned char* smem) {
  Epi3GateA ea{p.zG, p.b_gate, p.mrg};
  Epi3GateB eb{p.zG, p.b_gate, p.mrg};
  for (int round = 0;; ++round) {
    int tm, tn; const int r = xcd_tile(vb, nvb, round, NTOK / 256, DM / 128, tm, tn);
    if (r == 0) break;
    if (r == 1) {
      gemm_tile3(p.out_a, DM, p.Wt_aout, DM, DM, tm * 256, tn * 128, ea, smem);
      gemm_tile3(p.pooled, 512, p.Wt_eff, 512, 512, tm * 256, tn * 128, eb, smem);
    }
  }
}
__device__ __forceinline__ void ph_gemm_simple(const bf16_t* A, int lda, const bf16_t* Bt, int ldb, int K, int M, int N, bf16_t* C, int ldc, int vb, int nvb, unsigned char* smem) {
  Epi3StoreBf16 epi{C, ldc};
  for (int round = 0;; ++round) {
    int tm, tn; const int r = xcd_tile(vb, nvb, round, M / 256, N / 128, tm, tn);
    if (r == 0) break;
    if (r == 1) gemm_tile3(A, lda, Bt, ldb, K, tm * 256, tn * 128, epi, smem);
  }
}


#define O_R1 0
#define O_R2 10240
#define O_TA (O_R2 + 17408)
#define O_TR (O_TA + 4608)
#define O_TB (O_TR + 4608)
#define O_TK (O_TB + 4608)
#define O_TBT (O_TK + 4608)
#define O_TKT (O_TBT + 5120)
#define O_TVT (O_TKT + 5120)
#define O_GAM (O_TVT + 5120)
#define O_TST (O_GAM + 256)
#define RWKV_SMEM (O_TST + 2 * 9216)
#define NSUP 65
__device__ __forceinline__ void lds_wave_fence() { asm volatile("s_waitcnt lgkmcnt(0)" ::: "memory"); }
__device__ __forceinline__ u32x2 pack4(const f32x4& v) { u32x2 r; r.x = pack2(v[0], v[1]); r.y = pack2(v[2], v[3]); return r; }

struct RwkvConsts { bf16x8 w2f[2], a2f[2]; };

typedef short s16x4 __attribute__((ext_vector_type(4)));
__device__ __forceinline__ float fast_tanh(float x) { const float e = __expf(2.0f * x); return 1.0f - __fdividef(2.0f, e + 1.0f); }
template <int NS, bool WANTY>
__device__ __forceinline__ void rwkv_chunk(const P& p, unsigned char* smem, int d, int h, int rowbase, int T, int isc0, bool has_next, f32x4 (&st)[NS][4], u32x4 (&pf)[5]) {
  int tid = threadIdx.x;
  asm volatile("" : "+v"(tid));
  const int lane = tid & 63, w = __builtin_amdgcn_readfirstlane(tid >> 6), l15 = lane & 15, q = lane >> 4;
  const int tt = tid >> 3, cg = tid & 7, ch0 = h * 64 + cg * 8;
  const int isc = isc0 + tt, t = d == 0 ? isc : T - 1 - isc;
  bf16_t* TWD = (bf16_t*)(smem + O_R1); bf16_t* TAD = TWD + 32 * 72;
  float* WT = (float*)(smem + O_R1);
  bf16_t* XT = (bf16_t*)(smem + O_R1); bf16_t* UT = XT + 64 * 40;
  float* LW = (float*)(smem + O_R2); float* LA = LW + 32 * 68;
  float* TL = (float*)(smem + O_R2);
  bf16_t* TT = (bf16_t*)(smem + O_R2 + 4608); bf16_t* TAK = TT + 32 * 40; bf16_t* TRB = TAK + 32 * 40; bf16_t* TRK = TRB + 32 * 40; bf16_t* TLB = TRK + 32 * 40;
  bf16_t* TA = (bf16_t*)(smem + O_TA); bf16_t* TR = (bf16_t*)(smem + O_TR); bf16_t* TB = (bf16_t*)(smem + O_TB); bf16_t* TK = (bf16_t*)(smem + O_TK);
  bf16_t* TBT = (bf16_t*)(smem + O_TBT); bf16_t* TKT = (bf16_t*)(smem + O_TKT); bf16_t* TVT = (bf16_t*)(smem + O_TVT);
  float* GAM = (float*)(smem + O_GAM);
  bf16_t* TST = (bf16_t*)(smem + O_TST);
  __syncthreads();
  float k8[8], r8[8];
  {
    u32x4 pk;
#pragma unroll
    for (int i = 0; i < 4; ++i) pk[i] = pack2(fast_tanh(bflo(pf[0][i])), fast_tanh(bfhi(pf[0][i])));
    *(u32x4*)(TWD + tt * 72 + cg * 8) = pk;
    *(u32x4*)(TAD + tt * 72 + cg * 8) = pf[1];
  }
#pragma unroll
  for (int i = 0; i < 4; ++i) { k8[2 * i] = bflo(pf[2][i]); k8[2 * i + 1] = bfhi(pf[2][i]); if (WANTY) { r8[2 * i] = bflo(pf[3][i]); r8[2 * i + 1] = bfhi(pf[3][i]); } }
  const u32x4 vzc = pf[4];
  __syncthreads();
  {
    f32x4 lw[2], la[2];
    bf16x8 w2f[2], a2f[2];
#pragma unroll
    for (int ks = 0; ks < 2; ++ks) {
      w2f[ks] = *(const bf16x8*)(p.w2T + ((size_t)d * 1024 + h * 64 + 16 * w + l15) * 64 + 32 * ks + 8 * q);
      a2f[ks] = *(const bf16x8*)(p.a2T + ((size_t)d * 1024 + h * 64 + 16 * w + l15) * 64 + 32 * ks + 8 * q);
    }
#pragma unroll
    for (int it = 0; it < 2; ++it) { lw[it] = (f32x4){0.f, 0.f, 0.f, 0.f}; la[it] = (f32x4){0.f, 0.f, 0.f, 0.f}; }
#pragma unroll
    for (int ks = 0; ks < 2; ++ks)
#pragma unroll
      for (int it = 0; it < 2; ++it) {
        const bf16x8 aw = *(const bf16x8*)(TWD + (16 * it + l15) * 72 + 32 * ks + 8 * q);
        const bf16x8 aa = *(const bf16x8*)(TAD + (16 * it + l15) * 72 + 32 * ks + 8 * q);
        lw[it] = __builtin_amdgcn_mfma_f32_16x16x32_bf16(aw, w2f[ks], lw[it], 0, 0, 0);
        la[it] = __builtin_amdgcn_mfma_f32_16x16x32_bf16(aa, a2f[ks], la[it], 0, 0, 0);
      }
    {
      const float cw0 = p.w0[d * 1024 + h * 64 + 16 * w + l15];
      float tot0 = 0.f;
#pragma unroll
      for (int it = 0; it < 2; ++it) {
        float pr[4];
#pragma unroll
        for (int rg = 0; rg < 4; ++rg) {
          const float xw = -(cw0 + lw[it][rg]);
          const float sp = fmaxf(xw, 0.f) + __logf(1.0f + __expf(-fabsf(xw)));
          const float e = __expf(-sp - 0.5f);
          pr[rg] = rg == 0 ? e : pr[rg - 1] + e;
        }
        float x = pr[3];
        float y = __shfl_up(x, 16); if (q >= 1) x += y;
        y = __shfl_up(x, 32); if (q >= 2) x += y;
        const float base = (x - pr[3]) + (it == 1 ? tot0 : 0.f);
        if (it == 0) tot0 = __shfl(x, 48 + l15);
#pragma unroll
        for (int rg = 0; rg < 4; ++rg) lw[it][rg] = pr[rg] + base;
      }
      if (q == 3) GAM[16 * w + l15] = __expf(-lw[1][3]);
    }
#pragma unroll
    for (int it = 0; it < 2; ++it)
#pragma unroll
      for (int rg = 0; rg < 4; ++rg) { LW[(16 * it + 4 * q + rg) * 68 + 16 * w + l15] = lw[it][rg]; LA[(16 * it + 4 * q + rg) * 68 + 16 * w + l15] = la[it][rg]; }
  }
  __syncthreads();
  float icl[8], kkn[8], kd[8];
  {
    float ss = 0.f, bd = 0.f;
    float ca0[8], ckk[8], cka[8], crk[8];
#pragma unroll
    for (int e4 = 0; e4 < 8; e4 += 4) {
      const f32x4 b2 = *(const f32x4*)(p.a0 + d * 1024 + ch0 + e4), c2 = *(const f32x4*)(p.k_k + ch0 + e4);
      const f32x4 d2 = *(const f32x4*)(p.k_a + ch0 + e4), f2 = *(const f32x4*)(p.r_k + ch0 + e4);
#pragma unroll
      for (int e = 0; e < 4; ++e) { ca0[e4 + e] = b2[e]; ckk[e4 + e] = c2[e]; cka[e4 + e] = d2[e]; crk[e4 + e] = f2[e]; }
    }
#pragma unroll
    for (int e = 0; e < 8; ++e) {
      icl[e] = sigmoidf_(ca0[e] + LA[tt * 68 + cg * 8 + e]);
      kkn[e] = k8[e] * ckk[e]; ss += kkn[e] * kkn[e];
      kd[e] = k8[e] * (1.f + (icl[e] - 1.f) * cka[e]);
      if (WANTY) bd += r8[e] * kd[e] * crk[e];
    }
    ss = red8(ss); if (WANTY) bd = red8(bd);
    const float rn = rsqrtf(fmaxf(ss, 1e-24f));
#pragma unroll
    for (int e = 0; e < 8; ++e) kkn[e] *= rn;
    if (WANTY && cg == 0) p.bdot[((size_t)d * NTOK + rowbase + t) * 16 + h] = bd;
  }
  {
    float ta[8], tr[8], tb[8], tk[8], v8[8];
#pragma unroll
    for (int i = 0; i < 4; ++i) { v8[2 * i] = bflo(vzc[i]); v8[2 * i + 1] = bfhi(vzc[i]); }
#pragma unroll
    for (int e = 0; e < 8; ++e) {
      const float Li = LW[tt * 68 + cg * 8 + e];
      const float Lp = tt > 0 ? LW[(tt - 1) * 68 + cg * 8 + e] : 0.f;
      const float gi = __expf(-Li), gim1 = __expf(-Lp), ginv = __expf(Li);
      ta[e] = -kkn[e] * gim1; if (WANTY) tr[e] = r8[e] * gi; tb[e] = kkn[e] * icl[e] * ginv; tk[e] = kd[e] * ginv;
    }
    u32x4 pk;
    pk.x = pack2(ta[0], ta[1]); pk.y = pack2(ta[2], ta[3]); pk.z = pack2(ta[4], ta[5]); pk.w = pack2(ta[6], ta[7]); *(u32x4*)(TA + tt * 72 + cg * 8) = pk;
    if (WANTY) { pk.x = pack2(tr[0], tr[1]); pk.y = pack2(tr[2], tr[3]); pk.z = pack2(tr[4], tr[5]); pk.w = pack2(tr[6], tr[7]); *(u32x4*)(TR + tt * 72 + cg * 8) = pk; }
    pk.x = pack2(tb[0], tb[1]); pk.y = pack2(tb[2], tb[3]); pk.z = pack2(tb[4], tb[5]); pk.w = pack2(tb[6], tb[7]); *(u32x4*)(TB + tt * 72 + cg * 8) = pk;
    pk.x = pack2(tk[0], tk[1]); pk.y = pack2(tk[2], tk[3]); pk.z = pack2(tk[4], tk[5]); pk.w = pack2(tk[6], tk[7]); *(u32x4*)(TK + tt * 72 + cg * 8) = pk;
#pragma unroll
    for (int e = 0; e < 8; ++e) { TBT[(cg * 8 + e) * 40 + tt] = f2bf(tb[e]); TKT[(cg * 8 + e) * 40 + tt] = f2bf(tk[e]); TVT[(cg * 8 + e) * 40 + tt] = f2bf(v8[e]); }
  }
  __syncthreads();
  if (WANTY || w < 2) {
    const bf16_t* X = (w < 2) ? TA : TR; const bf16_t* Y = (w & 1) ? TK : TB;
    f32x4 g[2][2];
#pragma unroll
    for (int it = 0; it < 2; ++it)
#pragma unroll
      for (int s2 = 0; s2 < 2; ++s2) g[it][s2] = (f32x4){0.f, 0.f, 0.f, 0.f};
#pragma unroll
    for (int ks = 0; ks < 2; ++ks) {
      bf16x8 xa[2], yb[2];
#pragma unroll
      for (int it = 0; it < 2; ++it) { xa[it] = *(const bf16x8*)(X + (16 * it + l15) * 72 + 32 * ks + 8 * q); yb[it] = *(const bf16x8*)(Y + (16 * it + l15) * 72 + 32 * ks + 8 * q); }
#pragma unroll
      for (int it = 0; it < 2; ++it)
#pragma unroll
        for (int s2 = 0; s2 < 2; ++s2) g[it][s2] = __builtin_amdgcn_mfma_f32_16x16x32_bf16(xa[it], yb[s2], g[it][s2], 0, 0, 0);
    }
    bf16_t* dst = w == 1 ? TAK : (w == 2 ? TRB : TRK);
#pragma unroll
    for (int it = 0; it < 2; ++it)
#pragma unroll
      for (int s2 = 0; s2 < 2; ++s2)
#pragma unroll
        for (int rg = 0; rg < 4; ++rg) {
          const int i = 16 * it + 4 * q + rg, s = 16 * s2 + l15;
          const float val = g[it][s2][rg];
          if (w == 0) {
            TL[i * 36 + s] = (s < i) ? val : 0.f;
            if (it == 1 && s2 == 0) TLB[(i - 16) * 40 + s] = f2bf(val);
          } else dst[i * 40 + s] = f2bf(((w == 1) ? (s < i) : (s <= i)) ? val : 0.f);
        }
  }
  if (w == 0) {
    lds_wave_fence();
    const int c = lane & 15, hb = lane & 16;
    float Tr[16];
#pragma unroll
    for (int i = 0; i < 16; ++i) {
      float acc = (i == c) ? 1.f : 0.f;
#pragma unroll
      for (int j4 = 0; j4 < (i + 3) / 4; ++j4) {
        const f32x4 l4 = *(const f32x4*)(TL + (hb + i) * 36 + hb + 4 * j4);
#pragma unroll
        for (int jj = 0; jj < 4; ++jj) if (4 * j4 + jj < i) acc += l4[jj] * Tr[4 * j4 + jj];
      }
      Tr[i] = acc;
    }
    if (lane < 32) {
#pragma unroll
      for (int i = 0; i < 16; ++i) TT[(hb + i) * 40 + hb + c] = f2bf(Tr[i]);
    }
  }
  __syncthreads();
  if (has_next) {
    const int isn = isc + 32, tn = d == 0 ? isn : T - 1 - isn;
    const bf16_t* zr = p.zA + (size_t)(rowbase + tn) * SHIFTC;
    pf[0] = *(const u32x4*)(zr + 3072 + d * 64 + cg * 8);
    pf[1] = *(const u32x4*)(zr + 3200 + d * 64 + cg * 8);
    pf[2] = *(const u32x4*)(zr + 1024 + ch0);
    if (WANTY) pf[3] = *(const u32x4*)(zr + ch0);
    pf[4] = *(const u32x4*)(zr + 2048 + ch0);
  }
  const bf16x8 vfr = *(const bf16x8*)(TVT + (16 * w + l15) * 40 + 8 * q);
  const s16x4 t1f = *(const s16x4*)(TT + l15 * 40 + 4 * q), t2f = *(const s16x4*)(TT + (16 + l15) * 40 + 16 + 4 * q), l21f = *(const s16x4*)(TLB + l15 * 40 + 4 * q);
  bf16_t* XTw = XT + (16 * w + l15) * 40; bf16_t* UTw = UT + (16 * w + l15) * 40;
#pragma unroll
  for (int si = 0; si < NS; ++si) {
    const bool useV = (NS == 1) || (si == 1);
    const bf16_t* STs = TST + (si * 64 + 16 * w + l15) * 72;
    bf16x8 sf[2];
    sf[0] = *(const bf16x8*)(STs + 8 * q); sf[1] = *(const bf16x8*)(STs + 32 + 8 * q);
    f32x4 xa[2];
#pragma unroll
    for (int it = 0; it < 2; ++it) {
      xa[it] = (f32x4){0.f, 0.f, 0.f, 0.f};
#pragma unroll
      for (int ks = 0; ks < 2; ++ks) xa[it] = __builtin_amdgcn_mfma_f32_16x16x32_bf16(*(const bf16x8*)(TA + (16 * it + l15) * 72 + 32 * ks + 8 * q), sf[ks], xa[it], 0, 0, 0);
      if (useV) xa[it] = __builtin_amdgcn_mfma_f32_16x16x32_bf16(*(const bf16x8*)(TAK + (16 * it + l15) * 40 + 8 * q), vfr, xa[it], 0, 0, 0);
    }
    *(u32x2*)(XTw + 4 * q) = pack4(xa[0]);
    lds_wave_fence();
    f32x4 ua = __builtin_amdgcn_mfma_f32_16x16x16bf16_1k(t1f, *(const s16x4*)(XTw + 4 * q), (f32x4){0.f, 0.f, 0.f, 0.f}, 0, 0, 0);
    *(u32x2*)(UTw + 4 * q) = pack4(ua);
    lds_wave_fence();
    xa[1] = __builtin_amdgcn_mfma_f32_16x16x16bf16_1k(l21f, *(const s16x4*)(UTw + 4 * q), xa[1], 0, 0, 0);
    *(u32x2*)(XTw + 16 + 4 * q) = pack4(xa[1]);
    lds_wave_fence();
    ua = __builtin_amdgcn_mfma_f32_16x16x16bf16_1k(t2f, *(const s16x4*)(XTw + 16 + 4 * q), (f32x4){0.f, 0.f, 0.f, 0.f}, 0, 0, 0);
    *(u32x2*)(UTw + 16 + 4 * q) = pack4(ua);
    lds_wave_fence();
    const bf16x8 uf = *(const bf16x8*)(UTw + 8 * q);
    if (WANTY) {
#pragma unroll
      for (int it = 0; it < 2; ++it) {
        f32x4 ya = (f32x4){0.f, 0.f, 0.f, 0.f};
#pragma unroll
        for (int ks = 0; ks < 2; ++ks) ya = __builtin_amdgcn_mfma_f32_16x16x32_bf16(*(const bf16x8*)(TR + (16 * it + l15) * 72 + 32 * ks + 8 * q), sf[ks], ya, 0, 0, 0);
        ya = __builtin_amdgcn_mfma_f32_16x16x32_bf16(*(const bf16x8*)(TRB + (16 * it + l15) * 40 + 8 * q), uf, ya, 0, 0, 0);
        ya = __builtin_amdgcn_mfma_f32_16x16x32_bf16(*(const bf16x8*)(TRK + (16 * it + l15) * 40 + 8 * q), vfr, ya, 0, 0, 0);
        bf16_t* Yd = d == 0 ? p.Y0 : p.Y1;
#pragma unroll
        for (int rg = 0; rg < 4; ++rg) {
          const int iq = isc0 + 16 * it + 4 * q + rg, tq = d == 0 ? iq : T - 1 - iq;
          Yd[(size_t)(rowbase + tq) * DM + h * 64 + 16 * w + l15] = f2bf(ya[rg]);
        }
      }
    }
#pragma unroll
    for (int kt = 0; kt < 4; ++kt) {
      f32x4 hv = st[si][kt];
      hv = __builtin_amdgcn_mfma_f32_16x16x32_bf16(*(const bf16x8*)(TBT + (16 * kt + l15) * 40 + 8 * q), uf, hv, 0, 0, 0);
      if (useV) hv = __builtin_amdgcn_mfma_f32_16x16x32_bf16(*(const bf16x8*)(TKT + (16 * kt + l15) * 40 + 8 * q), vfr, hv, 0, 0, 0);
      hv *= *(const f32x4*)(GAM + 16 * kt + 4 * q);
      st[si][kt] = hv;
      *(u32x2*)(TST + (si * 64 + 16 * w + l15) * 72 + 16 * kt + 4 * q) = pack4(hv);
    }
  }
}

template <bool WANTY>
__device__ __forceinline__ void rwkv_prefetch_first(const P& p, int d, int h, int rowbase, int T, int isc0, u32x4 (&pf)[5]) {
  const int tid = threadIdx.x, tt = tid >> 3, cg = tid & 7, ch0 = h * 64 + cg * 8, isc = isc0 + tt, t = d == 0 ? isc : T - 1 - isc;
  const bf16_t* zr = p.zA + (size_t)(rowbase + t) * SHIFTC;
  pf[0] = *(const u32x4*)(zr + 3072 + d * 64 + cg * 8);
  pf[1] = *(const u32x4*)(zr + 3200 + d * 64 + cg * 8);
  pf[2] = *(const u32x4*)(zr + 1024 + ch0);
  pf[3] = WANTY ? *(const u32x4*)(zr + ch0) : (u32x4){0u, 0u, 0u, 0u};
  pf[4] = *(const u32x4*)(zr + 2048 + ch0);
}
__device__ __forceinline__ void rwkv_consts(const P& p, int d, int h, RwkvConsts& cc) {
  const int tid = threadIdx.x, lane = tid & 63, w = tid >> 6, l15 = lane & 15, q = lane >> 4;
#pragma unroll
  for (int ks = 0; ks < 2; ++ks) {
    cc.w2f[ks] = *(const bf16x8*)(p.w2T + ((size_t)d * 1024 + h * 64 + 16 * w + l15) * 64 + 32 * ks + 8 * q);
    cc.a2f[ks] = *(const bf16x8*)(p.a2T + ((size_t)d * 1024 + h * 64 + 16 * w + l15) * 64 + 32 * ks + 8 * q);
  }
}
__device__ __forceinline__ void ph_rwkv_A(const P& p, int vb, int nvb, unsigned char* smem) {
  const int tid = threadIdx.x, lane = tid & 63, w = tid >> 6, l15 = lane & 15, q = lane >> 4;
  bf16_t* TST = (bf16_t*)(smem + O_TST);
  for (int item = vb; item < 64 * 64; item += nvb) {
    const int chain = item >> 6, j = item & 63, b = chain >> 5, d = (chain >> 4) & 1, h = chain & 15;
    const bool latent = j > 0;
    const int T = latent ? SEQ : CTXL, rowbase = latent ? b * SEQ : NTOK + b * CTXL, base = latent ? (j - 1) * 256 : 0;
    RwkvConsts cc; rwkv_consts(p, d, h, cc);
    f32x4 st[2][4];
    __syncthreads();
#pragma unroll
    for (int kt = 0; kt < 4; ++kt) {
#pragma unroll
      for (int rg = 0; rg < 4; ++rg) st[0][kt][rg] = (16 * kt + 4 * q + rg == 16 * w + l15) ? 1.f : 0.f;
      st[1][kt] = (f32x4){0.f, 0.f, 0.f, 0.f};
      *(u32x2*)(TST + (16 * w + l15) * 72 + 16 * kt + 4 * q) = pack4(st[0][kt]);
      *(u32x2*)(TST + (64 + 16 * w + l15) * 72 + 16 * kt + 4 * q) = pack4(st[1][kt]);
    }
    u32x4 pf[5]; rwkv_prefetch_first<false>(p, d, h, rowbase, T, base, pf);
    for (int c = 0; c < 8; ++c) rwkv_chunk<2, false>(p, smem, d, h, rowbase, T, base + 32 * c, c < 7, st, pf);
    const size_t slot = (size_t)chain * NSUP + j;
#pragma unroll
    for (int kt = 0; kt < 4; ++kt) {
#pragma unroll
      for (int rg = 0; rg < 4; ++rg) p.Mst[(slot * 64 + 16 * kt + 4 * q + rg) * 64 + 16 * w + l15] = f2bf(st[0][kt][rg]);
      *(f32x4*)(p.Nst + (slot * 64 + 16 * w + l15) * 64 + 16 * kt + 4 * q) = st[1][kt];
    }
  }
}
__device__ __forceinline__ void ph_rwkv_B(const P& p, int vb, int nvb, unsigned char* smem) {
  const int tid = threadIdx.x, lane = tid & 63, w = tid >> 6, l15 = lane & 15, q = lane >> 4;
  bf16_t* HT = (bf16_t*)smem;
  for (int chain = vb; chain < 64; chain += nvb) {
    f32x4 hs[4];
#pragma unroll
    for (int kt = 0; kt < 4; ++kt) hs[kt] = (f32x4){0.f, 0.f, 0.f, 0.f};
    __syncthreads();
    for (int j = 0; j < 64; ++j) {
      const size_t slot = (size_t)chain * NSUP + j;
      f32x4 nv[4];
#pragma unroll
      for (int kt = 0; kt < 4; ++kt) nv[kt] = *(const f32x4*)(p.Nst + (slot * 64 + 16 * w + l15) * 64 + 16 * kt + 4 * q);
      bf16x8 mf[4][2];
#pragma unroll
      for (int kt = 0; kt < 4; ++kt)
#pragma unroll
        for (int ks = 0; ks < 2; ++ks) mf[kt][ks] = *(const bf16x8*)(p.Mst + (slot * 64 + 16 * kt + l15) * 64 + 32 * ks + 8 * q);
#pragma unroll
      for (int kt = 0; kt < 4; ++kt) {
        *(f32x4*)(p.Nst + (slot * 64 + 16 * w + l15) * 64 + 16 * kt + 4 * q) = hs[kt];
        *(u32x2*)(HT + (16 * w + l15) * 72 + 16 * kt + 4 * q) = pack4(hs[kt]);
      }
      lds_wave_fence();
      bf16x8 hf[2];
      hf[0] = *(const bf16x8*)(HT + (16 * w + l15) * 72 + 8 * q); hf[1] = *(const bf16x8*)(HT + (16 * w + l15) * 72 + 32 + 8 * q);
      lds_wave_fence();
#pragma unroll
      for (int kt = 0; kt < 4; ++kt) {
        f32x4 a = nv[kt];
#pragma unroll
        for (int ks = 0; ks < 2; ++ks) a = __builtin_amdgcn_mfma_f32_16x16x32_bf16(mf[kt][ks], hf[ks], a, 0, 0, 0);
        hs[kt] = a;
      }
    }
    const size_t slot = (size_t)chain * NSUP + 64;
#pragma unroll
    for (int kt = 0; kt < 4; ++kt) *(f32x4*)(p.Nst + (slot * 64 + 16 * w + l15) * 64 + 16 * kt + 4 * q) = hs[kt];
  }
}
__device__ __forceinline__ void ph_rwkv_C(const P& p, int vb, int nvb, unsigned char* smem) {
  const int tid = threadIdx.x, lane = tid & 63, w = tid >> 6, l15 = lane & 15, q = lane >> 4;
  bf16_t* TST = (bf16_t*)(smem + O_TST);
  for (int item = vb; item < 64 * 64; item += nvb) {
    const int chain = item >> 6, j = (item & 63) + 1, b = chain >> 5, d = (chain >> 4) & 1, h = chain & 15;
    RwkvConsts cc; rwkv_consts(p, d, h, cc);
    f32x4 st[1][4];
    const size_t slot = (size_t)chain * NSUP + j;
    __syncthreads();
#pragma unroll
    for (int kt = 0; kt < 4; ++kt) {
      st[0][kt] = *(const f32x4*)(p.Nst + (slot * 64 + 16 * w + l15) * 64 + 16 * kt + 4 * q);
      *(u32x2*)(TST + (16 * w + l15) * 72 + 16 * kt + 4 * q) = pack4(st[0][kt]);
    }
    u32x4 pf[5]; rwkv_prefetch_first<true>(p, d, h, b * SEQ, SEQ, (j - 1) * 256, pf);
    for (int c = 0; c < 8; ++c) rwkv_chunk<1, true>(p, smem, d, h, b * SEQ, SEQ, (j - 1) * 256 + 32 * c, c < 7, st, pf);
  }
}

#define RO_SMEM (128 * 16 * 4)
__device__ __forceinline__ void ph_readout(const P& p, int vb, int nvb, unsigned char* smem) {
  float* sgT = (float*)smem;
  const int tid = threadIdx.x, c4 = tid * 4, h = tid >> 4;
  const float4 lnw = *(const float4*)(p.ln_x_w + c4), lnb = *(const float4*)(p.ln_x_b + c4);
  for (int item = vb; item < NTOK / 16; item += nvb) {
    const int tok0 = item * 16;
    __syncthreads();
    {
      const int tk = tid >> 4, l8 = (tid & 15) * 8, m = tok0 + tk, b = m / SEQ, t = m % SEQ;
      float o[8];
      load_shift8(p.zA, p.mu_shift, b * SEQ, t, SEQ, 3328 + l8, o);
#pragma unroll
      for (int e = 0; e < 8; ++e) sgT[(l8 + e) * 16 + tk] = sigmoidf_(o[e]);
    }
    __syncthreads();
    float4 g[16];
#pragma unroll
    for (int k = 0; k < 16; ++k) g[k] = make_float4(0.f, 0.f, 0.f, 0.f);
    for (int l = 0; l < 128; ++l) {
      const float4 w = *(const float4*)(p.g2 + (size_t)l * 1024 + c4);
      const float4 s0 = *(const float4*)(sgT + l * 16), s1 = *(const float4*)(sgT + l * 16 + 4), s2 = *(const float4*)(sgT + l * 16 + 8), s3 = *(const float4*)(sgT + l * 16 + 12);
      const float sv[16] = {s0.x, s0.y, s0.z, s0.w, s1.x, s1.y, s1.z, s1.w, s2.x, s2.y, s2.z, s2.w, s3.x, s3.y, s3.z, s3.w};
#pragma unroll
      for (int k = 0; k < 16; ++k) { g[k].x += sv[k] * w.x; g[k].y += sv[k] * w.y; g[k].z += sv[k] * w.z; g[k].w += sv[k] * w.w; }
    }
#pragma unroll
    for (int k = 0; k < 16; ++k) {
      const int m = tok0 + k, b = m / SEQ, t = m % SEQ;
      const uint2 y0 = *(const uint2*)(p.Y0 + (size_t)m * DM + c4), y1 = *(const uint2*)(p.Y1 + (size_t)m * DM + c4);
      float y[4] = {bflo(y0.x) + bflo(y1.x), bfhi(y0.x) + bfhi(y1.x), bflo(y0.y) + bflo(y1.y), bfhi(y0.y) + bfhi(y1.y)};
      const float mu = red16(y[0] + y[1] + y[2] + y[3]) * (1.f / 64.f);
      float q = 0.f;
#pragma unroll
      for (int e = 0; e < 4; ++e) { y[e] -= mu; q += y[e] * y[e]; }
      const float rs = rsqrtf(red16(q) * (1.f / 64.f) + 64e-5f);
      const bf16_t* zr = p.zA + (size_t)m * SHIFTC + 2048 + c4;
      const uint2 zc = *(const uint2*)zr;
      uint2 zp = make_uint2(0, 0), zn = make_uint2(0, 0);
      if (t > 0) zp = *(const uint2*)(zr - SHIFTC);
      if (t < SEQ - 1) zn = *(const uint2*)(zr + SHIFTC);
      const float4 mu4 = *(const float4*)(p.mu_shift + 2048 + c4);
      float v[4];
      v[0] = bflo(zc.x) + mu4.x * (0.5f * (bflo(zp.x) + bflo(zn.x)) - bflo(zc.x));
      v[1] = bfhi(zc.x) + mu4.y * (0.5f * (bfhi(zp.x) + bfhi(zn.x)) - bfhi(zc.x));
      v[2] = bflo(zc.y) + mu4.z * (0.5f * (bflo(zp.y) + bflo(zn.y)) - bflo(zc.y));
      v[3] = bfhi(zc.y) + mu4.w * (0.5f * (bfhi(zp.y) + bfhi(zn.y)) - bfhi(zc.y));
      const float bon = 0.5f * (p.bdot[(size_t)m * 16 + h] + p.bdot[((size_t)NTOK + m) * 16 + h]);
      const float o0 = (y[0] * rs * lnw.x + lnb.x + bon * v[0]) * g[k].x, o1 = (y[1] * rs * lnw.y + lnb.y + bon * v[1]) * g[k].y;
      const float o2 = (y[2] * rs * lnw.z + lnb.z + bon * v[2]) * g[k].z, o3 = (y[3] * rs * lnw.w + lnb.w + bon * v[3]) * g[k].w;
      uint2 w; w.x = pack2(o0, o1); w.y = pack2(o2, o3);
      *(uint2*)(p.out_a + (size_t)m * DM + c4) = w;
    }
  }
}

#define POOL_SMEM (64 * 128 * 4)
__device__ __forceinline__ void ph_pool(const P& p, int vb, int nvb, unsigned char* smem) {
  float* V = (float*)smem;
  const int tid = threadIdx.x;
  for (int item = vb; item < 2 * 256 * 4; item += nvb) {
    const int j = item & 3, r = (item >> 2) & 255, b = item >> 10;
    const int win = 2 << j, half = win >> 1;
    const int r0 = max(r - half, 0), r1 = min(r + half, 256);
    __syncthreads();
    const int cp = tid & 63, cq = tid >> 6;
    float a0[16], a1[16];
#pragma unroll
    for (int i = 0; i < 16; ++i) { a0[i] = 0.f; a1[i] = 0.f; }
    for (int rr = r0; rr < r1; ++rr) {
      const bf16_t* base = p.zP + ((size_t)b * SEQ + rr * 64) * 512 + j * 128 + cp * 2;
#pragma unroll
      for (int i = 0; i < 16; ++i) {
        const unsigned u = *(const unsigned*)(base + (size_t)(cq + 4 * i) * 512);
        a0[i] += bflo(u); a1[i] += bfhi(u);
      }
    }
#pragma unroll
    for (int i = 0; i < 16; ++i) { V[(cq + 4 * i) * 128 + cp * 2] = a0[i]; V[(cq + 4 * i) * 128 + cp * 2 + 1] = a1[i]; }
    __syncthreads();
#pragma unroll
    for (int i = 0; i < 16; ++i) {
      const int col = cq + 4 * i, c0 = max(col - half, 0), c1 = min(col + half, 64);
      float s0 = 0.f, s1 = 0.f;
      for (int cc = c0; cc < c1; ++cc) { s0 += V[cc * 128 + cp * 2]; s1 += V[cc * 128 + cp * 2 + 1]; }
      const float inv = 1.0f / (float)((r1 - r0) * (c1 - c0));
      const size_t tokoff = ((size_t)b * SEQ + r * 64 + col) * 512 + j * 128 + cp * 2;
      const unsigned u = *(const unsigned*)(p.zP + tokoff);
      *(unsigned*)(p.pooled + tokoff) = pack2(s0 * inv - bflo(u), s1 * inv - bfhi(u));
    }
  }
}
__device__ __forceinline__ void ph_merge(const P& p, int vb, int nvb) {
  for (size_t i = ((size_t)vb * 256 + threadIdx.x) * 4; i < (size_t)NTOK * DM; i += (size_t)nvb * 1024) {
    const size_t m = i >> 10; const int c = (int)(i & 1023);
    const uint2 g1 = *(const uint2*)(p.zG + m * 2048 + c), g2 = *(const uint2*)(p.zG + m * 2048 + 1024 + c);
    const uint2 a = *(const uint2*)(p.ya + i), bq = *(const uint2*)(p.yb + i);
    const float4 b1 = *(const float4*)(p.b_gate + c), b2 = *(const float4*)(p.b_gate + 1024 + c);
    const float m0 = sigmoidf_(bflo(g1.x) + b1.x) * bflo(a.x) + sigmoidf_(bflo(g2.x) + b2.x) * bflo(bq.x);
    const float m1 = sigmoidf_(bfhi(g1.x) + b1.y) * bfhi(a.x) + sigmoidf_(bfhi(g2.x) + b2.y) * bfhi(bq.x);
    const float m2 = sigmoidf_(bflo(g1.y) + b1.z) * bflo(a.y) + sigmoidf_(bflo(g2.y) + b2.z) * bflo(bq.y);
    const float m3 = sigmoidf_(bfhi(g1.y) + b1.w) * bfhi(a.y) + sigmoidf_(bfhi(g2.y) + b2.w) * bfhi(bq.y);
    uint2 w; w.x = pack2(m0, m1); w.y = pack2(m2, m3);
    *(uint2*)(p.mrg + i) = w;
  }
}
__device__ __forceinline__ void ph_res1(const P& p, int vb, int nvb) {
  const int lane = threadIdx.x & 63, wid = threadIdx.x >> 6;
  for (int m = vb * 4 + wid; m < NTOK; m += nvb * 4) {
    const float* md = p.mod + (m / SEQ) * 6144;
    float mx[16]; float ss = 0.f;
#pragma unroll
    for (int i = 0; i < 4; ++i) {
      const uint2 u = *(const uint2*)(p.mix + (size_t)m * DM + i * 256 + lane * 4);
      mx[4 * i] = bflo(u.x); mx[4 * i + 1] = bfhi(u.x); mx[4 * i + 2] = bflo(u.y); mx[4 * i + 3] = bfhi(u.y);
#pragma unroll
      for (int e = 0; e < 4; ++e) ss += mx[4 * i + e] * mx[4 * i + e];
    }
    ss = wave_sum(ss);
    const float rstd = rsqrtf(ss * (1.0f / 1024.0f) + 1e-6f);
    float x1[16]; float s2 = 0.f;
#pragma unroll
    for (int i = 0; i < 4; ++i) {
      const int col = i * 256 + lane * 4;
      const float4 xv = *(const float4*)(p.x + (size_t)m * DM + col), g = *(const float4*)(p.g_post_mix + col), gt = *(const float4*)(md + 2048 + col);
      x1[4 * i] = xv.x + gt.x * mx[4 * i] * rstd * g.x; x1[4 * i + 1] = xv.y + gt.y * mx[4 * i + 1] * rstd * g.y;
      x1[4 * i + 2] = xv.z + gt.z * mx[4 * i + 2] * rstd * g.z; x1[4 * i + 3] = xv.w + gt.w * mx[4 * i + 3] * rstd * g.w;
      *(float4*)(p.out + (size_t)m * DM + col) = make_float4(x1[4 * i], x1[4 * i + 1], x1[4 * i + 2], x1[4 * i + 3]);
#pragma unroll
      for (int e = 0; e < 4; ++e) s2 += x1[4 * i + e] * x1[4 * i + e];
    }
    s2 = wave_sum(s2);
    const float r2 = rsqrtf(s2 * (1.0f / 1024.0f) + 1e-6f);
#pragma unroll
    for (int i = 0; i < 4; ++i) {
      const int col = i * 256 + lane * 4;
      const float4 g = *(const float4*)(p.g_pre_ffn + col), sh = *(const float4*)(md + 3072 + col), sc = *(const float4*)(md + 4096 + col);
      uint2 w;
      w.x = pack2(x1[4 * i] * r2 * g.x * (1.f + sc.x) + sh.x, x1[4 * i + 1] * r2 * g.y * (1.f + sc.y) + sh.y);
      w.y = pack2(x1[4 * i + 2] * r2 * g.z * (1.f + sc.z) + sh.z, x1[4 * i + 3] * r2 * g.w * (1.f + sc.w) + sh.w);
      *(uint2*)(p.hx2 + (size_t)m * DM + col) = w;
    }
  }
}

#define PS1_SMEM (128 * 133 * 4)
#define CE_DESC(a, b) { const float _mx = fmaxf(a, b), _mn = fminf(a, b); a = _mx; b = _mn; }
template <int N> __device__ __forceinline__ void bitonic_sort_desc(float (&v)[N]) {
#pragma unroll
  for (int k = 2; k <= N; k <<= 1)
#pragma unroll
    for (int j = k >> 1; j > 0; j >>= 1)
#pragma unroll
      for (int i = 0; i < N; ++i) { const int l = i ^ j; if (l > i) { if ((i & k) == 0) CE_DESC(v[i], v[l]) else CE_DESC(v[l], v[i]) } }
}
__device__ __forceinline__ void bitonic_merge16_desc(float (&v)[16]) {
#pragma unroll
  for (int j = 8; j > 0; j >>= 1)
#pragma unroll
    for (int i = 0; i < 16; ++i) { const int l = i ^ j; if (l > i) CE_DESC(v[i], v[l]) }
}
__device__ __forceinline__ void ph_peer_s1(const P& p, int vb, int nvb, unsigned char* smem) {
  float* S = (float*)smem;
  EpiLds epi{S};
  const int tid = threadIdx.x, sub = tid & 3;
  for (int item = vb; item < 256 * 16; item += nvb) {
    const int hp = item & 15, tm = item >> 4;
    __syncthreads();
    gemm_tile(p.q + hp * 128, 2048, p.keys + (size_t)hp * 128 * 128, 128, 128, tm * 128, 0, epi, smem);
    __syncthreads();
#pragma unroll 1
    for (int pass = 0; pass < 2; ++pass) {
      const int row = pass * 64 + (tid >> 2);
      float a[16], b[16];
#pragma unroll
      for (int i = 0; i < 16; ++i) {
        a[i] = __uint_as_float((__float_as_uint(S[row * 133 + sub * 33 + i]) & ~127u) | (unsigned)(sub * 32 + i));
        b[i] = __uint_as_float((__float_as_uint(S[row * 133 + sub * 33 + 16 + i]) & ~127u) | (unsigned)(sub * 32 + 16 + i));
      }
      bitonic_sort_desc<16>(a); bitonic_sort_desc<16>(b);
#pragma unroll
      for (int i = 0; i < 16; ++i) a[i] = fmaxf(a[i], b[15 - i]);
      bitonic_merge16_desc(a);
#pragma unroll
      for (int lvl = 1; lvl <= 2; lvl <<= 1) {
#pragma unroll
        for (int i = 0; i < 16; ++i) b[i] = __shfl_xor(a[i], lvl);
#pragma unroll
        for (int i = 0; i < 16; ++i) a[i] = fmaxf(a[i], b[15 - i]);
        bitonic_merge16_desc(a);
      }
      if (sub == 0) {
        const size_t ob = ((size_t)(tm * 128 + row) * 16 + hp) * 16;
#pragma unroll
        for (int i = 0; i < 16; i += 4) {
          *(f32x4*)(p.sv + ob + i) = (f32x4){a[i], a[i + 1], a[i + 2], a[i + 3]};
          typedef int i32x4 __attribute__((ext_vector_type(4)));
          *(i32x4*)(p.si + ob + i) = (i32x4){(int)(__float_as_uint(a[i]) & 127u), (int)(__float_as_uint(a[i + 1]) & 127u), (int)(__float_as_uint(a[i + 2]) & 127u), (int)(__float_as_uint(a[i + 3]) & 127u)};
        }
      }
    }
  }
}
__device__ __forceinline__ void top16_merge(float (&x)[16], const float (&y)[16]) {
#pragma unroll
  for (int i = 0; i < 16; ++i) x[i] = fmaxf(x[i], y[15 - i]);
  bitonic_merge16_desc(x);
}
__device__ __forceinline__ void ph_peer_s2(const P& p, int vb, int nvb, unsigned char* smem) {
  unsigned char* lut = smem;
  __syncthreads();
  if (threadIdx.x == 0) {
    int n = 0;
#pragma unroll
    for (int i = 0; i < 16; ++i)
#pragma unroll
      for (int j = 0; j < 16; ++j)
        if ((i + 1) * (j + 1) <= 16) { lut[n] = (unsigned char)((i << 4) | j); ++n; }
  }
  __syncthreads();
  for (int it = vb * 256 + threadIdx.x; it < NTOK * 8; it += nvb * 256) {
    const size_t ob = (size_t)it * 32;
    float a[16], bq[16];
#pragma unroll
    for (int i = 0; i < 16; i += 4) {
      const f32x4 fa = *(const f32x4*)(p.sv + ob + i), fb = *(const f32x4*)(p.sv + ob + 16 + i);
#pragma unroll
      for (int e = 0; e < 4; ++e) { a[i + e] = fa[e]; bq[i + e] = fb[e]; }
    }
    float g0[16], g1[16], g2[16], g3[16];
    {
      int n = 0;
#pragma unroll
      for (int i = 0; i < 16; ++i)
#pragma unroll
        for (int j = 0; j < 16; ++j)
          if ((i + 1) * (j + 1) <= 16) {
            const float v = __uint_as_float((__float_as_uint(a[i] + bq[j]) & ~63u) | (unsigned)n);
            if (n < 16) g0[n] = v; else if (n < 32) g1[n - 16] = v; else if (n < 48) g2[n - 32] = v; else g3[n - 48] = v;
            ++n;
          }
#pragma unroll
      for (int k = 2; k < 16; ++k) g3[k] = -3.0e38f;
    }
    bitonic_sort_desc<16>(g0); bitonic_sort_desc<16>(g1); bitonic_sort_desc<16>(g2); bitonic_sort_desc<16>(g3);
    top16_merge(g0, g1); top16_merge(g2, g3); top16_merge(g0, g2);
    float den = 0.f; float ex[16]; int seli[16];
#pragma unroll
    for (int k = 0; k < 16; ++k) {
      ex[k] = __expf(g0[k] - g0[0]); den += ex[k];
      const int ij = lut[__float_as_uint(g0[k]) & 63u];
      const int ka = (int)(__float_as_uint(p.sv[ob + (ij >> 4)]) & 127u), kb = (int)(__float_as_uint(p.sv[ob + 16 + (ij & 15)]) & 127u);
      seli[k] = ka * 128 + kb;
    }
    const float inv = 1.0f / den;
    const size_t o2 = (size_t)it * 16;
    typedef int i32x4 __attribute__((ext_vector_type(4)));
#pragma unroll
    for (int k = 0; k < 16; k += 4) {
      *(i32x4*)(p.pidx + o2 + k) = (i32x4){seli[k], seli[k + 1], seli[k + 2], seli[k + 3]};
      *(f32x4*)(p.pgate + o2 + k) = (f32x4){ex[k] * inv, ex[k + 1] * inv, ex[k + 2] * inv, ex[k + 3] * inv};
    }
  }
}
typedef float f32x2 __attribute__((ext_vector_type(2)));
typedef float f32x16 __attribute__((ext_vector_type(16)));
typedef float f32x32 __attribute__((ext_vector_type(32)));
typedef unsigned u32x6 __attribute__((ext_vector_type(6)));
__device__ __forceinline__ float half_max(float v) {
#pragma unroll
  for (int o = 16; o > 0; o >>= 1) v = fmaxf(v, __shfl_xor(v, o));
  return v;
}
__device__ __forceinline__ float half_sum(float v) {
#pragma unroll
  for (int o = 16; o > 0; o >>= 1) v += __shfl_xor(v, o);
  return v;
}
__device__ __forceinline__ void ph_cvt_fp6(const float* __restrict__ in, unsigned char* __restrict__ out, float* __restrict__ inv_scale, int vb, int nvb) {
  const int lane = threadIdx.x & 63, wid = threadIdx.x >> 6, hf = lane >> 5, sl = lane & 31;
  for (int rp = vb * 4 + wid; rp < 8192; rp += nvb * 4) {
    const int row = rp * 2 + hf;
    f32x16 a, b2; float am = 0.f;
#pragma unroll
    for (int i = 0; i < 4; ++i) {
      const f32x4 v0 = *(const f32x4*)(in + (size_t)row * DM + sl * 32 + 4 * i), v1 = *(const f32x4*)(in + (size_t)row * DM + sl * 32 + 16 + 4 * i);
#pragma unroll
      for (int e = 0; e < 4; ++e) { a[4 * i + e] = v0[e]; b2[4 * i + e] = v1[e]; am = fmaxf(am, fmaxf(fabsf(v0[e]), fabsf(v1[e]))); }
    }
    am = half_max(am);
    const float sc = am > 0.f ? 7.0f / am : 1.0f;
    const u32x6 pk = __builtin_amdgcn_cvt_scalef32_2xpk16_fp6_f32(a * sc, b2 * sc, 1.0f);
    unsigned char* o = out + (size_t)row * 768 + sl * 24;
    *(u32x2*)(o) = (u32x2){pk[0], pk[1]}; *(u32x2*)(o + 8) = (u32x2){pk[2], pk[3]}; *(u32x2*)(o + 16) = (u32x2){pk[4], pk[5]};
    if (sl == 0) inv_scale[row] = am > 0.f ? am / 7.0f : 1.0f;
  }
}
__device__ __forceinline__ u32x6 load_row6(const unsigned char* base, int id, int sl) {
  const unsigned char* q = base + (size_t)id * 768 + sl * 24;
  const u32x2 a = *(const u32x2*)q, b = *(const u32x2*)(q + 8), c = *(const u32x2*)(q + 16);
  return (u32x6){a.x, a.y, b.x, b.y, c.x, c.y};
}
#define GATHER_SMEM (4 * 64 * 33 * 4)
__device__ __forceinline__ void ph_peer_gather(const P& p, int vb, int nvb, unsigned char* smem) {
  int tid_ = threadIdx.x;
  asm volatile("" : "+v"(tid_));
  const int lane = tid_ & 63, wid = tid_ >> 6, hf = lane >> 5, sl = lane & 31;
  float* scr = (float*)smem + (wid * 64 + lane) * 33;
  int* tauL = (int*)(smem + GATHER_SMEM) + wid * 32;
  {
    f32x16 a, b2;
#pragma unroll
    for (int i = 0; i < 16; ++i) { a[i] = __uint_as_float((unsigned)i << 20) * 0x1p126f; b2[i] = __uint_as_float((unsigned)(16 + i) << 20) * 0x1p126f; }
    const f32x32 o = __builtin_amdgcn_cvt_scalef32_pk32_f32_fp6(__builtin_amdgcn_cvt_scalef32_2xpk16_fp6_f32(a, b2, 1.0f), 1.0f);
    if (lane == 0) {
#pragma unroll
      for (int j = 0; j < 32; ++j) tauL[j] = (int)((__float_as_uint(o[j] * 0x1p-126f) >> 20) & 31u);
    }
  }
  const int jmap = 2 * (lane & 1) + ((lane >> 1) & 1);
  __syncthreads();
  for (int m = vb * 4 + wid; m < NTOK; m += nvb * 4) {
    const float* md = p.mod + (m / SEQ) * 6144;
    float xh[32];
    {
#pragma unroll
      for (int c4 = 0; c4 < 4; ++c4) {
        const u32x4 u = *(const u32x4*)(p.hx2 + (size_t)m * DM + sl * 32 + 8 * c4);
#pragma unroll
        for (int e = 0; e < 4; ++e) { scr[8 * c4 + 2 * e] = bflo(u[e]); scr[8 * c4 + 2 * e + 1] = bfhi(u[e]); }
      }
      lds_wave_fence();
#pragma unroll
      for (int j = 0; j < 32; ++j) xh[j] = scr[tauL[j]];
      lds_wave_fence();
    }
    const int id0 = p.pidx[(size_t)m * 128 + lane], id1 = p.pidx[(size_t)m * 128 + 64 + lane];
    const float su0 = p.us[id0], su1 = p.us[id1];
    const float gs0 = p.pgate[(size_t)m * 128 + lane] * p.vs[id0], gs1 = p.pgate[(size_t)m * 128 + 64 + lane] * p.vs[id1];
    float acch[32];
#pragma unroll
    for (int k = 0; k < 32; ++k) acch[k] = 0.f;
#pragma unroll 1
    for (int e0 = 0; e0 < 128; e0 += 8) {
      u32x6 ur[4], vr[4];
#pragma unroll
      for (int j = 0; j < 4; ++j) {
        const int id = __shfl(e0 < 64 ? id0 : id1, (e0 + hf * 4 + j) & 63);
        ur[j] = load_row6(p.ub8, id, sl);
        vr[j] = load_row6(p.vb8, id, sl);
      }
      float d[4];
#pragma unroll
      for (int j = 0; j < 4; ++j) {
        const f32x32 f = __builtin_amdgcn_cvt_scalef32_pk32_f32_fp6(ur[j], 1.0f);
        float s0 = 0.f, s1 = 0.f;
#pragma unroll
        for (int k = 0; k < 32; k += 2) { s0 += f[k] * xh[k]; s1 += f[k + 1] * xh[k + 1]; }
        d[j] = s0 + s1;
      }
      float r2[2], r1;
      {
        const bool lo = (lane & 1) == 0;
#pragma unroll
        for (int i = 0; i < 2; ++i) { const float keep = lo ? d[i] : d[i + 2], send = lo ? d[i + 2] : d[i]; r2[i] = keep + __shfl_xor(send, 1); }
        const bool lo2 = (lane & 2) == 0;
        { const float keep = lo2 ? r2[0] : r2[1], send = lo2 ? r2[1] : r2[0]; r1 = keep + __shfl_xor(send, 2); }
        r1 += __shfl_xor(r1, 4); r1 += __shfl_xor(r1, 8); r1 += __shfl_xor(r1, 16);
      }
      const int esrc = (e0 + hf * 4 + jmap) & 63;
      const float su = __shfl(e0 < 64 ? su0 : su1, esrc), gs = __shfl(e0 < 64 ? gs0 : gs1, esrc);
      const float sdot = r1 * su;
      const float cf = 0.5f * sdot * (1.0f + erff(sdot * 0.70710678118654752f)) * gs;
#pragma unroll
      for (int j = 0; j < 4; ++j) {
        const float cj = __shfl(cf, (lane & 32) | ((j >> 1) | ((j & 1) << 1)));
        const f32x32 f = __builtin_amdgcn_cvt_scalef32_pk32_f32_fp6(vr[j], 1.0f);
#pragma unroll
        for (int k = 0; k < 32; ++k) acch[k] += cj * f[k];
      }
    }
#pragma unroll
    for (int k = 0; k < 32; ++k) { acch[k] += __shfl_xor(acch[k], 32); scr[tauL[k]] = acch[k]; }
    lds_wave_fence();
    float ss = 0.f;
#pragma unroll
    for (int k = 0; k < 32; ++k) { const float v = scr[k]; ss += v * v; }
    ss = half_sum(ss);
    const float rstd = rsqrtf(ss * (1.0f / 1024.0f) + 1e-6f);
#pragma unroll
    for (int k4 = 0; k4 < 4; ++k4) {
      const int kk = hf * 16 + k4 * 4, col = sl * 32 + kk;
      f32x4 x1 = *(const f32x4*)(p.out + (size_t)m * DM + col);
      const f32x4 g = *(const f32x4*)(p.g_post_ffn + col), gt = *(const f32x4*)(md + 5120 + col);
#pragma unroll
      for (int e = 0; e < 4; ++e) x1[e] += gt[e] * scr[kk + e] * rstd * g[e];
      *(f32x4*)(p.out + (size_t)m * DM + col) = x1;
    }
    lds_wave_fence();
  }
}

#define XB_TMO      128
#define XB_XCNT(j)  (256  + 64 * (j))
#define XB_XSUB(j)  (1280 + 64 * (j))
#define XB_XGEN(j)  (2304 + 64 * (j))
#define XB_TOP      3328
#define XB_TOPGEN   3392
#define XCD_BAR_WORDS 3456
#define XB_SPIN_CAP (1u << 20)
#define LAS __attribute__((address_space(3)))
__device__ __forceinline__ unsigned xb_ld(unsigned* p)              { return __hip_atomic_load(p, __ATOMIC_RELAXED, __HIP_MEMORY_SCOPE_AGENT); }
__device__ __forceinline__ unsigned xb_add(unsigned* p, unsigned v) { return __hip_atomic_fetch_add(p, v, __ATOMIC_RELAXED, __HIP_MEMORY_SCOPE_AGENT); }
__device__ __forceinline__ unsigned xb_xcc_id() { return (unsigned)__builtin_amdgcn_s_getreg((3 << 11) | 20) & 0xFu; }
#define XB_SPIN(cond, bar) do { unsigned _sp = 0; while (cond) { __builtin_amdgcn_s_sleep(1); \
    if ((++_sp & 255u) == 0u) { if (xb_ld(&(bar)[XB_TMO])) break; if (_sp > XB_SPIN_CAP) { atomicAdd(&(bar)[XB_TMO], 1u); break; } } } } while (0)
struct XcdBarrier { unsigned* bar; unsigned x; volatile LAS unsigned* st; };
__device__ __forceinline__ XcdBarrier xcd_barrier_post(unsigned* bar, volatile LAS unsigned* st) {
  XcdBarrier b; b.bar = bar; b.x = xb_xcc_id(); b.st = st;
  if (threadIdx.x == 0) (void)xb_add(&bar[XB_XCNT(b.x)], 1u);
  return b;
}
__device__ __forceinline__ void xcd_barrier_complete(unsigned* bar, unsigned x, unsigned& nloc, unsigned& nx) {
  const unsigned G = gridDim.x * gridDim.y * gridDim.z;
  unsigned sum, cnt, mine, sp = 0u;
  for (;;) {
    sum = 0u; cnt = 0u; mine = 0u;
#pragma unroll
    for (unsigned j = 0; j < 16; ++j) { const unsigned c = xb_ld(&bar[XB_XCNT(j)]); sum += c; cnt += (c > 0u) ? 1u : 0u; mine = (j == x) ? c : mine; }
    if (sum == G) break;
    __builtin_amdgcn_s_sleep(1);
    if ((++sp & 255u) == 0u) { if (xb_ld(&bar[XB_TMO])) break; if (sp > XB_SPIN_CAP) { atomicAdd(&bar[XB_TMO], 1u); break; } }
  }
  nloc = mine > 0u ? mine : 1u; nx = cnt > 0u ? cnt : 1u;
}
__device__ __forceinline__ void xcd_barrier(const XcdBarrier& b) {
  asm volatile("s_waitcnt vmcnt(0)" ::: "memory");
  __syncthreads();
  if (threadIdx.x == 0) {
    unsigned* bar = b.bar;
    __builtin_amdgcn_s_waitcnt(0);
    unsigned nloc = b.st[0], nx = b.st[1];
    if (nloc == 0u) { xcd_barrier_complete(bar, b.x, nloc, nx); b.st[0] = nloc; b.st[1] = nx; }
    const unsigned old = xb_add(&bar[XB_XSUB(b.x)], 1u);
    const unsigned gen = old / nloc;
    if (old + 1u == (gen + 1u) * nloc) {
      __builtin_amdgcn_fence(__ATOMIC_RELEASE, "agent");
      asm volatile("s_waitcnt vmcnt(0)" ::: "memory");
      const unsigned og = xb_add(&bar[XB_TOP], 1u);
      const unsigned tg = og / nx;
      if (og + 1u == (tg + 1u) * nx) xb_add(&bar[XB_TOPGEN], 1u);
      else XB_SPIN(xb_ld(&bar[XB_TOPGEN]) == tg, bar);
      __builtin_amdgcn_fence(__ATOMIC_ACQUIRE, "agent");
      xb_add(&bar[XB_XGEN(b.x)], 1u);
      asm volatile("s_waitcnt vmcnt(0)" ::: "memory");
    } else {
      XB_SPIN(xb_ld(&bar[XB_XGEN(b.x)]) == gen, bar);
      __builtin_amdgcn_fence(__ATOMIC_ACQUIRE, "agent");
      asm volatile("s_waitcnt vmcnt(0)" ::: "memory");
    }
  }
  __syncthreads();
}

#define SMEM_BYTES RWKV_SMEM
__global__ void __launch_bounds__(256, 2) mega(P p) {
  __shared__ __attribute__((aligned(16))) unsigned char smem[SMEM_BYTES + 16];
  cg::grid_group grid = cg::this_grid();
  const int vb = blockIdx.x, nvb = gridDim.x;
  if (threadIdx.x == 0) *(u32x4*)(smem + SMEM_BYTES) = (u32x4){0u, 0u, 0u, 0u};
  __syncthreads();
  const XcdBarrier xb = xcd_barrier_post(p.bar, (volatile LAS unsigned*)(smem + SMEM_BYTES));
  ph_mod(p, vb, nvb, smem);
  ph_transpose(p.w_in, p.Wt_in, DM, INC, vb, nvb, smem);
  ph_transpose(p.w2, p.w2T, 64, 1024, vb, nvb, smem);
  ph_transpose(p.w2 + 65536, p.w2T + 65536, 64, 1024, vb, nvb, smem);
  ph_transpose(p.a2, p.a2T, 64, 1024, vb, nvb, smem);
  ph_transpose(p.a2 + 65536, p.a2T + 65536, 64, 1024, vb, nvb, smem);
  if (p.bar == nullptr) grid.sync();
  xcd_barrier(xb);
  ph_norm1(p, vb, nvb);
  xcd_barrier(xb);
  ph_gemm1(p, vb, nvb, smem);
  xcd_barrier(xb);
  ph_rwkv_A(p, vb, nvb, smem);
  xcd_barrier(xb);
  ph_rwkv_B(p, vb, nvb, smem);
  if (nvb > 128 && vb >= 64) {
    const int v2 = vb - 64, n2 = nvb - 64;
    ph_transpose(p.w_a_out, p.Wt_aout, DM, DM, v2, n2, smem);
    ph_transpose(p.w_o, p.Wt_o, DM, DM, v2, n2, smem);
    ph_transpose(p.peer_wq, p.Wt_q, DM, 2048, v2, n2, smem);
    ph_transpose(p.g2, p.g2T, 128, 1024, v2, n2, smem);
    ph_weff(p, v2, n2);
    ph_convert(p.peer_keys, p.keys, (size_t)16 * 128 * 128, v2, n2);
  } else if (nvb <= 128) {
    ph_transpose(p.w_a_out, p.Wt_aout, DM, DM, vb, nvb, smem);
    ph_transpose(p.w_o, p.Wt_o, DM, DM, vb, nvb, smem);
    ph_transpose(p.peer_wq, p.Wt_q, DM, 2048, vb, nvb, smem);
    ph_transpose(p.g2, p.g2T, 128, 1024, vb, nvb, smem);
    ph_weff(p, vb, nvb);
    ph_convert(p.peer_keys, p.keys, (size_t)16 * 128 * 128, vb, nvb);
  }
  xcd_barrier(xb);
  ph_rwkv_C(p, vb, nvb, smem);
  ph_sg(p, vb, nvb);
  xcd_barrier(xb);
  ph_readout_gemm(p, vb, nvb, smem);
  ph_pool(p, vb, nvb, smem);
  ph_cvt_fp6(p.peer_u, p.ub8, p.us, vb, nvb);
  ph_cvt_fp6(p.peer_v, p.vb8, p.vs, vb, nvb);
  xcd_barrier(xb);
  ph_gemm_merge(p, vb, nvb, smem);
  xcd_barrier(xb);
  ph_gemm_simple(p.mrg, DM, p.Wt_o, DM, DM, NTOK, DM, p.mix, DM, vb, nvb, smem);
  xcd_barrier(xb);
  ph_res1(p, vb, nvb);
  xcd_barrier(xb);
  ph_gemm_simple(p.hx2, DM, p.Wt_q, DM, DM, NTOK, 2048, p.q, 2048, vb, nvb, smem);
  xcd_barrier(xb);
  ph_peer_s1(p, vb, nvb, smem);
  xcd_barrier(xb);
  ph_peer_s2(p, vb, nvb, smem);
  xcd_barrier(xb);
  ph_peer_gather(p, vb, nvb, smem);
}

extern "C" void kernel_launch(void* const* d_in, const int* in_sizes, int n_in, void* d_out, int out_size, void* d_ws, size_t ws_size, hipStream_t stream) {
  P p{};
  const float** f = (const float**)&p;
  for (int i = 0; i < 32; ++i) f[i] = (const float*)d_in[i];
  p.out = (float*)d_out;
  p.bar = (unsigned*)((unsigned char*)d_ws + 511 * 1048576);
  unsigned char* w = (unsigned char*)d_ws;
  const size_t MiB = 1048576;
  const size_t HM = 524288;
  p.hx = (bf16_t*)(w + 4096);
  p.zA = (bf16_t*)(w + 65 * MiB + 8192);
  p.zP = (bf16_t*)(w + 569 * HM);
  p.zG = (bf16_t*)d_out;
  unsigned char* rw = w + 633 * HM;
  p.Wt_in = (bf16_t*)rw; rw += 12 * MiB;
  p.Wt_aout = (bf16_t*)rw; rw += 2 * MiB;
  p.Wt_eff = (bf16_t*)rw; rw += 1 * MiB;
  p.Wt_o = (bf16_t*)rw; rw += 2 * MiB;
  p.Wt_q = (bf16_t*)rw; rw += 4 * MiB;
  p.keys = (bf16_t*)rw; rw += HM;
  p.mod = (float*)rw; rw += HM;
  p.g2T = (bf16_t*)rw; rw += HM;
  p.w2T = (bf16_t*)rw; rw += HM;
  p.a2T = (bf16_t*)rw; rw += HM;
  p.Y0 = (bf16_t*)(w + 0 * MiB);
  p.Y1 = (bf16_t*)(w + 340 * MiB);
  p.bdot = (float*)(w + 404 * MiB);
  p.Mst = (bf16_t*)(w + 408 * MiB);
  p.sg = (bf16_t*)(w + 408 * MiB);
  p.Nst = (float*)(w + 441 * MiB);
  p.ub8 = w + 416 * MiB;
  p.vb8 = w + 432 * MiB;
  p.us = (float*)(w + 448 * MiB);
  p.vs = (float*)(w + 449 * MiB);
  p.pooled = (bf16_t*)(w + 478 * MiB);
  p.out_a = (bf16_t*)(w + 0 * MiB);
  p.ya = (bf16_t*)(w + 65 * MiB);
  p.yb = (bf16_t*)(w + 129 * MiB);
  p.mrg = (bf16_t*)(w + 193 * MiB);
  p.mix = (bf16_t*)(w + 65 * MiB);
  p.hx2 = (bf16_t*)(w + 0 * MiB);
  p.q = (bf16_t*)(w + 129 * MiB);
  p.sv = (float*)(w + 340 * MiB);
  p.si = (int*)(w + 372 * MiB);
  p.pidx = (int*)(w + 257 * MiB);
  p.pgate = (float*)(w + 273 * MiB);
  static int grid_blocks = 0;
  if (!grid_blocks) {
    int dev = 0, cus = 0, per_cu = 0;
    hipGetDevice(&dev);
    hipDeviceGetAttribute(&cus, hipDeviceAttributeMultiprocessorCount, dev);
    hipOccupancyMaxActiveBlocksPerMultiprocessor(&per_cu, mega, 256, 0);
    if (per_cu > 2) per_cu = 2;
    if (per_cu < 1) per_cu = 1;
    grid_blocks = cus * per_cu;
  }
  hipMemsetAsync(p.bar, 0, XCD_BAR_WORDS * 4, stream);
  void* args[] = {&p};
  hipError_t e = hipLaunchCooperativeKernel((void*)mega, dim3(grid_blocks), dim3(256), args, 0, stream);
  if (e != hipSuccess) fprintf(stderr, "cooperative launch failed: %s (grid %d)\n", hipGetErrorString(e), grid_blocks);
}
```

```cpp
#include <hip/hip_runtime.h>
#include <hip/hip_cooperative_groups.h>
#include <stdint.h>
#include <cstdio>
namespace cg = cooperative_groups;

typedef unsigned short bf16_t;
typedef short bf16x8 __attribute__((ext_vector_type(8)));
typedef float f32x4 __attribute__((ext_vector_type(4)));
typedef unsigned u32x4 __attribute__((ext_vector_type(4)));
typedef unsigned u32x2 __attribute__((ext_vector_type(2)));
typedef float f32x2 __attribute__((ext_vector_type(2)));

#define NTOK 32768
#define SEQ 16384
#define CTXL 256
#define NCTX 512
#define MROWS 33280
#define DM 1024
#define SHIFTC 3456
#define INC 6016

typedef __bf16 hwbf2 __attribute__((ext_vector_type(2)));
typedef float hwf2 __attribute__((ext_vector_type(2)));
__device__ __forceinline__ unsigned pack2(float a, float b) { return __builtin_bit_cast(unsigned, __builtin_convertvector((hwf2){a, b}, hwbf2)); }
__device__ __forceinline__ bf16_t f2bf(float f) { return __builtin_bit_cast(unsigned short, (__bf16)f); }
__device__ __forceinline__ float bf2f(bf16_t h) { return __uint_as_float(((unsigned)h) << 16); }
__device__ __forceinline__ float bflo(unsigned u) { return __uint_as_float(u << 16); }
__device__ __forceinline__ float bfhi(unsigned u) { return __uint_as_float(u & 0xffff0000u); }
__device__ __forceinline__ float sigmoidf_(float x) { return 1.0f / (1.0f + __expf(-x)); }

__device__ __forceinline__ void load_shift8(const bf16_t* __restrict__ zA, const float* __restrict__ mu, int rowbase, int t, int T, int col0, float* o) {
  const u32x4 zc = *(const u32x4*)(zA + (size_t)(rowbase + t) * SHIFTC + col0);
  u32x4 zp = (u32x4){0u, 0u, 0u, 0u}, zn = (u32x4){0u, 0u, 0u, 0u};
  if (t > 0) zp = *(const u32x4*)(zA + (size_t)(rowbase + t - 1) * SHIFTC + col0);
  if (t < T - 1) zn = *(const u32x4*)(zA + (size_t)(rowbase + t + 1) * SHIFTC + col0);
  const unsigned c[4] = {zc.x, zc.y, zc.z, zc.w}, pv[4] = {zp.x, zp.y, zp.z, zp.w}, nv[4] = {zn.x, zn.y, zn.z, zn.w};
  const f32x4 m0 = *(const f32x4*)(mu + col0), m1 = *(const f32x4*)(mu + col0 + 4);
  const float mm[8] = {m0[0], m0[1], m0[2], m0[3], m1[0], m1[1], m1[2], m1[3]};
#pragma unroll
  for (int i = 0; i < 4; ++i) {
    const float z0 = bflo(c[i]), z1 = bfhi(c[i]);
    o[2 * i] = z0 + mm[2 * i] * (0.5f * (bflo(pv[i]) + bflo(nv[i])) - z0);
    o[2 * i + 1] = z1 + mm[2 * i + 1] * (0.5f * (bfhi(pv[i]) + bfhi(nv[i])) - z1);
  }
}
__device__ __forceinline__ void load8(const bf16_t* __restrict__ zA, int row, int col0, float* o) {
  const u32x4 zc = *(const u32x4*)(zA + (size_t)row * SHIFTC + col0);
#pragma unroll
  for (int i = 0; i < 4; ++i) { o[2 * i] = bflo(zc[i]); o[2 * i + 1] = bfhi(zc[i]); }
}
__device__ __forceinline__ void load_shift4(const bf16_t* __restrict__ zA, const float* __restrict__ mu, int rowbase, int t, int T, int col0, float* o) {
  const u32x2 zc = *(const u32x2*)(zA + (size_t)(rowbase + t) * SHIFTC + col0);
  u32x2 zp = (u32x2){0u, 0u}, zn = (u32x2){0u, 0u};
  if (t > 0) zp = *(const u32x2*)(zA + (size_t)(rowbase + t - 1) * SHIFTC + col0);
  if (t < T - 1) zn = *(const u32x2*)(zA + (size_t)(rowbase + t + 1) * SHIFTC + col0);
#pragma unroll
  for (int i = 0; i < 2; ++i) {
    const float z0 = bflo(zc[i]), z1 = bfhi(zc[i]);
    o[2 * i] = z0 + mu[col0 + 2 * i] * (0.5f * (bflo(zp[i]) + bflo(zn[i])) - z0);
    o[2 * i + 1] = z1 + mu[col0 + 2 * i + 1] * (0.5f * (bfhi(zp[i]) + bfhi(zn[i])) - z1);
  }
}
__device__ __forceinline__ float red16(float v) {
  v += __shfl_xor(v, 1); v += __shfl_xor(v, 2); v += __shfl_xor(v, 4); v += __shfl_xor(v, 8);
  return v;
}
__device__ __forceinline__ float red8(float v) {
  v += __shfl_xor(v, 1); v += __shfl_xor(v, 2); v += __shfl_xor(v, 4);
  return v;
}

struct P {
  const float *x, *c, *ctx, *c_ctx, *w_mod, *b_mod, *g_pre_mix, *g_post_mix, *g_pre_ffn, *g_post_ffn, *w_in, *b_gate, *mu_shift,
      *w0, *w2, *a0, *a2, *g2, *k_k, *k_a, *r_k, *ln_x_w, *ln_x_b, *w_a_out, *w_pool, *pool_scale, *w_b_out, *w_o, *peer_wq,
      *peer_keys, *peer_u, *peer_v;
  float* out;
  unsigned* bar;
  bf16_t* hx;
  bf16_t* zA;
  bf16_t* zP;
  bf16_t* zG;
  bf16_t* Wt_in;
  bf16_t* Wt_aout;
  bf16_t* Wt_eff;
  bf16_t* Wt_o;
  bf16_t* Wt_q;
  bf16_t* keys;
  float* mod;
  unsigned char* ub8;
  unsigned char* vb8;
  float* us;
  float* vs;
  bf16_t* sg;
  bf16_t* g2T;
  bf16_t* w2T;
  bf16_t* a2T;
  bf16_t* Mst;
  float* Nst;
  bf16_t* Y0;
  bf16_t* Y1;
  float* bdot;
  bf16_t* out_a;
  bf16_t* ya;
  bf16_t* pooled;
  bf16_t* yb;
  bf16_t* mrg;
  bf16_t* mix;
  bf16_t* hx2;
  bf16_t* q;
  float* sv;
  int* si;
  int* pidx;
  float* pgate;
};

#define GS 72
#define GEMM_SMEM (2 * 128 * GS * 2)
template <class Epi>
__device__ __forceinline__ void gemm_tile(const bf16_t* __restrict__ A, int lda, const bf16_t* __restrict__ Bt, int ldb, int K, int m0, int n0,
                                          const Epi& epi, unsigned char* smem) {
  const int tid = threadIdx.x, lane = tid & 63, wid = tid >> 6, wr = wid >> 1, wc = wid & 1;
  bf16_t* sA = (bf16_t*)smem;
  bf16_t* sB = sA + 128 * GS;
  f32x4 acc[4][4];
#pragma unroll
  for (int i = 0; i < 4; ++i)
#pragma unroll
    for (int j = 0; j < 4; ++j) acc[i][j] = (f32x4){0.f, 0.f, 0.f, 0.f};
  const int lrow = tid >> 3, lcol = (tid & 7) * 8;
  const bf16_t* pa = A + (size_t)(m0 + lrow) * lda + lcol;
  const bf16_t* pb = Bt + (size_t)(n0 + lrow) * ldb + lcol;
  u32x4 ra[4], rb[4];
#pragma unroll
  for (int p = 0; p < 4; ++p) {
    ra[p] = *(const u32x4*)(pa + (size_t)(32 * p) * lda);
    rb[p] = *(const u32x4*)(pb + (size_t)(32 * p) * ldb);
  }
  for (int k0 = 0; k0 < K; k0 += 64) {
#pragma unroll
    for (int p = 0; p < 4; ++p) {
      *(u32x4*)(sA + (lrow + 32 * p) * GS + lcol) = ra[p];
      *(u32x4*)(sB + (lrow + 32 * p) * GS + lcol) = rb[p];
    }
    __syncthreads();
    if (k0 + 64 < K) {
#pragma unroll
      for (int p = 0; p < 4; ++p) {
        ra[p] = *(const u32x4*)(pa + (size_t)(32 * p) * lda + k0 + 64);
        rb[p] = *(const u32x4*)(pb + (size_t)(32 * p) * ldb + k0 + 64);
      }
    }
#pragma unroll
    for (int kk = 0; kk < 2; ++kk) {
      bf16x8 af[4], bfr[4];
#pragma unroll
      for (int i = 0; i < 4; ++i) af[i] = *(const bf16x8*)(sA + (wr * 64 + i * 16 + (lane & 15)) * GS + kk * 32 + (lane >> 4) * 8);
#pragma unroll
      for (int j = 0; j < 4; ++j) bfr[j] = *(const bf16x8*)(sB + (wc * 64 + j * 16 + (lane & 15)) * GS + kk * 32 + (lane >> 4) * 8);
#pragma unroll
      for (int i = 0; i < 4; ++i)
#pragma unroll
        for (int j = 0; j < 4; ++j) acc[i][j] = __builtin_amdgcn_mfma_f32_16x16x32_bf16(bfr[j], af[i], acc[i][j], 0, 0, 0);
    }
    __syncthreads();
  }
#pragma unroll
  for (int i = 0; i < 4; ++i)
#pragma unroll
    for (int j = 0; j < 4; ++j) epi(m0 + wr * 64 + i * 16 + (lane & 15), n0 + wc * 64 + j * 16 + (lane >> 4) * 4, acc[i][j]);
}

#define G2S 40
#define GEMM2_SMEM (2 * (256 + 128) * G2S * 2)
template <class Epi>
__device__ __forceinline__ void gemm_tile2(const bf16_t* __restrict__ A, int lda, const bf16_t* __restrict__ Bt, int ldb, int K, int m0, int n0,
                                           const Epi& epi, unsigned char* smem) {
  const int tid = threadIdx.x, lane = tid & 63, wid = tid >> 6, wr = wid >> 1, wc = wid & 1, l15 = lane & 15, q = lane >> 4;
  bf16_t* sA = (bf16_t*)smem;
  bf16_t* sB = sA + 2 * 256 * G2S;
  f32x4 acc[8][4];
#pragma unroll
  for (int i = 0; i < 8; ++i)
#pragma unroll
    for (int j = 0; j < 4; ++j) acc[i][j] = (f32x4){0.f, 0.f, 0.f, 0.f};
  const int lrow = tid >> 2, lcol = (tid & 3) * 8;
  const bf16_t* pa = A + (size_t)(m0 + lrow) * lda + lcol;
  const bf16_t* pb = Bt + (size_t)(n0 + lrow) * ldb + lcol;
  u32x4 ra[4], rb[2];
#pragma unroll
  for (int pp = 0; pp < 4; ++pp) ra[pp] = *(const u32x4*)(pa + (size_t)(64 * pp) * lda);
#pragma unroll
  for (int pp = 0; pp < 2; ++pp) rb[pp] = *(const u32x4*)(pb + (size_t)(64 * pp) * ldb);
  __syncthreads();
#pragma unroll
  for (int pp = 0; pp < 4; ++pp) *(u32x4*)(sA + (lrow + 64 * pp) * G2S + lcol) = ra[pp];
#pragma unroll
  for (int pp = 0; pp < 2; ++pp) *(u32x4*)(sB + (lrow + 64 * pp) * G2S + lcol) = rb[pp];
  __syncthreads();
  const int nk = K >> 5;
  for (int kt = 0; kt < nk; ++kt) {
    const int cur = kt & 1;
    const bf16_t* cA = sA + cur * 256 * G2S;
    const bf16_t* cB = sB + cur * 128 * G2S;
    if (kt + 1 < nk) {
#pragma unroll
      for (int pp = 0; pp < 4; ++pp) ra[pp] = *(const u32x4*)(pa + (size_t)(64 * pp) * lda + (kt + 1) * 32);
#pragma unroll
      for (int pp = 0; pp < 2; ++pp) rb[pp] = *(const u32x4*)(pb + (size_t)(64 * pp) * ldb + (kt + 1) * 32);
    }
    bf16x8 bfr[4];
#pragma unroll
    for (int j = 0; j < 4; ++j) bfr[j] = *(const bf16x8*)(cB + (wc * 64 + j * 16 + l15) * G2S + q * 8);
#pragma unroll
    for (int i = 0; i < 8; ++i) {
      const bf16x8 af = *(const bf16x8*)(cA + (wr * 128 + i * 16 + l15) * G2S + q * 8);
#pragma unroll
      for (int j = 0; j < 4; ++j) acc[i][j] = __builtin_amdgcn_mfma_f32_16x16x32_bf16(bfr[j], af, acc[i][j], 0, 0, 0);
    }
    if (kt + 1 < nk) {
      bf16_t* nA = sA + (cur ^ 1) * 256 * G2S;
      bf16_t* nB = sB + (cur ^ 1) * 128 * G2S;
#pragma unroll
      for (int pp = 0; pp < 4; ++pp) *(u32x4*)(nA + (lrow + 64 * pp) * G2S + lcol) = ra[pp];
#pragma unroll
      for (int pp = 0; pp < 2; ++pp) *(u32x4*)(nB + (lrow + 64 * pp) * G2S + lcol) = rb[pp];
    }
    __syncthreads();
  }
#pragma unroll
  for (int i = 0; i < 8; ++i)
#pragma unroll
    for (int j = 0; j < 4; ++j) epi(m0 + wr * 128 + i * 16 + l15, n0 + wc * 64 + j * 16 + q * 4, acc[i][j]);
}

#define G3_STAGE 24576
#define G3_ES 136
#define GEMM3_SMEM (256 * G3_ES * 2)
typedef __attribute__((address_space(3))) unsigned lds_u32;
template <class Epi>
__device__ __forceinline__ void gemm_tile3(const bf16_t* __restrict__ A, int lda, const bf16_t* __restrict__ Bt, int ldb, int K, int m0, int n0,
                                           const Epi& epi, unsigned char* smem) {
  int tid = threadIdx.x;
  asm volatile("" : "+v"(tid));
  const int lane = tid & 63, wid = __builtin_amdgcn_readfirstlane(tid >> 6), wr = wid >> 1, wc = wid & 1, l15 = lane & 15, q = lane >> 4;
  f32x4 acc[8][4];
#pragma unroll
  for (int i = 0; i < 8; ++i)
#pragma unroll
    for (int j = 0; j < 4; ++j) acc[i][j] = (f32x4){0.f, 0.f, 0.f, 0.f};
  const int gr = lane >> 2, gc = ((lane & 3) ^ (((gr >> 2) & 1) << 1)) * 8;
  const bf16_t* pa = A + (long)(m0 + wid * 64 + gr) * lda + gc;
  const bf16_t* pb = Bt + (size_t)(n0 + wid * 32 + gr) * ldb + gc;
  unsigned char* dA = smem + wid * 4096 + lane * 16;
  unsigned char* dB = smem + 16384 + wid * 2048 + lane * 16;
  const int sw = (q ^ (((l15 >> 2) & 1) << 1)) * 16;
  const unsigned char* fA = smem + (wr * 128 + l15) * 64 + sw;
  const unsigned char* fB = smem + 16384 + (wc * 64 + l15) * 64 + sw;
#define G3_ISSUE(ST, KT) { _Pragma("unroll") for (int ii = 0; ii < 4; ++ii) __builtin_amdgcn_global_load_lds((const unsigned*)(pa + (size_t)(16 * ii) * lda + (KT) * 32), (lds_u32*)(dA + (ST) * G3_STAGE + ii * 1024), 16, 0, 0); \
                           _Pragma("unroll") for (int ii = 0; ii < 2; ++ii) __builtin_amdgcn_global_load_lds((const unsigned*)(pb + (size_t)(16 * ii) * ldb + (KT) * 32), (lds_u32*)(dB + (ST) * G3_STAGE + ii * 1024), 16, 0, 0); }
  const int nk = K >> 5;
  __syncthreads();
  G3_ISSUE(0, 0);
  for (int kt = 0; kt < nk; ++kt) {
    const int cur = kt & 1;
    asm volatile("s_waitcnt vmcnt(0)" ::: "memory");
    __syncthreads();
    if (kt + 1 < nk) G3_ISSUE(cur ^ 1, kt + 1);
    const unsigned char* cA = fA + cur * G3_STAGE;
    const unsigned char* cB = fB + cur * G3_STAGE;
    bf16x8 bfr[4];
#pragma unroll
    for (int j = 0; j < 4; ++j) bfr[j] = *(const bf16x8*)(cB + j * 1024);
#pragma unroll
    for (int i = 0; i < 8; ++i) {
      const bf16x8 af = *(const bf16x8*)(cA + i * 1024);
#pragma unroll
      for (int j = 0; j < 4; ++j) acc[i][j] = __builtin_amdgcn_mfma_f32_16x16x32_bf16(bfr[j], af, acc[i][j], 0, 0, 0);
    }
  }
#undef G3_ISSUE
  bf16_t* sE = (bf16_t*)smem;
  __syncthreads();
#pragma unroll
  for (int i = 0; i < 8; ++i)
#pragma unroll
    for (int j = 0; j < 4; ++j) {
      u32x2 w; w.x = pack2(acc[i][j][0], acc[i][j][1]); w.y = pack2(acc[i][j][2], acc[i][j][3]);
      *(u32x2*)(sE + (wr * 128 + i * 16 + l15) * G3_ES + wc * 64 + j * 16 + q * 4) = w;
    }
  __syncthreads();
  epi.finish(sE, m0, n0, tid);
}
template <class D> struct Epi3RowChunks {
  __device__ __forceinline__ void finish(const bf16_t* sE, int m0, int n0, int tid) const {
#pragma unroll
    for (int pp = 0; pp < 16; ++pp) {
      const int id = tid + 256 * pp, row = id >> 4, cc = (id & 15) * 8;
      static_cast<const D*>(this)->store(m0 + row, n0 + cc, *(const u32x4*)(sE + row * G3_ES + cc));
    }
  }
};
struct Epi3StoreBf16 : Epi3RowChunks<Epi3StoreBf16> {
  bf16_t* C; int ldc;
  __device__ Epi3StoreBf16(bf16_t* c, int l) : C(c), ldc(l) {}
  __device__ __forceinline__ void store(int m, int n, const u32x4& v) const { *(u32x4*)(C + (size_t)m * ldc + n) = v; }
};
struct Epi3GateA : Epi3RowChunks<Epi3GateA> {
  const bf16_t* zG; const float* bg; bf16_t* mrg;
  __device__ Epi3GateA(const bf16_t* z, const float* b, bf16_t* m) : zG(z), bg(b), mrg(m) {}
  __device__ __forceinline__ void store(int m, int n, const u32x4& v) const {
    const u32x4 g = *(const u32x4*)(zG + (size_t)m * 2048 + n);
    const f32x4 b0 = *(const f32x4*)(bg + n), b1 = *(const f32x4*)(bg + n + 4);
    u32x4 o;
#pragma unroll
    for (int i = 0; i < 4; ++i) {
      const float bl = i < 2 ? b0[2 * i] : b1[2 * i - 4], bh = i < 2 ? b0[2 * i + 1] : b1[2 * i - 3];
      o[i] = pack2(sigmoidf_(bflo(g[i]) + bl) * bflo(v[i]), sigmoidf_(bfhi(g[i]) + bh) * bfhi(v[i]));
    }
    *(u32x4*)(mrg + (size_t)m * DM + n) = o;
  }
};
struct Epi3GateB : Epi3RowChunks<Epi3GateB> {
  const bf16_t* zG; const float* bg; bf16_t* mrg;
  __device__ Epi3GateB(const bf16_t* z, const float* b, bf16_t* m) : zG(z), bg(b), mrg(m) {}
  __device__ __forceinline__ void store(int m, int n, const u32x4& v) const {
    const u32x4 g = *(const u32x4*)(zG + (size_t)m * 2048 + 1024 + n);
    const u32x4 a = *(const u32x4*)(mrg + (size_t)m * DM + n);
    const f32x4 b0 = *(const f32x4*)(bg + 1024 + n), b1 = *(const f32x4*)(bg + 1024 + n + 4);
    u32x4 o;
#pragma unroll
    for (int i = 0; i < 4; ++i) {
      const float bl = i < 2 ? b0[2 * i] : b1[2 * i - 4], bh = i < 2 ? b0[2 * i + 1] : b1[2 * i - 3];
      o[i] = pack2(bflo(a[i]) + sigmoidf_(bflo(g[i]) + bl) * bflo(v[i]), bfhi(a[i]) + sigmoidf_(bfhi(g[i]) + bh) * bfhi(v[i]));
    }
    *(u32x4*)(mrg + (size_t)m * DM + n) = o;
  }
};
struct Epi3ZS {
  bf16_t* zA; const float* mu; int own_lo, own_hi, t0, T;
  __device__ __forceinline__ void finish(const bf16_t* sE, int m0, int n0, int tid) const {
#pragma unroll 4
    for (int pq = 0; pq < 16; ++pq) {
      const int id = tid + 256 * pq, row = id >> 4, cc = (id & 15) * 8, t = t0 + row;
      if (row < own_lo || row > own_hi) continue;
      const u32x4 zc = *(const u32x4*)(sE + row * G3_ES + cc);
      u32x4 zp = (u32x4){0u, 0u, 0u, 0u}, zn = (u32x4){0u, 0u, 0u, 0u};
      if (t > 0) zp = *(const u32x4*)(sE + (row - 1) * G3_ES + cc);
      if (t < T - 1) zn = *(const u32x4*)(sE + (row + 1) * G3_ES + cc);
      const f32x4 m0v = *(const f32x4*)(mu + n0 + cc), m1v = *(const f32x4*)(mu + n0 + cc + 4);
      const float mm[8] = {m0v[0], m0v[1], m0v[2], m0v[3], m1v[0], m1v[1], m1v[2], m1v[3]};
      u32x4 o;
#pragma unroll
      for (int i = 0; i < 4; ++i) {
        const float z0 = bflo(zc[i]), z1 = bfhi(zc[i]);
        o[i] = pack2(z0 + mm[2 * i] * (0.5f * (bflo(zp[i]) + bflo(zn[i])) - z0), z1 + mm[2 * i + 1] * (0.5f * (bfhi(zp[i]) + bfhi(zn[i])) - z1));
      }
      *(u32x4*)(zA + (long)(m0 + row) * SHIFTC + n0 + cc) = o;
    }
  }
};
struct Epi3Z : Epi3RowChunks<Epi3Z> {
  bf16_t *zA, *zP, *zG;
  __device__ Epi3Z(bf16_t* a, bf16_t* b, bf16_t* c) : zA(a), zP(b), zG(c) {}
  __device__ __forceinline__ void store(int m, int n, const u32x4& v) const {
    if (n < SHIFTC) *(u32x4*)(zA + (size_t)m * SHIFTC + n) = v;
    else if (m < NTOK) {
      if (n < SHIFTC + 512) *(u32x4*)(zP + (size_t)m * 512 + (n - SHIFTC)) = v;
      else *(u32x4*)(zG + (size_t)m * 2048 + (n - SHIFTC - 512)) = v;
    }
  }
};

struct EpiStoreBf16 {
  bf16_t* C; int ldc;
  __device__ __forceinline__ void operator()(int m, int n, const f32x4& v) const {
    uint2 w; w.x = pack2(v[0], v[1]); w.y = pack2(v[2], v[3]);
    *(uint2*)(C + (size_t)m * ldc + n) = w;
  }
};
struct EpiZ {
  bf16_t *zA, *zP, *zG;
  __device__ __forceinline__ void operator()(int m, int n, const f32x4& v) const {
    uint2 w; w.x = pack2(v[0], v[1]); w.y = pack2(v[2], v[3]);
    if (n < SHIFTC) *(uint2*)(zA + (size_t)m * SHIFTC + n) = w;
    else if (m < NTOK) {
      if (n < SHIFTC + 512) *(uint2*)(zP + (size_t)m * 512 + (n - SHIFTC)) = w;
      else *(uint2*)(zG + (size_t)m * 2048 + (n - SHIFTC - 512)) = w;
    }
  }
};
struct EpiLds {
  float* S;
  __device__ __forceinline__ void operator()(int m, int n, const f32x4& v) const {
    float* r = S + (m & 127) * 133 + n + (n >> 5);
    r[0] = v[0]; r[1] = v[1]; r[2] = v[2]; r[3] = v[3];
  }
};

__device__ __forceinline__ void ph_transpose(const float* __restrict__ in, bf16_t* __restrict__ out, int K, int N, int vb, int nvb, unsigned char* smem) {
  float* t = (float*)smem;
  const int tk = K / 64, tn = N / 64, tid = threadIdx.x, tx = tid & 15, ty = tid >> 4;
  for (int it = vb; it < tk * tn; it += nvb) {
    const int k0 = (it / tn) * 64, n0 = (it % tn) * 64;
    __syncthreads();
#pragma unroll
    for (int r = 0; r < 4; ++r) {
      const f32x4 v = *(const f32x4*)(in + (size_t)(k0 + ty + 16 * r) * N + n0 + 4 * tx);
#pragma unroll
      for (int e = 0; e < 4; ++e) t[(ty + 16 * r) * 65 + 4 * tx + e] = v[e];
    }
    __syncthreads();
    const int n = tid >> 2, kq = (tid & 3) * 16;
    u32x4 w0, w1;
#pragma unroll
    for (int e = 0; e < 4; ++e) {
      w0[e] = pack2(t[(kq + 2 * e) * 65 + n], t[(kq + 2 * e + 1) * 65 + n]);
      w1[e] = pack2(t[(kq + 8 + 2 * e) * 65 + n], t[(kq + 8 + 2 * e + 1) * 65 + n]);
    }
    *(u32x4*)(out + (size_t)(n0 + n) * K + k0 + kq) = w0;
    *(u32x4*)(out + (size_t)(n0 + n) * K + k0 + kq + 8) = w1;
  }
}
__device__ __forceinline__ void ph_convert(const float* __restrict__ in, bf16_t* __restrict__ out, size_t n, int vb, int nvb) {
  for (size_t i = ((size_t)vb * 256 + threadIdx.x) * 4; i < n; i += (size_t)nvb * 1024) {
    const float4 v = *(const float4*)(in + i);
    uint2 w; w.x = pack2(v.x, v.y); w.y = pack2(v.z, v.w);
    *(uint2*)(out + i) = w;
  }
}
__device__ __forceinline__ void ph_weff(const P& p, int vb, int nvb) {
  for (int it = vb * 256 + threadIdx.x; it < 512 * 1024; it += nvb * 256) {
    const int n = it & 1023, k = it >> 10, j = k >> 7, kl = k & 127;
    const float* wp = p.w_pool + ((size_t)j * 128 + kl) * 128;
    float s = 0.f;
    for (int c = 0; c < 128; ++c) s += wp[c] * p.pool_scale[j * 128 + c] * p.w_b_out[(size_t)(j * 128 + c) * 1024 + n];
    p.Wt_eff[(size_t)n * 512 + k] = f2bf(s);
  }
}
__device__ __forceinline__ void ph_mod(const P& p, int vb, int nvb, unsigned char* smem) {
  float* red = (float*)smem;
  const int lane = threadIdx.x & 63, wid = threadIdx.x >> 6;
  for (int it = vb; it < 96; it += nvb) {
    const int n = it * 64 + lane;
    float a0 = 0.f, a1 = 0.f, a2 = 0.f;
#pragma unroll 32
    for (int k = wid * 256; k < wid * 256 + 256; ++k) {
      const float w = p.w_mod[(size_t)k * 6144 + n];
      const float c0 = p.c[k], c1 = p.c[1024 + k], c2 = p.c_ctx[k];
      a0 += c0 * sigmoidf_(c0) * w; a1 += c1 * sigmoidf_(c1) * w; a2 += c2 * sigmoidf_(c2) * w;
    }
    __syncthreads();
    red[(wid * 3 + 0) * 64 + lane] = a0; red[(wid * 3 + 1) * 64 + lane] = a1; red[(wid * 3 + 2) * 64 + lane] = a2;
    __syncthreads();
    if (wid < 3) {
      const float sum = red[(0 * 3 + wid) * 64 + lane] + red[(1 * 3 + wid) * 64 + lane] + red[(2 * 3 + wid) * 64 + lane] + red[(3 * 3 + wid) * 64 + lane];
      p.mod[wid * 6144 + n] = sum + p.b_mod[n];
    }
  }
}
__device__ __forceinline__ float wave_sum(float v) {
#pragma unroll
  for (int o = 32; o > 0; o >>= 1) v += __shfl_xor(v, o);
  return v;
}
__device__ __forceinline__ void ph_norm1(const P& p, int vb, int nvb) {
  const int lane = threadIdx.x & 63, wid = threadIdx.x >> 6, nw = nvb * 4;
  for (int m0 = vb * 4 + wid; m0 < MROWS; m0 += 2 * nw) {
    const int m1 = m0 + nw; const bool has1 = m1 < MROWS; const int mb = has1 ? m1 : m0;
    const float* srcA = m0 < NTOK ? p.x + (size_t)m0 * DM : p.ctx + (size_t)(m0 - NTOK) * DM;
    const float* srcB = mb < NTOK ? p.x + (size_t)mb * DM : p.ctx + (size_t)(mb - NTOK) * DM;
    f32x4 va[4], vbq[4]; float sa = 0.f, sb = 0.f;
#pragma unroll
    for (int i = 0; i < 4; ++i) { va[i] = *(const f32x4*)(srcA + i * 256 + lane * 4); vbq[i] = *(const f32x4*)(srcB + i * 256 + lane * 4); }
#pragma unroll
    for (int i = 0; i < 4; ++i)
#pragma unroll
      for (int e = 0; e < 4; ++e) { sa += va[i][e] * va[i][e]; sb += vbq[i][e] * vbq[i][e]; }
    sa = wave_sum(sa); sb = wave_sum(sb);
#pragma unroll
    for (int rr = 0; rr < 2; ++rr) {
      if (rr == 1 && !has1) break;
      const int m = rr == 0 ? m0 : m1;
      const float rstd = rsqrtf((rr == 0 ? sa : sb) * (1.0f / 1024.0f) + 1e-6f);
      const float* md = p.mod + (m < NTOK ? (m / SEQ) : 2) * 6144;
#pragma unroll
      for (int i = 0; i < 4; ++i) {
        const int col = i * 256 + lane * 4;
        const f32x4 v = rr == 0 ? va[i] : vbq[i];
        const f32x4 g = *(const f32x4*)(p.g_pre_mix + col), sh = *(const f32x4*)(md + col), sc = *(const f32x4*)(md + 1024 + col);
        u32x2 w;
        w.x = pack2(v[0] * rstd * g[0] * (1.f + sc[0]) + sh[0], v[1] * rstd * g[1] * (1.f + sc[1]) + sh[1]);
        w.y = pack2(v[2] * rstd * g[2] * (1.f + sc[2]) + sh[2], v[3] * rstd * g[3] * (1.f + sc[3]) + sh[3]);
        *(u32x2*)(p.hx + (size_t)m * DM + col) = w;
      }
    }
  }
}
struct Epi3Readout {
  const P* pp;
  __device__ __forceinline__ void finish(const bf16_t* sE, int m0, int n0, int tid) const {
    const P& p = *pp;
#pragma unroll 2
    for (int pq = 0; pq < 16; ++pq) {
      const int id = tid + 256 * pq, row = id >> 4, cc = (id & 15) * 8, m = m0 + row, n = n0 + cc, t = m % SEQ, h = n >> 6;
      const u32x4 g = *(const u32x4*)(sE + row * G3_ES + cc);
      const u32x4 y0 = *(const u32x4*)(p.Y0 + (size_t)m * DM + n), y1 = *(const u32x4*)(p.Y1 + (size_t)m * DM + n);
      float y[8], v[8];
#pragma unroll
      for (int i = 0; i < 4; ++i) { y[2 * i] = bflo(y0[i]) + bflo(y1[i]); y[2 * i + 1] = bfhi(y0[i]) + bfhi(y1[i]); }
      float sm = 0.f;
#pragma unroll
      for (int i = 0; i < 8; ++i) sm += y[i];
      const float mu = red8(sm) * (1.f / 64.f);
      float qv = 0.f;
#pragma unroll
      for (int i = 0; i < 8; ++i) { y[i] -= mu; qv += y[i] * y[i]; }
      const float rs = rsqrtf(red8(qv) * (1.f / 64.f) + 64e-5f);
      load8(p.zA, m, 2048 + n, v);
      const float bon = 0.5f * (p.bdot[(size_t)m * 16 + h] + p.bdot[((size_t)NTOK + m) * 16 + h]);
      const f32x4 w0 = *(const f32x4*)(p.ln_x_w + n), w1 = *(const f32x4*)(p.ln_x_w + n + 4), b0 = *(const f32x4*)(p.ln_x_b + n), b1 = *(const f32x4*)(p.ln_x_b + n + 4);
      const float lw[8] = {w0[0], w0[1], w0[2], w0[3], w1[0], w1[1], w1[2], w1[3]}, lb[8] = {b0[0], b0[1], b0[2], b0[3], b1[0], b1[1], b1[2], b1[3]};
      u32x4 o;
#pragma unroll
      for (int i = 0; i < 4; ++i)
        o[i] = pack2((y[2 * i] * rs * lw[2 * i] + lb[2 * i] + bon * v[2 * i]) * bflo(g[i]), (y[2 * i + 1] * rs * lw[2 * i + 1] + lb[2 * i + 1] + bon * v[2 * i + 1]) * bfhi(g[i]));
      *(u32x4*)(p.out_a + (size_t)m * DM + n) = o;
    }
  }
};
__device__ __forceinline__ int xcd_tile(int vb, int nvb, int round, int TM, int TN, int& tm, int& tn) {
  if (nvb % 64 != 0) { const int it = round * nvb + vb; if (it >= TM * TN) return 0; tm = it % TM; tn = it / TM; return 1; }
  const int spg = nvb >> 3, g = vb & 7, slot = vb >> 3, SC = spg >> 3;
  const int nsr = (TM + 7) >> 3, nsc = (TN + SC - 1) / SC, st = round * 8 + g;
  if (st >= nsr * nsc) return 0;
  tm = (st % nsr) * 8 + (slot & 7); tn = (st / nsr) * SC + (slot >> 3);
  return (tm < TM && tn < TN) ? 1 : 2;
}
__device__ __forceinline__ void ph_gemm1(const P& p, int vb, int nvb, unsigned char* smem) {
  const int NS_ = 132 * 27, NALL = NS_ + 128 * 20;
  const int per = nvb >> 3;
  for (int round = 0;; ++round) {
    int item;
    if ((nvb & 7) == 0) { const int blk = round * 8 + (vb & 7); if (blk * per >= NALL) break; item = blk * per + (vb >> 3); if (item >= NALL) continue; }
    else { item = round * nvb + vb; if (item >= NALL) break; }
    if (item < NS_) {
      const int cgp = item / (132 * 9), rem = item % (132 * 9), tmS = rem / 9, tn = cgp * 9 + rem % 9;
      Epi3ZS epi;
      epi.zA = p.zA; epi.mu = p.mu_shift;
      int m0;
      if (tmS < 130) { const int b = tmS / 65, i = tmS % 65; m0 = b * SEQ + 254 * i - 1; epi.own_lo = 1; epi.own_hi = min(254, SEQ - 254 * i); epi.t0 = 254 * i - 1; epi.T = SEQ; }
      else { m0 = NTOK + (tmS - 130) * CTXL; epi.own_lo = 0; epi.own_hi = 255; epi.t0 = 0; epi.T = CTXL; }
      gemm_tile3(p.hx, DM, p.Wt_in, DM, DM, m0, tn * 128, epi, smem);
    } else {
      const int i2 = item - NS_;
      int tm, tn;
      if (i2 < 2048) { tm = (i2 & 1023) >> 3; tn = 27 + (i2 >> 10) * 8 + (i2 & 7); } else { tm = (i2 - 2048) >> 2; tn = 43 + (i2 & 3); }
      Epi3Z epi{p.zA, p.zP, p.zG};
      gemm_tile3(p.hx, DM, p.Wt_in, DM, DM, tm * 256, tn * 128, epi, smem);
    }
  }
}
__device__ __forceinline__ void ph_readout_gemm(const P& p, int vb, int nvb, unsigned char* smem) {
  Epi3Readout epi{&p};
  for (int round = 0;; ++round) {
    int tm, tn; const int r = xcd_tile(vb, nvb, round, NTOK / 256, DM / 128, tm, tn);
    if (r == 0) break;
    if (r == 1) gemm_tile3(p.sg, 128, p.g2T, 128, 128, tm * 256, tn * 128, epi, smem);
  }
}
__device__ __forceinline__ void ph_sg(const P& p, int vb, int nvb) {
  for (int it = vb * 256 + threadIdx.x; it < NTOK * 16; it += nvb * 256) {
    const int m = it >> 4, l8 = (it & 15) * 8, t = m % SEQ;
    float o[8];
    load8(p.zA, m, 3328 + l8, o);
    u32x4 w;
#pragma unroll
    for (int i = 0; i < 4; ++i) w[i] = pack2(sigmoidf_(o[2 * i]), sigmoidf_(o[2 * i + 1]));
    *(u32x4*)(p.sg + (size_t)m * 128 + l8) = w;
  }
}
__device__ __forceinline__ void ph_gemm_merge(const P& p, int vb, int nvb, unsigned char* smem) {
  Epi3GateA ea{p.zG, p.b_gate, p.mrg};
  Epi3GateB eb{p.zG, p.b_gate, p.mrg};
  for (int round = 0;; ++round) {
    int tm, tn; const int r = xcd_tile(vb, nvb, round, NTOK / 256, DM / 128, tm, tn);
    if (r == 0) break;
    if (r == 1) {
      gemm_tile3(p.out_a, DM, p.Wt_aout, DM, DM, tm * 256, tn * 128, ea, smem);
      gemm_tile3(p.pooled, 512, p.Wt_eff, 512, 512, tm * 256, tn * 128, eb, smem);
    }
  }
}
__device__ __forceinline__ void ph_gemm_simple(const bf16_t* A, int lda, const bf16_t* Bt, int ldb, int K, int M, int N, bf16_t* C, int ldc, int vb, int nvb, unsigned char* smem) {
  Epi3StoreBf16 epi{C, ldc};
  for (int round = 0;; ++round) {
    int tm, tn; const int r = xcd_tile(vb, nvb, round, M / 256, N / 128, tm, tn);
    if (r == 0) break;
    if (r == 1) gemm_tile3(A, lda, Bt, ldb, K, tm * 256, tn * 128, epi, smem);
  }
}


#define O_R1 0
#define O_R2 10240
#define O_TA (O_R2 + 17408)
#define O_TR (O_TA + 4608)
#define O_TB (O_TR + 4608)
#define O_TK (O_TB + 4608)
#define O_TBT (O_TK + 4608)
#define O_TKT (O_TBT + 5120)
#define O_TVT (O_TKT + 5120)
#define O_GAM (O_TVT + 5120)
#define O_TST (O_GAM + 256)
#define RWKV_SMEM (O_TST + 2 * 9216)
#define NSUP 65
__device__ __forceinline__ void lds_wave_fence() { asm volatile("s_waitcnt lgkmcnt(0)" ::: "memory"); }
__device__ __forceinline__ u32x2 pack4(const f32x4& v) { u32x2 r; r.x = pack2(v[0], v[1]); r.y = pack2(v[2], v[3]); return r; }

struct RwkvConsts { bf16x8 w2f[2], a2f[2]; };

typedef short s16x4 __attribute__((ext_vector_type(4)));
__device__ __forceinline__ float fast_tanh(float x) { const float e = __expf(2.0f * x); return 1.0f - __fdividef(2.0f, e + 1.0f); }
template <int NS, bool WANTY>
__device__ __forceinline__ void rwkv_chunk(const P& p, unsigned char* smem, int d, int h, int rowbase, int T, int isc0, bool has_next, f32x4 (&st)[NS][4], u32x4 (&pf)[5]) {
  int tid = threadIdx.x;
  asm volatile("" : "+v"(tid));
  const int lane = tid & 63, w = __builtin_amdgcn_readfirstlane(tid >> 6), l15 = lane & 15, q = lane >> 4;
  const int tt = tid >> 3, cg = tid & 7, ch0 = h * 64 + cg * 8;
  const int isc = isc0 + tt, t = d == 0 ? isc : T - 1 - isc;
  bf16_t* TWD = (bf16_t*)(smem + O_R1); bf16_t* TAD = TWD + 32 * 72;
  float* WT = (float*)(smem + O_R1);
  bf16_t* XT = (bf16_t*)(smem + O_R1); bf16_t* UT = XT + 64 * 40;
  float* LW = (float*)(smem + O_R2); float* LA = LW + 32 * 68;
  float* TL = (float*)(smem + O_R2);
  bf16_t* TT = (bf16_t*)(smem + O_R2 + 4608); bf16_t* TAK = TT + 32 * 40; bf16_t* TRB = TAK + 32 * 40; bf16_t* TRK = TRB + 32 * 40; bf16_t* TLB = TRK + 32 * 40;
  bf16_t* TA = (bf16_t*)(smem + O_TA); bf16_t* TR = (bf16_t*)(smem + O_TR); bf16_t* TB = (bf16_t*)(smem + O_TB); bf16_t* TK = (bf16_t*)(smem + O_TK);
  bf16_t* TBT = (bf16_t*)(smem + O_TBT); bf16_t* TKT = (bf16_t*)(smem + O_TKT); bf16_t* TVT = (bf16_t*)(smem + O_TVT);
  float* GAM = (float*)(smem + O_GAM);
  bf16_t* TST = (bf16_t*)(smem + O_TST);
  __syncthreads();
  float k8[8], r8[8];
  {
    u32x4 pk;
#pragma unroll
    for (int i = 0; i < 4; ++i) pk[i] = pack2(fast_tanh(bflo(pf[0][i])), fast_tanh(bfhi(pf[0][i])));
    *(u32x4*)(TWD + tt * 72 + cg * 8) = pk;
    *(u32x4*)(TAD + tt * 72 + cg * 8) = pf[1];
  }
#pragma unroll
  for (int i = 0; i < 4; ++i) { k8[2 * i] = bflo(pf[2][i]); k8[2 * i + 1] = bfhi(pf[2][i]); if (WANTY) { r8[2 * i] = bflo(pf[3][i]); r8[2 * i + 1] = bfhi(pf[3][i]); } }
  const u32x4 vzc = pf[4];
  __syncthreads();
  {
    f32x4 lw[2], la[2];
    bf16x8 w2f[2], a2f[2];
#pragma unroll
    for (int ks = 0; ks < 2; ++ks) {
      w2f[ks] = *(const bf16x8*)(p.w2T + ((size_t)d * 1024 + h * 64 + 16 * w + l15) * 64 + 32 * ks + 8 * q);
      a2f[ks] = *(const bf16x8*)(p.a2T + ((size_t)d * 1024 + h * 64 + 16 * w + l15) * 64 + 32 * ks + 8 * q);
    }
#pragma unroll
    for (int it = 0; it < 2; ++it) { lw[it] = (f32x4){0.f, 0.f, 0.f, 0.f}; la[it] = (f32x4){0.f, 0.f, 0.f, 0.f}; }
#pragma unroll
    for (int ks = 0; ks < 2; ++ks)
#pragma unroll
      for (int it = 0; it < 2; ++it) {
        const bf16x8 aw = *(const bf16x8*)(TWD + (16 * it + l15) * 72 + 32 * ks + 8 * q);
        const bf16x8 aa = *(const bf16x8*)(TAD + (16 * it + l15) * 72 + 32 * ks + 8 * q);
        lw[it] = __builtin_amdgcn_mfma_f32_16x16x32_bf16(aw, w2f[ks], lw[it], 0, 0, 0);
        la[it] = __builtin_amdgcn_mfma_f32_16x16x32_bf16(aa, a2f[ks], la[it], 0, 0, 0);
      }
    {
      const float cw0 = p.w0[d * 1024 + h * 64 + 16 * w + l15];
      float tot0 = 0.f;
#pragma unroll
      for (int it = 0; it < 2; ++it) {
        float pr[4];
#pragma unroll
        for (int rg = 0; rg < 4; ++rg) {
          const float xw = -(cw0 + lw[it][rg]);
          const float sp = fmaxf(xw, 0.f) + __logf(1.0f + __expf(-fabsf(xw)));
          const float e = __expf(-sp - 0.5f);
          pr[rg] = rg == 0 ? e : pr[rg - 1] + e;
        }
        float x = pr[3];
        float y = __shfl_up(x, 16); if (q >= 1) x += y;
        y = __shfl_up(x, 32); if (q >= 2) x += y;
        const float base = (x - pr[3]) + (it == 1 ? tot0 : 0.f);
        if (it == 0) tot0 = __shfl(x, 48 + l15);
#pragma unroll
        for (int rg = 0; rg < 4; ++rg) lw[it][rg] = pr[rg] + base;
      }
      if (q == 3) GAM[16 * w + l15] = __expf(-lw[1][3]);
    }
#pragma unroll
    for (int it = 0; it < 2; ++it)
#pragma unroll
      for (int rg = 0; rg < 4; ++rg) { LW[(16 * it + 4 * q + rg) * 68 + 16 * w + l15] = lw[it][rg]; LA[(16 * it + 4 * q + rg) * 68 + 16 * w + l15] = la[it][rg]; }
  }
  __syncthreads();
  float icl[8], kkn[8], kd[8];
  {
    float ss = 0.f, bd = 0.f;
    float ca0[8], ckk[8], cka[8], crk[8];
#pragma unroll
    for (int e4 = 0; e4 < 8; e4 += 4) {
      const f32x4 b2 = *(const f32x4*)(p.a0 + d * 1024 + ch0 + e4), c2 = *(const f32x4*)(p.k_k + ch0 + e4);
      const f32x4 d2 = *(const f32x4*)(p.k_a + ch0 + e4), f2 = *(const f32x4*)(p.r_k + ch0 + e4);
#pragma unroll
      for (int e = 0; e < 4; ++e) { ca0[e4 + e] = b2[e]; ckk[e4 + e] = c2[e]; cka[e4 + e] = d2[e]; crk[e4 + e] = f2[e]; }
    }
#pragma unroll
    for (int e = 0; e < 8; ++e) {
      icl[e] = sigmoidf_(ca0[e] + LA[tt * 68 + cg * 8 + e]);
      kkn[e] = k8[e] * ckk[e]; ss += kkn[e] * kkn[e];
      kd[e] = k8[e] * (1.f + (icl[e] - 1.f) * cka[e]);
      if (WANTY) bd += r8[e] * kd[e] * crk[e];
    }
    ss = red8(ss); if (WANTY) bd = red8(bd);
    const float rn = rsqrtf(fmaxf(ss, 1e-24f));
#pragma unroll
    for (int e = 0; e < 8; ++e) kkn[e] *= rn;
    if (WANTY && cg == 0) p.bdot[((size_t)d * NTOK + rowbase + t) * 16 + h] = bd;
  }
  {
    float ta[8], tr[8], tb[8], tk[8], v8[8];
#pragma unroll
    for (int i = 0; i < 4; ++i) { v8[2 * i] = bflo(vzc[i]); v8[2 * i + 1] = bfhi(vzc[i]); }
#pragma unroll
    for (int e = 0; e < 8; ++e) {
      const float Li = LW[tt * 68 + cg * 8 + e];
      const float Lp = tt > 0 ? LW[(tt - 1) * 68 + cg * 8 + e] : 0.f;
      const float gi = __expf(-Li), gim1 = __expf(-Lp), ginv = __expf(Li);
      ta[e] = -kkn[e] * gim1; if (WANTY) tr[e] = r8[e] * gi; tb[e] = kkn[e] * icl[e] * ginv; tk[e] = kd[e] * ginv;
    }
    u32x4 pk;
    pk.x = pack2(ta[0], ta[1]); pk.y = pack2(ta[2], ta[3]); pk.z = pack2(ta[4], ta[5]); pk.w = pack2(ta[6], ta[7]); *(u32x4*)(TA + tt * 72 + cg * 8) = pk;
    if (WANTY) { pk.x = pack2(tr[0], tr[1]); pk.y = pack2(tr[2], tr[3]); pk.z = pack2(tr[4], tr[5]); pk.w = pack2(tr[6], tr[7]); *(u32x4*)(TR + tt * 72 + cg * 8) = pk; }
    pk.x = pack2(tb[0], tb[1]); pk.y = pack2(tb[2], tb[3]); pk.z = pack2(tb[4], tb[5]); pk.w = pack2(tb[6], tb[7]); *(u32x4*)(TB + tt * 72 + cg * 8) = pk;
    pk.x = pack2(tk[0], tk[1]); pk.y = pack2(tk[2], tk[3]); pk.z = pack2(tk[4], tk[5]); pk.w = pack2(tk[6], tk[7]); *(u32x4*)(TK + tt * 72 + cg * 8) = pk;
#pragma unroll
    for (int e = 0; e < 8; ++e) { TBT[(cg * 8 + e) * 40 + tt] = f2bf(tb[e]); TKT[(cg * 8 + e) * 40 + tt] = f2bf(tk[e]); TVT[(cg * 8 + e) * 40 + tt] = f2bf(v8[e]); }
  }
  __syncthreads();
  if (WANTY || w < 2) {
    const bf16_t* X = (w < 2) ? TA : TR; const bf16_t* Y = (w & 1) ? TK : TB;
    f32x4 g[2][2];
#pragma unroll
    for (int it = 0; it < 2; ++it)
#pragma unroll
      for (int s2 = 0; s2 < 2; ++s2) g[it][s2] = (f32x4){0.f, 0.f, 0.f, 0.f};
#pragma unroll
    for (int ks = 0; ks < 2; ++ks) {
      bf16x8 xa[2], yb[2];
#pragma unroll
      for (int it = 0; it < 2; ++it) { xa[it] = *(const bf16x8*)(X + (16 * it + l15) * 72 + 32 * ks + 8 * q); yb[it] = *(const bf16x8*)(Y + (16 * it + l15) * 72 + 32 * ks + 8 * q); }
#pragma unroll
      for (int it = 0; it < 2; ++it)
#pragma unroll
        for (int s2 = 0; s2 < 2; ++s2) g[it][s2] = __builtin_amdgcn_mfma_f32_16x16x32_bf16(xa[it], yb[s2], g[it][s2], 0, 0, 0);
    }
    bf16_t* dst = w == 1 ? TAK : (w == 2 ? TRB : TRK);
#pragma unroll
    for (int it = 0; it < 2; ++it)
#pragma unroll
      for (int s2 = 0; s2 < 2; ++s2)
#pragma unroll
        for (int rg = 0; rg < 4; ++rg) {
          const int i = 16 * it + 4 * q + rg, s = 16 * s2 + l15;
          const float val = g[it][s2][rg];
          if (w == 0) {
            TL[i * 36 + s] = (s < i) ? val : 0.f;
            if (it == 1 && s2 == 0) TLB[(i - 16) * 40 + s] = f2bf(val);
          } else dst[i * 40 + s] = f2bf(((w == 1) ? (s < i) : (s <= i)) ? val : 0.f);
        }
  }
  if (w == 0) {
    lds_wave_fence();
    const int c = lane & 15, hb = lane & 16;
    float Tr[16];
#pragma unroll
    for (int i = 0; i < 16; ++i) {
      float acc = (i == c) ? 1.f : 0.f;
#pragma unroll
      for (int j4 = 0; j4 < (i + 3) / 4; ++j4) {
        const f32x4 l4 = *(const f32x4*)(TL + (hb + i) * 36 + hb + 4 * j4);
#pragma unroll
        for (int jj = 0; jj < 4; ++jj) if (4 * j4 + jj < i) acc += l4[jj] * Tr[4 * j4 + jj];
      }
      Tr[i] = acc;
    }
    if (lane < 32) {
#pragma unroll
      for (int i = 0; i < 16; ++i) TT[(hb + i) * 40 + hb + c] = f2bf(Tr[i]);
    }
  }
  __syncthreads();
  if (has_next) {
    const int isn = isc + 32, tn = d == 0 ? isn : T - 1 - isn;
    const bf16_t* zr = p.zA + (size_t)(rowbase + tn) * SHIFTC;
    pf[0] = *(const u32x4*)(zr + 3072 + d * 64 + cg * 8);
    pf[1] = *(const u32x4*)(zr + 3200 + d * 64 + cg * 8);
    pf[2] = *(const u32x4*)(zr + 1024 + ch0);
    if (WANTY) pf[3] = *(const u32x4*)(zr + ch0);
    pf[4] = *(const u32x4*)(zr + 2048 + ch0);
  }
  const bf16x8 vfr = *(const bf16x8*)(TVT + (16 * w + l15) * 40 + 8 * q);
  const s16x4 t1f = *(const s16x4*)(TT + l15 * 40 + 4 * q), t2f = *(const s16x4*)(TT + (16 + l15) * 40 + 16 + 4 * q), l21f = *(const s16x4*)(TLB + l15 * 40 + 4 * q);
  bf16_t* XTw = XT + (16 * w + l15) * 40; bf16_t* UTw = UT + (16 * w + l15) * 40;
#pragma unroll
  for (int si = 0; si < NS; ++si) {
    const bool useV = (NS == 1) || (si == 1);
    const bf16_t* STs = TST + (si * 64 + 16 * w + l15) * 72;
    bf16x8 sf[2];
    sf[0] = *(const bf16x8*)(STs + 8 * q); sf[1] = *(const bf16x8*)(STs + 32 + 8 * q);
    f32x4 xa[2];
#pragma unroll
    for (int it = 0; it < 2; ++it) {
      xa[it] = (f32x4){0.f, 0.f, 0.f, 0.f};
#pragma unroll
      for (int ks = 0; ks < 2; ++ks) xa[it] = __builtin_amdgcn_mfma_f32_16x16x32_bf16(*(const bf16x8*)(TA + (16 * it + l15) * 72 + 32 * ks + 8 * q), sf[ks], xa[it], 0, 0, 0);
      if (useV) xa[it] = __builtin_amdgcn_mfma_f32_16x16x32_bf16(*(const bf16x8*)(TAK + (16 * it + l15) * 40 + 8 * q), vfr, xa[it], 0, 0, 0);
    }
    *(u32x2*)(XTw + 4 * q) = pack4(xa[0]);
    lds_wave_fence();
    f32x4 ua = __builtin_amdgcn_mfma_f32_16x16x16bf16_1k(t1f, *(const s16x4*)(XTw + 4 * q), (f32x4){0.f, 0.f, 0.f, 0.f}, 0, 0, 0);
    *(u32x2*)(UTw + 4 * q) = pack4(ua);
    lds_wave_fence();
    xa[1] = __builtin_amdgcn_mfma_f32_16x16x16bf16_1k(l21f, *(const s16x4*)(UTw + 4 * q), xa[1], 0, 0, 0);
    *(u32x2*)(XTw + 16 + 4 * q) = pack4(xa[1]);
    lds_wave_fence();
    ua = __builtin_amdgcn_mfma_f32_16x16x16bf16_1k(t2f, *(const s16x4*)(XTw + 16 + 4 * q), (f32x4){0.f, 0.f, 0.f, 0.f}, 0, 0, 0);
    *(u32x2*)(UTw + 16 + 4 * q) = pack4(ua);
    lds_wave_fence();
    const bf16x8 uf = *(const bf16x8*)(UTw + 8 * q);
    if (WANTY) {
#pragma unroll
      for (int it = 0; it < 2; ++it) {
        f32x4 ya = (f32x4){0.f, 0.f, 0.f, 0.f};
#pragma unroll
        for (int ks = 0; ks < 2; ++ks) ya = __builtin_amdgcn_mfma_f32_16x16x32_bf16(*(const bf16x8*)(TR + (16 * it + l15) * 72 + 32 * ks + 8 * q), sf[ks], ya, 0, 0, 0);
        ya = __builtin_amdgcn_mfma_f32_16x16x32_bf16(*(const bf16x8*)(TRB + (16 * it + l15) * 40 + 8 * q), uf, ya, 0, 0, 0);
        ya = __builtin_amdgcn_mfma_f32_16x16x32_bf16(*(const bf16x8*)(TRK + (16 * it + l15) * 40 + 8 * q), vfr, ya, 0, 0, 0);
        bf16_t* Yd = d == 0 ? p.Y0 : p.Y1;
#pragma unroll
        for (int rg = 0; rg < 4; ++rg) {
          const int iq = isc0 + 16 * it + 4 * q + rg, tq = d == 0 ? iq : T - 1 - iq;
          Yd[(size_t)(rowbase + tq) * DM + h * 64 + 16 * w + l15] = f2bf(ya[rg]);
        }
      }
    }
#pragma unroll
    for (int kt = 0; kt < 4; ++kt) {
      f32x4 hv = st[si][kt];
      hv = __builtin_amdgcn_mfma_f32_16x16x32_bf16(*(const bf16x8*)(TBT + (16 * kt + l15) * 40 + 8 * q), uf, hv, 0, 0, 0);
      if (useV) hv = __builtin_amdgcn_mfma_f32_16x16x32_bf16(*(const bf16x8*)(TKT + (16 * kt + l15) * 40 + 8 * q), vfr, hv, 0, 0, 0);
      hv *= *(const f32x4*)(GAM + 16 * kt + 4 * q);
      st[si][kt] = hv;
      *(u32x2*)(TST + (si * 64 + 16 * w + l15) * 72 + 16 * kt + 4 * q) = pack4(hv);
    }
  }
}

template <bool WANTY>
__device__ __forceinline__ void rwkv_prefetch_first(const P& p, int d, int h, int rowbase, int T, int isc0, u32x4 (&pf)[5]) {
  const int tid = threadIdx.x, tt = tid >> 3, cg = tid & 7, ch0 = h * 64 + cg * 8, isc = isc0 + tt, t = d == 0 ? isc : T - 1 - isc;
  const bf16_t* zr = p.zA + (size_t)(rowbase + t) * SHIFTC;
  pf[0] = *(const u32x4*)(zr + 3072 + d * 64 + cg * 8);
  pf[1] = *(const u32x4*)(zr + 3200 + d * 64 + cg * 8);
  pf[2] = *(const u32x4*)(zr + 1024 + ch0);
  pf[3] = WANTY ? *(const u32x4*)(zr + ch0) : (u32x4){0u, 0u, 0u, 0u};
  pf[4] = *(const u32x4*)(zr + 2048 + ch0);
}
__device__ __forceinline__ void rwkv_consts(const P& p, int d, int h, RwkvConsts& cc) {
  const int tid = threadIdx.x, lane = tid & 63, w = tid >> 6, l15 = lane & 15, q = lane >> 4;
#pragma unroll
  for (int ks = 0; ks < 2; ++ks) {
    cc.w2f[ks] = *(const bf16x8*)(p.w2T + ((size_t)d * 1024 + h * 64 + 16 * w + l15) * 64 + 32 * ks + 8 * q);
    cc.a2f[ks] = *(const bf16x8*)(p.a2T + ((size_t)d * 1024 + h * 64 + 16 * w + l15) * 64 + 32 * ks + 8 * q);
  }
}
__device__ __forceinline__ void ph_rwkv_A(const P& p, int vb, int nvb, unsigned char* smem) {
  const int tid = threadIdx.x, lane = tid & 63, w = tid >> 6, l15 = lane & 15, q = lane >> 4;
  bf16_t* TST = (bf16_t*)(smem + O_TST);
  for (int item = vb; item < 64 * 64; item += nvb) {
    const int chain = item >> 6, j = item & 63, b = chain >> 5, d = (chain >> 4) & 1, h = chain & 15;
    const bool latent = j > 0;
    const int T = latent ? SEQ : CTXL, rowbase = latent ? b * SEQ : NTOK + b * CTXL, base = latent ? (j - 1) * 256 : 0;
    RwkvConsts cc; rwkv_consts(p, d, h, cc);
    f32x4 st[2][4];
    __syncthreads();
#pragma unroll
    for (int kt = 0; kt < 4; ++kt) {
#pragma unroll
      for (int rg = 0; rg < 4; ++rg) st[0][kt][rg] = (16 * kt + 4 * q + rg == 16 * w + l15) ? 1.f : 0.f;
      st[1][kt] = (f32x4){0.f, 0.f, 0.f, 0.f};
      *(u32x2*)(TST + (16 * w + l15) * 72 + 16 * kt + 4 * q) = pack4(st[0][kt]);
      *(u32x2*)(TST + (64 + 16 * w + l15) * 72 + 16 * kt + 4 * q) = pack4(st[1][kt]);
    }
    u32x4 pf[5]; rwkv_prefetch_first<false>(p, d, h, rowbase, T, base, pf);
    for (int c = 0; c < 8; ++c) rwkv_chunk<2, false>(p, smem, d, h, rowbase, T, base + 32 * c, c < 7, st, pf);
    const size_t slot = (size_t)chain * NSUP + j;
#pragma unroll
    for (int kt = 0; kt < 4; ++kt) {
#pragma unroll
      for (int rg = 0; rg < 4; ++rg) p.Mst[(slot * 64 + 16 * kt + 4 * q + rg) * 64 + 16 * w + l15] = f2bf(st[0][kt][rg]);
      *(f32x4*)(p.Nst + (slot * 64 + 16 * w + l15) * 64 + 16 * kt + 4 * q) = st[1][kt];
    }
  }
}
__device__ __forceinline__ void ph_rwkv_B(const P& p, int vb, int nvb, unsigned char* smem) {
  const int tid = threadIdx.x, lane = tid & 63, w = tid >> 6, l15 = lane & 15, q = lane >> 4;
  bf16_t* HT = (bf16_t*)smem;
  for (int chain = vb; chain < 64; chain += nvb) {
    f32x4 hs[4];
#pragma unroll
    for (int kt = 0; kt < 4; ++kt) hs[kt] = (f32x4){0.f, 0.f, 0.f, 0.f};
    __syncthreads();
    for (int j = 0; j < 64; ++j) {
      const size_t slot = (size_t)chain * NSUP + j;
      f32x4 nv[4];
#pragma unroll
      for (int kt = 0; kt < 4; ++kt) nv[kt] = *(const f32x4*)(p.Nst + (slot * 64 + 16 * w + l15) * 64 + 16 * kt + 4 * q);
      bf16x8 mf[4][2];
#pragma unroll
      for (int kt = 0; kt < 4; ++kt)
#pragma unroll
        for (int ks = 0; ks < 2; ++ks) mf[kt][ks] = *(const bf16x8*)(p.Mst + (slot * 64 + 16 * kt + l15) * 64 + 32 * ks + 8 * q);
#pragma unroll
      for (int kt = 0; kt < 4; ++kt) {
        *(f32x4*)(p.Nst + (slot * 64 + 16 * w + l15) * 64 + 16 * kt + 4 * q) = hs[kt];
        *(u32x2*)(HT + (16 * w + l15) * 72 + 16 * kt + 4 * q) = pack4(hs[kt]);
      }
      lds_wave_fence();
      bf16x8 hf[2];
      hf[0] = *(const bf16x8*)(HT + (16 * w + l15) * 72 + 8 * q); hf[1] = *(const bf16x8*)(HT + (16 * w + l15) * 72 + 32 + 8 * q);
      lds_wave_fence();
#pragma unroll
      for (int kt = 0; kt < 4; ++kt) {
        f32x4 a = nv[kt];
#pragma unroll
        for (int ks = 0; ks < 2; ++ks) a = __builtin_amdgcn_mfma_f32_16x16x32_bf16(mf[kt][ks], hf[ks], a, 0, 0, 0);
        hs[kt] = a;
      }
    }
    const size_t slot = (size_t)chain * NSUP + 64;
#pragma unroll
    for (int kt = 0; kt < 4; ++kt) *(f32x4*)(p.Nst + (slot * 64 + 16 * w + l15) * 64 + 16 * kt + 4 * q) = hs[kt];
  }
}
__device__ __forceinline__ void ph_rwkv_C(const P& p, int vb, int nvb, unsigned char* smem) {
  const int tid = threadIdx.x, lane = tid & 63, w = tid >> 6, l15 = lane & 15, q = lane >> 4;
  bf16_t* TST = (bf16_t*)(smem + O_TST);
  for (int item = vb; item < 64 * 64; item += nvb) {
    const int chain = item >> 6, j = (item & 63) + 1, b = chain >> 5, d = (chain >> 4) & 1, h = chain & 15;
    RwkvConsts cc; rwkv_consts(p, d, h, cc);
    f32x4 st[1][4];
    const size_t slot = (size_t)chain * NSUP + j;
    __syncthreads();
#pragma unroll
    for (int kt = 0; kt < 4; ++kt) {
      st[0][kt] = *(const f32x4*)(p.Nst + (slot * 64 + 16 * w + l15) * 64 + 16 * kt + 4 * q);
      *(u32x2*)(TST + (16 * w + l15) * 72 + 16 * kt + 4 * q) = pack4(st[0][kt]);
    }
    u32x4 pf[5]; rwkv_prefetch_first<true>(p, d, h, b * SEQ, SEQ, (j - 1) * 256, pf);
    for (int c = 0; c < 8; ++c) rwkv_chunk<1, true>(p, smem, d, h, b * SEQ, SEQ, (j - 1) * 256 + 32 * c, c < 7, st, pf);
  }
}

#define RO_SMEM (128 * 16 * 4)
__device__ __forceinline__ void ph_readout(const P& p, int vb, int nvb, unsigned char* smem) {
  float* sgT = (float*)smem;
  const int tid = threadIdx.x, c4 = tid * 4, h = tid >> 4;
  const float4 lnw = *(const float4*)(p.ln_x_w + c4), lnb = *(const float4*)(p.ln_x_b + c4);
  for (int item = vb; item < NTOK / 16; item += nvb) {
    const int tok0 = item * 16;
    __syncthreads();
    {
      const int tk = tid >> 4, l8 = (tid & 15) * 8, m = tok0 + tk, b = m / SEQ, t = m % SEQ;
      float o[8];
      load_shift8(p.zA, p.mu_shift, b * SEQ, t, SEQ, 3328 + l8, o);
#pragma unroll
      for (int e = 0; e < 8; ++e) sgT[(l8 + e) * 16 + tk] = sigmoidf_(o[e]);
    }
    __syncthreads();
    float4 g[16];
#pragma unroll
    for (int k = 0; k < 16; ++k) g[k] = make_float4(0.f, 0.f, 0.f, 0.f);
    for (int l = 0; l < 128; ++l) {
      const float4 w = *(const float4*)(p.g2 + (size_t)l * 1024 + c4);
      const float4 s0 = *(const float4*)(sgT + l * 16), s1 = *(const float4*)(sgT + l * 16 + 4), s2 = *(const float4*)(sgT + l * 16 + 8), s3 = *(const float4*)(sgT + l * 16 + 12);
      const float sv[16] = {s0.x, s0.y, s0.z, s0.w, s1.x, s1.y, s1.z, s1.w, s2.x, s2.y, s2.z, s2.w, s3.x, s3.y, s3.z, s3.w};
#pragma unroll
      for (int k = 0; k < 16; ++k) { g[k].x += sv[k] * w.x; g[k].y += sv[k] * w.y; g[k].z += sv[k] * w.z; g[k].w += sv[k] * w.w; }
    }
#pragma unroll
    for (int k = 0; k < 16; ++k) {
      const int m = tok0 + k, b = m / SEQ, t = m % SEQ;
      const uint2 y0 = *(const uint2*)(p.Y0 + (size_t)m * DM + c4), y1 = *(const uint2*)(p.Y1 + (size_t)m * DM + c4);
      float y[4] = {bflo(y0.x) + bflo(y1.x), bfhi(y0.x) + bfhi(y1.x), bflo(y0.y) + bflo(y1.y), bfhi(y0.y) + bfhi(y1.y)};
      const float mu = red16(y[0] + y[1] + y[2] + y[3]) * (1.f / 64.f);
      float q = 0.f;
#pragma unroll
      for (int e = 0; e < 4; ++e) { y[e] -= mu; q += y[e] * y[e]; }
      const float rs = rsqrtf(red16(q) * (1.f / 64.f) + 64e-5f);
      const bf16_t* zr = p.zA + (size_t)m * SHIFTC + 2048 + c4;
      const uint2 zc = *(const uint2*)zr;
      uint2 zp = make_uint2(0, 0), zn = make_uint2(0, 0);
      if (t > 0) zp = *(const uint2*)(zr - SHIFTC);
      if (t < SEQ - 1) zn = *(const uint2*)(zr + SHIFTC);
      const float4 mu4 = *(const float4*)(p.mu_shift + 2048 + c4);
      float v[4];
      v[0] = bflo(zc.x) + mu4.x * (0.5f * (bflo(zp.x) + bflo(zn.x)) - bflo(zc.x));
      v[1] = bfhi(zc.x) + mu4.y * (0.5f * (bfhi(zp.x) + bfhi(zn.x)) - bfhi(zc.x));
      v[2] = bflo(zc.y) + mu4.z * (0.5f * (bflo(zp.y) + bflo(zn.y)) - bflo(zc.y));
      v[3] = bfhi(zc.y) + mu4.w * (0.5f * (bfhi(zp.y) + bfhi(zn.y)) - bfhi(zc.y));
      const float bon = 0.5f * (p.bdot[(size_t)m * 16 + h] + p.bdot[((size_t)NTOK + m) * 16 + h]);
      const float o0 = (y[0] * rs * lnw.x + lnb.x + bon * v[0]) * g[k].x, o1 = (y[1] * rs * lnw.y + lnb.y + bon * v[1]) * g[k].y;
      const float o2 = (y[2] * rs * lnw.z + lnb.z + bon * v[2]) * g[k].z, o3 = (y[3] * rs * lnw.w + lnb.w + bon * v[3]) * g[k].w;
      uint2 w; w.x = pack2(o0, o1); w.y = pack2(o2, o3);
      *(uint2*)(p.out_a + (size_t)m * DM + c4) = w;
    }
  }
}

#define POOL_SMEM (64 * 128 * 4)
__device__ __forceinline__ void ph_pool(const P& p, int vb, int nvb, unsigned char* smem) {
  float* V = (float*)smem;
  const int tid = threadIdx.x, cp = tid & 63, cq = tid >> 6;
  for (int item = vb; item < 2 * 4 * 64; item += nvb) {
    const int j = item & 3, st = (item >> 2) & 63, b = item >> 8;
    const int win = 2 << j, half = win >> 1;
    const bf16_t* zb = p.zP + (size_t)b * SEQ * 512 + j * 128 + cp * 2;
    float a0[16], a1[16];
#pragma unroll
    for (int i = 0; i < 16; ++i) { a0[i] = 0.f; a1[i] = 0.f; }
    {
      const int r = 4 * st, r0 = max(r - half, 0), r1 = min(r + half, 256);
      for (int rr = r0; rr < r1; ++rr) {
#pragma unroll
        for (int i = 0; i < 16; ++i) { const unsigned u = *(const unsigned*)(zb + (size_t)(rr * 64 + cq * 16 + i) * 512); a0[i] += bflo(u); a1[i] += bfhi(u); }
      }
    }
    for (int dr = 0; dr < 4; ++dr) {
      const int r = 4 * st + dr, r0 = max(r - half, 0), r1 = min(r + half, 256);
      if (dr > 0) {
        const int radd = r + half - 1, rsub = r - half - 1;
        if (radd < 256) {
#pragma unroll
          for (int i = 0; i < 16; ++i) { const unsigned u = *(const unsigned*)(zb + (size_t)(radd * 64 + cq * 16 + i) * 512); a0[i] += bflo(u); a1[i] += bfhi(u); }
        }
        if (rsub >= 0) {
#pragma unroll
          for (int i = 0; i < 16; ++i) { const unsigned u = *(const unsigned*)(zb + (size_t)(rsub * 64 + cq * 16 + i) * 512); a0[i] -= bflo(u); a1[i] -= bfhi(u); }
        }
      }
      __syncthreads();
#pragma unroll
      for (int i = 0; i < 16; ++i) *(f32x2*)(V + (cq * 16 + i) * 128 + cp * 2) = (f32x2){a0[i], a1[i]};
      __syncthreads();
      float s0 = 0.f, s1 = 0.f;
      {
        const int c = cq * 16, c0 = max(c - half, 0), c1 = min(c + half, 64);
        for (int cc = c0; cc < c1; ++cc) { const f32x2 v = *(const f32x2*)(V + cc * 128 + cp * 2); s0 += v.x; s1 += v.y; }
      }
#pragma unroll
      for (int i = 0; i < 16; ++i) {
        const int c = cq * 16 + i, c0 = max(c - half, 0), c1 = min(c + half, 64);
        if (i > 0) {
          const int cadd = c + half - 1, csub = c - half - 1;
          if (cadd < 64) { const f32x2 v = *(const f32x2*)(V + cadd * 128 + cp * 2); s0 += v.x; s1 += v.y; }
          if (csub >= 0) { const f32x2 v = *(const f32x2*)(V + csub * 128 + cp * 2); s0 -= v.x; s1 -= v.y; }
        }
        const float inv = 1.0f / (float)((r1 - r0) * (c1 - c0));
        const size_t tokoff = ((size_t)b * SEQ + r * 64 + c) * 512 + j * 128 + cp * 2;
        const unsigned u = *(const unsigned*)(p.zP + tokoff);
        *(unsigned*)(p.pooled + tokoff) = pack2(s0 * inv - bflo(u), s1 * inv - bfhi(u));
      }
    }
  }
}
__device__ __forceinline__ void ph_merge(const P& p, int vb, int nvb) {
  for (size_t i = ((size_t)vb * 256 + threadIdx.x) * 4; i < (size_t)NTOK * DM; i += (size_t)nvb * 1024) {
    const size_t m = i >> 10; const int c = (int)(i & 1023);
    const uint2 g1 = *(const uint2*)(p.zG + m * 2048 + c), g2 = *(const uint2*)(p.zG + m * 2048 + 1024 + c);
    const uint2 a = *(const uint2*)(p.ya + i), bq = *(const uint2*)(p.yb + i);
    const float4 b1 = *(const float4*)(p.b_gate + c), b2 = *(const float4*)(p.b_gate + 1024 + c);
    const float m0 = sigmoidf_(bflo(g1.x) + b1.x) * bflo(a.x) + sigmoidf_(bflo(g2.x) + b2.x) * bflo(bq.x);
    const float m1 = sigmoidf_(bfhi(g1.x) + b1.y) * bfhi(a.x) + sigmoidf_(bfhi(g2.x) + b2.y) * bfhi(bq.x);
    const float m2 = sigmoidf_(bflo(g1.y) + b1.z) * bflo(a.y) + sigmoidf_(bflo(g2.y) + b2.z) * bflo(bq.y);
    const float m3 = sigmoidf_(bfhi(g1.y) + b1.w) * bfhi(a.y) + sigmoidf_(bfhi(g2.y) + b2.w) * bfhi(bq.y);
    uint2 w; w.x = pack2(m0, m1); w.y = pack2(m2, m3);
    *(uint2*)(p.mrg + i) = w;
  }
}
__device__ __forceinline__ void ph_res1(const P& p, int vb, int nvb) {
  const int lane = threadIdx.x & 63, wid = threadIdx.x >> 6;
  for (int m = vb * 4 + wid; m < NTOK; m += nvb * 4) {
    const float* md = p.mod + (m / SEQ) * 6144;
    float mx[16]; float ss = 0.f;
#pragma unroll
    for (int i = 0; i < 4; ++i) {
      const uint2 u = *(const uint2*)(p.mix + (size_t)m * DM + i * 256 + lane * 4);
      mx[4 * i] = bflo(u.x); mx[4 * i + 1] = bfhi(u.x); mx[4 * i + 2] = bflo(u.y); mx[4 * i + 3] = bfhi(u.y);
#pragma unroll
      for (int e = 0; e < 4; ++e) ss += mx[4 * i + e] * mx[4 * i + e];
    }
    ss = wave_sum(ss);
    const float rstd = rsqrtf(ss * (1.0f / 1024.0f) + 1e-6f);
    float x1[16]; float s2 = 0.f;
#pragma unroll
    for (int i = 0; i < 4; ++i) {
      const int col = i * 256 + lane * 4;
      const float4 xv = *(const float4*)(p.x + (size_t)m * DM + col), g = *(const float4*)(p.g_post_mix + col), gt = *(const float4*)(md + 2048 + col);
      x1[4 * i] = xv.x + gt.x * mx[4 * i] * rstd * g.x; x1[4 * i + 1] = xv.y + gt.y * mx[4 * i + 1] * rstd * g.y;
      x1[4 * i + 2] = xv.z + gt.z * mx[4 * i + 2] * rstd * g.z; x1[4 * i + 3] = xv.w + gt.w * mx[4 * i + 3] * rstd * g.w;
      *(float4*)(p.out + (size_t)m * DM + col) = make_float4(x1[4 * i], x1[4 * i + 1], x1[4 * i + 2], x1[4 * i + 3]);
#pragma unroll
      for (int e = 0; e < 4; ++e) s2 += x1[4 * i + e] * x1[4 * i + e];
    }
    s2 = wave_sum(s2);
    const float r2 = rsqrtf(s2 * (1.0f / 1024.0f) + 1e-6f);
#pragma unroll
    for (int i = 0; i < 4; ++i) {
      const int col = i * 256 + lane * 4;
      const float4 g = *(const float4*)(p.g_pre_ffn + col), sh = *(const float4*)(md + 3072 + col), sc = *(const float4*)(md + 4096 + col);
      uint2 w;
      w.x = pack2(x1[4 * i] * r2 * g.x * (1.f + sc.x) + sh.x, x1[4 * i + 1] * r2 * g.y * (1.f + sc.y) + sh.y);
      w.y = pack2(x1[4 * i + 2] * r2 * g.z * (1.f + sc.z) + sh.z, x1[4 * i + 3] * r2 * g.w * (1.f + sc.w) + sh.w);
      *(uint2*)(p.hx2 + (size_t)m * DM + col) = w;
    }
  }
}

#define PS1_SMEM (128 * 133 * 4)
#define CE_DESC(a, b) { const float _mx = fmaxf(a, b), _mn = fminf(a, b); a = _mx; b = _mn; }
template <int N> __device__ __forceinline__ void bitonic_sort_desc(float (&v)[N]) {
#pragma unroll
  for (int k = 2; k <= N; k <<= 1)
#pragma unroll
    for (int j = k >> 1; j > 0; j >>= 1)
#pragma unroll
      for (int i = 0; i < N; ++i) { const int l = i ^ j; if (l > i) { if ((i & k) == 0) CE_DESC(v[i], v[l]) else CE_DESC(v[l], v[i]) } }
}
__device__ __forceinline__ void bitonic_merge16_desc(float (&v)[16]) {
#pragma unroll
  for (int j = 8; j > 0; j >>= 1)
#pragma unroll
    for (int i = 0; i < 16; ++i) { const int l = i ^ j; if (l > i) CE_DESC(v[i], v[l]) }
}
__device__ __forceinline__ void ph_peer_s1(const P& p, int vb, int nvb, unsigned char* smem) {
  float* S = (float*)smem;
  EpiLds epi{S};
  const int tid = threadIdx.x, sub = tid & 3;
  for (int item = vb; item < 256 * 16; item += nvb) {
    const int hp = item & 15, tm = item >> 4;
    __syncthreads();
    gemm_tile(p.q + hp * 128, 2048, p.keys + (size_t)hp * 128 * 128, 128, 128, tm * 128, 0, epi, smem);
    __syncthreads();
#pragma unroll 1
    for (int pass = 0; pass < 2; ++pass) {
      const int row = pass * 64 + (tid >> 2);
      float a[16], b[16];
#pragma unroll
      for (int i = 0; i < 16; ++i) {
        a[i] = __uint_as_float((__float_as_uint(S[row * 133 + sub * 33 + i]) & ~127u) | (unsigned)(sub * 32 + i));
        b[i] = __uint_as_float((__float_as_uint(S[row * 133 + sub * 33 + 16 + i]) & ~127u) | (unsigned)(sub * 32 + 16 + i));
      }
      bitonic_sort_desc<16>(a); bitonic_sort_desc<16>(b);
#pragma unroll
      for (int i = 0; i < 16; ++i) a[i] = fmaxf(a[i], b[15 - i]);
      bitonic_merge16_desc(a);
#pragma unroll
      for (int lvl = 1; lvl <= 2; lvl <<= 1) {
#pragma unroll
        for (int i = 0; i < 16; ++i) b[i] = __shfl_xor(a[i], lvl);
#pragma unroll
        for (int i = 0; i < 16; ++i) a[i] = fmaxf(a[i], b[15 - i]);
        bitonic_merge16_desc(a);
      }
      if (sub == 0) {
        const size_t ob = ((size_t)(tm * 128 + row) * 16 + hp) * 16;
#pragma unroll
        for (int i = 0; i < 16; i += 4) {
          *(f32x4*)(p.sv + ob + i) = (f32x4){a[i], a[i + 1], a[i + 2], a[i + 3]};
          typedef int i32x4 __attribute__((ext_vector_type(4)));
          *(i32x4*)(p.si + ob + i) = (i32x4){(int)(__float_as_uint(a[i]) & 127u), (int)(__float_as_uint(a[i + 1]) & 127u), (int)(__float_as_uint(a[i + 2]) & 127u), (int)(__float_as_uint(a[i + 3]) & 127u)};
        }
      }
    }
  }
}
__device__ __forceinline__ void top16_merge(float (&x)[16], const float (&y)[16]) {
#pragma unroll
  for (int i = 0; i < 16; ++i) x[i] = fmaxf(x[i], y[15 - i]);
  bitonic_merge16_desc(x);
}
__device__ __forceinline__ void ph_peer_s2(const P& p, int vb, int nvb, unsigned char* smem) {
  unsigned char* lut = smem;
  __syncthreads();
  if (threadIdx.x == 0) {
    int n = 0;
#pragma unroll
    for (int i = 0; i < 16; ++i)
#pragma unroll
      for (int j = 0; j < 16; ++j)
        if ((i + 1) * (j + 1) <= 16) { lut[n] = (unsigned char)((i << 4) | j); ++n; }
  }
  __syncthreads();
  for (int it = vb * 256 + threadIdx.x; it < NTOK * 8; it += nvb * 256) {
    const size_t ob = (size_t)it * 32;
    float a[16], bq[16];
#pragma unroll
    for (int i = 0; i < 16; i += 4) {
      const f32x4 fa = *(const f32x4*)(p.sv + ob + i), fb = *(const f32x4*)(p.sv + ob + 16 + i);
#pragma unroll
      for (int e = 0; e < 4; ++e) { a[i + e] = fa[e]; bq[i + e] = fb[e]; }
    }
    float g0[16], g1[16], g2[16], g3[16];
    {
      int n = 0;
#pragma unroll
      for (int i = 0; i < 16; ++i)
#pragma unroll
        for (int j = 0; j < 16; ++j)
          if ((i + 1) * (j + 1) <= 16) {
            const float v = __uint_as_float((__float_as_uint(a[i] + bq[j]) & ~63u) | (unsigned)n);
            if (n < 16) g0[n] = v; else if (n < 32) g1[n - 16] = v; else if (n < 48) g2[n - 32] = v; else g3[n - 48] = v;
            ++n;
          }
#pragma unroll
      for (int k = 2; k < 16; ++k) g3[k] = -3.0e38f;
    }
    bitonic_sort_desc<16>(g0); bitonic_sort_desc<16>(g1); bitonic_sort_desc<16>(g2); bitonic_sort_desc<16>(g3);
    top16_merge(g0, g1); top16_merge(g2, g3); top16_merge(g0, g2);
    float den = 0.f; float ex[16]; int seli[16];
#pragma unroll
    for (int k = 0; k < 16; ++k) {
      ex[k] = __expf(g0[k] - g0[0]); den += ex[k];
      const int ij = lut[__float_as_uint(g0[k]) & 63u];
      const int ka = (int)(__float_as_uint(p.sv[ob + (ij >> 4)]) & 127u), kb = (int)(__float_as_uint(p.sv[ob + 16 + (ij & 15)]) & 127u);
      seli[k] = ka * 128 + kb;
    }
    const float inv = 1.0f / den;
    const size_t o2 = (size_t)it * 16;
    typedef int i32x4 __attribute__((ext_vector_type(4)));
#pragma unroll
    for (int k = 0; k < 16; k += 4) {
      *(i32x4*)(p.pidx + o2 + k) = (i32x4){seli[k], seli[k + 1], seli[k + 2], seli[k + 3]};
      *(f32x4*)(p.pgate + o2 + k) = (f32x4){ex[k] * inv, ex[k + 1] * inv, ex[k + 2] * inv, ex[k + 3] * inv};
    }
  }
}
typedef float f32x16 __attribute__((ext_vector_type(16)));
typedef float f32x32 __attribute__((ext_vector_type(32)));
typedef unsigned u32x6 __attribute__((ext_vector_type(6)));
__device__ __forceinline__ float half_max(float v) {
#pragma unroll
  for (int o = 16; o > 0; o >>= 1) v = fmaxf(v, __shfl_xor(v, o));
  return v;
}
__device__ __forceinline__ float half_sum(float v) {
#pragma unroll
  for (int o = 16; o > 0; o >>= 1) v += __shfl_xor(v, o);
  return v;
}
__device__ __forceinline__ void ph_cvt_fp6(const float* __restrict__ in, unsigned char* __restrict__ out, float* __restrict__ inv_scale, int vb, int nvb) {
  const int lane = threadIdx.x & 63, wid = threadIdx.x >> 6, hf = lane >> 5, sl = lane & 31;
  for (int rp = vb * 4 + wid; rp < 8192; rp += nvb * 4) {
    const int row = rp * 2 + hf;
    f32x16 a, b2; float am = 0.f;
#pragma unroll
    for (int i = 0; i < 4; ++i) {
      const f32x4 v0 = *(const f32x4*)(in + (size_t)row * DM + sl * 32 + 4 * i), v1 = *(const f32x4*)(in + (size_t)row * DM + sl * 32 + 16 + 4 * i);
#pragma unroll
      for (int e = 0; e < 4; ++e) { a[4 * i + e] = v0[e]; b2[4 * i + e] = v1[e]; am = fmaxf(am, fmaxf(fabsf(v0[e]), fabsf(v1[e]))); }
    }
    am = half_max(am);
    const float sc = am > 0.f ? 7.0f / am : 1.0f;
    const u32x6 pk = __builtin_amdgcn_cvt_scalef32_2xpk16_fp6_f32(a * sc, b2 * sc, 1.0f);
    unsigned char* o = out + (size_t)row * 768 + sl * 24;
    *(u32x2*)(o) = (u32x2){pk[0], pk[1]}; *(u32x2*)(o + 8) = (u32x2){pk[2], pk[3]}; *(u32x2*)(o + 16) = (u32x2){pk[4], pk[5]};
    if (sl == 0) inv_scale[row] = am > 0.f ? am / 7.0f : 1.0f;
  }
}
__device__ __forceinline__ u32x6 load_row6(const unsigned char* base, int id, int sl) {
  const unsigned char* q = base + (size_t)id * 768 + sl * 24;
  const u32x2 a = *(const u32x2*)q, b = *(const u32x2*)(q + 8), c = *(const u32x2*)(q + 16);
  return (u32x6){a.x, a.y, b.x, b.y, c.x, c.y};
}
#define GATHER_SMEM (4 * 64 * 33 * 4)
__device__ __forceinline__ void ph_peer_gather(const P& p, int vb, int nvb, unsigned char* smem) {
  int tid_ = threadIdx.x;
  asm volatile("" : "+v"(tid_));
  const int lane = tid_ & 63, wid = tid_ >> 6, hf = lane >> 5, sl = lane & 31;
  float* scr = (float*)smem + (wid * 64 + lane) * 33;
  int* tauL = (int*)(smem + GATHER_SMEM) + wid * 32;
  {
    f32x16 a, b2;
#pragma unroll
    for (int i = 0; i < 16; ++i) { a[i] = __uint_as_float((unsigned)i << 20) * 0x1p126f; b2[i] = __uint_as_float((unsigned)(16 + i) << 20) * 0x1p126f; }
    const f32x32 o = __builtin_amdgcn_cvt_scalef32_pk32_f32_fp6(__builtin_amdgcn_cvt_scalef32_2xpk16_fp6_f32(a, b2, 1.0f), 1.0f);
    if (lane == 0) {
#pragma unroll
      for (int j = 0; j < 32; ++j) tauL[j] = (int)((__float_as_uint(o[j] * 0x1p-126f) >> 20) & 31u);
    }
  }
  const int jmap = 2 * (lane & 1) + ((lane >> 1) & 1);
  __syncthreads();
  for (int m = vb * 4 + wid; m < NTOK; m += nvb * 4) {
    const float* md = p.mod + (m / SEQ) * 6144;
    float xh[32];
    {
#pragma unroll
      for (int c4 = 0; c4 < 4; ++c4) {
        const u32x4 u = *(const u32x4*)(p.hx2 + (size_t)m * DM + sl * 32 + 8 * c4);
#pragma unroll
        for (int e = 0; e < 4; ++e) { scr[8 * c4 + 2 * e] = bflo(u[e]); scr[8 * c4 + 2 * e + 1] = bfhi(u[e]); }
      }
      lds_wave_fence();
#pragma unroll
      for (int j = 0; j < 32; ++j) xh[j] = scr[tauL[j]];
      lds_wave_fence();
    }
    const int id0 = p.pidx[(size_t)m * 128 + lane], id1 = p.pidx[(size_t)m * 128 + 64 + lane];
    const float su0 = p.us[id0], su1 = p.us[id1];
    const float gs0 = p.pgate[(size_t)m * 128 + lane] * p.vs[id0], gs1 = p.pgate[(size_t)m * 128 + 64 + lane] * p.vs[id1];
    float acch[32];
#pragma unroll
    for (int k = 0; k < 32; ++k) acch[k] = 0.f;
#pragma unroll 1
    for (int e0 = 0; e0 < 128; e0 += 8) {
      u32x6 ur[4], vr[4];
#pragma unroll
      for (int j = 0; j < 4; ++j) {
        const int id = __shfl(e0 < 64 ? id0 : id1, (e0 + hf * 4 + j) & 63);
        ur[j] = load_row6(p.ub8, id, sl);
        vr[j] = load_row6(p.vb8, id, sl);
      }
      float d[4];
#pragma unroll
      for (int j = 0; j < 4; ++j) {
        const f32x32 f = __builtin_amdgcn_cvt_scalef32_pk32_f32_fp6(ur[j], 1.0f);
        float s0 = 0.f, s1 = 0.f;
#pragma unroll
        for (int k = 0; k < 32; k += 2) { s0 += f[k] * xh[k]; s1 += f[k + 1] * xh[k + 1]; }
        d[j] = s0 + s1;
      }
      float r2[2], r1;
      {
        const bool lo = (lane & 1) == 0;
#pragma unroll
        for (int i = 0; i < 2; ++i) { const float keep = lo ? d[i] : d[i + 2], send = lo ? d[i + 2] : d[i]; r2[i] = keep + __shfl_xor(send, 1); }
        const bool lo2 = (lane & 2) == 0;
        { const float keep = lo2 ? r2[0] : r2[1], send = lo2 ? r2[1] : r2[0]; r1 = keep + __shfl_xor(send, 2); }
        r1 += __shfl_xor(r1, 4); r1 += __shfl_xor(r1, 8); r1 += __shfl_xor(r1, 16);
      }
      const int esrc = (e0 + hf * 4 + jmap) & 63;
      const float su = __shfl(e0 < 64 ? su0 : su1, esrc), gs = __shfl(e0 < 64 ? gs0 : gs1, esrc);
      const float sdot = r1 * su;
      const float cf = 0.5f * sdot * (1.0f + erff(sdot * 0.70710678118654752f)) * gs;
#pragma unroll
      for (int j = 0; j < 4; ++j) {
        const float cj = __shfl(cf, (lane & 32) | ((j >> 1) | ((j & 1) << 1)));
        const f32x32 f = __builtin_amdgcn_cvt_scalef32_pk32_f32_fp6(vr[j], 1.0f);
#pragma unroll
        for (int k = 0; k < 32; ++k) acch[k] += cj * f[k];
      }
    }
#pragma unroll
    for (int k = 0; k < 32; ++k) { acch[k] += __shfl_xor(acch[k], 32); scr[tauL[k]] = acch[k]; }
    lds_wave_fence();
    float ss = 0.f;
#pragma unroll
    for (int k = 0; k < 32; ++k) { const float v = scr[k]; ss += v * v; }
    ss = half_sum(ss);
    const float rstd = rsqrtf(ss * (1.0f / 1024.0f) + 1e-6f);
#pragma unroll
    for (int k4 = 0; k4 < 4; ++k4) {
      const int kk = hf * 16 + k4 * 4, col = sl * 32 + kk;
      f32x4 x1 = *(const f32x4*)(p.out + (size_t)m * DM + col);
      const f32x4 g = *(const f32x4*)(p.g_post_ffn + col), gt = *(const f32x4*)(md + 5120 + col);
#pragma unroll
      for (int e = 0; e < 4; ++e) x1[e] += gt[e] * scr[kk + e] * rstd * g[e];
      *(f32x4*)(p.out + (size_t)m * DM + col) = x1;
    }
    lds_wave_fence();
  }
}

#define XB_TMO      128
#define XB_XCNT(j)  (256  + 64 * (j))
#define XB_XSUB(j)  (1280 + 64 * (j))
#define XB_XGEN(j)  (2304 + 64 * (j))
#define XB_TOP      3328
#define XB_TOPGEN   3392
#define XCD_BAR_WORDS 3456
#define XB_SPIN_CAP (1u << 20)
#define LAS __attribute__((address_space(3)))
__device__ __forceinline__ unsigned xb_ld(unsigned* p)              { return __hip_atomic_load(p, __ATOMIC_RELAXED, __HIP_MEMORY_SCOPE_AGENT); }
__device__ __forceinline__ unsigned xb_add(unsigned* p, unsigned v) { return __hip_atomic_fetch_add(p, v, __ATOMIC_RELAXED, __HIP_MEMORY_SCOPE_AGENT); }
__device__ __forceinline__ unsigned xb_xcc_id() { return (unsigned)__builtin_amdgcn_s_getreg((3 << 11) | 20) & 0xFu; }
#define XB_SPIN(cond, bar) do { unsigned _sp = 0; while (cond) { __builtin_amdgcn_s_sleep(1); \
    if ((++_sp & 255u) == 0u) { if (xb_ld(&(bar)[XB_TMO])) break; if (_sp > XB_SPIN_CAP) { atomicAdd(&(bar)[XB_TMO], 1u); break; } } } } while (0)
struct XcdBarrier { unsigned* bar; unsigned x; volatile LAS unsigned* st; };
__device__ __forceinline__ XcdBarrier xcd_barrier_post(unsigned* bar, volatile LAS unsigned* st) {
  XcdBarrier b; b.bar = bar; b.x = xb_xcc_id(); b.st = st;
  if (threadIdx.x == 0) (void)xb_add(&bar[XB_XCNT(b.x)], 1u);
  return b;
}
__device__ __forceinline__ void xcd_barrier_complete(unsigned* bar, unsigned x, unsigned& nloc, unsigned& nx) {
  const unsigned G = gridDim.x * gridDim.y * gridDim.z;
  unsigned sum, cnt, mine, sp = 0u;
  for (;;) {
    sum = 0u; cnt = 0u; mine = 0u;
#pragma unroll
    for (unsigned j = 0; j < 16; ++j) { const unsigned c = xb_ld(&bar[XB_XCNT(j)]); sum += c; cnt += (c > 0u) ? 1u : 0u; mine = (j == x) ? c : mine; }
    if (sum == G) break;
    __builtin_amdgcn_s_sleep(1);
    if ((++sp & 255u) == 0u) { if (xb_ld(&bar[XB_TMO])) break; if (sp > XB_SPIN_CAP) { atomicAdd(&bar[XB_TMO], 1u); break; } }
  }
  nloc = mine > 0u ? mine : 1u; nx = cnt > 0u ? cnt : 1u;
}
__device__ __forceinline__ void xcd_barrier(const XcdBarrier& b) {
  asm volatile("s_waitcnt vmcnt(0)" ::: "memory");
  __syncthreads();
  if (threadIdx.x == 0) {
    unsigned* bar = b.bar;
    __builtin_amdgcn_s_waitcnt(0);
    unsigned nloc = b.st[0], nx = b.st[1];
    if (nloc == 0u) { xcd_barrier_complete(bar, b.x, nloc, nx); b.st[0] = nloc; b.st[1] = nx; }
    const unsigned old = xb_add(&bar[XB_XSUB(b.x)], 1u);
    const unsigned gen = old / nloc;
    if (old + 1u == (gen + 1u) * nloc) {
      __builtin_amdgcn_fence(__ATOMIC_RELEASE, "agent");
      asm volatile("s_waitcnt vmcnt(0)" ::: "memory");
      const unsigned og = xb_add(&bar[XB_TOP], 1u);
      const unsigned tg = og / nx;
      if (og + 1u == (tg + 1u) * nx) xb_add(&bar[XB_TOPGEN], 1u);
      else XB_SPIN(xb_ld(&bar[XB_TOPGEN]) == tg, bar);
      __builtin_amdgcn_fence(__ATOMIC_ACQUIRE, "agent");
      xb_add(&bar[XB_XGEN(b.x)], 1u);
      asm volatile("s_waitcnt vmcnt(0)" ::: "memory");
    } else {
      XB_SPIN(xb_ld(&bar[XB_XGEN(b.x)]) == gen, bar);
      __builtin_amdgcn_fence(__ATOMIC_ACQUIRE, "agent");
      asm volatile("s_waitcnt vmcnt(0)" ::: "memory");
    }
  }
  __syncthreads();
}

#define SMEM_BYTES RWKV_SMEM
__global__ void __launch_bounds__(256, 2) mega(P p) {
  __shared__ __attribute__((aligned(16))) unsigned char smem[SMEM_BYTES + 16];
  cg::grid_group grid = cg::this_grid();
  const int vb = blockIdx.x, nvb = gridDim.x;
  if (threadIdx.x == 0) *(u32x4*)(smem + SMEM_BYTES) = (u32x4){0u, 0u, 0u, 0u};
  __syncthreads();
  const XcdBarrier xb = xcd_barrier_post(p.bar, (volatile LAS unsigned*)(smem + SMEM_BYTES));
  ph_mod(p, vb, nvb, smem);
  ph_transpose(p.w_in, p.Wt_in, DM, INC, vb, nvb, smem);
  ph_transpose(p.w2, p.w2T, 64, 1024, vb, nvb, smem);
  ph_transpose(p.w2 + 65536, p.w2T + 65536, 64, 1024, vb, nvb, smem);
  ph_transpose(p.a2, p.a2T, 64, 1024, vb, nvb, smem);
  ph_transpose(p.a2 + 65536, p.a2T + 65536, 64, 1024, vb, nvb, smem);
  if (p.bar == nullptr) grid.sync();
  xcd_barrier(xb);
  ph_norm1(p, vb, nvb);
  xcd_barrier(xb);
  ph_gemm1(p, vb, nvb, smem);
  xcd_barrier(xb);
  ph_rwkv_A(p, vb, nvb, smem);
  xcd_barrier(xb);
  ph_rwkv_B(p, vb, nvb, smem);
  if (nvb > 128 && vb >= 64) {
    const int v2 = vb - 64, n2 = nvb - 64;
    ph_transpose(p.w_a_out, p.Wt_aout, DM, DM, v2, n2, smem);
    ph_transpose(p.w_o, p.Wt_o, DM, DM, v2, n2, smem);
    ph_transpose(p.peer_wq, p.Wt_q, DM, 2048, v2, n2, smem);
    ph_transpose(p.g2, p.g2T, 128, 1024, v2, n2, smem);
    ph_weff(p, v2, n2);
    ph_convert(p.peer_keys, p.keys, (size_t)16 * 128 * 128, v2, n2);
  } else if (nvb <= 128) {
    ph_transpose(p.w_a_out, p.Wt_aout, DM, DM, vb, nvb, smem);
    ph_transpose(p.w_o, p.Wt_o, DM, DM, vb, nvb, smem);
    ph_transpose(p.peer_wq, p.Wt_q, DM, 2048, vb, nvb, smem);
    ph_transpose(p.g2, p.g2T, 128, 1024, vb, nvb, smem);
    ph_weff(p, vb, nvb);
    ph_convert(p.peer_keys, p.keys, (size_t)16 * 128 * 128, vb, nvb);
  }
  xcd_barrier(xb);
  ph_rwkv_C(p, vb, nvb, smem);
  ph_sg(p, vb, nvb);
  xcd_barrier(xb);
  ph_readout_gemm(p, vb, nvb, smem);
  ph_pool(p, vb, nvb, smem);
  ph_cvt_fp6(p.peer_u, p.ub8, p.us, vb, nvb);
  ph_cvt_fp6(p.peer_v, p.vb8, p.vs, vb, nvb);
  xcd_barrier(xb);
  ph_gemm_merge(p, vb, nvb, smem);
  xcd_barrier(xb);
  ph_gemm_simple(p.mrg, DM, p.Wt_o, DM, DM, NTOK, DM, p.mix, DM, vb, nvb, smem);
  xcd_barrier(xb);
  ph_res1(p, vb, nvb);
  xcd_barrier(xb);
  ph_gemm_simple(p.hx2, DM, p.Wt_q, DM, DM, NTOK, 2048, p.q, 2048, vb, nvb, smem);
  xcd_barrier(xb);
  ph_peer_s1(p, vb, nvb, smem);
  xcd_barrier(xb);
  ph_peer_s2(p, vb, nvb, smem);
  xcd_barrier(xb);
  ph_peer_gather(p, vb, nvb, smem);
}

extern "C" void kernel_launch(void* const* d_in, const int* in_sizes, int n_in, void* d_out, int out_size, void* d_ws, size_t ws_size, hipStream_t stream) {
  P p{};
  const float** f = (const float**)&p;
  for (int i = 0; i < 32; ++i) f[i] = (const float*)d_in[i];
  p.out = (float*)d_out;
  p.bar = (unsigned*)((unsigned char*)d_ws + 511 * 1048576);
  unsigned char* w = (unsigned char*)d_ws;
  const size_t MiB = 1048576;
  const size_t HM = 524288;
  p.hx = (bf16_t*)(w + 4096);
  p.zA = (bf16_t*)(w + 65 * MiB + 8192);
  p.zP = (bf16_t*)(w + 569 * HM);
  p.zG = (bf16_t*)d_out;
  unsigned char* rw = w + 633 * HM;
  p.Wt_in = (bf16_t*)rw; rw += 12 * MiB;
  p.Wt_aout = (bf16_t*)rw; rw += 2 * MiB;
  p.Wt_eff = (bf16_t*)rw; rw += 1 * MiB;
  p.Wt_o = (bf16_t*)rw; rw += 2 * MiB;
  p.Wt_q = (bf16_t*)rw; rw += 4 * MiB;
  p.keys = (bf16_t*)rw; rw += HM;
  p.mod = (float*)rw; rw += HM;
  p.g2T = (bf16_t*)rw; rw += HM;
  p.w2T = (bf16_t*)rw; rw += HM;
  p.a2T = (bf16_t*)rw; rw += HM;
  p.Y0 = (bf16_t*)(w + 0 * MiB);
  p.Y1 = (bf16_t*)(w + 340 * MiB);
  p.bdot = (float*)(w + 404 * MiB);
  p.Mst = (bf16_t*)(w + 408 * MiB);
  p.sg = (bf16_t*)(w + 408 * MiB);
  p.Nst = (float*)(w + 441 * MiB);
  p.ub8 = w + 416 * MiB;
  p.vb8 = w + 432 * MiB;
  p.us = (float*)(w + 448 * MiB);
  p.vs = (float*)(w + 449 * MiB);
  p.pooled = (bf16_t*)(w + 478 * MiB);
  p.out_a = (bf16_t*)(w + 0 * MiB);
  p.ya = (bf16_t*)(w + 65 * MiB);
  p.yb = (bf16_t*)(w + 129 * MiB);
  p.mrg = (bf16_t*)(w + 193 * MiB);
  p.mix = (bf16_t*)(w + 65 * MiB);
  p.hx2 = (bf16_t*)(w + 0 * MiB);
  p.q = (bf16_t*)(w + 129 * MiB);
  p.sv = (float*)(w + 340 * MiB);
  p.si = (int*)(w + 372 * MiB);
  p.pidx = (int*)(w + 257 * MiB);
  p.pgate = (float*)(w + 273 * MiB);
  static int grid_blocks = 0;
  if (!grid_blocks) {
    int dev = 0, cus = 0, per_cu = 0;
    hipGetDevice(&dev);
    hipDeviceGetAttribute(&cus, hipDeviceAttributeMultiprocessorCount, dev);
    hipOccupancyMaxActiveBlocksPerMultiprocessor(&per_cu, mega, 256, 0);
    if (per_cu > 2) per_cu = 2;
    if (per_cu < 1) per_cu = 1;
    grid_blocks = cus * per_cu;
  }
  hipMemsetAsync(p.bar, 0, XCD_BAR_WORDS * 4, stream);
  void* args[] = {&p};
  hipError_t e = hipLaunchCooperativeKernel((void*)mega, dim3(grid_blocks), dim3(256), args, 0, stream);
  if (e != hipSuccess) fprintf(stderr, "cooperative launch failed: %s (grid %d)\n", hipGetErrorString(e), grid_blocks);
}
```

```cpp
#include <hip/hip_runtime.h>
#include <hip/hip_cooperative_groups.h>
#include <stdint.h>
#include <cstdio>
namespace cg = cooperative_groups;

typedef unsigned short bf16_t;
typedef short bf16x8 __attribute__((ext_vector_type(8)));
typedef float f32x4 __attribute__((ext_vector_type(4)));
typedef unsigned u32x4 __attribute__((ext_vector_type(4)));
typedef unsigned u32x2 __attribute__((ext_vector_type(2)));
typedef float f32x2 __attribute__((ext_vector_type(2)));

#define NTOK 32768
#define SEQ 16384
#define CTXL 256
#define NCTX 512
#define MROWS 33280
#define DM 1024
#define SHIFTC 3456
#define INC 6016

typedef __bf16 hwbf2 __attribute__((ext_vector_type(2)));
typedef float hwf2 __attribute__((ext_vector_type(2)));
__device__ __forceinline__ unsigned pack2(float a, float b) { return __builtin_bit_cast(unsigned, __builtin_convertvector((hwf2){a, b}, hwbf2)); }
__device__ __forceinline__ bf16_t f2bf(float f) { return __builtin_bit_cast(unsigned short, (__bf16)f); }
__device__ __forceinline__ float bf2f(bf16_t h) { return __uint_as_float(((unsigned)h) << 16); }
__device__ __forceinline__ float bflo(unsigned u) { return __uint_as_float(u << 16); }
__device__ __forceinline__ float bfhi(unsigned u) { return __uint_as_float(u & 0xffff0000u); }
__device__ __forceinline__ float sigmoidf_(float x) { return 1.0f / (1.0f + __expf(-x)); }

__device__ __forceinline__ void load8(const bf16_t* __restrict__ zA, int row, int col0, float* o) {
  const u32x4 zc = *(const u32x4*)(zA + (size_t)row * SHIFTC + col0);
#pragma unroll
  for (int i = 0; i < 4; ++i) { o[2 * i] = bflo(zc[i]); o[2 * i + 1] = bfhi(zc[i]); }
}
__device__ __forceinline__ float red16(float v) {
  v += __shfl_xor(v, 1); v += __shfl_xor(v, 2); v += __shfl_xor(v, 4); v += __shfl_xor(v, 8);
  return v;
}
__device__ __forceinline__ float red8(float v) {
  v += __shfl_xor(v, 1); v += __shfl_xor(v, 2); v += __shfl_xor(v, 4);
  return v;
}

struct P {
  const float *x, *c, *ctx, *c_ctx, *w_mod, *b_mod, *g_pre_mix, *g_post_mix, *g_pre_ffn, *g_post_ffn, *w_in, *b_gate, *mu_shift,
      *w0, *w2, *a0, *a2, *g2, *k_k, *k_a, *r_k, *ln_x_w, *ln_x_b, *w_a_out, *w_pool, *pool_scale, *w_b_out, *w_o, *peer_wq,
      *peer_keys, *peer_u, *peer_v;
  float* out;
  unsigned* bar;
  bf16_t* hx;
  bf16_t* zA;
  bf16_t* zP;
  bf16_t* zG;
  bf16_t* Wt_in;
  bf16_t* Wt_aout;
  bf16_t* Wt_eff;
  bf16_t* Wt_o;
  bf16_t* Wt_q;
  bf16_t* keys;
  float* mod;
  unsigned char* ub8;
  unsigned char* vb8;
  float* us;
  float* vs;
  bf16_t* sg;
  bf16_t* g2T;
  bf16_t* w2T;
  bf16_t* a2T;
  bf16_t* Mst;
  float* Nst;
  bf16_t* Y0;
  bf16_t* Y1;
  float* bdot;
  bf16_t* out_a;
  bf16_t* ya;
  bf16_t* pooled;
  bf16_t* yb;
  bf16_t* mrg;
  bf16_t* mix;
  bf16_t* hx2;
  bf16_t* q;
  float* sv;
  int* si;
  int* pidx;
  float* pgate;
};

#define GS 72
#define GEMM_SMEM (2 * 128 * GS * 2)
template <class Epi>
__device__ __forceinline__ void gemm_tile(const bf16_t* __restrict__ A, int lda, const bf16_t* __restrict__ Bt, int ldb, int K, int m0, int n0,
                                          const Epi& epi, unsigned char* smem) {
  const int tid = threadIdx.x, lane = tid & 63, wid = tid >> 6, wr = wid >> 1, wc = wid & 1;
  bf16_t* sA = (bf16_t*)smem;
  bf16_t* sB = sA + 128 * GS;
  f32x4 acc[4][4];
#pragma unroll
  for (int i = 0; i < 4; ++i)
#pragma unroll
    for (int j = 0; j < 4; ++j) acc[i][j] = (f32x4){0.f, 0.f, 0.f, 0.f};
  const int lrow = tid >> 3, lcol = (tid & 7) * 8;
  const bf16_t* pa = A + (size_t)(m0 + lrow) * lda + lcol;
  const bf16_t* pb = Bt + (size_t)(n0 + lrow) * ldb + lcol;
  u32x4 ra[4], rb[4];
#pragma unroll
  for (int p = 0; p < 4; ++p) {
    ra[p] = *(const u32x4*)(pa + (size_t)(32 * p) * lda);
    rb[p] = *(const u32x4*)(pb + (size_t)(32 * p) * ldb);
  }
  for (int k0 = 0; k0 < K; k0 += 64) {
#pragma unroll
    for (int p = 0; p < 4; ++p) {
      *(u32x4*)(sA + (lrow + 32 * p) * GS + lcol) = ra[p];
      *(u32x4*)(sB + (lrow + 32 * p) * GS + lcol) = rb[p];
    }
    __syncthreads();
    if (k0 + 64 < K) {
#pragma unroll
      for (int p = 0; p < 4; ++p) {
        ra[p] = *(const u32x4*)(pa + (size_t)(32 * p) * lda + k0 + 64);
        rb[p] = *(const u32x4*)(pb + (size_t)(32 * p) * ldb + k0 + 64);
      }
    }
#pragma unroll
    for (int kk = 0; kk < 2; ++kk) {
      bf16x8 af[4], bfr[4];
#pragma unroll
      for (int i = 0; i < 4; ++i) af[i] = *(const bf16x8*)(sA + (wr * 64 + i * 16 + (lane & 15)) * GS + kk * 32 + (lane >> 4) * 8);
#pragma unroll
      for (int j = 0; j < 4; ++j) bfr[j] = *(const bf16x8*)(sB + (wc * 64 + j * 16 + (lane & 15)) * GS + kk * 32 + (lane >> 4) * 8);
#pragma unroll
      for (int i = 0; i < 4; ++i)
#pragma unroll
        for (int j = 0; j < 4; ++j) acc[i][j] = __builtin_amdgcn_mfma_f32_16x16x32_bf16(bfr[j], af[i], acc[i][j], 0, 0, 0);
    }
    __syncthreads();
  }
#pragma unroll
  for (int i = 0; i < 4; ++i)
#pragma unroll
    for (int j = 0; j < 4; ++j) epi(m0 + wr * 64 + i * 16 + (lane & 15), n0 + wc * 64 + j * 16 + (lane >> 4) * 4, acc[i][j]);
}

#define G3_STAGE 24576
#define G3_ES 136
#define GEMM3_SMEM (256 * G3_ES * 2)
typedef __attribute__((address_space(3))) unsigned lds_u32;
template <class Epi>
__device__ __forceinline__ void gemm_tile3(const bf16_t* __restrict__ A, int lda, const bf16_t* __restrict__ Bt, int ldb, int K, int m0, int n0,
                                           const Epi& epi, unsigned char* smem) {
  int tid = threadIdx.x;
  asm volatile("" : "+v"(tid));
  const int lane = tid & 63, wid = __builtin_amdgcn_readfirstlane(tid >> 6), wr = wid >> 1, wc = wid & 1, l15 = lane & 15, q = lane >> 4;
  f32x4 acc[8][4];
#pragma unroll
  for (int i = 0; i < 8; ++i)
#pragma unroll
    for (int j = 0; j < 4; ++j) acc[i][j] = (f32x4){0.f, 0.f, 0.f, 0.f};
  const int gr = lane >> 2, gc = ((lane & 3) ^ (((gr >> 2) & 1) << 1)) * 8;
  const bf16_t* pa = A + (long)(m0 + wid * 64 + gr) * lda + gc;
  const bf16_t* pb = Bt + (size_t)(n0 + wid * 32 + gr) * ldb + gc;
  unsigned char* dA = smem + wid * 4096 + lane * 16;
  unsigned char* dB = smem + 16384 + wid * 2048 + lane * 16;
  const int sw = (q ^ (((l15 >> 2) & 1) << 1)) * 16;
  const unsigned char* fA = smem + (wr * 128 + l15) * 64 + sw;
  const unsigned char* fB = smem + 16384 + (wc * 64 + l15) * 64 + sw;
#define G3_ISSUE(ST, KT) { _Pragma("unroll") for (int ii = 0; ii < 4; ++ii) __builtin_amdgcn_global_load_lds((const unsigned*)(pa + (size_t)(16 * ii) * lda + (KT) * 32), (lds_u32*)(dA + (ST) * G3_STAGE + ii * 1024), 16, 0, 0); \
                           _Pragma("unroll") for (int ii = 0; ii < 2; ++ii) __builtin_amdgcn_global_load_lds((const unsigned*)(pb + (size_t)(16 * ii) * ldb + (KT) * 32), (lds_u32*)(dB + (ST) * G3_STAGE + ii * 1024), 16, 0, 0); }
  const int nk = K >> 5;
  __syncthreads();
  G3_ISSUE(0, 0);
  for (int kt = 0; kt < nk; ++kt) {
    const int cur = kt & 1;
    asm volatile("s_waitcnt vmcnt(0)" ::: "memory");
    __syncthreads();
    if (kt + 1 < nk) G3_ISSUE(cur ^ 1, kt + 1);
    const unsigned char* cA = fA + cur * G3_STAGE;
    const unsigned char* cB = fB + cur * G3_STAGE;
    bf16x8 bfr[4];
#pragma unroll
    for (int j = 0; j < 4; ++j) bfr[j] = *(const bf16x8*)(cB + j * 1024);
#pragma unroll
    for (int i = 0; i < 8; ++i) {
      const bf16x8 af = *(const bf16x8*)(cA + i * 1024);
#pragma unroll
      for (int j = 0; j < 4; ++j) acc[i][j] = __builtin_amdgcn_mfma_f32_16x16x32_bf16(bfr[j], af, acc[i][j], 0, 0, 0);
    }
  }
#undef G3_ISSUE
  bf16_t* sE = (bf16_t*)smem;
  __syncthreads();
#pragma unroll
  for (int i = 0; i < 8; ++i)
#pragma unroll
    for (int j = 0; j < 4; ++j) {
      u32x2 w; w.x = pack2(acc[i][j][0], acc[i][j][1]); w.y = pack2(acc[i][j][2], acc[i][j][3]);
      *(u32x2*)(sE + (wr * 128 + i * 16 + l15) * G3_ES + wc * 64 + j * 16 + q * 4) = w;
    }
  __syncthreads();
  epi.finish(sE, m0, n0, tid);
}
template <class D> struct Epi3RowChunks {
  __device__ __forceinline__ void finish(const bf16_t* sE, int m0, int n0, int tid) const {
#pragma unroll
    for (int pp = 0; pp < 16; ++pp) {
      const int id = tid + 256 * pp, row = id >> 4, cc = (id & 15) * 8;
      static_cast<const D*>(this)->store(m0 + row, n0 + cc, *(const u32x4*)(sE + row * G3_ES + cc));
    }
  }
};
struct Epi3StoreBf16 : Epi3RowChunks<Epi3StoreBf16> {
  bf16_t* C; int ldc;
  __device__ Epi3StoreBf16(bf16_t* c, int l) : C(c), ldc(l) {}
  __device__ __forceinline__ void store(int m, int n, const u32x4& v) const { *(u32x4*)(C + (size_t)m * ldc + n) = v; }
};
struct Epi3GateA : Epi3RowChunks<Epi3GateA> {
  const bf16_t* zG; const float* bg; bf16_t* mrg;
  __device__ Epi3GateA(const bf16_t* z, const float* b, bf16_t* m) : zG(z), bg(b), mrg(m) {}
  __device__ __forceinline__ void store(int m, int n, const u32x4& v) const {
    const u32x4 g = *(const u32x4*)(zG + (size_t)m * 2048 + n);
    const f32x4 b0 = *(const f32x4*)(bg + n), b1 = *(const f32x4*)(bg + n + 4);
    u32x4 o;
#pragma unroll
    for (int i = 0; i < 4; ++i) {
      const float bl = i < 2 ? b0[2 * i] : b1[2 * i - 4], bh = i < 2 ? b0[2 * i + 1] : b1[2 * i - 3];
      o[i] = pack2(sigmoidf_(bflo(g[i]) + bl) * bflo(v[i]), sigmoidf_(bfhi(g[i]) + bh) * bfhi(v[i]));
    }
    *(u32x4*)(mrg + (size_t)m * DM + n) = o;
  }
};
struct Epi3GateB : Epi3RowChunks<Epi3GateB> {
  const bf16_t* zG; const float* bg; bf16_t* mrg;
  __device__ Epi3GateB(const bf16_t* z, const float* b, bf16_t* m) : zG(z), bg(b), mrg(m) {}
  __device__ __forceinline__ void store(int m, int n, const u32x4& v) const {
    const u32x4 g = *(const u32x4*)(zG + (size_t)m * 2048 + 1024 + n);
    const u32x4 a = *(const u32x4*)(mrg + (size_t)m * DM + n);
    const f32x4 b0 = *(const f32x4*)(bg + 1024 + n), b1 = *(const f32x4*)(bg + 1024 + n + 4);
    u32x4 o;
#pragma unroll
    for (int i = 0; i < 4; ++i) {
      const float bl = i < 2 ? b0[2 * i] : b1[2 * i - 4], bh = i < 2 ? b0[2 * i + 1] : b1[2 * i - 3];
      o[i] = pack2(bflo(a[i]) + sigmoidf_(bflo(g[i]) + bl) * bflo(v[i]), bfhi(a[i]) + sigmoidf_(bfhi(g[i]) + bh) * bfhi(v[i]));
    }
    *(u32x4*)(mrg + (size_t)m * DM + n) = o;
  }
};
struct Epi3ZS {
  bf16_t* zA; const float* mu; int own_lo, own_hi, t0, T;
  __device__ __forceinline__ void finish(const bf16_t* sE, int m0, int n0, int tid) const {
#pragma unroll 4
    for (int pq = 0; pq < 16; ++pq) {
      const int id = tid + 256 * pq, row = id >> 4, cc = (id & 15) * 8, t = t0 + row;
      if (row < own_lo || row > own_hi) continue;
      const u32x4 zc = *(const u32x4*)(sE + row * G3_ES + cc);
      u32x4 zp = (u32x4){0u, 0u, 0u, 0u}, zn = (u32x4){0u, 0u, 0u, 0u};
      if (t > 0) zp = *(const u32x4*)(sE + (row - 1) * G3_ES + cc);
      if (t < T - 1) zn = *(const u32x4*)(sE + (row + 1) * G3_ES + cc);
      const f32x4 m0v = *(const f32x4*)(mu + n0 + cc), m1v = *(const f32x4*)(mu + n0 + cc + 4);
      const float mm[8] = {m0v[0], m0v[1], m0v[2], m0v[3], m1v[0], m1v[1], m1v[2], m1v[3]};
      u32x4 o;
#pragma unroll
      for (int i = 0; i < 4; ++i) {
        const float z0 = bflo(zc[i]), z1 = bfhi(zc[i]);
        o[i] = pack2(z0 + mm[2 * i] * (0.5f * (bflo(zp[i]) + bflo(zn[i])) - z0), z1 + mm[2 * i + 1] * (0.5f * (bfhi(zp[i]) + bfhi(zn[i])) - z1));
      }
      *(u32x4*)(zA + (long)(m0 + row) * SHIFTC + n0 + cc) = o;
    }
  }
};
struct Epi3Z : Epi3RowChunks<Epi3Z> {
  bf16_t *zA, *zP, *zG;
  __device__ Epi3Z(bf16_t* a, bf16_t* b, bf16_t* c) : zA(a), zP(b), zG(c) {}
  __device__ __forceinline__ void store(int m, int n, const u32x4& v) const {
    if (n < SHIFTC) *(u32x4*)(zA + (size_t)m * SHIFTC + n) = v;
    else if (m < NTOK) {
      if (n < SHIFTC + 512) *(u32x4*)(zP + (size_t)m * 512 + (n - SHIFTC)) = v;
      else *(u32x4*)(zG + (size_t)m * 2048 + (n - SHIFTC - 512)) = v;
    }
  }
};

struct EpiLds {
  float* S;
  __device__ __forceinline__ void operator()(int m, int n, const f32x4& v) const {
    float* r = S + (m & 127) * 133 + n + (n >> 5);
    r[0] = v[0]; r[1] = v[1]; r[2] = v[2]; r[3] = v[3];
  }
};

__device__ __forceinline__ void ph_transpose(const float* __restrict__ in, bf16_t* __restrict__ out, int K, int N, int vb, int nvb, unsigned char* smem) {
  float* t = (float*)smem;
  const int tk = K / 64, tn = N / 64, tid = threadIdx.x, tx = tid & 15, ty = tid >> 4;
  for (int it = vb; it < tk * tn; it += nvb) {
    const int k0 = (it / tn) * 64, n0 = (it % tn) * 64;
    __syncthreads();
#pragma unroll
    for (int r = 0; r < 4; ++r) {
      const f32x4 v = *(const f32x4*)(in + (size_t)(k0 + ty + 16 * r) * N + n0 + 4 * tx);
#pragma unroll
      for (int e = 0; e < 4; ++e) t[(ty + 16 * r) * 65 + 4 * tx + e] = v[e];
    }
    __syncthreads();
    const int n = tid >> 2, kq = (tid & 3) * 16;
    u32x4 w0, w1;
#pragma unroll
    for (int e = 0; e < 4; ++e) {
      w0[e] = pack2(t[(kq + 2 * e) * 65 + n], t[(kq + 2 * e + 1) * 65 + n]);
      w1[e] = pack2(t[(kq + 8 + 2 * e) * 65 + n], t[(kq + 8 + 2 * e + 1) * 65 + n]);
    }
    *(u32x4*)(out + (size_t)(n0 + n) * K + k0 + kq) = w0;
    *(u32x4*)(out + (size_t)(n0 + n) * K + k0 + kq + 8) = w1;
  }
}
__device__ __forceinline__ void ph_convert(const float* __restrict__ in, bf16_t* __restrict__ out, size_t n, int vb, int nvb) {
  for (size_t i = ((size_t)vb * 256 + threadIdx.x) * 4; i < n; i += (size_t)nvb * 1024) {
    const float4 v = *(const float4*)(in + i);
    uint2 w; w.x = pack2(v.x, v.y); w.y = pack2(v.z, v.w);
    *(uint2*)(out + i) = w;
  }
}
__device__ __forceinline__ void ph_weff(const P& p, int vb, int nvb) {
  for (int it = vb * 256 + threadIdx.x; it < 512 * 1024; it += nvb * 256) {
    const int n = it & 1023, k = it >> 10, j = k >> 7, kl = k & 127;
    const float* wp = p.w_pool + ((size_t)j * 128 + kl) * 128;
    float s = 0.f;
    for (int c = 0; c < 128; ++c) s += wp[c] * p.pool_scale[j * 128 + c] * p.w_b_out[(size_t)(j * 128 + c) * 1024 + n];
    p.Wt_eff[(size_t)n * 512 + k] = f2bf(s);
  }
}
__device__ __forceinline__ void ph_mod(const P& p, int vb, int nvb, unsigned char* smem) {
  float* red = (float*)smem;
  const int lane = threadIdx.x & 63, wid = threadIdx.x >> 6;
  for (int it = vb; it < 96; it += nvb) {
    const int n = it * 64 + lane;
    float a0 = 0.f, a1 = 0.f, a2 = 0.f;
#pragma unroll 32
    for (int k = wid * 256; k < wid * 256 + 256; ++k) {
      const float w = p.w_mod[(size_t)k * 6144 + n];
      const float c0 = p.c[k], c1 = p.c[1024 + k], c2 = p.c_ctx[k];
      a0 += c0 * sigmoidf_(c0) * w; a1 += c1 * sigmoidf_(c1) * w; a2 += c2 * sigmoidf_(c2) * w;
    }
    __syncthreads();
    red[(wid * 3 + 0) * 64 + lane] = a0; red[(wid * 3 + 1) * 64 + lane] = a1; red[(wid * 3 + 2) * 64 + lane] = a2;
    __syncthreads();
    if (wid < 3) {
      const float sum = red[(0 * 3 + wid) * 64 + lane] + red[(1 * 3 + wid) * 64 + lane] + red[(2 * 3 + wid) * 64 + lane] + red[(3 * 3 + wid) * 64 + lane];
      p.mod[wid * 6144 + n] = sum + p.b_mod[n];
    }
  }
}
__device__ __forceinline__ float wave_sum(float v) {
#pragma unroll
  for (int o = 32; o > 0; o >>= 1) v += __shfl_xor(v, o);
  return v;
}
__device__ __forceinline__ void ph_norm1(const P& p, int vb, int nvb) {
  const int lane = threadIdx.x & 63, wid = threadIdx.x >> 6, nw = nvb * 4;
  for (int m0 = vb * 4 + wid; m0 < MROWS; m0 += 2 * nw) {
    const int m1 = m0 + nw; const bool has1 = m1 < MROWS; const int mb = has1 ? m1 : m0;
    const float* srcA = m0 < NTOK ? p.x + (size_t)m0 * DM : p.ctx + (size_t)(m0 - NTOK) * DM;
    const float* srcB = mb < NTOK ? p.x + (size_t)mb * DM : p.ctx + (size_t)(mb - NTOK) * DM;
    f32x4 va[4], vbq[4]; float sa = 0.f, sb = 0.f;
#pragma unroll
    for (int i = 0; i < 4; ++i) { va[i] = *(const f32x4*)(srcA + i * 256 + lane * 4); vbq[i] = *(const f32x4*)(srcB + i * 256 + lane * 4); }
#pragma unroll
    for (int i = 0; i < 4; ++i)
#pragma unroll
      for (int e = 0; e < 4; ++e) { sa += va[i][e] * va[i][e]; sb += vbq[i][e] * vbq[i][e]; }
    sa = wave_sum(sa); sb = wave_sum(sb);
#pragma unroll
    for (int rr = 0; rr < 2; ++rr) {
      if (rr == 1 && !has1) break;
      const int m = rr == 0 ? m0 : m1;
      const float rstd = rsqrtf((rr == 0 ? sa : sb) * (1.0f / 1024.0f) + 1e-6f);
      const float* md = p.mod + (m < NTOK ? (m / SEQ) : 2) * 6144;
#pragma unroll
      for (int i = 0; i < 4; ++i) {
        const int col = i * 256 + lane * 4;
        const f32x4 v = rr == 0 ? va[i] : vbq[i];
        const f32x4 g = *(const f32x4*)(p.g_pre_mix + col), sh = *(const f32x4*)(md + col), sc = *(const f32x4*)(md + 1024 + col);
        u32x2 w;
        w.x = pack2(v[0] * rstd * g[0] * (1.f + sc[0]) + sh[0], v[1] * rstd * g[1] * (1.f + sc[1]) + sh[1]);
        w.y = pack2(v[2] * rstd * g[2] * (1.f + sc[2]) + sh[2], v[3] * rstd * g[3] * (1.f + sc[3]) + sh[3]);
        *(u32x2*)(p.hx + (size_t)m * DM + col) = w;
      }
    }
  }
}
struct Epi3Readout {
  const P* pp;
  __device__ __forceinline__ void finish(const bf16_t* sE, int m0, int n0, int tid) const {
    const P& p = *pp;
#pragma unroll 2
    for (int pq = 0; pq < 16; ++pq) {
      const int id = tid + 256 * pq, row = id >> 4, cc = (id & 15) * 8, m = m0 + row, n = n0 + cc, t = m % SEQ, h = n >> 6;
      const u32x4 g = *(const u32x4*)(sE + row * G3_ES + cc);
      const u32x4 y0 = *(const u32x4*)(p.Y0 + (size_t)m * DM + n), y1 = *(const u32x4*)(p.Y1 + (size_t)m * DM + n);
      float y[8], v[8];
#pragma unroll
      for (int i = 0; i < 4; ++i) { y[2 * i] = bflo(y0[i]) + bflo(y1[i]); y[2 * i + 1] = bfhi(y0[i]) + bfhi(y1[i]); }
      float sm = 0.f;
#pragma unroll
      for (int i = 0; i < 8; ++i) sm += y[i];
      const float mu = red8(sm) * (1.f / 64.f);
      float qv = 0.f;
#pragma unroll
      for (int i = 0; i < 8; ++i) { y[i] -= mu; qv += y[i] * y[i]; }
      const float rs = rsqrtf(red8(qv) * (1.f / 64.f) + 64e-5f);
      load8(p.zA, m, 2048 + n, v);
      const float bon = 0.5f * (p.bdot[(size_t)m * 16 + h] + p.bdot[((size_t)NTOK + m) * 16 + h]);
      const f32x4 w0 = *(const f32x4*)(p.ln_x_w + n), w1 = *(const f32x4*)(p.ln_x_w + n + 4), b0 = *(const f32x4*)(p.ln_x_b + n), b1 = *(const f32x4*)(p.ln_x_b + n + 4);
      const float lw[8] = {w0[0], w0[1], w0[2], w0[3], w1[0], w1[1], w1[2], w1[3]}, lb[8] = {b0[0], b0[1], b0[2], b0[3], b1[0], b1[1], b1[2], b1[3]};
      u32x4 o;
#pragma unroll
      for (int i = 0; i < 4; ++i)
        o[i] = pack2((y[2 * i] * rs * lw[2 * i] + lb[2 * i] + bon * v[2 * i]) * bflo(g[i]), (y[2 * i + 1] * rs * lw[2 * i + 1] + lb[2 * i + 1] + bon * v[2 * i + 1]) * bfhi(g[i]));
      *(u32x4*)(p.out_a + (size_t)m * DM + n) = o;
    }
  }
};
__device__ __forceinline__ int xcd_tile(int vb, int nvb, int round, int TM, int TN, int& tm, int& tn) {
  if (nvb % 64 != 0) { const int it = round * nvb + vb; if (it >= TM * TN) return 0; tm = it % TM; tn = it / TM; return 1; }
  const int spg = nvb >> 3, g = vb & 7, slot = vb >> 3, SC = spg >> 3;
  const int nsr = (TM + 7) >> 3, nsc = (TN + SC - 1) / SC, st = round * 8 + g;
  if (st >= nsr * nsc) return 0;
  tm = (st % nsr) * 8 + (slot & 7); tn = (st / nsr) * SC + (slot >> 3);
  return (tm < TM && tn < TN) ? 1 : 2;
}
__device__ __forceinline__ void ph_gemm1(const P& p, int vb, int nvb, unsigned char* smem) {
  const int NS_ = 132 * 27, NALL = NS_ + 128 * 20;
  const int per = nvb >> 3;
  for (int round = 0;; ++round) {
    int item;
    if ((nvb & 7) == 0) { const int blk = round * 8 + (vb & 7); if (blk * per >= NALL) break; item = blk * per + (vb >> 3); if (item >= NALL) continue; }
    else { item = round * nvb + vb; if (item >= NALL) break; }
    if (item < NS_) {
      const int cgp = item / (132 * 9), rem = item % (132 * 9), tmS = rem / 9, tn = cgp * 9 + rem % 9;
      Epi3ZS epi;
      epi.zA = p.zA; epi.mu = p.mu_shift;
      int m0;
      if (tmS < 130) { const int b = tmS / 65, i = tmS % 65; m0 = b * SEQ + 254 * i - 1; epi.own_lo = 1; epi.own_hi = min(254, SEQ - 254 * i); epi.t0 = 254 * i - 1; epi.T = SEQ; }
      else { m0 = NTOK + (tmS - 130) * CTXL; epi.own_lo = 0; epi.own_hi = 255; epi.t0 = 0; epi.T = CTXL; }
      gemm_tile3(p.hx, DM, p.Wt_in, DM, DM, m0, tn * 128, epi, smem);
    } else {
      const int i2 = item - NS_;
      int tm, tn;
      if (i2 < 2048) { tm = (i2 & 1023) >> 3; tn = 27 + (i2 >> 10) * 8 + (i2 & 7); } else { tm = (i2 - 2048) >> 2; tn = 43 + (i2 & 3); }
      Epi3Z epi{p.zA, p.zP, p.zG};
      gemm_tile3(p.hx, DM, p.Wt_in, DM, DM, tm * 256, tn * 128, epi, smem);
    }
  }
}
__device__ __forceinline__ void ph_readout_gemm(const P& p, int vb, int nvb, unsigned char* smem) {
  Epi3Readout epi{&p};
  for (int round = 0;; ++round) {
    int tm, tn; const int r = xcd_tile(vb, nvb, round, NTOK / 256, DM / 128, tm, tn);
    if (r == 0) break;
    if (r == 1) gemm_tile3(p.sg, 128, p.g2T, 128, 128, tm * 256, tn * 128, epi, smem);
  }
}
__device__ __forceinline__ void ph_sg(const P& p, int vb, int nvb) {
  for (int it = vb * 256 + threadIdx.x; it < NTOK * 16; it += nvb * 256) {
    const int m = it >> 4, l8 = (it & 15) * 8, t = m % SEQ;
    float o[8];
    load8(p.zA, m, 3328 + l8, o);
    u32x4 w;
#pragma unroll
    for (int i = 0; i < 4; ++i) w[i] = pack2(sigmoidf_(o[2 * i]), sigmoidf_(o[2 * i + 1]));
    *(u32x4*)(p.sg + (size_t)m * 128 + l8) = w;
  }
}
__device__ __forceinline__ void ph_gemm_merge(const P& p, int vb, int nvb, unsigned char* smem) {
  Epi3GateA ea{p.zG, p.b_gate, p.mrg};
  Epi3GateB eb{p.zG, p.b_gate, p.mrg};
  for (int round = 0;; ++round) {
    int tm, tn; const int r = xcd_tile(vb, nvb, round, NTOK / 256, DM / 128, tm, tn);
    if (r == 0) break;
    if (r == 1) {
      gemm_tile3(p.out_a, DM, p.Wt_aout, DM, DM, tm * 256, tn * 128, ea, smem);
      gemm_tile3(p.pooled, 512, p.Wt_eff, 512, 512, tm * 256, tn * 128, eb, smem);
    }
  }
}
__device__ __forceinline__ void ph_gemm_simple(const bf16_t* A, int lda, const bf16_t* Bt, int ldb, int K, int M, int N, bf16_t* C, int ldc, int vb, int nvb, unsigned char* smem) {
  Epi3StoreBf16 epi{C, ldc};
  for (int round = 0;; ++round) {
    int tm, tn; const int r = xcd_tile(vb, nvb, round, M / 256, N / 128, tm, tn);
    if (r == 0) break;
    if (r == 1) gemm_tile3(A, lda, Bt, ldb, K, tm * 256, tn * 128, epi, smem);
  }
}


#define O_R1 0
#define O_R2 10240
#define O_TA (O_R2 + 17408)
#define O_TR (O_TA + 4608)
#define O_TB (O_TR + 4608)
#define O_TK (O_TB + 4608)
#define O_TBT (O_TK + 4608)
#define O_TKT (O_TBT + 5120)
#define O_TVT (O_TKT + 5120)
#define O_GAM (O_TVT + 5120)
#define O_TST (O_GAM + 256)
#define RWKV_SMEM (O_TST + 2 * 9216)
#define NSUP 65
__device__ __forceinline__ void lds_wave_fence() { asm volatile("s_waitcnt lgkmcnt(0)" ::: "memory"); }
__device__ __forceinline__ u32x2 pack4(const f32x4& v) { u32x2 r; r.x = pack2(v[0], v[1]); r.y = pack2(v[2], v[3]); return r; }


typedef short s16x4 __attribute__((ext_vector_type(4)));
__device__ __forceinline__ float fast_tanh(float x) { const float e = __expf(2.0f * x); return 1.0f - __fdividef(2.0f, e + 1.0f); }
template <int NS, bool WANTY>
__device__ __forceinline__ void rwkv_chunk(const P& p, unsigned char* smem, int d, int h, int rowbase, int T, int isc0, bool has_next, f32x4 (&st)[NS][4], u32x4 (&pf)[5]) {
  int tid = threadIdx.x;
  asm volatile("" : "+v"(tid));
  const int lane = tid & 63, w = __builtin_amdgcn_readfirstlane(tid >> 6), l15 = lane & 15, q = lane >> 4;
  const int tt = tid >> 3, cg = tid & 7, ch0 = h * 64 + cg * 8;
  const int isc = isc0 + tt, t = d == 0 ? isc : T - 1 - isc;
  bf16_t* TWD = (bf16_t*)(smem + O_R1); bf16_t* TAD = TWD + 32 * 72;
  float* WT = (float*)(smem + O_R1);
  bf16_t* XT = (bf16_t*)(smem + O_R1); bf16_t* UT = XT + 64 * 40;
  float* LW = (float*)(smem + O_R2); float* LA = LW + 32 * 68;
  float* TL = (float*)(smem + O_R2);
  bf16_t* TT = (bf16_t*)(smem + O_R2 + 4608); bf16_t* TAK = TT + 32 * 40; bf16_t* TRB = TAK + 32 * 40; bf16_t* TRK = TRB + 32 * 40; bf16_t* TLB = TRK + 32 * 40;
  bf16_t* TA = (bf16_t*)(smem + O_TA); bf16_t* TR = (bf16_t*)(smem + O_TR); bf16_t* TB = (bf16_t*)(smem + O_TB); bf16_t* TK = (bf16_t*)(smem + O_TK);
  bf16_t* TBT = (bf16_t*)(smem + O_TBT); bf16_t* TKT = (bf16_t*)(smem + O_TKT); bf16_t* TVT = (bf16_t*)(smem + O_TVT);
  float* GAM = (float*)(smem + O_GAM);
  bf16_t* TST = (bf16_t*)(smem + O_TST);
  __syncthreads();
  float k8[8], r8[8];
  {
    u32x4 pk;
#pragma unroll
    for (int i = 0; i < 4; ++i) pk[i] = pack2(fast_tanh(bflo(pf[0][i])), fast_tanh(bfhi(pf[0][i])));
    *(u32x4*)(TWD + tt * 72 + cg * 8) = pk;
    *(u32x4*)(TAD + tt * 72 + cg * 8) = pf[1];
  }
#pragma unroll
  for (int i = 0; i < 4; ++i) { k8[2 * i] = bflo(pf[2][i]); k8[2 * i + 1] = bfhi(pf[2][i]); if (WANTY) { r8[2 * i] = bflo(pf[3][i]); r8[2 * i + 1] = bfhi(pf[3][i]); } }
  const u32x4 vzc = pf[4];
  __syncthreads();
  {
    f32x4 lw[2], la[2];
    bf16x8 w2f[2], a2f[2];
#pragma unroll
    for (int ks = 0; ks < 2; ++ks) {
      w2f[ks] = *(const bf16x8*)(p.w2T + ((size_t)d * 1024 + h * 64 + 16 * w + l15) * 64 + 32 * ks + 8 * q);
      a2f[ks] = *(const bf16x8*)(p.a2T + ((size_t)d * 1024 + h * 64 + 16 * w + l15) * 64 + 32 * ks + 8 * q);
    }
#pragma unroll
    for (int it = 0; it < 2; ++it) { lw[it] = (f32x4){0.f, 0.f, 0.f, 0.f}; la[it] = (f32x4){0.f, 0.f, 0.f, 0.f}; }
#pragma unroll
    for (int ks = 0; ks < 2; ++ks)
#pragma unroll
      for (int it = 0; it < 2; ++it) {
        const bf16x8 aw = *(const bf16x8*)(TWD + (16 * it + l15) * 72 + 32 * ks + 8 * q);
        const bf16x8 aa = *(const bf16x8*)(TAD + (16 * it + l15) * 72 + 32 * ks + 8 * q);
        lw[it] = __builtin_amdgcn_mfma_f32_16x16x32_bf16(aw, w2f[ks], lw[it], 0, 0, 0);
        la[it] = __builtin_amdgcn_mfma_f32_16x16x32_bf16(aa, a2f[ks], la[it], 0, 0, 0);
      }
    {
      const float cw0 = p.w0[d * 1024 + h * 64 + 16 * w + l15];
      float tot0 = 0.f;
#pragma unroll
      for (int it = 0; it < 2; ++it) {
        float pr[4];
#pragma unroll
        for (int rg = 0; rg < 4; ++rg) {
          const float xw = -(cw0 + lw[it][rg]);
          const float sp = fmaxf(xw, 0.f) + __logf(1.0f + __expf(-fabsf(xw)));
          const float e = __expf(-sp - 0.5f);
          pr[rg] = rg == 0 ? e : pr[rg - 1] + e;
        }
        float x = pr[3];
        float y = __shfl_up(x, 16); if (q >= 1) x += y;
        y = __shfl_up(x, 32); if (q >= 2) x += y;
        const float base = (x - pr[3]) + (it == 1 ? tot0 : 0.f);
        if (it == 0) tot0 = __shfl(x, 48 + l15);
#pragma unroll
        for (int rg = 0; rg < 4; ++rg) lw[it][rg] = pr[rg] + base;
      }
      if (q == 3) GAM[16 * w + l15] = __expf(-lw[1][3]);
    }
#pragma unroll
    for (int it = 0; it < 2; ++it)
#pragma unroll
      for (int rg = 0; rg < 4; ++rg) { LW[(16 * it + 4 * q + rg) * 68 + 16 * w + l15] = lw[it][rg]; LA[(16 * it + 4 * q + rg) * 68 + 16 * w + l15] = la[it][rg]; }
  }
  __syncthreads();
  float icl[8], kkn[8], kd[8];
  {
    float ss = 0.f, bd = 0.f;
    float ca0[8], ckk[8], cka[8], crk[8];
#pragma unroll
    for (int e4 = 0; e4 < 8; e4 += 4) {
      const f32x4 b2 = *(const f32x4*)(p.a0 + d * 1024 + ch0 + e4), c2 = *(const f32x4*)(p.k_k + ch0 + e4);
      const f32x4 d2 = *(const f32x4*)(p.k_a + ch0 + e4), f2 = *(const f32x4*)(p.r_k + ch0 + e4);
#pragma unroll
      for (int e = 0; e < 4; ++e) { ca0[e4 + e] = b2[e]; ckk[e4 + e] = c2[e]; cka[e4 + e] = d2[e]; crk[e4 + e] = f2[e]; }
    }
#pragma unroll
    for (int e = 0; e < 8; ++e) {
      icl[e] = sigmoidf_(ca0[e] + LA[tt * 68 + cg * 8 + e]);
      kkn[e] = k8[e] * ckk[e]; ss += kkn[e] * kkn[e];
      kd[e] = k8[e] * (1.f + (icl[e] - 1.f) * cka[e]);
      if (WANTY) bd += r8[e] * kd[e] * crk[e];
    }
    ss = red8(ss); if (WANTY) bd = red8(bd);
    const float rn = rsqrtf(fmaxf(ss, 1e-24f));
#pragma unroll
    for (int e = 0; e < 8; ++e) kkn[e] *= rn;
    if (WANTY && cg == 0) p.bdot[((size_t)d * NTOK + rowbase + t) * 16 + h] = bd;
  }
  {
    float ta[8], tr[8], tb[8], tk[8], v8[8];
#pragma unroll
    for (int i = 0; i < 4; ++i) { v8[2 * i] = bflo(vzc[i]); v8[2 * i + 1] = bfhi(vzc[i]); }
#pragma unroll
    for (int e = 0; e < 8; ++e) {
      const float Li = LW[tt * 68 + cg * 8 + e];
      const float Lp = tt > 0 ? LW[(tt - 1) * 68 + cg * 8 + e] : 0.f;
      const float gi = __expf(-Li), gim1 = __expf(-Lp), ginv = __expf(Li);
      ta[e] = -kkn[e] * gim1; if (WANTY) tr[e] = r8[e] * gi; tb[e] = kkn[e] * icl[e] * ginv; tk[e] = kd[e] * ginv;
    }
    u32x4 pk;
    pk.x = pack2(ta[0], ta[1]); pk.y = pack2(ta[2], ta[3]); pk.z = pack2(ta[4], ta[5]); pk.w = pack2(ta[6], ta[7]); *(u32x4*)(TA + tt * 72 + cg * 8) = pk;
    if (WANTY) { pk.x = pack2(tr[0], tr[1]); pk.y = pack2(tr[2], tr[3]); pk.z = pack2(tr[4], tr[5]); pk.w = pack2(tr[6], tr[7]); *(u32x4*)(TR + tt * 72 + cg * 8) = pk; }
    pk.x = pack2(tb[0], tb[1]); pk.y = pack2(tb[2], tb[3]); pk.z = pack2(tb[4], tb[5]); pk.w = pack2(tb[6], tb[7]); *(u32x4*)(TB + tt * 72 + cg * 8) = pk;
    pk.x = pack2(tk[0], tk[1]); pk.y = pack2(tk[2], tk[3]); pk.z = pack2(tk[4], tk[5]); pk.w = pack2(tk[6], tk[7]); *(u32x4*)(TK + tt * 72 + cg * 8) = pk;
#pragma unroll
    for (int e = 0; e < 8; ++e) { TBT[(cg * 8 + e) * 40 + tt] = f2bf(tb[e]); TKT[(cg * 8 + e) * 40 + tt] = f2bf(tk[e]); TVT[(cg * 8 + e) * 40 + tt] = f2bf(v8[e]); }
  }
  __syncthreads();
  if (WANTY || w < 2) {
    const bf16_t* X = (w < 2) ? TA : TR; const bf16_t* Y = (w & 1) ? TK : TB;
    f32x4 g[2][2];
#pragma unroll
    for (int it = 0; it < 2; ++it)
#pragma unroll
      for (int s2 = 0; s2 < 2; ++s2) g[it][s2] = (f32x4){0.f, 0.f, 0.f, 0.f};
#pragma unroll
    for (int ks = 0; ks < 2; ++ks) {
      bf16x8 xa[2], yb[2];
#pragma unroll
      for (int it = 0; it < 2; ++it) { xa[it] = *(const bf16x8*)(X + (16 * it + l15) * 72 + 32 * ks + 8 * q); yb[it] = *(const bf16x8*)(Y + (16 * it + l15) * 72 + 32 * ks + 8 * q); }
#pragma unroll
      for (int it = 0; it < 2; ++it)
#pragma unroll
        for (int s2 = 0; s2 < 2; ++s2) g[it][s2] = __builtin_amdgcn_mfma_f32_16x16x32_bf16(xa[it], yb[s2], g[it][s2], 0, 0, 0);
    }
    bf16_t* dst = w == 1 ? TAK : (w == 2 ? TRB : TRK);
#pragma unroll
    for (int it = 0; it < 2; ++it)
#pragma unroll
      for (int s2 = 0; s2 < 2; ++s2)
#pragma unroll
        for (int rg = 0; rg < 4; ++rg) {
          const int i = 16 * it + 4 * q + rg, s = 16 * s2 + l15;
          const float val = g[it][s2][rg];
          if (w == 0) {
            TL[i * 36 + s] = (s < i) ? val : 0.f;
            if (it == 1 && s2 == 0) TLB[(i - 16) * 40 + s] = f2bf(val);
          } else dst[i * 40 + s] = f2bf(((w == 1) ? (s < i) : (s <= i)) ? val : 0.f);
        }
  }
  if (w == 0) {
    lds_wave_fence();
    const int c = lane & 15, hb = lane & 16;
    float Tr[16];
#pragma unroll
    for (int i = 0; i < 16; ++i) {
      float acc = (i == c) ? 1.f : 0.f;
#pragma unroll
      for (int j4 = 0; j4 < (i + 3) / 4; ++j4) {
        const f32x4 l4 = *(const f32x4*)(TL + (hb + i) * 36 + hb + 4 * j4);
#pragma unroll
        for (int jj = 0; jj < 4; ++jj) if (4 * j4 + jj < i) acc += l4[jj] * Tr[4 * j4 + jj];
      }
      Tr[i] = acc;
    }
    if (lane < 32) {
#pragma unroll
      for (int i = 0; i < 16; ++i) TT[(hb + i) * 40 + hb + c] = f2bf(Tr[i]);
    }
  }
  __syncthreads();
  if (has_next) {
    const int isn = isc + 32, tn = d == 0 ? isn : T - 1 - isn;
    const bf16_t* zr = p.zA + (size_t)(rowbase + tn) * SHIFTC;
    pf[0] = *(const u32x4*)(zr + 3072 + d * 64 + cg * 8);
    pf[1] = *(const u32x4*)(zr + 3200 + d * 64 + cg * 8);
    pf[2] = *(const u32x4*)(zr + 1024 + ch0);
    if (WANTY) pf[3] = *(const u32x4*)(zr + ch0);
    pf[4] = *(const u32x4*)(zr + 2048 + ch0);
  }
  const bf16x8 vfr = *(const bf16x8*)(TVT + (16 * w + l15) * 40 + 8 * q);
  const s16x4 t1f = *(const s16x4*)(TT + l15 * 40 + 4 * q), t2f = *(const s16x4*)(TT + (16 + l15) * 40 + 16 + 4 * q), l21f = *(const s16x4*)(TLB + l15 * 40 + 4 * q);
  bf16_t* XTw = XT + (16 * w + l15) * 40; bf16_t* UTw = UT + (16 * w + l15) * 40;
#pragma unroll
  for (int si = 0; si < NS; ++si) {
    const bool useV = (NS == 1) || (si == 1);
    const bf16_t* STs = TST + (si * 64 + 16 * w + l15) * 72;
    bf16x8 sf[2];
    sf[0] = *(const bf16x8*)(STs + 8 * q); sf[1] = *(const bf16x8*)(STs + 32 + 8 * q);
    f32x4 xa[2];
#pragma unroll
    for (int it = 0; it < 2; ++it) {
      xa[it] = (f32x4){0.f, 0.f, 0.f, 0.f};
#pragma unroll
      for (int ks = 0; ks < 2; ++ks) xa[it] = __builtin_amdgcn_mfma_f32_16x16x32_bf16(*(const bf16x8*)(TA + (16 * it + l15) * 72 + 32 * ks + 8 * q), sf[ks], xa[it], 0, 0, 0);
      if (useV) xa[it] = __builtin_amdgcn_mfma_f32_16x16x32_bf16(*(const bf16x8*)(TAK + (16 * it + l15) * 40 + 8 * q), vfr, xa[it], 0, 0, 0);
    }
    *(u32x2*)(XTw + 4 * q) = pack4(xa[0]);
    lds_wave_fence();
    f32x4 ua = __builtin_amdgcn_mfma_f32_16x16x16bf16_1k(t1f, *(const s16x4*)(XTw + 4 * q), (f32x4){0.f, 0.f, 0.f, 0.f}, 0, 0, 0);
    *(u32x2*)(UTw + 4 * q) = pack4(ua);
    lds_wave_fence();
    xa[1] = __builtin_amdgcn_mfma_f32_16x16x16bf16_1k(l21f, *(const s16x4*)(UTw + 4 * q), xa[1], 0, 0, 0);
    *(u32x2*)(XTw + 16 + 4 * q) = pack4(xa[1]);
    lds_wave_fence();
    ua = __builtin_amdgcn_mfma_f32_16x16x16bf16_1k(t2f, *(const s16x4*)(XTw + 16 + 4 * q), (f32x4){0.f, 0.f, 0.f, 0.f}, 0, 0, 0);
    *(u32x2*)(UTw + 16 + 4 * q) = pack4(ua);
    lds_wave_fence();
    const bf16x8 uf = *(const bf16x8*)(UTw + 8 * q);
    if (WANTY) {
#pragma unroll
      for (int it = 0; it < 2; ++it) {
        f32x4 ya = (f32x4){0.f, 0.f, 0.f, 0.f};
#pragma unroll
        for (int ks = 0; ks < 2; ++ks) ya = __builtin_amdgcn_mfma_f32_16x16x32_bf16(*(const bf16x8*)(TR + (16 * it + l15) * 72 + 32 * ks + 8 * q), sf[ks], ya, 0, 0, 0);
        ya = __builtin_amdgcn_mfma_f32_16x16x32_bf16(*(const bf16x8*)(TRB + (16 * it + l15) * 40 + 8 * q), uf, ya, 0, 0, 0);
        ya = __builtin_amdgcn_mfma_f32_16x16x32_bf16(*(const bf16x8*)(TRK + (16 * it + l15) * 40 + 8 * q), vfr, ya, 0, 0, 0);
        bf16_t* Yd = d == 0 ? p.Y0 : p.Y1;
#pragma unroll
        for (int rg = 0; rg < 4; ++rg) {
          const int iq = isc0 + 16 * it + 4 * q + rg, tq = d == 0 ? iq : T - 1 - iq;
          Yd[(size_t)(rowbase + tq) * DM + h * 64 + 16 * w + l15] = f2bf(ya[rg]);
        }
      }
    }
#pragma unroll
    for (int kt = 0; kt < 4; ++kt) {
      f32x4 hv = st[si][kt];
      hv = __builtin_amdgcn_mfma_f32_16x16x32_bf16(*(const bf16x8*)(TBT + (16 * kt + l15) * 40 + 8 * q), uf, hv, 0, 0, 0);
      if (useV) hv = __builtin_amdgcn_mfma_f32_16x16x32_bf16(*(const bf16x8*)(TKT + (16 * kt + l15) * 40 + 8 * q), vfr, hv, 0, 0, 0);
      hv *= *(const f32x4*)(GAM + 16 * kt + 4 * q);
      st[si][kt] = hv;
      *(u32x2*)(TST + (si * 64 + 16 * w + l15) * 72 + 16 * kt + 4 * q) = pack4(hv);
    }
  }
}

template <bool WANTY>
__device__ __forceinline__ void rwkv_prefetch_first(const P& p, int d, int h, int rowbase, int T, int isc0, u32x4 (&pf)[5]) {
  const int tid = threadIdx.x, tt = tid >> 3, cg = tid & 7, ch0 = h * 64 + cg * 8, isc = isc0 + tt, t = d == 0 ? isc : T - 1 - isc;
  const bf16_t* zr = p.zA + (size_t)(rowbase + t) * SHIFTC;
  pf[0] = *(const u32x4*)(zr + 3072 + d * 64 + cg * 8);
  pf[1] = *(const u32x4*)(zr + 3200 + d * 64 + cg * 8);
  pf[2] = *(const u32x4*)(zr + 1024 + ch0);
  pf[3] = WANTY ? *(const u32x4*)(zr + ch0) : (u32x4){0u, 0u, 0u, 0u};
  pf[4] = *(const u32x4*)(zr + 2048 + ch0);
}
__device__ __forceinline__ void ph_rwkv_A(const P& p, int vb, int nvb, unsigned char* smem) {
  const int tid = threadIdx.x, lane = tid & 63, w = tid >> 6, l15 = lane & 15, q = lane >> 4;
  bf16_t* TST = (bf16_t*)(smem + O_TST);
  for (int item = vb; item < 64 * 64; item += nvb) {
    const int chain = item >> 6, j = item & 63, b = chain >> 5, d = (chain >> 4) & 1, h = chain & 15;
    const bool latent = j > 0;
    const int T = latent ? SEQ : CTXL, rowbase = latent ? b * SEQ : NTOK + b * CTXL, base = latent ? (j - 1) * 256 : 0;
    f32x4 st[2][4];
    __syncthreads();
#pragma unroll
    for (int kt = 0; kt < 4; ++kt) {
#pragma unroll
      for (int rg = 0; rg < 4; ++rg) st[0][kt][rg] = (16 * kt + 4 * q + rg == 16 * w + l15) ? 1.f : 0.f;
      st[1][kt] = (f32x4){0.f, 0.f, 0.f, 0.f};
      *(u32x2*)(TST + (16 * w + l15) * 72 + 16 * kt + 4 * q) = pack4(st[0][kt]);
      *(u32x2*)(TST + (64 + 16 * w + l15) * 72 + 16 * kt + 4 * q) = pack4(st[1][kt]);
    }
    u32x4 pf[5]; rwkv_prefetch_first<false>(p, d, h, rowbase, T, base, pf);
    for (int c = 0; c < 8; ++c) rwkv_chunk<2, false>(p, smem, d, h, rowbase, T, base + 32 * c, c < 7, st, pf);
    const size_t slot = (size_t)chain * NSUP + j;
#pragma unroll
    for (int kt = 0; kt < 4; ++kt) {
#pragma unroll
      for (int rg = 0; rg < 4; ++rg) p.Mst[(slot * 64 + 16 * kt + 4 * q + rg) * 64 + 16 * w + l15] = f2bf(st[0][kt][rg]);
      *(f32x4*)(p.Nst + (slot * 64 + 16 * w + l15) * 64 + 16 * kt + 4 * q) = st[1][kt];
    }
  }
}
__device__ __forceinline__ void ph_rwkv_B(const P& p, int vb, int nvb, unsigned char* smem) {
  const int tid = threadIdx.x, lane = tid & 63, w = tid >> 6, l15 = lane & 15, q = lane >> 4;
  bf16_t* HT = (bf16_t*)smem;
  for (int chain = vb; chain < 64; chain += nvb) {
    f32x4 hs[4];
#pragma unroll
    for (int kt = 0; kt < 4; ++kt) hs[kt] = (f32x4){0.f, 0.f, 0.f, 0.f};
    __syncthreads();
    for (int j = 0; j < 64; ++j) {
      const size_t slot = (size_t)chain * NSUP + j;
      f32x4 nv[4];
#pragma unroll
      for (int kt = 0; kt < 4; ++kt) nv[kt] = *(const f32x4*)(p.Nst + (slot * 64 + 16 * w + l15) * 64 + 16 * kt + 4 * q);
      bf16x8 mf[4][2];
#pragma unroll
      for (int kt = 0; kt < 4; ++kt)
#pragma unroll
        for (int ks = 0; ks < 2; ++ks) mf[kt][ks] = *(const bf16x8*)(p.Mst + (slot * 64 + 16 * kt + l15) * 64 + 32 * ks + 8 * q);
#pragma unroll
      for (int kt = 0; kt < 4; ++kt) {
        *(f32x4*)(p.Nst + (slot * 64 + 16 * w + l15) * 64 + 16 * kt + 4 * q) = hs[kt];
        *(u32x2*)(HT + (16 * w + l15) * 72 + 16 * kt + 4 * q) = pack4(hs[kt]);
      }
      lds_wave_fence();
      bf16x8 hf[2];
      hf[0] = *(const bf16x8*)(HT + (16 * w + l15) * 72 + 8 * q); hf[1] = *(const bf16x8*)(HT + (16 * w + l15) * 72 + 32 + 8 * q);
      lds_wave_fence();
#pragma unroll
      for (int kt = 0; kt < 4; ++kt) {
        f32x4 a = nv[kt];
#pragma unroll
        for (int ks = 0; ks < 2; ++ks) a = __builtin_amdgcn_mfma_f32_16x16x32_bf16(mf[kt][ks], hf[ks], a, 0, 0, 0);
        hs[kt] = a;
      }
    }
    const size_t slot = (size_t)chain * NSUP + 64;
#pragma unroll
    for (int kt = 0; kt < 4; ++kt) *(f32x4*)(p.Nst + (slot * 64 + 16 * w + l15) * 64 + 16 * kt + 4 * q) = hs[kt];
  }
}
__device__ __forceinline__ void ph_rwkv_C(const P& p, int vb, int nvb, unsigned char* smem) {
  const int tid = threadIdx.x, lane = tid & 63, w = tid >> 6, l15 = lane & 15, q = lane >> 4;
  bf16_t* TST = (bf16_t*)(smem + O_TST);
  for (int item = vb; item < 64 * 64; item += nvb) {
    const int chain = item >> 6, j = (item & 63) + 1, b = chain >> 5, d = (chain >> 4) & 1, h = chain & 15;
    f32x4 st[1][4];
    const size_t slot = (size_t)chain * NSUP + j;
    __syncthreads();
#pragma unroll
    for (int kt = 0; kt < 4; ++kt) {
      st[0][kt] = *(const f32x4*)(p.Nst + (slot * 64 + 16 * w + l15) * 64 + 16 * kt + 4 * q);
      *(u32x2*)(TST + (16 * w + l15) * 72 + 16 * kt + 4 * q) = pack4(st[0][kt]);
    }
    u32x4 pf[5]; rwkv_prefetch_first<true>(p, d, h, b * SEQ, SEQ, (j - 1) * 256, pf);
    for (int c = 0; c < 8; ++c) rwkv_chunk<1, true>(p, smem, d, h, b * SEQ, SEQ, (j - 1) * 256 + 32 * c, c < 7, st, pf);
  }
}

#define POOL_SMEM (64 * 128 * 4)
__device__ __forceinline__ void ph_pool(const P& p, int vb, int nvb, unsigned char* smem) {
  float* V = (float*)smem;
  const int tid = threadIdx.x, cp = tid & 63, cq = tid >> 6;
  for (int item = vb; item < 2 * 4 * 64; item += nvb) {
    const int j = item & 3, st = (item >> 2) & 63, b = item >> 8;
    const int win = 2 << j, half = win >> 1;
    const bf16_t* zb = p.zP + (size_t)b * SEQ * 512 + j * 128 + cp * 2;
    float a0[16], a1[16];
#pragma unroll
    for (int i = 0; i < 16; ++i) { a0[i] = 0.f; a1[i] = 0.f; }
    {
      const int r = 4 * st, r0 = max(r - half, 0), r1 = min(r + half, 256);
      for (int rr = r0; rr < r1; ++rr) {
#pragma unroll
        for (int i = 0; i < 16; ++i) { const unsigned u = *(const unsigned*)(zb + (size_t)(rr * 64 + cq * 16 + i) * 512); a0[i] += bflo(u); a1[i] += bfhi(u); }
      }
    }
    for (int dr = 0; dr < 4; ++dr) {
      const int r = 4 * st + dr, r0 = max(r - half, 0), r1 = min(r + half, 256);
      if (dr > 0) {
        const int radd = r + half - 1, rsub = r - half - 1;
        if (radd < 256) {
#pragma unroll
          for (int i = 0; i < 16; ++i) { const unsigned u = *(const unsigned*)(zb + (size_t)(radd * 64 + cq * 16 + i) * 512); a0[i] += bflo(u); a1[i] += bfhi(u); }
        }
        if (rsub >= 0) {
#pragma unroll
          for (int i = 0; i < 16; ++i) { const unsigned u = *(const unsigned*)(zb + (size_t)(rsub * 64 + cq * 16 + i) * 512); a0[i] -= bflo(u); a1[i] -= bfhi(u); }
        }
      }
      __syncthreads();
#pragma unroll
      for (int i = 0; i < 16; ++i) *(f32x2*)(V + (cq * 16 + i) * 128 + cp * 2) = (f32x2){a0[i], a1[i]};
      __syncthreads();
      float s0 = 0.f, s1 = 0.f;
      {
        const int c = cq * 16, c0 = max(c - half, 0), c1 = min(c + half, 64);
        for (int cc = c0; cc < c1; ++cc) { const f32x2 v = *(const f32x2*)(V + cc * 128 + cp * 2); s0 += v.x; s1 += v.y; }
      }
#pragma unroll
      for (int i = 0; i < 16; ++i) {
        const int c = cq * 16 + i, c0 = max(c - half, 0), c1 = min(c + half, 64);
        if (i > 0) {
          const int cadd = c + half - 1, csub = c - half - 1;
          if (cadd < 64) { const f32x2 v = *(const f32x2*)(V + cadd * 128 + cp * 2); s0 += v.x; s1 += v.y; }
          if (csub >= 0) { const f32x2 v = *(const f32x2*)(V + csub * 128 + cp * 2); s0 -= v.x; s1 -= v.y; }
        }
        const float inv = 1.0f / (float)((r1 - r0) * (c1 - c0));
        const size_t tokoff = ((size_t)b * SEQ + r * 64 + c) * 512 + j * 128 + cp * 2;
        const unsigned u = *(const unsigned*)(p.zP + tokoff);
        *(unsigned*)(p.pooled + tokoff) = pack2(s0 * inv - bflo(u), s1 * inv - bfhi(u));
      }
    }
  }
}
__device__ __forceinline__ void ph_res1(const P& p, int vb, int nvb) {
  const int lane = threadIdx.x & 63, wid = threadIdx.x >> 6;
  for (int m = vb * 4 + wid; m < NTOK; m += nvb * 4) {
    const float* md = p.mod + (m / SEQ) * 6144;
    float mx[16]; float ss = 0.f;
#pragma unroll
    for (int i = 0; i < 4; ++i) {
      const uint2 u = *(const uint2*)(p.mix + (size_t)m * DM + i * 256 + lane * 4);
      mx[4 * i] = bflo(u.x); mx[4 * i + 1] = bfhi(u.x); mx[4 * i + 2] = bflo(u.y); mx[4 * i + 3] = bfhi(u.y);
#pragma unroll
      for (int e = 0; e < 4; ++e) ss += mx[4 * i + e] * mx[4 * i + e];
    }
    ss = wave_sum(ss);
    const float rstd = rsqrtf(ss * (1.0f / 1024.0f) + 1e-6f);
    float x1[16]; float s2 = 0.f;
#pragma unroll
    for (int i = 0; i < 4; ++i) {
      const int col = i * 256 + lane * 4;
      const float4 xv = *(const float4*)(p.x + (size_t)m * DM + col), g = *(const float4*)(p.g_post_mix + col), gt = *(const float4*)(md + 2048 + col);
      x1[4 * i] = xv.x + gt.x * mx[4 * i] * rstd * g.x; x1[4 * i + 1] = xv.y + gt.y * mx[4 * i + 1] * rstd * g.y;
      x1[4 * i + 2] = xv.z + gt.z * mx[4 * i + 2] * rstd * g.z; x1[4 * i + 3] = xv.w + gt.w * mx[4 * i + 3] * rstd * g.w;
      *(float4*)(p.out + (size_t)m * DM + col) = make_float4(x1[4 * i], x1[4 * i + 1], x1[4 * i + 2], x1[4 * i + 3]);
#pragma unroll
      for (int e = 0; e < 4; ++e) s2 += x1[4 * i + e] * x1[4 * i + e];
    }
    s2 = wave_sum(s2);
    const float r2 = rsqrtf(s2 * (1.0f / 1024.0f) + 1e-6f);
#pragma unroll
    for (int i = 0; i < 4; ++i) {
      const int col = i * 256 + lane * 4;
      const float4 g = *(const float4*)(p.g_pre_ffn + col), sh = *(const float4*)(md + 3072 + col), sc = *(const float4*)(md + 4096 + col);
      uint2 w;
      w.x = pack2(x1[4 * i] * r2 * g.x * (1.f + sc.x) + sh.x, x1[4 * i + 1] * r2 * g.y * (1.f + sc.y) + sh.y);
      w.y = pack2(x1[4 * i + 2] * r2 * g.z * (1.f + sc.z) + sh.z, x1[4 * i + 3] * r2 * g.w * (1.f + sc.w) + sh.w);
      *(uint2*)(p.hx2 + (size_t)m * DM + col) = w;
    }
  }
}

#define PS1_SMEM (128 * 133 * 4)
#define CE_DESC(a, b) { const float _mx = fmaxf(a, b), _mn = fminf(a, b); a = _mx; b = _mn; }
template <int N> __device__ __forceinline__ void bitonic_sort_desc(float (&v)[N]) {
#pragma unroll
  for (int k = 2; k <= N; k <<= 1)
#pragma unroll
    for (int j = k >> 1; j > 0; j >>= 1)
#pragma unroll
      for (int i = 0; i < N; ++i) { const int l = i ^ j; if (l > i) { if ((i & k) == 0) CE_DESC(v[i], v[l]) else CE_DESC(v[l], v[i]) } }
}
__device__ __forceinline__ void bitonic_merge16_desc(float (&v)[16]) {
#pragma unroll
  for (int j = 8; j > 0; j >>= 1)
#pragma unroll
    for (int i = 0; i < 16; ++i) { const int l = i ^ j; if (l > i) CE_DESC(v[i], v[l]) }
}
__device__ __forceinline__ void ph_peer_s1(const P& p, int vb, int nvb, unsigned char* smem) {
  float* S = (float*)smem;
  EpiLds epi{S};
  const int tid = threadIdx.x, sub = tid & 3;
  for (int item = vb; item < 256 * 16; item += nvb) {
    const int hp = item & 15, tm = item >> 4;
    __syncthreads();
    gemm_tile(p.q + hp * 128, 2048, p.keys + (size_t)hp * 128 * 128, 128, 128, tm * 128, 0, epi, smem);
    __syncthreads();
#pragma unroll 1
    for (int pass = 0; pass < 2; ++pass) {
      const int row = pass * 64 + (tid >> 2);
      float a[16], b[16];
#pragma unroll
      for (int i = 0; i < 16; ++i) {
        a[i] = __uint_as_float((__float_as_uint(S[row * 133 + sub * 33 + i]) & ~127u) | (unsigned)(sub * 32 + i));
        b[i] = __uint_as_float((__float_as_uint(S[row * 133 + sub * 33 + 16 + i]) & ~127u) | (unsigned)(sub * 32 + 16 + i));
      }
      bitonic_sort_desc<16>(a); bitonic_sort_desc<16>(b);
#pragma unroll
      for (int i = 0; i < 16; ++i) a[i] = fmaxf(a[i], b[15 - i]);
      bitonic_merge16_desc(a);
#pragma unroll
      for (int lvl = 1; lvl <= 2; lvl <<= 1) {
#pragma unroll
        for (int i = 0; i < 16; ++i) b[i] = __shfl_xor(a[i], lvl);
#pragma unroll
        for (int i = 0; i < 16; ++i) a[i] = fmaxf(a[i], b[15 - i]);
        bitonic_merge16_desc(a);
      }
      if (sub == 0) {
        const size_t ob = ((size_t)(tm * 128 + row) * 16 + hp) * 16;
#pragma unroll
        for (int i = 0; i < 16; i += 4) {
          *(f32x4*)(p.sv + ob + i) = (f32x4){a[i], a[i + 1], a[i + 2], a[i + 3]};
          typedef int i32x4 __attribute__((ext_vector_type(4)));
          *(i32x4*)(p.si + ob + i) = (i32x4){(int)(__float_as_uint(a[i]) & 127u), (int)(__float_as_uint(a[i + 1]) & 127u), (int)(__float_as_uint(a[i + 2]) & 127u), (int)(__float_as_uint(a[i + 3]) & 127u)};
        }
      }
    }
  }
}
__device__ __forceinline__ void top16_merge(float (&x)[16], const float (&y)[16]) {
#pragma unroll
  for (int i = 0; i < 16; ++i) x[i] = fmaxf(x[i], y[15 - i]);
  bitonic_merge16_desc(x);
}
__device__ __forceinline__ void ph_peer_s2(const P& p, int vb, int nvb, unsigned char* smem) {
  unsigned char* lut = smem;
  __syncthreads();
  if (threadIdx.x == 0) {
    int n = 0;
#pragma unroll
    for (int i = 0; i < 16; ++i)
#pragma unroll
      for (int j = 0; j < 16; ++j)
        if ((i + 1) * (j + 1) <= 16) { lut[n] = (unsigned char)((i << 4) | j); ++n; }
  }
  __syncthreads();
  for (int it = vb * 256 + threadIdx.x; it < NTOK * 8; it += nvb * 256) {
    const size_t ob = (size_t)it * 32;
    float a[16], bq[16];
#pragma unroll
    for (int i = 0; i < 16; i += 4) {
      const f32x4 fa = *(const f32x4*)(p.sv + ob + i), fb = *(const f32x4*)(p.sv + ob + 16 + i);
#pragma unroll
      for (int e = 0; e < 4; ++e) { a[i + e] = fa[e]; bq[i + e] = fb[e]; }
    }
    float g0[16], g1[16], g2[16], g3[16];
    {
      int n = 0;
#pragma unroll
      for (int i = 0; i < 16; ++i)
#pragma unroll
        for (int j = 0; j < 16; ++j)
          if ((i + 1) * (j + 1) <= 16) {
            const float v = __uint_as_float((__float_as_uint(a[i] + bq[j]) & ~63u) | (unsigned)n);
            if (n < 16) g0[n] = v; else if (n < 32) g1[n - 16] = v; else if (n < 48) g2[n - 32] = v; else g3[n - 48] = v;
            ++n;
          }
#pragma unroll
      for (int k = 2; k < 16; ++k) g3[k] = -3.0e38f;
    }
    bitonic_sort_desc<16>(g0); bitonic_sort_desc<16>(g1); bitonic_sort_desc<16>(g2); bitonic_sort_desc<16>(g3);
    top16_merge(g0, g1); top16_merge(g2, g3); top16_merge(g0, g2);
    float den = 0.f; float ex[16]; int seli[16];
#pragma unroll
    for (int k = 0; k < 16; ++k) {
      ex[k] = __expf(g0[k] - g0[0]); den += ex[k];
      const int ij = lut[__float_as_uint(g0[k]) & 63u];
      const int ka = (int)(__float_as_uint(p.sv[ob + (ij >> 4)]) & 127u), kb = (int)(__float_as_uint(p.sv[ob + 16 + (ij & 15)]) & 127u);
      seli[k] = ka * 128 + kb;
    }
    const float inv = 1.0f / den;
    const size_t o2 = (size_t)it * 16;
    typedef int i32x4 __attribute__((ext_vector_type(4)));
#pragma unroll
    for (int k = 0; k < 16; k += 4) {
      *(i32x4*)(p.pidx + o2 + k) = (i32x4){seli[k], seli[k + 1], seli[k + 2], seli[k + 3]};
      *(f32x4*)(p.pgate + o2 + k) = (f32x4){ex[k] * inv, ex[k + 1] * inv, ex[k + 2] * inv, ex[k + 3] * inv};
    }
  }
}
typedef float f32x16 __attribute__((ext_vector_type(16)));
typedef float f32x32 __attribute__((ext_vector_type(32)));
typedef unsigned u32x6 __attribute__((ext_vector_type(6)));
__device__ __forceinline__ float half_max(float v) {
#pragma unroll
  for (int o = 16; o > 0; o >>= 1) v = fmaxf(v, __shfl_xor(v, o));
  return v;
}
__device__ __forceinline__ float half_sum(float v) {
#pragma unroll
  for (int o = 16; o > 0; o >>= 1) v += __shfl_xor(v, o);
  return v;
}
__device__ __forceinline__ void ph_cvt_fp6(const float* __restrict__ in, unsigned char* __restrict__ out, float* __restrict__ inv_scale, int vb, int nvb) {
  const int lane = threadIdx.x & 63, wid = threadIdx.x >> 6, hf = lane >> 5, sl = lane & 31;
  for (int rp = vb * 4 + wid; rp < 8192; rp += nvb * 4) {
    const int row = rp * 2 + hf;
    f32x16 a, b2; float am = 0.f;
#pragma unroll
    for (int i = 0; i < 4; ++i) {
      const f32x4 v0 = *(const f32x4*)(in + (size_t)row * DM + sl * 32 + 4 * i), v1 = *(const f32x4*)(in + (size_t)row * DM + sl * 32 + 16 + 4 * i);
#pragma unroll
      for (int e = 0; e < 4; ++e) { a[4 * i + e] = v0[e]; b2[4 * i + e] = v1[e]; am = fmaxf(am, fmaxf(fabsf(v0[e]), fabsf(v1[e]))); }
    }
    am = half_max(am);
    const float sc = am > 0.f ? 7.0f / am : 1.0f;
    const u32x6 pk = __builtin_amdgcn_cvt_scalef32_2xpk16_fp6_f32(a * sc, b2 * sc, 1.0f);
    unsigned char* o = out + (size_t)row * 768 + sl * 24;
    *(u32x2*)(o) = (u32x2){pk[0], pk[1]}; *(u32x2*)(o + 8) = (u32x2){pk[2], pk[3]}; *(u32x2*)(o + 16) = (u32x2){pk[4], pk[5]};
    if (sl == 0) inv_scale[row] = am > 0.f ? am / 7.0f : 1.0f;
  }
}
__device__ __forceinline__ u32x6 load_row6(const unsigned char* base, int id, int sl) {
  const unsigned char* q = base + (size_t)id * 768 + sl * 24;
  const u32x2 a = *(const u32x2*)q, b = *(const u32x2*)(q + 8), c = *(const u32x2*)(q + 16);
  return (u32x6){a.x, a.y, b.x, b.y, c.x, c.y};
}
#define GATHER_SMEM (4 * 64 * 33 * 4)
__device__ __forceinline__ void ph_peer_gather(const P& p, int vb, int nvb, unsigned char* smem) {
  int tid_ = threadIdx.x;
  asm volatile("" : "+v"(tid_));
  const int lane = tid_ & 63, wid = tid_ >> 6, hf = lane >> 5, sl = lane & 31;
  float* scr = (float*)smem + (wid * 64 + lane) * 33;
  int* tauL = (int*)(smem + GATHER_SMEM) + wid * 32;
  {
    f32x16 a, b2;
#pragma unroll
    for (int i = 0; i < 16; ++i) { a[i] = __uint_as_float((unsigned)i << 20) * 0x1p126f; b2[i] = __uint_as_float((unsigned)(16 + i) << 20) * 0x1p126f; }
    const f32x32 o = __builtin_amdgcn_cvt_scalef32_pk32_f32_fp6(__builtin_amdgcn_cvt_scalef32_2xpk16_fp6_f32(a, b2, 1.0f), 1.0f);
    if (lane == 0) {
#pragma unroll
      for (int j = 0; j < 32; ++j) tauL[j] = (int)((__float_as_uint(o[j] * 0x1p-126f) >> 20) & 31u);
    }
  }
  const int jmap = 2 * (lane & 1) + ((lane >> 1) & 1);
  __syncthreads();
  for (int m = vb * 4 + wid; m < NTOK; m += nvb * 4) {
    const float* md = p.mod + (m / SEQ) * 6144;
    float xh[32];
    {
#pragma unroll
      for (int c4 = 0; c4 < 4; ++c4) {
        const u32x4 u = *(const u32x4*)(p.hx2 + (size_t)m * DM + sl * 32 + 8 * c4);
#pragma unroll
        for (int e = 0; e < 4; ++e) { scr[8 * c4 + 2 * e] = bflo(u[e]); scr[8 * c4 + 2 * e + 1] = bfhi(u[e]); }
      }
      lds_wave_fence();
#pragma unroll
      for (int j = 0; j < 32; ++j) xh[j] = scr[tauL[j]];
      lds_wave_fence();
    }
    const int id0 = p.pidx[(size_t)m * 128 + lane], id1 = p.pidx[(size_t)m * 128 + 64 + lane];
    const float su0 = p.us[id0], su1 = p.us[id1];
    const float gs0 = p.pgate[(size_t)m * 128 + lane] * p.vs[id0], gs1 = p.pgate[(size_t)m * 128 + 64 + lane] * p.vs[id1];
    float acch[32];
#pragma unroll
    for (int k = 0; k < 32; ++k) acch[k] = 0.f;
#pragma unroll 1
    for (int e0 = 0; e0 < 128; e0 += 8) {
      u32x6 ur[4], vr[4];
#pragma unroll
      for (int j = 0; j < 4; ++j) {
        const int id = __shfl(e0 < 64 ? id0 : id1, (e0 + hf * 4 + j) & 63);
        ur[j] = load_row6(p.ub8, id, sl);
        vr[j] = load_row6(p.vb8, id, sl);
      }
      float d[4];
#pragma unroll
      for (int j = 0; j < 4; ++j) {
        const f32x32 f = __builtin_amdgcn_cvt_scalef32_pk32_f32_fp6(ur[j], 1.0f);
        float s0 = 0.f, s1 = 0.f;
#pragma unroll
        for (int k = 0; k < 32; k += 2) { s0 += f[k] * xh[k]; s1 += f[k + 1] * xh[k + 1]; }
        d[j] = s0 + s1;
      }
      float r2[2], r1;
      {
        const bool lo = (lane & 1) == 0;
#pragma unroll
        for (int i = 0; i < 2; ++i) { const float keep = lo ? d[i] : d[i + 2], send = lo ? d[i + 2] : d[i]; r2[i] = keep + __shfl_xor(send, 1); }
        const bool lo2 = (lane & 2) == 0;
        { const float keep = lo2 ? r2[0] : r2[1], send = lo2 ? r2[1] : r2[0]; r1 = keep + __shfl_xor(send, 2); }
        r1 += __shfl_xor(r1, 4); r1 += __shfl_xor(r1, 8); r1 += __shfl_xor(r1, 16);
      }
      const int esrc = (e0 + hf * 4 + jmap) & 63;
      const float su = __shfl(e0 < 64 ? su0 : su1, esrc), gs = __shfl(e0 < 64 ? gs0 : gs1, esrc);
      const float sdot = r1 * su;
      const float cf = 0.5f * sdot * (1.0f + erff(sdot * 0.70710678118654752f)) * gs;
#pragma unroll
      for (int j = 0; j < 4; ++j) {
        const float cj = __shfl(cf, (lane & 32) | ((j >> 1) | ((j & 1) << 1)));
        const f32x32 f = __builtin_amdgcn_cvt_scalef32_pk32_f32_fp6(vr[j], 1.0f);
#pragma unroll
        for (int k = 0; k < 32; ++k) acch[k] += cj * f[k];
      }
    }
#pragma unroll
    for (int k = 0; k < 32; ++k) { acch[k] += __shfl_xor(acch[k], 32); scr[tauL[k]] = acch[k]; }
    lds_wave_fence();
    float ss = 0.f;
#pragma unroll
    for (int k = 0; k < 32; ++k) { const float v = scr[k]; ss += v * v; }
    ss = half_sum(ss);
    const float rstd = rsqrtf(ss * (1.0f / 1024.0f) + 1e-6f);
#pragma unroll
    for (int k4 = 0; k4 < 4; ++k4) {
      const int kk = hf * 16 + k4 * 4, col = sl * 32 + kk;
      f32x4 x1 = *(const f32x4*)(p.out + (size_t)m * DM + col);
      const f32x4 g = *(const f32x4*)(p.g_post_ffn + col), gt = *(const f32x4*)(md + 5120 + col);
#pragma unroll
      for (int e = 0; e < 4; ++e) x1[e] += gt[e] * scr[kk + e] * rstd * g[e];
      *(f32x4*)(p.out + (size_t)m * DM + col) = x1;
    }
    lds_wave_fence();
  }
}

#define XB_TMO      128
#define XB_XCNT(j)  (256  + 64 * (j))
#define XB_XSUB(j)  (1280 + 64 * (j))
#define XB_XGEN(j)  (2304 + 64 * (j))
#define XB_TOP      3328
#define XB_TOPGEN   3392
#define XCD_BAR_WORDS 3456
#define XB_SPIN_CAP (1u << 20)
#define LAS __attribute__((address_space(3)))
__device__ __forceinline__ unsigned xb_ld(unsigned* p)              { return __hip_atomic_load(p, __ATOMIC_RELAXED, __HIP_MEMORY_SCOPE_AGENT); }
__device__ __forceinline__ unsigned xb_add(unsigned* p, unsigned v) { return __hip_atomic_fetch_add(p, v, __ATOMIC_RELAXED, __HIP_MEMORY_SCOPE_AGENT); }
__device__ __forceinline__ unsigned xb_xcc_id() { return (unsigned)__builtin_amdgcn_s_getreg((3 << 11) | 20) & 0xFu; }
#define XB_SPIN(cond, bar) do { unsigned _sp = 0; while (cond) { __builtin_amdgcn_s_sleep(1); \
    if ((++_sp & 255u) == 0u) { if (xb_ld(&(bar)[XB_TMO])) break; if (_sp > XB_SPIN_CAP) { atomicAdd(&(bar)[XB_TMO], 1u); break; } } } } while (0)
struct XcdBarrier { unsigned* bar; unsigned x; volatile LAS unsigned* st; };
__device__ __forceinline__ XcdBarrier xcd_barrier_post(unsigned* bar, volatile LAS unsigned* st) {
  XcdBarrier b; b.bar = bar; b.x = xb_xcc_id(); b.st = st;
  if (threadIdx.x == 0) (void)xb_add(&bar[XB_XCNT(b.x)], 1u);
  return b;
}
__device__ __forceinline__ void xcd_barrier_complete(unsigned* bar, unsigned x, unsigned& nloc, unsigned& nx) {
  const unsigned G = gridDim.x * gridDim.y * gridDim.z;
  unsigned sum, cnt, mine, sp = 0u;
  for (;;) {
    sum = 0u; cnt = 0u; mine = 0u;
#pragma unroll
    for (unsigned j = 0; j < 16; ++j) { const unsigned c = xb_ld(&bar[XB_XCNT(j)]); sum += c; cnt += (c > 0u) ? 1u : 0u; mine = (j == x) ? c : mine; }
    if (sum == G) break;
    __builtin_amdgcn_s_sleep(1);
    if ((++sp & 255u) == 0u) { if (xb_ld(&bar[XB_TMO])) break; if (sp > XB_SPIN_CAP) { atomicAdd(&bar[XB_TMO], 1u); break; } }
  }
  nloc = mine > 0u ? mine : 1u; nx = cnt > 0u ? cnt : 1u;
}
__device__ __forceinline__ void xcd_barrier(const XcdBarrier& b) {
  asm volatile("s_waitcnt vmcnt(0)" ::: "memory");
  __syncthreads();
  if (threadIdx.x == 0) {
    unsigned* bar = b.bar;
    __builtin_amdgcn_s_waitcnt(0);
    unsigned nloc = b.st[0], nx = b.st[1];
    if (nloc == 0u) { xcd_barrier_complete(bar, b.x, nloc, nx); b.st[0] = nloc; b.st[1] = nx; }
    const unsigned old = xb_add(&bar[XB_XSUB(b.x)], 1u);
    const unsigned gen = old / nloc;
    if (old + 1u == (gen + 1u) * nloc) {
      __builtin_amdgcn_fence(__ATOMIC_RELEASE, "agent");
      asm volatile("s_waitcnt vmcnt(0)" ::: "memory");
      const unsigned og = xb_add(&bar[XB_TOP], 1u);
      const unsigned tg = og / nx;
      if (og + 1u == (tg + 1u) * nx) xb_add(&bar[XB_TOPGEN], 1u);
      else XB_SPIN(xb_ld(&bar[XB_TOPGEN]) == tg, bar);
      __builtin_amdgcn_fence(__ATOMIC_ACQUIRE, "agent");
      xb_add(&bar[XB_XGEN(b.x)], 1u);
      asm volatile("s_waitcnt vmcnt(0)" ::: "memory");
    } else {
      XB_SPIN(xb_ld(&bar[XB_XGEN(b.x)]) == gen, bar);
      __builtin_amdgcn_fence(__ATOMIC_ACQUIRE, "agent");
      asm volatile("s_waitcnt vmcnt(0)" ::: "memory");
    }
  }
  __syncthreads();
}

#define SMEM_BYTES RWKV_SMEM
__global__ void __launch_bounds__(256, 2) mega(P p) {
  __shared__ __attribute__((aligned(16))) unsigned char smem[SMEM_BYTES + 16];
  cg::grid_group grid = cg::this_grid();
  const int vb = blockIdx.x, nvb = gridDim.x;
  if (threadIdx.x == 0) *(u32x4*)(smem + SMEM_BYTES) = (u32x4){0u, 0u, 0u, 0u};
  __syncthreads();
  const XcdBarrier xb = xcd_barrier_post(p.bar, (volatile LAS unsigned*)(smem + SMEM_BYTES));
  ph_mod(p, vb, nvb, smem);
  ph_transpose(p.w_in, p.Wt_in, DM, INC, vb, nvb, smem);
  ph_transpose(p.w2, p.w2T, 64, 1024, vb, nvb, smem);
  ph_transpose(p.w2 + 65536, p.w2T + 65536, 64, 1024, vb, nvb, smem);
  ph_transpose(p.a2, p.a2T, 64, 1024, vb, nvb, smem);
  ph_transpose(p.a2 + 65536, p.a2T + 65536, 64, 1024, vb, nvb, smem);
  if (p.bar == nullptr) grid.sync();
  xcd_barrier(xb);
  ph_norm1(p, vb, nvb);
  xcd_barrier(xb);
  ph_gemm1(p, vb, nvb, smem);
  xcd_barrier(xb);
  ph_rwkv_A(p, vb, nvb, smem);
  xcd_barrier(xb);
  ph_rwkv_B(p, vb, nvb, smem);
  if (nvb > 128 && vb >= 64) {
    const int v2 = vb - 64, n2 = nvb - 64;
    ph_transpose(p.w_a_out, p.Wt_aout, DM, DM, v2, n2, smem);
    ph_transpose(p.w_o, p.Wt_o, DM, DM, v2, n2, smem);
    ph_transpose(p.peer_wq, p.Wt_q, DM, 2048, v2, n2, smem);
    ph_transpose(p.g2, p.g2T, 128, 1024, v2, n2, smem);
    ph_weff(p, v2, n2);
    ph_convert(p.peer_keys, p.keys, (size_t)16 * 128 * 128, v2, n2);
  } else if (nvb <= 128) {
    ph_transpose(p.w_a_out, p.Wt_aout, DM, DM, vb, nvb, smem);
    ph_transpose(p.w_o, p.Wt_o, DM, DM, vb, nvb, smem);
    ph_transpose(p.peer_wq, p.Wt_q, DM, 2048, vb, nvb, smem);
    ph_transpose(p.g2, p.g2T, 128, 1024, vb, nvb, smem);
    ph_weff(p, vb, nvb);
    ph_convert(p.peer_keys, p.keys, (size_t)16 * 128 * 128, vb, nvb);
  }
  xcd_barrier(xb);
  ph_rwkv_C(p, vb, nvb, smem);
  ph_sg(p, vb, nvb);
  xcd_barrier(xb);
  ph_readout_gemm(p, vb, nvb, smem);
  ph_pool(p, vb, nvb, smem);
  ph_cvt_fp6(p.peer_u, p.ub8, p.us, vb, nvb);
  ph_cvt_fp6(p.peer_v, p.vb8, p.vs, vb, nvb);
  xcd_barrier(xb);
  ph_gemm_merge(p, vb, nvb, smem);
  xcd_barrier(xb);
  ph_gemm_simple(p.mrg, DM, p.Wt_o, DM, DM, NTOK, DM, p.mix, DM, vb, nvb, smem);
  xcd_barrier(xb);
  ph_res1(p, vb, nvb);
  xcd_barrier(xb);
  ph_gemm_simple(p.hx2, DM, p.Wt_q, DM, DM, NTOK, 2048, p.q, 2048, vb, nvb, smem);
  xcd_barrier(xb);
  ph_peer_s1(p, vb, nvb, smem);
  xcd_barrier(xb);
  ph_peer_s2(p, vb, nvb, smem);
  xcd_barrier(xb);
  ph_peer_gather(p, vb, nvb, smem);
}

extern "C" void kernel_launch(void* const* d_in, const int* in_sizes, int n_in, void* d_out, int out_size, void* d_ws, size_t ws_size, hipStream_t stream) {
  P p{};
  const float** f = (const float**)&p;
  for (int i = 0; i < 32; ++i) f[i] = (const float*)d_in[i];
  p.out = (float*)d_out;
  p.bar = (unsigned*)((unsigned char*)d_ws + 511 * 1048576);
  unsigned char* w = (unsigned char*)d_ws;
  const size_t MiB = 1048576;
  const size_t HM = 524288;
  p.hx = (bf16_t*)(w + 4096);
  p.zA = (bf16_t*)(w + 65 * MiB + 8192);
  p.zP = (bf16_t*)(w + 569 * HM);
  p.zG = (bf16_t*)d_out;
  unsigned char* rw = w + 633 * HM;
  p.Wt_in = (bf16_t*)rw; rw += 12 * MiB;
  p.Wt_aout = (bf16_t*)rw; rw += 2 * MiB;
  p.Wt_eff = (bf16_t*)rw; rw += 1 * MiB;
  p.Wt_o = (bf16_t*)rw; rw += 2 * MiB;
  p.Wt_q = (bf16_t*)rw; rw += 4 * MiB;
  p.keys = (bf16_t*)rw; rw += HM;
  p.mod = (float*)rw; rw += HM;
  p.g2T = (bf16_t*)rw; rw += HM;
  p.w2T = (bf16_t*)rw; rw += HM;
  p.a2T = (bf16_t*)rw; rw += HM;
  p.Y0 = (bf16_t*)(w + 0 * MiB);
  p.Y1 = (bf16_t*)(w + 340 * MiB);
  p.bdot = (float*)(w + 404 * MiB);
  p.Mst = (bf16_t*)(w + 408 * MiB);
  p.sg = (bf16_t*)(w + 408 * MiB);
  p.Nst = (float*)(w + 441 * MiB);
  p.ub8 = w + 416 * MiB;
  p.vb8 = w + 432 * MiB;
  p.us = (float*)(w + 448 * MiB);
  p.vs = (float*)(w + 449 * MiB);
  p.pooled = (bf16_t*)(w + 478 * MiB);
  p.out_a = (bf16_t*)(w + 0 * MiB);
  p.ya = (bf16_t*)(w + 65 * MiB);
  p.yb = (bf16_t*)(w + 129 * MiB);
  p.mrg = (bf16_t*)(w + 193 * MiB);
  p.mix = (bf16_t*)(w + 65 * MiB);
  p.hx2 = (bf16_t*)(w + 0 * MiB);
  p.q = (bf16_t*)(w + 129 * MiB);
  p.sv = (float*)(w + 340 * MiB);
  p.si = (int*)(w + 372 * MiB);
  p.pidx = (int*)(w + 257 * MiB);
  p.pgate = (float*)(w + 273 * MiB);
  static int grid_blocks = 0;
  if (!grid_blocks) {
    int dev = 0, cus = 0, per_cu = 0;
    hipGetDevice(&dev);
    hipDeviceGetAttribute(&cus, hipDeviceAttributeMultiprocessorCount, dev);
    hipOccupancyMaxActiveBlocksPerMultiprocessor(&per_cu, mega, 256, 0);
    if (per_cu > 2) per_cu = 2;
    if (per_cu < 1) per_cu = 1;
    grid_blocks = cus * per_cu;
  }
  hipMemsetAsync(p.bar, 0, XCD_BAR_WORDS * 4, stream);
  void* args[] = {&p};
  hipError_t e = hipLaunchCooperativeKernel((void*)mega, dim3(grid_blocks), dim3(256), args, 0, stream);
  if (e != hipSuccess) fprintf(stderr, "cooperative launch failed: %s (grid %d)\n", hipGetErrorString(e), grid_blocks);
}
```

```cpp
#include <hip/hip_runtime.h>
#include <hip/hip_cooperative_groups.h>
#include <stdint.h>
#include <cstdio>
namespace cg = cooperative_groups;

typedef unsigned short bf16_t;
typedef short bf16x8 __attribute__((ext_vector_type(8)));
typedef float f32x4 __attribute__((ext_vector_type(4)));
typedef unsigned u32x4 __attribute__((ext_vector_type(4)));
typedef unsigned u32x2 __attribute__((ext_vector_type(2)));
typedef float f32x2 __attribute__((ext_vector_type(2)));

__device__ __forceinline__ int tid_opaque() { int t = threadIdx.x; asm volatile("" : "+v"(t)); return t; }
#define TIDX tid_opaque()
#define NTOK 32768
#define SEQ 16384
#define CTXL 256
#define NCTX 512
#define MROWS 33280
#define DM 1024
#define SHIFTC 3456
#define INC 6016

typedef __bf16 hwbf2 __attribute__((ext_vector_type(2)));
typedef float hwf2 __attribute__((ext_vector_type(2)));
__device__ __forceinline__ unsigned pack2(float a, float b) { return __builtin_bit_cast(unsigned, __builtin_convertvector((hwf2){a, b}, hwbf2)); }
__device__ __forceinline__ bf16_t f2bf(float f) { return __builtin_bit_cast(unsigned short, (__bf16)f); }
__device__ __forceinline__ float bf2f(bf16_t h) { return __uint_as_float(((unsigned)h) << 16); }
__device__ __forceinline__ float bflo(unsigned u) { return __uint_as_float(u << 16); }
__device__ __forceinline__ float bfhi(unsigned u) { return __uint_as_float(u & 0xffff0000u); }
__device__ __forceinline__ float sigmoidf_(float x) { return __builtin_amdgcn_rcpf(1.0f + __expf(-x)); }

__device__ __forceinline__ void load8(const bf16_t* __restrict__ zA, int row, int col0, float* o) {
  const u32x4 zc = *(const u32x4*)(zA + (size_t)row * SHIFTC + col0);
#pragma unroll
  for (int i = 0; i < 4; ++i) { o[2 * i] = bflo(zc[i]); o[2 * i + 1] = bfhi(zc[i]); }
}
__device__ __forceinline__ float red16(float v) {
  v += __shfl_xor(v, 1); v += __shfl_xor(v, 2); v += __shfl_xor(v, 4); v += __shfl_xor(v, 8);
  return v;
}
__device__ __forceinline__ float red8(float v) {
  v += __shfl_xor(v, 1); v += __shfl_xor(v, 2); v += __shfl_xor(v, 4);
  return v;
}

struct P {
  const float *x, *c, *ctx, *c_ctx, *w_mod, *b_mod, *g_pre_mix, *g_post_mix, *g_pre_ffn, *g_post_ffn, *w_in, *b_gate, *mu_shift,
      *w0, *w2, *a0, *a2, *g2, *k_k, *k_a, *r_k, *ln_x_w, *ln_x_b, *w_a_out, *w_pool, *pool_scale, *w_b_out, *w_o, *peer_wq,
      *peer_keys, *peer_u, *peer_v;
  float* out;
  unsigned* bar;
  bf16_t* hx;
  bf16_t* zA;
  bf16_t* zP;
  bf16_t* zG;
  bf16_t* Wt_in;
  bf16_t* Wt_aout;
  bf16_t* Wt_eff;
  bf16_t* Wt_o;
  bf16_t* Wt_q;
  bf16_t* keys;
  float* mod;
  unsigned char* ub8;
  unsigned char* vb8;
  float* us;
  float* vs;
  bf16_t* sg;
  bf16_t* g2T;
  bf16_t* w2T;
  bf16_t* a2T;
  bf16_t* Mst;
  float* Nst;
  bf16_t* Y0;
  bf16_t* Y1;
  float* bdot;
  bf16_t* out_a;
  bf16_t* ya;
  bf16_t* pooled;
  bf16_t* yb;
  bf16_t* mrg;
  bf16_t* mix;
  bf16_t* hx2;
  bf16_t* q;
  float* sv;
  int* si;
  int* pidx;
  float* pgate;
};

#define GS 72
#define GEMM_SMEM (2 * 128 * GS * 2)
template <class Epi>
__device__ __forceinline__ void gemm_tile(const bf16_t* __restrict__ A, int lda, const bf16_t* __restrict__ Bt, int ldb, int K, int m0, int n0,
                                          const Epi& epi, unsigned char* smem) {
  const int tid = TIDX, lane = tid & 63, wid = tid >> 6, wr = wid >> 1, wc = wid & 1;
  bf16_t* sA = (bf16_t*)smem;
  bf16_t* sB = sA + 128 * GS;
  f32x4 acc[4][4];
#pragma unroll
  for (int i = 0; i < 4; ++i)
#pragma unroll
    for (int j = 0; j < 4; ++j) acc[i][j] = (f32x4){0.f, 0.f, 0.f, 0.f};
  const int lrow = tid >> 3, lcol = (tid & 7) * 8;
  const bf16_t* pa = A + (size_t)(m0 + lrow) * lda + lcol;
  const bf16_t* pb = Bt + (size_t)(n0 + lrow) * ldb + lcol;
  u32x4 ra[4], rb[4];
#pragma unroll
  for (int p = 0; p < 4; ++p) {
    ra[p] = *(const u32x4*)(pa + (size_t)(32 * p) * lda);
    rb[p] = *(const u32x4*)(pb + (size_t)(32 * p) * ldb);
  }
  for (int k0 = 0; k0 < K; k0 += 64) {
#pragma unroll
    for (int p = 0; p < 4; ++p) {
      *(u32x4*)(sA + (lrow + 32 * p) * GS + lcol) = ra[p];
      *(u32x4*)(sB + (lrow + 32 * p) * GS + lcol) = rb[p];
    }
    __syncthreads();
    if (k0 + 64 < K) {
#pragma unroll
      for (int p = 0; p < 4; ++p) {
        ra[p] = *(const u32x4*)(pa + (size_t)(32 * p) * lda + k0 + 64);
        rb[p] = *(const u32x4*)(pb + (size_t)(32 * p) * ldb + k0 + 64);
      }
    }
#pragma unroll
    for (int kk = 0; kk < 2; ++kk) {
      bf16x8 af[4], bfr[4];
#pragma unroll
      for (int i = 0; i < 4; ++i) af[i] = *(const bf16x8*)(sA + (wr * 64 + i * 16 + (lane & 15)) * GS + kk * 32 + (lane >> 4) * 8);
#pragma unroll
      for (int j = 0; j < 4; ++j) bfr[j] = *(const bf16x8*)(sB + (wc * 64 + j * 16 + (lane & 15)) * GS + kk * 32 + (lane >> 4) * 8);
#pragma unroll
      for (int i = 0; i < 4; ++i)
#pragma unroll
        for (int j = 0; j < 4; ++j) acc[i][j] = __builtin_amdgcn_mfma_f32_16x16x32_bf16(bfr[j], af[i], acc[i][j], 0, 0, 0);
    }
    __syncthreads();
  }
#pragma unroll
  for (int i = 0; i < 4; ++i)
#pragma unroll
    for (int j = 0; j < 4; ++j) epi(m0 + wr * 64 + i * 16 + (lane & 15), n0 + wc * 64 + j * 16 + (lane >> 4) * 4, acc[i][j]);
}

#define G3_STAGE 24576
#define G3_ES 136
#define GEMM3_SMEM (256 * G3_ES * 2)
typedef __attribute__((address_space(3))) unsigned lds_u32;
template <class Epi>
__device__ __forceinline__ void gemm_tile3(const bf16_t* __restrict__ A, int lda, const bf16_t* __restrict__ Bt, int ldb, int K, int m0, int n0,
                                           const Epi& epi, unsigned char* smem) {
  int tid = TIDX;
  asm volatile("" : "+v"(tid));
  const int lane = tid & 63, wid = __builtin_amdgcn_readfirstlane(tid >> 6), wr = wid >> 1, wc = wid & 1, l15 = lane & 15, q = lane >> 4;
  f32x4 acc[8][4];
#pragma unroll
  for (int i = 0; i < 8; ++i)
#pragma unroll
    for (int j = 0; j < 4; ++j) acc[i][j] = (f32x4){0.f, 0.f, 0.f, 0.f};
  const int gr = lane >> 2, gc = ((lane & 3) ^ (((gr >> 2) & 1) << 1)) * 8;
  const bf16_t* pa = A + (long)(m0 + wid * 64 + gr) * lda + gc;
  const bf16_t* pb = Bt + (size_t)(n0 + wid * 32 + gr) * ldb + gc;
  unsigned char* dA = smem + wid * 4096 + lane * 16;
  unsigned char* dB = smem + 16384 + wid * 2048 + lane * 16;
  const int sw = (q ^ (((l15 >> 2) & 1) << 1)) * 16;
  const unsigned char* fA = smem + (wr * 128 + l15) * 64 + sw;
  const unsigned char* fB = smem + 16384 + (wc * 64 + l15) * 64 + sw;
#define G3_ISSUE(ST, KT) { _Pragma("unroll") for (int ii = 0; ii < 4; ++ii) __builtin_amdgcn_global_load_lds((const unsigned*)(pa + (size_t)(16 * ii) * lda + (KT) * 32), (lds_u32*)(dA + (ST) * G3_STAGE + ii * 1024), 16, 0, 0); \
                           _Pragma("unroll") for (int ii = 0; ii < 2; ++ii) __builtin_amdgcn_global_load_lds((const unsigned*)(pb + (size_t)(16 * ii) * ldb + (KT) * 32), (lds_u32*)(dB + (ST) * G3_STAGE + ii * 1024), 16, 0, 0); }
  const int nk = K >> 5;
  __syncthreads();
  G3_ISSUE(0, 0);
  for (int kt = 0; kt < nk; ++kt) {
    const int cur = kt & 1;
    asm volatile("s_waitcnt vmcnt(0)" ::: "memory");
    __syncthreads();
    if (kt + 1 < nk) G3_ISSUE(cur ^ 1, kt + 1);
    const unsigned char* cA = fA + cur * G3_STAGE;
    const unsigned char* cB = fB + cur * G3_STAGE;
    bf16x8 bfr[4];
#pragma unroll
    for (int j = 0; j < 4; ++j) bfr[j] = *(const bf16x8*)(cB + j * 1024);
#pragma unroll
    for (int i = 0; i < 8; ++i) {
      const bf16x8 af = *(const bf16x8*)(cA + i * 1024);
#pragma unroll
      for (int j = 0; j < 4; ++j) acc[i][j] = __builtin_amdgcn_mfma_f32_16x16x32_bf16(bfr[j], af, acc[i][j], 0, 0, 0);
    }
  }
#undef G3_ISSUE
  bf16_t* sE = (bf16_t*)smem;
  __syncthreads();
#pragma unroll
  for (int i = 0; i < 8; ++i)
#pragma unroll
    for (int j = 0; j < 4; ++j) {
      u32x2 w; w.x = pack2(acc[i][j][0], acc[i][j][1]); w.y = pack2(acc[i][j][2], acc[i][j][3]);
      *(u32x2*)(sE + (wr * 128 + i * 16 + l15) * G3_ES + wc * 64 + j * 16 + q * 4) = w;
    }
  __syncthreads();
  epi.finish(sE, m0, n0, tid);
}
template <class D> struct Epi3RowChunks {
  __device__ __forceinline__ void finish(const bf16_t* sE, int m0, int n0, int tid) const {
#pragma unroll
    for (int pp = 0; pp < 16; ++pp) {
      const int id = tid + 256 * pp, row = id >> 4, cc = (id & 15) * 8;
      static_cast<const D*>(this)->store(m0 + row, n0 + cc, *(const u32x4*)(sE + row * G3_ES + cc));
    }
  }
};
struct Epi3StoreBf16 : Epi3RowChunks<Epi3StoreBf16> {
  bf16_t* C; int ldc;
  __device__ Epi3StoreBf16(bf16_t* c, int l) : C(c), ldc(l) {}
  __device__ __forceinline__ void store(int m, int n, const u32x4& v) const { *(u32x4*)(C + (size_t)m * ldc + n) = v; }
};
struct Epi3GateA : Epi3RowChunks<Epi3GateA> {
  const bf16_t* zG; const float* bg; bf16_t* mrg;
  __device__ Epi3GateA(const bf16_t* z, const float* b, bf16_t* m) : zG(z), bg(b), mrg(m) {}
  __device__ __forceinline__ void store(int m, int n, const u32x4& v) const {
    const u32x4 g = *(const u32x4*)(zG + (size_t)m * 2048 + n);
    const f32x4 b0 = *(const f32x4*)(bg + n), b1 = *(const f32x4*)(bg + n + 4);
    u32x4 o;
#pragma unroll
    for (int i = 0; i < 4; ++i) {
      const float bl = i < 2 ? b0[2 * i] : b1[2 * i - 4], bh = i < 2 ? b0[2 * i + 1] : b1[2 * i - 3];
      o[i] = pack2(sigmoidf_(bflo(g[i]) + bl) * bflo(v[i]), sigmoidf_(bfhi(g[i]) + bh) * bfhi(v[i]));
    }
    *(u32x4*)(mrg + (size_t)m * DM + n) = o;
  }
};
struct Epi3GateB : Epi3RowChunks<Epi3GateB> {
  const bf16_t* zG; const float* bg; bf16_t* mrg;
  __device__ Epi3GateB(const bf16_t* z, const float* b, bf16_t* m) : zG(z), bg(b), mrg(m) {}
  __device__ __forceinline__ void store(int m, int n, const u32x4& v) const {
    const u32x4 g = *(const u32x4*)(zG + (size_t)m * 2048 + 1024 + n);
    const u32x4 a = *(const u32x4*)(mrg + (size_t)m * DM + n);
    const f32x4 b0 = *(const f32x4*)(bg + 1024 + n), b1 = *(const f32x4*)(bg + 1024 + n + 4);
    u32x4 o;
#pragma unroll
    for (int i = 0; i < 4; ++i) {
      const float bl = i < 2 ? b0[2 * i] : b1[2 * i - 4], bh = i < 2 ? b0[2 * i + 1] : b1[2 * i - 3];
      o[i] = pack2(bflo(a[i]) + sigmoidf_(bflo(g[i]) + bl) * bflo(v[i]), bfhi(a[i]) + sigmoidf_(bfhi(g[i]) + bh) * bfhi(v[i]));
    }
    *(u32x4*)(mrg + (size_t)m * DM + n) = o;
  }
};
struct Epi3ZS {
  bf16_t* zA; const float* mu; int own_lo, own_hi, t0, T;
  __device__ __forceinline__ void finish(const bf16_t* sE, int m0, int n0, int tid) const {
#pragma unroll 4
    for (int pq = 0; pq < 16; ++pq) {
      const int id = tid + 256 * pq, row = id >> 4, cc = (id & 15) * 8, t = t0 + row;
      if (row < own_lo || row > own_hi) continue;
      const u32x4 zc = *(const u32x4*)(sE + row * G3_ES + cc);
      u32x4 zp = (u32x4){0u, 0u, 0u, 0u}, zn = (u32x4){0u, 0u, 0u, 0u};
      if (t > 0) zp = *(const u32x4*)(sE + (row - 1) * G3_ES + cc);
      if (t < T - 1) zn = *(const u32x4*)(sE + (row + 1) * G3_ES + cc);
      const f32x4 m0v = *(const f32x4*)(mu + n0 + cc), m1v = *(const f32x4*)(mu + n0 + cc + 4);
      const float mm[8] = {m0v[0], m0v[1], m0v[2], m0v[3], m1v[0], m1v[1], m1v[2], m1v[3]};
      u32x4 o;
#pragma unroll
      for (int i = 0; i < 4; ++i) {
        const float z0 = bflo(zc[i]), z1 = bfhi(zc[i]);
        o[i] = pack2(z0 + mm[2 * i] * (0.5f * (bflo(zp[i]) + bflo(zn[i])) - z0), z1 + mm[2 * i + 1] * (0.5f * (bfhi(zp[i]) + bfhi(zn[i])) - z1));
      }
      *(u32x4*)(zA + (long)(m0 + row) * SHIFTC + n0 + cc) = o;
    }
  }
};
struct Epi3Z : Epi3RowChunks<Epi3Z> {
  bf16_t *zA, *zP, *zG;
  __device__ Epi3Z(bf16_t* a, bf16_t* b, bf16_t* c) : zA(a), zP(b), zG(c) {}
  __device__ __forceinline__ void store(int m, int n, const u32x4& v) const {
    if (n < SHIFTC) *(u32x4*)(zA + (size_t)m * SHIFTC + n) = v;
    else if (m < NTOK) {
      if (n < SHIFTC + 512) *(u32x4*)(zP + (size_t)m * 512 + (n - SHIFTC)) = v;
      else *(u32x4*)(zG + (size_t)m * 2048 + (n - SHIFTC - 512)) = v;
    }
  }
};

struct EpiLds {
  float* S;
  __device__ __forceinline__ void operator()(int m, int n, const f32x4& v) const {
    float* r = S + (m & 127) * 133 + n + (n >> 5);
    r[0] = v[0]; r[1] = v[1]; r[2] = v[2]; r[3] = v[3];
  }
};

__device__ __forceinline__ void ph_transpose(const float* __restrict__ in, bf16_t* __restrict__ out, int K, int N, int vb, int nvb, unsigned char* smem) {
  float* t = (float*)smem;
  const int tk = K / 64, tn = N / 64, tid = TIDX, tx = tid & 15, ty = tid >> 4;
  for (int it = vb; it < tk * tn; it += nvb) {
    const int k0 = (it / tn) * 64, n0 = (it % tn) * 64;
    __syncthreads();
#pragma unroll
    for (int r = 0; r < 4; ++r) {
      const f32x4 v = *(const f32x4*)(in + (size_t)(k0 + ty + 16 * r) * N + n0 + 4 * tx);
#pragma unroll
      for (int e = 0; e < 4; ++e) t[(ty + 16 * r) * 65 + 4 * tx + e] = v[e];
    }
    __syncthreads();
    const int n = tid >> 2, kq = (tid & 3) * 16;
    u32x4 w0, w1;
#pragma unroll
    for (int e = 0; e < 4; ++e) {
      w0[e] = pack2(t[(kq + 2 * e) * 65 + n], t[(kq + 2 * e + 1) * 65 + n]);
      w1[e] = pack2(t[(kq + 8 + 2 * e) * 65 + n], t[(kq + 8 + 2 * e + 1) * 65 + n]);
    }
    *(u32x4*)(out + (size_t)(n0 + n) * K + k0 + kq) = w0;
    *(u32x4*)(out + (size_t)(n0 + n) * K + k0 + kq + 8) = w1;
  }
}
__device__ __forceinline__ void ph_convert(const float* __restrict__ in, bf16_t* __restrict__ out, size_t n, int vb, int nvb) {
  for (size_t i = ((size_t)vb * 256 + TIDX) * 4; i < n; i += (size_t)nvb * 1024) {
    const float4 v = *(const float4*)(in + i);
    uint2 w; w.x = pack2(v.x, v.y); w.y = pack2(v.z, v.w);
    *(uint2*)(out + i) = w;
  }
}
__device__ __forceinline__ void ph_weff(const P& p, int vb, int nvb) {
  for (int it = vb * 256 + TIDX; it < 512 * 1024; it += nvb * 256) {
    const int n = it & 1023, k = it >> 10, j = k >> 7, kl = k & 127;
    const float* wp = p.w_pool + ((size_t)j * 128 + kl) * 128;
    float s = 0.f;
    for (int c = 0; c < 128; ++c) s += wp[c] * p.pool_scale[j * 128 + c] * p.w_b_out[(size_t)(j * 128 + c) * 1024 + n];
    p.Wt_eff[(size_t)n * 512 + k] = f2bf(s);
  }
}
__device__ __forceinline__ void ph_mod(const P& p, int vb, int nvb, unsigned char* smem) {
  float* red = (float*)smem;
  const int lane = TIDX & 63, wid = TIDX >> 6;
  for (int it = vb; it < 96; it += nvb) {
    const int n = it * 64 + lane;
    float a0 = 0.f, a1 = 0.f, a2 = 0.f;
#pragma unroll 8
    for (int k = wid * 256; k < wid * 256 + 256; ++k) {
      const float w = p.w_mod[(size_t)k * 6144 + n];
      const float c0 = p.c[k], c1 = p.c[1024 + k], c2 = p.c_ctx[k];
      a0 += c0 * sigmoidf_(c0) * w; a1 += c1 * sigmoidf_(c1) * w; a2 += c2 * sigmoidf_(c2) * w;
    }
    __syncthreads();
    red[(wid * 3 + 0) * 64 + lane] = a0; red[(wid * 3 + 1) * 64 + lane] = a1; red[(wid * 3 + 2) * 64 + lane] = a2;
    __syncthreads();
    if (wid < 3) {
      const float sum = red[(0 * 3 + wid) * 64 + lane] + red[(1 * 3 + wid) * 64 + lane] + red[(2 * 3 + wid) * 64 + lane] + red[(3 * 3 + wid) * 64 + lane];
      p.mod[wid * 6144 + n] = sum + p.b_mod[n];
    }
  }
}
__device__ __forceinline__ float wave_sum(float v) {
#pragma unroll
  for (int o = 32; o > 0; o >>= 1) v += __shfl_xor(v, o);
  return v;
}
__device__ __forceinline__ void ph_norm1(const P& p, int vb, int nvb) {
  const int lane = TIDX & 63, wid = TIDX >> 6, nw = nvb * 4;
  for (int m0 = vb * 4 + wid; m0 < MROWS; m0 += 2 * nw) {
    const int m1 = m0 + nw; const bool has1 = m1 < MROWS; const int mb = has1 ? m1 : m0;
    const float* srcA = m0 < NTOK ? p.x + (size_t)m0 * DM : p.ctx + (size_t)(m0 - NTOK) * DM;
    const float* srcB = mb < NTOK ? p.x + (size_t)mb * DM : p.ctx + (size_t)(mb - NTOK) * DM;
    f32x4 va[4], vbq[4]; float sa = 0.f, sb = 0.f;
#pragma unroll
    for (int i = 0; i < 4; ++i) { va[i] = *(const f32x4*)(srcA + i * 256 + lane * 4); vbq[i] = *(const f32x4*)(srcB + i * 256 + lane * 4); }
#pragma unroll
    for (int i = 0; i < 4; ++i)
#pragma unroll
      for (int e = 0; e < 4; ++e) { sa += va[i][e] * va[i][e]; sb += vbq[i][e] * vbq[i][e]; }
    sa = wave_sum(sa); sb = wave_sum(sb);
#pragma unroll
    for (int rr = 0; rr < 2; ++rr) {
      if (rr == 1 && !has1) break;
      const int m = rr == 0 ? m0 : m1;
      const float rstd = rsqrtf((rr == 0 ? sa : sb) * (1.0f / 1024.0f) + 1e-6f);
      const float* md = p.mod + (m < NTOK ? (m / SEQ) : 2) * 6144;
#pragma unroll
      for (int i = 0; i < 4; ++i) {
        const int col = i * 256 + lane * 4;
        const f32x4 v = rr == 0 ? va[i] : vbq[i];
        const f32x4 g = *(const f32x4*)(p.g_pre_mix + col), sh = *(const f32x4*)(md + col), sc = *(const f32x4*)(md + 1024 + col);
        u32x2 w;
        w.x = pack2(v[0] * rstd * g[0] * (1.f + sc[0]) + sh[0], v[1] * rstd * g[1] * (1.f + sc[1]) + sh[1]);
        w.y = pack2(v[2] * rstd * g[2] * (1.f + sc[2]) + sh[2], v[3] * rstd * g[3] * (1.f + sc[3]) + sh[3]);
        *(u32x2*)(p.hx + (size_t)m * DM + col) = w;
      }
    }
  }
}
struct Epi3Readout {
  const P* pp;
  __device__ __forceinline__ void finish(const bf16_t* sE, int m0, int n0, int tid) const {
    const P& p = *pp;
#pragma unroll 2
    for (int pq = 0; pq < 16; ++pq) {
      const int id = tid + 256 * pq, row = id >> 4, cc = (id & 15) * 8, m = m0 + row, n = n0 + cc, t = m % SEQ, h = n >> 6;
      const u32x4 g = *(const u32x4*)(sE + row * G3_ES + cc);
      const u32x4 y0 = *(const u32x4*)(p.Y0 + (size_t)m * DM + n), y1 = *(const u32x4*)(p.Y1 + (size_t)m * DM + n);
      float y[8], v[8];
#pragma unroll
      for (int i = 0; i < 4; ++i) { y[2 * i] = bflo(y0[i]) + bflo(y1[i]); y[2 * i + 1] = bfhi(y0[i]) + bfhi(y1[i]); }
      float sm = 0.f;
#pragma unroll
      for (int i = 0; i < 8; ++i) sm += y[i];
      const float mu = red8(sm) * (1.f / 64.f);
      float qv = 0.f;
#pragma unroll
      for (int i = 0; i < 8; ++i) { y[i] -= mu; qv += y[i] * y[i]; }
      const float rs = rsqrtf(red8(qv) * (1.f / 64.f) + 64e-5f);
      load8(p.zA, m, 2048 + n, v);
      const float bon = 0.5f * (p.bdot[(size_t)m * 16 + h] + p.bdot[((size_t)NTOK + m) * 16 + h]);
      const f32x4 w0 = *(const f32x4*)(p.ln_x_w + n), w1 = *(const f32x4*)(p.ln_x_w + n + 4), b0 = *(const f32x4*)(p.ln_x_b + n), b1 = *(const f32x4*)(p.ln_x_b + n + 4);
      const float lw[8] = {w0[0], w0[1], w0[2], w0[3], w1[0], w1[1], w1[2], w1[3]}, lb[8] = {b0[0], b0[1], b0[2], b0[3], b1[0], b1[1], b1[2], b1[3]};
      u32x4 o;
#pragma unroll
      for (int i = 0; i < 4; ++i)
        o[i] = pack2((y[2 * i] * rs * lw[2 * i] + lb[2 * i] + bon * v[2 * i]) * bflo(g[i]), (y[2 * i + 1] * rs * lw[2 * i + 1] + lb[2 * i + 1] + bon * v[2 * i + 1]) * bfhi(g[i]));
      *(u32x4*)(p.out_a + (size_t)m * DM + n) = o;
    }
  }
};
__device__ __forceinline__ int xcd_tile(int vb, int nvb, int round, int TM, int TN, int& tm, int& tn) {
  if (nvb % 64 != 0) { const int it = round * nvb + vb; if (it >= TM * TN) return 0; tm = it % TM; tn = it / TM; return 1; }
  const int spg = nvb >> 3, g = vb & 7, slot = vb >> 3, SC = spg >> 3;
  const int nsr = (TM + 7) >> 3, nsc = (TN + SC - 1) / SC, st = round * 8 + g;
  if (st >= nsr * nsc) return 0;
  tm = (st % nsr) * 8 + (slot & 7); tn = (st / nsr) * SC + (slot >> 3);
  return (tm < TM && tn < TN) ? 1 : 2;
}
__device__ __forceinline__ void ph_gemm1(const P& p, int vb, int nvb, unsigned char* smem) {
  const int NS_ = 132 * 27, NALL = NS_ + 128 * 20;
  const int per = nvb >> 3;
  for (int round = 0;; ++round) {
    int item;
    if ((nvb & 7) == 0) { const int blk = round * 8 + (vb & 7); if (blk * per >= NALL) break; item = blk * per + (vb >> 3); if (item >= NALL) continue; }
    else { item = round * nvb + vb; if (item >= NALL) break; }
    if (item < NS_) {
      const int cgp = item / (132 * 9), rem = item % (132 * 9), tmS = rem / 9, tn = cgp * 9 + rem % 9;
      Epi3ZS epi;
      epi.zA = p.zA; epi.mu = p.mu_shift;
      int m0;
      if (tmS < 130) { const int b = tmS / 65, i = tmS % 65; m0 = b * SEQ + 254 * i - 1; epi.own_lo = 1; epi.own_hi = min(254, SEQ - 254 * i); epi.t0 = 254 * i - 1; epi.T = SEQ; }
      else { m0 = NTOK + (tmS - 130) * CTXL; epi.own_lo = 0; epi.own_hi = 255; epi.t0 = 0; epi.T = CTXL; }
      gemm_tile3(p.hx, DM, p.Wt_in, DM, DM, m0, tn * 128, epi, smem);
    } else {
      const int i2 = item - NS_;
      int tm, tn;
      if (i2 < 2048) { tm = (i2 & 1023) >> 3; tn = 27 + (i2 >> 10) * 8 + (i2 & 7); } else { tm = (i2 - 2048) >> 2; tn = 43 + (i2 & 3); }
      Epi3Z epi{p.zA, p.zP, p.zG};
      gemm_tile3(p.hx, DM, p.Wt_in, DM, DM, tm * 256, tn * 128, epi, smem);
    }
  }
}
__device__ __forceinline__ void ph_readout_gemm(const P& p, int vb, int nvb, unsigned char* smem) {
  Epi3Readout epi{&p};
  for (int round = 0;; ++round) {
    int tm, tn; const int r = xcd_tile(vb, nvb, round, NTOK / 256, DM / 128, tm, tn);
    if (r == 0) break;
    if (r == 1) gemm_tile3(p.sg, 128, p.g2T, 128, 128, tm * 256, tn * 128, epi, smem);
  }
}
__device__ __forceinline__ void ph_sg(const P& p, int vb, int nvb) {
  for (int it = vb * 256 + TIDX; it < NTOK * 16; it += nvb * 256) {
    const int m = it >> 4, l8 = (it & 15) * 8, t = m % SEQ;
    float o[8];
    load8(p.zA, m, 3328 + l8, o);
    u32x4 w;
#pragma unroll
    for (int i = 0; i < 4; ++i) w[i] = pack2(sigmoidf_(o[2 * i]), sigmoidf_(o[2 * i + 1]));
    *(u32x4*)(p.sg + (size_t)m * 128 + l8) = w;
  }
}
__device__ __forceinline__ void ph_gemm_merge(const P& p, int vb, int nvb, unsigned char* smem) {
  Epi3GateA ea{p.zG, p.b_gate, p.mrg};
  Epi3GateB eb{p.zG, p.b_gate, p.mrg};
  for (int round = 0;; ++round) {
    int tm, tn; const int r = xcd_tile(vb, nvb, round, NTOK / 256, DM / 128, tm, tn);
    if (r == 0) break;
    if (r == 1) {
      gemm_tile3(p.out_a, DM, p.Wt_aout, DM, DM, tm * 256, tn * 128, ea, smem);
      gemm_tile3(p.pooled, 512, p.Wt_eff, 512, 512, tm * 256, tn * 128, eb, smem);
    }
  }
}
__device__ __forceinline__ void ph_gemm_simple(const bf16_t* A, int lda, const bf16_t* Bt, int ldb, int K, int M, int N, bf16_t* C, int ldc, int vb, int nvb, unsigned char* smem) {
  Epi3StoreBf16 epi{C, ldc};
  for (int round = 0;; ++round) {
    int tm, tn; const int r = xcd_tile(vb, nvb, round, M / 256, N / 128, tm, tn);
    if (r == 0) break;
    if (r == 1) gemm_tile3(A, lda, Bt, ldb, K, tm * 256, tn * 128, epi, smem);
  }
}


#define O_R1 0
#define O_R2 10240
#define O_TA (O_R2 + 17408)
#define O_TR (O_TA + 4608)
#define O_TB (O_TR + 4608)
#define O_TK (O_TB + 4608)
#define O_TBT (O_TK + 4608)
#define O_TKT (O_TBT + 5120)
#define O_TVT (O_TKT + 5120)
#define O_GAM (O_TVT + 5120)
#define O_TST (O_GAM + 256)
#define RWKV_SMEM (O_TST + 2 * 9216)
#define NSUP 65
__device__ __forceinline__ void lds_wave_fence() { asm volatile("s_waitcnt lgkmcnt(0)" ::: "memory"); }
__device__ __forceinline__ u32x2 pack4(const f32x4& v) { u32x2 r; r.x = pack2(v[0], v[1]); r.y = pack2(v[2], v[3]); return r; }


typedef short s16x4 __attribute__((ext_vector_type(4)));
__device__ __forceinline__ float fast_tanh(float x) { const float e = __builtin_amdgcn_exp2f(2.885390082f * x); return 1.0f - 2.0f * __builtin_amdgcn_rcpf(e + 1.0f); }
template <int NS, bool WANTY>
__device__ __forceinline__ void rwkv_chunk(const P& p, unsigned char* smem, int d, int h, int rowbase, int T, int isc0, bool has_next, f32x4 (&st)[NS][4], u32x4 (&pf)[5]) {
  int tid = TIDX;
  asm volatile("" : "+v"(tid));
  const int lane = tid & 63, w = __builtin_amdgcn_readfirstlane(tid >> 6), l15 = lane & 15, q = lane >> 4;
  const int tt = tid >> 3, cg = tid & 7, ch0 = h * 64 + cg * 8;
  const int isc = isc0 + tt, t = d == 0 ? isc : T - 1 - isc;
  bf16_t* TWD = (bf16_t*)(smem + O_R1); bf16_t* TAD = TWD + 32 * 72;
  float* WT = (float*)(smem + O_R1);
  bf16_t* XT = (bf16_t*)(smem + O_R1); bf16_t* UT = XT + 64 * 40;
  float* LW = (float*)(smem + O_R2); float* LA = LW + 32 * 68;
  float* TL = (float*)(smem + O_R2);
  bf16_t* TT = (bf16_t*)(smem + O_R2 + 4608); bf16_t* TAK = TT + 32 * 40; bf16_t* TRB = TAK + 32 * 40; bf16_t* TRK = TRB + 32 * 40; bf16_t* TLB = TRK + 32 * 40;
  bf16_t* TA = (bf16_t*)(smem + O_TA); bf16_t* TR = (bf16_t*)(smem + O_TR); bf16_t* TB = (bf16_t*)(smem + O_TB); bf16_t* TK = (bf16_t*)(smem + O_TK);
  bf16_t* TBT = (bf16_t*)(smem + O_TBT); bf16_t* TKT = (bf16_t*)(smem + O_TKT); bf16_t* TVT = (bf16_t*)(smem + O_TVT);
  float* GAM = (float*)(smem + O_GAM);
  bf16_t* TST = (bf16_t*)(smem + O_TST);
  __syncthreads();
  float k8[8], r8[8];
  {
    u32x4 pk;
#pragma unroll
    for (int i = 0; i < 4; ++i) pk[i] = pack2(fast_tanh(bflo(pf[0][i])), fast_tanh(bfhi(pf[0][i])));
    *(u32x4*)(TWD + tt * 72 + cg * 8) = pk;
    *(u32x4*)(TAD + tt * 72 + cg * 8) = pf[1];
  }
#pragma unroll
  for (int i = 0; i < 4; ++i) { k8[2 * i] = bflo(pf[2][i]); k8[2 * i + 1] = bfhi(pf[2][i]); if (WANTY) { r8[2 * i] = bflo(pf[3][i]); r8[2 * i + 1] = bfhi(pf[3][i]); } }
  const u32x4 vzc = pf[4];
  __syncthreads();
  {
    f32x4 lw[2], la[2];
    bf16x8 w2f[2], a2f[2];
#pragma unroll
    for (int ks = 0; ks < 2; ++ks) {
      w2f[ks] = *(const bf16x8*)(p.w2T + ((size_t)d * 1024 + h * 64 + 16 * w + l15) * 64 + 32 * ks + 8 * q);
      a2f[ks] = *(const bf16x8*)(p.a2T + ((size_t)d * 1024 + h * 64 + 16 * w + l15) * 64 + 32 * ks + 8 * q);
    }
#pragma unroll
    for (int it = 0; it < 2; ++it) { lw[it] = (f32x4){0.f, 0.f, 0.f, 0.f}; la[it] = (f32x4){0.f, 0.f, 0.f, 0.f}; }
#pragma unroll
    for (int ks = 0; ks < 2; ++ks)
#pragma unroll
      for (int it = 0; it < 2; ++it) {
        const bf16x8 aw = *(const bf16x8*)(TWD + (16 * it + l15) * 72 + 32 * ks + 8 * q);
        const bf16x8 aa = *(const bf16x8*)(TAD + (16 * it + l15) * 72 + 32 * ks + 8 * q);
        lw[it] = __builtin_amdgcn_mfma_f32_16x16x32_bf16(aw, w2f[ks], lw[it], 0, 0, 0);
        la[it] = __builtin_amdgcn_mfma_f32_16x16x32_bf16(aa, a2f[ks], la[it], 0, 0, 0);
      }
    {
      const float cw0 = p.w0[d * 1024 + h * 64 + 16 * w + l15];
      float tot0 = 0.f;
#pragma unroll
      for (int it = 0; it < 2; ++it) {
        float pr[4];
#pragma unroll
        for (int rg = 0; rg < 4; ++rg) {
          const float e = 0.87505707f * sigmoidf_(cw0 + lw[it][rg]);
          pr[rg] = rg == 0 ? e : pr[rg - 1] + e;
        }
        float x = pr[3];
        float y = __shfl_up(x, 16); if (q >= 1) x += y;
        y = __shfl_up(x, 32); if (q >= 2) x += y;
        const float base = (x - pr[3]) + (it == 1 ? tot0 : 0.f);
        if (it == 0) tot0 = __shfl(x, 48 + l15);
#pragma unroll
        for (int rg = 0; rg < 4; ++rg) lw[it][rg] = pr[rg] + base;
      }
      if (q == 3) GAM[16 * w + l15] = __builtin_amdgcn_exp2f(-lw[1][3]);
    }
#pragma unroll
    for (int it = 0; it < 2; ++it)
#pragma unroll
      for (int rg = 0; rg < 4; ++rg) { LW[(16 * it + 4 * q + rg) * 68 + 16 * w + l15] = lw[it][rg]; LA[(16 * it + 4 * q + rg) * 68 + 16 * w + l15] = la[it][rg]; }
  }
  __syncthreads();
  float icl[8], kkn[8], kd[8];
  {
    float ss = 0.f, bd = 0.f;
    float ca0[8], ckk[8], cka[8], crk[8];
#pragma unroll
    for (int e4 = 0; e4 < 8; e4 += 4) {
      const f32x4 b2 = *(const f32x4*)(p.a0 + d * 1024 + ch0 + e4), c2 = *(const f32x4*)(p.k_k + ch0 + e4);
      const f32x4 d2 = *(const f32x4*)(p.k_a + ch0 + e4), f2 = *(const f32x4*)(p.r_k + ch0 + e4);
#pragma unroll
      for (int e = 0; e < 4; ++e) { ca0[e4 + e] = b2[e]; ckk[e4 + e] = c2[e]; cka[e4 + e] = d2[e]; crk[e4 + e] = f2[e]; }
    }
    float lav[8];
    { const f32x4 l0 = *(const f32x4*)(LA + tt * 68 + cg * 8), l1 = *(const f32x4*)(LA + tt * 68 + cg * 8 + 4);
#pragma unroll
      for (int e = 0; e < 4; ++e) { lav[e] = l0[e]; lav[4 + e] = l1[e]; } }
#pragma unroll
    for (int e = 0; e < 8; ++e) {
      icl[e] = sigmoidf_(ca0[e] + lav[e]);
      kkn[e] = k8[e] * ckk[e]; ss += kkn[e] * kkn[e];
      kd[e] = k8[e] * (1.f + (icl[e] - 1.f) * cka[e]);
      if (WANTY) bd += r8[e] * kd[e] * crk[e];
    }
    ss = red8(ss); if (WANTY) bd = red8(bd);
    const float rn = rsqrtf(fmaxf(ss, 1e-24f));
#pragma unroll
    for (int e = 0; e < 8; ++e) kkn[e] *= rn;
    if (WANTY && cg == 0) p.bdot[((size_t)d * NTOK + rowbase + t) * 16 + h] = bd;
  }
  {
    float ta[8], tr[8], tb[8], tk[8], v8[8];
#pragma unroll
    for (int i = 0; i < 4; ++i) { v8[2 * i] = bflo(vzc[i]); v8[2 * i + 1] = bfhi(vzc[i]); }
    float Lv[8], Lpv[8];
    {
      const f32x4 a0 = *(const f32x4*)(LW + tt * 68 + cg * 8), a1 = *(const f32x4*)(LW + tt * 68 + cg * 8 + 4);
      const int tp = tt > 0 ? tt - 1 : 0;
      const f32x4 b0 = *(const f32x4*)(LW + tp * 68 + cg * 8), b1 = *(const f32x4*)(LW + tp * 68 + cg * 8 + 4);
#pragma unroll
      for (int e = 0; e < 4; ++e) { Lv[e] = a0[e]; Lv[4 + e] = a1[e]; Lpv[e] = tt > 0 ? b0[e] : 0.f; Lpv[4 + e] = tt > 0 ? b1[e] : 0.f; }
    }
#pragma unroll
    for (int e = 0; e < 8; ++e) {
      const float Li = Lv[e];
      const float Lp = Lpv[e];
      const float gi = __builtin_amdgcn_exp2f(-Li), gim1 = __builtin_amdgcn_exp2f(-Lp), ginv = __builtin_amdgcn_exp2f(Li);
      ta[e] = -kkn[e] * gim1; if (WANTY) tr[e] = r8[e] * gi; tb[e] = kkn[e] * icl[e] * ginv; tk[e] = kd[e] * ginv;
    }
    u32x4 pk;
    pk.x = pack2(ta[0], ta[1]); pk.y = pack2(ta[2], ta[3]); pk.z = pack2(ta[4], ta[5]); pk.w = pack2(ta[6], ta[7]); *(u32x4*)(TA + tt * 72 + cg * 8) = pk;
    if (WANTY) { pk.x = pack2(tr[0], tr[1]); pk.y = pack2(tr[2], tr[3]); pk.z = pack2(tr[4], tr[5]); pk.w = pack2(tr[6], tr[7]); *(u32x4*)(TR + tt * 72 + cg * 8) = pk; }
    pk.x = pack2(tb[0], tb[1]); pk.y = pack2(tb[2], tb[3]); pk.z = pack2(tb[4], tb[5]); pk.w = pack2(tb[6], tb[7]); *(u32x4*)(TB + tt * 72 + cg * 8) = pk;
    pk.x = pack2(tk[0], tk[1]); pk.y = pack2(tk[2], tk[3]); pk.z = pack2(tk[4], tk[5]); pk.w = pack2(tk[6], tk[7]); *(u32x4*)(TK + tt * 72 + cg * 8) = pk;
#pragma unroll
    for (int e = 0; e < 8; ++e) { TBT[(cg * 8 + e) * 40 + tt] = f2bf(tb[e]); TKT[(cg * 8 + e) * 40 + tt] = f2bf(tk[e]); TVT[(cg * 8 + e) * 40 + tt] = f2bf(v8[e]); }
  }
  __syncthreads();
  if (WANTY || w < 2) {
    const bf16_t* X = (w < 2) ? TA : TR; const bf16_t* Y = (w & 1) ? TK : TB;
    f32x4 g[2][2];
#pragma unroll
    for (int it = 0; it < 2; ++it)
#pragma unroll
      for (int s2 = 0; s2 < 2; ++s2) g[it][s2] = (f32x4){0.f, 0.f, 0.f, 0.f};
#pragma unroll
    for (int ks = 0; ks < 2; ++ks) {
      bf16x8 xa[2], yb[2];
#pragma unroll
      for (int it = 0; it < 2; ++it) { xa[it] = *(const bf16x8*)(X + (16 * it + l15) * 72 + 32 * ks + 8 * q); yb[it] = *(const bf16x8*)(Y + (16 * it + l15) * 72 + 32 * ks + 8 * q); }
#pragma unroll
      for (int it = 0; it < 2; ++it)
#pragma unroll
        for (int s2 = 0; s2 < 2; ++s2) g[it][s2] = __builtin_amdgcn_mfma_f32_16x16x32_bf16(xa[it], yb[s2], g[it][s2], 0, 0, 0);
    }
    if (w == 0) {
#pragma unroll
      for (int it = 0; it < 2; ++it)
#pragma unroll
        for (int s2 = 0; s2 < 2; ++s2)
#pragma unroll
          for (int rg = 0; rg < 4; ++rg) {
            const int i = 16 * it + 4 * q + rg, s = 16 * s2 + l15;
            TL[i * 36 + s] = (s < i) ? g[it][s2][rg] : 0.f;
          }
#pragma unroll
      for (int rg = 0; rg < 4; ++rg) TLB[(4 * q + rg) * 40 + l15] = f2bf(g[1][0][rg]);
    } else {
      bf16_t* dst = w == 1 ? TAK : (w == 2 ? TRB : TRK);
      const int incl = w == 1 ? 0 : 1;
#pragma unroll
      for (int it = 0; it < 2; ++it)
#pragma unroll
        for (int s2 = 0; s2 < 2; ++s2)
#pragma unroll
          for (int rg = 0; rg < 4; ++rg) {
            const int i = 16 * it + 4 * q + rg, s = 16 * s2 + l15;
            dst[i * 40 + s] = f2bf((s < i + incl) ? g[it][s2][rg] : 0.f);
          }
    }
  }
  if (w == 0) {
    lds_wave_fence();
    const int c = lane & 15, hb = lane & 16;
    float Tr[16];
    f32x4 Lr[16][4];
#pragma unroll
    for (int i = 1; i < 16; ++i)
#pragma unroll
      for (int j4 = 0; j4 < (i + 3) / 4; ++j4) Lr[i][j4] = *(const f32x4*)(TL + (hb + i) * 36 + hb + 4 * j4);
#pragma unroll
    for (int i = 0; i < 16; ++i) {
      float acc = (i == c) ? 1.f : 0.f;
#pragma unroll
      for (int j = 0; j < i; ++j) acc += Lr[i][j >> 2][j & 3] * Tr[j];
      Tr[i] = acc;
    }
    if (lane < 32) {
#pragma unroll
      for (int i = 0; i < 16; ++i) TT[(hb + i) * 40 + hb + c] = f2bf(Tr[i]);
    }
  }
  __syncthreads();
  if (has_next) {
    const int isn = isc + 32, tn = d == 0 ? isn : T - 1 - isn;
    const bf16_t* zr = p.zA + (size_t)(rowbase + tn) * SHIFTC;
    pf[0] = *(const u32x4*)(zr + 3072 + d * 64 + cg * 8);
    pf[1] = *(const u32x4*)(zr + 3200 + d * 64 + cg * 8);
    pf[2] = *(const u32x4*)(zr + 1024 + ch0);
    if (WANTY) pf[3] = *(const u32x4*)(zr + ch0);
    pf[4] = *(const u32x4*)(zr + 2048 + ch0);
  }
  const bf16x8 vfr = *(const bf16x8*)(TVT + (16 * w + l15) * 40 + 8 * q);
  const s16x4 t1f = *(const s16x4*)(TT + l15 * 40 + 4 * q), t2f = *(const s16x4*)(TT + (16 + l15) * 40 + 16 + 4 * q), l21f = *(const s16x4*)(TLB + l15 * 40 + 4 * q);
  bf16_t* XTw = XT + (16 * w + l15) * 40; bf16_t* UTw = UT + (16 * w + l15) * 40;
#pragma unroll
  for (int si = 0; si < NS; ++si) {
    const bool useV = (NS == 1) || (si == 1);
    const bf16_t* STs = TST + (si * 64 + 16 * w + l15) * 72;
    bf16x8 sf[2];
    sf[0] = *(const bf16x8*)(STs + 8 * q); sf[1] = *(const bf16x8*)(STs + 32 + 8 * q);
    f32x4 xa[2];
#pragma unroll
    for (int it = 0; it < 2; ++it) {
      xa[it] = (f32x4){0.f, 0.f, 0.f, 0.f};
#pragma unroll
      for (int ks = 0; ks < 2; ++ks) xa[it] = __builtin_amdgcn_mfma_f32_16x16x32_bf16(*(const bf16x8*)(TA + (16 * it + l15) * 72 + 32 * ks + 8 * q), sf[ks], xa[it], 0, 0, 0);
      if (useV) xa[it] = __builtin_amdgcn_mfma_f32_16x16x32_bf16(*(const bf16x8*)(TAK + (16 * it + l15) * 40 + 8 * q), vfr, xa[it], 0, 0, 0);
    }
    *(u32x2*)(XTw + 4 * q) = pack4(xa[0]);
    lds_wave_fence();
    f32x4 ua = __builtin_amdgcn_mfma_f32_16x16x16bf16_1k(t1f, *(const s16x4*)(XTw + 4 * q), (f32x4){0.f, 0.f, 0.f, 0.f}, 0, 0, 0);
    *(u32x2*)(UTw + 4 * q) = pack4(ua);
    lds_wave_fence();
    xa[1] = __builtin_amdgcn_mfma_f32_16x16x16bf16_1k(l21f, *(const s16x4*)(UTw + 4 * q), xa[1], 0, 0, 0);
    *(u32x2*)(XTw + 16 + 4 * q) = pack4(xa[1]);
    lds_wave_fence();
    ua = __builtin_amdgcn_mfma_f32_16x16x16bf16_1k(t2f, *(const s16x4*)(XTw + 16 + 4 * q), (f32x4){0.f, 0.f, 0.f, 0.f}, 0, 0, 0);
    *(u32x2*)(UTw + 16 + 4 * q) = pack4(ua);
    lds_wave_fence();
    const bf16x8 uf = *(const bf16x8*)(UTw + 8 * q);
    if (WANTY) {
#pragma unroll
      for (int it = 0; it < 2; ++it) {
        f32x4 ya = (f32x4){0.f, 0.f, 0.f, 0.f};
#pragma unroll
        for (int ks = 0; ks < 2; ++ks) ya = __builtin_amdgcn_mfma_f32_16x16x32_bf16(*(const bf16x8*)(TR + (16 * it + l15) * 72 + 32 * ks + 8 * q), sf[ks], ya, 0, 0, 0);
        ya = __builtin_amdgcn_mfma_f32_16x16x32_bf16(*(const bf16x8*)(TRB + (16 * it + l15) * 40 + 8 * q), uf, ya, 0, 0, 0);
        ya = __builtin_amdgcn_mfma_f32_16x16x32_bf16(*(const bf16x8*)(TRK + (16 * it + l15) * 40 + 8 * q), vfr, ya, 0, 0, 0);
        bf16_t* Yd = d == 0 ? p.Y0 : p.Y1;
#pragma unroll
        for (int rg = 0; rg < 4; ++rg) {
          const int iq = isc0 + 16 * it + 4 * q + rg, tq = d == 0 ? iq : T - 1 - iq;
          Yd[(size_t)(rowbase + tq) * DM + h * 64 + 16 * w + l15] = f2bf(ya[rg]);
        }
      }
    }
#pragma unroll
    for (int kt = 0; kt < 4; ++kt) {
      f32x4 hv = st[si][kt];
      hv = __builtin_amdgcn_mfma_f32_16x16x32_bf16(*(const bf16x8*)(TBT + (16 * kt + l15) * 40 + 8 * q), uf, hv, 0, 0, 0);
      if (useV) hv = __builtin_amdgcn_mfma_f32_16x16x32_bf16(*(const bf16x8*)(TKT + (16 * kt + l15) * 40 + 8 * q), vfr, hv, 0, 0, 0);
      hv *= *(const f32x4*)(GAM + 16 * kt + 4 * q);
      st[si][kt] = hv;
      *(u32x2*)(TST + (si * 64 + 16 * w + l15) * 72 + 16 * kt + 4 * q) = pack4(hv);
    }
  }
}

template <bool WANTY>
__device__ __forceinline__ void rwkv_prefetch_first(const P& p, int d, int h, int rowbase, int T, int isc0, u32x4 (&pf)[5]) {
  const int tid = TIDX, tt = tid >> 3, cg = tid & 7, ch0 = h * 64 + cg * 8, isc = isc0 + tt, t = d == 0 ? isc : T - 1 - isc;
  const bf16_t* zr = p.zA + (size_t)(rowbase + t) * SHIFTC;
  pf[0] = *(const u32x4*)(zr + 3072 + d * 64 + cg * 8);
  pf[1] = *(const u32x4*)(zr + 3200 + d * 64 + cg * 8);
  pf[2] = *(const u32x4*)(zr + 1024 + ch0);
  pf[3] = WANTY ? *(const u32x4*)(zr + ch0) : (u32x4){0u, 0u, 0u, 0u};
  pf[4] = *(const u32x4*)(zr + 2048 + ch0);
}
__device__ __forceinline__ void ph_rwkv_A(const P& p, int vb, int nvb, unsigned char* smem) {
  const int tid = TIDX, lane = tid & 63, w = tid >> 6, l15 = lane & 15, q = lane >> 4;
  bf16_t* TST = (bf16_t*)(smem + O_TST);
  for (int item = vb; item < 64 * 64; item += nvb) {
    const int chain = item >> 6, j = item & 63, b = chain >> 5, d = (chain >> 4) & 1, h = chain & 15;
    const bool latent = j > 0;
    const int T = latent ? SEQ : CTXL, rowbase = latent ? b * SEQ : NTOK + b * CTXL, base = latent ? (j - 1) * 256 : 0;
    f32x4 st[2][4];
    __syncthreads();
#pragma unroll
    for (int kt = 0; kt < 4; ++kt) {
#pragma unroll
      for (int rg = 0; rg < 4; ++rg) st[0][kt][rg] = (16 * kt + 4 * q + rg == 16 * w + l15) ? 1.f : 0.f;
      st[1][kt] = (f32x4){0.f, 0.f, 0.f, 0.f};
      *(u32x2*)(TST + (16 * w + l15) * 72 + 16 * kt + 4 * q) = pack4(st[0][kt]);
      *(u32x2*)(TST + (64 + 16 * w + l15) * 72 + 16 * kt + 4 * q) = pack4(st[1][kt]);
    }
    u32x4 pf[5]; rwkv_prefetch_first<false>(p, d, h, rowbase, T, base, pf);
    for (int c = 0; c < 8; ++c) rwkv_chunk<2, false>(p, smem, d, h, rowbase, T, base + 32 * c, c < 7, st, pf);
    const size_t slot = (size_t)chain * NSUP + j;
#pragma unroll
    for (int kt = 0; kt < 4; ++kt) {
#pragma unroll
      for (int rg = 0; rg < 4; ++rg) p.Mst[(slot * 64 + 16 * kt + 4 * q + rg) * 64 + 16 * w + l15] = f2bf(st[0][kt][rg]);
      *(f32x4*)(p.Nst + (slot * 64 + 16 * w + l15) * 64 + 16 * kt + 4 * q) = st[1][kt];
    }
  }
}
__device__ __forceinline__ void ph_rwkv_B(const P& p, int vb, int nvb, unsigned char* smem) {
  const int tid = TIDX, lane = tid & 63, w = tid >> 6, l15 = lane & 15, q = lane >> 4;
  bf16_t* HT = (bf16_t*)smem;
  for (int chain = vb; chain < 64; chain += nvb) {
    f32x4 hs[4];
#pragma unroll
    for (int kt = 0; kt < 4; ++kt) hs[kt] = (f32x4){0.f, 0.f, 0.f, 0.f};
    __syncthreads();
    for (int j = 0; j < 64; ++j) {
      const size_t slot = (size_t)chain * NSUP + j;
      f32x4 nv[4];
#pragma unroll
      for (int kt = 0; kt < 4; ++kt) nv[kt] = *(const f32x4*)(p.Nst + (slot * 64 + 16 * w + l15) * 64 + 16 * kt + 4 * q);
      bf16x8 mf[4][2];
#pragma unroll
      for (int kt = 0; kt < 4; ++kt)
#pragma unroll
        for (int ks = 0; ks < 2; ++ks) mf[kt][ks] = *(const bf16x8*)(p.Mst + (slot * 64 + 16 * kt + l15) * 64 + 32 * ks + 8 * q);
#pragma unroll
      for (int kt = 0; kt < 4; ++kt) {
        *(f32x4*)(p.Nst + (slot * 64 + 16 * w + l15) * 64 + 16 * kt + 4 * q) = hs[kt];
        *(u32x2*)(HT + (16 * w + l15) * 72 + 16 * kt + 4 * q) = pack4(hs[kt]);
      }
      lds_wave_fence();
      bf16x8 hf[2];
      hf[0] = *(const bf16x8*)(HT + (16 * w + l15) * 72 + 8 * q); hf[1] = *(const bf16x8*)(HT + (16 * w + l15) * 72 + 32 + 8 * q);
      lds_wave_fence();
#pragma unroll
      for (int kt = 0; kt < 4; ++kt) {
        f32x4 a = nv[kt];
#pragma unroll
        for (int ks = 0; ks < 2; ++ks) a = __builtin_amdgcn_mfma_f32_16x16x32_bf16(mf[kt][ks], hf[ks], a, 0, 0, 0);
        hs[kt] = a;
      }
    }
    const size_t slot = (size_t)chain * NSUP + 64;
#pragma unroll
    for (int kt = 0; kt < 4; ++kt) *(f32x4*)(p.Nst + (slot * 64 + 16 * w + l15) * 64 + 16 * kt + 4 * q) = hs[kt];
  }
}
__device__ __forceinline__ void ph_rwkv_C(const P& p, int vb, int nvb, unsigned char* smem) {
  const int tid = TIDX, lane = tid & 63, w = tid >> 6, l15 = lane & 15, q = lane >> 4;
  bf16_t* TST = (bf16_t*)(smem + O_TST);
  for (int item = vb; item < 64 * 64; item += nvb) {
    const int chain = item >> 6, j = (item & 63) + 1, b = chain >> 5, d = (chain >> 4) & 1, h = chain & 15;
    f32x4 st[1][4];
    const size_t slot = (size_t)chain * NSUP + j;
    __syncthreads();
#pragma unroll
    for (int kt = 0; kt < 4; ++kt) {
      st[0][kt] = *(const f32x4*)(p.Nst + (slot * 64 + 16 * w + l15) * 64 + 16 * kt + 4 * q);
      *(u32x2*)(TST + (16 * w + l15) * 72 + 16 * kt + 4 * q) = pack4(st[0][kt]);
    }
    u32x4 pf[5]; rwkv_prefetch_first<true>(p, d, h, b * SEQ, SEQ, (j - 1) * 256, pf);
    for (int c = 0; c < 8; ++c) rwkv_chunk<1, true>(p, smem, d, h, b * SEQ, SEQ, (j - 1) * 256 + 32 * c, c < 7, st, pf);
  }
}

#define POOL_SMEM (64 * 128 * 4)
__device__ __forceinline__ void ph_pool(const P& p, int vb, int nvb, unsigned char* smem) {
  float* V = (float*)smem;
  const int tid = TIDX, cp = tid & 63, cq = tid >> 6;
  for (int item = vb; item < 2 * 4 * 64; item += nvb) {
    const int j = item & 3, st = (item >> 2) & 63, b = item >> 8;
    const int win = 2 << j, half = win >> 1;
    const bf16_t* zb = p.zP + (size_t)b * SEQ * 512 + j * 128 + cp * 2;
    float a0[16], a1[16];
#pragma unroll
    for (int i = 0; i < 16; ++i) { a0[i] = 0.f; a1[i] = 0.f; }
    {
      const int r = 4 * st, r0 = max(r - half, 0), r1 = min(r + half, 256);
      for (int rr = r0; rr < r1; ++rr) {
#pragma unroll
        for (int i = 0; i < 16; ++i) { const unsigned u = *(const unsigned*)(zb + (size_t)(rr * 64 + cq * 16 + i) * 512); a0[i] += bflo(u); a1[i] += bfhi(u); }
      }
    }
    for (int dr = 0; dr < 4; ++dr) {
      const int r = 4 * st + dr, r0 = max(r - half, 0), r1 = min(r + half, 256);
      if (dr > 0) {
        const int radd = r + half - 1, rsub = r - half - 1;
        if (radd < 256) {
#pragma unroll
          for (int i = 0; i < 16; ++i) { const unsigned u = *(const unsigned*)(zb + (size_t)(radd * 64 + cq * 16 + i) * 512); a0[i] += bflo(u); a1[i] += bfhi(u); }
        }
        if (rsub >= 0) {
#pragma unroll
          for (int i = 0; i < 16; ++i) { const unsigned u = *(const unsigned*)(zb + (size_t)(rsub * 64 + cq * 16 + i) * 512); a0[i] -= bflo(u); a1[i] -= bfhi(u); }
        }
      }
      __syncthreads();
#pragma unroll
      for (int i = 0; i < 16; ++i) *(f32x2*)(V + (cq * 16 + i) * 128 + cp * 2) = (f32x2){a0[i], a1[i]};
      __syncthreads();
      float s0 = 0.f, s1 = 0.f;
      {
        const int c = cq * 16, c0 = max(c - half, 0), c1 = min(c + half, 64);
        for (int cc = c0; cc < c1; ++cc) { const f32x2 v = *(const f32x2*)(V + cc * 128 + cp * 2); s0 += v.x; s1 += v.y; }
      }
#pragma unroll
      for (int i = 0; i < 16; ++i) {
        const int c = cq * 16 + i, c0 = max(c - half, 0), c1 = min(c + half, 64);
        if (i > 0) {
          const int cadd = c + half - 1, csub = c - half - 1;
          if (cadd < 64) { const f32x2 v = *(const f32x2*)(V + cadd * 128 + cp * 2); s0 += v.x; s1 += v.y; }
          if (csub >= 0) { const f32x2 v = *(const f32x2*)(V + csub * 128 + cp * 2); s0 -= v.x; s1 -= v.y; }
        }
        const float inv = __builtin_amdgcn_rcpf((float)((r1 - r0) * (c1 - c0)));
        const size_t tokoff = ((size_t)b * SEQ + r * 64 + c) * 512 + j * 128 + cp * 2;
        const unsigned u = *(const unsigned*)(p.zP + tokoff);
        *(unsigned*)(p.pooled + tokoff) = pack2(s0 * inv - bflo(u), s1 * inv - bfhi(u));
      }
    }
  }
}
__device__ __forceinline__ void ph_res1(const P& p, int vb, int nvb) {
  const int lane = TIDX & 63, wid = TIDX >> 6;
  for (int m = vb * 4 + wid; m < NTOK; m += nvb * 4) {
    const float* md = p.mod + (m / SEQ) * 6144;
    float mx[16]; float ss = 0.f;
#pragma unroll
    for (int i = 0; i < 4; ++i) {
      const uint2 u = *(const uint2*)(p.mix + (size_t)m * DM + i * 256 + lane * 4);
      mx[4 * i] = bflo(u.x); mx[4 * i + 1] = bfhi(u.x); mx[4 * i + 2] = bflo(u.y); mx[4 * i + 3] = bfhi(u.y);
#pragma unroll
      for (int e = 0; e < 4; ++e) ss += mx[4 * i + e] * mx[4 * i + e];
    }
    ss = wave_sum(ss);
    const float rstd = rsqrtf(ss * (1.0f / 1024.0f) + 1e-6f);
    float x1[16]; float s2 = 0.f;
#pragma unroll
    for (int i = 0; i < 4; ++i) {
      const int col = i * 256 + lane * 4;
      const float4 xv = *(const float4*)(p.x + (size_t)m * DM + col), g = *(const float4*)(p.g_post_mix + col), gt = *(const float4*)(md + 2048 + col);
      x1[4 * i] = xv.x + gt.x * mx[4 * i] * rstd * g.x; x1[4 * i + 1] = xv.y + gt.y * mx[4 * i + 1] * rstd * g.y;
      x1[4 * i + 2] = xv.z + gt.z * mx[4 * i + 2] * rstd * g.z; x1[4 * i + 3] = xv.w + gt.w * mx[4 * i + 3] * rstd * g.w;
      *(float4*)(p.out + (size_t)m * DM + col) = make_float4(x1[4 * i], x1[4 * i + 1], x1[4 * i + 2], x1[4 * i + 3]);
#pragma unroll
      for (int e = 0; e < 4; ++e) s2 += x1[4 * i + e] * x1[4 * i + e];
    }
    s2 = wave_sum(s2);
    const float r2 = rsqrtf(s2 * (1.0f / 1024.0f) + 1e-6f);
#pragma unroll
    for (int i = 0; i < 4; ++i) {
      const int col = i * 256 + lane * 4;
      const float4 g = *(const float4*)(p.g_pre_ffn + col), sh = *(const float4*)(md + 3072 + col), sc = *(const float4*)(md + 4096 + col);
      uint2 w;
      w.x = pack2(x1[4 * i] * r2 * g.x * (1.f + sc.x) + sh.x, x1[4 * i + 1] * r2 * g.y * (1.f + sc.y) + sh.y);
      w.y = pack2(x1[4 * i + 2] * r2 * g.z * (1.f + sc.z) + sh.z, x1[4 * i + 3] * r2 * g.w * (1.f + sc.w) + sh.w);
      *(uint2*)(p.hx2 + (size_t)m * DM + col) = w;
    }
  }
}

#define PS1_SMEM (128 * 133 * 4)
#define CE_DESC(a, b) { const float _mx = fmaxf(a, b), _mn = fminf(a, b); a = _mx; b = _mn; }
template <int N> __device__ __forceinline__ void bitonic_sort_desc(float (&v)[N]) {
#pragma unroll
  for (int k = 2; k <= N; k <<= 1)
#pragma unroll
    for (int j = k >> 1; j > 0; j >>= 1)
#pragma unroll
      for (int i = 0; i < N; ++i) { const int l = i ^ j; if (l > i) { if ((i & k) == 0) CE_DESC(v[i], v[l]) else CE_DESC(v[l], v[i]) } }
}
__device__ __forceinline__ void bitonic_merge16_desc(float (&v)[16]) {
#pragma unroll
  for (int j = 8; j > 0; j >>= 1)
#pragma unroll
    for (int i = 0; i < 16; ++i) { const int l = i ^ j; if (l > i) CE_DESC(v[i], v[l]) }
}
__device__ __forceinline__ void ph_peer_s1(const P& p, int vb, int nvb, unsigned char* smem) {
  float* S = (float*)smem;
  EpiLds epi{S};
  const int tid = TIDX, sub = tid & 3;
  for (int item = vb; item < 256 * 16; item += nvb) {
    const int hp = item & 15, tm = item >> 4;
    __syncthreads();
    gemm_tile(p.q + hp * 128, 2048, p.keys + (size_t)hp * 128 * 128, 128, 128, tm * 128, 0, epi, smem);
    __syncthreads();
#pragma unroll 1
    for (int pass = 0; pass < 2; ++pass) {
      const int row = pass * 64 + (tid >> 2);
      float a[16], b[16];
#pragma unroll
      for (int i = 0; i < 16; ++i) {
        a[i] = __uint_as_float((__float_as_uint(S[row * 133 + sub * 33 + i]) & ~127u) | (unsigned)(sub * 32 + i));
        b[i] = __uint_as_float((__float_as_uint(S[row * 133 + sub * 33 + 16 + i]) & ~127u) | (unsigned)(sub * 32 + 16 + i));
      }
      bitonic_sort_desc<16>(a); bitonic_sort_desc<16>(b);
#pragma unroll
      for (int i = 0; i < 16; ++i) a[i] = fmaxf(a[i], b[15 - i]);
      bitonic_merge16_desc(a);
#pragma unroll
      for (int lvl = 1; lvl <= 2; lvl <<= 1) {
#pragma unroll
        for (int i = 0; i < 16; ++i) b[i] = __shfl_xor(a[i], lvl);
#pragma unroll
        for (int i = 0; i < 16; ++i) a[i] = fmaxf(a[i], b[15 - i]);
        bitonic_merge16_desc(a);
      }
      if (sub == 0) {
        const size_t ob = ((size_t)(tm * 128 + row) * 16 + hp) * 16;
#pragma unroll
        for (int i = 0; i < 16; i += 4) {
          *(f32x4*)(p.sv + ob + i) = (f32x4){a[i], a[i + 1], a[i + 2], a[i + 3]};
          typedef int i32x4 __attribute__((ext_vector_type(4)));
          *(i32x4*)(p.si + ob + i) = (i32x4){(int)(__float_as_uint(a[i]) & 127u), (int)(__float_as_uint(a[i + 1]) & 127u), (int)(__float_as_uint(a[i + 2]) & 127u), (int)(__float_as_uint(a[i + 3]) & 127u)};
        }
      }
    }
  }
}
__device__ __forceinline__ void top16_merge(float (&x)[16], const float (&y)[16]) {
#pragma unroll
  for (int i = 0; i < 16; ++i) x[i] = fmaxf(x[i], y[15 - i]);
  bitonic_merge16_desc(x);
}
__device__ __forceinline__ void ph_peer_s2(const P& p, int vb, int nvb, unsigned char* smem) {
  unsigned char* lut = smem;
  __syncthreads();
  if (TIDX == 0) {
    int n = 0;
#pragma unroll
    for (int i = 0; i < 16; ++i)
#pragma unroll
      for (int j = 0; j < 16; ++j)
        if ((i + 1) * (j + 1) <= 16) { lut[n] = (unsigned char)((i << 4) | j); ++n; }
  }
  __syncthreads();
  for (int it = vb * 256 + TIDX; it < NTOK * 8; it += nvb * 256) {
    const size_t ob = (size_t)it * 32;
    float a[16], bq[16];
#pragma unroll
    for (int i = 0; i < 16; i += 4) {
      const f32x4 fa = *(const f32x4*)(p.sv + ob + i), fb = *(const f32x4*)(p.sv + ob + 16 + i);
#pragma unroll
      for (int e = 0; e < 4; ++e) { a[i + e] = fa[e]; bq[i + e] = fb[e]; }
    }
    float g0[16], g1[16], g2[16], g3[16];
    {
      int n = 0;
#pragma unroll
      for (int i = 0; i < 16; ++i)
#pragma unroll
        for (int j = 0; j < 16; ++j)
          if ((i + 1) * (j + 1) <= 16) {
            const float v = __uint_as_float((__float_as_uint(a[i] + bq[j]) & ~63u) | (unsigned)n);
            if (n < 16) g0[n] = v; else if (n < 32) g1[n - 16] = v; else if (n < 48) g2[n - 32] = v; else g3[n - 48] = v;
            ++n;
          }
#pragma unroll
      for (int k = 2; k < 16; ++k) g3[k] = -3.0e38f;
    }
    bitonic_sort_desc<16>(g0); bitonic_sort_desc<16>(g1); bitonic_sort_desc<16>(g2); bitonic_sort_desc<16>(g3);
    top16_merge(g0, g1); top16_merge(g2, g3); top16_merge(g0, g2);
    float den = 0.f; float ex[16]; int seli[16];
#pragma unroll
    for (int k = 0; k < 16; ++k) {
      ex[k] = __expf(g0[k] - g0[0]); den += ex[k];
      const int ij = lut[__float_as_uint(g0[k]) & 63u];
      const int ka = (int)(__float_as_uint(p.sv[ob + (ij >> 4)]) & 127u), kb = (int)(__float_as_uint(p.sv[ob + 16 + (ij & 15)]) & 127u);
      seli[k] = ka * 128 + kb;
    }
    const float inv = 1.0f / den;
    const size_t o2 = (size_t)it * 16;
    typedef int i32x4 __attribute__((ext_vector_type(4)));
#pragma unroll
    for (int k = 0; k < 16; k += 4) {
      *(i32x4*)(p.pidx + o2 + k) = (i32x4){seli[k], seli[k + 1], seli[k + 2], seli[k + 3]};
      *(f32x4*)(p.pgate + o2 + k) = (f32x4){ex[k] * inv, ex[k + 1] * inv, ex[k + 2] * inv, ex[k + 3] * inv};
    }
  }
}
typedef float f32x16 __attribute__((ext_vector_type(16)));
typedef float f32x32 __attribute__((ext_vector_type(32)));
typedef unsigned u32x6 __attribute__((ext_vector_type(6)));
__device__ __forceinline__ float gelu_as(float v) {
  const float t = __builtin_amdgcn_rcpf(fabsf(v) * 0.2316418882f + 1.0f);
  float qq = t * 0.5307027145f + (-0.7265760135f); qq = qq * t + 0.7107068705f; qq = qq * t + (-0.142248368f); qq = qq * t + 0.127414796f; qq = qq * t;
  const float m = v * (qq * __builtin_amdgcn_exp2f((v * v) * (-0.72134752044f)));
  return v < 0.f ? m : v - m;
}
__device__ __forceinline__ float half_max(float v) {
#pragma unroll
  for (int o = 16; o > 0; o >>= 1) v = fmaxf(v, __shfl_xor(v, o));
  return v;
}
__device__ __forceinline__ float half_sum(float v) {
#pragma unroll
  for (int o = 16; o > 0; o >>= 1) v += __shfl_xor(v, o);
  return v;
}
__device__ __forceinline__ void ph_cvt_fp6(const float* __restrict__ in, unsigned char* __restrict__ out, float* __restrict__ inv_scale, int vb, int nvb) {
  const int lane = TIDX & 63, wid = TIDX >> 6, hf = lane >> 5, sl = lane & 31;
  for (int rp = vb * 4 + wid; rp < 8192; rp += nvb * 4) {
    const int row = rp * 2 + hf;
    f32x16 a, b2; float am = 0.f;
#pragma unroll
    for (int i = 0; i < 4; ++i) {
      const f32x4 v0 = *(const f32x4*)(in + (size_t)row * DM + sl * 32 + 4 * i), v1 = *(const f32x4*)(in + (size_t)row * DM + sl * 32 + 16 + 4 * i);
#pragma unroll
      for (int e = 0; e < 4; ++e) { a[4 * i + e] = v0[e]; b2[4 * i + e] = v1[e]; am = fmaxf(am, fmaxf(fabsf(v0[e]), fabsf(v1[e]))); }
    }
    am = half_max(am);
    const float sc = am > 0.f ? 7.0f / am : 1.0f;
    const u32x6 pk = __builtin_amdgcn_cvt_scalef32_2xpk16_fp6_f32(a * sc, b2 * sc, 1.0f);
    unsigned char* o = out + (size_t)row * 768 + sl * 24;
    *(u32x2*)(o) = (u32x2){pk[0], pk[1]}; *(u32x2*)(o + 8) = (u32x2){pk[2], pk[3]}; *(u32x2*)(o + 16) = (u32x2){pk[4], pk[5]};
    if (sl == 0) inv_scale[row] = am > 0.f ? am / 7.0f : 1.0f;
  }
}
__device__ __forceinline__ u32x6 load_row6(const unsigned char* base, int id, int sl) {
  const unsigned char* q = base + (size_t)id * 768 + sl * 24;
  const u32x2 a = *(const u32x2*)q, b = *(const u32x2*)(q + 8), c = *(const u32x2*)(q + 16);
  return (u32x6){a.x, a.y, b.x, b.y, c.x, c.y};
}
#define GATHER_SMEM (4 * 64 * 33 * 4)
__device__ __forceinline__ void ph_peer_gather(const P& p, int vb, int nvb, unsigned char* smem) {
  int tid_ = TIDX;
  asm volatile("" : "+v"(tid_));
  const int lane = tid_ & 63, wid = tid_ >> 6, hf = lane >> 5, sl = lane & 31;
  float* scr = (float*)smem + (wid * 64 + lane) * 33;
  int* tauL = (int*)(smem + GATHER_SMEM) + wid * 32;
  {
    f32x16 a, b2;
#pragma unroll
    for (int i = 0; i < 16; ++i) { a[i] = __uint_as_float((unsigned)i << 20) * 0x1p126f; b2[i] = __uint_as_float((unsigned)(16 + i) << 20) * 0x1p126f; }
    const f32x32 o = __builtin_amdgcn_cvt_scalef32_pk32_f32_fp6(__builtin_amdgcn_cvt_scalef32_2xpk16_fp6_f32(a, b2, 1.0f), 1.0f);
    if (lane == 0) {
#pragma unroll
      for (int j = 0; j < 32; ++j) tauL[j] = (int)((__float_as_uint(o[j] * 0x1p-126f) >> 20) & 31u);
    }
  }
  const int jmap = 2 * (lane & 1) + ((lane >> 1) & 1);
  __syncthreads();
  for (int m = vb * 4 + wid; m < NTOK; m += nvb * 4) {
    const float* md = p.mod + (m / SEQ) * 6144;
    float xh[32];
    {
#pragma unroll
      for (int c4 = 0; c4 < 4; ++c4) {
        const u32x4 u = *(const u32x4*)(p.hx2 + (size_t)m * DM + sl * 32 + 8 * c4);
#pragma unroll
        for (int e = 0; e < 4; ++e) { scr[8 * c4 + 2 * e] = bflo(u[e]); scr[8 * c4 + 2 * e + 1] = bfhi(u[e]); }
      }
      lds_wave_fence();
#pragma unroll
      for (int j = 0; j < 32; ++j) xh[j] = scr[tauL[j]];
      lds_wave_fence();
    }
    const int id0 = p.pidx[(size_t)m * 128 + lane], id1 = p.pidx[(size_t)m * 128 + 64 + lane];
    const float su0 = p.us[id0], su1 = p.us[id1];
    const float gs0 = p.pgate[(size_t)m * 128 + lane] * p.vs[id0], gs1 = p.pgate[(size_t)m * 128 + 64 + lane] * p.vs[id1];
    float acch[32];
#pragma unroll
    for (int k = 0; k < 32; ++k) acch[k] = 0.f;
#pragma unroll 1
    for (int e0 = 0; e0 < 128; e0 += 8) {
      u32x6 ur[4], vr[4];
#pragma unroll
      for (int j = 0; j < 4; ++j) {
        const int id = __shfl(e0 < 64 ? id0 : id1, (e0 + hf * 4 + j) & 63);
        ur[j] = load_row6(p.ub8, id, sl);
        vr[j] = load_row6(p.vb8, id, sl);
      }
      float d[4];
#pragma unroll
      for (int j = 0; j < 4; ++j) {
        const f32x32 f = __builtin_amdgcn_cvt_scalef32_pk32_f32_fp6(ur[j], 1.0f);
        float s0 = 0.f, s1 = 0.f;
#pragma unroll
        for (int k = 0; k < 32; k += 2) { s0 += f[k] * xh[k]; s1 += f[k + 1] * xh[k + 1]; }
        d[j] = s0 + s1;
        __builtin_amdgcn_sched_barrier(0);
      }
      float r2[2], r1;
      {
        const bool lo = (lane & 1) == 0;
#pragma unroll
        for (int i = 0; i < 2; ++i) { const float keep = lo ? d[i] : d[i + 2], send = lo ? d[i + 2] : d[i]; r2[i] = keep + __shfl_xor(send, 1); }
        const bool lo2 = (lane & 2) == 0;
        { const float keep = lo2 ? r2[0] : r2[1], send = lo2 ? r2[1] : r2[0]; r1 = keep + __shfl_xor(send, 2); }
        r1 += __shfl_xor(r1, 4); r1 += __shfl_xor(r1, 8); r1 += __shfl_xor(r1, 16);
      }
      const int esrc = (e0 + hf * 4 + jmap) & 63;
      const float su = __shfl(e0 < 64 ? su0 : su1, esrc), gs = __shfl(e0 < 64 ? gs0 : gs1, esrc);
      const float sdot = r1 * su;
      const float cf = gelu_as(sdot) * gs;
#pragma unroll
      for (int j = 0; j < 4; ++j) {
        const float cj = __shfl(cf, (lane & 32) | ((j >> 1) | ((j & 1) << 1)));
        const f32x32 f = __builtin_amdgcn_cvt_scalef32_pk32_f32_fp6(vr[j], 1.0f);
#pragma unroll
        for (int k = 0; k < 32; ++k) acch[k] += cj * f[k];
        __builtin_amdgcn_sched_barrier(0);
      }
    }
#pragma unroll
    for (int k = 0; k < 32; ++k) { acch[k] += __shfl_xor(acch[k], 32); scr[tauL[k]] = acch[k]; }
    lds_wave_fence();
    float ss = 0.f;
#pragma unroll
    for (int k = 0; k < 32; ++k) { const float v = scr[k]; ss += v * v; }
    ss = half_sum(ss);
    const float rstd = rsqrtf(ss * (1.0f / 1024.0f) + 1e-6f);
#pragma unroll
    for (int k4 = 0; k4 < 4; ++k4) {
      const int kk = hf * 16 + k4 * 4, col = sl * 32 + kk;
      f32x4 x1 = *(const f32x4*)(p.out + (size_t)m * DM + col);
      const f32x4 g = *(const f32x4*)(p.g_post_ffn + col), gt = *(const f32x4*)(md + 5120 + col);
#pragma unroll
      for (int e = 0; e < 4; ++e) x1[e] += gt[e] * scr[kk + e] * rstd * g[e];
      *(f32x4*)(p.out + (size_t)m * DM + col) = x1;
    }
    lds_wave_fence();
  }
}

#define XB_TMO      128
#define XB_XCNT(j)  (256  + 64 * (j))
#define XB_XSUB(j)  (1280 + 64 * (j))
#define XB_XGEN(j)  (2304 + 64 * (j))
#define XB_TOP      3328
#define XB_TOPGEN   3392
#define XCD_BAR_WORDS 3456
#define XB_SPIN_CAP (1u << 20)
#define LAS __attribute__((address_space(3)))
__device__ __forceinline__ unsigned xb_ld(unsigned* p)              { return __hip_atomic_load(p, __ATOMIC_RELAXED, __HIP_MEMORY_SCOPE_AGENT); }
__device__ __forceinline__ unsigned xb_add(unsigned* p, unsigned v) { return __hip_atomic_fetch_add(p, v, __ATOMIC_RELAXED, __HIP_MEMORY_SCOPE_AGENT); }
__device__ __forceinline__ unsigned xb_xcc_id() { return (unsigned)__builtin_amdgcn_s_getreg((3 << 11) | 20) & 0xFu; }
#define XB_SPIN(cond, bar) do { unsigned _sp = 0; while (cond) { __builtin_amdgcn_s_sleep(1); \
    if ((++_sp & 255u) == 0u) { if (xb_ld(&(bar)[XB_TMO])) break; if (_sp > XB_SPIN_CAP) { atomicAdd(&(bar)[XB_TMO], 1u); break; } } } } while (0)
struct XcdBarrier { unsigned* bar; unsigned x; volatile LAS unsigned* st; };
__device__ __forceinline__ XcdBarrier xcd_barrier_post(unsigned* bar, volatile LAS unsigned* st) {
  XcdBarrier b; b.bar = bar; b.x = xb_xcc_id(); b.st = st;
  if (TIDX == 0) (void)xb_add(&bar[XB_XCNT(b.x)], 1u);
  return b;
}
__device__ __forceinline__ void xcd_barrier_complete(unsigned* bar, unsigned x, unsigned& nloc, unsigned& nx) {
  const unsigned G = gridDim.x * gridDim.y * gridDim.z;
  unsigned sum, cnt, mine, sp = 0u;
  for (;;) {
    sum = 0u; cnt = 0u; mine = 0u;
#pragma unroll
    for (unsigned j = 0; j < 16; ++j) { const unsigned c = xb_ld(&bar[XB_XCNT(j)]); sum += c; cnt += (c > 0u) ? 1u : 0u; mine = (j == x) ? c : mine; }
    if (sum == G) break;
    __builtin_amdgcn_s_sleep(1);
    if ((++sp & 255u) == 0u) { if (xb_ld(&bar[XB_TMO])) break; if (sp > XB_SPIN_CAP) { atomicAdd(&bar[XB_TMO], 1u); break; } }
  }
  nloc = mine > 0u ? mine : 1u; nx = cnt > 0u ? cnt : 1u;
}
__device__ __forceinline__ void xcd_barrier(const XcdBarrier& b) {
  asm volatile("s_waitcnt vmcnt(0)" ::: "memory");
  __syncthreads();
  if (TIDX == 0) {
    unsigned* bar = b.bar;
    __builtin_amdgcn_s_waitcnt(0);
    unsigned nloc = b.st[0], nx = b.st[1];
    if (nloc == 0u) { xcd_barrier_complete(bar, b.x, nloc, nx); b.st[0] = nloc; b.st[1] = nx; }
    const unsigned old = xb_add(&bar[XB_XSUB(b.x)], 1u);
    const unsigned gen = old / nloc;
    if (old + 1u == (gen + 1u) * nloc) {
      __builtin_amdgcn_fence(__ATOMIC_RELEASE, "agent");
      asm volatile("s_waitcnt vmcnt(0)" ::: "memory");
      const unsigned og = xb_add(&bar[XB_TOP], 1u);
      const unsigned tg = og / nx;
      if (og + 1u == (tg + 1u) * nx) xb_add(&bar[XB_TOPGEN], 1u);
      else XB_SPIN(xb_ld(&bar[XB_TOPGEN]) == tg, bar);
      __builtin_amdgcn_fence(__ATOMIC_ACQUIRE, "agent");
      xb_add(&bar[XB_XGEN(b.x)], 1u);
      asm volatile("s_waitcnt vmcnt(0)" ::: "memory");
    } else {
      XB_SPIN(xb_ld(&bar[XB_XGEN(b.x)]) == gen, bar);
      __builtin_amdgcn_fence(__ATOMIC_ACQUIRE, "agent");
      asm volatile("s_waitcnt vmcnt(0)" ::: "memory");
    }
  }
  __syncthreads();
}

#define SMEM_BYTES RWKV_SMEM
__global__ void __launch_bounds__(256, 2) mega(P p) {
  __shared__ __attribute__((aligned(16))) unsigned char smem[SMEM_BYTES + 16];
  cg::grid_group grid = cg::this_grid();
  const int vb = blockIdx.x, nvb = gridDim.x;
  if (TIDX == 0) *(u32x4*)(smem + SMEM_BYTES) = (u32x4){0u, 0u, 0u, 0u};
  __syncthreads();
  const XcdBarrier xb = xcd_barrier_post(p.bar, (volatile LAS unsigned*)(smem + SMEM_BYTES));
  ph_mod(p, vb, nvb, smem);
  ph_transpose(p.w_in, p.Wt_in, DM, INC, vb, nvb, smem);
  ph_transpose(p.w2, p.w2T, 64, 1024, vb, nvb, smem);
  ph_transpose(p.w2 + 65536, p.w2T + 65536, 64, 1024, vb, nvb, smem);
  ph_transpose(p.a2, p.a2T, 64, 1024, vb, nvb, smem);
  ph_transpose(p.a2 + 65536, p.a2T + 65536, 64, 1024, vb, nvb, smem);
  if (p.bar == nullptr) grid.sync();
  xcd_barrier(xb);
  ph_norm1(p, vb, nvb);
  xcd_barrier(xb);
  ph_gemm1(p, vb, nvb, smem);
  xcd_barrier(xb);
  ph_rwkv_A(p, vb, nvb, smem);
  xcd_barrier(xb);
  ph_rwkv_B(p, vb, nvb, smem);
  if (nvb > 128 && vb >= 64) {
    const int v2 = vb - 64, n2 = nvb - 64;
    ph_transpose(p.w_a_out, p.Wt_aout, DM, DM, v2, n2, smem);
    ph_transpose(p.w_o, p.Wt_o, DM, DM, v2, n2, smem);
    ph_transpose(p.peer_wq, p.Wt_q, DM, 2048, v2, n2, smem);
    ph_transpose(p.g2, p.g2T, 128, 1024, v2, n2, smem);
    ph_weff(p, v2, n2);
    ph_convert(p.peer_keys, p.keys, (size_t)16 * 128 * 128, v2, n2);
  } else if (nvb <= 128) {
    ph_transpose(p.w_a_out, p.Wt_aout, DM, DM, vb, nvb, smem);
    ph_transpose(p.w_o, p.Wt_o, DM, DM, vb, nvb, smem);
    ph_transpose(p.peer_wq, p.Wt_q, DM, 2048, vb, nvb, smem);
    ph_transpose(p.g2, p.g2T, 128, 1024, vb, nvb, smem);
    ph_weff(p, vb, nvb);
    ph_convert(p.peer_keys, p.keys, (size_t)16 * 128 * 128, vb, nvb);
  }
  xcd_barrier(xb);
  ph_rwkv_C(p, vb, nvb, smem);
  ph_sg(p, vb, nvb);
  xcd_barrier(xb);
  ph_readout_gemm(p, vb, nvb, smem);
  ph_pool(p, vb, nvb, smem);
  ph_cvt_fp6(p.peer_u, p.ub8, p.us, vb, nvb);
  ph_cvt_fp6(p.peer_v, p.vb8, p.vs, vb, nvb);
  xcd_barrier(xb);
  ph_gemm_merge(p, vb, nvb, smem);
  xcd_barrier(xb);
  ph_gemm_simple(p.mrg, DM, p.Wt_o, DM, DM, NTOK, DM, p.mix, DM, vb, nvb, smem);
  xcd_barrier(xb);
  ph_res1(p, vb, nvb);
  xcd_barrier(xb);
  ph_gemm_simple(p.hx2, DM, p.Wt_q, DM, DM, NTOK, 2048, p.q, 2048, vb, nvb, smem);
  xcd_barrier(xb);
  ph_peer_s1(p, vb, nvb, smem);
  xcd_barrier(xb);
  ph_peer_s2(p, vb, nvb, smem);
  xcd_barrier(xb);
  ph_peer_gather(p, vb, nvb, smem);
}

extern "C" void kernel_launch(void* const* d_in, const int* in_sizes, int n_in, void* d_out, int out_size, void* d_ws, size_t ws_size, hipStream_t stream) {
  P p{};
  const float** f = (const float**)&p;
  for (int i = 0; i < 32; ++i) f[i] = (const float*)d_in[i];
  p.out = (float*)d_out;
  p.bar = (unsigned*)((unsigned char*)d_ws + 511 * 1048576);
  unsigned char* w = (unsigned char*)d_ws;
  const size_t MiB = 1048576;
  const size_t HM = 524288;
  p.hx = (bf16_t*)(w + 4096);
  p.zA = (bf16_t*)(w + 65 * MiB + 8192);
  p.zP = (bf16_t*)(w + 569 * HM);
  p.zG = (bf16_t*)d_out;
  unsigned char* rw = w + 633 * HM;
  p.Wt_in = (bf16_t*)rw; rw += 12 * MiB;
  p.Wt_aout = (bf16_t*)rw; rw += 2 * MiB;
  p.Wt_eff = (bf16_t*)rw; rw += 1 * MiB;
  p.Wt_o = (bf16_t*)rw; rw += 2 * MiB;
  p.Wt_q = (bf16_t*)rw; rw += 4 * MiB;
  p.keys = (bf16_t*)rw; rw += HM;
  p.mod = (float*)rw; rw += HM;
  p.g2T = (bf16_t*)rw; rw += HM;
  p.w2T = (bf16_t*)rw; rw += HM;
  p.a2T = (bf16_t*)rw; rw += HM;
  p.Y0 = (bf16_t*)(w + 0 * MiB);
  p.Y1 = (bf16_t*)(w + 340 * MiB);
  p.bdot = (float*)(w + 404 * MiB);
  p.Mst = (bf16_t*)(w + 408 * MiB);
  p.sg = (bf16_t*)(w + 408 * MiB);
  p.Nst = (float*)(w + 441 * MiB);
  p.ub8 = w + 416 * MiB;
  p.vb8 = w + 432 * MiB;
  p.us = (float*)(w + 448 * MiB);
  p.vs = (float*)(w + 449 * MiB);
  p.pooled = (bf16_t*)(w + 478 * MiB);
  p.out_a = (bf16_t*)(w + 0 * MiB);
  p.ya = (bf16_t*)(w + 65 * MiB);
  p.yb = (bf16_t*)(w + 129 * MiB);
  p.mrg = (bf16_t*)(w + 193 * MiB);
  p.mix = (bf16_t*)(w + 65 * MiB);
  p.hx2 = (bf16_t*)(w + 0 * MiB);
  p.q = (bf16_t*)(w + 129 * MiB);
  p.sv = (float*)(w + 340 * MiB);
  p.si = (int*)(w + 372 * MiB);
  p.pidx = (int*)(w + 257 * MiB);
  p.pgate = (float*)(w + 273 * MiB);
  static int grid_blocks = 0;
  if (!grid_blocks) {
    int dev = 0, cus = 0, per_cu = 0;
    hipGetDevice(&dev);
    hipDeviceGetAttribute(&cus, hipDeviceAttributeMultiprocessorCount, dev);
    hipOccupancyMaxActiveBlocksPerMultiprocessor(&per_cu, mega, 256, 0);
    if (per_cu > 2) per_cu = 2;
    if (per_cu < 1) per_cu = 1;
    grid_blocks = cus * per_cu;
  }
  hipMemsetAsync(p.bar, 0, XCD_BAR_WORDS * 4, stream);
  void* args[] = {&p};
  hipError_t e = hipLaunchCooperativeKernel((void*)mega, dim3(grid_blocks), dim3(256), args, 0, stream);
  if (e != hipSuccess) fprintf(stderr, "cooperative launch failed: %s (grid %d)\n", hipGetErrorString(e), grid_blocks);
}
```

```cpp
#include <hip/hip_runtime.h>
#include <hip/hip_cooperative_groups.h>
#include <stdint.h>
#include <cstdio>
namespace cg = cooperative_groups;

typedef unsigned short bf16_t;
typedef short bf16x8 __attribute__((ext_vector_type(8)));
typedef float f32x4 __attribute__((ext_vector_type(4)));
typedef unsigned u32x4 __attribute__((ext_vector_type(4)));
typedef unsigned u32x2 __attribute__((ext_vector_type(2)));
typedef float f32x2 __attribute__((ext_vector_type(2)));

__device__ __forceinline__ int tid_opaque() { int t = threadIdx.x; asm volatile("" : "+v"(t)); return t; }
#define TIDX tid_opaque()
#define NTOK 32768
#define SEQ 16384
#define CTXL 256
#define NCTX 512
#define MROWS 33280
#define DM 1024
#define SHIFTC 3456
#define INC 6016

typedef __bf16 hwbf2 __attribute__((ext_vector_type(2)));
typedef float hwf2 __attribute__((ext_vector_type(2)));
__device__ __forceinline__ unsigned pack2(float a, float b) { return __builtin_bit_cast(unsigned, __builtin_convertvector((hwf2){a, b}, hwbf2)); }
__device__ __forceinline__ bf16_t f2bf(float f) { return __builtin_bit_cast(unsigned short, (__bf16)f); }
__device__ __forceinline__ float bf2f(bf16_t h) { return __uint_as_float(((unsigned)h) << 16); }
__device__ __forceinline__ float bflo(unsigned u) { return __uint_as_float(u << 16); }
__device__ __forceinline__ float bfhi(unsigned u) { return __uint_as_float(u & 0xffff0000u); }
__device__ __forceinline__ float sigmoidf_(float x) { return __builtin_amdgcn_rcpf(1.0f + __expf(-x)); }

__device__ __forceinline__ void load8(const bf16_t* __restrict__ zA, int row, int col0, float* o) {
  const u32x4 zc = *(const u32x4*)(zA + (size_t)row * SHIFTC + col0);
#pragma unroll
  for (int i = 0; i < 4; ++i) { o[2 * i] = bflo(zc[i]); o[2 * i + 1] = bfhi(zc[i]); }
}
__device__ __forceinline__ float red16(float v) {
  v += __shfl_xor(v, 1); v += __shfl_xor(v, 2); v += __shfl_xor(v, 4); v += __shfl_xor(v, 8);
  return v;
}
__device__ __forceinline__ float red8(float v) {
  v += __shfl_xor(v, 1); v += __shfl_xor(v, 2); v += __shfl_xor(v, 4);
  return v;
}

struct P {
  const float *x, *c, *ctx, *c_ctx, *w_mod, *b_mod, *g_pre_mix, *g_post_mix, *g_pre_ffn, *g_post_ffn, *w_in, *b_gate, *mu_shift,
      *w0, *w2, *a0, *a2, *g2, *k_k, *k_a, *r_k, *ln_x_w, *ln_x_b, *w_a_out, *w_pool, *pool_scale, *w_b_out, *w_o, *peer_wq,
      *peer_keys, *peer_u, *peer_v;
  float* out;
  unsigned* bar;
  bf16_t* hx;
  signed char* hx8;
  float* hsa;
  signed char* Wt8;
  float* wsb;
  unsigned* colmax;
  bf16_t* zA;
  bf16_t* zP;
  bf16_t* zG;
  bf16_t* Wt_in;
  bf16_t* Wt_aout;
  bf16_t* Wt_eff;
  bf16_t* Wt_o;
  bf16_t* Wt_q;
  bf16_t* keys;
  float* mod;
  unsigned char* ub8;
  unsigned char* vb8;
  float* us;
  float* vs;
  bf16_t* sg;
  bf16_t* g2T;
  bf16_t* w2T;
  bf16_t* a2T;
  bf16_t* Mst;
  float* Nst;
  bf16_t* Y0;
  bf16_t* Y1;
  float* bdot;
  bf16_t* out_a;
  bf16_t* ya;
  bf16_t* pooled;
  bf16_t* yb;
  bf16_t* mrg;
  bf16_t* mix;
  bf16_t* hx2;
  bf16_t* q;
  float* sv;
  int* si;
  int* pidx;
  float* pgate;
};

#define GS 72
#define GEMM_SMEM (2 * 128 * GS * 2)
template <class Epi>
__device__ __forceinline__ void gemm_tile(const bf16_t* __restrict__ A, int lda, const bf16_t* __restrict__ Bt, int ldb, int K, int m0, int n0,
                                          const Epi& epi, unsigned char* smem) {
  const int tid = TIDX, lane = tid & 63, wid = tid >> 6, wr = wid >> 1, wc = wid & 1;
  bf16_t* sA = (bf16_t*)smem;
  bf16_t* sB = sA + 128 * GS;
  f32x4 acc[4][4];
#pragma unroll
  for (int i = 0; i < 4; ++i)
#pragma unroll
    for (int j = 0; j < 4; ++j) acc[i][j] = (f32x4){0.f, 0.f, 0.f, 0.f};
  const int lrow = tid >> 3, lcol = (tid & 7) * 8;
  const bf16_t* pa = A + (size_t)(m0 + lrow) * lda + lcol;
  const bf16_t* pb = Bt + (size_t)(n0 + lrow) * ldb + lcol;
  u32x4 ra[4], rb[4];
#pragma unroll
  for (int p = 0; p < 4; ++p) {
    ra[p] = *(const u32x4*)(pa + (size_t)(32 * p) * lda);
    rb[p] = *(const u32x4*)(pb + (size_t)(32 * p) * ldb);
  }
  for (int k0 = 0; k0 < K; k0 += 64) {
#pragma unroll
    for (int p = 0; p < 4; ++p) {
      *(u32x4*)(sA + (lrow + 32 * p) * GS + lcol) = ra[p];
      *(u32x4*)(sB + (lrow + 32 * p) * GS + lcol) = rb[p];
    }
    __syncthreads();
    if (k0 + 64 < K) {
#pragma unroll
      for (int p = 0; p < 4; ++p) {
        ra[p] = *(const u32x4*)(pa + (size_t)(32 * p) * lda + k0 + 64);
        rb[p] = *(const u32x4*)(pb + (size_t)(32 * p) * ldb + k0 + 64);
      }
    }
#pragma unroll
    for (int kk = 0; kk < 2; ++kk) {
      bf16x8 af[4], bfr[4];
#pragma unroll
      for (int i = 0; i < 4; ++i) af[i] = *(const bf16x8*)(sA + (wr * 64 + i * 16 + (lane & 15)) * GS + kk * 32 + (lane >> 4) * 8);
#pragma unroll
      for (int j = 0; j < 4; ++j) bfr[j] = *(const bf16x8*)(sB + (wc * 64 + j * 16 + (lane & 15)) * GS + kk * 32 + (lane >> 4) * 8);
#pragma unroll
      for (int i = 0; i < 4; ++i)
#pragma unroll
        for (int j = 0; j < 4; ++j) acc[i][j] = __builtin_amdgcn_mfma_f32_16x16x32_bf16(bfr[j], af[i], acc[i][j], 0, 0, 0);
    }
    __syncthreads();
  }
#pragma unroll
  for (int i = 0; i < 4; ++i)
#pragma unroll
    for (int j = 0; j < 4; ++j) epi(m0 + wr * 64 + i * 16 + (lane & 15), n0 + wc * 64 + j * 16 + (lane >> 4) * 4, acc[i][j]);
}

#define G3_STAGE 24576
#define G3_ES 136
#define GEMM3_SMEM (256 * G3_ES * 2)
typedef __attribute__((address_space(3))) unsigned lds_u32;
template <class Epi>
__device__ __forceinline__ void gemm_tile3(const bf16_t* __restrict__ A, int lda, const bf16_t* __restrict__ Bt, int ldb, int K, int m0, int n0,
                                           const Epi& epi, unsigned char* smem) {
  int tid = TIDX;
  asm volatile("" : "+v"(tid));
  const int lane = tid & 63, wid = __builtin_amdgcn_readfirstlane(tid >> 6), wr = wid >> 1, wc = wid & 1, l15 = lane & 15, q = lane >> 4;
  f32x4 acc[8][4];
#pragma unroll
  for (int i = 0; i < 8; ++i)
#pragma unroll
    for (int j = 0; j < 4; ++j) acc[i][j] = (f32x4){0.f, 0.f, 0.f, 0.f};
  const int gr = lane >> 2, gc = ((lane & 3) ^ (((gr >> 2) & 1) << 1)) * 8;
  const bf16_t* pa = A + (long)(m0 + wid * 64 + gr) * lda + gc;
  const bf16_t* pb = Bt + (size_t)(n0 + wid * 32 + gr) * ldb + gc;
  unsigned char* dA = smem + wid * 4096 + lane * 16;
  unsigned char* dB = smem + 16384 + wid * 2048 + lane * 16;
  const int sw = (q ^ (((l15 >> 2) & 1) << 1)) * 16;
  const unsigned char* fA = smem + (wr * 128 + l15) * 64 + sw;
  const unsigned char* fB = smem + 16384 + (wc * 64 + l15) * 64 + sw;
#define G3_ISSUE(ST, KT) { _Pragma("unroll") for (int ii = 0; ii < 4; ++ii) __builtin_amdgcn_global_load_lds((const unsigned*)(pa + (size_t)(16 * ii) * lda + (KT) * 32), (lds_u32*)(dA + (ST) * G3_STAGE + ii * 1024), 16, 0, 0); \
                           _Pragma("unroll") for (int ii = 0; ii < 2; ++ii) __builtin_amdgcn_global_load_lds((const unsigned*)(pb + (size_t)(16 * ii) * ldb + (KT) * 32), (lds_u32*)(dB + (ST) * G3_STAGE + ii * 1024), 16, 0, 0); }
  const int nk = K >> 5;
  __syncthreads();
  G3_ISSUE(0, 0);
  for (int kt = 0; kt < nk; ++kt) {
    const int cur = kt & 1;
    asm volatile("s_waitcnt vmcnt(0)" ::: "memory");
    __syncthreads();
    if (kt + 1 < nk) G3_ISSUE(cur ^ 1, kt + 1);
    const unsigned char* cA = fA + cur * G3_STAGE;
    const unsigned char* cB = fB + cur * G3_STAGE;
    bf16x8 bfr[4];
#pragma unroll
    for (int j = 0; j < 4; ++j) bfr[j] = *(const bf16x8*)(cB + j * 1024);
#pragma unroll
    for (int i = 0; i < 8; ++i) {
      const bf16x8 af = *(const bf16x8*)(cA + i * 1024);
#pragma unroll
      for (int j = 0; j < 4; ++j) acc[i][j] = __builtin_amdgcn_mfma_f32_16x16x32_bf16(bfr[j], af, acc[i][j], 0, 0, 0);
    }
  }
#undef G3_ISSUE
  bf16_t* sE = (bf16_t*)smem;
  __syncthreads();
#pragma unroll
  for (int i = 0; i < 8; ++i)
#pragma unroll
    for (int j = 0; j < 4; ++j) {
      u32x2 w; w.x = pack2(acc[i][j][0], acc[i][j][1]); w.y = pack2(acc[i][j][2], acc[i][j][3]);
      *(u32x2*)(sE + (wr * 128 + i * 16 + l15) * G3_ES + wc * 64 + j * 16 + q * 4) = w;
    }
  __syncthreads();
  epi.finish(sE, m0, n0, tid);
}
typedef int i32x4v __attribute__((ext_vector_type(4)));
template <class Epi>
__device__ __forceinline__ void gemm_tile3_i8(const signed char* __restrict__ A, int lda, const signed char* __restrict__ Bt, int ldb, int K, int m0, int n0,
                                              const float* __restrict__ sa, const float* __restrict__ sb, const Epi& epi, unsigned char* smem) {
  int tid = TIDX;
  asm volatile("" : "+v"(tid));
  const int lane = tid & 63, wid = __builtin_amdgcn_readfirstlane(tid >> 6), wr = wid >> 1, wc = wid & 1, l15 = lane & 15, q = lane >> 4;
  i32x4v acc[8][4];
#pragma unroll
  for (int i = 0; i < 8; ++i)
#pragma unroll
    for (int j = 0; j < 4; ++j) acc[i][j] = (i32x4v){0, 0, 0, 0};
  const int gr = lane >> 2, gc = ((lane & 3) ^ (((gr >> 2) & 1) << 1)) * 16;
  const signed char* pa = A + (long)(m0 + wid * 64 + gr) * lda + gc;
  const signed char* pb = Bt + (size_t)(n0 + wid * 32 + gr) * ldb + gc;
  unsigned char* dA = smem + wid * 4096 + lane * 16;
  unsigned char* dB = smem + 16384 + wid * 2048 + lane * 16;
  const int sw = (q ^ (((l15 >> 2) & 1) << 1)) * 16;
  const unsigned char* fA = smem + (wr * 128 + l15) * 64 + sw;
  const unsigned char* fB = smem + 16384 + (wc * 64 + l15) * 64 + sw;
#define G3_ISSUE(ST, KT) { _Pragma("unroll") for (int ii = 0; ii < 4; ++ii) __builtin_amdgcn_global_load_lds((const unsigned*)(pa + (size_t)(16 * ii) * lda + (KT) * 64), (lds_u32*)(dA + (ST) * G3_STAGE + ii * 1024), 16, 0, 0); \
                           _Pragma("unroll") for (int ii = 0; ii < 2; ++ii) __builtin_amdgcn_global_load_lds((const unsigned*)(pb + (size_t)(16 * ii) * ldb + (KT) * 64), (lds_u32*)(dB + (ST) * G3_STAGE + ii * 1024), 16, 0, 0); }
  const int nk = K >> 6;
  __syncthreads();
  G3_ISSUE(0, 0);
  for (int kt = 0; kt < nk; ++kt) {
    const int cur = kt & 1;
    asm volatile("s_waitcnt vmcnt(0)" ::: "memory");
    __syncthreads();
    if (kt + 1 < nk) G3_ISSUE(cur ^ 1, kt + 1);
    const unsigned char* cA = fA + cur * G3_STAGE;
    const unsigned char* cB = fB + cur * G3_STAGE;
    i32x4v bfr[4];
#pragma unroll
    for (int j = 0; j < 4; ++j) bfr[j] = *(const i32x4v*)(cB + j * 1024);
#pragma unroll
    for (int i = 0; i < 8; ++i) {
      const i32x4v af = *(const i32x4v*)(cA + i * 1024);
#pragma unroll
      for (int j = 0; j < 4; ++j) acc[i][j] = __builtin_amdgcn_mfma_i32_16x16x64_i8(bfr[j], af, acc[i][j], 0, 0, 0);
    }
  }
#undef G3_ISSUE
  bf16_t* sE = (bf16_t*)smem;
  f32x4 sb4[4];
#pragma unroll
  for (int j = 0; j < 4; ++j) sb4[j] = *(const f32x4*)(sb + n0 + wc * 64 + j * 16 + q * 4);
  __syncthreads();
#pragma unroll
  for (int i = 0; i < 8; ++i) {
    const float sr = sa[m0 + wr * 128 + i * 16 + l15];
#pragma unroll
    for (int j = 0; j < 4; ++j) {
      u32x2 w;
      w.x = pack2((float)acc[i][j][0] * (sr * sb4[j][0]), (float)acc[i][j][1] * (sr * sb4[j][1]));
      w.y = pack2((float)acc[i][j][2] * (sr * sb4[j][2]), (float)acc[i][j][3] * (sr * sb4[j][3]));
      *(u32x2*)(sE + (wr * 128 + i * 16 + l15) * G3_ES + wc * 64 + j * 16 + q * 4) = w;
    }
  }
  __syncthreads();
  epi.finish(sE, m0, n0, tid);
}
template <class D> struct Epi3RowChunks {
  __device__ __forceinline__ void finish(const bf16_t* sE, int m0, int n0, int tid) const {
#pragma unroll
    for (int pp = 0; pp < 16; ++pp) {
      const int id = tid + 256 * pp, row = id >> 4, cc = (id & 15) * 8;
      static_cast<const D*>(this)->store(m0 + row, n0 + cc, *(const u32x4*)(sE + row * G3_ES + cc));
    }
  }
};
struct Epi3StoreBf16 : Epi3RowChunks<Epi3StoreBf16> {
  bf16_t* C; int ldc;
  __device__ Epi3StoreBf16(bf16_t* c, int l) : C(c), ldc(l) {}
  __device__ __forceinline__ void store(int m, int n, const u32x4& v) const { *(u32x4*)(C + (size_t)m * ldc + n) = v; }
};
struct Epi3GateA : Epi3RowChunks<Epi3GateA> {
  const bf16_t* zG; const float* bg; bf16_t* mrg;
  __device__ Epi3GateA(const bf16_t* z, const float* b, bf16_t* m) : zG(z), bg(b), mrg(m) {}
  __device__ __forceinline__ void store(int m, int n, const u32x4& v) const {
    const u32x4 g = *(const u32x4*)(zG + (size_t)m * 2048 + n);
    const f32x4 b0 = *(const f32x4*)(bg + n), b1 = *(const f32x4*)(bg + n + 4);
    u32x4 o;
#pragma unroll
    for (int i = 0; i < 4; ++i) {
      const float bl = i < 2 ? b0[2 * i] : b1[2 * i - 4], bh = i < 2 ? b0[2 * i + 1] : b1[2 * i - 3];
      o[i] = pack2(sigmoidf_(bflo(g[i]) + bl) * bflo(v[i]), sigmoidf_(bfhi(g[i]) + bh) * bfhi(v[i]));
    }
    *(u32x4*)(mrg + (size_t)m * DM + n) = o;
  }
};
struct Epi3GateB : Epi3RowChunks<Epi3GateB> {
  const bf16_t* zG; const float* bg; bf16_t* mrg;
  __device__ Epi3GateB(const bf16_t* z, const float* b, bf16_t* m) : zG(z), bg(b), mrg(m) {}
  __device__ __forceinline__ void store(int m, int n, const u32x4& v) const {
    const u32x4 g = *(const u32x4*)(zG + (size_t)m * 2048 + 1024 + n);
    const u32x4 a = *(const u32x4*)(mrg + (size_t)m * DM + n);
    const f32x4 b0 = *(const f32x4*)(bg + 1024 + n), b1 = *(const f32x4*)(bg + 1024 + n + 4);
    u32x4 o;
#pragma unroll
    for (int i = 0; i < 4; ++i) {
      const float bl = i < 2 ? b0[2 * i] : b1[2 * i - 4], bh = i < 2 ? b0[2 * i + 1] : b1[2 * i - 3];
      o[i] = pack2(bflo(a[i]) + sigmoidf_(bflo(g[i]) + bl) * bflo(v[i]), bfhi(a[i]) + sigmoidf_(bfhi(g[i]) + bh) * bfhi(v[i]));
    }
    *(u32x4*)(mrg + (size_t)m * DM + n) = o;
  }
};
struct Epi3ZS {
  bf16_t* zA; const float* mu; int own_lo, own_hi, t0, T;
  __device__ __forceinline__ void finish(const bf16_t* sE, int m0, int n0, int tid) const {
#pragma unroll 4
    for (int pq = 0; pq < 16; ++pq) {
      const int id = tid + 256 * pq, row = id >> 4, cc = (id & 15) * 8, t = t0 + row;
      if (row < own_lo || row > own_hi) continue;
      const u32x4 zc = *(const u32x4*)(sE + row * G3_ES + cc);
      u32x4 zp = (u32x4){0u, 0u, 0u, 0u}, zn = (u32x4){0u, 0u, 0u, 0u};
      if (t > 0) zp = *(const u32x4*)(sE + (row - 1) * G3_ES + cc);
      if (t < T - 1) zn = *(const u32x4*)(sE + (row + 1) * G3_ES + cc);
      const f32x4 m0v = *(const f32x4*)(mu + n0 + cc), m1v = *(const f32x4*)(mu + n0 + cc + 4);
      const float mm[8] = {m0v[0], m0v[1], m0v[2], m0v[3], m1v[0], m1v[1], m1v[2], m1v[3]};
      u32x4 o;
#pragma unroll
      for (int i = 0; i < 4; ++i) {
        const float z0 = bflo(zc[i]), z1 = bfhi(zc[i]);
        o[i] = pack2(z0 + mm[2 * i] * (0.5f * (bflo(zp[i]) + bflo(zn[i])) - z0), z1 + mm[2 * i + 1] * (0.5f * (bfhi(zp[i]) + bfhi(zn[i])) - z1));
      }
      *(u32x4*)(zA + (long)(m0 + row) * SHIFTC + n0 + cc) = o;
    }
  }
};
struct Epi3Z : Epi3RowChunks<Epi3Z> {
  bf16_t *zA, *zP, *zG;
  __device__ Epi3Z(bf16_t* a, bf16_t* b, bf16_t* c) : zA(a), zP(b), zG(c) {}
  __device__ __forceinline__ void store(int m, int n, const u32x4& v) const {
    if (n < SHIFTC) *(u32x4*)(zA + (size_t)m * SHIFTC + n) = v;
    else if (m < NTOK) {
      if (n < SHIFTC + 512) *(u32x4*)(zP + (size_t)m * 512 + (n - SHIFTC)) = v;
      else *(u32x4*)(zG + (size_t)m * 2048 + (n - SHIFTC - 512)) = v;
    }
  }
};

struct EpiLds {
  float* S;
  __device__ __forceinline__ void operator()(int m, int n, const f32x4& v) const {
    float* r = S + (m & 127) * 133 + n + (n >> 5);
    r[0] = v[0]; r[1] = v[1]; r[2] = v[2]; r[3] = v[3];
  }
};

__device__ __forceinline__ void ph_transpose(const float* __restrict__ in, bf16_t* __restrict__ out, int K, int N, int vb, int nvb, unsigned char* smem) {
  float* t = (float*)smem;
  const int tk = K / 64, tn = N / 64, tid = TIDX, tx = tid & 15, ty = tid >> 4;
  for (int it = vb; it < tk * tn; it += nvb) {
    const int k0 = (it / tn) * 64, n0 = (it % tn) * 64;
    __syncthreads();
#pragma unroll
    for (int r = 0; r < 4; ++r) {
      const f32x4 v = *(const f32x4*)(in + (size_t)(k0 + ty + 16 * r) * N + n0 + 4 * tx);
#pragma unroll
      for (int e = 0; e < 4; ++e) t[(ty + 16 * r) * 65 + 4 * tx + e] = v[e];
    }
    __syncthreads();
    const int n = tid >> 2, kq = (tid & 3) * 16;
    u32x4 w0, w1;
#pragma unroll
    for (int e = 0; e < 4; ++e) {
      w0[e] = pack2(t[(kq + 2 * e) * 65 + n], t[(kq + 2 * e + 1) * 65 + n]);
      w1[e] = pack2(t[(kq + 8 + 2 * e) * 65 + n], t[(kq + 8 + 2 * e + 1) * 65 + n]);
    }
    *(u32x4*)(out + (size_t)(n0 + n) * K + k0 + kq) = w0;
    *(u32x4*)(out + (size_t)(n0 + n) * K + k0 + kq + 8) = w1;
  }
}
__device__ __forceinline__ void ph_colmax(const float* __restrict__ in, unsigned* __restrict__ colmax, int K, int N, int vb, int nvb, unsigned char* smem) {
  float* red = (float*)smem;
  const int tk = K / 64, tn = N / 64, tid = TIDX, n = tid & 63, kq = tid >> 6;
  for (int it = vb; it < tk * tn; it += nvb) {
    const int k0 = (it / tn) * 64 + kq * 16, n0 = (it % tn) * 64;
    float mx = 0.f;
#pragma unroll
    for (int r = 0; r < 16; ++r) mx = fmaxf(mx, fabsf(in[(size_t)(k0 + r) * N + n0 + n]));
    __syncthreads();
    red[kq * 64 + n] = mx;
    __syncthreads();
    if (kq == 0) atomicMax(colmax + n0 + n, __float_as_uint(fmaxf(fmaxf(red[n], red[64 + n]), fmaxf(red[128 + n], red[192 + n]))));
  }
}
__device__ __forceinline__ void ph_transpose_i8(const float* __restrict__ in, signed char* __restrict__ out, const unsigned* __restrict__ colmax, float* __restrict__ sbv,
                                                int K, int N, int vb, int nvb, unsigned char* smem) {
  float* t = (float*)smem;
  const int tk = K / 64, tn = N / 64, tid = TIDX, tx = tid & 15, ty = tid >> 4;
  for (int it = vb; it < tk * tn; it += nvb) {
    const int k0 = (it / tn) * 64, n0 = (it % tn) * 64;
    __syncthreads();
#pragma unroll
    for (int r = 0; r < 4; ++r) {
      const f32x4 v = *(const f32x4*)(in + (size_t)(k0 + ty + 16 * r) * N + n0 + 4 * tx);
#pragma unroll
      for (int e = 0; e < 4; ++e) t[(ty + 16 * r) * 65 + 4 * tx + e] = v[e];
    }
    __syncthreads();
    const int n = tid >> 2, kq = (tid & 3) * 16;
    const float cmx = __uint_as_float(colmax[n0 + n]);
    const float sc = cmx > 0.f ? 127.0f / cmx : 0.f;
    if (k0 == 0 && kq == 0) sbv[n0 + n] = cmx > 0.f ? cmx / 127.0f : 1.0f;
    u32x4 w;
#pragma unroll
    for (int e = 0; e < 4; ++e) {
      unsigned pk = 0;
#pragma unroll
      for (int b = 0; b < 4; ++b) { const int qv = (int)rintf(t[(kq + 4 * e + b) * 65 + n] * sc); pk |= ((unsigned)qv & 255u) << (8 * b); }
      w[e] = pk;
    }
    *(u32x4*)(out + (size_t)(n0 + n) * K + k0 + kq) = w;
  }
}
__device__ __forceinline__ void ph_convert(const float* __restrict__ in, bf16_t* __restrict__ out, size_t n, int vb, int nvb) {
  for (size_t i = ((size_t)vb * 256 + TIDX) * 4; i < n; i += (size_t)nvb * 1024) {
    const float4 v = *(const float4*)(in + i);
    uint2 w; w.x = pack2(v.x, v.y); w.y = pack2(v.z, v.w);
    *(uint2*)(out + i) = w;
  }
}
__device__ __forceinline__ void ph_weff(const P& p, int vb, int nvb) {
  for (int it = vb * 256 + TIDX; it < 512 * 1024; it += nvb * 256) {
    const int n = it & 1023, k = it >> 10, j = k >> 7, kl = k & 127;
    const float* wp = p.w_pool + ((size_t)j * 128 + kl) * 128;
    float s = 0.f;
    for (int c = 0; c < 128; ++c) s += wp[c] * p.pool_scale[j * 128 + c] * p.w_b_out[(size_t)(j * 128 + c) * 1024 + n];
    p.Wt_eff[(size_t)n * 512 + k] = f2bf(s);
  }
}
__device__ __forceinline__ void ph_mod(const P& p, int vb, int nvb, unsigned char* smem) {
  float* red = (float*)smem;
  const int lane = TIDX & 63, wid = TIDX >> 6;
  for (int it = vb; it < 96; it += nvb) {
    const int n = it * 64 + lane;
    float a0 = 0.f, a1 = 0.f, a2 = 0.f;
#pragma unroll 8
    for (int k = wid * 256; k < wid * 256 + 256; ++k) {
      const float w = p.w_mod[(size_t)k * 6144 + n];
      const float c0 = p.c[k], c1 = p.c[1024 + k], c2 = p.c_ctx[k];
      a0 += c0 * sigmoidf_(c0) * w; a1 += c1 * sigmoidf_(c1) * w; a2 += c2 * sigmoidf_(c2) * w;
    }
    __syncthreads();
    red[(wid * 3 + 0) * 64 + lane] = a0; red[(wid * 3 + 1) * 64 + lane] = a1; red[(wid * 3 + 2) * 64 + lane] = a2;
    __syncthreads();
    if (wid < 3) {
      const float sum = red[(0 * 3 + wid) * 64 + lane] + red[(1 * 3 + wid) * 64 + lane] + red[(2 * 3 + wid) * 64 + lane] + red[(3 * 3 + wid) * 64 + lane];
      p.mod[wid * 6144 + n] = sum + p.b_mod[n];
    }
  }
}
__device__ __forceinline__ float wave_sum(float v) {
#pragma unroll
  for (int o = 32; o > 0; o >>= 1) v += __shfl_xor(v, o);
  return v;
}
__device__ __forceinline__ void ph_norm1(const P& p, int vb, int nvb) {
  const int lane = TIDX & 63, wid = TIDX >> 6, nw = nvb * 4;
  for (int m0 = vb * 4 + wid; m0 < MROWS; m0 += 2 * nw) {
    const int m1 = m0 + nw; const bool has1 = m1 < MROWS; const int mb = has1 ? m1 : m0;
    const float* srcA = m0 < NTOK ? p.x + (size_t)m0 * DM : p.ctx + (size_t)(m0 - NTOK) * DM;
    const float* srcB = mb < NTOK ? p.x + (size_t)mb * DM : p.ctx + (size_t)(mb - NTOK) * DM;
    f32x4 va[4], vbq[4]; float sa = 0.f, sb = 0.f;
#pragma unroll
    for (int i = 0; i < 4; ++i) { va[i] = *(const f32x4*)(srcA + i * 256 + lane * 4); vbq[i] = *(const f32x4*)(srcB + i * 256 + lane * 4); }
#pragma unroll
    for (int i = 0; i < 4; ++i)
#pragma unroll
      for (int e = 0; e < 4; ++e) { sa += va[i][e] * va[i][e]; sb += vbq[i][e] * vbq[i][e]; }
    sa = wave_sum(sa); sb = wave_sum(sb);
#pragma unroll
    for (int rr = 0; rr < 2; ++rr) {
      if (rr == 1 && !has1) break;
      const int m = rr == 0 ? m0 : m1;
      const float rstd = rsqrtf((rr == 0 ? sa : sb) * (1.0f / 1024.0f) + 1e-6f);
      const float* md = p.mod + (m < NTOK ? (m / SEQ) : 2) * 6144;
      f32x4 y[4]; float am = 0.f;
#pragma unroll
      for (int i = 0; i < 4; ++i) {
        const int col = i * 256 + lane * 4;
        const f32x4 v = rr == 0 ? va[i] : vbq[i];
        const f32x4 g = *(const f32x4*)(p.g_pre_mix + col), sh = *(const f32x4*)(md + col), sc = *(const f32x4*)(md + 1024 + col);
#pragma unroll
        for (int e = 0; e < 4; ++e) { y[i][e] = v[e] * rstd * g[e] * (1.f + sc[e]) + sh[e]; am = fmaxf(am, fabsf(y[i][e])); }
      }
#pragma unroll
      for (int o = 32; o > 0; o >>= 1) am = fmaxf(am, __shfl_xor(am, o));
      const float qs = am > 0.f ? 127.0f / am : 0.f;
      if (lane == 0) p.hsa[m] = am > 0.f ? am / 127.0f : 1.0f;
#pragma unroll
      for (int i = 0; i < 4; ++i) {
        unsigned pk = 0;
#pragma unroll
        for (int e = 0; e < 4; ++e) pk |= ((unsigned)(int)rintf(y[i][e] * qs) & 255u) << (8 * e);
        *(unsigned*)(p.hx8 + (size_t)m * DM + i * 256 + lane * 4) = pk;
      }
    }
  }
}
struct Epi3Readout {
  const P* pp;
  __device__ __forceinline__ void finish(const bf16_t* sE, int m0, int n0, int tid) const {
    const P& p = *pp;
#pragma unroll 2
    for (int pq = 0; pq < 16; ++pq) {
      const int id = tid + 256 * pq, row = id >> 4, cc = (id & 15) * 8, m = m0 + row, n = n0 + cc, t = m % SEQ, h = n >> 6;
      const u32x4 g = *(const u32x4*)(sE + row * G3_ES + cc);
      const u32x4 y0 = *(const u32x4*)(p.Y0 + (size_t)m * DM + n), y1 = *(const u32x4*)(p.Y1 + (size_t)m * DM + n);
      float y[8], v[8];
#pragma unroll
      for (int i = 0; i < 4; ++i) { y[2 * i] = bflo(y0[i]) + bflo(y1[i]); y[2 * i + 1] = bfhi(y0[i]) + bfhi(y1[i]); }
      float sm = 0.f;
#pragma unroll
      for (int i = 0; i < 8; ++i) sm += y[i];
      const float mu = red8(sm) * (1.f / 64.f);
      float qv = 0.f;
#pragma unroll
      for (int i = 0; i < 8; ++i) { y[i] -= mu; qv += y[i] * y[i]; }
      const float rs = rsqrtf(red8(qv) * (1.f / 64.f) + 64e-5f);
      load8(p.zA, m, 2048 + n, v);
      const float bon = 0.5f * (p.bdot[(size_t)m * 16 + h] + p.bdot[((size_t)NTOK + m) * 16 + h]);
      const f32x4 w0 = *(const f32x4*)(p.ln_x_w + n), w1 = *(const f32x4*)(p.ln_x_w + n + 4), b0 = *(const f32x4*)(p.ln_x_b + n), b1 = *(const f32x4*)(p.ln_x_b + n + 4);
      const float lw[8] = {w0[0], w0[1], w0[2], w0[3], w1[0], w1[1], w1[2], w1[3]}, lb[8] = {b0[0], b0[1], b0[2], b0[3], b1[0], b1[1], b1[2], b1[3]};
      u32x4 o;
#pragma unroll
      for (int i = 0; i < 4; ++i)
        o[i] = pack2((y[2 * i] * rs * lw[2 * i] + lb[2 * i] + bon * v[2 * i]) * bflo(g[i]), (y[2 * i + 1] * rs * lw[2 * i + 1] + lb[2 * i + 1] + bon * v[2 * i + 1]) * bfhi(g[i]));
      *(u32x4*)(p.out_a + (size_t)m * DM + n) = o;
    }
  }
};
__device__ __forceinline__ int xcd_tile(int vb, int nvb, int round, int TM, int TN, int& tm, int& tn) {
  if (nvb % 64 != 0) { const int it = round * nvb + vb; if (it >= TM * TN) return 0; tm = it % TM; tn = it / TM; return 1; }
  const int spg = nvb >> 3, g = vb & 7, slot = vb >> 3, SC = spg >> 3;
  const int nsr = (TM + 7) >> 3, nsc = (TN + SC - 1) / SC, st = round * 8 + g;
  if (st >= nsr * nsc) return 0;
  tm = (st % nsr) * 8 + (slot & 7); tn = (st / nsr) * SC + (slot >> 3);
  return (tm < TM && tn < TN) ? 1 : 2;
}
__device__ __forceinline__ void ph_gemm1(const P& p, int vb, int nvb, unsigned char* smem) {
  const int NS_ = 132 * 27, NALL = NS_ + 128 * 20;
  const int per = nvb >> 3;
  for (int round = 0;; ++round) {
    int item;
    if ((nvb & 7) == 0) { const int blk = round * 8 + (vb & 7); if (blk * per >= NALL) break; item = blk * per + (vb >> 3); if (item >= NALL) continue; }
    else { item = round * nvb + vb; if (item >= NALL) break; }
    if (item < NS_) {
      const int cgp = item / (132 * 9), rem = item % (132 * 9), tmS = rem / 9, tn = cgp * 9 + rem % 9;
      Epi3ZS epi;
      epi.zA = p.zA; epi.mu = p.mu_shift;
      int m0;
      if (tmS < 130) { const int b = tmS / 65, i = tmS % 65; m0 = b * SEQ + 254 * i - 1; epi.own_lo = 1; epi.own_hi = min(254, SEQ - 254 * i); epi.t0 = 254 * i - 1; epi.T = SEQ; }
      else { m0 = NTOK + (tmS - 130) * CTXL; epi.own_lo = 0; epi.own_hi = 255; epi.t0 = 0; epi.T = CTXL; }
      gemm_tile3_i8(p.hx8, DM, p.Wt8, DM, DM, m0, tn * 128, p.hsa, p.wsb, epi, smem);
    } else {
      const int i2 = item - NS_;
      int tm, tn;
      if (i2 < 2048) { tm = (i2 & 1023) >> 3; tn = 27 + (i2 >> 10) * 8 + (i2 & 7); } else { tm = (i2 - 2048) >> 2; tn = 43 + (i2 & 3); }
      Epi3Z epi{p.zA, p.zP, p.zG};
      gemm_tile3_i8(p.hx8, DM, p.Wt8, DM, DM, tm * 256, tn * 128, p.hsa, p.wsb, epi, smem);
    }
  }
}
__device__ __forceinline__ void ph_readout_gemm(const P& p, int vb, int nvb, unsigned char* smem) {
  Epi3Readout epi{&p};
  for (int round = 0;; ++round) {
    int tm, tn; const int r = xcd_tile(vb, nvb, round, NTOK / 256, DM / 128, tm, tn);
    if (r == 0) break;
    if (r == 1) gemm_tile3(p.sg, 128, p.g2T, 128, 128, tm * 256, tn * 128, epi, smem);
  }
}
__device__ __forceinline__ void ph_sg(const P& p, int vb, int nvb) {
  for (int it = vb * 256 + TIDX; it < NTOK * 16; it += nvb * 256) {
    const int m = it >> 4, l8 = (it & 15) * 8, t = m % SEQ;
    float o[8];
    load8(p.zA, m, 3328 + l8, o);
    u32x4 w;
#pragma unroll
    for (int i = 0; i < 4; ++i) w[i] = pack2(sigmoidf_(o[2 * i]), sigmoidf_(o[2 * i + 1]));
    *(u32x4*)(p.sg + (size_t)m * 128 + l8) = w;
  }
}
__device__ __forceinline__ void ph_gemm_merge(const P& p, int vb, int nvb, unsigned char* smem) {
  Epi3GateA ea{p.zG, p.b_gate, p.mrg};
  Epi3GateB eb{p.zG, p.b_gate, p.mrg};
  for (int round = 0;; ++round) {
    int tm, tn; const int r = xcd_tile(vb, nvb, round, NTOK / 256, DM / 128, tm, tn);
    if (r == 0) break;
    if (r == 1) {
      gemm_tile3(p.out_a, DM, p.Wt_aout, DM, DM, tm * 256, tn * 128, ea, smem);
      gemm_tile3(p.pooled, 512, p.Wt_eff, 512, 512, tm * 256, tn * 128, eb, smem);
    }
  }
}
__device__ __forceinline__ void ph_gemm_simple(const bf16_t* A, int lda, const bf16_t* Bt, int ldb, int K, int M, int N, bf16_t* C, int ldc, int vb, int nvb, unsigned char* smem) {
  Epi3StoreBf16 epi{C, ldc};
  for (int round = 0;; ++round) {
    int tm, tn; const int r = xcd_tile(vb, nvb, round, M / 256, N / 128, tm, tn);
    if (r == 0) break;
    if (r == 1) gemm_tile3(A, lda, Bt, ldb, K, tm * 256, tn * 128, epi, smem);
  }
}


#define O_R1 0
#define O_R2 10240
#define O_TA (O_R2 + 17408)
#define O_TR (O_TA + 4608)
#define O_TB (O_TR + 4608)
#define O_TK (O_TB + 4608)
#define O_TBT (O_TK + 4608)
#define O_TKT (O_TBT + 5120)
#define O_TVT (O_TKT + 5120)
#define O_GAM (O_TVT + 5120)
#define O_TST (O_GAM + 256)
#define RWKV_SMEM (O_TST + 2 * 9216)
#define NSUP 65
__device__ __forceinline__ void lds_wave_fence() { asm volatile("s_waitcnt lgkmcnt(0)" ::: "memory"); }
__device__ __forceinline__ u32x2 pack4(const f32x4& v) { u32x2 r; r.x = pack2(v[0], v[1]); r.y = pack2(v[2], v[3]); return r; }


typedef short s16x4 __attribute__((ext_vector_type(4)));
__device__ __forceinline__ float fast_tanh(float x) { const float e = __builtin_amdgcn_exp2f(2.885390082f * x); return 1.0f - 2.0f * __builtin_amdgcn_rcpf(e + 1.0f); }
template <int NS, bool WANTY>
__device__ __forceinline__ void rwkv_chunk(const P& p, unsigned char* smem, int d, int h, int rowbase, int T, int isc0, bool has_next, f32x4 (&st)[NS][4], u32x4 (&pf)[5]) {
  int tid = TIDX;
  asm volatile("" : "+v"(tid));
  const int lane = tid & 63, w = __builtin_amdgcn_readfirstlane(tid >> 6), l15 = lane & 15, q = lane >> 4;
  const int tt = tid >> 3, cg = tid & 7, ch0 = h * 64 + cg * 8;
  const int isc = isc0 + tt, t = d == 0 ? isc : T - 1 - isc;
  bf16_t* TWD = (bf16_t*)(smem + O_R1); bf16_t* TAD = TWD + 32 * 72;
  float* WT = (float*)(smem + O_R1);
  bf16_t* XT = (bf16_t*)(smem + O_R1); bf16_t* UT = XT + 64 * 40;
  float* LW = (float*)(smem + O_R2); float* LA = LW + 32 * 68;
  float* TL = (float*)(smem + O_R2);
  bf16_t* TT = (bf16_t*)(smem + O_R2 + 4608); bf16_t* TAK = TT + 32 * 40; bf16_t* TRB = TAK + 32 * 40; bf16_t* TRK = TRB + 32 * 40; bf16_t* TLB = TRK + 32 * 40;
  bf16_t* TA = (bf16_t*)(smem + O_TA); bf16_t* TR = (bf16_t*)(smem + O_TR); bf16_t* TB = (bf16_t*)(smem + O_TB); bf16_t* TK = (bf16_t*)(smem + O_TK);
  bf16_t* TBT = (bf16_t*)(smem + O_TBT); bf16_t* TKT = (bf16_t*)(smem + O_TKT); bf16_t* TVT = (bf16_t*)(smem + O_TVT);
  float* GAM = (float*)(smem + O_GAM);
  bf16_t* TST = (bf16_t*)(smem + O_TST);
  __syncthreads();
  float k8[8], r8[8];
  {
    u32x4 pk;
#pragma unroll
    for (int i = 0; i < 4; ++i) pk[i] = pack2(fast_tanh(bflo(pf[0][i])), fast_tanh(bfhi(pf[0][i])));
    *(u32x4*)(TWD + tt * 72 + cg * 8) = pk;
    *(u32x4*)(TAD + tt * 72 + cg * 8) = pf[1];
  }
#pragma unroll
  for (int i = 0; i < 4; ++i) { k8[2 * i] = bflo(pf[2][i]); k8[2 * i + 1] = bfhi(pf[2][i]); if (WANTY) { r8[2 * i] = bflo(pf[3][i]); r8[2 * i + 1] = bfhi(pf[3][i]); } }
  const u32x4 vzc = pf[4];
  __syncthreads();
  {
    f32x4 lw[2], la[2];
    bf16x8 w2f[2], a2f[2];
#pragma unroll
    for (int ks = 0; ks < 2; ++ks) {
      w2f[ks] = *(const bf16x8*)(p.w2T + ((size_t)d * 1024 + h * 64 + 16 * w + l15) * 64 + 32 * ks + 8 * q);
      a2f[ks] = *(const bf16x8*)(p.a2T + ((size_t)d * 1024 + h * 64 + 16 * w + l15) * 64 + 32 * ks + 8 * q);
    }
#pragma unroll
    for (int it = 0; it < 2; ++it) { lw[it] = (f32x4){0.f, 0.f, 0.f, 0.f}; la[it] = (f32x4){0.f, 0.f, 0.f, 0.f}; }
#pragma unroll
    for (int ks = 0; ks < 2; ++ks)
#pragma unroll
      for (int it = 0; it < 2; ++it) {
        const bf16x8 aw = *(const bf16x8*)(TWD + (16 * it + l15) * 72 + 32 * ks + 8 * q);
        const bf16x8 aa = *(const bf16x8*)(TAD + (16 * it + l15) * 72 + 32 * ks + 8 * q);
        lw[it] = __builtin_amdgcn_mfma_f32_16x16x32_bf16(aw, w2f[ks], lw[it], 0, 0, 0);
        la[it] = __builtin_amdgcn_mfma_f32_16x16x32_bf16(aa, a2f[ks], la[it], 0, 0, 0);
      }
    {
      const float cw0 = p.w0[d * 1024 + h * 64 + 16 * w + l15];
      float tot0 = 0.f;
#pragma unroll
      for (int it = 0; it < 2; ++it) {
        float pr[4];
#pragma unroll
        for (int rg = 0; rg < 4; ++rg) {
          const float e = 0.87505707f * sigmoidf_(cw0 + lw[it][rg]);
          pr[rg] = rg == 0 ? e : pr[rg - 1] + e;
        }
        float x = pr[3];
        float y = __shfl_up(x, 16); if (q >= 1) x += y;
        y = __shfl_up(x, 32); if (q >= 2) x += y;
        const float base = (x - pr[3]) + (it == 1 ? tot0 : 0.f);
        if (it == 0) tot0 = __shfl(x, 48 + l15);
#pragma unroll
        for (int rg = 0; rg < 4; ++rg) lw[it][rg] = pr[rg] + base;
      }
      if (q == 3) GAM[16 * w + l15] = __builtin_amdgcn_exp2f(-lw[1][3]);
    }
#pragma unroll
    for (int it = 0; it < 2; ++it)
#pragma unroll
      for (int rg = 0; rg < 4; ++rg) { LW[(16 * it + 4 * q + rg) * 68 + 16 * w + l15] = lw[it][rg]; LA[(16 * it + 4 * q + rg) * 68 + 16 * w + l15] = la[it][rg]; }
  }
  __syncthreads();
  float icl[8], kkn[8], kd[8];
  {
    float ss = 0.f, bd = 0.f;
    float ca0[8], ckk[8], cka[8], crk[8];
#pragma unroll
    for (int e4 = 0; e4 < 8; e4 += 4) {
      const f32x4 b2 = *(const f32x4*)(p.a0 + d * 1024 + ch0 + e4), c2 = *(const f32x4*)(p.k_k + ch0 + e4);
      const f32x4 d2 = *(const f32x4*)(p.k_a + ch0 + e4), f2 = *(const f32x4*)(p.r_k + ch0 + e4);
#pragma unroll
      for (int e = 0; e < 4; ++e) { ca0[e4 + e] = b2[e]; ckk[e4 + e] = c2[e]; cka[e4 + e] = d2[e]; crk[e4 + e] = f2[e]; }
    }
    float lav[8];
    { const f32x4 l0 = *(const f32x4*)(LA + tt * 68 + cg * 8), l1 = *(const f32x4*)(LA + tt * 68 + cg * 8 + 4);
#pragma unroll
      for (int e = 0; e < 4; ++e) { lav[e] = l0[e]; lav[4 + e] = l1[e]; } }
#pragma unroll
    for (int e = 0; e < 8; ++e) {
      icl[e] = sigmoidf_(ca0[e] + lav[e]);
      kkn[e] = k8[e] * ckk[e]; ss += kkn[e] * kkn[e];
      kd[e] = k8[e] * (1.f + (icl[e] - 1.f) * cka[e]);
      if (WANTY) bd += r8[e] * kd[e] * crk[e];
    }
    ss = red8(ss); if (WANTY) bd = red8(bd);
    const float rn = rsqrtf(fmaxf(ss, 1e-24f));
#pragma unroll
    for (int e = 0; e < 8; ++e) kkn[e] *= rn;
    if (WANTY && cg == 0) p.bdot[((size_t)d * NTOK + rowbase + t) * 16 + h] = bd;
  }
  {
    float ta[8], tr[8], tb[8], tk[8], v8[8];
#pragma unroll
    for (int i = 0; i < 4; ++i) { v8[2 * i] = bflo(vzc[i]); v8[2 * i + 1] = bfhi(vzc[i]); }
    float Lv[8], Lpv[8];
    {
      const f32x4 a0 = *(const f32x4*)(LW + tt * 68 + cg * 8), a1 = *(const f32x4*)(LW + tt * 68 + cg * 8 + 4);
      const int tp = tt > 0 ? tt - 1 : 0;
      const f32x4 b0 = *(const f32x4*)(LW + tp * 68 + cg * 8), b1 = *(const f32x4*)(LW + tp * 68 + cg * 8 + 4);
#pragma unroll
      for (int e = 0; e < 4; ++e) { Lv[e] = a0[e]; Lv[4 + e] = a1[e]; Lpv[e] = tt > 0 ? b0[e] : 0.f; Lpv[4 + e] = tt > 0 ? b1[e] : 0.f; }
    }
#pragma unroll
    for (int e = 0; e < 8; ++e) {
      const float Li = Lv[e];
      const float Lp = Lpv[e];
      const float gi = __builtin_amdgcn_exp2f(-Li), gim1 = __builtin_amdgcn_exp2f(-Lp), ginv = __builtin_amdgcn_exp2f(Li);
      ta[e] = -kkn[e] * gim1; if (WANTY) tr[e] = r8[e] * gi; tb[e] = kkn[e] * icl[e] * ginv; tk[e] = kd[e] * ginv;
    }
    u32x4 pk;
    pk.x = pack2(ta[0], ta[1]); pk.y = pack2(ta[2], ta[3]); pk.z = pack2(ta[4], ta[5]); pk.w = pack2(ta[6], ta[7]); *(u32x4*)(TA + tt * 72 + cg * 8) = pk;
    if (WANTY) { pk.x = pack2(tr[0], tr[1]); pk.y = pack2(tr[2], tr[3]); pk.z = pack2(tr[4], tr[5]); pk.w = pack2(tr[6], tr[7]); *(u32x4*)(TR + tt * 72 + cg * 8) = pk; }
    pk.x = pack2(tb[0], tb[1]); pk.y = pack2(tb[2], tb[3]); pk.z = pack2(tb[4], tb[5]); pk.w = pack2(tb[6], tb[7]); *(u32x4*)(TB + tt * 72 + cg * 8) = pk;
    pk.x = pack2(tk[0], tk[1]); pk.y = pack2(tk[2], tk[3]); pk.z = pack2(tk[4], tk[5]); pk.w = pack2(tk[6], tk[7]); *(u32x4*)(TK + tt * 72 + cg * 8) = pk;
#pragma unroll
    for (int e = 0; e < 8; ++e) { TBT[(cg * 8 + e) * 40 + tt] = f2bf(tb[e]); TKT[(cg * 8 + e) * 40 + tt] = f2bf(tk[e]); TVT[(cg * 8 + e) * 40 + tt] = f2bf(v8[e]); }
  }
  __syncthreads();
  if (WANTY || w < 2) {
    const bf16_t* X = (w < 2) ? TA : TR; const bf16_t* Y = (w & 1) ? TK : TB;
    f32x4 g[2][2];
#pragma unroll
    for (int it = 0; it < 2; ++it)
#pragma unroll
      for (int s2 = 0; s2 < 2; ++s2) g[it][s2] = (f32x4){0.f, 0.f, 0.f, 0.f};
#pragma unroll
    for (int ks = 0; ks < 2; ++ks) {
      bf16x8 xa[2], yb[2];
#pragma unroll
      for (int it = 0; it < 2; ++it) { xa[it] = *(const bf16x8*)(X + (16 * it + l15) * 72 + 32 * ks + 8 * q); yb[it] = *(const bf16x8*)(Y + (16 * it + l15) * 72 + 32 * ks + 8 * q); }
#pragma unroll
      for (int it = 0; it < 2; ++it)
#pragma unroll
        for (int s2 = 0; s2 < 2; ++s2) g[it][s2] = __builtin_amdgcn_mfma_f32_16x16x32_bf16(xa[it], yb[s2], g[it][s2], 0, 0, 0);
    }
    if (w == 0) {
#pragma unroll
      for (int it = 0; it < 2; ++it)
#pragma unroll
        for (int s2 = 0; s2 < 2; ++s2)
#pragma unroll
          for (int rg = 0; rg < 4; ++rg) {
            const int i = 16 * it + 4 * q + rg, s = 16 * s2 + l15;
            TL[i * 36 + s] = (s < i) ? g[it][s2][rg] : 0.f;
          }
#pragma unroll
      for (int rg = 0; rg < 4; ++rg) TLB[(4 * q + rg) * 40 + l15] = f2bf(g[1][0][rg]);
    } else {
      bf16_t* dst = w == 1 ? TAK : (w == 2 ? TRB : TRK);
      const int incl = w == 1 ? 0 : 1;
#pragma unroll
      for (int it = 0; it < 2; ++it)
#pragma unroll
        for (int s2 = 0; s2 < 2; ++s2)
#pragma unroll
          for (int rg = 0; rg < 4; ++rg) {
            const int i = 16 * it + 4 * q + rg, s = 16 * s2 + l15;
            dst[i * 40 + s] = f2bf((s < i + incl) ? g[it][s2][rg] : 0.f);
          }
    }
  }
  if (w == 0) {
    lds_wave_fence();
    const int c = lane & 15, hb = lane & 16;
    float Tr[16];
    f32x4 Lr[16][4];
#pragma unroll
    for (int i = 1; i < 16; ++i)
#pragma unroll
      for (int j4 = 0; j4 < (i + 3) / 4; ++j4) Lr[i][j4] = *(const f32x4*)(TL + (hb + i) * 36 + hb + 4 * j4);
#pragma unroll
    for (int i = 0; i < 16; ++i) {
      float acc = (i == c) ? 1.f : 0.f;
#pragma unroll
      for (int j = 0; j < i; ++j) acc += Lr[i][j >> 2][j & 3] * Tr[j];
      Tr[i] = acc;
    }
    if (lane < 32) {
#pragma unroll
      for (int i = 0; i < 16; ++i) TT[(hb + i) * 40 + hb + c] = f2bf(Tr[i]);
    }
  }
  __syncthreads();
  if (has_next) {
    const int isn = isc + 32, tn = d == 0 ? isn : T - 1 - isn;
    const bf16_t* zr = p.zA + (size_t)(rowbase + tn) * SHIFTC;
    pf[0] = *(const u32x4*)(zr + 3072 + d * 64 + cg * 8);
    pf[1] = *(const u32x4*)(zr + 3200 + d * 64 + cg * 8);
    pf[2] = *(const u32x4*)(zr + 1024 + ch0);
    if (WANTY) pf[3] = *(const u32x4*)(zr + ch0);
    pf[4] = *(const u32x4*)(zr + 2048 + ch0);
  }
  const bf16x8 vfr = *(const bf16x8*)(TVT + (16 * w + l15) * 40 + 8 * q);
  const s16x4 t1f = *(const s16x4*)(TT + l15 * 40 + 4 * q), t2f = *(const s16x4*)(TT + (16 + l15) * 40 + 16 + 4 * q), l21f = *(const s16x4*)(TLB + l15 * 40 + 4 * q);
  bf16_t* XTw = XT + (16 * w + l15) * 40; bf16_t* UTw = UT + (16 * w + l15) * 40;
#pragma unroll
  for (int si = 0; si < NS; ++si) {
    const bool useV = (NS == 1) || (si == 1);
    const bf16_t* STs = TST + (si * 64 + 16 * w + l15) * 72;
    bf16x8 sf[2];
    sf[0] = *(const bf16x8*)(STs + 8 * q); sf[1] = *(const bf16x8*)(STs + 32 + 8 * q);
    f32x4 xa[2];
#pragma unroll
    for (int it = 0; it < 2; ++it) {
      xa[it] = (f32x4){0.f, 0.f, 0.f, 0.f};
#pragma unroll
      for (int ks = 0; ks < 2; ++ks) xa[it] = __builtin_amdgcn_mfma_f32_16x16x32_bf16(*(const bf16x8*)(TA + (16 * it + l15) * 72 + 32 * ks + 8 * q), sf[ks], xa[it], 0, 0, 0);
      if (useV) xa[it] = __builtin_amdgcn_mfma_f32_16x16x32_bf16(*(const bf16x8*)(TAK + (16 * it + l15) * 40 + 8 * q), vfr, xa[it], 0, 0, 0);
    }
    *(u32x2*)(XTw + 4 * q) = pack4(xa[0]);
    lds_wave_fence();
    f32x4 ua = __builtin_amdgcn_mfma_f32_16x16x16bf16_1k(t1f, *(const s16x4*)(XTw + 4 * q), (f32x4){0.f, 0.f, 0.f, 0.f}, 0, 0, 0);
    *(u32x2*)(UTw + 4 * q) = pack4(ua);
    lds_wave_fence();
    xa[1] = __builtin_amdgcn_mfma_f32_16x16x16bf16_1k(l21f, *(const s16x4*)(UTw + 4 * q), xa[1], 0, 0, 0);
    *(u32x2*)(XTw + 16 + 4 * q) = pack4(xa[1]);
    lds_wave_fence();
    ua = __builtin_amdgcn_mfma_f32_16x16x16bf16_1k(t2f, *(const s16x4*)(XTw + 16 + 4 * q), (f32x4){0.f, 0.f, 0.f, 0.f}, 0, 0, 0);
    *(u32x2*)(UTw + 16 + 4 * q) = pack4(ua);
    lds_wave_fence();
    const bf16x8 uf = *(const bf16x8*)(UTw + 8 * q);
    if (WANTY) {
#pragma unroll
      for (int it = 0; it < 2; ++it) {
        f32x4 ya = (f32x4){0.f, 0.f, 0.f, 0.f};
#pragma unroll
        for (int ks = 0; ks < 2; ++ks) ya = __builtin_amdgcn_mfma_f32_16x16x32_bf16(*(const bf16x8*)(TR + (16 * it + l15) * 72 + 32 * ks + 8 * q), sf[ks], ya, 0, 0, 0);
        ya = __builtin_amdgcn_mfma_f32_16x16x32_bf16(*(const bf16x8*)(TRB + (16 * it + l15) * 40 + 8 * q), uf, ya, 0, 0, 0);
        ya = __builtin_amdgcn_mfma_f32_16x16x32_bf16(*(const bf16x8*)(TRK + (16 * it + l15) * 40 + 8 * q), vfr, ya, 0, 0, 0);
        bf16_t* Yd = d == 0 ? p.Y0 : p.Y1;
#pragma unroll
        for (int rg = 0; rg < 4; ++rg) {
          const int iq = isc0 + 16 * it + 4 * q + rg, tq = d == 0 ? iq : T - 1 - iq;
          Yd[(size_t)(rowbase + tq) * DM + h * 64 + 16 * w + l15] = f2bf(ya[rg]);
        }
      }
    }
#pragma unroll
    for (int kt = 0; kt < 4; ++kt) {
      f32x4 hv = st[si][kt];
      hv = __builtin_amdgcn_mfma_f32_16x16x32_bf16(*(const bf16x8*)(TBT + (16 * kt + l15) * 40 + 8 * q), uf, hv, 0, 0, 0);
      if (useV) hv = __builtin_amdgcn_mfma_f32_16x16x32_bf16(*(const bf16x8*)(TKT + (16 * kt + l15) * 40 + 8 * q), vfr, hv, 0, 0, 0);
      hv *= *(const f32x4*)(GAM + 16 * kt + 4 * q);
      st[si][kt] = hv;
      *(u32x2*)(TST + (si * 64 + 16 * w + l15) * 72 + 16 * kt + 4 * q) = pack4(hv);
    }
  }
}

template <bool WANTY>
__device__ __forceinline__ void rwkv_prefetch_first(const P& p, int d, int h, int rowbase, int T, int isc0, u32x4 (&pf)[5]) {
  const int tid = TIDX, tt = tid >> 3, cg = tid & 7, ch0 = h * 64 + cg * 8, isc = isc0 + tt, t = d == 0 ? isc : T - 1 - isc;
  const bf16_t* zr = p.zA + (size_t)(rowbase + t) * SHIFTC;
  pf[0] = *(const u32x4*)(zr + 3072 + d * 64 + cg * 8);
  pf[1] = *(const u32x4*)(zr + 3200 + d * 64 + cg * 8);
  pf[2] = *(const u32x4*)(zr + 1024 + ch0);
  pf[3] = WANTY ? *(const u32x4*)(zr + ch0) : (u32x4){0u, 0u, 0u, 0u};
  pf[4] = *(const u32x4*)(zr + 2048 + ch0);
}
__device__ __forceinline__ void ph_rwkv_A(const P& p, int vb, int nvb, unsigned char* smem) {
  const int tid = TIDX, lane = tid & 63, w = tid >> 6, l15 = lane & 15, q = lane >> 4;
  bf16_t* TST = (bf16_t*)(smem + O_TST);
  for (int item = vb; item < 64 * 64; item += nvb) {
    const int chain = item >> 6, j = item & 63, b = chain >> 5, d = (chain >> 4) & 1, h = chain & 15;
    const bool latent = j > 0;
    const int T = latent ? SEQ : CTXL, rowbase = latent ? b * SEQ : NTOK + b * CTXL, base = latent ? (j - 1) * 256 : 0;
    f32x4 st[2][4];
    __syncthreads();
#pragma unroll
    for (int kt = 0; kt < 4; ++kt) {
#pragma unroll
      for (int rg = 0; rg < 4; ++rg) st[0][kt][rg] = (16 * kt + 4 * q + rg == 16 * w + l15) ? 1.f : 0.f;
      st[1][kt] = (f32x4){0.f, 0.f, 0.f, 0.f};
      *(u32x2*)(TST + (16 * w + l15) * 72 + 16 * kt + 4 * q) = pack4(st[0][kt]);
      *(u32x2*)(TST + (64 + 16 * w + l15) * 72 + 16 * kt + 4 * q) = pack4(st[1][kt]);
    }
    u32x4 pf[5]; rwkv_prefetch_first<false>(p, d, h, rowbase, T, base, pf);
    for (int c = 0; c < 8; ++c) rwkv_chunk<2, false>(p, smem, d, h, rowbase, T, base + 32 * c, c < 7, st, pf);
    const size_t slot = (size_t)chain * NSUP + j;
#pragma unroll
    for (int kt = 0; kt < 4; ++kt) {
#pragma unroll
      for (int rg = 0; rg < 4; ++rg) p.Mst[(slot * 64 + 16 * kt + 4 * q + rg) * 64 + 16 * w + l15] = f2bf(st[0][kt][rg]);
      *(f32x4*)(p.Nst + (slot * 64 + 16 * w + l15) * 64 + 16 * kt + 4 * q) = st[1][kt];
    }
  }
}
__device__ __forceinline__ void ph_rwkv_B(const P& p, int vb, int nvb, unsigned char* smem) {
  const int tid = TIDX, lane = tid & 63, w = tid >> 6, l15 = lane & 15, q = lane >> 4;
  bf16_t* HT = (bf16_t*)smem;
  for (int chain = vb; chain < 64; chain += nvb) {
    f32x4 hs[4];
#pragma unroll
    for (int kt = 0; kt < 4; ++kt) hs[kt] = (f32x4){0.f, 0.f, 0.f, 0.f};
    __syncthreads();
    for (int j = 0; j < 64; ++j) {
      const size_t slot = (size_t)chain * NSUP + j;
      f32x4 nv[4];
#pragma unroll
      for (int kt = 0; kt < 4; ++kt) nv[kt] = *(const f32x4*)(p.Nst + (slot * 64 + 16 * w + l15) * 64 + 16 * kt + 4 * q);
      bf16x8 mf[4][2];
#pragma unroll
      for (int kt = 0; kt < 4; ++kt)
#pragma unroll
        for (int ks = 0; ks < 2; ++ks) mf[kt][ks] = *(const bf16x8*)(p.Mst + (slot * 64 + 16 * kt + l15) * 64 + 32 * ks + 8 * q);
#pragma unroll
      for (int kt = 0; kt < 4; ++kt) {
        *(f32x4*)(p.Nst + (slot * 64 + 16 * w + l15) * 64 + 16 * kt + 4 * q) = hs[kt];
        *(u32x2*)(HT + (16 * w + l15) * 72 + 16 * kt + 4 * q) = pack4(hs[kt]);
      }
      lds_wave_fence();
      bf16x8 hf[2];
      hf[0] = *(const bf16x8*)(HT + (16 * w + l15) * 72 + 8 * q); hf[1] = *(const bf16x8*)(HT + (16 * w + l15) * 72 + 32 + 8 * q);
      lds_wave_fence();
#pragma unroll
      for (int kt = 0; kt < 4; ++kt) {
        f32x4 a = nv[kt];
#pragma unroll
        for (int ks = 0; ks < 2; ++ks) a = __builtin_amdgcn_mfma_f32_16x16x32_bf16(mf[kt][ks], hf[ks], a, 0, 0, 0);
        hs[kt] = a;
      }
    }
    const size_t slot = (size_t)chain * NSUP + 64;
#pragma unroll
    for (int kt = 0; kt < 4; ++kt) *(f32x4*)(p.Nst + (slot * 64 + 16 * w + l15) * 64 + 16 * kt + 4 * q) = hs[kt];
  }
}
__device__ __forceinline__ void ph_rwkv_C(const P& p, int vb, int nvb, unsigned char* smem) {
  const int tid = TIDX, lane = tid & 63, w = tid >> 6, l15 = lane & 15, q = lane >> 4;
  bf16_t* TST = (bf16_t*)(smem + O_TST);
  for (int item = vb; item < 64 * 64; item += nvb) {
    const int chain = item >> 6, j = (item & 63) + 1, b = chain >> 5, d = (chain >> 4) & 1, h = chain & 15;
    f32x4 st[1][4];
    const size_t slot = (size_t)chain * NSUP + j;
    __syncthreads();
#pragma unroll
    for (int kt = 0; kt < 4; ++kt) {
      st[0][kt] = *(const f32x4*)(p.Nst + (slot * 64 + 16 * w + l15) * 64 + 16 * kt + 4 * q);
      *(u32x2*)(TST + (16 * w + l15) * 72 + 16 * kt + 4 * q) = pack4(st[0][kt]);
    }
    u32x4 pf[5]; rwkv_prefetch_first<true>(p, d, h, b * SEQ, SEQ, (j - 1) * 256, pf);
    for (int c = 0; c < 8; ++c) rwkv_chunk<1, true>(p, smem, d, h, b * SEQ, SEQ, (j - 1) * 256 + 32 * c, c < 7, st, pf);
  }
}

#define POOL_SMEM (64 * 128 * 4)
__device__ __forceinline__ void ph_pool(const P& p, int vb, int nvb, unsigned char* smem) {
  float* V = (float*)smem;
  const int tid = TIDX, cp = tid & 63, cq = tid >> 6;
  for (int item = vb; item < 2 * 4 * 64; item += nvb) {
    const int j = item & 3, st = (item >> 2) & 63, b = item >> 8;
    const int win = 2 << j, half = win >> 1;
    const bf16_t* zb = p.zP + (size_t)b * SEQ * 512 + j * 128 + cp * 2;
    float a0[16], a1[16];
#pragma unroll
    for (int i = 0; i < 16; ++i) { a0[i] = 0.f; a1[i] = 0.f; }
    {
      const int r = 4 * st, r0 = max(r - half, 0), r1 = min(r + half, 256);
      for (int rr = r0; rr < r1; ++rr) {
#pragma unroll
        for (int i = 0; i < 16; ++i) { const unsigned u = *(const unsigned*)(zb + (size_t)(rr * 64 + cq * 16 + i) * 512); a0[i] += bflo(u); a1[i] += bfhi(u); }
      }
    }
    for (int dr = 0; dr < 4; ++dr) {
      const int r = 4 * st + dr, r0 = max(r - half, 0), r1 = min(r + half, 256);
      if (dr > 0) {
        const int radd = r + half - 1, rsub = r - half - 1;
        if (radd < 256) {
#pragma unroll
          for (int i = 0; i < 16; ++i) { const unsigned u = *(const unsigned*)(zb + (size_t)(radd * 64 + cq * 16 + i) * 512); a0[i] += bflo(u); a1[i] += bfhi(u); }
        }
        if (rsub >= 0) {
#pragma unroll
          for (int i = 0; i < 16; ++i) { const unsigned u = *(const unsigned*)(zb + (size_t)(rsub * 64 + cq * 16 + i) * 512); a0[i] -= bflo(u); a1[i] -= bfhi(u); }
        }
      }
      __syncthreads();
#pragma unroll
      for (int i = 0; i < 16; ++i) *(f32x2*)(V + (cq * 16 + i) * 128 + cp * 2) = (f32x2){a0[i], a1[i]};
      __syncthreads();
      float s0 = 0.f, s1 = 0.f;
      {
        const int c = cq * 16, c0 = max(c - half, 0), c1 = min(c + half, 64);
        for (int cc = c0; cc < c1; ++cc) { const f32x2 v = *(const f32x2*)(V + cc * 128 + cp * 2); s0 += v.x; s1 += v.y; }
      }
#pragma unroll
      for (int i = 0; i < 16; ++i) {
        const int c = cq * 16 + i, c0 = max(c - half, 0), c1 = min(c + half, 64);
        if (i > 0) {
          const int cadd = c + half - 1, csub = c - half - 1;
          if (cadd < 64) { const f32x2 v = *(const f32x2*)(V + cadd * 128 + cp * 2); s0 += v.x; s1 += v.y; }
          if (csub >= 0) { const f32x2 v = *(const f32x2*)(V + csub * 128 + cp * 2); s0 -= v.x; s1 -= v.y; }
        }
        const float inv = __builtin_amdgcn_rcpf((float)((r1 - r0) * (c1 - c0)));
        const size_t tokoff = ((size_t)b * SEQ + r * 64 + c) * 512 + j * 128 + cp * 2;
        const unsigned u = *(const unsigned*)(p.zP + tokoff);
        *(unsigned*)(p.pooled + tokoff) = pack2(s0 * inv - bflo(u), s1 * inv - bfhi(u));
      }
    }
  }
}
__device__ __forceinline__ void ph_res1(const P& p, int vb, int nvb) {
  const int lane = TIDX & 63, wid = TIDX >> 6;
  for (int m = vb * 4 + wid; m < NTOK; m += nvb * 4) {
    const float* md = p.mod + (m / SEQ) * 6144;
    float mx[16]; float ss = 0.f;
#pragma unroll
    for (int i = 0; i < 4; ++i) {
      const uint2 u = *(const uint2*)(p.mix + (size_t)m * DM + i * 256 + lane * 4);
      mx[4 * i] = bflo(u.x); mx[4 * i + 1] = bfhi(u.x); mx[4 * i + 2] = bflo(u.y); mx[4 * i + 3] = bfhi(u.y);
#pragma unroll
      for (int e = 0; e < 4; ++e) ss += mx[4 * i + e] * mx[4 * i + e];
    }
    ss = wave_sum(ss);
    const float rstd = rsqrtf(ss * (1.0f / 1024.0f) + 1e-6f);
    float x1[16]; float s2 = 0.f;
#pragma unroll
    for (int i = 0; i < 4; ++i) {
      const int col = i * 256 + lane * 4;
      const float4 xv = *(const float4*)(p.x + (size_t)m * DM + col), g = *(const float4*)(p.g_post_mix + col), gt = *(const float4*)(md + 2048 + col);
      x1[4 * i] = xv.x + gt.x * mx[4 * i] * rstd * g.x; x1[4 * i + 1] = xv.y + gt.y * mx[4 * i + 1] * rstd * g.y;
      x1[4 * i + 2] = xv.z + gt.z * mx[4 * i + 2] * rstd * g.z; x1[4 * i + 3] = xv.w + gt.w * mx[4 * i + 3] * rstd * g.w;
      *(float4*)(p.out + (size_t)m * DM + col) = make_float4(x1[4 * i], x1[4 * i + 1], x1[4 * i + 2], x1[4 * i + 3]);
#pragma unroll
      for (int e = 0; e < 4; ++e) s2 += x1[4 * i + e] * x1[4 * i + e];
    }
    s2 = wave_sum(s2);
    const float r2 = rsqrtf(s2 * (1.0f / 1024.0f) + 1e-6f);
#pragma unroll
    for (int i = 0; i < 4; ++i) {
      const int col = i * 256 + lane * 4;
      const float4 g = *(const float4*)(p.g_pre_ffn + col), sh = *(const float4*)(md + 3072 + col), sc = *(const float4*)(md + 4096 + col);
      uint2 w;
      w.x = pack2(x1[4 * i] * r2 * g.x * (1.f + sc.x) + sh.x, x1[4 * i + 1] * r2 * g.y * (1.f + sc.y) + sh.y);
      w.y = pack2(x1[4 * i + 2] * r2 * g.z * (1.f + sc.z) + sh.z, x1[4 * i + 3] * r2 * g.w * (1.f + sc.w) + sh.w);
      *(uint2*)(p.hx2 + (size_t)m * DM + col) = w;
    }
  }
}

#define PS1_SMEM (128 * 133 * 4)
#define CE_DESC(a, b) { const float _mx = fmaxf(a, b), _mn = fminf(a, b); a = _mx; b = _mn; }
template <int N> __device__ __forceinline__ void bitonic_sort_desc(float (&v)[N]) {
#pragma unroll
  for (int k = 2; k <= N; k <<= 1)
#pragma unroll
    for (int j = k >> 1; j > 0; j >>= 1)
#pragma unroll
      for (int i = 0; i < N; ++i) { const int l = i ^ j; if (l > i) { if ((i & k) == 0) CE_DESC(v[i], v[l]) else CE_DESC(v[l], v[i]) } }
}
__device__ __forceinline__ void bitonic_merge16_desc(float (&v)[16]) {
#pragma unroll
  for (int j = 8; j > 0; j >>= 1)
#pragma unroll
    for (int i = 0; i < 16; ++i) { const int l = i ^ j; if (l > i) CE_DESC(v[i], v[l]) }
}
__device__ __forceinline__ void ph_peer_s1(const P& p, int vb, int nvb, unsigned char* smem) {
  float* S = (float*)smem;
  EpiLds epi{S};
  const int tid = TIDX, sub = tid & 3;
  for (int item = vb; item < 256 * 16; item += nvb) {
    const int hp = item & 15, tm = item >> 4;
    __syncthreads();
    gemm_tile(p.q + hp * 128, 2048, p.keys + (size_t)hp * 128 * 128, 128, 128, tm * 128, 0, epi, smem);
    __syncthreads();
#pragma unroll 1
    for (int pass = 0; pass < 2; ++pass) {
      const int row = pass * 64 + (tid >> 2);
      float a[16], b[16];
#pragma unroll
      for (int i = 0; i < 16; ++i) {
        a[i] = __uint_as_float((__float_as_uint(S[row * 133 + sub * 33 + i]) & ~127u) | (unsigned)(sub * 32 + i));
        b[i] = __uint_as_float((__float_as_uint(S[row * 133 + sub * 33 + 16 + i]) & ~127u) | (unsigned)(sub * 32 + 16 + i));
      }
      bitonic_sort_desc<16>(a); bitonic_sort_desc<16>(b);
#pragma unroll
      for (int i = 0; i < 16; ++i) a[i] = fmaxf(a[i], b[15 - i]);
      bitonic_merge16_desc(a);
#pragma unroll
      for (int lvl = 1; lvl <= 2; lvl <<= 1) {
#pragma unroll
        for (int i = 0; i < 16; ++i) b[i] = __shfl_xor(a[i], lvl);
#pragma unroll
        for (int i = 0; i < 16; ++i) a[i] = fmaxf(a[i], b[15 - i]);
        bitonic_merge16_desc(a);
      }
      if (sub == 0) {
        const size_t ob = ((size_t)(tm * 128 + row) * 16 + hp) * 16;
#pragma unroll
        for (int i = 0; i < 16; i += 4) {
          *(f32x4*)(p.sv + ob + i) = (f32x4){a[i], a[i + 1], a[i + 2], a[i + 3]};
          typedef int i32x4 __attribute__((ext_vector_type(4)));
          *(i32x4*)(p.si + ob + i) = (i32x4){(int)(__float_as_uint(a[i]) & 127u), (int)(__float_as_uint(a[i + 1]) & 127u), (int)(__float_as_uint(a[i + 2]) & 127u), (int)(__float_as_uint(a[i + 3]) & 127u)};
        }
      }
    }
  }
}
__device__ __forceinline__ void top16_merge(float (&x)[16], const float (&y)[16]) {
#pragma unroll
  for (int i = 0; i < 16; ++i) x[i] = fmaxf(x[i], y[15 - i]);
  bitonic_merge16_desc(x);
}
__device__ __forceinline__ void ph_peer_s2(const P& p, int vb, int nvb, unsigned char* smem) {
  unsigned char* lut = smem;
  __syncthreads();
  if (TIDX == 0) {
    int n = 0;
#pragma unroll
    for (int i = 0; i < 16; ++i)
#pragma unroll
      for (int j = 0; j < 16; ++j)
        if ((i + 1) * (j + 1) <= 16) { lut[n] = (unsigned char)((i << 4) | j); ++n; }
  }
  __syncthreads();
  for (int it = vb * 256 + TIDX; it < NTOK * 8; it += nvb * 256) {
    const size_t ob = (size_t)it * 32;
    float a[16], bq[16];
#pragma unroll
    for (int i = 0; i < 16; i += 4) {
      const f32x4 fa = *(const f32x4*)(p.sv + ob + i), fb = *(const f32x4*)(p.sv + ob + 16 + i);
#pragma unroll
      for (int e = 0; e < 4; ++e) { a[i + e] = fa[e]; bq[i + e] = fb[e]; }
    }
    float g0[16], g1[16], g2[16], g3[16];
    {
      int n = 0;
#pragma unroll
      for (int i = 0; i < 16; ++i)
#pragma unroll
        for (int j = 0; j < 16; ++j)
          if ((i + 1) * (j + 1) <= 16) {
            const float v = __uint_as_float((__float_as_uint(a[i] + bq[j]) & ~63u) | (unsigned)n);
            if (n < 16) g0[n] = v; else if (n < 32) g1[n - 16] = v; else if (n < 48) g2[n - 32] = v; else g3[n - 48] = v;
            ++n;
          }
#pragma unroll
      for (int k = 2; k < 16; ++k) g3[k] = -3.0e38f;
    }
    bitonic_sort_desc<16>(g0); bitonic_sort_desc<16>(g1); bitonic_sort_desc<16>(g2); bitonic_sort_desc<16>(g3);
    top16_merge(g0, g1); top16_merge(g2, g3); top16_merge(g0, g2);
    float den = 0.f; float ex[16]; int seli[16];
#pragma unroll
    for (int k = 0; k < 16; ++k) {
      ex[k] = __expf(g0[k] - g0[0]); den += ex[k];
      const int ij = lut[__float_as_uint(g0[k]) & 63u];
      const int ka = (int)(__float_as_uint(p.sv[ob + (ij >> 4)]) & 127u), kb = (int)(__float_as_uint(p.sv[ob + 16 + (ij & 15)]) & 127u);
      seli[k] = ka * 128 + kb;
    }
    const float inv = 1.0f / den;
    const size_t o2 = (size_t)it * 16;
    typedef int i32x4 __attribute__((ext_vector_type(4)));
#pragma unroll
    for (int k = 0; k < 16; k += 4) {
      *(i32x4*)(p.pidx + o2 + k) = (i32x4){seli[k], seli[k + 1], seli[k + 2], seli[k + 3]};
      *(f32x4*)(p.pgate + o2 + k) = (f32x4){ex[k] * inv, ex[k + 1] * inv, ex[k + 2] * inv, ex[k + 3] * inv};
    }
  }
}
typedef float f32x16 __attribute__((ext_vector_type(16)));
typedef float f32x32 __attribute__((ext_vector_type(32)));
typedef unsigned u32x6 __attribute__((ext_vector_type(6)));
__device__ __forceinline__ float gelu_as(float v) {
  const float t = __builtin_amdgcn_rcpf(fabsf(v) * 0.2316418882f + 1.0f);
  float qq = t * 0.5307027145f + (-0.7265760135f); qq = qq * t + 0.7107068705f; qq = qq * t + (-0.142248368f); qq = qq * t + 0.127414796f; qq = qq * t;
  const float m = v * (qq * __builtin_amdgcn_exp2f((v * v) * (-0.72134752044f)));
  return v < 0.f ? m : v - m;
}
__device__ __forceinline__ float half_max(float v) {
#pragma unroll
  for (int o = 16; o > 0; o >>= 1) v = fmaxf(v, __shfl_xor(v, o));
  return v;
}
__device__ __forceinline__ float half_sum(float v) {
#pragma unroll
  for (int o = 16; o > 0; o >>= 1) v += __shfl_xor(v, o);
  return v;
}
__device__ __forceinline__ void ph_cvt_fp6(const float* __restrict__ in, unsigned char* __restrict__ out, float* __restrict__ inv_scale, int vb, int nvb) {
  const int lane = TIDX & 63, wid = TIDX >> 6, hf = lane >> 5, sl = lane & 31;
  for (int rp = vb * 4 + wid; rp < 8192; rp += nvb * 4) {
    const int row = rp * 2 + hf;
    f32x16 a, b2; float am = 0.f;
#pragma unroll
    for (int i = 0; i < 4; ++i) {
      const f32x4 v0 = *(const f32x4*)(in + (size_t)row * DM + sl * 32 + 4 * i), v1 = *(const f32x4*)(in + (size_t)row * DM + sl * 32 + 16 + 4 * i);
#pragma unroll
      for (int e = 0; e < 4; ++e) { a[4 * i + e] = v0[e]; b2[4 * i + e] = v1[e]; am = fmaxf(am, fmaxf(fabsf(v0[e]), fabsf(v1[e]))); }
    }
    am = half_max(am);
    const float sc = am > 0.f ? 7.0f / am : 1.0f;
    const u32x6 pk = __builtin_amdgcn_cvt_scalef32_2xpk16_fp6_f32(a * sc, b2 * sc, 1.0f);
    unsigned char* o = out + (size_t)row * 768 + sl * 24;
    *(u32x2*)(o) = (u32x2){pk[0], pk[1]}; *(u32x2*)(o + 8) = (u32x2){pk[2], pk[3]}; *(u32x2*)(o + 16) = (u32x2){pk[4], pk[5]};
    if (sl == 0) inv_scale[row] = am > 0.f ? am / 7.0f : 1.0f;
  }
}
__device__ __forceinline__ u32x6 load_row6(const unsigned char* base, int id, int sl) {
  const unsigned char* q = base + (size_t)id * 768 + sl * 24;
  const u32x2 a = *(const u32x2*)q, b = *(const u32x2*)(q + 8), c = *(const u32x2*)(q + 16);
  return (u32x6){a.x, a.y, b.x, b.y, c.x, c.y};
}
#define GATHER_SMEM (4 * 64 * 33 * 4)
__device__ __forceinline__ void ph_peer_gather(const P& p, int vb, int nvb, unsigned char* smem) {
  int tid_ = TIDX;
  asm volatile("" : "+v"(tid_));
  const int lane = tid_ & 63, wid = tid_ >> 6, hf = lane >> 5, sl = lane & 31;
  float* scr = (float*)smem + (wid * 64 + lane) * 33;
  int* tauL = (int*)(smem + GATHER_SMEM) + wid * 32;
  {
    f32x16 a, b2;
#pragma unroll
    for (int i = 0; i < 16; ++i) { a[i] = __uint_as_float((unsigned)i << 20) * 0x1p126f; b2[i] = __uint_as_float((unsigned)(16 + i) << 20) * 0x1p126f; }
    const f32x32 o = __builtin_amdgcn_cvt_scalef32_pk32_f32_fp6(__builtin_amdgcn_cvt_scalef32_2xpk16_fp6_f32(a, b2, 1.0f), 1.0f);
    if (lane == 0) {
#pragma unroll
      for (int j = 0; j < 32; ++j) tauL[j] = (int)((__float_as_uint(o[j] * 0x1p-126f) >> 20) & 31u);
    }
  }
  const int jmap = 2 * (lane & 1) + ((lane >> 1) & 1);
  __syncthreads();
  for (int m = vb * 4 + wid; m < NTOK; m += nvb * 4) {
    const float* md = p.mod + (m / SEQ) * 6144;
    float xh[32];
    {
#pragma unroll
      for (int c4 = 0; c4 < 4; ++c4) {
        const u32x4 u = *(const u32x4*)(p.hx2 + (size_t)m * DM + sl * 32 + 8 * c4);
#pragma unroll
        for (int e = 0; e < 4; ++e) { scr[8 * c4 + 2 * e] = bflo(u[e]); scr[8 * c4 + 2 * e + 1] = bfhi(u[e]); }
      }
      lds_wave_fence();
#pragma unroll
      for (int j = 0; j < 32; ++j) xh[j] = scr[tauL[j]];
      lds_wave_fence();
    }
    const int id0 = p.pidx[(size_t)m * 128 + lane], id1 = p.pidx[(size_t)m * 128 + 64 + lane];
    const float su0 = p.us[id0], su1 = p.us[id1];
    const float gs0 = p.pgate[(size_t)m * 128 + lane] * p.vs[id0], gs1 = p.pgate[(size_t)m * 128 + 64 + lane] * p.vs[id1];
    float acch[32];
#pragma unroll
    for (int k = 0; k < 32; ++k) acch[k] = 0.f;
#pragma unroll 1
    for (int e0 = 0; e0 < 128; e0 += 8) {
      u32x6 ur[4], vr[4];
#pragma unroll
      for (int j = 0; j < 4; ++j) {
        const int id = __shfl(e0 < 64 ? id0 : id1, (e0 + hf * 4 + j) & 63);
        ur[j] = load_row6(p.ub8, id, sl);
        vr[j] = load_row6(p.vb8, id, sl);
      }
      float d[4];
#pragma unroll
      for (int j = 0; j < 4; ++j) {
        const f32x32 f = __builtin_amdgcn_cvt_scalef32_pk32_f32_fp6(ur[j], 1.0f);
        float s0 = 0.f, s1 = 0.f;
#pragma unroll
        for (int k = 0; k < 32; k += 2) { s0 += f[k] * xh[k]; s1 += f[k + 1] * xh[k + 1]; }
        d[j] = s0 + s1;
        __builtin_amdgcn_sched_barrier(0);
      }
      float r2[2], r1;
      {
        const bool lo = (lane & 1) == 0;
#pragma unroll
        for (int i = 0; i < 2; ++i) { const float keep = lo ? d[i] : d[i + 2], send = lo ? d[i + 2] : d[i]; r2[i] = keep + __shfl_xor(send, 1); }
        const bool lo2 = (lane & 2) == 0;
        { const float keep = lo2 ? r2[0] : r2[1], send = lo2 ? r2[1] : r2[0]; r1 = keep + __shfl_xor(send, 2); }
        r1 += __shfl_xor(r1, 4); r1 += __shfl_xor(r1, 8); r1 += __shfl_xor(r1, 16);
      }
      const int esrc = (e0 + hf * 4 + jmap) & 63;
      const float su = __shfl(e0 < 64 ? su0 : su1, esrc), gs = __shfl(e0 < 64 ? gs0 : gs1, esrc);
      const float sdot = r1 * su;
      const float cf = gelu_as(sdot) * gs;
#pragma unroll
      for (int j = 0; j < 4; ++j) {
        const float cj = __shfl(cf, (lane & 32) | ((j >> 1) | ((j & 1) << 1)));
        const f32x32 f = __builtin_amdgcn_cvt_scalef32_pk32_f32_fp6(vr[j], 1.0f);
#pragma unroll
        for (int k = 0; k < 32; ++k) acch[k] += cj * f[k];
        __builtin_amdgcn_sched_barrier(0);
      }
    }
#pragma unroll
    for (int k = 0; k < 32; ++k) { acch[k] += __shfl_xor(acch[k], 32); scr[tauL[k]] = acch[k]; }
    lds_wave_fence();
    float ss = 0.f;
#pragma unroll
    for (int k = 0; k < 32; ++k) { const float v = scr[k]; ss += v * v; }
    ss = half_sum(ss);
    const float rstd = rsqrtf(ss * (1.0f / 1024.0f) + 1e-6f);
#pragma unroll
    for (int k4 = 0; k4 < 4; ++k4) {
      const int kk = hf * 16 + k4 * 4, col = sl * 32 + kk;
      f32x4 x1 = *(const f32x4*)(p.out + (size_t)m * DM + col);
      const f32x4 g = *(const f32x4*)(p.g_post_ffn + col), gt = *(const f32x4*)(md + 5120 + col);
#pragma unroll
      for (int e = 0; e < 4; ++e) x1[e] += gt[e] * scr[kk + e] * rstd * g[e];
      *(f32x4*)(p.out + (size_t)m * DM + col) = x1;
    }
    lds_wave_fence();
  }
}

#define XB_TMO      128
#define XB_XCNT(j)  (256  + 64 * (j))
#define XB_XSUB(j)  (1280 + 64 * (j))
#define XB_XGEN(j)  (2304 + 64 * (j))
#define XB_TOP      3328
#define XB_TOPGEN   3392
#define XCD_BAR_WORDS 3456
#define XB_SPIN_CAP (1u << 20)
#define LAS __attribute__((address_space(3)))
__device__ __forceinline__ unsigned xb_ld(unsigned* p)              { return __hip_atomic_load(p, __ATOMIC_RELAXED, __HIP_MEMORY_SCOPE_AGENT); }
__device__ __forceinline__ unsigned xb_add(unsigned* p, unsigned v) { return __hip_atomic_fetch_add(p, v, __ATOMIC_RELAXED, __HIP_MEMORY_SCOPE_AGENT); }
__device__ __forceinline__ unsigned xb_xcc_id() { return (unsigned)__builtin_amdgcn_s_getreg((3 << 11) | 20) & 0xFu; }
#define XB_SPIN(cond, bar) do { unsigned _sp = 0; while (cond) { __builtin_amdgcn_s_sleep(1); \
    if ((++_sp & 255u) == 0u) { if (xb_ld(&(bar)[XB_TMO])) break; if (_sp > XB_SPIN_CAP) { atomicAdd(&(bar)[XB_TMO], 1u); break; } } } } while (0)
struct XcdBarrier { unsigned* bar; unsigned x; volatile LAS unsigned* st; };
__device__ __forceinline__ XcdBarrier xcd_barrier_post(unsigned* bar, volatile LAS unsigned* st) {
  XcdBarrier b; b.bar = bar; b.x = xb_xcc_id(); b.st = st;
  if (TIDX == 0) (void)xb_add(&bar[XB_XCNT(b.x)], 1u);
  return b;
}
__device__ __forceinline__ void xcd_barrier_complete(unsigned* bar, unsigned x, unsigned& nloc, unsigned& nx) {
  const unsigned G = gridDim.x * gridDim.y * gridDim.z;
  unsigned sum, cnt, mine, sp = 0u;
  for (;;) {
    sum = 0u; cnt = 0u; mine = 0u;
#pragma unroll
    for (unsigned j = 0; j < 16; ++j) { const unsigned c = xb_ld(&bar[XB_XCNT(j)]); sum += c; cnt += (c > 0u) ? 1u : 0u; mine = (j == x) ? c : mine; }
    if (sum == G) break;
    __builtin_amdgcn_s_sleep(1);
    if ((++sp & 255u) == 0u) { if (xb_ld(&bar[XB_TMO])) break; if (sp > XB_SPIN_CAP) { atomicAdd(&bar[XB_TMO], 1u); break; } }
  }
  nloc = mine > 0u ? mine : 1u; nx = cnt > 0u ? cnt : 1u;
}
__device__ __forceinline__ void xcd_barrier(const XcdBarrier& b) {
  asm volatile("s_waitcnt vmcnt(0)" ::: "memory");
  __syncthreads();
  if (TIDX == 0) {
    unsigned* bar = b.bar;
    __builtin_amdgcn_s_waitcnt(0);
    unsigned nloc = b.st[0], nx = b.st[1];
    if (nloc == 0u) { xcd_barrier_complete(bar, b.x, nloc, nx); b.st[0] = nloc; b.st[1] = nx; }
    const unsigned old = xb_add(&bar[XB_XSUB(b.x)], 1u);
    const unsigned gen = old / nloc;
    if (old + 1u == (gen + 1u) * nloc) {
      __builtin_amdgcn_fence(__ATOMIC_RELEASE, "agent");
      asm volatile("s_waitcnt vmcnt(0)" ::: "memory");
      const unsigned og = xb_add(&bar[XB_TOP], 1u);
      const unsigned tg = og / nx;
      if (og + 1u == (tg + 1u) * nx) xb_add(&bar[XB_TOPGEN], 1u);
      else XB_SPIN(xb_ld(&bar[XB_TOPGEN]) == tg, bar);
      __builtin_amdgcn_fence(__ATOMIC_ACQUIRE, "agent");
      xb_add(&bar[XB_XGEN(b.x)], 1u);
      asm volatile("s_waitcnt vmcnt(0)" ::: "memory");
    } else {
      XB_SPIN(xb_ld(&bar[XB_XGEN(b.x)]) == gen, bar);
      __builtin_amdgcn_fence(__ATOMIC_ACQUIRE, "agent");
      asm volatile("s_waitcnt vmcnt(0)" ::: "memory");
    }
  }
  __syncthreads();
}

#define SMEM_BYTES RWKV_SMEM
__global__ void __launch_bounds__(256, 2) mega(P p) {
  __shared__ __attribute__((aligned(16))) unsigned char smem[SMEM_BYTES + 16];
  cg::grid_group grid = cg::this_grid();
  const int vb = blockIdx.x, nvb = gridDim.x;
  if (TIDX == 0) *(u32x4*)(smem + SMEM_BYTES) = (u32x4){0u, 0u, 0u, 0u};
  __syncthreads();
  const XcdBarrier xb = xcd_barrier_post(p.bar, (volatile LAS unsigned*)(smem + SMEM_BYTES));
  ph_mod(p, vb, nvb, smem);
  ph_colmax(p.w_in, p.colmax, DM, INC, vb, nvb, smem);
  ph_transpose(p.w2, p.w2T, 64, 1024, vb, nvb, smem);
  ph_transpose(p.w2 + 65536, p.w2T + 65536, 64, 1024, vb, nvb, smem);
  ph_transpose(p.a2, p.a2T, 64, 1024, vb, nvb, smem);
  ph_transpose(p.a2 + 65536, p.a2T + 65536, 64, 1024, vb, nvb, smem);
  if (p.bar == nullptr) grid.sync();
  xcd_barrier(xb);
  ph_norm1(p, vb, nvb);
  ph_transpose_i8(p.w_in, p.Wt8, p.colmax, p.wsb, DM, INC, vb, nvb, smem);
  xcd_barrier(xb);
  ph_gemm1(p, vb, nvb, smem);
  xcd_barrier(xb);
  ph_rwkv_A(p, vb, nvb, smem);
  xcd_barrier(xb);
  ph_rwkv_B(p, vb, nvb, smem);
  if (nvb > 128 && vb >= 64) {
    const int v2 = vb - 64, n2 = nvb - 64;
    ph_transpose(p.w_a_out, p.Wt_aout, DM, DM, v2, n2, smem);
    ph_transpose(p.w_o, p.Wt_o, DM, DM, v2, n2, smem);
    ph_transpose(p.peer_wq, p.Wt_q, DM, 2048, v2, n2, smem);
    ph_transpose(p.g2, p.g2T, 128, 1024, v2, n2, smem);
    ph_weff(p, v2, n2);
    ph_convert(p.peer_keys, p.keys, (size_t)16 * 128 * 128, v2, n2);
  } else if (nvb <= 128) {
    ph_transpose(p.w_a_out, p.Wt_aout, DM, DM, vb, nvb, smem);
    ph_transpose(p.w_o, p.Wt_o, DM, DM, vb, nvb, smem);
    ph_transpose(p.peer_wq, p.Wt_q, DM, 2048, vb, nvb, smem);
    ph_transpose(p.g2, p.g2T, 128, 1024, vb, nvb, smem);
    ph_weff(p, vb, nvb);
    ph_convert(p.peer_keys, p.keys, (size_t)16 * 128 * 128, vb, nvb);
  }
  xcd_barrier(xb);
  ph_rwkv_C(p, vb, nvb, smem);
  ph_sg(p, vb, nvb);
  xcd_barrier(xb);
  ph_readout_gemm(p, vb, nvb, smem);
  ph_pool(p, vb, nvb, smem);
  ph_cvt_fp6(p.peer_u, p.ub8, p.us, vb, nvb);
  ph_cvt_fp6(p.peer_v, p.vb8, p.vs, vb, nvb);
  xcd_barrier(xb);
  ph_gemm_merge(p, vb, nvb, smem);
  xcd_barrier(xb);
  ph_gemm_simple(p.mrg, DM, p.Wt_o, DM, DM, NTOK, DM, p.mix, DM, vb, nvb, smem);
  xcd_barrier(xb);
  ph_res1(p, vb, nvb);
  xcd_barrier(xb);
  ph_gemm_simple(p.hx2, DM, p.Wt_q, DM, DM, NTOK, 2048, p.q, 2048, vb, nvb, smem);
  xcd_barrier(xb);
  ph_peer_s1(p, vb, nvb, smem);
  xcd_barrier(xb);
  ph_peer_s2(p, vb, nvb, smem);
  xcd_barrier(xb);
  ph_peer_gather(p, vb, nvb, smem);
}

extern "C" void kernel_launch(void* const* d_in, const int* in_sizes, int n_in, void* d_out, int out_size, void* d_ws, size_t ws_size, hipStream_t stream) {
  P p{};
  const float** f = (const float**)&p;
  for (int i = 0; i < 32; ++i) f[i] = (const float*)d_in[i];
  p.out = (float*)d_out;
  p.bar = (unsigned*)((unsigned char*)d_ws + 511 * 1048576);
  unsigned char* w = (unsigned char*)d_ws;
  const size_t MiB = 1048576;
  const size_t HM = 524288;
  p.hx = (bf16_t*)(w + 4096);
  p.hx8 = (signed char*)(w + 4096);
  p.hsa = (float*)(w + 40 * MiB) + 4;
  p.colmax = p.bar + XCD_BAR_WORDS;
  p.zA = (bf16_t*)(w + 65 * MiB + 8192);
  p.zP = (bf16_t*)(w + 569 * HM);
  p.zG = (bf16_t*)d_out;
  unsigned char* rw = w + 633 * HM;
  p.Wt_in = (bf16_t*)rw; p.Wt8 = (signed char*)rw; rw += 11 * MiB; p.wsb = (float*)rw; rw += 1 * MiB;
  p.Wt_aout = (bf16_t*)rw; rw += 2 * MiB;
  p.Wt_eff = (bf16_t*)rw; rw += 1 * MiB;
  p.Wt_o = (bf16_t*)rw; rw += 2 * MiB;
  p.Wt_q = (bf16_t*)rw; rw += 4 * MiB;
  p.keys = (bf16_t*)rw; rw += HM;
  p.mod = (float*)rw; rw += HM;
  p.g2T = (bf16_t*)rw; rw += HM;
  p.w2T = (bf16_t*)rw; rw += HM;
  p.a2T = (bf16_t*)rw; rw += HM;
  p.Y0 = (bf16_t*)(w + 0 * MiB);
  p.Y1 = (bf16_t*)(w + 340 * MiB);
  p.bdot = (float*)(w + 404 * MiB);
  p.Mst = (bf16_t*)(w + 408 * MiB);
  p.sg = (bf16_t*)(w + 408 * MiB);
  p.Nst = (float*)(w + 441 * MiB);
  p.ub8 = w + 416 * MiB;
  p.vb8 = w + 432 * MiB;
  p.us = (float*)(w + 448 * MiB);
  p.vs = (float*)(w + 449 * MiB);
  p.pooled = (bf16_t*)(w + 478 * MiB);
  p.out_a = (bf16_t*)(w + 0 * MiB);
  p.ya = (bf16_t*)(w + 65 * MiB);
  p.yb = (bf16_t*)(w + 129 * MiB);
  p.mrg = (bf16_t*)(w + 193 * MiB);
  p.mix = (bf16_t*)(w + 65 * MiB);
  p.hx2 = (bf16_t*)(w + 0 * MiB);
  p.q = (bf16_t*)(w + 129 * MiB);
  p.sv = (float*)(w + 340 * MiB);
  p.si = (int*)(w + 372 * MiB);
  p.pidx = (int*)(w + 257 * MiB);
  p.pgate = (float*)(w + 273 * MiB);
  static int grid_blocks = 0;
  if (!grid_blocks) {
    int dev = 0, cus = 0, per_cu = 0;
    hipGetDevice(&dev);
    hipDeviceGetAttribute(&cus, hipDeviceAttributeMultiprocessorCount, dev);
    hipOccupancyMaxActiveBlocksPerMultiprocessor(&per_cu, mega, 256, 0);
    if (per_cu > 2) per_cu = 2;
    if (per_cu < 1) per_cu = 1;
    grid_blocks = cus * per_cu;
  }
  hipMemsetAsync(p.bar, 0, (XCD_BAR_WORDS + 6016) * 4, stream);
  void* args[] = {&p};
  hipError_t e = hipLaunchCooperativeKernel((void*)mega, dim3(grid_blocks), dim3(256), args, 0, stream);
  if (e != hipSuccess) fprintf(stderr, "cooperative launch failed: %s (grid %d)\n", hipGetErrorString(e), grid_blocks);
}
```

```cpp
#include <hip/hip_runtime.h>
#include <hip/hip_cooperative_groups.h>
#include <stdint.h>
#include <cstdio>
namespace cg = cooperative_groups;

typedef unsigned short bf16_t;
typedef short bf16x8 __attribute__((ext_vector_type(8)));
typedef float f32x4 __attribute__((ext_vector_type(4)));
typedef unsigned u32x4 __attribute__((ext_vector_type(4)));
typedef unsigned u32x2 __attribute__((ext_vector_type(2)));
typedef float f32x2 __attribute__((ext_vector_type(2)));

__device__ __forceinline__ int tid_opaque() { int t = threadIdx.x; asm volatile("" : "+v"(t)); return t; }
#define TIDX tid_opaque()
#define NTOK 32768
#define SEQ 16384
#define CTXL 256
#define NCTX 512
#define MROWS 33280
#define DM 1024
#define SHIFTC 3456
#define INC 6016

typedef __bf16 hwbf2 __attribute__((ext_vector_type(2)));
typedef float hwf2 __attribute__((ext_vector_type(2)));
__device__ __forceinline__ unsigned pack2(float a, float b) { return __builtin_bit_cast(unsigned, __builtin_convertvector((hwf2){a, b}, hwbf2)); }
__device__ __forceinline__ bf16_t f2bf(float f) { return __builtin_bit_cast(unsigned short, (__bf16)f); }
__device__ __forceinline__ float bf2f(bf16_t h) { return __uint_as_float(((unsigned)h) << 16); }
__device__ __forceinline__ float bflo(unsigned u) { return __uint_as_float(u << 16); }
__device__ __forceinline__ float bfhi(unsigned u) { return __uint_as_float(u & 0xffff0000u); }
__device__ __forceinline__ float sigmoidf_(float x) { return __builtin_amdgcn_rcpf(1.0f + __expf(-x)); }

__device__ __forceinline__ void load8(const bf16_t* __restrict__ zA, int row, int col0, float* o) {
  const u32x4 zc = *(const u32x4*)(zA + (size_t)row * SHIFTC + col0);
#pragma unroll
  for (int i = 0; i < 4; ++i) { o[2 * i] = bflo(zc[i]); o[2 * i + 1] = bfhi(zc[i]); }
}
__device__ __forceinline__ float red16(float v) {
  v += __shfl_xor(v, 1); v += __shfl_xor(v, 2); v += __shfl_xor(v, 4); v += __shfl_xor(v, 8);
  return v;
}
__device__ __forceinline__ float red8(float v) {
  v += __shfl_xor(v, 1); v += __shfl_xor(v, 2); v += __shfl_xor(v, 4);
  return v;
}

struct P {
  const float *x, *c, *ctx, *c_ctx, *w_mod, *b_mod, *g_pre_mix, *g_post_mix, *g_pre_ffn, *g_post_ffn, *w_in, *b_gate, *mu_shift,
      *w0, *w2, *a0, *a2, *g2, *k_k, *k_a, *r_k, *ln_x_w, *ln_x_b, *w_a_out, *w_pool, *pool_scale, *w_b_out, *w_o, *peer_wq,
      *peer_keys, *peer_u, *peer_v;
  float* out;
  unsigned* bar;
  bf16_t* hx;
  signed char* hx8;
  float* hsa;
  signed char* Wt8;
  float* wsb;
  unsigned* colmax;
  bf16_t* zA;
  bf16_t* zP;
  bf16_t* zG;
  bf16_t* Wt_in;
  bf16_t* Wt_aout;
  bf16_t* Wt_eff;
  bf16_t* Wt_o;
  bf16_t* Wt_q;
  bf16_t* keys;
  float* mod;
  unsigned char* ub8;
  unsigned char* vb8;
  float* us;
  float* vs;
  bf16_t* sg;
  bf16_t* g2T;
  bf16_t* w2T;
  bf16_t* a2T;
  bf16_t* Mst;
  float* Nst;
  bf16_t* Y0;
  bf16_t* Y1;
  float* bdot;
  bf16_t* out_a;
  bf16_t* ya;
  bf16_t* pooled;
  bf16_t* yb;
  bf16_t* mrg;
  bf16_t* mix;
  bf16_t* hx2;
  bf16_t* q;
  float* sv;
  int* si;
  int* pidx;
  float* pgate;
};

#define GS 72
#define GEMM_SMEM (2 * 128 * GS * 2)
template <class Epi>
__device__ __forceinline__ void gemm_tile(const bf16_t* __restrict__ A, int lda, const bf16_t* __restrict__ Bt, int ldb, int K, int m0, int n0,
                                          const Epi& epi, unsigned char* smem) {
  const int tid = TIDX, lane = tid & 63, wid = tid >> 6, wr = wid >> 1, wc = wid & 1;
  bf16_t* sA = (bf16_t*)smem;
  bf16_t* sB = sA + 128 * GS;
  f32x4 acc[4][4];
#pragma unroll
  for (int i = 0; i < 4; ++i)
#pragma unroll
    for (int j = 0; j < 4; ++j) acc[i][j] = (f32x4){0.f, 0.f, 0.f, 0.f};
  const int lrow = tid >> 3, lcol = (tid & 7) * 8;
  const bf16_t* pa = A + (size_t)(m0 + lrow) * lda + lcol;
  const bf16_t* pb = Bt + (size_t)(n0 + lrow) * ldb + lcol;
  u32x4 ra[4], rb[4];
#pragma unroll
  for (int p = 0; p < 4; ++p) {
    ra[p] = *(const u32x4*)(pa + (size_t)(32 * p) * lda);
    rb[p] = *(const u32x4*)(pb + (size_t)(32 * p) * ldb);
  }
  for (int k0 = 0; k0 < K; k0 += 64) {
#pragma unroll
    for (int p = 0; p < 4; ++p) {
      *(u32x4*)(sA + (lrow + 32 * p) * GS + lcol) = ra[p];
      *(u32x4*)(sB + (lrow + 32 * p) * GS + lcol) = rb[p];
    }
    __syncthreads();
    if (k0 + 64 < K) {
#pragma unroll
      for (int p = 0; p < 4; ++p) {
        ra[p] = *(const u32x4*)(pa + (size_t)(32 * p) * lda + k0 + 64);
        rb[p] = *(const u32x4*)(pb + (size_t)(32 * p) * ldb + k0 + 64);
      }
    }
#pragma unroll
    for (int kk = 0; kk < 2; ++kk) {
      bf16x8 af[4], bfr[4];
#pragma unroll
      for (int i = 0; i < 4; ++i) af[i] = *(const bf16x8*)(sA + (wr * 64 + i * 16 + (lane & 15)) * GS + kk * 32 + (lane >> 4) * 8);
#pragma unroll
      for (int j = 0; j < 4; ++j) bfr[j] = *(const bf16x8*)(sB + (wc * 64 + j * 16 + (lane & 15)) * GS + kk * 32 + (lane >> 4) * 8);
#pragma unroll
      for (int i = 0; i < 4; ++i)
#pragma unroll
        for (int j = 0; j < 4; ++j) acc[i][j] = __builtin_amdgcn_mfma_f32_16x16x32_bf16(bfr[j], af[i], acc[i][j], 0, 0, 0);
    }
    __syncthreads();
  }
#pragma unroll
  for (int i = 0; i < 4; ++i)
#pragma unroll
    for (int j = 0; j < 4; ++j) epi(m0 + wr * 64 + i * 16 + (lane & 15), n0 + wc * 64 + j * 16 + (lane >> 4) * 4, acc[i][j]);
}

#define G3_STAGE 24576
#define G3_ES 136
#define GEMM3_SMEM (256 * G3_ES * 2)
typedef __attribute__((address_space(3))) unsigned lds_u32;
template <class Epi>
__device__ __forceinline__ void gemm_tile3(const bf16_t* __restrict__ A, int lda, const bf16_t* __restrict__ Bt, int ldb, int K, int m0, int n0,
                                           const Epi& epi, unsigned char* smem) {
  int tid = TIDX;
  asm volatile("" : "+v"(tid));
  const int lane = tid & 63, wid = __builtin_amdgcn_readfirstlane(tid >> 6), wr = wid >> 1, wc = wid & 1, l15 = lane & 15, q = lane >> 4;
  f32x4 acc[8][4];
#pragma unroll
  for (int i = 0; i < 8; ++i)
#pragma unroll
    for (int j = 0; j < 4; ++j) acc[i][j] = (f32x4){0.f, 0.f, 0.f, 0.f};
  const int gr = lane >> 2, gc = ((lane & 3) ^ (((gr >> 2) & 1) << 1)) * 8;
  const bf16_t* pa = A + (long)(m0 + wid * 64 + gr) * lda + gc;
  const bf16_t* pb = Bt + (size_t)(n0 + wid * 32 + gr) * ldb + gc;
  unsigned char* dA = smem + wid * 4096 + lane * 16;
  unsigned char* dB = smem + 16384 + wid * 2048 + lane * 16;
  const int sw = (q ^ (((l15 >> 2) & 1) << 1)) * 16;
  const unsigned char* fA = smem + (wr * 128 + l15) * 64 + sw;
  const unsigned char* fB = smem + 16384 + (wc * 64 + l15) * 64 + sw;
#define G3_ISSUE(ST, KT) { _Pragma("unroll") for (int ii = 0; ii < 4; ++ii) __builtin_amdgcn_global_load_lds((const unsigned*)(pa + (size_t)(16 * ii) * lda + (KT) * 32), (lds_u32*)(dA + (ST) * G3_STAGE + ii * 1024), 16, 0, 0); \
                           _Pragma("unroll") for (int ii = 0; ii < 2; ++ii) __builtin_amdgcn_global_load_lds((const unsigned*)(pb + (size_t)(16 * ii) * ldb + (KT) * 32), (lds_u32*)(dB + (ST) * G3_STAGE + ii * 1024), 16, 0, 0); }
  const int nk = K >> 5;
  __syncthreads();
  G3_ISSUE(0, 0);
  for (int kt = 0; kt < nk; ++kt) {
    const int cur = kt & 1;
    asm volatile("s_waitcnt vmcnt(0)" ::: "memory");
    __syncthreads();
    if (kt + 1 < nk) G3_ISSUE(cur ^ 1, kt + 1);
    const unsigned char* cA = fA + cur * G3_STAGE;
    const unsigned char* cB = fB + cur * G3_STAGE;
    bf16x8 bfr[4];
#pragma unroll
    for (int j = 0; j < 4; ++j) bfr[j] = *(const bf16x8*)(cB + j * 1024);
#pragma unroll
    for (int i = 0; i < 8; ++i) {
      const bf16x8 af = *(const bf16x8*)(cA + i * 1024);
#pragma unroll
      for (int j = 0; j < 4; ++j) acc[i][j] = __builtin_amdgcn_mfma_f32_16x16x32_bf16(bfr[j], af, acc[i][j], 0, 0, 0);
    }
  }
#undef G3_ISSUE
  bf16_t* sE = (bf16_t*)smem;
  __syncthreads();
#pragma unroll
  for (int i = 0; i < 8; ++i)
#pragma unroll
    for (int j = 0; j < 4; ++j) {
      u32x2 w; w.x = pack2(acc[i][j][0], acc[i][j][1]); w.y = pack2(acc[i][j][2], acc[i][j][3]);
      *(u32x2*)(sE + (wr * 128 + i * 16 + l15) * G3_ES + wc * 64 + j * 16 + q * 4) = w;
    }
  __syncthreads();
  epi.finish(sE, m0, n0, tid);
}
typedef int i32x4v __attribute__((ext_vector_type(4)));
template <class Epi>
__device__ __forceinline__ void gemm_tile3_i8(const signed char* __restrict__ A, int lda, const signed char* __restrict__ Bt, int ldb, int K, int m0, int n0,
                                              const float* __restrict__ sa, const float* __restrict__ sb, const Epi& epi, unsigned char* smem) {
  int tid = TIDX;
  asm volatile("" : "+v"(tid));
  const int lane = tid & 63, wid = __builtin_amdgcn_readfirstlane(tid >> 6), wr = wid >> 1, wc = wid & 1, l15 = lane & 15, q = lane >> 4;
  i32x4v acc[8][4];
#pragma unroll
  for (int i = 0; i < 8; ++i)
#pragma unroll
    for (int j = 0; j < 4; ++j) acc[i][j] = (i32x4v){0, 0, 0, 0};
  const int gr = lane >> 2, gc = ((lane & 3) ^ (((gr >> 2) & 1) << 1)) * 16;
  const signed char* pa = A + (long)(m0 + wid * 64 + gr) * lda + gc;
  const signed char* pb = Bt + (size_t)(n0 + wid * 32 + gr) * ldb + gc;
  unsigned char* dA = smem + wid * 4096 + lane * 16;
  unsigned char* dB = smem + 16384 + wid * 2048 + lane * 16;
  const int sw = (q ^ (((l15 >> 2) & 1) << 1)) * 16;
  const unsigned char* fA = smem + (wr * 128 + l15) * 64 + sw;
  const unsigned char* fB = smem + 16384 + (wc * 64 + l15) * 64 + sw;
#define G3_ISSUE(ST, KT) { _Pragma("unroll") for (int ii = 0; ii < 4; ++ii) __builtin_amdgcn_global_load_lds((const unsigned*)(pa + (size_t)(16 * ii) * lda + (KT) * 64), (lds_u32*)(dA + (ST) * G3_STAGE + ii * 1024), 16, 0, 0); \
                           _Pragma("unroll") for (int ii = 0; ii < 2; ++ii) __builtin_amdgcn_global_load_lds((const unsigned*)(pb + (size_t)(16 * ii) * ldb + (KT) * 64), (lds_u32*)(dB + (ST) * G3_STAGE + ii * 1024), 16, 0, 0); }
  const int nk = K >> 6;
  __syncthreads();
  G3_ISSUE(0, 0);
  for (int kt = 0; kt < nk; ++kt) {
    const int cur = kt & 1;
    asm volatile("s_waitcnt vmcnt(0)" ::: "memory");
    __syncthreads();
    if (kt + 1 < nk) G3_ISSUE(cur ^ 1, kt + 1);
    const unsigned char* cA = fA + cur * G3_STAGE;
    const unsigned char* cB = fB + cur * G3_STAGE;
    i32x4v bfr[4];
#pragma unroll
    for (int j = 0; j < 4; ++j) bfr[j] = *(const i32x4v*)(cB + j * 1024);
#pragma unroll
    for (int i = 0; i < 8; ++i) {
      const i32x4v af = *(const i32x4v*)(cA + i * 1024);
#pragma unroll
      for (int j = 0; j < 4; ++j) acc[i][j] = __builtin_amdgcn_mfma_i32_16x16x64_i8(bfr[j], af, acc[i][j], 0, 0, 0);
    }
  }
#undef G3_ISSUE
  bf16_t* sE = (bf16_t*)smem;
  f32x4 sb4[4];
#pragma unroll
  for (int j = 0; j < 4; ++j) sb4[j] = *(const f32x4*)(sb + n0 + wc * 64 + j * 16 + q * 4);
  __syncthreads();
#pragma unroll
  for (int i = 0; i < 8; ++i) {
    const float sr = sa[m0 + wr * 128 + i * 16 + l15];
#pragma unroll
    for (int j = 0; j < 4; ++j) {
      u32x2 w;
      w.x = pack2((float)acc[i][j][0] * (sr * sb4[j][0]), (float)acc[i][j][1] * (sr * sb4[j][1]));
      w.y = pack2((float)acc[i][j][2] * (sr * sb4[j][2]), (float)acc[i][j][3] * (sr * sb4[j][3]));
      *(u32x2*)(sE + (wr * 128 + i * 16 + l15) * G3_ES + wc * 64 + j * 16 + q * 4) = w;
    }
  }
  __syncthreads();
  epi.finish(sE, m0, n0, tid);
}
template <class D> struct Epi3RowChunks {
  __device__ __forceinline__ void finish(const bf16_t* sE, int m0, int n0, int tid) const {
#pragma unroll
    for (int pp = 0; pp < 16; ++pp) {
      const int id = tid + 256 * pp, row = id >> 4, cc = (id & 15) * 8;
      static_cast<const D*>(this)->store(m0 + row, n0 + cc, *(const u32x4*)(sE + row * G3_ES + cc));
    }
  }
};
struct Epi3StoreBf16 : Epi3RowChunks<Epi3StoreBf16> {
  bf16_t* C; int ldc;
  __device__ Epi3StoreBf16(bf16_t* c, int l) : C(c), ldc(l) {}
  __device__ __forceinline__ void store(int m, int n, const u32x4& v) const { *(u32x4*)(C + (size_t)m * ldc + n) = v; }
};
struct Epi3GateA : Epi3RowChunks<Epi3GateA> {
  const bf16_t* zG; const float* bg; bf16_t* mrg;
  __device__ Epi3GateA(const bf16_t* z, const float* b, bf16_t* m) : zG(z), bg(b), mrg(m) {}
  __device__ __forceinline__ void store(int m, int n, const u32x4& v) const {
    const u32x4 g = *(const u32x4*)(zG + (size_t)m * 2048 + n);
    const f32x4 b0 = *(const f32x4*)(bg + n), b1 = *(const f32x4*)(bg + n + 4);
    u32x4 o;
#pragma unroll
    for (int i = 0; i < 4; ++i) {
      const float bl = i < 2 ? b0[2 * i] : b1[2 * i - 4], bh = i < 2 ? b0[2 * i + 1] : b1[2 * i - 3];
      o[i] = pack2(sigmoidf_(bflo(g[i]) + bl) * bflo(v[i]), sigmoidf_(bfhi(g[i]) + bh) * bfhi(v[i]));
    }
    *(u32x4*)(mrg + (size_t)m * DM + n) = o;
  }
};
struct Epi3GateB : Epi3RowChunks<Epi3GateB> {
  const bf16_t* zG; const float* bg; bf16_t* mrg;
  __device__ Epi3GateB(const bf16_t* z, const float* b, bf16_t* m) : zG(z), bg(b), mrg(m) {}
  __device__ __forceinline__ void store(int m, int n, const u32x4& v) const {
    const u32x4 g = *(const u32x4*)(zG + (size_t)m * 2048 + 1024 + n);
    const u32x4 a = *(const u32x4*)(mrg + (size_t)m * DM + n);
    const f32x4 b0 = *(const f32x4*)(bg + 1024 + n), b1 = *(const f32x4*)(bg + 1024 + n + 4);
    u32x4 o;
#pragma unroll
    for (int i = 0; i < 4; ++i) {
      const float bl = i < 2 ? b0[2 * i] : b1[2 * i - 4], bh = i < 2 ? b0[2 * i + 1] : b1[2 * i - 3];
      o[i] = pack2(bflo(a[i]) + sigmoidf_(bflo(g[i]) + bl) * bflo(v[i]), bfhi(a[i]) + sigmoidf_(bfhi(g[i]) + bh) * bfhi(v[i]));
    }
    *(u32x4*)(mrg + (size_t)m * DM + n) = o;
  }
};
struct Epi3ZS {
  bf16_t* zA; const float* mu; int own_lo, own_hi, t0, T;
  __device__ __forceinline__ void finish(const bf16_t* sE, int m0, int n0, int tid) const {
#pragma unroll 4
    for (int pq = 0; pq < 16; ++pq) {
      const int id = tid + 256 * pq, row = id >> 4, cc = (id & 15) * 8, t = t0 + row;
      if (row < own_lo || row > own_hi) continue;
      const u32x4 zc = *(const u32x4*)(sE + row * G3_ES + cc);
      u32x4 zp = (u32x4){0u, 0u, 0u, 0u}, zn = (u32x4){0u, 0u, 0u, 0u};
      if (t > 0) zp = *(const u32x4*)(sE + (row - 1) * G3_ES + cc);
      if (t < T - 1) zn = *(const u32x4*)(sE + (row + 1) * G3_ES + cc);
      const f32x4 m0v = *(const f32x4*)(mu + n0 + cc), m1v = *(const f32x4*)(mu + n0 + cc + 4);
      const float mm[8] = {m0v[0], m0v[1], m0v[2], m0v[3], m1v[0], m1v[1], m1v[2], m1v[3]};
      u32x4 o;
#pragma unroll
      for (int i = 0; i < 4; ++i) {
        const float z0 = bflo(zc[i]), z1 = bfhi(zc[i]);
        o[i] = pack2(z0 + mm[2 * i] * (0.5f * (bflo(zp[i]) + bflo(zn[i])) - z0), z1 + mm[2 * i + 1] * (0.5f * (bfhi(zp[i]) + bfhi(zn[i])) - z1));
      }
      *(u32x4*)(zA + (long)(m0 + row) * SHIFTC + n0 + cc) = o;
    }
  }
};
struct Epi3Z : Epi3RowChunks<Epi3Z> {
  bf16_t *zA, *zP, *zG;
  __device__ Epi3Z(bf16_t* a, bf16_t* b, bf16_t* c) : zA(a), zP(b), zG(c) {}
  __device__ __forceinline__ void store(int m, int n, const u32x4& v) const {
    if (n < SHIFTC) *(u32x4*)(zA + (size_t)m * SHIFTC + n) = v;
    else if (m < NTOK) {
      if (n < SHIFTC + 512) *(u32x4*)(zP + (size_t)m * 512 + (n - SHIFTC)) = v;
      else *(u32x4*)(zG + (size_t)m * 2048 + (n - SHIFTC - 512)) = v;
    }
  }
};

struct EpiLds {
  float* S;
  __device__ __forceinline__ void operator()(int m, int n, const f32x4& v) const {
    float* r = S + (m & 127) * 133 + n + (n >> 5);
    r[0] = v[0]; r[1] = v[1]; r[2] = v[2]; r[3] = v[3];
  }
};

__device__ __forceinline__ void ph_transpose(const float* __restrict__ in, bf16_t* __restrict__ out, int K, int N, int vb, int nvb, unsigned char* smem) {
  float* t = (float*)smem;
  const int tk = K / 64, tn = N / 64, tid = TIDX, tx = tid & 15, ty = tid >> 4;
  for (int it = vb; it < tk * tn; it += nvb) {
    const int k0 = (it / tn) * 64, n0 = (it % tn) * 64;
    __syncthreads();
#pragma unroll
    for (int r = 0; r < 4; ++r) {
      const f32x4 v = *(const f32x4*)(in + (size_t)(k0 + ty + 16 * r) * N + n0 + 4 * tx);
#pragma unroll
      for (int e = 0; e < 4; ++e) t[(ty + 16 * r) * 65 + 4 * tx + e] = v[e];
    }
    __syncthreads();
    const int n = tid >> 2, kq = (tid & 3) * 16;
    u32x4 w0, w1;
#pragma unroll
    for (int e = 0; e < 4; ++e) {
      w0[e] = pack2(t[(kq + 2 * e) * 65 + n], t[(kq + 2 * e + 1) * 65 + n]);
      w1[e] = pack2(t[(kq + 8 + 2 * e) * 65 + n], t[(kq + 8 + 2 * e + 1) * 65 + n]);
    }
    *(u32x4*)(out + (size_t)(n0 + n) * K + k0 + kq) = w0;
    *(u32x4*)(out + (size_t)(n0 + n) * K + k0 + kq + 8) = w1;
  }
}
__device__ __forceinline__ void ph_colmax(const float* __restrict__ in, unsigned* __restrict__ colmax, int K, int N, int vb, int nvb, unsigned char* smem) {
  float* red = (float*)smem;
  const int tk = K / 64, tn = N / 64, tid = TIDX, n = tid & 63, kq = tid >> 6;
  for (int it = vb; it < tk * tn; it += nvb) {
    const int k0 = (it / tn) * 64 + kq * 16, n0 = (it % tn) * 64;
    float mx = 0.f;
#pragma unroll
    for (int r = 0; r < 16; ++r) mx = fmaxf(mx, fabsf(in[(size_t)(k0 + r) * N + n0 + n]));
    __syncthreads();
    red[kq * 64 + n] = mx;
    __syncthreads();
    if (kq == 0) atomicMax(colmax + n0 + n, __float_as_uint(fmaxf(fmaxf(red[n], red[64 + n]), fmaxf(red[128 + n], red[192 + n]))));
  }
}
__device__ __forceinline__ void ph_transpose_i8(const float* __restrict__ in, signed char* __restrict__ out, const unsigned* __restrict__ colmax, float* __restrict__ sbv,
                                                int K, int N, int vb, int nvb, unsigned char* smem) {
  float* t = (float*)smem;
  const int tk = K / 64, tn = N / 64, tid = TIDX, tx = tid & 15, ty = tid >> 4;
  for (int it = vb; it < tk * tn; it += nvb) {
    const int k0 = (it / tn) * 64, n0 = (it % tn) * 64;
    __syncthreads();
#pragma unroll
    for (int r = 0; r < 4; ++r) {
      const f32x4 v = *(const f32x4*)(in + (size_t)(k0 + ty + 16 * r) * N + n0 + 4 * tx);
#pragma unroll
      for (int e = 0; e < 4; ++e) t[(ty + 16 * r) * 65 + 4 * tx + e] = v[e];
    }
    __syncthreads();
    const int n = tid >> 2, kq = (tid & 3) * 16;
    const float cmx = __uint_as_float(colmax[n0 + n]);
    const float sc = cmx > 0.f ? 127.0f / cmx : 0.f;
    if (k0 == 0 && kq == 0) sbv[n0 + n] = cmx > 0.f ? cmx / 127.0f : 1.0f;
    u32x4 w;
#pragma unroll
    for (int e = 0; e < 4; ++e) {
      unsigned pk = 0;
#pragma unroll
      for (int b = 0; b < 4; ++b) { const int qv = (int)rintf(t[(kq + 4 * e + b) * 65 + n] * sc); pk |= ((unsigned)qv & 255u) << (8 * b); }
      w[e] = pk;
    }
    *(u32x4*)(out + (size_t)(n0 + n) * K + k0 + kq) = w;
  }
}
__device__ __forceinline__ void ph_convert(const float* __restrict__ in, bf16_t* __restrict__ out, size_t n, int vb, int nvb) {
  for (size_t i = ((size_t)vb * 256 + TIDX) * 4; i < n; i += (size_t)nvb * 1024) {
    const float4 v = *(const float4*)(in + i);
    uint2 w; w.x = pack2(v.x, v.y); w.y = pack2(v.z, v.w);
    *(uint2*)(out + i) = w;
  }
}
__device__ __forceinline__ void ph_weff(const P& p, int vb, int nvb) {
  for (int it = vb * 256 + TIDX; it < 512 * 1024; it += nvb * 256) {
    const int n = it & 1023, k = it >> 10, j = k >> 7, kl = k & 127;
    const float* wp = p.w_pool + ((size_t)j * 128 + kl) * 128;
    float s = 0.f;
    for (int c = 0; c < 128; ++c) s += wp[c] * p.pool_scale[j * 128 + c] * p.w_b_out[(size_t)(j * 128 + c) * 1024 + n];
    p.Wt_eff[(size_t)n * 512 + k] = f2bf(s);
  }
}
__device__ __forceinline__ void ph_mod(const P& p, int vb, int nvb, unsigned char* smem) {
  float* red = (float*)smem;
  const int lane = TIDX & 63, wid = TIDX >> 6;
  for (int it = vb; it < 96; it += nvb) {
    const int n = it * 64 + lane;
    float a0 = 0.f, a1 = 0.f, a2 = 0.f;
#pragma unroll 8
    for (int k = wid * 256; k < wid * 256 + 256; ++k) {
      const float w = p.w_mod[(size_t)k * 6144 + n];
      const float c0 = p.c[k], c1 = p.c[1024 + k], c2 = p.c_ctx[k];
      a0 += c0 * sigmoidf_(c0) * w; a1 += c1 * sigmoidf_(c1) * w; a2 += c2 * sigmoidf_(c2) * w;
    }
    __syncthreads();
    red[(wid * 3 + 0) * 64 + lane] = a0; red[(wid * 3 + 1) * 64 + lane] = a1; red[(wid * 3 + 2) * 64 + lane] = a2;
    __syncthreads();
    if (wid < 3) {
      const float sum = red[(0 * 3 + wid) * 64 + lane] + red[(1 * 3 + wid) * 64 + lane] + red[(2 * 3 + wid) * 64 + lane] + red[(3 * 3 + wid) * 64 + lane];
      p.mod[wid * 6144 + n] = sum + p.b_mod[n];
    }
  }
}
__device__ __forceinline__ float wave_sum(float v) {
#pragma unroll
  for (int o = 32; o > 0; o >>= 1) v += __shfl_xor(v, o);
  return v;
}
__device__ __forceinline__ void ph_norm1(const P& p, int vb, int nvb) {
  const int lane = TIDX & 63, wid = TIDX >> 6, nw = nvb * 4;
  for (int m0 = vb * 4 + wid; m0 < MROWS; m0 += 2 * nw) {
    const int m1 = m0 + nw; const bool has1 = m1 < MROWS; const int mb = has1 ? m1 : m0;
    const float* srcA = m0 < NTOK ? p.x + (size_t)m0 * DM : p.ctx + (size_t)(m0 - NTOK) * DM;
    const float* srcB = mb < NTOK ? p.x + (size_t)mb * DM : p.ctx + (size_t)(mb - NTOK) * DM;
    f32x4 va[4], vbq[4]; float sa = 0.f, sb = 0.f;
#pragma unroll
    for (int i = 0; i < 4; ++i) { va[i] = *(const f32x4*)(srcA + i * 256 + lane * 4); vbq[i] = *(const f32x4*)(srcB + i * 256 + lane * 4); }
#pragma unroll
    for (int i = 0; i < 4; ++i)
#pragma unroll
      for (int e = 0; e < 4; ++e) { sa += va[i][e] * va[i][e]; sb += vbq[i][e] * vbq[i][e]; }
    sa = wave_sum(sa); sb = wave_sum(sb);
#pragma unroll
    for (int rr = 0; rr < 2; ++rr) {
      if (rr == 1 && !has1) break;
      const int m = rr == 0 ? m0 : m1;
      const float rstd = rsqrtf((rr == 0 ? sa : sb) * (1.0f / 1024.0f) + 1e-6f);
      const float* md = p.mod + (m < NTOK ? (m / SEQ) : 2) * 6144;
      f32x4 y[4]; float am = 0.f;
#pragma unroll
      for (int i = 0; i < 4; ++i) {
        const int col = i * 256 + lane * 4;
        const f32x4 v = rr == 0 ? va[i] : vbq[i];
        const f32x4 g = *(const f32x4*)(p.g_pre_mix + col), sh = *(const f32x4*)(md + col), sc = *(const f32x4*)(md + 1024 + col);
#pragma unroll
        for (int e = 0; e < 4; ++e) { y[i][e] = v[e] * rstd * g[e] * (1.f + sc[e]) + sh[e]; am = fmaxf(am, fabsf(y[i][e])); }
      }
#pragma unroll
      for (int o = 32; o > 0; o >>= 1) am = fmaxf(am, __shfl_xor(am, o));
      const float qs = am > 0.f ? 127.0f / am : 0.f;
      if (lane == 0) p.hsa[m] = am > 0.f ? am / 127.0f : 1.0f;
#pragma unroll
      for (int i = 0; i < 4; ++i) {
        unsigned pk = 0;
#pragma unroll
        for (int e = 0; e < 4; ++e) pk |= ((unsigned)(int)rintf(y[i][e] * qs) & 255u) << (8 * e);
        *(unsigned*)(p.hx8 + (size_t)m * DM + i * 256 + lane * 4) = pk;
      }
    }
  }
}
struct Epi3Readout {
  const P* pp;
  __device__ __forceinline__ void finish(const bf16_t* sE, int m0, int n0, int tid) const {
    const P& p = *pp;
#pragma unroll 2
    for (int pq = 0; pq < 16; ++pq) {
      const int id = tid + 256 * pq, row = id >> 4, cc = (id & 15) * 8, m = m0 + row, n = n0 + cc, t = m % SEQ, h = n >> 6;
      const u32x4 g = *(const u32x4*)(sE + row * G3_ES + cc);
      const u32x4 y0 = *(const u32x4*)(p.Y0 + (size_t)m * DM + n);
      float y[8], v[8];
#pragma unroll
      for (int i = 0; i < 4; ++i) { y[2 * i] = bflo(y0[i]); y[2 * i + 1] = bfhi(y0[i]); }
      float sm = 0.f;
#pragma unroll
      for (int i = 0; i < 8; ++i) sm += y[i];
      const float mu = red8(sm) * (1.f / 64.f);
      float qv = 0.f;
#pragma unroll
      for (int i = 0; i < 8; ++i) { y[i] -= mu; qv += y[i] * y[i]; }
      const float rs = rsqrtf(red8(qv) * (1.f / 64.f) + 64e-5f);
      load8(p.zA, m, 2048 + n, v);
      const float bon = 0.5f * (p.bdot[(size_t)m * 16 + h] + p.bdot[((size_t)NTOK + m) * 16 + h]);
      const f32x4 w0 = *(const f32x4*)(p.ln_x_w + n), w1 = *(const f32x4*)(p.ln_x_w + n + 4), b0 = *(const f32x4*)(p.ln_x_b + n), b1 = *(const f32x4*)(p.ln_x_b + n + 4);
      const float lw[8] = {w0[0], w0[1], w0[2], w0[3], w1[0], w1[1], w1[2], w1[3]}, lb[8] = {b0[0], b0[1], b0[2], b0[3], b1[0], b1[1], b1[2], b1[3]};
      u32x4 o;
#pragma unroll
      for (int i = 0; i < 4; ++i)
        o[i] = pack2((y[2 * i] * rs * lw[2 * i] + lb[2 * i] + bon * v[2 * i]) * bflo(g[i]), (y[2 * i + 1] * rs * lw[2 * i + 1] + lb[2 * i + 1] + bon * v[2 * i + 1]) * bfhi(g[i]));
      *(u32x4*)(p.out_a + (size_t)m * DM + n) = o;
    }
  }
};
__device__ __forceinline__ int xcd_tile(int vb, int nvb, int round, int TM, int TN, int& tm, int& tn) {
  if (nvb % 64 != 0) { const int it = round * nvb + vb; if (it >= TM * TN) return 0; tm = it % TM; tn = it / TM; return 1; }
  const int spg = nvb >> 3, g = vb & 7, slot = vb >> 3, SC = spg >> 3;
  const int nsr = (TM + 7) >> 3, nsc = (TN + SC - 1) / SC, st = round * 8 + g;
  if (st >= nsr * nsc) return 0;
  tm = (st % nsr) * 8 + (slot & 7); tn = (st / nsr) * SC + (slot >> 3);
  return (tm < TM && tn < TN) ? 1 : 2;
}
__device__ __forceinline__ void ph_gemm1(const P& p, int vb, int nvb, unsigned char* smem) {
  const int NS_ = 132 * 27, NALL = NS_ + 128 * 20;
  const int per = nvb >> 3;
  for (int round = 0;; ++round) {
    int item;
    if ((nvb & 7) == 0) { const int blk = round * 8 + (vb & 7); if (blk * per >= NALL) break; item = blk * per + (vb >> 3); if (item >= NALL) continue; }
    else { item = round * nvb + vb; if (item >= NALL) break; }
    if (item < NS_) {
      const int cgp = item / (132 * 9), rem = item % (132 * 9), tmS = rem / 9, tn = cgp * 9 + rem % 9;
      Epi3ZS epi;
      epi.zA = p.zA; epi.mu = p.mu_shift;
      int m0;
      if (tmS < 130) { const int b = tmS / 65, i = tmS % 65; m0 = b * SEQ + 254 * i - 1; epi.own_lo = 1; epi.own_hi = min(254, SEQ - 254 * i); epi.t0 = 254 * i - 1; epi.T = SEQ; }
      else { m0 = NTOK + (tmS - 130) * CTXL; epi.own_lo = 0; epi.own_hi = 255; epi.t0 = 0; epi.T = CTXL; }
      gemm_tile3_i8(p.hx8, DM, p.Wt8, DM, DM, m0, tn * 128, p.hsa, p.wsb, epi, smem);
    } else {
      const int i2 = item - NS_;
      int tm, tn;
      if (i2 < 2048) { tm = (i2 & 1023) >> 3; tn = 27 + (i2 >> 10) * 8 + (i2 & 7); } else { tm = (i2 - 2048) >> 2; tn = 43 + (i2 & 3); }
      Epi3Z epi{p.zA, p.zP, p.zG};
      gemm_tile3_i8(p.hx8, DM, p.Wt8, DM, DM, tm * 256, tn * 128, p.hsa, p.wsb, epi, smem);
    }
  }
}
__device__ __forceinline__ void ph_readout_gemm(const P& p, int vb, int nvb, unsigned char* smem) {
  Epi3Readout epi{&p};
  for (int round = 0;; ++round) {
    int tm, tn; const int r = xcd_tile(vb, nvb, round, NTOK / 256, DM / 128, tm, tn);
    if (r == 0) break;
    if (r == 1) gemm_tile3(p.sg, 128, p.g2T, 128, 128, tm * 256, tn * 128, epi, smem);
  }
}
__device__ __forceinline__ void ph_sg(const P& p, int vb, int nvb) {
  for (int it = vb * 256 + TIDX; it < NTOK * 16; it += nvb * 256) {
    const int m = it >> 4, l8 = (it & 15) * 8, t = m % SEQ;
    float o[8];
    load8(p.zA, m, 3328 + l8, o);
    u32x4 w;
#pragma unroll
    for (int i = 0; i < 4; ++i) w[i] = pack2(sigmoidf_(o[2 * i]), sigmoidf_(o[2 * i + 1]));
    *(u32x4*)(p.sg + (size_t)m * 128 + l8) = w;
  }
}
__device__ __forceinline__ void ph_gemm_merge(const P& p, int vb, int nvb, unsigned char* smem) {
  Epi3GateA ea{p.zG, p.b_gate, p.mrg};
  Epi3GateB eb{p.zG, p.b_gate, p.mrg};
  for (int round = 0;; ++round) {
    int tm, tn; const int r = xcd_tile(vb, nvb, round, NTOK / 256, DM / 128, tm, tn);
    if (r == 0) break;
    if (r == 1) {
      gemm_tile3(p.out_a, DM, p.Wt_aout, DM, DM, tm * 256, tn * 128, ea, smem);
      gemm_tile3(p.pooled, 512, p.Wt_eff, 512, 512, tm * 256, tn * 128, eb, smem);
    }
  }
}
__device__ __forceinline__ void ph_gemm_simple(const bf16_t* A, int lda, const bf16_t* Bt, int ldb, int K, int M, int N, bf16_t* C, int ldc, int vb, int nvb, unsigned char* smem) {
  Epi3StoreBf16 epi{C, ldc};
  for (int round = 0;; ++round) {
    int tm, tn; const int r = xcd_tile(vb, nvb, round, M / 256, N / 128, tm, tn);
    if (r == 0) break;
    if (r == 1) gemm_tile3(A, lda, Bt, ldb, K, tm * 256, tn * 128, epi, smem);
  }
}


#define O_R1 0
#define O_R2 10240
#define O_TA (O_R2 + 17408)
#define O_TR (O_TA + 4608)
#define O_TB (O_TR + 4608)
#define O_TK (O_TB + 4608)
#define O_TBT (O_TK + 4608)
#define O_TKT (O_TBT + 5120)
#define O_TVT (O_TKT + 5120)
#define O_GAM (O_TVT + 5120)
#define O_TST (O_GAM + 256)
#define RWKV_SMEM (O_TST + 2 * 9216)
#define NSUP 65
__device__ __forceinline__ void lds_wave_fence() { asm volatile("s_waitcnt lgkmcnt(0)" ::: "memory"); }
__device__ __forceinline__ u32x2 pack4(const f32x4& v) { u32x2 r; r.x = pack2(v[0], v[1]); r.y = pack2(v[2], v[3]); return r; }


typedef short s16x4 __attribute__((ext_vector_type(4)));
__device__ __forceinline__ float fast_tanh(float x) { const float e = __builtin_amdgcn_exp2f(2.885390082f * x); return 1.0f - 2.0f * __builtin_amdgcn_rcpf(e + 1.0f); }
template <int NS, bool WANTY>
__device__ __forceinline__ void rwkv_chunk(const P& p, unsigned char* smem, int d, int h, int rowbase, int T, int isc0, bool has_next, f32x4 (&st)[NS][4], u32x4 (&pf)[5]) {
  int tid = TIDX;
  asm volatile("" : "+v"(tid));
  const int lane = tid & 63, w = __builtin_amdgcn_readfirstlane(tid >> 6), l15 = lane & 15, q = lane >> 4;
  const int tt = tid >> 3, cg = tid & 7, ch0 = h * 64 + cg * 8;
  const int isc = isc0 + tt, t = d == 0 ? isc : T - 1 - isc;
  bf16_t* TWD = (bf16_t*)(smem + O_R1); bf16_t* TAD = TWD + 32 * 72;
  float* WT = (float*)(smem + O_R1);
  bf16_t* XT = (bf16_t*)(smem + O_R1); bf16_t* UT = XT + 64 * 40;
  float* LW = (float*)(smem + O_R2); float* LA = LW + 32 * 68;
  float* TL = (float*)(smem + O_R2);
  bf16_t* TT = (bf16_t*)(smem + O_R2 + 4608); bf16_t* TAK = TT + 32 * 40; bf16_t* TRB = TAK + 32 * 40; bf16_t* TRK = TRB + 32 * 40; bf16_t* TLB = TRK + 32 * 40;
  bf16_t* TA = (bf16_t*)(smem + O_TA); bf16_t* TR = (bf16_t*)(smem + O_TR); bf16_t* TB = (bf16_t*)(smem + O_TB); bf16_t* TK = (bf16_t*)(smem + O_TK);
  bf16_t* TBT = (bf16_t*)(smem + O_TBT); bf16_t* TKT = (bf16_t*)(smem + O_TKT); bf16_t* TVT = (bf16_t*)(smem + O_TVT);
  float* GAM = (float*)(smem + O_GAM);
  bf16_t* TST = (bf16_t*)(smem + O_TST);
  __syncthreads();
  float k8[8], r8[8];
  {
    u32x4 pk;
#pragma unroll
    for (int i = 0; i < 4; ++i) pk[i] = pack2(fast_tanh(bflo(pf[0][i])), fast_tanh(bfhi(pf[0][i])));
    *(u32x4*)(TWD + tt * 72 + cg * 8) = pk;
    *(u32x4*)(TAD + tt * 72 + cg * 8) = pf[1];
  }
#pragma unroll
  for (int i = 0; i < 4; ++i) { k8[2 * i] = bflo(pf[2][i]); k8[2 * i + 1] = bfhi(pf[2][i]); if (WANTY) { r8[2 * i] = bflo(pf[3][i]); r8[2 * i + 1] = bfhi(pf[3][i]); } }
  const u32x4 vzc = pf[4];
  __syncthreads();
  {
    f32x4 lw[2], la[2];
    bf16x8 w2f[2], a2f[2];
#pragma unroll
    for (int ks = 0; ks < 2; ++ks) {
      w2f[ks] = *(const bf16x8*)(p.w2T + ((size_t)d * 1024 + h * 64 + 16 * w + l15) * 64 + 32 * ks + 8 * q);
      a2f[ks] = *(const bf16x8*)(p.a2T + ((size_t)d * 1024 + h * 64 + 16 * w + l15) * 64 + 32 * ks + 8 * q);
    }
#pragma unroll
    for (int it = 0; it < 2; ++it) { lw[it] = (f32x4){0.f, 0.f, 0.f, 0.f}; la[it] = (f32x4){0.f, 0.f, 0.f, 0.f}; }
#pragma unroll
    for (int ks = 0; ks < 2; ++ks)
#pragma unroll
      for (int it = 0; it < 2; ++it) {
        const bf16x8 aw = *(const bf16x8*)(TWD + (16 * it + l15) * 72 + 32 * ks + 8 * q);
        const bf16x8 aa = *(const bf16x8*)(TAD + (16 * it + l15) * 72 + 32 * ks + 8 * q);
        lw[it] = __builtin_amdgcn_mfma_f32_16x16x32_bf16(aw, w2f[ks], lw[it], 0, 0, 0);
        la[it] = __builtin_amdgcn_mfma_f32_16x16x32_bf16(aa, a2f[ks], la[it], 0, 0, 0);
      }
    {
      const float cw0 = p.w0[d * 1024 + h * 64 + 16 * w + l15];
      float tot0 = 0.f;
#pragma unroll
      for (int it = 0; it < 2; ++it) {
        float pr[4];
#pragma unroll
        for (int rg = 0; rg < 4; ++rg) {
          const float e = 0.87505707f * sigmoidf_(cw0 + lw[it][rg]);
          pr[rg] = rg == 0 ? e : pr[rg - 1] + e;
        }
        float x = pr[3];
        float y = __shfl_up(x, 16); if (q >= 1) x += y;
        y = __shfl_up(x, 32); if (q >= 2) x += y;
        const float base = (x - pr[3]) + (it == 1 ? tot0 : 0.f);
        if (it == 0) tot0 = __shfl(x, 48 + l15);
#pragma unroll
        for (int rg = 0; rg < 4; ++rg) lw[it][rg] = pr[rg] + base;
      }
      if (q == 3) GAM[16 * w + l15] = __builtin_amdgcn_exp2f(-lw[1][3]);
    }
#pragma unroll
    for (int it = 0; it < 2; ++it)
#pragma unroll
      for (int rg = 0; rg < 4; ++rg) { LW[(16 * it + 4 * q + rg) * 68 + 16 * w + l15] = lw[it][rg]; LA[(16 * it + 4 * q + rg) * 68 + 16 * w + l15] = la[it][rg]; }
  }
  __syncthreads();
  float icl[8], kkn[8], kd[8];
  {
    float ss = 0.f, bd = 0.f;
    float ca0[8], ckk[8], cka[8], crk[8];
#pragma unroll
    for (int e4 = 0; e4 < 8; e4 += 4) {
      const f32x4 b2 = *(const f32x4*)(p.a0 + d * 1024 + ch0 + e4), c2 = *(const f32x4*)(p.k_k + ch0 + e4);
      const f32x4 d2 = *(const f32x4*)(p.k_a + ch0 + e4), f2 = *(const f32x4*)(p.r_k + ch0 + e4);
#pragma unroll
      for (int e = 0; e < 4; ++e) { ca0[e4 + e] = b2[e]; ckk[e4 + e] = c2[e]; cka[e4 + e] = d2[e]; crk[e4 + e] = f2[e]; }
    }
    float lav[8];
    { const f32x4 l0 = *(const f32x4*)(LA + tt * 68 + cg * 8), l1 = *(const f32x4*)(LA + tt * 68 + cg * 8 + 4);
#pragma unroll
      for (int e = 0; e < 4; ++e) { lav[e] = l0[e]; lav[4 + e] = l1[e]; } }
#pragma unroll
    for (int e = 0; e < 8; ++e) {
      icl[e] = sigmoidf_(ca0[e] + lav[e]);
      kkn[e] = k8[e] * ckk[e]; ss += kkn[e] * kkn[e];
      kd[e] = k8[e] * (1.f + (icl[e] - 1.f) * cka[e]);
      if (WANTY) bd += r8[e] * kd[e] * crk[e];
    }
    ss = red8(ss); if (WANTY) bd = red8(bd);
    const float rn = rsqrtf(fmaxf(ss, 1e-24f));
#pragma unroll
    for (int e = 0; e < 8; ++e) kkn[e] *= rn;
    if (WANTY && cg == 0) p.bdot[((size_t)d * NTOK + rowbase + t) * 16 + h] = bd;
  }
  {
    float ta[8], tr[8], tb[8], tk[8], v8[8];
#pragma unroll
    for (int i = 0; i < 4; ++i) { v8[2 * i] = bflo(vzc[i]); v8[2 * i + 1] = bfhi(vzc[i]); }
    float Lv[8], Lpv[8];
    {
      const f32x4 a0 = *(const f32x4*)(LW + tt * 68 + cg * 8), a1 = *(const f32x4*)(LW + tt * 68 + cg * 8 + 4);
      const int tp = tt > 0 ? tt - 1 : 0;
      const f32x4 b0 = *(const f32x4*)(LW + tp * 68 + cg * 8), b1 = *(const f32x4*)(LW + tp * 68 + cg * 8 + 4);
#pragma unroll
      for (int e = 0; e < 4; ++e) { Lv[e] = a0[e]; Lv[4 + e] = a1[e]; Lpv[e] = tt > 0 ? b0[e] : 0.f; Lpv[4 + e] = tt > 0 ? b1[e] : 0.f; }
    }
#pragma unroll
    for (int e = 0; e < 8; ++e) {
      const float Li = Lv[e];
      const float Lp = Lpv[e];
      const float gi = __builtin_amdgcn_exp2f(-Li), gim1 = __builtin_amdgcn_exp2f(-Lp), ginv = __builtin_amdgcn_exp2f(Li);
      ta[e] = -kkn[e] * gim1; if (WANTY) tr[e] = r8[e] * gi; tb[e] = kkn[e] * icl[e] * ginv; tk[e] = kd[e] * ginv;
    }
    u32x4 pk;
    pk.x = pack2(ta[0], ta[1]); pk.y = pack2(ta[2], ta[3]); pk.z = pack2(ta[4], ta[5]); pk.w = pack2(ta[6], ta[7]); *(u32x4*)(TA + tt * 72 + cg * 8) = pk;
    if (WANTY) { pk.x = pack2(tr[0], tr[1]); pk.y = pack2(tr[2], tr[3]); pk.z = pack2(tr[4], tr[5]); pk.w = pack2(tr[6], tr[7]); *(u32x4*)(TR + tt * 72 + cg * 8) = pk; }
    pk.x = pack2(tb[0], tb[1]); pk.y = pack2(tb[2], tb[3]); pk.z = pack2(tb[4], tb[5]); pk.w = pack2(tb[6], tb[7]); *(u32x4*)(TB + tt * 72 + cg * 8) = pk;
    pk.x = pack2(tk[0], tk[1]); pk.y = pack2(tk[2], tk[3]); pk.z = pack2(tk[4], tk[5]); pk.w = pack2(tk[6], tk[7]); *(u32x4*)(TK + tt * 72 + cg * 8) = pk;
#pragma unroll
    for (int e = 0; e < 8; ++e) { TBT[(cg * 8 + e) * 40 + tt] = f2bf(tb[e]); TKT[(cg * 8 + e) * 40 + tt] = f2bf(tk[e]); TVT[(cg * 8 + e) * 40 + tt] = f2bf(v8[e]); }
  }
  __syncthreads();
  if (WANTY || w < 2) {
    const bf16_t* X = (w < 2) ? TA : TR; const bf16_t* Y = (w & 1) ? TK : TB;
    f32x4 g[2][2];
#pragma unroll
    for (int it = 0; it < 2; ++it)
#pragma unroll
      for (int s2 = 0; s2 < 2; ++s2) g[it][s2] = (f32x4){0.f, 0.f, 0.f, 0.f};
#pragma unroll
    for (int ks = 0; ks < 2; ++ks) {
      bf16x8 xa[2], yb[2];
#pragma unroll
      for (int it = 0; it < 2; ++it) { xa[it] = *(const bf16x8*)(X + (16 * it + l15) * 72 + 32 * ks + 8 * q); yb[it] = *(const bf16x8*)(Y + (16 * it + l15) * 72 + 32 * ks + 8 * q); }
#pragma unroll
      for (int it = 0; it < 2; ++it)
#pragma unroll
        for (int s2 = 0; s2 < 2; ++s2) g[it][s2] = __builtin_amdgcn_mfma_f32_16x16x32_bf16(xa[it], yb[s2], g[it][s2], 0, 0, 0);
    }
    if (w == 0) {
#pragma unroll
      for (int it = 0; it < 2; ++it)
#pragma unroll
        for (int s2 = 0; s2 < 2; ++s2)
#pragma unroll
          for (int rg = 0; rg < 4; ++rg) {
            const int i = 16 * it + 4 * q + rg, s = 16 * s2 + l15;
            TL[i * 36 + s] = (s < i) ? g[it][s2][rg] : 0.f;
          }
#pragma unroll
      for (int rg = 0; rg < 4; ++rg) TLB[(4 * q + rg) * 40 + l15] = f2bf(g[1][0][rg]);
    } else {
      bf16_t* dst = w == 1 ? TAK : (w == 2 ? TRB : TRK);
      const int incl = w == 1 ? 0 : 1;
#pragma unroll
      for (int it = 0; it < 2; ++it)
#pragma unroll
        for (int s2 = 0; s2 < 2; ++s2)
#pragma unroll
          for (int rg = 0; rg < 4; ++rg) {
            const int i = 16 * it + 4 * q + rg, s = 16 * s2 + l15;
            dst[i * 40 + s] = f2bf((s < i + incl) ? g[it][s2][rg] : 0.f);
          }
    }
  }
  if (w == 0) {
    lds_wave_fence();
    const int c = lane & 15, hb = lane & 16;
    float Tr[16];
    f32x4 Lr[16][4];
#pragma unroll
    for (int i = 1; i < 16; ++i)
#pragma unroll
      for (int j4 = 0; j4 < (i + 3) / 4; ++j4) Lr[i][j4] = *(const f32x4*)(TL + (hb + i) * 36 + hb + 4 * j4);
#pragma unroll
    for (int i = 0; i < 16; ++i) {
      float acc = (i == c) ? 1.f : 0.f;
#pragma unroll
      for (int j = 0; j < i; ++j) acc += Lr[i][j >> 2][j & 3] * Tr[j];
      Tr[i] = acc;
    }
    if (lane < 32) {
#pragma unroll
      for (int i = 0; i < 16; ++i) TT[(hb + i) * 40 + hb + c] = f2bf(Tr[i]);
    }
  }
  __syncthreads();
  if (has_next) {
    const int isn = isc + 32, tn = d == 0 ? isn : T - 1 - isn;
    const bf16_t* zr = p.zA + (size_t)(rowbase + tn) * SHIFTC;
    pf[0] = *(const u32x4*)(zr + 3072 + d * 64 + cg * 8);
    pf[1] = *(const u32x4*)(zr + 3200 + d * 64 + cg * 8);
    pf[2] = *(const u32x4*)(zr + 1024 + ch0);
    if (WANTY) pf[3] = *(const u32x4*)(zr + ch0);
    pf[4] = *(const u32x4*)(zr + 2048 + ch0);
  }
  bf16_t yprev[2][4];
  if (WANTY) {
#pragma unroll
    for (int it = 0; it < 2; ++it)
#pragma unroll
      for (int rg = 0; rg < 4; ++rg) {
        yprev[it][rg] = 0;
        if (d == 1) yprev[it][rg] = p.Y0[(size_t)(rowbase + T - 1 - (isc0 + 16 * it + 4 * q + rg)) * DM + h * 64 + 16 * w + l15];
      }
  }
  const bf16x8 vfr = *(const bf16x8*)(TVT + (16 * w + l15) * 40 + 8 * q);
  const s16x4 t1f = *(const s16x4*)(TT + l15 * 40 + 4 * q), t2f = *(const s16x4*)(TT + (16 + l15) * 40 + 16 + 4 * q), l21f = *(const s16x4*)(TLB + l15 * 40 + 4 * q);
  bf16_t* XTw = XT + (16 * w + l15) * 40; bf16_t* UTw = UT + (16 * w + l15) * 40;
#pragma unroll
  for (int si = 0; si < NS; ++si) {
    const bool useV = (NS == 1) || (si == 1);
    const bf16_t* STs = TST + (si * 64 + 16 * w + l15) * 72;
    bf16x8 sf[2];
    sf[0] = *(const bf16x8*)(STs + 8 * q); sf[1] = *(const bf16x8*)(STs + 32 + 8 * q);
    f32x4 xa[2];
#pragma unroll
    for (int it = 0; it < 2; ++it) {
      xa[it] = (f32x4){0.f, 0.f, 0.f, 0.f};
#pragma unroll
      for (int ks = 0; ks < 2; ++ks) xa[it] = __builtin_amdgcn_mfma_f32_16x16x32_bf16(*(const bf16x8*)(TA + (16 * it + l15) * 72 + 32 * ks + 8 * q), sf[ks], xa[it], 0, 0, 0);
      if (useV) xa[it] = __builtin_amdgcn_mfma_f32_16x16x32_bf16(*(const bf16x8*)(TAK + (16 * it + l15) * 40 + 8 * q), vfr, xa[it], 0, 0, 0);
    }
    *(u32x2*)(XTw + 4 * q) = pack4(xa[0]);
    lds_wave_fence();
    f32x4 ua = __builtin_amdgcn_mfma_f32_16x16x16bf16_1k(t1f, *(const s16x4*)(XTw + 4 * q), (f32x4){0.f, 0.f, 0.f, 0.f}, 0, 0, 0);
    *(u32x2*)(UTw + 4 * q) = pack4(ua);
    lds_wave_fence();
    xa[1] = __builtin_amdgcn_mfma_f32_16x16x16bf16_1k(l21f, *(const s16x4*)(UTw + 4 * q), xa[1], 0, 0, 0);
    *(u32x2*)(XTw + 16 + 4 * q) = pack4(xa[1]);
    lds_wave_fence();
    ua = __builtin_amdgcn_mfma_f32_16x16x16bf16_1k(t2f, *(const s16x4*)(XTw + 16 + 4 * q), (f32x4){0.f, 0.f, 0.f, 0.f}, 0, 0, 0);
    *(u32x2*)(UTw + 16 + 4 * q) = pack4(ua);
    lds_wave_fence();
    const bf16x8 uf = *(const bf16x8*)(UTw + 8 * q);
    if (WANTY) {
#pragma unroll
      for (int it = 0; it < 2; ++it) {
        f32x4 ya = (f32x4){0.f, 0.f, 0.f, 0.f};
#pragma unroll
        for (int ks = 0; ks < 2; ++ks) ya = __builtin_amdgcn_mfma_f32_16x16x32_bf16(*(const bf16x8*)(TR + (16 * it + l15) * 72 + 32 * ks + 8 * q), sf[ks], ya, 0, 0, 0);
        ya = __builtin_amdgcn_mfma_f32_16x16x32_bf16(*(const bf16x8*)(TRB + (16 * it + l15) * 40 + 8 * q), uf, ya, 0, 0, 0);
        if (useV) ya = __builtin_amdgcn_mfma_f32_16x16x32_bf16(*(const bf16x8*)(TRK + (16 * it + l15) * 40 + 8 * q), vfr, ya, 0, 0, 0);
#pragma unroll
        for (int rg = 0; rg < 4; ++rg) {
          const int iq = isc0 + 16 * it + 4 * q + rg, tq = d == 0 ? iq : T - 1 - iq;
          if (useV) {
            p.Y0[(size_t)(rowbase + tq) * DM + h * 64 + 16 * w + l15] = f2bf(ya[rg] + bf2f(yprev[it][rg]));
          } else {
            bf16_t* pp = d == 0 ? p.Y1 + (size_t)(rowbase + tq) * DM : p.zA + (size_t)(rowbase + tq) * SHIFTC;
            pp[h * 64 + 16 * w + l15] = f2bf(ya[rg]);
          }
        }
      }
    }
#pragma unroll
    for (int kt = 0; kt < 4; ++kt) {
      f32x4 hv = st[si][kt];
      hv = __builtin_amdgcn_mfma_f32_16x16x32_bf16(*(const bf16x8*)(TBT + (16 * kt + l15) * 40 + 8 * q), uf, hv, 0, 0, 0);
      if (useV) hv = __builtin_amdgcn_mfma_f32_16x16x32_bf16(*(const bf16x8*)(TKT + (16 * kt + l15) * 40 + 8 * q), vfr, hv, 0, 0, 0);
      hv *= *(const f32x4*)(GAM + 16 * kt + 4 * q);
      st[si][kt] = hv;
      *(u32x2*)(TST + (si * 64 + 16 * w + l15) * 72 + 16 * kt + 4 * q) = pack4(hv);
    }
  }
}

template <bool WANTY>
__device__ __forceinline__ void rwkv_prefetch_first(const P& p, int d, int h, int rowbase, int T, int isc0, u32x4 (&pf)[5]) {
  const int tid = TIDX, tt = tid >> 3, cg = tid & 7, ch0 = h * 64 + cg * 8, isc = isc0 + tt, t = d == 0 ? isc : T - 1 - isc;
  const bf16_t* zr = p.zA + (size_t)(rowbase + t) * SHIFTC;
  pf[0] = *(const u32x4*)(zr + 3072 + d * 64 + cg * 8);
  pf[1] = *(const u32x4*)(zr + 3200 + d * 64 + cg * 8);
  pf[2] = *(const u32x4*)(zr + 1024 + ch0);
  pf[3] = WANTY ? *(const u32x4*)(zr + ch0) : (u32x4){0u, 0u, 0u, 0u};
  pf[4] = *(const u32x4*)(zr + 2048 + ch0);
}
template <bool LAT>
__device__ __forceinline__ void rwkv_super(const P& p, unsigned char* smem, int chain, int j) {
  const int tid = TIDX, lane = tid & 63, w = tid >> 6, l15 = lane & 15, q = lane >> 4;
  bf16_t* TST = (bf16_t*)(smem + O_TST);
  const int b = chain >> 5, d = (chain >> 4) & 1, h = chain & 15;
  const int T = LAT ? SEQ : CTXL, rowbase = LAT ? b * SEQ : NTOK + b * CTXL, base = LAT ? (j - 1) * 256 : 0;
  f32x4 st[2][4];
  __syncthreads();
#pragma unroll
  for (int kt = 0; kt < 4; ++kt) {
#pragma unroll
    for (int rg = 0; rg < 4; ++rg) st[0][kt][rg] = (16 * kt + 4 * q + rg == 16 * w + l15) ? 1.f : 0.f;
    st[1][kt] = (f32x4){0.f, 0.f, 0.f, 0.f};
    *(u32x2*)(TST + (16 * w + l15) * 72 + 16 * kt + 4 * q) = pack4(st[0][kt]);
    *(u32x2*)(TST + (64 + 16 * w + l15) * 72 + 16 * kt + 4 * q) = pack4(st[1][kt]);
  }
  u32x4 pf[5]; rwkv_prefetch_first<LAT>(p, d, h, rowbase, T, base, pf);
  for (int c = 0; c < 8; ++c) rwkv_chunk<2, LAT>(p, smem, d, h, rowbase, T, base + 32 * c, c < 7, st, pf);
  if (j < 64) {
    const size_t slot = (size_t)chain * NSUP + j;
#pragma unroll
    for (int kt = 0; kt < 4; ++kt) {
#pragma unroll
      for (int rg = 0; rg < 4; ++rg) p.Mst[(slot * 64 + 16 * kt + 4 * q + rg) * 64 + 16 * w + l15] = f2bf(st[0][kt][rg]);
      *(f32x4*)(p.Nst + (slot * 64 + 16 * w + l15) * 64 + 16 * kt + 4 * q) = st[1][kt];
    }
  }
}
__device__ __forceinline__ void ph_rwkv_A(const P& p, int vb, int nvb, unsigned char* smem) {
  for (int chain = vb; chain < 64; chain += nvb) rwkv_super<false>(p, smem, chain, 0);
  for (int item = vb; item < 2048; item += nvb) {
    const int b = item >> 10, J = (item >> 4) & 63, h = item & 15;
#pragma unroll 1
    for (int d = 0; d < 2; ++d) {
      rwkv_super<true>(p, smem, b * 32 + d * 16 + h, d == 0 ? J + 1 : 64 - J);
      asm volatile("s_waitcnt vmcnt(0)" ::: "memory");
      __syncthreads();
    }
  }
}
__device__ __forceinline__ void ph_rwkv_B(const P& p, int vb, int nvb, unsigned char* smem) {
  const int tid = TIDX, lane = tid & 63, w = tid >> 6, l15 = lane & 15, q = lane >> 4;
  bf16_t* HT = (bf16_t*)smem;
  for (int chain = vb; chain < 64; chain += nvb) {
    f32x4 hs[4];
#pragma unroll
    for (int kt = 0; kt < 4; ++kt) hs[kt] = (f32x4){0.f, 0.f, 0.f, 0.f};
    __syncthreads();
    for (int j = 0; j < 64; ++j) {
      const size_t slot = (size_t)chain * NSUP + j;
      f32x4 nv[4];
#pragma unroll
      for (int kt = 0; kt < 4; ++kt) nv[kt] = *(const f32x4*)(p.Nst + (slot * 64 + 16 * w + l15) * 64 + 16 * kt + 4 * q);
      bf16x8 mf[4][2];
#pragma unroll
      for (int kt = 0; kt < 4; ++kt)
#pragma unroll
        for (int ks = 0; ks < 2; ++ks) mf[kt][ks] = *(const bf16x8*)(p.Mst + (slot * 64 + 16 * kt + l15) * 64 + 32 * ks + 8 * q);
#pragma unroll
      for (int kt = 0; kt < 4; ++kt) {
        *(f32x4*)(p.Nst + (slot * 64 + 16 * w + l15) * 64 + 16 * kt + 4 * q) = hs[kt];
        *(u32x2*)(HT + (16 * w + l15) * 72 + 16 * kt + 4 * q) = pack4(hs[kt]);
      }
      lds_wave_fence();
      bf16x8 hf[2];
      hf[0] = *(const bf16x8*)(HT + (16 * w + l15) * 72 + 8 * q); hf[1] = *(const bf16x8*)(HT + (16 * w + l15) * 72 + 32 + 8 * q);
      lds_wave_fence();
#pragma unroll
      for (int kt = 0; kt < 4; ++kt) {
        f32x4 a = nv[kt];
#pragma unroll
        for (int ks = 0; ks < 2; ++ks) a = __builtin_amdgcn_mfma_f32_16x16x32_bf16(mf[kt][ks], hf[ks], a, 0, 0, 0);
        hs[kt] = a;
      }
    }
    const size_t slot = (size_t)chain * NSUP + 64;
#pragma unroll
    for (int kt = 0; kt < 4; ++kt) *(f32x4*)(p.Nst + (slot * 64 + 16 * w + l15) * 64 + 16 * kt + 4 * q) = hs[kt];
  }
}
__device__ __forceinline__ void ph_ycorr(const P& p, int vb, int nvb) {
  const int tid = TIDX, lane = tid & 63, w = tid >> 6, l15 = lane & 15, q = lane >> 4;
  for (int item = vb; item < 2048; item += nvb) {
    const int b = item >> 10, J = (item >> 4) & 63, h = item & 15;
    const size_t tok0 = (size_t)b * SEQ + J * 256 + 64 * w;
    bf16x8 hf[4][4];
#pragma unroll
    for (int kk = 0; kk < 4; ++kk) {
      const size_t slot = kk < 2 ? (size_t)(b * 32 + h) * NSUP + (J + 1) : (size_t)(b * 32 + 16 + h) * NSUP + (64 - J);
#pragma unroll
      for (int nt = 0; nt < 4; ++nt) {
        const float* src = p.Nst + (slot * 64 + 16 * nt + l15) * 64 + 32 * (kk & 1) + 8 * q;
        const f32x4 a = *(const f32x4*)src, c = *(const f32x4*)(src + 4);
        const u32x4 pk = (u32x4){pack2(a[0], a[1]), pack2(a[2], a[3]), pack2(c[0], c[1]), pack2(c[2], c[3])};
        hf[kk][nt] = __builtin_bit_cast(bf16x8, pk);
      }
    }
#pragma unroll 1
    for (int mt = 0; mt < 4; ++mt) {
      const size_t tok = tok0 + 16 * mt + l15;
      bf16x8 pa[4];
#pragma unroll
      for (int kk = 0; kk < 2; ++kk) {
        pa[kk] = *(const bf16x8*)(p.Y1 + tok * DM + h * 64 + 32 * kk + 8 * q);
        pa[2 + kk] = *(const bf16x8*)(p.zA + tok * SHIFTC + h * 64 + 32 * kk + 8 * q);
      }
      u32x2 yo[4];
#pragma unroll
      for (int nt = 0; nt < 4; ++nt) yo[nt] = *(const u32x2*)(p.Y0 + tok * DM + h * 64 + 16 * nt + 4 * q);
#pragma unroll
      for (int nt = 0; nt < 4; ++nt) {
        f32x4 acc = (f32x4){bflo(yo[nt].x), bfhi(yo[nt].x), bflo(yo[nt].y), bfhi(yo[nt].y)};
#pragma unroll
        for (int kk = 0; kk < 4; ++kk) acc = __builtin_amdgcn_mfma_f32_16x16x32_bf16(hf[kk][nt], pa[kk], acc, 0, 0, 0);
        *(u32x2*)(p.Y0 + tok * DM + h * 64 + 16 * nt + 4 * q) = pack4(acc);
      }
    }
  }
}

#define POOL_SMEM (64 * 128 * 4)
__device__ __forceinline__ void ph_pool(const P& p, int vb, int nvb, unsigned char* smem) {
  float* V = (float*)smem;
  const int tid = TIDX, cp = tid & 63, cq = tid >> 6;
  for (int item = vb; item < 2 * 4 * 64; item += nvb) {
    const int j = item & 3, st = (item >> 2) & 63, b = item >> 8;
    const int win = 2 << j, half = win >> 1;
    const bf16_t* zb = p.zP + (size_t)b * SEQ * 512 + j * 128 + cp * 2;
    float a0[16], a1[16];
#pragma unroll
    for (int i = 0; i < 16; ++i) { a0[i] = 0.f; a1[i] = 0.f; }
    {
      const int r = 4 * st, r0 = max(r - half, 0), r1 = min(r + half, 256);
      for (int rr = r0; rr < r1; ++rr) {
#pragma unroll
        for (int i = 0; i < 16; ++i) { const unsigned u = *(const unsigned*)(zb + (size_t)(rr * 64 + cq * 16 + i) * 512); a0[i] += bflo(u); a1[i] += bfhi(u); }
      }
    }
    for (int dr = 0; dr < 4; ++dr) {
      const int r = 4 * st + dr, r0 = max(r - half, 0), r1 = min(r + half, 256);
      if (dr > 0) {
        const int radd = r + half - 1, rsub = r - half - 1;
        if (radd < 256) {
#pragma unroll
          for (int i = 0; i < 16; ++i) { const unsigned u = *(const unsigned*)(zb + (size_t)(radd * 64 + cq * 16 + i) * 512); a0[i] += bflo(u); a1[i] += bfhi(u); }
        }
        if (rsub >= 0) {
#pragma unroll
          for (int i = 0; i < 16; ++i) { const unsigned u = *(const unsigned*)(zb + (size_t)(rsub * 64 + cq * 16 + i) * 512); a0[i] -= bflo(u); a1[i] -= bfhi(u); }
        }
      }
      __syncthreads();
#pragma unroll
      for (int i = 0; i < 16; ++i) *(f32x2*)(V + (cq * 16 + i) * 128 + cp * 2) = (f32x2){a0[i], a1[i]};
      __syncthreads();
      float s0 = 0.f, s1 = 0.f;
      {
        const int c = cq * 16, c0 = max(c - half, 0), c1 = min(c + half, 64);
        for (int cc = c0; cc < c1; ++cc) { const f32x2 v = *(const f32x2*)(V + cc * 128 + cp * 2); s0 += v.x; s1 += v.y; }
      }
#pragma unroll
      for (int i = 0; i < 16; ++i) {
        const int c = cq * 16 + i, c0 = max(c - half, 0), c1 = min(c + half, 64);
        if (i > 0) {
          const int cadd = c + half - 1, csub = c - half - 1;
          if (cadd < 64) { const f32x2 v = *(const f32x2*)(V + cadd * 128 + cp * 2); s0 += v.x; s1 += v.y; }
          if (csub >= 0) { const f32x2 v = *(const f32x2*)(V + csub * 128 + cp * 2); s0 -= v.x; s1 -= v.y; }
        }
        const float inv = __builtin_amdgcn_rcpf((float)((r1 - r0) * (c1 - c0)));
        const size_t tokoff = ((size_t)b * SEQ + r * 64 + c) * 512 + j * 128 + cp * 2;
        const unsigned u = *(const unsigned*)(p.zP + tokoff);
        *(unsigned*)(p.pooled + tokoff) = pack2(s0 * inv - bflo(u), s1 * inv - bfhi(u));
      }
    }
  }
}
__device__ __forceinline__ void ph_res1(const P& p, int vb, int nvb) {
  const int lane = TIDX & 63, wid = TIDX >> 6;
  for (int m = vb * 4 + wid; m < NTOK; m += nvb * 4) {
    const float* md = p.mod + (m / SEQ) * 6144;
    float mx[16]; float ss = 0.f;
#pragma unroll
    for (int i = 0; i < 4; ++i) {
      const uint2 u = *(const uint2*)(p.mix + (size_t)m * DM + i * 256 + lane * 4);
      mx[4 * i] = bflo(u.x); mx[4 * i + 1] = bfhi(u.x); mx[4 * i + 2] = bflo(u.y); mx[4 * i + 3] = bfhi(u.y);
#pragma unroll
      for (int e = 0; e < 4; ++e) ss += mx[4 * i + e] * mx[4 * i + e];
    }
    ss = wave_sum(ss);
    const float rstd = rsqrtf(ss * (1.0f / 1024.0f) + 1e-6f);
    float x1[16]; float s2 = 0.f;
#pragma unroll
    for (int i = 0; i < 4; ++i) {
      const int col = i * 256 + lane * 4;
      const float4 xv = *(const float4*)(p.x + (size_t)m * DM + col), g = *(const float4*)(p.g_post_mix + col), gt = *(const float4*)(md + 2048 + col);
      x1[4 * i] = xv.x + gt.x * mx[4 * i] * rstd * g.x; x1[4 * i + 1] = xv.y + gt.y * mx[4 * i + 1] * rstd * g.y;
      x1[4 * i + 2] = xv.z + gt.z * mx[4 * i + 2] * rstd * g.z; x1[4 * i + 3] = xv.w + gt.w * mx[4 * i + 3] * rstd * g.w;
      *(float4*)(p.out + (size_t)m * DM + col) = make_float4(x1[4 * i], x1[4 * i + 1], x1[4 * i + 2], x1[4 * i + 3]);
#pragma unroll
      for (int e = 0; e < 4; ++e) s2 += x1[4 * i + e] * x1[4 * i + e];
    }
    s2 = wave_sum(s2);
    const float r2 = rsqrtf(s2 * (1.0f / 1024.0f) + 1e-6f);
#pragma unroll
    for (int i = 0; i < 4; ++i) {
      const int col = i * 256 + lane * 4;
      const float4 g = *(const float4*)(p.g_pre_ffn + col), sh = *(const float4*)(md + 3072 + col), sc = *(const float4*)(md + 4096 + col);
      uint2 w;
      w.x = pack2(x1[4 * i] * r2 * g.x * (1.f + sc.x) + sh.x, x1[4 * i + 1] * r2 * g.y * (1.f + sc.y) + sh.y);
      w.y = pack2(x1[4 * i + 2] * r2 * g.z * (1.f + sc.z) + sh.z, x1[4 * i + 3] * r2 * g.w * (1.f + sc.w) + sh.w);
      *(uint2*)(p.hx2 + (size_t)m * DM + col) = w;
    }
  }
}

#define PS1_SMEM (128 * 133 * 4)
#define CE_DESC(a, b) { const float _mx = fmaxf(a, b), _mn = fminf(a, b); a = _mx; b = _mn; }
template <int N> __device__ __forceinline__ void bitonic_sort_desc(float (&v)[N]) {
#pragma unroll
  for (int k = 2; k <= N; k <<= 1)
#pragma unroll
    for (int j = k >> 1; j > 0; j >>= 1)
#pragma unroll
      for (int i = 0; i < N; ++i) { const int l = i ^ j; if (l > i) { if ((i & k) == 0) CE_DESC(v[i], v[l]) else CE_DESC(v[l], v[i]) } }
}
__device__ __forceinline__ void bitonic_merge16_desc(float (&v)[16]) {
#pragma unroll
  for (int j = 8; j > 0; j >>= 1)
#pragma unroll
    for (int i = 0; i < 16; ++i) { const int l = i ^ j; if (l > i) CE_DESC(v[i], v[l]) }
}
__device__ __forceinline__ void ph_peer_s1(const P& p, int vb, int nvb, unsigned char* smem) {
  float* S = (float*)smem;
  EpiLds epi{S};
  const int tid = TIDX, sub = tid & 3;
  for (int item = vb; item < 256 * 16; item += nvb) {
    const int hp = item & 15, tm = item >> 4;
    __syncthreads();
    gemm_tile(p.q + hp * 128, 2048, p.keys + (size_t)hp * 128 * 128, 128, 128, tm * 128, 0, epi, smem);
    __syncthreads();
#pragma unroll 1
    for (int pass = 0; pass < 2; ++pass) {
      const int row = pass * 64 + (tid >> 2);
      float a[16], b[16];
#pragma unroll
      for (int i = 0; i < 16; ++i) {
        a[i] = __uint_as_float((__float_as_uint(S[row * 133 + sub * 33 + i]) & ~127u) | (unsigned)(sub * 32 + i));
        b[i] = __uint_as_float((__float_as_uint(S[row * 133 + sub * 33 + 16 + i]) & ~127u) | (unsigned)(sub * 32 + 16 + i));
      }
      bitonic_sort_desc<16>(a); bitonic_sort_desc<16>(b);
#pragma unroll
      for (int i = 0; i < 16; ++i) a[i] = fmaxf(a[i], b[15 - i]);
      bitonic_merge16_desc(a);
#pragma unroll
      for (int lvl = 1; lvl <= 2; lvl <<= 1) {
#pragma unroll
        for (int i = 0; i < 16; ++i) b[i] = __shfl_xor(a[i], lvl);
#pragma unroll
        for (int i = 0; i < 16; ++i) a[i] = fmaxf(a[i], b[15 - i]);
        bitonic_merge16_desc(a);
      }
      if (sub == 0) {
        const size_t ob = ((size_t)(tm * 128 + row) * 16 + hp) * 16;
#pragma unroll
        for (int i = 0; i < 16; i += 4) {
          *(f32x4*)(p.sv + ob + i) = (f32x4){a[i], a[i + 1], a[i + 2], a[i + 3]};
          typedef int i32x4 __attribute__((ext_vector_type(4)));
          *(i32x4*)(p.si + ob + i) = (i32x4){(int)(__float_as_uint(a[i]) & 127u), (int)(__float_as_uint(a[i + 1]) & 127u), (int)(__float_as_uint(a[i + 2]) & 127u), (int)(__float_as_uint(a[i + 3]) & 127u)};
        }
      }
    }
  }
}
__device__ __forceinline__ void top16_merge(float (&x)[16], const float (&y)[16]) {
#pragma unroll
  for (int i = 0; i < 16; ++i) x[i] = fmaxf(x[i], y[15 - i]);
  bitonic_merge16_desc(x);
}
__device__ __forceinline__ void ph_peer_s2(const P& p, int vb, int nvb, unsigned char* smem) {
  unsigned char* lut = smem;
  __syncthreads();
  if (TIDX == 0) {
    int n = 0;
#pragma unroll
    for (int i = 0; i < 16; ++i)
#pragma unroll
      for (int j = 0; j < 16; ++j)
        if ((i + 1) * (j + 1) <= 16) { lut[n] = (unsigned char)((i << 4) | j); ++n; }
  }
  __syncthreads();
  for (int it = vb * 256 + TIDX; it < NTOK * 8; it += nvb * 256) {
    const size_t ob = (size_t)it * 32;
    float a[16], bq[16];
#pragma unroll
    for (int i = 0; i < 16; i += 4) {
      const f32x4 fa = *(const f32x4*)(p.sv + ob + i), fb = *(const f32x4*)(p.sv + ob + 16 + i);
#pragma unroll
      for (int e = 0; e < 4; ++e) { a[i + e] = fa[e]; bq[i + e] = fb[e]; }
    }
    float g0[16], g1[16], g2[16], g3[16];
    {
      int n = 0;
#pragma unroll
      for (int i = 0; i < 16; ++i)
#pragma unroll
        for (int j = 0; j < 16; ++j)
          if ((i + 1) * (j + 1) <= 16) {
            const float v = __uint_as_float((__float_as_uint(a[i] + bq[j]) & ~63u) | (unsigned)n);
            if (n < 16) g0[n] = v; else if (n < 32) g1[n - 16] = v; else if (n < 48) g2[n - 32] = v; else g3[n - 48] = v;
            ++n;
          }
#pragma unroll
      for (int k = 2; k < 16; ++k) g3[k] = -3.0e38f;
    }
    bitonic_sort_desc<16>(g0); bitonic_sort_desc<16>(g1); bitonic_sort_desc<16>(g2); bitonic_sort_desc<16>(g3);
    top16_merge(g0, g1); top16_merge(g2, g3); top16_merge(g0, g2);
    float den = 0.f; float ex[16]; int seli[16];
#pragma unroll
    for (int k = 0; k < 16; ++k) {
      ex[k] = __expf(g0[k] - g0[0]); den += ex[k];
      const int ij = lut[__float_as_uint(g0[k]) & 63u];
      const int ka = (int)(__float_as_uint(p.sv[ob + (ij >> 4)]) & 127u), kb = (int)(__float_as_uint(p.sv[ob + 16 + (ij & 15)]) & 127u);
      seli[k] = ka * 128 + kb;
    }
    const float inv = 1.0f / den;
    const size_t o2 = (size_t)it * 16;
    typedef int i32x4 __attribute__((ext_vector_type(4)));
#pragma unroll
    for (int k = 0; k < 16; k += 4) {
      *(i32x4*)(p.pidx + o2 + k) = (i32x4){seli[k], seli[k + 1], seli[k + 2], seli[k + 3]};
      *(f32x4*)(p.pgate + o2 + k) = (f32x4){ex[k] * inv, ex[k + 1] * inv, ex[k + 2] * inv, ex[k + 3] * inv};
    }
  }
}
typedef float f32x16 __attribute__((ext_vector_type(16)));
typedef float f32x32 __attribute__((ext_vector_type(32)));
typedef unsigned u32x6 __attribute__((ext_vector_type(6)));
__device__ __forceinline__ float gelu_as(float v) {
  const float t = __builtin_amdgcn_rcpf(fabsf(v) * 0.2316418882f + 1.0f);
  float qq = t * 0.5307027145f + (-0.7265760135f); qq = qq * t + 0.7107068705f; qq = qq * t + (-0.142248368f); qq = qq * t + 0.127414796f; qq = qq * t;
  const float m = v * (qq * __builtin_amdgcn_exp2f((v * v) * (-0.72134752044f)));
  return v < 0.f ? m : v - m;
}
__device__ __forceinline__ float half_max(float v) {
#pragma unroll
  for (int o = 16; o > 0; o >>= 1) v = fmaxf(v, __shfl_xor(v, o));
  return v;
}
__device__ __forceinline__ float half_sum(float v) {
#pragma unroll
  for (int o = 16; o > 0; o >>= 1) v += __shfl_xor(v, o);
  return v;
}
__device__ __forceinline__ void ph_cvt_fp6(const float* __restrict__ in, unsigned char* __restrict__ out, float* __restrict__ inv_scale, int vb, int nvb) {
  const int lane = TIDX & 63, wid = TIDX >> 6, hf = lane >> 5, sl = lane & 31;
  for (int rp = vb * 4 + wid; rp < 8192; rp += nvb * 4) {
    const int row = rp * 2 + hf;
    f32x16 a, b2; float am = 0.f;
#pragma unroll
    for (int i = 0; i < 4; ++i) {
      const f32x4 v0 = *(const f32x4*)(in + (size_t)row * DM + sl * 32 + 4 * i), v1 = *(const f32x4*)(in + (size_t)row * DM + sl * 32 + 16 + 4 * i);
#pragma unroll
      for (int e = 0; e < 4; ++e) { a[4 * i + e] = v0[e]; b2[4 * i + e] = v1[e]; am = fmaxf(am, fmaxf(fabsf(v0[e]), fabsf(v1[e]))); }
    }
    am = half_max(am);
    const float sc = am > 0.f ? 7.0f / am : 1.0f;
    const u32x6 pk = __builtin_amdgcn_cvt_scalef32_2xpk16_fp6_f32(a * sc, b2 * sc, 1.0f);
    unsigned char* o = out + (size_t)row * 768 + sl * 24;
    *(u32x2*)(o) = (u32x2){pk[0], pk[1]}; *(u32x2*)(o + 8) = (u32x2){pk[2], pk[3]}; *(u32x2*)(o + 16) = (u32x2){pk[4], pk[5]};
    if (sl == 0) inv_scale[row] = am > 0.f ? am / 7.0f : 1.0f;
  }
}
__device__ __forceinline__ u32x6 load_row6(const unsigned char* base, int id, int sl) {
  const unsigned char* q = base + (size_t)id * 768 + sl * 24;
  const u32x2 a = *(const u32x2*)q, b = *(const u32x2*)(q + 8), c = *(const u32x2*)(q + 16);
  return (u32x6){a.x, a.y, b.x, b.y, c.x, c.y};
}
#define GATHER_SMEM (4 * 64 * 33 * 4)
__device__ __forceinline__ void ph_peer_gather(const P& p, int vb, int nvb, unsigned char* smem) {
  int tid_ = TIDX;
  asm volatile("" : "+v"(tid_));
  const int lane = tid_ & 63, wid = tid_ >> 6, hf = lane >> 5, sl = lane & 31;
  float* scr = (float*)smem + (wid * 64 + lane) * 33;
  int* tauL = (int*)(smem + GATHER_SMEM) + wid * 32;
  {
    f32x16 a, b2;
#pragma unroll
    for (int i = 0; i < 16; ++i) { a[i] = __uint_as_float((unsigned)i << 20) * 0x1p126f; b2[i] = __uint_as_float((unsigned)(16 + i) << 20) * 0x1p126f; }
    const f32x32 o = __builtin_amdgcn_cvt_scalef32_pk32_f32_fp6(__builtin_amdgcn_cvt_scalef32_2xpk16_fp6_f32(a, b2, 1.0f), 1.0f);
    if (lane == 0) {
#pragma unroll
      for (int j = 0; j < 32; ++j) tauL[j] = (int)((__float_as_uint(o[j] * 0x1p-126f) >> 20) & 31u);
    }
  }
  const int jmap = 2 * (lane & 1) + ((lane >> 1) & 1);
  __syncthreads();
  for (int m = vb * 4 + wid; m < NTOK; m += nvb * 4) {
    const float* md = p.mod + (m / SEQ) * 6144;
    float xh[32];
    {
#pragma unroll
      for (int c4 = 0; c4 < 4; ++c4) {
        const u32x4 u = *(const u32x4*)(p.hx2 + (size_t)m * DM + sl * 32 + 8 * c4);
#pragma unroll
        for (int e = 0; e < 4; ++e) { scr[8 * c4 + 2 * e] = bflo(u[e]); scr[8 * c4 + 2 * e + 1] = bfhi(u[e]); }
      }
      lds_wave_fence();
#pragma unroll
      for (int j = 0; j < 32; ++j) xh[j] = scr[tauL[j]];
      lds_wave_fence();
    }
    const int id0 = p.pidx[(size_t)m * 128 + lane], id1 = p.pidx[(size_t)m * 128 + 64 + lane];
    const float su0 = p.us[id0], su1 = p.us[id1];
    const float gs0 = p.pgate[(size_t)m * 128 + lane] * p.vs[id0], gs1 = p.pgate[(size_t)m * 128 + 64 + lane] * p.vs[id1];
    float acch[32];
#pragma unroll
    for (int k = 0; k < 32; ++k) acch[k] = 0.f;
#pragma unroll 1
    for (int e0 = 0; e0 < 128; e0 += 8) {
      u32x6 ur[4], vr[4];
#pragma unroll
      for (int j = 0; j < 4; ++j) {
        const int id = __shfl(e0 < 64 ? id0 : id1, (e0 + hf * 4 + j) & 63);
        ur[j] = load_row6(p.ub8, id, sl);
        vr[j] = load_row6(p.vb8, id, sl);
      }
      float d[4];
#pragma unroll
      for (int j = 0; j < 4; ++j) {
        const f32x32 f = __builtin_amdgcn_cvt_scalef32_pk32_f32_fp6(ur[j], 1.0f);
        float s0 = 0.f, s1 = 0.f;
#pragma unroll
        for (int k = 0; k < 32; k += 2) { s0 += f[k] * xh[k]; s1 += f[k + 1] * xh[k + 1]; }
        d[j] = s0 + s1;
        __builtin_amdgcn_sched_barrier(0);
      }
      float r2[2], r1;
      {
        const bool lo = (lane & 1) == 0;
#pragma unroll
        for (int i = 0; i < 2; ++i) { const float keep = lo ? d[i] : d[i + 2], send = lo ? d[i + 2] : d[i]; r2[i] = keep + __shfl_xor(send, 1); }
        const bool lo2 = (lane & 2) == 0;
        { const float keep = lo2 ? r2[0] : r2[1], send = lo2 ? r2[1] : r2[0]; r1 = keep + __shfl_xor(send, 2); }
        r1 += __shfl_xor(r1, 4); r1 += __shfl_xor(r1, 8); r1 += __shfl_xor(r1, 16);
      }
      const int esrc = (e0 + hf * 4 + jmap) & 63;
      const float su = __shfl(e0 < 64 ? su0 : su1, esrc), gs = __shfl(e0 < 64 ? gs0 : gs1, esrc);
      const float sdot = r1 * su;
      const float cf = gelu_as(sdot) * gs;
#pragma unroll
      for (int j = 0; j < 4; ++j) {
        const float cj = __shfl(cf, (lane & 32) | ((j >> 1) | ((j & 1) << 1)));
        const f32x32 f = __builtin_amdgcn_cvt_scalef32_pk32_f32_fp6(vr[j], 1.0f);
#pragma unroll
        for (int k = 0; k < 32; ++k) acch[k] += cj * f[k];
        __builtin_amdgcn_sched_barrier(0);
      }
    }
#pragma unroll
    for (int k = 0; k < 32; ++k) { acch[k] += __shfl_xor(acch[k], 32); scr[tauL[k]] = acch[k]; }
    lds_wave_fence();
    float ss = 0.f;
#pragma unroll
    for (int k = 0; k < 32; ++k) { const float v = scr[k]; ss += v * v; }
    ss = half_sum(ss);
    const float rstd = rsqrtf(ss * (1.0f / 1024.0f) + 1e-6f);
#pragma unroll
    for (int k4 = 0; k4 < 4; ++k4) {
      const int kk = hf * 16 + k4 * 4, col = sl * 32 + kk;
      f32x4 x1 = *(const f32x4*)(p.out + (size_t)m * DM + col);
      const f32x4 g = *(const f32x4*)(p.g_post_ffn + col), gt = *(const f32x4*)(md + 5120 + col);
#pragma unroll
      for (int e = 0; e < 4; ++e) x1[e] += gt[e] * scr[kk + e] * rstd * g[e];
      *(f32x4*)(p.out + (size_t)m * DM + col) = x1;
    }
    lds_wave_fence();
  }
}

#define XB_TMO      128
#define XB_XCNT(j)  (256  + 64 * (j))
#define XB_XSUB(j)  (1280 + 64 * (j))
#define XB_XGEN(j)  (2304 + 64 * (j))
#define XB_TOP      3328
#define XB_TOPGEN   3392
#define XCD_BAR_WORDS 3456
#define XB_SPIN_CAP (1u << 20)
#define LAS __attribute__((address_space(3)))
__device__ __forceinline__ unsigned xb_ld(unsigned* p)              { return __hip_atomic_load(p, __ATOMIC_RELAXED, __HIP_MEMORY_SCOPE_AGENT); }
__device__ __forceinline__ unsigned xb_add(unsigned* p, unsigned v) { return __hip_atomic_fetch_add(p, v, __ATOMIC_RELAXED, __HIP_MEMORY_SCOPE_AGENT); }
__device__ __forceinline__ unsigned xb_xcc_id() { return (unsigned)__builtin_amdgcn_s_getreg((3 << 11) | 20) & 0xFu; }
#define XB_SPIN(cond, bar) do { unsigned _sp = 0; while (cond) { __builtin_amdgcn_s_sleep(1); \
    if ((++_sp & 255u) == 0u) { if (xb_ld(&(bar)[XB_TMO])) break; if (_sp > XB_SPIN_CAP) { atomicAdd(&(bar)[XB_TMO], 1u); break; } } } } while (0)
struct XcdBarrier { unsigned* bar; unsigned x; volatile LAS unsigned* st; };
__device__ __forceinline__ XcdBarrier xcd_barrier_post(unsigned* bar, volatile LAS unsigned* st) {
  XcdBarrier b; b.bar = bar; b.x = xb_xcc_id(); b.st = st;
  if (TIDX == 0) (void)xb_add(&bar[XB_XCNT(b.x)], 1u);
  return b;
}
__device__ __forceinline__ void xcd_barrier_complete(unsigned* bar, unsigned x, unsigned& nloc, unsigned& nx) {
  const unsigned G = gridDim.x * gridDim.y * gridDim.z;
  unsigned sum, cnt, mine, sp = 0u;
  for (;;) {
    sum = 0u; cnt = 0u; mine = 0u;
#pragma unroll
    for (unsigned j = 0; j < 16; ++j) { const unsigned c = xb_ld(&bar[XB_XCNT(j)]); sum += c; cnt += (c > 0u) ? 1u : 0u; mine = (j == x) ? c : mine; }
    if (sum == G) break;
    __builtin_amdgcn_s_sleep(1);
    if ((++sp & 255u) == 0u) { if (xb_ld(&bar[XB_TMO])) break; if (sp > XB_SPIN_CAP) { atomicAdd(&bar[XB_TMO], 1u); break; } }
  }
  nloc = mine > 0u ? mine : 1u; nx = cnt > 0u ? cnt : 1u;
}
__device__ __forceinline__ void xcd_barrier(const XcdBarrier& b) {
  asm volatile("s_waitcnt vmcnt(0)" ::: "memory");
  __syncthreads();
  if (TIDX == 0) {
    unsigned* bar = b.bar;
    __builtin_amdgcn_s_waitcnt(0);
    unsigned nloc = b.st[0], nx = b.st[1];
    if (nloc == 0u) { xcd_barrier_complete(bar, b.x, nloc, nx); b.st[0] = nloc; b.st[1] = nx; }
    const unsigned old = xb_add(&bar[XB_XSUB(b.x)], 1u);
    const unsigned gen = old / nloc;
    if (old + 1u == (gen + 1u) * nloc) {
      __builtin_amdgcn_fence(__ATOMIC_RELEASE, "agent");
      asm volatile("s_waitcnt vmcnt(0)" ::: "memory");
      const unsigned og = xb_add(&bar[XB_TOP], 1u);
      const unsigned tg = og / nx;
      if (og + 1u == (tg + 1u) * nx) xb_add(&bar[XB_TOPGEN], 1u);
      else XB_SPIN(xb_ld(&bar[XB_TOPGEN]) == tg, bar);
      __builtin_amdgcn_fence(__ATOMIC_ACQUIRE, "agent");
      xb_add(&bar[XB_XGEN(b.x)], 1u);
      asm volatile("s_waitcnt vmcnt(0)" ::: "memory");
    } else {
      XB_SPIN(xb_ld(&bar[XB_XGEN(b.x)]) == gen, bar);
      __builtin_amdgcn_fence(__ATOMIC_ACQUIRE, "agent");
      asm volatile("s_waitcnt vmcnt(0)" ::: "memory");
    }
  }
  __syncthreads();
}

#define SMEM_BYTES RWKV_SMEM
__global__ void __launch_bounds__(256, 2) mega(P p) {
  __shared__ __attribute__((aligned(16))) unsigned char smem[SMEM_BYTES + 16];
  cg::grid_group grid = cg::this_grid();
  const int vb = blockIdx.x, nvb = gridDim.x;
  if (TIDX == 0) *(u32x4*)(smem + SMEM_BYTES) = (u32x4){0u, 0u, 0u, 0u};
  __syncthreads();
  const XcdBarrier xb = xcd_barrier_post(p.bar, (volatile LAS unsigned*)(smem + SMEM_BYTES));
  ph_mod(p, vb, nvb, smem);
  ph_colmax(p.w_in, p.colmax, DM, INC, vb, nvb, smem);
  ph_transpose(p.w2, p.w2T, 64, 1024, vb, nvb, smem);
  ph_transpose(p.w2 + 65536, p.w2T + 65536, 64, 1024, vb, nvb, smem);
  ph_transpose(p.a2, p.a2T, 64, 1024, vb, nvb, smem);
  ph_transpose(p.a2 + 65536, p.a2T + 65536, 64, 1024, vb, nvb, smem);
  if (p.bar == nullptr) grid.sync();
  xcd_barrier(xb);
  ph_norm1(p, vb, nvb);
  ph_transpose_i8(p.w_in, p.Wt8, p.colmax, p.wsb, DM, INC, vb, nvb, smem);
  xcd_barrier(xb);
  ph_gemm1(p, vb, nvb, smem);
  xcd_barrier(xb);
  ph_rwkv_A(p, vb, nvb, smem);
  xcd_barrier(xb);
  ph_rwkv_B(p, vb, nvb, smem);
  if (nvb > 128 && vb >= 64) {
    const int v2 = vb - 64, n2 = nvb - 64;
    ph_transpose(p.w_a_out, p.Wt_aout, DM, DM, v2, n2, smem);
    ph_transpose(p.w_o, p.Wt_o, DM, DM, v2, n2, smem);
    ph_transpose(p.peer_wq, p.Wt_q, DM, 2048, v2, n2, smem);
    ph_transpose(p.g2, p.g2T, 128, 1024, v2, n2, smem);
    ph_weff(p, v2, n2);
    ph_convert(p.peer_keys, p.keys, (size_t)16 * 128 * 128, v2, n2);
  } else if (nvb <= 128) {
    ph_transpose(p.w_a_out, p.Wt_aout, DM, DM, vb, nvb, smem);
    ph_transpose(p.w_o, p.Wt_o, DM, DM, vb, nvb, smem);
    ph_transpose(p.peer_wq, p.Wt_q, DM, 2048, vb, nvb, smem);
    ph_transpose(p.g2, p.g2T, 128, 1024, vb, nvb, smem);
    ph_weff(p, vb, nvb);
    ph_convert(p.peer_keys, p.keys, (size_t)16 * 128 * 128, vb, nvb);
  }
  xcd_barrier(xb);
  ph_ycorr(p, vb, nvb);
  ph_sg(p, vb, nvb);
  xcd_barrier(xb);
  ph_readout_gemm(p, vb, nvb, smem);
  ph_pool(p, vb, nvb, smem);
  ph_cvt_fp6(p.peer_u, p.ub8, p.us, vb, nvb);
  ph_cvt_fp6(p.peer_v, p.vb8, p.vs, vb, nvb);
  xcd_barrier(xb);
  ph_gemm_merge(p, vb, nvb, smem);
  xcd_barrier(xb);
  ph_gemm_simple(p.mrg, DM, p.Wt_o, DM, DM, NTOK, DM, p.mix, DM, vb, nvb, smem);
  xcd_barrier(xb);
  ph_res1(p, vb, nvb);
  xcd_barrier(xb);
  ph_gemm_simple(p.hx2, DM, p.Wt_q, DM, DM, NTOK, 2048, p.q, 2048, vb, nvb, smem);
  xcd_barrier(xb);
  ph_peer_s1(p, vb, nvb, smem);
  xcd_barrier(xb);
  ph_peer_s2(p, vb, nvb, smem);
  xcd_barrier(xb);
  ph_peer_gather(p, vb, nvb, smem);
}

extern "C" void kernel_launch(void* const* d_in, const int* in_sizes, int n_in, void* d_out, int out_size, void* d_ws, size_t ws_size, hipStream_t stream) {
  P p{};
  const float** f = (const float**)&p;
  for (int i = 0; i < 32; ++i) f[i] = (const float*)d_in[i];
  p.out = (float*)d_out;
  p.bar = (unsigned*)((unsigned char*)d_ws + 511 * 1048576);
  unsigned char* w = (unsigned char*)d_ws;
  const size_t MiB = 1048576;
  const size_t HM = 524288;
  p.hx = (bf16_t*)(w + 4096);
  p.hx8 = (signed char*)(w + 4096);
  p.hsa = (float*)(w + 40 * MiB) + 4;
  p.colmax = p.bar + XCD_BAR_WORDS;
  p.zA = (bf16_t*)(w + 65 * MiB + 8192);
  p.zP = (bf16_t*)(w + 569 * HM);
  p.zG = (bf16_t*)d_out;
  unsigned char* rw = w + 633 * HM;
  p.Wt_in = (bf16_t*)rw; p.Wt8 = (signed char*)rw; rw += 11 * MiB; p.wsb = (float*)rw; rw += 1 * MiB;
  p.Wt_aout = (bf16_t*)rw; rw += 2 * MiB;
  p.Wt_eff = (bf16_t*)rw; rw += 1 * MiB;
  p.Wt_o = (bf16_t*)rw; rw += 2 * MiB;
  p.Wt_q = (bf16_t*)rw; rw += 4 * MiB;
  p.keys = (bf16_t*)rw; rw += HM;
  p.mod = (float*)rw; rw += HM;
  p.g2T = (bf16_t*)rw; rw += HM;
  p.w2T = (bf16_t*)rw; rw += HM;
  p.a2T = (bf16_t*)rw; rw += HM;
  p.Y0 = (bf16_t*)(w + 0 * MiB);
  p.Y1 = (bf16_t*)(w + 340 * MiB);
  p.bdot = (float*)(w + 404 * MiB);
  p.Mst = (bf16_t*)(w + 408 * MiB);
  p.sg = (bf16_t*)(w + 408 * MiB);
  p.Nst = (float*)(w + 441 * MiB);
  p.ub8 = w + 416 * MiB;
  p.vb8 = w + 432 * MiB;
  p.us = (float*)(w + 448 * MiB);
  p.vs = (float*)(w + 449 * MiB);
  p.pooled = (bf16_t*)(w + 478 * MiB);
  p.out_a = (bf16_t*)(w + 0 * MiB);
  p.ya = (bf16_t*)(w + 65 * MiB);
  p.yb = (bf16_t*)(w + 129 * MiB);
  p.mrg = (bf16_t*)(w + 193 * MiB);
  p.mix = (bf16_t*)(w + 65 * MiB);
  p.hx2 = (bf16_t*)(w + 0 * MiB);
  p.q = (bf16_t*)(w + 129 * MiB);
  p.sv = (float*)(w + 340 * MiB);
  p.si = (int*)(w + 372 * MiB);
  p.pidx = (int*)(w + 257 * MiB);
  p.pgate = (float*)(w + 273 * MiB);
  static int grid_blocks = 0;
  if (!grid_blocks) {
    int dev = 0, cus = 0, per_cu = 0;
    hipGetDevice(&dev);
    hipDeviceGetAttribute(&cus, hipDeviceAttributeMultiprocessorCount, dev);
    hipOccupancyMaxActiveBlocksPerMultiprocessor(&per_cu, mega, 256, 0);
    if (per_cu > 2) per_cu = 2;
    if (per_cu < 1) per_cu = 1;
    grid_blocks = cus * per_cu;
  }
  hipMemsetAsync(p.bar, 0, (XCD_BAR_WORDS + 6016) * 4, stream);
  void* args[] = {&p};
  hipError_t e = hipLaunchCooperativeKernel((void*)mega, dim3(grid_blocks), dim3(256), args, 0, stream);
  if (e != hipSuccess) fprintf(stderr, "cooperative launch failed: %s (grid %d)\n", hipGetErrorString(e), grid_blocks);
}
```

```cpp
#include <hip/hip_runtime.h>
#include <hip/hip_cooperative_groups.h>
#include <stdint.h>
#include <cstdio>
namespace cg = cooperative_groups;

typedef unsigned short bf16_t;
typedef short bf16x8 __attribute__((ext_vector_type(8)));
typedef float f32x4 __attribute__((ext_vector_type(4)));
typedef unsigned u32x4 __attribute__((ext_vector_type(4)));
typedef unsigned u32x2 __attribute__((ext_vector_type(2)));
typedef float f32x2 __attribute__((ext_vector_type(2)));

__device__ __forceinline__ int tid_opaque() { int t = threadIdx.x; asm volatile("" : "+v"(t)); return t; }
#define TIDX tid_opaque()
#define NTOK 32768
#define SEQ 16384
#define CTXL 256
#define NCTX 512
#define MROWS 33280
#define DM 1024
#define SHIFTC 3456
#define INC 6016

typedef __bf16 hwbf2 __attribute__((ext_vector_type(2)));
typedef float hwf2 __attribute__((ext_vector_type(2)));
__device__ __forceinline__ unsigned pack2(float a, float b) { return __builtin_bit_cast(unsigned, __builtin_convertvector((hwf2){a, b}, hwbf2)); }
__device__ __forceinline__ bf16_t f2bf(float f) { return __builtin_bit_cast(unsigned short, (__bf16)f); }
__device__ __forceinline__ float bf2f(bf16_t h) { return __uint_as_float(((unsigned)h) << 16); }
__device__ __forceinline__ float bflo(unsigned u) { return __uint_as_float(u << 16); }
__device__ __forceinline__ float bfhi(unsigned u) { return __uint_as_float(u & 0xffff0000u); }
__device__ __forceinline__ float sigmoidf_(float x) { return __builtin_amdgcn_rcpf(1.0f + __expf(-x)); }

__device__ __forceinline__ void load8(const bf16_t* __restrict__ zA, int row, int col0, float* o) {
  const u32x4 zc = *(const u32x4*)(zA + (size_t)row * SHIFTC + col0);
#pragma unroll
  for (int i = 0; i < 4; ++i) { o[2 * i] = bflo(zc[i]); o[2 * i + 1] = bfhi(zc[i]); }
}
__device__ __forceinline__ float red16(float v) {
  v += __shfl_xor(v, 1); v += __shfl_xor(v, 2); v += __shfl_xor(v, 4); v += __shfl_xor(v, 8);
  return v;
}
__device__ __forceinline__ float red8(float v) {
  v += __shfl_xor(v, 1); v += __shfl_xor(v, 2); v += __shfl_xor(v, 4);
  return v;
}

struct P {
  const float *x, *c, *ctx, *c_ctx, *w_mod, *b_mod, *g_pre_mix, *g_post_mix, *g_pre_ffn, *g_post_ffn, *w_in, *b_gate, *mu_shift,
      *w0, *w2, *a0, *a2, *g2, *k_k, *k_a, *r_k, *ln_x_w, *ln_x_b, *w_a_out, *w_pool, *pool_scale, *w_b_out, *w_o, *peer_wq,
      *peer_keys, *peer_u, *peer_v;
  float* out;
  unsigned* bar;
  bf16_t* hx;
  signed char* hx8;
  float* hsa;
  signed char* Wt8;
  float* wsb;
  unsigned* colmax;
  bf16_t* zA;
  bf16_t* zP;
  bf16_t* zG;
  bf16_t* Wt_in;
  bf16_t* Wt_aout;
  bf16_t* Wt_eff;
  bf16_t* Wt_o;
  bf16_t* Wt_q;
  bf16_t* keys;
  float* mod;
  unsigned char* ub8;
  unsigned char* vb8;
  float* us;
  float* vs;
  bf16_t* sg;
  bf16_t* g2T;
  bf16_t* w2T;
  bf16_t* a2T;
  bf16_t* Mst;
  float* Nst;
  bf16_t* Y0;
  bf16_t* Y1;
  float* bdot;
  bf16_t* out_a;
  bf16_t* ya;
  bf16_t* pooled;
  bf16_t* yb;
  bf16_t* mrg;
  bf16_t* mix;
  bf16_t* hx2;
  bf16_t* q;
  float* sv;
  int* si;
  int* pidx;
  float* pgate;
};

#define GS 72
#define GEMM_SMEM (2 * 128 * GS * 2)
template <class Epi>
__device__ __forceinline__ void gemm_tile(const bf16_t* __restrict__ A, int lda, const bf16_t* __restrict__ Bt, int ldb, int K, int m0, int n0,
                                          const Epi& epi, unsigned char* smem) {
  const int tid = TIDX, lane = tid & 63, wid = tid >> 6, wr = wid >> 1, wc = wid & 1;
  bf16_t* sA = (bf16_t*)smem;
  bf16_t* sB = sA + 128 * GS;
  f32x4 acc[4][4];
#pragma unroll
  for (int i = 0; i < 4; ++i)
#pragma unroll
    for (int j = 0; j < 4; ++j) acc[i][j] = (f32x4){0.f, 0.f, 0.f, 0.f};
  const int lrow = tid >> 3, lcol = (tid & 7) * 8;
  const bf16_t* pa = A + (size_t)(m0 + lrow) * lda + lcol;
  const bf16_t* pb = Bt + (size_t)(n0 + lrow) * ldb + lcol;
  u32x4 ra[4], rb[4];
#pragma unroll
  for (int p = 0; p < 4; ++p) {
    ra[p] = *(const u32x4*)(pa + (size_t)(32 * p) * lda);
    rb[p] = *(const u32x4*)(pb + (size_t)(32 * p) * ldb);
  }
  for (int k0 = 0; k0 < K; k0 += 64) {
#pragma unroll
    for (int p = 0; p < 4; ++p) {
      *(u32x4*)(sA + (lrow + 32 * p) * GS + lcol) = ra[p];
      *(u32x4*)(sB + (lrow + 32 * p) * GS + lcol) = rb[p];
    }
    __syncthreads();
    if (k0 + 64 < K) {
#pragma unroll
      for (int p = 0; p < 4; ++p) {
        ra[p] = *(const u32x4*)(pa + (size_t)(32 * p) * lda + k0 + 64);
        rb[p] = *(const u32x4*)(pb + (size_t)(32 * p) * ldb + k0 + 64);
      }
    }
#pragma unroll
    for (int kk = 0; kk < 2; ++kk) {
      bf16x8 af[4], bfr[4];
#pragma unroll
      for (int i = 0; i < 4; ++i) af[i] = *(const bf16x8*)(sA + (wr * 64 + i * 16 + (lane & 15)) * GS + kk * 32 + (lane >> 4) * 8);
#pragma unroll
      for (int j = 0; j < 4; ++j) bfr[j] = *(const bf16x8*)(sB + (wc * 64 + j * 16 + (lane & 15)) * GS + kk * 32 + (lane >> 4) * 8);
#pragma unroll
      for (int i = 0; i < 4; ++i)
#pragma unroll
        for (int j = 0; j < 4; ++j) acc[i][j] = __builtin_amdgcn_mfma_f32_16x16x32_bf16(bfr[j], af[i], acc[i][j], 0, 0, 0);
    }
    __syncthreads();
  }
#pragma unroll
  for (int i = 0; i < 4; ++i)
#pragma unroll
    for (int j = 0; j < 4; ++j) epi(m0 + wr * 64 + i * 16 + (lane & 15), n0 + wc * 64 + j * 16 + (lane >> 4) * 4, acc[i][j]);
}

#define G3_STAGE 24576
#define G3_ES 136
#define GEMM3_SMEM (256 * G3_ES * 2)
typedef __attribute__((address_space(3))) unsigned lds_u32;
template <class Epi>
__device__ __forceinline__ void gemm_tile3(const bf16_t* __restrict__ A, int lda, const bf16_t* __restrict__ Bt, int ldb, int K, int m0, int n0,
                                           const Epi& epi, unsigned char* smem) {
  int tid = TIDX;
  asm volatile("" : "+v"(tid));
  const int lane = tid & 63, wid = __builtin_amdgcn_readfirstlane(tid >> 6), wr = wid >> 1, wc = wid & 1, l15 = lane & 15, q = lane >> 4;
  f32x4 acc[8][4];
#pragma unroll
  for (int i = 0; i < 8; ++i)
#pragma unroll
    for (int j = 0; j < 4; ++j) acc[i][j] = (f32x4){0.f, 0.f, 0.f, 0.f};
  const int gr = lane >> 2, gc = ((lane & 3) ^ (((gr >> 2) & 1) << 1)) * 8;
  const bf16_t* pa = A + (long)(m0 + wid * 64 + gr) * lda + gc;
  const bf16_t* pb = Bt + (size_t)(n0 + wid * 32 + gr) * ldb + gc;
  unsigned char* dA = smem + wid * 4096 + lane * 16;
  unsigned char* dB = smem + 16384 + wid * 2048 + lane * 16;
  const int sw = (q ^ (((l15 >> 2) & 1) << 1)) * 16;
  const unsigned char* fA = smem + (wr * 128 + l15) * 64 + sw;
  const unsigned char* fB = smem + 16384 + (wc * 64 + l15) * 64 + sw;
#define G3_ISSUE(ST, KT) { _Pragma("unroll") for (int ii = 0; ii < 4; ++ii) __builtin_amdgcn_global_load_lds((const unsigned*)(pa + (size_t)(16 * ii) * lda + (KT) * 32), (lds_u32*)(dA + (ST) * G3_STAGE + ii * 1024), 16, 0, 0); \
                           _Pragma("unroll") for (int ii = 0; ii < 2; ++ii) __builtin_amdgcn_global_load_lds((const unsigned*)(pb + (size_t)(16 * ii) * ldb + (KT) * 32), (lds_u32*)(dB + (ST) * G3_STAGE + ii * 1024), 16, 0, 0); }
  const int nk = K >> 5;
  __syncthreads();
  G3_ISSUE(0, 0);
  for (int kt = 0; kt < nk; ++kt) {
    const int cur = kt & 1;
    asm volatile("s_waitcnt vmcnt(0)" ::: "memory");
    __syncthreads();
    if (kt + 1 < nk) G3_ISSUE(cur ^ 1, kt + 1);
    const unsigned char* cA = fA + cur * G3_STAGE;
    const unsigned char* cB = fB + cur * G3_STAGE;
    bf16x8 bfr[4];
#pragma unroll
    for (int j = 0; j < 4; ++j) bfr[j] = *(const bf16x8*)(cB + j * 1024);
#pragma unroll
    for (int i = 0; i < 8; ++i) {
      const bf16x8 af = *(const bf16x8*)(cA + i * 1024);
#pragma unroll
      for (int j = 0; j < 4; ++j) acc[i][j] = __builtin_amdgcn_mfma_f32_16x16x32_bf16(bfr[j], af, acc[i][j], 0, 0, 0);
    }
  }
#undef G3_ISSUE
  bf16_t* sE = (bf16_t*)smem;
  __syncthreads();
#pragma unroll
  for (int i = 0; i < 8; ++i)
#pragma unroll
    for (int j = 0; j < 4; ++j) {
      u32x2 w; w.x = pack2(acc[i][j][0], acc[i][j][1]); w.y = pack2(acc[i][j][2], acc[i][j][3]);
      *(u32x2*)(sE + (wr * 128 + i * 16 + l15) * G3_ES + wc * 64 + j * 16 + q * 4) = w;
    }
  __syncthreads();
  epi.finish(sE, m0, n0, tid);
}
typedef int i32x4v __attribute__((ext_vector_type(4)));
template <class Epi>
__device__ __forceinline__ void gemm_tile3_i8(const signed char* __restrict__ A, int lda, const signed char* __restrict__ Bt, int ldb, int K, int m0, int n0,
                                              const float* __restrict__ sa, const float* __restrict__ sb, const Epi& epi, unsigned char* smem) {
  int tid = TIDX;
  asm volatile("" : "+v"(tid));
  const int lane = tid & 63, wid = __builtin_amdgcn_readfirstlane(tid >> 6), wr = wid >> 1, wc = wid & 1, l15 = lane & 15, q = lane >> 4;
  i32x4v acc[8][4];
#pragma unroll
  for (int i = 0; i < 8; ++i)
#pragma unroll
    for (int j = 0; j < 4; ++j) acc[i][j] = (i32x4v){0, 0, 0, 0};
  const int gr = lane >> 2, gc = ((lane & 3) ^ (((gr >> 2) & 1) << 1)) * 16;
  const signed char* pa = A + (long)(m0 + wid * 64 + gr) * lda + gc;
  const signed char* pb = Bt + (size_t)(n0 + wid * 32 + gr) * ldb + gc;
  unsigned char* dA = smem + wid * 4096 + lane * 16;
  unsigned char* dB = smem + 16384 + wid * 2048 + lane * 16;
  const int sw = (q ^ (((l15 >> 2) & 1) << 1)) * 16;
  const unsigned char* fA = smem + (wr * 128 + l15) * 64 + sw;
  const unsigned char* fB = smem + 16384 + (wc * 64 + l15) * 64 + sw;
#define G3_ISSUE(ST, KT) { _Pragma("unroll") for (int ii = 0; ii < 4; ++ii) __builtin_amdgcn_global_load_lds((const unsigned*)(pa + (size_t)(16 * ii) * lda + (KT) * 64), (lds_u32*)(dA + (ST) * G3_STAGE + ii * 1024), 16, 0, 0); \
                           _Pragma("unroll") for (int ii = 0; ii < 2; ++ii) __builtin_amdgcn_global_load_lds((const unsigned*)(pb + (size_t)(16 * ii) * ldb + (KT) * 64), (lds_u32*)(dB + (ST) * G3_STAGE + ii * 1024), 16, 0, 0); }
  const int nk = K >> 6;
  __syncthreads();
  G3_ISSUE(0, 0);
  for (int kt = 0; kt < nk; ++kt) {
    const int cur = kt & 1;
    asm volatile("s_waitcnt vmcnt(0)" ::: "memory");
    __syncthreads();
    if (kt + 1 < nk) G3_ISSUE(cur ^ 1, kt + 1);
    const unsigned char* cA = fA + cur * G3_STAGE;
    const unsigned char* cB = fB + cur * G3_STAGE;
    i32x4v bfr[4];
#pragma unroll
    for (int j = 0; j < 4; ++j) bfr[j] = *(const i32x4v*)(cB + j * 1024);
#pragma unroll
    for (int i = 0; i < 8; ++i) {
      const i32x4v af = *(const i32x4v*)(cA + i * 1024);
#pragma unroll
      for (int j = 0; j < 4; ++j) acc[i][j] = __builtin_amdgcn_mfma_i32_16x16x64_i8(bfr[j], af, acc[i][j], 0, 0, 0);
    }
  }
#undef G3_ISSUE
  bf16_t* sE = (bf16_t*)smem;
  f32x4 sb4[4];
#pragma unroll
  for (int j = 0; j < 4; ++j) sb4[j] = *(const f32x4*)(sb + n0 + wc * 64 + j * 16 + q * 4);
  __syncthreads();
#pragma unroll
  for (int i = 0; i < 8; ++i) {
    const float sr = sa[m0 + wr * 128 + i * 16 + l15];
#pragma unroll
    for (int j = 0; j < 4; ++j) {
      u32x2 w;
      w.x = pack2((float)acc[i][j][0] * (sr * sb4[j][0]), (float)acc[i][j][1] * (sr * sb4[j][1]));
      w.y = pack2((float)acc[i][j][2] * (sr * sb4[j][2]), (float)acc[i][j][3] * (sr * sb4[j][3]));
      *(u32x2*)(sE + (wr * 128 + i * 16 + l15) * G3_ES + wc * 64 + j * 16 + q * 4) = w;
    }
  }
  __syncthreads();
  epi.finish(sE, m0, n0, tid);
}
template <class D> struct Epi3RowChunks {
  __device__ __forceinline__ void finish(const bf16_t* sE, int m0, int n0, int tid) const {
#pragma unroll
    for (int pp = 0; pp < 16; ++pp) {
      const int id = tid + 256 * pp, row = id >> 4, cc = (id & 15) * 8;
      static_cast<const D*>(this)->store(m0 + row, n0 + cc, *(const u32x4*)(sE + row * G3_ES + cc));
    }
  }
};
struct Epi3StoreBf16 : Epi3RowChunks<Epi3StoreBf16> {
  bf16_t* C; int ldc;
  __device__ Epi3StoreBf16(bf16_t* c, int l) : C(c), ldc(l) {}
  __device__ __forceinline__ void store(int m, int n, const u32x4& v) const { *(u32x4*)(C + (size_t)m * ldc + n) = v; }
};
struct Epi3GateA : Epi3RowChunks<Epi3GateA> {
  const bf16_t* zG; const float* bg; bf16_t* mrg;
  __device__ Epi3GateA(const bf16_t* z, const float* b, bf16_t* m) : zG(z), bg(b), mrg(m) {}
  __device__ __forceinline__ void store(int m, int n, const u32x4& v) const {
    const u32x4 g = *(const u32x4*)(zG + (size_t)m * 2048 + n);
    const f32x4 b0 = *(const f32x4*)(bg + n), b1 = *(const f32x4*)(bg + n + 4);
    u32x4 o;
#pragma unroll
    for (int i = 0; i < 4; ++i) {
      const float bl = i < 2 ? b0[2 * i] : b1[2 * i - 4], bh = i < 2 ? b0[2 * i + 1] : b1[2 * i - 3];
      o[i] = pack2(sigmoidf_(bflo(g[i]) + bl) * bflo(v[i]), sigmoidf_(bfhi(g[i]) + bh) * bfhi(v[i]));
    }
    *(u32x4*)(mrg + (size_t)m * DM + n) = o;
  }
};
struct Epi3GateB : Epi3RowChunks<Epi3GateB> {
  const bf16_t* zG; const float* bg; bf16_t* mrg;
  __device__ Epi3GateB(const bf16_t* z, const float* b, bf16_t* m) : zG(z), bg(b), mrg(m) {}
  __device__ __forceinline__ void store(int m, int n, const u32x4& v) const {
    const u32x4 g = *(const u32x4*)(zG + (size_t)m * 2048 + 1024 + n);
    const u32x4 a = *(const u32x4*)(mrg + (size_t)m * DM + n);
    const f32x4 b0 = *(const f32x4*)(bg + 1024 + n), b1 = *(const f32x4*)(bg + 1024 + n + 4);
    u32x4 o;
#pragma unroll
    for (int i = 0; i < 4; ++i) {
      const float bl = i < 2 ? b0[2 * i] : b1[2 * i - 4], bh = i < 2 ? b0[2 * i + 1] : b1[2 * i - 3];
      o[i] = pack2(bflo(a[i]) + sigmoidf_(bflo(g[i]) + bl) * bflo(v[i]), bfhi(a[i]) + sigmoidf_(bfhi(g[i]) + bh) * bfhi(v[i]));
    }
    *(u32x4*)(mrg + (size_t)m * DM + n) = o;
  }
};
struct Epi3ZS {
  bf16_t* zA; const float* mu; int own_lo, own_hi, t0, T;
  __device__ __forceinline__ void finish(const bf16_t* sE, int m0, int n0, int tid) const {
#pragma unroll 4
    for (int pq = 0; pq < 16; ++pq) {
      const int id = tid + 256 * pq, row = id >> 4, cc = (id & 15) * 8, t = t0 + row;
      if (row < own_lo || row > own_hi) continue;
      const u32x4 zc = *(const u32x4*)(sE + row * G3_ES + cc);
      u32x4 zp = (u32x4){0u, 0u, 0u, 0u}, zn = (u32x4){0u, 0u, 0u, 0u};
      if (t > 0) zp = *(const u32x4*)(sE + (row - 1) * G3_ES + cc);
      if (t < T - 1) zn = *(const u32x4*)(sE + (row + 1) * G3_ES + cc);
      const f32x4 m0v = *(const f32x4*)(mu + n0 + cc), m1v = *(const f32x4*)(mu + n0 + cc + 4);
      const float mm[8] = {m0v[0], m0v[1], m0v[2], m0v[3], m1v[0], m1v[1], m1v[2], m1v[3]};
      u32x4 o;
#pragma unroll
      for (int i = 0; i < 4; ++i) {
        const float z0 = bflo(zc[i]), z1 = bfhi(zc[i]);
        o[i] = pack2(z0 + mm[2 * i] * (0.5f * (bflo(zp[i]) + bflo(zn[i])) - z0), z1 + mm[2 * i + 1] * (0.5f * (bfhi(zp[i]) + bfhi(zn[i])) - z1));
      }
      *(u32x4*)(zA + (long)(m0 + row) * SHIFTC + n0 + cc) = o;
    }
  }
};
struct Epi3Z : Epi3RowChunks<Epi3Z> {
  bf16_t *zA, *zP, *zG;
  __device__ Epi3Z(bf16_t* a, bf16_t* b, bf16_t* c) : zA(a), zP(b), zG(c) {}
  __device__ __forceinline__ void store(int m, int n, const u32x4& v) const {
    if (n < SHIFTC) *(u32x4*)(zA + (size_t)m * SHIFTC + n) = v;
    else if (m < NTOK) {
      if (n < SHIFTC + 512) *(u32x4*)(zP + (size_t)m * 512 + (n - SHIFTC)) = v;
      else *(u32x4*)(zG + (size_t)m * 2048 + (n - SHIFTC - 512)) = v;
    }
  }
};

struct EpiLds {
  float* S;
  __device__ __forceinline__ void operator()(int m, int n, const f32x4& v) const {
    float* r = S + (m & 127) * 133 + n + (n >> 5);
    r[0] = v[0]; r[1] = v[1]; r[2] = v[2]; r[3] = v[3];
  }
};

__device__ __forceinline__ void ph_transpose(const float* __restrict__ in, bf16_t* __restrict__ out, int K, int N, int vb, int nvb, unsigned char* smem) {
  float* t = (float*)smem;
  const int tk = K / 64, tn = N / 64, tid = TIDX, tx = tid & 15, ty = tid >> 4;
  for (int it = vb; it < tk * tn; it += nvb) {
    const int k0 = (it / tn) * 64, n0 = (it % tn) * 64;
    __syncthreads();
#pragma unroll
    for (int r = 0; r < 4; ++r) {
      const f32x4 v = *(const f32x4*)(in + (size_t)(k0 + ty + 16 * r) * N + n0 + 4 * tx);
#pragma unroll
      for (int e = 0; e < 4; ++e) t[(ty + 16 * r) * 65 + 4 * tx + e] = v[e];
    }
    __syncthreads();
    const int n = tid >> 2, kq = (tid & 3) * 16;
    u32x4 w0, w1;
#pragma unroll
    for (int e = 0; e < 4; ++e) {
      w0[e] = pack2(t[(kq + 2 * e) * 65 + n], t[(kq + 2 * e + 1) * 65 + n]);
      w1[e] = pack2(t[(kq + 8 + 2 * e) * 65 + n], t[(kq + 8 + 2 * e + 1) * 65 + n]);
    }
    *(u32x4*)(out + (size_t)(n0 + n) * K + k0 + kq) = w0;
    *(u32x4*)(out + (size_t)(n0 + n) * K + k0 + kq + 8) = w1;
  }
}
__device__ __forceinline__ void ph_colmax(const float* __restrict__ in, unsigned* __restrict__ colmax, int K, int N, int vb, int nvb, unsigned char* smem) {
  float* red = (float*)smem;
  const int tk = K / 64, tn = N / 64, tid = TIDX, n = tid & 63, kq = tid >> 6;
  for (int it = vb; it < tk * tn; it += nvb) {
    const int k0 = (it / tn) * 64 + kq * 16, n0 = (it % tn) * 64;
    float mx = 0.f;
#pragma unroll
    for (int r = 0; r < 16; ++r) mx = fmaxf(mx, fabsf(in[(size_t)(k0 + r) * N + n0 + n]));
    __syncthreads();
    red[kq * 64 + n] = mx;
    __syncthreads();
    if (kq == 0) atomicMax(colmax + n0 + n, __float_as_uint(fmaxf(fmaxf(red[n], red[64 + n]), fmaxf(red[128 + n], red[192 + n]))));
  }
}
__device__ __forceinline__ void ph_transpose_i8(const float* __restrict__ in, signed char* __restrict__ out, const unsigned* __restrict__ colmax, float* __restrict__ sbv,
                                                int K, int N, int vb, int nvb, unsigned char* smem) {
  float* t = (float*)smem;
  const int tk = K / 64, tn = N / 64, tid = TIDX, tx = tid & 15, ty = tid >> 4;
  for (int it = vb; it < tk * tn; it += nvb) {
    const int k0 = (it / tn) * 64, n0 = (it % tn) * 64;
    __syncthreads();
#pragma unroll
    for (int r = 0; r < 4; ++r) {
      const f32x4 v = *(const f32x4*)(in + (size_t)(k0 + ty + 16 * r) * N + n0 + 4 * tx);
#pragma unroll
      for (int e = 0; e < 4; ++e) t[(ty + 16 * r) * 65 + 4 * tx + e] = v[e];
    }
    __syncthreads();
    const int n = tid >> 2, kq = (tid & 3) * 16;
    const float cmx = __uint_as_float(colmax[n0 + n]);
    const float sc = cmx > 0.f ? 127.0f / cmx : 0.f;
    if (k0 == 0 && kq == 0) sbv[n0 + n] = cmx > 0.f ? cmx / 127.0f : 1.0f;
    u32x4 w;
#pragma unroll
    for (int e = 0; e < 4; ++e) {
      unsigned pk = 0;
#pragma unroll
      for (int b = 0; b < 4; ++b) { const int qv = (int)rintf(t[(kq + 4 * e + b) * 65 + n] * sc); pk |= ((unsigned)qv & 255u) << (8 * b); }
      w[e] = pk;
    }
    *(u32x4*)(out + (size_t)(n0 + n) * K + k0 + kq) = w;
  }
}
__device__ __forceinline__ void ph_convert(const float* __restrict__ in, bf16_t* __restrict__ out, size_t n, int vb, int nvb) {
  for (size_t i = ((size_t)vb * 256 + TIDX) * 4; i < n; i += (size_t)nvb * 1024) {
    const float4 v = *(const float4*)(in + i);
    uint2 w; w.x = pack2(v.x, v.y); w.y = pack2(v.z, v.w);
    *(uint2*)(out + i) = w;
  }
}
__device__ __forceinline__ void ph_weff(const P& p, int vb, int nvb) {
  for (int it = vb * 256 + TIDX; it < 512 * 1024; it += nvb * 256) {
    const int n = it & 1023, k = it >> 10, j = k >> 7, kl = k & 127;
    const float* wp = p.w_pool + ((size_t)j * 128 + kl) * 128;
    float s = 0.f;
    for (int c = 0; c < 128; ++c) s += wp[c] * p.pool_scale[j * 128 + c] * p.w_b_out[(size_t)(j * 128 + c) * 1024 + n];
    p.Wt_eff[(size_t)n * 512 + k] = f2bf(s);
  }
}
__device__ __forceinline__ void ph_mod(const P& p, int vb, int nvb, unsigned char* smem) {
  float* red = (float*)smem;
  const int lane = TIDX & 63, wid = TIDX >> 6;
  for (int it = vb; it < 96; it += nvb) {
    const int n = it * 64 + lane;
    float a0 = 0.f, a1 = 0.f, a2 = 0.f;
#pragma unroll 8
    for (int k = wid * 256; k < wid * 256 + 256; ++k) {
      const float w = p.w_mod[(size_t)k * 6144 + n];
      const float c0 = p.c[k], c1 = p.c[1024 + k], c2 = p.c_ctx[k];
      a0 += c0 * sigmoidf_(c0) * w; a1 += c1 * sigmoidf_(c1) * w; a2 += c2 * sigmoidf_(c2) * w;
    }
    __syncthreads();
    red[(wid * 3 + 0) * 64 + lane] = a0; red[(wid * 3 + 1) * 64 + lane] = a1; red[(wid * 3 + 2) * 64 + lane] = a2;
    __syncthreads();
    if (wid < 3) {
      const float sum = red[(0 * 3 + wid) * 64 + lane] + red[(1 * 3 + wid) * 64 + lane] + red[(2 * 3 + wid) * 64 + lane] + red[(3 * 3 + wid) * 64 + lane];
      p.mod[wid * 6144 + n] = sum + p.b_mod[n];
    }
  }
}
__device__ __forceinline__ float wave_sum(float v) {
#pragma unroll
  for (int o = 32; o > 0; o >>= 1) v += __shfl_xor(v, o);
  return v;
}
__device__ __forceinline__ void ph_norm1(const P& p, int vb, int nvb) {
  const int lane = TIDX & 63, wid = TIDX >> 6, nw = nvb * 4;
  for (int m0 = vb * 4 + wid; m0 < MROWS; m0 += 2 * nw) {
    const int m1 = m0 + nw; const bool has1 = m1 < MROWS; const int mb = has1 ? m1 : m0;
    const float* srcA = m0 < NTOK ? p.x + (size_t)m0 * DM : p.ctx + (size_t)(m0 - NTOK) * DM;
    const float* srcB = mb < NTOK ? p.x + (size_t)mb * DM : p.ctx + (size_t)(mb - NTOK) * DM;
    f32x4 va[4], vbq[4]; float sa = 0.f, sb = 0.f;
#pragma unroll
    for (int i = 0; i < 4; ++i) { va[i] = *(const f32x4*)(srcA + i * 256 + lane * 4); vbq[i] = *(const f32x4*)(srcB + i * 256 + lane * 4); }
#pragma unroll
    for (int i = 0; i < 4; ++i)
#pragma unroll
      for (int e = 0; e < 4; ++e) { sa += va[i][e] * va[i][e]; sb += vbq[i][e] * vbq[i][e]; }
    sa = wave_sum(sa); sb = wave_sum(sb);
#pragma unroll
    for (int rr = 0; rr < 2; ++rr) {
      if (rr == 1 && !has1) break;
      const int m = rr == 0 ? m0 : m1;
      const float rstd = rsqrtf((rr == 0 ? sa : sb) * (1.0f / 1024.0f) + 1e-6f);
      const float* md = p.mod + (m < NTOK ? (m / SEQ) : 2) * 6144;
      f32x4 y[4]; float am = 0.f;
#pragma unroll
      for (int i = 0; i < 4; ++i) {
        const int col = i * 256 + lane * 4;
        const f32x4 v = rr == 0 ? va[i] : vbq[i];
        const f32x4 g = *(const f32x4*)(p.g_pre_mix + col), sh = *(const f32x4*)(md + col), sc = *(const f32x4*)(md + 1024 + col);
#pragma unroll
        for (int e = 0; e < 4; ++e) { y[i][e] = v[e] * rstd * g[e] * (1.f + sc[e]) + sh[e]; am = fmaxf(am, fabsf(y[i][e])); }
      }
#pragma unroll
      for (int o = 32; o > 0; o >>= 1) am = fmaxf(am, __shfl_xor(am, o));
      const float qs = am > 0.f ? 127.0f / am : 0.f;
      if (lane == 0) p.hsa[m] = am > 0.f ? am / 127.0f : 1.0f;
#pragma unroll
      for (int i = 0; i < 4; ++i) {
        unsigned pk = 0;
#pragma unroll
        for (int e = 0; e < 4; ++e) pk |= ((unsigned)(int)rintf(y[i][e] * qs) & 255u) << (8 * e);
        *(unsigned*)(p.hx8 + (size_t)m * DM + i * 256 + lane * 4) = pk;
      }
    }
  }
}
struct Epi3Readout {
  const P* pp;
  __device__ __forceinline__ void finish(const bf16_t* sE, int m0, int n0, int tid) const {
    const P& p = *pp;
#pragma unroll 2
    for (int pq = 0; pq < 16; ++pq) {
      const int id = tid + 256 * pq, row = id >> 4, cc = (id & 15) * 8, m = m0 + row, n = n0 + cc, t = m % SEQ, h = n >> 6;
      const u32x4 g = *(const u32x4*)(sE + row * G3_ES + cc);
      const u32x4 y0 = *(const u32x4*)(p.Y0 + (size_t)m * DM + n);
      float y[8], v[8];
#pragma unroll
      for (int i = 0; i < 4; ++i) { y[2 * i] = bflo(y0[i]); y[2 * i + 1] = bfhi(y0[i]); }
      float sm = 0.f;
#pragma unroll
      for (int i = 0; i < 8; ++i) sm += y[i];
      const float mu = red8(sm) * (1.f / 64.f);
      float qv = 0.f;
#pragma unroll
      for (int i = 0; i < 8; ++i) { y[i] -= mu; qv += y[i] * y[i]; }
      const float rs = rsqrtf(red8(qv) * (1.f / 64.f) + 64e-5f);
      load8(p.zA, m, 2048 + n, v);
      const float bon = 0.5f * (p.bdot[(size_t)m * 16 + h] + p.bdot[((size_t)NTOK + m) * 16 + h]);
      const f32x4 w0 = *(const f32x4*)(p.ln_x_w + n), w1 = *(const f32x4*)(p.ln_x_w + n + 4), b0 = *(const f32x4*)(p.ln_x_b + n), b1 = *(const f32x4*)(p.ln_x_b + n + 4);
      const float lw[8] = {w0[0], w0[1], w0[2], w0[3], w1[0], w1[1], w1[2], w1[3]}, lb[8] = {b0[0], b0[1], b0[2], b0[3], b1[0], b1[1], b1[2], b1[3]};
      u32x4 o;
#pragma unroll
      for (int i = 0; i < 4; ++i)
        o[i] = pack2((y[2 * i] * rs * lw[2 * i] + lb[2 * i] + bon * v[2 * i]) * bflo(g[i]), (y[2 * i + 1] * rs * lw[2 * i + 1] + lb[2 * i + 1] + bon * v[2 * i + 1]) * bfhi(g[i]));
      *(u32x4*)(p.out_a + (size_t)m * DM + n) = o;
    }
  }
};
__device__ __forceinline__ int xcd_tile(int vb, int nvb, int round, int TM, int TN, int& tm, int& tn) {
  if (nvb % 64 != 0) { const int it = round * nvb + vb; if (it >= TM * TN) return 0; tm = it % TM; tn = it / TM; return 1; }
  const int spg = nvb >> 3, g = vb & 7, slot = vb >> 3, SC = spg >> 3;
  const int nsr = (TM + 7) >> 3, nsc = (TN + SC - 1) / SC, st = round * 8 + g;
  if (st >= nsr * nsc) return 0;
  tm = (st % nsr) * 8 + (slot & 7); tn = (st / nsr) * SC + (slot >> 3);
  return (tm < TM && tn < TN) ? 1 : 2;
}
__device__ __forceinline__ void ph_gemm1(const P& p, int vb, int nvb, unsigned char* smem) {
  const int NS_ = 132 * 27, NALL = NS_ + 128 * 20;
  const int per = nvb >> 3;
  for (int round = 0;; ++round) {
    int item;
    if ((nvb & 7) == 0) { const int blk = round * 8 + (vb & 7); if (blk * per >= NALL) break; item = blk * per + (vb >> 3); if (item >= NALL) continue; }
    else { item = round * nvb + vb; if (item >= NALL) break; }
    if (item < NS_) {
      const int cgp = item / (132 * 9), rem = item % (132 * 9), tmS = rem / 9, tn = cgp * 9 + rem % 9;
      Epi3ZS epi;
      epi.zA = p.zA; epi.mu = p.mu_shift;
      int m0;
      if (tmS < 130) { const int b = tmS / 65, i = tmS % 65; m0 = b * SEQ + 254 * i - 1; epi.own_lo = 1; epi.own_hi = min(254, SEQ - 254 * i); epi.t0 = 254 * i - 1; epi.T = SEQ; }
      else { m0 = NTOK + (tmS - 130) * CTXL; epi.own_lo = 0; epi.own_hi = 255; epi.t0 = 0; epi.T = CTXL; }
      gemm_tile3_i8(p.hx8, DM, p.Wt8, DM, DM, m0, tn * 128, p.hsa, p.wsb, epi, smem);
    } else {
      const int i2 = item - NS_;
      int tm, tn;
      if (i2 < 2048) { tm = (i2 & 1023) >> 3; tn = 27 + (i2 >> 10) * 8 + (i2 & 7); } else { tm = (i2 - 2048) >> 2; tn = 43 + (i2 & 3); }
      Epi3Z epi{p.zA, p.zP, p.zG};
      gemm_tile3_i8(p.hx8, DM, p.Wt8, DM, DM, tm * 256, tn * 128, p.hsa, p.wsb, epi, smem);
    }
  }
}
__device__ __forceinline__ void ph_readout_gemm(const P& p, int vb, int nvb, unsigned char* smem) {
  Epi3Readout epi{&p};
  for (int round = 0;; ++round) {
    int tm, tn; const int r = xcd_tile(vb, nvb, round, NTOK / 256, DM / 128, tm, tn);
    if (r == 0) break;
    if (r == 1) gemm_tile3(p.sg, 128, p.g2T, 128, 128, tm * 256, tn * 128, epi, smem);
  }
}
__device__ __forceinline__ void ph_sg(const P& p, int vb, int nvb) {
  for (int it = vb * 256 + TIDX; it < NTOK * 16; it += nvb * 256) {
    const int m = it >> 4, l8 = (it & 15) * 8, t = m % SEQ;
    float o[8];
    load8(p.zA, m, 3328 + l8, o);
    u32x4 w;
#pragma unroll
    for (int i = 0; i < 4; ++i) w[i] = pack2(sigmoidf_(o[2 * i]), sigmoidf_(o[2 * i + 1]));
    *(u32x4*)(p.sg + (size_t)m * 128 + l8) = w;
  }
}
__device__ __forceinline__ void ph_gemm_merge(const P& p, int vb, int nvb, unsigned char* smem) {
  Epi3GateA ea{p.zG, p.b_gate, p.mrg};
  Epi3GateB eb{p.zG, p.b_gate, p.mrg};
  for (int round = 0;; ++round) {
    int tm, tn; const int r = xcd_tile(vb, nvb, round, NTOK / 256, DM / 128, tm, tn);
    if (r == 0) break;
    if (r == 1) {
      gemm_tile3(p.out_a, DM, p.Wt_aout, DM, DM, tm * 256, tn * 128, ea, smem);
      gemm_tile3(p.pooled, 512, p.Wt_eff, 512, 512, tm * 256, tn * 128, eb, smem);
    }
  }
}
__device__ __forceinline__ void ph_gemm_simple(const bf16_t* A, int lda, const bf16_t* Bt, int ldb, int K, int M, int N, bf16_t* C, int ldc, int vb, int nvb, unsigned char* smem) {
  Epi3StoreBf16 epi{C, ldc};
  for (int round = 0;; ++round) {
    int tm, tn; const int r = xcd_tile(vb, nvb, round, M / 256, N / 128, tm, tn);
    if (r == 0) break;
    if (r == 1) gemm_tile3(A, lda, Bt, ldb, K, tm * 256, tn * 128, epi, smem);
  }
}


#define O_R1 0
#define O_R2 10240
#define O_TA (O_R2 + 17408)
#define O_TR (O_TA + 4608)
#define O_TB (O_TR + 4608)
#define O_TK (O_TB + 4608)
#define O_TBT (O_TK + 4608)
#define O_TKT (O_TBT + 5120)
#define O_TVT (O_TKT + 5120)
#define O_GAM (O_TVT + 5120)
#define O_TST (O_GAM + 256)
#define RWKV_SMEM (O_TST + 2 * 9216)
#define NSUP 65
__device__ __forceinline__ void lds_wave_fence() { asm volatile("s_waitcnt lgkmcnt(0)" ::: "memory"); }
__device__ __forceinline__ u32x2 pack4(const f32x4& v) { u32x2 r; r.x = pack2(v[0], v[1]); r.y = pack2(v[2], v[3]); return r; }


typedef short s16x4 __attribute__((ext_vector_type(4)));
__device__ __forceinline__ float fast_tanh(float x) { const float e = __builtin_amdgcn_exp2f(2.885390082f * x); return 1.0f - 2.0f * __builtin_amdgcn_rcpf(e + 1.0f); }
template <int NS, bool WANTY>
__device__ __forceinline__ void rwkv_chunk(const P& p, unsigned char* smem, int d, int h, int rowbase, int T, int isc0, bool has_next, f32x4 (&st)[NS][4], u32x4 (&pf)[5]) {
  int tid = TIDX;
  asm volatile("" : "+v"(tid));
  const int lane = tid & 63, w = __builtin_amdgcn_readfirstlane(tid >> 6), l15 = lane & 15, q = lane >> 4;
  const int tt = tid >> 3, cg = tid & 7, ch0 = h * 64 + cg * 8;
  const int isc = isc0 + tt, t = d == 0 ? isc : T - 1 - isc;
  bf16_t* TWD = (bf16_t*)(smem + O_R1); bf16_t* TAD = TWD + 32 * 72;
  float* WT = (float*)(smem + O_R1);
  bf16_t* XT = (bf16_t*)(smem + O_R1); bf16_t* UT = XT + 64 * 40;
  float* LW = (float*)(smem + O_R2); float* LA = LW + 32 * 68;
  float* TL = (float*)(smem + O_R2);
  bf16_t* TT = (bf16_t*)(smem + O_R2 + 4608); bf16_t* TAK = TT + 32 * 40; bf16_t* TRB = TAK + 32 * 40; bf16_t* TRK = TRB + 32 * 40; bf16_t* TLB = TRK + 32 * 40;
  bf16_t* TA = (bf16_t*)(smem + O_TA); bf16_t* TR = (bf16_t*)(smem + O_TR); bf16_t* TB = (bf16_t*)(smem + O_TB); bf16_t* TK = (bf16_t*)(smem + O_TK);
  bf16_t* TBT = (bf16_t*)(smem + O_TBT); bf16_t* TKT = (bf16_t*)(smem + O_TKT); bf16_t* TVT = (bf16_t*)(smem + O_TVT);
  float* GAM = (float*)(smem + O_GAM);
  bf16_t* TST = (bf16_t*)(smem + O_TST);
  __syncthreads();
  float k8[8], r8[8];
  {
    u32x4 pk;
#pragma unroll
    for (int i = 0; i < 4; ++i) pk[i] = pack2(fast_tanh(bflo(pf[0][i])), fast_tanh(bfhi(pf[0][i])));
    *(u32x4*)(TWD + tt * 72 + cg * 8) = pk;
    *(u32x4*)(TAD + tt * 72 + cg * 8) = pf[1];
  }
#pragma unroll
  for (int i = 0; i < 4; ++i) { k8[2 * i] = bflo(pf[2][i]); k8[2 * i + 1] = bfhi(pf[2][i]); if (WANTY) { r8[2 * i] = bflo(pf[3][i]); r8[2 * i + 1] = bfhi(pf[3][i]); } }
  const u32x4 vzc = pf[4];
  __syncthreads();
  {
    f32x4 lw[2], la[2];
    bf16x8 w2f[2], a2f[2];
#pragma unroll
    for (int ks = 0; ks < 2; ++ks) {
      w2f[ks] = *(const bf16x8*)(p.w2T + ((size_t)d * 1024 + h * 64 + 16 * w + l15) * 64 + 32 * ks + 8 * q);
      a2f[ks] = *(const bf16x8*)(p.a2T + ((size_t)d * 1024 + h * 64 + 16 * w + l15) * 64 + 32 * ks + 8 * q);
    }
#pragma unroll
    for (int it = 0; it < 2; ++it) { lw[it] = (f32x4){0.f, 0.f, 0.f, 0.f}; la[it] = (f32x4){0.f, 0.f, 0.f, 0.f}; }
#pragma unroll
    for (int ks = 0; ks < 2; ++ks)
#pragma unroll
      for (int it = 0; it < 2; ++it) {
        const bf16x8 aw = *(const bf16x8*)(TWD + (16 * it + l15) * 72 + 32 * ks + 8 * q);
        const bf16x8 aa = *(const bf16x8*)(TAD + (16 * it + l15) * 72 + 32 * ks + 8 * q);
        lw[it] = __builtin_amdgcn_mfma_f32_16x16x32_bf16(aw, w2f[ks], lw[it], 0, 0, 0);
        la[it] = __builtin_amdgcn_mfma_f32_16x16x32_bf16(aa, a2f[ks], la[it], 0, 0, 0);
      }
    {
      const float cw0 = p.w0[d * 1024 + h * 64 + 16 * w + l15];
      float tot0 = 0.f;
#pragma unroll
      for (int it = 0; it < 2; ++it) {
        float pr[4];
#pragma unroll
        for (int rg = 0; rg < 4; ++rg) {
          const float e = 0.87505707f * sigmoidf_(cw0 + lw[it][rg]);
          pr[rg] = rg == 0 ? e : pr[rg - 1] + e;
        }
        float x = pr[3];
        float y = __shfl_up(x, 16); if (q >= 1) x += y;
        y = __shfl_up(x, 32); if (q >= 2) x += y;
        const float base = (x - pr[3]) + (it == 1 ? tot0 : 0.f);
        if (it == 0) tot0 = __shfl(x, 48 + l15);
#pragma unroll
        for (int rg = 0; rg < 4; ++rg) lw[it][rg] = pr[rg] + base;
      }
      if (q == 3) GAM[16 * w + l15] = __builtin_amdgcn_exp2f(-lw[1][3]);
    }
#pragma unroll
    for (int it = 0; it < 2; ++it)
#pragma unroll
      for (int rg = 0; rg < 4; ++rg) { LW[(16 * it + 4 * q + rg) * 68 + 16 * w + l15] = lw[it][rg]; LA[(16 * it + 4 * q + rg) * 68 + 16 * w + l15] = la[it][rg]; }
  }
  __syncthreads();
  float icl[8], kkn[8], kd[8];
  {
    float ss = 0.f, bd = 0.f;
    float ca0[8], ckk[8], cka[8], crk[8];
#pragma unroll
    for (int e4 = 0; e4 < 8; e4 += 4) {
      const f32x4 b2 = *(const f32x4*)(p.a0 + d * 1024 + ch0 + e4), c2 = *(const f32x4*)(p.k_k + ch0 + e4);
      const f32x4 d2 = *(const f32x4*)(p.k_a + ch0 + e4), f2 = *(const f32x4*)(p.r_k + ch0 + e4);
#pragma unroll
      for (int e = 0; e < 4; ++e) { ca0[e4 + e] = b2[e]; ckk[e4 + e] = c2[e]; cka[e4 + e] = d2[e]; crk[e4 + e] = f2[e]; }
    }
    float lav[8];
    { const f32x4 l0 = *(const f32x4*)(LA + tt * 68 + cg * 8), l1 = *(const f32x4*)(LA + tt * 68 + cg * 8 + 4);
#pragma unroll
      for (int e = 0; e < 4; ++e) { lav[e] = l0[e]; lav[4 + e] = l1[e]; } }
#pragma unroll
    for (int e = 0; e < 8; ++e) {
      icl[e] = sigmoidf_(ca0[e] + lav[e]);
      kkn[e] = k8[e] * ckk[e]; ss += kkn[e] * kkn[e];
      kd[e] = k8[e] * (1.f + (icl[e] - 1.f) * cka[e]);
      if (WANTY) bd += r8[e] * kd[e] * crk[e];
    }
    ss = red8(ss); if (WANTY) bd = red8(bd);
    const float rn = rsqrtf(fmaxf(ss, 1e-24f));
#pragma unroll
    for (int e = 0; e < 8; ++e) kkn[e] *= rn;
    if (WANTY && cg == 0) p.bdot[((size_t)d * NTOK + rowbase + t) * 16 + h] = bd;
  }
  {
    float ta[8], tr[8], tb[8], tk[8], v8[8];
#pragma unroll
    for (int i = 0; i < 4; ++i) { v8[2 * i] = bflo(vzc[i]); v8[2 * i + 1] = bfhi(vzc[i]); }
    float Lv[8], Lpv[8];
    {
      const f32x4 a0 = *(const f32x4*)(LW + tt * 68 + cg * 8), a1 = *(const f32x4*)(LW + tt * 68 + cg * 8 + 4);
      const int tp = tt > 0 ? tt - 1 : 0;
      const f32x4 b0 = *(const f32x4*)(LW + tp * 68 + cg * 8), b1 = *(const f32x4*)(LW + tp * 68 + cg * 8 + 4);
#pragma unroll
      for (int e = 0; e < 4; ++e) { Lv[e] = a0[e]; Lv[4 + e] = a1[e]; Lpv[e] = tt > 0 ? b0[e] : 0.f; Lpv[4 + e] = tt > 0 ? b1[e] : 0.f; }
    }
#pragma unroll
    for (int e = 0; e < 8; ++e) {
      const float Li = Lv[e];
      const float Lp = Lpv[e];
      const float gi = __builtin_amdgcn_exp2f(-Li), gim1 = __builtin_amdgcn_exp2f(-Lp), ginv = __builtin_amdgcn_exp2f(Li);
      ta[e] = -kkn[e] * gim1; if (WANTY) tr[e] = r8[e] * gi; tb[e] = kkn[e] * icl[e] * ginv; tk[e] = kd[e] * ginv;
    }
    u32x4 pk;
    pk.x = pack2(ta[0], ta[1]); pk.y = pack2(ta[2], ta[3]); pk.z = pack2(ta[4], ta[5]); pk.w = pack2(ta[6], ta[7]); *(u32x4*)(TA + tt * 72 + cg * 8) = pk;
    if (WANTY) { pk.x = pack2(tr[0], tr[1]); pk.y = pack2(tr[2], tr[3]); pk.z = pack2(tr[4], tr[5]); pk.w = pack2(tr[6], tr[7]); *(u32x4*)(TR + tt * 72 + cg * 8) = pk; }
    pk.x = pack2(tb[0], tb[1]); pk.y = pack2(tb[2], tb[3]); pk.z = pack2(tb[4], tb[5]); pk.w = pack2(tb[6], tb[7]); *(u32x4*)(TB + tt * 72 + cg * 8) = pk;
    pk.x = pack2(tk[0], tk[1]); pk.y = pack2(tk[2], tk[3]); pk.z = pack2(tk[4], tk[5]); pk.w = pack2(tk[6], tk[7]); *(u32x4*)(TK + tt * 72 + cg * 8) = pk;
#pragma unroll
    for (int e = 0; e < 8; ++e) { TBT[(cg * 8 + e) * 40 + tt] = f2bf(tb[e]); TKT[(cg * 8 + e) * 40 + tt] = f2bf(tk[e]); TVT[(cg * 8 + e) * 40 + tt] = f2bf(v8[e]); }
  }
  __syncthreads();
  if (WANTY || w < 2) {
    const bf16_t* X = (w < 2) ? TA : TR; const bf16_t* Y = (w & 1) ? TK : TB;
    f32x4 g[2][2];
#pragma unroll
    for (int it = 0; it < 2; ++it)
#pragma unroll
      for (int s2 = 0; s2 < 2; ++s2) g[it][s2] = (f32x4){0.f, 0.f, 0.f, 0.f};
#pragma unroll
    for (int ks = 0; ks < 2; ++ks) {
      bf16x8 xa[2], yb[2];
#pragma unroll
      for (int it = 0; it < 2; ++it) { xa[it] = *(const bf16x8*)(X + (16 * it + l15) * 72 + 32 * ks + 8 * q); yb[it] = *(const bf16x8*)(Y + (16 * it + l15) * 72 + 32 * ks + 8 * q); }
#pragma unroll
      for (int it = 0; it < 2; ++it)
#pragma unroll
        for (int s2 = 0; s2 < 2; ++s2) g[it][s2] = __builtin_amdgcn_mfma_f32_16x16x32_bf16(xa[it], yb[s2], g[it][s2], 0, 0, 0);
    }
    if (w == 0) {
#pragma unroll
      for (int it = 0; it < 2; ++it)
#pragma unroll
        for (int s2 = 0; s2 < 2; ++s2)
#pragma unroll
          for (int rg = 0; rg < 4; ++rg) {
            const int i = 16 * it + 4 * q + rg, s = 16 * s2 + l15;
            TL[i * 36 + s] = (s < i) ? g[it][s2][rg] : 0.f;
          }
#pragma unroll
      for (int rg = 0; rg < 4; ++rg) TLB[(4 * q + rg) * 40 + l15] = f2bf(g[1][0][rg]);
    } else {
      bf16_t* dst = w == 1 ? TAK : (w == 2 ? TRB : TRK);
      const int incl = w == 1 ? 0 : 1;
#pragma unroll
      for (int it = 0; it < 2; ++it)
#pragma unroll
        for (int s2 = 0; s2 < 2; ++s2)
#pragma unroll
          for (int rg = 0; rg < 4; ++rg) {
            const int i = 16 * it + 4 * q + rg, s = 16 * s2 + l15;
            dst[i * 40 + s] = f2bf((s < i + incl) ? g[it][s2][rg] : 0.f);
          }
    }
  }
  if (w == 0) {
    lds_wave_fence();
    const int c = lane & 15, hb = lane & 16;
    float Tr[16];
    f32x4 Lr[16][4];
#pragma unroll
    for (int i = 1; i < 16; ++i)
#pragma unroll
      for (int j4 = 0; j4 < (i + 3) / 4; ++j4) Lr[i][j4] = *(const f32x4*)(TL + (hb + i) * 36 + hb + 4 * j4);
#pragma unroll
    for (int i = 0; i < 16; ++i) {
      float acc = (i == c) ? 1.f : 0.f;
#pragma unroll
      for (int j = 0; j < i; ++j) acc += Lr[i][j >> 2][j & 3] * Tr[j];
      Tr[i] = acc;
    }
    if (lane < 32) {
#pragma unroll
      for (int i = 0; i < 16; ++i) TT[(hb + i) * 40 + hb + c] = f2bf(Tr[i]);
    }
  }
  __syncthreads();
  if (has_next) {
    const int isn = isc + 32, tn = d == 0 ? isn : T - 1 - isn;
    const bf16_t* zr = p.zA + (size_t)(rowbase + tn) * SHIFTC;
    pf[0] = *(const u32x4*)(zr + 3072 + d * 64 + cg * 8);
    pf[1] = *(const u32x4*)(zr + 3200 + d * 64 + cg * 8);
    pf[2] = *(const u32x4*)(zr + 1024 + ch0);
    if (WANTY) pf[3] = *(const u32x4*)(zr + ch0);
    pf[4] = *(const u32x4*)(zr + 2048 + ch0);
  }
  bf16_t yprev[2][4];
  if (WANTY) {
#pragma unroll
    for (int it = 0; it < 2; ++it)
#pragma unroll
      for (int rg = 0; rg < 4; ++rg) {
        yprev[it][rg] = 0;
        if (d == 1) yprev[it][rg] = p.Y0[(size_t)(rowbase + T - 1 - (isc0 + 16 * it + 4 * q + rg)) * DM + h * 64 + 16 * w + l15];
      }
  }
  const bf16x8 vfr = *(const bf16x8*)(TVT + (16 * w + l15) * 40 + 8 * q);
  const s16x4 t1f = *(const s16x4*)(TT + l15 * 40 + 4 * q), t2f = *(const s16x4*)(TT + (16 + l15) * 40 + 16 + 4 * q), l21f = *(const s16x4*)(TLB + l15 * 40 + 4 * q);
  bf16_t* XTw = XT + (16 * w + l15) * 40; bf16_t* UTw = UT + (16 * w + l15) * 40;
#pragma unroll
  for (int si = 0; si < NS; ++si) {
    const bool useV = (NS == 1) || (si == 1);
    const bf16_t* STs = TST + (si * 64 + 16 * w + l15) * 72;
    bf16x8 sf[2];
    sf[0] = *(const bf16x8*)(STs + 8 * q); sf[1] = *(const bf16x8*)(STs + 32 + 8 * q);
    f32x4 xa[2];
#pragma unroll
    for (int it = 0; it < 2; ++it) {
      xa[it] = (f32x4){0.f, 0.f, 0.f, 0.f};
#pragma unroll
      for (int ks = 0; ks < 2; ++ks) xa[it] = __builtin_amdgcn_mfma_f32_16x16x32_bf16(*(const bf16x8*)(TA + (16 * it + l15) * 72 + 32 * ks + 8 * q), sf[ks], xa[it], 0, 0, 0);
      if (useV) xa[it] = __builtin_amdgcn_mfma_f32_16x16x32_bf16(*(const bf16x8*)(TAK + (16 * it + l15) * 40 + 8 * q), vfr, xa[it], 0, 0, 0);
    }
    *(u32x2*)(XTw + 4 * q) = pack4(xa[0]);
    lds_wave_fence();
    f32x4 ua = __builtin_amdgcn_mfma_f32_16x16x16bf16_1k(t1f, *(const s16x4*)(XTw + 4 * q), (f32x4){0.f, 0.f, 0.f, 0.f}, 0, 0, 0);
    *(u32x2*)(UTw + 4 * q) = pack4(ua);
    lds_wave_fence();
    xa[1] = __builtin_amdgcn_mfma_f32_16x16x16bf16_1k(l21f, *(const s16x4*)(UTw + 4 * q), xa[1], 0, 0, 0);
    *(u32x2*)(XTw + 16 + 4 * q) = pack4(xa[1]);
    lds_wave_fence();
    ua = __builtin_amdgcn_mfma_f32_16x16x16bf16_1k(t2f, *(const s16x4*)(XTw + 16 + 4 * q), (f32x4){0.f, 0.f, 0.f, 0.f}, 0, 0, 0);
    *(u32x2*)(UTw + 16 + 4 * q) = pack4(ua);
    lds_wave_fence();
    const bf16x8 uf = *(const bf16x8*)(UTw + 8 * q);
    if (WANTY) {
#pragma unroll
      for (int it = 0; it < 2; ++it) {
        f32x4 ya = (f32x4){0.f, 0.f, 0.f, 0.f};
#pragma unroll
        for (int ks = 0; ks < 2; ++ks) ya = __builtin_amdgcn_mfma_f32_16x16x32_bf16(*(const bf16x8*)(TR + (16 * it + l15) * 72 + 32 * ks + 8 * q), sf[ks], ya, 0, 0, 0);
        ya = __builtin_amdgcn_mfma_f32_16x16x32_bf16(*(const bf16x8*)(TRB + (16 * it + l15) * 40 + 8 * q), uf, ya, 0, 0, 0);
        if (useV) ya = __builtin_amdgcn_mfma_f32_16x16x32_bf16(*(const bf16x8*)(TRK + (16 * it + l15) * 40 + 8 * q), vfr, ya, 0, 0, 0);
#pragma unroll
        for (int rg = 0; rg < 4; ++rg) {
          const int iq = isc0 + 16 * it + 4 * q + rg, tq = d == 0 ? iq : T - 1 - iq;
          if (useV) {
            p.Y0[(size_t)(rowbase + tq) * DM + h * 64 + 16 * w + l15] = f2bf(ya[rg] + bf2f(yprev[it][rg]));
          } else {
            bf16_t* pp = d == 0 ? p.Y1 + (size_t)(rowbase + tq) * DM : p.zA + (size_t)(rowbase + tq) * SHIFTC;
            pp[h * 64 + 16 * w + l15] = f2bf(ya[rg]);
          }
        }
      }
    }
#pragma unroll
    for (int kt = 0; kt < 4; ++kt) {
      f32x4 hv = st[si][kt];
      hv = __builtin_amdgcn_mfma_f32_16x16x32_bf16(*(const bf16x8*)(TBT + (16 * kt + l15) * 40 + 8 * q), uf, hv, 0, 0, 0);
      if (useV) hv = __builtin_amdgcn_mfma_f32_16x16x32_bf16(*(const bf16x8*)(TKT + (16 * kt + l15) * 40 + 8 * q), vfr, hv, 0, 0, 0);
      hv *= *(const f32x4*)(GAM + 16 * kt + 4 * q);
      st[si][kt] = hv;
      *(u32x2*)(TST + (si * 64 + 16 * w + l15) * 72 + 16 * kt + 4 * q) = pack4(hv);
    }
  }
}

template <bool WANTY>
__device__ __forceinline__ void rwkv_prefetch_first(const P& p, int d, int h, int rowbase, int T, int isc0, u32x4 (&pf)[5]) {
  const int tid = TIDX, tt = tid >> 3, cg = tid & 7, ch0 = h * 64 + cg * 8, isc = isc0 + tt, t = d == 0 ? isc : T - 1 - isc;
  const bf16_t* zr = p.zA + (size_t)(rowbase + t) * SHIFTC;
  pf[0] = *(const u32x4*)(zr + 3072 + d * 64 + cg * 8);
  pf[1] = *(const u32x4*)(zr + 3200 + d * 64 + cg * 8);
  pf[2] = *(const u32x4*)(zr + 1024 + ch0);
  pf[3] = WANTY ? *(const u32x4*)(zr + ch0) : (u32x4){0u, 0u, 0u, 0u};
  pf[4] = *(const u32x4*)(zr + 2048 + ch0);
}
template <bool LAT>
__device__ __forceinline__ void rwkv_super(const P& p, unsigned char* smem, int chain, int j) {
  const int tid = TIDX, lane = tid & 63, w = tid >> 6, l15 = lane & 15, q = lane >> 4;
  bf16_t* TST = (bf16_t*)(smem + O_TST);
  const int b = chain >> 5, d = (chain >> 4) & 1, h = chain & 15;
  const int T = LAT ? SEQ : CTXL, rowbase = LAT ? b * SEQ : NTOK + b * CTXL, base = LAT ? (j - 1) * 256 : 0;
  f32x4 st[2][4];
  __syncthreads();
#pragma unroll
  for (int kt = 0; kt < 4; ++kt) {
#pragma unroll
    for (int rg = 0; rg < 4; ++rg) st[0][kt][rg] = (16 * kt + 4 * q + rg == 16 * w + l15) ? 1.f : 0.f;
    st[1][kt] = (f32x4){0.f, 0.f, 0.f, 0.f};
    *(u32x2*)(TST + (16 * w + l15) * 72 + 16 * kt + 4 * q) = pack4(st[0][kt]);
    *(u32x2*)(TST + (64 + 16 * w + l15) * 72 + 16 * kt + 4 * q) = pack4(st[1][kt]);
  }
  u32x4 pf[5]; rwkv_prefetch_first<LAT>(p, d, h, rowbase, T, base, pf);
  for (int c = 0; c < 8; ++c) rwkv_chunk<2, LAT>(p, smem, d, h, rowbase, T, base + 32 * c, c < 7, st, pf);
  if (j < 64) {
    const size_t slot = (size_t)chain * NSUP + j;
#pragma unroll
    for (int kt = 0; kt < 4; ++kt) {
#pragma unroll
      for (int rg = 0; rg < 4; ++rg) p.Mst[(slot * 64 + 16 * kt + 4 * q + rg) * 64 + 16 * w + l15] = f2bf(st[0][kt][rg]);
      *(f32x4*)(p.Nst + (slot * 64 + 16 * w + l15) * 64 + 16 * kt + 4 * q) = st[1][kt];
    }
  }
}
__device__ __forceinline__ void ph_rwkv_A(const P& p, int vb, int nvb, unsigned char* smem) {
  for (int chain = vb; chain < 64; chain += nvb) rwkv_super<false>(p, smem, chain, 0);
  for (int item = vb; item < 2048; item += nvb) {
    const int b = item >> 10, J = (item >> 4) & 63, h = item & 15;
#pragma unroll 1
    for (int d = 0; d < 2; ++d) {
      rwkv_super<true>(p, smem, b * 32 + d * 16 + h, d == 0 ? J + 1 : 64 - J);
      asm volatile("s_waitcnt vmcnt(0)" ::: "memory");
      __syncthreads();
    }
  }
}
__device__ __forceinline__ void ph_rwkv_B(const P& p, int vb, int nvb, unsigned char* smem) {
  const int tid = TIDX, lane = tid & 63, w = tid >> 6, l15 = lane & 15, q = lane >> 4;
  bf16_t* HT = (bf16_t*)smem;
  for (int chain = vb; chain < 64; chain += nvb) {
    f32x4 hs[4];
#pragma unroll
    for (int kt = 0; kt < 4; ++kt) hs[kt] = (f32x4){0.f, 0.f, 0.f, 0.f};
    __syncthreads();
    for (int j = 0; j < 64; ++j) {
      const size_t slot = (size_t)chain * NSUP + j;
      f32x4 nv[4];
#pragma unroll
      for (int kt = 0; kt < 4; ++kt) nv[kt] = *(const f32x4*)(p.Nst + (slot * 64 + 16 * w + l15) * 64 + 16 * kt + 4 * q);
      bf16x8 mf[4][2];
#pragma unroll
      for (int kt = 0; kt < 4; ++kt)
#pragma unroll
        for (int ks = 0; ks < 2; ++ks) mf[kt][ks] = *(const bf16x8*)(p.Mst + (slot * 64 + 16 * kt + l15) * 64 + 32 * ks + 8 * q);
#pragma unroll
      for (int kt = 0; kt < 4; ++kt) {
        *(f32x4*)(p.Nst + (slot * 64 + 16 * w + l15) * 64 + 16 * kt + 4 * q) = hs[kt];
        *(u32x2*)(HT + (16 * w + l15) * 72 + 16 * kt + 4 * q) = pack4(hs[kt]);
      }
      lds_wave_fence();
      bf16x8 hf[2];
      hf[0] = *(const bf16x8*)(HT + (16 * w + l15) * 72 + 8 * q); hf[1] = *(const bf16x8*)(HT + (16 * w + l15) * 72 + 32 + 8 * q);
      lds_wave_fence();
#pragma unroll
      for (int kt = 0; kt < 4; ++kt) {
        f32x4 a = nv[kt];
#pragma unroll
        for (int ks = 0; ks < 2; ++ks) a = __builtin_amdgcn_mfma_f32_16x16x32_bf16(mf[kt][ks], hf[ks], a, 0, 0, 0);
        hs[kt] = a;
      }
    }
    const size_t slot = (size_t)chain * NSUP + 64;
#pragma unroll
    for (int kt = 0; kt < 4; ++kt) *(f32x4*)(p.Nst + (slot * 64 + 16 * w + l15) * 64 + 16 * kt + 4 * q) = hs[kt];
  }
}
__device__ __forceinline__ void ph_ycorr(const P& p, int vb, int nvb) {
  const int tid = TIDX, lane = tid & 63, w = tid >> 6, l15 = lane & 15, q = lane >> 4;
  for (int item = vb; item < 2048; item += nvb) {
    const int b = item >> 10, J = (item >> 4) & 63, h = item & 15;
    const size_t tok0 = (size_t)b * SEQ + J * 256 + 64 * w;
    bf16x8 hf[4][4];
#pragma unroll
    for (int kk = 0; kk < 4; ++kk) {
      const size_t slot = kk < 2 ? (size_t)(b * 32 + h) * NSUP + (J + 1) : (size_t)(b * 32 + 16 + h) * NSUP + (64 - J);
#pragma unroll
      for (int nt = 0; nt < 4; ++nt) {
        const float* src = p.Nst + (slot * 64 + 16 * nt + l15) * 64 + 32 * (kk & 1) + 8 * q;
        const f32x4 a = *(const f32x4*)src, c = *(const f32x4*)(src + 4);
        const u32x4 pk = (u32x4){pack2(a[0], a[1]), pack2(a[2], a[3]), pack2(c[0], c[1]), pack2(c[2], c[3])};
        hf[kk][nt] = __builtin_bit_cast(bf16x8, pk);
      }
    }
#pragma unroll 1
    for (int mt = 0; mt < 4; ++mt) {
      const size_t tok = tok0 + 16 * mt + l15;
      bf16x8 pa[4];
#pragma unroll
      for (int kk = 0; kk < 2; ++kk) {
        pa[kk] = *(const bf16x8*)(p.Y1 + tok * DM + h * 64 + 32 * kk + 8 * q);
        pa[2 + kk] = *(const bf16x8*)(p.zA + tok * SHIFTC + h * 64 + 32 * kk + 8 * q);
      }
      u32x2 yo[4];
#pragma unroll
      for (int nt = 0; nt < 4; ++nt) yo[nt] = *(const u32x2*)(p.Y0 + tok * DM + h * 64 + 16 * nt + 4 * q);
#pragma unroll
      for (int nt = 0; nt < 4; ++nt) {
        f32x4 acc = (f32x4){bflo(yo[nt].x), bfhi(yo[nt].x), bflo(yo[nt].y), bfhi(yo[nt].y)};
#pragma unroll
        for (int kk = 0; kk < 4; ++kk) acc = __builtin_amdgcn_mfma_f32_16x16x32_bf16(hf[kk][nt], pa[kk], acc, 0, 0, 0);
        *(u32x2*)(p.Y0 + tok * DM + h * 64 + 16 * nt + 4 * q) = pack4(acc);
      }
    }
  }
}

#define POOL_SMEM (64 * 128 * 4)
__device__ __forceinline__ void ph_pool(const P& p, int vb, int nvb, unsigned char* smem) {
  float* V = (float*)smem;
  const int tid = TIDX, cp = tid & 63, cq = tid >> 6;
  for (int item = vb; item < 2 * 4 * 64; item += nvb) {
    const int j = item & 3, st = (item >> 2) & 63, b = item >> 8;
    const int win = 2 << j, half = win >> 1;
    const bf16_t* zb = p.zP + (size_t)b * SEQ * 512 + j * 128 + cp * 2;
    float a0[16], a1[16];
#pragma unroll
    for (int i = 0; i < 16; ++i) { a0[i] = 0.f; a1[i] = 0.f; }
    {
      const int r = 4 * st, r0 = max(r - half, 0), r1 = min(r + half, 256);
      for (int rr = r0; rr < r1; ++rr) {
#pragma unroll
        for (int i = 0; i < 16; ++i) { const unsigned u = *(const unsigned*)(zb + (size_t)(rr * 64 + cq * 16 + i) * 512); a0[i] += bflo(u); a1[i] += bfhi(u); }
      }
    }
    for (int dr = 0; dr < 4; ++dr) {
      const int r = 4 * st + dr, r0 = max(r - half, 0), r1 = min(r + half, 256);
      if (dr > 0) {
        const int radd = r + half - 1, rsub = r - half - 1;
        if (radd < 256) {
#pragma unroll
          for (int i = 0; i < 16; ++i) { const unsigned u = *(const unsigned*)(zb + (size_t)(radd * 64 + cq * 16 + i) * 512); a0[i] += bflo(u); a1[i] += bfhi(u); }
        }
        if (rsub >= 0) {
#pragma unroll
          for (int i = 0; i < 16; ++i) { const unsigned u = *(const unsigned*)(zb + (size_t)(rsub * 64 + cq * 16 + i) * 512); a0[i] -= bflo(u); a1[i] -= bfhi(u); }
        }
      }
      __syncthreads();
#pragma unroll
      for (int i = 0; i < 16; ++i) *(f32x2*)(V + (cq * 16 + i) * 128 + cp * 2) = (f32x2){a0[i], a1[i]};
      __syncthreads();
      float s0 = 0.f, s1 = 0.f;
      {
        const int c = cq * 16, c0 = max(c - half, 0), c1 = min(c + half, 64);
        for (int cc = c0; cc < c1; ++cc) { const f32x2 v = *(const f32x2*)(V + cc * 128 + cp * 2); s0 += v.x; s1 += v.y; }
      }
#pragma unroll
      for (int i = 0; i < 16; ++i) {
        const int c = cq * 16 + i, c0 = max(c - half, 0), c1 = min(c + half, 64);
        if (i > 0) {
          const int cadd = c + half - 1, csub = c - half - 1;
          if (cadd < 64) { const f32x2 v = *(const f32x2*)(V + cadd * 128 + cp * 2); s0 += v.x; s1 += v.y; }
          if (csub >= 0) { const f32x2 v = *(const f32x2*)(V + csub * 128 + cp * 2); s0 -= v.x; s1 -= v.y; }
        }
        const float inv = __builtin_amdgcn_rcpf((float)((r1 - r0) * (c1 - c0)));
        const size_t tokoff = ((size_t)b * SEQ + r * 64 + c) * 512 + j * 128 + cp * 2;
        const unsigned u = *(const unsigned*)(p.zP + tokoff);
        *(unsigned*)(p.pooled + tokoff) = pack2(s0 * inv - bflo(u), s1 * inv - bfhi(u));
      }
    }
  }
}
__device__ __forceinline__ void ph_res1(const P& p, int vb, int nvb) {
  const int lane = TIDX & 63, wid = TIDX >> 6;
  for (int m = vb * 4 + wid; m < NTOK; m += nvb * 4) {
    const float* md = p.mod + (m / SEQ) * 6144;
    float mx[16]; float ss = 0.f;
#pragma unroll
    for (int i = 0; i < 4; ++i) {
      const uint2 u = *(const uint2*)(p.mix + (size_t)m * DM + i * 256 + lane * 4);
      mx[4 * i] = bflo(u.x); mx[4 * i + 1] = bfhi(u.x); mx[4 * i + 2] = bflo(u.y); mx[4 * i + 3] = bfhi(u.y);
#pragma unroll
      for (int e = 0; e < 4; ++e) ss += mx[4 * i + e] * mx[4 * i + e];
    }
    ss = wave_sum(ss);
    const float rstd = rsqrtf(ss * (1.0f / 1024.0f) + 1e-6f);
    float x1[16]; float s2 = 0.f;
#pragma unroll
    for (int i = 0; i < 4; ++i) {
      const int col = i * 256 + lane * 4;
      const float4 xv = *(const float4*)(p.x + (size_t)m * DM + col), g = *(const float4*)(p.g_post_mix + col), gt = *(const float4*)(md + 2048 + col);
      x1[4 * i] = xv.x + gt.x * mx[4 * i] * rstd * g.x; x1[4 * i + 1] = xv.y + gt.y * mx[4 * i + 1] * rstd * g.y;
      x1[4 * i + 2] = xv.z + gt.z * mx[4 * i + 2] * rstd * g.z; x1[4 * i + 3] = xv.w + gt.w * mx[4 * i + 3] * rstd * g.w;
      *(float4*)(p.out + (size_t)m * DM + col) = make_float4(x1[4 * i], x1[4 * i + 1], x1[4 * i + 2], x1[4 * i + 3]);
#pragma unroll
      for (int e = 0; e < 4; ++e) s2 += x1[4 * i + e] * x1[4 * i + e];
    }
    s2 = wave_sum(s2);
    const float r2 = rsqrtf(s2 * (1.0f / 1024.0f) + 1e-6f);
#pragma unroll
    for (int i = 0; i < 4; ++i) {
      const int col = i * 256 + lane * 4;
      const float4 g = *(const float4*)(p.g_pre_ffn + col), sh = *(const float4*)(md + 3072 + col), sc = *(const float4*)(md + 4096 + col);
      uint2 w;
      w.x = pack2(x1[4 * i] * r2 * g.x * (1.f + sc.x) + sh.x, x1[4 * i + 1] * r2 * g.y * (1.f + sc.y) + sh.y);
      w.y = pack2(x1[4 * i + 2] * r2 * g.z * (1.f + sc.z) + sh.z, x1[4 * i + 3] * r2 * g.w * (1.f + sc.w) + sh.w);
      *(uint2*)(p.hx2 + (size_t)m * DM + col) = w;
    }
  }
}

#define PS1_SMEM (128 * 133 * 4)
#define CE_DESC(a, b) { const float _mx = fmaxf(a, b), _mn = fminf(a, b); a = _mx; b = _mn; }
template <int N> __device__ __forceinline__ void bitonic_sort_desc(float (&v)[N]) {
#pragma unroll
  for (int k = 2; k <= N; k <<= 1)
#pragma unroll
    for (int j = k >> 1; j > 0; j >>= 1)
#pragma unroll
      for (int i = 0; i < N; ++i) { const int l = i ^ j; if (l > i) { if ((i & k) == 0) CE_DESC(v[i], v[l]) else CE_DESC(v[l], v[i]) } }
}
__device__ __forceinline__ void bitonic_merge16_desc(float (&v)[16]) {
#pragma unroll
  for (int j = 8; j > 0; j >>= 1)
#pragma unroll
    for (int i = 0; i < 16; ++i) { const int l = i ^ j; if (l > i) CE_DESC(v[i], v[l]) }
}
__device__ __forceinline__ void ph_peer_s1(const P& p, int vb, int nvb, unsigned char* smem) {
  float* S = (float*)smem;
  EpiLds epi{S};
  const int tid = TIDX, sub = tid & 3;
  for (int item = vb; item < 256 * 16; item += nvb) {
    const int hp = item & 15, tm = item >> 4;
    __syncthreads();
    gemm_tile(p.q + hp * 128, 2048, p.keys + (size_t)hp * 128 * 128, 128, 128, tm * 128, 0, epi, smem);
    __syncthreads();
#pragma unroll 1
    for (int pass = 0; pass < 2; ++pass) {
      const int row = pass * 64 + (tid >> 2);
      float a[16], b[16];
#pragma unroll
      for (int i = 0; i < 16; ++i) {
        a[i] = __uint_as_float((__float_as_uint(S[row * 133 + sub * 33 + i]) & ~127u) | (unsigned)(sub * 32 + i));
        b[i] = __uint_as_float((__float_as_uint(S[row * 133 + sub * 33 + 16 + i]) & ~127u) | (unsigned)(sub * 32 + 16 + i));
      }
      bitonic_sort_desc<16>(a); bitonic_sort_desc<16>(b);
#pragma unroll
      for (int i = 0; i < 16; ++i) a[i] = fmaxf(a[i], b[15 - i]);
      bitonic_merge16_desc(a);
#pragma unroll
      for (int lvl = 1; lvl <= 2; lvl <<= 1) {
#pragma unroll
        for (int i = 0; i < 16; ++i) b[i] = __shfl_xor(a[i], lvl);
#pragma unroll
        for (int i = 0; i < 16; ++i) a[i] = fmaxf(a[i], b[15 - i]);
        bitonic_merge16_desc(a);
      }
      if (sub == 0) {
        const size_t ob = ((size_t)(tm * 128 + row) * 16 + hp) * 16;
#pragma unroll
        for (int i = 0; i < 16; i += 4) {
          *(f32x4*)(p.sv + ob + i) = (f32x4){a[i], a[i + 1], a[i + 2], a[i + 3]};
          typedef int i32x4 __attribute__((ext_vector_type(4)));
          *(i32x4*)(p.si + ob + i) = (i32x4){(int)(__float_as_uint(a[i]) & 127u), (int)(__float_as_uint(a[i + 1]) & 127u), (int)(__float_as_uint(a[i + 2]) & 127u), (int)(__float_as_uint(a[i + 3]) & 127u)};
        }
      }
    }
  }
}
__device__ __forceinline__ void top16_merge(float (&x)[16], const float (&y)[16]) {
#pragma unroll
  for (int i = 0; i < 16; ++i) x[i] = fmaxf(x[i], y[15 - i]);
  bitonic_merge16_desc(x);
}
__device__ __forceinline__ void ph_peer_s2(const P& p, int vb, int nvb, unsigned char* smem) {
  unsigned char* lut = smem;
  __syncthreads();
  if (TIDX == 0) {
    int n = 0;
#pragma unroll
    for (int i = 0; i < 16; ++i)
#pragma unroll
      for (int j = 0; j < 16; ++j)
        if ((i + 1) * (j + 1) <= 16) { lut[n] = (unsigned char)((i << 4) | j); ++n; }
  }
  __syncthreads();
  for (int it = vb * 256 + TIDX; it < NTOK * 8; it += nvb * 256) {
    const size_t ob = (size_t)it * 32;
    float a[16], bq[16];
#pragma unroll
    for (int i = 0; i < 16; i += 4) {
      const f32x4 fa = *(const f32x4*)(p.sv + ob + i), fb = *(const f32x4*)(p.sv + ob + 16 + i);
#pragma unroll
      for (int e = 0; e < 4; ++e) { a[i + e] = fa[e]; bq[i + e] = fb[e]; }
    }
    float g0[16], g1[16], g2[16], g3[16];
    {
      int n = 0;
#pragma unroll
      for (int i = 0; i < 16; ++i)
#pragma unroll
        for (int j = 0; j < 16; ++j)
          if ((i + 1) * (j + 1) <= 16) {
            const float v = __uint_as_float((__float_as_uint(a[i] + bq[j]) & ~63u) | (unsigned)n);
            if (n < 16) g0[n] = v; else if (n < 32) g1[n - 16] = v; else if (n < 48) g2[n - 32] = v; else g3[n - 48] = v;
            ++n;
          }
#pragma unroll
      for (int k = 2; k < 16; ++k) g3[k] = -3.0e38f;
    }
    bitonic_sort_desc<16>(g0); bitonic_sort_desc<16>(g1); bitonic_sort_desc<16>(g2); bitonic_sort_desc<16>(g3);
    top16_merge(g0, g1); top16_merge(g2, g3); top16_merge(g0, g2);
    float den = 0.f; float ex[16]; int seli[16];
#pragma unroll
    for (int k = 0; k < 16; ++k) {
      ex[k] = __expf(g0[k] - g0[0]); den += ex[k];
      const int ij = lut[__float_as_uint(g0[k]) & 63u];
      const int ka = (int)(__float_as_uint(p.sv[ob + (ij >> 4)]) & 127u), kb = (int)(__float_as_uint(p.sv[ob + 16 + (ij & 15)]) & 127u);
      seli[k] = ka * 128 + kb;
    }
    const float inv = 1.0f / den;
    const size_t o2 = (size_t)it * 16;
    typedef int i32x4 __attribute__((ext_vector_type(4)));
#pragma unroll
    for (int k = 0; k < 16; k += 4) {
      *(i32x4*)(p.pidx + o2 + k) = (i32x4){seli[k], seli[k + 1], seli[k + 2], seli[k + 3]};
      *(f32x4*)(p.pgate + o2 + k) = (f32x4){ex[k] * inv, ex[k + 1] * inv, ex[k + 2] * inv, ex[k + 3] * inv};
    }
  }
}
typedef float f32x16 __attribute__((ext_vector_type(16)));
typedef float f32x32 __attribute__((ext_vector_type(32)));
typedef unsigned u32x6 __attribute__((ext_vector_type(6)));
__device__ __forceinline__ float gelu_as(float v) {
  const float t = __builtin_amdgcn_rcpf(fabsf(v) * 0.2316418882f + 1.0f);
  float qq = t * 0.5307027145f + (-0.7265760135f); qq = qq * t + 0.7107068705f; qq = qq * t + (-0.142248368f); qq = qq * t + 0.127414796f; qq = qq * t;
  const float m = v * (qq * __builtin_amdgcn_exp2f((v * v) * (-0.72134752044f)));
  return v < 0.f ? m : v - m;
}
__device__ __forceinline__ float half_max(float v) {
#pragma unroll
  for (int o = 16; o > 0; o >>= 1) v = fmaxf(v, __shfl_xor(v, o));
  return v;
}
__device__ __forceinline__ float half_sum(float v) {
#pragma unroll
  for (int o = 16; o > 0; o >>= 1) v += __shfl_xor(v, o);
  return v;
}
__device__ __forceinline__ void ph_cvt_fp6(const float* __restrict__ in, unsigned char* __restrict__ out, float* __restrict__ inv_scale, int vb, int nvb) {
  const int lane = TIDX & 63, wid = TIDX >> 6, hf = lane >> 5, sl = lane & 31;
  for (int rp = vb * 4 + wid; rp < 8192; rp += nvb * 4) {
    const int row = rp * 2 + hf;
    f32x16 a, b2; float am = 0.f;
#pragma unroll
    for (int i = 0; i < 4; ++i) {
      const f32x4 v0 = *(const f32x4*)(in + (size_t)row * DM + sl * 32 + 4 * i), v1 = *(const f32x4*)(in + (size_t)row * DM + sl * 32 + 16 + 4 * i);
#pragma unroll
      for (int e = 0; e < 4; ++e) { a[4 * i + e] = v0[e]; b2[4 * i + e] = v1[e]; am = fmaxf(am, fmaxf(fabsf(v0[e]), fabsf(v1[e]))); }
    }
    am = half_max(am);
    const float sc = am > 0.f ? 7.0f / am : 1.0f;
    const u32x6 pk = __builtin_amdgcn_cvt_scalef32_2xpk16_fp6_f32(a * sc, b2 * sc, 1.0f);
    unsigned char* o = out + (size_t)row * 768 + sl * 24;
    *(u32x2*)(o) = (u32x2){pk[0], pk[1]}; *(u32x2*)(o + 8) = (u32x2){pk[2], pk[3]}; *(u32x2*)(o + 16) = (u32x2){pk[4], pk[5]};
    if (sl == 0) inv_scale[row] = am > 0.f ? am / 7.0f : 1.0f;
  }
}
__device__ __forceinline__ void ph_cvt_fp4(const float* __restrict__ in, unsigned char* __restrict__ out, float* __restrict__ inv_scale, int vb, int nvb) {
  const int lane = TIDX & 63, wid = TIDX >> 6, hf = lane >> 5, sl = lane & 31;
  const f32x2 probe = __builtin_amdgcn_cvt_scalef32_pk_f32_fp4(__builtin_amdgcn_cvt_scalef32_pk_fp4_f32(0u, 1.0f, 2.0f, 1.0f, 0), 1.0f, 0);
  const bool sw = probe.x != 1.0f;
  for (int rp = vb * 4 + wid; rp < 8192; rp += nvb * 4) {
    const int row = rp * 2 + hf;
    f32x4 v[8]; float am = 0.f;
#pragma unroll
    for (int i = 0; i < 8; ++i) {
      v[i] = *(const f32x4*)(in + (size_t)row * DM + sl * 32 + 4 * i);
#pragma unroll
      for (int e = 0; e < 4; ++e) am = fmaxf(am, fabsf(v[i][e]));
    }
    am = half_max(am);
    const float sc = am > 0.f ? 6.0f / am : 1.0f;
    u32x4 pk = (u32x4){0u, 0u, 0u, 0u};
#pragma unroll
    for (int w = 0; w < 4; ++w) {
      unsigned word = 0u;
      float c[8];
#pragma unroll
      for (int e = 0; e < 4; ++e) { c[e] = v[2 * w][e] * sc; c[4 + e] = v[2 * w + 1][e] * sc; }
      word = __builtin_amdgcn_cvt_scalef32_pk_fp4_f32(word, sw ? c[1] : c[0], sw ? c[0] : c[1], 1.0f, 0);
      word = __builtin_amdgcn_cvt_scalef32_pk_fp4_f32(word, sw ? c[3] : c[2], sw ? c[2] : c[3], 1.0f, 1);
      word = __builtin_amdgcn_cvt_scalef32_pk_fp4_f32(word, sw ? c[5] : c[4], sw ? c[4] : c[5], 1.0f, 2);
      word = __builtin_amdgcn_cvt_scalef32_pk_fp4_f32(word, sw ? c[7] : c[6], sw ? c[6] : c[7], 1.0f, 3);
      pk[w] = word;
    }
    *(u32x4*)(out + (size_t)row * 512 + sl * 16) = pk;
    if (sl == 0) inv_scale[row] = am > 0.f ? am / 6.0f : 1.0f;
  }
}
__device__ __forceinline__ u32x6 load_row6(const unsigned char* base, int id, int sl) {
  const unsigned char* q = base + (size_t)id * 768 + sl * 24;
  const u32x2 a = *(const u32x2*)q, b = *(const u32x2*)(q + 8), c = *(const u32x2*)(q + 16);
  return (u32x6){a.x, a.y, b.x, b.y, c.x, c.y};
}
#define GATHER_SMEM (4 * 64 * 33 * 4)
__device__ __forceinline__ void ph_peer_gather(const P& p, int vb, int nvb, unsigned char* smem) {
  int tid_ = TIDX;
  asm volatile("" : "+v"(tid_));
  const int lane = tid_ & 63, wid = tid_ >> 6, hf = lane >> 5, sl = lane & 31;
  float* scr = (float*)smem + (wid * 64 + lane) * 33;
  int* tauL = (int*)(smem + GATHER_SMEM) + wid * 32;
  {
    f32x16 a, b2;
#pragma unroll
    for (int i = 0; i < 16; ++i) { a[i] = __uint_as_float((unsigned)i << 20) * 0x1p126f; b2[i] = __uint_as_float((unsigned)(16 + i) << 20) * 0x1p126f; }
    const f32x32 o = __builtin_amdgcn_cvt_scalef32_pk32_f32_fp6(__builtin_amdgcn_cvt_scalef32_2xpk16_fp6_f32(a, b2, 1.0f), 1.0f);
    if (lane == 0) {
#pragma unroll
      for (int j = 0; j < 32; ++j) tauL[j] = (int)((__float_as_uint(o[j] * 0x1p-126f) >> 20) & 31u);
    }
  }
  const int jmap = 2 * (lane & 1) + ((lane >> 1) & 1);
  __syncthreads();
  for (int m = vb * 4 + wid; m < NTOK; m += nvb * 4) {
    const float* md = p.mod + (m / SEQ) * 6144;
    float xh[32];
    {
#pragma unroll
      for (int c4 = 0; c4 < 4; ++c4) {
        const u32x4 u = *(const u32x4*)(p.hx2 + (size_t)m * DM + sl * 32 + 8 * c4);
#pragma unroll
        for (int e = 0; e < 4; ++e) { scr[8 * c4 + 2 * e] = bflo(u[e]); scr[8 * c4 + 2 * e + 1] = bfhi(u[e]); }
      }
      lds_wave_fence();
#pragma unroll
      for (int j = 0; j < 32; ++j) xh[j] = scr[tauL[j]];
      lds_wave_fence();
    }
    const int id0 = p.pidx[(size_t)m * 128 + lane], id1 = p.pidx[(size_t)m * 128 + 64 + lane];
    const float su0 = p.us[id0], su1 = p.us[id1];
    const float gs0 = p.pgate[(size_t)m * 128 + lane] * p.vs[id0], gs1 = p.pgate[(size_t)m * 128 + 64 + lane] * p.vs[id1];
    f32x2 acc2[16];
#pragma unroll
    for (int k = 0; k < 16; ++k) acc2[k] = (f32x2){0.f, 0.f};
#pragma unroll 1
    for (int e0 = 0; e0 < 128; e0 += 8) {
      u32x6 ur[4]; u32x4 vr[4];
#pragma unroll
      for (int j = 0; j < 4; ++j) {
        const int id = __shfl(e0 < 64 ? id0 : id1, (e0 + hf * 4 + j) & 63);
        ur[j] = load_row6(p.ub8, id, sl);
        vr[j] = *(const u32x4*)(p.vb8 + (size_t)id * 512 + sl * 16);
      }
      float d[4];
#pragma unroll
      for (int j = 0; j < 4; ++j) {
        const f32x32 f = __builtin_amdgcn_cvt_scalef32_pk32_f32_fp6(ur[j], 1.0f);
        float s0 = 0.f, s1 = 0.f;
#pragma unroll
        for (int k = 0; k < 32; k += 2) { s0 += f[k] * xh[k]; s1 += f[k + 1] * xh[k + 1]; }
        d[j] = s0 + s1;
        __builtin_amdgcn_sched_barrier(0);
      }
      float r2[2], r1;
      {
        const bool lo = (lane & 1) == 0;
#pragma unroll
        for (int i = 0; i < 2; ++i) { const float keep = lo ? d[i] : d[i + 2], send = lo ? d[i + 2] : d[i]; r2[i] = keep + __shfl_xor(send, 1); }
        const bool lo2 = (lane & 2) == 0;
        { const float keep = lo2 ? r2[0] : r2[1], send = lo2 ? r2[1] : r2[0]; r1 = keep + __shfl_xor(send, 2); }
        r1 += __shfl_xor(r1, 4); r1 += __shfl_xor(r1, 8); r1 += __shfl_xor(r1, 16);
      }
      const int esrc = (e0 + hf * 4 + jmap) & 63;
      const float su = __shfl(e0 < 64 ? su0 : su1, esrc), gs = __shfl(e0 < 64 ? gs0 : gs1, esrc);
      const float sdot = r1 * su;
      const float cf = gelu_as(sdot) * gs;
#pragma unroll
      for (int j = 0; j < 4; ++j) {
        const float cj = __shfl(cf, (lane & 32) | ((j >> 1) | ((j & 1) << 1)));
        const f32x2 cj2 = (f32x2){cj, cj};
#pragma unroll
        for (int w = 0; w < 4; ++w) {
          acc2[4 * w + 0] += cj2 * __builtin_amdgcn_cvt_scalef32_pk_f32_fp4(vr[j][w], 1.0f, 0);
          acc2[4 * w + 1] += cj2 * __builtin_amdgcn_cvt_scalef32_pk_f32_fp4(vr[j][w], 1.0f, 1);
          acc2[4 * w + 2] += cj2 * __builtin_amdgcn_cvt_scalef32_pk_f32_fp4(vr[j][w], 1.0f, 2);
          acc2[4 * w + 3] += cj2 * __builtin_amdgcn_cvt_scalef32_pk_f32_fp4(vr[j][w], 1.0f, 3);
        }
      }
    }
#pragma unroll
    for (int k = 0; k < 16; ++k) { scr[2 * k] = acc2[k].x + __shfl_xor(acc2[k].x, 32); scr[2 * k + 1] = acc2[k].y + __shfl_xor(acc2[k].y, 32); }
    lds_wave_fence();
    float ss = 0.f;
#pragma unroll
    for (int k = 0; k < 32; ++k) { const float v = scr[k]; ss += v * v; }
    ss = half_sum(ss);
    const float rstd = rsqrtf(ss * (1.0f / 1024.0f) + 1e-6f);
#pragma unroll
    for (int k4 = 0; k4 < 4; ++k4) {
      const int kk = hf * 16 + k4 * 4, col = sl * 32 + kk;
      f32x4 x1 = *(const f32x4*)(p.out + (size_t)m * DM + col);
      const f32x4 g = *(const f32x4*)(p.g_post_ffn + col), gt = *(const f32x4*)(md + 5120 + col);
#pragma unroll
      for (int e = 0; e < 4; ++e) x1[e] += gt[e] * scr[kk + e] * rstd * g[e];
      *(f32x4*)(p.out + (size_t)m * DM + col) = x1;
    }
    lds_wave_fence();
  }
}

#define XB_TMO      128
#define XB_XCNT(j)  (256  + 64 * (j))
#define XB_XSUB(j)  (1280 + 64 * (j))
#define XB_XGEN(j)  (2304 + 64 * (j))
#define XB_TOP      3328
#define XB_TOPGEN   3392
#define XCD_BAR_WORDS 3456
#define XB_SPIN_CAP (1u << 20)
#define LAS __attribute__((address_space(3)))
__device__ __forceinline__ unsigned xb_ld(unsigned* p)              { return __hip_atomic_load(p, __ATOMIC_RELAXED, __HIP_MEMORY_SCOPE_AGENT); }
__device__ __forceinline__ unsigned xb_add(unsigned* p, unsigned v) { return __hip_atomic_fetch_add(p, v, __ATOMIC_RELAXED, __HIP_MEMORY_SCOPE_AGENT); }
__device__ __forceinline__ unsigned xb_xcc_id() { return (unsigned)__builtin_amdgcn_s_getreg((3 << 11) | 20) & 0xFu; }
#define XB_SPIN(cond, bar) do { unsigned _sp = 0; while (cond) { __builtin_amdgcn_s_sleep(1); \
    if ((++_sp & 255u) == 0u) { if (xb_ld(&(bar)[XB_TMO])) break; if (_sp > XB_SPIN_CAP) { atomicAdd(&(bar)[XB_TMO], 1u); break; } } } } while (0)
struct XcdBarrier { unsigned* bar; unsigned x; volatile LAS unsigned* st; };
__device__ __forceinline__ XcdBarrier xcd_barrier_post(unsigned* bar, volatile LAS unsigned* st) {
  XcdBarrier b; b.bar = bar; b.x = xb_xcc_id(); b.st = st;
  if (TIDX == 0) (void)xb_add(&bar[XB_XCNT(b.x)], 1u);
  return b;
}
__device__ __forceinline__ void xcd_barrier_complete(unsigned* bar, unsigned x, unsigned& nloc, unsigned& nx) {
  const unsigned G = gridDim.x * gridDim.y * gridDim.z;
  unsigned sum, cnt, mine, sp = 0u;
  for (;;) {
    sum = 0u; cnt = 0u; mine = 0u;
#pragma unroll
    for (unsigned j = 0; j < 16; ++j) { const unsigned c = xb_ld(&bar[XB_XCNT(j)]); sum += c; cnt += (c > 0u) ? 1u : 0u; mine = (j == x) ? c : mine; }
    if (sum == G) break;
    __builtin_amdgcn_s_sleep(1);
    if ((++sp & 255u) == 0u) { if (xb_ld(&bar[XB_TMO])) break; if (sp > XB_SPIN_CAP) { atomicAdd(&bar[XB_TMO], 1u); break; } }
  }
  nloc = mine > 0u ? mine : 1u; nx = cnt > 0u ? cnt : 1u;
}
__device__ __forceinline__ void xcd_barrier(const XcdBarrier& b) {
  asm volatile("s_waitcnt vmcnt(0)" ::: "memory");
  __syncthreads();
  if (TIDX == 0) {
    unsigned* bar = b.bar;
    __builtin_amdgcn_s_waitcnt(0);
    unsigned nloc = b.st[0], nx = b.st[1];
    if (nloc == 0u) { xcd_barrier_complete(bar, b.x, nloc, nx); b.st[0] = nloc; b.st[1] = nx; }
    const unsigned old = xb_add(&bar[XB_XSUB(b.x)], 1u);
    const unsigned gen = old / nloc;
    if (old + 1u == (gen + 1u) * nloc) {
      __builtin_amdgcn_fence(__ATOMIC_RELEASE, "agent");
      asm volatile("s_waitcnt vmcnt(0)" ::: "memory");
      const unsigned og = xb_add(&bar[XB_TOP], 1u);
      const unsigned tg = og / nx;
      if (og + 1u == (tg + 1u) * nx) xb_add(&bar[XB_TOPGEN], 1u);
      else XB_SPIN(xb_ld(&bar[XB_TOPGEN]) == tg, bar);
      __builtin_amdgcn_fence(__ATOMIC_ACQUIRE, "agent");
      xb_add(&bar[XB_XGEN(b.x)], 1u);
      asm volatile("s_waitcnt vmcnt(0)" ::: "memory");
    } else {
      XB_SPIN(xb_ld(&bar[XB_XGEN(b.x)]) == gen, bar);
      __builtin_amdgcn_fence(__ATOMIC_ACQUIRE, "agent");
      asm volatile("s_waitcnt vmcnt(0)" ::: "memory");
    }
  }
  __syncthreads();
}

#define SMEM_BYTES RWKV_SMEM
__global__ void __launch_bounds__(256, 2) mega(P p) {
  __shared__ __attribute__((aligned(16))) unsigned char smem[SMEM_BYTES + 16];
  cg::grid_group grid = cg::this_grid();
  const int vb = blockIdx.x, nvb = gridDim.x;
  if (TIDX == 0) *(u32x4*)(smem + SMEM_BYTES) = (u32x4){0u, 0u, 0u, 0u};
  __syncthreads();
  const XcdBarrier xb = xcd_barrier_post(p.bar, (volatile LAS unsigned*)(smem + SMEM_BYTES));
  ph_mod(p, vb, nvb, smem);
  ph_colmax(p.w_in, p.colmax, DM, INC, vb, nvb, smem);
  ph_transpose(p.w2, p.w2T, 64, 1024, vb, nvb, smem);
  ph_transpose(p.w2 + 65536, p.w2T + 65536, 64, 1024, vb, nvb, smem);
  ph_transpose(p.a2, p.a2T, 64, 1024, vb, nvb, smem);
  ph_transpose(p.a2 + 65536, p.a2T + 65536, 64, 1024, vb, nvb, smem);
  if (p.bar == nullptr) grid.sync();
  xcd_barrier(xb);
  ph_norm1(p, vb, nvb);
  ph_transpose_i8(p.w_in, p.Wt8, p.colmax, p.wsb, DM, INC, vb, nvb, smem);
  xcd_barrier(xb);
  ph_gemm1(p, vb, nvb, smem);
  xcd_barrier(xb);
  ph_rwkv_A(p, vb, nvb, smem);
  xcd_barrier(xb);
  ph_rwkv_B(p, vb, nvb, smem);
  if (nvb > 128 && vb >= 64) {
    const int v2 = vb - 64, n2 = nvb - 64;
    ph_transpose(p.w_a_out, p.Wt_aout, DM, DM, v2, n2, smem);
    ph_transpose(p.w_o, p.Wt_o, DM, DM, v2, n2, smem);
    ph_transpose(p.peer_wq, p.Wt_q, DM, 2048, v2, n2, smem);
    ph_transpose(p.g2, p.g2T, 128, 1024, v2, n2, smem);
    ph_weff(p, v2, n2);
    ph_convert(p.peer_keys, p.keys, (size_t)16 * 128 * 128, v2, n2);
  } else if (nvb <= 128) {
    ph_transpose(p.w_a_out, p.Wt_aout, DM, DM, vb, nvb, smem);
    ph_transpose(p.w_o, p.Wt_o, DM, DM, vb, nvb, smem);
    ph_transpose(p.peer_wq, p.Wt_q, DM, 2048, vb, nvb, smem);
    ph_transpose(p.g2, p.g2T, 128, 1024, vb, nvb, smem);
    ph_weff(p, vb, nvb);
    ph_convert(p.peer_keys, p.keys, (size_t)16 * 128 * 128, vb, nvb);
  }
  xcd_barrier(xb);
  ph_ycorr(p, vb, nvb);
  ph_sg(p, vb, nvb);
  xcd_barrier(xb);
  ph_readout_gemm(p, vb, nvb, smem);
  ph_pool(p, vb, nvb, smem);
  ph_cvt_fp6(p.peer_u, p.ub8, p.us, vb, nvb);
  ph_cvt_fp4(p.peer_v, p.vb8, p.vs, vb, nvb);
  xcd_barrier(xb);
  ph_gemm_merge(p, vb, nvb, smem);
  xcd_barrier(xb);
  ph_gemm_simple(p.mrg, DM, p.Wt_o, DM, DM, NTOK, DM, p.mix, DM, vb, nvb, smem);
  xcd_barrier(xb);
  ph_res1(p, vb, nvb);
  xcd_barrier(xb);
  ph_gemm_simple(p.hx2, DM, p.Wt_q, DM, DM, NTOK, 2048, p.q, 2048, vb, nvb, smem);
  xcd_barrier(xb);
  ph_peer_s1(p, vb, nvb, smem);
  xcd_barrier(xb);
  ph_peer_s2(p, vb, nvb, smem);
  xcd_barrier(xb);
  ph_peer_gather(p, vb, nvb, smem);
}

extern "C" void kernel_launch(void* const* d_in, const int* in_sizes, int n_in, void* d_out, int out_size, void* d_ws, size_t ws_size, hipStream_t stream) {
  P p{};
  const float** f = (const float**)&p;
  for (int i = 0; i < 32; ++i) f[i] = (const float*)d_in[i];
  p.out = (float*)d_out;
  p.bar = (unsigned*)((unsigned char*)d_ws + 511 * 1048576);
  unsigned char* w = (unsigned char*)d_ws;
  const size_t MiB = 1048576;
  const size_t HM = 524288;
  p.hx = (bf16_t*)(w + 4096);
  p.hx8 = (signed char*)(w + 4096);
  p.hsa = (float*)(w + 40 * MiB) + 4;
  p.colmax = p.bar + XCD_BAR_WORDS;
  p.zA = (bf16_t*)(w + 65 * MiB + 8192);
  p.zP = (bf16_t*)(w + 569 * HM);
  p.zG = (bf16_t*)d_out;
  unsigned char* rw = w + 633 * HM;
  p.Wt_in = (bf16_t*)rw; p.Wt8 = (signed char*)rw; rw += 11 * MiB; p.wsb = (float*)rw; rw += 1 * MiB;
  p.Wt_aout = (bf16_t*)rw; rw += 2 * MiB;
  p.Wt_eff = (bf16_t*)rw; rw += 1 * MiB;
  p.Wt_o = (bf16_t*)rw; rw += 2 * MiB;
  p.Wt_q = (bf16_t*)rw; rw += 4 * MiB;
  p.keys = (bf16_t*)rw; rw += HM;
  p.mod = (float*)rw; rw += HM;
  p.g2T = (bf16_t*)rw; rw += HM;
  p.w2T = (bf16_t*)rw; rw += HM;
  p.a2T = (bf16_t*)rw; rw += HM;
  p.Y0 = (bf16_t*)(w + 0 * MiB);
  p.Y1 = (bf16_t*)(w + 340 * MiB);
  p.bdot = (float*)(w + 404 * MiB);
  p.Mst = (bf16_t*)(w + 408 * MiB);
  p.sg = (bf16_t*)(w + 408 * MiB);
  p.Nst = (float*)(w + 441 * MiB);
  p.ub8 = w + 416 * MiB;
  p.vb8 = w + 432 * MiB;
  p.us = (float*)(w + 448 * MiB);
  p.vs = (float*)(w + 449 * MiB);
  p.pooled = (bf16_t*)(w + 478 * MiB);
  p.out_a = (bf16_t*)(w + 0 * MiB);
  p.ya = (bf16_t*)(w + 65 * MiB);
  p.yb = (bf16_t*)(w + 129 * MiB);
  p.mrg = (bf16_t*)(w + 193 * MiB);
  p.mix = (bf16_t*)(w + 65 * MiB);
  p.hx2 = (bf16_t*)(w + 0 * MiB);
  p.q = (bf16_t*)(w + 129 * MiB);
  p.sv = (float*)(w + 340 * MiB);
  p.si = (int*)(w + 372 * MiB);
  p.pidx = (int*)(w + 257 * MiB);
  p.pgate = (float*)(w + 273 * MiB);
  static int grid_blocks = 0;
  if (!grid_blocks) {
    int dev = 0, cus = 0, per_cu = 0;
    hipGetDevice(&dev);
    hipDeviceGetAttribute(&cus, hipDeviceAttributeMultiprocessorCount, dev);
    hipOccupancyMaxActiveBlocksPerMultiprocessor(&per_cu, mega, 256, 0);
    if (per_cu > 2) per_cu = 2;
    if (per_cu < 1) per_cu = 1;
    grid_blocks = cus * per_cu;
  }
  hipMemsetAsync(p.bar, 0, (XCD_BAR_WORDS + 6016) * 4, stream);
  void* args[] = {&p};
  hipError_t e = hipLaunchCooperativeKernel((void*)mega, dim3(grid_blocks), dim3(256), args, 0, stream);
  if (e != hipSuccess) fprintf(stderr, "cooperative launch failed: %s (grid %d)\n", hipGetErrorString(e), grid_blocks);
}
```

```cpp
#include <hip/hip_runtime.h>
#include <hip/hip_cooperative_groups.h>
#include <stdint.h>
#include <cstdio>
namespace cg = cooperative_groups;

typedef unsigned short bf16_t;
typedef short bf16x8 __attribute__((ext_vector_type(8)));
typedef float f32x4 __attribute__((ext_vector_type(4)));
typedef unsigned u32x4 __attribute__((ext_vector_type(4)));
typedef unsigned u32x2 __attribute__((ext_vector_type(2)));
typedef float f32x2 __attribute__((ext_vector_type(2)));

__device__ __forceinline__ int tid_opaque() { int t = threadIdx.x; asm volatile("" : "+v"(t)); return t; }
#define TIDX tid_opaque()
#define NTOK 32768
#define SEQ 16384
#define CTXL 256
#define NCTX 512
#define MROWS 33280
#define DM 1024
#define SHIFTC 3456
#define INC 6016

typedef __bf16 hwbf2 __attribute__((ext_vector_type(2)));
typedef float hwf2 __attribute__((ext_vector_type(2)));
__device__ __forceinline__ unsigned pack2(float a, float b) { return __builtin_bit_cast(unsigned, __builtin_convertvector((hwf2){a, b}, hwbf2)); }
__device__ __forceinline__ bf16_t f2bf(float f) { return __builtin_bit_cast(unsigned short, (__bf16)f); }
__device__ __forceinline__ float bf2f(bf16_t h) { return __uint_as_float(((unsigned)h) << 16); }
__device__ __forceinline__ float bflo(unsigned u) { return __uint_as_float(u << 16); }
__device__ __forceinline__ float bfhi(unsigned u) { return __uint_as_float(u & 0xffff0000u); }
__device__ __forceinline__ float sigmoidf_(float x) { return __builtin_amdgcn_rcpf(1.0f + __expf(-x)); }

__device__ __forceinline__ void load8(const bf16_t* __restrict__ zA, int row, int col0, float* o) {
  const u32x4 zc = *(const u32x4*)(zA + (size_t)row * SHIFTC + col0);
#pragma unroll
  for (int i = 0; i < 4; ++i) { o[2 * i] = bflo(zc[i]); o[2 * i + 1] = bfhi(zc[i]); }
}
__device__ __forceinline__ float red16(float v) {
  v += __shfl_xor(v, 1); v += __shfl_xor(v, 2); v += __shfl_xor(v, 4); v += __shfl_xor(v, 8);
  return v;
}
__device__ __forceinline__ float red8(float v) {
  v += __shfl_xor(v, 1); v += __shfl_xor(v, 2); v += __shfl_xor(v, 4);
  return v;
}

struct P {
  const float *x, *c, *ctx, *c_ctx, *w_mod, *b_mod, *g_pre_mix, *g_post_mix, *g_pre_ffn, *g_post_ffn, *w_in, *b_gate, *mu_shift,
      *w0, *w2, *a0, *a2, *g2, *k_k, *k_a, *r_k, *ln_x_w, *ln_x_b, *w_a_out, *w_pool, *pool_scale, *w_b_out, *w_o, *peer_wq,
      *peer_keys, *peer_u, *peer_v;
  float* out;
  unsigned* bar;
  bf16_t* hx;
  signed char* hx8;
  float* hsa;
  signed char* Wt8;
  float* wsb;
  unsigned* colmax;
  bf16_t* zA;
  bf16_t* zP;
  bf16_t* zG;
  bf16_t* Wt_in;
  bf16_t* Wt_aout;
  bf16_t* Wt_eff;
  bf16_t* Wt_o;
  bf16_t* Wt_q;
  bf16_t* keys;
  float* mod;
  unsigned char* ub8;
  unsigned char* vb8;
  float* us;
  float* vs;
  bf16_t* sg;
  bf16_t* g2T;
  bf16_t* w2T;
  bf16_t* a2T;
  bf16_t* Mst;
  float* Nst;
  bf16_t* Y0;
  bf16_t* Y1;
  float* bdot;
  bf16_t* out_a;
  bf16_t* ya;
  bf16_t* pooled;
  bf16_t* yb;
  bf16_t* mrg;
  bf16_t* mix;
  bf16_t* hx2;
  bf16_t* q;
  float* sv;
  int* si;
  int* pidx;
  float* pgate;
};

#define GS 72
#define GEMM_SMEM (2 * 128 * GS * 2)
template <class Epi>
__device__ __forceinline__ void gemm_tile(const bf16_t* __restrict__ A, int lda, const bf16_t* __restrict__ Bt, int ldb, int K, int m0, int n0,
                                          const Epi& epi, unsigned char* smem) {
  const int tid = TIDX, lane = tid & 63, wid = tid >> 6, wr = wid >> 1, wc = wid & 1;
  bf16_t* sA = (bf16_t*)smem;
  bf16_t* sB = sA + 128 * GS;
  f32x4 acc[4][4];
#pragma unroll
  for (int i = 0; i < 4; ++i)
#pragma unroll
    for (int j = 0; j < 4; ++j) acc[i][j] = (f32x4){0.f, 0.f, 0.f, 0.f};
  const int lrow = tid >> 3, lcol = (tid & 7) * 8;
  const bf16_t* pa = A + (size_t)(m0 + lrow) * lda + lcol;
  const bf16_t* pb = Bt + (size_t)(n0 + lrow) * ldb + lcol;
  u32x4 ra[4], rb[4];
#pragma unroll
  for (int p = 0; p < 4; ++p) {
    ra[p] = *(const u32x4*)(pa + (size_t)(32 * p) * lda);
    rb[p] = *(const u32x4*)(pb + (size_t)(32 * p) * ldb);
  }
  for (int k0 = 0; k0 < K; k0 += 64) {
#pragma unroll
    for (int p = 0; p < 4; ++p) {
      *(u32x4*)(sA + (lrow + 32 * p) * GS + lcol) = ra[p];
      *(u32x4*)(sB + (lrow + 32 * p) * GS + lcol) = rb[p];
    }
    __syncthreads();
    if (k0 + 64 < K) {
#pragma unroll
      for (int p = 0; p < 4; ++p) {
        ra[p] = *(const u32x4*)(pa + (size_t)(32 * p) * lda + k0 + 64);
        rb[p] = *(const u32x4*)(pb + (size_t)(32 * p) * ldb + k0 + 64);
      }
    }
#pragma unroll
    for (int kk = 0; kk < 2; ++kk) {
      bf16x8 af[4], bfr[4];
#pragma unroll
      for (int i = 0; i < 4; ++i) af[i] = *(const bf16x8*)(sA + (wr * 64 + i * 16 + (lane & 15)) * GS + kk * 32 + (lane >> 4) * 8);
#pragma unroll
      for (int j = 0; j < 4; ++j) bfr[j] = *(const bf16x8*)(sB + (wc * 64 + j * 16 + (lane & 15)) * GS + kk * 32 + (lane >> 4) * 8);
#pragma unroll
      for (int i = 0; i < 4; ++i)
#pragma unroll
        for (int j = 0; j < 4; ++j) acc[i][j] = __builtin_amdgcn_mfma_f32_16x16x32_bf16(bfr[j], af[i], acc[i][j], 0, 0, 0);
    }
    __syncthreads();
  }
#pragma unroll
  for (int i = 0; i < 4; ++i)
#pragma unroll
    for (int j = 0; j < 4; ++j) epi(m0 + wr * 64 + i * 16 + (lane & 15), n0 + wc * 64 + j * 16 + (lane >> 4) * 4, acc[i][j]);
}

#define G3_STAGE 24576
#define G3_ES 136
#define GEMM3_SMEM (256 * G3_ES * 2)
typedef __attribute__((address_space(3))) unsigned lds_u32;
template <class Epi>
__device__ __forceinline__ void gemm_tile3(const bf16_t* __restrict__ A, int lda, const bf16_t* __restrict__ Bt, int ldb, int K, int m0, int n0,
                                           const Epi& epi, unsigned char* smem) {
  int tid = TIDX;
  asm volatile("" : "+v"(tid));
  const int lane = tid & 63, wid = __builtin_amdgcn_readfirstlane(tid >> 6), wr = wid >> 1, wc = wid & 1, l15 = lane & 15, q = lane >> 4;
  f32x4 acc[8][4];
#pragma unroll
  for (int i = 0; i < 8; ++i)
#pragma unroll
    for (int j = 0; j < 4; ++j) acc[i][j] = (f32x4){0.f, 0.f, 0.f, 0.f};
  const int gr = lane >> 2, gc = ((lane & 3) ^ (((gr >> 2) & 1) << 1)) * 8;
  const bf16_t* pa = A + (long)(m0 + wid * 64 + gr) * lda + gc;
  const bf16_t* pb = Bt + (size_t)(n0 + wid * 32 + gr) * ldb + gc;
  unsigned char* dA = smem + wid * 4096 + lane * 16;
  unsigned char* dB = smem + 16384 + wid * 2048 + lane * 16;
  const int sw = (q ^ (((l15 >> 2) & 1) << 1)) * 16;
  const unsigned char* fA = smem + (wr * 128 + l15) * 64 + sw;
  const unsigned char* fB = smem + 16384 + (wc * 64 + l15) * 64 + sw;
#define G3_ISSUE(ST, KT) { _Pragma("unroll") for (int ii = 0; ii < 4; ++ii) __builtin_amdgcn_global_load_lds((const unsigned*)(pa + (size_t)(16 * ii) * lda + (KT) * 32), (lds_u32*)(dA + (ST) * G3_STAGE + ii * 1024), 16, 0, 0); \
                           _Pragma("unroll") for (int ii = 0; ii < 2; ++ii) __builtin_amdgcn_global_load_lds((const unsigned*)(pb + (size_t)(16 * ii) * ldb + (KT) * 32), (lds_u32*)(dB + (ST) * G3_STAGE + ii * 1024), 16, 0, 0); }
  const int nk = K >> 5;
  __syncthreads();
  G3_ISSUE(0, 0);
  for (int kt = 0; kt < nk; ++kt) {
    const int cur = kt & 1;
    asm volatile("s_waitcnt vmcnt(0)" ::: "memory");
    __syncthreads();
    if (kt + 1 < nk) G3_ISSUE(cur ^ 1, kt + 1);
    const unsigned char* cA = fA + cur * G3_STAGE;
    const unsigned char* cB = fB + cur * G3_STAGE;
    bf16x8 bfr[4];
#pragma unroll
    for (int j = 0; j < 4; ++j) bfr[j] = *(const bf16x8*)(cB + j * 1024);
#pragma unroll
    for (int i = 0; i < 8; ++i) {
      const bf16x8 af = *(const bf16x8*)(cA + i * 1024);
#pragma unroll
      for (int j = 0; j < 4; ++j) acc[i][j] = __builtin_amdgcn_mfma_f32_16x16x32_bf16(bfr[j], af, acc[i][j], 0, 0, 0);
    }
  }
#undef G3_ISSUE
  bf16_t* sE = (bf16_t*)smem;
  __syncthreads();
#pragma unroll
  for (int i = 0; i < 8; ++i)
#pragma unroll
    for (int j = 0; j < 4; ++j) {
      u32x2 w; w.x = pack2(acc[i][j][0], acc[i][j][1]); w.y = pack2(acc[i][j][2], acc[i][j][3]);
      *(u32x2*)(sE + (wr * 128 + i * 16 + l15) * G3_ES + wc * 64 + j * 16 + q * 4) = w;
    }
  __syncthreads();
  epi.finish(sE, m0, n0, tid);
}
typedef int i32x4v __attribute__((ext_vector_type(4)));
template <class Epi>
__device__ __forceinline__ void gemm_tile3_i8(const signed char* __restrict__ A, int lda, const signed char* __restrict__ Bt, int ldb, int K, int m0, int n0,
                                              const float* __restrict__ sa, const float* __restrict__ sb, const Epi& epi, unsigned char* smem) {
  int tid = TIDX;
  asm volatile("" : "+v"(tid));
  const int lane = tid & 63, wid = __builtin_amdgcn_readfirstlane(tid >> 6), wr = wid >> 1, wc = wid & 1, l15 = lane & 15, q = lane >> 4;
  i32x4v acc[8][4];
#pragma unroll
  for (int i = 0; i < 8; ++i)
#pragma unroll
    for (int j = 0; j < 4; ++j) acc[i][j] = (i32x4v){0, 0, 0, 0};
  const int gr = lane >> 2, gc = ((lane & 3) ^ (((gr >> 2) & 1) << 1)) * 16;
  const signed char* pa = A + (long)(m0 + wid * 64 + gr) * lda + gc;
  const signed char* pb = Bt + (size_t)(n0 + wid * 32 + gr) * ldb + gc;
  unsigned char* dA = smem + wid * 4096 + lane * 16;
  unsigned char* dB = smem + 16384 + wid * 2048 + lane * 16;
  const int sw = (q ^ (((l15 >> 2) & 1) << 1)) * 16;
  const unsigned char* fA = smem + (wr * 128 + l15) * 64 + sw;
  const unsigned char* fB = smem + 16384 + (wc * 64 + l15) * 64 + sw;
#define G3_ISSUE(ST, KT) { _Pragma("unroll") for (int ii = 0; ii < 4; ++ii) __builtin_amdgcn_global_load_lds((const unsigned*)(pa + (size_t)(16 * ii) * lda + (KT) * 64), (lds_u32*)(dA + (ST) * G3_STAGE + ii * 1024), 16, 0, 0); \
                           _Pragma("unroll") for (int ii = 0; ii < 2; ++ii) __builtin_amdgcn_global_load_lds((const unsigned*)(pb + (size_t)(16 * ii) * ldb + (KT) * 64), (lds_u32*)(dB + (ST) * G3_STAGE + ii * 1024), 16, 0, 0); }
  const int nk = K >> 6;
  __syncthreads();
  G3_ISSUE(0, 0);
  for (int kt = 0; kt < nk; ++kt) {
    const int cur = kt & 1;
    asm volatile("s_waitcnt vmcnt(0)" ::: "memory");
    __syncthreads();
    if (kt + 1 < nk) G3_ISSUE(cur ^ 1, kt + 1);
    const unsigned char* cA = fA + cur * G3_STAGE;
    const unsigned char* cB = fB + cur * G3_STAGE;
    i32x4v bfr[4];
#pragma unroll
    for (int j = 0; j < 4; ++j) bfr[j] = *(const i32x4v*)(cB + j * 1024);
#pragma unroll
    for (int i = 0; i < 8; ++i) {
      const i32x4v af = *(const i32x4v*)(cA + i * 1024);
#pragma unroll
      for (int j = 0; j < 4; ++j) acc[i][j] = __builtin_amdgcn_mfma_i32_16x16x64_i8(bfr[j], af, acc[i][j], 0, 0, 0);
    }
  }
#undef G3_ISSUE
  bf16_t* sE = (bf16_t*)smem;
  f32x4 sb4[4];
#pragma unroll
  for (int j = 0; j < 4; ++j) sb4[j] = *(const f32x4*)(sb + n0 + wc * 64 + j * 16 + q * 4);
  __syncthreads();
#pragma unroll
  for (int i = 0; i < 8; ++i) {
    const float sr = sa[m0 + wr * 128 + i * 16 + l15];
#pragma unroll
    for (int j = 0; j < 4; ++j) {
      u32x2 w;
      w.x = pack2((float)acc[i][j][0] * (sr * sb4[j][0]), (float)acc[i][j][1] * (sr * sb4[j][1]));
      w.y = pack2((float)acc[i][j][2] * (sr * sb4[j][2]), (float)acc[i][j][3] * (sr * sb4[j][3]));
      *(u32x2*)(sE + (wr * 128 + i * 16 + l15) * G3_ES + wc * 64 + j * 16 + q * 4) = w;
    }
  }
  __syncthreads();
  epi.finish(sE, m0, n0, tid);
}
template <class D> struct Epi3RowChunks {
  __device__ __forceinline__ void finish(const bf16_t* sE, int m0, int n0, int tid) const {
#pragma unroll
    for (int pp = 0; pp < 16; ++pp) {
      const int id = tid + 256 * pp, row = id >> 4, cc = (id & 15) * 8;
      static_cast<const D*>(this)->store(m0 + row, n0 + cc, *(const u32x4*)(sE + row * G3_ES + cc));
    }
  }
};
struct Epi3StoreBf16 : Epi3RowChunks<Epi3StoreBf16> {
  bf16_t* C; int ldc;
  __device__ Epi3StoreBf16(bf16_t* c, int l) : C(c), ldc(l) {}
  __device__ __forceinline__ void store(int m, int n, const u32x4& v) const { *(u32x4*)(C + (size_t)m * ldc + n) = v; }
};
struct Epi3GateA : Epi3RowChunks<Epi3GateA> {
  const bf16_t* zG; const float* bg; bf16_t* mrg;
  __device__ Epi3GateA(const bf16_t* z, const float* b, bf16_t* m) : zG(z), bg(b), mrg(m) {}
  __device__ __forceinline__ void store(int m, int n, const u32x4& v) const {
    const u32x4 g = *(const u32x4*)(zG + (size_t)m * 2048 + n);
    const f32x4 b0 = *(const f32x4*)(bg + n), b1 = *(const f32x4*)(bg + n + 4);
    u32x4 o;
#pragma unroll
    for (int i = 0; i < 4; ++i) {
      const float bl = i < 2 ? b0[2 * i] : b1[2 * i - 4], bh = i < 2 ? b0[2 * i + 1] : b1[2 * i - 3];
      o[i] = pack2(sigmoidf_(bflo(g[i]) + bl) * bflo(v[i]), sigmoidf_(bfhi(g[i]) + bh) * bfhi(v[i]));
    }
    *(u32x4*)(mrg + (size_t)m * DM + n) = o;
  }
};
struct Epi3GateB : Epi3RowChunks<Epi3GateB> {
  const bf16_t* zG; const float* bg; bf16_t* mrg;
  __device__ Epi3GateB(const bf16_t* z, const float* b, bf16_t* m) : zG(z), bg(b), mrg(m) {}
  __device__ __forceinline__ void store(int m, int n, const u32x4& v) const {
    const u32x4 g = *(const u32x4*)(zG + (size_t)m * 2048 + 1024 + n);
    const u32x4 a = *(const u32x4*)(mrg + (size_t)m * DM + n);
    const f32x4 b0 = *(const f32x4*)(bg + 1024 + n), b1 = *(const f32x4*)(bg + 1024 + n + 4);
    u32x4 o;
#pragma unroll
    for (int i = 0; i < 4; ++i) {
      const float bl = i < 2 ? b0[2 * i] : b1[2 * i - 4], bh = i < 2 ? b0[2 * i + 1] : b1[2 * i - 3];
      o[i] = pack2(bflo(a[i]) + sigmoidf_(bflo(g[i]) + bl) * bflo(v[i]), bfhi(a[i]) + sigmoidf_(bfhi(g[i]) + bh) * bfhi(v[i]));
    }
    *(u32x4*)(mrg + (size_t)m * DM + n) = o;
  }
};
struct Epi3ZS {
  bf16_t* zA; const float* mu; int own_lo, own_hi, t0, T;
  __device__ __forceinline__ void finish(const bf16_t* sE, int m0, int n0, int tid) const {
#pragma unroll 4
    for (int pq = 0; pq < 16; ++pq) {
      const int id = tid + 256 * pq, row = id >> 4, cc = (id & 15) * 8, t = t0 + row;
      if (row < own_lo || row > own_hi) continue;
      const u32x4 zc = *(const u32x4*)(sE + row * G3_ES + cc);
      u32x4 zp = (u32x4){0u, 0u, 0u, 0u}, zn = (u32x4){0u, 0u, 0u, 0u};
      if (t > 0) zp = *(const u32x4*)(sE + (row - 1) * G3_ES + cc);
      if (t < T - 1) zn = *(const u32x4*)(sE + (row + 1) * G3_ES + cc);
      const f32x4 m0v = *(const f32x4*)(mu + n0 + cc), m1v = *(const f32x4*)(mu + n0 + cc + 4);
      const float mm[8] = {m0v[0], m0v[1], m0v[2], m0v[3], m1v[0], m1v[1], m1v[2], m1v[3]};
      u32x4 o;
#pragma unroll
      for (int i = 0; i < 4; ++i) {
        const float z0 = bflo(zc[i]), z1 = bfhi(zc[i]);
        o[i] = pack2(z0 + mm[2 * i] * (0.5f * (bflo(zp[i]) + bflo(zn[i])) - z0), z1 + mm[2 * i + 1] * (0.5f * (bfhi(zp[i]) + bfhi(zn[i])) - z1));
      }
      *(u32x4*)(zA + (long)(m0 + row) * SHIFTC + n0 + cc) = o;
    }
  }
};
struct Epi3Z : Epi3RowChunks<Epi3Z> {
  bf16_t *zA, *zP, *zG;
  __device__ Epi3Z(bf16_t* a, bf16_t* b, bf16_t* c) : zA(a), zP(b), zG(c) {}
  __device__ __forceinline__ void store(int m, int n, const u32x4& v) const {
    if (n < SHIFTC) *(u32x4*)(zA + (size_t)m * SHIFTC + n) = v;
    else if (m < NTOK) {
      if (n < SHIFTC + 512) *(u32x4*)(zP + (size_t)m * 512 + (n - SHIFTC)) = v;
      else *(u32x4*)(zG + (size_t)m * 2048 + (n - SHIFTC - 512)) = v;
    }
  }
};

struct EpiLds {
  float* S;
  __device__ __forceinline__ void operator()(int m, int n, const f32x4& v) const {
    float* r = S + (m & 127) * 133 + n + (n >> 5);
    r[0] = v[0]; r[1] = v[1]; r[2] = v[2]; r[3] = v[3];
  }
};

__device__ __forceinline__ void ph_transpose(const float* __restrict__ in, bf16_t* __restrict__ out, int K, int N, int vb, int nvb, unsigned char* smem) {
  float* t = (float*)smem;
  const int tk = K / 64, tn = N / 64, tid = TIDX, tx = tid & 15, ty = tid >> 4;
  for (int it = vb; it < tk * tn; it += nvb) {
    const int k0 = (it / tn) * 64, n0 = (it % tn) * 64;
    __syncthreads();
#pragma unroll
    for (int r = 0; r < 4; ++r) {
      const f32x4 v = *(const f32x4*)(in + (size_t)(k0 + ty + 16 * r) * N + n0 + 4 * tx);
#pragma unroll
      for (int e = 0; e < 4; ++e) t[(ty + 16 * r) * 65 + 4 * tx + e] = v[e];
    }
    __syncthreads();
    const int n = tid >> 2, kq = (tid & 3) * 16;
    u32x4 w0, w1;
#pragma unroll
    for (int e = 0; e < 4; ++e) {
      w0[e] = pack2(t[(kq + 2 * e) * 65 + n], t[(kq + 2 * e + 1) * 65 + n]);
      w1[e] = pack2(t[(kq + 8 + 2 * e) * 65 + n], t[(kq + 8 + 2 * e + 1) * 65 + n]);
    }
    *(u32x4*)(out + (size_t)(n0 + n) * K + k0 + kq) = w0;
    *(u32x4*)(out + (size_t)(n0 + n) * K + k0 + kq + 8) = w1;
  }
}
__device__ __forceinline__ void ph_colmax(const float* __restrict__ in, unsigned* __restrict__ colmax, int K, int N, int vb, int nvb, unsigned char* smem) {
  float* red = (float*)smem;
  const int tk = K / 64, tn = N / 64, tid = TIDX, n = tid & 63, kq = tid >> 6;
  for (int it = vb; it < tk * tn; it += nvb) {
    const int k0 = (it / tn) * 64 + kq * 16, n0 = (it % tn) * 64;
    float mx = 0.f;
#pragma unroll
    for (int r = 0; r < 16; ++r) mx = fmaxf(mx, fabsf(in[(size_t)(k0 + r) * N + n0 + n]));
    __syncthreads();
    red[kq * 64 + n] = mx;
    __syncthreads();
    if (kq == 0) atomicMax(colmax + n0 + n, __float_as_uint(fmaxf(fmaxf(red[n], red[64 + n]), fmaxf(red[128 + n], red[192 + n]))));
  }
}
__device__ __forceinline__ void ph_transpose_i8(const float* __restrict__ in, signed char* __restrict__ out, const unsigned* __restrict__ colmax, float* __restrict__ sbv,
                                                int K, int N, int vb, int nvb, unsigned char* smem) {
  float* t = (float*)smem;
  const int tk = K / 64, tn = N / 64, tid = TIDX, tx = tid & 15, ty = tid >> 4;
  for (int it = vb; it < tk * tn; it += nvb) {
    const int k0 = (it / tn) * 64, n0 = (it % tn) * 64;
    __syncthreads();
#pragma unroll
    for (int r = 0; r < 4; ++r) {
      const f32x4 v = *(const f32x4*)(in + (size_t)(k0 + ty + 16 * r) * N + n0 + 4 * tx);
#pragma unroll
      for (int e = 0; e < 4; ++e) t[(ty + 16 * r) * 65 + 4 * tx + e] = v[e];
    }
    __syncthreads();
    const int n = tid >> 2, kq = (tid & 3) * 16;
    const float cmx = __uint_as_float(colmax[n0 + n]);
    const float sc = cmx > 0.f ? 127.0f / cmx : 0.f;
    if (k0 == 0 && kq == 0) sbv[n0 + n] = cmx > 0.f ? cmx / 127.0f : 1.0f;
    u32x4 w;
#pragma unroll
    for (int e = 0; e < 4; ++e) {
      unsigned pk = 0;
#pragma unroll
      for (int b = 0; b < 4; ++b) { const int qv = (int)rintf(t[(kq + 4 * e + b) * 65 + n] * sc); pk |= ((unsigned)qv & 255u) << (8 * b); }
      w[e] = pk;
    }
    *(u32x4*)(out + (size_t)(n0 + n) * K + k0 + kq) = w;
  }
}
__device__ __forceinline__ void ph_convert(const float* __restrict__ in, bf16_t* __restrict__ out, size_t n, int vb, int nvb) {
  for (size_t i = ((size_t)vb * 256 + TIDX) * 4; i < n; i += (size_t)nvb * 1024) {
    const float4 v = *(const float4*)(in + i);
    uint2 w; w.x = pack2(v.x, v.y); w.y = pack2(v.z, v.w);
    *(uint2*)(out + i) = w;
  }
}
__device__ __forceinline__ void ph_weff(const P& p, int vb, int nvb) {
  for (int it = vb * 256 + TIDX; it < 512 * 1024; it += nvb * 256) {
    const int n = it & 1023, k = it >> 10, j = k >> 7, kl = k & 127;
    const float* wp = p.w_pool + ((size_t)j * 128 + kl) * 128;
    float s = 0.f;
    for (int c = 0; c < 128; ++c) s += wp[c] * p.pool_scale[j * 128 + c] * p.w_b_out[(size_t)(j * 128 + c) * 1024 + n];
    p.Wt_eff[(size_t)n * 512 + k] = f2bf(s);
  }
}
__device__ __forceinline__ void ph_mod(const P& p, int vb, int nvb, unsigned char* smem) {
  float* red = (float*)smem;
  const int lane = TIDX & 63, wid = TIDX >> 6;
  for (int it = vb; it < 96; it += nvb) {
    const int n = it * 64 + lane;
    float a0 = 0.f, a1 = 0.f, a2 = 0.f;
#pragma unroll 8
    for (int k = wid * 256; k < wid * 256 + 256; ++k) {
      const float w = p.w_mod[(size_t)k * 6144 + n];
      const float c0 = p.c[k], c1 = p.c[1024 + k], c2 = p.c_ctx[k];
      a0 += c0 * sigmoidf_(c0) * w; a1 += c1 * sigmoidf_(c1) * w; a2 += c2 * sigmoidf_(c2) * w;
    }
    __syncthreads();
    red[(wid * 3 + 0) * 64 + lane] = a0; red[(wid * 3 + 1) * 64 + lane] = a1; red[(wid * 3 + 2) * 64 + lane] = a2;
    __syncthreads();
    if (wid < 3) {
      const float sum = red[(0 * 3 + wid) * 64 + lane] + red[(1 * 3 + wid) * 64 + lane] + red[(2 * 3 + wid) * 64 + lane] + red[(3 * 3 + wid) * 64 + lane];
      p.mod[wid * 6144 + n] = sum + p.b_mod[n];
    }
  }
}
__device__ __forceinline__ float wave_sum(float v) {
#pragma unroll
  for (int o = 32; o > 0; o >>= 1) v += __shfl_xor(v, o);
  return v;
}
__device__ __forceinline__ void ph_norm1(const P& p, int vb, int nvb) {
  const int lane = TIDX & 63, wid = TIDX >> 6, nw = nvb * 4;
  for (int m0 = vb * 4 + wid; m0 < MROWS; m0 += 2 * nw) {
    const int m1 = m0 + nw; const bool has1 = m1 < MROWS; const int mb = has1 ? m1 : m0;
    const float* srcA = m0 < NTOK ? p.x + (size_t)m0 * DM : p.ctx + (size_t)(m0 - NTOK) * DM;
    const float* srcB = mb < NTOK ? p.x + (size_t)mb * DM : p.ctx + (size_t)(mb - NTOK) * DM;
    f32x4 va[4], vbq[4]; float sa = 0.f, sb = 0.f;
#pragma unroll
    for (int i = 0; i < 4; ++i) { va[i] = *(const f32x4*)(srcA + i * 256 + lane * 4); vbq[i] = *(const f32x4*)(srcB + i * 256 + lane * 4); }
#pragma unroll
    for (int i = 0; i < 4; ++i)
#pragma unroll
      for (int e = 0; e < 4; ++e) { sa += va[i][e] * va[i][e]; sb += vbq[i][e] * vbq[i][e]; }
    sa = wave_sum(sa); sb = wave_sum(sb);
#pragma unroll
    for (int rr = 0; rr < 2; ++rr) {
      if (rr == 1 && !has1) break;
      const int m = rr == 0 ? m0 : m1;
      const float rstd = rsqrtf((rr == 0 ? sa : sb) * (1.0f / 1024.0f) + 1e-6f);
      const float* md = p.mod + (m < NTOK ? (m / SEQ) : 2) * 6144;
      f32x4 y[4]; float am = 0.f;
#pragma unroll
      for (int i = 0; i < 4; ++i) {
        const int col = i * 256 + lane * 4;
        const f32x4 v = rr == 0 ? va[i] : vbq[i];
        const f32x4 g = *(const f32x4*)(p.g_pre_mix + col), sh = *(const f32x4*)(md + col), sc = *(const f32x4*)(md + 1024 + col);
#pragma unroll
        for (int e = 0; e < 4; ++e) { y[i][e] = v[e] * rstd * g[e] * (1.f + sc[e]) + sh[e]; am = fmaxf(am, fabsf(y[i][e])); }
      }
#pragma unroll
      for (int o = 32; o > 0; o >>= 1) am = fmaxf(am, __shfl_xor(am, o));
      const float qs = am > 0.f ? 127.0f / am : 0.f;
      if (lane == 0) p.hsa[m] = am > 0.f ? am / 127.0f : 1.0f;
#pragma unroll
      for (int i = 0; i < 4; ++i) {
        unsigned pk = 0;
#pragma unroll
        for (int e = 0; e < 4; ++e) pk |= ((unsigned)(int)rintf(y[i][e] * qs) & 255u) << (8 * e);
        *(unsigned*)(p.hx8 + (size_t)m * DM + i * 256 + lane * 4) = pk;
      }
    }
  }
}
struct Epi3Readout {
  const P* pp;
  __device__ __forceinline__ void finish(const bf16_t* sE, int m0, int n0, int tid) const {
    const P& p = *pp;
#pragma unroll 2
    for (int pq = 0; pq < 16; ++pq) {
      const int id = tid + 256 * pq, row = id >> 4, cc = (id & 15) * 8, m = m0 + row, n = n0 + cc, t = m % SEQ, h = n >> 6;
      const u32x4 g = *(const u32x4*)(sE + row * G3_ES + cc);
      const u32x4 y0 = *(const u32x4*)(p.Y0 + (size_t)m * DM + n);
      float y[8], v[8];
#pragma unroll
      for (int i = 0; i < 4; ++i) { y[2 * i] = bflo(y0[i]); y[2 * i + 1] = bfhi(y0[i]); }
      float sm = 0.f;
#pragma unroll
      for (int i = 0; i < 8; ++i) sm += y[i];
      const float mu = red8(sm) * (1.f / 64.f);
      float qv = 0.f;
#pragma unroll
      for (int i = 0; i < 8; ++i) { y[i] -= mu; qv += y[i] * y[i]; }
      const float rs = rsqrtf(red8(qv) * (1.f / 64.f) + 64e-5f);
      load8(p.zA, m, 2048 + n, v);
      const float bon = 0.5f * (p.bdot[(size_t)m * 16 + h] + p.bdot[((size_t)NTOK + m) * 16 + h]);
      const f32x4 w0 = *(const f32x4*)(p.ln_x_w + n), w1 = *(const f32x4*)(p.ln_x_w + n + 4), b0 = *(const f32x4*)(p.ln_x_b + n), b1 = *(const f32x4*)(p.ln_x_b + n + 4);
      const float lw[8] = {w0[0], w0[1], w0[2], w0[3], w1[0], w1[1], w1[2], w1[3]}, lb[8] = {b0[0], b0[1], b0[2], b0[3], b1[0], b1[1], b1[2], b1[3]};
      u32x4 o;
#pragma unroll
      for (int i = 0; i < 4; ++i)
        o[i] = pack2((y[2 * i] * rs * lw[2 * i] + lb[2 * i] + bon * v[2 * i]) * bflo(g[i]), (y[2 * i + 1] * rs * lw[2 * i + 1] + lb[2 * i + 1] + bon * v[2 * i + 1]) * bfhi(g[i]));
      *(u32x4*)(p.out_a + (size_t)m * DM + n) = o;
    }
  }
};
__device__ __forceinline__ int xcd_tile(int vb, int nvb, int round, int TM, int TN, int& tm, int& tn) {
  if (nvb % 64 != 0) { const int it = round * nvb + vb; if (it >= TM * TN) return 0; tm = it % TM; tn = it / TM; return 1; }
  const int spg = nvb >> 3, g = vb & 7, slot = vb >> 3, SC = spg >> 3;
  const int nsr = (TM + 7) >> 3, nsc = (TN + SC - 1) / SC, st = round * 8 + g;
  if (st >= nsr * nsc) return 0;
  tm = (st % nsr) * 8 + (slot & 7); tn = (st / nsr) * SC + (slot >> 3);
  return (tm < TM && tn < TN) ? 1 : 2;
}
__device__ __forceinline__ void ph_gemm1(const P& p, int vb, int nvb, unsigned char* smem) {
  const int NS_ = 132 * 27, NALL = NS_ + 128 * 20;
  const int per = nvb >> 3;
  for (int round = 0;; ++round) {
    int item;
    if ((nvb & 7) == 0) { const int blk = round * 8 + (vb & 7); if (blk * per >= NALL) break; item = blk * per + (vb >> 3); if (item >= NALL) continue; }
    else { item = round * nvb + vb; if (item >= NALL) break; }
    if (item < NS_) {
      const int cgp = item / (132 * 9), rem = item % (132 * 9), tmS = rem / 9, tn = cgp * 9 + rem % 9;
      Epi3ZS epi;
      epi.zA = p.zA; epi.mu = p.mu_shift;
      int m0;
      if (tmS < 130) { const int b = tmS / 65, i = tmS % 65; m0 = b * SEQ + 254 * i - 1; epi.own_lo = 1; epi.own_hi = min(254, SEQ - 254 * i); epi.t0 = 254 * i - 1; epi.T = SEQ; }
      else { m0 = NTOK + (tmS - 130) * CTXL; epi.own_lo = 0; epi.own_hi = 255; epi.t0 = 0; epi.T = CTXL; }
      gemm_tile3_i8(p.hx8, DM, p.Wt8, DM, DM, m0, tn * 128, p.hsa, p.wsb, epi, smem);
    } else {
      const int i2 = item - NS_;
      int tm, tn;
      if (i2 < 2048) { tm = (i2 & 1023) >> 3; tn = 27 + (i2 >> 10) * 8 + (i2 & 7); } else { tm = (i2 - 2048) >> 2; tn = 43 + (i2 & 3); }
      Epi3Z epi{p.zA, p.zP, p.zG};
      gemm_tile3_i8(p.hx8, DM, p.Wt8, DM, DM, tm * 256, tn * 128, p.hsa, p.wsb, epi, smem);
    }
  }
}
__device__ __forceinline__ void ph_readout_gemm(const P& p, int vb, int nvb, unsigned char* smem) {
  Epi3Readout epi{&p};
  for (int round = 0;; ++round) {
    int tm, tn; const int r = xcd_tile(vb, nvb, round, NTOK / 256, DM / 128, tm, tn);
    if (r == 0) break;
    if (r == 1) gemm_tile3(p.sg, 128, p.g2T, 128, 128, tm * 256, tn * 128, epi, smem);
  }
}
__device__ __forceinline__ void ph_sg(const P& p, int vb, int nvb) {
  for (int it = vb * 256 + TIDX; it < NTOK * 16; it += nvb * 256) {
    const int m = it >> 4, l8 = (it & 15) * 8, t = m % SEQ;
    float o[8];
    load8(p.zA, m, 3328 + l8, o);
    u32x4 w;
#pragma unroll
    for (int i = 0; i < 4; ++i) w[i] = pack2(sigmoidf_(o[2 * i]), sigmoidf_(o[2 * i + 1]));
    *(u32x4*)(p.sg + (size_t)m * 128 + l8) = w;
  }
}
__device__ __forceinline__ void ph_gemm_merge(const P& p, int vb, int nvb, unsigned char* smem) {
  Epi3GateA ea{p.zG, p.b_gate, p.mrg};
  Epi3GateB eb{p.zG, p.b_gate, p.mrg};
  for (int round = 0;; ++round) {
    int tm, tn; const int r = xcd_tile(vb, nvb, round, NTOK / 256, DM / 128, tm, tn);
    if (r == 0) break;
    if (r == 1) {
      gemm_tile3(p.out_a, DM, p.Wt_aout, DM, DM, tm * 256, tn * 128, ea, smem);
      gemm_tile3(p.pooled, 512, p.Wt_eff, 512, 512, tm * 256, tn * 128, eb, smem);
    }
  }
}
__device__ __forceinline__ void ph_gemm_simple(const bf16_t* A, int lda, const bf16_t* Bt, int ldb, int K, int M, int N, bf16_t* C, int ldc, int vb, int nvb, unsigned char* smem) {
  Epi3StoreBf16 epi{C, ldc};
  for (int round = 0;; ++round) {
    int tm, tn; const int r = xcd_tile(vb, nvb, round, M / 256, N / 128, tm, tn);
    if (r == 0) break;
    if (r == 1) gemm_tile3(A, lda, Bt, ldb, K, tm * 256, tn * 128, epi, smem);
  }
}


#define O_R1 0
#define O_R2 10240
#define O_TA (O_R2 + 17408)
#define O_TR (O_TA + 4608)
#define O_TB (O_TR + 4608)
#define O_TK (O_TB + 4608)
#define O_TBT (O_TK + 4608)
#define O_TKT (O_TBT + 5120)
#define O_TVT (O_TKT + 5120)
#define O_GAM (O_TVT + 5120)
#define O_TST (O_GAM + 256)
#define RWKV_SMEM (O_TST + 2 * 9216)
#define NSUP 65
__device__ __forceinline__ void lds_wave_fence() { asm volatile("s_waitcnt lgkmcnt(0)" ::: "memory"); }
__device__ __forceinline__ u32x2 pack4(const f32x4& v) { u32x2 r; r.x = pack2(v[0], v[1]); r.y = pack2(v[2], v[3]); return r; }


typedef short s16x4 __attribute__((ext_vector_type(4)));
__device__ __forceinline__ float fast_tanh(float x) { const float e = __builtin_amdgcn_exp2f(2.885390082f * x); return 1.0f - 2.0f * __builtin_amdgcn_rcpf(e + 1.0f); }
template <int NS, bool WANTY>
__device__ __forceinline__ void rwkv_chunk(const P& p, unsigned char* smem, int d, int h, int rowbase, int T, int isc0, bool has_next, f32x4 (&st)[NS][4], u32x4 (&pf)[5]) {
  int tid = TIDX;
  asm volatile("" : "+v"(tid));
  const int lane = tid & 63, w = __builtin_amdgcn_readfirstlane(tid >> 6), l15 = lane & 15, q = lane >> 4;
  const int tt = tid >> 3, cg = tid & 7, ch0 = h * 64 + cg * 8;
  const int isc = isc0 + tt, t = d == 0 ? isc : T - 1 - isc;
  bf16_t* TWD = (bf16_t*)(smem + O_R1); bf16_t* TAD = TWD + 32 * 72;
  float* WT = (float*)(smem + O_R1);
  bf16_t* XT = (bf16_t*)(smem + O_R1); bf16_t* UT = XT + 64 * 40;
  float* LW = (float*)(smem + O_R2); float* LA = LW + 32 * 68;
  float* TL = (float*)(smem + O_R2);
  bf16_t* TT = (bf16_t*)(smem + O_R2 + 4608); bf16_t* TAK = TT + 32 * 40; bf16_t* TRB = TAK + 32 * 40; bf16_t* TRK = TRB + 32 * 40; bf16_t* TLB = TRK + 32 * 40;
  bf16_t* TA = (bf16_t*)(smem + O_TA); bf16_t* TR = (bf16_t*)(smem + O_TR); bf16_t* TB = (bf16_t*)(smem + O_TB); bf16_t* TK = (bf16_t*)(smem + O_TK);
  bf16_t* TBT = (bf16_t*)(smem + O_TBT); bf16_t* TKT = (bf16_t*)(smem + O_TKT); bf16_t* TVT = (bf16_t*)(smem + O_TVT);
  float* GAM = (float*)(smem + O_GAM);
  bf16_t* TST = (bf16_t*)(smem + O_TST);
  __syncthreads();
  float k8[8], r8[8];
  {
    u32x4 pk;
#pragma unroll
    for (int i = 0; i < 4; ++i) pk[i] = pack2(fast_tanh(bflo(pf[0][i])), fast_tanh(bfhi(pf[0][i])));
    *(u32x4*)(TWD + tt * 72 + cg * 8) = pk;
    *(u32x4*)(TAD + tt * 72 + cg * 8) = pf[1];
  }
#pragma unroll
  for (int i = 0; i < 4; ++i) { k8[2 * i] = bflo(pf[2][i]); k8[2 * i + 1] = bfhi(pf[2][i]); if (WANTY) { r8[2 * i] = bflo(pf[3][i]); r8[2 * i + 1] = bfhi(pf[3][i]); } }
  const u32x4 vzc = pf[4];
  __syncthreads();
  {
    f32x4 lw[2], la[2];
    bf16x8 w2f[2], a2f[2];
#pragma unroll
    for (int ks = 0; ks < 2; ++ks) {
      w2f[ks] = *(const bf16x8*)(p.w2T + ((size_t)d * 1024 + h * 64 + 16 * w + l15) * 64 + 32 * ks + 8 * q);
      a2f[ks] = *(const bf16x8*)(p.a2T + ((size_t)d * 1024 + h * 64 + 16 * w + l15) * 64 + 32 * ks + 8 * q);
    }
#pragma unroll
    for (int it = 0; it < 2; ++it) { lw[it] = (f32x4){0.f, 0.f, 0.f, 0.f}; la[it] = (f32x4){0.f, 0.f, 0.f, 0.f}; }
#pragma unroll
    for (int ks = 0; ks < 2; ++ks)
#pragma unroll
      for (int it = 0; it < 2; ++it) {
        const bf16x8 aw = *(const bf16x8*)(TWD + (16 * it + l15) * 72 + 32 * ks + 8 * q);
        const bf16x8 aa = *(const bf16x8*)(TAD + (16 * it + l15) * 72 + 32 * ks + 8 * q);
        lw[it] = __builtin_amdgcn_mfma_f32_16x16x32_bf16(aw, w2f[ks], lw[it], 0, 0, 0);
        la[it] = __builtin_amdgcn_mfma_f32_16x16x32_bf16(aa, a2f[ks], la[it], 0, 0, 0);
      }
    {
      const float cw0 = p.w0[d * 1024 + h * 64 + 16 * w + l15];
      float tot0 = 0.f;
#pragma unroll
      for (int it = 0; it < 2; ++it) {
        float pr[4];
#pragma unroll
        for (int rg = 0; rg < 4; ++rg) {
          const float e = 0.87505707f * sigmoidf_(cw0 + lw[it][rg]);
          pr[rg] = rg == 0 ? e : pr[rg - 1] + e;
        }
        float x = pr[3];
        float y = __shfl_up(x, 16); if (q >= 1) x += y;
        y = __shfl_up(x, 32); if (q >= 2) x += y;
        const float base = (x - pr[3]) + (it == 1 ? tot0 : 0.f);
        if (it == 0) tot0 = __shfl(x, 48 + l15);
#pragma unroll
        for (int rg = 0; rg < 4; ++rg) lw[it][rg] = pr[rg] + base;
      }
      if (q == 3) GAM[16 * w + l15] = __builtin_amdgcn_exp2f(-lw[1][3]);
    }
#pragma unroll
    for (int it = 0; it < 2; ++it)
#pragma unroll
      for (int rg = 0; rg < 4; ++rg) { LW[(16 * it + 4 * q + rg) * 68 + 16 * w + l15] = lw[it][rg]; LA[(16 * it + 4 * q + rg) * 68 + 16 * w + l15] = la[it][rg]; }
  }
  __syncthreads();
  float icl[8], kkn[8], kd[8];
  {
    float ss = 0.f, bd = 0.f;
    float ca0[8], ckk[8], cka[8], crk[8];
#pragma unroll
    for (int e4 = 0; e4 < 8; e4 += 4) {
      const f32x4 b2 = *(const f32x4*)(p.a0 + d * 1024 + ch0 + e4), c2 = *(const f32x4*)(p.k_k + ch0 + e4);
      const f32x4 d2 = *(const f32x4*)(p.k_a + ch0 + e4), f2 = *(const f32x4*)(p.r_k + ch0 + e4);
#pragma unroll
      for (int e = 0; e < 4; ++e) { ca0[e4 + e] = b2[e]; ckk[e4 + e] = c2[e]; cka[e4 + e] = d2[e]; crk[e4 + e] = f2[e]; }
    }
    float lav[8];
    { const f32x4 l0 = *(const f32x4*)(LA + tt * 68 + cg * 8), l1 = *(const f32x4*)(LA + tt * 68 + cg * 8 + 4);
#pragma unroll
      for (int e = 0; e < 4; ++e) { lav[e] = l0[e]; lav[4 + e] = l1[e]; } }
#pragma unroll
    for (int e = 0; e < 8; ++e) {
      icl[e] = sigmoidf_(ca0[e] + lav[e]);
      kkn[e] = k8[e] * ckk[e]; ss += kkn[e] * kkn[e];
      kd[e] = k8[e] * (1.f + (icl[e] - 1.f) * cka[e]);
      if (WANTY) bd += r8[e] * kd[e] * crk[e];
    }
    ss = red8(ss); if (WANTY) bd = red8(bd);
    const float rn = rsqrtf(fmaxf(ss, 1e-24f));
#pragma unroll
    for (int e = 0; e < 8; ++e) kkn[e] *= rn;
    if (WANTY && cg == 0) p.bdot[((size_t)d * NTOK + rowbase + t) * 16 + h] = bd;
  }
  {
    float ta[8], tr[8], tb[8], tk[8], v8[8];
#pragma unroll
    for (int i = 0; i < 4; ++i) { v8[2 * i] = bflo(vzc[i]); v8[2 * i + 1] = bfhi(vzc[i]); }
    float Lv[8], Lpv[8];
    {
      const f32x4 a0 = *(const f32x4*)(LW + tt * 68 + cg * 8), a1 = *(const f32x4*)(LW + tt * 68 + cg * 8 + 4);
      const int tp = tt > 0 ? tt - 1 : 0;
      const f32x4 b0 = *(const f32x4*)(LW + tp * 68 + cg * 8), b1 = *(const f32x4*)(LW + tp * 68 + cg * 8 + 4);
#pragma unroll
      for (int e = 0; e < 4; ++e) { Lv[e] = a0[e]; Lv[4 + e] = a1[e]; Lpv[e] = tt > 0 ? b0[e] : 0.f; Lpv[4 + e] = tt > 0 ? b1[e] : 0.f; }
    }
#pragma unroll
    for (int e = 0; e < 8; ++e) {
      const float Li = Lv[e];
      const float Lp = Lpv[e];
      const float gi = __builtin_amdgcn_exp2f(-Li), gim1 = __builtin_amdgcn_exp2f(-Lp), ginv = __builtin_amdgcn_exp2f(Li);
      ta[e] = -kkn[e] * gim1; if (WANTY) tr[e] = r8[e] * gi; tb[e] = kkn[e] * icl[e] * ginv; tk[e] = kd[e] * ginv;
    }
    u32x4 pk;
    pk.x = pack2(ta[0], ta[1]); pk.y = pack2(ta[2], ta[3]); pk.z = pack2(ta[4], ta[5]); pk.w = pack2(ta[6], ta[7]); *(u32x4*)(TA + tt * 72 + cg * 8) = pk;
    if (WANTY) { pk.x = pack2(tr[0], tr[1]); pk.y = pack2(tr[2], tr[3]); pk.z = pack2(tr[4], tr[5]); pk.w = pack2(tr[6], tr[7]); *(u32x4*)(TR + tt * 72 + cg * 8) = pk; }
    pk.x = pack2(tb[0], tb[1]); pk.y = pack2(tb[2], tb[3]); pk.z = pack2(tb[4], tb[5]); pk.w = pack2(tb[6], tb[7]); *(u32x4*)(TB + tt * 72 + cg * 8) = pk;
    pk.x = pack2(tk[0], tk[1]); pk.y = pack2(tk[2], tk[3]); pk.z = pack2(tk[4], tk[5]); pk.w = pack2(tk[6], tk[7]); *(u32x4*)(TK + tt * 72 + cg * 8) = pk;
#pragma unroll
    for (int e = 0; e < 8; ++e) { TBT[(cg * 8 + e) * 40 + tt] = f2bf(tb[e]); TKT[(cg * 8 + e) * 40 + tt] = f2bf(tk[e]); TVT[(cg * 8 + e) * 40 + tt] = f2bf(v8[e]); }
  }
  __syncthreads();
  if (WANTY || w < 2) {
    const bf16_t* X = (w < 2) ? TA : TR; const bf16_t* Y = (w & 1) ? TK : TB;
    f32x4 g[2][2];
#pragma unroll
    for (int it = 0; it < 2; ++it)
#pragma unroll
      for (int s2 = 0; s2 < 2; ++s2) g[it][s2] = (f32x4){0.f, 0.f, 0.f, 0.f};
#pragma unroll
    for (int ks = 0; ks < 2; ++ks) {
      bf16x8 xa[2], yb[2];
#pragma unroll
      for (int it = 0; it < 2; ++it) { xa[it] = *(const bf16x8*)(X + (16 * it + l15) * 72 + 32 * ks + 8 * q); yb[it] = *(const bf16x8*)(Y + (16 * it + l15) * 72 + 32 * ks + 8 * q); }
#pragma unroll
      for (int it = 0; it < 2; ++it)
#pragma unroll
        for (int s2 = 0; s2 < 2; ++s2) g[it][s2] = __builtin_amdgcn_mfma_f32_16x16x32_bf16(xa[it], yb[s2], g[it][s2], 0, 0, 0);
    }
    if (w == 0) {
#pragma unroll
      for (int it = 0; it < 2; ++it)
#pragma unroll
        for (int s2 = 0; s2 < 2; ++s2)
#pragma unroll
          for (int rg = 0; rg < 4; ++rg) {
            const int i = 16 * it + 4 * q + rg, s = 16 * s2 + l15;
            TL[i * 36 + s] = (s < i) ? g[it][s2][rg] : 0.f;
          }
#pragma unroll
      for (int rg = 0; rg < 4; ++rg) TLB[(4 * q + rg) * 40 + l15] = f2bf(g[1][0][rg]);
    } else {
      bf16_t* dst = w == 1 ? TAK : (w == 2 ? TRB : TRK);
      const int incl = w == 1 ? 0 : 1;
#pragma unroll
      for (int it = 0; it < 2; ++it)
#pragma unroll
        for (int s2 = 0; s2 < 2; ++s2)
#pragma unroll
          for (int rg = 0; rg < 4; ++rg) {
            const int i = 16 * it + 4 * q + rg, s = 16 * s2 + l15;
            dst[i * 40 + s] = f2bf((s < i + incl) ? g[it][s2][rg] : 0.f);
          }
    }
  }
  if (w == 0) {
    lds_wave_fence();
    const int c = lane & 15, hb = lane & 16;
    float Tr[16];
    f32x4 Lr[16][4];
#pragma unroll
    for (int i = 1; i < 16; ++i)
#pragma unroll
      for (int j4 = 0; j4 < (i + 3) / 4; ++j4) Lr[i][j4] = *(const f32x4*)(TL + (hb + i) * 36 + hb + 4 * j4);
#pragma unroll
    for (int i = 0; i < 16; ++i) {
      float acc = (i == c) ? 1.f : 0.f;
#pragma unroll
      for (int j = 0; j < i; ++j) acc += Lr[i][j >> 2][j & 3] * Tr[j];
      Tr[i] = acc;
    }
    if (lane < 32) {
#pragma unroll
      for (int i = 0; i < 16; ++i) TT[(hb + i) * 40 + hb + c] = f2bf(Tr[i]);
    }
  }
  __syncthreads();
  if (has_next) {
    const int isn = isc + 32, tn = d == 0 ? isn : T - 1 - isn;
    const bf16_t* zr = p.zA + (size_t)(rowbase + tn) * SHIFTC;
    pf[0] = *(const u32x4*)(zr + 3072 + d * 64 + cg * 8);
    pf[1] = *(const u32x4*)(zr + 3200 + d * 64 + cg * 8);
    pf[2] = *(const u32x4*)(zr + 1024 + ch0);
    if (WANTY) pf[3] = *(const u32x4*)(zr + ch0);
    pf[4] = *(const u32x4*)(zr + 2048 + ch0);
  }
  bf16_t yprev[2][4];
  if (WANTY) {
#pragma unroll
    for (int it = 0; it < 2; ++it)
#pragma unroll
      for (int rg = 0; rg < 4; ++rg) {
        yprev[it][rg] = 0;
        if (d == 1) yprev[it][rg] = p.Y0[(size_t)(rowbase + T - 1 - (isc0 + 16 * it + 4 * q + rg)) * DM + h * 64 + 16 * w + l15];
      }
  }
  const bf16x8 vfr = *(const bf16x8*)(TVT + (16 * w + l15) * 40 + 8 * q);
  const s16x4 t1f = *(const s16x4*)(TT + l15 * 40 + 4 * q), t2f = *(const s16x4*)(TT + (16 + l15) * 40 + 16 + 4 * q), l21f = *(const s16x4*)(TLB + l15 * 40 + 4 * q);
  bf16_t* XTw = XT + (16 * w + l15) * 40; bf16_t* UTw = UT + (16 * w + l15) * 40;
#pragma unroll
  for (int si = 0; si < NS; ++si) {
    const bool useV = (NS == 1) || (si == 1);
    const bf16_t* STs = TST + (si * 64 + 16 * w + l15) * 72;
    bf16x8 sf[2];
    sf[0] = *(const bf16x8*)(STs + 8 * q); sf[1] = *(const bf16x8*)(STs + 32 + 8 * q);
    f32x4 xa[2];
#pragma unroll
    for (int it = 0; it < 2; ++it) {
      xa[it] = (f32x4){0.f, 0.f, 0.f, 0.f};
#pragma unroll
      for (int ks = 0; ks < 2; ++ks) xa[it] = __builtin_amdgcn_mfma_f32_16x16x32_bf16(*(const bf16x8*)(TA + (16 * it + l15) * 72 + 32 * ks + 8 * q), sf[ks], xa[it], 0, 0, 0);
      if (useV) xa[it] = __builtin_amdgcn_mfma_f32_16x16x32_bf16(*(const bf16x8*)(TAK + (16 * it + l15) * 40 + 8 * q), vfr, xa[it], 0, 0, 0);
    }
    *(u32x2*)(XTw + 4 * q) = pack4(xa[0]);
    lds_wave_fence();
    f32x4 ua = __builtin_amdgcn_mfma_f32_16x16x16bf16_1k(t1f, *(const s16x4*)(XTw + 4 * q), (f32x4){0.f, 0.f, 0.f, 0.f}, 0, 0, 0);
    *(u32x2*)(UTw + 4 * q) = pack4(ua);
    lds_wave_fence();
    xa[1] = __builtin_amdgcn_mfma_f32_16x16x16bf16_1k(l21f, *(const s16x4*)(UTw + 4 * q), xa[1], 0, 0, 0);
    *(u32x2*)(XTw + 16 + 4 * q) = pack4(xa[1]);
    lds_wave_fence();
    ua = __builtin_amdgcn_mfma_f32_16x16x16bf16_1k(t2f, *(const s16x4*)(XTw + 16 + 4 * q), (f32x4){0.f, 0.f, 0.f, 0.f}, 0, 0, 0);
    *(u32x2*)(UTw + 16 + 4 * q) = pack4(ua);
    lds_wave_fence();
    const bf16x8 uf = *(const bf16x8*)(UTw + 8 * q);
    if (WANTY) {
#pragma unroll
      for (int it = 0; it < 2; ++it) {
        f32x4 ya = (f32x4){0.f, 0.f, 0.f, 0.f};
#pragma unroll
        for (int ks = 0; ks < 2; ++ks) ya = __builtin_amdgcn_mfma_f32_16x16x32_bf16(*(const bf16x8*)(TR + (16 * it + l15) * 72 + 32 * ks + 8 * q), sf[ks], ya, 0, 0, 0);
        ya = __builtin_amdgcn_mfma_f32_16x16x32_bf16(*(const bf16x8*)(TRB + (16 * it + l15) * 40 + 8 * q), uf, ya, 0, 0, 0);
        if (useV) ya = __builtin_amdgcn_mfma_f32_16x16x32_bf16(*(const bf16x8*)(TRK + (16 * it + l15) * 40 + 8 * q), vfr, ya, 0, 0, 0);
#pragma unroll
        for (int rg = 0; rg < 4; ++rg) {
          const int iq = isc0 + 16 * it + 4 * q + rg, tq = d == 0 ? iq : T - 1 - iq;
          if (useV) {
            p.Y0[(size_t)(rowbase + tq) * DM + h * 64 + 16 * w + l15] = f2bf(ya[rg] + bf2f(yprev[it][rg]));
          } else {
            bf16_t* pp = d == 0 ? p.Y1 + (size_t)(rowbase + tq) * DM : p.zA + (size_t)(rowbase + tq) * SHIFTC;
            pp[h * 64 + 16 * w + l15] = f2bf(ya[rg]);
          }
        }
      }
    }
#pragma unroll
    for (int kt = 0; kt < 4; ++kt) {
      f32x4 hv = st[si][kt];
      hv = __builtin_amdgcn_mfma_f32_16x16x32_bf16(*(const bf16x8*)(TBT + (16 * kt + l15) * 40 + 8 * q), uf, hv, 0, 0, 0);
      if (useV) hv = __builtin_amdgcn_mfma_f32_16x16x32_bf16(*(const bf16x8*)(TKT + (16 * kt + l15) * 40 + 8 * q), vfr, hv, 0, 0, 0);
      hv *= *(const f32x4*)(GAM + 16 * kt + 4 * q);
      st[si][kt] = hv;
      *(u32x2*)(TST + (si * 64 + 16 * w + l15) * 72 + 16 * kt + 4 * q) = pack4(hv);
    }
  }
}

template <bool WANTY>
__device__ __forceinline__ void rwkv_prefetch_first(const P& p, int d, int h, int rowbase, int T, int isc0, u32x4 (&pf)[5]) {
  const int tid = TIDX, tt = tid >> 3, cg = tid & 7, ch0 = h * 64 + cg * 8, isc = isc0 + tt, t = d == 0 ? isc : T - 1 - isc;
  const bf16_t* zr = p.zA + (size_t)(rowbase + t) * SHIFTC;
  pf[0] = *(const u32x4*)(zr + 3072 + d * 64 + cg * 8);
  pf[1] = *(const u32x4*)(zr + 3200 + d * 64 + cg * 8);
  pf[2] = *(const u32x4*)(zr + 1024 + ch0);
  pf[3] = WANTY ? *(const u32x4*)(zr + ch0) : (u32x4){0u, 0u, 0u, 0u};
  pf[4] = *(const u32x4*)(zr + 2048 + ch0);
}
template <bool LAT>
__device__ __forceinline__ void rwkv_super(const P& p, unsigned char* smem, int chain, int j) {
  const int tid = TIDX, lane = tid & 63, w = tid >> 6, l15 = lane & 15, q = lane >> 4;
  bf16_t* TST = (bf16_t*)(smem + O_TST);
  const int b = chain >> 5, d = (chain >> 4) & 1, h = chain & 15;
  const int T = LAT ? SEQ : CTXL, rowbase = LAT ? b * SEQ : NTOK + b * CTXL, base = LAT ? (j - 1) * 256 : 0;
  f32x4 st[2][4];
  __syncthreads();
#pragma unroll
  for (int kt = 0; kt < 4; ++kt) {
#pragma unroll
    for (int rg = 0; rg < 4; ++rg) st[0][kt][rg] = (16 * kt + 4 * q + rg == 16 * w + l15) ? 1.f : 0.f;
    st[1][kt] = (f32x4){0.f, 0.f, 0.f, 0.f};
    *(u32x2*)(TST + (16 * w + l15) * 72 + 16 * kt + 4 * q) = pack4(st[0][kt]);
    *(u32x2*)(TST + (64 + 16 * w + l15) * 72 + 16 * kt + 4 * q) = pack4(st[1][kt]);
  }
  u32x4 pf[5]; rwkv_prefetch_first<LAT>(p, d, h, rowbase, T, base, pf);
  for (int c = 0; c < 8; ++c) rwkv_chunk<2, LAT>(p, smem, d, h, rowbase, T, base + 32 * c, c < 7, st, pf);
  if (j < 64) {
    const size_t slot = (size_t)chain * NSUP + j;
#pragma unroll
    for (int kt = 0; kt < 4; ++kt) {
#pragma unroll
      for (int rg = 0; rg < 4; ++rg) p.Mst[(slot * 64 + 16 * kt + 4 * q + rg) * 64 + 16 * w + l15] = f2bf(st[0][kt][rg]);
      *(f32x4*)(p.Nst + (slot * 64 + 16 * w + l15) * 64 + 16 * kt + 4 * q) = st[1][kt];
    }
  }
}
__device__ __forceinline__ void ph_rwkv_A(const P& p, int vb, int nvb, unsigned char* smem) {
  for (int chain = vb; chain < 64; chain += nvb) rwkv_super<false>(p, smem, chain, 0);
  for (int item = vb; item < 2048; item += nvb) {
    const int b = item >> 10, J = (item >> 4) & 63, h = item & 15;
#pragma unroll 1
    for (int d = 0; d < 2; ++d) {
      rwkv_super<true>(p, smem, b * 32 + d * 16 + h, d == 0 ? J + 1 : 64 - J);
      asm volatile("s_waitcnt vmcnt(0)" ::: "memory");
      __syncthreads();
    }
  }
}
__device__ __forceinline__ void ph_rwkv_B(const P& p, int vb, int nvb, unsigned char* smem) {
  const int tid = TIDX, lane = tid & 63, w = tid >> 6, l15 = lane & 15, q = lane >> 4;
  bf16_t* HT = (bf16_t*)smem;
  for (int chain = vb; chain < 64; chain += nvb) {
    f32x4 hs[4];
#pragma unroll
    for (int kt = 0; kt < 4; ++kt) hs[kt] = (f32x4){0.f, 0.f, 0.f, 0.f};
    __syncthreads();
    for (int j = 0; j < 64; ++j) {
      const size_t slot = (size_t)chain * NSUP + j;
      f32x4 nv[4];
#pragma unroll
      for (int kt = 0; kt < 4; ++kt) nv[kt] = *(const f32x4*)(p.Nst + (slot * 64 + 16 * w + l15) * 64 + 16 * kt + 4 * q);
      bf16x8 mf[4][2];
#pragma unroll
      for (int kt = 0; kt < 4; ++kt)
#pragma unroll
        for (int ks = 0; ks < 2; ++ks) mf[kt][ks] = *(const bf16x8*)(p.Mst + (slot * 64 + 16 * kt + l15) * 64 + 32 * ks + 8 * q);
#pragma unroll
      for (int kt = 0; kt < 4; ++kt) {
        *(f32x4*)(p.Nst + (slot * 64 + 16 * w + l15) * 64 + 16 * kt + 4 * q) = hs[kt];
        *(u32x2*)(HT + (16 * w + l15) * 72 + 16 * kt + 4 * q) = pack4(hs[kt]);
      }
      lds_wave_fence();
      bf16x8 hf[2];
      hf[0] = *(const bf16x8*)(HT + (16 * w + l15) * 72 + 8 * q); hf[1] = *(const bf16x8*)(HT + (16 * w + l15) * 72 + 32 + 8 * q);
      lds_wave_fence();
#pragma unroll
      for (int kt = 0; kt < 4; ++kt) {
        f32x4 a = nv[kt];
#pragma unroll
        for (int ks = 0; ks < 2; ++ks) a = __builtin_amdgcn_mfma_f32_16x16x32_bf16(mf[kt][ks], hf[ks], a, 0, 0, 0);
        hs[kt] = a;
      }
    }
    const size_t slot = (size_t)chain * NSUP + 64;
#pragma unroll
    for (int kt = 0; kt < 4; ++kt) *(f32x4*)(p.Nst + (slot * 64 + 16 * w + l15) * 64 + 16 * kt + 4 * q) = hs[kt];
  }
}
__device__ __forceinline__ void ph_ycorr(const P& p, int vb, int nvb) {
  const int tid = TIDX, lane = tid & 63, w = tid >> 6, l15 = lane & 15, q = lane >> 4;
  for (int item = vb; item < 2048; item += nvb) {
    const int b = item >> 10, J = (item >> 4) & 63, h = item & 15;
    const size_t tok0 = (size_t)b * SEQ + J * 256 + 64 * w;
    bf16x8 hf[4][4];
#pragma unroll
    for (int kk = 0; kk < 4; ++kk) {
      const size_t slot = kk < 2 ? (size_t)(b * 32 + h) * NSUP + (J + 1) : (size_t)(b * 32 + 16 + h) * NSUP + (64 - J);
#pragma unroll
      for (int nt = 0; nt < 4; ++nt) {
        const float* src = p.Nst + (slot * 64 + 16 * nt + l15) * 64 + 32 * (kk & 1) + 8 * q;
        const f32x4 a = *(const f32x4*)src, c = *(const f32x4*)(src + 4);
        const u32x4 pk = (u32x4){pack2(a[0], a[1]), pack2(a[2], a[3]), pack2(c[0], c[1]), pack2(c[2], c[3])};
        hf[kk][nt] = __builtin_bit_cast(bf16x8, pk);
      }
    }
#pragma unroll 1
    for (int mt = 0; mt < 4; ++mt) {
      const size_t tok = tok0 + 16 * mt + l15;
      bf16x8 pa[4];
#pragma unroll
      for (int kk = 0; kk < 2; ++kk) {
        pa[kk] = *(const bf16x8*)(p.Y1 + tok * DM + h * 64 + 32 * kk + 8 * q);
        pa[2 + kk] = *(const bf16x8*)(p.zA + tok * SHIFTC + h * 64 + 32 * kk + 8 * q);
      }
      u32x2 yo[4];
#pragma unroll
      for (int nt = 0; nt < 4; ++nt) yo[nt] = *(const u32x2*)(p.Y0 + tok * DM + h * 64 + 16 * nt + 4 * q);
#pragma unroll
      for (int nt = 0; nt < 4; ++nt) {
        f32x4 acc = (f32x4){bflo(yo[nt].x), bfhi(yo[nt].x), bflo(yo[nt].y), bfhi(yo[nt].y)};
#pragma unroll
        for (int kk = 0; kk < 4; ++kk) acc = __builtin_amdgcn_mfma_f32_16x16x32_bf16(hf[kk][nt], pa[kk], acc, 0, 0, 0);
        *(u32x2*)(p.Y0 + tok * DM + h * 64 + 16 * nt + 4 * q) = pack4(acc);
      }
    }
  }
}

#define POOL_SMEM (64 * 128 * 4)
__device__ __forceinline__ void ph_pool(const P& p, int vb, int nvb, unsigned char* smem) {
  float* V = (float*)smem;
  const int tid = TIDX, cp = tid & 63, cq = tid >> 6;
  for (int item = vb; item < 2 * 4 * 64; item += nvb) {
    const int j = item & 3, st = (item >> 2) & 63, b = item >> 8;
    const int win = 2 << j, half = win >> 1;
    const bf16_t* zb = p.zP + (size_t)b * SEQ * 512 + j * 128 + cp * 2;
    float a0[16], a1[16];
#pragma unroll
    for (int i = 0; i < 16; ++i) { a0[i] = 0.f; a1[i] = 0.f; }
    {
      const int r = 4 * st, r0 = max(r - half, 0), r1 = min(r + half, 256);
      for (int rr = r0; rr < r1; ++rr) {
#pragma unroll
        for (int i = 0; i < 16; ++i) { const unsigned u = *(const unsigned*)(zb + (size_t)(rr * 64 + cq * 16 + i) * 512); a0[i] += bflo(u); a1[i] += bfhi(u); }
      }
    }
    for (int dr = 0; dr < 4; ++dr) {
      const int r = 4 * st + dr, r0 = max(r - half, 0), r1 = min(r + half, 256);
      if (dr > 0) {
        const int radd = r + half - 1, rsub = r - half - 1;
        if (radd < 256) {
#pragma unroll
          for (int i = 0; i < 16; ++i) { const unsigned u = *(const unsigned*)(zb + (size_t)(radd * 64 + cq * 16 + i) * 512); a0[i] += bflo(u); a1[i] += bfhi(u); }
        }
        if (rsub >= 0) {
#pragma unroll
          for (int i = 0; i < 16; ++i) { const unsigned u = *(const unsigned*)(zb + (size_t)(rsub * 64 + cq * 16 + i) * 512); a0[i] -= bflo(u); a1[i] -= bfhi(u); }
        }
      }
      __syncthreads();
#pragma unroll
      for (int i = 0; i < 16; ++i) *(f32x2*)(V + (cq * 16 + i) * 128 + cp * 2) = (f32x2){a0[i], a1[i]};
      __syncthreads();
      float s0 = 0.f, s1 = 0.f;
      {
        const int c = cq * 16, c0 = max(c - half, 0), c1 = min(c + half, 64);
        for (int cc = c0; cc < c1; ++cc) { const f32x2 v = *(const f32x2*)(V + cc * 128 + cp * 2); s0 += v.x; s1 += v.y; }
      }
#pragma unroll
      for (int i = 0; i < 16; ++i) {
        const int c = cq * 16 + i, c0 = max(c - half, 0), c1 = min(c + half, 64);
        if (i > 0) {
          const int cadd = c + half - 1, csub = c - half - 1;
          if (cadd < 64) { const f32x2 v = *(const f32x2*)(V + cadd * 128 + cp * 2); s0 += v.x; s1 += v.y; }
          if (csub >= 0) { const f32x2 v = *(const f32x2*)(V + csub * 128 + cp * 2); s0 -= v.x; s1 -= v.y; }
        }
        const float inv = __builtin_amdgcn_rcpf((float)((r1 - r0) * (c1 - c0)));
        const size_t tokoff = ((size_t)b * SEQ + r * 64 + c) * 512 + j * 128 + cp * 2;
        const unsigned u = *(const unsigned*)(p.zP + tokoff);
        *(unsigned*)(p.pooled + tokoff) = pack2(s0 * inv - bflo(u), s1 * inv - bfhi(u));
      }
    }
  }
}
__device__ __forceinline__ void ph_res1(const P& p, int vb, int nvb) {
  const int lane = TIDX & 63, wid = TIDX >> 6;
  for (int m = vb * 4 + wid; m < NTOK; m += nvb * 4) {
    const float* md = p.mod + (m / SEQ) * 6144;
    float mx[16]; float ss = 0.f;
#pragma unroll
    for (int i = 0; i < 4; ++i) {
      const uint2 u = *(const uint2*)(p.mix + (size_t)m * DM + i * 256 + lane * 4);
      mx[4 * i] = bflo(u.x); mx[4 * i + 1] = bfhi(u.x); mx[4 * i + 2] = bflo(u.y); mx[4 * i + 3] = bfhi(u.y);
#pragma unroll
      for (int e = 0; e < 4; ++e) ss += mx[4 * i + e] * mx[4 * i + e];
    }
    ss = wave_sum(ss);
    const float rstd = rsqrtf(ss * (1.0f / 1024.0f) + 1e-6f);
    float x1[16]; float s2 = 0.f;
#pragma unroll
    for (int i = 0; i < 4; ++i) {
      const int col = i * 256 + lane * 4;
      const float4 xv = *(const float4*)(p.x + (size_t)m * DM + col), g = *(const float4*)(p.g_post_mix + col), gt = *(const float4*)(md + 2048 + col);
      x1[4 * i] = xv.x + gt.x * mx[4 * i] * rstd * g.x; x1[4 * i + 1] = xv.y + gt.y * mx[4 * i + 1] * rstd * g.y;
      x1[4 * i + 2] = xv.z + gt.z * mx[4 * i + 2] * rstd * g.z; x1[4 * i + 3] = xv.w + gt.w * mx[4 * i + 3] * rstd * g.w;
      *(float4*)(p.out + (size_t)m * DM + col) = make_float4(x1[4 * i], x1[4 * i + 1], x1[4 * i + 2], x1[4 * i + 3]);
#pragma unroll
      for (int e = 0; e < 4; ++e) s2 += x1[4 * i + e] * x1[4 * i + e];
    }
    s2 = wave_sum(s2);
    const float r2 = rsqrtf(s2 * (1.0f / 1024.0f) + 1e-6f);
#pragma unroll
    for (int i = 0; i < 4; ++i) {
      const int col = i * 256 + lane * 4;
      const float4 g = *(const float4*)(p.g_pre_ffn + col), sh = *(const float4*)(md + 3072 + col), sc = *(const float4*)(md + 4096 + col);
      uint2 w;
      w.x = pack2(x1[4 * i] * r2 * g.x * (1.f + sc.x) + sh.x, x1[4 * i + 1] * r2 * g.y * (1.f + sc.y) + sh.y);
      w.y = pack2(x1[4 * i + 2] * r2 * g.z * (1.f + sc.z) + sh.z, x1[4 * i + 3] * r2 * g.w * (1.f + sc.w) + sh.w);
      *(uint2*)(p.hx2 + (size_t)m * DM + col) = w;
    }
  }
}

#define PS1_SMEM (128 * 133 * 4)
#define CE_DESC(a, b) { const float _mx = fmaxf(a, b), _mn = fminf(a, b); a = _mx; b = _mn; }
template <int N> __device__ __forceinline__ void bitonic_sort_desc(float (&v)[N]) {
#pragma unroll
  for (int k = 2; k <= N; k <<= 1)
#pragma unroll
    for (int j = k >> 1; j > 0; j >>= 1)
#pragma unroll
      for (int i = 0; i < N; ++i) { const int l = i ^ j; if (l > i) { if ((i & k) == 0) CE_DESC(v[i], v[l]) else CE_DESC(v[l], v[i]) } }
}
__device__ __forceinline__ void bitonic_merge16_desc(float (&v)[16]) {
#pragma unroll
  for (int j = 8; j > 0; j >>= 1)
#pragma unroll
    for (int i = 0; i < 16; ++i) { const int l = i ^ j; if (l > i) CE_DESC(v[i], v[l]) }
}
__device__ __forceinline__ void ph_peer_s1(const P& p, int vb, int nvb, unsigned char* smem) {
  float* S = (float*)smem;
  EpiLds epi{S};
  const int tid = TIDX, sub = tid & 3;
  for (int item = vb; item < 256 * 16; item += nvb) {
    const int hp = item & 15, tm = item >> 4;
    __syncthreads();
    gemm_tile(p.q + hp * 128, 2048, p.keys + (size_t)hp * 128 * 128, 128, 128, tm * 128, 0, epi, smem);
    __syncthreads();
#pragma unroll 1
    for (int pass = 0; pass < 2; ++pass) {
      const int row = pass * 64 + (tid >> 2);
      float a[16], b[16];
#pragma unroll
      for (int i = 0; i < 16; ++i) {
        a[i] = __uint_as_float((__float_as_uint(S[row * 133 + sub * 33 + i]) & ~127u) | (unsigned)(sub * 32 + i));
        b[i] = __uint_as_float((__float_as_uint(S[row * 133 + sub * 33 + 16 + i]) & ~127u) | (unsigned)(sub * 32 + 16 + i));
      }
      bitonic_sort_desc<16>(a); bitonic_sort_desc<16>(b);
#pragma unroll
      for (int i = 0; i < 16; ++i) a[i] = fmaxf(a[i], b[15 - i]);
      bitonic_merge16_desc(a);
#pragma unroll
      for (int lvl = 1; lvl <= 2; lvl <<= 1) {
#pragma unroll
        for (int i = 0; i < 16; ++i) b[i] = __shfl_xor(a[i], lvl);
#pragma unroll
        for (int i = 0; i < 16; ++i) a[i] = fmaxf(a[i], b[15 - i]);
        bitonic_merge16_desc(a);
      }
      if (sub == 0) {
        const size_t ob = ((size_t)(tm * 128 + row) * 16 + hp) * 16;
#pragma unroll
        for (int i = 0; i < 16; i += 4) {
          *(f32x4*)(p.sv + ob + i) = (f32x4){a[i], a[i + 1], a[i + 2], a[i + 3]};
          typedef int i32x4 __attribute__((ext_vector_type(4)));
          *(i32x4*)(p.si + ob + i) = (i32x4){(int)(__float_as_uint(a[i]) & 127u), (int)(__float_as_uint(a[i + 1]) & 127u), (int)(__float_as_uint(a[i + 2]) & 127u), (int)(__float_as_uint(a[i + 3]) & 127u)};
        }
      }
    }
  }
}
__device__ __forceinline__ void top16_merge(float (&x)[16], const float (&y)[16]) {
#pragma unroll
  for (int i = 0; i < 16; ++i) x[i] = fmaxf(x[i], y[15 - i]);
  bitonic_merge16_desc(x);
}
__device__ __forceinline__ void ph_peer_s2(const P& p, int vb, int nvb, unsigned char* smem) {
  unsigned char* lut = smem;
  __syncthreads();
  if (TIDX == 0) {
    int n = 0;
#pragma unroll
    for (int i = 0; i < 16; ++i)
#pragma unroll
      for (int j = 0; j < 16; ++j)
        if ((i + 1) * (j + 1) <= 16) { lut[n] = (unsigned char)((i << 4) | j); ++n; }
  }
  __syncthreads();
  for (int it = vb * 256 + TIDX; it < NTOK * 8; it += nvb * 256) {
    const size_t ob = (size_t)it * 32;
    float a[16], bq[16];
#pragma unroll
    for (int i = 0; i < 16; i += 4) {
      const f32x4 fa = *(const f32x4*)(p.sv + ob + i), fb = *(const f32x4*)(p.sv + ob + 16 + i);
#pragma unroll
      for (int e = 0; e < 4; ++e) { a[i + e] = fa[e]; bq[i + e] = fb[e]; }
    }
    float g0[16], g1[16], g2[16], g3[16];
    {
      int n = 0;
#pragma unroll
      for (int i = 0; i < 16; ++i)
#pragma unroll
        for (int j = 0; j < 16; ++j)
          if ((i + 1) * (j + 1) <= 16) {
            const float v = __uint_as_float((__float_as_uint(a[i] + bq[j]) & ~63u) | (unsigned)n);
            if (n < 16) g0[n] = v; else if (n < 32) g1[n - 16] = v; else if (n < 48) g2[n - 32] = v; else g3[n - 48] = v;
            ++n;
          }
#pragma unroll
      for (int k = 2; k < 16; ++k) g3[k] = -3.0e38f;
    }
    bitonic_sort_desc<16>(g0); bitonic_sort_desc<16>(g1); bitonic_sort_desc<16>(g2); bitonic_sort_desc<16>(g3);
    top16_merge(g0, g1); top16_merge(g2, g3); top16_merge(g0, g2);
    float den = 0.f; float ex[16]; int seli[16];
#pragma unroll
    for (int k = 0; k < 16; ++k) {
      ex[k] = __expf(g0[k] - g0[0]); den += ex[k];
      const int ij = lut[__float_as_uint(g0[k]) & 63u];
      const int ka = (int)(__float_as_uint(p.sv[ob + (ij >> 4)]) & 127u), kb = (int)(__float_as_uint(p.sv[ob + 16 + (ij & 15)]) & 127u);
      seli[k] = ka * 128 + kb;
    }
    const float inv = 1.0f / den;
    const size_t o2 = (size_t)it * 16;
    typedef int i32x4 __attribute__((ext_vector_type(4)));
#pragma unroll
    for (int k = 0; k < 16; k += 4) {
      *(i32x4*)(p.pidx + o2 + k) = (i32x4){seli[k], seli[k + 1], seli[k + 2], seli[k + 3]};
      *(f32x4*)(p.pgate + o2 + k) = (f32x4){ex[k] * inv, ex[k + 1] * inv, ex[k + 2] * inv, ex[k + 3] * inv};
    }
  }
}
typedef float f32x16 __attribute__((ext_vector_type(16)));
typedef float f32x32 __attribute__((ext_vector_type(32)));
typedef unsigned u32x6 __attribute__((ext_vector_type(6)));
__device__ __forceinline__ float gelu_as(float v) {
  const float t = __builtin_amdgcn_rcpf(fabsf(v) * 0.2316418882f + 1.0f);
  float qq = t * 0.5307027145f + (-0.7265760135f); qq = qq * t + 0.7107068705f; qq = qq * t + (-0.142248368f); qq = qq * t + 0.127414796f; qq = qq * t;
  const float m = v * (qq * __builtin_amdgcn_exp2f((v * v) * (-0.72134752044f)));
  return v < 0.f ? m : v - m;
}
__device__ __forceinline__ float half_max(float v) {
#pragma unroll
  for (int o = 16; o > 0; o >>= 1) v = fmaxf(v, __shfl_xor(v, o));
  return v;
}
__device__ __forceinline__ float half_sum(float v) {
#pragma unroll
  for (int o = 16; o > 0; o >>= 1) v += __shfl_xor(v, o);
  return v;
}
__device__ __forceinline__ void ph_cvt_fp6(const float* __restrict__ in, unsigned char* __restrict__ out, float* __restrict__ inv_scale, int vb, int nvb) {
  const int lane = TIDX & 63, wid = TIDX >> 6, hf = lane >> 5, sl = lane & 31;
  for (int rp = vb * 4 + wid; rp < 8192; rp += nvb * 4) {
    const int row = rp * 2 + hf;
    f32x16 a, b2; float am = 0.f;
#pragma unroll
    for (int i = 0; i < 4; ++i) {
      const f32x4 v0 = *(const f32x4*)(in + (size_t)row * DM + sl * 32 + 4 * i), v1 = *(const f32x4*)(in + (size_t)row * DM + sl * 32 + 16 + 4 * i);
#pragma unroll
      for (int e = 0; e < 4; ++e) { a[4 * i + e] = v0[e]; b2[4 * i + e] = v1[e]; am = fmaxf(am, fmaxf(fabsf(v0[e]), fabsf(v1[e]))); }
    }
    am = half_max(am);
    const float sc = am > 0.f ? 7.0f / am : 1.0f;
    const u32x6 pk = __builtin_amdgcn_cvt_scalef32_2xpk16_fp6_f32(a * sc, b2 * sc, 1.0f);
    unsigned char* o = out + (size_t)row * 768 + sl * 24;
    *(u32x2*)(o) = (u32x2){pk[0], pk[1]}; *(u32x2*)(o + 8) = (u32x2){pk[2], pk[3]}; *(u32x2*)(o + 16) = (u32x2){pk[4], pk[5]};
    if (sl == 0) inv_scale[row] = am > 0.f ? am / 7.0f : 1.0f;
  }
}
__device__ __forceinline__ void ph_cvt_fp4(const float* __restrict__ in, unsigned char* __restrict__ out, float* __restrict__ inv_scale, int vb, int nvb) {
  const int lane = TIDX & 63, wid = TIDX >> 6, hf = lane >> 5, sl = lane & 31;
  const f32x2 probe = __builtin_amdgcn_cvt_scalef32_pk_f32_fp4(__builtin_amdgcn_cvt_scalef32_pk_fp4_f32(0u, 1.0f, 2.0f, 1.0f, 0), 1.0f, 0);
  const bool sw = probe.x != 1.0f;
  for (int rp = vb * 4 + wid; rp < 8192; rp += nvb * 4) {
    const int row = rp * 2 + hf;
    f32x4 v[8]; float am = 0.f;
#pragma unroll
    for (int i = 0; i < 8; ++i) {
      v[i] = *(const f32x4*)(in + (size_t)row * DM + sl * 32 + 4 * i);
#pragma unroll
      for (int e = 0; e < 4; ++e) am = fmaxf(am, fabsf(v[i][e]));
    }
    am = half_max(am);
    const float sc = am > 0.f ? 6.0f / am : 1.0f;
    u32x4 pk = (u32x4){0u, 0u, 0u, 0u};
#pragma unroll
    for (int w = 0; w < 4; ++w) {
      unsigned word = 0u;
      float c[8];
#pragma unroll
      for (int e = 0; e < 4; ++e) { c[e] = v[2 * w][e] * sc; c[4 + e] = v[2 * w + 1][e] * sc; }
      word = __builtin_amdgcn_cvt_scalef32_pk_fp4_f32(word, sw ? c[1] : c[0], sw ? c[0] : c[1], 1.0f, 0);
      word = __builtin_amdgcn_cvt_scalef32_pk_fp4_f32(word, sw ? c[3] : c[2], sw ? c[2] : c[3], 1.0f, 1);
      word = __builtin_amdgcn_cvt_scalef32_pk_fp4_f32(word, sw ? c[5] : c[4], sw ? c[4] : c[5], 1.0f, 2);
      word = __builtin_amdgcn_cvt_scalef32_pk_fp4_f32(word, sw ? c[7] : c[6], sw ? c[6] : c[7], 1.0f, 3);
      pk[w] = word;
    }
    *(u32x4*)(out + (size_t)row * 512 + sl * 16) = pk;
    if (sl == 0) inv_scale[row] = am > 0.f ? am / 6.0f : 1.0f;
  }
}
__device__ __forceinline__ u32x6 load_row6(const unsigned char* base, int id, int sl) {
  const unsigned char* q = base + (size_t)id * 768 + sl * 24;
  const u32x2 a = *(const u32x2*)q, b = *(const u32x2*)(q + 8), c = *(const u32x2*)(q + 16);
  return (u32x6){a.x, a.y, b.x, b.y, c.x, c.y};
}
#define GATHER_SMEM (4 * 64 * 33 * 4)
__device__ __forceinline__ void ph_peer_gather(const P& p, int vb, int nvb, unsigned char* smem) {
  int tid_ = TIDX;
  asm volatile("" : "+v"(tid_));
  const int lane = tid_ & 63, wid = tid_ >> 6, hf = lane >> 5, sl = lane & 31;
  float* scr = (float*)smem + (wid * 64 + lane) * 33;
  int* tauL = (int*)(smem + GATHER_SMEM) + wid * 32;
  {
    f32x16 a, b2;
#pragma unroll
    for (int i = 0; i < 16; ++i) { a[i] = __uint_as_float((unsigned)i << 20) * 0x1p126f; b2[i] = __uint_as_float((unsigned)(16 + i) << 20) * 0x1p126f; }
    const f32x32 o = __builtin_amdgcn_cvt_scalef32_pk32_f32_fp6(__builtin_amdgcn_cvt_scalef32_2xpk16_fp6_f32(a, b2, 1.0f), 1.0f);
    if (lane == 0) {
#pragma unroll
      for (int j = 0; j < 32; ++j) tauL[j] = (int)((__float_as_uint(o[j] * 0x1p-126f) >> 20) & 31u);
    }
  }
  const int jmap = 2 * (lane & 1) + ((lane >> 1) & 1);
  __syncthreads();
  int id0, id1; float su0, su1, gs0, gs1; u32x4 xr[4];
  {
    const int m0 = min(vb * 4 + wid, NTOK - 1);
    id0 = p.pidx[(size_t)m0 * 128 + lane]; id1 = p.pidx[(size_t)m0 * 128 + 64 + lane];
#pragma unroll
    for (int c4 = 0; c4 < 4; ++c4) xr[c4] = *(const u32x4*)(p.hx2 + (size_t)m0 * DM + sl * 32 + 8 * c4);
    su0 = p.us[id0]; su1 = p.us[id1];
    gs0 = p.pgate[(size_t)m0 * 128 + lane] * p.vs[id0]; gs1 = p.pgate[(size_t)m0 * 128 + 64 + lane] * p.vs[id1];
  }
  for (int m = vb * 4 + wid; m < NTOK; m += nvb * 4) {
    const float* md = p.mod + (m / SEQ) * 6144;
    f32x2 xp2[16];
#pragma unroll
    for (int c4 = 0; c4 < 4; ++c4)
#pragma unroll
      for (int e = 0; e < 4; ++e) xp2[4 * c4 + e] = (f32x2){bflo(xr[c4][e]), bfhi(xr[c4][e])};
    const int mn = min(m + nvb * 4, NTOK - 1);
    const int nid0 = p.pidx[(size_t)mn * 128 + lane], nid1 = p.pidx[(size_t)mn * 128 + 64 + lane];
    const float ng0 = p.pgate[(size_t)mn * 128 + lane], ng1 = p.pgate[(size_t)mn * 128 + 64 + lane];
#pragma unroll
    for (int c4 = 0; c4 < 4; ++c4) xr[c4] = *(const u32x4*)(p.hx2 + (size_t)mn * DM + sl * 32 + 8 * c4);
    float nsu0 = 0.f, nsu1 = 0.f, nvs0 = 0.f, nvs1 = 0.f;
    f32x2 acc2[16];
#pragma unroll
    for (int k = 0; k < 16; ++k) acc2[k] = (f32x2){0.f, 0.f};
#pragma unroll 1
    for (int e0 = 0; e0 < 128; e0 += 8) {
      if (e0 == 64) { nsu0 = p.us[nid0]; nsu1 = p.us[nid1]; nvs0 = p.vs[nid0]; nvs1 = p.vs[nid1]; }
      u32x4 ur[4], vr[4];
#pragma unroll
      for (int j = 0; j < 4; ++j) {
        const int id = __shfl(e0 < 64 ? id0 : id1, (e0 + hf * 4 + j) & 63);
        ur[j] = *(const u32x4*)(p.ub8 + (size_t)id * 512 + sl * 16);
        vr[j] = *(const u32x4*)(p.vb8 + (size_t)id * 512 + sl * 16);
      }
      float d[4];
#pragma unroll
      for (int j = 0; j < 4; ++j) {
        f32x2 s0 = (f32x2){0.f, 0.f}, s1 = (f32x2){0.f, 0.f};
#pragma unroll
        for (int w = 0; w < 4; ++w) {
          s0 += __builtin_amdgcn_cvt_scalef32_pk_f32_fp4(ur[j][w], 1.0f, 0) * xp2[4 * w + 0];
          s1 += __builtin_amdgcn_cvt_scalef32_pk_f32_fp4(ur[j][w], 1.0f, 1) * xp2[4 * w + 1];
          s0 += __builtin_amdgcn_cvt_scalef32_pk_f32_fp4(ur[j][w], 1.0f, 2) * xp2[4 * w + 2];
          s1 += __builtin_amdgcn_cvt_scalef32_pk_f32_fp4(ur[j][w], 1.0f, 3) * xp2[4 * w + 3];
        }
        d[j] = (s0.x + s0.y) + (s1.x + s1.y);
      }
      float r2[2], r1;
      {
        const bool lo = (lane & 1) == 0;
#pragma unroll
        for (int i = 0; i < 2; ++i) { const float keep = lo ? d[i] : d[i + 2], send = lo ? d[i + 2] : d[i]; r2[i] = keep + __shfl_xor(send, 1); }
        const bool lo2 = (lane & 2) == 0;
        { const float keep = lo2 ? r2[0] : r2[1], send = lo2 ? r2[1] : r2[0]; r1 = keep + __shfl_xor(send, 2); }
        r1 += __shfl_xor(r1, 4); r1 += __shfl_xor(r1, 8); r1 += __shfl_xor(r1, 16);
      }
      const int esrc = (e0 + hf * 4 + jmap) & 63;
      const float su = __shfl(e0 < 64 ? su0 : su1, esrc), gs = __shfl(e0 < 64 ? gs0 : gs1, esrc);
      const float sdot = r1 * su;
      const float cf = gelu_as(sdot) * gs;
#pragma unroll
      for (int j = 0; j < 4; ++j) {
        const float cj = __shfl(cf, (lane & 32) | ((j >> 1) | ((j & 1) << 1)));
        const f32x2 cj2 = (f32x2){cj, cj};
#pragma unroll
        for (int w = 0; w < 4; ++w) {
          acc2[4 * w + 0] += cj2 * __builtin_amdgcn_cvt_scalef32_pk_f32_fp4(vr[j][w], 1.0f, 0);
          acc2[4 * w + 1] += cj2 * __builtin_amdgcn_cvt_scalef32_pk_f32_fp4(vr[j][w], 1.0f, 1);
          acc2[4 * w + 2] += cj2 * __builtin_amdgcn_cvt_scalef32_pk_f32_fp4(vr[j][w], 1.0f, 2);
          acc2[4 * w + 3] += cj2 * __builtin_amdgcn_cvt_scalef32_pk_f32_fp4(vr[j][w], 1.0f, 3);
        }
      }
    }
#pragma unroll
    for (int k = 0; k < 16; ++k) { scr[2 * k] = acc2[k].x + __shfl_xor(acc2[k].x, 32); scr[2 * k + 1] = acc2[k].y + __shfl_xor(acc2[k].y, 32); }
    lds_wave_fence();
    float ss = 0.f;
#pragma unroll
    for (int k = 0; k < 32; ++k) { const float v = scr[k]; ss += v * v; }
    ss = half_sum(ss);
    const float rstd = rsqrtf(ss * (1.0f / 1024.0f) + 1e-6f);
#pragma unroll
    for (int k4 = 0; k4 < 4; ++k4) {
      const int kk = hf * 16 + k4 * 4, col = sl * 32 + kk;
      f32x4 x1 = *(const f32x4*)(p.out + (size_t)m * DM + col);
      const f32x4 g = *(const f32x4*)(p.g_post_ffn + col), gt = *(const f32x4*)(md + 5120 + col);
#pragma unroll
      for (int e = 0; e < 4; ++e) x1[e] += gt[e] * scr[kk + e] * rstd * g[e];
      *(f32x4*)(p.out + (size_t)m * DM + col) = x1;
    }
    lds_wave_fence();
    id0 = nid0; id1 = nid1; su0 = nsu0; su1 = nsu1; gs0 = ng0 * nvs0; gs1 = ng1 * nvs1;
  }
}

#define XB_TMO      128
#define XB_XCNT(j)  (256  + 64 * (j))
#define XB_XSUB(j)  (1280 + 64 * (j))
#define XB_XGEN(j)  (2304 + 64 * (j))
#define XB_TOP      3328
#define XB_TOPGEN   3392
#define XCD_BAR_WORDS 3456
#define XB_SPIN_CAP (1u << 20)
#define LAS __attribute__((address_space(3)))
__device__ __forceinline__ unsigned xb_ld(unsigned* p)              { return __hip_atomic_load(p, __ATOMIC_RELAXED, __HIP_MEMORY_SCOPE_AGENT); }
__device__ __forceinline__ unsigned xb_add(unsigned* p, unsigned v) { return __hip_atomic_fetch_add(p, v, __ATOMIC_RELAXED, __HIP_MEMORY_SCOPE_AGENT); }
__device__ __forceinline__ unsigned xb_xcc_id() { return (unsigned)__builtin_amdgcn_s_getreg((3 << 11) | 20) & 0xFu; }
#define XB_SPIN(cond, bar) do { unsigned _sp = 0; while (cond) { __builtin_amdgcn_s_sleep(1); \
    if ((++_sp & 255u) == 0u) { if (xb_ld(&(bar)[XB_TMO])) break; if (_sp > XB_SPIN_CAP) { atomicAdd(&(bar)[XB_TMO], 1u); break; } } } } while (0)
struct XcdBarrier { unsigned* bar; unsigned x; volatile LAS unsigned* st; };
__device__ __forceinline__ XcdBarrier xcd_barrier_post(unsigned* bar, volatile LAS unsigned* st) {
  XcdBarrier b; b.bar = bar; b.x = xb_xcc_id(); b.st = st;
  if (TIDX == 0) (void)xb_add(&bar[XB_XCNT(b.x)], 1u);
  return b;
}
__device__ __forceinline__ void xcd_barrier_complete(unsigned* bar, unsigned x, unsigned& nloc, unsigned& nx) {
  const unsigned G = gridDim.x * gridDim.y * gridDim.z;
  unsigned sum, cnt, mine, sp = 0u;
  for (;;) {
    sum = 0u; cnt = 0u; mine = 0u;
#pragma unroll
    for (unsigned j = 0; j < 16; ++j) { const unsigned c = xb_ld(&bar[XB_XCNT(j)]); sum += c; cnt += (c > 0u) ? 1u : 0u; mine = (j == x) ? c : mine; }
    if (sum == G) break;
    __builtin_amdgcn_s_sleep(1);
    if ((++sp & 255u) == 0u) { if (xb_ld(&bar[XB_TMO])) break; if (sp > XB_SPIN_CAP) { atomicAdd(&bar[XB_TMO], 1u); break; } }
  }
  nloc = mine > 0u ? mine : 1u; nx = cnt > 0u ? cnt : 1u;
}
__device__ __forceinline__ void xcd_barrier(const XcdBarrier& b) {
  asm volatile("s_waitcnt vmcnt(0)" ::: "memory");
  __syncthreads();
  if (TIDX == 0) {
    unsigned* bar = b.bar;
    __builtin_amdgcn_s_waitcnt(0);
    unsigned nloc = b.st[0], nx = b.st[1];
    if (nloc == 0u) { xcd_barrier_complete(bar, b.x, nloc, nx); b.st[0] = nloc; b.st[1] = nx; }
    const unsigned old = xb_add(&bar[XB_XSUB(b.x)], 1u);
    const unsigned gen = old / nloc;
    if (old + 1u == (gen + 1u) * nloc) {
      __builtin_amdgcn_fence(__ATOMIC_RELEASE, "agent");
      asm volatile("s_waitcnt vmcnt(0)" ::: "memory");
      const unsigned og = xb_add(&bar[XB_TOP], 1u);
      const unsigned tg = og / nx;
      if (og + 1u == (tg + 1u) * nx) xb_add(&bar[XB_TOPGEN], 1u);
      else XB_SPIN(xb_ld(&bar[XB_TOPGEN]) == tg, bar);
      __builtin_amdgcn_fence(__ATOMIC_ACQUIRE, "agent");
      xb_add(&bar[XB_XGEN(b.x)], 1u);
      asm volatile("s_waitcnt vmcnt(0)" ::: "memory");
    } else {
      XB_SPIN(xb_ld(&bar[XB_XGEN(b.x)]) == gen, bar);
      __builtin_amdgcn_fence(__ATOMIC_ACQUIRE, "agent");
      asm volatile("s_waitcnt vmcnt(0)" ::: "memory");
    }
  }
  __syncthreads();
}

#define SMEM_BYTES RWKV_SMEM
__global__ void __launch_bounds__(256, 2) mega(P p) {
  __shared__ __attribute__((aligned(16))) unsigned char smem[SMEM_BYTES + 16];
  cg::grid_group grid = cg::this_grid();
  const int vb = blockIdx.x, nvb = gridDim.x;
  if (TIDX == 0) *(u32x4*)(smem + SMEM_BYTES) = (u32x4){0u, 0u, 0u, 0u};
  __syncthreads();
  const XcdBarrier xb = xcd_barrier_post(p.bar, (volatile LAS unsigned*)(smem + SMEM_BYTES));
  ph_mod(p, vb, nvb, smem);
  ph_colmax(p.w_in, p.colmax, DM, INC, vb, nvb, smem);
  ph_transpose(p.w2, p.w2T, 64, 1024, vb, nvb, smem);
  ph_transpose(p.w2 + 65536, p.w2T + 65536, 64, 1024, vb, nvb, smem);
  ph_transpose(p.a2, p.a2T, 64, 1024, vb, nvb, smem);
  ph_transpose(p.a2 + 65536, p.a2T + 65536, 64, 1024, vb, nvb, smem);
  if (p.bar == nullptr) grid.sync();
  xcd_barrier(xb);
  ph_norm1(p, vb, nvb);
  ph_transpose_i8(p.w_in, p.Wt8, p.colmax, p.wsb, DM, INC, vb, nvb, smem);
  xcd_barrier(xb);
  ph_gemm1(p, vb, nvb, smem);
  xcd_barrier(xb);
  ph_rwkv_A(p, vb, nvb, smem);
  xcd_barrier(xb);
  ph_rwkv_B(p, vb, nvb, smem);
  if (nvb > 128 && vb >= 64) {
    const int v2 = vb - 64, n2 = nvb - 64;
    ph_transpose(p.w_a_out, p.Wt_aout, DM, DM, v2, n2, smem);
    ph_transpose(p.w_o, p.Wt_o, DM, DM, v2, n2, smem);
    ph_transpose(p.peer_wq, p.Wt_q, DM, 2048, v2, n2, smem);
    ph_transpose(p.g2, p.g2T, 128, 1024, v2, n2, smem);
    ph_weff(p, v2, n2);
    ph_convert(p.peer_keys, p.keys, (size_t)16 * 128 * 128, v2, n2);
  } else if (nvb <= 128) {
    ph_transpose(p.w_a_out, p.Wt_aout, DM, DM, vb, nvb, smem);
    ph_transpose(p.w_o, p.Wt_o, DM, DM, vb, nvb, smem);
    ph_transpose(p.peer_wq, p.Wt_q, DM, 2048, vb, nvb, smem);
    ph_transpose(p.g2, p.g2T, 128, 1024, vb, nvb, smem);
    ph_weff(p, vb, nvb);
    ph_convert(p.peer_keys, p.keys, (size_t)16 * 128 * 128, vb, nvb);
  }
  xcd_barrier(xb);
  ph_ycorr(p, vb, nvb);
  ph_sg(p, vb, nvb);
  xcd_barrier(xb);
  ph_readout_gemm(p, vb, nvb, smem);
  ph_pool(p, vb, nvb, smem);
  ph_cvt_fp4(p.peer_u, p.ub8, p.us, vb, nvb);
  ph_cvt_fp4(p.peer_v, p.vb8, p.vs, vb, nvb);
  xcd_barrier(xb);
  ph_gemm_merge(p, vb, nvb, smem);
  xcd_barrier(xb);
  ph_gemm_simple(p.mrg, DM, p.Wt_o, DM, DM, NTOK, DM, p.mix, DM, vb, nvb, smem);
  xcd_barrier(xb);
  ph_res1(p, vb, nvb);
  xcd_barrier(xb);
  ph_gemm_simple(p.hx2, DM, p.Wt_q, DM, DM, NTOK, 2048, p.q, 2048, vb, nvb, smem);
  xcd_barrier(xb);
  ph_peer_s1(p, vb, nvb, smem);
  xcd_barrier(xb);
  ph_peer_s2(p, vb, nvb, smem);
  xcd_barrier(xb);
  ph_peer_gather(p, vb, nvb, smem);
}

extern "C" void kernel_launch(void* const* d_in, const int* in_sizes, int n_in, void* d_out, int out_size, void* d_ws, size_t ws_size, hipStream_t stream) {
  P p{};
  const float** f = (const float**)&p;
  for (int i = 0; i < 32; ++i) f[i] = (const float*)d_in[i];
  p.out = (float*)d_out;
  p.bar = (unsigned*)((unsigned char*)d_ws + 511 * 1048576);
  unsigned char* w = (unsigned char*)d_ws;
  const size_t MiB = 1048576;
  const size_t HM = 524288;
  p.hx = (bf16_t*)(w + 4096);
  p.hx8 = (signed char*)(w + 4096);
  p.hsa = (float*)(w + 40 * MiB) + 4;
  p.colmax = p.bar + XCD_BAR_WORDS;
  p.zA = (bf16_t*)(w + 65 * MiB + 8192);
  p.zP = (bf16_t*)(w + 569 * HM);
  p.zG = (bf16_t*)d_out;
  unsigned char* rw = w + 633 * HM;
  p.Wt_in = (bf16_t*)rw; p.Wt8 = (signed char*)rw; rw += 11 * MiB; p.wsb = (float*)rw; rw += 1 * MiB;
  p.Wt_aout = (bf16_t*)rw; rw += 2 * MiB;
  p.Wt_eff = (bf16_t*)rw; rw += 1 * MiB;
  p.Wt_o = (bf16_t*)rw; rw += 2 * MiB;
  p.Wt_q = (bf16_t*)rw; rw += 4 * MiB;
  p.keys = (bf16_t*)rw; rw += HM;
  p.mod = (float*)rw; rw += HM;
  p.g2T = (bf16_t*)rw; rw += HM;
  p.w2T = (bf16_t*)rw; rw += HM;
  p.a2T = (bf16_t*)rw; rw += HM;
  p.Y0 = (bf16_t*)(w + 0 * MiB);
  p.Y1 = (bf16_t*)(w + 340 * MiB);
  p.bdot = (float*)(w + 404 * MiB);
  p.Mst = (bf16_t*)(w + 408 * MiB);
  p.sg = (bf16_t*)(w + 408 * MiB);
  p.Nst = (float*)(w + 441 * MiB);
  p.ub8 = w + 416 * MiB;
  p.vb8 = w + 432 * MiB;
  p.us = (float*)(w + 448 * MiB);
  p.vs = (float*)(w + 449 * MiB);
  p.pooled = (bf16_t*)(w + 478 * MiB);
  p.out_a = (bf16_t*)(w + 0 * MiB);
  p.ya = (bf16_t*)(w + 65 * MiB);
  p.yb = (bf16_t*)(w + 129 * MiB);
  p.mrg = (bf16_t*)(w + 193 * MiB);
  p.mix = (bf16_t*)(w + 65 * MiB);
  p.hx2 = (bf16_t*)(w + 0 * MiB);
  p.q = (bf16_t*)(w + 129 * MiB);
  p.sv = (float*)(w + 340 * MiB);
  p.si = (int*)(w + 372 * MiB);
  p.pidx = (int*)(w + 257 * MiB);
  p.pgate = (float*)(w + 273 * MiB);
  static int grid_blocks = 0;
  if (!grid_blocks) {
    int dev = 0, cus = 0, per_cu = 0;
    hipGetDevice(&dev);
    hipDeviceGetAttribute(&cus, hipDeviceAttributeMultiprocessorCount, dev);
    hipOccupancyMaxActiveBlocksPerMultiprocessor(&per_cu, mega, 256, 0);
    if (per_cu > 2) per_cu = 2;
    if (per_cu < 1) per_cu = 1;
    grid_blocks = cus * per_cu;
  }
  hipMemsetAsync(p.bar, 0, (XCD_BAR_WORDS + 6016) * 4, stream);
  void* args[] = {&p};
  hipError_t e = hipLaunchCooperativeKernel((void*)mega, dim3(grid_blocks), dim3(256), args, 0, stream);
  if (e != hipSuccess) fprintf(stderr, "cooperative launch failed: %s (grid %d)\n", hipGetErrorString(e), grid_blocks);
}
```

```cpp
#include <hip/hip_runtime.h>
#include <hip/hip_cooperative_groups.h>
#include <stdint.h>
#include <cstdio>
namespace cg = cooperative_groups;

typedef unsigned short bf16_t;
typedef short bf16x8 __attribute__((ext_vector_type(8)));
typedef float f32x4 __attribute__((ext_vector_type(4)));
typedef unsigned u32x4 __attribute__((ext_vector_type(4)));
typedef unsigned u32x2 __attribute__((ext_vector_type(2)));
typedef float f32x2 __attribute__((ext_vector_type(2)));

__device__ __forceinline__ int tid_opaque() { int t = threadIdx.x; asm volatile("" : "+v"(t)); return t; }
#define TIDX tid_opaque()
#define NTOK 32768
#define SEQ 16384
#define CTXL 256
#define NCTX 512
#define MROWS 33280
#define DM 1024
#define SHIFTC 3456
#define INC 6016

typedef __bf16 hwbf2 __attribute__((ext_vector_type(2)));
typedef float hwf2 __attribute__((ext_vector_type(2)));
__device__ __forceinline__ unsigned pack2(float a, float b) { return __builtin_bit_cast(unsigned, __builtin_convertvector((hwf2){a, b}, hwbf2)); }
__device__ __forceinline__ bf16_t f2bf(float f) { return __builtin_bit_cast(unsigned short, (__bf16)f); }
__device__ __forceinline__ float bf2f(bf16_t h) { return __uint_as_float(((unsigned)h) << 16); }
__device__ __forceinline__ float bflo(unsigned u) { return __uint_as_float(u << 16); }
__device__ __forceinline__ float bfhi(unsigned u) { return __uint_as_float(u & 0xffff0000u); }
__device__ __forceinline__ float sigmoidf_(float x) { return __builtin_amdgcn_rcpf(1.0f + __expf(-x)); }

__device__ __forceinline__ void load8(const bf16_t* __restrict__ zA, int row, int col0, float* o) {
  const u32x4 zc = *(const u32x4*)(zA + (size_t)row * SHIFTC + col0);
#pragma unroll
  for (int i = 0; i < 4; ++i) { o[2 * i] = bflo(zc[i]); o[2 * i + 1] = bfhi(zc[i]); }
}
__device__ __forceinline__ float red16(float v) {
  v += __shfl_xor(v, 1); v += __shfl_xor(v, 2); v += __shfl_xor(v, 4); v += __shfl_xor(v, 8);
  return v;
}
__device__ __forceinline__ float red8(float v) {
  v += __shfl_xor(v, 1); v += __shfl_xor(v, 2); v += __shfl_xor(v, 4);
  return v;
}

struct P {
  const float *x, *c, *ctx, *c_ctx, *w_mod, *b_mod, *g_pre_mix, *g_post_mix, *g_pre_ffn, *g_post_ffn, *w_in, *b_gate, *mu_shift,
      *w0, *w2, *a0, *a2, *g2, *k_k, *k_a, *r_k, *ln_x_w, *ln_x_b, *w_a_out, *w_pool, *pool_scale, *w_b_out, *w_o, *peer_wq,
      *peer_keys, *peer_u, *peer_v;
  float* out;
  unsigned* bar;
  bf16_t* hx;
  signed char* hx8;
  float* hsa;
  signed char* Wt8;
  float* wsb;
  unsigned* colmax;
  bf16_t* zA;
  bf16_t* zP;
  bf16_t* zG;
  bf16_t* Wt_in;
  bf16_t* Wt_aout;
  bf16_t* Wt_eff;
  bf16_t* Wt_o;
  bf16_t* Wt_q;
  bf16_t* keys;
  float* mod;
  unsigned char* ub8;
  unsigned char* vb8;
  float* us;
  float* vs;
  bf16_t* sg;
  bf16_t* g2T;
  bf16_t* w2T;
  bf16_t* a2T;
  bf16_t* Mst;
  float* Nst;
  bf16_t* Y0;
  bf16_t* Y1;
  float* bdot;
  bf16_t* out_a;
  bf16_t* ya;
  bf16_t* pooled;
  bf16_t* yb;
  bf16_t* mrg;
  bf16_t* mix;
  bf16_t* hx2;
  bf16_t* q;
  float* sv;
  int* si;
  int* pidx;
  float* pgate;
};

#define GS 72
#define GEMM_SMEM (2 * 128 * GS * 2)
template <class Epi>
__device__ __forceinline__ void gemm_tile(const bf16_t* __restrict__ A, int lda, const bf16_t* __restrict__ Bt, int ldb, int K, int m0, int n0,
                                          const Epi& epi, unsigned char* smem) {
  const int tid = TIDX, lane = tid & 63, wid = tid >> 6, wr = wid >> 1, wc = wid & 1;
  bf16_t* sA = (bf16_t*)smem;
  bf16_t* sB = sA + 128 * GS;
  f32x4 acc[4][4];
#pragma unroll
  for (int i = 0; i < 4; ++i)
#pragma unroll
    for (int j = 0; j < 4; ++j) acc[i][j] = (f32x4){0.f, 0.f, 0.f, 0.f};
  const int lrow = tid >> 3, lcol = (tid & 7) * 8;
  const bf16_t* pa = A + (size_t)(m0 + lrow) * lda + lcol;
  const bf16_t* pb = Bt + (size_t)(n0 + lrow) * ldb + lcol;
  u32x4 ra[4], rb[4];
#pragma unroll
  for (int p = 0; p < 4; ++p) {
    ra[p] = *(const u32x4*)(pa + (size_t)(32 * p) * lda);
    rb[p] = *(const u32x4*)(pb + (size_t)(32 * p) * ldb);
  }
  for (int k0 = 0; k0 < K; k0 += 64) {
#pragma unroll
    for (int p = 0; p < 4; ++p) {
      *(u32x4*)(sA + (lrow + 32 * p) * GS + lcol) = ra[p];
      *(u32x4*)(sB + (lrow + 32 * p) * GS + lcol) = rb[p];
    }
    __syncthreads();
    if (k0 + 64 < K) {
#pragma unroll
      for (int p = 0; p < 4; ++p) {
        ra[p] = *(const u32x4*)(pa + (size_t)(32 * p) * lda + k0 + 64);
        rb[p] = *(const u32x4*)(pb + (size_t)(32 * p) * ldb + k0 + 64);
      }
    }
#pragma unroll
    for (int kk = 0; kk < 2; ++kk) {
      bf16x8 af[4], bfr[4];
#pragma unroll
      for (int i = 0; i < 4; ++i) af[i] = *(const bf16x8*)(sA + (wr * 64 + i * 16 + (lane & 15)) * GS + kk * 32 + (lane >> 4) * 8);
#pragma unroll
      for (int j = 0; j < 4; ++j) bfr[j] = *(const bf16x8*)(sB + (wc * 64 + j * 16 + (lane & 15)) * GS + kk * 32 + (lane >> 4) * 8);
#pragma unroll
      for (int i = 0; i < 4; ++i)
#pragma unroll
        for (int j = 0; j < 4; ++j) acc[i][j] = __builtin_amdgcn_mfma_f32_16x16x32_bf16(bfr[j], af[i], acc[i][j], 0, 0, 0);
    }
    __syncthreads();
  }
#pragma unroll
  for (int i = 0; i < 4; ++i)
#pragma unroll
    for (int j = 0; j < 4; ++j) epi(m0 + wr * 64 + i * 16 + (lane & 15), n0 + wc * 64 + j * 16 + (lane >> 4) * 4, acc[i][j]);
}

#define G3_STAGE 24576
#define G3_ES 136
#define GEMM3_SMEM (256 * G3_ES * 2)
typedef __attribute__((address_space(3))) unsigned lds_u32;
template <class Epi>
__device__ __forceinline__ void gemm_tile3(const bf16_t* __restrict__ A, int lda, const bf16_t* __restrict__ Bt, int ldb, int K, int m0, int n0,
                                           const Epi& epi, unsigned char* smem) {
  int tid = TIDX;
  asm volatile("" : "+v"(tid));
  const int lane = tid & 63, wid = __builtin_amdgcn_readfirstlane(tid >> 6), wr = wid >> 1, wc = wid & 1, l15 = lane & 15, q = lane >> 4;
  f32x4 acc[8][4];
#pragma unroll
  for (int i = 0; i < 8; ++i)
#pragma unroll
    for (int j = 0; j < 4; ++j) acc[i][j] = (f32x4){0.f, 0.f, 0.f, 0.f};
  const int gr = lane >> 2, gc = ((lane & 3) ^ (((gr >> 2) & 1) << 1)) * 8;
  const bf16_t* pa = A + (long)(m0 + wid * 64 + gr) * lda + gc;
  const bf16_t* pb = Bt + (size_t)(n0 + wid * 32 + gr) * ldb + gc;
  unsigned char* dA = smem + wid * 4096 + lane * 16;
  unsigned char* dB = smem + 16384 + wid * 2048 + lane * 16;
  const int sw = (q ^ (((l15 >> 2) & 1) << 1)) * 16;
  const unsigned char* fA = smem + (wr * 128 + l15) * 64 + sw;
  const unsigned char* fB = smem + 16384 + (wc * 64 + l15) * 64 + sw;
#define G3_ISSUE(ST, KT) { _Pragma("unroll") for (int ii = 0; ii < 4; ++ii) __builtin_amdgcn_global_load_lds((const unsigned*)(pa + (size_t)(16 * ii) * lda + (KT) * 32), (lds_u32*)(dA + (ST) * G3_STAGE + ii * 1024), 16, 0, 0); \
                           _Pragma("unroll") for (int ii = 0; ii < 2; ++ii) __builtin_amdgcn_global_load_lds((const unsigned*)(pb + (size_t)(16 * ii) * ldb + (KT) * 32), (lds_u32*)(dB + (ST) * G3_STAGE + ii * 1024), 16, 0, 0); }
  const int nk = K >> 5;
  __syncthreads();
  G3_ISSUE(0, 0);
  for (int kt = 0; kt < nk; ++kt) {
    const int cur = kt & 1;
    asm volatile("s_waitcnt vmcnt(0)" ::: "memory");
    __syncthreads();
    if (kt + 1 < nk) G3_ISSUE(cur ^ 1, kt + 1);
    const unsigned char* cA = fA + cur * G3_STAGE;
    const unsigned char* cB = fB + cur * G3_STAGE;
    bf16x8 bfr[4];
#pragma unroll
    for (int j = 0; j < 4; ++j) bfr[j] = *(const bf16x8*)(cB + j * 1024);
#pragma unroll
    for (int i = 0; i < 8; ++i) {
      const bf16x8 af = *(const bf16x8*)(cA + i * 1024);
#pragma unroll
      for (int j = 0; j < 4; ++j) acc[i][j] = __builtin_amdgcn_mfma_f32_16x16x32_bf16(bfr[j], af, acc[i][j], 0, 0, 0);
    }
  }
#undef G3_ISSUE
  bf16_t* sE = (bf16_t*)smem;
  __syncthreads();
#pragma unroll
  for (int i = 0; i < 8; ++i)
#pragma unroll
    for (int j = 0; j < 4; ++j) {
      u32x2 w; w.x = pack2(acc[i][j][0], acc[i][j][1]); w.y = pack2(acc[i][j][2], acc[i][j][3]);
      *(u32x2*)(sE + (wr * 128 + i * 16 + l15) * G3_ES + wc * 64 + j * 16 + q * 4) = w;
    }
  __syncthreads();
  epi.finish(sE, m0, n0, tid);
}
typedef int i32x4v __attribute__((ext_vector_type(4)));
template <class Epi>
__device__ __forceinline__ void gemm_tile3_i8(const signed char* __restrict__ A, int lda, const signed char* __restrict__ Bt, int ldb, int K, int m0, int n0,
                                              const float* __restrict__ sa, const float* __restrict__ sb, const Epi& epi, unsigned char* smem) {
  int tid = TIDX;
  asm volatile("" : "+v"(tid));
  const int lane = tid & 63, wid = __builtin_amdgcn_readfirstlane(tid >> 6), wr = wid >> 1, wc = wid & 1, l15 = lane & 15, q = lane >> 4;
  i32x4v acc[8][4];
#pragma unroll
  for (int i = 0; i < 8; ++i)
#pragma unroll
    for (int j = 0; j < 4; ++j) acc[i][j] = (i32x4v){0, 0, 0, 0};
  const int gr = lane >> 2, gc = ((lane & 3) ^ (((gr >> 2) & 1) << 1)) * 16;
  const signed char* pa = A + (long)(m0 + wid * 64 + gr) * lda + gc;
  const signed char* pb = Bt + (size_t)(n0 + wid * 32 + gr) * ldb + gc;
  unsigned char* dA = smem + wid * 4096 + lane * 16;
  unsigned char* dB = smem + 16384 + wid * 2048 + lane * 16;
  const int sw = (q ^ (((l15 >> 2) & 1) << 1)) * 16;
  const unsigned char* fA = smem + (wr * 128 + l15) * 64 + sw;
  const unsigned char* fB = smem + 16384 + (wc * 64 + l15) * 64 + sw;
#define G3_ISSUE(ST, KT) { _Pragma("unroll") for (int ii = 0; ii < 4; ++ii) __builtin_amdgcn_global_load_lds((const unsigned*)(pa + (size_t)(16 * ii) * lda + (KT) * 64), (lds_u32*)(dA + (ST) * G3_STAGE + ii * 1024), 16, 0, 0); \
                           _Pragma("unroll") for (int ii = 0; ii < 2; ++ii) __builtin_amdgcn_global_load_lds((const unsigned*)(pb + (size_t)(16 * ii) * ldb + (KT) * 64), (lds_u32*)(dB + (ST) * G3_STAGE + ii * 1024), 16, 0, 0); }
  const int nk = K >> 6;
  __syncthreads();
  G3_ISSUE(0, 0);
  for (int kt = 0; kt < nk; ++kt) {
    const int cur = kt & 1;
    asm volatile("s_waitcnt vmcnt(0)" ::: "memory");
    __syncthreads();
    if (kt + 1 < nk) G3_ISSUE(cur ^ 1, kt + 1);
    const unsigned char* cA = fA + cur * G3_STAGE;
    const unsigned char* cB = fB + cur * G3_STAGE;
    i32x4v bfr[4];
#pragma unroll
    for (int j = 0; j < 4; ++j) bfr[j] = *(const i32x4v*)(cB + j * 1024);
#pragma unroll
    for (int i = 0; i < 8; ++i) {
      const i32x4v af = *(const i32x4v*)(cA + i * 1024);
#pragma unroll
      for (int j = 0; j < 4; ++j) acc[i][j] = __builtin_amdgcn_mfma_i32_16x16x64_i8(bfr[j], af, acc[i][j], 0, 0, 0);
    }
  }
#undef G3_ISSUE
  bf16_t* sE = (bf16_t*)smem;
  f32x4 sb4[4];
#pragma unroll
  for (int j = 0; j < 4; ++j) sb4[j] = *(const f32x4*)(sb + n0 + wc * 64 + j * 16 + q * 4);
  __syncthreads();
#pragma unroll
  for (int i = 0; i < 8; ++i) {
    const float sr = sa[m0 + wr * 128 + i * 16 + l15];
#pragma unroll
    for (int j = 0; j < 4; ++j) {
      u32x2 w;
      w.x = pack2((float)acc[i][j][0] * (sr * sb4[j][0]), (float)acc[i][j][1] * (sr * sb4[j][1]));
      w.y = pack2((float)acc[i][j][2] * (sr * sb4[j][2]), (float)acc[i][j][3] * (sr * sb4[j][3]));
      *(u32x2*)(sE + (wr * 128 + i * 16 + l15) * G3_ES + wc * 64 + j * 16 + q * 4) = w;
    }
  }
  __syncthreads();
  epi.finish(sE, m0, n0, tid);
}
template <class D> struct Epi3RowChunks {
  __device__ __forceinline__ void finish(const bf16_t* sE, int m0, int n0, int tid) const {
#pragma unroll
    for (int pp = 0; pp < 16; ++pp) {
      const int id = tid + 256 * pp, row = id >> 4, cc = (id & 15) * 8;
      static_cast<const D*>(this)->store(m0 + row, n0 + cc, *(const u32x4*)(sE + row * G3_ES + cc));
    }
  }
};
struct Epi3StoreBf16 : Epi3RowChunks<Epi3StoreBf16> {
  bf16_t* C; int ldc;
  __device__ Epi3StoreBf16(bf16_t* c, int l) : C(c), ldc(l) {}
  __device__ __forceinline__ void store(int m, int n, const u32x4& v) const { *(u32x4*)(C + (size_t)m * ldc + n) = v; }
};
struct Epi3GateA : Epi3RowChunks<Epi3GateA> {
  const bf16_t* zG; const float* bg; bf16_t* mrg;
  __device__ Epi3GateA(const bf16_t* z, const float* b, bf16_t* m) : zG(z), bg(b), mrg(m) {}
  __device__ __forceinline__ void store(int m, int n, const u32x4& v) const {
    const u32x4 g = *(const u32x4*)(zG + (size_t)m * 2048 + n);
    const f32x4 b0 = *(const f32x4*)(bg + n), b1 = *(const f32x4*)(bg + n + 4);
    u32x4 o;
#pragma unroll
    for (int i = 0; i < 4; ++i) {
      const float bl = i < 2 ? b0[2 * i] : b1[2 * i - 4], bh = i < 2 ? b0[2 * i + 1] : b1[2 * i - 3];
      o[i] = pack2(sigmoidf_(bflo(g[i]) + bl) * bflo(v[i]), sigmoidf_(bfhi(g[i]) + bh) * bfhi(v[i]));
    }
    *(u32x4*)(mrg + (size_t)m * DM + n) = o;
  }
};
struct Epi3GateB : Epi3RowChunks<Epi3GateB> {
  const bf16_t* zG; const float* bg; bf16_t* mrg;
  __device__ Epi3GateB(const bf16_t* z, const float* b, bf16_t* m) : zG(z), bg(b), mrg(m) {}
  __device__ __forceinline__ void store(int m, int n, const u32x4& v) const {
    const u32x4 g = *(const u32x4*)(zG + (size_t)m * 2048 + 1024 + n);
    const u32x4 a = *(const u32x4*)(mrg + (size_t)m * DM + n);
    const f32x4 b0 = *(const f32x4*)(bg + 1024 + n), b1 = *(const f32x4*)(bg + 1024 + n + 4);
    u32x4 o;
#pragma unroll
    for (int i = 0; i < 4; ++i) {
      const float bl = i < 2 ? b0[2 * i] : b1[2 * i - 4], bh = i < 2 ? b0[2 * i + 1] : b1[2 * i - 3];
      o[i] = pack2(bflo(a[i]) + sigmoidf_(bflo(g[i]) + bl) * bflo(v[i]), bfhi(a[i]) + sigmoidf_(bfhi(g[i]) + bh) * bfhi(v[i]));
    }
    *(u32x4*)(mrg + (size_t)m * DM + n) = o;
  }
};
struct Epi3ZS {
  bf16_t* zA; const float* mu; int own_lo, own_hi, t0, T;
  __device__ __forceinline__ void finish(const bf16_t* sE, int m0, int n0, int tid) const {
#pragma unroll 4
    for (int pq = 0; pq < 16; ++pq) {
      const int id = tid + 256 * pq, row = id >> 4, cc = (id & 15) * 8, t = t0 + row;
      if (row < own_lo || row > own_hi) continue;
      const u32x4 zc = *(const u32x4*)(sE + row * G3_ES + cc);
      u32x4 zp = (u32x4){0u, 0u, 0u, 0u}, zn = (u32x4){0u, 0u, 0u, 0u};
      if (t > 0) zp = *(const u32x4*)(sE + (row - 1) * G3_ES + cc);
      if (t < T - 1) zn = *(const u32x4*)(sE + (row + 1) * G3_ES + cc);
      const f32x4 m0v = *(const f32x4*)(mu + n0 + cc), m1v = *(const f32x4*)(mu + n0 + cc + 4);
      const float mm[8] = {m0v[0], m0v[1], m0v[2], m0v[3], m1v[0], m1v[1], m1v[2], m1v[3]};
      u32x4 o;
#pragma unroll
      for (int i = 0; i < 4; ++i) {
        const float z0 = bflo(zc[i]), z1 = bfhi(zc[i]);
        o[i] = pack2(z0 + mm[2 * i] * (0.5f * (bflo(zp[i]) + bflo(zn[i])) - z0), z1 + mm[2 * i + 1] * (0.5f * (bfhi(zp[i]) + bfhi(zn[i])) - z1));
      }
      *(u32x4*)(zA + (long)(m0 + row) * SHIFTC + n0 + cc) = o;
    }
  }
};
struct Epi3Z : Epi3RowChunks<Epi3Z> {
  bf16_t *zA, *zP, *zG;
  __device__ Epi3Z(bf16_t* a, bf16_t* b, bf16_t* c) : zA(a), zP(b), zG(c) {}
  __device__ __forceinline__ void store(int m, int n, const u32x4& v) const {
    if (n < SHIFTC) *(u32x4*)(zA + (size_t)m * SHIFTC + n) = v;
    else if (m < NTOK) {
      if (n < SHIFTC + 512) *(u32x4*)(zP + (size_t)m * 512 + (n - SHIFTC)) = v;
      else *(u32x4*)(zG + (size_t)m * 2048 + (n - SHIFTC - 512)) = v;
    }
  }
};

struct EpiLds {
  float* S;
  __device__ __forceinline__ void operator()(int m, int n, const f32x4& v) const {
    float* r = S + (m & 127) * 133 + n + (n >> 5);
    r[0] = v[0]; r[1] = v[1]; r[2] = v[2]; r[3] = v[3];
  }
};

__device__ __forceinline__ void ph_transpose(const float* __restrict__ in, bf16_t* __restrict__ out, int K, int N, int vb, int nvb, unsigned char* smem) {
  float* t = (float*)smem;
  const int tk = K / 64, tn = N / 64, tid = TIDX, tx = tid & 15, ty = tid >> 4;
  for (int it = vb; it < tk * tn; it += nvb) {
    const int k0 = (it / tn) * 64, n0 = (it % tn) * 64;
    __syncthreads();
#pragma unroll
    for (int r = 0; r < 4; ++r) {
      const f32x4 v = *(const f32x4*)(in + (size_t)(k0 + ty + 16 * r) * N + n0 + 4 * tx);
#pragma unroll
      for (int e = 0; e < 4; ++e) t[(ty + 16 * r) * 65 + 4 * tx + e] = v[e];
    }
    __syncthreads();
    const int n = tid >> 2, kq = (tid & 3) * 16;
    u32x4 w0, w1;
#pragma unroll
    for (int e = 0; e < 4; ++e) {
      w0[e] = pack2(t[(kq + 2 * e) * 65 + n], t[(kq + 2 * e + 1) * 65 + n]);
      w1[e] = pack2(t[(kq + 8 + 2 * e) * 65 + n], t[(kq + 8 + 2 * e + 1) * 65 + n]);
    }
    *(u32x4*)(out + (size_t)(n0 + n) * K + k0 + kq) = w0;
    *(u32x4*)(out + (size_t)(n0 + n) * K + k0 + kq + 8) = w1;
  }
}
__device__ __forceinline__ void ph_colmax(const float* __restrict__ in, unsigned* __restrict__ colmax, int K, int N, int vb, int nvb, unsigned char* smem) {
  float* red = (float*)smem;
  const int tk = K / 64, tn = N / 64, tid = TIDX, n = tid & 63, kq = tid >> 6;
  for (int it = vb; it < tk * tn; it += nvb) {
    const int k0 = (it / tn) * 64 + kq * 16, n0 = (it % tn) * 64;
    float mx = 0.f;
#pragma unroll
    for (int r = 0; r < 16; ++r) mx = fmaxf(mx, fabsf(in[(size_t)(k0 + r) * N + n0 + n]));
    __syncthreads();
    red[kq * 64 + n] = mx;
    __syncthreads();
    if (kq == 0) atomicMax(colmax + n0 + n, __float_as_uint(fmaxf(fmaxf(red[n], red[64 + n]), fmaxf(red[128 + n], red[192 + n]))));
  }
}
__device__ __forceinline__ void ph_transpose_i8(const float* __restrict__ in, signed char* __restrict__ out, const unsigned* __restrict__ colmax, float* __restrict__ sbv,
                                                int K, int N, int vb, int nvb, unsigned char* smem) {
  float* t = (float*)smem;
  const int tk = K / 64, tn = N / 64, tid = TIDX, tx = tid & 15, ty = tid >> 4;
  for (int it = vb; it < tk * tn; it += nvb) {
    const int k0 = (it / tn) * 64, n0 = (it % tn) * 64;
    __syncthreads();
#pragma unroll
    for (int r = 0; r < 4; ++r) {
      const f32x4 v = *(const f32x4*)(in + (size_t)(k0 + ty + 16 * r) * N + n0 + 4 * tx);
#pragma unroll
      for (int e = 0; e < 4; ++e) t[(ty + 16 * r) * 65 + 4 * tx + e] = v[e];
    }
    __syncthreads();
    const int n = tid >> 2, kq = (tid & 3) * 16;
    const float cmx = __uint_as_float(colmax[n0 + n]);
    const float sc = cmx > 0.f ? 127.0f / cmx : 0.f;
    if (k0 == 0 && kq == 0) sbv[n0 + n] = cmx > 0.f ? cmx / 127.0f : 1.0f;
    u32x4 w;
#pragma unroll
    for (int e = 0; e < 4; ++e) {
      unsigned pk = 0;
#pragma unroll
      for (int b = 0; b < 4; ++b) { const int qv = (int)rintf(t[(kq + 4 * e + b) * 65 + n] * sc); pk |= ((unsigned)qv & 255u) << (8 * b); }
      w[e] = pk;
    }
    *(u32x4*)(out + (size_t)(n0 + n) * K + k0 + kq) = w;
  }
}
__device__ __forceinline__ void ph_convert(const float* __restrict__ in, bf16_t* __restrict__ out, size_t n, int vb, int nvb) {
  for (size_t i = ((size_t)vb * 256 + TIDX) * 4; i < n; i += (size_t)nvb * 1024) {
    const float4 v = *(const float4*)(in + i);
    uint2 w; w.x = pack2(v.x, v.y); w.y = pack2(v.z, v.w);
    *(uint2*)(out + i) = w;
  }
}
__device__ __forceinline__ void ph_weff(const P& p, int vb, int nvb) {
  for (int it = vb * 256 + TIDX; it < 512 * 1024; it += nvb * 256) {
    const int n = it & 1023, k = it >> 10, j = k >> 7, kl = k & 127;
    const float* wp = p.w_pool + ((size_t)j * 128 + kl) * 128;
    float s = 0.f;
    for (int c = 0; c < 128; ++c) s += wp[c] * p.pool_scale[j * 128 + c] * p.w_b_out[(size_t)(j * 128 + c) * 1024 + n];
    p.Wt_eff[(size_t)n * 512 + k] = f2bf(s);
  }
}
__device__ __forceinline__ void ph_mod(const P& p, int vb, int nvb, unsigned char* smem) {
  float* red = (float*)smem;
  const int lane = TIDX & 63, wid = TIDX >> 6;
  for (int it = vb; it < 96; it += nvb) {
    const int n = it * 64 + lane;
    float a0 = 0.f, a1 = 0.f, a2 = 0.f;
#pragma unroll 8
    for (int k = wid * 256; k < wid * 256 + 256; ++k) {
      const float w = p.w_mod[(size_t)k * 6144 + n];
      const float c0 = p.c[k], c1 = p.c[1024 + k], c2 = p.c_ctx[k];
      a0 += c0 * sigmoidf_(c0) * w; a1 += c1 * sigmoidf_(c1) * w; a2 += c2 * sigmoidf_(c2) * w;
    }
    __syncthreads();
    red[(wid * 3 + 0) * 64 + lane] = a0; red[(wid * 3 + 1) * 64 + lane] = a1; red[(wid * 3 + 2) * 64 + lane] = a2;
    __syncthreads();
    if (wid < 3) {
      const float sum = red[(0 * 3 + wid) * 64 + lane] + red[(1 * 3 + wid) * 64 + lane] + red[(2 * 3 + wid) * 64 + lane] + red[(3 * 3 + wid) * 64 + lane];
      p.mod[wid * 6144 + n] = sum + p.b_mod[n];
    }
  }
}
__device__ __forceinline__ float wave_sum(float v) {
#pragma unroll
  for (int o = 32; o > 0; o >>= 1) v += __shfl_xor(v, o);
  return v;
}
__device__ __forceinline__ void ph_norm1(const P& p, int vb, int nvb) {
  const int lane = TIDX & 63, wid = TIDX >> 6, nw = nvb * 4;
  for (int m0 = vb * 4 + wid; m0 < MROWS; m0 += 2 * nw) {
    const int m1 = m0 + nw; const bool has1 = m1 < MROWS; const int mb = has1 ? m1 : m0;
    const float* srcA = m0 < NTOK ? p.x + (size_t)m0 * DM : p.ctx + (size_t)(m0 - NTOK) * DM;
    const float* srcB = mb < NTOK ? p.x + (size_t)mb * DM : p.ctx + (size_t)(mb - NTOK) * DM;
    f32x4 va[4], vbq[4]; float sa = 0.f, sb = 0.f;
#pragma unroll
    for (int i = 0; i < 4; ++i) { va[i] = *(const f32x4*)(srcA + i * 256 + lane * 4); vbq[i] = *(const f32x4*)(srcB + i * 256 + lane * 4); }
#pragma unroll
    for (int i = 0; i < 4; ++i)
#pragma unroll
      for (int e = 0; e < 4; ++e) { sa += va[i][e] * va[i][e]; sb += vbq[i][e] * vbq[i][e]; }
    sa = wave_sum(sa); sb = wave_sum(sb);
#pragma unroll
    for (int rr = 0; rr < 2; ++rr) {
      if (rr == 1 && !has1) break;
      const int m = rr == 0 ? m0 : m1;
      const float rstd = rsqrtf((rr == 0 ? sa : sb) * (1.0f / 1024.0f) + 1e-6f);
      const float* md = p.mod + (m < NTOK ? (m / SEQ) : 2) * 6144;
      f32x4 y[4]; float am = 0.f;
#pragma unroll
      for (int i = 0; i < 4; ++i) {
        const int col = i * 256 + lane * 4;
        const f32x4 v = rr == 0 ? va[i] : vbq[i];
        const f32x4 g = *(const f32x4*)(p.g_pre_mix + col), sh = *(const f32x4*)(md + col), sc = *(const f32x4*)(md + 1024 + col);
#pragma unroll
        for (int e = 0; e < 4; ++e) { y[i][e] = v[e] * rstd * g[e] * (1.f + sc[e]) + sh[e]; am = fmaxf(am, fabsf(y[i][e])); }
      }
#pragma unroll
      for (int o = 32; o > 0; o >>= 1) am = fmaxf(am, __shfl_xor(am, o));
      const float qs = am > 0.f ? 127.0f / am : 0.f;
      if (lane == 0) p.hsa[m] = am > 0.f ? am / 127.0f : 1.0f;
#pragma unroll
      for (int i = 0; i < 4; ++i) {
        unsigned pk = 0;
#pragma unroll
        for (int e = 0; e < 4; ++e) pk |= ((unsigned)(int)rintf(y[i][e] * qs) & 255u) << (8 * e);
        *(unsigned*)(p.hx8 + (size_t)m * DM + i * 256 + lane * 4) = pk;
      }
    }
  }
}
struct Epi3Readout {
  const P* pp;
  __device__ __forceinline__ void finish(const bf16_t* sE, int m0, int n0, int tid) const {
    const P& p = *pp;
#pragma unroll 2
    for (int pq = 0; pq < 16; ++pq) {
      const int id = tid + 256 * pq, row = id >> 4, cc = (id & 15) * 8, m = m0 + row, n = n0 + cc, t = m % SEQ, h = n >> 6;
      const u32x4 g = *(const u32x4*)(sE + row * G3_ES + cc);
      const u32x4 y0 = *(const u32x4*)(p.Y0 + (size_t)m * DM + n);
      float y[8], v[8];
#pragma unroll
      for (int i = 0; i < 4; ++i) { y[2 * i] = bflo(y0[i]); y[2 * i + 1] = bfhi(y0[i]); }
      float sm = 0.f;
#pragma unroll
      for (int i = 0; i < 8; ++i) sm += y[i];
      const float mu = red8(sm) * (1.f / 64.f);
      float qv = 0.f;
#pragma unroll
      for (int i = 0; i < 8; ++i) { y[i] -= mu; qv += y[i] * y[i]; }
      const float rs = rsqrtf(red8(qv) * (1.f / 64.f) + 64e-5f);
      load8(p.zA, m, 2048 + n, v);
      const float bon = 0.5f * (p.bdot[(size_t)m * 16 + h] + p.bdot[((size_t)NTOK + m) * 16 + h]);
      const f32x4 w0 = *(const f32x4*)(p.ln_x_w + n), w1 = *(const f32x4*)(p.ln_x_w + n + 4), b0 = *(const f32x4*)(p.ln_x_b + n), b1 = *(const f32x4*)(p.ln_x_b + n + 4);
      const float lw[8] = {w0[0], w0[1], w0[2], w0[3], w1[0], w1[1], w1[2], w1[3]}, lb[8] = {b0[0], b0[1], b0[2], b0[3], b1[0], b1[1], b1[2], b1[3]};
      u32x4 o;
#pragma unroll
      for (int i = 0; i < 4; ++i)
        o[i] = pack2((y[2 * i] * rs * lw[2 * i] + lb[2 * i] + bon * v[2 * i]) * bflo(g[i]), (y[2 * i + 1] * rs * lw[2 * i + 1] + lb[2 * i + 1] + bon * v[2 * i + 1]) * bfhi(g[i]));
      *(u32x4*)(p.out_a + (size_t)m * DM + n) = o;
    }
  }
};
__device__ __forceinline__ int xcd_tile(int vb, int nvb, int round, int TM, int TN, int& tm, int& tn) {
  if (nvb % 64 != 0) { const int it = round * nvb + vb; if (it >= TM * TN) return 0; tm = it % TM; tn = it / TM; return 1; }
  const int spg = nvb >> 3, g = vb & 7, slot = vb >> 3, SC = spg >> 3;
  const int nsr = (TM + 7) >> 3, nsc = (TN + SC - 1) / SC, st = round * 8 + g;
  if (st >= nsr * nsc) return 0;
  tm = (st % nsr) * 8 + (slot & 7); tn = (st / nsr) * SC + (slot >> 3);
  return (tm < TM && tn < TN) ? 1 : 2;
}
__device__ __forceinline__ void ph_gemm1(const P& p, int vb, int nvb, unsigned char* smem) {
  const int NS_ = 132 * 27, NALL = NS_ + 128 * 20;
  const int per = nvb >> 3;
  for (int round = 0;; ++round) {
    int item;
    if ((nvb & 7) == 0) { const int blk = round * 8 + (vb & 7); if (blk * per >= NALL) break; item = blk * per + (vb >> 3); if (item >= NALL) continue; }
    else { item = round * nvb + vb; if (item >= NALL) break; }
    if (item < NS_) {
      const int cgp = item / (132 * 9), rem = item % (132 * 9), tmS = rem / 9, tn = cgp * 9 + rem % 9;
      Epi3ZS epi;
      epi.zA = p.zA; epi.mu = p.mu_shift;
      int m0;
      if (tmS < 130) { const int b = tmS / 65, i = tmS % 65; m0 = b * SEQ + 254 * i - 1; epi.own_lo = 1; epi.own_hi = min(254, SEQ - 254 * i); epi.t0 = 254 * i - 1; epi.T = SEQ; }
      else { m0 = NTOK + (tmS - 130) * CTXL; epi.own_lo = 0; epi.own_hi = 255; epi.t0 = 0; epi.T = CTXL; }
      gemm_tile3_i8(p.hx8, DM, p.Wt8, DM, DM, m0, tn * 128, p.hsa, p.wsb, epi, smem);
    } else {
      const int i2 = item - NS_;
      int tm, tn;
      if (i2 < 2048) { tm = (i2 & 1023) >> 3; tn = 27 + (i2 >> 10) * 8 + (i2 & 7); } else { tm = (i2 - 2048) >> 2; tn = 43 + (i2 & 3); }
      Epi3Z epi{p.zA, p.zP, p.zG};
      gemm_tile3_i8(p.hx8, DM, p.Wt8, DM, DM, tm * 256, tn * 128, p.hsa, p.wsb, epi, smem);
    }
  }
}
__device__ __forceinline__ void ph_readout_gemm(const P& p, int vb, int nvb, unsigned char* smem) {
  Epi3Readout epi{&p};
  for (int round = 0;; ++round) {
    int tm, tn; const int r = xcd_tile(vb, nvb, round, NTOK / 256, DM / 128, tm, tn);
    if (r == 0) break;
    if (r == 1) gemm_tile3(p.sg, 128, p.g2T, 128, 128, tm * 256, tn * 128, epi, smem);
  }
}
__device__ __forceinline__ void ph_sg(const P& p, int vb, int nvb) {
  for (int it = vb * 256 + TIDX; it < NTOK * 16; it += nvb * 256) {
    const int m = it >> 4, l8 = (it & 15) * 8, t = m % SEQ;
    float o[8];
    load8(p.zA, m, 3328 + l8, o);
    u32x4 w;
#pragma unroll
    for (int i = 0; i < 4; ++i) w[i] = pack2(sigmoidf_(o[2 * i]), sigmoidf_(o[2 * i + 1]));
    *(u32x4*)(p.sg + (size_t)m * 128 + l8) = w;
  }
}
__device__ __forceinline__ void ph_gemm_merge(const P& p, int vb, int nvb, unsigned char* smem) {
  Epi3GateA ea{p.zG, p.b_gate, p.mrg};
  Epi3GateB eb{p.zG, p.b_gate, p.mrg};
  for (int round = 0;; ++round) {
    int tm, tn; const int r = xcd_tile(vb, nvb, round, NTOK / 256, DM / 128, tm, tn);
    if (r == 0) break;
    if (r == 1) {
      gemm_tile3(p.out_a, DM, p.Wt_aout, DM, DM, tm * 256, tn * 128, ea, smem);
      gemm_tile3(p.pooled, 512, p.Wt_eff, 512, 512, tm * 256, tn * 128, eb, smem);
    }
  }
}
__device__ __forceinline__ void ph_gemm_simple(const bf16_t* A, int lda, const bf16_t* Bt, int ldb, int K, int M, int N, bf16_t* C, int ldc, int vb, int nvb, unsigned char* smem) {
  Epi3StoreBf16 epi{C, ldc};
  for (int round = 0;; ++round) {
    int tm, tn; const int r = xcd_tile(vb, nvb, round, M / 256, N / 128, tm, tn);
    if (r == 0) break;
    if (r == 1) gemm_tile3(A, lda, Bt, ldb, K, tm * 256, tn * 128, epi, smem);
  }
}


#define O_R1 0
#define O_R2 10240
#define O_TA (O_R2 + 17408)
#define O_TR (O_TA + 4608)
#define O_TB (O_TR + 4608)
#define O_TK (O_TB + 4608)
#define O_TBT (O_TK + 4608)
#define O_TKT (O_TBT + 5120)
#define O_TVT (O_TKT + 5120)
#define O_GAM (O_TVT + 5120)
#define O_TST (O_GAM + 256)
#define RWKV_SMEM (O_TST + 2 * 9216)
#define NSUP 65
__device__ __forceinline__ void lds_wave_fence() { asm volatile("s_waitcnt lgkmcnt(0)" ::: "memory"); }
__device__ __forceinline__ u32x2 pack4(const f32x4& v) { u32x2 r; r.x = pack2(v[0], v[1]); r.y = pack2(v[2], v[3]); return r; }


typedef short s16x4 __attribute__((ext_vector_type(4)));
__device__ __forceinline__ float fast_tanh(float x) { const float e = __builtin_amdgcn_exp2f(2.885390082f * x); return 1.0f - 2.0f * __builtin_amdgcn_rcpf(e + 1.0f); }
template <int NS, bool WANTY>
__device__ __forceinline__ void rwkv_chunk(const P& p, unsigned char* smem, int d, int h, int rowbase, int T, int isc0, bool has_next, f32x4 (&st)[NS][4], u32x4 (&pf)[5]) {
  int tid = TIDX;
  asm volatile("" : "+v"(tid));
  const int lane = tid & 63, w = __builtin_amdgcn_readfirstlane(tid >> 6), l15 = lane & 15, q = lane >> 4;
  const int tt = tid >> 3, cg = tid & 7, ch0 = h * 64 + cg * 8;
  const int isc = isc0 + tt, t = d == 0 ? isc : T - 1 - isc;
  bf16_t* TWD = (bf16_t*)(smem + O_R1); bf16_t* TAD = TWD + 32 * 72;
  float* WT = (float*)(smem + O_R1);
  bf16_t* XT = (bf16_t*)(smem + O_R1); bf16_t* UT = XT + 64 * 40;
  float* LW = (float*)(smem + O_R2); float* LA = LW + 32 * 68;
  float* TL = (float*)(smem + O_R2);
  bf16_t* TT = (bf16_t*)(smem + O_R2 + 4608); bf16_t* TAK = TT + 32 * 40; bf16_t* TRB = TAK + 32 * 40; bf16_t* TRK = TRB + 32 * 40; bf16_t* TLB = TRK + 32 * 40;
  bf16_t* TA = (bf16_t*)(smem + O_TA); bf16_t* TR = (bf16_t*)(smem + O_TR); bf16_t* TB = (bf16_t*)(smem + O_TB); bf16_t* TK = (bf16_t*)(smem + O_TK);
  bf16_t* TBT = (bf16_t*)(smem + O_TBT); bf16_t* TKT = (bf16_t*)(smem + O_TKT); bf16_t* TVT = (bf16_t*)(smem + O_TVT);
  float* GAM = (float*)(smem + O_GAM);
  bf16_t* TST = (bf16_t*)(smem + O_TST);
  __syncthreads();
  float k8[8], r8[8];
  {
    u32x4 pk;
#pragma unroll
    for (int i = 0; i < 4; ++i) pk[i] = pack2(fast_tanh(bflo(pf[0][i])), fast_tanh(bfhi(pf[0][i])));
    *(u32x4*)(TWD + tt * 72 + cg * 8) = pk;
    *(u32x4*)(TAD + tt * 72 + cg * 8) = pf[1];
  }
#pragma unroll
  for (int i = 0; i < 4; ++i) { k8[2 * i] = bflo(pf[2][i]); k8[2 * i + 1] = bfhi(pf[2][i]); if (WANTY) { r8[2 * i] = bflo(pf[3][i]); r8[2 * i + 1] = bfhi(pf[3][i]); } }
  const u32x4 vzc = pf[4];
  __syncthreads();
  {
    f32x4 lw[2], la[2];
    bf16x8 w2f[2], a2f[2];
#pragma unroll
    for (int ks = 0; ks < 2; ++ks) {
      w2f[ks] = *(const bf16x8*)(p.w2T + ((size_t)d * 1024 + h * 64 + 16 * w + l15) * 64 + 32 * ks + 8 * q);
      a2f[ks] = *(const bf16x8*)(p.a2T + ((size_t)d * 1024 + h * 64 + 16 * w + l15) * 64 + 32 * ks + 8 * q);
    }
#pragma unroll
    for (int it = 0; it < 2; ++it) { lw[it] = (f32x4){0.f, 0.f, 0.f, 0.f}; la[it] = (f32x4){0.f, 0.f, 0.f, 0.f}; }
#pragma unroll
    for (int ks = 0; ks < 2; ++ks)
#pragma unroll
      for (int it = 0; it < 2; ++it) {
        const bf16x8 aw = *(const bf16x8*)(TWD + (16 * it + l15) * 72 + 32 * ks + 8 * q);
        const bf16x8 aa = *(const bf16x8*)(TAD + (16 * it + l15) * 72 + 32 * ks + 8 * q);
        lw[it] = __builtin_amdgcn_mfma_f32_16x16x32_bf16(aw, w2f[ks], lw[it], 0, 0, 0);
        la[it] = __builtin_amdgcn_mfma_f32_16x16x32_bf16(aa, a2f[ks], la[it], 0, 0, 0);
      }
    {
      const float cw0 = p.w0[d * 1024 + h * 64 + 16 * w + l15];
      float tot0 = 0.f;
#pragma unroll
      for (int it = 0; it < 2; ++it) {
        float pr[4];
#pragma unroll
        for (int rg = 0; rg < 4; ++rg) {
          const float e = 0.87505707f * sigmoidf_(cw0 + lw[it][rg]);
          pr[rg] = rg == 0 ? e : pr[rg - 1] + e;
        }
        float x = pr[3];
        float y = __shfl_up(x, 16); if (q >= 1) x += y;
        y = __shfl_up(x, 32); if (q >= 2) x += y;
        const float base = (x - pr[3]) + (it == 1 ? tot0 : 0.f);
        if (it == 0) tot0 = __shfl(x, 48 + l15);
#pragma unroll
        for (int rg = 0; rg < 4; ++rg) lw[it][rg] = pr[rg] + base;
      }
      if (q == 3) GAM[16 * w + l15] = __builtin_amdgcn_exp2f(-lw[1][3]);
    }
#pragma unroll
    for (int it = 0; it < 2; ++it)
#pragma unroll
      for (int rg = 0; rg < 4; ++rg) { LW[(16 * it + 4 * q + rg) * 68 + 16 * w + l15] = lw[it][rg]; LA[(16 * it + 4 * q + rg) * 68 + 16 * w + l15] = la[it][rg]; }
  }
  __syncthreads();
  float icl[8], kkn[8], kd[8];
  {
    float ss = 0.f, bd = 0.f;
    float ca0[8], ckk[8], cka[8], crk[8];
#pragma unroll
    for (int e4 = 0; e4 < 8; e4 += 4) {
      const f32x4 b2 = *(const f32x4*)(p.a0 + d * 1024 + ch0 + e4), c2 = *(const f32x4*)(p.k_k + ch0 + e4);
      const f32x4 d2 = *(const f32x4*)(p.k_a + ch0 + e4), f2 = *(const f32x4*)(p.r_k + ch0 + e4);
#pragma unroll
      for (int e = 0; e < 4; ++e) { ca0[e4 + e] = b2[e]; ckk[e4 + e] = c2[e]; cka[e4 + e] = d2[e]; crk[e4 + e] = f2[e]; }
    }
    float lav[8];
    { const f32x4 l0 = *(const f32x4*)(LA + tt * 68 + cg * 8), l1 = *(const f32x4*)(LA + tt * 68 + cg * 8 + 4);
#pragma unroll
      for (int e = 0; e < 4; ++e) { lav[e] = l0[e]; lav[4 + e] = l1[e]; } }
#pragma unroll
    for (int e = 0; e < 8; ++e) {
      icl[e] = sigmoidf_(ca0[e] + lav[e]);
      kkn[e] = k8[e] * ckk[e]; ss += kkn[e] * kkn[e];
      kd[e] = k8[e] * (1.f + (icl[e] - 1.f) * cka[e]);
      if (WANTY) bd += r8[e] * kd[e] * crk[e];
    }
    ss = red8(ss); if (WANTY) bd = red8(bd);
    const float rn = rsqrtf(fmaxf(ss, 1e-24f));
#pragma unroll
    for (int e = 0; e < 8; ++e) kkn[e] *= rn;
    if (WANTY && cg == 0) p.bdot[((size_t)d * NTOK + rowbase + t) * 16 + h] = bd;
  }
  {
    float ta[8], tr[8], tb[8], tk[8], v8[8];
#pragma unroll
    for (int i = 0; i < 4; ++i) { v8[2 * i] = bflo(vzc[i]); v8[2 * i + 1] = bfhi(vzc[i]); }
    float Lv[8], Lpv[8];
    {
      const f32x4 a0 = *(const f32x4*)(LW + tt * 68 + cg * 8), a1 = *(const f32x4*)(LW + tt * 68 + cg * 8 + 4);
      const int tp = tt > 0 ? tt - 1 : 0;
      const f32x4 b0 = *(const f32x4*)(LW + tp * 68 + cg * 8), b1 = *(const f32x4*)(LW + tp * 68 + cg * 8 + 4);
#pragma unroll
      for (int e = 0; e < 4; ++e) { Lv[e] = a0[e]; Lv[4 + e] = a1[e]; Lpv[e] = tt > 0 ? b0[e] : 0.f; Lpv[4 + e] = tt > 0 ? b1[e] : 0.f; }
    }
#pragma unroll
    for (int e = 0; e < 8; ++e) {
      const float Li = Lv[e];
      const float Lp = Lpv[e];
      const float gi = __builtin_amdgcn_exp2f(-Li), gim1 = __builtin_amdgcn_exp2f(-Lp), ginv = __builtin_amdgcn_exp2f(Li);
      ta[e] = -kkn[e] * gim1; if (WANTY) tr[e] = r8[e] * gi; tb[e] = kkn[e] * icl[e] * ginv; tk[e] = kd[e] * ginv;
    }
    u32x4 pk;
    pk.x = pack2(ta[0], ta[1]); pk.y = pack2(ta[2], ta[3]); pk.z = pack2(ta[4], ta[5]); pk.w = pack2(ta[6], ta[7]); *(u32x4*)(TA + tt * 72 + cg * 8) = pk;
    if (WANTY) { pk.x = pack2(tr[0], tr[1]); pk.y = pack2(tr[2], tr[3]); pk.z = pack2(tr[4], tr[5]); pk.w = pack2(tr[6], tr[7]); *(u32x4*)(TR + tt * 72 + cg * 8) = pk; }
    pk.x = pack2(tb[0], tb[1]); pk.y = pack2(tb[2], tb[3]); pk.z = pack2(tb[4], tb[5]); pk.w = pack2(tb[6], tb[7]); *(u32x4*)(TB + tt * 72 + cg * 8) = pk;
    pk.x = pack2(tk[0], tk[1]); pk.y = pack2(tk[2], tk[3]); pk.z = pack2(tk[4], tk[5]); pk.w = pack2(tk[6], tk[7]); *(u32x4*)(TK + tt * 72 + cg * 8) = pk;
    { const int tts = tt ^ ((cg >> 1) << 3);
#pragma unroll
    for (int e = 0; e < 8; ++e) { TBT[(cg * 8 + e) * 40 + tts] = f2bf(tb[e]); TKT[(cg * 8 + e) * 40 + tts] = f2bf(tk[e]); TVT[(cg * 8 + e) * 40 + tts] = f2bf(v8[e]); } }
  }
  __syncthreads();
  if (WANTY || w < 2) {
    const bf16_t* X = (w < 2) ? TA : TR; const bf16_t* Y = (w & 1) ? TK : TB;
    f32x4 g[2][2];
#pragma unroll
    for (int it = 0; it < 2; ++it)
#pragma unroll
      for (int s2 = 0; s2 < 2; ++s2) g[it][s2] = (f32x4){0.f, 0.f, 0.f, 0.f};
#pragma unroll
    for (int ks = 0; ks < 2; ++ks) {
      bf16x8 xa[2], yb[2];
#pragma unroll
      for (int it = 0; it < 2; ++it) { xa[it] = *(const bf16x8*)(X + (16 * it + l15) * 72 + 32 * ks + 8 * q); yb[it] = *(const bf16x8*)(Y + (16 * it + l15) * 72 + 32 * ks + 8 * q); }
#pragma unroll
      for (int it = 0; it < 2; ++it)
#pragma unroll
        for (int s2 = 0; s2 < 2; ++s2) g[it][s2] = __builtin_amdgcn_mfma_f32_16x16x32_bf16(xa[it], yb[s2], g[it][s2], 0, 0, 0);
    }
    if (w == 0) {
#pragma unroll
      for (int it = 0; it < 2; ++it)
#pragma unroll
        for (int s2 = 0; s2 < 2; ++s2)
#pragma unroll
          for (int rg = 0; rg < 4; ++rg) {
            const int i = 16 * it + 4 * q + rg, s = 16 * s2 + l15;
            TL[i * 36 + s] = (s < i) ? g[it][s2][rg] : 0.f;
          }
#pragma unroll
      for (int rg = 0; rg < 4; ++rg) TLB[(4 * q + rg) * 40 + l15] = f2bf(g[1][0][rg]);
    } else {
      bf16_t* dst = w == 1 ? TAK : (w == 2 ? TRB : TRK);
      const int incl = w == 1 ? 0 : 1;
#pragma unroll
      for (int it = 0; it < 2; ++it)
#pragma unroll
        for (int s2 = 0; s2 < 2; ++s2)
#pragma unroll
          for (int rg = 0; rg < 4; ++rg) {
            const int i = 16 * it + 4 * q + rg, s = 16 * s2 + l15;
            dst[i * 40 + s] = f2bf((s < i + incl) ? g[it][s2][rg] : 0.f);
          }
    }
  }
  if (w == 0) {
    lds_wave_fence();
    const int c = lane & 15, hb = lane & 16;
    float Tr[16];
    f32x4 Lr[16][4];
#pragma unroll
    for (int i = 1; i < 16; ++i)
#pragma unroll
      for (int j4 = 0; j4 < (i + 3) / 4; ++j4) Lr[i][j4] = *(const f32x4*)(TL + (hb + i) * 36 + hb + 4 * j4);
#pragma unroll
    for (int i = 0; i < 16; ++i) {
      float acc = (i == c) ? 1.f : 0.f;
#pragma unroll
      for (int j = 0; j < i; ++j) acc += Lr[i][j >> 2][j & 3] * Tr[j];
      Tr[i] = acc;
    }
    if (lane < 32) {
#pragma unroll
      for (int i = 0; i < 16; ++i) TT[(hb + i) * 40 + hb + c] = f2bf(Tr[i]);
    }
  }
  __syncthreads();
  if (has_next) {
    const int isn = isc + 32, tn = d == 0 ? isn : T - 1 - isn;
    const bf16_t* zr = p.zA + (size_t)(rowbase + tn) * SHIFTC;
    pf[0] = *(const u32x4*)(zr + 3072 + d * 64 + cg * 8);
    pf[1] = *(const u32x4*)(zr + 3200 + d * 64 + cg * 8);
    pf[2] = *(const u32x4*)(zr + 1024 + ch0);
    if (WANTY) pf[3] = *(const u32x4*)(zr + ch0);
    pf[4] = *(const u32x4*)(zr + 2048 + ch0);
  }
  bf16_t yprev[2][4];
  if (WANTY) {
#pragma unroll
    for (int it = 0; it < 2; ++it)
#pragma unroll
      for (int rg = 0; rg < 4; ++rg) {
        yprev[it][rg] = 0;
        if (d == 1) yprev[it][rg] = p.Y0[(size_t)(rowbase + T - 1 - (isc0 + 16 * it + 4 * q + rg)) * DM + h * 64 + 16 * w + l15];
      }
  }
  const bf16x8 vfr = *(const bf16x8*)(TVT + (16 * w + l15) * 40 + 8 * (q ^ w));
  const s16x4 t1f = *(const s16x4*)(TT + l15 * 40 + 4 * q), t2f = *(const s16x4*)(TT + (16 + l15) * 40 + 16 + 4 * q), l21f = *(const s16x4*)(TLB + l15 * 40 + 4 * q);
  bf16_t* XTw = XT + (16 * w + l15) * 40; bf16_t* UTw = UT + (16 * w + l15) * 40;
#pragma unroll
  for (int si = 0; si < NS; ++si) {
    const bool useV = (NS == 1) || (si == 1);
    const bf16_t* STs = TST + (si * 64 + 16 * w + l15) * 72;
    bf16x8 sf[2];
    sf[0] = *(const bf16x8*)(STs + 8 * q); sf[1] = *(const bf16x8*)(STs + 32 + 8 * q);
    f32x4 xa[2];
#pragma unroll
    for (int it = 0; it < 2; ++it) {
      xa[it] = (f32x4){0.f, 0.f, 0.f, 0.f};
#pragma unroll
      for (int ks = 0; ks < 2; ++ks) xa[it] = __builtin_amdgcn_mfma_f32_16x16x32_bf16(*(const bf16x8*)(TA + (16 * it + l15) * 72 + 32 * ks + 8 * q), sf[ks], xa[it], 0, 0, 0);
      if (useV) xa[it] = __builtin_amdgcn_mfma_f32_16x16x32_bf16(*(const bf16x8*)(TAK + (16 * it + l15) * 40 + 8 * q), vfr, xa[it], 0, 0, 0);
    }
    *(u32x2*)(XTw + 4 * q) = pack4(xa[0]);
    lds_wave_fence();
    f32x4 ua = __builtin_amdgcn_mfma_f32_16x16x16bf16_1k(t1f, *(const s16x4*)(XTw + 4 * q), (f32x4){0.f, 0.f, 0.f, 0.f}, 0, 0, 0);
    *(u32x2*)(UTw + 4 * q) = pack4(ua);
    lds_wave_fence();
    xa[1] = __builtin_amdgcn_mfma_f32_16x16x16bf16_1k(l21f, *(const s16x4*)(UTw + 4 * q), xa[1], 0, 0, 0);
    *(u32x2*)(XTw + 16 + 4 * q) = pack4(xa[1]);
    lds_wave_fence();
    ua = __builtin_amdgcn_mfma_f32_16x16x16bf16_1k(t2f, *(const s16x4*)(XTw + 16 + 4 * q), (f32x4){0.f, 0.f, 0.f, 0.f}, 0, 0, 0);
    *(u32x2*)(UTw + 16 + 4 * q) = pack4(ua);
    lds_wave_fence();
    const bf16x8 uf = *(const bf16x8*)(UTw + 8 * q);
    if (WANTY) {
#pragma unroll
      for (int it = 0; it < 2; ++it) {
        f32x4 ya = (f32x4){0.f, 0.f, 0.f, 0.f};
#pragma unroll
        for (int ks = 0; ks < 2; ++ks) ya = __builtin_amdgcn_mfma_f32_16x16x32_bf16(*(const bf16x8*)(TR + (16 * it + l15) * 72 + 32 * ks + 8 * q), sf[ks], ya, 0, 0, 0);
        ya = __builtin_amdgcn_mfma_f32_16x16x32_bf16(*(const bf16x8*)(TRB + (16 * it + l15) * 40 + 8 * q), uf, ya, 0, 0, 0);
        if (useV) ya = __builtin_amdgcn_mfma_f32_16x16x32_bf16(*(const bf16x8*)(TRK + (16 * it + l15) * 40 + 8 * q), vfr, ya, 0, 0, 0);
#pragma unroll
        for (int rg = 0; rg < 4; ++rg) {
          const int iq = isc0 + 16 * it + 4 * q + rg, tq = d == 0 ? iq : T - 1 - iq;
          if (useV) {
            p.Y0[(size_t)(rowbase + tq) * DM + h * 64 + 16 * w + l15] = f2bf(ya[rg] + bf2f(yprev[it][rg]));
          } else {
            bf16_t* pp = d == 0 ? p.Y1 + (size_t)(rowbase + tq) * DM : p.zA + (size_t)(rowbase + tq) * SHIFTC;
            pp[h * 64 + 16 * w + l15] = f2bf(ya[rg]);
          }
        }
      }
    }
#pragma unroll
    for (int kt = 0; kt < 4; ++kt) {
      f32x4 hv = st[si][kt];
      hv = __builtin_amdgcn_mfma_f32_16x16x32_bf16(*(const bf16x8*)(TBT + (16 * kt + l15) * 40 + 8 * (q ^ kt)), uf, hv, 0, 0, 0);
      if (useV) hv = __builtin_amdgcn_mfma_f32_16x16x32_bf16(*(const bf16x8*)(TKT + (16 * kt + l15) * 40 + 8 * (q ^ kt)), vfr, hv, 0, 0, 0);
      hv *= *(const f32x4*)(GAM + 16 * kt + 4 * q);
      st[si][kt] = hv;
      *(u32x2*)(TST + (si * 64 + 16 * w + l15) * 72 + 16 * kt + 4 * q) = pack4(hv);
    }
  }
}

template <bool WANTY>
__device__ __forceinline__ void rwkv_prefetch_first(const P& p, int d, int h, int rowbase, int T, int isc0, u32x4 (&pf)[5]) {
  const int tid = TIDX, tt = tid >> 3, cg = tid & 7, ch0 = h * 64 + cg * 8, isc = isc0 + tt, t = d == 0 ? isc : T - 1 - isc;
  const bf16_t* zr = p.zA + (size_t)(rowbase + t) * SHIFTC;
  pf[0] = *(const u32x4*)(zr + 3072 + d * 64 + cg * 8);
  pf[1] = *(const u32x4*)(zr + 3200 + d * 64 + cg * 8);
  pf[2] = *(const u32x4*)(zr + 1024 + ch0);
  pf[3] = WANTY ? *(const u32x4*)(zr + ch0) : (u32x4){0u, 0u, 0u, 0u};
  pf[4] = *(const u32x4*)(zr + 2048 + ch0);
}
template <bool LAT>
__device__ __forceinline__ void rwkv_super(const P& p, unsigned char* smem, int chain, int j) {
  const int tid = TIDX, lane = tid & 63, w = tid >> 6, l15 = lane & 15, q = lane >> 4;
  bf16_t* TST = (bf16_t*)(smem + O_TST);
  const int b = chain >> 5, d = (chain >> 4) & 1, h = chain & 15;
  const int T = LAT ? SEQ : CTXL, rowbase = LAT ? b * SEQ : NTOK + b * CTXL, base = LAT ? (j - 1) * 256 : 0;
  f32x4 st[2][4];
  __syncthreads();
#pragma unroll
  for (int kt = 0; kt < 4; ++kt) {
#pragma unroll
    for (int rg = 0; rg < 4; ++rg) st[0][kt][rg] = (16 * kt + 4 * q + rg == 16 * w + l15) ? 1.f : 0.f;
    st[1][kt] = (f32x4){0.f, 0.f, 0.f, 0.f};
    *(u32x2*)(TST + (16 * w + l15) * 72 + 16 * kt + 4 * q) = pack4(st[0][kt]);
    *(u32x2*)(TST + (64 + 16 * w + l15) * 72 + 16 * kt + 4 * q) = pack4(st[1][kt]);
  }
  u32x4 pf[5]; rwkv_prefetch_first<LAT>(p, d, h, rowbase, T, base, pf);
  for (int c = 0; c < 8; ++c) rwkv_chunk<2, LAT>(p, smem, d, h, rowbase, T, base + 32 * c, c < 7, st, pf);
  if (j < 64) {
    const size_t slot = (size_t)chain * NSUP + j;
#pragma unroll
    for (int kt = 0; kt < 4; ++kt) {
#pragma unroll
      for (int rg = 0; rg < 4; ++rg) p.Mst[(slot * 64 + 16 * kt + 4 * q + rg) * 64 + 16 * w + l15] = f2bf(st[0][kt][rg]);
      *(f32x4*)(p.Nst + (slot * 64 + 16 * w + l15) * 64 + 16 * kt + 4 * q) = st[1][kt];
    }
  }
}
__device__ __forceinline__ void ph_rwkv_A(const P& p, int vb, int nvb, unsigned char* smem) {
  for (int chain = vb; chain < 64; chain += nvb) rwkv_super<false>(p, smem, chain, 0);
  for (int item = vb; item < 2048; item += nvb) {
    const int b = item >> 10, J = (item >> 4) & 63, h = item & 15;
#pragma unroll 1
    for (int d = 0; d < 2; ++d) {
      rwkv_super<true>(p, smem, b * 32 + d * 16 + h, d == 0 ? J + 1 : 64 - J);
      asm volatile("s_waitcnt vmcnt(0)" ::: "memory");
      __syncthreads();
    }
  }
}
__device__ __forceinline__ void ph_rwkv_B(const P& p, int vb, int nvb, unsigned char* smem) {
  const int tid = TIDX, lane = tid & 63, w = tid >> 6, l15 = lane & 15, q = lane >> 4;
  bf16_t* HT = (bf16_t*)smem;
  for (int chain = vb; chain < 64; chain += nvb) {
    f32x4 hs[4];
#pragma unroll
    for (int kt = 0; kt < 4; ++kt) hs[kt] = (f32x4){0.f, 0.f, 0.f, 0.f};
    __syncthreads();
    for (int j = 0; j < 64; ++j) {
      const size_t slot = (size_t)chain * NSUP + j;
      f32x4 nv[4];
#pragma unroll
      for (int kt = 0; kt < 4; ++kt) nv[kt] = *(const f32x4*)(p.Nst + (slot * 64 + 16 * w + l15) * 64 + 16 * kt + 4 * q);
      bf16x8 mf[4][2];
#pragma unroll
      for (int kt = 0; kt < 4; ++kt)
#pragma unroll
        for (int ks = 0; ks < 2; ++ks) mf[kt][ks] = *(const bf16x8*)(p.Mst + (slot * 64 + 16 * kt + l15) * 64 + 32 * ks + 8 * q);
#pragma unroll
      for (int kt = 0; kt < 4; ++kt) {
        *(f32x4*)(p.Nst + (slot * 64 + 16 * w + l15) * 64 + 16 * kt + 4 * q) = hs[kt];
        *(u32x2*)(HT + (16 * w + l15) * 72 + 16 * kt + 4 * q) = pack4(hs[kt]);
      }
      lds_wave_fence();
      bf16x8 hf[2];
      hf[0] = *(const bf16x8*)(HT + (16 * w + l15) * 72 + 8 * q); hf[1] = *(const bf16x8*)(HT + (16 * w + l15) * 72 + 32 + 8 * q);
      lds_wave_fence();
#pragma unroll
      for (int kt = 0; kt < 4; ++kt) {
        f32x4 a = nv[kt];
#pragma unroll
        for (int ks = 0; ks < 2; ++ks) a = __builtin_amdgcn_mfma_f32_16x16x32_bf16(mf[kt][ks], hf[ks], a, 0, 0, 0);
        hs[kt] = a;
      }
    }
    const size_t slot = (size_t)chain * NSUP + 64;
#pragma unroll
    for (int kt = 0; kt < 4; ++kt) *(f32x4*)(p.Nst + (slot * 64 + 16 * w + l15) * 64 + 16 * kt + 4 * q) = hs[kt];
  }
}
__device__ __forceinline__ void ph_ycorr(const P& p, int vb, int nvb) {
  const int tid = TIDX, lane = tid & 63, w = tid >> 6, l15 = lane & 15, q = lane >> 4;
  for (int item = vb; item < 2048; item += nvb) {
    const int b = item >> 10, J = (item >> 4) & 63, h = item & 15;
    const size_t tok0 = (size_t)b * SEQ + J * 256 + 64 * w;
    bf16x8 hf[4][4];
#pragma unroll
    for (int kk = 0; kk < 4; ++kk) {
      const size_t slot = kk < 2 ? (size_t)(b * 32 + h) * NSUP + (J + 1) : (size_t)(b * 32 + 16 + h) * NSUP + (64 - J);
#pragma unroll
      for (int nt = 0; nt < 4; ++nt) {
        const float* src = p.Nst + (slot * 64 + 16 * nt + l15) * 64 + 32 * (kk & 1) + 8 * q;
        const f32x4 a = *(const f32x4*)src, c = *(const f32x4*)(src + 4);
        const u32x4 pk = (u32x4){pack2(a[0], a[1]), pack2(a[2], a[3]), pack2(c[0], c[1]), pack2(c[2], c[3])};
        hf[kk][nt] = __builtin_bit_cast(bf16x8, pk);
      }
    }
#pragma unroll 1
    for (int mt = 0; mt < 4; ++mt) {
      const size_t tok = tok0 + 16 * mt + l15;
      bf16x8 pa[4];
#pragma unroll
      for (int kk = 0; kk < 2; ++kk) {
        pa[kk] = *(const bf16x8*)(p.Y1 + tok * DM + h * 64 + 32 * kk + 8 * q);
        pa[2 + kk] = *(const bf16x8*)(p.zA + tok * SHIFTC + h * 64 + 32 * kk + 8 * q);
      }
      u32x2 yo[4];
#pragma unroll
      for (int nt = 0; nt < 4; ++nt) yo[nt] = *(const u32x2*)(p.Y0 + tok * DM + h * 64 + 16 * nt + 4 * q);
#pragma unroll
      for (int nt = 0; nt < 4; ++nt) {
        f32x4 acc = (f32x4){bflo(yo[nt].x), bfhi(yo[nt].x), bflo(yo[nt].y), bfhi(yo[nt].y)};
#pragma unroll
        for (int kk = 0; kk < 4; ++kk) acc = __builtin_amdgcn_mfma_f32_16x16x32_bf16(hf[kk][nt], pa[kk], acc, 0, 0, 0);
        *(u32x2*)(p.Y0 + tok * DM + h * 64 + 16 * nt + 4 * q) = pack4(acc);
      }
    }
  }
}

#define POOL_SMEM (64 * 128 * 4)
__device__ __forceinline__ void ph_pool(const P& p, int vb, int nvb, unsigned char* smem) {
  float* V = (float*)smem;
  const int tid = TIDX, cp = tid & 63, cq = tid >> 6;
  for (int item = vb; item < 2 * 4 * 64; item += nvb) {
    const int j = item & 3, st = (item >> 2) & 63, b = item >> 8;
    const int win = 2 << j, half = win >> 1;
    const bf16_t* zb = p.zP + (size_t)b * SEQ * 512 + j * 128 + cp * 2;
    float a0[16], a1[16];
#pragma unroll
    for (int i = 0; i < 16; ++i) { a0[i] = 0.f; a1[i] = 0.f; }
    {
      const int r = 4 * st, r0 = max(r - half, 0), r1 = min(r + half, 256);
      for (int rr = r0; rr < r1; ++rr) {
#pragma unroll
        for (int i = 0; i < 16; ++i) { const unsigned u = *(const unsigned*)(zb + (size_t)(rr * 64 + cq * 16 + i) * 512); a0[i] += bflo(u); a1[i] += bfhi(u); }
      }
    }
    for (int dr = 0; dr < 4; ++dr) {
      const int r = 4 * st + dr, r0 = max(r - half, 0), r1 = min(r + half, 256);
      if (dr > 0) {
        const int radd = r + half - 1, rsub = r - half - 1;
        if (radd < 256) {
#pragma unroll
          for (int i = 0; i < 16; ++i) { const unsigned u = *(const unsigned*)(zb + (size_t)(radd * 64 + cq * 16 + i) * 512); a0[i] += bflo(u); a1[i] += bfhi(u); }
        }
        if (rsub >= 0) {
#pragma unroll
          for (int i = 0; i < 16; ++i) { const unsigned u = *(const unsigned*)(zb + (size_t)(rsub * 64 + cq * 16 + i) * 512); a0[i] -= bflo(u); a1[i] -= bfhi(u); }
        }
      }
      __syncthreads();
#pragma unroll
      for (int i = 0; i < 16; ++i) *(f32x2*)(V + (cq * 16 + i) * 128 + cp * 2) = (f32x2){a0[i], a1[i]};
      __syncthreads();
      float s0 = 0.f, s1 = 0.f;
      {
        const int c = cq * 16, c0 = max(c - half, 0), c1 = min(c + half, 64);
        for (int cc = c0; cc < c1; ++cc) { const f32x2 v = *(const f32x2*)(V + cc * 128 + cp * 2); s0 += v.x; s1 += v.y; }
      }
#pragma unroll
      for (int i = 0; i < 16; ++i) {
        const int c = cq * 16 + i, c0 = max(c - half, 0), c1 = min(c + half, 64);
        if (i > 0) {
          const int cadd = c + half - 1, csub = c - half - 1;
          if (cadd < 64) { const f32x2 v = *(const f32x2*)(V + cadd * 128 + cp * 2); s0 += v.x; s1 += v.y; }
          if (csub >= 0) { const f32x2 v = *(const f32x2*)(V + csub * 128 + cp * 2); s0 -= v.x; s1 -= v.y; }
        }
        const float inv = __builtin_amdgcn_rcpf((float)((r1 - r0) * (c1 - c0)));
        const size_t tokoff = ((size_t)b * SEQ + r * 64 + c) * 512 + j * 128 + cp * 2;
        const unsigned u = *(const unsigned*)(p.zP + tokoff);
        *(unsigned*)(p.pooled + tokoff) = pack2(s0 * inv - bflo(u), s1 * inv - bfhi(u));
      }
    }
  }
}
__device__ __forceinline__ void ph_res1(const P& p, int vb, int nvb) {
  const int lane = TIDX & 63, wid = TIDX >> 6;
  for (int m = vb * 4 + wid; m < NTOK; m += nvb * 4) {
    const float* md = p.mod + (m / SEQ) * 6144;
    float mx[16]; float ss = 0.f;
#pragma unroll
    for (int i = 0; i < 4; ++i) {
      const uint2 u = *(const uint2*)(p.mix + (size_t)m * DM + i * 256 + lane * 4);
      mx[4 * i] = bflo(u.x); mx[4 * i + 1] = bfhi(u.x); mx[4 * i + 2] = bflo(u.y); mx[4 * i + 3] = bfhi(u.y);
#pragma unroll
      for (int e = 0; e < 4; ++e) ss += mx[4 * i + e] * mx[4 * i + e];
    }
    ss = wave_sum(ss);
    const float rstd = rsqrtf(ss * (1.0f / 1024.0f) + 1e-6f);
    float x1[16]; float s2 = 0.f;
#pragma unroll
    for (int i = 0; i < 4; ++i) {
      const int col = i * 256 + lane * 4;
      const float4 xv = *(const float4*)(p.x + (size_t)m * DM + col), g = *(const float4*)(p.g_post_mix + col), gt = *(const float4*)(md + 2048 + col);
      x1[4 * i] = xv.x + gt.x * mx[4 * i] * rstd * g.x; x1[4 * i + 1] = xv.y + gt.y * mx[4 * i + 1] * rstd * g.y;
      x1[4 * i + 2] = xv.z + gt.z * mx[4 * i + 2] * rstd * g.z; x1[4 * i + 3] = xv.w + gt.w * mx[4 * i + 3] * rstd * g.w;
      *(float4*)(p.out + (size_t)m * DM + col) = make_float4(x1[4 * i], x1[4 * i + 1], x1[4 * i + 2], x1[4 * i + 3]);
#pragma unroll
      for (int e = 0; e < 4; ++e) s2 += x1[4 * i + e] * x1[4 * i + e];
    }
    s2 = wave_sum(s2);
    const float r2 = rsqrtf(s2 * (1.0f / 1024.0f) + 1e-6f);
#pragma unroll
    for (int i = 0; i < 4; ++i) {
      const int col = i * 256 + lane * 4;
      const float4 g = *(const float4*)(p.g_pre_ffn + col), sh = *(const float4*)(md + 3072 + col), sc = *(const float4*)(md + 4096 + col);
      uint2 w;
      w.x = pack2(x1[4 * i] * r2 * g.x * (1.f + sc.x) + sh.x, x1[4 * i + 1] * r2 * g.y * (1.f + sc.y) + sh.y);
      w.y = pack2(x1[4 * i + 2] * r2 * g.z * (1.f + sc.z) + sh.z, x1[4 * i + 3] * r2 * g.w * (1.f + sc.w) + sh.w);
      *(uint2*)(p.hx2 + (size_t)m * DM + col) = w;
    }
  }
}

#define PS1_SMEM (128 * 133 * 4)
#define CE_DESC(a, b) { const float _mx = fmaxf(a, b), _mn = fminf(a, b); a = _mx; b = _mn; }
template <int N> __device__ __forceinline__ void bitonic_sort_desc(float (&v)[N]) {
#pragma unroll
  for (int k = 2; k <= N; k <<= 1)
#pragma unroll
    for (int j = k >> 1; j > 0; j >>= 1)
#pragma unroll
      for (int i = 0; i < N; ++i) { const int l = i ^ j; if (l > i) { if ((i & k) == 0) CE_DESC(v[i], v[l]) else CE_DESC(v[l], v[i]) } }
}
__device__ __forceinline__ void bitonic_merge16_desc(float (&v)[16]) {
#pragma unroll
  for (int j = 8; j > 0; j >>= 1)
#pragma unroll
    for (int i = 0; i < 16; ++i) { const int l = i ^ j; if (l > i) CE_DESC(v[i], v[l]) }
}
__device__ __forceinline__ void ph_peer_s1(const P& p, int vb, int nvb, unsigned char* smem) {
  float* S = (float*)smem;
  EpiLds epi{S};
  const int tid = TIDX, sub = tid & 3;
  for (int item = vb; item < 256 * 16; item += nvb) {
    const int hp = item & 15, tm = item >> 4;
    __syncthreads();
    gemm_tile(p.q + hp * 128, 2048, p.keys + (size_t)hp * 128 * 128, 128, 128, tm * 128, 0, epi, smem);
    __syncthreads();
#pragma unroll 1
    for (int pass = 0; pass < 2; ++pass) {
      const int row = pass * 64 + (tid >> 2);
      float a[16], b[16];
#pragma unroll
      for (int i = 0; i < 16; ++i) {
        a[i] = __uint_as_float((__float_as_uint(S[row * 133 + sub * 33 + i]) & ~127u) | (unsigned)(sub * 32 + i));
        b[i] = __uint_as_float((__float_as_uint(S[row * 133 + sub * 33 + 16 + i]) & ~127u) | (unsigned)(sub * 32 + 16 + i));
      }
      bitonic_sort_desc<16>(a); bitonic_sort_desc<16>(b);
#pragma unroll
      for (int i = 0; i < 16; ++i) a[i] = fmaxf(a[i], b[15 - i]);
      bitonic_merge16_desc(a);
#pragma unroll
      for (int lvl = 1; lvl <= 2; lvl <<= 1) {
#pragma unroll
        for (int i = 0; i < 16; ++i) b[i] = __shfl_xor(a[i], lvl);
#pragma unroll
        for (int i = 0; i < 16; ++i) a[i] = fmaxf(a[i], b[15 - i]);
        bitonic_merge16_desc(a);
      }
      if (sub == 0) {
        const size_t ob = ((size_t)(tm * 128 + row) * 16 + hp) * 16;
#pragma unroll
        for (int i = 0; i < 16; i += 4) {
          *(f32x4*)(p.sv + ob + i) = (f32x4){a[i], a[i + 1], a[i + 2], a[i + 3]};
          typedef int i32x4 __attribute__((ext_vector_type(4)));
          *(i32x4*)(p.si + ob + i) = (i32x4){(int)(__float_as_uint(a[i]) & 127u), (int)(__float_as_uint(a[i + 1]) & 127u), (int)(__float_as_uint(a[i + 2]) & 127u), (int)(__float_as_uint(a[i + 3]) & 127u)};
        }
      }
    }
  }
}
__device__ __forceinline__ void top16_merge(float (&x)[16], const float (&y)[16]) {
#pragma unroll
  for (int i = 0; i < 16; ++i) x[i] = fmaxf(x[i], y[15 - i]);
  bitonic_merge16_desc(x);
}
__device__ __forceinline__ void ph_peer_s2(const P& p, int vb, int nvb, unsigned char* smem) {
  unsigned char* lut = smem;
  __syncthreads();
  if (TIDX == 0) {
    int n = 0;
#pragma unroll
    for (int i = 0; i < 16; ++i)
#pragma unroll
      for (int j = 0; j < 16; ++j)
        if ((i + 1) * (j + 1) <= 16) { lut[n] = (unsigned char)((i << 4) | j); ++n; }
  }
  __syncthreads();
  for (int it = vb * 256 + TIDX; it < NTOK * 8; it += nvb * 256) {
    const size_t ob = (size_t)it * 32;
    float a[16], bq[16];
#pragma unroll
    for (int i = 0; i < 16; i += 4) {
      const f32x4 fa = *(const f32x4*)(p.sv + ob + i), fb = *(const f32x4*)(p.sv + ob + 16 + i);
#pragma unroll
      for (int e = 0; e < 4; ++e) { a[i + e] = fa[e]; bq[i + e] = fb[e]; }
    }
    float g0[16], g1[16], g2[16], g3[16];
    {
      int n = 0;
#pragma unroll
      for (int i = 0; i < 16; ++i)
#pragma unroll
        for (int j = 0; j < 16; ++j)
          if ((i + 1) * (j + 1) <= 16) {
            const float v = __uint_as_float((__float_as_uint(a[i] + bq[j]) & ~63u) | (unsigned)n);
            if (n < 16) g0[n] = v; else if (n < 32) g1[n - 16] = v; else if (n < 48) g2[n - 32] = v; else g3[n - 48] = v;
            ++n;
          }
#pragma unroll
      for (int k = 2; k < 16; ++k) g3[k] = -3.0e38f;
    }
    bitonic_sort_desc<16>(g0); bitonic_sort_desc<16>(g1); bitonic_sort_desc<16>(g2); bitonic_sort_desc<16>(g3);
    top16_merge(g0, g1); top16_merge(g2, g3); top16_merge(g0, g2);
    float den = 0.f; float ex[16]; int seli[16];
#pragma unroll
    for (int k = 0; k < 16; ++k) {
      ex[k] = __expf(g0[k] - g0[0]); den += ex[k];
      const int ij = lut[__float_as_uint(g0[k]) & 63u];
      const int ka = (int)(__float_as_uint(p.sv[ob + (ij >> 4)]) & 127u), kb = (int)(__float_as_uint(p.sv[ob + 16 + (ij & 15)]) & 127u);
      seli[k] = ka * 128 + kb;
    }
    const float inv = 1.0f / den;
    const size_t o2 = (size_t)it * 16;
    typedef int i32x4 __attribute__((ext_vector_type(4)));
#pragma unroll
    for (int k = 0; k < 16; k += 4) {
      *(i32x4*)(p.pidx + o2 + k) = (i32x4){seli[k], seli[k + 1], seli[k + 2], seli[k + 3]};
      *(f32x4*)(p.pgate + o2 + k) = (f32x4){ex[k] * inv, ex[k + 1] * inv, ex[k + 2] * inv, ex[k + 3] * inv};
    }
  }
}
typedef float f32x16 __attribute__((ext_vector_type(16)));
typedef float f32x32 __attribute__((ext_vector_type(32)));
typedef unsigned u32x6 __attribute__((ext_vector_type(6)));
__device__ __forceinline__ float gelu_as(float v) {
  const float t = __builtin_amdgcn_rcpf(fabsf(v) * 0.2316418882f + 1.0f);
  float qq = t * 0.5307027145f + (-0.7265760135f); qq = qq * t + 0.7107068705f; qq = qq * t + (-0.142248368f); qq = qq * t + 0.127414796f; qq = qq * t;
  const float m = v * (qq * __builtin_amdgcn_exp2f((v * v) * (-0.72134752044f)));
  return v < 0.f ? m : v - m;
}
__device__ __forceinline__ float half_max(float v) {
#pragma unroll
  for (int o = 16; o > 0; o >>= 1) v = fmaxf(v, __shfl_xor(v, o));
  return v;
}
__device__ __forceinline__ float half_sum(float v) {
#pragma unroll
  for (int o = 16; o > 0; o >>= 1) v += __shfl_xor(v, o);
  return v;
}
__device__ __forceinline__ void ph_cvt_fp6(const float* __restrict__ in, unsigned char* __restrict__ out, float* __restrict__ inv_scale, int vb, int nvb) {
  const int lane = TIDX & 63, wid = TIDX >> 6, hf = lane >> 5, sl = lane & 31;
  for (int rp = vb * 4 + wid; rp < 8192; rp += nvb * 4) {
    const int row = rp * 2 + hf;
    f32x16 a, b2; float am = 0.f;
#pragma unroll
    for (int i = 0; i < 4; ++i) {
      const f32x4 v0 = *(const f32x4*)(in + (size_t)row * DM + sl * 32 + 4 * i), v1 = *(const f32x4*)(in + (size_t)row * DM + sl * 32 + 16 + 4 * i);
#pragma unroll
      for (int e = 0; e < 4; ++e) { a[4 * i + e] = v0[e]; b2[4 * i + e] = v1[e]; am = fmaxf(am, fmaxf(fabsf(v0[e]), fabsf(v1[e]))); }
    }
    am = half_max(am);
    const float sc = am > 0.f ? 7.0f / am : 1.0f;
    const u32x6 pk = __builtin_amdgcn_cvt_scalef32_2xpk16_fp6_f32(a * sc, b2 * sc, 1.0f);
    unsigned char* o = out + (size_t)row * 768 + sl * 24;
    *(u32x2*)(o) = (u32x2){pk[0], pk[1]}; *(u32x2*)(o + 8) = (u32x2){pk[2], pk[3]}; *(u32x2*)(o + 16) = (u32x2){pk[4], pk[5]};
    if (sl == 0) inv_scale[row] = am > 0.f ? am / 7.0f : 1.0f;
  }
}
__device__ __forceinline__ void ph_cvt_fp4(const float* __restrict__ in, unsigned char* __restrict__ out, float* __restrict__ inv_scale, int vb, int nvb) {
  const int lane = TIDX & 63, wid = TIDX >> 6, hf = lane >> 5, sl = lane & 31;
  const f32x2 probe = __builtin_amdgcn_cvt_scalef32_pk_f32_fp4(__builtin_amdgcn_cvt_scalef32_pk_fp4_f32(0u, 1.0f, 2.0f, 1.0f, 0), 1.0f, 0);
  const bool sw = probe.x != 1.0f;
  for (int rp = vb * 4 + wid; rp < 8192; rp += nvb * 4) {
    const int row = rp * 2 + hf;
    f32x4 v[8]; float am = 0.f;
#pragma unroll
    for (int i = 0; i < 8; ++i) {
      v[i] = *(const f32x4*)(in + (size_t)row * DM + sl * 32 + 4 * i);
#pragma unroll
      for (int e = 0; e < 4; ++e) am = fmaxf(am, fabsf(v[i][e]));
    }
    am = half_max(am);
    const float sc = am > 0.f ? 6.0f / am : 1.0f;
    u32x4 pk = (u32x4){0u, 0u, 0u, 0u};
#pragma unroll
    for (int w = 0; w < 4; ++w) {
      unsigned word = 0u;
      float c[8];
#pragma unroll
      for (int e = 0; e < 4; ++e) { c[e] = v[2 * w][e] * sc; c[4 + e] = v[2 * w + 1][e] * sc; }
      word = __builtin_amdgcn_cvt_scalef32_pk_fp4_f32(word, sw ? c[1] : c[0], sw ? c[0] : c[1], 1.0f, 0);
      word = __builtin_amdgcn_cvt_scalef32_pk_fp4_f32(word, sw ? c[3] : c[2], sw ? c[2] : c[3], 1.0f, 1);
      word = __builtin_amdgcn_cvt_scalef32_pk_fp4_f32(word, sw ? c[5] : c[4], sw ? c[4] : c[5], 1.0f, 2);
      word = __builtin_amdgcn_cvt_scalef32_pk_fp4_f32(word, sw ? c[7] : c[6], sw ? c[6] : c[7], 1.0f, 3);
      pk[w] = word;
    }
    *(u32x4*)(out + (size_t)row * 512 + sl * 16) = pk;
    if (sl == 0) inv_scale[row] = am > 0.f ? am / 6.0f : 1.0f;
  }
}
__device__ __forceinline__ u32x6 load_row6(const unsigned char* base, int id, int sl) {
  const unsigned char* q = base + (size_t)id * 768 + sl * 24;
  const u32x2 a = *(const u32x2*)q, b = *(const u32x2*)(q + 8), c = *(const u32x2*)(q + 16);
  return (u32x6){a.x, a.y, b.x, b.y, c.x, c.y};
}
#define GATHER_SMEM (4 * 64 * 33 * 4)
__device__ __forceinline__ void ph_peer_gather(const P& p, int vb, int nvb, unsigned char* smem) {
  int tid_ = TIDX;
  asm volatile("" : "+v"(tid_));
  const int lane = tid_ & 63, wid = tid_ >> 6, hf = lane >> 5, sl = lane & 31;
  float* scr = (float*)smem + (wid * 64 + lane) * 33;
  int* tauL = (int*)(smem + GATHER_SMEM) + wid * 32;
  {
    f32x16 a, b2;
#pragma unroll
    for (int i = 0; i < 16; ++i) { a[i] = __uint_as_float((unsigned)i << 20) * 0x1p126f; b2[i] = __uint_as_float((unsigned)(16 + i) << 20) * 0x1p126f; }
    const f32x32 o = __builtin_amdgcn_cvt_scalef32_pk32_f32_fp6(__builtin_amdgcn_cvt_scalef32_2xpk16_fp6_f32(a, b2, 1.0f), 1.0f);
    if (lane == 0) {
#pragma unroll
      for (int j = 0; j < 32; ++j) tauL[j] = (int)((__float_as_uint(o[j] * 0x1p-126f) >> 20) & 31u);
    }
  }
  const int jmap = 2 * (lane & 1) + ((lane >> 1) & 1);
  __syncthreads();
  int id0, id1; float su0, su1, gs0, gs1; u32x4 xr[4];
  {
    const int m0 = min(vb * 4 + wid, NTOK - 1);
    id0 = p.pidx[(size_t)m0 * 128 + lane]; id1 = p.pidx[(size_t)m0 * 128 + 64 + lane];
#pragma unroll
    for (int c4 = 0; c4 < 4; ++c4) xr[c4] = *(const u32x4*)(p.hx2 + (size_t)m0 * DM + sl * 32 + 8 * c4);
    su0 = p.us[id0]; su1 = p.us[id1];
    gs0 = p.pgate[(size_t)m0 * 128 + lane] * p.vs[id0]; gs1 = p.pgate[(size_t)m0 * 128 + 64 + lane] * p.vs[id1];
  }
  for (int m = vb * 4 + wid; m < NTOK; m += nvb * 4) {
    const float* md = p.mod + (m / SEQ) * 6144;
    f32x2 xp2[16];
#pragma unroll
    for (int c4 = 0; c4 < 4; ++c4)
#pragma unroll
      for (int e = 0; e < 4; ++e) xp2[4 * c4 + e] = (f32x2){bflo(xr[c4][e]), bfhi(xr[c4][e])};
    const int mn = min(m + nvb * 4, NTOK - 1);
    const int nid0 = p.pidx[(size_t)mn * 128 + lane], nid1 = p.pidx[(size_t)mn * 128 + 64 + lane];
    const float ng0 = p.pgate[(size_t)mn * 128 + lane], ng1 = p.pgate[(size_t)mn * 128 + 64 + lane];
#pragma unroll
    for (int c4 = 0; c4 < 4; ++c4) xr[c4] = *(const u32x4*)(p.hx2 + (size_t)mn * DM + sl * 32 + 8 * c4);
    float nsu0 = 0.f, nsu1 = 0.f, nvs0 = 0.f, nvs1 = 0.f;
    f32x2 acc2[16];
#pragma unroll
    for (int k = 0; k < 16; ++k) acc2[k] = (f32x2){0.f, 0.f};
#pragma unroll 1
    for (int e0 = 0; e0 < 128; e0 += 8) {
      if (e0 == 64) { nsu0 = p.us[nid0]; nsu1 = p.us[nid1]; nvs0 = p.vs[nid0]; nvs1 = p.vs[nid1]; }
      u32x4 ur[4], vr[4];
#pragma unroll
      for (int j = 0; j < 4; ++j) {
        const int id = __shfl(e0 < 64 ? id0 : id1, (e0 + hf * 4 + j) & 63);
        ur[j] = *(const u32x4*)(p.ub8 + (size_t)id * 512 + sl * 16);
        vr[j] = *(const u32x4*)(p.vb8 + (size_t)id * 512 + sl * 16);
      }
      float d[4];
#pragma unroll
      for (int j = 0; j < 4; ++j) {
        f32x2 s0 = (f32x2){0.f, 0.f}, s1 = (f32x2){0.f, 0.f};
#pragma unroll
        for (int w = 0; w < 4; ++w) {
          s0 += __builtin_amdgcn_cvt_scalef32_pk_f32_fp4(ur[j][w], 1.0f, 0) * xp2[4 * w + 0];
          s1 += __builtin_amdgcn_cvt_scalef32_pk_f32_fp4(ur[j][w], 1.0f, 1) * xp2[4 * w + 1];
          s0 += __builtin_amdgcn_cvt_scalef32_pk_f32_fp4(ur[j][w], 1.0f, 2) * xp2[4 * w + 2];
          s1 += __builtin_amdgcn_cvt_scalef32_pk_f32_fp4(ur[j][w], 1.0f, 3) * xp2[4 * w + 3];
        }
        d[j] = (s0.x + s0.y) + (s1.x + s1.y);
      }
      float r2[2], r1;
      {
        const bool lo = (lane & 1) == 0;
#pragma unroll
        for (int i = 0; i < 2; ++i) { const float keep = lo ? d[i] : d[i + 2], send = lo ? d[i + 2] : d[i]; r2[i] = keep + __shfl_xor(send, 1); }
        const bool lo2 = (lane & 2) == 0;
        { const float keep = lo2 ? r2[0] : r2[1], send = lo2 ? r2[1] : r2[0]; r1 = keep + __shfl_xor(send, 2); }
        r1 += __shfl_xor(r1, 4); r1 += __shfl_xor(r1, 8); r1 += __shfl_xor(r1, 16);
      }
      const int esrc = (e0 + hf * 4 + jmap) & 63;
      const float su = __shfl(e0 < 64 ? su0 : su1, esrc), gs = __shfl(e0 < 64 ? gs0 : gs1, esrc);
      const float sdot = r1 * su;
      const float cf = gelu_as(sdot) * gs;
#pragma unroll
      for (int j = 0; j < 4; ++j) {
        const float cj = __shfl(cf, (lane & 32) | ((j >> 1) | ((j & 1) << 1)));
        const f32x2 cj2 = (f32x2){cj, cj};
#pragma unroll
        for (int w = 0; w < 4; ++w) {
          acc2[4 * w + 0] += cj2 * __builtin_amdgcn_cvt_scalef32_pk_f32_fp4(vr[j][w], 1.0f, 0);
          acc2[4 * w + 1] += cj2 * __builtin_amdgcn_cvt_scalef32_pk_f32_fp4(vr[j][w], 1.0f, 1);
          acc2[4 * w + 2] += cj2 * __builtin_amdgcn_cvt_scalef32_pk_f32_fp4(vr[j][w], 1.0f, 2);
          acc2[4 * w + 3] += cj2 * __builtin_amdgcn_cvt_scalef32_pk_f32_fp4(vr[j][w], 1.0f, 3);
        }
      }
    }
#pragma unroll
    for (int k = 0; k < 16; ++k) { scr[2 * k] = acc2[k].x + __shfl_xor(acc2[k].x, 32); scr[2 * k + 1] = acc2[k].y + __shfl_xor(acc2[k].y, 32); }
    lds_wave_fence();
    float ss = 0.f;
#pragma unroll
    for (int k = 0; k < 32; ++k) { const float v = scr[k]; ss += v * v; }
    ss = half_sum(ss);
    const float rstd = rsqrtf(ss * (1.0f / 1024.0f) + 1e-6f);
#pragma unroll
    for (int k4 = 0; k4 < 4; ++k4) {
      const int kk = hf * 16 + k4 * 4, col = sl * 32 + kk;
      f32x4 x1 = *(const f32x4*)(p.out + (size_t)m * DM + col);
      const f32x4 g = *(const f32x4*)(p.g_post_ffn + col), gt = *(const f32x4*)(md + 5120 + col);
#pragma unroll
      for (int e = 0; e < 4; ++e) x1[e] += gt[e] * scr[kk + e] * rstd * g[e];
      *(f32x4*)(p.out + (size_t)m * DM + col) = x1;
    }
    lds_wave_fence();
    id0 = nid0; id1 = nid1; su0 = nsu0; su1 = nsu1; gs0 = ng0 * nvs0; gs1 = ng1 * nvs1;
  }
}

#define XB_TMO      128
#define XB_XCNT(j)  (256  + 64 * (j))
#define XB_XSUB(j)  (1280 + 64 * (j))
#define XB_XGEN(j)  (2304 + 64 * (j))
#define XB_TOP      3328
#define XB_TOPGEN   3392
#define XCD_BAR_WORDS 3456
#define XB_SPIN_CAP (1u << 20)
#define LAS __attribute__((address_space(3)))
__device__ __forceinline__ unsigned xb_ld(unsigned* p)              { return __hip_atomic_load(p, __ATOMIC_RELAXED, __HIP_MEMORY_SCOPE_AGENT); }
__device__ __forceinline__ unsigned xb_add(unsigned* p, unsigned v) { return __hip_atomic_fetch_add(p, v, __ATOMIC_RELAXED, __HIP_MEMORY_SCOPE_AGENT); }
__device__ __forceinline__ unsigned xb_xcc_id() { return (unsigned)__builtin_amdgcn_s_getreg((3 << 11) | 20) & 0xFu; }
#define XB_SPIN(cond, bar) do { unsigned _sp = 0; while (cond) { __builtin_amdgcn_s_sleep(1); \
    if ((++_sp & 255u) == 0u) { if (xb_ld(&(bar)[XB_TMO])) break; if (_sp > XB_SPIN_CAP) { atomicAdd(&(bar)[XB_TMO], 1u); break; } } } } while (0)
struct XcdBarrier { unsigned* bar; unsigned x; volatile LAS unsigned* st; };
__device__ __forceinline__ XcdBarrier xcd_barrier_post(unsigned* bar, volatile LAS unsigned* st) {
  XcdBarrier b; b.bar = bar; b.x = xb_xcc_id(); b.st = st;
  if (TIDX == 0) (void)xb_add(&bar[XB_XCNT(b.x)], 1u);
  return b;
}
__device__ __forceinline__ void xcd_barrier_complete(unsigned* bar, unsigned x, unsigned& nloc, unsigned& nx) {
  const unsigned G = gridDim.x * gridDim.y * gridDim.z;
  unsigned sum, cnt, mine, sp = 0u;
  for (;;) {
    sum = 0u; cnt = 0u; mine = 0u;
#pragma unroll
    for (unsigned j = 0; j < 16; ++j) { const unsigned c = xb_ld(&bar[XB_XCNT(j)]); sum += c; cnt += (c > 0u) ? 1u : 0u; mine = (j == x) ? c : mine; }
    if (sum == G) break;
    __builtin_amdgcn_s_sleep(1);
    if ((++sp & 255u) == 0u) { if (xb_ld(&bar[XB_TMO])) break; if (sp > XB_SPIN_CAP) { atomicAdd(&bar[XB_TMO], 1u); break; } }
  }
  nloc = mine > 0u ? mine : 1u; nx = cnt > 0u ? cnt : 1u;
}
__device__ __forceinline__ void xcd_barrier(const XcdBarrier& b) {
  asm volatile("s_waitcnt vmcnt(0)" ::: "memory");
  __syncthreads();
  if (TIDX == 0) {
    unsigned* bar = b.bar;
    __builtin_amdgcn_s_waitcnt(0);
    unsigned nloc = b.st[0], nx = b.st[1];
    if (nloc == 0u) { xcd_barrier_complete(bar, b.x, nloc, nx); b.st[0] = nloc; b.st[1] = nx; }
    const unsigned old = xb_add(&bar[XB_XSUB(b.x)], 1u);
    const unsigned gen = old / nloc;
    if (old + 1u == (gen + 1u) * nloc) {
      __builtin_amdgcn_fence(__ATOMIC_RELEASE, "agent");
      asm volatile("s_waitcnt vmcnt(0)" ::: "memory");
      const unsigned og = xb_add(&bar[XB_TOP], 1u);
      const unsigned tg = og / nx;
      if (og + 1u == (tg + 1u) * nx) xb_add(&bar[XB_TOPGEN], 1u);
      else XB_SPIN(xb_ld(&bar[XB_TOPGEN]) == tg, bar);
      __builtin_amdgcn_fence(__ATOMIC_ACQUIRE, "agent");
      xb_add(&bar[XB_XGEN(b.x)], 1u);
      asm volatile("s_waitcnt vmcnt(0)" ::: "memory");
    } else {
      XB_SPIN(xb_ld(&bar[XB_XGEN(b.x)]) == gen, bar);
      __builtin_amdgcn_fence(__ATOMIC_ACQUIRE, "agent");
      asm volatile("s_waitcnt vmcnt(0)" ::: "memory");
    }
  }
  __syncthreads();
}

#define SMEM_BYTES RWKV_SMEM
__global__ void __launch_bounds__(256, 2) mega(P p) {
  __shared__ __attribute__((aligned(16))) unsigned char smem[SMEM_BYTES + 16];
  cg::grid_group grid = cg::this_grid();
  const int vb = blockIdx.x, nvb = gridDim.x;
  if (TIDX == 0) *(u32x4*)(smem + SMEM_BYTES) = (u32x4){0u, 0u, 0u, 0u};
  __syncthreads();
  const XcdBarrier xb = xcd_barrier_post(p.bar, (volatile LAS unsigned*)(smem + SMEM_BYTES));
  ph_mod(p, vb, nvb, smem);
  ph_colmax(p.w_in, p.colmax, DM, INC, vb, nvb, smem);
  ph_transpose(p.w2, p.w2T, 64, 1024, vb, nvb, smem);
  ph_transpose(p.w2 + 65536, p.w2T + 65536, 64, 1024, vb, nvb, smem);
  ph_transpose(p.a2, p.a2T, 64, 1024, vb, nvb, smem);
  ph_transpose(p.a2 + 65536, p.a2T + 65536, 64, 1024, vb, nvb, smem);
  if (p.bar == nullptr) grid.sync();
  xcd_barrier(xb);
  ph_norm1(p, vb, nvb);
  ph_transpose_i8(p.w_in, p.Wt8, p.colmax, p.wsb, DM, INC, vb, nvb, smem);
  xcd_barrier(xb);
  ph_gemm1(p, vb, nvb, smem);
  xcd_barrier(xb);
  ph_rwkv_A(p, vb, nvb, smem);
  xcd_barrier(xb);
  ph_rwkv_B(p, vb, nvb, smem);
  if (nvb > 128 && vb >= 64) {
    const int v2 = vb - 64, n2 = nvb - 64;
    ph_transpose(p.w_a_out, p.Wt_aout, DM, DM, v2, n2, smem);
    ph_transpose(p.w_o, p.Wt_o, DM, DM, v2, n2, smem);
    ph_transpose(p.peer_wq, p.Wt_q, DM, 2048, v2, n2, smem);
    ph_transpose(p.g2, p.g2T, 128, 1024, v2, n2, smem);
    ph_weff(p, v2, n2);
    ph_convert(p.peer_keys, p.keys, (size_t)16 * 128 * 128, v2, n2);
  } else if (nvb <= 128) {
    ph_transpose(p.w_a_out, p.Wt_aout, DM, DM, vb, nvb, smem);
    ph_transpose(p.w_o, p.Wt_o, DM, DM, vb, nvb, smem);
    ph_transpose(p.peer_wq, p.Wt_q, DM, 2048, vb, nvb, smem);
    ph_transpose(p.g2, p.g2T, 128, 1024, vb, nvb, smem);
    ph_weff(p, vb, nvb);
    ph_convert(p.peer_keys, p.keys, (size_t)16 * 128 * 128, vb, nvb);
  }
  xcd_barrier(xb);
  ph_ycorr(p, vb, nvb);
  ph_sg(p, vb, nvb);
  xcd_barrier(xb);
  ph_readout_gemm(p, vb, nvb, smem);
  ph_pool(p, vb, nvb, smem);
  ph_cvt_fp4(p.peer_u, p.ub8, p.us, vb, nvb);
  ph_cvt_fp4(p.peer_v, p.vb8, p.vs, vb, nvb);
  xcd_barrier(xb);
  ph_gemm_merge(p, vb, nvb, smem);
  xcd_barrier(xb);
  ph_gemm_simple(p.mrg, DM, p.Wt_o, DM, DM, NTOK, DM, p.mix, DM, vb, nvb, smem);
  xcd_barrier(xb);
  ph_res1(p, vb, nvb);
  xcd_barrier(xb);
  ph_gemm_simple(p.hx2, DM, p.Wt_q, DM, DM, NTOK, 2048, p.q, 2048, vb, nvb, smem);
  xcd_barrier(xb);
  ph_peer_s1(p, vb, nvb, smem);
  xcd_barrier(xb);
  ph_peer_s2(p, vb, nvb, smem);
  xcd_barrier(xb);
  ph_peer_gather(p, vb, nvb, smem);
}

extern "C" void kernel_launch(void* const* d_in, const int* in_sizes, int n_in, void* d_out, int out_size, void* d_ws, size_t ws_size, hipStream_t stream) {
  P p{};
  const float** f = (const float**)&p;
  for (int i = 0; i < 32; ++i) f[i] = (const float*)d_in[i];
  p.out = (float*)d_out;
  p.bar = (unsigned*)((unsigned char*)d_ws + 511 * 1048576);
  unsigned char* w = (unsigned char*)d_ws;
  const size_t MiB = 1048576;
  const size_t HM = 524288;
  p.hx = (bf16_t*)(w + 4096);
  p.hx8 = (signed char*)(w + 4096);
  p.hsa = (float*)(w + 40 * MiB) + 4;
  p.colmax = p.bar + XCD_BAR_WORDS;
  p.zA = (bf16_t*)(w + 65 * MiB + 8192);
  p.zP = (bf16_t*)(w + 569 * HM);
  p.zG = (bf16_t*)d_out;
  unsigned char* rw = w + 633 * HM;
  p.Wt_in = (bf16_t*)rw; p.Wt8 = (signed char*)rw; rw += 11 * MiB; p.wsb = (float*)rw; rw += 1 * MiB;
  p.Wt_aout = (bf16_t*)rw; rw += 2 * MiB;
  p.Wt_eff = (bf16_t*)rw; rw += 1 * MiB;
  p.Wt_o = (bf16_t*)rw; rw += 2 * MiB;
  p.Wt_q = (bf16_t*)rw; rw += 4 * MiB;
  p.keys = (bf16_t*)rw; rw += HM;
  p.mod = (float*)rw; rw += HM;
  p.g2T = (bf16_t*)rw; rw += HM;
  p.w2T = (bf16_t*)rw; rw += HM;
  p.a2T = (bf16_t*)rw; rw += HM;
  p.Y0 = (bf16_t*)(w + 0 * MiB);
  p.Y1 = (bf16_t*)(w + 340 * MiB);
  p.bdot = (float*)(w + 404 * MiB);
  p.Mst = (bf16_t*)(w + 408 * MiB);
  p.sg = (bf16_t*)(w + 408 * MiB);
  p.Nst = (float*)(w + 441 * MiB);
  p.ub8 = w + 416 * MiB;
  p.vb8 = w + 432 * MiB;
  p.us = (float*)(w + 448 * MiB);
  p.vs = (float*)(w + 449 * MiB);
  p.pooled = (bf16_t*)(w + 478 * MiB);
  p.out_a = (bf16_t*)(w + 0 * MiB);
  p.ya = (bf16_t*)(w + 65 * MiB);
  p.yb = (bf16_t*)(w + 129 * MiB);
  p.mrg = (bf16_t*)(w + 193 * MiB);
  p.mix = (bf16_t*)(w + 65 * MiB);
  p.hx2 = (bf16_t*)(w + 0 * MiB);
  p.q = (bf16_t*)(w + 129 * MiB);
  p.sv = (float*)(w + 340 * MiB);
  p.si = (int*)(w + 372 * MiB);
  p.pidx = (int*)(w + 257 * MiB);
  p.pgate = (float*)(w + 273 * MiB);
  static int grid_blocks = 0;
  if (!grid_blocks) {
    int dev = 0, cus = 0, per_cu = 0;
    hipGetDevice(&dev);
    hipDeviceGetAttribute(&cus, hipDeviceAttributeMultiprocessorCount, dev);
    hipOccupancyMaxActiveBlocksPerMultiprocessor(&per_cu, mega, 256, 0);
    if (per_cu > 2) per_cu = 2;
    if (per_cu < 1) per_cu = 1;
    grid_blocks = cus * per_cu;
  }
  hipMemsetAsync(p.bar, 0, (XCD_BAR_WORDS + 6016) * 4, stream);
  void* args[] = {&p};
  hipError_t e = hipLaunchCooperativeKernel((void*)mega, dim3(grid_blocks), dim3(256), args, 0, stream);
  if (e != hipSuccess) fprintf(stderr, "cooperative launch failed: %s (grid %d)\n", hipGetErrorString(e), grid_blocks);
}
```

```cpp
#include <hip/hip_runtime.h>
#include <hip/hip_cooperative_groups.h>
#include <stdint.h>
#include <cstdio>
namespace cg = cooperative_groups;

typedef unsigned short bf16_t;
typedef short bf16x8 __attribute__((ext_vector_type(8)));
typedef float f32x4 __attribute__((ext_vector_type(4)));
typedef unsigned u32x4 __attribute__((ext_vector_type(4)));
typedef unsigned u32x2 __attribute__((ext_vector_type(2)));
typedef float f32x2 __attribute__((ext_vector_type(2)));

__device__ __forceinline__ int tid_opaque() { int t = threadIdx.x; asm volatile("" : "+v"(t)); return t; }
#define TIDX tid_opaque()
#define NTOK 32768
#define SEQ 16384
#define CTXL 256
#define NCTX 512
#define MROWS 33280
#define DM 1024
#define SHIFTC 3456
#define INC 6016

typedef __bf16 hwbf2 __attribute__((ext_vector_type(2)));
typedef float hwf2 __attribute__((ext_vector_type(2)));
__device__ __forceinline__ unsigned pack2(float a, float b) { return __builtin_bit_cast(unsigned, __builtin_convertvector((hwf2){a, b}, hwbf2)); }
__device__ __forceinline__ bf16_t f2bf(float f) { return __builtin_bit_cast(unsigned short, (__bf16)f); }
__device__ __forceinline__ float bf2f(bf16_t h) { return __uint_as_float(((unsigned)h) << 16); }
__device__ __forceinline__ float bflo(unsigned u) { return __uint_as_float(u << 16); }
__device__ __forceinline__ float bfhi(unsigned u) { return __uint_as_float(u & 0xffff0000u); }
__device__ __forceinline__ float sigmoidf_(float x) { return __builtin_amdgcn_rcpf(1.0f + __expf(-x)); }
__device__ __forceinline__ float fast_tanh(float x) { const float e = __builtin_amdgcn_exp2f(2.885390082f * x); return 1.0f - 2.0f * __builtin_amdgcn_rcpf(e + 1.0f); }

__device__ __forceinline__ void load8(const bf16_t* __restrict__ zA, int row, int col0, float* o) {
  const u32x4 zc = *(const u32x4*)(zA + (size_t)row * SHIFTC + col0);
#pragma unroll
  for (int i = 0; i < 4; ++i) { o[2 * i] = bflo(zc[i]); o[2 * i + 1] = bfhi(zc[i]); }
}
__device__ __forceinline__ float red16(float v) {
  v += __shfl_xor(v, 1); v += __shfl_xor(v, 2); v += __shfl_xor(v, 4); v += __shfl_xor(v, 8);
  return v;
}
__device__ __forceinline__ float red8(float v) {
  v += __shfl_xor(v, 1); v += __shfl_xor(v, 2); v += __shfl_xor(v, 4);
  return v;
}

struct P {
  const float *x, *c, *ctx, *c_ctx, *w_mod, *b_mod, *g_pre_mix, *g_post_mix, *g_pre_ffn, *g_post_ffn, *w_in, *b_gate, *mu_shift,
      *w0, *w2, *a0, *a2, *g2, *k_k, *k_a, *r_k, *ln_x_w, *ln_x_b, *w_a_out, *w_pool, *pool_scale, *w_b_out, *w_o, *peer_wq,
      *peer_keys, *peer_u, *peer_v;
  float* out;
  unsigned* bar;
  bf16_t* hx;
  signed char* hx8;
  float* hsa;
  signed char* Wt8;
  float* wsb;
  unsigned* colmax;
  bf16_t* zA;
  bf16_t* zP;
  bf16_t* zG;
  bf16_t* Wt_in;
  bf16_t* Wt_aout;
  bf16_t* Wt_eff;
  bf16_t* Wt_o;
  bf16_t* Wt_q;
  bf16_t* keys;
  float* mod;
  unsigned char* ub8;
  unsigned char* vb8;
  float* us;
  float* vs;
  bf16_t* sg;
  bf16_t* g2T;
  bf16_t* w2T;
  bf16_t* a2T;
  bf16_t* Mst;
  float* Nst;
  bf16_t* Y0;
  bf16_t* Y1;
  float* bdot;
  bf16_t* out_a;
  bf16_t* ya;
  bf16_t* pooled;
  bf16_t* yb;
  bf16_t* mrg;
  bf16_t* mix;
  bf16_t* hx2;
  bf16_t* x1b;
  bf16_t* q;
  float* sv;
  int* si;
  int* pidx;
  float* pgate;
};

#define GS 72
#define GEMM_SMEM (2 * 128 * GS * 2)
template <class Epi>
__device__ __forceinline__ void gemm_tile(const bf16_t* __restrict__ A, int lda, const bf16_t* __restrict__ Bt, int ldb, int K, int m0, int n0,
                                          const Epi& epi, unsigned char* smem) {
  const int tid = TIDX, lane = tid & 63, wid = tid >> 6, wr = wid >> 1, wc = wid & 1;
  bf16_t* sA = (bf16_t*)smem;
  bf16_t* sB = sA + 128 * GS;
  f32x4 acc[4][4];
#pragma unroll
  for (int i = 0; i < 4; ++i)
#pragma unroll
    for (int j = 0; j < 4; ++j) acc[i][j] = (f32x4){0.f, 0.f, 0.f, 0.f};
  const int lrow = tid >> 3, lcol = (tid & 7) * 8;
  const bf16_t* pa = A + (size_t)(m0 + lrow) * lda + lcol;
  const bf16_t* pb = Bt + (size_t)(n0 + lrow) * ldb + lcol;
  u32x4 ra[4], rb[4];
#pragma unroll
  for (int p = 0; p < 4; ++p) {
    ra[p] = *(const u32x4*)(pa + (size_t)(32 * p) * lda);
    rb[p] = *(const u32x4*)(pb + (size_t)(32 * p) * ldb);
  }
  for (int k0 = 0; k0 < K; k0 += 64) {
#pragma unroll
    for (int p = 0; p < 4; ++p) {
      *(u32x4*)(sA + (lrow + 32 * p) * GS + lcol) = ra[p];
      *(u32x4*)(sB + (lrow + 32 * p) * GS + lcol) = rb[p];
    }
    __syncthreads();
    if (k0 + 64 < K) {
#pragma unroll
      for (int p = 0; p < 4; ++p) {
        ra[p] = *(const u32x4*)(pa + (size_t)(32 * p) * lda + k0 + 64);
        rb[p] = *(const u32x4*)(pb + (size_t)(32 * p) * ldb + k0 + 64);
      }
    }
#pragma unroll
    for (int kk = 0; kk < 2; ++kk) {
      bf16x8 af[4], bfr[4];
#pragma unroll
      for (int i = 0; i < 4; ++i) af[i] = *(const bf16x8*)(sA + (wr * 64 + i * 16 + (lane & 15)) * GS + kk * 32 + (lane >> 4) * 8);
#pragma unroll
      for (int j = 0; j < 4; ++j) bfr[j] = *(const bf16x8*)(sB + (wc * 64 + j * 16 + (lane & 15)) * GS + kk * 32 + (lane >> 4) * 8);
#pragma unroll
      for (int i = 0; i < 4; ++i)
#pragma unroll
        for (int j = 0; j < 4; ++j) acc[i][j] = __builtin_amdgcn_mfma_f32_16x16x32_bf16(bfr[j], af[i], acc[i][j], 0, 0, 0);
    }
    __syncthreads();
  }
#pragma unroll
  for (int i = 0; i < 4; ++i)
#pragma unroll
    for (int j = 0; j < 4; ++j) epi(m0 + wr * 64 + i * 16 + (lane & 15), n0 + wc * 64 + j * 16 + (lane >> 4) * 4, acc[i][j]);
}

#define G3_STAGE 24576
#define G3_ES 136
#define GEMM3_SMEM (256 * G3_ES * 2)
typedef __attribute__((address_space(3))) unsigned lds_u32;
template <class Epi>
__device__ __forceinline__ void gemm_tile3(const bf16_t* __restrict__ A, int lda, const bf16_t* __restrict__ Bt, int ldb, int K, int m0, int n0,
                                           const Epi& epi, unsigned char* smem) {
  int tid = TIDX;
  asm volatile("" : "+v"(tid));
  const int lane = tid & 63, wid = __builtin_amdgcn_readfirstlane(tid >> 6), wr = wid >> 1, wc = wid & 1, l15 = lane & 15, q = lane >> 4;
  f32x4 acc[8][4];
#pragma unroll
  for (int i = 0; i < 8; ++i)
#pragma unroll
    for (int j = 0; j < 4; ++j) acc[i][j] = (f32x4){0.f, 0.f, 0.f, 0.f};
  const int gr = lane >> 2, gc = ((lane & 3) ^ (((gr >> 2) & 1) << 1)) * 8;
  const bf16_t* pa = A + (long)(m0 + wid * 64 + gr) * lda + gc;
  const bf16_t* pb = Bt + (size_t)(n0 + wid * 32 + gr) * ldb + gc;
  unsigned char* dA = smem + wid * 4096 + lane * 16;
  unsigned char* dB = smem + 16384 + wid * 2048 + lane * 16;
  const int sw = (q ^ (((l15 >> 2) & 1) << 1)) * 16;
  const unsigned char* fA = smem + (wr * 128 + l15) * 64 + sw;
  const unsigned char* fB = smem + 16384 + (wc * 64 + l15) * 64 + sw;
#define G3_ISSUE(ST, KT) { _Pragma("unroll") for (int ii = 0; ii < 4; ++ii) __builtin_amdgcn_global_load_lds((const unsigned*)(pa + (size_t)(16 * ii) * lda + (KT) * 32), (lds_u32*)(dA + (ST) * G3_STAGE + ii * 1024), 16, 0, 0); \
                           _Pragma("unroll") for (int ii = 0; ii < 2; ++ii) __builtin_amdgcn_global_load_lds((const unsigned*)(pb + (size_t)(16 * ii) * ldb + (KT) * 32), (lds_u32*)(dB + (ST) * G3_STAGE + ii * 1024), 16, 0, 0); }
  const int nk = K >> 5;
  __syncthreads();
  G3_ISSUE(0, 0);
  for (int kt = 0; kt < nk; ++kt) {
    const int cur = kt & 1;
    asm volatile("s_waitcnt vmcnt(0)" ::: "memory");
    __syncthreads();
    if (kt + 1 < nk) G3_ISSUE(cur ^ 1, kt + 1);
    const unsigned char* cA = fA + cur * G3_STAGE;
    const unsigned char* cB = fB + cur * G3_STAGE;
    bf16x8 bfr[4];
#pragma unroll
    for (int j = 0; j < 4; ++j) bfr[j] = *(const bf16x8*)(cB + j * 1024);
#pragma unroll
    for (int i = 0; i < 8; ++i) {
      const bf16x8 af = *(const bf16x8*)(cA + i * 1024);
#pragma unroll
      for (int j = 0; j < 4; ++j) acc[i][j] = __builtin_amdgcn_mfma_f32_16x16x32_bf16(bfr[j], af, acc[i][j], 0, 0, 0);
    }
  }
#undef G3_ISSUE
  bf16_t* sE = (bf16_t*)smem;
  __syncthreads();
#pragma unroll
  for (int i = 0; i < 8; ++i)
#pragma unroll
    for (int j = 0; j < 4; ++j) {
      u32x2 w; w.x = pack2(acc[i][j][0], acc[i][j][1]); w.y = pack2(acc[i][j][2], acc[i][j][3]);
      *(u32x2*)(sE + (wr * 128 + i * 16 + l15) * G3_ES + wc * 64 + j * 16 + q * 4) = w;
    }
  __syncthreads();
  epi.finish(sE, m0, n0, tid);
}
typedef int i32x4v __attribute__((ext_vector_type(4)));
template <class Epi>
__device__ __forceinline__ void gemm_tile3_i8(const signed char* __restrict__ A, int lda, const signed char* __restrict__ Bt, int ldb, int K, int m0, int n0,
                                              const float* __restrict__ sa, const float* __restrict__ sb, const Epi& epi, unsigned char* smem) {
  int tid = TIDX;
  asm volatile("" : "+v"(tid));
  const int lane = tid & 63, wid = __builtin_amdgcn_readfirstlane(tid >> 6), wr = wid >> 1, wc = wid & 1, l15 = lane & 15, q = lane >> 4;
  i32x4v acc[8][4];
#pragma unroll
  for (int i = 0; i < 8; ++i)
#pragma unroll
    for (int j = 0; j < 4; ++j) acc[i][j] = (i32x4v){0, 0, 0, 0};
  const int gr = lane >> 2, gc = ((lane & 3) ^ (((gr >> 2) & 1) << 1)) * 16;
  const signed char* pa = A + (long)(m0 + wid * 64 + gr) * lda + gc;
  const signed char* pb = Bt + (size_t)(n0 + wid * 32 + gr) * ldb + gc;
  unsigned char* dA = smem + wid * 4096 + lane * 16;
  unsigned char* dB = smem + 16384 + wid * 2048 + lane * 16;
  const int sw = (q ^ (((l15 >> 2) & 1) << 1)) * 16;
  const unsigned char* fA = smem + (wr * 128 + l15) * 64 + sw;
  const unsigned char* fB = smem + 16384 + (wc * 64 + l15) * 64 + sw;
#define G3_ISSUE(ST, KT) { _Pragma("unroll") for (int ii = 0; ii < 4; ++ii) __builtin_amdgcn_global_load_lds((const unsigned*)(pa + (size_t)(16 * ii) * lda + (KT) * 64), (lds_u32*)(dA + (ST) * G3_STAGE + ii * 1024), 16, 0, 0); \
                           _Pragma("unroll") for (int ii = 0; ii < 2; ++ii) __builtin_amdgcn_global_load_lds((const unsigned*)(pb + (size_t)(16 * ii) * ldb + (KT) * 64), (lds_u32*)(dB + (ST) * G3_STAGE + ii * 1024), 16, 0, 0); }
  const int nk = K >> 6;
  __syncthreads();
  G3_ISSUE(0, 0);
  for (int kt = 0; kt < nk; ++kt) {
    const int cur = kt & 1;
    asm volatile("s_waitcnt vmcnt(0)" ::: "memory");
    __syncthreads();
    if (kt + 1 < nk) G3_ISSUE(cur ^ 1, kt + 1);
    const unsigned char* cA = fA + cur * G3_STAGE;
    const unsigned char* cB = fB + cur * G3_STAGE;
    i32x4v bfr[4];
#pragma unroll
    for (int j = 0; j < 4; ++j) bfr[j] = *(const i32x4v*)(cB + j * 1024);
#pragma unroll
    for (int i = 0; i < 8; ++i) {
      const i32x4v af = *(const i32x4v*)(cA + i * 1024);
#pragma unroll
      for (int j = 0; j < 4; ++j) acc[i][j] = __builtin_amdgcn_mfma_i32_16x16x64_i8(bfr[j], af, acc[i][j], 0, 0, 0);
    }
  }
#undef G3_ISSUE
  bf16_t* sE = (bf16_t*)smem;
  f32x4 sb4[4];
#pragma unroll
  for (int j = 0; j < 4; ++j) sb4[j] = *(const f32x4*)(sb + n0 + wc * 64 + j * 16 + q * 4);
  __syncthreads();
#pragma unroll
  for (int i = 0; i < 8; ++i) {
    const float sr = sa[m0 + wr * 128 + i * 16 + l15];
#pragma unroll
    for (int j = 0; j < 4; ++j) {
      u32x2 w;
      w.x = pack2((float)acc[i][j][0] * (sr * sb4[j][0]), (float)acc[i][j][1] * (sr * sb4[j][1]));
      w.y = pack2((float)acc[i][j][2] * (sr * sb4[j][2]), (float)acc[i][j][3] * (sr * sb4[j][3]));
      *(u32x2*)(sE + (wr * 128 + i * 16 + l15) * G3_ES + wc * 64 + j * 16 + q * 4) = w;
    }
  }
  __syncthreads();
  epi.finish(sE, m0, n0, tid);
}
template <class D> struct Epi3RowChunks {
  __device__ __forceinline__ void finish(const bf16_t* sE, int m0, int n0, int tid) const {
#pragma unroll
    for (int pp = 0; pp < 16; ++pp) {
      const int id = tid + 256 * pp, row = id >> 4, cc = (id & 15) * 8;
      static_cast<const D*>(this)->store(m0 + row, n0 + cc, *(const u32x4*)(sE + row * G3_ES + cc));
    }
  }
};
struct Epi3StoreBf16 : Epi3RowChunks<Epi3StoreBf16> {
  bf16_t* C; int ldc;
  __device__ Epi3StoreBf16(bf16_t* c, int l) : C(c), ldc(l) {}
  __device__ __forceinline__ void store(int m, int n, const u32x4& v) const { *(u32x4*)(C + (size_t)m * ldc + n) = v; }
};
struct Epi3GateA : Epi3RowChunks<Epi3GateA> {
  const bf16_t* zG; const float* bg; bf16_t* mrg;
  __device__ Epi3GateA(const bf16_t* z, const float* b, bf16_t* m) : zG(z), bg(b), mrg(m) {}
  __device__ __forceinline__ void store(int m, int n, const u32x4& v) const {
    const u32x4 g = *(const u32x4*)(zG + (size_t)m * 2048 + n);
    const f32x4 b0 = *(const f32x4*)(bg + n), b1 = *(const f32x4*)(bg + n + 4);
    u32x4 o;
#pragma unroll
    for (int i = 0; i < 4; ++i) {
      const float bl = i < 2 ? b0[2 * i] : b1[2 * i - 4], bh = i < 2 ? b0[2 * i + 1] : b1[2 * i - 3];
      o[i] = pack2(sigmoidf_(bflo(g[i]) + bl) * bflo(v[i]), sigmoidf_(bfhi(g[i]) + bh) * bfhi(v[i]));
    }
    *(u32x4*)(mrg + (size_t)m * DM + n) = o;
  }
};
struct Epi3GateB : Epi3RowChunks<Epi3GateB> {
  const bf16_t* zG; const float* bg; bf16_t* mrg;
  __device__ Epi3GateB(const bf16_t* z, const float* b, bf16_t* m) : zG(z), bg(b), mrg(m) {}
  __device__ __forceinline__ void store(int m, int n, const u32x4& v) const {
    const u32x4 g = *(const u32x4*)(zG + (size_t)m * 2048 + 1024 + n);
    const u32x4 a = *(const u32x4*)(mrg + (size_t)m * DM + n);
    const f32x4 b0 = *(const f32x4*)(bg + 1024 + n), b1 = *(const f32x4*)(bg + 1024 + n + 4);
    u32x4 o;
#pragma unroll
    for (int i = 0; i < 4; ++i) {
      const float bl = i < 2 ? b0[2 * i] : b1[2 * i - 4], bh = i < 2 ? b0[2 * i + 1] : b1[2 * i - 3];
      o[i] = pack2(bflo(a[i]) + sigmoidf_(bflo(g[i]) + bl) * bflo(v[i]), bfhi(a[i]) + sigmoidf_(bfhi(g[i]) + bh) * bfhi(v[i]));
    }
    *(u32x4*)(mrg + (size_t)m * DM + n) = o;
  }
};
struct Epi3ZS {
  bf16_t* zA; const float* mu; int own_lo, own_hi, t0, T;
  __device__ __forceinline__ void finish(const bf16_t* sE, int m0, int n0, int tid) const {
#pragma unroll 4
    for (int pq = 0; pq < 16; ++pq) {
      const int id = tid + 256 * pq, row = id >> 4, cc = (id & 15) * 8, t = t0 + row;
      if (row < own_lo || row > own_hi) continue;
      const u32x4 zc = *(const u32x4*)(sE + row * G3_ES + cc);
      u32x4 zp = (u32x4){0u, 0u, 0u, 0u}, zn = (u32x4){0u, 0u, 0u, 0u};
      if (t > 0) zp = *(const u32x4*)(sE + (row - 1) * G3_ES + cc);
      if (t < T - 1) zn = *(const u32x4*)(sE + (row + 1) * G3_ES + cc);
      const f32x4 m0v = *(const f32x4*)(mu + n0 + cc), m1v = *(const f32x4*)(mu + n0 + cc + 4);
      const float mm[8] = {m0v[0], m0v[1], m0v[2], m0v[3], m1v[0], m1v[1], m1v[2], m1v[3]};
      u32x4 o;
#pragma unroll
      for (int i = 0; i < 4; ++i) {
        const float z0 = bflo(zc[i]), z1 = bfhi(zc[i]);
        float s0 = z0 + mm[2 * i] * (0.5f * (bflo(zp[i]) + bflo(zn[i])) - z0), s1 = z1 + mm[2 * i + 1] * (0.5f * (bfhi(zp[i]) + bfhi(zn[i])) - z1);
        if (n0 == 3072) { s0 = fast_tanh(s0); s1 = fast_tanh(s1); }
        if (n0 == 3328) { s0 = sigmoidf_(s0); s1 = sigmoidf_(s1); }
        o[i] = pack2(s0, s1);
      }
      *(u32x4*)(zA + (long)(m0 + row) * SHIFTC + n0 + cc) = o;
    }
  }
};
struct Epi3Z : Epi3RowChunks<Epi3Z> {
  bf16_t *zA, *zP, *zG;
  __device__ Epi3Z(bf16_t* a, bf16_t* b, bf16_t* c) : zA(a), zP(b), zG(c) {}
  __device__ __forceinline__ void store(int m, int n, const u32x4& v) const {
    if (n < SHIFTC) *(u32x4*)(zA + (size_t)m * SHIFTC + n) = v;
    else if (m < NTOK) {
      if (n < SHIFTC + 512) *(u32x4*)(zP + (size_t)m * 512 + (n - SHIFTC)) = v;
      else *(u32x4*)(zG + (size_t)m * 2048 + (n - SHIFTC - 512)) = v;
    }
  }
};

struct EpiLds {
  float* S;
  __device__ __forceinline__ void operator()(int m, int n, const f32x4& v) const {
    float* r = S + (m & 127) * 133 + n + (n >> 5);
    r[0] = v[0]; r[1] = v[1]; r[2] = v[2]; r[3] = v[3];
  }
};

__device__ __forceinline__ void ph_transpose(const float* __restrict__ in, bf16_t* __restrict__ out, int K, int N, int vb, int nvb, unsigned char* smem) {
  float* t = (float*)smem;
  const int tk = K / 64, tn = N / 64, tid = TIDX, tx = tid & 15, ty = tid >> 4;
  for (int it = vb; it < tk * tn; it += nvb) {
    const int k0 = (it / tn) * 64, n0 = (it % tn) * 64;
    __syncthreads();
#pragma unroll
    for (int r = 0; r < 4; ++r) {
      const f32x4 v = *(const f32x4*)(in + (size_t)(k0 + ty + 16 * r) * N + n0 + 4 * tx);
#pragma unroll
      for (int e = 0; e < 4; ++e) t[(ty + 16 * r) * 65 + 4 * tx + e] = v[e];
    }
    __syncthreads();
    const int n = tid >> 2, kq = (tid & 3) * 16;
    u32x4 w0, w1;
#pragma unroll
    for (int e = 0; e < 4; ++e) {
      w0[e] = pack2(t[(kq + 2 * e) * 65 + n], t[(kq + 2 * e + 1) * 65 + n]);
      w1[e] = pack2(t[(kq + 8 + 2 * e) * 65 + n], t[(kq + 8 + 2 * e + 1) * 65 + n]);
    }
    *(u32x4*)(out + (size_t)(n0 + n) * K + k0 + kq) = w0;
    *(u32x4*)(out + (size_t)(n0 + n) * K + k0 + kq + 8) = w1;
  }
}
__device__ __forceinline__ void ph_colmax(const float* __restrict__ in, unsigned* __restrict__ colmax, int K, int N, int vb, int nvb, unsigned char* smem) {
  float* red = (float*)smem;
  const int tk = K / 64, tn = N / 64, tid = TIDX, n = tid & 63, kq = tid >> 6;
  for (int it = vb; it < tk * tn; it += nvb) {
    const int k0 = (it / tn) * 64 + kq * 16, n0 = (it % tn) * 64;
    float mx = 0.f;
#pragma unroll
    for (int r = 0; r < 16; ++r) mx = fmaxf(mx, fabsf(in[(size_t)(k0 + r) * N + n0 + n]));
    __syncthreads();
    red[kq * 64 + n] = mx;
    __syncthreads();
    if (kq == 0) atomicMax(colmax + n0 + n, __float_as_uint(fmaxf(fmaxf(red[n], red[64 + n]), fmaxf(red[128 + n], red[192 + n]))));
  }
}
__device__ __forceinline__ void ph_transpose_i8(const float* __restrict__ in, signed char* __restrict__ out, const unsigned* __restrict__ colmax, float* __restrict__ sbv,
                                                int K, int N, int vb, int nvb, unsigned char* smem) {
  float* t = (float*)smem;
  const int tk = K / 64, tn = N / 64, tid = TIDX, tx = tid & 15, ty = tid >> 4;
  for (int it = vb; it < tk * tn; it += nvb) {
    const int k0 = (it / tn) * 64, n0 = (it % tn) * 64;
    __syncthreads();
#pragma unroll
    for (int r = 0; r < 4; ++r) {
      const f32x4 v = *(const f32x4*)(in + (size_t)(k0 + ty + 16 * r) * N + n0 + 4 * tx);
#pragma unroll
      for (int e = 0; e < 4; ++e) t[(ty + 16 * r) * 65 + 4 * tx + e] = v[e];
    }
    __syncthreads();
    const int n = tid >> 2, kq = (tid & 3) * 16;
    const float cmx = __uint_as_float(colmax[n0 + n]);
    const float sc = cmx > 0.f ? 127.0f / cmx : 0.f;
    if (k0 == 0 && kq == 0) sbv[n0 + n] = cmx > 0.f ? cmx / 127.0f : 1.0f;
    u32x4 w;
#pragma unroll
    for (int e = 0; e < 4; ++e) {
      unsigned pk = 0;
#pragma unroll
      for (int b = 0; b < 4; ++b) { const int qv = (int)rintf(t[(kq + 4 * e + b) * 65 + n] * sc); pk |= ((unsigned)qv & 255u) << (8 * b); }
      w[e] = pk;
    }
    *(u32x4*)(out + (size_t)(n0 + n) * K + k0 + kq) = w;
  }
}
__device__ __forceinline__ void ph_convert(const float* __restrict__ in, bf16_t* __restrict__ out, size_t n, int vb, int nvb) {
  for (size_t i = ((size_t)vb * 256 + TIDX) * 4; i < n; i += (size_t)nvb * 1024) {
    const float4 v = *(const float4*)(in + i);
    uint2 w; w.x = pack2(v.x, v.y); w.y = pack2(v.z, v.w);
    *(uint2*)(out + i) = w;
  }
}
__device__ __forceinline__ void ph_weff(const P& p, int vb, int nvb) {
  for (int it = vb * 256 + TIDX; it < 512 * 1024; it += nvb * 256) {
    const int n = it & 1023, k = it >> 10, j = k >> 7, kl = k & 127;
    const float* wp = p.w_pool + ((size_t)j * 128 + kl) * 128;
    float s = 0.f;
    for (int c = 0; c < 128; ++c) s += wp[c] * p.pool_scale[j * 128 + c] * p.w_b_out[(size_t)(j * 128 + c) * 1024 + n];
    p.Wt_eff[(size_t)n * 512 + k] = f2bf(s);
  }
}
__device__ __forceinline__ void ph_mod(const P& p, int vb, int nvb, unsigned char* smem) {
  float* red = (float*)smem;
  const int lane = TIDX & 63, wid = TIDX >> 6;
  for (int it = vb; it < 96; it += nvb) {
    const int n = it * 64 + lane;
    float a0 = 0.f, a1 = 0.f, a2 = 0.f;
#pragma unroll 8
    for (int k = wid * 256; k < wid * 256 + 256; ++k) {
      const float w = p.w_mod[(size_t)k * 6144 + n];
      const float c0 = p.c[k], c1 = p.c[1024 + k], c2 = p.c_ctx[k];
      a0 += c0 * sigmoidf_(c0) * w; a1 += c1 * sigmoidf_(c1) * w; a2 += c2 * sigmoidf_(c2) * w;
    }
    __syncthreads();
    red[(wid * 3 + 0) * 64 + lane] = a0; red[(wid * 3 + 1) * 64 + lane] = a1; red[(wid * 3 + 2) * 64 + lane] = a2;
    __syncthreads();
    if (wid < 3) {
      const float sum = red[(0 * 3 + wid) * 64 + lane] + red[(1 * 3 + wid) * 64 + lane] + red[(2 * 3 + wid) * 64 + lane] + red[(3 * 3 + wid) * 64 + lane];
      p.mod[wid * 6144 + n] = sum + p.b_mod[n];
    }
  }
}
__device__ __forceinline__ float wave_sum(float v) {
#pragma unroll
  for (int o = 32; o > 0; o >>= 1) v += __shfl_xor(v, o);
  return v;
}
__device__ __forceinline__ void ph_norm1(const P& p, int vb, int nvb) {
  const int lane = TIDX & 63, wid = TIDX >> 6, nw = nvb * 4;
  for (int m0 = vb * 4 + wid; m0 < MROWS; m0 += 2 * nw) {
    const int m1 = m0 + nw; const bool has1 = m1 < MROWS; const int mb = has1 ? m1 : m0;
    const float* srcA = m0 < NTOK ? p.x + (size_t)m0 * DM : p.ctx + (size_t)(m0 - NTOK) * DM;
    const float* srcB = mb < NTOK ? p.x + (size_t)mb * DM : p.ctx + (size_t)(mb - NTOK) * DM;
    f32x4 va[4], vbq[4]; float sa = 0.f, sb = 0.f;
#pragma unroll
    for (int i = 0; i < 4; ++i) { va[i] = *(const f32x4*)(srcA + i * 256 + lane * 4); vbq[i] = *(const f32x4*)(srcB + i * 256 + lane * 4); }
#pragma unroll
    for (int i = 0; i < 4; ++i)
#pragma unroll
      for (int e = 0; e < 4; ++e) { sa += va[i][e] * va[i][e]; sb += vbq[i][e] * vbq[i][e]; }
    sa = wave_sum(sa); sb = wave_sum(sb);
#pragma unroll
    for (int rr = 0; rr < 2; ++rr) {
      if (rr == 1 && !has1) break;
      const int m = rr == 0 ? m0 : m1;
      const float rstd = rsqrtf((rr == 0 ? sa : sb) * (1.0f / 1024.0f) + 1e-6f);
      const float* md = p.mod + (m < NTOK ? (m / SEQ) : 2) * 6144;
      f32x4 y[4]; float am = 0.f;
#pragma unroll
      for (int i = 0; i < 4; ++i) {
        const int col = i * 256 + lane * 4;
        const f32x4 v = rr == 0 ? va[i] : vbq[i];
        const f32x4 g = *(const f32x4*)(p.g_pre_mix + col), sh = *(const f32x4*)(md + col), sc = *(const f32x4*)(md + 1024 + col);
#pragma unroll
        for (int e = 0; e < 4; ++e) { y[i][e] = v[e] * rstd * g[e] * (1.f + sc[e]) + sh[e]; am = fmaxf(am, fabsf(y[i][e])); }
      }
#pragma unroll
      for (int o = 32; o > 0; o >>= 1) am = fmaxf(am, __shfl_xor(am, o));
      const float qs = am > 0.f ? 127.0f / am : 0.f;
      if (lane == 0) p.hsa[m] = am > 0.f ? am / 127.0f : 1.0f;
#pragma unroll
      for (int i = 0; i < 4; ++i) {
        unsigned pk = 0;
#pragma unroll
        for (int e = 0; e < 4; ++e) pk |= ((unsigned)(int)rintf(y[i][e] * qs) & 255u) << (8 * e);
        *(unsigned*)(p.hx8 + (size_t)m * DM + i * 256 + lane * 4) = pk;
      }
    }
  }
}
struct Epi3Readout {
  const P* pp;
  __device__ __forceinline__ void finish(const bf16_t* sE, int m0, int n0, int tid) const {
    const P& p = *pp;
#pragma unroll 2
    for (int pq = 0; pq < 16; ++pq) {
      const int id = tid + 256 * pq, row = id >> 4, cc = (id & 15) * 8, m = m0 + row, n = n0 + cc, t = m % SEQ, h = n >> 6;
      const u32x4 g = *(const u32x4*)(sE + row * G3_ES + cc);
      const u32x4 y0 = *(const u32x4*)(p.Y0 + (size_t)m * DM + n);
      float y[8], v[8];
#pragma unroll
      for (int i = 0; i < 4; ++i) { y[2 * i] = bflo(y0[i]); y[2 * i + 1] = bfhi(y0[i]); }
      float sm = 0.f;
#pragma unroll
      for (int i = 0; i < 8; ++i) sm += y[i];
      const float mu = red8(sm) * (1.f / 64.f);
      float qv = 0.f;
#pragma unroll
      for (int i = 0; i < 8; ++i) { y[i] -= mu; qv += y[i] * y[i]; }
      const float rs = rsqrtf(red8(qv) * (1.f / 64.f) + 64e-5f);
      load8(p.zA, m, 2048 + n, v);
      const float bon = 0.5f * (p.bdot[(size_t)m * 16 + h] + p.bdot[((size_t)NTOK + m) * 16 + h]);
      const f32x4 w0 = *(const f32x4*)(p.ln_x_w + n), w1 = *(const f32x4*)(p.ln_x_w + n + 4), b0 = *(const f32x4*)(p.ln_x_b + n), b1 = *(const f32x4*)(p.ln_x_b + n + 4);
      const float lw[8] = {w0[0], w0[1], w0[2], w0[3], w1[0], w1[1], w1[2], w1[3]}, lb[8] = {b0[0], b0[1], b0[2], b0[3], b1[0], b1[1], b1[2], b1[3]};
      u32x4 o;
#pragma unroll
      for (int i = 0; i < 4; ++i)
        o[i] = pack2((y[2 * i] * rs * lw[2 * i] + lb[2 * i] + bon * v[2 * i]) * bflo(g[i]), (y[2 * i + 1] * rs * lw[2 * i + 1] + lb[2 * i + 1] + bon * v[2 * i + 1]) * bfhi(g[i]));
      *(u32x4*)(p.out_a + (size_t)m * DM + n) = o;
    }
  }
};
__device__ __forceinline__ int xcd_tile(int vb, int nvb, int round, int TM, int TN, int& tm, int& tn) {
  if (nvb % 64 != 0) { const int it = round * nvb + vb; if (it >= TM * TN) return 0; tm = it % TM; tn = it / TM; return 1; }
  const int spg = nvb >> 3, g = vb & 7, slot = vb >> 3, SC = spg >> 3;
  const int nsr = (TM + 7) >> 3, nsc = (TN + SC - 1) / SC, st = round * 8 + g;
  if (st >= nsr * nsc) return 0;
  tm = (st % nsr) * 8 + (slot & 7); tn = (st / nsr) * SC + (slot >> 3);
  return (tm < TM && tn < TN) ? 1 : 2;
}
__device__ __forceinline__ void ph_gemm1(const P& p, int vb, int nvb, unsigned char* smem) {
  const int NS_ = 132 * 27, NALL = NS_ + 128 * 20;
  const int per = nvb >> 3;
  for (int round = 0;; ++round) {
    int item;
    if ((nvb & 7) == 0) { const int blk = round * 8 + (vb & 7); if (blk * per >= NALL) break; item = blk * per + (vb >> 3); if (item >= NALL) continue; }
    else { item = round * nvb + vb; if (item >= NALL) break; }
    if (item < NS_) {
      const int cgp = item / (132 * 9), rem = item % (132 * 9), tmS = rem / 9, tn = cgp * 9 + rem % 9;
      Epi3ZS epi;
      epi.zA = p.zA; epi.mu = p.mu_shift;
      int m0;
      if (tmS < 130) { const int b = tmS / 65, i = tmS % 65; m0 = b * SEQ + 254 * i - 1; epi.own_lo = 1; epi.own_hi = min(254, SEQ - 254 * i); epi.t0 = 254 * i - 1; epi.T = SEQ; }
      else { m0 = NTOK + (tmS - 130) * CTXL; epi.own_lo = 0; epi.own_hi = 255; epi.t0 = 0; epi.T = CTXL; }
      gemm_tile3_i8(p.hx8, DM, p.Wt8, DM, DM, m0, tn * 128, p.hsa, p.wsb, epi, smem);
    } else {
      const int i2 = item - NS_;
      int tm, tn;
      if (i2 < 2048) { tm = (i2 & 1023) >> 3; tn = 27 + (i2 >> 10) * 8 + (i2 & 7); } else { tm = (i2 - 2048) >> 2; tn = 43 + (i2 & 3); }
      Epi3Z epi{p.zA, p.zP, p.zG};
      gemm_tile3_i8(p.hx8, DM, p.Wt8, DM, DM, tm * 256, tn * 128, p.hsa, p.wsb, epi, smem);
    }
  }
}
__device__ __forceinline__ void ph_readout_gemm(const P& p, int vb, int nvb, unsigned char* smem) {
  Epi3Readout epi{&p};
  for (int round = 0;; ++round) {
    int tm, tn; const int r = xcd_tile(vb, nvb, round, NTOK / 256, DM / 128, tm, tn);
    if (r == 0) break;
    if (r == 1) gemm_tile3(p.zA + 3328, SHIFTC, p.g2T, 128, 128, tm * 256, tn * 128, epi, smem);
  }
}
__device__ __forceinline__ void ph_sg(const P& p, int vb, int nvb) {
  for (int it = vb * 256 + TIDX; it < NTOK * 16; it += nvb * 256) {
    const int m = it >> 4, l8 = (it & 15) * 8, t = m % SEQ;
    float o[8];
    load8(p.zA, m, 3328 + l8, o);
    u32x4 w;
#pragma unroll
    for (int i = 0; i < 4; ++i) w[i] = pack2(sigmoidf_(o[2 * i]), sigmoidf_(o[2 * i + 1]));
    *(u32x4*)(p.sg + (size_t)m * 128 + l8) = w;
  }
}
__device__ __forceinline__ void ph_gemm_merge(const P& p, int vb, int nvb, unsigned char* smem) {
  Epi3GateA ea{p.zG, p.b_gate, p.mrg};
  Epi3GateB eb{p.zG, p.b_gate, p.mrg};
  for (int round = 0;; ++round) {
    int tm, tn; const int r = xcd_tile(vb, nvb, round, NTOK / 256, DM / 128, tm, tn);
    if (r == 0) break;
    if (r == 1) {
      gemm_tile3(p.out_a, DM, p.Wt_aout, DM, DM, tm * 256, tn * 128, ea, smem);
      gemm_tile3(p.pooled, 512, p.Wt_eff, 512, 512, tm * 256, tn * 128, eb, smem);
    }
  }
}
__device__ __forceinline__ void ph_gemm_simple(const bf16_t* A, int lda, const bf16_t* Bt, int ldb, int K, int M, int N, bf16_t* C, int ldc, int vb, int nvb, unsigned char* smem) {
  Epi3StoreBf16 epi{C, ldc};
  for (int round = 0;; ++round) {
    int tm, tn; const int r = xcd_tile(vb, nvb, round, M / 256, N / 128, tm, tn);
    if (r == 0) break;
    if (r == 1) gemm_tile3(A, lda, Bt, ldb, K, tm * 256, tn * 128, epi, smem);
  }
}


#define O_R1 0
#define O_R2 10240
#define O_TA (O_R2 + 17408)
#define O_TR (O_TA + 4608)
#define O_TB (O_TR + 4608)
#define O_TK (O_TB + 4608)
#define O_TBT (O_TK + 4608)
#define O_TKT (O_TBT + 5120)
#define O_TVT (O_TKT + 5120)
#define O_GAM (O_TVT + 5120)
#define O_TST (O_GAM + 256)
#define RWKV_SMEM (O_TST + 2 * 9216)
#define NSUP 65
__device__ __forceinline__ void lds_wave_fence() { asm volatile("s_waitcnt lgkmcnt(0)" ::: "memory"); }
__device__ __forceinline__ u32x2 pack4(const f32x4& v) { u32x2 r; r.x = pack2(v[0], v[1]); r.y = pack2(v[2], v[3]); return r; }


typedef short s16x4 __attribute__((ext_vector_type(4)));
template <int NS, bool WANTY>
__device__ __forceinline__ void rwkv_chunk(const P& p, unsigned char* smem, int d, int h, int rowbase, int T, int isc0, bool has_next, f32x4 (&st)[NS][4], u32x4 (&pf)[5]) {
  int tid = TIDX;
  asm volatile("" : "+v"(tid));
  const int lane = tid & 63, w = __builtin_amdgcn_readfirstlane(tid >> 6), l15 = lane & 15, q = lane >> 4;
  const int tt = tid >> 3, cg = tid & 7, ch0 = h * 64 + cg * 8;
  const int isc = isc0 + tt, t = d == 0 ? isc : T - 1 - isc;
  bf16_t* TWD = (bf16_t*)(smem + O_R1); bf16_t* TAD = TWD + 32 * 72;
  float* WT = (float*)(smem + O_R1);
  bf16_t* XT = (bf16_t*)(smem + O_R1); bf16_t* UT = XT + 64 * 40;
  float* LW = (float*)(smem + O_R2); float* LA = LW + 32 * 68;
  float* TL = (float*)(smem + O_R2);
  bf16_t* TT = (bf16_t*)(smem + O_R2 + 4608); bf16_t* TAK = TT + 32 * 40; bf16_t* TRB = TAK + 32 * 40; bf16_t* TRK = TRB + 32 * 40; bf16_t* TLB = TRK + 32 * 40;
  bf16_t* TA = (bf16_t*)(smem + O_TA); bf16_t* TR = (bf16_t*)(smem + O_TR); bf16_t* TB = (bf16_t*)(smem + O_TB); bf16_t* TK = (bf16_t*)(smem + O_TK);
  bf16_t* TBT = (bf16_t*)(smem + O_TBT); bf16_t* TKT = (bf16_t*)(smem + O_TKT); bf16_t* TVT = (bf16_t*)(smem + O_TVT);
  float* GAM = (float*)(smem + O_GAM);
  bf16_t* TST = (bf16_t*)(smem + O_TST);
  __syncthreads();
  float k8[8], r8[8];
  *(u32x4*)(TWD + tt * 72 + cg * 8) = pf[0];
  *(u32x4*)(TAD + tt * 72 + cg * 8) = pf[1];
#pragma unroll
  for (int i = 0; i < 4; ++i) { k8[2 * i] = bflo(pf[2][i]); k8[2 * i + 1] = bfhi(pf[2][i]); if (WANTY) { r8[2 * i] = bflo(pf[3][i]); r8[2 * i + 1] = bfhi(pf[3][i]); } }
  const u32x4 vzc = pf[4];
  __syncthreads();
  {
    f32x4 lw[2], la[2];
    bf16x8 w2f[2], a2f[2];
#pragma unroll
    for (int ks = 0; ks < 2; ++ks) {
      w2f[ks] = *(const bf16x8*)(p.w2T + ((size_t)d * 1024 + h * 64 + 16 * w + l15) * 64 + 32 * ks + 8 * q);
      a2f[ks] = *(const bf16x8*)(p.a2T + ((size_t)d * 1024 + h * 64 + 16 * w + l15) * 64 + 32 * ks + 8 * q);
    }
#pragma unroll
    for (int it = 0; it < 2; ++it) { lw[it] = (f32x4){0.f, 0.f, 0.f, 0.f}; la[it] = (f32x4){0.f, 0.f, 0.f, 0.f}; }
#pragma unroll
    for (int ks = 0; ks < 2; ++ks)
#pragma unroll
      for (int it = 0; it < 2; ++it) {
        const bf16x8 aw = *(const bf16x8*)(TWD + (16 * it + l15) * 72 + 32 * ks + 8 * q);
        const bf16x8 aa = *(const bf16x8*)(TAD + (16 * it + l15) * 72 + 32 * ks + 8 * q);
        lw[it] = __builtin_amdgcn_mfma_f32_16x16x32_bf16(aw, w2f[ks], lw[it], 0, 0, 0);
        la[it] = __builtin_amdgcn_mfma_f32_16x16x32_bf16(aa, a2f[ks], la[it], 0, 0, 0);
      }
    {
      const float cw0 = p.w0[d * 1024 + h * 64 + 16 * w + l15];
      float tot0 = 0.f;
#pragma unroll
      for (int it = 0; it < 2; ++it) {
        float pr[4];
#pragma unroll
        for (int rg = 0; rg < 4; ++rg) {
          const float e = 0.87505707f * sigmoidf_(cw0 + lw[it][rg]);
          pr[rg] = rg == 0 ? e : pr[rg - 1] + e;
        }
        float x = pr[3];
        float y = __shfl_up(x, 16); if (q >= 1) x += y;
        y = __shfl_up(x, 32); if (q >= 2) x += y;
        const float base = (x - pr[3]) + (it == 1 ? tot0 : 0.f);
        if (it == 0) tot0 = __shfl(x, 48 + l15);
#pragma unroll
        for (int rg = 0; rg < 4; ++rg) lw[it][rg] = pr[rg] + base;
      }
      if (q == 3) GAM[16 * w + l15] = __builtin_amdgcn_exp2f(-lw[1][3]);
    }
#pragma unroll
    for (int it = 0; it < 2; ++it)
#pragma unroll
      for (int rg = 0; rg < 4; ++rg) { LW[(16 * it + 4 * q + rg) * 68 + 16 * w + l15] = lw[it][rg]; LA[(16 * it + 4 * q + rg) * 68 + 16 * w + l15] = la[it][rg]; }
  }
  __syncthreads();
  float icl[8], kkn[8], kd[8];
  {
    float ss = 0.f, bd = 0.f;
    float ca0[8], ckk[8], cka[8], crk[8];
#pragma unroll
    for (int e4 = 0; e4 < 8; e4 += 4) {
      const f32x4 b2 = *(const f32x4*)(p.a0 + d * 1024 + ch0 + e4), c2 = *(const f32x4*)(p.k_k + ch0 + e4);
      const f32x4 d2 = *(const f32x4*)(p.k_a + ch0 + e4), f2 = *(const f32x4*)(p.r_k + ch0 + e4);
#pragma unroll
      for (int e = 0; e < 4; ++e) { ca0[e4 + e] = b2[e]; ckk[e4 + e] = c2[e]; cka[e4 + e] = d2[e]; crk[e4 + e] = f2[e]; }
    }
    float lav[8];
    { const f32x4 l0 = *(const f32x4*)(LA + tt * 68 + cg * 8), l1 = *(const f32x4*)(LA + tt * 68 + cg * 8 + 4);
#pragma unroll
      for (int e = 0; e < 4; ++e) { lav[e] = l0[e]; lav[4 + e] = l1[e]; } }
#pragma unroll
    for (int e = 0; e < 8; ++e) {
      icl[e] = sigmoidf_(ca0[e] + lav[e]);
      kkn[e] = k8[e] * ckk[e]; ss += kkn[e] * kkn[e];
      kd[e] = k8[e] * (1.f + (icl[e] - 1.f) * cka[e]);
      if (WANTY) bd += r8[e] * kd[e] * crk[e];
    }
    ss = red8(ss); if (WANTY) bd = red8(bd);
    const float rn = rsqrtf(fmaxf(ss, 1e-24f));
#pragma unroll
    for (int e = 0; e < 8; ++e) kkn[e] *= rn;
    if (WANTY && cg == 0) p.bdot[((size_t)d * NTOK + rowbase + t) * 16 + h] = bd;
  }
  {
    float ta[8], tr[8], tb[8], tk[8], v8[8];
#pragma unroll
    for (int i = 0; i < 4; ++i) { v8[2 * i] = bflo(vzc[i]); v8[2 * i + 1] = bfhi(vzc[i]); }
    float Lv[8], Lpv[8];
    {
      const f32x4 a0 = *(const f32x4*)(LW + tt * 68 + cg * 8), a1 = *(const f32x4*)(LW + tt * 68 + cg * 8 + 4);
      const int tp = tt > 0 ? tt - 1 : 0;
      const f32x4 b0 = *(const f32x4*)(LW + tp * 68 + cg * 8), b1 = *(const f32x4*)(LW + tp * 68 + cg * 8 + 4);
#pragma unroll
      for (int e = 0; e < 4; ++e) { Lv[e] = a0[e]; Lv[4 + e] = a1[e]; Lpv[e] = tt > 0 ? b0[e] : 0.f; Lpv[4 + e] = tt > 0 ? b1[e] : 0.f; }
    }
#pragma unroll
    for (int e = 0; e < 8; ++e) {
      const float Li = Lv[e];
      const float Lp = Lpv[e];
      const float gi = __builtin_amdgcn_exp2f(-Li), gim1 = __builtin_amdgcn_exp2f(-Lp), ginv = __builtin_amdgcn_exp2f(Li);
      ta[e] = -kkn[e] * gim1; if (WANTY) tr[e] = r8[e] * gi; tb[e] = kkn[e] * icl[e] * ginv; tk[e] = kd[e] * ginv;
    }
    u32x4 pk;
    pk.x = pack2(ta[0], ta[1]); pk.y = pack2(ta[2], ta[3]); pk.z = pack2(ta[4], ta[5]); pk.w = pack2(ta[6], ta[7]); *(u32x4*)(TA + tt * 72 + cg * 8) = pk;
    if (WANTY) { pk.x = pack2(tr[0], tr[1]); pk.y = pack2(tr[2], tr[3]); pk.z = pack2(tr[4], tr[5]); pk.w = pack2(tr[6], tr[7]); *(u32x4*)(TR + tt * 72 + cg * 8) = pk; }
    pk.x = pack2(tb[0], tb[1]); pk.y = pack2(tb[2], tb[3]); pk.z = pack2(tb[4], tb[5]); pk.w = pack2(tb[6], tb[7]); *(u32x4*)(TB + tt * 72 + cg * 8) = pk;
    pk.x = pack2(tk[0], tk[1]); pk.y = pack2(tk[2], tk[3]); pk.z = pack2(tk[4], tk[5]); pk.w = pack2(tk[6], tk[7]); *(u32x4*)(TK + tt * 72 + cg * 8) = pk;
    { const int tts = tt ^ ((cg >> 1) << 3);
#pragma unroll
    for (int e = 0; e < 8; ++e) { TBT[(cg * 8 + e) * 40 + tts] = f2bf(tb[e]); TKT[(cg * 8 + e) * 40 + tts] = f2bf(tk[e]); TVT[(cg * 8 + e) * 40 + tts] = f2bf(v8[e]); } }
  }
  __syncthreads();
  if (WANTY || w < 2) {
    const bf16_t* X = (w < 2) ? TA : TR; const bf16_t* Y = (w & 1) ? TK : TB;
    f32x4 g[2][2];
#pragma unroll
    for (int it = 0; it < 2; ++it)
#pragma unroll
      for (int s2 = 0; s2 < 2; ++s2) g[it][s2] = (f32x4){0.f, 0.f, 0.f, 0.f};
#pragma unroll
    for (int ks = 0; ks < 2; ++ks) {
      bf16x8 xa[2], yb[2];
#pragma unroll
      for (int it = 0; it < 2; ++it) { xa[it] = *(const bf16x8*)(X + (16 * it + l15) * 72 + 32 * ks + 8 * q); yb[it] = *(const bf16x8*)(Y + (16 * it + l15) * 72 + 32 * ks + 8 * q); }
#pragma unroll
      for (int it = 0; it < 2; ++it)
#pragma unroll
        for (int s2 = 0; s2 < 2; ++s2) g[it][s2] = __builtin_amdgcn_mfma_f32_16x16x32_bf16(xa[it], yb[s2], g[it][s2], 0, 0, 0);
    }
    if (w == 0) {
#pragma unroll
      for (int it = 0; it < 2; ++it)
#pragma unroll
        for (int s2 = 0; s2 < 2; ++s2)
#pragma unroll
          for (int rg = 0; rg < 4; ++rg) {
            const int i = 16 * it + 4 * q + rg, s = 16 * s2 + l15;
            TL[i * 36 + s] = (s < i) ? g[it][s2][rg] : 0.f;
          }
#pragma unroll
      for (int rg = 0; rg < 4; ++rg) TLB[(4 * q + rg) * 40 + l15] = f2bf(g[1][0][rg]);
    } else {
      bf16_t* dst = w == 1 ? TAK : (w == 2 ? TRB : TRK);
      const int incl = w == 1 ? 0 : 1;
#pragma unroll
      for (int it = 0; it < 2; ++it)
#pragma unroll
        for (int s2 = 0; s2 < 2; ++s2)
#pragma unroll
          for (int rg = 0; rg < 4; ++rg) {
            const int i = 16 * it + 4 * q + rg, s = 16 * s2 + l15;
            dst[i * 40 + s] = f2bf((s < i + incl) ? g[it][s2][rg] : 0.f);
          }
    }
  }
  if (w == 0) {
    lds_wave_fence();
    const int c = lane & 15, hb = lane & 16;
    float Tr[16];
    f32x4 Lr[16][4];
#pragma unroll
    for (int i = 1; i < 16; ++i)
#pragma unroll
      for (int j4 = 0; j4 < (i + 3) / 4; ++j4) Lr[i][j4] = *(const f32x4*)(TL + (hb + i) * 36 + hb + 4 * j4);
#pragma unroll
    for (int i = 0; i < 16; ++i) {
      float acc = (i == c) ? 1.f : 0.f;
#pragma unroll
      for (int j = 0; j < i; ++j) acc += Lr[i][j >> 2][j & 3] * Tr[j];
      Tr[i] = acc;
    }
    if (lane < 32) {
#pragma unroll
      for (int i = 0; i < 16; ++i) TT[(hb + i) * 40 + hb + c] = f2bf(Tr[i]);
    }
  }
  __syncthreads();
  if (has_next) {
    const int isn = isc + 32, tn = d == 0 ? isn : T - 1 - isn;
    const bf16_t* zr = p.zA + (size_t)(rowbase + tn) * SHIFTC;
    pf[0] = *(const u32x4*)(zr + 3072 + d * 64 + cg * 8);
    pf[1] = *(const u32x4*)(zr + 3200 + d * 64 + cg * 8);
    pf[2] = *(const u32x4*)(zr + 1024 + ch0);
    if (WANTY) pf[3] = *(const u32x4*)(zr + ch0);
    pf[4] = *(const u32x4*)(zr + 2048 + ch0);
  }
  bf16_t yprev[2][4];
  if (WANTY) {
#pragma unroll
    for (int it = 0; it < 2; ++it)
#pragma unroll
      for (int rg = 0; rg < 4; ++rg) {
        yprev[it][rg] = 0;
        if (d == 1) yprev[it][rg] = p.Y0[(size_t)(rowbase + T - 1 - (isc0 + 16 * it + 4 * q + rg)) * DM + h * 64 + 16 * w + l15];
      }
  }
  const bf16x8 vfr = *(const bf16x8*)(TVT + (16 * w + l15) * 40 + 8 * (q ^ w));
  const s16x4 t1f = *(const s16x4*)(TT + l15 * 40 + 4 * q), t2f = *(const s16x4*)(TT + (16 + l15) * 40 + 16 + 4 * q), l21f = *(const s16x4*)(TLB + l15 * 40 + 4 * q);
  bf16_t* XTw = XT + (16 * w + l15) * 40; bf16_t* UTw = UT + (16 * w + l15) * 40;
#pragma unroll
  for (int si = 0; si < NS; ++si) {
    const bool useV = (NS == 1) || (si == 1);
    const bf16_t* STs = TST + (si * 64 + 16 * w + l15) * 72;
    bf16x8 sf[2];
    sf[0] = *(const bf16x8*)(STs + 8 * q); sf[1] = *(const bf16x8*)(STs + 32 + 8 * q);
    f32x4 xa[2];
#pragma unroll
    for (int it = 0; it < 2; ++it) {
      xa[it] = (f32x4){0.f, 0.f, 0.f, 0.f};
#pragma unroll
      for (int ks = 0; ks < 2; ++ks) xa[it] = __builtin_amdgcn_mfma_f32_16x16x32_bf16(*(const bf16x8*)(TA + (16 * it + l15) * 72 + 32 * ks + 8 * q), sf[ks], xa[it], 0, 0, 0);
      if (useV) xa[it] = __builtin_amdgcn_mfma_f32_16x16x32_bf16(*(const bf16x8*)(TAK + (16 * it + l15) * 40 + 8 * q), vfr, xa[it], 0, 0, 0);
    }
    *(u32x2*)(XTw + 4 * q) = pack4(xa[0]);
    lds_wave_fence();
    f32x4 ua = __builtin_amdgcn_mfma_f32_16x16x16bf16_1k(t1f, *(const s16x4*)(XTw + 4 * q), (f32x4){0.f, 0.f, 0.f, 0.f}, 0, 0, 0);
    *(u32x2*)(UTw + 4 * q) = pack4(ua);
    lds_wave_fence();
    xa[1] = __builtin_amdgcn_mfma_f32_16x16x16bf16_1k(l21f, *(const s16x4*)(UTw + 4 * q), xa[1], 0, 0, 0);
    *(u32x2*)(XTw + 16 + 4 * q) = pack4(xa[1]);
    lds_wave_fence();
    ua = __builtin_amdgcn_mfma_f32_16x16x16bf16_1k(t2f, *(const s16x4*)(XTw + 16 + 4 * q), (f32x4){0.f, 0.f, 0.f, 0.f}, 0, 0, 0);
    *(u32x2*)(UTw + 16 + 4 * q) = pack4(ua);
    lds_wave_fence();
    const bf16x8 uf = *(const bf16x8*)(UTw + 8 * q);
    if (WANTY) {
#pragma unroll
      for (int it = 0; it < 2; ++it) {
        f32x4 ya = (f32x4){0.f, 0.f, 0.f, 0.f};
#pragma unroll
        for (int ks = 0; ks < 2; ++ks) ya = __builtin_amdgcn_mfma_f32_16x16x32_bf16(*(const bf16x8*)(TR + (16 * it + l15) * 72 + 32 * ks + 8 * q), sf[ks], ya, 0, 0, 0);
        ya = __builtin_amdgcn_mfma_f32_16x16x32_bf16(*(const bf16x8*)(TRB + (16 * it + l15) * 40 + 8 * q), uf, ya, 0, 0, 0);
        if (useV) ya = __builtin_amdgcn_mfma_f32_16x16x32_bf16(*(const bf16x8*)(TRK + (16 * it + l15) * 40 + 8 * q), vfr, ya, 0, 0, 0);
#pragma unroll
        for (int rg = 0; rg < 4; ++rg) {
          const int iq = isc0 + 16 * it + 4 * q + rg, tq = d == 0 ? iq : T - 1 - iq;
          if (useV) {
            p.Y0[(size_t)(rowbase + tq) * DM + h * 64 + 16 * w + l15] = f2bf(ya[rg] + bf2f(yprev[it][rg]));
          } else {
            bf16_t* pp = d == 0 ? p.Y1 + (size_t)(rowbase + tq) * DM : p.zA + (size_t)(rowbase + tq) * SHIFTC;
            pp[h * 64 + 16 * w + l15] = f2bf(ya[rg]);
          }
        }
      }
    }
#pragma unroll
    for (int kt = 0; kt < 4; ++kt) {
      f32x4 hv = st[si][kt];
      hv = __builtin_amdgcn_mfma_f32_16x16x32_bf16(*(const bf16x8*)(TBT + (16 * kt + l15) * 40 + 8 * (q ^ kt)), uf, hv, 0, 0, 0);
      if (useV) hv = __builtin_amdgcn_mfma_f32_16x16x32_bf16(*(const bf16x8*)(TKT + (16 * kt + l15) * 40 + 8 * (q ^ kt)), vfr, hv, 0, 0, 0);
      hv *= *(const f32x4*)(GAM + 16 * kt + 4 * q);
      st[si][kt] = hv;
      *(u32x2*)(TST + (si * 64 + 16 * w + l15) * 72 + 16 * kt + 4 * q) = pack4(hv);
    }
  }
}

template <bool WANTY>
__device__ __forceinline__ void rwkv_prefetch_first(const P& p, int d, int h, int rowbase, int T, int isc0, u32x4 (&pf)[5]) {
  const int tid = TIDX, tt = tid >> 3, cg = tid & 7, ch0 = h * 64 + cg * 8, isc = isc0 + tt, t = d == 0 ? isc : T - 1 - isc;
  const bf16_t* zr = p.zA + (size_t)(rowbase + t) * SHIFTC;
  pf[0] = *(const u32x4*)(zr + 3072 + d * 64 + cg * 8);
  pf[1] = *(const u32x4*)(zr + 3200 + d * 64 + cg * 8);
  pf[2] = *(const u32x4*)(zr + 1024 + ch0);
  pf[3] = WANTY ? *(const u32x4*)(zr + ch0) : (u32x4){0u, 0u, 0u, 0u};
  pf[4] = *(const u32x4*)(zr + 2048 + ch0);
}
template <bool LAT>
__device__ __forceinline__ void rwkv_super(const P& p, unsigned char* smem, int chain, int j) {
  const int tid = TIDX, lane = tid & 63, w = tid >> 6, l15 = lane & 15, q = lane >> 4;
  bf16_t* TST = (bf16_t*)(smem + O_TST);
  const int b = chain >> 5, d = (chain >> 4) & 1, h = chain & 15;
  const int T = LAT ? SEQ : CTXL, rowbase = LAT ? b * SEQ : NTOK + b * CTXL, base = LAT ? (j - 1) * 256 : 0;
  f32x4 st[2][4];
  __syncthreads();
#pragma unroll
  for (int kt = 0; kt < 4; ++kt) {
#pragma unroll
    for (int rg = 0; rg < 4; ++rg) st[0][kt][rg] = (16 * kt + 4 * q + rg == 16 * w + l15) ? 1.f : 0.f;
    st[1][kt] = (f32x4){0.f, 0.f, 0.f, 0.f};
    *(u32x2*)(TST + (16 * w + l15) * 72 + 16 * kt + 4 * q) = pack4(st[0][kt]);
    *(u32x2*)(TST + (64 + 16 * w + l15) * 72 + 16 * kt + 4 * q) = pack4(st[1][kt]);
  }
  u32x4 pf[5]; rwkv_prefetch_first<LAT>(p, d, h, rowbase, T, base, pf);
  for (int c = 0; c < 8; ++c) rwkv_chunk<2, LAT>(p, smem, d, h, rowbase, T, base + 32 * c, c < 7, st, pf);
  if (j < 64) {
    const size_t slot = (size_t)chain * NSUP + j;
#pragma unroll
    for (int kt = 0; kt < 4; ++kt) {
#pragma unroll
      for (int rg = 0; rg < 4; ++rg) p.Mst[(slot * 64 + 16 * kt + 4 * q + rg) * 64 + 16 * w + l15] = f2bf(st[0][kt][rg]);
      *(f32x4*)(p.Nst + (slot * 64 + 16 * w + l15) * 64 + 16 * kt + 4 * q) = st[1][kt];
    }
  }
}
__device__ __forceinline__ void ph_rwkv_A(const P& p, int vb, int nvb, unsigned char* smem) {
  for (int chain = vb; chain < 64; chain += nvb) rwkv_super<false>(p, smem, chain, 0);
  for (int item = vb; item < 2048; item += nvb) {
    const int b = item >> 10, J = (item >> 4) & 63, h = item & 15;
#pragma unroll 1
    for (int d = 0; d < 2; ++d) {
      rwkv_super<true>(p, smem, b * 32 + d * 16 + h, d == 0 ? J + 1 : 64 - J);
      asm volatile("s_waitcnt vmcnt(0)" ::: "memory");
      __syncthreads();
    }
  }
}
__device__ __forceinline__ void ph_rwkv_B(const P& p, int vb, int nvb, unsigned char* smem) {
  const int tid = TIDX, lane = tid & 63, w = tid >> 6, l15 = lane & 15, q = lane >> 4;
  bf16_t* HT = (bf16_t*)smem;
  for (int chain = vb; chain < 64; chain += nvb) {
    f32x4 hs[4];
#pragma unroll
    for (int kt = 0; kt < 4; ++kt) hs[kt] = (f32x4){0.f, 0.f, 0.f, 0.f};
    __syncthreads();
    for (int j = 0; j < 64; ++j) {
      const size_t slot = (size_t)chain * NSUP + j;
      f32x4 nv[4];
#pragma unroll
      for (int kt = 0; kt < 4; ++kt) nv[kt] = *(const f32x4*)(p.Nst + (slot * 64 + 16 * w + l15) * 64 + 16 * kt + 4 * q);
      bf16x8 mf[4][2];
#pragma unroll
      for (int kt = 0; kt < 4; ++kt)
#pragma unroll
        for (int ks = 0; ks < 2; ++ks) mf[kt][ks] = *(const bf16x8*)(p.Mst + (slot * 64 + 16 * kt + l15) * 64 + 32 * ks + 8 * q);
#pragma unroll
      for (int kt = 0; kt < 4; ++kt) {
        *(f32x4*)(p.Nst + (slot * 64 + 16 * w + l15) * 64 + 16 * kt + 4 * q) = hs[kt];
        *(u32x2*)(HT + (16 * w + l15) * 72 + 16 * kt + 4 * q) = pack4(hs[kt]);
      }
      lds_wave_fence();
      bf16x8 hf[2];
      hf[0] = *(const bf16x8*)(HT + (16 * w + l15) * 72 + 8 * q); hf[1] = *(const bf16x8*)(HT + (16 * w + l15) * 72 + 32 + 8 * q);
      lds_wave_fence();
#pragma unroll
      for (int kt = 0; kt < 4; ++kt) {
        f32x4 a = nv[kt];
#pragma unroll
        for (int ks = 0; ks < 2; ++ks) a = __builtin_amdgcn_mfma_f32_16x16x32_bf16(mf[kt][ks], hf[ks], a, 0, 0, 0);
        hs[kt] = a;
      }
    }
    const size_t slot = (size_t)chain * NSUP + 64;
#pragma unroll
    for (int kt = 0; kt < 4; ++kt) *(f32x4*)(p.Nst + (slot * 64 + 16 * w + l15) * 64 + 16 * kt + 4 * q) = hs[kt];
  }
}
#define YC_LD 136
__device__ __forceinline__ void ph_ycorr(const P& p, int vb, int nvb, unsigned char* smem) {
  const int tid = TIDX, lane = tid & 63, w = tid >> 6, l15 = lane & 15, q = lane >> 4;
  bf16_t* HL = (bf16_t*)smem;
  bf16_t* GL = HL + 64 * YC_LD;
  for (int item = vb; item < 2048; item += nvb) {
    const int b = item >> 10, J = (item >> 4) & 63, h = item & 15;
    const size_t tok0 = (size_t)b * SEQ + J * 256 + 64 * w;
    __syncthreads();
    {
      const int v = tid >> 2, k0 = (tid & 3) * 32;
      const size_t slot = k0 < 64 ? (size_t)(b * 32 + h) * NSUP + (J + 1) : (size_t)(b * 32 + 16 + h) * NSUP + (64 - J);
      const float* src = p.Nst + (slot * 64 + v) * 64 + (k0 & 63);
#pragma unroll
      for (int i = 0; i < 4; ++i) {
        const f32x4 a = *(const f32x4*)(src + 8 * i), c = *(const f32x4*)(src + 8 * i + 4);
        *(u32x4*)(HL + v * YC_LD + k0 + 8 * i) = (u32x4){pack2(a[0], a[1]), pack2(a[2], a[3]), pack2(c[0], c[1]), pack2(c[2], c[3])};
        *(u32x4*)(GL + v * YC_LD + k0 + 8 * i) = *(const u32x4*)(p.g2T + (size_t)(h * 64 + v) * 128 + k0 + 8 * i);
      }
    }
    bf16x8 pa[4], sgf[4]; u32x2 yo[4], vv[4]; float bd0, bd1;
#define YC_LOAD(MT) { const size_t tk = tok0 + 16 * (MT) + l15; \
      _Pragma("unroll") for (int kk = 0; kk < 2; ++kk) { pa[kk] = *(const bf16x8*)(p.Y1 + tk * DM + h * 64 + 32 * kk + 8 * q); pa[2 + kk] = *(const bf16x8*)(p.zA + tk * SHIFTC + h * 64 + 32 * kk + 8 * q); } \
      _Pragma("unroll") for (int kk = 0; kk < 4; ++kk) sgf[kk] = *(const bf16x8*)(p.zA + tk * SHIFTC + 3328 + 32 * kk + 8 * q); \
      _Pragma("unroll") for (int nt = 0; nt < 4; ++nt) { yo[nt] = *(const u32x2*)(p.Y0 + tk * DM + h * 64 + 16 * nt + 4 * q); vv[nt] = *(const u32x2*)(p.zA + tk * SHIFTC + 2048 + h * 64 + 16 * nt + 4 * q); } \
      bd0 = p.bdot[tk * 16 + h]; bd1 = p.bdot[((size_t)NTOK + tk) * 16 + h]; }
    __syncthreads();
#pragma unroll 1
    for (int mt = 0; mt < 4; ++mt) {
      asm volatile("" ::: "memory");
      const size_t tok = tok0 + 16 * mt + l15;
      YC_LOAD(mt);
      bf16x8 cpa[4], csg[4]; u32x2 cyo[4], cvv[4];
#pragma unroll
      for (int i = 0; i < 4; ++i) { cpa[i] = pa[i]; csg[i] = sgf[i]; cyo[i] = yo[i]; cvv[i] = vv[i]; }
      const float bon = 0.5f * (bd0 + bd1);
      f32x4 yv[4], gv[4];
      float sm = 0.f;
#pragma unroll
      for (int nt = 0; nt < 4; ++nt) {
        f32x4 acc = (f32x4){bflo(cyo[nt].x), bfhi(cyo[nt].x), bflo(cyo[nt].y), bfhi(cyo[nt].y)};
        f32x4 g = (f32x4){0.f, 0.f, 0.f, 0.f};
#pragma unroll
        for (int kk = 0; kk < 4; ++kk) {
          acc = __builtin_amdgcn_mfma_f32_16x16x32_bf16(*(const bf16x8*)(HL + (16 * nt + l15) * YC_LD + 32 * kk + 8 * q), cpa[kk], acc, 0, 0, 0);
          g = __builtin_amdgcn_mfma_f32_16x16x32_bf16(*(const bf16x8*)(GL + (16 * nt + l15) * YC_LD + 32 * kk + 8 * q), csg[kk], g, 0, 0, 0);
        }
        yv[nt] = acc; gv[nt] = g;
        sm += (acc[0] + acc[1]) + (acc[2] + acc[3]);
      }
      sm += __shfl_xor(sm, 16); sm += __shfl_xor(sm, 32);
      const float mu = sm * (1.f / 64.f);
      float qv = 0.f;
#pragma unroll
      for (int nt = 0; nt < 4; ++nt)
#pragma unroll
        for (int rg = 0; rg < 4; ++rg) { yv[nt][rg] -= mu; qv += yv[nt][rg] * yv[nt][rg]; }
      qv += __shfl_xor(qv, 16); qv += __shfl_xor(qv, 32);
      const float rs = rsqrtf(qv * (1.f / 64.f) + 64e-5f);
#pragma unroll
      for (int nt = 0; nt < 4; ++nt) {
        const f32x4 v4 = (f32x4){bflo(cvv[nt].x), bfhi(cvv[nt].x), bflo(cvv[nt].y), bfhi(cvv[nt].y)};
        const f32x4 lw = *(const f32x4*)(p.ln_x_w + h * 64 + 16 * nt + 4 * q), lb = *(const f32x4*)(p.ln_x_b + h * 64 + 16 * nt + 4 * q);
        f32x4 o;
#pragma unroll
        for (int rg = 0; rg < 4; ++rg) o[rg] = (yv[nt][rg] * rs * lw[rg] + lb[rg] + bon * v4[rg]) * gv[nt][rg];
        *(u32x2*)(p.out_a + tok * DM + h * 64 + 16 * nt + 4 * q) = pack4(o);
      }
    }
#undef YC_LOAD
  }
  __syncthreads();
}

#define POOL_SMEM (64 * 128 * 4)
__device__ __forceinline__ void ph_pool(const P& p, int vb, int nvb, unsigned char* smem) {
  float* V = (float*)smem;
  const int tid = TIDX, cp = tid & 63, cq = tid >> 6;
  for (int item = vb; item < 2 * 4 * 64; item += nvb) {
    const int j = item & 3, st = (item >> 2) & 63, b = item >> 8;
    const int win = 2 << j, half = win >> 1;
    const bf16_t* zb = p.zP + (size_t)b * SEQ * 512 + j * 128 + cp * 2;
    float a0[16], a1[16];
#pragma unroll
    for (int i = 0; i < 16; ++i) { a0[i] = 0.f; a1[i] = 0.f; }
    {
      const int r = 4 * st, r0 = max(r - half, 0), r1 = min(r + half, 256);
      for (int rr = r0; rr < r1; ++rr) {
#pragma unroll
        for (int i = 0; i < 16; ++i) { const unsigned u = *(const unsigned*)(zb + (size_t)(rr * 64 + cq * 16 + i) * 512); a0[i] += bflo(u); a1[i] += bfhi(u); }
      }
    }
    for (int dr = 0; dr < 4; ++dr) {
      const int r = 4 * st + dr, r0 = max(r - half, 0), r1 = min(r + half, 256);
      if (dr > 0) {
        const int radd = r + half - 1, rsub = r - half - 1;
        if (radd < 256) {
#pragma unroll
          for (int i = 0; i < 16; ++i) { const unsigned u = *(const unsigned*)(zb + (size_t)(radd * 64 + cq * 16 + i) * 512); a0[i] += bflo(u); a1[i] += bfhi(u); }
        }
        if (rsub >= 0) {
#pragma unroll
          for (int i = 0; i < 16; ++i) { const unsigned u = *(const unsigned*)(zb + (size_t)(rsub * 64 + cq * 16 + i) * 512); a0[i] -= bflo(u); a1[i] -= bfhi(u); }
        }
      }
      __syncthreads();
#pragma unroll
      for (int i = 0; i < 16; ++i) *(f32x2*)(V + (cq * 16 + i) * 128 + cp * 2) = (f32x2){a0[i], a1[i]};
      __syncthreads();
      float s0 = 0.f, s1 = 0.f;
      {
        const int c = cq * 16, c0 = max(c - half, 0), c1 = min(c + half, 64);
        for (int cc = c0; cc < c1; ++cc) { const f32x2 v = *(const f32x2*)(V + cc * 128 + cp * 2); s0 += v.x; s1 += v.y; }
      }
#pragma unroll
      for (int i = 0; i < 16; ++i) {
        const int c = cq * 16 + i, c0 = max(c - half, 0), c1 = min(c + half, 64);
        if (i > 0) {
          const int cadd = c + half - 1, csub = c - half - 1;
          if (cadd < 64) { const f32x2 v = *(const f32x2*)(V + cadd * 128 + cp * 2); s0 += v.x; s1 += v.y; }
          if (csub >= 0) { const f32x2 v = *(const f32x2*)(V + csub * 128 + cp * 2); s0 -= v.x; s1 -= v.y; }
        }
        const float inv = __builtin_amdgcn_rcpf((float)((r1 - r0) * (c1 - c0)));
        const size_t tokoff = ((size_t)b * SEQ + r * 64 + c) * 512 + j * 128 + cp * 2;
        const unsigned u = *(const unsigned*)(p.zP + tokoff);
        *(unsigned*)(p.pooled + tokoff) = pack2(s0 * inv - bflo(u), s1 * inv - bfhi(u));
      }
    }
  }
}
__device__ __forceinline__ void ph_res1(const P& p, int vb, int nvb) {
  const int lane = TIDX & 63, wid = TIDX >> 6;
  for (int m = vb * 4 + wid; m < NTOK; m += nvb * 4) {
    const float* md = p.mod + (m / SEQ) * 6144;
    float mx[16]; float ss = 0.f;
#pragma unroll
    for (int i = 0; i < 4; ++i) {
      const uint2 u = *(const uint2*)(p.mix + (size_t)m * DM + i * 256 + lane * 4);
      mx[4 * i] = bflo(u.x); mx[4 * i + 1] = bfhi(u.x); mx[4 * i + 2] = bflo(u.y); mx[4 * i + 3] = bfhi(u.y);
#pragma unroll
      for (int e = 0; e < 4; ++e) ss += mx[4 * i + e] * mx[4 * i + e];
    }
    ss = wave_sum(ss);
    const float rstd = rsqrtf(ss * (1.0f / 1024.0f) + 1e-6f);
    float x1[16]; float s2 = 0.f;
#pragma unroll
    for (int i = 0; i < 4; ++i) {
      const int col = i * 256 + lane * 4;
      const float4 xv = *(const float4*)(p.x + (size_t)m * DM + col), g = *(const float4*)(p.g_post_mix + col), gt = *(const float4*)(md + 2048 + col);
      x1[4 * i] = xv.x + gt.x * mx[4 * i] * rstd * g.x; x1[4 * i + 1] = xv.y + gt.y * mx[4 * i + 1] * rstd * g.y;
      x1[4 * i + 2] = xv.z + gt.z * mx[4 * i + 2] * rstd * g.z; x1[4 * i + 3] = xv.w + gt.w * mx[4 * i + 3] * rstd * g.w;
      { uint2 xb; xb.x = pack2(x1[4 * i], x1[4 * i + 1]); xb.y = pack2(x1[4 * i + 2], x1[4 * i + 3]); *(uint2*)(p.x1b + (size_t)m * DM + col) = xb; }
#pragma unroll
      for (int e = 0; e < 4; ++e) s2 += x1[4 * i + e] * x1[4 * i + e];
    }
    s2 = wave_sum(s2);
    const float r2 = rsqrtf(s2 * (1.0f / 1024.0f) + 1e-6f);
#pragma unroll
    for (int i = 0; i < 4; ++i) {
      const int col = i * 256 + lane * 4;
      const float4 g = *(const float4*)(p.g_pre_ffn + col), sh = *(const float4*)(md + 3072 + col), sc = *(const float4*)(md + 4096 + col);
      uint2 w;
      w.x = pack2(x1[4 * i] * r2 * g.x * (1.f + sc.x) + sh.x, x1[4 * i + 1] * r2 * g.y * (1.f + sc.y) + sh.y);
      w.y = pack2(x1[4 * i + 2] * r2 * g.z * (1.f + sc.z) + sh.z, x1[4 * i + 3] * r2 * g.w * (1.f + sc.w) + sh.w);
      *(uint2*)(p.hx2 + (size_t)m * DM + col) = w;
    }
  }
}

#define PS1_SMEM (128 * 133 * 4)
#define CE_DESC(a, b) { const float _mx = fmaxf(a, b), _mn = fminf(a, b); a = _mx; b = _mn; }
template <int N> __device__ __forceinline__ void bitonic_sort_desc(float (&v)[N]) {
#pragma unroll
  for (int k = 2; k <= N; k <<= 1)
#pragma unroll
    for (int j = k >> 1; j > 0; j >>= 1)
#pragma unroll
      for (int i = 0; i < N; ++i) { const int l = i ^ j; if (l > i) { if ((i & k) == 0) CE_DESC(v[i], v[l]) else CE_DESC(v[l], v[i]) } }
}
__device__ __forceinline__ void bitonic_merge16_desc(float (&v)[16]) {
#pragma unroll
  for (int j = 8; j > 0; j >>= 1)
#pragma unroll
    for (int i = 0; i < 16; ++i) { const int l = i ^ j; if (l > i) CE_DESC(v[i], v[l]) }
}
__device__ __forceinline__ void ph_peer_s1(const P& p, int vb, int nvb, unsigned char* smem) {
  float* S = (float*)smem;
  EpiLds epi{S};
  const int tid = TIDX, sub = tid & 3;
  for (int item = vb; item < 256 * 16; item += nvb) {
    const int hp = item & 15, tm = item >> 4;
    __syncthreads();
    gemm_tile(p.q + hp * 128, 2048, p.keys + (size_t)hp * 128 * 128, 128, 128, tm * 128, 0, epi, smem);
    __syncthreads();
#pragma unroll 1
    for (int pass = 0; pass < 2; ++pass) {
      const int row = pass * 64 + (tid >> 2);
      float a[16], b[16];
#pragma unroll
      for (int i = 0; i < 16; ++i) {
        a[i] = __uint_as_float((__float_as_uint(S[row * 133 + sub * 33 + i]) & ~127u) | (unsigned)(sub * 32 + i));
        b[i] = __uint_as_float((__float_as_uint(S[row * 133 + sub * 33 + 16 + i]) & ~127u) | (unsigned)(sub * 32 + 16 + i));
      }
      bitonic_sort_desc<16>(a); bitonic_sort_desc<16>(b);
#pragma unroll
      for (int i = 0; i < 16; ++i) a[i] = fmaxf(a[i], b[15 - i]);
      bitonic_merge16_desc(a);
#pragma unroll
      for (int lvl = 1; lvl <= 2; lvl <<= 1) {
#pragma unroll
        for (int i = 0; i < 16; ++i) b[i] = __shfl_xor(a[i], lvl);
#pragma unroll
        for (int i = 0; i < 16; ++i) a[i] = fmaxf(a[i], b[15 - i]);
        bitonic_merge16_desc(a);
      }
      if (sub == 0) {
        const size_t ob = ((size_t)(tm * 128 + row) * 16 + hp) * 16;
#pragma unroll
        for (int i = 0; i < 16; i += 4) {
          *(f32x4*)(p.sv + ob + i) = (f32x4){a[i], a[i + 1], a[i + 2], a[i + 3]};
          typedef int i32x4 __attribute__((ext_vector_type(4)));
          *(i32x4*)(p.si + ob + i) = (i32x4){(int)(__float_as_uint(a[i]) & 127u), (int)(__float_as_uint(a[i + 1]) & 127u), (int)(__float_as_uint(a[i + 2]) & 127u), (int)(__float_as_uint(a[i + 3]) & 127u)};
        }
      }
    }
  }
}
__device__ __forceinline__ void top16_merge(float (&x)[16], const float (&y)[16]) {
#pragma unroll
  for (int i = 0; i < 16; ++i) x[i] = fmaxf(x[i], y[15 - i]);
  bitonic_merge16_desc(x);
}
__device__ __forceinline__ void ph_peer_s2(const P& p, int vb, int nvb, unsigned char* smem) {
  unsigned char* lut = smem;
  __syncthreads();
  if (TIDX == 0) {
    int n = 0;
#pragma unroll
    for (int i = 0; i < 16; ++i)
#pragma unroll
      for (int j = 0; j < 16; ++j)
        if ((i + 1) * (j + 1) <= 16) { lut[n] = (unsigned char)((i << 4) | j); ++n; }
  }
  __syncthreads();
  for (int it = vb * 256 + TIDX; it < NTOK * 8; it += nvb * 256) {
    const size_t ob = (size_t)it * 32;
    float a[16], bq[16];
#pragma unroll
    for (int i = 0; i < 16; i += 4) {
      const f32x4 fa = *(const f32x4*)(p.sv + ob + i), fb = *(const f32x4*)(p.sv + ob + 16 + i);
#pragma unroll
      for (int e = 0; e < 4; ++e) { a[i + e] = fa[e]; bq[i + e] = fb[e]; }
    }
    float g0[16], g1[16], g2[16], g3[16];
    {
      int n = 0;
#pragma unroll
      for (int i = 0; i < 16; ++i)
#pragma unroll
        for (int j = 0; j < 16; ++j)
          if ((i + 1) * (j + 1) <= 16) {
            const float v = __uint_as_float((__float_as_uint(a[i] + bq[j]) & ~63u) | (unsigned)n);
            if (n < 16) g0[n] = v; else if (n < 32) g1[n - 16] = v; else if (n < 48) g2[n - 32] = v; else g3[n - 48] = v;
            ++n;
          }
#pragma unroll
      for (int k = 2; k < 16; ++k) g3[k] = -3.0e38f;
    }
    bitonic_sort_desc<16>(g0); bitonic_sort_desc<16>(g1); bitonic_sort_desc<16>(g2); bitonic_sort_desc<16>(g3);
    top16_merge(g0, g1); top16_merge(g2, g3); top16_merge(g0, g2);
    float den = 0.f; float ex[16]; int seli[16];
#pragma unroll
    for (int k = 0; k < 16; ++k) {
      ex[k] = __expf(g0[k] - g0[0]); den += ex[k];
      const int ij = lut[__float_as_uint(g0[k]) & 63u];
      const int ka = (int)(__float_as_uint(p.sv[ob + (ij >> 4)]) & 127u), kb = (int)(__float_as_uint(p.sv[ob + 16 + (ij & 15)]) & 127u);
      seli[k] = ka * 128 + kb;
    }
    const float inv = 1.0f / den;
    const size_t o2 = (size_t)it * 16;
    typedef int i32x4 __attribute__((ext_vector_type(4)));
#pragma unroll
    for (int k = 0; k < 16; k += 4) {
      *(i32x4*)(p.pidx + o2 + k) = (i32x4){seli[k], seli[k + 1], seli[k + 2], seli[k + 3]};
      *(f32x4*)(p.pgate + o2 + k) = (f32x4){ex[k] * inv, ex[k + 1] * inv, ex[k + 2] * inv, ex[k + 3] * inv};
    }
  }
}
typedef float f32x16 __attribute__((ext_vector_type(16)));
typedef float f32x32 __attribute__((ext_vector_type(32)));
typedef unsigned u32x6 __attribute__((ext_vector_type(6)));
__device__ __forceinline__ float gelu_as(float v) {
  const float t = __builtin_amdgcn_rcpf(fabsf(v) * 0.2316418882f + 1.0f);
  float qq = t * 0.5307027145f + (-0.7265760135f); qq = qq * t + 0.7107068705f; qq = qq * t + (-0.142248368f); qq = qq * t + 0.127414796f; qq = qq * t;
  const float m = v * (qq * __builtin_amdgcn_exp2f((v * v) * (-0.72134752044f)));
  return v < 0.f ? m : v - m;
}
__device__ __forceinline__ float half_max(float v) {
#pragma unroll
  for (int o = 16; o > 0; o >>= 1) v = fmaxf(v, __shfl_xor(v, o));
  return v;
}
__device__ __forceinline__ float half_sum(float v) {
#pragma unroll
  for (int o = 16; o > 0; o >>= 1) v += __shfl_xor(v, o);
  return v;
}
__device__ __forceinline__ void ph_cvt_fp6(const float* __restrict__ in, unsigned char* __restrict__ out, float* __restrict__ inv_scale, int vb, int nvb) {
  const int lane = TIDX & 63, wid = TIDX >> 6, hf = lane >> 5, sl = lane & 31;
  for (int rp = vb * 4 + wid; rp < 8192; rp += nvb * 4) {
    const int row = rp * 2 + hf;
    f32x16 a, b2; float am = 0.f;
#pragma unroll
    for (int i = 0; i < 4; ++i) {
      const f32x4 v0 = *(const f32x4*)(in + (size_t)row * DM + sl * 32 + 4 * i), v1 = *(const f32x4*)(in + (size_t)row * DM + sl * 32 + 16 + 4 * i);
#pragma unroll
      for (int e = 0; e < 4; ++e) { a[4 * i + e] = v0[e]; b2[4 * i + e] = v1[e]; am = fmaxf(am, fmaxf(fabsf(v0[e]), fabsf(v1[e]))); }
    }
    am = half_max(am);
    const float sc = am > 0.f ? 7.0f / am : 1.0f;
    const u32x6 pk = __builtin_amdgcn_cvt_scalef32_2xpk16_fp6_f32(a * sc, b2 * sc, 1.0f);
    unsigned char* o = out + (size_t)row * 768 + sl * 24;
    *(u32x2*)(o) = (u32x2){pk[0], pk[1]}; *(u32x2*)(o + 8) = (u32x2){pk[2], pk[3]}; *(u32x2*)(o + 16) = (u32x2){pk[4], pk[5]};
    if (sl == 0) inv_scale[row] = am > 0.f ? am / 7.0f : 1.0f;
  }
}
__device__ __forceinline__ void ph_cvt_fp4(const float* __restrict__ in, unsigned char* __restrict__ out, float* __restrict__ inv_scale, int vb, int nvb) {
  const int lane = TIDX & 63, wid = TIDX >> 6, hf = lane >> 5, sl = lane & 31;
  const f32x2 probe = __builtin_amdgcn_cvt_scalef32_pk_f32_fp4(__builtin_amdgcn_cvt_scalef32_pk_fp4_f32(0u, 1.0f, 2.0f, 1.0f, 0), 1.0f, 0);
  const bool sw = probe.x != 1.0f;
  for (int rp = vb * 4 + wid; rp < 8192; rp += nvb * 4) {
    const int row = rp * 2 + hf;
    f32x4 v[8]; float am = 0.f;
#pragma unroll
    for (int i = 0; i < 8; ++i) {
      v[i] = *(const f32x4*)(in + (size_t)row * DM + sl * 32 + 4 * i);
#pragma unroll
      for (int e = 0; e < 4; ++e) am = fmaxf(am, fabsf(v[i][e]));
    }
    am = half_max(am);
    const float sc = am > 0.f ? 6.0f / am : 1.0f;
    u32x4 pk = (u32x4){0u, 0u, 0u, 0u};
#pragma unroll
    for (int w = 0; w < 4; ++w) {
      unsigned word = 0u;
      float c[8];
#pragma unroll
      for (int e = 0; e < 4; ++e) { c[e] = v[2 * w][e] * sc; c[4 + e] = v[2 * w + 1][e] * sc; }
      word = __builtin_amdgcn_cvt_scalef32_pk_fp4_f32(word, sw ? c[1] : c[0], sw ? c[0] : c[1], 1.0f, 0);
      word = __builtin_amdgcn_cvt_scalef32_pk_fp4_f32(word, sw ? c[3] : c[2], sw ? c[2] : c[3], 1.0f, 1);
      word = __builtin_amdgcn_cvt_scalef32_pk_fp4_f32(word, sw ? c[5] : c[4], sw ? c[4] : c[5], 1.0f, 2);
      word = __builtin_amdgcn_cvt_scalef32_pk_fp4_f32(word, sw ? c[7] : c[6], sw ? c[6] : c[7], 1.0f, 3);
      pk[w] = word;
    }
    *(u32x4*)(out + (size_t)row * 512 + sl * 16) = pk;
    if (sl == 0) inv_scale[row] = am > 0.f ? am / 6.0f : 1.0f;
  }
}
__device__ __forceinline__ u32x6 load_row6(const unsigned char* base, int id, int sl) {
  const unsigned char* q = base + (size_t)id * 768 + sl * 24;
  const u32x2 a = *(const u32x2*)q, b = *(const u32x2*)(q + 8), c = *(const u32x2*)(q + 16);
  return (u32x6){a.x, a.y, b.x, b.y, c.x, c.y};
}
#define GATHER_SMEM (4 * 64 * 33 * 4)
__device__ __forceinline__ void ph_peer_gather(const P& p, int vb, int nvb, unsigned char* smem) {
  int tid_ = TIDX;
  asm volatile("" : "+v"(tid_));
  const int lane = tid_ & 63, wid = tid_ >> 6, hf = lane >> 5, sl = lane & 31;
  float* scr = (float*)smem + (wid * 64 + lane) * 33;
  int* tauL = (int*)(smem + GATHER_SMEM) + wid * 32;
  {
    f32x16 a, b2;
#pragma unroll
    for (int i = 0; i < 16; ++i) { a[i] = __uint_as_float((unsigned)i << 20) * 0x1p126f; b2[i] = __uint_as_float((unsigned)(16 + i) << 20) * 0x1p126f; }
    const f32x32 o = __builtin_amdgcn_cvt_scalef32_pk32_f32_fp6(__builtin_amdgcn_cvt_scalef32_2xpk16_fp6_f32(a, b2, 1.0f), 1.0f);
    if (lane == 0) {
#pragma unroll
      for (int j = 0; j < 32; ++j) tauL[j] = (int)((__float_as_uint(o[j] * 0x1p-126f) >> 20) & 31u);
    }
  }
  const int jmap = 2 * (lane & 1) + ((lane >> 1) & 1);
  __syncthreads();
  int id0, id1; float su0, su1, gs0, gs1; u32x4 xr[4];
  {
    const int m0 = min(vb * 4 + wid, NTOK - 1);
    id0 = p.pidx[(size_t)m0 * 128 + lane]; id1 = p.pidx[(size_t)m0 * 128 + 64 + lane];
#pragma unroll
    for (int c4 = 0; c4 < 4; ++c4) xr[c4] = *(const u32x4*)(p.hx2 + (size_t)m0 * DM + sl * 32 + 8 * c4);
    su0 = p.us[id0]; su1 = p.us[id1];
    gs0 = p.pgate[(size_t)m0 * 128 + lane] * p.vs[id0]; gs1 = p.pgate[(size_t)m0 * 128 + 64 + lane] * p.vs[id1];
  }
  for (int m = vb * 4 + wid; m < NTOK; m += nvb * 4) {
    const float* md = p.mod + (m / SEQ) * 6144;
    f32x2 xp2[16];
#pragma unroll
    for (int c4 = 0; c4 < 4; ++c4)
#pragma unroll
      for (int e = 0; e < 4; ++e) xp2[4 * c4 + e] = (f32x2){bflo(xr[c4][e]), bfhi(xr[c4][e])};
    const int mn = min(m + nvb * 4, NTOK - 1);
    const int nid0 = p.pidx[(size_t)mn * 128 + lane], nid1 = p.pidx[(size_t)mn * 128 + 64 + lane];
    const float ng0 = p.pgate[(size_t)mn * 128 + lane], ng1 = p.pgate[(size_t)mn * 128 + 64 + lane];
#pragma unroll
    for (int c4 = 0; c4 < 4; ++c4) xr[c4] = *(const u32x4*)(p.hx2 + (size_t)mn * DM + sl * 32 + 8 * c4);
    float nsu0 = 0.f, nsu1 = 0.f, nvs0 = 0.f, nvs1 = 0.f;
    f32x2 acc2[16];
#pragma unroll
    for (int k = 0; k < 16; ++k) acc2[k] = (f32x2){0.f, 0.f};
#pragma unroll 1
    for (int e0 = 0; e0 < 128; e0 += 8) {
      if (e0 == 64) { nsu0 = p.us[nid0]; nsu1 = p.us[nid1]; nvs0 = p.vs[nid0]; nvs1 = p.vs[nid1]; }
      u32x4 ur[4], vr[4];
#pragma unroll
      for (int j = 0; j < 4; ++j) {
        const int id = __shfl(e0 < 64 ? id0 : id1, (e0 + hf * 4 + j) & 63);
        ur[j] = *(const u32x4*)(p.ub8 + (size_t)id * 512 + sl * 16);
        vr[j] = *(const u32x4*)(p.vb8 + (size_t)id * 512 + sl * 16);
      }
      float d[4];
#pragma unroll
      for (int j = 0; j < 4; ++j) {
        f32x2 s0 = (f32x2){0.f, 0.f}, s1 = (f32x2){0.f, 0.f};
#pragma unroll
        for (int w = 0; w < 4; ++w) {
          s0 += __builtin_amdgcn_cvt_scalef32_pk_f32_fp4(ur[j][w], 1.0f, 0) * xp2[4 * w + 0];
          s1 += __builtin_amdgcn_cvt_scalef32_pk_f32_fp4(ur[j][w], 1.0f, 1) * xp2[4 * w + 1];
          s0 += __builtin_amdgcn_cvt_scalef32_pk_f32_fp4(ur[j][w], 1.0f, 2) * xp2[4 * w + 2];
          s1 += __builtin_amdgcn_cvt_scalef32_pk_f32_fp4(ur[j][w], 1.0f, 3) * xp2[4 * w + 3];
        }
        d[j] = (s0.x + s0.y) + (s1.x + s1.y);
      }
      float r2[2], r1;
      {
        const bool lo = (lane & 1) == 0;
#pragma unroll
        for (int i = 0; i < 2; ++i) { const float keep = lo ? d[i] : d[i + 2], send = lo ? d[i + 2] : d[i]; r2[i] = keep + __shfl_xor(send, 1); }
        const bool lo2 = (lane & 2) == 0;
        { const float keep = lo2 ? r2[0] : r2[1], send = lo2 ? r2[1] : r2[0]; r1 = keep + __shfl_xor(send, 2); }
        r1 += __shfl_xor(r1, 4); r1 += __shfl_xor(r1, 8); r1 += __shfl_xor(r1, 16);
      }
      const int esrc = (e0 + hf * 4 + jmap) & 63;
      const float su = __shfl(e0 < 64 ? su0 : su1, esrc), gs = __shfl(e0 < 64 ? gs0 : gs1, esrc);
      const float sdot = r1 * su;
      const float cf = gelu_as(sdot) * gs;
#pragma unroll
      for (int j = 0; j < 4; ++j) {
        const float cj = __shfl(cf, (lane & 32) | ((j >> 1) | ((j & 1) << 1)));
        const f32x2 cj2 = (f32x2){cj, cj};
#pragma unroll
        for (int w = 0; w < 4; ++w) {
          acc2[4 * w + 0] += cj2 * __builtin_amdgcn_cvt_scalef32_pk_f32_fp4(vr[j][w], 1.0f, 0);
          acc2[4 * w + 1] += cj2 * __builtin_amdgcn_cvt_scalef32_pk_f32_fp4(vr[j][w], 1.0f, 1);
          acc2[4 * w + 2] += cj2 * __builtin_amdgcn_cvt_scalef32_pk_f32_fp4(vr[j][w], 1.0f, 2);
          acc2[4 * w + 3] += cj2 * __builtin_amdgcn_cvt_scalef32_pk_f32_fp4(vr[j][w], 1.0f, 3);
        }
      }
    }
#pragma unroll
    for (int k = 0; k < 16; ++k) { scr[2 * k] = acc2[k].x + __shfl_xor(acc2[k].x, 32); scr[2 * k + 1] = acc2[k].y + __shfl_xor(acc2[k].y, 32); }
    lds_wave_fence();
    float ss = 0.f;
#pragma unroll
    for (int k = 0; k < 32; ++k) { const float v = scr[k]; ss += v * v; }
    ss = half_sum(ss);
    const float rstd = rsqrtf(ss * (1.0f / 1024.0f) + 1e-6f);
#pragma unroll
    for (int k4 = 0; k4 < 4; ++k4) {
      const int kk = hf * 16 + k4 * 4, col = sl * 32 + kk;
      const u32x2 xb = *(const u32x2*)(p.x1b + (size_t)m * DM + col);
      f32x4 x1 = (f32x4){bflo(xb.x), bfhi(xb.x), bflo(xb.y), bfhi(xb.y)};
      const f32x4 g = *(const f32x4*)(p.g_post_ffn + col), gt = *(const f32x4*)(md + 5120 + col);
#pragma unroll
      for (int e = 0; e < 4; ++e) x1[e] += gt[e] * scr[kk + e] * rstd * g[e];
      *(f32x4*)(p.out + (size_t)m * DM + col) = x1;
    }
    lds_wave_fence();
    id0 = nid0; id1 = nid1; su0 = nsu0; su1 = nsu1; gs0 = ng0 * nvs0; gs1 = ng1 * nvs1;
  }
}

#define XB_TMO      128
#define XB_XCNT(j)  (256  + 64 * (j))
#define XB_XSUB(j)  (1280 + 64 * (j))
#define XB_XGEN(j)  (2304 + 64 * (j))
#define XB_TOP      3328
#define XB_TOPGEN   3392
#define XCD_BAR_WORDS 3456
#define XB_SPIN_CAP (1u << 20)
#define LAS __attribute__((address_space(3)))
__device__ __forceinline__ unsigned xb_ld(unsigned* p)              { return __hip_atomic_load(p, __ATOMIC_RELAXED, __HIP_MEMORY_SCOPE_AGENT); }
__device__ __forceinline__ unsigned xb_add(unsigned* p, unsigned v) { return __hip_atomic_fetch_add(p, v, __ATOMIC_RELAXED, __HIP_MEMORY_SCOPE_AGENT); }
__device__ __forceinline__ unsigned xb_xcc_id() { return (unsigned)__builtin_amdgcn_s_getreg((3 << 11) | 20) & 0xFu; }
#define XB_SPIN(cond, bar) do { unsigned _sp = 0; while (cond) { __builtin_amdgcn_s_sleep(1); \
    if ((++_sp & 255u) == 0u) { if (xb_ld(&(bar)[XB_TMO])) break; if (_sp > XB_SPIN_CAP) { atomicAdd(&(bar)[XB_TMO], 1u); break; } } } } while (0)
struct XcdBarrier { unsigned* bar; unsigned x; volatile LAS unsigned* st; };
__device__ __forceinline__ XcdBarrier xcd_barrier_post(unsigned* bar, volatile LAS unsigned* st) {
  XcdBarrier b; b.bar = bar; b.x = xb_xcc_id(); b.st = st;
  if (TIDX == 0) (void)xb_add(&bar[XB_XCNT(b.x)], 1u);
  return b;
}
__device__ __forceinline__ void xcd_barrier_complete(unsigned* bar, unsigned x, unsigned& nloc, unsigned& nx) {
  const unsigned G = gridDim.x * gridDim.y * gridDim.z;
  unsigned sum, cnt, mine, sp = 0u;
  for (;;) {
    sum = 0u; cnt = 0u; mine = 0u;
#pragma unroll
    for (unsigned j = 0; j < 16; ++j) { const unsigned c = xb_ld(&bar[XB_XCNT(j)]); sum += c; cnt += (c > 0u) ? 1u : 0u; mine = (j == x) ? c : mine; }
    if (sum == G) break;
    __builtin_amdgcn_s_sleep(1);
    if ((++sp & 255u) == 0u) { if (xb_ld(&bar[XB_TMO])) break; if (sp > XB_SPIN_CAP) { atomicAdd(&bar[XB_TMO], 1u); break; } }
  }
  nloc = mine > 0u ? mine : 1u; nx = cnt > 0u ? cnt : 1u;
}
__device__ __forceinline__ void xcd_barrier(const XcdBarrier& b) {
  asm volatile("s_waitcnt vmcnt(0)" ::: "memory");
  __syncthreads();
  if (TIDX == 0) {
    unsigned* bar = b.bar;
    __builtin_amdgcn_s_waitcnt(0);
    unsigned nloc = b.st[0], nx = b.st[1];
    if (nloc == 0u) { xcd_barrier_complete(bar, b.x, nloc, nx); b.st[0] = nloc; b.st[1] = nx; }
    const unsigned old = xb_add(&bar[XB_XSUB(b.x)], 1u);
    const unsigned gen = old / nloc;
    if (old + 1u == (gen + 1u) * nloc) {
      __builtin_amdgcn_fence(__ATOMIC_RELEASE, "agent");
      asm volatile("s_waitcnt vmcnt(0)" ::: "memory");
      const unsigned og = xb_add(&bar[XB_TOP], 1u);
      const unsigned tg = og / nx;
      if (og + 1u == (tg + 1u) * nx) xb_add(&bar[XB_TOPGEN], 1u);
      else XB_SPIN(xb_ld(&bar[XB_TOPGEN]) == tg, bar);
      __builtin_amdgcn_fence(__ATOMIC_ACQUIRE, "agent");
      xb_add(&bar[XB_XGEN(b.x)], 1u);
      asm volatile("s_waitcnt vmcnt(0)" ::: "memory");
    } else {
      XB_SPIN(xb_ld(&bar[XB_XGEN(b.x)]) == gen, bar);
      __builtin_amdgcn_fence(__ATOMIC_ACQUIRE, "agent");
      asm volatile("s_waitcnt vmcnt(0)" ::: "memory");
    }
  }
  __syncthreads();
}

#define SMEM_BYTES RWKV_SMEM
__global__ void __launch_bounds__(256, 2) mega(P p) {
  __shared__ __attribute__((aligned(16))) unsigned char smem[SMEM_BYTES + 16];
  cg::grid_group grid = cg::this_grid();
  const int vb = blockIdx.x, nvb = gridDim.x;
  if (TIDX == 0) *(u32x4*)(smem + SMEM_BYTES) = (u32x4){0u, 0u, 0u, 0u};
  __syncthreads();
  const XcdBarrier xb = xcd_barrier_post(p.bar, (volatile LAS unsigned*)(smem + SMEM_BYTES));
  ph_mod(p, vb, nvb, smem);
  ph_colmax(p.w_in, p.colmax, DM, INC, vb, nvb, smem);
  ph_transpose(p.w2, p.w2T, 64, 1024, vb, nvb, smem);
  ph_transpose(p.w2 + 65536, p.w2T + 65536, 64, 1024, vb, nvb, smem);
  ph_transpose(p.a2, p.a2T, 64, 1024, vb, nvb, smem);
  ph_transpose(p.a2 + 65536, p.a2T + 65536, 64, 1024, vb, nvb, smem);
  if (p.bar == nullptr) grid.sync();
  xcd_barrier(xb);
  ph_norm1(p, vb, nvb);
  ph_transpose_i8(p.w_in, p.Wt8, p.colmax, p.wsb, DM, INC, vb, nvb, smem);
  xcd_barrier(xb);
  ph_gemm1(p, vb, nvb, smem);
  xcd_barrier(xb);
  ph_rwkv_A(p, vb, nvb, smem);
  xcd_barrier(xb);
  ph_rwkv_B(p, vb, nvb, smem);
  if (nvb > 128 && vb >= 64) {
    const int v2 = vb - 64, n2 = nvb - 64;
    ph_transpose(p.w_a_out, p.Wt_aout, DM, DM, v2, n2, smem);
    ph_transpose(p.w_o, p.Wt_o, DM, DM, v2, n2, smem);
    ph_transpose(p.peer_wq, p.Wt_q, DM, 2048, v2, n2, smem);
    ph_transpose(p.g2, p.g2T, 128, 1024, v2, n2, smem);
    ph_weff(p, v2, n2);
    ph_convert(p.peer_keys, p.keys, (size_t)16 * 128 * 128, v2, n2);
  } else if (nvb <= 128) {
    ph_transpose(p.w_a_out, p.Wt_aout, DM, DM, vb, nvb, smem);
    ph_transpose(p.w_o, p.Wt_o, DM, DM, vb, nvb, smem);
    ph_transpose(p.peer_wq, p.Wt_q, DM, 2048, vb, nvb, smem);
    ph_transpose(p.g2, p.g2T, 128, 1024, vb, nvb, smem);
    ph_weff(p, vb, nvb);
    ph_convert(p.peer_keys, p.keys, (size_t)16 * 128 * 128, vb, nvb);
  }
  xcd_barrier(xb);
  ph_ycorr(p, vb, nvb, smem);
  ph_pool(p, vb, nvb, smem);
  ph_cvt_fp4(p.peer_u, p.ub8, p.us, vb, nvb);
  ph_cvt_fp4(p.peer_v, p.vb8, p.vs, vb, nvb);
  xcd_barrier(xb);
  ph_gemm_merge(p, vb, nvb, smem);
  xcd_barrier(xb);
  ph_gemm_simple(p.mrg, DM, p.Wt_o, DM, DM, NTOK, DM, p.mix, DM, vb, nvb, smem);
  xcd_barrier(xb);
  ph_res1(p, vb, nvb);
  xcd_barrier(xb);
  ph_gemm_simple(p.hx2, DM, p.Wt_q, DM, DM, NTOK, 2048, p.q, 2048, vb, nvb, smem);
  xcd_barrier(xb);
  ph_peer_s1(p, vb, nvb, smem);
  xcd_barrier(xb);
  ph_peer_s2(p, vb, nvb, smem);
  xcd_barrier(xb);
  ph_peer_gather(p, vb, nvb, smem);
}

extern "C" void kernel_launch(void* const* d_in, const int* in_sizes, int n_in, void* d_out, int out_size, void* d_ws, size_t ws_size, hipStream_t stream) {
  P p{};
  const float** f = (const float**)&p;
  for (int i = 0; i < 32; ++i) f[i] = (const float*)d_in[i];
  p.out = (float*)d_out;
  p.bar = (unsigned*)((unsigned char*)d_ws + 511 * 1048576);
  unsigned char* w = (unsigned char*)d_ws;
  const size_t MiB = 1048576;
  const size_t HM = 524288;
  p.hx = (bf16_t*)(w + 4096);
  p.hx8 = (signed char*)(w + 4096);
  p.hsa = (float*)(w + 40 * MiB) + 4;
  p.colmax = p.bar + XCD_BAR_WORDS;
  p.zA = (bf16_t*)(w + 65 * MiB + 8192);
  p.zP = (bf16_t*)(w + 569 * HM);
  p.zG = (bf16_t*)d_out;
  unsigned char* rw = w + 633 * HM;
  p.Wt_in = (bf16_t*)rw; p.Wt8 = (signed char*)rw; rw += 11 * MiB; p.wsb = (float*)rw; rw += 1 * MiB;
  p.Wt_aout = (bf16_t*)rw; rw += 2 * MiB;
  p.Wt_eff = (bf16_t*)rw; rw += 1 * MiB;
  p.Wt_o = (bf16_t*)rw; rw += 2 * MiB;
  p.Wt_q = (bf16_t*)rw; rw += 4 * MiB;
  p.keys = (bf16_t*)rw; rw += HM;
  p.mod = (float*)rw; rw += HM;
  p.g2T = (bf16_t*)rw; rw += HM;
  p.w2T = (bf16_t*)rw; rw += HM;
  p.a2T = (bf16_t*)rw; rw += HM;
  p.Y0 = (bf16_t*)(w + 0 * MiB);
  p.Y1 = (bf16_t*)(w + 340 * MiB);
  p.bdot = (float*)(w + 404 * MiB);
  p.Mst = (bf16_t*)(w + 408 * MiB);
  p.sg = (bf16_t*)(w + 408 * MiB);
  p.Nst = (float*)(w + 441 * MiB);
  p.ub8 = w + 416 * MiB;
  p.vb8 = w + 432 * MiB;
  p.us = (float*)(w + 448 * MiB);
  p.vs = (float*)(w + 449 * MiB);
  p.pooled = (bf16_t*)(w + 478 * MiB);
  p.out_a = (bf16_t*)(w + 0 * MiB);
  p.ya = (bf16_t*)(w + 65 * MiB);
  p.yb = (bf16_t*)(w + 129 * MiB);
  p.mrg = (bf16_t*)(w + 193 * MiB);
  p.mix = (bf16_t*)(w + 65 * MiB);
  p.hx2 = (bf16_t*)(w + 0 * MiB);
  p.x1b = (bf16_t*)(w + 65 * MiB);
  p.q = (bf16_t*)(w + 129 * MiB);
  p.sv = (float*)(w + 340 * MiB);
  p.si = (int*)(w + 372 * MiB);
  p.pidx = (int*)(w + 257 * MiB);
  p.pgate = (float*)(w + 273 * MiB);
  static int grid_blocks = 0;
  if (!grid_blocks) {
    int dev = 0, cus = 0, per_cu = 0;
    hipGetDevice(&dev);
    hipDeviceGetAttribute(&cus, hipDeviceAttributeMultiprocessorCount, dev);
    hipOccupancyMaxActiveBlocksPerMultiprocessor(&per_cu, mega, 256, 0);
    if (per_cu > 2) per_cu = 2;
    if (per_cu < 1) per_cu = 1;
    grid_blocks = cus * per_cu;
  }
  hipMemsetAsync(p.bar, 0, (XCD_BAR_WORDS + 6016) * 4, stream);
  void* args[] = {&p};
  hipError_t e = hipLaunchCooperativeKernel((void*)mega, dim3(grid_blocks), dim3(256), args, 0, stream);
  if (e != hipSuccess) fprintf(stderr, "cooperative launch failed: %s (grid %d)\n", hipGetErrorString(e), grid_blocks);
}
```

```cpp
#include <hip/hip_runtime.h>
#include <hip/hip_cooperative_groups.h>
#include <stdint.h>
#include <cstdio>
namespace cg = cooperative_groups;

typedef unsigned short bf16_t;
typedef short bf16x8 __attribute__((ext_vector_type(8)));
typedef float f32x4 __attribute__((ext_vector_type(4)));
typedef unsigned u32x4 __attribute__((ext_vector_type(4)));
typedef unsigned u32x2 __attribute__((ext_vector_type(2)));
typedef float f32x2 __attribute__((ext_vector_type(2)));

__device__ __forceinline__ int tid_opaque() { int t = threadIdx.x; asm volatile("" : "+v"(t)); return t; }
#define TIDX tid_opaque()
#define NTOK 32768
#define SEQ 16384
#define CTXL 256
#define NCTX 512
#define MROWS 33280
#define DM 1024
#define SHIFTC 3456
#define INC 6016

typedef __bf16 hwbf2 __attribute__((ext_vector_type(2)));
typedef float hwf2 __attribute__((ext_vector_type(2)));
__device__ __forceinline__ unsigned pack2(float a, float b) { return __builtin_bit_cast(unsigned, __builtin_convertvector((hwf2){a, b}, hwbf2)); }
__device__ __forceinline__ bf16_t f2bf(float f) { return __builtin_bit_cast(unsigned short, (__bf16)f); }
__device__ __forceinline__ float bf2f(bf16_t h) { return __uint_as_float(((unsigned)h) << 16); }
__device__ __forceinline__ float bflo(unsigned u) { return __uint_as_float(u << 16); }
__device__ __forceinline__ float bfhi(unsigned u) { return __uint_as_float(u & 0xffff0000u); }
__device__ __forceinline__ float sigmoidf_(float x) { return __builtin_amdgcn_rcpf(1.0f + __expf(-x)); }
__device__ __forceinline__ float fast_tanh(float x) { const float e = __builtin_amdgcn_exp2f(2.885390082f * x); return 1.0f - 2.0f * __builtin_amdgcn_rcpf(e + 1.0f); }

__device__ __forceinline__ void load8(const bf16_t* __restrict__ zA, int row, int col0, float* o) {
  const u32x4 zc = *(const u32x4*)(zA + (size_t)row * SHIFTC + col0);
#pragma unroll
  for (int i = 0; i < 4; ++i) { o[2 * i] = bflo(zc[i]); o[2 * i + 1] = bfhi(zc[i]); }
}
__device__ __forceinline__ float red16(float v) {
  v += __shfl_xor(v, 1); v += __shfl_xor(v, 2); v += __shfl_xor(v, 4); v += __shfl_xor(v, 8);
  return v;
}
__device__ __forceinline__ float red8(float v) {
  v += __shfl_xor(v, 1); v += __shfl_xor(v, 2); v += __shfl_xor(v, 4);
  return v;
}

struct P {
  const float *x, *c, *ctx, *c_ctx, *w_mod, *b_mod, *g_pre_mix, *g_post_mix, *g_pre_ffn, *g_post_ffn, *w_in, *b_gate, *mu_shift,
      *w0, *w2, *a0, *a2, *g2, *k_k, *k_a, *r_k, *ln_x_w, *ln_x_b, *w_a_out, *w_pool, *pool_scale, *w_b_out, *w_o, *peer_wq,
      *peer_keys, *peer_u, *peer_v;
  float* out;
  unsigned* bar;
  bf16_t* hx;
  signed char* hx8;
  float* hsa;
  signed char* Wt8;
  float* wsb;
  unsigned* colmax;
  bf16_t* zA;
  bf16_t* zP;
  bf16_t* zG;
  bf16_t* Wt_in;
  bf16_t* Wt_aout;
  bf16_t* Wt_eff;
  bf16_t* Wt_o;
  bf16_t* Wt_q;
  bf16_t* keys;
  float* mod;
  unsigned char* ub8;
  unsigned char* vb8;
  float* us;
  float* vs;
  bf16_t* sg;
  bf16_t* g2T;
  bf16_t* w2T;
  bf16_t* a2T;
  bf16_t* Mst;
  float* Nst;
  bf16_t* Y0;
  bf16_t* Y1;
  float* bdot;
  bf16_t* out_a;
  bf16_t* ya;
  bf16_t* pooled;
  bf16_t* yb;
  bf16_t* mrg;
  bf16_t* mix;
  bf16_t* hx2;
  bf16_t* x1b;
  bf16_t* q;
  float* sv;
  int* si;
  int* pidx;
  float* pgate;
};

#define GS 72
#define GEMM_SMEM (2 * 128 * GS * 2)
template <class Epi>
__device__ __forceinline__ void gemm_tile(const bf16_t* __restrict__ A, int lda, const bf16_t* __restrict__ Bt, int ldb, int K, int m0, int n0,
                                          const Epi& epi, unsigned char* smem) {
  const int tid = TIDX, lane = tid & 63, wid = tid >> 6, wr = wid >> 1, wc = wid & 1;
  bf16_t* sA = (bf16_t*)smem;
  bf16_t* sB = sA + 128 * GS;
  f32x4 acc[4][4];
#pragma unroll
  for (int i = 0; i < 4; ++i)
#pragma unroll
    for (int j = 0; j < 4; ++j) acc[i][j] = (f32x4){0.f, 0.f, 0.f, 0.f};
  const int lrow = tid >> 3, lcol = (tid & 7) * 8;
  const bf16_t* pa = A + (size_t)(m0 + lrow) * lda + lcol;
  const bf16_t* pb = Bt + (size_t)(n0 + lrow) * ldb + lcol;
  u32x4 ra[4], rb[4];
#pragma unroll
  for (int p = 0; p < 4; ++p) {
    ra[p] = *(const u32x4*)(pa + (size_t)(32 * p) * lda);
    rb[p] = *(const u32x4*)(pb + (size_t)(32 * p) * ldb);
  }
  for (int k0 = 0; k0 < K; k0 += 64) {
#pragma unroll
    for (int p = 0; p < 4; ++p) {
      *(u32x4*)(sA + (lrow + 32 * p) * GS + lcol) = ra[p];
      *(u32x4*)(sB + (lrow + 32 * p) * GS + lcol) = rb[p];
    }
    __syncthreads();
    if (k0 + 64 < K) {
#pragma unroll
      for (int p = 0; p < 4; ++p) {
        ra[p] = *(const u32x4*)(pa + (size_t)(32 * p) * lda + k0 + 64);
        rb[p] = *(const u32x4*)(pb + (size_t)(32 * p) * ldb + k0 + 64);
      }
    }
#pragma unroll
    for (int kk = 0; kk < 2; ++kk) {
      bf16x8 af[4], bfr[4];
#pragma unroll
      for (int i = 0; i < 4; ++i) af[i] = *(const bf16x8*)(sA + (wr * 64 + i * 16 + (lane & 15)) * GS + kk * 32 + (lane >> 4) * 8);
#pragma unroll
      for (int j = 0; j < 4; ++j) bfr[j] = *(const bf16x8*)(sB + (wc * 64 + j * 16 + (lane & 15)) * GS + kk * 32 + (lane >> 4) * 8);
#pragma unroll
      for (int i = 0; i < 4; ++i)
#pragma unroll
        for (int j = 0; j < 4; ++j) acc[i][j] = __builtin_amdgcn_mfma_f32_16x16x32_bf16(bfr[j], af[i], acc[i][j], 0, 0, 0);
    }
    __syncthreads();
  }
#pragma unroll
  for (int i = 0; i < 4; ++i)
#pragma unroll
    for (int j = 0; j < 4; ++j) epi(m0 + wr * 64 + i * 16 + (lane & 15), n0 + wc * 64 + j * 16 + (lane >> 4) * 4, acc[i][j]);
}

#define G3_STAGE 24576
#define G3_ES 136
#define GEMM3_SMEM (256 * G3_ES * 2)
typedef __attribute__((address_space(3))) unsigned lds_u32;
template <class Epi>
__device__ __forceinline__ void gemm_tile3(const bf16_t* __restrict__ A, int lda, const bf16_t* __restrict__ Bt, int ldb, int K, int m0, int n0,
                                           const Epi& epi, unsigned char* smem) {
  int tid = TIDX;
  asm volatile("" : "+v"(tid));
  const int lane = tid & 63, wid = __builtin_amdgcn_readfirstlane(tid >> 6), wr = wid >> 1, wc = wid & 1, l15 = lane & 15, q = lane >> 4;
  f32x4 acc[8][4];
#pragma unroll
  for (int i = 0; i < 8; ++i)
#pragma unroll
    for (int j = 0; j < 4; ++j) acc[i][j] = (f32x4){0.f, 0.f, 0.f, 0.f};
  const int gr = lane >> 2, gc = ((lane & 3) ^ (((gr >> 2) & 1) << 1)) * 8;
  const bf16_t* pa = A + (long)(m0 + wid * 64 + gr) * lda + gc;
  const bf16_t* pb = Bt + (size_t)(n0 + wid * 32 + gr) * ldb + gc;
  unsigned char* dA = smem + wid * 4096 + lane * 16;
  unsigned char* dB = smem + 16384 + wid * 2048 + lane * 16;
  const int sw = (q ^ (((l15 >> 2) & 1) << 1)) * 16;
  const unsigned char* fA = smem + (wr * 128 + l15) * 64 + sw;
  const unsigned char* fB = smem + 16384 + (wc * 64 + l15) * 64 + sw;
#define G3_ISSUE(ST, KT) { _Pragma("unroll") for (int ii = 0; ii < 4; ++ii) __builtin_amdgcn_global_load_lds((const unsigned*)(pa + (size_t)(16 * ii) * lda + (KT) * 32), (lds_u32*)(dA + (ST) * G3_STAGE + ii * 1024), 16, 0, 0); \
                           _Pragma("unroll") for (int ii = 0; ii < 2; ++ii) __builtin_amdgcn_global_load_lds((const unsigned*)(pb + (size_t)(16 * ii) * ldb + (KT) * 32), (lds_u32*)(dB + (ST) * G3_STAGE + ii * 1024), 16, 0, 0); }
  const int nk = K >> 5;
  __syncthreads();
  G3_ISSUE(0, 0);
  for (int kt = 0; kt < nk; ++kt) {
    const int cur = kt & 1;
    asm volatile("s_waitcnt vmcnt(0)" ::: "memory");
    __syncthreads();
    if (kt + 1 < nk) G3_ISSUE(cur ^ 1, kt + 1);
    const unsigned char* cA = fA + cur * G3_STAGE;
    const unsigned char* cB = fB + cur * G3_STAGE;
    bf16x8 bfr[4];
#pragma unroll
    for (int j = 0; j < 4; ++j) bfr[j] = *(const bf16x8*)(cB + j * 1024);
#pragma unroll
    for (int i = 0; i < 8; ++i) {
      const bf16x8 af = *(const bf16x8*)(cA + i * 1024);
#pragma unroll
      for (int j = 0; j < 4; ++j) acc[i][j] = __builtin_amdgcn_mfma_f32_16x16x32_bf16(bfr[j], af, acc[i][j], 0, 0, 0);
    }
  }
#undef G3_ISSUE
  bf16_t* sE = (bf16_t*)smem;
  __syncthreads();
#pragma unroll
  for (int i = 0; i < 8; ++i)
#pragma unroll
    for (int j = 0; j < 4; ++j) {
      u32x2 w; w.x = pack2(acc[i][j][0], acc[i][j][1]); w.y = pack2(acc[i][j][2], acc[i][j][3]);
      *(u32x2*)(sE + (wr * 128 + i * 16 + l15) * G3_ES + wc * 64 + j * 16 + q * 4) = w;
    }
  __syncthreads();
  epi.finish(sE, m0, n0, tid);
}
typedef int i32x4v __attribute__((ext_vector_type(4)));
template <class Epi>
__device__ __forceinline__ void gemm_tile3_i8(const signed char* __restrict__ A, int lda, const signed char* __restrict__ Bt, int ldb, int K, int m0, int n0,
                                              const float* __restrict__ sa, const float* __restrict__ sb, const Epi& epi, unsigned char* smem) {
  int tid = TIDX;
  asm volatile("" : "+v"(tid));
  const int lane = tid & 63, wid = __builtin_amdgcn_readfirstlane(tid >> 6), wr = wid >> 1, wc = wid & 1, l15 = lane & 15, q = lane >> 4;
  i32x4v acc[8][4];
#pragma unroll
  for (int i = 0; i < 8; ++i)
#pragma unroll
    for (int j = 0; j < 4; ++j) acc[i][j] = (i32x4v){0, 0, 0, 0};
  const int gr = lane >> 2, gc = ((lane & 3) ^ (((gr >> 2) & 1) << 1)) * 16;
  const signed char* pa = A + (long)(m0 + wid * 64 + gr) * lda + gc;
  const signed char* pb = Bt + (size_t)(n0 + wid * 32 + gr) * ldb + gc;
  unsigned char* dA = smem + wid * 4096 + lane * 16;
  unsigned char* dB = smem + 16384 + wid * 2048 + lane * 16;
  const int sw = (q ^ (((l15 >> 2) & 1) << 1)) * 16;
  const unsigned char* fA = smem + (wr * 128 + l15) * 64 + sw;
  const unsigned char* fB = smem + 16384 + (wc * 64 + l15) * 64 + sw;
#define G3_ISSUE(ST, KT) { _Pragma("unroll") for (int ii = 0; ii < 4; ++ii) __builtin_amdgcn_global_load_lds((const unsigned*)(pa + (size_t)(16 * ii) * lda + (KT) * 64), (lds_u32*)(dA + (ST) * G3_STAGE + ii * 1024), 16, 0, 0); \
                           _Pragma("unroll") for (int ii = 0; ii < 2; ++ii) __builtin_amdgcn_global_load_lds((const unsigned*)(pb + (size_t)(16 * ii) * ldb + (KT) * 64), (lds_u32*)(dB + (ST) * G3_STAGE + ii * 1024), 16, 0, 0); }
  const int nk = K >> 6;
  __syncthreads();
  G3_ISSUE(0, 0);
  for (int kt = 0; kt < nk; ++kt) {
    const int cur = kt & 1;
    asm volatile("s_waitcnt vmcnt(0)" ::: "memory");
    __syncthreads();
    if (kt + 1 < nk) G3_ISSUE(cur ^ 1, kt + 1);
    const unsigned char* cA = fA + cur * G3_STAGE;
    const unsigned char* cB = fB + cur * G3_STAGE;
    i32x4v bfr[4];
#pragma unroll
    for (int j = 0; j < 4; ++j) bfr[j] = *(const i32x4v*)(cB + j * 1024);
#pragma unroll
    for (int i = 0; i < 8; ++i) {
      const i32x4v af = *(const i32x4v*)(cA + i * 1024);
#pragma unroll
      for (int j = 0; j < 4; ++j) acc[i][j] = __builtin_amdgcn_mfma_i32_16x16x64_i8(bfr[j], af, acc[i][j], 0, 0, 0);
    }
  }
#undef G3_ISSUE
  bf16_t* sE = (bf16_t*)smem;
  f32x4 sb4[4];
#pragma unroll
  for (int j = 0; j < 4; ++j) sb4[j] = *(const f32x4*)(sb + n0 + wc * 64 + j * 16 + q * 4);
  __syncthreads();
#pragma unroll
  for (int i = 0; i < 8; ++i) {
    const float sr = sa[m0 + wr * 128 + i * 16 + l15];
#pragma unroll
    for (int j = 0; j < 4; ++j) {
      u32x2 w;
      w.x = pack2((float)acc[i][j][0] * (sr * sb4[j][0]), (float)acc[i][j][1] * (sr * sb4[j][1]));
      w.y = pack2((float)acc[i][j][2] * (sr * sb4[j][2]), (float)acc[i][j][3] * (sr * sb4[j][3]));
      *(u32x2*)(sE + (wr * 128 + i * 16 + l15) * G3_ES + wc * 64 + j * 16 + q * 4) = w;
    }
  }
  __syncthreads();
  epi.finish(sE, m0, n0, tid);
}
template <class D> struct Epi3RowChunks {
  __device__ __forceinline__ void finish(const bf16_t* sE, int m0, int n0, int tid) const {
#pragma unroll
    for (int pp = 0; pp < 16; ++pp) {
      const int id = tid + 256 * pp, row = id >> 4, cc = (id & 15) * 8;
      static_cast<const D*>(this)->store(m0 + row, n0 + cc, *(const u32x4*)(sE + row * G3_ES + cc));
    }
  }
};
struct Epi3StoreBf16 : Epi3RowChunks<Epi3StoreBf16> {
  bf16_t* C; int ldc;
  __device__ Epi3StoreBf16(bf16_t* c, int l) : C(c), ldc(l) {}
  __device__ __forceinline__ void store(int m, int n, const u32x4& v) const { *(u32x4*)(C + (size_t)m * ldc + n) = v; }
};
struct Epi3GateA : Epi3RowChunks<Epi3GateA> {
  const bf16_t* zG; const float* bg; bf16_t* mrg;
  __device__ Epi3GateA(const bf16_t* z, const float* b, bf16_t* m) : zG(z), bg(b), mrg(m) {}
  __device__ __forceinline__ void store(int m, int n, const u32x4& v) const {
    const u32x4 g = *(const u32x4*)(zG + (size_t)m * 2048 + n);
    const f32x4 b0 = *(const f32x4*)(bg + n), b1 = *(const f32x4*)(bg + n + 4);
    u32x4 o;
#pragma unroll
    for (int i = 0; i < 4; ++i) {
      const float bl = i < 2 ? b0[2 * i] : b1[2 * i - 4], bh = i < 2 ? b0[2 * i + 1] : b1[2 * i - 3];
      o[i] = pack2(sigmoidf_(bflo(g[i]) + bl) * bflo(v[i]), sigmoidf_(bfhi(g[i]) + bh) * bfhi(v[i]));
    }
    *(u32x4*)(mrg + (size_t)m * DM + n) = o;
  }
};
struct Epi3GateB : Epi3RowChunks<Epi3GateB> {
  const bf16_t* zG; const float* bg; bf16_t* mrg;
  __device__ Epi3GateB(const bf16_t* z, const float* b, bf16_t* m) : zG(z), bg(b), mrg(m) {}
  __device__ __forceinline__ void store(int m, int n, const u32x4& v) const {
    const u32x4 g = *(const u32x4*)(zG + (size_t)m * 2048 + 1024 + n);
    const u32x4 a = *(const u32x4*)(mrg + (size_t)m * DM + n);
    const f32x4 b0 = *(const f32x4*)(bg + 1024 + n), b1 = *(const f32x4*)(bg + 1024 + n + 4);
    u32x4 o;
#pragma unroll
    for (int i = 0; i < 4; ++i) {
      const float bl = i < 2 ? b0[2 * i] : b1[2 * i - 4], bh = i < 2 ? b0[2 * i + 1] : b1[2 * i - 3];
      o[i] = pack2(bflo(a[i]) + sigmoidf_(bflo(g[i]) + bl) * bflo(v[i]), bfhi(a[i]) + sigmoidf_(bfhi(g[i]) + bh) * bfhi(v[i]));
    }
    *(u32x4*)(mrg + (size_t)m * DM + n) = o;
  }
};
struct Epi3ZS {
  bf16_t* zA; const float* mu; int own_lo, own_hi, t0, T;
  __device__ __forceinline__ void finish(const bf16_t* sE, int m0, int n0, int tid) const {
#pragma unroll 4
    for (int pq = 0; pq < 16; ++pq) {
      const int id = tid + 256 * pq, row = id >> 4, cc = (id & 15) * 8, t = t0 + row;
      if (row < own_lo || row > own_hi) continue;
      const u32x4 zc = *(const u32x4*)(sE + row * G3_ES + cc);
      u32x4 zp = (u32x4){0u, 0u, 0u, 0u}, zn = (u32x4){0u, 0u, 0u, 0u};
      if (t > 0) zp = *(const u32x4*)(sE + (row - 1) * G3_ES + cc);
      if (t < T - 1) zn = *(const u32x4*)(sE + (row + 1) * G3_ES + cc);
      const f32x4 m0v = *(const f32x4*)(mu + n0 + cc), m1v = *(const f32x4*)(mu + n0 + cc + 4);
      const float mm[8] = {m0v[0], m0v[1], m0v[2], m0v[3], m1v[0], m1v[1], m1v[2], m1v[3]};
      u32x4 o;
#pragma unroll
      for (int i = 0; i < 4; ++i) {
        const float z0 = bflo(zc[i]), z1 = bfhi(zc[i]);
        float s0 = z0 + mm[2 * i] * (0.5f * (bflo(zp[i]) + bflo(zn[i])) - z0), s1 = z1 + mm[2 * i + 1] * (0.5f * (bfhi(zp[i]) + bfhi(zn[i])) - z1);
        if (n0 == 3072) { s0 = fast_tanh(s0); s1 = fast_tanh(s1); }
        if (n0 == 3328) { s0 = sigmoidf_(s0); s1 = sigmoidf_(s1); }
        o[i] = pack2(s0, s1);
      }
      *(u32x4*)(zA + (long)(m0 + row) * SHIFTC + n0 + cc) = o;
    }
  }
};
struct Epi3Z : Epi3RowChunks<Epi3Z> {
  bf16_t *zA, *zP, *zG;
  __device__ Epi3Z(bf16_t* a, bf16_t* b, bf16_t* c) : zA(a), zP(b), zG(c) {}
  __device__ __forceinline__ void store(int m, int n, const u32x4& v) const {
    if (n < SHIFTC) *(u32x4*)(zA + (size_t)m * SHIFTC + n) = v;
    else if (m < NTOK) {
      if (n < SHIFTC + 512) *(u32x4*)(zP + (size_t)m * 512 + (n - SHIFTC)) = v;
      else *(u32x4*)(zG + (size_t)m * 2048 + (n - SHIFTC - 512)) = v;
    }
  }
};

struct EpiLds {
  float* S;
  __device__ __forceinline__ void operator()(int m, int n, const f32x4& v) const {
    float* r = S + (m & 127) * 133 + n + (n >> 5);
    r[0] = v[0]; r[1] = v[1]; r[2] = v[2]; r[3] = v[3];
  }
};

__device__ __forceinline__ void ph_transpose(const float* __restrict__ in, bf16_t* __restrict__ out, int K, int N, int vb, int nvb, unsigned char* smem) {
  float* t = (float*)smem;
  const int tk = K / 64, tn = N / 64, tid = TIDX, tx = tid & 15, ty = tid >> 4;
  for (int it = vb; it < tk * tn; it += nvb) {
    const int k0 = (it / tn) * 64, n0 = (it % tn) * 64;
    __syncthreads();
#pragma unroll
    for (int r = 0; r < 4; ++r) {
      const f32x4 v = *(const f32x4*)(in + (size_t)(k0 + ty + 16 * r) * N + n0 + 4 * tx);
#pragma unroll
      for (int e = 0; e < 4; ++e) t[(ty + 16 * r) * 65 + 4 * tx + e] = v[e];
    }
    __syncthreads();
    const int n = tid >> 2, kq = (tid & 3) * 16;
    u32x4 w0, w1;
#pragma unroll
    for (int e = 0; e < 4; ++e) {
      w0[e] = pack2(t[(kq + 2 * e) * 65 + n], t[(kq + 2 * e + 1) * 65 + n]);
      w1[e] = pack2(t[(kq + 8 + 2 * e) * 65 + n], t[(kq + 8 + 2 * e + 1) * 65 + n]);
    }
    *(u32x4*)(out + (size_t)(n0 + n) * K + k0 + kq) = w0;
    *(u32x4*)(out + (size_t)(n0 + n) * K + k0 + kq + 8) = w1;
  }
}
__device__ __forceinline__ void ph_colmax(const float* __restrict__ in, unsigned* __restrict__ colmax, int K, int N, int vb, int nvb, unsigned char* smem) {
  float* red = (float*)smem;
  const int tk = K / 64, tn = N / 64, tid = TIDX, n = tid & 63, kq = tid >> 6;
  for (int it = vb; it < tk * tn; it += nvb) {
    const int k0 = (it / tn) * 64 + kq * 16, n0 = (it % tn) * 64;
    float mx = 0.f;
#pragma unroll
    for (int r = 0; r < 16; ++r) mx = fmaxf(mx, fabsf(in[(size_t)(k0 + r) * N + n0 + n]));
    __syncthreads();
    red[kq * 64 + n] = mx;
    __syncthreads();
    if (kq == 0) atomicMax(colmax + n0 + n, __float_as_uint(fmaxf(fmaxf(red[n], red[64 + n]), fmaxf(red[128 + n], red[192 + n]))));
  }
}
__device__ __forceinline__ void ph_transpose_i8(const float* __restrict__ in, signed char* __restrict__ out, const unsigned* __restrict__ colmax, float* __restrict__ sbv,
                                                int K, int N, int vb, int nvb, unsigned char* smem) {
  float* t = (float*)smem;
  const int tk = K / 64, tn = N / 64, tid = TIDX, tx = tid & 15, ty = tid >> 4;
  for (int it = vb; it < tk * tn; it += nvb) {
    const int k0 = (it / tn) * 64, n0 = (it % tn) * 64;
    __syncthreads();
#pragma unroll
    for (int r = 0; r < 4; ++r) {
      const f32x4 v = *(const f32x4*)(in + (size_t)(k0 + ty + 16 * r) * N + n0 + 4 * tx);
#pragma unroll
      for (int e = 0; e < 4; ++e) t[(ty + 16 * r) * 65 + 4 * tx + e] = v[e];
    }
    __syncthreads();
    const int n = tid >> 2, kq = (tid & 3) * 16;
    const float cmx = __uint_as_float(colmax[n0 + n]);
    const float sc = cmx > 0.f ? 127.0f / cmx : 0.f;
    if (k0 == 0 && kq == 0) sbv[n0 + n] = cmx > 0.f ? cmx / 127.0f : 1.0f;
    u32x4 w;
#pragma unroll
    for (int e = 0; e < 4; ++e) {
      unsigned pk = 0;
#pragma unroll
      for (int b = 0; b < 4; ++b) { const int qv = (int)rintf(t[(kq + 4 * e + b) * 65 + n] * sc); pk |= ((unsigned)qv & 255u) << (8 * b); }
      w[e] = pk;
    }
    *(u32x4*)(out + (size_t)(n0 + n) * K + k0 + kq) = w;
  }
}
__device__ __forceinline__ void ph_convert(const float* __restrict__ in, bf16_t* __restrict__ out, size_t n, int vb, int nvb) {
  for (size_t i = ((size_t)vb * 256 + TIDX) * 4; i < n; i += (size_t)nvb * 1024) {
    const float4 v = *(const float4*)(in + i);
    uint2 w; w.x = pack2(v.x, v.y); w.y = pack2(v.z, v.w);
    *(uint2*)(out + i) = w;
  }
}
__device__ __forceinline__ void ph_weff(const P& p, int vb, int nvb) {
  for (int it = vb * 256 + TIDX; it < 512 * 1024; it += nvb * 256) {
    const int n = it & 1023, k = it >> 10, j = k >> 7, kl = k & 127;
    const float* wp = p.w_pool + ((size_t)j * 128 + kl) * 128;
    float s = 0.f;
    for (int c = 0; c < 128; ++c) s += wp[c] * p.pool_scale[j * 128 + c] * p.w_b_out[(size_t)(j * 128 + c) * 1024 + n];
    p.Wt_eff[(size_t)n * 512 + k] = f2bf(s);
  }
}
__device__ __forceinline__ void ph_mod(const P& p, int vb, int nvb, unsigned char* smem) {
  float* red = (float*)smem;
  const int lane = TIDX & 63, wid = TIDX >> 6;
  for (int it = vb; it < 96; it += nvb) {
    const int n = it * 64 + lane;
    float a0 = 0.f, a1 = 0.f, a2 = 0.f;
#pragma unroll 8
    for (int k = wid * 256; k < wid * 256 + 256; ++k) {
      const float w = p.w_mod[(size_t)k * 6144 + n];
      const float c0 = p.c[k], c1 = p.c[1024 + k], c2 = p.c_ctx[k];
      a0 += c0 * sigmoidf_(c0) * w; a1 += c1 * sigmoidf_(c1) * w; a2 += c2 * sigmoidf_(c2) * w;
    }
    __syncthreads();
    red[(wid * 3 + 0) * 64 + lane] = a0; red[(wid * 3 + 1) * 64 + lane] = a1; red[(wid * 3 + 2) * 64 + lane] = a2;
    __syncthreads();
    if (wid < 3) {
      const float sum = red[(0 * 3 + wid) * 64 + lane] + red[(1 * 3 + wid) * 64 + lane] + red[(2 * 3 + wid) * 64 + lane] + red[(3 * 3 + wid) * 64 + lane];
      p.mod[wid * 6144 + n] = sum + p.b_mod[n];
    }
  }
}
__device__ __forceinline__ float wave_sum(float v) {
#pragma unroll
  for (int o = 32; o > 0; o >>= 1) v += __shfl_xor(v, o);
  return v;
}
__device__ __forceinline__ void ph_norm1(const P& p, int vb, int nvb) {
  const int lane = TIDX & 63, wid = TIDX >> 6, nw = nvb * 4;
  for (int m0 = vb * 4 + wid; m0 < MROWS; m0 += 2 * nw) {
    const int m1 = m0 + nw; const bool has1 = m1 < MROWS; const int mb = has1 ? m1 : m0;
    const float* srcA = m0 < NTOK ? p.x + (size_t)m0 * DM : p.ctx + (size_t)(m0 - NTOK) * DM;
    const float* srcB = mb < NTOK ? p.x + (size_t)mb * DM : p.ctx + (size_t)(mb - NTOK) * DM;
    f32x4 va[4], vbq[4]; float sa = 0.f, sb = 0.f;
#pragma unroll
    for (int i = 0; i < 4; ++i) { va[i] = *(const f32x4*)(srcA + i * 256 + lane * 4); vbq[i] = *(const f32x4*)(srcB + i * 256 + lane * 4); }
#pragma unroll
    for (int i = 0; i < 4; ++i)
#pragma unroll
      for (int e = 0; e < 4; ++e) { sa += va[i][e] * va[i][e]; sb += vbq[i][e] * vbq[i][e]; }
    sa = wave_sum(sa); sb = wave_sum(sb);
#pragma unroll
    for (int rr = 0; rr < 2; ++rr) {
      if (rr == 1 && !has1) break;
      const int m = rr == 0 ? m0 : m1;
      const float rstd = rsqrtf((rr == 0 ? sa : sb) * (1.0f / 1024.0f) + 1e-6f);
      const float* md = p.mod + (m < NTOK ? (m / SEQ) : 2) * 6144;
      f32x4 y[4]; float am = 0.f;
#pragma unroll
      for (int i = 0; i < 4; ++i) {
        const int col = i * 256 + lane * 4;
        const f32x4 v = rr == 0 ? va[i] : vbq[i];
        const f32x4 g = *(const f32x4*)(p.g_pre_mix + col), sh = *(const f32x4*)(md + col), sc = *(const f32x4*)(md + 1024 + col);
#pragma unroll
        for (int e = 0; e < 4; ++e) { y[i][e] = v[e] * rstd * g[e] * (1.f + sc[e]) + sh[e]; am = fmaxf(am, fabsf(y[i][e])); }
      }
#pragma unroll
      for (int o = 32; o > 0; o >>= 1) am = fmaxf(am, __shfl_xor(am, o));
      const float qs = am > 0.f ? 127.0f / am : 0.f;
      if (lane == 0) p.hsa[m] = am > 0.f ? am / 127.0f : 1.0f;
#pragma unroll
      for (int i = 0; i < 4; ++i) {
        unsigned pk = 0;
#pragma unroll
        for (int e = 0; e < 4; ++e) pk |= ((unsigned)(int)rintf(y[i][e] * qs) & 255u) << (8 * e);
        *(unsigned*)(p.hx8 + (size_t)m * DM + i * 256 + lane * 4) = pk;
      }
    }
  }
}
struct Epi3Readout {
  const P* pp;
  __device__ __forceinline__ void finish(const bf16_t* sE, int m0, int n0, int tid) const {
    const P& p = *pp;
#pragma unroll 2
    for (int pq = 0; pq < 16; ++pq) {
      const int id = tid + 256 * pq, row = id >> 4, cc = (id & 15) * 8, m = m0 + row, n = n0 + cc, t = m % SEQ, h = n >> 6;
      const u32x4 g = *(const u32x4*)(sE + row * G3_ES + cc);
      const u32x4 y0 = *(const u32x4*)(p.Y0 + (size_t)m * DM + n);
      float y[8], v[8];
#pragma unroll
      for (int i = 0; i < 4; ++i) { y[2 * i] = bflo(y0[i]); y[2 * i + 1] = bfhi(y0[i]); }
      float sm = 0.f;
#pragma unroll
      for (int i = 0; i < 8; ++i) sm += y[i];
      const float mu = red8(sm) * (1.f / 64.f);
      float qv = 0.f;
#pragma unroll
      for (int i = 0; i < 8; ++i) { y[i] -= mu; qv += y[i] * y[i]; }
      const float rs = rsqrtf(red8(qv) * (1.f / 64.f) + 64e-5f);
      load8(p.zA, m, 2048 + n, v);
      const float bon = 0.5f * (p.bdot[(size_t)m * 16 + h] + p.bdot[((size_t)NTOK + m) * 16 + h]);
      const f32x4 w0 = *(const f32x4*)(p.ln_x_w + n), w1 = *(const f32x4*)(p.ln_x_w + n + 4), b0 = *(const f32x4*)(p.ln_x_b + n), b1 = *(const f32x4*)(p.ln_x_b + n + 4);
      const float lw[8] = {w0[0], w0[1], w0[2], w0[3], w1[0], w1[1], w1[2], w1[3]}, lb[8] = {b0[0], b0[1], b0[2], b0[3], b1[0], b1[1], b1[2], b1[3]};
      u32x4 o;
#pragma unroll
      for (int i = 0; i < 4; ++i)
        o[i] = pack2((y[2 * i] * rs * lw[2 * i] + lb[2 * i] + bon * v[2 * i]) * bflo(g[i]), (y[2 * i + 1] * rs * lw[2 * i + 1] + lb[2 * i + 1] + bon * v[2 * i + 1]) * bfhi(g[i]));
      *(u32x4*)(p.out_a + (size_t)m * DM + n) = o;
    }
  }
};
__device__ __forceinline__ int xcd_tile(int vb, int nvb, int round, int TM, int TN, int& tm, int& tn) {
  if (nvb % 64 != 0) { const int it = round * nvb + vb; if (it >= TM * TN) return 0; tm = it % TM; tn = it / TM; return 1; }
  const int spg = nvb >> 3, g = vb & 7, slot = vb >> 3, SC = spg >> 3;
  const int nsr = (TM + 7) >> 3, nsc = (TN + SC - 1) / SC, st = round * 8 + g;
  if (st >= nsr * nsc) return 0;
  tm = (st % nsr) * 8 + (slot & 7); tn = (st / nsr) * SC + (slot >> 3);
  return (tm < TM && tn < TN) ? 1 : 2;
}
__device__ __forceinline__ void ph_gemm1(const P& p, int vb, int nvb, unsigned char* smem) {
  const int NS_ = 132 * 27, NALL = NS_ + 128 * 20;
  const int per = nvb >> 3;
  for (int round = 0;; ++round) {
    int item;
    if ((nvb & 7) == 0) { const int blk = round * 8 + (vb & 7); if (blk * per >= NALL) break; item = blk * per + (vb >> 3); if (item >= NALL) continue; }
    else { item = round * nvb + vb; if (item >= NALL) break; }
    if (item < NS_) {
      const int cgp = item / (132 * 9), rem = item % (132 * 9), tmS = rem / 9, tn = cgp * 9 + rem % 9;
      Epi3ZS epi;
      epi.zA = p.zA; epi.mu = p.mu_shift;
      int m0;
      if (tmS < 130) { const int b = tmS / 65, i = tmS % 65; m0 = b * SEQ + 254 * i - 1; epi.own_lo = 1; epi.own_hi = min(254, SEQ - 254 * i); epi.t0 = 254 * i - 1; epi.T = SEQ; }
      else { m0 = NTOK + (tmS - 130) * CTXL; epi.own_lo = 0; epi.own_hi = 255; epi.t0 = 0; epi.T = CTXL; }
      gemm_tile3_i8(p.hx8, DM, p.Wt8, DM, DM, m0, tn * 128, p.hsa, p.wsb, epi, smem);
    } else {
      const int i2 = item - NS_;
      int tm, tn;
      if (i2 < 2048) { tm = (i2 & 1023) >> 3; tn = 27 + (i2 >> 10) * 8 + (i2 & 7); } else { tm = (i2 - 2048) >> 2; tn = 43 + (i2 & 3); }
      Epi3Z epi{p.zA, p.zP, p.zG};
      gemm_tile3_i8(p.hx8, DM, p.Wt8, DM, DM, tm * 256, tn * 128, p.hsa, p.wsb, epi, smem);
    }
  }
}
__device__ __forceinline__ void ph_readout_gemm(const P& p, int vb, int nvb, unsigned char* smem) {
  Epi3Readout epi{&p};
  for (int round = 0;; ++round) {
    int tm, tn; const int r = xcd_tile(vb, nvb, round, NTOK / 256, DM / 128, tm, tn);
    if (r == 0) break;
    if (r == 1) gemm_tile3(p.zA + 3328, SHIFTC, p.g2T, 128, 128, tm * 256, tn * 128, epi, smem);
  }
}
__device__ __forceinline__ void ph_sg(const P& p, int vb, int nvb) {
  for (int it = vb * 256 + TIDX; it < NTOK * 16; it += nvb * 256) {
    const int m = it >> 4, l8 = (it & 15) * 8, t = m % SEQ;
    float o[8];
    load8(p.zA, m, 3328 + l8, o);
    u32x4 w;
#pragma unroll
    for (int i = 0; i < 4; ++i) w[i] = pack2(sigmoidf_(o[2 * i]), sigmoidf_(o[2 * i + 1]));
    *(u32x4*)(p.sg + (size_t)m * 128 + l8) = w;
  }
}
__device__ __forceinline__ void ph_gemm_merge(const P& p, int vb, int nvb, unsigned char* smem) {
  Epi3GateA ea{p.zG, p.b_gate, p.mrg};
  Epi3GateB eb{p.zG, p.b_gate, p.mrg};
  for (int round = 0;; ++round) {
    int tm, tn; const int r = xcd_tile(vb, nvb, round, NTOK / 256, DM / 128, tm, tn);
    if (r == 0) break;
    if (r == 1) {
      gemm_tile3(p.out_a, DM, p.Wt_aout, DM, DM, tm * 256, tn * 128, ea, smem);
      gemm_tile3(p.pooled, 512, p.Wt_eff, 512, 512, tm * 256, tn * 128, eb, smem);
    }
  }
}
__device__ __forceinline__ void ph_gemm_simple(const bf16_t* A, int lda, const bf16_t* Bt, int ldb, int K, int M, int N, bf16_t* C, int ldc, int vb, int nvb, unsigned char* smem) {
  Epi3StoreBf16 epi{C, ldc};
  for (int round = 0;; ++round) {
    int tm, tn; const int r = xcd_tile(vb, nvb, round, M / 256, N / 128, tm, tn);
    if (r == 0) break;
    if (r == 1) gemm_tile3(A, lda, Bt, ldb, K, tm * 256, tn * 128, epi, smem);
  }
}


#define O_R1 0
#define O_R2 10240
#define O_TA (O_R2 + 17408)
#define O_TR (O_TA + 4608)
#define O_TB (O_TR + 4608)
#define O_TK (O_TB + 4608)
#define O_TBT (O_TK + 4608)
#define O_TKT (O_TBT + 5120)
#define O_TVT (O_TKT + 5120)
#define O_GAM (O_TVT + 5120)
#define O_TST (O_GAM + 256)
#define RWKV_SMEM (O_TST + 2 * 9216)
#define NSUP 65
__device__ __forceinline__ void lds_wave_fence() { asm volatile("s_waitcnt lgkmcnt(0)" ::: "memory"); }
__device__ __forceinline__ u32x2 pack4(const f32x4& v) { u32x2 r; r.x = pack2(v[0], v[1]); r.y = pack2(v[2], v[3]); return r; }


typedef short s16x4 __attribute__((ext_vector_type(4)));
template <int NS, bool WANTY>
__device__ __forceinline__ void rwkv_chunk(const P& p, unsigned char* smem, int d, int h, int rowbase, int T, int isc0, bool has_next, f32x4 (&st)[NS][4], u32x4 (&pf)[5]) {
  int tid = TIDX;
  asm volatile("" : "+v"(tid));
  const int lane = tid & 63, w = __builtin_amdgcn_readfirstlane(tid >> 6), l15 = lane & 15, q = lane >> 4;
  const int tt = tid >> 3, cg = tid & 7, ch0 = h * 64 + cg * 8;
  const int isc = isc0 + tt, t = d == 0 ? isc : T - 1 - isc;
  bf16_t* TWD = (bf16_t*)(smem + O_R1); bf16_t* TAD = TWD + 32 * 72;
  float* WT = (float*)(smem + O_R1);
  bf16_t* XT = (bf16_t*)(smem + O_R1); bf16_t* UT = XT + 64 * 40;
  float* LW = (float*)(smem + O_R2); float* LA = LW + 32 * 68;
  float* TL = (float*)(smem + O_R2);
  bf16_t* TT = (bf16_t*)(smem + O_R2 + 4608); bf16_t* TAK = TT + 32 * 40; bf16_t* TRB = TAK + 32 * 40; bf16_t* TRK = TRB + 32 * 40; bf16_t* TLB = TRK + 32 * 40;
  bf16_t* TA = (bf16_t*)(smem + O_TA); bf16_t* TR = (bf16_t*)(smem + O_TR); bf16_t* TB = (bf16_t*)(smem + O_TB); bf16_t* TK = (bf16_t*)(smem + O_TK);
  bf16_t* TBT = (bf16_t*)(smem + O_TBT); bf16_t* TKT = (bf16_t*)(smem + O_TKT); bf16_t* TVT = (bf16_t*)(smem + O_TVT);
  float* GAM = (float*)(smem + O_GAM);
  bf16_t* TST = (bf16_t*)(smem + O_TST);
  __syncthreads();
  float k8[8], r8[8];
  *(u32x4*)(TWD + tt * 72 + cg * 8) = pf[0];
  *(u32x4*)(TAD + tt * 72 + cg * 8) = pf[1];
#pragma unroll
  for (int i = 0; i < 4; ++i) { k8[2 * i] = bflo(pf[2][i]); k8[2 * i + 1] = bfhi(pf[2][i]); if (WANTY) { r8[2 * i] = bflo(pf[3][i]); r8[2 * i + 1] = bfhi(pf[3][i]); } }
  const u32x4 vzc = pf[4];
  __syncthreads();
  {
    f32x4 lw[2], la[2];
    bf16x8 w2f[2], a2f[2];
#pragma unroll
    for (int ks = 0; ks < 2; ++ks) {
      w2f[ks] = *(const bf16x8*)(p.w2T + ((size_t)d * 1024 + h * 64 + 16 * w + l15) * 64 + 32 * ks + 8 * q);
      a2f[ks] = *(const bf16x8*)(p.a2T + ((size_t)d * 1024 + h * 64 + 16 * w + l15) * 64 + 32 * ks + 8 * q);
    }
#pragma unroll
    for (int it = 0; it < 2; ++it) { lw[it] = (f32x4){0.f, 0.f, 0.f, 0.f}; la[it] = (f32x4){0.f, 0.f, 0.f, 0.f}; }
#pragma unroll
    for (int ks = 0; ks < 2; ++ks)
#pragma unroll
      for (int it = 0; it < 2; ++it) {
        const bf16x8 aw = *(const bf16x8*)(TWD + (16 * it + l15) * 72 + 32 * ks + 8 * q);
        const bf16x8 aa = *(const bf16x8*)(TAD + (16 * it + l15) * 72 + 32 * ks + 8 * q);
        lw[it] = __builtin_amdgcn_mfma_f32_16x16x32_bf16(aw, w2f[ks], lw[it], 0, 0, 0);
        la[it] = __builtin_amdgcn_mfma_f32_16x16x32_bf16(aa, a2f[ks], la[it], 0, 0, 0);
      }
    {
      const float cw0 = p.w0[d * 1024 + h * 64 + 16 * w + l15];
      float tot0 = 0.f;
#pragma unroll
      for (int it = 0; it < 2; ++it) {
        float pr[4];
#pragma unroll
        for (int rg = 0; rg < 4; ++rg) {
          const float e = 0.87505707f * sigmoidf_(cw0 + lw[it][rg]);
          pr[rg] = rg == 0 ? e : pr[rg - 1] + e;
        }
        float x = pr[3];
        float y = __shfl_up(x, 16); if (q >= 1) x += y;
        y = __shfl_up(x, 32); if (q >= 2) x += y;
        const float base = (x - pr[3]) + (it == 1 ? tot0 : 0.f);
        if (it == 0) tot0 = __shfl(x, 48 + l15);
#pragma unroll
        for (int rg = 0; rg < 4; ++rg) lw[it][rg] = pr[rg] + base;
      }
      if (q == 3) GAM[16 * w + l15] = __builtin_amdgcn_exp2f(-lw[1][3]);
    }
#pragma unroll
    for (int it = 0; it < 2; ++it)
#pragma unroll
      for (int rg = 0; rg < 4; ++rg) { LW[(16 * it + 4 * q + rg) * 68 + 16 * w + l15] = lw[it][rg]; LA[(16 * it + 4 * q + rg) * 68 + 16 * w + l15] = la[it][rg]; }
  }
  __syncthreads();
  float icl[8], kkn[8], kd[8];
  {
    float ss = 0.f, bd = 0.f;
    float ca0[8], ckk[8], cka[8], crk[8];
#pragma unroll
    for (int e4 = 0; e4 < 8; e4 += 4) {
      const f32x4 b2 = *(const f32x4*)(p.a0 + d * 1024 + ch0 + e4), c2 = *(const f32x4*)(p.k_k + ch0 + e4);
      const f32x4 d2 = *(const f32x4*)(p.k_a + ch0 + e4), f2 = *(const f32x4*)(p.r_k + ch0 + e4);
#pragma unroll
      for (int e = 0; e < 4; ++e) { ca0[e4 + e] = b2[e]; ckk[e4 + e] = c2[e]; cka[e4 + e] = d2[e]; crk[e4 + e] = f2[e]; }
    }
    float lav[8];
    { const f32x4 l0 = *(const f32x4*)(LA + tt * 68 + cg * 8), l1 = *(const f32x4*)(LA + tt * 68 + cg * 8 + 4);
#pragma unroll
      for (int e = 0; e < 4; ++e) { lav[e] = l0[e]; lav[4 + e] = l1[e]; } }
#pragma unroll
    for (int e = 0; e < 8; ++e) {
      icl[e] = sigmoidf_(ca0[e] + lav[e]);
      kkn[e] = k8[e] * ckk[e]; ss += kkn[e] * kkn[e];
      kd[e] = k8[e] * (1.f + (icl[e] - 1.f) * cka[e]);
      if (WANTY) bd += r8[e] * kd[e] * crk[e];
    }
    ss = red8(ss); if (WANTY) bd = red8(bd);
    const float rn = rsqrtf(fmaxf(ss, 1e-24f));
#pragma unroll
    for (int e = 0; e < 8; ++e) kkn[e] *= rn;
    if (WANTY && cg == 0) p.bdot[((size_t)d * NTOK + rowbase + t) * 16 + h] = bd;
  }
  {
    float ta[8], tr[8], tb[8], tk[8], v8[8];
#pragma unroll
    for (int i = 0; i < 4; ++i) { v8[2 * i] = bflo(vzc[i]); v8[2 * i + 1] = bfhi(vzc[i]); }
    float Lv[8], Lpv[8];
    {
      const f32x4 a0 = *(const f32x4*)(LW + tt * 68 + cg * 8), a1 = *(const f32x4*)(LW + tt * 68 + cg * 8 + 4);
      const int tp = tt > 0 ? tt - 1 : 0;
      const f32x4 b0 = *(const f32x4*)(LW + tp * 68 + cg * 8), b1 = *(const f32x4*)(LW + tp * 68 + cg * 8 + 4);
#pragma unroll
      for (int e = 0; e < 4; ++e) { Lv[e] = a0[e]; Lv[4 + e] = a1[e]; Lpv[e] = tt > 0 ? b0[e] : 0.f; Lpv[4 + e] = tt > 0 ? b1[e] : 0.f; }
    }
#pragma unroll
    for (int e = 0; e < 8; ++e) {
      const float Li = Lv[e];
      const float Lp = Lpv[e];
      const float gi = __builtin_amdgcn_exp2f(-Li), gim1 = __builtin_amdgcn_exp2f(-Lp), ginv = __builtin_amdgcn_exp2f(Li);
      ta[e] = -kkn[e] * gim1; if (WANTY) tr[e] = r8[e] * gi; tb[e] = kkn[e] * icl[e] * ginv; tk[e] = kd[e] * ginv;
    }
    u32x4 pk;
    pk.x = pack2(ta[0], ta[1]); pk.y = pack2(ta[2], ta[3]); pk.z = pack2(ta[4], ta[5]); pk.w = pack2(ta[6], ta[7]); *(u32x4*)(TA + tt * 72 + cg * 8) = pk;
    if (WANTY) { pk.x = pack2(tr[0], tr[1]); pk.y = pack2(tr[2], tr[3]); pk.z = pack2(tr[4], tr[5]); pk.w = pack2(tr[6], tr[7]); *(u32x4*)(TR + tt * 72 + cg * 8) = pk; }
    pk.x = pack2(tb[0], tb[1]); pk.y = pack2(tb[2], tb[3]); pk.z = pack2(tb[4], tb[5]); pk.w = pack2(tb[6], tb[7]); *(u32x4*)(TB + tt * 72 + cg * 8) = pk;
    pk.x = pack2(tk[0], tk[1]); pk.y = pack2(tk[2], tk[3]); pk.z = pack2(tk[4], tk[5]); pk.w = pack2(tk[6], tk[7]); *(u32x4*)(TK + tt * 72 + cg * 8) = pk;
    { const int tts = tt ^ ((cg >> 1) << 3);
#pragma unroll
    for (int e = 0; e < 8; ++e) { TBT[(cg * 8 + e) * 40 + tts] = f2bf(tb[e]); TKT[(cg * 8 + e) * 40 + tts] = f2bf(tk[e]); TVT[(cg * 8 + e) * 40 + tts] = f2bf(v8[e]); } }
  }
  __syncthreads();
  if (WANTY || w < 2) {
    const bf16_t* X = (w < 2) ? TA : TR; const bf16_t* Y = (w & 1) ? TK : TB;
    f32x4 g[2][2];
#pragma unroll
    for (int it = 0; it < 2; ++it)
#pragma unroll
      for (int s2 = 0; s2 < 2; ++s2) g[it][s2] = (f32x4){0.f, 0.f, 0.f, 0.f};
#pragma unroll
    for (int ks = 0; ks < 2; ++ks) {
      bf16x8 xa[2], yb[2];
#pragma unroll
      for (int it = 0; it < 2; ++it) { xa[it] = *(const bf16x8*)(X + (16 * it + l15) * 72 + 32 * ks + 8 * q); yb[it] = *(const bf16x8*)(Y + (16 * it + l15) * 72 + 32 * ks + 8 * q); }
#pragma unroll
      for (int it = 0; it < 2; ++it)
#pragma unroll
        for (int s2 = 0; s2 < 2; ++s2) g[it][s2] = __builtin_amdgcn_mfma_f32_16x16x32_bf16(xa[it], yb[s2], g[it][s2], 0, 0, 0);
    }
    if (w == 0) {
#pragma unroll
      for (int it = 0; it < 2; ++it)
#pragma unroll
        for (int s2 = 0; s2 < 2; ++s2)
#pragma unroll
          for (int rg = 0; rg < 4; ++rg) {
            const int i = 16 * it + 4 * q + rg, s = 16 * s2 + l15;
            TL[i * 36 + s] = (s < i) ? g[it][s2][rg] : 0.f;
          }
#pragma unroll
      for (int rg = 0; rg < 4; ++rg) TLB[(4 * q + rg) * 40 + l15] = f2bf(g[1][0][rg]);
    } else {
      bf16_t* dst = w == 1 ? TAK : (w == 2 ? TRB : TRK);
      const int incl = w == 1 ? 0 : 1;
#pragma unroll
      for (int it = 0; it < 2; ++it)
#pragma unroll
        for (int s2 = 0; s2 < 2; ++s2)
#pragma unroll
          for (int rg = 0; rg < 4; ++rg) {
            const int i = 16 * it + 4 * q + rg, s = 16 * s2 + l15;
            dst[i * 40 + s] = f2bf((s < i + incl) ? g[it][s2][rg] : 0.f);
          }
    }
  }
  if (w == 0) {
    lds_wave_fence();
    const int c = lane & 15, hb = lane & 16;
    float Tr[16];
    f32x4 Lr[16][4];
#pragma unroll
    for (int i = 1; i < 16; ++i)
#pragma unroll
      for (int j4 = 0; j4 < (i + 3) / 4; ++j4) Lr[i][j4] = *(const f32x4*)(TL + (hb + i) * 36 + hb + 4 * j4);
#pragma unroll
    for (int i = 0; i < 16; ++i) {
      float acc = (i == c) ? 1.f : 0.f;
#pragma unroll
      for (int j = 0; j < i; ++j) acc += Lr[i][j >> 2][j & 3] * Tr[j];
      Tr[i] = acc;
    }
    if (lane < 32) {
#pragma unroll
      for (int i = 0; i < 16; ++i) TT[(hb + i) * 40 + hb + c] = f2bf(Tr[i]);
    }
  }
  __syncthreads();
  if (has_next) {
    const int isn = isc + 32, tn = d == 0 ? isn : T - 1 - isn;
    const bf16_t* zr = p.zA + (size_t)(rowbase + tn) * SHIFTC;
    pf[0] = *(const u32x4*)(zr + 3072 + d * 64 + cg * 8);
    pf[1] = *(const u32x4*)(zr + 3200 + d * 64 + cg * 8);
    pf[2] = *(const u32x4*)(zr + 1024 + ch0);
    if (WANTY) pf[3] = *(const u32x4*)(zr + ch0);
    pf[4] = *(const u32x4*)(zr + 2048 + ch0);
  }
  bf16_t yprev[2][4];
  if (WANTY) {
#pragma unroll
    for (int it = 0; it < 2; ++it)
#pragma unroll
      for (int rg = 0; rg < 4; ++rg) {
        yprev[it][rg] = 0;
        if (d == 1) yprev[it][rg] = p.Y0[(size_t)(rowbase + T - 1 - (isc0 + 16 * it + 4 * q + rg)) * DM + h * 64 + 16 * w + l15];
      }
  }
  const bf16x8 vfr = *(const bf16x8*)(TVT + (16 * w + l15) * 40 + 8 * (q ^ w));
  const s16x4 t1f = *(const s16x4*)(TT + l15 * 40 + 4 * q), t2f = *(const s16x4*)(TT + (16 + l15) * 40 + 16 + 4 * q), l21f = *(const s16x4*)(TLB + l15 * 40 + 4 * q);
  bf16_t* XTw = XT + (16 * w + l15) * 40; bf16_t* UTw = UT + (16 * w + l15) * 40;
#pragma unroll
  for (int si = 0; si < NS; ++si) {
    const bool useV = (NS == 1) || (si == 1);
    const bf16_t* STs = TST + (si * 64 + 16 * w + l15) * 72;
    bf16x8 sf[2];
    sf[0] = *(const bf16x8*)(STs + 8 * q); sf[1] = *(const bf16x8*)(STs + 32 + 8 * q);
    f32x4 xa[2];
#pragma unroll
    for (int it = 0; it < 2; ++it) {
      xa[it] = (f32x4){0.f, 0.f, 0.f, 0.f};
#pragma unroll
      for (int ks = 0; ks < 2; ++ks) xa[it] = __builtin_amdgcn_mfma_f32_16x16x32_bf16(*(const bf16x8*)(TA + (16 * it + l15) * 72 + 32 * ks + 8 * q), sf[ks], xa[it], 0, 0, 0);
      if (useV) xa[it] = __builtin_amdgcn_mfma_f32_16x16x32_bf16(*(const bf16x8*)(TAK + (16 * it + l15) * 40 + 8 * q), vfr, xa[it], 0, 0, 0);
    }
    *(u32x2*)(XTw + 4 * q) = pack4(xa[0]);
    lds_wave_fence();
    f32x4 ua = __builtin_amdgcn_mfma_f32_16x16x16bf16_1k(t1f, *(const s16x4*)(XTw + 4 * q), (f32x4){0.f, 0.f, 0.f, 0.f}, 0, 0, 0);
    *(u32x2*)(UTw + 4 * q) = pack4(ua);
    lds_wave_fence();
    xa[1] = __builtin_amdgcn_mfma_f32_16x16x16bf16_1k(l21f, *(const s16x4*)(UTw + 4 * q), xa[1], 0, 0, 0);
    *(u32x2*)(XTw + 16 + 4 * q) = pack4(xa[1]);
    lds_wave_fence();
    ua = __builtin_amdgcn_mfma_f32_16x16x16bf16_1k(t2f, *(const s16x4*)(XTw + 16 + 4 * q), (f32x4){0.f, 0.f, 0.f, 0.f}, 0, 0, 0);
    *(u32x2*)(UTw + 16 + 4 * q) = pack4(ua);
    lds_wave_fence();
    const bf16x8 uf = *(const bf16x8*)(UTw + 8 * q);
    if (WANTY) {
#pragma unroll
      for (int it = 0; it < 2; ++it) {
        f32x4 ya = (f32x4){0.f, 0.f, 0.f, 0.f};
#pragma unroll
        for (int ks = 0; ks < 2; ++ks) ya = __builtin_amdgcn_mfma_f32_16x16x32_bf16(*(const bf16x8*)(TR + (16 * it + l15) * 72 + 32 * ks + 8 * q), sf[ks], ya, 0, 0, 0);
        ya = __builtin_amdgcn_mfma_f32_16x16x32_bf16(*(const bf16x8*)(TRB + (16 * it + l15) * 40 + 8 * q), uf, ya, 0, 0, 0);
        if (useV) ya = __builtin_amdgcn_mfma_f32_16x16x32_bf16(*(const bf16x8*)(TRK + (16 * it + l15) * 40 + 8 * q), vfr, ya, 0, 0, 0);
#pragma unroll
        for (int rg = 0; rg < 4; ++rg) {
          const int iq = isc0 + 16 * it + 4 * q + rg, tq = d == 0 ? iq : T - 1 - iq;
          if (useV) {
            p.Y0[(size_t)(rowbase + tq) * DM + h * 64 + 16 * w + l15] = f2bf(ya[rg] + bf2f(yprev[it][rg]));
          } else {
            bf16_t* pp = d == 0 ? p.Y1 + (size_t)(rowbase + tq) * DM : p.zA + (size_t)(rowbase + tq) * SHIFTC;
            pp[h * 64 + 16 * w + l15] = f2bf(ya[rg]);
          }
        }
      }
    }
#pragma unroll
    for (int kt = 0; kt < 4; ++kt) {
      f32x4 hv = st[si][kt];
      hv = __builtin_amdgcn_mfma_f32_16x16x32_bf16(*(const bf16x8*)(TBT + (16 * kt + l15) * 40 + 8 * (q ^ kt)), uf, hv, 0, 0, 0);
      if (useV) hv = __builtin_amdgcn_mfma_f32_16x16x32_bf16(*(const bf16x8*)(TKT + (16 * kt + l15) * 40 + 8 * (q ^ kt)), vfr, hv, 0, 0, 0);
      hv *= *(const f32x4*)(GAM + 16 * kt + 4 * q);
      st[si][kt] = hv;
      *(u32x2*)(TST + (si * 64 + 16 * w + l15) * 72 + 16 * kt + 4 * q) = pack4(hv);
    }
  }
}

template <bool WANTY>
__device__ __forceinline__ void rwkv_prefetch_first(const P& p, int d, int h, int rowbase, int T, int isc0, u32x4 (&pf)[5]) {
  const int tid = TIDX, tt = tid >> 3, cg = tid & 7, ch0 = h * 64 + cg * 8, isc = isc0 + tt, t = d == 0 ? isc : T - 1 - isc;
  const bf16_t* zr = p.zA + (size_t)(rowbase + t) * SHIFTC;
  pf[0] = *(const u32x4*)(zr + 3072 + d * 64 + cg * 8);
  pf[1] = *(const u32x4*)(zr + 3200 + d * 64 + cg * 8);
  pf[2] = *(const u32x4*)(zr + 1024 + ch0);
  pf[3] = WANTY ? *(const u32x4*)(zr + ch0) : (u32x4){0u, 0u, 0u, 0u};
  pf[4] = *(const u32x4*)(zr + 2048 + ch0);
}
template <bool LAT>
__device__ __forceinline__ void rwkv_super(const P& p, unsigned char* smem, int chain, int j) {
  const int tid = TIDX, lane = tid & 63, w = tid >> 6, l15 = lane & 15, q = lane >> 4;
  bf16_t* TST = (bf16_t*)(smem + O_TST);
  const int b = chain >> 5, d = (chain >> 4) & 1, h = chain & 15;
  const int T = LAT ? SEQ : CTXL, rowbase = LAT ? b * SEQ : NTOK + b * CTXL, base = LAT ? (j - 1) * 256 : 0;
  f32x4 st[2][4];
  __syncthreads();
#pragma unroll
  for (int kt = 0; kt < 4; ++kt) {
#pragma unroll
    for (int rg = 0; rg < 4; ++rg) st[0][kt][rg] = (16 * kt + 4 * q + rg == 16 * w + l15) ? 1.f : 0.f;
    st[1][kt] = (f32x4){0.f, 0.f, 0.f, 0.f};
    *(u32x2*)(TST + (16 * w + l15) * 72 + 16 * kt + 4 * q) = pack4(st[0][kt]);
    *(u32x2*)(TST + (64 + 16 * w + l15) * 72 + 16 * kt + 4 * q) = pack4(st[1][kt]);
  }
  u32x4 pf[5]; rwkv_prefetch_first<LAT>(p, d, h, rowbase, T, base, pf);
  for (int c = 0; c < 8; ++c) rwkv_chunk<2, LAT>(p, smem, d, h, rowbase, T, base + 32 * c, c < 7, st, pf);
  if (j < 64) {
    const size_t slot = (size_t)chain * NSUP + j;
#pragma unroll
    for (int kt = 0; kt < 4; ++kt) {
#pragma unroll
      for (int rg = 0; rg < 4; ++rg) p.Mst[(slot * 64 + 16 * kt + 4 * q + rg) * 64 + 16 * w + l15] = f2bf(st[0][kt][rg]);
      *(f32x4*)(p.Nst + (slot * 64 + 16 * w + l15) * 64 + 16 * kt + 4 * q) = st[1][kt];
    }
  }
}
__device__ __forceinline__ void ph_rwkv_A(const P& p, int vb, int nvb, unsigned char* smem) {
  for (int chain = vb; chain < 64; chain += nvb) rwkv_super<false>(p, smem, chain, 0);
  for (int item = vb; item < 2048; item += nvb) {
    const int b = item >> 10, J = (item >> 4) & 63, h = item & 15;
#pragma unroll 1
    for (int d = 0; d < 2; ++d) {
      rwkv_super<true>(p, smem, b * 32 + d * 16 + h, d == 0 ? J + 1 : 64 - J);
      asm volatile("s_waitcnt vmcnt(0)" ::: "memory");
      __syncthreads();
    }
  }
}
__device__ __forceinline__ void ph_rwkv_B(const P& p, int vb, int nvb, unsigned char* smem) {
  const int tid = TIDX, lane = tid & 63, w = tid >> 6, l15 = lane & 15, q = lane >> 4;
  bf16_t* HT = (bf16_t*)smem;
  for (int chain = vb; chain < 64; chain += nvb) {
    f32x4 hs[4];
#pragma unroll
    for (int kt = 0; kt < 4; ++kt) hs[kt] = (f32x4){0.f, 0.f, 0.f, 0.f};
    __syncthreads();
    for (int j = 0; j < 64; ++j) {
      const size_t slot = (size_t)chain * NSUP + j;
      f32x4 nv[4];
#pragma unroll
      for (int kt = 0; kt < 4; ++kt) nv[kt] = *(const f32x4*)(p.Nst + (slot * 64 + 16 * w + l15) * 64 + 16 * kt + 4 * q);
      bf16x8 mf[4][2];
#pragma unroll
      for (int kt = 0; kt < 4; ++kt)
#pragma unroll
        for (int ks = 0; ks < 2; ++ks) mf[kt][ks] = *(const bf16x8*)(p.Mst + (slot * 64 + 16 * kt + l15) * 64 + 32 * ks + 8 * q);
#pragma unroll
      for (int kt = 0; kt < 4; ++kt) {
        *(f32x4*)(p.Nst + (slot * 64 + 16 * w + l15) * 64 + 16 * kt + 4 * q) = hs[kt];
        *(u32x2*)(HT + (16 * w + l15) * 72 + 16 * kt + 4 * q) = pack4(hs[kt]);
      }
      lds_wave_fence();
      bf16x8 hf[2];
      hf[0] = *(const bf16x8*)(HT + (16 * w + l15) * 72 + 8 * q); hf[1] = *(const bf16x8*)(HT + (16 * w + l15) * 72 + 32 + 8 * q);
      lds_wave_fence();
#pragma unroll
      for (int kt = 0; kt < 4; ++kt) {
        f32x4 a = nv[kt];
#pragma unroll
        for (int ks = 0; ks < 2; ++ks) a = __builtin_amdgcn_mfma_f32_16x16x32_bf16(mf[kt][ks], hf[ks], a, 0, 0, 0);
        hs[kt] = a;
      }
    }
    const size_t slot = (size_t)chain * NSUP + 64;
#pragma unroll
    for (int kt = 0; kt < 4; ++kt) *(f32x4*)(p.Nst + (slot * 64 + 16 * w + l15) * 64 + 16 * kt + 4 * q) = hs[kt];
  }
}
#define YC_LD 136
__device__ __forceinline__ void ph_ycorr(const P& p, int vb, int nvb, unsigned char* smem) {
  const int tid = TIDX, lane = tid & 63, w = tid >> 6, l15 = lane & 15, q = lane >> 4;
  bf16_t* HL = (bf16_t*)smem;
  bf16_t* GL = HL + 64 * YC_LD;
  for (int item = vb; item < 2048; item += nvb) {
    const int b = item >> 10, J = (item >> 4) & 63, h = item & 15;
    const size_t tok0 = (size_t)b * SEQ + J * 256 + 64 * w;
    __syncthreads();
    {
      const int v = tid >> 2, k0 = (tid & 3) * 32;
      const size_t slot = k0 < 64 ? (size_t)(b * 32 + h) * NSUP + (J + 1) : (size_t)(b * 32 + 16 + h) * NSUP + (64 - J);
      const float* src = p.Nst + (slot * 64 + v) * 64 + (k0 & 63);
#pragma unroll
      for (int i = 0; i < 4; ++i) {
        const f32x4 a = *(const f32x4*)(src + 8 * i), c = *(const f32x4*)(src + 8 * i + 4);
        *(u32x4*)(HL + v * YC_LD + k0 + 8 * i) = (u32x4){pack2(a[0], a[1]), pack2(a[2], a[3]), pack2(c[0], c[1]), pack2(c[2], c[3])};
        *(u32x4*)(GL + v * YC_LD + k0 + 8 * i) = *(const u32x4*)(p.g2T + (size_t)(h * 64 + v) * 128 + k0 + 8 * i);
      }
    }
    struct Ops { bf16x8 pa[4], sgf[4]; u32x2 yo[4], vv[4]; float bd0, bd1; };
    auto load_ops = [&](Ops& o, int mt) {
      const size_t tk = tok0 + 16 * mt + l15;
#pragma unroll
      for (int kk = 0; kk < 2; ++kk) { o.pa[kk] = *(const bf16x8*)(p.Y1 + tk * DM + h * 64 + 32 * kk + 8 * q); o.pa[2 + kk] = *(const bf16x8*)(p.zA + tk * SHIFTC + h * 64 + 32 * kk + 8 * q); }
#pragma unroll
      for (int kk = 0; kk < 4; ++kk) o.sgf[kk] = *(const bf16x8*)(p.zA + tk * SHIFTC + 3328 + 32 * kk + 8 * q);
#pragma unroll
      for (int nt = 0; nt < 4; ++nt) { o.yo[nt] = *(const u32x2*)(p.Y0 + tk * DM + h * 64 + 16 * nt + 4 * q); o.vv[nt] = *(const u32x2*)(p.zA + tk * SHIFTC + 2048 + h * 64 + 16 * nt + 4 * q); }
      o.bd0 = p.bdot[tk * 16 + h]; o.bd1 = p.bdot[((size_t)NTOK + tk) * 16 + h];
    };
    auto step = [&](const Ops& o, int mt) {
      asm volatile("" ::: "memory");
      const size_t tok = tok0 + 16 * mt + l15;
      const float bon = 0.5f * (o.bd0 + o.bd1);
      f32x4 yv[4], gv[4];
      float sm = 0.f;
#pragma unroll
      for (int nt = 0; nt < 4; ++nt) {
        f32x4 acc = (f32x4){bflo(o.yo[nt].x), bfhi(o.yo[nt].x), bflo(o.yo[nt].y), bfhi(o.yo[nt].y)};
        f32x4 g = (f32x4){0.f, 0.f, 0.f, 0.f};
#pragma unroll
        for (int kk = 0; kk < 4; ++kk) {
          acc = __builtin_amdgcn_mfma_f32_16x16x32_bf16(*(const bf16x8*)(HL + (16 * nt + l15) * YC_LD + 32 * kk + 8 * q), o.pa[kk], acc, 0, 0, 0);
          g = __builtin_amdgcn_mfma_f32_16x16x32_bf16(*(const bf16x8*)(GL + (16 * nt + l15) * YC_LD + 32 * kk + 8 * q), o.sgf[kk], g, 0, 0, 0);
        }
        yv[nt] = acc; gv[nt] = g;
        sm += (acc[0] + acc[1]) + (acc[2] + acc[3]);
      }
      sm += __shfl_xor(sm, 16); sm += __shfl_xor(sm, 32);
      const float mu = sm * (1.f / 64.f);
      float qv = 0.f;
#pragma unroll
      for (int nt = 0; nt < 4; ++nt)
#pragma unroll
        for (int rg = 0; rg < 4; ++rg) { yv[nt][rg] -= mu; qv += yv[nt][rg] * yv[nt][rg]; }
      qv += __shfl_xor(qv, 16); qv += __shfl_xor(qv, 32);
      const float rs = rsqrtf(qv * (1.f / 64.f) + 64e-5f);
#pragma unroll
      for (int nt = 0; nt < 4; ++nt) {
        const f32x4 v4 = (f32x4){bflo(o.vv[nt].x), bfhi(o.vv[nt].x), bflo(o.vv[nt].y), bfhi(o.vv[nt].y)};
        const f32x4 lw = *(const f32x4*)(p.ln_x_w + h * 64 + 16 * nt + 4 * q), lb = *(const f32x4*)(p.ln_x_b + h * 64 + 16 * nt + 4 * q);
        f32x4 ov;
#pragma unroll
        for (int rg = 0; rg < 4; ++rg) ov[rg] = (yv[nt][rg] * rs * lw[rg] + lb[rg] + bon * v4[rg]) * gv[nt][rg];
        *(u32x2*)(p.out_a + tok * DM + h * 64 + 16 * nt + 4 * q) = pack4(ov);
      }
    };
    Ops oa, ob;
    load_ops(oa, 0);
    __syncthreads();
    load_ops(ob, 1); step(oa, 0);
    load_ops(oa, 2); step(ob, 1);
    load_ops(ob, 3); step(oa, 2);
    step(ob, 3);
  }
  __syncthreads();
}

#define POOL_SMEM (64 * 128 * 4)
__device__ __forceinline__ void ph_pool(const P& p, int vb, int nvb, unsigned char* smem) {
  float* V = (float*)smem;
  const int tid = TIDX, cp = tid & 63, cq = tid >> 6;
  for (int item = vb; item < 2 * 4 * 64; item += nvb) {
    const int j = item & 3, st = (item >> 2) & 63, b = item >> 8;
    const int win = 2 << j, half = win >> 1;
    const bf16_t* zb = p.zP + (size_t)b * SEQ * 512 + j * 128 + cp * 2;
    float a0[16], a1[16];
#pragma unroll
    for (int i = 0; i < 16; ++i) { a0[i] = 0.f; a1[i] = 0.f; }
    {
      const int r = 4 * st, r0 = max(r - half, 0), r1 = min(r + half, 256);
      for (int rr = r0; rr < r1; ++rr) {
#pragma unroll
        for (int i = 0; i < 16; ++i) { const unsigned u = *(const unsigned*)(zb + (size_t)(rr * 64 + cq * 16 + i) * 512); a0[i] += bflo(u); a1[i] += bfhi(u); }
      }
    }
    for (int dr = 0; dr < 4; ++dr) {
      const int r = 4 * st + dr, r0 = max(r - half, 0), r1 = min(r + half, 256);
      if (dr > 0) {
        const int radd = r + half - 1, rsub = r - half - 1;
        if (radd < 256) {
#pragma unroll
          for (int i = 0; i < 16; ++i) { const unsigned u = *(const unsigned*)(zb + (size_t)(radd * 64 + cq * 16 + i) * 512); a0[i] += bflo(u); a1[i] += bfhi(u); }
        }
        if (rsub >= 0) {
#pragma unroll
          for (int i = 0; i < 16; ++i) { const unsigned u = *(const unsigned*)(zb + (size_t)(rsub * 64 + cq * 16 + i) * 512); a0[i] -= bflo(u); a1[i] -= bfhi(u); }
        }
      }
      __syncthreads();
#pragma unroll
      for (int i = 0; i < 16; ++i) *(f32x2*)(V + (cq * 16 + i) * 128 + cp * 2) = (f32x2){a0[i], a1[i]};
      __syncthreads();
      float s0 = 0.f, s1 = 0.f;
      {
        const int c = cq * 16, c0 = max(c - half, 0), c1 = min(c + half, 64);
        for (int cc = c0; cc < c1; ++cc) { const f32x2 v = *(const f32x2*)(V + cc * 128 + cp * 2); s0 += v.x; s1 += v.y; }
      }
#pragma unroll
      for (int i = 0; i < 16; ++i) {
        const int c = cq * 16 + i, c0 = max(c - half, 0), c1 = min(c + half, 64);
        if (i > 0) {
          const int cadd = c + half - 1, csub = c - half - 1;
          if (cadd < 64) { const f32x2 v = *(const f32x2*)(V + cadd * 128 + cp * 2); s0 += v.x; s1 += v.y; }
          if (csub >= 0) { const f32x2 v = *(const f32x2*)(V + csub * 128 + cp * 2); s0 -= v.x; s1 -= v.y; }
        }
        const float inv = __builtin_amdgcn_rcpf((float)((r1 - r0) * (c1 - c0)));
        const size_t tokoff = ((size_t)b * SEQ + r * 64 + c) * 512 + j * 128 + cp * 2;
        const unsigned u = *(const unsigned*)(p.zP + tokoff);
        *(unsigned*)(p.pooled + tokoff) = pack2(s0 * inv - bflo(u), s1 * inv - bfhi(u));
      }
    }
  }
}
__device__ __forceinline__ void ph_res1(const P& p, int vb, int nvb) {
  const int lane = TIDX & 63, wid = TIDX >> 6;
  for (int m = vb * 4 + wid; m < NTOK; m += nvb * 4) {
    const float* md = p.mod + (m / SEQ) * 6144;
    float mx[16]; float ss = 0.f;
#pragma unroll
    for (int i = 0; i < 4; ++i) {
      const uint2 u = *(const uint2*)(p.mix + (size_t)m * DM + i * 256 + lane * 4);
      mx[4 * i] = bflo(u.x); mx[4 * i + 1] = bfhi(u.x); mx[4 * i + 2] = bflo(u.y); mx[4 * i + 3] = bfhi(u.y);
#pragma unroll
      for (int e = 0; e < 4; ++e) ss += mx[4 * i + e] * mx[4 * i + e];
    }
    ss = wave_sum(ss);
    const float rstd = rsqrtf(ss * (1.0f / 1024.0f) + 1e-6f);
    float x1[16]; float s2 = 0.f;
#pragma unroll
    for (int i = 0; i < 4; ++i) {
      const int col = i * 256 + lane * 4;
      const float4 xv = *(const float4*)(p.x + (size_t)m * DM + col), g = *(const float4*)(p.g_post_mix + col), gt = *(const float4*)(md + 2048 + col);
      x1[4 * i] = xv.x + gt.x * mx[4 * i] * rstd * g.x; x1[4 * i + 1] = xv.y + gt.y * mx[4 * i + 1] * rstd * g.y;
      x1[4 * i + 2] = xv.z + gt.z * mx[4 * i + 2] * rstd * g.z; x1[4 * i + 3] = xv.w + gt.w * mx[4 * i + 3] * rstd * g.w;
      { uint2 xb; xb.x = pack2(x1[4 * i], x1[4 * i + 1]); xb.y = pack2(x1[4 * i + 2], x1[4 * i + 3]); *(uint2*)(p.x1b + (size_t)m * DM + col) = xb; }
#pragma unroll
      for (int e = 0; e < 4; ++e) s2 += x1[4 * i + e] * x1[4 * i + e];
    }
    s2 = wave_sum(s2);
    const float r2 = rsqrtf(s2 * (1.0f / 1024.0f) + 1e-6f);
#pragma unroll
    for (int i = 0; i < 4; ++i) {
      const int col = i * 256 + lane * 4;
      const float4 g = *(const float4*)(p.g_pre_ffn + col), sh = *(const float4*)(md + 3072 + col), sc = *(const float4*)(md + 4096 + col);
      uint2 w;
      w.x = pack2(x1[4 * i] * r2 * g.x * (1.f + sc.x) + sh.x, x1[4 * i + 1] * r2 * g.y * (1.f + sc.y) + sh.y);
      w.y = pack2(x1[4 * i + 2] * r2 * g.z * (1.f + sc.z) + sh.z, x1[4 * i + 3] * r2 * g.w * (1.f + sc.w) + sh.w);
      *(uint2*)(p.hx2 + (size_t)m * DM + col) = w;
    }
  }
}

#define PS1_SMEM (128 * 133 * 4)
#define CE_DESC(a, b) { const float _mx = fmaxf(a, b), _mn = fminf(a, b); a = _mx; b = _mn; }
template <int N> __device__ __forceinline__ void bitonic_sort_desc(float (&v)[N]) {
#pragma unroll
  for (int k = 2; k <= N; k <<= 1)
#pragma unroll
    for (int j = k >> 1; j > 0; j >>= 1)
#pragma unroll
      for (int i = 0; i < N; ++i) { const int l = i ^ j; if (l > i) { if ((i & k) == 0) CE_DESC(v[i], v[l]) else CE_DESC(v[l], v[i]) } }
}
__device__ __forceinline__ void bitonic_merge16_desc(float (&v)[16]) {
#pragma unroll
  for (int j = 8; j > 0; j >>= 1)
#pragma unroll
    for (int i = 0; i < 16; ++i) { const int l = i ^ j; if (l > i) CE_DESC(v[i], v[l]) }
}
__device__ __forceinline__ void ph_peer_s1(const P& p, int vb, int nvb, unsigned char* smem) {
  float* S = (float*)smem;
  EpiLds epi{S};
  const int tid = TIDX, sub = tid & 3;
  for (int item = vb; item < 256 * 16; item += nvb) {
    const int hp = item & 15, tm = item >> 4;
    __syncthreads();
    gemm_tile(p.q + hp * 128, 2048, p.keys + (size_t)hp * 128 * 128, 128, 128, tm * 128, 0, epi, smem);
    __syncthreads();
#pragma unroll 1
    for (int pass = 0; pass < 2; ++pass) {
      const int row = pass * 64 + (tid >> 2);
      float a[16], b[16];
#pragma unroll
      for (int i = 0; i < 16; ++i) {
        a[i] = __uint_as_float((__float_as_uint(S[row * 133 + sub * 33 + i]) & ~127u) | (unsigned)(sub * 32 + i));
        b[i] = __uint_as_float((__float_as_uint(S[row * 133 + sub * 33 + 16 + i]) & ~127u) | (unsigned)(sub * 32 + 16 + i));
      }
      bitonic_sort_desc<16>(a); bitonic_sort_desc<16>(b);
#pragma unroll
      for (int i = 0; i < 16; ++i) a[i] = fmaxf(a[i], b[15 - i]);
      bitonic_merge16_desc(a);
#pragma unroll
      for (int lvl = 1; lvl <= 2; lvl <<= 1) {
#pragma unroll
        for (int i = 0; i < 16; ++i) b[i] = __shfl_xor(a[i], lvl);
#pragma unroll
        for (int i = 0; i < 16; ++i) a[i] = fmaxf(a[i], b[15 - i]);
        bitonic_merge16_desc(a);
      }
      if (sub == 0) {
        const size_t ob = ((size_t)(tm * 128 + row) * 16 + hp) * 16;
#pragma unroll
        for (int i = 0; i < 16; i += 4) {
          *(f32x4*)(p.sv + ob + i) = (f32x4){a[i], a[i + 1], a[i + 2], a[i + 3]};
          typedef int i32x4 __attribute__((ext_vector_type(4)));
          *(i32x4*)(p.si + ob + i) = (i32x4){(int)(__float_as_uint(a[i]) & 127u), (int)(__float_as_uint(a[i + 1]) & 127u), (int)(__float_as_uint(a[i + 2]) & 127u), (int)(__float_as_uint(a[i + 3]) & 127u)};
        }
      }
    }
  }
}
__device__ __forceinline__ void top16_merge(float (&x)[16], const float (&y)[16]) {
#pragma unroll
  for (int i = 0; i < 16; ++i) x[i] = fmaxf(x[i], y[15 - i]);
  bitonic_merge16_desc(x);
}
__device__ __forceinline__ void ph_peer_s2(const P& p, int vb, int nvb, unsigned char* smem) {
  unsigned char* lut = smem;
  __syncthreads();
  if (TIDX == 0) {
    int n = 0;
#pragma unroll
    for (int i = 0; i < 16; ++i)
#pragma unroll
      for (int j = 0; j < 16; ++j)
        if ((i + 1) * (j + 1) <= 16) { lut[n] = (unsigned char)((i << 4) | j); ++n; }
  }
  __syncthreads();
  for (int it = vb * 256 + TIDX; it < NTOK * 8; it += nvb * 256) {
    const size_t ob = (size_t)it * 32;
    float a[16], bq[16];
#pragma unroll
    for (int i = 0; i < 16; i += 4) {
      const f32x4 fa = *(const f32x4*)(p.sv + ob + i), fb = *(const f32x4*)(p.sv + ob + 16 + i);
#pragma unroll
      for (int e = 0; e < 4; ++e) { a[i + e] = fa[e]; bq[i + e] = fb[e]; }
    }
    float g0[16], g1[16], g2[16], g3[16];
    {
      int n = 0;
#pragma unroll
      for (int i = 0; i < 16; ++i)
#pragma unroll
        for (int j = 0; j < 16; ++j)
          if ((i + 1) * (j + 1) <= 16) {
            const float v = __uint_as_float((__float_as_uint(a[i] + bq[j]) & ~63u) | (unsigned)n);
            if (n < 16) g0[n] = v; else if (n < 32) g1[n - 16] = v; else if (n < 48) g2[n - 32] = v; else g3[n - 48] = v;
            ++n;
          }
#pragma unroll
      for (int k = 2; k < 16; ++k) g3[k] = -3.0e38f;
    }
    bitonic_sort_desc<16>(g0); bitonic_sort_desc<16>(g1); bitonic_sort_desc<16>(g2); bitonic_sort_desc<16>(g3);
    top16_merge(g0, g1); top16_merge(g2, g3); top16_merge(g0, g2);
    float den = 0.f; float ex[16]; int seli[16];
#pragma unroll
    for (int k = 0; k < 16; ++k) {
      ex[k] = __expf(g0[k] - g0[0]); den += ex[k];
      const int ij = lut[__float_as_uint(g0[k]) & 63u];
      const int ka = (int)(__float_as_uint(p.sv[ob + (ij >> 4)]) & 127u), kb = (int)(__float_as_uint(p.sv[ob + 16 + (ij & 15)]) & 127u);
      seli[k] = ka * 128 + kb;
    }
    const float inv = 1.0f / den;
    const size_t o2 = (size_t)it * 16;
    typedef int i32x4 __attribute__((ext_vector_type(4)));
#pragma unroll
    for (int k = 0; k < 16; k += 4) {
      *(i32x4*)(p.pidx + o2 + k) = (i32x4){seli[k], seli[k + 1], seli[k + 2], seli[k + 3]};
      *(f32x4*)(p.pgate + o2 + k) = (f32x4){ex[k] * inv, ex[k + 1] * inv, ex[k + 2] * inv, ex[k + 3] * inv};
    }
  }
}
typedef float f32x16 __attribute__((ext_vector_type(16)));
typedef float f32x32 __attribute__((ext_vector_type(32)));
typedef unsigned u32x6 __attribute__((ext_vector_type(6)));
__device__ __forceinline__ float gelu_as(float v) {
  const float t = __builtin_amdgcn_rcpf(fabsf(v) * 0.2316418882f + 1.0f);
  float qq = t * 0.5307027145f + (-0.7265760135f); qq = qq * t + 0.7107068705f; qq = qq * t + (-0.142248368f); qq = qq * t + 0.127414796f; qq = qq * t;
  const float m = v * (qq * __builtin_amdgcn_exp2f((v * v) * (-0.72134752044f)));
  return v < 0.f ? m : v - m;
}
__device__ __forceinline__ float half_max(float v) {
#pragma unroll
  for (int o = 16; o > 0; o >>= 1) v = fmaxf(v, __shfl_xor(v, o));
  return v;
}
__device__ __forceinline__ float half_sum(float v) {
#pragma unroll
  for (int o = 16; o > 0; o >>= 1) v += __shfl_xor(v, o);
  return v;
}
__device__ __forceinline__ void ph_cvt_fp6(const float* __restrict__ in, unsigned char* __restrict__ out, float* __restrict__ inv_scale, int vb, int nvb) {
  const int lane = TIDX & 63, wid = TIDX >> 6, hf = lane >> 5, sl = lane & 31;
  for (int rp = vb * 4 + wid; rp < 8192; rp += nvb * 4) {
    const int row = rp * 2 + hf;
    f32x16 a, b2; float am = 0.f;
#pragma unroll
    for (int i = 0; i < 4; ++i) {
      const f32x4 v0 = *(const f32x4*)(in + (size_t)row * DM + sl * 32 + 4 * i), v1 = *(const f32x4*)(in + (size_t)row * DM + sl * 32 + 16 + 4 * i);
#pragma unroll
      for (int e = 0; e < 4; ++e) { a[4 * i + e] = v0[e]; b2[4 * i + e] = v1[e]; am = fmaxf(am, fmaxf(fabsf(v0[e]), fabsf(v1[e]))); }
    }
    am = half_max(am);
    const float sc = am > 0.f ? 7.0f / am : 1.0f;
    const u32x6 pk = __builtin_amdgcn_cvt_scalef32_2xpk16_fp6_f32(a * sc, b2 * sc, 1.0f);
    unsigned char* o = out + (size_t)row * 768 + sl * 24;
    *(u32x2*)(o) = (u32x2){pk[0], pk[1]}; *(u32x2*)(o + 8) = (u32x2){pk[2], pk[3]}; *(u32x2*)(o + 16) = (u32x2){pk[4], pk[5]};
    if (sl == 0) inv_scale[row] = am > 0.f ? am / 7.0f : 1.0f;
  }
}
__device__ __forceinline__ void ph_cvt_fp4(const float* __restrict__ in, unsigned char* __restrict__ out, float* __restrict__ inv_scale, int vb, int nvb) {
  const int lane = TIDX & 63, wid = TIDX >> 6, hf = lane >> 5, sl = lane & 31;
  const f32x2 probe = __builtin_amdgcn_cvt_scalef32_pk_f32_fp4(__builtin_amdgcn_cvt_scalef32_pk_fp4_f32(0u, 1.0f, 2.0f, 1.0f, 0), 1.0f, 0);
  const bool sw = probe.x != 1.0f;
  for (int rp = vb * 4 + wid; rp < 8192; rp += nvb * 4) {
    const int row = rp * 2 + hf;
    f32x4 v[8]; float am = 0.f;
#pragma unroll
    for (int i = 0; i < 8; ++i) {
      v[i] = *(const f32x4*)(in + (size_t)row * DM + sl * 32 + 4 * i);
#pragma unroll
      for (int e = 0; e < 4; ++e) am = fmaxf(am, fabsf(v[i][e]));
    }
    am = half_max(am);
    const float sc = am > 0.f ? 6.0f / am : 1.0f;
    u32x4 pk = (u32x4){0u, 0u, 0u, 0u};
#pragma unroll
    for (int w = 0; w < 4; ++w) {
      unsigned word = 0u;
      float c[8];
#pragma unroll
      for (int e = 0; e < 4; ++e) { c[e] = v[2 * w][e] * sc; c[4 + e] = v[2 * w + 1][e] * sc; }
      word = __builtin_amdgcn_cvt_scalef32_pk_fp4_f32(word, sw ? c[1] : c[0], sw ? c[0] : c[1], 1.0f, 0);
      word = __builtin_amdgcn_cvt_scalef32_pk_fp4_f32(word, sw ? c[3] : c[2], sw ? c[2] : c[3], 1.0f, 1);
      word = __builtin_amdgcn_cvt_scalef32_pk_fp4_f32(word, sw ? c[5] : c[4], sw ? c[4] : c[5], 1.0f, 2);
      word = __builtin_amdgcn_cvt_scalef32_pk_fp4_f32(word, sw ? c[7] : c[6], sw ? c[6] : c[7], 1.0f, 3);
      pk[w] = word;
    }
    *(u32x4*)(out + (size_t)row * 512 + sl * 16) = pk;
    if (sl == 0) inv_scale[row] = am > 0.f ? am / 6.0f : 1.0f;
  }
}
__device__ __forceinline__ u32x6 load_row6(const unsigned char* base, int id, int sl) {
  const unsigned char* q = base + (size_t)id * 768 + sl * 24;
  const u32x2 a = *(const u32x2*)q, b = *(const u32x2*)(q + 8), c = *(const u32x2*)(q + 16);
  return (u32x6){a.x, a.y, b.x, b.y, c.x, c.y};
}
#define GATHER_SMEM (4 * 64 * 33 * 4)
__device__ __forceinline__ void ph_peer_gather(const P& p, int vb, int nvb, unsigned char* smem) {
  int tid_ = TIDX;
  asm volatile("" : "+v"(tid_));
  const int lane = tid_ & 63, wid = tid_ >> 6, hf = lane >> 5, sl = lane & 31;
  float* scr = (float*)smem + (wid * 64 + lane) * 33;
  int* tauL = (int*)(smem + GATHER_SMEM) + wid * 32;
  {
    f32x16 a, b2;
#pragma unroll
    for (int i = 0; i < 16; ++i) { a[i] = __uint_as_float((unsigned)i << 20) * 0x1p126f; b2[i] = __uint_as_float((unsigned)(16 + i) << 20) * 0x1p126f; }
    const f32x32 o = __builtin_amdgcn_cvt_scalef32_pk32_f32_fp6(__builtin_amdgcn_cvt_scalef32_2xpk16_fp6_f32(a, b2, 1.0f), 1.0f);
    if (lane == 0) {
#pragma unroll
      for (int j = 0; j < 32; ++j) tauL[j] = (int)((__float_as_uint(o[j] * 0x1p-126f) >> 20) & 31u);
    }
  }
  const int jmap = 2 * (lane & 1) + ((lane >> 1) & 1);
  __syncthreads();
  int id0, id1; float su0, su1, gs0, gs1; u32x4 xr[4];
  {
    const int m0 = min(vb * 4 + wid, NTOK - 1);
    id0 = p.pidx[(size_t)m0 * 128 + lane]; id1 = p.pidx[(size_t)m0 * 128 + 64 + lane];
#pragma unroll
    for (int c4 = 0; c4 < 4; ++c4) xr[c4] = *(const u32x4*)(p.hx2 + (size_t)m0 * DM + sl * 32 + 8 * c4);
    su0 = p.us[id0]; su1 = p.us[id1];
    gs0 = p.pgate[(size_t)m0 * 128 + lane] * p.vs[id0]; gs1 = p.pgate[(size_t)m0 * 128 + 64 + lane] * p.vs[id1];
  }
  for (int m = vb * 4 + wid; m < NTOK; m += nvb * 4) {
    const float* md = p.mod + (m / SEQ) * 6144;
    f32x2 xp2[16];
#pragma unroll
    for (int c4 = 0; c4 < 4; ++c4)
#pragma unroll
      for (int e = 0; e < 4; ++e) xp2[4 * c4 + e] = (f32x2){bflo(xr[c4][e]), bfhi(xr[c4][e])};
    const int mn = min(m + nvb * 4, NTOK - 1);
    const int nid0 = p.pidx[(size_t)mn * 128 + lane], nid1 = p.pidx[(size_t)mn * 128 + 64 + lane];
    const float ng0 = p.pgate[(size_t)mn * 128 + lane], ng1 = p.pgate[(size_t)mn * 128 + 64 + lane];
#pragma unroll
    for (int c4 = 0; c4 < 4; ++c4) xr[c4] = *(const u32x4*)(p.hx2 + (size_t)mn * DM + sl * 32 + 8 * c4);
    float nsu0 = 0.f, nsu1 = 0.f, nvs0 = 0.f, nvs1 = 0.f;
    f32x2 acc2[16];
#pragma unroll
    for (int k = 0; k < 16; ++k) acc2[k] = (f32x2){0.f, 0.f};
#pragma unroll 1
    for (int e0 = 0; e0 < 128; e0 += 8) {
      if (e0 == 64) { nsu0 = p.us[nid0]; nsu1 = p.us[nid1]; nvs0 = p.vs[nid0]; nvs1 = p.vs[nid1]; }
      u32x4 ur[4], vr[4];
#pragma unroll
      for (int j = 0; j < 4; ++j) {
        const int id = __shfl(e0 < 64 ? id0 : id1, (e0 + hf * 4 + j) & 63);
        ur[j] = *(const u32x4*)(p.ub8 + (size_t)id * 512 + sl * 16);
        vr[j] = *(const u32x4*)(p.vb8 + (size_t)id * 512 + sl * 16);
      }
      float d[4];
#pragma unroll
      for (int j = 0; j < 4; ++j) {
        f32x2 s0 = (f32x2){0.f, 0.f}, s1 = (f32x2){0.f, 0.f};
#pragma unroll
        for (int w = 0; w < 4; ++w) {
          s0 += __builtin_amdgcn_cvt_scalef32_pk_f32_fp4(ur[j][w], 1.0f, 0) * xp2[4 * w + 0];
          s1 += __builtin_amdgcn_cvt_scalef32_pk_f32_fp4(ur[j][w], 1.0f, 1) * xp2[4 * w + 1];
          s0 += __builtin_amdgcn_cvt_scalef32_pk_f32_fp4(ur[j][w], 1.0f, 2) * xp2[4 * w + 2];
          s1 += __builtin_amdgcn_cvt_scalef32_pk_f32_fp4(ur[j][w], 1.0f, 3) * xp2[4 * w + 3];
        }
        d[j] = (s0.x + s0.y) + (s1.x + s1.y);
      }
      float r2[2], r1;
      {
        const bool lo = (lane & 1) == 0;
#pragma unroll
        for (int i = 0; i < 2; ++i) { const float keep = lo ? d[i] : d[i + 2], send = lo ? d[i + 2] : d[i]; r2[i] = keep + __shfl_xor(send, 1); }
        const bool lo2 = (lane & 2) == 0;
        { const float keep = lo2 ? r2[0] : r2[1], send = lo2 ? r2[1] : r2[0]; r1 = keep + __shfl_xor(send, 2); }
        r1 += __shfl_xor(r1, 4); r1 += __shfl_xor(r1, 8); r1 += __shfl_xor(r1, 16);
      }
      const int esrc = (e0 + hf * 4 + jmap) & 63;
      const float su = __shfl(e0 < 64 ? su0 : su1, esrc), gs = __shfl(e0 < 64 ? gs0 : gs1, esrc);
      const float sdot = r1 * su;
      const float cf = gelu_as(sdot) * gs;
#pragma unroll
      for (int j = 0; j < 4; ++j) {
        const float cj = __shfl(cf, (lane & 32) | ((j >> 1) | ((j & 1) << 1)));
        const f32x2 cj2 = (f32x2){cj, cj};
#pragma unroll
        for (int w = 0; w < 4; ++w) {
          acc2[4 * w + 0] += cj2 * __builtin_amdgcn_cvt_scalef32_pk_f32_fp4(vr[j][w], 1.0f, 0);
          acc2[4 * w + 1] += cj2 * __builtin_amdgcn_cvt_scalef32_pk_f32_fp4(vr[j][w], 1.0f, 1);
          acc2[4 * w + 2] += cj2 * __builtin_amdgcn_cvt_scalef32_pk_f32_fp4(vr[j][w], 1.0f, 2);
          acc2[4 * w + 3] += cj2 * __builtin_amdgcn_cvt_scalef32_pk_f32_fp4(vr[j][w], 1.0f, 3);
        }
      }
    }
#pragma unroll
    for (int k = 0; k < 16; ++k) { scr[2 * k] = acc2[k].x + __shfl_xor(acc2[k].x, 32); scr[2 * k + 1] = acc2[k].y + __shfl_xor(acc2[k].y, 32); }
    lds_wave_fence();
    float ss = 0.f;
#pragma unroll
    for (int k = 0; k < 32; ++k) { const float v = scr[k]; ss += v * v; }
    ss = half_sum(ss);
    const float rstd = rsqrtf(ss * (1.0f / 1024.0f) + 1e-6f);
#pragma unroll
    for (int k4 = 0; k4 < 4; ++k4) {
      const int kk = hf * 16 + k4 * 4, col = sl * 32 + kk;
      const u32x2 xb = *(const u32x2*)(p.x1b + (size_t)m * DM + col);
      f32x4 x1 = (f32x4){bflo(xb.x), bfhi(xb.x), bflo(xb.y), bfhi(xb.y)};
      const f32x4 g = *(const f32x4*)(p.g_post_ffn + col), gt = *(const f32x4*)(md + 5120 + col);
#pragma unroll
      for (int e = 0; e < 4; ++e) x1[e] += gt[e] * scr[kk + e] * rstd * g[e];
      *(f32x4*)(p.out + (size_t)m * DM + col) = x1;
    }
    lds_wave_fence();
    id0 = nid0; id1 = nid1; su0 = nsu0; su1 = nsu1; gs0 = ng0 * nvs0; gs1 = ng1 * nvs1;
  }
}

#define XB_TMO      128
#define XB_XCNT(j)  (256  + 64 * (j))
#define XB_XSUB(j)  (1280 + 64 * (j))
#define XB_XGEN(j)  (2304 + 64 * (j))
#define XB_TOP      3328
#define XB_TOPGEN   3392
#define XCD_BAR_WORDS 3456
#define XB_SPIN_CAP (1u << 20)
#define LAS __attribute__((address_space(3)))
__device__ __forceinline__ unsigned xb_ld(unsigned* p)              { return __hip_atomic_load(p, __ATOMIC_RELAXED, __HIP_MEMORY_SCOPE_AGENT); }
__device__ __forceinline__ unsigned xb_add(unsigned* p, unsigned v) { return __hip_atomic_fetch_add(p, v, __ATOMIC_RELAXED, __HIP_MEMORY_SCOPE_AGENT); }
__device__ __forceinline__ unsigned xb_xcc_id() { return (unsigned)__builtin_amdgcn_s_getreg((3 << 11) | 20) & 0xFu; }
#define XB_SPIN(cond, bar) do { unsigned _sp = 0; while (cond) { __builtin_amdgcn_s_sleep(1); \
    if ((++_sp & 255u) == 0u) { if (xb_ld(&(bar)[XB_TMO])) break; if (_sp > XB_SPIN_CAP) { atomicAdd(&(bar)[XB_TMO], 1u); break; } } } } while (0)
struct XcdBarrier { unsigned* bar; unsigned x; volatile LAS unsigned* st; };
__device__ __forceinline__ XcdBarrier xcd_barrier_post(unsigned* bar, volatile LAS unsigned* st) {
  XcdBarrier b; b.bar = bar; b.x = xb_xcc_id(); b.st = st;
  if (TIDX == 0) (void)xb_add(&bar[XB_XCNT(b.x)], 1u);
  return b;
}
__device__ __forceinline__ void xcd_barrier_complete(unsigned* bar, unsigned x, unsigned& nloc, unsigned& nx) {
  const unsigned G = gridDim.x * gridDim.y * gridDim.z;
  unsigned sum, cnt, mine, sp = 0u;
  for (;;) {
    sum = 0u; cnt = 0u; mine = 0u;
#pragma unroll
    for (unsigned j = 0; j < 16; ++j) { const unsigned c = xb_ld(&bar[XB_XCNT(j)]); sum += c; cnt += (c > 0u) ? 1u : 0u; mine = (j == x) ? c : mine; }
    if (sum == G) break;
    __builtin_amdgcn_s_sleep(1);
    if ((++sp & 255u) == 0u) { if (xb_ld(&bar[XB_TMO])) break; if (sp > XB_SPIN_CAP) { atomicAdd(&bar[XB_TMO], 1u); break; } }
  }
  nloc = mine > 0u ? mine : 1u; nx = cnt > 0u ? cnt : 1u;
}
__device__ __forceinline__ void xcd_barrier(const XcdBarrier& b) {
  asm volatile("s_waitcnt vmcnt(0)" ::: "memory");
  __syncthreads();
  if (TIDX == 0) {
    unsigned* bar = b.bar;
    __builtin_amdgcn_s_waitcnt(0);
    unsigned nloc = b.st[0], nx = b.st[1];
    if (nloc == 0u) { xcd_barrier_complete(bar, b.x, nloc, nx); b.st[0] = nloc; b.st[1] = nx; }
    const unsigned old = xb_add(&bar[XB_XSUB(b.x)], 1u);
    const unsigned gen = old / nloc;
    if (old + 1u == (gen + 1u) * nloc) {
      __builtin_amdgcn_fence(__ATOMIC_RELEASE, "agent");
      asm volatile("s_waitcnt vmcnt(0)" ::: "memory");
      const unsigned og = xb_add(&bar[XB_TOP], 1u);
      const unsigned tg = og / nx;
      if (og + 1u == (tg + 1u) * nx) xb_add(&bar[XB_TOPGEN], 1u);
      else XB_SPIN(xb_ld(&bar[XB_TOPGEN]) == tg, bar);
      __builtin_amdgcn_fence(__ATOMIC_ACQUIRE, "agent");
      xb_add(&bar[XB_XGEN(b.x)], 1u);
      asm volatile("s_waitcnt vmcnt(0)" ::: "memory");
    } else {
      XB_SPIN(xb_ld(&bar[XB_XGEN(b.x)]) == gen, bar);
      __builtin_amdgcn_fence(__ATOMIC_ACQUIRE, "agent");
      asm volatile("s_waitcnt vmcnt(0)" ::: "memory");
    }
  }
  __syncthreads();
}

#define SMEM_BYTES RWKV_SMEM
__global__ void __launch_bounds__(256, 2) mega(P p) {
  __shared__ __attribute__((aligned(16))) unsigned char smem[SMEM_BYTES + 16];
  cg::grid_group grid = cg::this_grid();
  const int vb = blockIdx.x, nvb = gridDim.x;
  if (TIDX == 0) *(u32x4*)(smem + SMEM_BYTES) = (u32x4){0u, 0u, 0u, 0u};
  __syncthreads();
  const XcdBarrier xb = xcd_barrier_post(p.bar, (volatile LAS unsigned*)(smem + SMEM_BYTES));
  ph_mod(p, vb, nvb, smem);
  ph_colmax(p.w_in, p.colmax, DM, INC, vb, nvb, smem);
  ph_transpose(p.w2, p.w2T, 64, 1024, vb, nvb, smem);
  ph_transpose(p.w2 + 65536, p.w2T + 65536, 64, 1024, vb, nvb, smem);
  ph_transpose(p.a2, p.a2T, 64, 1024, vb, nvb, smem);
  ph_transpose(p.a2 + 65536, p.a2T + 65536, 64, 1024, vb, nvb, smem);
  if (p.bar == nullptr) grid.sync();
  xcd_barrier(xb);
  ph_norm1(p, vb, nvb);
  ph_transpose_i8(p.w_in, p.Wt8, p.colmax, p.wsb, DM, INC, vb, nvb, smem);
  xcd_barrier(xb);
  ph_gemm1(p, vb, nvb, smem);
  xcd_barrier(xb);
  ph_rwkv_A(p, vb, nvb, smem);
  xcd_barrier(xb);
  ph_rwkv_B(p, vb, nvb, smem);
  if (nvb > 128 && vb >= 64) {
    const int v2 = vb - 64, n2 = nvb - 64;
    ph_transpose(p.w_a_out, p.Wt_aout, DM, DM, v2, n2, smem);
    ph_transpose(p.w_o, p.Wt_o, DM, DM, v2, n2, smem);
    ph_transpose(p.peer_wq, p.Wt_q, DM, 2048, v2, n2, smem);
    ph_transpose(p.g2, p.g2T, 128, 1024, v2, n2, smem);
    ph_weff(p, v2, n2);
    ph_convert(p.peer_keys, p.keys, (size_t)16 * 128 * 128, v2, n2);
  } else if (nvb <= 128) {
    ph_transpose(p.w_a_out, p.Wt_aout, DM, DM, vb, nvb, smem);
    ph_transpose(p.w_o, p.Wt_o, DM, DM, vb, nvb, smem);
    ph_transpose(p.peer_wq, p.Wt_q, DM, 2048, vb, nvb, smem);
    ph_transpose(p.g2, p.g2T, 128, 1024, vb, nvb, smem);
    ph_weff(p, vb, nvb);
    ph_convert(p.peer_keys, p.keys, (size_t)16 * 128 * 128, vb, nvb);
  }
  xcd_barrier(xb);
  ph_ycorr(p, vb, nvb, smem);
  ph_pool(p, vb, nvb, smem);
  ph_cvt_fp4(p.peer_u, p.ub8, p.us, vb, nvb);
  xcd_barrier(xb);
  ph_gemm_merge(p, vb, nvb, smem);
  ph_cvt_fp4(p.peer_v, p.vb8, p.vs, vb, nvb);
  xcd_barrier(xb);
  ph_gemm_simple(p.mrg, DM, p.Wt_o, DM, DM, NTOK, DM, p.mix, DM, vb, nvb, smem);
  xcd_barrier(xb);
  ph_res1(p, vb, nvb);
  xcd_barrier(xb);
  ph_gemm_simple(p.hx2, DM, p.Wt_q, DM, DM, NTOK, 2048, p.q, 2048, vb, nvb, smem);
  xcd_barrier(xb);
  ph_peer_s1(p, vb, nvb, smem);
  xcd_barrier(xb);
  ph_peer_s2(p, vb, nvb, smem);
  xcd_barrier(xb);
  ph_peer_gather(p, vb, nvb, smem);
}

extern "C" void kernel_launch(void* const* d_in, const int* in_sizes, int n_in, void* d_out, int out_size, void* d_ws, size_t ws_size, hipStream_t stream) {
  P p{};
  const float** f = (const float**)&p;
  for (int i = 0; i < 32; ++i) f[i] = (const float*)d_in[i];
  p.out = (float*)d_out;
  p.bar = (unsigned*)((unsigned char*)d_ws + 511 * 1048576);
  unsigned char* w = (unsigned char*)d_ws;
  const size_t MiB = 1048576;
  const size_t HM = 524288;
  p.hx = (bf16_t*)(w + 4096);
  p.hx8 = (signed char*)(w + 4096);
  p.hsa = (float*)(w + 40 * MiB) + 4;
  p.colmax = p.bar + XCD_BAR_WORDS;
  p.zA = (bf16_t*)(w + 65 * MiB + 8192);
  p.zP = (bf16_t*)(w + 569 * HM);
  p.zG = (bf16_t*)d_out;
  unsigned char* rw = w + 633 * HM;
  p.Wt_in = (bf16_t*)rw; p.Wt8 = (signed char*)rw; rw += 11 * MiB; p.wsb = (float*)rw; rw += 1 * MiB;
  p.Wt_aout = (bf16_t*)rw; rw += 2 * MiB;
  p.Wt_eff = (bf16_t*)rw; rw += 1 * MiB;
  p.Wt_o = (bf16_t*)rw; rw += 2 * MiB;
  p.Wt_q = (bf16_t*)rw; rw += 4 * MiB;
  p.keys = (bf16_t*)rw; rw += HM;
  p.mod = (float*)rw; rw += HM;
  p.g2T = (bf16_t*)rw; rw += HM;
  p.w2T = (bf16_t*)rw; rw += HM;
  p.a2T = (bf16_t*)rw; rw += HM;
  p.Y0 = (bf16_t*)(w + 0 * MiB);
  p.Y1 = (bf16_t*)(w + 340 * MiB);
  p.bdot = (float*)(w + 404 * MiB);
  p.Mst = (bf16_t*)(w + 408 * MiB);
  p.sg = (bf16_t*)(w + 408 * MiB);
  p.Nst = (float*)(w + 441 * MiB);
  p.ub8 = w + 633 * HM;
  p.vb8 = w + 441 * MiB;
  p.us = (float*)(w + 633 * HM + 8 * MiB);
  p.vs = (float*)(w + 449 * MiB);
  p.pooled = (bf16_t*)(w + 408 * MiB);
  p.out_a = (bf16_t*)(w + 0 * MiB);
  p.ya = (bf16_t*)(w + 65 * MiB);
  p.yb = (bf16_t*)(w + 129 * MiB);
  p.mrg = (bf16_t*)(w + 193 * MiB);
  p.mix = (bf16_t*)(w + 65 * MiB);
  p.hx2 = (bf16_t*)(w + 0 * MiB);
  p.x1b = (bf16_t*)(w + 65 * MiB);
  p.q = (bf16_t*)(w + 129 * MiB);
  p.sv = (float*)(w + 340 * MiB);
  p.si = (int*)(w + 372 * MiB);
  p.pidx = (int*)(w + 257 * MiB);
  p.pgate = (float*)(w + 273 * MiB);
  static int grid_blocks = 0;
  if (!grid_blocks) {
    int dev = 0, cus = 0, per_cu = 0;
    hipGetDevice(&dev);
    hipDeviceGetAttribute(&cus, hipDeviceAttributeMultiprocessorCount, dev);
    hipOccupancyMaxActiveBlocksPerMultiprocessor(&per_cu, mega, 256, 0);
    if (per_cu > 2) per_cu = 2;
    if (per_cu < 1) per_cu = 1;
    grid_blocks = cus * per_cu;
  }
  hipMemsetAsync(p.bar, 0, (XCD_BAR_WORDS + 6016) * 4, stream);
  void* args[] = {&p};
  hipError_t e = hipLaunchCooperativeKernel((void*)mega, dim3(grid_blocks), dim3(256), args, 0, stream);
  if (e != hipSuccess) fprintf(stderr, "cooperative launch failed: %s (grid %d)\n", hipGetErrorString(e), grid_blocks);
}
```

```cpp
#include <hip/hip_runtime.h>
#include <hip/hip_cooperative_groups.h>
#include <stdint.h>
#include <cstdio>
namespace cg = cooperative_groups;

typedef unsigned short bf16_t;
typedef short bf16x8 __attribute__((ext_vector_type(8)));
typedef float f32x4 __attribute__((ext_vector_type(4)));
typedef unsigned u32x4 __attribute__((ext_vector_type(4)));
typedef unsigned u32x2 __attribute__((ext_vector_type(2)));
typedef float f32x2 __attribute__((ext_vector_type(2)));

__device__ __forceinline__ int tid_opaque() { int t = threadIdx.x; asm volatile("" : "+v"(t)); return t; }
#define TIDX tid_opaque()
#define NTOK 32768
#define SEQ 16384
#define CTXL 256
#define NCTX 512
#define MROWS 33280
#define DM 1024
#define SHIFTC 3456
#define INC 6016

typedef __bf16 hwbf2 __attribute__((ext_vector_type(2)));
typedef float hwf2 __attribute__((ext_vector_type(2)));
__device__ __forceinline__ unsigned pack2(float a, float b) { return __builtin_bit_cast(unsigned, __builtin_convertvector((hwf2){a, b}, hwbf2)); }
__device__ __forceinline__ bf16_t f2bf(float f) { return __builtin_bit_cast(unsigned short, (__bf16)f); }
__device__ __forceinline__ float bf2f(bf16_t h) { return __uint_as_float(((unsigned)h) << 16); }
__device__ __forceinline__ float bflo(unsigned u) { return __uint_as_float(u << 16); }
__device__ __forceinline__ float bfhi(unsigned u) { return __uint_as_float(u & 0xffff0000u); }
__device__ __forceinline__ float sigmoidf_(float x) { return __builtin_amdgcn_rcpf(1.0f + __expf(-x)); }
__device__ __forceinline__ float fast_tanh(float x) { const float e = __builtin_amdgcn_exp2f(2.885390082f * x); return 1.0f - 2.0f * __builtin_amdgcn_rcpf(e + 1.0f); }

__device__ __forceinline__ void load8(const bf16_t* __restrict__ zA, int row, int col0, float* o) {
  const u32x4 zc = *(const u32x4*)(zA + (size_t)row * SHIFTC + col0);
#pragma unroll
  for (int i = 0; i < 4; ++i) { o[2 * i] = bflo(zc[i]); o[2 * i + 1] = bfhi(zc[i]); }
}
__device__ __forceinline__ float red16(float v) {
  v += __shfl_xor(v, 1); v += __shfl_xor(v, 2); v += __shfl_xor(v, 4); v += __shfl_xor(v, 8);
  return v;
}
__device__ __forceinline__ float red8(float v) {
  v += __shfl_xor(v, 1); v += __shfl_xor(v, 2); v += __shfl_xor(v, 4);
  return v;
}

struct P {
  const float *x, *c, *ctx, *c_ctx, *w_mod, *b_mod, *g_pre_mix, *g_post_mix, *g_pre_ffn, *g_post_ffn, *w_in, *b_gate, *mu_shift,
      *w0, *w2, *a0, *a2, *g2, *k_k, *k_a, *r_k, *ln_x_w, *ln_x_b, *w_a_out, *w_pool, *pool_scale, *w_b_out, *w_o, *peer_wq,
      *peer_keys, *peer_u, *peer_v;
  float* out;
  unsigned* bar;
  unsigned* colmax;
  unsigned char* w;
  __device__ __forceinline__ bf16_t* hx() const { return (bf16_t*)(w + 4096ull); }
  __device__ __forceinline__ signed char* hx8() const { return (signed char*)(w + 4096ull); }
  __device__ __forceinline__ float* hsa() const { return (float*)(w + 41943056ull); }
  __device__ __forceinline__ signed char* Wt8() const { return (signed char*)(w + 331874304ull); }
  __device__ __forceinline__ float* wsb() const { return (float*)(w + 343408640ull); }
  __device__ __forceinline__ bf16_t* zA() const { return (bf16_t*)(w + 68165632ull); }
  __device__ __forceinline__ bf16_t* zP() const { return (bf16_t*)(w + 298319872ull); }
  __device__ __forceinline__ bf16_t* zG() const { return (bf16_t*)out; }
  __device__ __forceinline__ bf16_t* Wt_in() const { return (bf16_t*)(w + 331874304ull); }
  __device__ __forceinline__ bf16_t* Wt_aout() const { return (bf16_t*)(w + 344457216ull); }
  __device__ __forceinline__ bf16_t* Wt_eff() const { return (bf16_t*)(w + 346554368ull); }
  __device__ __forceinline__ bf16_t* Wt_o() const { return (bf16_t*)(w + 347602944ull); }
  __device__ __forceinline__ bf16_t* Wt_q() const { return (bf16_t*)(w + 349700096ull); }
  __device__ __forceinline__ bf16_t* keys() const { return (bf16_t*)(w + 353894400ull); }
  __device__ __forceinline__ float* mod() const { return (float*)(w + 354418688ull); }
  __device__ __forceinline__ unsigned char* ub8() const { return (unsigned char*)(w + 331874304ull); }
  __device__ __forceinline__ unsigned char* vb8() const { return (unsigned char*)(w + 462422016ull); }
  __device__ __forceinline__ float* us() const { return (float*)(w + 340262912ull); }
  __device__ __forceinline__ float* vs() const { return (float*)(w + 470810624ull); }
  __device__ __forceinline__ bf16_t* sg() const { return (bf16_t*)(w + 427819008ull); }
  __device__ __forceinline__ bf16_t* g2T() const { return (bf16_t*)(w + 354942976ull); }
  __device__ __forceinline__ bf16_t* w2T() const { return (bf16_t*)(w + 355467264ull); }
  __device__ __forceinline__ bf16_t* a2T() const { return (bf16_t*)(w + 355991552ull); }
  __device__ __forceinline__ bf16_t* Mst() const { return (bf16_t*)(w + 427819008ull); }
  __device__ __forceinline__ float* Nst() const { return (float*)(w + 462422016ull); }
  __device__ __forceinline__ bf16_t* Y0() const { return (bf16_t*)(w + 0ull); }
  __device__ __forceinline__ bf16_t* Y1() const { return (bf16_t*)(w + 356515840ull); }
  __device__ __forceinline__ float* bdot() const { return (float*)(w + 423624704ull); }
  __device__ __forceinline__ bf16_t* out_a() const { return (bf16_t*)(w + 0ull); }
  __device__ __forceinline__ bf16_t* ya() const { return (bf16_t*)(w + 68157440ull); }
  __device__ __forceinline__ bf16_t* pooled() const { return (bf16_t*)(w + 427819008ull); }
  __device__ __forceinline__ bf16_t* yb() const { return (bf16_t*)(w + 135266304ull); }
  __device__ __forceinline__ bf16_t* mrg() const { return (bf16_t*)(w + 202375168ull); }
  __device__ __forceinline__ bf16_t* mix() const { return (bf16_t*)(w + 68157440ull); }
  __device__ __forceinline__ bf16_t* hx2() const { return (bf16_t*)(w + 0ull); }
  __device__ __forceinline__ bf16_t* x1b() const { return (bf16_t*)(w + 68157440ull); }
  __device__ __forceinline__ bf16_t* q() const { return (bf16_t*)(w + 135266304ull); }
  __device__ __forceinline__ float* sv() const { return (float*)(w + 356515840ull); }
  __device__ __forceinline__ int* si() const { return (int*)(w + 390070272ull); }
  __device__ __forceinline__ int* pidx() const { return (int*)(w + 269484032ull); }
  __device__ __forceinline__ float* pgate() const { return (float*)(w + 286261248ull); }
};

#define GS 72
#define GEMM_SMEM (2 * 128 * GS * 2)
template <class Epi>
__device__ __forceinline__ void gemm_tile(const bf16_t* __restrict__ A, int lda, const bf16_t* __restrict__ Bt, int ldb, int K, int m0, int n0,
                                          const Epi& epi, unsigned char* smem) {
  const int tid = TIDX, lane = tid & 63, wid = tid >> 6, wr = wid >> 1, wc = wid & 1;
  bf16_t* sA = (bf16_t*)smem;
  bf16_t* sB = sA + 128 * GS;
  f32x4 acc[4][4];
#pragma unroll
  for (int i = 0; i < 4; ++i)
#pragma unroll
    for (int j = 0; j < 4; ++j) acc[i][j] = (f32x4){0.f, 0.f, 0.f, 0.f};
  const int lrow = tid >> 3, lcol = (tid & 7) * 8;
  const bf16_t* pa = A + (size_t)(m0 + lrow) * lda + lcol;
  const bf16_t* pb = Bt + (size_t)(n0 + lrow) * ldb + lcol;
  u32x4 ra[4], rb[4];
#pragma unroll
  for (int p = 0; p < 4; ++p) {
    ra[p] = *(const u32x4*)(pa + (size_t)(32 * p) * lda);
    rb[p] = *(const u32x4*)(pb + (size_t)(32 * p) * ldb);
  }
  for (int k0 = 0; k0 < K; k0 += 64) {
#pragma unroll
    for (int p = 0; p < 4; ++p) {
      *(u32x4*)(sA + (lrow + 32 * p) * GS + lcol) = ra[p];
      *(u32x4*)(sB + (lrow + 32 * p) * GS + lcol) = rb[p];
    }
    __syncthreads();
    if (k0 + 64 < K) {
#pragma unroll
      for (int p = 0; p < 4; ++p) {
        ra[p] = *(const u32x4*)(pa + (size_t)(32 * p) * lda + k0 + 64);
        rb[p] = *(const u32x4*)(pb + (size_t)(32 * p) * ldb + k0 + 64);
      }
    }
#pragma unroll
    for (int kk = 0; kk < 2; ++kk) {
      bf16x8 af[4], bfr[4];
#pragma unroll
      for (int i = 0; i < 4; ++i) af[i] = *(const bf16x8*)(sA + (wr * 64 + i * 16 + (lane & 15)) * GS + kk * 32 + (lane >> 4) * 8);
#pragma unroll
      for (int j = 0; j < 4; ++j) bfr[j] = *(const bf16x8*)(sB + (wc * 64 + j * 16 + (lane & 15)) * GS + kk * 32 + (lane >> 4) * 8);
#pragma unroll
      for (int i = 0; i < 4; ++i)
#pragma unroll
        for (int j = 0; j < 4; ++j) acc[i][j] = __builtin_amdgcn_mfma_f32_16x16x32_bf16(bfr[j], af[i], acc[i][j], 0, 0, 0);
    }
    __syncthreads();
  }
#pragma unroll
  for (int i = 0; i < 4; ++i)
#pragma unroll
    for (int j = 0; j < 4; ++j) epi(m0 + wr * 64 + i * 16 + (lane & 15), n0 + wc * 64 + j * 16 + (lane >> 4) * 4, acc[i][j]);
}

#define G3_STAGE 24576
#define G3_ES 136
#define GEMM3_SMEM (256 * G3_ES * 2)
typedef __attribute__((address_space(3))) unsigned lds_u32;
template <class Epi>
__device__ __forceinline__ void gemm_tile3(const bf16_t* __restrict__ A, int lda, const bf16_t* __restrict__ Bt, int ldb, int K, int m0, int n0,
                                           const Epi& epi, unsigned char* smem) {
  int tid = TIDX;
  asm volatile("" : "+v"(tid));
  const int lane = tid & 63, wid = __builtin_amdgcn_readfirstlane(tid >> 6), wr = wid >> 1, wc = wid & 1, l15 = lane & 15, q = lane >> 4;
  f32x4 acc[8][4];
#pragma unroll
  for (int i = 0; i < 8; ++i)
#pragma unroll
    for (int j = 0; j < 4; ++j) acc[i][j] = (f32x4){0.f, 0.f, 0.f, 0.f};
  const int gr = lane >> 2, gc = ((lane & 3) ^ (((gr >> 2) & 1) << 1)) * 8;
  const bf16_t* pa = A + (long)(m0 + wid * 64 + gr) * lda + gc;
  const bf16_t* pb = Bt + (size_t)(n0 + wid * 32 + gr) * ldb + gc;
  unsigned char* dA = smem + wid * 4096 + lane * 16;
  unsigned char* dB = smem + 16384 + wid * 2048 + lane * 16;
  const int sw = (q ^ (((l15 >> 2) & 1) << 1)) * 16;
  const unsigned char* fA = smem + (wr * 128 + l15) * 64 + sw;
  const unsigned char* fB = smem + 16384 + (wc * 64 + l15) * 64 + sw;
#define G3_ISSUE(ST, KT) { _Pragma("unroll") for (int ii = 0; ii < 4; ++ii) __builtin_amdgcn_global_load_lds((const unsigned*)(pa + (size_t)(16 * ii) * lda + (KT) * 32), (lds_u32*)(dA + (ST) * G3_STAGE + ii * 1024), 16, 0, 0); \
                           _Pragma("unroll") for (int ii = 0; ii < 2; ++ii) __builtin_amdgcn_global_load_lds((const unsigned*)(pb + (size_t)(16 * ii) * ldb + (KT) * 32), (lds_u32*)(dB + (ST) * G3_STAGE + ii * 1024), 16, 0, 0); }
  const int nk = K >> 5;
  __syncthreads();
  G3_ISSUE(0, 0);
  for (int kt = 0; kt < nk; ++kt) {
    const int cur = kt & 1;
    asm volatile("s_waitcnt vmcnt(0)" ::: "memory");
    __syncthreads();
    if (kt + 1 < nk) G3_ISSUE(cur ^ 1, kt + 1);
    const unsigned char* cA = fA + cur * G3_STAGE;
    const unsigned char* cB = fB + cur * G3_STAGE;
    bf16x8 bfr[4];
#pragma unroll
    for (int j = 0; j < 4; ++j) bfr[j] = *(const bf16x8*)(cB + j * 1024);
#pragma unroll
    for (int i = 0; i < 8; ++i) {
      const bf16x8 af = *(const bf16x8*)(cA + i * 1024);
#pragma unroll
      for (int j = 0; j < 4; ++j) acc[i][j] = __builtin_amdgcn_mfma_f32_16x16x32_bf16(bfr[j], af, acc[i][j], 0, 0, 0);
    }
  }
#undef G3_ISSUE
  bf16_t* sE = (bf16_t*)smem;
  __syncthreads();
#pragma unroll
  for (int i = 0; i < 8; ++i)
#pragma unroll
    for (int j = 0; j < 4; ++j) {
      u32x2 w; w.x = pack2(acc[i][j][0], acc[i][j][1]); w.y = pack2(acc[i][j][2], acc[i][j][3]);
      *(u32x2*)(sE + (wr * 128 + i * 16 + l15) * G3_ES + wc * 64 + j * 16 + q * 4) = w;
    }
  __syncthreads();
  epi.finish(sE, m0, n0, tid);
}
typedef int i32x4v __attribute__((ext_vector_type(4)));
template <class Epi>
__device__ __forceinline__ void gemm_tile3_i8(const signed char* __restrict__ A, int lda, const signed char* __restrict__ Bt, int ldb, int K, int m0, int n0,
                                              const float* __restrict__ sa, const float* __restrict__ sb, const Epi& epi, unsigned char* smem) {
  int tid = TIDX;
  asm volatile("" : "+v"(tid));
  const int lane = tid & 63, wid = __builtin_amdgcn_readfirstlane(tid >> 6), wr = wid >> 1, wc = wid & 1, l15 = lane & 15, q = lane >> 4;
  i32x4v acc[8][4];
#pragma unroll
  for (int i = 0; i < 8; ++i)
#pragma unroll
    for (int j = 0; j < 4; ++j) acc[i][j] = (i32x4v){0, 0, 0, 0};
  const int gr = lane >> 2, gc = ((lane & 3) ^ (((gr >> 2) & 1) << 1)) * 16;
  const signed char* pa = A + (long)(m0 + wid * 64 + gr) * lda + gc;
  const signed char* pb = Bt + (size_t)(n0 + wid * 32 + gr) * ldb + gc;
  unsigned char* dA = smem + wid * 4096 + lane * 16;
  unsigned char* dB = smem + 16384 + wid * 2048 + lane * 16;
  const int sw = (q ^ (((l15 >> 2) & 1) << 1)) * 16;
  const unsigned char* fA = smem + (wr * 128 + l15) * 64 + sw;
  const unsigned char* fB = smem + 16384 + (wc * 64 + l15) * 64 + sw;
#define G3_ISSUE(ST, KT) { _Pragma("unroll") for (int ii = 0; ii < 4; ++ii) __builtin_amdgcn_global_load_lds((const unsigned*)(pa + (size_t)(16 * ii) * lda + (KT) * 64), (lds_u32*)(dA + (ST) * G3_STAGE + ii * 1024), 16, 0, 0); \
                           _Pragma("unroll") for (int ii = 0; ii < 2; ++ii) __builtin_amdgcn_global_load_lds((const unsigned*)(pb + (size_t)(16 * ii) * ldb + (KT) * 64), (lds_u32*)(dB + (ST) * G3_STAGE + ii * 1024), 16, 0, 0); }
  const int nk = K >> 6;
  __syncthreads();
  G3_ISSUE(0, 0);
  for (int kt = 0; kt < nk; ++kt) {
    const int cur = kt & 1;
    asm volatile("s_waitcnt vmcnt(0)" ::: "memory");
    __syncthreads();
    if (kt + 1 < nk) G3_ISSUE(cur ^ 1, kt + 1);
    const unsigned char* cA = fA + cur * G3_STAGE;
    const unsigned char* cB = fB + cur * G3_STAGE;
    i32x4v bfr[4];
#pragma unroll
    for (int j = 0; j < 4; ++j) bfr[j] = *(const i32x4v*)(cB + j * 1024);
#pragma unroll
    for (int i = 0; i < 8; ++i) {
      const i32x4v af = *(const i32x4v*)(cA + i * 1024);
#pragma unroll
      for (int j = 0; j < 4; ++j) acc[i][j] = __builtin_amdgcn_mfma_i32_16x16x64_i8(bfr[j], af, acc[i][j], 0, 0, 0);
    }
  }
#undef G3_ISSUE
  bf16_t* sE = (bf16_t*)smem;
  f32x4 sb4[4];
#pragma unroll
  for (int j = 0; j < 4; ++j) sb4[j] = *(const f32x4*)(sb + n0 + wc * 64 + j * 16 + q * 4);
  __syncthreads();
#pragma unroll
  for (int i = 0; i < 8; ++i) {
    const float sr = sa[m0 + wr * 128 + i * 16 + l15];
#pragma unroll
    for (int j = 0; j < 4; ++j) {
      u32x2 w;
      w.x = pack2((float)acc[i][j][0] * (sr * sb4[j][0]), (float)acc[i][j][1] * (sr * sb4[j][1]));
      w.y = pack2((float)acc[i][j][2] * (sr * sb4[j][2]), (float)acc[i][j][3] * (sr * sb4[j][3]));
      *(u32x2*)(sE + (wr * 128 + i * 16 + l15) * G3_ES + wc * 64 + j * 16 + q * 4) = w;
    }
  }
  __syncthreads();
  epi.finish(sE, m0, n0, tid);
}
template <class D> struct Epi3RowChunks {
  __device__ __forceinline__ void finish(const bf16_t* sE, int m0, int n0, int tid) const {
#pragma unroll
    for (int pp = 0; pp < 16; ++pp) {
      const int id = tid + 256 * pp, row = id >> 4, cc = (id & 15) * 8;
      static_cast<const D*>(this)->store(m0 + row, n0 + cc, *(const u32x4*)(sE + row * G3_ES + cc));
    }
  }
};
struct Epi3StoreBf16 : Epi3RowChunks<Epi3StoreBf16> {
  bf16_t* C; int ldc;
  __device__ Epi3StoreBf16(bf16_t* c, int l) : C(c), ldc(l) {}
  __device__ __forceinline__ void store(int m, int n, const u32x4& v) const { *(u32x4*)(C + (size_t)m * ldc + n) = v; }
};
struct Epi3GateA : Epi3RowChunks<Epi3GateA> {
  const bf16_t* zG; const float* bg; bf16_t* mrg;
  __device__ Epi3GateA(const bf16_t* z, const float* b, bf16_t* m) : zG(z), bg(b), mrg(m) {}
  __device__ __forceinline__ void store(int m, int n, const u32x4& v) const {
    const u32x4 g = *(const u32x4*)(zG + (size_t)m * 2048 + n);
    const f32x4 b0 = *(const f32x4*)(bg + n), b1 = *(const f32x4*)(bg + n + 4);
    u32x4 o;
#pragma unroll
    for (int i = 0; i < 4; ++i) {
      const float bl = i < 2 ? b0[2 * i] : b1[2 * i - 4], bh = i < 2 ? b0[2 * i + 1] : b1[2 * i - 3];
      o[i] = pack2(sigmoidf_(bflo(g[i]) + bl) * bflo(v[i]), sigmoidf_(bfhi(g[i]) + bh) * bfhi(v[i]));
    }
    *(u32x4*)(mrg + (size_t)m * DM + n) = o;
  }
};
struct Epi3GateB : Epi3RowChunks<Epi3GateB> {
  const bf16_t* zG; const float* bg; bf16_t* mrg;
  __device__ Epi3GateB(const bf16_t* z, const float* b, bf16_t* m) : zG(z), bg(b), mrg(m) {}
  __device__ __forceinline__ void store(int m, int n, const u32x4& v) const {
    const u32x4 g = *(const u32x4*)(zG + (size_t)m * 2048 + 1024 + n);
    const u32x4 a = *(const u32x4*)(mrg + (size_t)m * DM + n);
    const f32x4 b0 = *(const f32x4*)(bg + 1024 + n), b1 = *(const f32x4*)(bg + 1024 + n + 4);
    u32x4 o;
#pragma unroll
    for (int i = 0; i < 4; ++i) {
      const float bl = i < 2 ? b0[2 * i] : b1[2 * i - 4], bh = i < 2 ? b0[2 * i + 1] : b1[2 * i - 3];
      o[i] = pack2(bflo(a[i]) + sigmoidf_(bflo(g[i]) + bl) * bflo(v[i]), bfhi(a[i]) + sigmoidf_(bfhi(g[i]) + bh) * bfhi(v[i]));
    }
    *(u32x4*)(mrg + (size_t)m * DM + n) = o;
  }
};
struct Epi3ZS {
  bf16_t* zA; const float* mu; int own_lo, own_hi, t0, T;
  __device__ __forceinline__ void finish(const bf16_t* sE, int m0, int n0, int tid) const {
#pragma unroll 4
    for (int pq = 0; pq < 16; ++pq) {
      const int id = tid + 256 * pq, row = id >> 4, cc = (id & 15) * 8, t = t0 + row;
      if (row < own_lo || row > own_hi) continue;
      const u32x4 zc = *(const u32x4*)(sE + row * G3_ES + cc);
      u32x4 zp = (u32x4){0u, 0u, 0u, 0u}, zn = (u32x4){0u, 0u, 0u, 0u};
      if (t > 0) zp = *(const u32x4*)(sE + (row - 1) * G3_ES + cc);
      if (t < T - 1) zn = *(const u32x4*)(sE + (row + 1) * G3_ES + cc);
      const f32x4 m0v = *(const f32x4*)(mu + n0 + cc), m1v = *(const f32x4*)(mu + n0 + cc + 4);
      const float mm[8] = {m0v[0], m0v[1], m0v[2], m0v[3], m1v[0], m1v[1], m1v[2], m1v[3]};
      u32x4 o;
#pragma unroll
      for (int i = 0; i < 4; ++i) {
        const float z0 = bflo(zc[i]), z1 = bfhi(zc[i]);
        float s0 = z0 + mm[2 * i] * (0.5f * (bflo(zp[i]) + bflo(zn[i])) - z0), s1 = z1 + mm[2 * i + 1] * (0.5f * (bfhi(zp[i]) + bfhi(zn[i])) - z1);
        if (n0 == 3072) { s0 = fast_tanh(s0); s1 = fast_tanh(s1); }
        if (n0 == 3328) { s0 = sigmoidf_(s0); s1 = sigmoidf_(s1); }
        o[i] = pack2(s0, s1);
      }
      *(u32x4*)(zA + (long)(m0 + row) * SHIFTC + n0 + cc) = o;
    }
  }
};
struct Epi3Z : Epi3RowChunks<Epi3Z> {
  bf16_t *zA, *zP, *zG;
  __device__ Epi3Z(bf16_t* a, bf16_t* b, bf16_t* c) : zA(a), zP(b), zG(c) {}
  __device__ __forceinline__ void store(int m, int n, const u32x4& v) const {
    if (n < SHIFTC) *(u32x4*)(zA + (size_t)m * SHIFTC + n) = v;
    else if (m < NTOK) {
      if (n < SHIFTC + 512) *(u32x4*)(zP + (size_t)m * 512 + (n - SHIFTC)) = v;
      else *(u32x4*)(zG + (size_t)m * 2048 + (n - SHIFTC - 512)) = v;
    }
  }
};

struct EpiLds {
  float* S;
  __device__ __forceinline__ void operator()(int m, int n, const f32x4& v) const {
    float* r = S + (m & 127) * 133 + n + (n >> 5);
    r[0] = v[0]; r[1] = v[1]; r[2] = v[2]; r[3] = v[3];
  }
};

__device__ __forceinline__ void ph_transpose(const float* __restrict__ in, bf16_t* __restrict__ out, int K, int N, int vb, int nvb, unsigned char* smem) {
  float* t = (float*)smem;
  const int tk = K / 64, tn = N / 64, tid = TIDX, tx = tid & 15, ty = tid >> 4;
  for (int it = vb; it < tk * tn; it += nvb) {
    const int k0 = (it / tn) * 64, n0 = (it % tn) * 64;
    __syncthreads();
#pragma unroll
    for (int r = 0; r < 4; ++r) {
      const f32x4 v = *(const f32x4*)(in + (size_t)(k0 + ty + 16 * r) * N + n0 + 4 * tx);
#pragma unroll
      for (int e = 0; e < 4; ++e) t[(ty + 16 * r) * 65 + 4 * tx + e] = v[e];
    }
    __syncthreads();
    const int n = tid >> 2, kq = (tid & 3) * 16;
    u32x4 w0, w1;
#pragma unroll
    for (int e = 0; e < 4; ++e) {
      w0[e] = pack2(t[(kq + 2 * e) * 65 + n], t[(kq + 2 * e + 1) * 65 + n]);
      w1[e] = pack2(t[(kq + 8 + 2 * e) * 65 + n], t[(kq + 8 + 2 * e + 1) * 65 + n]);
    }
    *(u32x4*)(out + (size_t)(n0 + n) * K + k0 + kq) = w0;
    *(u32x4*)(out + (size_t)(n0 + n) * K + k0 + kq + 8) = w1;
  }
}
__device__ __forceinline__ void ph_colmax(const float* __restrict__ in, unsigned* __restrict__ colmax, int K, int N, int vb, int nvb, unsigned char* smem) {
  float* red = (float*)smem;
  const int tk = K / 64, tn = N / 64, tid = TIDX, n = tid & 63, kq = tid >> 6;
  for (int it = vb; it < tk * tn; it += nvb) {
    const int k0 = (it / tn) * 64 + kq * 16, n0 = (it % tn) * 64;
    float mx = 0.f;
#pragma unroll
    for (int r = 0; r < 16; ++r) mx = fmaxf(mx, fabsf(in[(size_t)(k0 + r) * N + n0 + n]));
    __syncthreads();
    red[kq * 64 + n] = mx;
    __syncthreads();
    if (kq == 0) atomicMax(colmax + n0 + n, __float_as_uint(fmaxf(fmaxf(red[n], red[64 + n]), fmaxf(red[128 + n], red[192 + n]))));
  }
}
__device__ __forceinline__ void ph_transpose_i8(const float* __restrict__ in, signed char* __restrict__ out, const unsigned* __restrict__ colmax, float* __restrict__ sbv,
                                                int K, int N, int vb, int nvb, unsigned char* smem) {
  float* t = (float*)smem;
  const int tk = K / 64, tn = N / 64, tid = TIDX, tx = tid & 15, ty = tid >> 4;
  for (int it = vb; it < tk * tn; it += nvb) {
    const int k0 = (it / tn) * 64, n0 = (it % tn) * 64;
    __syncthreads();
#pragma unroll
    for (int r = 0; r < 4; ++r) {
      const f32x4 v = *(const f32x4*)(in + (size_t)(k0 + ty + 16 * r) * N + n0 + 4 * tx);
#pragma unroll
      for (int e = 0; e < 4; ++e) t[(ty + 16 * r) * 65 + 4 * tx + e] = v[e];
    }
    __syncthreads();
    const int n = tid >> 2, kq = (tid & 3) * 16;
    const float cmx = __uint_as_float(colmax[n0 + n]);
    const float sc = cmx > 0.f ? 127.0f / cmx : 0.f;
    if (k0 == 0 && kq == 0) sbv[n0 + n] = cmx > 0.f ? cmx / 127.0f : 1.0f;
    u32x4 w;
#pragma unroll
    for (int e = 0; e < 4; ++e) {
      unsigned pk = 0;
#pragma unroll
      for (int b = 0; b < 4; ++b) { const int qv = (int)rintf(t[(kq + 4 * e + b) * 65 + n] * sc); pk |= ((unsigned)qv & 255u) << (8 * b); }
      w[e] = pk;
    }
    *(u32x4*)(out + (size_t)(n0 + n) * K + k0 + kq) = w;
  }
}
__device__ __forceinline__ void ph_convert(const float* __restrict__ in, bf16_t* __restrict__ out, size_t n, int vb, int nvb) {
  for (size_t i = ((size_t)vb * 256 + TIDX) * 4; i < n; i += (size_t)nvb * 1024) {
    const float4 v = *(const float4*)(in + i);
    uint2 w; w.x = pack2(v.x, v.y); w.y = pack2(v.z, v.w);
    *(uint2*)(out + i) = w;
  }
}
__device__ __forceinline__ void ph_weff(const P& p, int vb, int nvb) {
  for (int it = vb * 256 + TIDX; it < 512 * 1024; it += nvb * 256) {
    const int n = it & 1023, k = it >> 10, j = k >> 7, kl = k & 127;
    const float* wp = p.w_pool + ((size_t)j * 128 + kl) * 128;
    float s = 0.f;
    for (int c = 0; c < 128; ++c) s += wp[c] * p.pool_scale[j * 128 + c] * p.w_b_out[(size_t)(j * 128 + c) * 1024 + n];
    p.Wt_eff()[(size_t)n * 512 + k] = f2bf(s);
  }
}
__device__ __forceinline__ void ph_mod(const P& p, int vb, int nvb, unsigned char* smem) {
  float* sl = (float*)smem;
  float* red = sl + 3072;
  const int tid = TIDX, col = tid & 31, kg = tid >> 5;
  if (vb < 192)
    for (int i = tid; i < 1024; i += 256) {
      const float c0 = p.c[i], c1 = p.c[1024 + i], c2 = p.c_ctx[i];
      sl[i] = c0 * sigmoidf_(c0); sl[1024 + i] = c1 * sigmoidf_(c1); sl[2048 + i] = c2 * sigmoidf_(c2);
    }
  for (int it = vb; it < 192; it += nvb) {
    const int n = it * 32 + col;
    __syncthreads();
    float a0 = 0.f, a1 = 0.f, a2 = 0.f;
#pragma unroll 32
    for (int i = 0; i < 128; ++i) {
      const int k = kg + 8 * i;
      const float w = p.w_mod[(size_t)k * 6144 + n];
      a0 += sl[k] * w; a1 += sl[1024 + k] * w; a2 += sl[2048 + k] * w;
    }
    red[(kg * 3 + 0) * 32 + col] = a0; red[(kg * 3 + 1) * 32 + col] = a1; red[(kg * 3 + 2) * 32 + col] = a2;
    __syncthreads();
    if (tid < 96) {
      const int r = tid >> 5;
      float sum = p.b_mod[n];
#pragma unroll
      for (int g = 0; g < 8; ++g) sum += red[(g * 3 + r) * 32 + col];
      p.mod()[r * 6144 + n] = sum;
    }
  }
}
__device__ __forceinline__ float wave_sum(float v) {
#pragma unroll
  for (int o = 32; o > 0; o >>= 1) v += __shfl_xor(v, o);
  return v;
}
__device__ __forceinline__ void ph_norm1(const P& p, int vb, int nvb) {
  const int lane = TIDX & 63, wid = TIDX >> 6, nw = nvb * 4;
  for (int m0 = vb * 4 + wid; m0 < MROWS; m0 += 2 * nw) {
    const int m1 = m0 + nw; const bool has1 = m1 < MROWS; const int mb = has1 ? m1 : m0;
    const float* srcA = m0 < NTOK ? p.x + (size_t)m0 * DM : p.ctx + (size_t)(m0 - NTOK) * DM;
    const float* srcB = mb < NTOK ? p.x + (size_t)mb * DM : p.ctx + (size_t)(mb - NTOK) * DM;
    f32x4 va[4], vbq[4]; float sa = 0.f, sb = 0.f;
#pragma unroll
    for (int i = 0; i < 4; ++i) { va[i] = *(const f32x4*)(srcA + i * 256 + lane * 4); vbq[i] = *(const f32x4*)(srcB + i * 256 + lane * 4); }
#pragma unroll
    for (int i = 0; i < 4; ++i)
#pragma unroll
      for (int e = 0; e < 4; ++e) { sa += va[i][e] * va[i][e]; sb += vbq[i][e] * vbq[i][e]; }
    sa = wave_sum(sa); sb = wave_sum(sb);
#pragma unroll
    for (int rr = 0; rr < 2; ++rr) {
      if (rr == 1 && !has1) break;
      const int m = rr == 0 ? m0 : m1;
      const float rstd = rsqrtf((rr == 0 ? sa : sb) * (1.0f / 1024.0f) + 1e-6f);
      const float* md = p.mod() + (m < NTOK ? (m / SEQ) : 2) * 6144;
      f32x4 y[4]; float am = 0.f;
#pragma unroll
      for (int i = 0; i < 4; ++i) {
        const int col = i * 256 + lane * 4;
        const f32x4 v = rr == 0 ? va[i] : vbq[i];
        const f32x4 g = *(const f32x4*)(p.g_pre_mix + col), sh = *(const f32x4*)(md + col), sc = *(const f32x4*)(md + 1024 + col);
#pragma unroll
        for (int e = 0; e < 4; ++e) { y[i][e] = v[e] * rstd * g[e] * (1.f + sc[e]) + sh[e]; am = fmaxf(am, fabsf(y[i][e])); }
      }
#pragma unroll
      for (int o = 32; o > 0; o >>= 1) am = fmaxf(am, __shfl_xor(am, o));
      const float qs = am > 0.f ? 127.0f / am : 0.f;
      if (lane == 0) p.hsa()[m] = am > 0.f ? am / 127.0f : 1.0f;
#pragma unroll
      for (int i = 0; i < 4; ++i) {
        unsigned pk = 0;
#pragma unroll
        for (int e = 0; e < 4; ++e) pk |= ((unsigned)(int)rintf(y[i][e] * qs) & 255u) << (8 * e);
        *(unsigned*)(p.hx8() + (size_t)m * DM + i * 256 + lane * 4) = pk;
      }
    }
  }
}
struct Epi3Readout {
  const P* pp;
  __device__ __forceinline__ void finish(const bf16_t* sE, int m0, int n0, int tid) const {
    const P& p = *pp;
#pragma unroll 2
    for (int pq = 0; pq < 16; ++pq) {
      const int id = tid + 256 * pq, row = id >> 4, cc = (id & 15) * 8, m = m0 + row, n = n0 + cc, t = m % SEQ, h = n >> 6;
      const u32x4 g = *(const u32x4*)(sE + row * G3_ES + cc);
      const u32x4 y0 = *(const u32x4*)(p.Y0() + (size_t)m * DM + n);
      float y[8], v[8];
#pragma unroll
      for (int i = 0; i < 4; ++i) { y[2 * i] = bflo(y0[i]); y[2 * i + 1] = bfhi(y0[i]); }
      float sm = 0.f;
#pragma unroll
      for (int i = 0; i < 8; ++i) sm += y[i];
      const float mu = red8(sm) * (1.f / 64.f);
      float qv = 0.f;
#pragma unroll
      for (int i = 0; i < 8; ++i) { y[i] -= mu; qv += y[i] * y[i]; }
      const float rs = rsqrtf(red8(qv) * (1.f / 64.f) + 64e-5f);
      load8(p.zA(), m, 2048 + n, v);
      const float bon = 0.5f * (p.bdot()[(size_t)m * 16 + h] + p.bdot()[((size_t)NTOK + m) * 16 + h]);
      const f32x4 w0 = *(const f32x4*)(p.ln_x_w + n), w1 = *(const f32x4*)(p.ln_x_w + n + 4), b0 = *(const f32x4*)(p.ln_x_b + n), b1 = *(const f32x4*)(p.ln_x_b + n + 4);
      const float lw[8] = {w0[0], w0[1], w0[2], w0[3], w1[0], w1[1], w1[2], w1[3]}, lb[8] = {b0[0], b0[1], b0[2], b0[3], b1[0], b1[1], b1[2], b1[3]};
      u32x4 o;
#pragma unroll
      for (int i = 0; i < 4; ++i)
        o[i] = pack2((y[2 * i] * rs * lw[2 * i] + lb[2 * i] + bon * v[2 * i]) * bflo(g[i]), (y[2 * i + 1] * rs * lw[2 * i + 1] + lb[2 * i + 1] + bon * v[2 * i + 1]) * bfhi(g[i]));
      *(u32x4*)(p.out_a() + (size_t)m * DM + n) = o;
    }
  }
};
__device__ __forceinline__ int xcd_tile(int vb, int nvb, int round, int TM, int TN, int& tm, int& tn) {
  if (nvb % 64 != 0) { const int it = round * nvb + vb; if (it >= TM * TN) return 0; tm = it % TM; tn = it / TM; return 1; }
  const int spg = nvb >> 3, g = vb & 7, slot = vb >> 3, SC = spg >> 3;
  const int nsr = (TM + 7) >> 3, nsc = (TN + SC - 1) / SC, st = round * 8 + g;
  if (st >= nsr * nsc) return 0;
  tm = (st % nsr) * 8 + (slot & 7); tn = (st / nsr) * SC + (slot >> 3);
  return (tm < TM && tn < TN) ? 1 : 2;
}
__device__ __forceinline__ void ph_gemm1(const P& p, int vb, int nvb, unsigned char* smem) {
  const int NS_ = 132 * 27, NALL = NS_ + 128 * 20;
  const int per = nvb >> 3;
  for (int round = 0;; ++round) {
    int item;
    if ((nvb & 7) == 0) { const int blk = round * 8 + (vb & 7); if (blk * per >= NALL) break; item = blk * per + (vb >> 3); if (item >= NALL) continue; }
    else { item = round * nvb + vb; if (item >= NALL) break; }
    if (item < NS_) {
      const int cgp = item / (132 * 9), rem = item % (132 * 9), tmS = rem / 9, tn = cgp * 9 + rem % 9;
      Epi3ZS epi;
      epi.zA = p.zA(); epi.mu = p.mu_shift;
      int m0;
      if (tmS < 130) { const int b = tmS / 65, i = tmS % 65; m0 = b * SEQ + 254 * i - 1; epi.own_lo = 1; epi.own_hi = min(254, SEQ - 254 * i); epi.t0 = 254 * i - 1; epi.T = SEQ; }
      else { m0 = NTOK + (tmS - 130) * CTXL; epi.own_lo = 0; epi.own_hi = 255; epi.t0 = 0; epi.T = CTXL; }
      gemm_tile3_i8(p.hx8(), DM, p.Wt8(), DM, DM, m0, tn * 128, p.hsa(), p.wsb(), epi, smem);
    } else {
      const int i2 = item - NS_;
      int tm, tn;
      if (i2 < 2048) { tm = (i2 & 1023) >> 3; tn = 27 + (i2 >> 10) * 8 + (i2 & 7); } else { tm = (i2 - 2048) >> 2; tn = 43 + (i2 & 3); }
      Epi3Z epi{p.zA(), p.zP(), p.zG()};
      gemm_tile3_i8(p.hx8(), DM, p.Wt8(), DM, DM, tm * 256, tn * 128, p.hsa(), p.wsb(), epi, smem);
    }
  }
}
__device__ __forceinline__ void ph_readout_gemm(const P& p, int vb, int nvb, unsigned char* smem) {
  Epi3Readout epi{&p};
  for (int round = 0;; ++round) {
    int tm, tn; const int r = xcd_tile(vb, nvb, round, NTOK / 256, DM / 128, tm, tn);
    if (r == 0) break;
    if (r == 1) gemm_tile3(p.zA() + 3328, SHIFTC, p.g2T(), 128, 128, tm * 256, tn * 128, epi, smem);
  }
}
__device__ __forceinline__ void ph_sg(const P& p, int vb, int nvb) {
  for (int it = vb * 256 + TIDX; it < NTOK * 16; it += nvb * 256) {
    const int m = it >> 4, l8 = (it & 15) * 8, t = m % SEQ;
    float o[8];
    load8(p.zA(), m, 3328 + l8, o);
    u32x4 w;
#pragma unroll
    for (int i = 0; i < 4; ++i) w[i] = pack2(sigmoidf_(o[2 * i]), sigmoidf_(o[2 * i + 1]));
    *(u32x4*)(p.sg() + (size_t)m * 128 + l8) = w;
  }
}
__device__ __forceinline__ void ph_gemm_merge(const P& p, int vb, int nvb, unsigned char* smem) {
  Epi3GateA ea{p.zG(), p.b_gate, p.mrg()};
  Epi3GateB eb{p.zG(), p.b_gate, p.mrg()};
  for (int round = 0;; ++round) {
    int tm, tn; const int r = xcd_tile(vb, nvb, round, NTOK / 256, DM / 128, tm, tn);
    if (r == 0) break;
    if (r == 1) {
      gemm_tile3(p.out_a(), DM, p.Wt_aout(), DM, DM, tm * 256, tn * 128, ea, smem);
      gemm_tile3(p.pooled(), 512, p.Wt_eff(), 512, 512, tm * 256, tn * 128, eb, smem);
    }
  }
}
__device__ __forceinline__ void ph_gemm_simple(const bf16_t* A, int lda, const bf16_t* Bt, int ldb, int K, int M, int N, bf16_t* C, int ldc, int vb, int nvb, unsigned char* smem) {
  Epi3StoreBf16 epi{C, ldc};
  for (int round = 0;; ++round) {
    int tm, tn; const int r = xcd_tile(vb, nvb, round, M / 256, N / 128, tm, tn);
    if (r == 0) break;
    if (r == 1) gemm_tile3(A, lda, Bt, ldb, K, tm * 256, tn * 128, epi, smem);
  }
}


#define O_R1 0
#define O_R2 10240
#define O_TA (O_R2 + 17408)
#define O_TR (O_TA + 4608)
#define O_TB (O_TR + 4608)
#define O_TK (O_TB + 4608)
#define O_TBT (O_TK + 4608)
#define O_TKT (O_TBT + 5120)
#define O_TVT (O_TKT + 5120)
#define O_GAM (O_TVT + 5120)
#define O_TST (O_GAM + 256)
#define RWKV_SMEM (O_TST + 2 * 9216)
#define NSUP 65
__device__ __forceinline__ void lds_wave_fence() { asm volatile("s_waitcnt lgkmcnt(0)" ::: "memory"); }
__device__ __forceinline__ u32x2 pack4(const f32x4& v) { u32x2 r; r.x = pack2(v[0], v[1]); r.y = pack2(v[2], v[3]); return r; }


typedef short s16x4 __attribute__((ext_vector_type(4)));
template <int NS, bool WANTY>
__device__ __forceinline__ void rwkv_chunk(const P& p, unsigned char* smem, int d, int h, int rowbase, int T, int isc0, bool has_next, f32x4 (&st)[NS][4], u32x4 (&pf)[5]) {
  int tid = TIDX;
  asm volatile("" : "+v"(tid));
  const int lane = tid & 63, w = __builtin_amdgcn_readfirstlane(tid >> 6), l15 = lane & 15, q = lane >> 4;
  const int tt = tid >> 3, cg = tid & 7, ch0 = h * 64 + cg * 8;
  const int isc = isc0 + tt, t = d == 0 ? isc : T - 1 - isc;
  bf16_t* TWD = (bf16_t*)(smem + O_R1); bf16_t* TAD = TWD + 32 * 72;
  float* WT = (float*)(smem + O_R1);
  bf16_t* XT = (bf16_t*)(smem + O_R1); bf16_t* UT = XT + 64 * 40;
  float* LW = (float*)(smem + O_R2); float* LA = LW + 32 * 68;
  float* TL = (float*)(smem + O_R2);
  bf16_t* TT = (bf16_t*)(smem + O_R2 + 4608); bf16_t* TAK = TT + 32 * 40; bf16_t* TRB = TAK + 32 * 40; bf16_t* TRK = TRB + 32 * 40; bf16_t* TLB = TRK + 32 * 40;
  bf16_t* TA = (bf16_t*)(smem + O_TA); bf16_t* TR = (bf16_t*)(smem + O_TR); bf16_t* TB = (bf16_t*)(smem + O_TB); bf16_t* TK = (bf16_t*)(smem + O_TK);
  bf16_t* TBT = (bf16_t*)(smem + O_TBT); bf16_t* TKT = (bf16_t*)(smem + O_TKT); bf16_t* TVT = (bf16_t*)(smem + O_TVT);
  float* GAM = (float*)(smem + O_GAM);
  bf16_t* TST = (bf16_t*)(smem + O_TST);
  __syncthreads();
  float k8[8], r8[8];
  *(u32x4*)(TWD + tt * 72 + cg * 8) = pf[0];
  *(u32x4*)(TAD + tt * 72 + cg * 8) = pf[1];
#pragma unroll
  for (int i = 0; i < 4; ++i) { k8[2 * i] = bflo(pf[2][i]); k8[2 * i + 1] = bfhi(pf[2][i]); if (WANTY) { r8[2 * i] = bflo(pf[3][i]); r8[2 * i + 1] = bfhi(pf[3][i]); } }
  const u32x4 vzc = pf[4];
  float ca0[8], ckk[8], cka[8], crk[8];
#pragma unroll
  for (int e4 = 0; e4 < 8; e4 += 4) {
    const f32x4 b2 = *(const f32x4*)(p.a0 + d * 1024 + ch0 + e4), c2 = *(const f32x4*)(p.k_k + ch0 + e4);
    const f32x4 d2 = *(const f32x4*)(p.k_a + ch0 + e4), f2 = *(const f32x4*)(p.r_k + ch0 + e4);
#pragma unroll
    for (int e = 0; e < 4; ++e) { ca0[e4 + e] = b2[e]; ckk[e4 + e] = c2[e]; cka[e4 + e] = d2[e]; crk[e4 + e] = f2[e]; }
  }
  __syncthreads();
  {
    f32x4 lw[2], la[2];
    bf16x8 w2f[2], a2f[2];
#pragma unroll
    for (int ks = 0; ks < 2; ++ks) {
      w2f[ks] = *(const bf16x8*)(p.w2T() + ((size_t)d * 1024 + h * 64 + 16 * w + l15) * 64 + 32 * ks + 8 * q);
      a2f[ks] = *(const bf16x8*)(p.a2T() + ((size_t)d * 1024 + h * 64 + 16 * w + l15) * 64 + 32 * ks + 8 * q);
    }
#pragma unroll
    for (int it = 0; it < 2; ++it) { lw[it] = (f32x4){0.f, 0.f, 0.f, 0.f}; la[it] = (f32x4){0.f, 0.f, 0.f, 0.f}; }
#pragma unroll
    for (int ks = 0; ks < 2; ++ks)
#pragma unroll
      for (int it = 0; it < 2; ++it) {
        const bf16x8 aw = *(const bf16x8*)(TWD + (16 * it + l15) * 72 + 32 * ks + 8 * q);
        const bf16x8 aa = *(const bf16x8*)(TAD + (16 * it + l15) * 72 + 32 * ks + 8 * q);
        lw[it] = __builtin_amdgcn_mfma_f32_16x16x32_bf16(aw, w2f[ks], lw[it], 0, 0, 0);
        la[it] = __builtin_amdgcn_mfma_f32_16x16x32_bf16(a2f[ks], aa, la[it], 0, 0, 0);
      }
    {
      const float cw0 = p.w0[d * 1024 + h * 64 + 16 * w + l15];
      float tot0 = 0.f;
#pragma unroll
      for (int it = 0; it < 2; ++it) {
        float pr[4];
#pragma unroll
        for (int rg = 0; rg < 4; ++rg) {
          const float e = 0.87505707f * sigmoidf_(cw0 + lw[it][rg]);
          pr[rg] = rg == 0 ? e : pr[rg - 1] + e;
        }
        float x = pr[3];
        float y = __shfl_up(x, 16); if (q >= 1) x += y;
        y = __shfl_up(x, 32); if (q >= 2) x += y;
        const float base = (x - pr[3]) + (it == 1 ? tot0 : 0.f);
        if (it == 0) tot0 = __shfl(x, 48 + l15);
#pragma unroll
        for (int rg = 0; rg < 4; ++rg) lw[it][rg] = pr[rg] + base;
      }
      if (q == 3) GAM[16 * w + l15] = __builtin_amdgcn_exp2f(-lw[1][3]);
    }
#pragma unroll
    for (int it = 0; it < 2; ++it)
#pragma unroll
      for (int rg = 0; rg < 4; ++rg) LW[(16 * it + 4 * q + rg) * 68 + 16 * w + l15] = lw[it][rg];
#pragma unroll
    for (int it = 0; it < 2; ++it) *(f32x4*)(LA + (16 * it + l15) * 68 + 16 * w + 4 * q) = la[it];
  }
  __syncthreads();
  float icl[8], kkn[8], kd[8];
  {
    float ss = 0.f, bd = 0.f;
    float lav[8];
    { const f32x4 l0 = *(const f32x4*)(LA + tt * 68 + cg * 8), l1 = *(const f32x4*)(LA + tt * 68 + cg * 8 + 4);
#pragma unroll
      for (int e = 0; e < 4; ++e) { lav[e] = l0[e]; lav[4 + e] = l1[e]; } }
#pragma unroll
    for (int e = 0; e < 8; ++e) {
      icl[e] = sigmoidf_(ca0[e] + lav[e]);
      kkn[e] = k8[e] * ckk[e]; ss += kkn[e] * kkn[e];
      kd[e] = k8[e] * (1.f + (icl[e] - 1.f) * cka[e]);
      if (WANTY) bd += r8[e] * kd[e] * crk[e];
    }
    ss = red8(ss); if (WANTY) bd = red8(bd);
    const float rn = rsqrtf(fmaxf(ss, 1e-24f));
#pragma unroll
    for (int e = 0; e < 8; ++e) kkn[e] *= rn;
    if (WANTY && cg == 0) p.bdot()[((size_t)d * NTOK + rowbase + t) * 16 + h] = bd;
  }
  {
    float ta[8], tr[8], tb[8], tk[8];
    float Lv[8], Lpv[8];
    {
      const f32x4 a0 = *(const f32x4*)(LW + tt * 68 + cg * 8), a1 = *(const f32x4*)(LW + tt * 68 + cg * 8 + 4);
      const int tp = tt > 0 ? tt - 1 : 0;
      const f32x4 b0 = *(const f32x4*)(LW + tp * 68 + cg * 8), b1 = *(const f32x4*)(LW + tp * 68 + cg * 8 + 4);
#pragma unroll
      for (int e = 0; e < 4; ++e) { Lv[e] = a0[e]; Lv[4 + e] = a1[e]; Lpv[e] = tt > 0 ? b0[e] : 0.f; Lpv[4 + e] = tt > 0 ? b1[e] : 0.f; }
    }
#pragma unroll
    for (int e = 0; e < 8; ++e) {
      const float Li = Lv[e];
      const float Lp = Lpv[e];
      const float gi = __builtin_amdgcn_exp2f(-Li), gim1 = __builtin_amdgcn_exp2f(-Lp), ginv = __builtin_amdgcn_exp2f(Li);
      ta[e] = -kkn[e] * gim1; if (WANTY) tr[e] = r8[e] * gi; tb[e] = kkn[e] * icl[e] * ginv; tk[e] = kd[e] * ginv;
    }
    u32x4 pk;
    pk.x = pack2(ta[0], ta[1]); pk.y = pack2(ta[2], ta[3]); pk.z = pack2(ta[4], ta[5]); pk.w = pack2(ta[6], ta[7]); *(u32x4*)(TA + tt * 72 + cg * 8) = pk;
    if (WANTY) { pk.x = pack2(tr[0], tr[1]); pk.y = pack2(tr[2], tr[3]); pk.z = pack2(tr[4], tr[5]); pk.w = pack2(tr[6], tr[7]); *(u32x4*)(TR + tt * 72 + cg * 8) = pk; }
    u32x4 pkb, pkk;
    pkb.x = pack2(tb[0], tb[1]); pkb.y = pack2(tb[2], tb[3]); pkb.z = pack2(tb[4], tb[5]); pkb.w = pack2(tb[6], tb[7]); *(u32x4*)(TB + tt * 72 + cg * 8) = pkb;
    pkk.x = pack2(tk[0], tk[1]); pkk.y = pack2(tk[2], tk[3]); pkk.z = pack2(tk[4], tk[5]); pkk.w = pack2(tk[6], tk[7]); *(u32x4*)(TK + tt * 72 + cg * 8) = pkk;
    { const int tts = tt ^ ((cg >> 1) << 3);
#pragma unroll
    for (int e = 0; e < 8; ++e) {
      TBT[(cg * 8 + e) * 40 + tts] = (bf16_t)(pkb[e >> 1] >> (16 * (e & 1)));
      TKT[(cg * 8 + e) * 40 + tts] = (bf16_t)(pkk[e >> 1] >> (16 * (e & 1)));
      TVT[(cg * 8 + e) * 40 + tts] = (bf16_t)(vzc[e >> 1] >> (16 * (e & 1)));
    } }
  }
  __syncthreads();
  if (WANTY || w < 2) {
    const bf16_t* X = (w < 2) ? TA : TR; const bf16_t* Y = (w & 1) ? TK : TB;
    f32x4 g[2][2];
#pragma unroll
    for (int it = 0; it < 2; ++it)
#pragma unroll
      for (int s2 = 0; s2 < 2; ++s2) g[it][s2] = (f32x4){0.f, 0.f, 0.f, 0.f};
#pragma unroll
    for (int ks = 0; ks < 2; ++ks) {
      bf16x8 xa[2], yb[2];
#pragma unroll
      for (int it = 0; it < 2; ++it) { xa[it] = *(const bf16x8*)(X + (16 * it + l15) * 72 + 32 * ks + 8 * q); yb[it] = *(const bf16x8*)(Y + (16 * it + l15) * 72 + 32 * ks + 8 * q); }
#pragma unroll
      for (int it = 0; it < 2; ++it)
#pragma unroll
        for (int s2 = 0; s2 < 2; ++s2) g[it][s2] = __builtin_amdgcn_mfma_f32_16x16x32_bf16(xa[it], yb[s2], g[it][s2], 0, 0, 0);
    }
    if (w == 0) {
#pragma unroll
      for (int it = 0; it < 2; ++it)
#pragma unroll
        for (int s2 = 0; s2 < 2; ++s2)
#pragma unroll
          for (int rg = 0; rg < 4; ++rg) {
            const int i = 16 * it + 4 * q + rg, s = 16 * s2 + l15;
            TL[i * 36 + s] = (s < i) ? g[it][s2][rg] : 0.f;
          }
#pragma unroll
      for (int rg = 0; rg < 4; ++rg) TLB[(4 * q + rg) * 40 + l15] = f2bf(g[1][0][rg]);
    } else {
      bf16_t* dst = w == 1 ? TAK : (w == 2 ? TRB : TRK);
      const int incl = w == 1 ? 0 : 1;
#pragma unroll
      for (int it = 0; it < 2; ++it)
#pragma unroll
        for (int s2 = 0; s2 < 2; ++s2)
#pragma unroll
          for (int rg = 0; rg < 4; ++rg) {
            const int i = 16 * it + 4 * q + rg, s = 16 * s2 + l15;
            dst[i * 40 + s] = f2bf((s < i + incl) ? g[it][s2][rg] : 0.f);
          }
    }
  }
  if (w == 0) {
    lds_wave_fence();
    const int c = lane & 15, hb = lane & 16;
    float Tr[16];
    f32x4 Lr[16][4];
#pragma unroll
    for (int i = 1; i < 16; ++i)
#pragma unroll
      for (int j4 = 0; j4 < (i + 3) / 4; ++j4) Lr[i][j4] = *(const f32x4*)(TL + (hb + i) * 36 + hb + 4 * j4);
#pragma unroll
    for (int i = 0; i < 16; ++i) {
      float acc = (i == c) ? 1.f : 0.f;
#pragma unroll
      for (int j = 0; j < i; ++j) acc += Lr[i][j >> 2][j & 3] * Tr[j];
      Tr[i] = acc;
    }
    if (lane < 32) {
#pragma unroll
      for (int i = 0; i < 16; ++i) TT[(hb + i) * 40 + hb + c] = f2bf(Tr[i]);
    }
  }
  __syncthreads();
  if (has_next) {
    const int isn = isc + 32, tn = d == 0 ? isn : T - 1 - isn;
    const bf16_t* zr = p.zA() + (size_t)(rowbase + tn) * SHIFTC;
    pf[0] = *(const u32x4*)(zr + 3072 + d * 64 + cg * 8);
    pf[1] = *(const u32x4*)(zr + 3200 + d * 64 + cg * 8);
    pf[2] = *(const u32x4*)(zr + 1024 + ch0);
    if (WANTY) pf[3] = *(const u32x4*)(zr + ch0);
    pf[4] = *(const u32x4*)(zr + 2048 + ch0);
  }
  u32x2 yprev[2];
  if (WANTY) {
#pragma unroll
    for (int it = 0; it < 2; ++it) {
      yprev[it] = (u32x2){0u, 0u};
      if (d == 1) yprev[it] = *(const u32x2*)(p.Y0() + (size_t)(rowbase + T - 1 - (isc0 + 16 * it + l15)) * DM + h * 64 + 16 * w + 4 * q);
    }
  }
  const bf16x8 vfr = *(const bf16x8*)(TVT + (16 * w + l15) * 40 + 8 * (q ^ w));
  const s16x4 t1f = *(const s16x4*)(TT + l15 * 40 + 4 * q), t2f = *(const s16x4*)(TT + (16 + l15) * 40 + 16 + 4 * q), l21f = *(const s16x4*)(TLB + l15 * 40 + 4 * q);
  bf16_t* XTw = XT + (16 * w + l15) * 40; bf16_t* UTw = UT + (16 * w + l15) * 40;
#pragma unroll
  for (int si = 0; si < NS; ++si) {
    const bool useV = (NS == 1) || (si == 1);
    const bf16_t* STs = TST + (si * 64 + 16 * w + l15) * 72;
    bf16x8 sf[2];
    sf[0] = *(const bf16x8*)(STs + 8 * q); sf[1] = *(const bf16x8*)(STs + 32 + 8 * q);
    f32x4 xa[2];
#pragma unroll
    for (int it = 0; it < 2; ++it) {
      xa[it] = (f32x4){0.f, 0.f, 0.f, 0.f};
#pragma unroll
      for (int ks = 0; ks < 2; ++ks) xa[it] = __builtin_amdgcn_mfma_f32_16x16x32_bf16(*(const bf16x8*)(TA + (16 * it + l15) * 72 + 32 * ks + 8 * q), sf[ks], xa[it], 0, 0, 0);
      if (useV) xa[it] = __builtin_amdgcn_mfma_f32_16x16x32_bf16(*(const bf16x8*)(TAK + (16 * it + l15) * 40 + 8 * q), vfr, xa[it], 0, 0, 0);
    }
    const f32x4 ut = __builtin_amdgcn_mfma_f32_16x16x16bf16_1k(t1f, __builtin_bit_cast(s16x4, pack4(xa[0])), (f32x4){0.f, 0.f, 0.f, 0.f}, 0, 0, 0);
    const u32x2 utp = pack4(ut);
    xa[1] = __builtin_amdgcn_mfma_f32_16x16x16bf16_1k(l21f, __builtin_bit_cast(s16x4, utp), xa[1], 0, 0, 0);
    const f32x4 ub = __builtin_amdgcn_mfma_f32_16x16x16bf16_1k(t2f, __builtin_bit_cast(s16x4, pack4(xa[1])), (f32x4){0.f, 0.f, 0.f, 0.f}, 0, 0, 0);
    *(u32x2*)(UTw + 4 * q) = utp;
    *(u32x2*)(UTw + 16 + 4 * q) = pack4(ub);
    lds_wave_fence();
    const bf16x8 uf = *(const bf16x8*)(UTw + 8 * q);
    if (WANTY) {
#pragma unroll
      for (int it = 0; it < 2; ++it) {
        f32x4 ya = (f32x4){0.f, 0.f, 0.f, 0.f};
#pragma unroll
        for (int ks = 0; ks < 2; ++ks) ya = __builtin_amdgcn_mfma_f32_16x16x32_bf16(sf[ks], *(const bf16x8*)(TR + (16 * it + l15) * 72 + 32 * ks + 8 * q), ya, 0, 0, 0);
        ya = __builtin_amdgcn_mfma_f32_16x16x32_bf16(uf, *(const bf16x8*)(TRB + (16 * it + l15) * 40 + 8 * q), ya, 0, 0, 0);
        if (useV) ya = __builtin_amdgcn_mfma_f32_16x16x32_bf16(vfr, *(const bf16x8*)(TRK + (16 * it + l15) * 40 + 8 * q), ya, 0, 0, 0);
        const int iq = isc0 + 16 * it + l15, tq = d == 0 ? iq : T - 1 - iq;
        if (useV) {
          ya += (f32x4){bflo(yprev[it].x), bfhi(yprev[it].x), bflo(yprev[it].y), bfhi(yprev[it].y)};
          *(u32x2*)(p.Y0() + (size_t)(rowbase + tq) * DM + h * 64 + 16 * w + 4 * q) = pack4(ya);
        } else {
          bf16_t* pp = d == 0 ? p.Y1() + (size_t)(rowbase + tq) * DM : p.zA() + (size_t)(rowbase + tq) * SHIFTC;
          *(u32x2*)(pp + h * 64 + 16 * w + 4 * q) = pack4(ya);
        }
      }
    }
#pragma unroll
    for (int kt = 0; kt < 4; ++kt) {
      f32x4 hv = st[si][kt];
      hv = __builtin_amdgcn_mfma_f32_16x16x32_bf16(*(const bf16x8*)(TBT + (16 * kt + l15) * 40 + 8 * (q ^ kt)), uf, hv, 0, 0, 0);
      if (useV) hv = __builtin_amdgcn_mfma_f32_16x16x32_bf16(*(const bf16x8*)(TKT + (16 * kt + l15) * 40 + 8 * (q ^ kt)), vfr, hv, 0, 0, 0);
      hv *= *(const f32x4*)(GAM + 16 * kt + 4 * q);
      st[si][kt] = hv;
      *(u32x2*)(TST + (si * 64 + 16 * w + l15) * 72 + 16 * kt + 4 * q) = pack4(hv);
    }
  }
}

template <bool WANTY>
__device__ __forceinline__ void rwkv_prefetch_first(const P& p, int d, int h, int rowbase, int T, int isc0, u32x4 (&pf)[5]) {
  const int tid = TIDX, tt = tid >> 3, cg = tid & 7, ch0 = h * 64 + cg * 8, isc = isc0 + tt, t = d == 0 ? isc : T - 1 - isc;
  const bf16_t* zr = p.zA() + (size_t)(rowbase + t) * SHIFTC;
  pf[0] = *(const u32x4*)(zr + 3072 + d * 64 + cg * 8);
  pf[1] = *(const u32x4*)(zr + 3200 + d * 64 + cg * 8);
  pf[2] = *(const u32x4*)(zr + 1024 + ch0);
  pf[3] = WANTY ? *(const u32x4*)(zr + ch0) : (u32x4){0u, 0u, 0u, 0u};
  pf[4] = *(const u32x4*)(zr + 2048 + ch0);
}
template <bool LAT>
__device__ __forceinline__ void rwkv_super(const P& p, unsigned char* smem, int chain, int j) {
  const int tid = TIDX, lane = tid & 63, w = tid >> 6, l15 = lane & 15, q = lane >> 4;
  bf16_t* TST = (bf16_t*)(smem + O_TST);
  const int b = chain >> 5, d = (chain >> 4) & 1, h = chain & 15;
  const int T = LAT ? SEQ : CTXL, rowbase = LAT ? b * SEQ : NTOK + b * CTXL, base = LAT ? (j - 1) * 256 : 0;
  f32x4 st[2][4];
  __syncthreads();
#pragma unroll
  for (int kt = 0; kt < 4; ++kt) {
#pragma unroll
    for (int rg = 0; rg < 4; ++rg) st[0][kt][rg] = (16 * kt + 4 * q + rg == 16 * w + l15) ? 1.f : 0.f;
    st[1][kt] = (f32x4){0.f, 0.f, 0.f, 0.f};
    *(u32x2*)(TST + (16 * w + l15) * 72 + 16 * kt + 4 * q) = pack4(st[0][kt]);
    *(u32x2*)(TST + (64 + 16 * w + l15) * 72 + 16 * kt + 4 * q) = pack4(st[1][kt]);
  }
  u32x4 pf[5]; rwkv_prefetch_first<LAT>(p, d, h, rowbase, T, base, pf);
  for (int c = 0; c < 8; ++c) rwkv_chunk<2, LAT>(p, smem, d, h, rowbase, T, base + 32 * c, c < 7, st, pf);
  if (j < 64) {
    const size_t slot = (size_t)chain * NSUP + j;
#pragma unroll
    for (int kt = 0; kt < 4; ++kt) {
#pragma unroll
      for (int rg = 0; rg < 4; ++rg) p.Mst()[(slot * 64 + 16 * kt + 4 * q + rg) * 64 + 16 * w + l15] = f2bf(st[0][kt][rg]);
      *(f32x4*)(p.Nst() + (slot * 64 + 16 * w + l15) * 64 + 16 * kt + 4 * q) = st[1][kt];
    }
  }
}
__device__ __forceinline__ void ph_rwkv_A(const P& p, int vb, int nvb, unsigned char* smem) {
  for (int chain = vb; chain < 64; chain += nvb) rwkv_super<false>(p, smem, chain, 0);
  for (int item = vb; item < 2048; item += nvb) {
    const int b = item >> 10, J = (item >> 4) & 63, h = item & 15;
#pragma unroll 1
    for (int d = 0; d < 2; ++d) {
      rwkv_super<true>(p, smem, b * 32 + d * 16 + h, d == 0 ? J + 1 : 64 - J);
      asm volatile("s_waitcnt vmcnt(0)" ::: "memory");
      __syncthreads();
    }
  }
}
__device__ __forceinline__ void ph_rwkv_B(const P& p, int vb, int nvb, unsigned char* smem) {
  const int tid = TIDX, lane = tid & 63, w = tid >> 6, l15 = lane & 15, q = lane >> 4;
  bf16_t* HT = (bf16_t*)smem;
  for (int chain = vb; chain < 64; chain += nvb) {
    f32x4 hs[4];
#pragma unroll
    for (int kt = 0; kt < 4; ++kt) hs[kt] = (f32x4){0.f, 0.f, 0.f, 0.f};
    __syncthreads();
    for (int j = 0; j < 64; ++j) {
      const size_t slot = (size_t)chain * NSUP + j;
      f32x4 nv[4];
#pragma unroll
      for (int kt = 0; kt < 4; ++kt) nv[kt] = *(const f32x4*)(p.Nst() + (slot * 64 + 16 * w + l15) * 64 + 16 * kt + 4 * q);
      bf16x8 mf[4][2];
#pragma unroll
      for (int kt = 0; kt < 4; ++kt)
#pragma unroll
        for (int ks = 0; ks < 2; ++ks) mf[kt][ks] = *(const bf16x8*)(p.Mst() + (slot * 64 + 16 * kt + l15) * 64 + 32 * ks + 8 * q);
#pragma unroll
      for (int kt = 0; kt < 4; ++kt) {
        *(f32x4*)(p.Nst() + (slot * 64 + 16 * w + l15) * 64 + 16 * kt + 4 * q) = hs[kt];
        *(u32x2*)(HT + (16 * w + l15) * 72 + 16 * kt + 4 * q) = pack4(hs[kt]);
      }
      lds_wave_fence();
      bf16x8 hf[2];
      hf[0] = *(const bf16x8*)(HT + (16 * w + l15) * 72 + 8 * q); hf[1] = *(const bf16x8*)(HT + (16 * w + l15) * 72 + 32 + 8 * q);
      lds_wave_fence();
#pragma unroll
      for (int kt = 0; kt < 4; ++kt) {
        f32x4 a = nv[kt];
#pragma unroll
        for (int ks = 0; ks < 2; ++ks) a = __builtin_amdgcn_mfma_f32_16x16x32_bf16(mf[kt][ks], hf[ks], a, 0, 0, 0);
        hs[kt] = a;
      }
    }
    const size_t slot = (size_t)chain * NSUP + 64;
#pragma unroll
    for (int kt = 0; kt < 4; ++kt) *(f32x4*)(p.Nst() + (slot * 64 + 16 * w + l15) * 64 + 16 * kt + 4 * q) = hs[kt];
  }
}
#define YC_LD 136
__device__ __forceinline__ void ph_ycorr(const P& p, int vb, int nvb, unsigned char* smem) {
  const int tid = TIDX, lane = tid & 63, w = tid >> 6, l15 = lane & 15, q = lane >> 4;
  bf16_t* HL = (bf16_t*)smem;
  bf16_t* GL = HL + 64 * YC_LD;
  for (int item = vb; item < 2048; item += nvb) {
    const int b = item >> 10, J = (item >> 4) & 63, h = item & 15;
    const size_t tok0 = (size_t)b * SEQ + J * 256 + 64 * w;
    __syncthreads();
    {
      const int v = tid >> 2, k0 = (tid & 3) * 32;
      const size_t slot = k0 < 64 ? (size_t)(b * 32 + h) * NSUP + (J + 1) : (size_t)(b * 32 + 16 + h) * NSUP + (64 - J);
      const float* src = p.Nst() + (slot * 64 + v) * 64 + (k0 & 63);
#pragma unroll
      for (int i = 0; i < 4; ++i) {
        const f32x4 a = *(const f32x4*)(src + 8 * i), c = *(const f32x4*)(src + 8 * i + 4);
        *(u32x4*)(HL + v * YC_LD + k0 + 8 * i) = (u32x4){pack2(a[0], a[1]), pack2(a[2], a[3]), pack2(c[0], c[1]), pack2(c[2], c[3])};
        *(u32x4*)(GL + v * YC_LD + k0 + 8 * i) = *(const u32x4*)(p.g2T() + (size_t)(h * 64 + v) * 128 + k0 + 8 * i);
      }
    }
    struct Ops { bf16x8 pa[4], sgf[4]; u32x2 yo[4], vv[4]; float bd0, bd1; };
    auto load_ops = [&](Ops& o, int mt) {
      const size_t tk = tok0 + 16 * mt + l15;
#pragma unroll
      for (int kk = 0; kk < 2; ++kk) { o.pa[kk] = *(const bf16x8*)(p.Y1() + tk * DM + h * 64 + 32 * kk + 8 * q); o.pa[2 + kk] = *(const bf16x8*)(p.zA() + tk * SHIFTC + h * 64 + 32 * kk + 8 * q); }
#pragma unroll
      for (int kk = 0; kk < 4; ++kk) o.sgf[kk] = *(const bf16x8*)(p.zA() + tk * SHIFTC + 3328 + 32 * kk + 8 * q);
#pragma unroll
      for (int nt = 0; nt < 4; ++nt) { o.yo[nt] = *(const u32x2*)(p.Y0() + tk * DM + h * 64 + 16 * nt + 4 * q); o.vv[nt] = *(const u32x2*)(p.zA() + tk * SHIFTC + 2048 + h * 64 + 16 * nt + 4 * q); }
      o.bd0 = p.bdot()[tk * 16 + h]; o.bd1 = p.bdot()[((size_t)NTOK + tk) * 16 + h];
    };
    auto step = [&](const Ops& o, int mt) {
      asm volatile("" ::: "memory");
      const size_t tok = tok0 + 16 * mt + l15;
      const float bon = 0.5f * (o.bd0 + o.bd1);
      f32x4 yv[4], gv[4];
      float sm = 0.f;
#pragma unroll
      for (int nt = 0; nt < 4; ++nt) {
        f32x4 acc = (f32x4){bflo(o.yo[nt].x), bfhi(o.yo[nt].x), bflo(o.yo[nt].y), bfhi(o.yo[nt].y)};
        f32x4 g = (f32x4){0.f, 0.f, 0.f, 0.f};
#pragma unroll
        for (int kk = 0; kk < 4; ++kk) {
          acc = __builtin_amdgcn_mfma_f32_16x16x32_bf16(*(const bf16x8*)(HL + (16 * nt + l15) * YC_LD + 32 * kk + 8 * q), o.pa[kk], acc, 0, 0, 0);
          g = __builtin_amdgcn_mfma_f32_16x16x32_bf16(*(const bf16x8*)(GL + (16 * nt + l15) * YC_LD + 32 * kk + 8 * q), o.sgf[kk], g, 0, 0, 0);
        }
        yv[nt] = acc; gv[nt] = g;
        sm += (acc[0] + acc[1]) + (acc[2] + acc[3]);
      }
      sm += __shfl_xor(sm, 16); sm += __shfl_xor(sm, 32);
      const float mu = sm * (1.f / 64.f);
      float qv = 0.f;
#pragma unroll
      for (int nt = 0; nt < 4; ++nt)
#pragma unroll
        for (int rg = 0; rg < 4; ++rg) { yv[nt][rg] -= mu; qv += yv[nt][rg] * yv[nt][rg]; }
      qv += __shfl_xor(qv, 16); qv += __shfl_xor(qv, 32);
      const float rs = rsqrtf(qv * (1.f / 64.f) + 64e-5f);
#pragma unroll
      for (int nt = 0; nt < 4; ++nt) {
        const f32x4 v4 = (f32x4){bflo(o.vv[nt].x), bfhi(o.vv[nt].x), bflo(o.vv[nt].y), bfhi(o.vv[nt].y)};
        const f32x4 lw = *(const f32x4*)(p.ln_x_w + h * 64 + 16 * nt + 4 * q), lb = *(const f32x4*)(p.ln_x_b + h * 64 + 16 * nt + 4 * q);
        f32x4 ov;
#pragma unroll
        for (int rg = 0; rg < 4; ++rg) ov[rg] = (yv[nt][rg] * rs * lw[rg] + lb[rg] + bon * v4[rg]) * gv[nt][rg];
        *(u32x2*)(p.out_a() + tok * DM + h * 64 + 16 * nt + 4 * q) = pack4(ov);
      }
    };
    Ops oa, ob;
    load_ops(oa, 0);
    __syncthreads();
    load_ops(ob, 1); step(oa, 0);
    load_ops(oa, 2); step(ob, 1);
    load_ops(ob, 3); step(oa, 2);
    step(ob, 3);
  }
  __syncthreads();
}

#define POOL_SMEM (64 * 128 * 4)
__device__ __forceinline__ void ph_pool(const P& p, int vb, int nvb, unsigned char* smem) {
  float* V = (float*)smem;
  const int tid = TIDX, cp = tid & 63, cq = tid >> 6;
  for (int item = vb; item < 2 * 4 * 64; item += nvb) {
    const int j = item & 3, st = (item >> 2) & 63, b = item >> 8;
    const int win = 2 << j, half = win >> 1;
    const bf16_t* zb = p.zP() + (size_t)b * SEQ * 512 + j * 128 + cp * 2;
    float a0[16], a1[16];
#pragma unroll
    for (int i = 0; i < 16; ++i) { a0[i] = 0.f; a1[i] = 0.f; }
    {
      const int r = 4 * st, r0 = max(r - half, 0), r1 = min(r + half, 256);
      for (int rr = r0; rr < r1; ++rr) {
#pragma unroll
        for (int i = 0; i < 16; ++i) { const unsigned u = *(const unsigned*)(zb + (size_t)(rr * 64 + cq * 16 + i) * 512); a0[i] += bflo(u); a1[i] += bfhi(u); }
      }
    }
    for (int dr = 0; dr < 4; ++dr) {
      const int r = 4 * st + dr, r0 = max(r - half, 0), r1 = min(r + half, 256);
      if (dr > 0) {
        const int radd = r + half - 1, rsub = r - half - 1;
        if (radd < 256) {
#pragma unroll
          for (int i = 0; i < 16; ++i) { const unsigned u = *(const unsigned*)(zb + (size_t)(radd * 64 + cq * 16 + i) * 512); a0[i] += bflo(u); a1[i] += bfhi(u); }
        }
        if (rsub >= 0) {
#pragma unroll
          for (int i = 0; i < 16; ++i) { const unsigned u = *(const unsigned*)(zb + (size_t)(rsub * 64 + cq * 16 + i) * 512); a0[i] -= bflo(u); a1[i] -= bfhi(u); }
        }
      }
      __syncthreads();
#pragma unroll
      for (int i = 0; i < 16; ++i) *(f32x2*)(V + (cq * 16 + i) * 128 + cp * 2) = (f32x2){a0[i], a1[i]};
      __syncthreads();
      float s0 = 0.f, s1 = 0.f;
      {
        const int c = cq * 16, c0 = max(c - half, 0), c1 = min(c + half, 64);
        for (int cc = c0; cc < c1; ++cc) { const f32x2 v = *(const f32x2*)(V + cc * 128 + cp * 2); s0 += v.x; s1 += v.y; }
      }
#pragma unroll
      for (int i = 0; i < 16; ++i) {
        const int c = cq * 16 + i, c0 = max(c - half, 0), c1 = min(c + half, 64);
        if (i > 0) {
          const int cadd = c + half - 1, csub = c - half - 1;
          if (cadd < 64) { const f32x2 v = *(const f32x2*)(V + cadd * 128 + cp * 2); s0 += v.x; s1 += v.y; }
          if (csub >= 0) { const f32x2 v = *(const f32x2*)(V + csub * 128 + cp * 2); s0 -= v.x; s1 -= v.y; }
        }
        const float inv = __builtin_amdgcn_rcpf((float)((r1 - r0) * (c1 - c0)));
        const size_t tokoff = ((size_t)b * SEQ + r * 64 + c) * 512 + j * 128 + cp * 2;
        const unsigned u = *(const unsigned*)(p.zP() + tokoff);
        *(unsigned*)(p.pooled() + tokoff) = pack2(s0 * inv - bflo(u), s1 * inv - bfhi(u));
      }
    }
  }
}
__device__ __forceinline__ void ph_res1(const P& p, int vb, int nvb) {
  const int lane = TIDX & 63, wid = TIDX >> 6;
  for (int m = vb * 4 + wid; m < NTOK; m += nvb * 4) {
    const float* md = p.mod() + (m / SEQ) * 6144;
    float mx[16]; float ss = 0.f;
#pragma unroll
    for (int i = 0; i < 4; ++i) {
      const uint2 u = *(const uint2*)(p.mix() + (size_t)m * DM + i * 256 + lane * 4);
      mx[4 * i] = bflo(u.x); mx[4 * i + 1] = bfhi(u.x); mx[4 * i + 2] = bflo(u.y); mx[4 * i + 3] = bfhi(u.y);
#pragma unroll
      for (int e = 0; e < 4; ++e) ss += mx[4 * i + e] * mx[4 * i + e];
    }
    ss = wave_sum(ss);
    const float rstd = rsqrtf(ss * (1.0f / 1024.0f) + 1e-6f);
    float x1[16]; float s2 = 0.f;
#pragma unroll
    for (int i = 0; i < 4; ++i) {
      const int col = i * 256 + lane * 4;
      const float4 xv = *(const float4*)(p.x + (size_t)m * DM + col), g = *(const float4*)(p.g_post_mix + col), gt = *(const float4*)(md + 2048 + col);
      x1[4 * i] = xv.x + gt.x * mx[4 * i] * rstd * g.x; x1[4 * i + 1] = xv.y + gt.y * mx[4 * i + 1] * rstd * g.y;
      x1[4 * i + 2] = xv.z + gt.z * mx[4 * i + 2] * rstd * g.z; x1[4 * i + 3] = xv.w + gt.w * mx[4 * i + 3] * rstd * g.w;
      { uint2 xb; xb.x = pack2(x1[4 * i], x1[4 * i + 1]); xb.y = pack2(x1[4 * i + 2], x1[4 * i + 3]); *(uint2*)(p.x1b() + (size_t)m * DM + col) = xb; }
#pragma unroll
      for (int e = 0; e < 4; ++e) s2 += x1[4 * i + e] * x1[4 * i + e];
    }
    s2 = wave_sum(s2);
    const float r2 = rsqrtf(s2 * (1.0f / 1024.0f) + 1e-6f);
#pragma unroll
    for (int i = 0; i < 4; ++i) {
      const int col = i * 256 + lane * 4;
      const float4 g = *(const float4*)(p.g_pre_ffn + col), sh = *(const float4*)(md + 3072 + col), sc = *(const float4*)(md + 4096 + col);
      uint2 w;
      w.x = pack2(x1[4 * i] * r2 * g.x * (1.f + sc.x) + sh.x, x1[4 * i + 1] * r2 * g.y * (1.f + sc.y) + sh.y);
      w.y = pack2(x1[4 * i + 2] * r2 * g.z * (1.f + sc.z) + sh.z, x1[4 * i + 3] * r2 * g.w * (1.f + sc.w) + sh.w);
      *(uint2*)(p.hx2() + (size_t)m * DM + col) = w;
    }
  }
}

#define PS1_SMEM (128 * 133 * 4)
#define CE_DESC(a, b) { const float _mx = fmaxf(a, b), _mn = fminf(a, b); a = _mx; b = _mn; }
template <int N> __device__ __forceinline__ void bitonic_sort_desc(float (&v)[N]) {
#pragma unroll
  for (int k = 2; k <= N; k <<= 1)
#pragma unroll
    for (int j = k >> 1; j > 0; j >>= 1)
#pragma unroll
      for (int i = 0; i < N; ++i) { const int l = i ^ j; if (l > i) { if ((i & k) == 0) CE_DESC(v[i], v[l]) else CE_DESC(v[l], v[i]) } }
}
__device__ __forceinline__ void bitonic_merge16_desc(float (&v)[16]) {
#pragma unroll
  for (int j = 8; j > 0; j >>= 1)
#pragma unroll
    for (int i = 0; i < 16; ++i) { const int l = i ^ j; if (l > i) CE_DESC(v[i], v[l]) }
}
struct Epi3PeerS1 {
  const bf16_t* keys; float* sv;
  __device__ __forceinline__ void finish(const bf16_t* sE, int m0, int n0, int tid) const {
    const int lane = tid & 63, w = tid >> 6, l15 = lane & 15, q = lane >> 4;
    const int hp = n0 >> 7;
    const bf16_t* kb = keys + (size_t)hp * 128 * 128;
    bf16x8 qf[4][4];
#pragma unroll
    for (int mt = 0; mt < 4; ++mt)
#pragma unroll
      for (int ks = 0; ks < 4; ++ks) qf[mt][ks] = *(const bf16x8*)(sE + (64 * w + 16 * mt + l15) * G3_ES + 32 * ks + 8 * q);
    f32x4 sc[4][8];
#pragma unroll
    for (int nt = 0; nt < 8; ++nt) {
      bf16x8 kf[4];
#pragma unroll
      for (int ks = 0; ks < 4; ++ks) kf[ks] = *(const bf16x8*)(kb + (size_t)(16 * nt + l15) * 128 + 32 * ks + 8 * q);
#pragma unroll
      for (int mt = 0; mt < 4; ++mt) {
        f32x4 acc = (f32x4){0.f, 0.f, 0.f, 0.f};
#pragma unroll
        for (int ks = 0; ks < 4; ++ks) acc = __builtin_amdgcn_mfma_f32_16x16x32_bf16(kf[ks], qf[mt][ks], acc, 0, 0, 0);
        sc[mt][nt] = acc;
      }
    }
#pragma unroll
    for (int mt = 0; mt < 4; ++mt) {
      const int row = 64 * w + 16 * mt + l15;
      float a[16], b[16];
#pragma unroll
      for (int nt = 0; nt < 8; ++nt)
#pragma unroll
        for (int rg = 0; rg < 4; ++rg) {
          const float v = __uint_as_float((__float_as_uint(sc[mt][nt][rg]) & ~127u) | (unsigned)(16 * nt + 4 * q + rg));
          if (nt < 4) a[4 * nt + rg] = v; else b[4 * (nt - 4) + rg] = v;
        }
      bitonic_sort_desc<16>(a); bitonic_sort_desc<16>(b);
#pragma unroll
      for (int i = 0; i < 16; ++i) a[i] = fmaxf(a[i], b[15 - i]);
      bitonic_merge16_desc(a);
#pragma unroll
      for (int lvl = 16; lvl <= 32; lvl <<= 1) {
#pragma unroll
        for (int i = 0; i < 16; ++i) b[i] = __shfl_xor(a[i], lvl);
#pragma unroll
        for (int i = 0; i < 16; ++i) a[i] = fmaxf(a[i], b[15 - i]);
        bitonic_merge16_desc(a);
      }
      if (q == 0) {
        const size_t ob = ((size_t)(m0 + row) * 16 + hp) * 16;
#pragma unroll
        for (int i = 0; i < 16; i += 4) *(f32x4*)(sv + ob + i) = (f32x4){a[i], a[i + 1], a[i + 2], a[i + 3]};
      }
    }
  }
};
__device__ __forceinline__ void ph_gemm_q_s1(const P& p, int vb, int nvb, unsigned char* smem) {
  Epi3PeerS1 epi{p.keys(), p.sv()};
  for (int round = 0;; ++round) {
    int tm, tn; const int r = xcd_tile(vb, nvb, round, NTOK / 256, 2048 / 128, tm, tn);
    if (r == 0) break;
    if (r == 1) gemm_tile3(p.hx2(), DM, p.Wt_q(), DM, DM, tm * 256, tn * 128, epi, smem);
  }
}
__device__ __forceinline__ void ph_peer_s1(const P& p, int vb, int nvb, unsigned char* smem) {
  float* S = (float*)smem;
  EpiLds epi{S};
  const int tid = TIDX, sub = tid & 3;
  for (int item = vb; item < 256 * 16; item += nvb) {
    const int hp = item & 15, tm = item >> 4;
    __syncthreads();
    gemm_tile(p.q() + hp * 128, 2048, p.keys() + (size_t)hp * 128 * 128, 128, 128, tm * 128, 0, epi, smem);
    __syncthreads();
#pragma unroll 1
    for (int pass = 0; pass < 2; ++pass) {
      const int row = pass * 64 + (tid >> 2);
      float a[16], b[16];
#pragma unroll
      for (int i = 0; i < 16; ++i) {
        a[i] = __uint_as_float((__float_as_uint(S[row * 133 + sub * 33 + i]) & ~127u) | (unsigned)(sub * 32 + i));
        b[i] = __uint_as_float((__float_as_uint(S[row * 133 + sub * 33 + 16 + i]) & ~127u) | (unsigned)(sub * 32 + 16 + i));
      }
      bitonic_sort_desc<16>(a); bitonic_sort_desc<16>(b);
#pragma unroll
      for (int i = 0; i < 16; ++i) a[i] = fmaxf(a[i], b[15 - i]);
      bitonic_merge16_desc(a);
#pragma unroll
      for (int lvl = 1; lvl <= 2; lvl <<= 1) {
#pragma unroll
        for (int i = 0; i < 16; ++i) b[i] = __shfl_xor(a[i], lvl);
#pragma unroll
        for (int i = 0; i < 16; ++i) a[i] = fmaxf(a[i], b[15 - i]);
        bitonic_merge16_desc(a);
      }
      if (sub == 0) {
        const size_t ob = ((size_t)(tm * 128 + row) * 16 + hp) * 16;
#pragma unroll
        for (int i = 0; i < 16; i += 4) {
          *(f32x4*)(p.sv() + ob + i) = (f32x4){a[i], a[i + 1], a[i + 2], a[i + 3]};
        }
      }
    }
  }
}
__device__ __forceinline__ void top16_merge(float (&x)[16], const float (&y)[16]) {
#pragma unroll
  for (int i = 0; i < 16; ++i) x[i] = fmaxf(x[i], y[15 - i]);
  bitonic_merge16_desc(x);
}
__device__ __forceinline__ void peer_s2_lut(unsigned char* lut) {
  if (TIDX == 0) {
    int n = 0;
#pragma unroll
    for (int i = 0; i < 16; ++i)
#pragma unroll
      for (int j = 0; j < 16; ++j)
        if ((i + 1) * (j + 1) <= 16) { lut[n] = (unsigned char)((i << 4) | j); ++n; }
  }
}
__device__ __forceinline__ void peer_s2_one(const P& p, const unsigned char* lut, int it) {
  {
    const size_t ob = (size_t)it * 32;
    float a[16], bq[16];
#pragma unroll
    for (int i = 0; i < 16; i += 4) {
      const f32x4 fa = *(const f32x4*)(p.sv() + ob + i), fb = *(const f32x4*)(p.sv() + ob + 16 + i);
#pragma unroll
      for (int e = 0; e < 4; ++e) { a[i + e] = fa[e]; bq[i + e] = fb[e]; }
    }
    float g0[16], g1[16], g2[16], g3[16];
    {
      int n = 0;
#pragma unroll
      for (int i = 0; i < 16; ++i)
#pragma unroll
        for (int j = 0; j < 16; ++j)
          if ((i + 1) * (j + 1) <= 16) {
            const float v = __uint_as_float((__float_as_uint(a[i] + bq[j]) & ~63u) | (unsigned)n);
            if (n < 16) g0[n] = v; else if (n < 32) g1[n - 16] = v; else if (n < 48) g2[n - 32] = v; else g3[n - 48] = v;
            ++n;
          }
#pragma unroll
      for (int k = 2; k < 16; ++k) g3[k] = -3.0e38f;
    }
    bitonic_sort_desc<16>(g0); bitonic_sort_desc<16>(g1); bitonic_sort_desc<16>(g2); bitonic_sort_desc<16>(g3);
    top16_merge(g0, g1); top16_merge(g2, g3); top16_merge(g0, g2);
    float den = 0.f; float ex[16]; int seli[16];
#pragma unroll
    for (int k = 0; k < 16; ++k) {
      ex[k] = __expf(g0[k] - g0[0]); den += ex[k];
      const int ij = lut[__float_as_uint(g0[k]) & 63u];
      const int ka = (int)(__float_as_uint(p.sv()[ob + (ij >> 4)]) & 127u), kb = (int)(__float_as_uint(p.sv()[ob + 16 + (ij & 15)]) & 127u);
      seli[k] = ka * 128 + kb;
    }
    const float inv = 1.0f / den;
    const size_t o2 = (size_t)it * 16;
    typedef int i32x4 __attribute__((ext_vector_type(4)));
#pragma unroll
    for (int k = 0; k < 16; k += 4) {
      *(i32x4*)(p.pidx() + o2 + k) = (i32x4){seli[k], seli[k + 1], seli[k + 2], seli[k + 3]};
      *(f32x4*)(p.pgate() + o2 + k) = (f32x4){ex[k] * inv, ex[k + 1] * inv, ex[k + 2] * inv, ex[k + 3] * inv};
    }
  }
}
__device__ __forceinline__ void ph_gemm_q_s12(const P& p, int vb, int nvb, unsigned char* smem) {
  Epi3PeerS1 epi{p.keys(), p.sv()};
  unsigned char* lut = smem + 79872;
  __syncthreads();
  peer_s2_lut(lut);
  __syncthreads();
  for (int round = 0;; ++round) {
    int tm, th; const int r = xcd_tile(vb, nvb, round, NTOK / 256, 8, tm, th);
    if (r == 0) break;
    if (r == 1) {
      gemm_tile3(p.hx2(), DM, p.Wt_q(), DM, DM, tm * 256, (2 * th) * 128, epi, smem);
      gemm_tile3(p.hx2(), DM, p.Wt_q(), DM, DM, tm * 256, (2 * th + 1) * 128, epi, smem);
      asm volatile("s_waitcnt vmcnt(0)" ::: "memory");
      __syncthreads();
      peer_s2_one(p, lut, (tm * 256 + TIDX) * 8 + th);
    }
  }
}
typedef float f32x16 __attribute__((ext_vector_type(16)));
typedef float f32x32 __attribute__((ext_vector_type(32)));
typedef unsigned u32x6 __attribute__((ext_vector_type(6)));
__device__ __forceinline__ float gelu_as(float v) {
  const float t = __builtin_amdgcn_rcpf(fabsf(v) * 0.2316418882f + 1.0f);
  float qq = t * 0.5307027145f + (-0.7265760135f); qq = qq * t + 0.7107068705f; qq = qq * t + (-0.142248368f); qq = qq * t + 0.127414796f; qq = qq * t;
  const float m = v * (qq * __builtin_amdgcn_exp2f((v * v) * (-0.72134752044f)));
  return v < 0.f ? m : v - m;
}
__device__ __forceinline__ float half_max(float v) {
#pragma unroll
  for (int o = 16; o > 0; o >>= 1) v = fmaxf(v, __shfl_xor(v, o));
  return v;
}
__device__ __forceinline__ float half_sum(float v) {
#pragma unroll
  for (int o = 16; o > 0; o >>= 1) v += __shfl_xor(v, o);
  return v;
}
__device__ __forceinline__ void ph_cvt_fp6(const float* __restrict__ in, unsigned char* __restrict__ out, float* __restrict__ inv_scale, int vb, int nvb) {
  const int lane = TIDX & 63, wid = TIDX >> 6, hf = lane >> 5, sl = lane & 31;
  for (int rp = vb * 4 + wid; rp < 8192; rp += nvb * 4) {
    const int row = rp * 2 + hf;
    f32x16 a, b2; float am = 0.f;
#pragma unroll
    for (int i = 0; i < 4; ++i) {
      const f32x4 v0 = *(const f32x4*)(in + (size_t)row * DM + sl * 32 + 4 * i), v1 = *(const f32x4*)(in + (size_t)row * DM + sl * 32 + 16 + 4 * i);
#pragma unroll
      for (int e = 0; e < 4; ++e) { a[4 * i + e] = v0[e]; b2[4 * i + e] = v1[e]; am = fmaxf(am, fmaxf(fabsf(v0[e]), fabsf(v1[e]))); }
    }
    am = half_max(am);
    const float sc = am > 0.f ? 7.0f / am : 1.0f;
    const u32x6 pk = __builtin_amdgcn_cvt_scalef32_2xpk16_fp6_f32(a * sc, b2 * sc, 1.0f);
    unsigned char* o = out + (size_t)row * 768 + sl * 24;
    *(u32x2*)(o) = (u32x2){pk[0], pk[1]}; *(u32x2*)(o + 8) = (u32x2){pk[2], pk[3]}; *(u32x2*)(o + 16) = (u32x2){pk[4], pk[5]};
    if (sl == 0) inv_scale[row] = am > 0.f ? am / 7.0f : 1.0f;
  }
}
__device__ __forceinline__ void ph_cvt_fp4(const float* __restrict__ in, unsigned char* __restrict__ out, float* __restrict__ inv_scale, int vb, int nvb) {
  const int lane = TIDX & 63, wid = TIDX >> 6, hf = lane >> 5, sl = lane & 31;
  const f32x2 probe = __builtin_amdgcn_cvt_scalef32_pk_f32_fp4(__builtin_amdgcn_cvt_scalef32_pk_fp4_f32(0u, 1.0f, 2.0f, 1.0f, 0), 1.0f, 0);
  const bool sw = probe.x != 1.0f;
  for (int rp = vb * 4 + wid; rp < 8192; rp += nvb * 4) {
    const int row = rp * 2 + hf;
    f32x4 v[8]; float am = 0.f;
#pragma unroll
    for (int i = 0; i < 8; ++i) {
      v[i] = *(const f32x4*)(in + (size_t)row * DM + sl * 32 + 4 * i);
#pragma unroll
      for (int e = 0; e < 4; ++e) am = fmaxf(am, fabsf(v[i][e]));
    }
    am = half_max(am);
    const float sc = am > 0.f ? 6.0f / am : 1.0f;
    u32x4 pk = (u32x4){0u, 0u, 0u, 0u};
#pragma unroll
    for (int w = 0; w < 4; ++w) {
      unsigned word = 0u;
      float c[8];
#pragma unroll
      for (int e = 0; e < 4; ++e) { c[e] = v[2 * w][e] * sc; c[4 + e] = v[2 * w + 1][e] * sc; }
      word = __builtin_amdgcn_cvt_scalef32_pk_fp4_f32(word, sw ? c[1] : c[0], sw ? c[0] : c[1], 1.0f, 0);
      word = __builtin_amdgcn_cvt_scalef32_pk_fp4_f32(word, sw ? c[3] : c[2], sw ? c[2] : c[3], 1.0f, 1);
      word = __builtin_amdgcn_cvt_scalef32_pk_fp4_f32(word, sw ? c[5] : c[4], sw ? c[4] : c[5], 1.0f, 2);
      word = __builtin_amdgcn_cvt_scalef32_pk_fp4_f32(word, sw ? c[7] : c[6], sw ? c[6] : c[7], 1.0f, 3);
      pk[w] = word;
    }
    *(u32x4*)(out + (size_t)row * 512 + sl * 16) = pk;
    if (sl == 0) inv_scale[row] = am > 0.f ? am / 6.0f : 1.0f;
  }
}
__device__ __forceinline__ u32x6 load_row6(const unsigned char* base, int id, int sl) {
  const unsigned char* q = base + (size_t)id * 768 + sl * 24;
  const u32x2 a = *(const u32x2*)q, b = *(const u32x2*)(q + 8), c = *(const u32x2*)(q + 16);
  return (u32x6){a.x, a.y, b.x, b.y, c.x, c.y};
}
#define GATHER_SMEM (4 * 64 * 33 * 4)
__device__ __forceinline__ void ph_peer_gather(const P& p, int vb, int nvb, unsigned char* smem) {
  int tid_ = TIDX;
  asm volatile("" : "+v"(tid_));
  const int lane = tid_ & 63, wid = tid_ >> 6, hf = lane >> 5, sl = lane & 31;
  float* scr = (float*)smem + (wid * 64 + lane) * 33;
  int* tauL = (int*)(smem + GATHER_SMEM) + wid * 32;
  {
    f32x16 a, b2;
#pragma unroll
    for (int i = 0; i < 16; ++i) { a[i] = __uint_as_float((unsigned)i << 20) * 0x1p126f; b2[i] = __uint_as_float((unsigned)(16 + i) << 20) * 0x1p126f; }
    const f32x32 o = __builtin_amdgcn_cvt_scalef32_pk32_f32_fp6(__builtin_amdgcn_cvt_scalef32_2xpk16_fp6_f32(a, b2, 1.0f), 1.0f);
    if (lane == 0) {
#pragma unroll
      for (int j = 0; j < 32; ++j) tauL[j] = (int)((__float_as_uint(o[j] * 0x1p-126f) >> 20) & 31u);
    }
  }
  const int jmap = 2 * (lane & 1) + ((lane >> 1) & 1);
  __syncthreads();
  int id0, id1; float su0, su1, gs0, gs1; u32x4 xr[4];
  {
    const int m0 = min(vb * 4 + wid, NTOK - 1);
    id0 = p.pidx()[(size_t)m0 * 128 + lane]; id1 = p.pidx()[(size_t)m0 * 128 + 64 + lane];
#pragma unroll
    for (int c4 = 0; c4 < 4; ++c4) xr[c4] = *(const u32x4*)(p.hx2() + (size_t)m0 * DM + sl * 32 + 8 * c4);
    su0 = p.us()[id0]; su1 = p.us()[id1];
    gs0 = p.pgate()[(size_t)m0 * 128 + lane] * p.vs()[id0]; gs1 = p.pgate()[(size_t)m0 * 128 + 64 + lane] * p.vs()[id1];
  }
  for (int m = vb * 4 + wid; m < NTOK; m += nvb * 4) {
    const float* md = p.mod() + (m / SEQ) * 6144;
    f32x2 xp2[16];
#pragma unroll
    for (int c4 = 0; c4 < 4; ++c4)
#pragma unroll
      for (int e = 0; e < 4; ++e) xp2[4 * c4 + e] = (f32x2){bflo(xr[c4][e]), bfhi(xr[c4][e])};
    const int mn = min(m + nvb * 4, NTOK - 1);
    const int nid0 = p.pidx()[(size_t)mn * 128 + lane], nid1 = p.pidx()[(size_t)mn * 128 + 64 + lane];
    const float ng0 = p.pgate()[(size_t)mn * 128 + lane], ng1 = p.pgate()[(size_t)mn * 128 + 64 + lane];
#pragma unroll
    for (int c4 = 0; c4 < 4; ++c4) xr[c4] = *(const u32x4*)(p.hx2() + (size_t)mn * DM + sl * 32 + 8 * c4);
    float nsu0 = 0.f, nsu1 = 0.f, nvs0 = 0.f, nvs1 = 0.f;
    u32x2 xres[4];
#pragma unroll
    for (int k4 = 0; k4 < 4; ++k4) xres[k4] = *(const u32x2*)(p.x1b() + (size_t)m * DM + sl * 32 + hf * 16 + k4 * 4);
    f32x2 acc2[16];
#pragma unroll
    for (int k = 0; k < 16; ++k) acc2[k] = (f32x2){0.f, 0.f};
#pragma unroll 1
    for (int e0 = 0; e0 < 128; e0 += 8) {
      if (e0 == 64) { nsu0 = p.us()[nid0]; nsu1 = p.us()[nid1]; nvs0 = p.vs()[nid0]; nvs1 = p.vs()[nid1]; }
      u32x4 ur[4], vr[4];
#pragma unroll
      for (int j = 0; j < 4; ++j) {
        const int id = __shfl(e0 < 64 ? id0 : id1, (e0 + hf * 4 + j) & 63);
        ur[j] = *(const u32x4*)(p.ub8() + (size_t)id * 512 + sl * 16);
        vr[j] = *(const u32x4*)(p.vb8() + (size_t)id * 512 + sl * 16);
      }
      float d[4];
#pragma unroll
      for (int j = 0; j < 4; ++j) {
        f32x2 s0 = (f32x2){0.f, 0.f}, s1 = (f32x2){0.f, 0.f};
#pragma unroll
        for (int w = 0; w < 4; ++w) {
          s0 += __builtin_amdgcn_cvt_scalef32_pk_f32_fp4(ur[j][w], 1.0f, 0) * xp2[4 * w + 0];
          s1 += __builtin_amdgcn_cvt_scalef32_pk_f32_fp4(ur[j][w], 1.0f, 1) * xp2[4 * w + 1];
          s0 += __builtin_amdgcn_cvt_scalef32_pk_f32_fp4(ur[j][w], 1.0f, 2) * xp2[4 * w + 2];
          s1 += __builtin_amdgcn_cvt_scalef32_pk_f32_fp4(ur[j][w], 1.0f, 3) * xp2[4 * w + 3];
        }
        d[j] = (s0.x + s0.y) + (s1.x + s1.y);
      }
      float r2[2], r1;
      {
        const bool lo = (lane & 1) == 0;
#pragma unroll
        for (int i = 0; i < 2; ++i) { const float keep = lo ? d[i] : d[i + 2], send = lo ? d[i + 2] : d[i]; r2[i] = keep + __shfl_xor(send, 1); }
        const bool lo2 = (lane & 2) == 0;
        { const float keep = lo2 ? r2[0] : r2[1], send = lo2 ? r2[1] : r2[0]; r1 = keep + __shfl_xor(send, 2); }
        r1 += __shfl_xor(r1, 4); r1 += __shfl_xor(r1, 8); r1 += __shfl_xor(r1, 16);
      }
      const int esrc = (e0 + hf * 4 + jmap) & 63;
      const float su = __shfl(e0 < 64 ? su0 : su1, esrc), gs = __shfl(e0 < 64 ? gs0 : gs1, esrc);
      const float sdot = r1 * su;
      const float cf = gelu_as(sdot) * gs;
#pragma unroll
      for (int j = 0; j < 4; ++j) {
        const float cj = __shfl(cf, (lane & 32) | ((j >> 1) | ((j & 1) << 1)));
        const f32x2 cj2 = (f32x2){cj, cj};
#pragma unroll
        for (int w = 0; w < 4; ++w) {
          acc2[4 * w + 0] += cj2 * __builtin_amdgcn_cvt_scalef32_pk_f32_fp4(vr[j][w], 1.0f, 0);
          acc2[4 * w + 1] += cj2 * __builtin_amdgcn_cvt_scalef32_pk_f32_fp4(vr[j][w], 1.0f, 1);
          acc2[4 * w + 2] += cj2 * __builtin_amdgcn_cvt_scalef32_pk_f32_fp4(vr[j][w], 1.0f, 2);
          acc2[4 * w + 3] += cj2 * __builtin_amdgcn_cvt_scalef32_pk_f32_fp4(vr[j][w], 1.0f, 3);
        }
      }
    }
#pragma unroll
    for (int k = 0; k < 16; ++k) { scr[2 * k] = acc2[k].x + __shfl_xor(acc2[k].x, 32); scr[2 * k + 1] = acc2[k].y + __shfl_xor(acc2[k].y, 32); }
    lds_wave_fence();
    float ss = 0.f;
#pragma unroll
    for (int k = 0; k < 32; ++k) { const float v = scr[k]; ss += v * v; }
    ss = half_sum(ss);
    const float rstd = rsqrtf(ss * (1.0f / 1024.0f) + 1e-6f);
#pragma unroll
    for (int k4 = 0; k4 < 4; ++k4) {
      const int kk = hf * 16 + k4 * 4, col = sl * 32 + kk;
      const u32x2 xb = xres[k4];
      f32x4 x1 = (f32x4){bflo(xb.x), bfhi(xb.x), bflo(xb.y), bfhi(xb.y)};
      const f32x4 g = *(const f32x4*)(p.g_post_ffn + col), gt = *(const f32x4*)(md + 5120 + col);
#pragma unroll
      for (int e = 0; e < 4; ++e) x1[e] += gt[e] * scr[kk + e] * rstd * g[e];
      *(f32x4*)(p.out + (size_t)m * DM + col) = x1;
    }
    lds_wave_fence();
    id0 = nid0; id1 = nid1; su0 = nsu0; su1 = nsu1; gs0 = ng0 * nvs0; gs1 = ng1 * nvs1;
  }
}

#define XB_TMO      128
#define XB_XCNT(j)  (256  + 64 * (j))
#define XB_XSUB(j)  (1280 + 64 * (j))
#define XB_XGEN(j)  (2304 + 64 * (j))
#define XB_TOP      3328
#define XB_TOPGEN   3392
#define XCD_BAR_WORDS 3456
#define XB_SPIN_CAP (1u << 20)
#define LAS __attribute__((address_space(3)))
__device__ __forceinline__ unsigned xb_ld(unsigned* p)              { return __hip_atomic_load(p, __ATOMIC_RELAXED, __HIP_MEMORY_SCOPE_AGENT); }
__device__ __forceinline__ unsigned xb_add(unsigned* p, unsigned v) { return __hip_atomic_fetch_add(p, v, __ATOMIC_RELAXED, __HIP_MEMORY_SCOPE_AGENT); }
__device__ __forceinline__ unsigned xb_xcc_id() { return (unsigned)__builtin_amdgcn_s_getreg((3 << 11) | 20) & 0xFu; }
#define XB_SPIN(cond, bar) do { unsigned _sp = 0; while (cond) { __builtin_amdgcn_s_sleep(1); \
    if ((++_sp & 255u) == 0u) { if (xb_ld(&(bar)[XB_TMO])) break; if (_sp > XB_SPIN_CAP) { atomicAdd(&(bar)[XB_TMO], 1u); break; } } } } while (0)
struct XcdBarrier { unsigned* bar; unsigned x; volatile LAS unsigned* st; };
__device__ __forceinline__ XcdBarrier xcd_barrier_post(unsigned* bar, volatile LAS unsigned* st) {
  XcdBarrier b; b.bar = bar; b.x = xb_xcc_id(); b.st = st;
  if (TIDX == 0) (void)xb_add(&bar[XB_XCNT(b.x)], 1u);
  return b;
}
__device__ __forceinline__ void xcd_barrier_complete(unsigned* bar, unsigned x, unsigned& nloc, unsigned& nx) {
  const unsigned G = gridDim.x * gridDim.y * gridDim.z;
  unsigned sum, cnt, mine, sp = 0u;
  for (;;) {
    sum = 0u; cnt = 0u; mine = 0u;
#pragma unroll
    for (unsigned j = 0; j < 16; ++j) { const unsigned c = xb_ld(&bar[XB_XCNT(j)]); sum += c; cnt += (c > 0u) ? 1u : 0u; mine = (j == x) ? c : mine; }
    if (sum == G) break;
    __builtin_amdgcn_s_sleep(1);
    if ((++sp & 255u) == 0u) { if (xb_ld(&bar[XB_TMO])) break; if (sp > XB_SPIN_CAP) { atomicAdd(&bar[XB_TMO], 1u); break; } }
  }
  nloc = mine > 0u ? mine : 1u; nx = cnt > 0u ? cnt : 1u;
}
__device__ __forceinline__ void xcd_barrier(const XcdBarrier& b) {
  asm volatile("s_waitcnt vmcnt(0)" ::: "memory");
  __syncthreads();
  if (TIDX == 0) {
    unsigned* bar = b.bar;
    __builtin_amdgcn_s_waitcnt(0);
    unsigned nloc = b.st[0], nx = b.st[1];
    if (nloc == 0u) { xcd_barrier_complete(bar, b.x, nloc, nx); b.st[0] = nloc; b.st[1] = nx; }
    const unsigned old = xb_add(&bar[XB_XSUB(b.x)], 1u);
    const unsigned gen = old / nloc;
    if (old + 1u == (gen + 1u) * nloc) {
      __builtin_amdgcn_fence(__ATOMIC_RELEASE, "agent");
      asm volatile("s_waitcnt vmcnt(0)" ::: "memory");
      const unsigned og = xb_add(&bar[XB_TOP], 1u);
      const unsigned tg = og / nx;
      if (og + 1u == (tg + 1u) * nx) xb_add(&bar[XB_TOPGEN], 1u);
      else XB_SPIN(xb_ld(&bar[XB_TOPGEN]) == tg, bar);
      __builtin_amdgcn_fence(__ATOMIC_ACQUIRE, "agent");
      xb_add(&bar[XB_XGEN(b.x)], 1u);
      asm volatile("s_waitcnt vmcnt(0)" ::: "memory");
    } else {
      XB_SPIN(xb_ld(&bar[XB_XGEN(b.x)]) == gen, bar);
      __builtin_amdgcn_fence(__ATOMIC_ACQUIRE, "agent");
      asm volatile("s_waitcnt vmcnt(0)" ::: "memory");
    }
  }
  __syncthreads();
}

#define SMEM_BYTES RWKV_SMEM
typedef const __attribute__((address_space(4))) P* KArgs;
__device__ __forceinline__ P load_args() {
#if defined(__HIP_DEVICE_COMPILE__)
  KArgs k = (KArgs)__builtin_amdgcn_kernarg_segment_ptr();
  asm volatile("" : "+s"(k));
  return *k;
#else
  return P{};
#endif
}
__global__ void __launch_bounds__(256, 2) mega(P pk) {
  __shared__ __attribute__((aligned(16))) unsigned char smem[SMEM_BYTES + 16];
  cg::grid_group grid = cg::this_grid();
  const int vb = blockIdx.x, nvb = gridDim.x;
  if (TIDX == 0) *(u32x4*)(smem + SMEM_BYTES) = (u32x4){0u, 0u, 0u, 0u};
  __syncthreads();
  const XcdBarrier xb = xcd_barrier_post(pk.bar, (volatile LAS unsigned*)(smem + SMEM_BYTES));
  {
    const P p = load_args();
    ph_mod(p, vb, nvb, smem);
    {
      const bool split = nvb >= 384;
      const int v2 = split ? vb - 192 : vb, n2 = split ? nvb - 192 : nvb;
      if (v2 >= 0) {
        ph_colmax(p.w_in, p.colmax, DM, INC, v2, n2, smem);
        ph_transpose(p.w2, p.w2T(), 64, 1024, v2, n2, smem);
        ph_transpose(p.w2 + 65536, p.w2T() + 65536, 64, 1024, v2, n2, smem);
        ph_transpose(p.a2, p.a2T(), 64, 1024, v2, n2, smem);
        ph_transpose(p.a2 + 65536, p.a2T() + 65536, 64, 1024, v2, n2, smem);
      }
    }
    if (p.bar == nullptr) grid.sync();
  }
  xcd_barrier(xb);
  {
    const P p = load_args();
    ph_norm1(p, vb, nvb);
    ph_transpose_i8(p.w_in, p.Wt8(), p.colmax, p.wsb(), DM, INC, vb, nvb, smem);
  }
  xcd_barrier(xb);
  {
    const P p = load_args();
    ph_gemm1(p, vb, nvb, smem);
  }
  xcd_barrier(xb);
  {
    const P p = load_args();
    ph_rwkv_A(p, vb, nvb, smem);
  }
  xcd_barrier(xb);
  {
    const P p = load_args();
    ph_rwkv_B(p, vb, nvb, smem);
    if (nvb > 256 && vb >= 64 && !(vb >= (nvb >> 1) && vb < (nvb >> 1) + 64)) {
      const int v2 = vb < (nvb >> 1) ? vb - 64 : vb - 128, n2 = nvb - 128;
      ph_transpose(p.w_a_out, p.Wt_aout(), DM, DM, v2, n2, smem);
      ph_transpose(p.w_o, p.Wt_o(), DM, DM, v2, n2, smem);
      ph_transpose(p.peer_wq, p.Wt_q(), DM, 2048, v2, n2, smem);
      ph_transpose(p.g2, p.g2T(), 128, 1024, v2, n2, smem);
      ph_weff(p, v2, n2);
      ph_convert(p.peer_keys, p.keys(), (size_t)16 * 128 * 128, v2, n2);
    } else if (nvb <= 256) {
      ph_transpose(p.w_a_out, p.Wt_aout(), DM, DM, vb, nvb, smem);
      ph_transpose(p.w_o, p.Wt_o(), DM, DM, vb, nvb, smem);
      ph_transpose(p.peer_wq, p.Wt_q(), DM, 2048, vb, nvb, smem);
      ph_transpose(p.g2, p.g2T(), 128, 1024, vb, nvb, smem);
      ph_weff(p, vb, nvb);
      ph_convert(p.peer_keys, p.keys(), (size_t)16 * 128 * 128, vb, nvb);
    }
  }
  xcd_barrier(xb);
  {
    const P p = load_args();
    ph_ycorr(p, vb, nvb, smem);
    ph_pool(p, vb, nvb, smem);
    ph_cvt_fp4(p.peer_u, p.ub8(), p.us(), vb, nvb);
  }
  xcd_barrier(xb);
  {
    const P p = load_args();
    ph_gemm_merge(p, vb, nvb, smem);
    ph_cvt_fp4(p.peer_v, p.vb8(), p.vs(), vb, nvb);
  }
  xcd_barrier(xb);
  {
    const P p = load_args();
    ph_gemm_simple(p.mrg(), DM, p.Wt_o(), DM, DM, NTOK, DM, p.mix(), DM, vb, nvb, smem);
  }
  xcd_barrier(xb);
  {
    const P p = load_args();
    ph_res1(p, vb, nvb);
  }
  xcd_barrier(xb);
  {
    const P p = load_args();
    ph_gemm_q_s12(p, vb, nvb, smem);
  }
  xcd_barrier(xb);
  {
    const P p = load_args();
    ph_peer_gather(p, vb, nvb, smem);
  }
}

extern "C" void kernel_launch(void* const* d_in, const int* in_sizes, int n_in, void* d_out, int out_size, void* d_ws, size_t ws_size, hipStream_t stream) {
  P p{};
  const float** f = (const float**)&p;
  for (int i = 0; i < 32; ++i) f[i] = (const float*)d_in[i];
  p.out = (float*)d_out;
  p.bar = (unsigned*)((unsigned char*)d_ws + 511 * 1048576);
  unsigned char* w = (unsigned char*)d_ws;
  const size_t MiB = 1048576;
  const size_t HM = 524288;
  p.w = w;
  p.colmax = p.bar + XCD_BAR_WORDS;
  static int grid_blocks = 0;
  if (!grid_blocks) {
    int dev = 0, cus = 0, per_cu = 0;
    hipGetDevice(&dev);
    hipDeviceGetAttribute(&cus, hipDeviceAttributeMultiprocessorCount, dev);
    hipOccupancyMaxActiveBlocksPerMultiprocessor(&per_cu, mega, 256, 0);
    if (per_cu > 2) per_cu = 2;
    if (per_cu < 1) per_cu = 1;
    grid_blocks = cus * per_cu;
  }
  hipMemsetAsync(p.bar, 0, (XCD_BAR_WORDS + 6016) * 4, stream);
  void* args[] = {&p};
  hipError_t e = hipLaunchCooperativeKernel((void*)mega, dim3(grid_blocks), dim3(256), args, 0, stream);
  if (e != hipSuccess) fprintf(stderr, "cooperative launch failed: %s (grid %d)\n", hipGetErrorString(e), grid_blocks);
}
```
